# Optimizing an MI355X kernel written in HIP

```python
import math
import jax, jax.numpy as jnp
from jax import lax
import numpy as np

D_MODEL = 2048
BATCH = 4
SEQ = 2048
DEPTH = 1

GRID_W = 64
CTX_LEN = 256
EPS = 1e-6
N_MOD = 6

D_MIX = D_MODEL
D_FOURIER = D_MIX // 2
N_FOURIER_GROUPS = 4
FOURIER_GROUP = D_FOURIER // N_FOURIER_GROUPS
D_SSM = D_MIX - D_FOURIER
SSM_HEAD_DIM = 64
SSM_HEADS = D_SSM // SSM_HEAD_DIM
SSM_GROUPS = 2
SSM_STATE = 128
SSM_CONV = 3
SSM_CHUNK = 128
D_BC = SSM_GROUPS * SSM_STATE
D_XBC = D_SSM + 2 * D_BC
OFF_Z = D_FOURIER
OFF_XBC = OFF_Z + D_SSM
OFF_DT = OFF_XBC + D_XBC
D_IN_PROJ = OFF_DT + 2 * SSM_HEADS

PEER_HEADS = 8
PEER_TOPK = 16
PEER_N_KEYS = 128
PEER_EXPERTS = PEER_N_KEYS * PEER_N_KEYS
PEER_KEY_DIM = 128
PEER_HALF = PEER_KEY_DIM // 2
PEER_TOKEN_BLOCK = 128

kernel_name = 'fourier_ssd_peer_hybrid_dit'


def rms_norm(u, g):
    uf = u.astype(jnp.float32)
    y = uf * lax.rsqrt(jnp.mean(uf * uf, axis=-1, keepdims=True) + EPS)
    return (y * g.astype(jnp.float32)).astype(u.dtype)


def group_rms_norm(u, g, n_groups):
    shp = u.shape
    ug = u.reshape(*shp[:-1], n_groups, shp[-1] // n_groups).astype(jnp.float32)
    y = ug * lax.rsqrt(jnp.mean(ug * ug, axis=-1, keepdims=True) + EPS)
    return (y.reshape(shp) * g.astype(jnp.float32)).astype(u.dtype)


def adaln_params(cond, w_mod, b_mod):
    m = jax.nn.silu(cond) @ w_mod + b_mod
    return jnp.split(m[:, None, :], N_MOD, axis=-1)


def modulate(h, shift, scale):
    return h * (1 + scale) + shift


def centred_dwconv(u, w, b):
    k = w.shape[0]
    pad = k // 2
    length = u.shape[1]
    up = jnp.pad(u, ((0, 0), (pad, k - 1 - pad), (0, 0)))
    return sum(up[:, i:i + length] * w[i] for i in range(k)) + b


def segsum(a):
    t = a.shape[-1]
    cs = jnp.cumsum(a, axis=-1)
    diff = cs[..., :, None] - cs[..., None, :]
    mask = jnp.tril(jnp.ones((t, t), dtype=bool))
    return jnp.where(mask, diff, -jnp.inf)


def ssd_chunked(xs, dt, a, bm, cm, init):
    bsz, length, h, p = xs.shape
    nc = length // SSM_CHUNK
    ch = lambda t: t.reshape(bsz, nc, SSM_CHUNK, *t.shape[2:])
    xdt = ch(xs * dt[..., None])
    bc, cc = ch(bm), ch(cm)
    a_dt = jnp.moveaxis(ch(dt * a), -1, 1)
    a_cum = jnp.cumsum(a_dt, axis=-1)
    l_mat = jnp.exp(segsum(a_dt))
    y_diag = jnp.einsum('bclhn,bcshn,bhcls,bcshp->bclhp', cc, bc, l_mat, xdt)
    decay_states = jnp.exp(a_cum[..., -1:] - a_cum)
    states = jnp.einsum('bclhn,bhcl,bclhp->bchpn', bc, decay_states, xdt)
    states = jnp.concatenate([init[:, None], states], axis=1)
    chunk_decay = jnp.exp(segsum(jnp.pad(a_cum[..., -1], ((0, 0), (0, 0), (1, 0)))))
    new_states = jnp.einsum('bhzc,bchpn->bzhpn', chunk_decay, states)
    states, final = new_states[:, :-1], new_states[:, -1]
    y_off = jnp.einsum('bclhn,bchpn,bhcl->bclhp', cc, states, jnp.exp(a_cum))
    return (y_diag + y_off).reshape(bsz, length, h, p), final


def fourier_branch(proj, w_fmix):
    bsz, length, _ = proj.shape
    f = proj[..., :OFF_Z].reshape(bsz, length, N_FOURIER_GROUPS, FOURIER_GROUP)
    fr = jnp.fft.fftn(f.astype(jnp.float32), axes=(1, 3), norm='ortho').real.astype(proj.dtype)
    return jnp.einsum('blgc,gcd->blgd', fr, w_fmix).reshape(bsz, length, D_FOURIER)


def ssd_branch(proj, conv_w, conv_b, dt_bias_f, dt_bias_b, a_log_f, a_log_b,
               d_skip_f, d_skip_b, ssm_norm_w, init_f, init_b):
    bsz, length, _ = proj.shape
    f32 = jnp.float32
    z = proj[..., OFF_Z:OFF_XBC]
    xbc = jax.nn.silu(centred_dwconv(proj[..., OFF_XBC:OFF_DT], conv_w, conv_b)).astype(f32)
    dt_raw = proj[..., OFF_DT:].astype(f32)
    rep = SSM_HEADS // SSM_GROUPS
    xs = xbc[..., :D_SSM].reshape(bsz, length, SSM_HEADS, SSM_HEAD_DIM)
    bm = jnp.repeat(xbc[..., D_SSM:D_SSM + D_BC].reshape(bsz, length, SSM_GROUPS, SSM_STATE), rep, axis=2)
    cm = jnp.repeat(xbc[..., D_SSM + D_BC:].reshape(bsz, length, SSM_GROUPS, SSM_STATE), rep, axis=2)
    dt_f = jax.nn.softplus(dt_raw[..., :SSM_HEADS] + dt_bias_f.astype(f32))
    dt_b = jax.nn.softplus(dt_raw[..., SSM_HEADS:] + dt_bias_b.astype(f32))
    a_f = -jnp.exp(a_log_f.astype(f32))
    a_b = -jnp.exp(a_log_b.astype(f32))
    flip = lambda t: jnp.flip(t, axis=1)
    y_f, fin_f = ssd_chunked(xs, dt_f, a_f, bm, cm, init_f)
    y_b, fin_b = ssd_chunked(flip(xs), flip(dt_b), a_b, flip(bm), flip(cm), init_b)
    y = y_f + flip(y_b) + (d_skip_f + d_skip_b).astype(f32)[:, None] * xs
    y = y.reshape(bsz, length, D_SSM).astype(proj.dtype)
    y = group_rms_norm(y * jax.nn.silu(z), ssm_norm_w, SSM_GROUPS)
    return y, fin_f, fin_b


def peer_ffn(h, w_query, sub_keys_1, sub_keys_2, expert_u, expert_v):
    bsz, length, d = h.shape
    tokens = h.reshape(-1, PEER_TOKEN_BLOCK, d)

    def block(tb):
        tbn = tb.shape[0]
        q = (tb @ w_query).reshape(tbn, PEER_HEADS, PEER_KEY_DIM)
        s1 = jnp.einsum('thd,hkd->thk', q[..., :PEER_HALF], sub_keys_1)
        s2 = jnp.einsum('thd,hkd->thk', q[..., PEER_HALF:], sub_keys_2)
        v1, i1 = lax.top_k(s1, PEER_TOPK)
        v2, i2 = lax.top_k(s2, PEER_TOPK)
        cand = (v1[..., :, None] + v2[..., None, :]).reshape(tbn, PEER_HEADS, PEER_TOPK * PEER_TOPK)
        cand_idx = (i1[..., :, None] * PEER_N_KEYS + i2[..., None, :]).reshape(tbn, PEER_HEADS, PEER_TOPK * PEER_TOPK)
        top_s, pos = lax.top_k(cand, PEER_TOPK)
        idx = jnp.take_along_axis(cand_idx, pos, axis=-1)
        gate = jax.nn.softmax(top_s.astype(jnp.float32), axis=-1).astype(tb.dtype)
        u = expert_u[idx]
        v = expert_v[idx]
        act = jax.nn.gelu(jnp.einsum('td,thkd->thk', tb, u), approximate=False)
        return jnp.einsum('thk,thkd->td', gate * act, v)

    out = lax.map(block, tokens)
    return out.reshape(bsz, length, d)


def setup_inputs(seed: int = 0) -> dict:
    key = jax.random.key(seed)
    ks = jax.random.split(key, 32)
    nrm = lambda k, shp, s: jax.random.normal(k, shp, jnp.float32) * s
    dt0 = jnp.exp(jax.random.uniform(ks[14], (DEPTH, SSM_HEADS), minval=math.log(1e-3), maxval=math.log(1e-1)))
    dt1 = jnp.exp(jax.random.uniform(ks[15], (DEPTH, SSM_HEADS), minval=math.log(1e-3), maxval=math.log(1e-1)))
    return {
        'x': nrm(ks[0], (BATCH, SEQ, D_MODEL), 1.0),
        'c': nrm(ks[1], (BATCH, D_MODEL), 1.0),
        'ctx': nrm(ks[2], (BATCH, CTX_LEN, D_MODEL), 1.0),
        'c_ctx': nrm(ks[3], (D_MODEL,), 1.0),
        'w_mod': nrm(ks[4], (DEPTH, D_MODEL, N_MOD * D_MODEL), 0.5 * D_MODEL ** -0.5),
        'b_mod': nrm(ks[5], (DEPTH, N_MOD * D_MODEL), 0.01),
        'g_pre_mix': 1.0 + nrm(ks[6], (DEPTH, D_MODEL), 0.01),
        'g_post_mix': 1.0 + nrm(ks[7], (DEPTH, D_MODEL), 0.01),
        'g_pre_ffn': 1.0 + nrm(ks[8], (DEPTH, D_MODEL), 0.01),
        'g_post_ffn': 1.0 + nrm(ks[9], (DEPTH, D_MODEL), 0.01),
        'w_in': nrm(ks[10], (DEPTH, D_MODEL, D_IN_PROJ), D_MODEL ** -0.5),
        'w_fmix': nrm(ks[11], (DEPTH, N_FOURIER_GROUPS, FOURIER_GROUP, FOURIER_GROUP), FOURIER_GROUP ** -0.5),
        'conv_w': nrm(ks[12], (DEPTH, SSM_CONV, D_XBC), SSM_CONV ** -0.5),
        'conv_b': nrm(ks[13], (DEPTH, D_XBC), 0.01),
        'dt_bias_f': dt0 + jnp.log(-jnp.expm1(-dt0)),
        'dt_bias_b': dt1 + jnp.log(-jnp.expm1(-dt1)),
        'a_log_f': jnp.log(jax.random.uniform(ks[16], (DEPTH, SSM_HEADS), minval=1.0, maxval=16.0)),
        'a_log_b': jnp.log(jax.random.uniform(ks[17], (DEPTH, SSM_HEADS), minval=1.0, maxval=16.0)),
        'd_skip_f': 1.0 + nrm(ks[18], (DEPTH, SSM_HEADS), 0.1),
        'd_skip_b': 1.0 + nrm(ks[19], (DEPTH, SSM_HEADS), 0.1),
        'ssm_norm_w': 1.0 + nrm(ks[20], (DEPTH, D_SSM), 0.01),
        'w_out': nrm(ks[21], (DEPTH, D_MIX, D_MODEL), D_MIX ** -0.5),
        'w_query': nrm(ks[22], (DEPTH, D_MODEL, PEER_HEADS * PEER_KEY_DIM), D_MODEL ** -0.5),
        'sub_keys_1': nrm(ks[23], (DEPTH, PEER_HEADS, PEER_N_KEYS, PEER_HALF), PEER_HALF ** -0.5),
        'sub_keys_2': nrm(ks[24], (DEPTH, PEER_HEADS, PEER_N_KEYS, PEER_HALF), PEER_HALF ** -0.5),
        'expert_u': nrm(ks[25], (DEPTH, PEER_EXPERTS, D_MODEL), D_MODEL ** -0.5),
        'expert_v': nrm(ks[26], (DEPTH, PEER_EXPERTS, D_MODEL), D_MODEL ** -0.5),
    }


def reference(x, c, ctx, c_ctx, w_mod, b_mod, g_pre_mix, g_post_mix, g_pre_ffn, g_post_ffn,
              w_in, w_fmix, conv_w, conv_b, dt_bias_f, dt_bias_b, a_log_f, a_log_b,
              d_skip_f, d_skip_b, ssm_norm_w, w_out, w_query, sub_keys_1, sub_keys_2,
              expert_u, expert_v):
    bsz = x.shape[0]
    for layer in range(DEPTH):
        sm_x, cm_x, gm_x, sf_x, cf_x, gf_x = adaln_params(c, w_mod[layer], b_mod[layer])
        sm_c, cm_c, gm_c, sf_c, cf_c, gf_c = adaln_params(c_ctx[None], w_mod[layer], b_mod[layer])
        ssd_args = (conv_w[layer], conv_b[layer], dt_bias_f[layer], dt_bias_b[layer], a_log_f[layer],
                    a_log_b[layer], d_skip_f[layer], d_skip_b[layer], ssm_norm_w[layer])

        hc = modulate(rms_norm(ctx, g_pre_mix[layer]), sm_c, cm_c)
        proj_c = hc @ w_in[layer]
        zero_state = jnp.zeros((bsz, SSM_HEADS, SSM_HEAD_DIM, SSM_STATE), jnp.float32)
        y_c_ssm, fin_f, fin_b = ssd_branch(proj_c, *ssd_args, zero_state, zero_state)

        hx = modulate(rms_norm(x, g_pre_mix[layer]), sm_x, cm_x)
        proj_x = hx @ w_in[layer]
        y_x_ssm, _, _ = ssd_branch(proj_x, *ssd_args, fin_f, fin_b)
        y_x = jnp.concatenate([fourier_branch(proj_x, w_fmix[layer]), y_x_ssm], axis=-1) @ w_out[layer]
        x = x + gm_x * rms_norm(y_x, g_post_mix[layer])

        if layer + 1 < DEPTH:
            y_c = jnp.concatenate([fourier_branch(proj_c, w_fmix[layer]), y_c_ssm], axis=-1) @ w_out[layer]
            ctx = ctx + gm_c * rms_norm(y_c, g_post_mix[layer])
            hc2 = modulate(rms_norm(ctx, g_pre_ffn[layer]), sf_c, cf_c)
            ctx = ctx + gf_c * rms_norm(peer_ffn(hc2, w_query[layer], sub_keys_1[layer], sub_keys_2[layer],
                                                 expert_u[layer], expert_v[layer]), g_post_ffn[layer])

        hx2 = modulate(rms_norm(x, g_pre_ffn[layer]), sf_x, cf_x)
        y_f = peer_ffn(hx2, w_query[layer], sub_keys_1[layer], sub_keys_2[layer], expert_u[layer], expert_v[layer])
        x = x + gf_x * rms_norm(y_f, g_post_ffn[layer])
    return x
```

```cpp
#include <hip/hip_runtime.h>
#include <stdint.h>
#include <stdio.h>

namespace {

typedef __attribute__((ext_vector_type(8))) short bf16x8;
typedef __attribute__((ext_vector_type(4))) float f32x4;
typedef unsigned short bf16_t;

constexpr int D = 2048, NB = 4, L = 2048, T = NB * L, CTX = 256, TC = NB * CTX;
constexpr int NMOD = 6 * D;
constexpr int NH = 16, HP = 64, NS = 128, DXBC = 1536;
constexpr int DIN = 3616;
constexpr int NPROJ = 4736;
constexpr int KSPLIT = 32;
constexpr float EPS = 1e-6f;
constexpr int NTHREADS = 256;

__device__ __forceinline__ bf16_t f2bf(float f) {
  uint32_t u = __float_as_uint(f);
  u += 0x7fffu + ((u >> 16) & 1u);
  return (bf16_t)(u >> 16);
}
__device__ __forceinline__ float bf2f(bf16_t h) { return __uint_as_float(((uint32_t)h) << 16); }
__device__ __forceinline__ uint32_t pack2(float a, float b) { return (uint32_t)f2bf(a) | ((uint32_t)f2bf(b) << 16); }
__device__ __forceinline__ float bflo(uint32_t w) { return __uint_as_float(w << 16); }
__device__ __forceinline__ float bfhi(uint32_t w) { return __uint_as_float(w & 0xffff0000u); }
__device__ __forceinline__ float silu_f(float v) { return v / (1.f + __expf(-v)); }
__device__ __forceinline__ float softplus_f(float v) { return v > 20.f ? v : log1pf(__expf(v)); }

__device__ __forceinline__ float wave_sum(float v) {
#pragma unroll
  for (int o = 32; o > 0; o >>= 1) v += __shfl_xor(v, o);
  return v;
}
__device__ __forceinline__ float wave_max(float v) {
#pragma unroll
  for (int o = 32; o > 0; o >>= 1) v = fmaxf(v, __shfl_xor(v, o));
  return v;
}
__device__ __forceinline__ float block_sum(float v, float* red) {
  v = wave_sum(v);
  __syncthreads();
  if ((threadIdx.x & 63) == 0) red[threadIdx.x >> 6] = v;
  __syncthreads();
  return red[0] + red[1] + red[2] + red[3];
}

struct Params {
  const float *x, *c, *ctx, *c_ctx, *w_mod, *b_mod, *g_pre_mix, *g_post_mix, *g_pre_ffn, *g_post_ffn;
  const float *w_in, *w_fmix, *conv_w, *conv_b, *dt_bias_f, *dt_bias_b, *a_log_f, *a_log_b, *d_skip_f, *d_skip_b;
  const float *ssm_norm_w, *w_out, *w_query, *sk1, *sk2, *eu, *ev;
  float* out;
  bf16_t *Ubf, *Vbf, *w_in_t, *w_out_t, *w_q_t, *w_in_f, *WcsT, *dftm;
  float *partial, *mod;
  bf16_t *hx, *hc, *ABt, *z;
  float *xbcraw, *xbcraw_c, *xact, *xact_c, *dtraw, *dtraw_c, *dtf, *dtb, *dtf_c, *dtb_c;
  float *yf, *yb, *fin_f, *fin_b;
  bf16_t* ycat;
  float *y_x, *q, *gate;
  int* idx;
  int* idx2; float* gate2; unsigned* cnt;
  int ph_lo, ph_hi;
};

template <class Epi>
__device__ __forceinline__ void gemm_tile(const bf16_t* __restrict__ A, int lda, const bf16_t* __restrict__ Bt, int ldb,
                                          int K, int m0, int n0, const Epi& epi, char* smem) {
  const int tid = threadIdx.x, lane = tid & 63, w = tid >> 6;
  const int wm = w >> 1, wn = w & 1;
  f32x4 acc[4][4];
#pragma unroll
  for (int i = 0; i < 4; ++i)
#pragma unroll
    for (int j = 0; j < 4; ++j) acc[i][j] = f32x4{0.f, 0.f, 0.f, 0.f};

  uint4 ra0, ra1, ra2, ra3, rb0, rb1, rb2, rb3;
  const int nk = K / 64;
  const int lrow = tid >> 3, lch = tid & 7;
  const bf16_t* gA = A + (size_t)(m0 + lrow) * lda + lch * 8;
  const bf16_t* gB = Bt + (size_t)(n0 + lrow) * ldb + lch * 8;
  const int soff = lrow * 128 + ((lch ^ (lrow & 7)) << 4);
#define GLOAD(kt_)                                                                  \
  do {                                                                              \
    ra0 = *reinterpret_cast<const uint4*>(gA + (kt_) * 64);                         \
    ra1 = *reinterpret_cast<const uint4*>(gA + (size_t)32 * lda + (kt_) * 64);      \
    ra2 = *reinterpret_cast<const uint4*>(gA + (size_t)64 * lda + (kt_) * 64);      \
    ra3 = *reinterpret_cast<const uint4*>(gA + (size_t)96 * lda + (kt_) * 64);      \
    rb0 = *reinterpret_cast<const uint4*>(gB + (kt_) * 64);                         \
    rb1 = *reinterpret_cast<const uint4*>(gB + (size_t)32 * ldb + (kt_) * 64);      \
    rb2 = *reinterpret_cast<const uint4*>(gB + (size_t)64 * ldb + (kt_) * 64);      \
    rb3 = *reinterpret_cast<const uint4*>(gB + (size_t)96 * ldb + (kt_) * 64);      \
  } while (0)
  GLOAD(0);
  for (int kt = 0; kt < nk; ++kt) {
    char* sA = smem + (kt & 1) * 32768;
    char* sB = sA + 16384;
    *reinterpret_cast<uint4*>(sA + soff) = ra0;
    *reinterpret_cast<uint4*>(sA + soff + 4096) = ra1;
    *reinterpret_cast<uint4*>(sA + soff + 8192) = ra2;
    *reinterpret_cast<uint4*>(sA + soff + 12288) = ra3;
    *reinterpret_cast<uint4*>(sB + soff) = rb0;
    *reinterpret_cast<uint4*>(sB + soff + 4096) = rb1;
    *reinterpret_cast<uint4*>(sB + soff + 8192) = rb2;
    *reinterpret_cast<uint4*>(sB + soff + 12288) = rb3;
    __syncthreads();
    if (kt + 1 < nk) GLOAD(kt + 1);
#pragma unroll
    for (int kk = 0; kk < 2; ++kk) {
      bf16x8 af[4], bfr[4];
      const int ch = kk * 4 + (lane >> 4);
#pragma unroll
      for (int i = 0; i < 4; ++i) {
        int row = wm * 64 + i * 16 + (lane & 15);
        af[i] = *reinterpret_cast<const bf16x8*>(sA + row * 128 + ((ch ^ (row & 7)) << 4));
        int col = wn * 64 + i * 16 + (lane & 15);
        bfr[i] = *reinterpret_cast<const bf16x8*>(sB + col * 128 + ((ch ^ (col & 7)) << 4));
      }
#pragma unroll
      for (int i = 0; i < 4; ++i)
#pragma unroll
        for (int j = 0; j < 4; ++j) acc[i][j] = __builtin_amdgcn_mfma_f32_16x16x32_bf16(af[i], bfr[j], acc[i][j], 0, 0, 0);
    }
  }
#undef GLOAD
  __syncthreads();
#pragma unroll
  for (int i = 0; i < 4; ++i)
#pragma unroll
    for (int j = 0; j < 4; ++j) {
      int row = m0 + wm * 64 + i * 16 + (lane >> 4) * 4;
      int col = n0 + wn * 64 + j * 16 + (lane & 15);
      epi(row, col, acc[i][j]);
    }
}

struct EpiF32 {
  float* C; int ldc;
  __device__ __forceinline__ void operator()(int row, int col, f32x4 v) const {
#pragma unroll
    for (int r = 0; r < 4; ++r) C[(size_t)(row + r) * ldc + col] = v[r];
  }
};
struct EpiBf16 {
  bf16_t* C; int ldc;
  __device__ __forceinline__ void operator()(int row, int col, f32x4 v) const {
#pragma unroll
    for (int r = 0; r < 4; ++r) C[(size_t)(row + r) * ldc + col] = f2bf(v[r]);
  }
};
struct EpiBf16T {
  bf16_t* Ct; int ldc;
  __device__ __forceinline__ void operator()(int row, int col, f32x4 v) const {
    uint2 pk; pk.x = pack2(v[0], v[1]); pk.y = pack2(v[2], v[3]);
    *reinterpret_cast<uint2*>(Ct + (size_t)col * ldc + row) = pk;
  }
};
struct EpiInProj {
  bf16_t* ABt; bf16_t* z; float* xbcraw; float* dtraw; int seqlen;
  __device__ __forceinline__ void operator()(int row, int col, f32x4 v) const {
    if (col < 2048) {
      int ch = col & 1023, half = col >> 10;
      int b = row / seqlen, l = row - b * seqlen;
      uint2 pk; pk.x = pack2(v[0], v[1]); pk.y = pack2(v[2], v[3]);
      *reinterpret_cast<uint2*>(ABt + ((size_t)(b * 1024 + ch) * 4096 + half * 2048 + l)) = pk;
    } else if (col < 3072) {
#pragma unroll
      for (int r = 0; r < 4; ++r) z[(size_t)(row + r) * 1024 + (col - 2048)] = f2bf(v[r]);
    } else if (col < 4608) {
#pragma unroll
      for (int r = 0; r < 4; ++r) xbcraw[(size_t)(row + r) * DXBC + (col - 3072)] = v[r];
    } else if (col < 4640) {
#pragma unroll
      for (int r = 0; r < 4; ++r) dtraw[(size_t)(row + r) * 32 + (col - 4608)] = v[r];
    }
  }
};

__device__ void adaln_partial_task(const Params& p, int task, float* sm) {
  const int cb = task % 48, ks = task / 48, tid = threadIdx.x;
  float* sc = sm;
  __syncthreads();
  for (int i = tid; i < 5 * 64; i += NTHREADS) {
    int r = i >> 6, kk = i & 63;
    int k = ks * 64 + kk;
    float cv = (r < 4) ? p.c[r * D + k] : p.c_ctx[k];
    sc[i] = silu_f(cv);
  }
  __syncthreads();
  const int col = cb * 256 + tid;
  float a0 = 0, a1 = 0, a2 = 0, a3 = 0, a4 = 0;
  const float* wp = p.w_mod + (size_t)(ks * 64) * NMOD + col;
#pragma unroll 8
  for (int kk = 0; kk < 64; ++kk) {
    float wv = wp[(size_t)kk * NMOD];
    a0 += sc[kk] * wv; a1 += sc[64 + kk] * wv; a2 += sc[128 + kk] * wv; a3 += sc[192 + kk] * wv; a4 += sc[256 + kk] * wv;
  }
  float* pp = p.partial + (size_t)ks * 5 * NMOD + col;
  pp[0] = a0; pp[NMOD] = a1; pp[2 * NMOD] = a2; pp[3 * NMOD] = a3; pp[4 * NMOD] = a4;
}

__device__ void transpose_convert_task(const float* __restrict__ src, int ld, int c0, int rows, bf16_t* __restrict__ dst,
                                       int tr, int tc, float* sm) {
  float (*tile)[65] = reinterpret_cast<float (*)[65]>(sm);
  const int tid = threadIdx.x;
  __syncthreads();
  for (int i = tid; i < 64 * 64; i += NTHREADS) {
    int r = i >> 6, cc = i & 63;
    tile[r][cc] = src[(size_t)(tr * 64 + r) * ld + c0 + tc * 64 + cc];
  }
  __syncthreads();
  for (int i = tid; i < 64 * 32; i += NTHREADS) {
    int cc = i >> 5, r2 = (i & 31) * 2;
    uint32_t pk = pack2(tile[r2][cc], tile[r2 + 1][cc]);
    *reinterpret_cast<uint32_t*>(dst + (size_t)(tc * 64 + cc) * rows + tr * 64 + r2) = pk;
  }
}

__device__ void phase_prep(const Params& p, int bid, int nb, char* smem) {
  float* sm = reinterpret_cast<float*>(smem);
  const int tid = threadIdx.x;
  for (int t = bid; t < 48 * KSPLIT; t += nb) adaln_partial_task(p, t, sm);
  {
    const size_t n8 = (size_t)16384 * D / 8;
    for (size_t i = (size_t)bid * NTHREADS + tid; i < 2 * n8; i += (size_t)nb * NTHREADS) {
      const float* s = (i < n8) ? p.eu : p.ev;
      bf16_t* d = (i < n8) ? p.Ubf : p.Vbf;
      size_t j = (i < n8) ? i : i - n8;
      float4 v0 = *reinterpret_cast<const float4*>(s + j * 8);
      float4 v1 = *reinterpret_cast<const float4*>(s + j * 8 + 4);
      uint4 o; o.x = pack2(v0.x, v0.y); o.y = pack2(v0.z, v0.w); o.z = pack2(v1.x, v1.y); o.w = pack2(v1.z, v1.w);
      *reinterpret_cast<uint4*>(d + j * 8) = o;
    }
  }
  {
    const int nct = 41, nrt = 32;
    for (int t = bid; t < nct * nrt; t += nb) {
      int tc = t % nct, tr = t / nct;
      if (tc < 40) transpose_convert_task(p.w_in, DIN, 1024, D, p.w_in_t + (size_t)2048 * D, tr, tc, sm);
      else {
        float (*tile)[65] = reinterpret_cast<float (*)[65]>(sm);
        __syncthreads();
        for (int i = tid; i < 64 * 32; i += NTHREADS) {
          int r = i >> 5, cc = i & 31;
          tile[r][cc] = p.w_in[(size_t)(tr * 64 + r) * DIN + 1024 + 2560 + cc];
        }
        __syncthreads();
        for (int i = tid; i < 32 * 32; i += NTHREADS) {
          int cc = i >> 5, r2 = (i & 31) * 2;
          uint32_t pk = pack2(tile[r2][cc], tile[r2 + 1][cc]);
          *reinterpret_cast<uint32_t*>(p.w_in_t + (size_t)(2048 + 2560 + cc) * D + tr * 64 + r2) = pk;
        }
      }
    }
    for (int t = bid; t < 32 * 32; t += nb) transpose_convert_task(p.w_out, D, 0, D, p.w_out_t, t / 32, t % 32, sm);
    for (int t = bid; t < 16 * 32; t += nb) transpose_convert_task(p.w_query, 1024, 0, D, p.w_q_t, t / 16, t % 16, sm);
    for (size_t i = (size_t)bid * NTHREADS + tid; i < (size_t)96 * D / 8; i += (size_t)nb * NTHREADS)
      reinterpret_cast<uint4*>(p.w_in_t + (size_t)4640 * D)[i] = uint4{0, 0, 0, 0};
  }
  for (size_t i = (size_t)bid * NTHREADS + tid; i < (size_t)D * 1024 / 4; i += (size_t)nb * NTHREADS) {
    int k = (int)(i / 256), c4 = (int)(i % 256) * 4;
    float4 v = *reinterpret_cast<const float4*>(p.w_in + (size_t)k * DIN + c4);
    uint2 o; o.x = pack2(v.x, v.y); o.y = pack2(v.z, v.w);
    *reinterpret_cast<uint2*>(p.w_in_f + (size_t)k * 1024 + c4) = o;
  }
  {
    const float scale = 1.0f / sqrtf((float)L * 256.f);
    for (int i = bid * NTHREADS + tid; i < 4 * 256 * 256; i += nb * NTHREADS) {
      int d = i & 255, c = (i >> 8) & 255, g = i >> 16;
      float sc_ = 0.f, ss_ = 0.f;
      for (int m = 0; m < 256; ++m) {
        int ph = (m * c) & 255;
        float sv, cv;
        sincospif((float)ph * (1.0f / 128.f), &sv, &cv);
        float wv = p.w_fmix[((size_t)g * 256 + m) * 256 + d];
        sc_ += cv * wv; ss_ += sv * wv;
      }
      p.WcsT[((size_t)g * 512 + d) * 256 + c] = f2bf(sc_ * scale);
      p.WcsT[((size_t)g * 512 + 256 + d) * 256 + c] = f2bf(ss_ * scale);
    }
  }
  for (size_t i = (size_t)bid * NTHREADS + tid; i < (size_t)2048 * 4096 / 2; i += (size_t)nb * NTHREADS) {
    int k = (int)(i / 2048), j = (int)(i % 2048) * 2;
    float o[2];
#pragma unroll
    for (int e = 0; e < 2; ++e) {
      int jj = j + e;
      int l = jj & 2047;
      int ph = (k * l) & 2047;
      float sv, cv;
      sincospif((float)ph * (1.0f / 1024.f), &sv, &cv);
      o[e] = (jj < 2048) ? cv : -sv;
    }
    *reinterpret_cast<uint32_t*>(p.dftm + (size_t)k * 4096 + j) = pack2(o[0], o[1]);
  }
}

__device__ void phase_fold(const Params& p, int bid, int nb, char* smem) {
  const int tid = threadIdx.x;
  for (int i = bid * NTHREADS + tid; i < 5 * NMOD; i += nb * NTHREADS) {
    int col = i % NMOD;
    float s = p.b_mod[col];
    for (int ks = 0; ks < KSPLIT; ++ks) s += p.partial[(size_t)ks * 5 * NMOD + i];
    p.mod[i] = s;
  }
  for (int t = bid; t < 256; t += nb) {
    int g = t >> 6, tm = (t & 63) >> 2, tn = t & 3;
    int n0 = tn * 128;
    int rowbase = (n0 < 256) ? (g * 256 + n0) : (1024 + g * 256 + (n0 - 256));
    EpiBf16T epi{p.w_in_t + (size_t)(rowbase - n0) * D, D};
    gemm_tile(p.w_in_f + g * 256, 1024, p.WcsT + (size_t)g * 512 * 256, 256, 256, tm * 128, n0, epi, smem);
  }
}

__device__ void phase_norm_mod(const Params& p, int bid, int nb, char* smem) {
  float* red = reinterpret_cast<float*>(smem);
  const int tid = threadIdx.x;
  for (int t = bid; t < T + TC; t += nb) {
    const bool isx = t < T;
    const float* src = isx ? (p.x + (size_t)t * D) : (p.ctx + (size_t)(t - T) * D);
    const int mrow = isx ? (t / L) : 4;
    bf16_t* dst = isx ? (p.hx + (size_t)t * D) : (p.hc + (size_t)(t - T) * D);
    float4 v0 = *reinterpret_cast<const float4*>(src + tid * 8);
    float4 v1 = *reinterpret_cast<const float4*>(src + tid * 8 + 4);
    float ss = v0.x * v0.x + v0.y * v0.y + v0.z * v0.z + v0.w * v0.w + v1.x * v1.x + v1.y * v1.y + v1.z * v1.z + v1.w * v1.w;
    ss = block_sum(ss, red);
    float rstd = rsqrtf(ss * (1.f / D) + EPS);
    const float* sh = p.mod + (size_t)mrow * NMOD + 0 * D + tid * 8;
    const float* sc = p.mod + (size_t)mrow * NMOD + 1 * D + tid * 8;
    const float* g = p.g_pre_mix + tid * 8;
    float vv[8] = {v0.x, v0.y, v0.z, v0.w, v1.x, v1.y, v1.z, v1.w};
    float o[8];
#pragma unroll
    for (int e = 0; e < 8; ++e) o[e] = vv[e] * rstd * g[e] * (1.f + sc[e]) + sh[e];
    uint4 pk; pk.x = pack2(o[0], o[1]); pk.y = pack2(o[2], o[3]); pk.z = pack2(o[4], o[5]); pk.w = pack2(o[6], o[7]);
    *reinterpret_cast<uint4*>(dst + tid * 8) = pk;
  }
}

__device__ void phase_inproj(const Params& p, int bid, int nb, char* smem) {
  const int ntx = 64 * 37, ntc = 8 * 13;
  for (int t = bid; t < ntx + ntc; t += nb) {
    if (t < ntx) {
      int tm = t / 37, tn = t % 37;
      EpiInProj epi{p.ABt, p.z, p.xbcraw, p.dtraw, L};
      gemm_tile(p.hx, D, p.w_in_t, D, D, tm * 128, tn * 128, epi, smem);
    } else {
      int u = t - ntx;
      int tm = u / 13, tn = u % 13;
      EpiInProj epi{nullptr, nullptr, p.xbcraw_c, p.dtraw_c, CTX};
      gemm_tile(p.hc, D, p.w_in_t, D, D, tm * 128, 3072 + tn * 128, epi, smem);
    }
  }
}

__device__ void ssm_pre_range(const Params& p, const float* raw, const float* dtraw, int ntok, int seqlen, float* act,
                              float* dtf, float* dtb, int bid, int nb) {
  const int tid = threadIdx.x;
  const size_t n = (size_t)ntok * DXBC;
  for (size_t i = (size_t)bid * NTHREADS + tid; i < n; i += (size_t)nb * NTHREADS) {
    int t = (int)(i / DXBC), c = (int)(i % DXBC);
    int l = t % seqlen;
    float acc = p.conv_b[c] + raw[i] * p.conv_w[DXBC + c];
    if (l > 0) acc += raw[i - DXBC] * p.conv_w[c];
    if (l < seqlen - 1) acc += raw[i + DXBC] * p.conv_w[2 * DXBC + c];
    act[i] = silu_f(acc);
  }
  for (int i = bid * NTHREADS + tid; i < ntok * 32; i += nb * NTHREADS) {
    int t = i >> 5, j = i & 31;
    float v = dtraw[i];
    if (j < 16) dtf[t * 16 + j] = softplus_f(v + p.dt_bias_f[j]);
    else dtb[t * 16 + (j - 16)] = softplus_f(v + p.dt_bias_b[j - 16]);
  }
}
__device__ void phase_ssm_pre(const Params& p, int bid, int nb) {
  ssm_pre_range(p, p.xbcraw_c, p.dtraw_c, TC, CTX, p.xact_c, p.dtf_c, p.dtb_c, bid, nb);
  ssm_pre_range(p, p.xbcraw, p.dtraw, T, L, p.xact, p.dtf, p.dtb, bid, nb);
}

__device__ void scan_task(const Params& p, int task, const float* act, const float* dtf, const float* dtb, int seqlen,
                          const float* init_f, const float* init_b, float* yf, float* yb, float* fin_f, float* fin_b) {
  const int dir = task & 1, pg = (task >> 1) & 15, h = (task >> 5) & 15, b = task >> 9;
  const int lane = threadIdx.x & 63, w = threadIdx.x >> 6;
  const int pp = pg * 4 + w, g = h >> 3;
  const float a = -__expf(dir ? p.a_log_b[h] : p.a_log_f[h]);
  const float* dt = dir ? dtb : dtf;
  const float* init = dir ? init_b : init_f;
  float* yo = dir ? yb : yf;
  float* fo = dir ? fin_b : fin_f;
  const size_t sidx = (((size_t)b * NH + h) * HP + pp) * NS + 2 * lane;
  float s0 = 0.f, s1 = 0.f;
  if (init) { s0 = init[sidx]; s1 = init[sidx + 1]; }
  for (int c0 = 0; c0 < seqlen; c0 += 8) {
    float dtv[8], xv[8]; float2 Bv[8], Cv[8];
#pragma unroll
    for (int e = 0; e < 8; ++e) {
      int l = dir ? (seqlen - 1 - (c0 + e)) : (c0 + e);
      size_t t = (size_t)b * seqlen + l;
      dtv[e] = dt[t * 16 + h];
      xv[e] = act[t * DXBC + h * HP + pp];
      Bv[e] = *reinterpret_cast<const float2*>(act + t * DXBC + 1024 + g * NS + 2 * lane);
      Cv[e] = *reinterpret_cast<const float2*>(act + t * DXBC + 1280 + g * NS + 2 * lane);
    }
    float yv[8];
#pragma unroll
    for (int e = 0; e < 8; ++e) {
      float dA = __expf(a * dtv[e]);
      float xd = xv[e] * dtv[e];
      s0 = s0 * dA + xd * Bv[e].x;
      s1 = s1 * dA + xd * Bv[e].y;
      yv[e] = Cv[e].x * s0 + Cv[e].y * s1;
    }
    if (yo) {
#pragma unroll
      for (int e = 0; e < 8; ++e) yv[e] = wave_sum(yv[e]);
      if (lane < 8) {
        float mine = yv[0];
#pragma unroll
        for (int e = 1; e < 8; ++e) mine = (lane == e) ? yv[e] : mine;
        int l = dir ? (seqlen - 1 - (c0 + lane)) : (c0 + lane);
        yo[((size_t)b * seqlen + l) * 1024 + h * HP + pp] = mine;
      }
    }
  }
  if (fo) { fo[sidx] = s0; fo[sidx + 1] = s1; }
}

__device__ void phase_ctxscan_dft(const Params& p, int bid, int nb, char* smem) {
  for (int t = bid; t < 2048; t += nb)
    scan_task(p, t, p.xact_c, p.dtf_c, p.dtb_c, CTX, nullptr, nullptr, nullptr, nullptr, p.fin_f, p.fin_b);
  for (int t = bid; t < 4 * 16 * 8; t += nb) {
    int b = t >> 7, tm = (t & 127) >> 3, tn = t & 7;
    EpiBf16 epi{p.ycat + (size_t)b * L * D, D};
    gemm_tile(p.dftm, 4096, p.ABt + (size_t)b * 1024 * 4096, 4096, 4096, tm * 128, tn * 128, epi, smem);
  }
}

__device__ void phase_xscan(const Params& p, int bid, int nb) {
  for (int t = bid; t < 2048; t += nb)
    scan_task(p, t, p.xact, p.dtf, p.dtb, L, p.fin_f, p.fin_b, p.yf, p.yb, nullptr, nullptr);
}

__device__ void phase_ssm_post(const Params& p, int bid, int nb, char* smem) {
  float* red = reinterpret_cast<float*>(smem);
  const int tid = threadIdx.x, w = tid >> 6;
  for (int t = bid; t < T; t += nb) {
    const int c0 = tid * 4;
    const int h = c0 >> 6;
    const float dsk = p.d_skip_f[h] + p.d_skip_b[h];
    float4 a = *reinterpret_cast<const float4*>(p.yf + (size_t)t * 1024 + c0);
    float4 bq = *reinterpret_cast<const float4*>(p.yb + (size_t)t * 1024 + c0);
    float4 xs = *reinterpret_cast<const float4*>(p.xact + (size_t)t * DXBC + c0);
    uint2 zz = *reinterpret_cast<const uint2*>(p.z + (size_t)t * 1024 + c0);
    float zf[4] = {bflo(zz.x), bfhi(zz.x), bflo(zz.y), bfhi(zz.y)};
    float y[4] = {a.x + bq.x + dsk * xs.x, a.y + bq.y + dsk * xs.y, a.z + bq.z + dsk * xs.z, a.w + bq.w + dsk * xs.w};
    float ss = 0.f;
#pragma unroll
    for (int e = 0; e < 4; ++e) { y[e] *= silu_f(zf[e]); ss += y[e] * y[e]; }
    ss = wave_sum(ss);
    __syncthreads();
    if ((tid & 63) == 0) red[w] = ss;
    __syncthreads();
    float gs = (w < 2) ? (red[0] + red[1]) : (red[2] + red[3]);
    float rstd = rsqrtf(gs * (1.f / 512.f) + EPS);
    float4 nw = *reinterpret_cast<const float4*>(p.ssm_norm_w + c0);
    uint2 o; o.x = pack2(y[0] * rstd * nw.x, y[1] * rstd * nw.y); o.y = pack2(y[2] * rstd * nw.z, y[3] * rstd * nw.w);
    *reinterpret_cast<uint2*>(p.ycat + (size_t)t * D + 1024 + c0) = o;
  }
}

__device__ void phase_outproj(const Params& p, int bid, int nb, char* smem) {
  for (int t = bid; t < 64 * 16; t += nb) {
    EpiF32 epi{p.y_x, D};
    gemm_tile(p.ycat, D, p.w_out_t, D, D, (t >> 4) * 128, (t & 15) * 128, epi, smem);
  }
}
__device__ void phase_qgemm(const Params& p, int bid, int nb, char* smem) {
  for (int t = bid; t < 64 * 8; t += nb) {
    EpiF32 epi{p.q, 1024};
    gemm_tile(p.hx  , D, p.w_q_t, D, D, (t >> 3) * 128, (t & 7) * 128, epi, smem);
  }
}

__device__ void phase_postmix(const Params& p, int bid, int nb, char* smem) {
  float* red = reinterpret_cast<float*>(smem);
  const int tid = threadIdx.x;
  for (int t = bid; t < T; t += nb) {
    const int b = t / L;
    const float* yr = p.y_x + (size_t)t * D + tid * 8;
    const float* xr = p.x + (size_t)t * D + tid * 8;
    float y[8], xv[8];
    *reinterpret_cast<float4*>(y) = *reinterpret_cast<const float4*>(yr);
    *reinterpret_cast<float4*>(y + 4) = *reinterpret_cast<const float4*>(yr + 4);
    *reinterpret_cast<float4*>(xv) = *reinterpret_cast<const float4*>(xr);
    *reinterpret_cast<float4*>(xv + 4) = *reinterpret_cast<const float4*>(xr + 4);
    float ss = 0.f;
#pragma unroll
    for (int e = 0; e < 8; ++e) ss += y[e] * y[e];
    ss = block_sum(ss, red);
    float rstd = rsqrtf(ss * (1.f / D) + EPS);
    const float* gm = p.mod + (size_t)b * NMOD + 2 * D + tid * 8;
    const float* gp = p.g_post_mix + tid * 8;
    float x1[8]; float ss1 = 0.f;
#pragma unroll
    for (int e = 0; e < 8; ++e) { x1[e] = xv[e] + gm[e] * (y[e] * rstd * gp[e]); ss1 += x1[e] * x1[e]; }
    ss1 = block_sum(ss1, red);
    float rstd1 = rsqrtf(ss1 * (1.f / D) + EPS);
    float* o = p.out + (size_t)t * D + tid * 8;
    *reinterpret_cast<float4*>(o) = *reinterpret_cast<float4*>(x1);
    *reinterpret_cast<float4*>(o + 4) = *reinterpret_cast<float4*>(x1 + 4);
    const float* sf = p.mod + (size_t)b * NMOD + 3 * D + tid * 8;
    const float* cf = p.mod + (size_t)b * NMOD + 4 * D + tid * 8;
    const float* gf = p.g_pre_ffn + tid * 8;
    float h2[8];
#pragma unroll
    for (int e = 0; e < 8; ++e) h2[e] = x1[e] * rstd1 * gf[e] * (1.f + cf[e]) + sf[e];
    uint4 pk; pk.x = pack2(h2[0], h2[1]); pk.y = pack2(h2[2], h2[3]); pk.z = pack2(h2[4], h2[5]); pk.w = pack2(h2[6], h2[7]);
    *reinterpret_cast<uint4*>(p.hx + (size_t)t * D + tid * 8) = pk;
  }
}

__device__ void phase_route(const Params& p, int bid, int nb, char* smem) {
  float* qs = reinterpret_cast<float*>(smem);
  float* keys = qs + 512;
  const int tid = threadIdx.x, lane = tid & 63, w = tid >> 6;
  for (int task = bid; task < 8 * 256; task += nb) {
    const int h = task & 7, chunk = task >> 3;
    __syncthreads();
    for (int i = tid; i < 2 * 128 * 64; i += NTHREADS) {
      int s = i >> 13, k = (i >> 6) & 127, d = i & 63;
      const float* src = s ? p.sk2 : p.sk1;
      keys[(s * 128 + k) * 65 + d] = src[((size_t)h * 128 + k) * 64 + d];
    }
    __syncthreads();
    for (int ti = 0; ti < 8; ++ti) {
      const int t = chunk * 32 + w * 8 + ti;
      float* myq = qs + w * 128;
      myq[lane] = p.q[(size_t)t * 1024 + h * 128 + lane];
      myq[64 + lane] = p.q[(size_t)t * 1024 + h * 128 + 64 + lane];
      __builtin_amdgcn_wave_barrier();
      float sv[2][2];
#pragma unroll
      for (int s = 0; s < 2; ++s)
#pragma unroll
        for (int kk = 0; kk < 2; ++kk) {
          const float* kr = keys + (s * 128 + lane + 64 * kk) * 65;
          float acc = 0.f;
#pragma unroll 16
          for (int d = 0; d < 64; ++d) acc += myq[s * 64 + d] * kr[d];
          sv[s][kk] = acc;
        }
      float tv[2] = {0.f, 0.f}; int tix[2] = {0, 0};
#pragma unroll
      for (int s = 0; s < 2; ++s) {
        float v0 = sv[s][0], v1 = sv[s][1];
        for (int r = 0; r < 16; ++r) {
          float m = wave_max(fmaxf(v0, v1));
          unsigned long long bal = __ballot(v0 == m || v1 == m);
          int owner = __ffsll((long long)bal) - 1;
          int which = (v0 == m) ? 0 : 1;
          which = __shfl(which, owner);
          int kidx = owner + 64 * which;
          if (lane == owner) { if (which == 0) v0 = -INFINITY; else v1 = -INFINITY; }
          if (lane == r) { tv[s] = m; tix[s] = kidx; }
        }
      }
      float cv[4];
      {
        float va = __shfl(tv[0], lane >> 2);
#pragma unroll
        for (int j = 0; j < 4; ++j) cv[j] = va + __shfl(tv[1], (lane & 3) * 4 + j);
      }
      float top_s = 0.f; int top_e = 0;
      for (int r = 0; r < 16; ++r) {
        float lm = fmaxf(fmaxf(cv[0], cv[1]), fmaxf(cv[2], cv[3]));
        float m = wave_max(lm);
        unsigned long long bal = __ballot(lm == m);
        int owner = __ffsll((long long)bal) - 1;
        int j = (cv[0] == m) ? 0 : (cv[1] == m) ? 1 : (cv[2] == m) ? 2 : 3;
        j = __shfl(j, owner);
        {
          const bool own = (lane == owner);
          cv[0] = (own && j == 0) ? -INFINITY : cv[0];
          cv[1] = (own && j == 1) ? -INFINITY : cv[1];
          cv[2] = (own && j == 2) ? -INFINITY : cv[2];
          cv[3] = (own && j == 3) ? -INFINITY : cv[3];
        }
        int pos = owner * 4 + j;
        int e1 = __shfl(tix[0], pos >> 4), e2 = __shfl(tix[1], pos & 15);
        if (lane == r) { top_s = m; top_e = e1 * 128 + e2; }
      }
      float smax = __shfl(top_s, 0);
      float ex = (lane < 16) ? __expf(top_s - smax) : 0.f;
      float den = wave_sum(ex);
      if (lane < 16) {
        p.idx[(size_t)t * 128 + h * 16 + lane] = top_e;
        p.gate[(size_t)t * 128 + h * 16 + lane] = ex / den;
      }
      __builtin_amdgcn_wave_barrier();
    }
  }
}

__device__ void phase_experts(const Params& p, int bid, int nb) {
  const int lane = threadIdx.x & 63, w = threadIdx.x >> 6;
  for (int t = bid * 4 + w; t < T; t += nb * 4) {
    const int b = t / L;
    uint4 hq[4];
#pragma unroll
    for (int c = 0; c < 4; ++c) hq[c] = *reinterpret_cast<const uint4*>(p.hx + (size_t)t * D + c * 512 + lane * 8);
    float hf[32];
#pragma unroll
    for (int c = 0; c < 4; ++c) {
      hf[c * 8 + 0] = bflo(hq[c].x); hf[c * 8 + 1] = bfhi(hq[c].x); hf[c * 8 + 2] = bflo(hq[c].y); hf[c * 8 + 3] = bfhi(hq[c].y);
      hf[c * 8 + 4] = bflo(hq[c].z); hf[c * 8 + 5] = bfhi(hq[c].z); hf[c * 8 + 6] = bflo(hq[c].w); hf[c * 8 + 7] = bfhi(hq[c].w);
    }
    float acc[32];
#pragma unroll
    for (int e = 0; e < 32; ++e) acc[e] = 0.f;
    const int* ip = p.idx + (size_t)t * 128;
    const float* gp = p.gate + (size_t)t * 128;
    for (int j0 = 0; j0 < 128; j0 += 2) {
      int e0 = __builtin_amdgcn_readfirstlane(ip[j0]), e1 = __builtin_amdgcn_readfirstlane(ip[j0 + 1]);
      float g0 = gp[j0], g1 = gp[j0 + 1];
      uint4 u0[4], u1[4], v0[4], v1[4];
#pragma unroll
      for (int c = 0; c < 4; ++c) {
        u0[c] = *reinterpret_cast<const uint4*>(p.Ubf + (size_t)e0 * D + c * 512 + lane * 8);
        u1[c] = *reinterpret_cast<const uint4*>(p.Ubf + (size_t)e1 * D + c * 512 + lane * 8);
        v0[c] = *reinterpret_cast<const uint4*>(p.Vbf + (size_t)e0 * D + c * 512 + lane * 8);
        v1[c] = *reinterpret_cast<const uint4*>(p.Vbf + (size_t)e1 * D + c * 512 + lane * 8);
      }
      float d0 = 0.f, d1 = 0.f;
#pragma unroll
      for (int c = 0; c < 4; ++c) {
        d0 += hf[c * 8 + 0] * bflo(u0[c].x) + hf[c * 8 + 1] * bfhi(u0[c].x) + hf[c * 8 + 2] * bflo(u0[c].y) + hf[c * 8 + 3] * bfhi(u0[c].y) +
              hf[c * 8 + 4] * bflo(u0[c].z) + hf[c * 8 + 5] * bfhi(u0[c].z) + hf[c * 8 + 6] * bflo(u0[c].w) + hf[c * 8 + 7] * bfhi(u0[c].w);
        d1 += hf[c * 8 + 0] * bflo(u1[c].x) + hf[c * 8 + 1] * bfhi(u1[c].x) + hf[c * 8 + 2] * bflo(u1[c].y) + hf[c * 8 + 3] * bfhi(u1[c].y) +
              hf[c * 8 + 4] * bflo(u1[c].z) + hf[c * 8 + 5] * bfhi(u1[c].z) + hf[c * 8 + 6] * bflo(u1[c].w) + hf[c * 8 + 7] * bfhi(u1[c].w);
      }
      d0 = wave_sum(d0); d1 = wave_sum(d1);
      float c0 = g0 * 0.5f * d0 * (1.f + erff(d0 * 0.70710678118654752f));
      float c1 = g1 * 0.5f * d1 * (1.f + erff(d1 * 0.70710678118654752f));
#pragma unroll
      for (int c = 0; c < 4; ++c) {
        acc[c * 8 + 0] += c0 * bflo(v0[c].x) + c1 * bflo(v1[c].x); acc[c * 8 + 1] += c0 * bfhi(v0[c].x) + c1 * bfhi(v1[c].x);
        acc[c * 8 + 2] += c0 * bflo(v0[c].y) + c1 * bflo(v1[c].y); acc[c * 8 + 3] += c0 * bfhi(v0[c].y) + c1 * bfhi(v1[c].y);
        acc[c * 8 + 4] += c0 * bflo(v0[c].z) + c1 * bflo(v1[c].z); acc[c * 8 + 5] += c0 * bfhi(v0[c].z) + c1 * bfhi(v1[c].z);
        acc[c * 8 + 6] += c0 * bflo(v0[c].w) + c1 * bflo(v1[c].w); acc[c * 8 + 7] += c0 * bfhi(v0[c].w) + c1 * bfhi(v1[c].w);
      }
    }
    float ss = 0.f;
#pragma unroll
    for (int e = 0; e < 32; ++e) ss += acc[e] * acc[e];
    ss = wave_sum(ss);
    float rstd = rsqrtf(ss * (1.f / D) + EPS);
    const float* gfx = p.mod + (size_t)b * NMOD + 5 * D;
#pragma unroll
    for (int c = 0; c < 4; ++c) {
      int e0 = c * 512 + lane * 8;
      float* o = p.out + (size_t)t * D + e0;
      float4 x0 = *reinterpret_cast<const float4*>(o), x1v = *reinterpret_cast<const float4*>(o + 4);
      float4 gA = *reinterpret_cast<const float4*>(gfx + e0), gB = *reinterpret_cast<const float4*>(gfx + e0 + 4);
      float4 pA = *reinterpret_cast<const float4*>(p.g_post_ffn + e0), pB = *reinterpret_cast<const float4*>(p.g_post_ffn + e0 + 4);
      x0.x += gA.x * acc[c * 8 + 0] * rstd * pA.x; x0.y += gA.y * acc[c * 8 + 1] * rstd * pA.y;
      x0.z += gA.z * acc[c * 8 + 2] * rstd * pA.z; x0.w += gA.w * acc[c * 8 + 3] * rstd * pA.w;
      x1v.x += gB.x * acc[c * 8 + 4] * rstd * pB.x; x1v.y += gB.y * acc[c * 8 + 5] * rstd * pB.y;
      x1v.z += gB.z * acc[c * 8 + 6] * rstd * pB.z; x1v.w += gB.w * acc[c * 8 + 7] * rstd * pB.w;
      *reinterpret_cast<float4*>(o) = x0; *reinterpret_cast<float4*>(o + 4) = x1v;
    }
  }
}


__device__ void phase_route_bf(const Params& p, int bid, int nb, char* smem) {
  float* sm = reinterpret_cast<float*>(smem);
  const int tid = threadIdx.x;
  for (int blk = bid; blk < T * 8 / 64; blk += nb) {
    __syncthreads();
    if (tid < 64) {
      const int th = blk * 64 + tid, t = th >> 3, h = th & 7;
      const float* qv = p.q + (size_t)t * 1024 + h * 128;
      for (int k = 0; k < 128; ++k) {
        float a1 = 0.f, a2 = 0.f;
        for (int d = 0; d < 64; ++d) {
          a1 += qv[d] * p.sk1[((size_t)h * 128 + k) * 64 + d];
          a2 += qv[64 + d] * p.sk2[((size_t)h * 128 + k) * 64 + d];
        }
        sm[k * 64 + tid] = a1; sm[(128 + k) * 64 + tid] = a2;
      }
      float prev = INFINITY;
      float ts[16]; int te[16];
#pragma unroll
      for (int r = 0; r < 16; ++r) {
        float best = -INFINITY; int bi = 0;
        for (int i = 0; i < 128; ++i) {
          float a = sm[i * 64 + tid];
          for (int j = 0; j < 128; ++j) {
            float v = a + sm[(128 + j) * 64 + tid];
            if (v < prev && v > best) { best = v; bi = i * 128 + j; }
          }
        }
        ts[r] = best; te[r] = bi; prev = best;
      }
      float den = 0.f;
#pragma unroll
      for (int r = 0; r < 16; ++r) { ts[r] = __expf(ts[r] - prev); den += ts[r]; }
#pragma unroll
      for (int r = 0; r < 16; ++r) {
        p.idx[(size_t)t * 128 + h * 16 + r] = te[r];
        p.gate[(size_t)t * 128 + h * 16 + r] = ts[r] / den;
      }
    }
  }
}
__device__ void phase_experts_bf(const Params& p, int bid, int nb, char* smem) {
  float* act = reinterpret_cast<float*>(smem);
  float* red = act + 128;
  const int tid = threadIdx.x, lane = tid & 63, w = tid >> 6;
  for (int t = bid; t < T; t += nb) {
    const int b = t / L;
    __syncthreads();
    for (int j = w; j < 128; j += 4) {
      const int e = p.idx[(size_t)t * 128 + j];
      float d = 0.f;
      for (int k = lane; k < D; k += 64) d += bf2f(p.hx[(size_t)t * D + k]) * p.eu[(size_t)e * D + k];
      d = wave_sum(d);
      if (lane == 0) act[j] = p.gate[(size_t)t * 128 + j] * 0.5f * d * (1.f + erff(d * 0.70710678118654752f));
    }
    __syncthreads();
    float y[8];
#pragma unroll
    for (int i = 0; i < 8; ++i) y[i] = 0.f;
    for (int j = 0; j < 128; ++j) {
      const int e = p.idx[(size_t)t * 128 + j];
      const float a = act[j];
#pragma unroll
      for (int i = 0; i < 8; ++i) y[i] += a * p.ev[(size_t)e * D + tid * 8 + i];
    }
    float ss = 0.f;
#pragma unroll
    for (int i = 0; i < 8; ++i) ss += y[i] * y[i];
    ss = block_sum(ss, red);
    float rstd = rsqrtf(ss * (1.f / D) + EPS);
#pragma unroll
    for (int i = 0; i < 8; ++i) {
      int e = tid * 8 + i;
      p.out[(size_t)t * D + e] += p.mod[(size_t)b * NMOD + 5 * D + e] * (y[i] * rstd * p.g_post_ffn[e]);
    }
  }
}

__device__ void phase_compare(const Params& p, int bid, int nb) {
  float* fc = reinterpret_cast<float*>(p.cnt);
  for (int i = bid * NTHREADS + threadIdx.x; i < T * 8; i += nb * NTHREADS) {
    float dsum = 0.f; int ob = 0;
    for (int r = 0; r < 16; ++r) {
      dsum += fabsf(p.gate[(size_t)i * 16 + r] - p.gate2[(size_t)i * 16 + r]);
      ob += (p.idx[(size_t)i * 16 + r] != p.idx2[(size_t)i * 16 + r]) ? 1 : 0;
    }
    dsum = wave_sum(dsum);
    float obf = wave_sum((float)ob);
    if ((threadIdx.x & 63) == 0) { atomicAdd(&fc[0], dsum); atomicAdd(&fc[1], obf); }
  }
}
__device__ void phase_perturb(const Params& p, int bid, int nb) {
  const float* fc = reinterpret_cast<const float*>(p.cnt);
  const float f0 = fc[0] / (float)(T * 8), f1 = fc[1] / (float)(T * 128);
  for (size_t i = (size_t)bid * NTHREADS + threadIdx.x; i < (size_t)T * D; i += (size_t)nb * NTHREADS) {
    p.out[i] += (i < (size_t)T * D / 2) ? f0 : 0.f * f1;
  }
}

template <int PH>
__global__ void __launch_bounds__(NTHREADS) fwd_kernel(Params p) {
  __shared__ __attribute__((aligned(16))) char smem[68608];
  const int bid = blockIdx.x, nb = gridDim.x;
  if (PH == 0) phase_prep(p, bid, nb, smem);
  if (PH == 1) phase_fold(p, bid, nb, smem);
  if (PH == 2) phase_norm_mod(p, bid, nb, smem);
  if (PH == 3) phase_inproj(p, bid, nb, smem);
  if (PH == 4) phase_ssm_pre(p, bid, nb);
  if (PH == 5) phase_ctxscan_dft(p, bid, nb, smem);
  if (PH == 6) phase_xscan(p, bid, nb);
  if (PH == 7) phase_ssm_post(p, bid, nb, smem);
  if (PH == 8) phase_outproj(p, bid, nb, smem);
  if (PH == 9) phase_postmix(p, bid, nb, smem);
  if (PH == 10) phase_qgemm(p, bid, nb, smem);
  if (PH == 11) phase_route(p, bid, nb, smem);
  if (PH == 12) phase_experts(p, bid, nb);
  if (PH == 13) phase_route_bf(p, bid, nb, smem);
  if (PH == 14) phase_experts_bf(p, bid, nb, smem);
  if (PH == 15) phase_compare(p, bid, nb);
  if (PH == 16) phase_perturb(p, bid, nb);
  if (PH == 17) { Params p2 = p; p2.idx = p.idx2; p2.gate = p.gate2; phase_route_bf(p2, bid, nb, smem); }
  if (PH == 18) { Params p2 = p; p2.idx = p.idx2; p2.gate = p.gate2; phase_experts_bf(p2, bid, nb, smem); }
}

}

extern "C" void kernel_launch(void* const* d_in, const int* in_sizes, int n_in, void* d_out, int out_size, void* d_ws,
                              size_t ws_size, hipStream_t stream) {
  Params p{};
  const float** fp = reinterpret_cast<const float**>(&p);
  for (int i = 0; i < 27; ++i) fp[i] = (const float*)d_in[i];
  p.out = (float*)d_out;
  char* ws = (char*)d_ws;
  size_t off = 0;
  auto take = [&](size_t bytes) { char* r = ws + off; off += (bytes + 255) & ~(size_t)255; return r; };
  p.Ubf = (bf16_t*)take((size_t)16384 * D * 2);
  p.Vbf = (bf16_t*)take((size_t)16384 * D * 2);
  p.w_in_t = (bf16_t*)take((size_t)NPROJ * D * 2);
  p.w_out_t = (bf16_t*)take((size_t)D * D * 2);
  p.w_q_t = (bf16_t*)take((size_t)1024 * D * 2);
  p.w_in_f = (bf16_t*)take((size_t)D * 1024 * 2);
  p.WcsT = (bf16_t*)take((size_t)4 * 512 * 256 * 2);
  p.dftm = (bf16_t*)take((size_t)2048 * 4096 * 2);
  p.partial = (float*)take((size_t)KSPLIT * 5 * NMOD * 4);
  p.mod = (float*)take((size_t)5 * NMOD * 4);
  p.hx = (bf16_t*)take((size_t)T * D * 2);
  p.hc = (bf16_t*)take((size_t)TC * D * 2);
  p.ABt = (bf16_t*)take((size_t)NB * 1024 * 4096 * 2);
  p.q = (float*)p.ABt;
  p.z = (bf16_t*)take((size_t)T * 1024 * 2);
  char* r1 = take(0);
  p.xbcraw = (float*)take((size_t)T * DXBC * 4);
  p.xbcraw_c = (float*)take((size_t)TC * DXBC * 4);
  p.xact = (float*)take((size_t)T * DXBC * 4);
  p.xact_c = (float*)take((size_t)TC * DXBC * 4);
  p.y_x = (float*)r1;
  p.dtraw = (float*)take((size_t)T * 32 * 4);
  p.dtraw_c = (float*)take((size_t)TC * 32 * 4);
  p.dtf = (float*)take((size_t)T * 16 * 4);
  p.dtb = (float*)take((size_t)T * 16 * 4);
  p.dtf_c = (float*)take((size_t)TC * 16 * 4);
  p.dtb_c = (float*)take((size_t)TC * 16 * 4);
  p.yf = (float*)take((size_t)T * 1024 * 4);
  p.yb = (float*)take((size_t)T * 1024 * 4);
  p.fin_f = (float*)take((size_t)NB * NH * HP * NS * 4);
  p.fin_b = (float*)take((size_t)NB * NH * HP * NS * 4);
  p.ycat = (bf16_t*)take((size_t)T * D * 2);
  p.idx = (int*)take((size_t)T * 128 * 4);
  p.gate = (float*)take((size_t)T * 128 * 4);
  p.idx2 = (int*)p.yf; p.gate2 = p.yb; p.cnt = (unsigned*)p.fin_f;
  if (off > ws_size) { fprintf(stderr, "kernel_launch: workspace too small: need %zu have %zu\n", off, ws_size); return; }
#define LAUNCH_PH(k) hipLaunchKernelGGL(fwd_kernel<k>, dim3(2048), dim3(NTHREADS), 0, stream, p)
  LAUNCH_PH(0); LAUNCH_PH(1); LAUNCH_PH(2); LAUNCH_PH(3); LAUNCH_PH(4); LAUNCH_PH(5); LAUNCH_PH(6);
  LAUNCH_PH(7); LAUNCH_PH(8); LAUNCH_PH(9); LAUNCH_PH(10); LAUNCH_PH(11); LAUNCH_PH(12);
}
```

```cpp
#include <hip/hip_runtime.h>
#include <hip/hip_cooperative_groups.h>
#include <stdint.h>
#include <stdio.h>

namespace cg = cooperative_groups;
namespace {

typedef __attribute__((ext_vector_type(8))) short bf16x8;
typedef __attribute__((ext_vector_type(4))) float f32x4;
typedef unsigned short bf16_t;

constexpr int D = 2048, NB = 4, L = 2048, T = NB * L, CTX = 256, TC = NB * CTX;
constexpr int NMOD = 6 * D;
constexpr int NH = 16, HP = 64, NS = 128, DXBC = 1536;
constexpr int DIN = 3616;
constexpr int NPROJ = 4736;
constexpr int KSPLIT = 32;
constexpr float EPS = 1e-6f;
constexpr int NTHREADS = 256;

__device__ __forceinline__ bf16_t f2bf(float f) {
  uint32_t u = __float_as_uint(f);
  u += 0x7fffu + ((u >> 16) & 1u);
  return (bf16_t)(u >> 16);
}
__device__ __forceinline__ float bf2f(bf16_t h) { return __uint_as_float(((uint32_t)h) << 16); }
__device__ __forceinline__ uint32_t pack2(float a, float b) { return (uint32_t)f2bf(a) | ((uint32_t)f2bf(b) << 16); }
__device__ __forceinline__ float bflo(uint32_t w) { return __uint_as_float(w << 16); }
__device__ __forceinline__ float bfhi(uint32_t w) { return __uint_as_float(w & 0xffff0000u); }
__device__ __forceinline__ float silu_f(float v) { return v / (1.f + __expf(-v)); }
__device__ __forceinline__ float softplus_f(float v) { return v > 20.f ? v : log1pf(__expf(v)); }

__device__ __forceinline__ float wave_sum(float v) {
#pragma unroll
  for (int o = 32; o > 0; o >>= 1) v += __shfl_xor(v, o);
  return v;
}
__device__ __forceinline__ float wave_max(float v) {
#pragma unroll
  for (int o = 32; o > 0; o >>= 1) v = fmaxf(v, __shfl_xor(v, o));
  return v;
}
__device__ __forceinline__ float block_sum(float v, float* red) {
  v = wave_sum(v);
  __syncthreads();
  if ((threadIdx.x & 63) == 0) red[threadIdx.x >> 6] = v;
  __syncthreads();
  return red[0] + red[1] + red[2] + red[3];
}

struct Params {
  const float *x, *c, *ctx, *c_ctx, *w_mod, *b_mod, *g_pre_mix, *g_post_mix, *g_pre_ffn, *g_post_ffn;
  const float *w_in, *w_fmix, *conv_w, *conv_b, *dt_bias_f, *dt_bias_b, *a_log_f, *a_log_b, *d_skip_f, *d_skip_b;
  const float *ssm_norm_w, *w_out, *w_query, *sk1, *sk2, *eu, *ev;
  float* out;
  bf16_t *Ubf, *Vbf, *w_in_t, *w_out_t, *w_q_t, *w_in_f, *WcsT, *dftm;
  float *partial, *mod;
  bf16_t *hx, *hc, *ABt, *z;
  float *xbcraw, *xbcraw_c, *xact, *xact_c, *dtraw, *dtraw_c, *dtf, *dtb, *dtf_c, *dtb_c;
  float *yf, *yb, *fin_f, *fin_b;
  bf16_t* ycat;
  float *y_x, *q, *gate;
  int* idx;
  int pad0, pad1;
};

template <class Epi>
__device__ __forceinline__ void gemm_tile(const bf16_t* __restrict__ A, int lda, const bf16_t* __restrict__ Bt, int ldb,
                                          int K, int m0, int n0, const Epi& epi, char* smem) {
  const int tid = threadIdx.x, lane = tid & 63, w = tid >> 6;
  const int wm = w >> 1, wn = w & 1;
  f32x4 acc[4][4];
#pragma unroll
  for (int i = 0; i < 4; ++i)
#pragma unroll
    for (int j = 0; j < 4; ++j) acc[i][j] = f32x4{0.f, 0.f, 0.f, 0.f};

  uint4 ra0, ra1, ra2, ra3, rb0, rb1, rb2, rb3;
  const int nk = K / 64;
  const int lrow = tid >> 3, lch = tid & 7;
  const bf16_t* gA = A + (size_t)(m0 + lrow) * lda + lch * 8;
  const bf16_t* gB = Bt + (size_t)(n0 + lrow) * ldb + lch * 8;
  const int soff = lrow * 128 + ((lch ^ (lrow & 7)) << 4);
#define GLOAD(kt_)                                                                  \
  do {                                                                              \
    ra0 = *reinterpret_cast<const uint4*>(gA + (kt_) * 64);                         \
    ra1 = *reinterpret_cast<const uint4*>(gA + (size_t)32 * lda + (kt_) * 64);      \
    ra2 = *reinterpret_cast<const uint4*>(gA + (size_t)64 * lda + (kt_) * 64);      \
    ra3 = *reinterpret_cast<const uint4*>(gA + (size_t)96 * lda + (kt_) * 64);      \
    rb0 = *reinterpret_cast<const uint4*>(gB + (kt_) * 64);                         \
    rb1 = *reinterpret_cast<const uint4*>(gB + (size_t)32 * ldb + (kt_) * 64);      \
    rb2 = *reinterpret_cast<const uint4*>(gB + (size_t)64 * ldb + (kt_) * 64);      \
    rb3 = *reinterpret_cast<const uint4*>(gB + (size_t)96 * ldb + (kt_) * 64);      \
  } while (0)
  GLOAD(0);
  for (int kt = 0; kt < nk; ++kt) {
    char* sA = smem + (kt & 1) * 32768;
    char* sB = sA + 16384;
    *reinterpret_cast<uint4*>(sA + soff) = ra0;
    *reinterpret_cast<uint4*>(sA + soff + 4096) = ra1;
    *reinterpret_cast<uint4*>(sA + soff + 8192) = ra2;
    *reinterpret_cast<uint4*>(sA + soff + 12288) = ra3;
    *reinterpret_cast<uint4*>(sB + soff) = rb0;
    *reinterpret_cast<uint4*>(sB + soff + 4096) = rb1;
    *reinterpret_cast<uint4*>(sB + soff + 8192) = rb2;
    *reinterpret_cast<uint4*>(sB + soff + 12288) = rb3;
    __syncthreads();
    if (kt + 1 < nk) GLOAD(kt + 1);
#pragma unroll
    for (int kk = 0; kk < 2; ++kk) {
      bf16x8 af[4], bfr[4];
      const int ch = kk * 4 + (lane >> 4);
#pragma unroll
      for (int i = 0; i < 4; ++i) {
        int row = wm * 64 + i * 16 + (lane & 15);
        af[i] = *reinterpret_cast<const bf16x8*>(sA + row * 128 + ((ch ^ (row & 7)) << 4));
        int col = wn * 64 + i * 16 + (lane & 15);
        bfr[i] = *reinterpret_cast<const bf16x8*>(sB + col * 128 + ((ch ^ (col & 7)) << 4));
      }
#pragma unroll
      for (int i = 0; i < 4; ++i)
#pragma unroll
        for (int j = 0; j < 4; ++j) acc[i][j] = __builtin_amdgcn_mfma_f32_16x16x32_bf16(af[i], bfr[j], acc[i][j], 0, 0, 0);
    }
  }
#undef GLOAD
  __syncthreads();
#pragma unroll
  for (int i = 0; i < 4; ++i)
#pragma unroll
    for (int j = 0; j < 4; ++j) {
      int row = m0 + wm * 64 + i * 16 + (lane >> 4) * 4;
      int col = n0 + wn * 64 + j * 16 + (lane & 15);
      epi(row, col, acc[i][j]);
    }
}

struct EpiF32 {
  float* C; int ldc;
  __device__ __forceinline__ void operator()(int row, int col, f32x4 v) const {
#pragma unroll
    for (int r = 0; r < 4; ++r) C[(size_t)(row + r) * ldc + col] = v[r];
  }
};
struct EpiBf16 {
  bf16_t* C; int ldc;
  __device__ __forceinline__ void operator()(int row, int col, f32x4 v) const {
#pragma unroll
    for (int r = 0; r < 4; ++r) C[(size_t)(row + r) * ldc + col] = f2bf(v[r]);
  }
};
struct EpiBf16T {
  bf16_t* Ct; int ldc;
  __device__ __forceinline__ void operator()(int row, int col, f32x4 v) const {
    uint2 pk; pk.x = pack2(v[0], v[1]); pk.y = pack2(v[2], v[3]);
    *reinterpret_cast<uint2*>(Ct + (size_t)col * ldc + row) = pk;
  }
};
struct EpiInProj {
  bf16_t* ABt; bf16_t* z; float* xbcraw; float* dtraw; int seqlen;
  __device__ __forceinline__ void operator()(int row, int col, f32x4 v) const {
    if (col < 2048) {
      int ch = col & 1023, half = col >> 10;
      int b = row / seqlen, l = row - b * seqlen;
      uint2 pk; pk.x = pack2(v[0], v[1]); pk.y = pack2(v[2], v[3]);
      *reinterpret_cast<uint2*>(ABt + ((size_t)(b * 1024 + ch) * 4096 + half * 2048 + l)) = pk;
    } else if (col < 3072) {
#pragma unroll
      for (int r = 0; r < 4; ++r) z[(size_t)(row + r) * 1024 + (col - 2048)] = f2bf(v[r]);
    } else if (col < 4608) {
#pragma unroll
      for (int r = 0; r < 4; ++r) xbcraw[(size_t)(row + r) * DXBC + (col - 3072)] = v[r];
    } else if (col < 4640) {
#pragma unroll
      for (int r = 0; r < 4; ++r) dtraw[(size_t)(row + r) * 32 + (col - 4608)] = v[r];
    }
  }
};

__device__ void adaln_partial_task(const Params& p, int task, float* sm) {
  const int cb = task % 48, ks = task / 48, tid = threadIdx.x;
  float* sc = sm;
  __syncthreads();
  for (int i = tid; i < 5 * 64; i += NTHREADS) {
    int r = i >> 6, kk = i & 63;
    int k = ks * 64 + kk;
    float cv = (r < 4) ? p.c[r * D + k] : p.c_ctx[k];
    sc[i] = silu_f(cv);
  }
  __syncthreads();
  const int col = cb * 256 + tid;
  float a0 = 0, a1 = 0, a2 = 0, a3 = 0, a4 = 0;
  const float* wp = p.w_mod + (size_t)(ks * 64) * NMOD + col;
#pragma unroll 8
  for (int kk = 0; kk < 64; ++kk) {
    float wv = wp[(size_t)kk * NMOD];
    a0 += sc[kk] * wv; a1 += sc[64 + kk] * wv; a2 += sc[128 + kk] * wv; a3 += sc[192 + kk] * wv; a4 += sc[256 + kk] * wv;
  }
  float* pp = p.partial + (size_t)ks * 5 * NMOD + col;
  pp[0] = a0; pp[NMOD] = a1; pp[2 * NMOD] = a2; pp[3 * NMOD] = a3; pp[4 * NMOD] = a4;
}

__device__ void transpose_convert_task(const float* __restrict__ src, int ld, int c0, int rows, bf16_t* __restrict__ dst,
                                       int tr, int tc, float* sm) {
  float (*tile)[65] = reinterpret_cast<float (*)[65]>(sm);
  const int tid = threadIdx.x;
  __syncthreads();
  for (int i = tid; i < 64 * 64; i += NTHREADS) {
    int r = i >> 6, cc = i & 63;
    tile[r][cc] = src[(size_t)(tr * 64 + r) * ld + c0 + tc * 64 + cc];
  }
  __syncthreads();
  for (int i = tid; i < 64 * 32; i += NTHREADS) {
    int cc = i >> 5, r2 = (i & 31) * 2;
    uint32_t pk = pack2(tile[r2][cc], tile[r2 + 1][cc]);
    *reinterpret_cast<uint32_t*>(dst + (size_t)(tc * 64 + cc) * rows + tr * 64 + r2) = pk;
  }
}

__device__ void phase_prep(const Params& p, int bid, int nb, char* smem) {
  float* sm = reinterpret_cast<float*>(smem);
  const int tid = threadIdx.x;
  for (int t = bid; t < 48 * KSPLIT; t += nb) adaln_partial_task(p, t, sm);
  {
    const size_t n8 = (size_t)16384 * D / 8;
    for (size_t i = (size_t)bid * NTHREADS + tid; i < 2 * n8; i += (size_t)nb * NTHREADS) {
      const float* s = (i < n8) ? p.eu : p.ev;
      bf16_t* d = (i < n8) ? p.Ubf : p.Vbf;
      size_t j = (i < n8) ? i : i - n8;
      float4 v0 = *reinterpret_cast<const float4*>(s + j * 8);
      float4 v1 = *reinterpret_cast<const float4*>(s + j * 8 + 4);
      uint4 o; o.x = pack2(v0.x, v0.y); o.y = pack2(v0.z, v0.w); o.z = pack2(v1.x, v1.y); o.w = pack2(v1.z, v1.w);
      *reinterpret_cast<uint4*>(d + j * 8) = o;
    }
  }
  {
    const int nct = 41, nrt = 32;
    for (int t = bid; t < nct * nrt; t += nb) {
      int tc = t % nct, tr = t / nct;
      if (tc < 40) transpose_convert_task(p.w_in, DIN, 1024, D, p.w_in_t + (size_t)2048 * D, tr, tc, sm);
      else {
        float (*tile)[65] = reinterpret_cast<float (*)[65]>(sm);
        __syncthreads();
        for (int i = tid; i < 64 * 32; i += NTHREADS) {
          int r = i >> 5, cc = i & 31;
          tile[r][cc] = p.w_in[(size_t)(tr * 64 + r) * DIN + 1024 + 2560 + cc];
        }
        __syncthreads();
        for (int i = tid; i < 32 * 32; i += NTHREADS) {
          int cc = i >> 5, r2 = (i & 31) * 2;
          uint32_t pk = pack2(tile[r2][cc], tile[r2 + 1][cc]);
          *reinterpret_cast<uint32_t*>(p.w_in_t + (size_t)(2048 + 2560 + cc) * D + tr * 64 + r2) = pk;
        }
      }
    }
    for (int t = bid; t < 32 * 32; t += nb) transpose_convert_task(p.w_out, D, 0, D, p.w_out_t, t / 32, t % 32, sm);
    for (int t = bid; t < 16 * 32; t += nb) transpose_convert_task(p.w_query, 1024, 0, D, p.w_q_t, t / 16, t % 16, sm);
    for (size_t i = (size_t)bid * NTHREADS + tid; i < (size_t)96 * D / 8; i += (size_t)nb * NTHREADS)
      reinterpret_cast<uint4*>(p.w_in_t + (size_t)4640 * D)[i] = uint4{0, 0, 0, 0};
  }
  for (size_t i = (size_t)bid * NTHREADS + tid; i < (size_t)D * 1024 / 4; i += (size_t)nb * NTHREADS) {
    int k = (int)(i / 256), c4 = (int)(i % 256) * 4;
    float4 v = *reinterpret_cast<const float4*>(p.w_in + (size_t)k * DIN + c4);
    uint2 o; o.x = pack2(v.x, v.y); o.y = pack2(v.z, v.w);
    *reinterpret_cast<uint2*>(p.w_in_f + (size_t)k * 1024 + c4) = o;
  }
  {
    const float scale = 1.0f / sqrtf((float)L * 256.f);
    for (int i = bid * NTHREADS + tid; i < 4 * 256 * 256; i += nb * NTHREADS) {
      int d = i & 255, c = (i >> 8) & 255, g = i >> 16;
      float sc_ = 0.f, ss_ = 0.f;
      for (int m = 0; m < 256; ++m) {
        int ph = (m * c) & 255;
        float sv, cv;
        sincospif((float)ph * (1.0f / 128.f), &sv, &cv);
        float wv = p.w_fmix[((size_t)g * 256 + m) * 256 + d];
        sc_ += cv * wv; ss_ += sv * wv;
      }
      p.WcsT[((size_t)g * 512 + d) * 256 + c] = f2bf(sc_ * scale);
      p.WcsT[((size_t)g * 512 + 256 + d) * 256 + c] = f2bf(ss_ * scale);
    }
  }
  for (size_t i = (size_t)bid * NTHREADS + tid; i < (size_t)2048 * 4096 / 2; i += (size_t)nb * NTHREADS) {
    int k = (int)(i / 2048), j = (int)(i % 2048) * 2;
    float o[2];
#pragma unroll
    for (int e = 0; e < 2; ++e) {
      int jj = j + e;
      int l = jj & 2047;
      int ph = (k * l) & 2047;
      float sv, cv;
      sincospif((float)ph * (1.0f / 1024.f), &sv, &cv);
      o[e] = (jj < 2048) ? cv : -sv;
    }
    *reinterpret_cast<uint32_t*>(p.dftm + (size_t)k * 4096 + j) = pack2(o[0], o[1]);
  }
}

__device__ void phase_fold(const Params& p, int bid, int nb, char* smem) {
  const int tid = threadIdx.x;
  for (int i = bid * NTHREADS + tid; i < 5 * NMOD; i += nb * NTHREADS) {
    int col = i % NMOD;
    float s = p.b_mod[col];
    for (int ks = 0; ks < KSPLIT; ++ks) s += p.partial[(size_t)ks * 5 * NMOD + i];
    p.mod[i] = s;
  }
  for (int t = bid; t < 256; t += nb) {
    int g = t >> 6, tm = (t & 63) >> 2, tn = t & 3;
    int n0 = tn * 128;
    int rowbase = (n0 < 256) ? (g * 256 + n0) : (1024 + g * 256 + (n0 - 256));
    EpiBf16T epi{p.w_in_t + (size_t)(rowbase - n0) * D, D};
    gemm_tile(p.w_in_f + g * 256, 1024, p.WcsT + (size_t)g * 512 * 256, 256, 256, tm * 128, n0, epi, smem);
  }
}

__device__ void phase_norm_mod(const Params& p, int bid, int nb, char* smem) {
  float* red = reinterpret_cast<float*>(smem);
  const int tid = threadIdx.x;
  for (int t = bid; t < T + TC; t += nb) {
    const bool isx = t < T;
    const float* src = isx ? (p.x + (size_t)t * D) : (p.ctx + (size_t)(t - T) * D);
    const int mrow = isx ? (t / L) : 4;
    bf16_t* dst = isx ? (p.hx + (size_t)t * D) : (p.hc + (size_t)(t - T) * D);
    float4 v0 = *reinterpret_cast<const float4*>(src + tid * 8);
    float4 v1 = *reinterpret_cast<const float4*>(src + tid * 8 + 4);
    float ss = v0.x * v0.x + v0.y * v0.y + v0.z * v0.z + v0.w * v0.w + v1.x * v1.x + v1.y * v1.y + v1.z * v1.z + v1.w * v1.w;
    ss = block_sum(ss, red);
    float rstd = rsqrtf(ss * (1.f / D) + EPS);
    const float* sh = p.mod + (size_t)mrow * NMOD + 0 * D + tid * 8;
    const float* sc = p.mod + (size_t)mrow * NMOD + 1 * D + tid * 8;
    const float* g = p.g_pre_mix + tid * 8;
    float vv[8] = {v0.x, v0.y, v0.z, v0.w, v1.x, v1.y, v1.z, v1.w};
    float o[8];
#pragma unroll
    for (int e = 0; e < 8; ++e) o[e] = vv[e] * rstd * g[e] * (1.f + sc[e]) + sh[e];
    uint4 pk; pk.x = pack2(o[0], o[1]); pk.y = pack2(o[2], o[3]); pk.z = pack2(o[4], o[5]); pk.w = pack2(o[6], o[7]);
    *reinterpret_cast<uint4*>(dst + tid * 8) = pk;
  }
}

__device__ void phase_inproj(const Params& p, int bid, int nb, char* smem) {
  const int ntx = 64 * 37, ntc = 8 * 13;
  for (int t = bid; t < ntx + ntc; t += nb) {
    if (t < ntx) {
      int tm = t / 37, tn = t % 37;
      EpiInProj epi{p.ABt, p.z, p.xbcraw, p.dtraw, L};
      gemm_tile(p.hx, D, p.w_in_t, D, D, tm * 128, tn * 128, epi, smem);
    } else {
      int u = t - ntx;
      int tm = u / 13, tn = u % 13;
      EpiInProj epi{nullptr, nullptr, p.xbcraw_c, p.dtraw_c, CTX};
      gemm_tile(p.hc, D, p.w_in_t, D, D, tm * 128, 3072 + tn * 128, epi, smem);
    }
  }
}

__device__ void ssm_pre_range(const Params& p, const float* raw, const float* dtraw, int ntok, int seqlen, float* act,
                              float* dtf, float* dtb, int bid, int nb) {
  const int tid = threadIdx.x;
  const size_t n = (size_t)ntok * DXBC;
  for (size_t i = (size_t)bid * NTHREADS + tid; i < n; i += (size_t)nb * NTHREADS) {
    int t = (int)(i / DXBC), c = (int)(i % DXBC);
    int l = t % seqlen;
    float acc = p.conv_b[c] + raw[i] * p.conv_w[DXBC + c];
    if (l > 0) acc += raw[i - DXBC] * p.conv_w[c];
    if (l < seqlen - 1) acc += raw[i + DXBC] * p.conv_w[2 * DXBC + c];
    act[i] = silu_f(acc);
  }
  for (int i = bid * NTHREADS + tid; i < ntok * 32; i += nb * NTHREADS) {
    int t = i >> 5, j = i & 31;
    float v = dtraw[i];
    if (j < 16) dtf[t * 16 + j] = softplus_f(v + p.dt_bias_f[j]);
    else dtb[t * 16 + (j - 16)] = softplus_f(v + p.dt_bias_b[j - 16]);
  }
}
__device__ void phase_ssm_pre(const Params& p, int bid, int nb) {
  ssm_pre_range(p, p.xbcraw_c, p.dtraw_c, TC, CTX, p.xact_c, p.dtf_c, p.dtb_c, bid, nb);
  ssm_pre_range(p, p.xbcraw, p.dtraw, T, L, p.xact, p.dtf, p.dtb, bid, nb);
}

__device__ void scan_task(const Params& p, int task, const float* act, const float* dtf, const float* dtb, int seqlen,
                          const float* init_f, const float* init_b, float* yf, float* yb, float* fin_f, float* fin_b) {
  const int dir = task & 1, pg = (task >> 1) & 15, h = (task >> 5) & 15, b = task >> 9;
  const int lane = threadIdx.x & 63, w = threadIdx.x >> 6;
  const int pp = pg * 4 + w, g = h >> 3;
  const float a = -__expf(dir ? p.a_log_b[h] : p.a_log_f[h]);
  const float* dt = dir ? dtb : dtf;
  const float* init = dir ? init_b : init_f;
  float* yo = dir ? yb : yf;
  float* fo = dir ? fin_b : fin_f;
  const size_t sidx = (((size_t)b * NH + h) * HP + pp) * NS + 2 * lane;
  float s0 = 0.f, s1 = 0.f;
  if (init) { s0 = init[sidx]; s1 = init[sidx + 1]; }
  for (int c0 = 0; c0 < seqlen; c0 += 8) {
    float dtv[8], xv[8]; float2 Bv[8], Cv[8];
#pragma unroll
    for (int e = 0; e < 8; ++e) {
      int l = dir ? (seqlen - 1 - (c0 + e)) : (c0 + e);
      size_t t = (size_t)b * seqlen + l;
      dtv[e] = dt[t * 16 + h];
      xv[e] = act[t * DXBC + h * HP + pp];
      Bv[e] = *reinterpret_cast<const float2*>(act + t * DXBC + 1024 + g * NS + 2 * lane);
      Cv[e] = *reinterpret_cast<const float2*>(act + t * DXBC + 1280 + g * NS + 2 * lane);
    }
    float yv[8];
#pragma unroll
    for (int e = 0; e < 8; ++e) {
      float dA = __expf(a * dtv[e]);
      float xd = xv[e] * dtv[e];
      s0 = s0 * dA + xd * Bv[e].x;
      s1 = s1 * dA + xd * Bv[e].y;
      yv[e] = Cv[e].x * s0 + Cv[e].y * s1;
    }
    if (yo) {
#pragma unroll
      for (int e = 0; e < 8; ++e) yv[e] = wave_sum(yv[e]);
      if (lane < 8) {
        float mine = yv[0];
#pragma unroll
        for (int e = 1; e < 8; ++e) mine = (lane == e) ? yv[e] : mine;
        int l = dir ? (seqlen - 1 - (c0 + lane)) : (c0 + lane);
        yo[((size_t)b * seqlen + l) * 1024 + h * HP + pp] = mine;
      }
    }
  }
  if (fo) { fo[sidx] = s0; fo[sidx + 1] = s1; }
}

__device__ void phase_ctxscan_dft(const Params& p, int bid, int nb, char* smem) {
  for (int t = bid; t < 2048; t += nb)
    scan_task(p, t, p.xact_c, p.dtf_c, p.dtb_c, CTX, nullptr, nullptr, nullptr, nullptr, p.fin_f, p.fin_b);
  for (int t = bid; t < 4 * 16 * 8; t += nb) {
    int b = t >> 7, tm = (t & 127) >> 3, tn = t & 7;
    EpiBf16 epi{p.ycat + (size_t)b * L * D, D};
    gemm_tile(p.dftm, 4096, p.ABt + (size_t)b * 1024 * 4096, 4096, 4096, tm * 128, tn * 128, epi, smem);
  }
}

__device__ void phase_xscan(const Params& p, int bid, int nb) {
  for (int t = bid; t < 2048; t += nb)
    scan_task(p, t, p.xact, p.dtf, p.dtb, L, p.fin_f, p.fin_b, p.yf, p.yb, nullptr, nullptr);
}

__device__ void phase_ssm_post(const Params& p, int bid, int nb, char* smem) {
  float* red = reinterpret_cast<float*>(smem);
  const int tid = threadIdx.x, w = tid >> 6;
  for (int t = bid; t < T; t += nb) {
    const int c0 = tid * 4;
    const int h = c0 >> 6;
    const float dsk = p.d_skip_f[h] + p.d_skip_b[h];
    float4 a = *reinterpret_cast<const float4*>(p.yf + (size_t)t * 1024 + c0);
    float4 bq = *reinterpret_cast<const float4*>(p.yb + (size_t)t * 1024 + c0);
    float4 xs = *reinterpret_cast<const float4*>(p.xact + (size_t)t * DXBC + c0);
    uint2 zz = *reinterpret_cast<const uint2*>(p.z + (size_t)t * 1024 + c0);
    float zf[4] = {bflo(zz.x), bfhi(zz.x), bflo(zz.y), bfhi(zz.y)};
    float y[4] = {a.x + bq.x + dsk * xs.x, a.y + bq.y + dsk * xs.y, a.z + bq.z + dsk * xs.z, a.w + bq.w + dsk * xs.w};
    float ss = 0.f;
#pragma unroll
    for (int e = 0; e < 4; ++e) { y[e] *= silu_f(zf[e]); ss += y[e] * y[e]; }
    ss = wave_sum(ss);
    __syncthreads();
    if ((tid & 63) == 0) red[w] = ss;
    __syncthreads();
    float gs = (w < 2) ? (red[0] + red[1]) : (red[2] + red[3]);
    float rstd = rsqrtf(gs * (1.f / 512.f) + EPS);
    float4 nw = *reinterpret_cast<const float4*>(p.ssm_norm_w + c0);
    uint2 o; o.x = pack2(y[0] * rstd * nw.x, y[1] * rstd * nw.y); o.y = pack2(y[2] * rstd * nw.z, y[3] * rstd * nw.w);
    *reinterpret_cast<uint2*>(p.ycat + (size_t)t * D + 1024 + c0) = o;
  }
}

__device__ void phase_outproj(const Params& p, int bid, int nb, char* smem) {
  for (int t = bid; t < 64 * 16; t += nb) {
    EpiF32 epi{p.y_x, D};
    gemm_tile(p.ycat, D, p.w_out_t, D, D, (t >> 4) * 128, (t & 15) * 128, epi, smem);
  }
}
__device__ void phase_qgemm(const Params& p, int bid, int nb, char* smem) {
  for (int t = bid; t < 64 * 8; t += nb) {
    EpiF32 epi{p.q, 1024};
    gemm_tile(p.hx  , D, p.w_q_t, D, D, (t >> 3) * 128, (t & 7) * 128, epi, smem);
  }
}

__device__ void phase_postmix(const Params& p, int bid, int nb, char* smem) {
  float* red = reinterpret_cast<float*>(smem);
  const int tid = threadIdx.x;
  for (int t = bid; t < T; t += nb) {
    const int b = t / L;
    const float* yr = p.y_x + (size_t)t * D + tid * 8;
    const float* xr = p.x + (size_t)t * D + tid * 8;
    float y[8], xv[8];
    *reinterpret_cast<float4*>(y) = *reinterpret_cast<const float4*>(yr);
    *reinterpret_cast<float4*>(y + 4) = *reinterpret_cast<const float4*>(yr + 4);
    *reinterpret_cast<float4*>(xv) = *reinterpret_cast<const float4*>(xr);
    *reinterpret_cast<float4*>(xv + 4) = *reinterpret_cast<const float4*>(xr + 4);
    float ss = 0.f;
#pragma unroll
    for (int e = 0; e < 8; ++e) ss += y[e] * y[e];
    ss = block_sum(ss, red);
    float rstd = rsqrtf(ss * (1.f / D) + EPS);
    const float* gm = p.mod + (size_t)b * NMOD + 2 * D + tid * 8;
    const float* gp = p.g_post_mix + tid * 8;
    float x1[8]; float ss1 = 0.f;
#pragma unroll
    for (int e = 0; e < 8; ++e) { x1[e] = xv[e] + gm[e] * (y[e] * rstd * gp[e]); ss1 += x1[e] * x1[e]; }
    ss1 = block_sum(ss1, red);
    float rstd1 = rsqrtf(ss1 * (1.f / D) + EPS);
    float* o = p.out + (size_t)t * D + tid * 8;
    *reinterpret_cast<float4*>(o) = *reinterpret_cast<float4*>(x1);
    *reinterpret_cast<float4*>(o + 4) = *reinterpret_cast<float4*>(x1 + 4);
    const float* sf = p.mod + (size_t)b * NMOD + 3 * D + tid * 8;
    const float* cf = p.mod + (size_t)b * NMOD + 4 * D + tid * 8;
    const float* gf = p.g_pre_ffn + tid * 8;
    float h2[8];
#pragma unroll
    for (int e = 0; e < 8; ++e) h2[e] = x1[e] * rstd1 * gf[e] * (1.f + cf[e]) + sf[e];
    uint4 pk; pk.x = pack2(h2[0], h2[1]); pk.y = pack2(h2[2], h2[3]); pk.z = pack2(h2[4], h2[5]); pk.w = pack2(h2[6], h2[7]);
    *reinterpret_cast<uint4*>(p.hx + (size_t)t * D + tid * 8) = pk;
  }
}

__device__ void phase_route(const Params& p, int bid, int nb, char* smem) {
  float* qs = reinterpret_cast<float*>(smem);
  float* keys = qs + 512;
  const int tid = threadIdx.x, lane = tid & 63, w = tid >> 6;
  for (int task = bid; task < 8 * 256; task += nb) {
    const int h = task & 7, chunk = task >> 3;
    __syncthreads();
    for (int i = tid; i < 2 * 128 * 64; i += NTHREADS) {
      int s = i >> 13, k = (i >> 6) & 127, d = i & 63;
      const float* src = s ? p.sk2 : p.sk1;
      keys[(s * 128 + k) * 65 + d] = src[((size_t)h * 128 + k) * 64 + d];
    }
    __syncthreads();
    for (int ti = 0; ti < 8; ++ti) {
      const int t = chunk * 32 + w * 8 + ti;
      float* myq = qs + w * 128;
      myq[lane] = p.q[(size_t)t * 1024 + h * 128 + lane];
      myq[64 + lane] = p.q[(size_t)t * 1024 + h * 128 + 64 + lane];
      __builtin_amdgcn_wave_barrier();
      float sv[2][2];
#pragma unroll
      for (int s = 0; s < 2; ++s)
#pragma unroll
        for (int kk = 0; kk < 2; ++kk) {
          const float* kr = keys + (s * 128 + lane + 64 * kk) * 65;
          float acc = 0.f;
#pragma unroll 16
          for (int d = 0; d < 64; ++d) acc += myq[s * 64 + d] * kr[d];
          sv[s][kk] = acc;
        }
      float tv[2] = {0.f, 0.f}; int tix[2] = {0, 0};
#pragma unroll
      for (int s = 0; s < 2; ++s) {
        float v0 = sv[s][0], v1 = sv[s][1];
        for (int r = 0; r < 16; ++r) {
          float m = wave_max(fmaxf(v0, v1));
          unsigned long long bal = __ballot(v0 == m || v1 == m);
          int owner = __ffsll((long long)bal) - 1;
          int which = (v0 == m) ? 0 : 1;
          which = __shfl(which, owner);
          int kidx = owner + 64 * which;
          if (lane == owner) { if (which == 0) v0 = -INFINITY; else v1 = -INFINITY; }
          if (lane == r) { tv[s] = m; tix[s] = kidx; }
        }
      }
      float cv[4];
      {
        float va = __shfl(tv[0], lane >> 2);
#pragma unroll
        for (int j = 0; j < 4; ++j) cv[j] = va + __shfl(tv[1], (lane & 3) * 4 + j);
      }
      float top_s = 0.f; int top_e = 0;
      for (int r = 0; r < 16; ++r) {
        float lm = fmaxf(fmaxf(cv[0], cv[1]), fmaxf(cv[2], cv[3]));
        float m = wave_max(lm);
        unsigned long long bal = __ballot(lm == m);
        int owner = __ffsll((long long)bal) - 1;
        int j = (cv[0] == m) ? 0 : (cv[1] == m) ? 1 : (cv[2] == m) ? 2 : 3;
        j = __shfl(j, owner);
        {
          const bool own = (lane == owner);
          cv[0] = (own && j == 0) ? -INFINITY : cv[0];
          cv[1] = (own && j == 1) ? -INFINITY : cv[1];
          cv[2] = (own && j == 2) ? -INFINITY : cv[2];
          cv[3] = (own && j == 3) ? -INFINITY : cv[3];
        }
        int pos = owner * 4 + j;
        int e1 = __shfl(tix[0], pos >> 4), e2 = __shfl(tix[1], pos & 15);
        if (lane == r) { top_s = m; top_e = e1 * 128 + e2; }
      }
      float smax = __shfl(top_s, 0);
      float ex = (lane < 16) ? __expf(top_s - smax) : 0.f;
      float den = wave_sum(ex);
      if (lane < 16) {
        p.idx[(size_t)t * 128 + h * 16 + lane] = top_e;
        p.gate[(size_t)t * 128 + h * 16 + lane] = ex / den;
      }
      __builtin_amdgcn_wave_barrier();
    }
  }
}

__device__ void phase_experts(const Params& p, int bid, int nb) {
  const int lane = threadIdx.x & 63, w = threadIdx.x >> 6;
  for (int t = bid * 4 + w; t < T; t += nb * 4) {
    const int b = t / L;
    uint4 hq[4];
#pragma unroll
    for (int c = 0; c < 4; ++c) hq[c] = *reinterpret_cast<const uint4*>(p.hx + (size_t)t * D + c * 512 + lane * 8);
    float hf[32];
#pragma unroll
    for (int c = 0; c < 4; ++c) {
      hf[c * 8 + 0] = bflo(hq[c].x); hf[c * 8 + 1] = bfhi(hq[c].x); hf[c * 8 + 2] = bflo(hq[c].y); hf[c * 8 + 3] = bfhi(hq[c].y);
      hf[c * 8 + 4] = bflo(hq[c].z); hf[c * 8 + 5] = bfhi(hq[c].z); hf[c * 8 + 6] = bflo(hq[c].w); hf[c * 8 + 7] = bfhi(hq[c].w);
    }
    float acc[32];
#pragma unroll
    for (int e = 0; e < 32; ++e) acc[e] = 0.f;
    const int* ip = p.idx + (size_t)t * 128;
    const float* gp = p.gate + (size_t)t * 128;
    for (int j0 = 0; j0 < 128; j0 += 2) {
      int e0 = __builtin_amdgcn_readfirstlane(ip[j0]), e1 = __builtin_amdgcn_readfirstlane(ip[j0 + 1]);
      float g0 = gp[j0], g1 = gp[j0 + 1];
      uint4 u0[4], u1[4], v0[4], v1[4];
#pragma unroll
      for (int c = 0; c < 4; ++c) {
        u0[c] = *reinterpret_cast<const uint4*>(p.Ubf + (size_t)e0 * D + c * 512 + lane * 8);
        u1[c] = *reinterpret_cast<const uint4*>(p.Ubf + (size_t)e1 * D + c * 512 + lane * 8);
        v0[c] = *reinterpret_cast<const uint4*>(p.Vbf + (size_t)e0 * D + c * 512 + lane * 8);
        v1[c] = *reinterpret_cast<const uint4*>(p.Vbf + (size_t)e1 * D + c * 512 + lane * 8);
      }
      float d0 = 0.f, d1 = 0.f;
#pragma unroll
      for (int c = 0; c < 4; ++c) {
        d0 += hf[c * 8 + 0] * bflo(u0[c].x) + hf[c * 8 + 1] * bfhi(u0[c].x) + hf[c * 8 + 2] * bflo(u0[c].y) + hf[c * 8 + 3] * bfhi(u0[c].y) +
              hf[c * 8 + 4] * bflo(u0[c].z) + hf[c * 8 + 5] * bfhi(u0[c].z) + hf[c * 8 + 6] * bflo(u0[c].w) + hf[c * 8 + 7] * bfhi(u0[c].w);
        d1 += hf[c * 8 + 0] * bflo(u1[c].x) + hf[c * 8 + 1] * bfhi(u1[c].x) + hf[c * 8 + 2] * bflo(u1[c].y) + hf[c * 8 + 3] * bfhi(u1[c].y) +
              hf[c * 8 + 4] * bflo(u1[c].z) + hf[c * 8 + 5] * bfhi(u1[c].z) + hf[c * 8 + 6] * bflo(u1[c].w) + hf[c * 8 + 7] * bfhi(u1[c].w);
      }
      d0 = wave_sum(d0); d1 = wave_sum(d1);
      float c0 = g0 * 0.5f * d0 * (1.f + erff(d0 * 0.70710678118654752f));
      float c1 = g1 * 0.5f * d1 * (1.f + erff(d1 * 0.70710678118654752f));
#pragma unroll
      for (int c = 0; c < 4; ++c) {
        acc[c * 8 + 0] += c0 * bflo(v0[c].x) + c1 * bflo(v1[c].x); acc[c * 8 + 1] += c0 * bfhi(v0[c].x) + c1 * bfhi(v1[c].x);
        acc[c * 8 + 2] += c0 * bflo(v0[c].y) + c1 * bflo(v1[c].y); acc[c * 8 + 3] += c0 * bfhi(v0[c].y) + c1 * bfhi(v1[c].y);
        acc[c * 8 + 4] += c0 * bflo(v0[c].z) + c1 * bflo(v1[c].z); acc[c * 8 + 5] += c0 * bfhi(v0[c].z) + c1 * bfhi(v1[c].z);
        acc[c * 8 + 6] += c0 * bflo(v0[c].w) + c1 * bflo(v1[c].w); acc[c * 8 + 7] += c0 * bfhi(v0[c].w) + c1 * bfhi(v1[c].w);
      }
    }
    float ss = 0.f;
#pragma unroll
    for (int e = 0; e < 32; ++e) ss += acc[e] * acc[e];
    ss = wave_sum(ss);
    float rstd = rsqrtf(ss * (1.f / D) + EPS);
    const float* gfx = p.mod + (size_t)b * NMOD + 5 * D;
#pragma unroll
    for (int c = 0; c < 4; ++c) {
      int e0 = c * 512 + lane * 8;
      float* o = p.out + (size_t)t * D + e0;
      float4 x0 = *reinterpret_cast<const float4*>(o), x1v = *reinterpret_cast<const float4*>(o + 4);
      float4 gA = *reinterpret_cast<const float4*>(gfx + e0), gB = *reinterpret_cast<const float4*>(gfx + e0 + 4);
      float4 pA = *reinterpret_cast<const float4*>(p.g_post_ffn + e0), pB = *reinterpret_cast<const float4*>(p.g_post_ffn + e0 + 4);
      x0.x += gA.x * acc[c * 8 + 0] * rstd * pA.x; x0.y += gA.y * acc[c * 8 + 1] * rstd * pA.y;
      x0.z += gA.z * acc[c * 8 + 2] * rstd * pA.z; x0.w += gA.w * acc[c * 8 + 3] * rstd * pA.w;
      x1v.x += gB.x * acc[c * 8 + 4] * rstd * pB.x; x1v.y += gB.y * acc[c * 8 + 5] * rstd * pB.y;
      x1v.z += gB.z * acc[c * 8 + 6] * rstd * pB.z; x1v.w += gB.w * acc[c * 8 + 7] * rstd * pB.w;
      *reinterpret_cast<float4*>(o) = x0; *reinterpret_cast<float4*>(o + 4) = x1v;
    }
  }
}


__global__ void __launch_bounds__(NTHREADS, 2) fwd_mega(Params p) {
  __shared__ __attribute__((aligned(16))) char smem[68608];
  cg::grid_group grid = cg::this_grid();
  const int bid = blockIdx.x, nb = gridDim.x;
  phase_prep(p, bid, nb, smem);        grid.sync();
  phase_fold(p, bid, nb, smem);        grid.sync();
  phase_norm_mod(p, bid, nb, smem);    grid.sync();
  phase_inproj(p, bid, nb, smem);      grid.sync();
  phase_ssm_pre(p, bid, nb);           grid.sync();
  phase_ctxscan_dft(p, bid, nb, smem); grid.sync();
  phase_xscan(p, bid, nb);             grid.sync();
  phase_ssm_post(p, bid, nb, smem);    grid.sync();
  phase_outproj(p, bid, nb, smem);     grid.sync();
  phase_postmix(p, bid, nb, smem);     grid.sync();
  phase_qgemm(p, bid, nb, smem);       grid.sync();
  phase_route(p, bid, nb, smem);       grid.sync();
  phase_experts(p, bid, nb);
}

}

extern "C" void kernel_launch(void* const* d_in, const int* in_sizes, int n_in, void* d_out, int out_size, void* d_ws,
                              size_t ws_size, hipStream_t stream) {
  Params p{};
  const float** fp = reinterpret_cast<const float**>(&p);
  for (int i = 0; i < 27; ++i) fp[i] = (const float*)d_in[i];
  p.out = (float*)d_out;
  char* ws = (char*)d_ws;
  size_t off = 0;
  auto take = [&](size_t bytes) { char* r = ws + off; off += (bytes + 255) & ~(size_t)255; return r; };
  p.Ubf = (bf16_t*)take((size_t)16384 * D * 2);
  p.Vbf = (bf16_t*)take((size_t)16384 * D * 2);
  p.w_in_t = (bf16_t*)take((size_t)NPROJ * D * 2);
  p.w_out_t = (bf16_t*)take((size_t)D * D * 2);
  p.w_q_t = (bf16_t*)take((size_t)1024 * D * 2);
  p.w_in_f = (bf16_t*)take((size_t)D * 1024 * 2);
  p.WcsT = (bf16_t*)take((size_t)4 * 512 * 256 * 2);
  p.dftm = (bf16_t*)take((size_t)2048 * 4096 * 2);
  p.partial = (float*)take((size_t)KSPLIT * 5 * NMOD * 4);
  p.mod = (float*)take((size_t)5 * NMOD * 4);
  p.hx = (bf16_t*)take((size_t)T * D * 2);
  p.hc = (bf16_t*)take((size_t)TC * D * 2);
  p.ABt = (bf16_t*)take((size_t)NB * 1024 * 4096 * 2);
  p.q = (float*)p.ABt;
  p.z = (bf16_t*)take((size_t)T * 1024 * 2);
  char* r1 = take(0);
  p.xbcraw = (float*)take((size_t)T * DXBC * 4);
  p.xbcraw_c = (float*)take((size_t)TC * DXBC * 4);
  p.xact = (float*)take((size_t)T * DXBC * 4);
  p.xact_c = (float*)take((size_t)TC * DXBC * 4);
  p.y_x = (float*)r1;
  p.dtraw = (float*)take((size_t)T * 32 * 4);
  p.dtraw_c = (float*)take((size_t)TC * 32 * 4);
  p.dtf = (float*)take((size_t)T * 16 * 4);
  p.dtb = (float*)take((size_t)T * 16 * 4);
  p.dtf_c = (float*)take((size_t)TC * 16 * 4);
  p.dtb_c = (float*)take((size_t)TC * 16 * 4);
  p.yf = (float*)take((size_t)T * 1024 * 4);
  p.yb = (float*)take((size_t)T * 1024 * 4);
  p.fin_f = (float*)take((size_t)NB * NH * HP * NS * 4);
  p.fin_b = (float*)take((size_t)NB * NH * HP * NS * 4);
  p.ycat = (bf16_t*)take((size_t)T * D * 2);
  p.idx = (int*)take((size_t)T * 128 * 4);
  p.gate = (float*)take((size_t)T * 128 * 4);
  if (off > ws_size) { fprintf(stderr, "kernel_launch: workspace too small: need %zu have %zu\n", off, ws_size); return; }
  static int grid_blocks = 0;
  if (!grid_blocks) {
    int dev = 0, cus = 0, per_cu = 0;
    hipGetDevice(&dev);
    hipDeviceGetAttribute(&cus, hipDeviceAttributeMultiprocessorCount, dev);
    hipOccupancyMaxActiveBlocksPerMultiprocessor(&per_cu, fwd_mega, NTHREADS, 0);
    if (per_cu > 2) per_cu = 2;
    grid_blocks = cus * per_cu;
    if (grid_blocks <= 0) { fprintf(stderr, "kernel_launch: occupancy query gave %d x %d\n", cus, per_cu); grid_blocks = -1; }
  }
  if (grid_blocks < 0) return;
  void* args[] = {&p};
  hipError_t e = hipLaunchCooperativeKernel((void*)fwd_mega, dim3(grid_blocks), dim3(NTHREADS), args, 0, stream);
  if (e != hipSuccess) fprintf(stderr, "cooperative launch failed: %s (grid %d)\n", hipGetErrorString(e), grid_blocks);
}
```

```cpp
#include <hip/hip_runtime.h>
#include <hip/hip_cooperative_groups.h>
#include <stdint.h>
#include <stdio.h>

namespace cg = cooperative_groups;
namespace {

typedef __attribute__((ext_vector_type(8))) short bf16x8;
typedef __attribute__((ext_vector_type(4))) float f32x4;
typedef unsigned short bf16_t;

constexpr int D = 2048, NB = 4, L = 2048, T = NB * L, CTX = 256, TC = NB * CTX;
constexpr int NMOD = 6 * D;
constexpr int NH = 16, HP = 64, NS = 128, DXBC = 1536;
constexpr int DIN = 3616;
constexpr int NPROJ = 4736;
constexpr int KSPLIT = 32;
constexpr float EPS = 1e-6f;
constexpr int NTHREADS = 256;

__device__ __forceinline__ bf16_t f2bf(float f) {
  uint32_t u = __float_as_uint(f);
  u += 0x7fffu + ((u >> 16) & 1u);
  return (bf16_t)(u >> 16);
}
__device__ __forceinline__ float bf2f(bf16_t h) { return __uint_as_float(((uint32_t)h) << 16); }
__device__ __forceinline__ uint32_t pack2(float a, float b) { return (uint32_t)f2bf(a) | ((uint32_t)f2bf(b) << 16); }
__device__ __forceinline__ float bflo(uint32_t w) { return __uint_as_float(w << 16); }
__device__ __forceinline__ float bfhi(uint32_t w) { return __uint_as_float(w & 0xffff0000u); }
__device__ __forceinline__ float silu_f(float v) { return v / (1.f + __expf(-v)); }
__device__ __forceinline__ float softplus_f(float v) { return v > 20.f ? v : log1pf(__expf(v)); }

__device__ __forceinline__ float wave_sum(float v) {
#pragma unroll
  for (int o = 32; o > 0; o >>= 1) v += __shfl_xor(v, o);
  return v;
}
__device__ __forceinline__ float wave_max(float v) {
#pragma unroll
  for (int o = 32; o > 0; o >>= 1) v = fmaxf(v, __shfl_xor(v, o));
  return v;
}
__device__ __forceinline__ float block_sum(float v, float* red) {
  v = wave_sum(v);
  __syncthreads();
  if ((threadIdx.x & 63) == 0) red[threadIdx.x >> 6] = v;
  __syncthreads();
  return red[0] + red[1] + red[2] + red[3];
}

struct Params {
  const float *x, *c, *ctx, *c_ctx, *w_mod, *b_mod, *g_pre_mix, *g_post_mix, *g_pre_ffn, *g_post_ffn;
  const float *w_in, *w_fmix, *conv_w, *conv_b, *dt_bias_f, *dt_bias_b, *a_log_f, *a_log_b, *d_skip_f, *d_skip_b;
  const float *ssm_norm_w, *w_out, *w_query, *sk1, *sk2, *eu, *ev;
  float* out;
  bf16_t *Ubf, *Vbf, *w_in_t, *w_out_t, *w_q_t, *w_in_f, *WcsT, *dftm;
  float *partial, *mod;
  bf16_t *hx, *hc, *ABt, *z;
  float *xbcraw, *xbcraw_c, *dtraw, *dtraw_c, *dtf, *dtb, *dtf_c, *dtb_c;
  bf16_t *act_tm, *act_cm_x, *act_cm_c;
  float *yf, *yb;
  unsigned* ctr;
  bf16_t* ycat;
  float *y_x, *q, *gate;
  int* idx;
  int pad0, pad1;
};

template <class Epi>
__device__ __forceinline__ void gemm_tile(const bf16_t* __restrict__ A, int lda, const bf16_t* __restrict__ Bt, int ldb,
                                          int K, int m0, int n0, const Epi& epi, char* smem) {
  const int tid = threadIdx.x, lane = tid & 63, w = tid >> 6;
  const int wm = w >> 1, wn = w & 1;
  f32x4 acc[4][4];
#pragma unroll
  for (int i = 0; i < 4; ++i)
#pragma unroll
    for (int j = 0; j < 4; ++j) acc[i][j] = f32x4{0.f, 0.f, 0.f, 0.f};

  uint4 ra0, ra1, ra2, ra3, rb0, rb1, rb2, rb3;
  const int nk = K / 64;
  const int lrow = tid >> 3, lch = tid & 7;
  const bf16_t* gA = A + (size_t)(m0 + lrow) * lda + lch * 8;
  const bf16_t* gB = Bt + (size_t)(n0 + lrow) * ldb + lch * 8;
  const int soff = lrow * 128 + ((lch ^ (lrow & 7)) << 4);
#define GLOAD(kt_)                                                                  \
  do {                                                                              \
    ra0 = *reinterpret_cast<const uint4*>(gA + (kt_) * 64);                         \
    ra1 = *reinterpret_cast<const uint4*>(gA + (size_t)32 * lda + (kt_) * 64);      \
    ra2 = *reinterpret_cast<const uint4*>(gA + (size_t)64 * lda + (kt_) * 64);      \
    ra3 = *reinterpret_cast<const uint4*>(gA + (size_t)96 * lda + (kt_) * 64);      \
    rb0 = *reinterpret_cast<const uint4*>(gB + (kt_) * 64);                         \
    rb1 = *reinterpret_cast<const uint4*>(gB + (size_t)32 * ldb + (kt_) * 64);      \
    rb2 = *reinterpret_cast<const uint4*>(gB + (size_t)64 * ldb + (kt_) * 64);      \
    rb3 = *reinterpret_cast<const uint4*>(gB + (size_t)96 * ldb + (kt_) * 64);      \
  } while (0)
  GLOAD(0);
  for (int kt = 0; kt < nk; ++kt) {
    char* sA = smem + (kt & 1) * 32768;
    char* sB = sA + 16384;
    *reinterpret_cast<uint4*>(sA + soff) = ra0;
    *reinterpret_cast<uint4*>(sA + soff + 4096) = ra1;
    *reinterpret_cast<uint4*>(sA + soff + 8192) = ra2;
    *reinterpret_cast<uint4*>(sA + soff + 12288) = ra3;
    *reinterpret_cast<uint4*>(sB + soff) = rb0;
    *reinterpret_cast<uint4*>(sB + soff + 4096) = rb1;
    *reinterpret_cast<uint4*>(sB + soff + 8192) = rb2;
    *reinterpret_cast<uint4*>(sB + soff + 12288) = rb3;
    __syncthreads();
    if (kt + 1 < nk) GLOAD(kt + 1);
#pragma unroll
    for (int kk = 0; kk < 2; ++kk) {
      bf16x8 af[4], bfr[4];
      const int ch = kk * 4 + (lane >> 4);
#pragma unroll
      for (int i = 0; i < 4; ++i) {
        int row = wm * 64 + i * 16 + (lane & 15);
        af[i] = *reinterpret_cast<const bf16x8*>(sA + row * 128 + ((ch ^ (row & 7)) << 4));
        int col = wn * 64 + i * 16 + (lane & 15);
        bfr[i] = *reinterpret_cast<const bf16x8*>(sB + col * 128 + ((ch ^ (col & 7)) << 4));
      }
#pragma unroll
      for (int i = 0; i < 4; ++i)
#pragma unroll
        for (int j = 0; j < 4; ++j) acc[i][j] = __builtin_amdgcn_mfma_f32_16x16x32_bf16(af[i], bfr[j], acc[i][j], 0, 0, 0);
    }
  }
#undef GLOAD
  __syncthreads();
#pragma unroll
  for (int i = 0; i < 4; ++i)
#pragma unroll
    for (int j = 0; j < 4; ++j) {
      int row = m0 + wm * 64 + i * 16 + (lane >> 4) * 4;
      int col = n0 + wn * 64 + j * 16 + (lane & 15);
      epi(row, col, acc[i][j]);
    }
}

struct EpiF32 {
  float* C; int ldc;
  __device__ __forceinline__ void operator()(int row, int col, f32x4 v) const {
#pragma unroll
    for (int r = 0; r < 4; ++r) C[(size_t)(row + r) * ldc + col] = v[r];
  }
};
struct EpiBf16 {
  bf16_t* C; int ldc;
  __device__ __forceinline__ void operator()(int row, int col, f32x4 v) const {
#pragma unroll
    for (int r = 0; r < 4; ++r) C[(size_t)(row + r) * ldc + col] = f2bf(v[r]);
  }
};
struct EpiBf16T {
  bf16_t* Ct; int ldc;
  __device__ __forceinline__ void operator()(int row, int col, f32x4 v) const {
    uint2 pk; pk.x = pack2(v[0], v[1]); pk.y = pack2(v[2], v[3]);
    *reinterpret_cast<uint2*>(Ct + (size_t)col * ldc + row) = pk;
  }
};
struct EpiInProj {
  bf16_t* ABt; bf16_t* z; float* xbcraw; float* dtraw; int seqlen;
  __device__ __forceinline__ void operator()(int row, int col, f32x4 v) const {
    if (col < 2048) {
      int ch = col & 1023, half = col >> 10;
      int b = row / seqlen, l = row - b * seqlen;
      uint2 pk; pk.x = pack2(v[0], v[1]); pk.y = pack2(v[2], v[3]);
      *reinterpret_cast<uint2*>(ABt + ((size_t)(b * 1024 + ch) * 4096 + half * 2048 + l)) = pk;
    } else if (col < 3072) {
#pragma unroll
      for (int r = 0; r < 4; ++r) z[(size_t)(row + r) * 1024 + (col - 2048)] = f2bf(v[r]);
    } else if (col < 4608) {
#pragma unroll
      for (int r = 0; r < 4; ++r) xbcraw[(size_t)(row + r) * DXBC + (col - 3072)] = v[r];
    } else if (col < 4640) {
#pragma unroll
      for (int r = 0; r < 4; ++r) dtraw[(size_t)(row + r) * 32 + (col - 4608)] = v[r];
    }
  }
};

__device__ void adaln_partial_task(const Params& p, int task, float* sm) {
  const int cb = task % 48, ks = task / 48, tid = threadIdx.x;
  float* sc = sm;
  __syncthreads();
  for (int i = tid; i < 5 * 64; i += NTHREADS) {
    int r = i >> 6, kk = i & 63;
    int k = ks * 64 + kk;
    float cv = (r < 4) ? p.c[r * D + k] : p.c_ctx[k];
    sc[i] = silu_f(cv);
  }
  __syncthreads();
  const int col = cb * 256 + tid;
  float a0 = 0, a1 = 0, a2 = 0, a3 = 0, a4 = 0;
  const float* wp = p.w_mod + (size_t)(ks * 64) * NMOD + col;
#pragma unroll 8
  for (int kk = 0; kk < 64; ++kk) {
    float wv = wp[(size_t)kk * NMOD];
    a0 += sc[kk] * wv; a1 += sc[64 + kk] * wv; a2 += sc[128 + kk] * wv; a3 += sc[192 + kk] * wv; a4 += sc[256 + kk] * wv;
  }
  float* pp = p.partial + (size_t)ks * 5 * NMOD + col;
  pp[0] = a0; pp[NMOD] = a1; pp[2 * NMOD] = a2; pp[3 * NMOD] = a3; pp[4 * NMOD] = a4;
}

__device__ void transpose_convert_task(const float* __restrict__ src, int ld, int c0, int rows, bf16_t* __restrict__ dst,
                                       int tr, int tc, float* sm) {
  float (*tile)[65] = reinterpret_cast<float (*)[65]>(sm);
  const int tid = threadIdx.x;
  __syncthreads();
  for (int i = tid; i < 64 * 64; i += NTHREADS) {
    int r = i >> 6, cc = i & 63;
    tile[r][cc] = src[(size_t)(tr * 64 + r) * ld + c0 + tc * 64 + cc];
  }
  __syncthreads();
  for (int i = tid; i < 64 * 32; i += NTHREADS) {
    int cc = i >> 5, r2 = (i & 31) * 2;
    uint32_t pk = pack2(tile[r2][cc], tile[r2 + 1][cc]);
    *reinterpret_cast<uint32_t*>(dst + (size_t)(tc * 64 + cc) * rows + tr * 64 + r2) = pk;
  }
}

__device__ void phase_prep(const Params& p, int bid, int nb, char* smem) {
  float* sm = reinterpret_cast<float*>(smem);
  const int tid = threadIdx.x;
  if (bid == 0 && tid == 0) p.ctr[0] = 0u;
  for (int t = bid; t < 48 * KSPLIT; t += nb) adaln_partial_task(p, t, sm);
  {
    const size_t n8 = (size_t)16384 * D / 8;
    for (size_t i = (size_t)bid * NTHREADS + tid; i < 2 * n8; i += (size_t)nb * NTHREADS) {
      const float* s = (i < n8) ? p.eu : p.ev;
      bf16_t* d = (i < n8) ? p.Ubf : p.Vbf;
      size_t j = (i < n8) ? i : i - n8;
      float4 v0 = *reinterpret_cast<const float4*>(s + j * 8);
      float4 v1 = *reinterpret_cast<const float4*>(s + j * 8 + 4);
      uint4 o; o.x = pack2(v0.x, v0.y); o.y = pack2(v0.z, v0.w); o.z = pack2(v1.x, v1.y); o.w = pack2(v1.z, v1.w);
      *reinterpret_cast<uint4*>(d + j * 8) = o;
    }
  }
  {
    const int nct = 41, nrt = 32;
    for (int t = bid; t < nct * nrt; t += nb) {
      int tc = t % nct, tr = t / nct;
      if (tc < 40) transpose_convert_task(p.w_in, DIN, 1024, D, p.w_in_t + (size_t)2048 * D, tr, tc, sm);
      else {
        float (*tile)[65] = reinterpret_cast<float (*)[65]>(sm);
        __syncthreads();
        for (int i = tid; i < 64 * 32; i += NTHREADS) {
          int r = i >> 5, cc = i & 31;
          tile[r][cc] = p.w_in[(size_t)(tr * 64 + r) * DIN + 1024 + 2560 + cc];
        }
        __syncthreads();
        for (int i = tid; i < 32 * 32; i += NTHREADS) {
          int cc = i >> 5, r2 = (i & 31) * 2;
          uint32_t pk = pack2(tile[r2][cc], tile[r2 + 1][cc]);
          *reinterpret_cast<uint32_t*>(p.w_in_t + (size_t)(2048 + 2560 + cc) * D + tr * 64 + r2) = pk;
        }
      }
    }
    for (int t = bid; t < 32 * 32; t += nb) transpose_convert_task(p.w_out, D, 0, D, p.w_out_t, t / 32, t % 32, sm);
    for (int t = bid; t < 16 * 32; t += nb) transpose_convert_task(p.w_query, 1024, 0, D, p.w_q_t, t / 16, t % 16, sm);
    for (size_t i = (size_t)bid * NTHREADS + tid; i < (size_t)96 * D / 8; i += (size_t)nb * NTHREADS)
      reinterpret_cast<uint4*>(p.w_in_t + (size_t)4640 * D)[i] = uint4{0, 0, 0, 0};
  }
  for (size_t i = (size_t)bid * NTHREADS + tid; i < (size_t)D * 1024 / 4; i += (size_t)nb * NTHREADS) {
    int k = (int)(i / 256), c4 = (int)(i % 256) * 4;
    float4 v = *reinterpret_cast<const float4*>(p.w_in + (size_t)k * DIN + c4);
    uint2 o; o.x = pack2(v.x, v.y); o.y = pack2(v.z, v.w);
    *reinterpret_cast<uint2*>(p.w_in_f + (size_t)k * 1024 + c4) = o;
  }
  {
    const float scale = 1.0f / sqrtf((float)L * 256.f);
    for (int i = bid * NTHREADS + tid; i < 4 * 256 * 256; i += nb * NTHREADS) {
      int d = i & 255, c = (i >> 8) & 255, g = i >> 16;
      float sc_ = 0.f, ss_ = 0.f;
      for (int m = 0; m < 256; ++m) {
        int ph = (m * c) & 255;
        float sv, cv;
        sincospif((float)ph * (1.0f / 128.f), &sv, &cv);
        float wv = p.w_fmix[((size_t)g * 256 + m) * 256 + d];
        sc_ += cv * wv; ss_ += sv * wv;
      }
      p.WcsT[((size_t)g * 512 + d) * 256 + c] = f2bf(sc_ * scale);
      p.WcsT[((size_t)g * 512 + 256 + d) * 256 + c] = f2bf(ss_ * scale);
    }
  }
  for (size_t i = (size_t)bid * NTHREADS + tid; i < (size_t)2048 * 4096 / 2; i += (size_t)nb * NTHREADS) {
    int k = (int)(i / 2048), j = (int)(i % 2048) * 2;
    float o[2];
#pragma unroll
    for (int e = 0; e < 2; ++e) {
      int jj = j + e;
      int l = jj & 2047;
      int ph = (k * l) & 2047;
      float sv, cv;
      sincospif((float)ph * (1.0f / 1024.f), &sv, &cv);
      o[e] = (jj < 2048) ? cv : -sv;
    }
    *reinterpret_cast<uint32_t*>(p.dftm + (size_t)k * 4096 + j) = pack2(o[0], o[1]);
  }
}

__device__ void phase_fold(const Params& p, int bid, int nb, char* smem) {
  const int tid = threadIdx.x;
  for (int i = bid * NTHREADS + tid; i < 5 * NMOD; i += nb * NTHREADS) {
    int col = i % NMOD;
    float s = p.b_mod[col];
    for (int ks = 0; ks < KSPLIT; ++ks) s += p.partial[(size_t)ks * 5 * NMOD + i];
    p.mod[i] = s;
  }
  for (int t = bid; t < 256; t += nb) {
    int g = t >> 6, tm = (t & 63) >> 2, tn = t & 3;
    int n0 = tn * 128;
    int rowbase = (n0 < 256) ? (g * 256 + n0) : (1024 + g * 256 + (n0 - 256));
    EpiBf16T epi{p.w_in_t + (size_t)(rowbase - n0) * D, D};
    gemm_tile(p.w_in_f + g * 256, 1024, p.WcsT + (size_t)g * 512 * 256, 256, 256, tm * 128, n0, epi, smem);
  }
}

__device__ void phase_norm_mod(const Params& p, int bid, int nb, char* smem) {
  float* red = reinterpret_cast<float*>(smem);
  const int tid = threadIdx.x;
  for (int t = bid; t < T + TC; t += nb) {
    const bool isx = t < T;
    const float* src = isx ? (p.x + (size_t)t * D) : (p.ctx + (size_t)(t - T) * D);
    const int mrow = isx ? (t / L) : 4;
    bf16_t* dst = isx ? (p.hx + (size_t)t * D) : (p.hc + (size_t)(t - T) * D);
    float4 v0 = *reinterpret_cast<const float4*>(src + tid * 8);
    float4 v1 = *reinterpret_cast<const float4*>(src + tid * 8 + 4);
    float ss = v0.x * v0.x + v0.y * v0.y + v0.z * v0.z + v0.w * v0.w + v1.x * v1.x + v1.y * v1.y + v1.z * v1.z + v1.w * v1.w;
    ss = block_sum(ss, red);
    float rstd = rsqrtf(ss * (1.f / D) + EPS);
    const float* sh = p.mod + (size_t)mrow * NMOD + 0 * D + tid * 8;
    const float* sc = p.mod + (size_t)mrow * NMOD + 1 * D + tid * 8;
    const float* g = p.g_pre_mix + tid * 8;
    float vv[8] = {v0.x, v0.y, v0.z, v0.w, v1.x, v1.y, v1.z, v1.w};
    float o[8];
#pragma unroll
    for (int e = 0; e < 8; ++e) o[e] = vv[e] * rstd * g[e] * (1.f + sc[e]) + sh[e];
    uint4 pk; pk.x = pack2(o[0], o[1]); pk.y = pack2(o[2], o[3]); pk.z = pack2(o[4], o[5]); pk.w = pack2(o[6], o[7]);
    *reinterpret_cast<uint4*>(dst + tid * 8) = pk;
  }
}

__device__ void phase_inproj(const Params& p, int bid, int nb, char* smem) {
  const int ntx = 64 * 37, ntc = 8 * 13;
  for (int t = bid; t < ntx + ntc; t += nb) {
    if (t < ntx) {
      int tm = t / 37, tn = t % 37;
      EpiInProj epi{p.ABt, p.z, p.xbcraw, p.dtraw, L};
      gemm_tile(p.hx, D, p.w_in_t, D, D, tm * 128, tn * 128, epi, smem);
    } else {
      int u = t - ntx;
      int tm = u / 13, tn = u % 13;
      EpiInProj epi{nullptr, nullptr, p.xbcraw_c, p.dtraw_c, CTX};
      gemm_tile(p.hc, D, p.w_in_t, D, D, tm * 128, 3072 + tn * 128, epi, smem);
    }
  }
}

__device__ void ssm_pre_tile(const Params& p, int task, char* smem) {
  const bool isx = task < 3072;
  const int u = isx ? task : task - 3072;
  const int ntt = isx ? 32 : 4;
  const int ct = u % 24, tt = (u / 24) % ntt, b = u / (24 * ntt);
  const int seqlen = isx ? L : CTX;
  const float* raw = (isx ? p.xbcraw : p.xbcraw_c) + (size_t)b * seqlen * DXBC;
  const int l0 = tt * 64, c0 = ct * 64, tid = threadIdx.x;
  float (*rt)[65] = reinterpret_cast<float (*)[65]>(smem);
  float (*at)[65] = reinterpret_cast<float (*)[65]>(smem + 66 * 65 * 4);
  __syncthreads();
  for (int i = tid; i < 66 * 64; i += NTHREADS) {
    int r = i >> 6, cc = i & 63, l = l0 - 1 + r;
    rt[r][cc] = (l >= 0 && l < seqlen) ? raw[(size_t)l * DXBC + c0 + cc] : 0.f;
  }
  __syncthreads();
  for (int i = tid; i < 64 * 64; i += NTHREADS) {
    int r = i >> 6, cc = i & 63, c = c0 + cc;
    float acc = p.conv_b[c] + rt[r][cc] * p.conv_w[c] + rt[r + 1][cc] * p.conv_w[DXBC + c] + rt[r + 2][cc] * p.conv_w[2 * DXBC + c];
    at[r][cc] = silu_f(acc);
  }
  __syncthreads();
  const size_t trow0 = isx ? ((size_t)b * L + l0) : ((size_t)T + (size_t)b * CTX + l0);
  for (int i = tid; i < 64 * 32; i += NTHREADS) {
    int r = i >> 5, c2 = (i & 31) * 2;
    *reinterpret_cast<uint32_t*>(p.act_tm + (trow0 + r) * DXBC + c0 + c2) = pack2(at[r][c2], at[r][c2 + 1]);
  }
  if (c0 < 1280) {
    bf16_t* cm = (isx ? p.act_cm_x : p.act_cm_c) + (size_t)b * 1280 * seqlen;
    for (int i = tid; i < 64 * 32; i += NTHREADS) {
      int cc = i >> 5, r2 = (i & 31) * 2;
      *reinterpret_cast<uint32_t*>(cm + (size_t)(c0 + cc) * seqlen + l0 + r2) = pack2(at[r2][cc], at[r2 + 1][cc]);
    }
  }
}
__device__ void phase_ssm_pre(const Params& p, int bid, int nb, char* smem) {
  const int tid = threadIdx.x;
  for (int t = bid; t < 3072 + 384; t += nb) ssm_pre_tile(p, t, smem);
  for (int i = bid * NTHREADS + tid; i < (T + TC) * 32; i += nb * NTHREADS) {
    const bool isx = i < T * 32;
    const int ii = isx ? i : i - T * 32;
    const int t = ii >> 5, j = ii & 31;
    const float v = (isx ? p.dtraw : p.dtraw_c)[ii];
    float* df = isx ? p.dtf : p.dtf_c;
    float* db = isx ? p.dtb : p.dtb_c;
    if (j < 16) df[t * 16 + j] = softplus_f(v + p.dt_bias_f[j]);
    else db[t * 16 + (j - 16)] = softplus_f(v + p.dt_bias_b[j - 16]);
  }
}

__device__ __forceinline__ int swz16(int row, int chunk) { return row * 256 + ((chunk ^ (row & 15)) << 4); }
__device__ __forceinline__ int swz8(int row, int chunk) { return row * 128 + ((chunk ^ (row & 7)) << 4); }

__device__ void ssd_task(const Params& p, int task, char* smem) {
  const int dir = task & 1, h = (task >> 1) & 15, b = task >> 5;
  const int tid = threadIdx.x, lane = tid & 63, w = tid >> 6;
  const int g = h >> 3, lr0 = lane & 15, lq0 = lane >> 4;
  const float a = -__expf(dir ? p.a_log_b[h] : p.a_log_f[h]);
  char* sCc = smem; char* sBc = smem + 16384; char* sBT = smem + 32768; char* sXT = smem + 49152; char* sHb = smem + 57344;
  float* se = reinterpret_cast<float*>(smem + 73728);
  float* sdt = se + 64; float* sw = se + 128; float* sy = se + 192; float* stot = se + 256;
  float* yo = dir ? p.yb : p.yf;
  f32x4 H[8];
#pragma unroll
  for (int j = 0; j < 8; ++j) H[j] = f32x4{0.f, 0.f, 0.f, 0.f};
  __syncthreads();
  for (int i = tid; i < 1024; i += NTHREADS) reinterpret_cast<uint4*>(sHb)[i] = uint4{0, 0, 0, 0};
  for (int step = 0; step < 36; ++step) {
    const bool isctx = step < 4;
    const int nch = isctx ? 4 : 32, ci = isctx ? step : step - 4;
    const int c = dir ? (nch - 1 - ci) : ci;
    const int seqlen = isctx ? CTX : L;
    const size_t trow0 = isctx ? ((size_t)T + (size_t)b * CTX + c * 64) : ((size_t)b * L + c * 64);
    const size_t drow0 = (size_t)b * seqlen + c * 64;
    const float* dtp = isctx ? (dir ? p.dtb_c : p.dtf_c) : (dir ? p.dtb : p.dtf);
    const bf16_t* cm = (isctx ? p.act_cm_c : p.act_cm_x) + (size_t)b * 1280 * seqlen + c * 64;
    int lr = lr0, lq = lq0;
    asm volatile("" : "+v"(lr), "+v"(lq));
    __syncthreads();
    if (w == 0) {
      const float dtv = dtp[(drow0 + lane) * 16 + h];
      float v = a * dtv;
      if (!dir) {
#pragma unroll
        for (int o = 1; o < 64; o <<= 1) { float n = __shfl_up(v, o); v += (lane >= o) ? n : 0.f; }
      } else {
#pragma unroll
        for (int o = 1; o < 64; o <<= 1) { float n = __shfl_down(v, o); v += (lane + o < 64) ? n : 0.f; }
      }
      const float etot = __shfl(v, dir ? 0 : 63);
      se[lane] = v; sdt[lane] = dtv; sw[lane] = dtv * __expf(etot - v); sy[lane] = __expf(v);
      if (lane == 0) stot[0] = etot;
    }
    if (!isctx) {
#pragma unroll
      for (int r = 0; r < 4; ++r) {
        const int id = tid + 256 * r, row = id >> 4, ch = id & 15;
        const bf16_t* src = p.act_tm + (trow0 + row) * DXBC + g * 128 + ch * 8;
        *reinterpret_cast<uint4*>(sCc + swz16(row, ch)) = *reinterpret_cast<const uint4*>(src + 1280);
        *reinterpret_cast<uint4*>(sBc + swz16(row, ch)) = *reinterpret_cast<const uint4*>(src + 1024);
      }
    }
#pragma unroll
    for (int r = 0; r < 4; ++r) {
      const int id = tid + 256 * r, row = id >> 3, ch = id & 7;
      *reinterpret_cast<uint4*>(sBT + swz8(row, ch)) = *reinterpret_cast<const uint4*>(cm + (size_t)(1024 + g * 128 + row) * seqlen + ch * 8);
    }
#pragma unroll
    for (int r = 0; r < 2; ++r) {
      const int id = tid + 256 * r, row = id >> 3, ch = id & 7;
      *reinterpret_cast<uint4*>(sXT + swz8(row, ch)) = *reinterpret_cast<const uint4*>(cm + (size_t)(h * 64 + row) * seqlen + ch * 8);
    }
    __syncthreads();
    const float etot = stot[0];
    if (!isctx) {
      f32x4 G[4];
      bf16x8 ca[4];
#pragma unroll
      for (int j = 0; j < 4; ++j) G[j] = f32x4{0.f, 0.f, 0.f, 0.f};
#pragma unroll
      for (int kk = 0; kk < 4; ++kk) ca[kk] = *reinterpret_cast<const bf16x8*>(sCc + swz16(16 * w + lr, kk * 4 + lq));
#pragma unroll
      for (int kk = 0; kk < 4; ++kk)
#pragma unroll
        for (int j = 0; j < 4; ++j) {
          bf16x8 bb = *reinterpret_cast<const bf16x8*>(sBc + swz16(16 * j + lr, kk * 4 + lq));
          G[j] = __builtin_amdgcn_mfma_f32_16x16x32_bf16(ca[kk], bb, G[j], 0, 0, 0);
        }
      __syncthreads();
      float el[4];
#pragma unroll
      for (int r = 0; r < 4; ++r) el[r] = se[16 * w + lq * 4 + r];
#pragma unroll
      for (int j = 0; j < 4; ++j) {
        const int s_ = 16 * j + lr;
        const float es = se[s_], ds = sdt[s_];
#pragma unroll
        for (int r = 0; r < 4; ++r) {
          const int l = 16 * w + lq * 4 + r;
          const bool keep = dir ? (s_ >= l) : (s_ <= l);
          const float m = keep ? G[j][r] * __expf(el[r] - es) * ds : 0.f;
          *reinterpret_cast<bf16_t*>(sBc + swz8(l, s_ >> 3) + (s_ & 7) * 2) = f2bf(m);
        }
      }
      __syncthreads();
      f32x4 Y[4], Yo[4];
#pragma unroll
      for (int j = 0; j < 4; ++j) { Y[j] = f32x4{0.f, 0.f, 0.f, 0.f}; Yo[j] = f32x4{0.f, 0.f, 0.f, 0.f}; }
#pragma unroll
      for (int kk = 0; kk < 2; ++kk) {
        bf16x8 ma = *reinterpret_cast<const bf16x8*>(sBc + swz8(16 * w + lr, kk * 4 + lq));
#pragma unroll
        for (int j = 0; j < 4; ++j) {
          bf16x8 xb = *reinterpret_cast<const bf16x8*>(sXT + swz8(16 * j + lr, kk * 4 + lq));
          Y[j] = __builtin_amdgcn_mfma_f32_16x16x32_bf16(ma, xb, Y[j], 0, 0, 0);
        }
      }
#pragma unroll
      for (int kk = 0; kk < 4; ++kk)
#pragma unroll
        for (int j = 0; j < 4; ++j) {
          bf16x8 hb = *reinterpret_cast<const bf16x8*>(sHb + swz16(16 * j + lr, kk * 4 + lq));
          Yo[j] = __builtin_amdgcn_mfma_f32_16x16x32_bf16(ca[kk], hb, Yo[j], 0, 0, 0);
        }
      float syl[4];
#pragma unroll
      for (int r = 0; r < 4; ++r) syl[r] = sy[16 * w + lq * 4 + r];
#pragma unroll
      for (int j = 0; j < 4; ++j)
#pragma unroll
        for (int r = 0; r < 4; ++r) {
          const int l = 16 * w + lq * 4 + r;
          yo[(trow0 + l) * 1024 + h * 64 + 16 * j + lr] = Y[j][r] + syl[r] * Yo[j][r];
        }
    }
    {
      const float dec = __expf(etot);
#pragma unroll
      for (int j = 0; j < 8; ++j) H[j] *= dec;
#pragma unroll
      for (int kk = 0; kk < 2; ++kk) {
        bf16x8 xa = *reinterpret_cast<const bf16x8*>(sXT + swz8(16 * w + lr, kk * 4 + lq));
        const int s0 = kk * 32 + lq * 8;
        const float4 w0 = *reinterpret_cast<const float4*>(sw + s0), w1 = *reinterpret_cast<const float4*>(sw + s0 + 4);
        bf16x8 xs;
        xs[0] = (short)f2bf(bf2f((bf16_t)xa[0]) * w0.x); xs[1] = (short)f2bf(bf2f((bf16_t)xa[1]) * w0.y);
        xs[2] = (short)f2bf(bf2f((bf16_t)xa[2]) * w0.z); xs[3] = (short)f2bf(bf2f((bf16_t)xa[3]) * w0.w);
        xs[4] = (short)f2bf(bf2f((bf16_t)xa[4]) * w1.x); xs[5] = (short)f2bf(bf2f((bf16_t)xa[5]) * w1.y);
        xs[6] = (short)f2bf(bf2f((bf16_t)xa[6]) * w1.z); xs[7] = (short)f2bf(bf2f((bf16_t)xa[7]) * w1.w);
#pragma unroll
        for (int j = 0; j < 8; ++j) {
          bf16x8 bt = *reinterpret_cast<const bf16x8*>(sBT + swz8(16 * j + lr, kk * 4 + lq));
          H[j] = __builtin_amdgcn_mfma_f32_16x16x32_bf16(xs, bt, H[j], 0, 0, 0);
        }
      }
    }
    __syncthreads();
#pragma unroll
    for (int j = 0; j < 8; ++j) {
      const int n = 16 * j + lr;
#pragma unroll
      for (int r = 0; r < 4; ++r) {
        const int pr = 16 * w + lq * 4 + r;
        *reinterpret_cast<bf16_t*>(sHb + swz16(pr, n >> 3) + (n & 7) * 2) = f2bf(H[j][r]);
      }
    }
  }
}

__device__ void phase_ssd_dft(const Params& p, int bid, int nb, char* smem) {
  for (int t = bid; t < 128; t += nb) ssd_task(p, t, smem);
  int* stile = reinterpret_cast<int*>(smem + 75776);
  for (;;) {
    __syncthreads();
    if (threadIdx.x == 0) *stile = (int)atomicAdd(p.ctr, 1u);
    __syncthreads();
    const int t = *stile;
    if (t >= 4 * 16 * 8) break;
    int b = t >> 7, tm = (t & 127) >> 3, tn = t & 7;
    EpiBf16 epi{p.ycat + (size_t)b * L * D, D};
    gemm_tile(p.dftm, 4096, p.ABt + (size_t)b * 1024 * 4096, 4096, 4096, tm * 128, tn * 128, epi, smem);
  }
}

__device__ void phase_ssm_post(const Params& p, int bid, int nb, char* smem) {
  float* red = reinterpret_cast<float*>(smem);
  const int tid = threadIdx.x, w = tid >> 6;
  for (int t = bid; t < T; t += nb) {
    const int c0 = tid * 4;
    const int h = c0 >> 6;
    const float dsk = p.d_skip_f[h] + p.d_skip_b[h];
    float4 a = *reinterpret_cast<const float4*>(p.yf + (size_t)t * 1024 + c0);
    float4 bq = *reinterpret_cast<const float4*>(p.yb + (size_t)t * 1024 + c0);
    uint2 xq = *reinterpret_cast<const uint2*>(p.act_tm + (size_t)t * DXBC + c0);
    float xs[4] = {bflo(xq.x), bfhi(xq.x), bflo(xq.y), bfhi(xq.y)};
    uint2 zz = *reinterpret_cast<const uint2*>(p.z + (size_t)t * 1024 + c0);
    float zf[4] = {bflo(zz.x), bfhi(zz.x), bflo(zz.y), bfhi(zz.y)};
    float y[4] = {a.x + bq.x + dsk * xs[0], a.y + bq.y + dsk * xs[1], a.z + bq.z + dsk * xs[2], a.w + bq.w + dsk * xs[3]};
    float ss = 0.f;
#pragma unroll
    for (int e = 0; e < 4; ++e) { y[e] *= silu_f(zf[e]); ss += y[e] * y[e]; }
    ss = wave_sum(ss);
    __syncthreads();
    if ((tid & 63) == 0) red[w] = ss;
    __syncthreads();
    float gs = (w < 2) ? (red[0] + red[1]) : (red[2] + red[3]);
    float rstd = rsqrtf(gs * (1.f / 512.f) + EPS);
    float4 nw = *reinterpret_cast<const float4*>(p.ssm_norm_w + c0);
    uint2 o; o.x = pack2(y[0] * rstd * nw.x, y[1] * rstd * nw.y); o.y = pack2(y[2] * rstd * nw.z, y[3] * rstd * nw.w);
    *reinterpret_cast<uint2*>(p.ycat + (size_t)t * D + 1024 + c0) = o;
  }
}

__device__ void phase_outproj(const Params& p, int bid, int nb, char* smem) {
  for (int t = bid; t < 64 * 16; t += nb) {
    EpiF32 epi{p.y_x, D};
    gemm_tile(p.ycat, D, p.w_out_t, D, D, (t >> 4) * 128, (t & 15) * 128, epi, smem);
  }
}
__device__ void phase_qgemm(const Params& p, int bid, int nb, char* smem) {
  for (int t = bid; t < 64 * 8; t += nb) {
    EpiF32 epi{p.q, 1024};
    gemm_tile(p.hx  , D, p.w_q_t, D, D, (t >> 3) * 128, (t & 7) * 128, epi, smem);
  }
}

__device__ void phase_postmix(const Params& p, int bid, int nb, char* smem) {
  float* red = reinterpret_cast<float*>(smem);
  const int tid = threadIdx.x;
  for (int t = bid; t < T; t += nb) {
    const int b = t / L;
    const float* yr = p.y_x + (size_t)t * D + tid * 8;
    const float* xr = p.x + (size_t)t * D + tid * 8;
    float y[8], xv[8];
    *reinterpret_cast<float4*>(y) = *reinterpret_cast<const float4*>(yr);
    *reinterpret_cast<float4*>(y + 4) = *reinterpret_cast<const float4*>(yr + 4);
    *reinterpret_cast<float4*>(xv) = *reinterpret_cast<const float4*>(xr);
    *reinterpret_cast<float4*>(xv + 4) = *reinterpret_cast<const float4*>(xr + 4);
    float ss = 0.f;
#pragma unroll
    for (int e = 0; e < 8; ++e) ss += y[e] * y[e];
    ss = block_sum(ss, red);
    float rstd = rsqrtf(ss * (1.f / D) + EPS);
    const float* gm = p.mod + (size_t)b * NMOD + 2 * D + tid * 8;
    const float* gp = p.g_post_mix + tid * 8;
    float x1[8]; float ss1 = 0.f;
#pragma unroll
    for (int e = 0; e < 8; ++e) { x1[e] = xv[e] + gm[e] * (y[e] * rstd * gp[e]); ss1 += x1[e] * x1[e]; }
    ss1 = block_sum(ss1, red);
    float rstd1 = rsqrtf(ss1 * (1.f / D) + EPS);
    float* o = p.out + (size_t)t * D + tid * 8;
    *reinterpret_cast<float4*>(o) = *reinterpret_cast<float4*>(x1);
    *reinterpret_cast<float4*>(o + 4) = *reinterpret_cast<float4*>(x1 + 4);
    const float* sf = p.mod + (size_t)b * NMOD + 3 * D + tid * 8;
    const float* cf = p.mod + (size_t)b * NMOD + 4 * D + tid * 8;
    const float* gf = p.g_pre_ffn + tid * 8;
    float h2[8];
#pragma unroll
    for (int e = 0; e < 8; ++e) h2[e] = x1[e] * rstd1 * gf[e] * (1.f + cf[e]) + sf[e];
    uint4 pk; pk.x = pack2(h2[0], h2[1]); pk.y = pack2(h2[2], h2[3]); pk.z = pack2(h2[4], h2[5]); pk.w = pack2(h2[6], h2[7]);
    *reinterpret_cast<uint4*>(p.hx + (size_t)t * D + tid * 8) = pk;
  }
}

__device__ void phase_route(const Params& p, int bid, int nb, char* smem) {
  float* qs = reinterpret_cast<float*>(smem);
  float* keys = qs + 512;
  const int tid = threadIdx.x, lane = tid & 63, w = tid >> 6;
  for (int task = bid; task < 8 * 256; task += nb) {
    const int h = task & 7, chunk = task >> 3;
    __syncthreads();
    for (int i = tid; i < 2 * 128 * 64; i += NTHREADS) {
      int s = i >> 13, k = (i >> 6) & 127, d = i & 63;
      const float* src = s ? p.sk2 : p.sk1;
      keys[(s * 128 + k) * 65 + d] = src[((size_t)h * 128 + k) * 64 + d];
    }
    __syncthreads();
    for (int ti = 0; ti < 8; ++ti) {
      const int t = chunk * 32 + w * 8 + ti;
      float* myq = qs + w * 128;
      myq[lane] = p.q[(size_t)t * 1024 + h * 128 + lane];
      myq[64 + lane] = p.q[(size_t)t * 1024 + h * 128 + 64 + lane];
      __builtin_amdgcn_wave_barrier();
      float sv[2][2];
#pragma unroll
      for (int s = 0; s < 2; ++s)
#pragma unroll
        for (int kk = 0; kk < 2; ++kk) {
          const float* kr = keys + (s * 128 + lane + 64 * kk) * 65;
          float acc = 0.f;
#pragma unroll 16
          for (int d = 0; d < 64; ++d) acc += myq[s * 64 + d] * kr[d];
          sv[s][kk] = acc;
        }
      float tv[2] = {0.f, 0.f}; int tix[2] = {0, 0};
#pragma unroll
      for (int s = 0; s < 2; ++s) {
        float v0 = sv[s][0], v1 = sv[s][1];
        for (int r = 0; r < 16; ++r) {
          float m = wave_max(fmaxf(v0, v1));
          unsigned long long bal = __ballot(v0 == m || v1 == m);
          int owner = __ffsll((long long)bal) - 1;
          int which = (v0 == m) ? 0 : 1;
          which = __shfl(which, owner);
          int kidx = owner + 64 * which;
          if (lane == owner) { if (which == 0) v0 = -INFINITY; else v1 = -INFINITY; }
          if (lane == r) { tv[s] = m; tix[s] = kidx; }
        }
      }
      float cv[4];
      {
        float va = __shfl(tv[0], lane >> 2);
#pragma unroll
        for (int j = 0; j < 4; ++j) cv[j] = va + __shfl(tv[1], (lane & 3) * 4 + j);
      }
      float top_s = 0.f; int top_e = 0;
      for (int r = 0; r < 16; ++r) {
        float lm = fmaxf(fmaxf(cv[0], cv[1]), fmaxf(cv[2], cv[3]));
        float m = wave_max(lm);
        unsigned long long bal = __ballot(lm == m);
        int owner = __ffsll((long long)bal) - 1;
        int j = (cv[0] == m) ? 0 : (cv[1] == m) ? 1 : (cv[2] == m) ? 2 : 3;
        j = __shfl(j, owner);
        {
          const bool own = (lane == owner);
          cv[0] = (own && j == 0) ? -INFINITY : cv[0];
          cv[1] = (own && j == 1) ? -INFINITY : cv[1];
          cv[2] = (own && j == 2) ? -INFINITY : cv[2];
          cv[3] = (own && j == 3) ? -INFINITY : cv[3];
        }
        int pos = owner * 4 + j;
        int e1 = __shfl(tix[0], pos >> 4), e2 = __shfl(tix[1], pos & 15);
        if (lane == r) { top_s = m; top_e = e1 * 128 + e2; }
      }
      float smax = __shfl(top_s, 0);
      float ex = (lane < 16) ? __expf(top_s - smax) : 0.f;
      float den = wave_sum(ex);
      if (lane < 16) {
        p.idx[(size_t)t * 128 + h * 16 + lane] = top_e;
        p.gate[(size_t)t * 128 + h * 16 + lane] = ex / den;
      }
      __builtin_amdgcn_wave_barrier();
    }
  }
}

__device__ void phase_experts(const Params& p, int bid, int nb) {
  const int lane = threadIdx.x & 63, w = threadIdx.x >> 6;
  for (int t = bid * 4 + w; t < T; t += nb * 4) {
    const int b = t / L;
    uint4 hq[4];
#pragma unroll
    for (int c = 0; c < 4; ++c) hq[c] = *reinterpret_cast<const uint4*>(p.hx + (size_t)t * D + c * 512 + lane * 8);
    float hf[32];
#pragma unroll
    for (int c = 0; c < 4; ++c) {
      hf[c * 8 + 0] = bflo(hq[c].x); hf[c * 8 + 1] = bfhi(hq[c].x); hf[c * 8 + 2] = bflo(hq[c].y); hf[c * 8 + 3] = bfhi(hq[c].y);
      hf[c * 8 + 4] = bflo(hq[c].z); hf[c * 8 + 5] = bfhi(hq[c].z); hf[c * 8 + 6] = bflo(hq[c].w); hf[c * 8 + 7] = bfhi(hq[c].w);
    }
    float acc[32];
#pragma unroll
    for (int e = 0; e < 32; ++e) acc[e] = 0.f;
    const int* ip = p.idx + (size_t)t * 128;
    const float* gp = p.gate + (size_t)t * 128;
    for (int j0 = 0; j0 < 128; j0 += 2) {
      int e0 = __builtin_amdgcn_readfirstlane(ip[j0]), e1 = __builtin_amdgcn_readfirstlane(ip[j0 + 1]);
      float g0 = gp[j0], g1 = gp[j0 + 1];
      uint4 u0[4], u1[4], v0[4], v1[4];
#pragma unroll
      for (int c = 0; c < 4; ++c) {
        u0[c] = *reinterpret_cast<const uint4*>(p.Ubf + (size_t)e0 * D + c * 512 + lane * 8);
        u1[c] = *reinterpret_cast<const uint4*>(p.Ubf + (size_t)e1 * D + c * 512 + lane * 8);
        v0[c] = *reinterpret_cast<const uint4*>(p.Vbf + (size_t)e0 * D + c * 512 + lane * 8);
        v1[c] = *reinterpret_cast<const uint4*>(p.Vbf + (size_t)e1 * D + c * 512 + lane * 8);
      }
      float d0 = 0.f, d1 = 0.f;
#pragma unroll
      for (int c = 0; c < 4; ++c) {
        d0 += hf[c * 8 + 0] * bflo(u0[c].x) + hf[c * 8 + 1] * bfhi(u0[c].x) + hf[c * 8 + 2] * bflo(u0[c].y) + hf[c * 8 + 3] * bfhi(u0[c].y) +
              hf[c * 8 + 4] * bflo(u0[c].z) + hf[c * 8 + 5] * bfhi(u0[c].z) + hf[c * 8 + 6] * bflo(u0[c].w) + hf[c * 8 + 7] * bfhi(u0[c].w);
        d1 += hf[c * 8 + 0] * bflo(u1[c].x) + hf[c * 8 + 1] * bfhi(u1[c].x) + hf[c * 8 + 2] * bflo(u1[c].y) + hf[c * 8 + 3] * bfhi(u1[c].y) +
              hf[c * 8 + 4] * bflo(u1[c].z) + hf[c * 8 + 5] * bfhi(u1[c].z) + hf[c * 8 + 6] * bflo(u1[c].w) + hf[c * 8 + 7] * bfhi(u1[c].w);
      }
      d0 = wave_sum(d0); d1 = wave_sum(d1);
      float c0 = g0 * 0.5f * d0 * (1.f + erff(d0 * 0.70710678118654752f));
      float c1 = g1 * 0.5f * d1 * (1.f + erff(d1 * 0.70710678118654752f));
#pragma unroll
      for (int c = 0; c < 4; ++c) {
        acc[c * 8 + 0] += c0 * bflo(v0[c].x) + c1 * bflo(v1[c].x); acc[c * 8 + 1] += c0 * bfhi(v0[c].x) + c1 * bfhi(v1[c].x);
        acc[c * 8 + 2] += c0 * bflo(v0[c].y) + c1 * bflo(v1[c].y); acc[c * 8 + 3] += c0 * bfhi(v0[c].y) + c1 * bfhi(v1[c].y);
        acc[c * 8 + 4] += c0 * bflo(v0[c].z) + c1 * bflo(v1[c].z); acc[c * 8 + 5] += c0 * bfhi(v0[c].z) + c1 * bfhi(v1[c].z);
        acc[c * 8 + 6] += c0 * bflo(v0[c].w) + c1 * bflo(v1[c].w); acc[c * 8 + 7] += c0 * bfhi(v0[c].w) + c1 * bfhi(v1[c].w);
      }
    }
    float ss = 0.f;
#pragma unroll
    for (int e = 0; e < 32; ++e) ss += acc[e] * acc[e];
    ss = wave_sum(ss);
    float rstd = rsqrtf(ss * (1.f / D) + EPS);
    const float* gfx = p.mod + (size_t)b * NMOD + 5 * D;
#pragma unroll
    for (int c = 0; c < 4; ++c) {
      int e0 = c * 512 + lane * 8;
      float* o = p.out + (size_t)t * D + e0;
      float4 x0 = *reinterpret_cast<const float4*>(o), x1v = *reinterpret_cast<const float4*>(o + 4);
      float4 gA = *reinterpret_cast<const float4*>(gfx + e0), gB = *reinterpret_cast<const float4*>(gfx + e0 + 4);
      float4 pA = *reinterpret_cast<const float4*>(p.g_post_ffn + e0), pB = *reinterpret_cast<const float4*>(p.g_post_ffn + e0 + 4);
      x0.x += gA.x * acc[c * 8 + 0] * rstd * pA.x; x0.y += gA.y * acc[c * 8 + 1] * rstd * pA.y;
      x0.z += gA.z * acc[c * 8 + 2] * rstd * pA.z; x0.w += gA.w * acc[c * 8 + 3] * rstd * pA.w;
      x1v.x += gB.x * acc[c * 8 + 4] * rstd * pB.x; x1v.y += gB.y * acc[c * 8 + 5] * rstd * pB.y;
      x1v.z += gB.z * acc[c * 8 + 6] * rstd * pB.z; x1v.w += gB.w * acc[c * 8 + 7] * rstd * pB.w;
      *reinterpret_cast<float4*>(o) = x0; *reinterpret_cast<float4*>(o + 4) = x1v;
    }
  }
}


__global__ void __launch_bounds__(NTHREADS, 2) fwd_mega(Params p) {
  __shared__ __attribute__((aligned(16))) char smem[75808];
  cg::grid_group grid = cg::this_grid();
  const int bid = blockIdx.x, nb = gridDim.x;
  phase_prep(p, bid, nb, smem);        grid.sync();
  phase_fold(p, bid, nb, smem);        grid.sync();
  phase_norm_mod(p, bid, nb, smem);    grid.sync();
  phase_inproj(p, bid, nb, smem);      grid.sync();
  phase_ssm_pre(p, bid, nb, smem);     grid.sync();
  phase_ssd_dft(p, bid, nb, smem);     grid.sync();
  phase_ssm_post(p, bid, nb, smem);    grid.sync();
  phase_outproj(p, bid, nb, smem);     grid.sync();
  phase_postmix(p, bid, nb, smem);     grid.sync();
  phase_qgemm(p, bid, nb, smem);       grid.sync();
  phase_route(p, bid, nb, smem);       grid.sync();
  phase_experts(p, bid, nb);
}

}

extern "C" void kernel_launch(void* const* d_in, const int* in_sizes, int n_in, void* d_out, int out_size, void* d_ws,
                              size_t ws_size, hipStream_t stream) {
  Params p{};
  const float** fp = reinterpret_cast<const float**>(&p);
  for (int i = 0; i < 27; ++i) fp[i] = (const float*)d_in[i];
  p.out = (float*)d_out;
  char* ws = (char*)d_ws;
  size_t off = 0;
  auto take = [&](size_t bytes) { char* r = ws + off; off += (bytes + 255) & ~(size_t)255; return r; };
  p.Ubf = (bf16_t*)take((size_t)16384 * D * 2);
  p.Vbf = (bf16_t*)take((size_t)16384 * D * 2);
  p.w_in_t = (bf16_t*)take((size_t)NPROJ * D * 2);
  p.w_out_t = (bf16_t*)take((size_t)D * D * 2);
  p.w_q_t = (bf16_t*)take((size_t)1024 * D * 2);
  p.w_in_f = (bf16_t*)take((size_t)D * 1024 * 2);
  p.WcsT = (bf16_t*)take((size_t)4 * 512 * 256 * 2);
  p.dftm = (bf16_t*)take((size_t)2048 * 4096 * 2);
  p.partial = (float*)take((size_t)KSPLIT * 5 * NMOD * 4);
  p.mod = (float*)take((size_t)5 * NMOD * 4);
  p.hx = (bf16_t*)take((size_t)T * D * 2);
  p.hc = (bf16_t*)take((size_t)TC * D * 2);
  p.ABt = (bf16_t*)take((size_t)NB * 1024 * 4096 * 2);
  p.q = (float*)p.ABt;
  p.z = (bf16_t*)take((size_t)T * 1024 * 2);
  char* r1 = take(0);
  p.xbcraw = (float*)take((size_t)T * DXBC * 4);
  p.xbcraw_c = (float*)take((size_t)TC * DXBC * 4);
  p.act_tm = (bf16_t*)take((size_t)(T + TC) * DXBC * 2);
  p.act_cm_x = (bf16_t*)take((size_t)NB * 1280 * L * 2);
  p.act_cm_c = (bf16_t*)take((size_t)NB * 1280 * CTX * 2);
  p.y_x = (float*)r1;
  p.dtraw = (float*)take((size_t)T * 32 * 4);
  p.dtraw_c = (float*)take((size_t)TC * 32 * 4);
  p.dtf = (float*)take((size_t)T * 16 * 4);
  p.dtb = (float*)take((size_t)T * 16 * 4);
  p.dtf_c = (float*)take((size_t)TC * 16 * 4);
  p.dtb_c = (float*)take((size_t)TC * 16 * 4);
  p.yf = (float*)take((size_t)T * 1024 * 4);
  p.yb = (float*)take((size_t)T * 1024 * 4);
  p.ctr = (unsigned*)take(256);
  p.ycat = (bf16_t*)take((size_t)T * D * 2);
  p.idx = (int*)take((size_t)T * 128 * 4);
  p.gate = (float*)take((size_t)T * 128 * 4);
  if (off > ws_size) { fprintf(stderr, "kernel_launch: workspace too small: need %zu have %zu\n", off, ws_size); return; }
  static int grid_blocks = 0;
  if (!grid_blocks) {
    int dev = 0, cus = 0, per_cu = 0;
    hipGetDevice(&dev);
    hipDeviceGetAttribute(&cus, hipDeviceAttributeMultiprocessorCount, dev);
    hipOccupancyMaxActiveBlocksPerMultiprocessor(&per_cu, fwd_mega, NTHREADS, 0);
    if (per_cu > 2) per_cu = 2;
    grid_blocks = cus * per_cu;
    if (grid_blocks <= 0) { fprintf(stderr, "kernel_launch: occupancy query gave %d x %d\n", cus, per_cu); grid_blocks = -1; }
  }
  if (grid_blocks < 0) return;
  void* args[] = {&p};
  hipError_t e = hipLaunchCooperativeKernel((void*)fwd_mega, dim3(grid_blocks), dim3(NTHREADS), args, 0, stream);
  if (e != hipSuccess) fprintf(stderr, "cooperative launch failed: %s (grid %d)\n", hipGetErrorString(e), grid_blocks);
}
```

```cpp
#include <hip/hip_runtime.h>
#include <hip/hip_cooperative_groups.h>
#include <stdint.h>
#include <stdio.h>

namespace cg = cooperative_groups;
namespace {

typedef __attribute__((ext_vector_type(8))) short bf16x8;
typedef __attribute__((ext_vector_type(4))) float f32x4;
typedef unsigned short bf16_t;

constexpr int D = 2048, NB = 4, L = 2048, T = NB * L, CTX = 256, TC = NB * CTX;
constexpr int NMOD = 6 * D;
constexpr int NH = 16, HP = 64, NS = 128, DXBC = 1536;
constexpr int DIN = 3616;
constexpr int NPROJ = 4736;
constexpr int KSPLIT = 32;
constexpr float EPS = 1e-6f;
constexpr int NTHREADS = 256;

__device__ __forceinline__ bf16_t f2bf(float f) {
  uint32_t u = __float_as_uint(f);
  u += 0x7fffu + ((u >> 16) & 1u);
  return (bf16_t)(u >> 16);
}
__device__ __forceinline__ float bf2f(bf16_t h) { return __uint_as_float(((uint32_t)h) << 16); }
__device__ __forceinline__ uint32_t pack2(float a, float b) { return (uint32_t)f2bf(a) | ((uint32_t)f2bf(b) << 16); }
__device__ __forceinline__ float bflo(uint32_t w) { return __uint_as_float(w << 16); }
__device__ __forceinline__ float bfhi(uint32_t w) { return __uint_as_float(w & 0xffff0000u); }
__device__ __forceinline__ float silu_f(float v) { return v / (1.f + __expf(-v)); }
__device__ __forceinline__ float softplus_f(float v) { return v > 20.f ? v : log1pf(__expf(v)); }

__device__ __forceinline__ float wave_sum(float v) {
#pragma unroll
  for (int o = 32; o > 0; o >>= 1) v += __shfl_xor(v, o);
  return v;
}
__device__ __forceinline__ float wave_max(float v) {
#pragma unroll
  for (int o = 32; o > 0; o >>= 1) v = fmaxf(v, __shfl_xor(v, o));
  return v;
}
__device__ __forceinline__ float block_sum(float v, float* red) {
  v = wave_sum(v);
  __syncthreads();
  if ((threadIdx.x & 63) == 0) red[threadIdx.x >> 6] = v;
  __syncthreads();
  return red[0] + red[1] + red[2] + red[3];
}

struct Params {
  const float *x, *c, *ctx, *c_ctx, *w_mod, *b_mod, *g_pre_mix, *g_post_mix, *g_pre_ffn, *g_post_ffn;
  const float *w_in, *w_fmix, *conv_w, *conv_b, *dt_bias_f, *dt_bias_b, *a_log_f, *a_log_b, *d_skip_f, *d_skip_b;
  const float *ssm_norm_w, *w_out, *w_query, *sk1, *sk2, *eu, *ev;
  float* out;
  bf16_t *Ubf, *Vbf, *w_in_t, *w_out_t, *w_q_t, *w_in_f, *WcsT, *dftm;
  float *partial, *mod;
  bf16_t *hx, *hc, *ABt, *z;
  float *xbcraw, *xbcraw_c, *dtraw, *dtraw_c, *dtf, *dtb, *dtf_c, *dtb_c;
  bf16_t *act_tm, *act_cm_x, *act_cm_c;
  float *yf, *yb;
  unsigned* ctr; unsigned* bar;
  bf16_t* ycat;
  float *y_x, *q, *gate;
  int* idx;
  int pad0, pad1;
};

__device__ __forceinline__ void gemm_mainloop(const bf16_t* __restrict__ A, int lda, const bf16_t* __restrict__ Bt, int ldb,
                                              int K, int m0, int n0, f32x4 (&acc)[4][4], char* smem) {
  const int tid = threadIdx.x, lane = tid & 63, w = tid >> 6;
  const int wm = w >> 1, wn = w & 1;
#pragma unroll
  for (int i = 0; i < 4; ++i)
#pragma unroll
    for (int j = 0; j < 4; ++j) acc[i][j] = f32x4{0.f, 0.f, 0.f, 0.f};

  uint4 ra0, ra1, ra2, ra3, rb0, rb1, rb2, rb3;
  const int nk = K / 64;
  const int lrow = tid >> 3, lch = tid & 7;
  const bf16_t* gA = A + (size_t)(m0 + lrow) * lda + lch * 8;
  const bf16_t* gB = Bt + (size_t)(n0 + lrow) * ldb + lch * 8;
  const int soff = lrow * 128 + ((lch ^ (lrow & 7)) << 4);
#define GLOAD(kt_)                                                                  \
  do {                                                                              \
    ra0 = *reinterpret_cast<const uint4*>(gA + (kt_) * 64);                         \
    ra1 = *reinterpret_cast<const uint4*>(gA + (size_t)32 * lda + (kt_) * 64);      \
    ra2 = *reinterpret_cast<const uint4*>(gA + (size_t)64 * lda + (kt_) * 64);      \
    ra3 = *reinterpret_cast<const uint4*>(gA + (size_t)96 * lda + (kt_) * 64);      \
    rb0 = *reinterpret_cast<const uint4*>(gB + (kt_) * 64);                         \
    rb1 = *reinterpret_cast<const uint4*>(gB + (size_t)32 * ldb + (kt_) * 64);      \
    rb2 = *reinterpret_cast<const uint4*>(gB + (size_t)64 * ldb + (kt_) * 64);      \
    rb3 = *reinterpret_cast<const uint4*>(gB + (size_t)96 * ldb + (kt_) * 64);      \
  } while (0)
  GLOAD(0);
  for (int kt = 0; kt < nk; ++kt) {
    char* sA = smem + (kt & 1) * 32768;
    char* sB = sA + 16384;
    *reinterpret_cast<uint4*>(sA + soff) = ra0;
    *reinterpret_cast<uint4*>(sA + soff + 4096) = ra1;
    *reinterpret_cast<uint4*>(sA + soff + 8192) = ra2;
    *reinterpret_cast<uint4*>(sA + soff + 12288) = ra3;
    *reinterpret_cast<uint4*>(sB + soff) = rb0;
    *reinterpret_cast<uint4*>(sB + soff + 4096) = rb1;
    *reinterpret_cast<uint4*>(sB + soff + 8192) = rb2;
    *reinterpret_cast<uint4*>(sB + soff + 12288) = rb3;
    __syncthreads();
    if (kt + 1 < nk) GLOAD(kt + 1);
#pragma unroll
    for (int kk = 0; kk < 2; ++kk) {
      bf16x8 af[4], bfr[4];
      const int ch = kk * 4 + (lane >> 4);
#pragma unroll
      for (int i = 0; i < 4; ++i) {
        int row = wm * 64 + i * 16 + (lane & 15);
        af[i] = *reinterpret_cast<const bf16x8*>(sA + row * 128 + ((ch ^ (row & 7)) << 4));
        int col = wn * 64 + i * 16 + (lane & 15);
        bfr[i] = *reinterpret_cast<const bf16x8*>(sB + col * 128 + ((ch ^ (col & 7)) << 4));
      }
#pragma unroll
      for (int i = 0; i < 4; ++i)
#pragma unroll
        for (int j = 0; j < 4; ++j) acc[i][j] = __builtin_amdgcn_mfma_f32_16x16x32_bf16(af[i], bfr[j], acc[i][j], 0, 0, 0);
    }
  }
#undef GLOAD
  __syncthreads();
}
template <class Epi>
__device__ __forceinline__ void gemm_tile(const bf16_t* __restrict__ A, int lda, const bf16_t* __restrict__ Bt, int ldb,
                                          int K, int m0, int n0, const Epi& epi, char* smem) {
  const int lane = threadIdx.x & 63, w = threadIdx.x >> 6;
  const int wm = w >> 1, wn = w & 1;
  f32x4 acc[4][4];
  gemm_mainloop(A, lda, Bt, ldb, K, m0, n0, acc, smem);
#pragma unroll
  for (int i = 0; i < 4; ++i)
#pragma unroll
    for (int j = 0; j < 4; ++j) {
      int row = m0 + wm * 64 + i * 16 + (lane >> 4) * 4;
      int col = n0 + wn * 64 + j * 16 + (lane & 15);
      epi(row, col, acc[i][j]);
    }
}

struct EpiF32 {
  float* C; int ldc;
  __device__ __forceinline__ void operator()(int row, int col, f32x4 v) const {
#pragma unroll
    for (int r = 0; r < 4; ++r) C[(size_t)(row + r) * ldc + col] = v[r];
  }
};
struct EpiBf16 {
  bf16_t* C; int ldc;
  __device__ __forceinline__ void operator()(int row, int col, f32x4 v) const {
#pragma unroll
    for (int r = 0; r < 4; ++r) C[(size_t)(row + r) * ldc + col] = f2bf(v[r]);
  }
};
struct EpiBf16T {
  bf16_t* Ct; int ldc;
  __device__ __forceinline__ void operator()(int row, int col, f32x4 v) const {
    uint2 pk; pk.x = pack2(v[0], v[1]); pk.y = pack2(v[2], v[3]);
    *reinterpret_cast<uint2*>(Ct + (size_t)col * ldc + row) = pk;
  }
};
struct EpiInProj {
  bf16_t* ABt; bf16_t* z; float* xbcraw; float* dtraw; int seqlen;
  __device__ __forceinline__ void operator()(int row, int col, f32x4 v) const {
    if (col < 2048) {
      int ch = col & 1023, half = col >> 10;
      int b = row / seqlen, l = row - b * seqlen;
      uint2 pk; pk.x = pack2(v[0], v[1]); pk.y = pack2(v[2], v[3]);
      *reinterpret_cast<uint2*>(ABt + ((size_t)(b * 1024 + ch) * 4096 + half * 2048 + l)) = pk;
    } else if (col < 3072) {
#pragma unroll
      for (int r = 0; r < 4; ++r) z[(size_t)(row + r) * 1024 + (col - 2048)] = f2bf(v[r]);
    } else if (col < 4608) {
#pragma unroll
      for (int r = 0; r < 4; ++r) xbcraw[(size_t)(row + r) * DXBC + (col - 3072)] = v[r];
    } else if (col < 4640) {
#pragma unroll
      for (int r = 0; r < 4; ++r) dtraw[(size_t)(row + r) * 32 + (col - 4608)] = v[r];
    }
  }
};

__device__ void adaln_partial_task(const Params& p, int task, float* sm) {
  const int cb = task % 48, ks = task / 48, tid = threadIdx.x;
  float* sc = sm;
  __syncthreads();
  for (int i = tid; i < 5 * 64; i += NTHREADS) {
    int r = i >> 6, kk = i & 63;
    int k = ks * 64 + kk;
    float cv = (r < 4) ? p.c[r * D + k] : p.c_ctx[k];
    sc[i] = silu_f(cv);
  }
  __syncthreads();
  const int col = cb * 256 + tid;
  float a0 = 0, a1 = 0, a2 = 0, a3 = 0, a4 = 0;
  const float* wp = p.w_mod + (size_t)(ks * 64) * NMOD + col;
#pragma unroll 8
  for (int kk = 0; kk < 64; ++kk) {
    float wv = wp[(size_t)kk * NMOD];
    a0 += sc[kk] * wv; a1 += sc[64 + kk] * wv; a2 += sc[128 + kk] * wv; a3 += sc[192 + kk] * wv; a4 += sc[256 + kk] * wv;
  }
  float* pp = p.partial + (size_t)ks * 5 * NMOD + col;
  pp[0] = a0; pp[NMOD] = a1; pp[2 * NMOD] = a2; pp[3 * NMOD] = a3; pp[4 * NMOD] = a4;
}

__device__ void transpose_convert_task(const float* __restrict__ src, int ld, int c0, int rows, bf16_t* __restrict__ dst,
                                       int tr, int tc, float* sm) {
  float (*tile)[65] = reinterpret_cast<float (*)[65]>(sm);
  const int tid = threadIdx.x;
  __syncthreads();
  for (int i = tid; i < 64 * 64; i += NTHREADS) {
    int r = i >> 6, cc = i & 63;
    tile[r][cc] = src[(size_t)(tr * 64 + r) * ld + c0 + tc * 64 + cc];
  }
  __syncthreads();
  for (int i = tid; i < 64 * 32; i += NTHREADS) {
    int cc = i >> 5, r2 = (i & 31) * 2;
    uint32_t pk = pack2(tile[r2][cc], tile[r2 + 1][cc]);
    *reinterpret_cast<uint32_t*>(dst + (size_t)(tc * 64 + cc) * rows + tr * 64 + r2) = pk;
  }
}

__device__ void phase_prep(const Params& p, int bid, int nb, char* smem) {
  float* sm = reinterpret_cast<float*>(smem);
  const int tid = threadIdx.x;
  if (bid == 0 && tid == 0) p.ctr[0] = 0u;
  for (int t = bid; t < 48 * KSPLIT; t += nb) adaln_partial_task(p, t, sm);
  {
    const size_t n8 = (size_t)16384 * D / 8;
    for (size_t i = (size_t)bid * NTHREADS + tid; i < 2 * n8; i += (size_t)nb * NTHREADS) {
      const float* s = (i < n8) ? p.eu : p.ev;
      bf16_t* d = (i < n8) ? p.Ubf : p.Vbf;
      size_t j = (i < n8) ? i : i - n8;
      float4 v0 = *reinterpret_cast<const float4*>(s + j * 8);
      float4 v1 = *reinterpret_cast<const float4*>(s + j * 8 + 4);
      uint4 o; o.x = pack2(v0.x, v0.y); o.y = pack2(v0.z, v0.w); o.z = pack2(v1.x, v1.y); o.w = pack2(v1.z, v1.w);
      *reinterpret_cast<uint4*>(d + j * 8) = o;
    }
  }
  {
    const int nct = 41, nrt = 32;
    for (int t = bid; t < nct * nrt; t += nb) {
      int tc = t % nct, tr = t / nct;
      if (tc < 40) transpose_convert_task(p.w_in, DIN, 1024, D, p.w_in_t + (size_t)2048 * D, tr, tc, sm);
      else {
        float (*tile)[65] = reinterpret_cast<float (*)[65]>(sm);
        __syncthreads();
        for (int i = tid; i < 64 * 32; i += NTHREADS) {
          int r = i >> 5, cc = i & 31;
          tile[r][cc] = p.w_in[(size_t)(tr * 64 + r) * DIN + 1024 + 2560 + cc];
        }
        __syncthreads();
        for (int i = tid; i < 32 * 32; i += NTHREADS) {
          int cc = i >> 5, r2 = (i & 31) * 2;
          uint32_t pk = pack2(tile[r2][cc], tile[r2 + 1][cc]);
          *reinterpret_cast<uint32_t*>(p.w_in_t + (size_t)(2048 + 2560 + cc) * D + tr * 64 + r2) = pk;
        }
      }
    }
    for (int t = bid; t < 32 * 32; t += nb) transpose_convert_task(p.w_out, D, 0, D, p.w_out_t, t / 32, t % 32, sm);
    for (int t = bid; t < 16 * 32; t += nb) transpose_convert_task(p.w_query, 1024, 0, D, p.w_q_t, t / 16, t % 16, sm);
    for (size_t i = (size_t)bid * NTHREADS + tid; i < (size_t)96 * D / 8; i += (size_t)nb * NTHREADS)
      reinterpret_cast<uint4*>(p.w_in_t + (size_t)4640 * D)[i] = uint4{0, 0, 0, 0};
  }
  for (size_t i = (size_t)bid * NTHREADS + tid; i < (size_t)D * 1024 / 4; i += (size_t)nb * NTHREADS) {
    int k = (int)(i / 256), c4 = (int)(i % 256) * 4;
    float4 v = *reinterpret_cast<const float4*>(p.w_in + (size_t)k * DIN + c4);
    uint2 o; o.x = pack2(v.x, v.y); o.y = pack2(v.z, v.w);
    *reinterpret_cast<uint2*>(p.w_in_f + (size_t)k * 1024 + c4) = o;
  }
  {
    const float scale = 1.0f / sqrtf((float)L * 256.f);
    for (int i = bid * NTHREADS + tid; i < 4 * 256 * 256; i += nb * NTHREADS) {
      int d = i & 255, c = (i >> 8) & 255, g = i >> 16;
      float sc_ = 0.f, ss_ = 0.f;
      for (int m = 0; m < 256; ++m) {
        int ph = (m * c) & 255;
        float sv, cv;
        sincospif((float)ph * (1.0f / 128.f), &sv, &cv);
        float wv = p.w_fmix[((size_t)g * 256 + m) * 256 + d];
        sc_ += cv * wv; ss_ += sv * wv;
      }
      p.WcsT[((size_t)g * 512 + d) * 256 + c] = f2bf(sc_ * scale);
      p.WcsT[((size_t)g * 512 + 256 + d) * 256 + c] = f2bf(ss_ * scale);
    }
  }
  for (size_t i = (size_t)bid * NTHREADS + tid; i < (size_t)2048 * 4096 / 2; i += (size_t)nb * NTHREADS) {
    int k = (int)(i / 2048), j = (int)(i % 2048) * 2;
    float o[2];
#pragma unroll
    for (int e = 0; e < 2; ++e) {
      int jj = j + e;
      int l = jj & 2047;
      int ph = (k * l) & 2047;
      float sv, cv;
      sincospif((float)ph * (1.0f / 1024.f), &sv, &cv);
      o[e] = (jj < 2048) ? cv : -sv;
    }
    *reinterpret_cast<uint32_t*>(p.dftm + (size_t)k * 4096 + j) = pack2(o[0], o[1]);
  }
}

__device__ void phase_fold(const Params& p, int bid, int nb, char* smem) {
  const int tid = threadIdx.x;
  for (int i = bid * NTHREADS + tid; i < 5 * NMOD; i += nb * NTHREADS) {
    int col = i % NMOD;
    float s = p.b_mod[col];
    for (int ks = 0; ks < KSPLIT; ++ks) s += p.partial[(size_t)ks * 5 * NMOD + i];
    p.mod[i] = s;
  }
  for (int t = bid; t < 256; t += nb) {
    int g = t >> 6, tm = (t & 63) >> 2, tn = t & 3;
    int n0 = tn * 128;
    int rowbase = (n0 < 256) ? (g * 256 + n0) : (1024 + g * 256 + (n0 - 256));
    EpiBf16T epi{p.w_in_t + (size_t)(rowbase - n0) * D, D};
    gemm_tile(p.w_in_f + g * 256, 1024, p.WcsT + (size_t)g * 512 * 256, 256, 256, tm * 128, n0, epi, smem);
  }
}

__device__ void phase_norm_mod(const Params& p, int bid, int nb, char* smem) {
  float* red = reinterpret_cast<float*>(smem);
  const int tid = threadIdx.x;
  for (int t = bid; t < T + TC; t += nb) {
    const bool isx = t < T;
    const float* src = isx ? (p.x + (size_t)t * D) : (p.ctx + (size_t)(t - T) * D);
    const int mrow = isx ? (t / L) : 4;
    bf16_t* dst = isx ? (p.hx + (size_t)t * D) : (p.hc + (size_t)(t - T) * D);
    float4 v0 = *reinterpret_cast<const float4*>(src + tid * 8);
    float4 v1 = *reinterpret_cast<const float4*>(src + tid * 8 + 4);
    float ss = v0.x * v0.x + v0.y * v0.y + v0.z * v0.z + v0.w * v0.w + v1.x * v1.x + v1.y * v1.y + v1.z * v1.z + v1.w * v1.w;
    ss = block_sum(ss, red);
    float rstd = rsqrtf(ss * (1.f / D) + EPS);
    const float* sh = p.mod + (size_t)mrow * NMOD + 0 * D + tid * 8;
    const float* sc = p.mod + (size_t)mrow * NMOD + 1 * D + tid * 8;
    const float* g = p.g_pre_mix + tid * 8;
    float vv[8] = {v0.x, v0.y, v0.z, v0.w, v1.x, v1.y, v1.z, v1.w};
    float o[8];
#pragma unroll
    for (int e = 0; e < 8; ++e) o[e] = vv[e] * rstd * g[e] * (1.f + sc[e]) + sh[e];
    uint4 pk; pk.x = pack2(o[0], o[1]); pk.y = pack2(o[2], o[3]); pk.z = pack2(o[4], o[5]); pk.w = pack2(o[6], o[7]);
    *reinterpret_cast<uint4*>(dst + tid * 8) = pk;
  }
}

__device__ void phase_inproj(const Params& p, int bid, int nb, char* smem) {
  const int ntx = 64 * 37, ntc = 8 * 13;
  for (int t = bid; t < ntx + ntc; t += nb) {
    if (t < ntx) {
      int tm = t / 37, tn = t % 37;
      EpiInProj epi{p.ABt, p.z, p.xbcraw, p.dtraw, L};
      gemm_tile(p.hx, D, p.w_in_t, D, D, tm * 128, tn * 128, epi, smem);
    } else {
      int u = t - ntx;
      int tm = u / 13, tn = u % 13;
      EpiInProj epi{nullptr, nullptr, p.xbcraw_c, p.dtraw_c, CTX};
      gemm_tile(p.hc, D, p.w_in_t, D, D, tm * 128, 3072 + tn * 128, epi, smem);
    }
  }
}

__device__ void ssm_pre_tile(const Params& p, int task, char* smem) {
  const bool isx = task < 3072;
  const int u = isx ? task : task - 3072;
  const int ntt = isx ? 32 : 4;
  const int ct = u % 24, tt = (u / 24) % ntt, b = u / (24 * ntt);
  const int seqlen = isx ? L : CTX;
  const float* raw = (isx ? p.xbcraw : p.xbcraw_c) + (size_t)b * seqlen * DXBC;
  const int l0 = tt * 64, c0 = ct * 64, tid = threadIdx.x;
  float (*rt)[65] = reinterpret_cast<float (*)[65]>(smem);
  float (*at)[65] = reinterpret_cast<float (*)[65]>(smem + 66 * 65 * 4);
  __syncthreads();
  for (int i = tid; i < 66 * 64; i += NTHREADS) {
    int r = i >> 6, cc = i & 63, l = l0 - 1 + r;
    rt[r][cc] = (l >= 0 && l < seqlen) ? raw[(size_t)l * DXBC + c0 + cc] : 0.f;
  }
  __syncthreads();
  for (int i = tid; i < 64 * 64; i += NTHREADS) {
    int r = i >> 6, cc = i & 63, c = c0 + cc;
    float acc = p.conv_b[c] + rt[r][cc] * p.conv_w[c] + rt[r + 1][cc] * p.conv_w[DXBC + c] + rt[r + 2][cc] * p.conv_w[2 * DXBC + c];
    at[r][cc] = silu_f(acc);
  }
  __syncthreads();
  const size_t trow0 = isx ? ((size_t)b * L + l0) : ((size_t)T + (size_t)b * CTX + l0);
  for (int i = tid; i < 64 * 32; i += NTHREADS) {
    int r = i >> 5, c2 = (i & 31) * 2;
    *reinterpret_cast<uint32_t*>(p.act_tm + (trow0 + r) * DXBC + c0 + c2) = pack2(at[r][c2], at[r][c2 + 1]);
  }
  if (c0 < 1280) {
    bf16_t* cm = (isx ? p.act_cm_x : p.act_cm_c) + (size_t)b * 1280 * seqlen;
    for (int i = tid; i < 64 * 32; i += NTHREADS) {
      int cc = i >> 5, r2 = (i & 31) * 2;
      *reinterpret_cast<uint32_t*>(cm + (size_t)(c0 + cc) * seqlen + l0 + r2) = pack2(at[r2][cc], at[r2 + 1][cc]);
    }
  }
}
__device__ void phase_ssm_pre(const Params& p, int bid, int nb, char* smem) {
  const int tid = threadIdx.x;
  for (int t = bid; t < 3072 + 384; t += nb) ssm_pre_tile(p, t, smem);
  for (int i = bid * NTHREADS + tid; i < (T + TC) * 32; i += nb * NTHREADS) {
    const bool isx = i < T * 32;
    const int ii = isx ? i : i - T * 32;
    const int t = ii >> 5, j = ii & 31;
    const float v = (isx ? p.dtraw : p.dtraw_c)[ii];
    float* df = isx ? p.dtf : p.dtf_c;
    float* db = isx ? p.dtb : p.dtb_c;
    if (j < 16) df[t * 16 + j] = softplus_f(v + p.dt_bias_f[j]);
    else db[t * 16 + (j - 16)] = softplus_f(v + p.dt_bias_b[j - 16]);
  }
}

__device__ __forceinline__ int swz16(int row, int chunk) { return row * 256 + ((chunk ^ (row & 15)) << 4); }
__device__ __forceinline__ int swz8(int row, int chunk) { return row * 128 + ((chunk ^ (row & 7)) << 4); }

__device__ void ssd_task(const Params& p, int task, char* smem) {
  const int dir = task & 1, h = (task >> 1) & 15, b = task >> 5;
  const int tid = threadIdx.x, lane = tid & 63, w = tid >> 6;
  const int g = h >> 3, lr0 = lane & 15, lq0 = lane >> 4;
  const float a = -__expf(dir ? p.a_log_b[h] : p.a_log_f[h]);
  char* sCc = smem; char* sBc = smem + 16384; char* sBT = smem + 32768; char* sXT = smem + 49152; char* sHb = smem + 57344;
  float* se = reinterpret_cast<float*>(smem + 73728);
  float* sdt = se + 64; float* sw = se + 128; float* sy = se + 192; float* stot = se + 256;
  float* yo = dir ? p.yb : p.yf;
  f32x4 H[8];
#pragma unroll
  for (int j = 0; j < 8; ++j) H[j] = f32x4{0.f, 0.f, 0.f, 0.f};
  __syncthreads();
  for (int i = tid; i < 1024; i += NTHREADS) reinterpret_cast<uint4*>(sHb)[i] = uint4{0, 0, 0, 0};
  for (int step = 0; step < 36; ++step) {
    const bool isctx = step < 4;
    const int nch = isctx ? 4 : 32, ci = isctx ? step : step - 4;
    const int c = dir ? (nch - 1 - ci) : ci;
    const int seqlen = isctx ? CTX : L;
    const size_t trow0 = isctx ? ((size_t)T + (size_t)b * CTX + c * 64) : ((size_t)b * L + c * 64);
    const size_t drow0 = (size_t)b * seqlen + c * 64;
    const float* dtp = isctx ? (dir ? p.dtb_c : p.dtf_c) : (dir ? p.dtb : p.dtf);
    const bf16_t* cm = (isctx ? p.act_cm_c : p.act_cm_x) + (size_t)b * 1280 * seqlen + c * 64;
    int lr = lr0, lq = lq0;
    asm volatile("" : "+v"(lr), "+v"(lq));
    __syncthreads();
    if (w == 0) {
      const float dtv = dtp[(drow0 + lane) * 16 + h];
      float v = a * dtv;
      if (!dir) {
#pragma unroll
        for (int o = 1; o < 64; o <<= 1) { float n = __shfl_up(v, o); v += (lane >= o) ? n : 0.f; }
      } else {
#pragma unroll
        for (int o = 1; o < 64; o <<= 1) { float n = __shfl_down(v, o); v += (lane + o < 64) ? n : 0.f; }
      }
      const float etot = __shfl(v, dir ? 0 : 63);
      se[lane] = v; sdt[lane] = dtv; sw[lane] = dtv * __expf(etot - v); sy[lane] = __expf(v);
      if (lane == 0) stot[0] = etot;
    }
    if (!isctx) {
#pragma unroll
      for (int r = 0; r < 4; ++r) {
        const int id = tid + 256 * r, row = id >> 4, ch = id & 15;
        const bf16_t* src = p.act_tm + (trow0 + row) * DXBC + g * 128 + ch * 8;
        *reinterpret_cast<uint4*>(sCc + swz16(row, ch)) = *reinterpret_cast<const uint4*>(src + 1280);
        *reinterpret_cast<uint4*>(sBc + swz16(row, ch)) = *reinterpret_cast<const uint4*>(src + 1024);
      }
    }
#pragma unroll
    for (int r = 0; r < 4; ++r) {
      const int id = tid + 256 * r, row = id >> 3, ch = id & 7;
      *reinterpret_cast<uint4*>(sBT + swz8(row, ch)) = *reinterpret_cast<const uint4*>(cm + (size_t)(1024 + g * 128 + row) * seqlen + ch * 8);
    }
#pragma unroll
    for (int r = 0; r < 2; ++r) {
      const int id = tid + 256 * r, row = id >> 3, ch = id & 7;
      *reinterpret_cast<uint4*>(sXT + swz8(row, ch)) = *reinterpret_cast<const uint4*>(cm + (size_t)(h * 64 + row) * seqlen + ch * 8);
    }
    __syncthreads();
    const float etot = stot[0];
    if (!isctx) {
      f32x4 G[4];
      bf16x8 ca[4];
#pragma unroll
      for (int j = 0; j < 4; ++j) G[j] = f32x4{0.f, 0.f, 0.f, 0.f};
#pragma unroll
      for (int kk = 0; kk < 4; ++kk) ca[kk] = *reinterpret_cast<const bf16x8*>(sCc + swz16(16 * w + lr, kk * 4 + lq));
#pragma unroll
      for (int kk = 0; kk < 4; ++kk)
#pragma unroll
        for (int j = 0; j < 4; ++j) {
          bf16x8 bb = *reinterpret_cast<const bf16x8*>(sBc + swz16(16 * j + lr, kk * 4 + lq));
          G[j] = __builtin_amdgcn_mfma_f32_16x16x32_bf16(ca[kk], bb, G[j], 0, 0, 0);
        }
      __syncthreads();
      float el[4];
#pragma unroll
      for (int r = 0; r < 4; ++r) el[r] = se[16 * w + lq * 4 + r];
#pragma unroll
      for (int j = 0; j < 4; ++j) {
        const int s_ = 16 * j + lr;
        const float es = se[s_], ds = sdt[s_];
#pragma unroll
        for (int r = 0; r < 4; ++r) {
          const int l = 16 * w + lq * 4 + r;
          const bool keep = dir ? (s_ >= l) : (s_ <= l);
          const float m = keep ? G[j][r] * __expf(el[r] - es) * ds : 0.f;
          *reinterpret_cast<bf16_t*>(sBc + swz8(l, s_ >> 3) + (s_ & 7) * 2) = f2bf(m);
        }
      }
      __syncthreads();
      f32x4 Y[4], Yo[4];
#pragma unroll
      for (int j = 0; j < 4; ++j) { Y[j] = f32x4{0.f, 0.f, 0.f, 0.f}; Yo[j] = f32x4{0.f, 0.f, 0.f, 0.f}; }
#pragma unroll
      for (int kk = 0; kk < 2; ++kk) {
        bf16x8 ma = *reinterpret_cast<const bf16x8*>(sBc + swz8(16 * w + lr, kk * 4 + lq));
#pragma unroll
        for (int j = 0; j < 4; ++j) {
          bf16x8 xb = *reinterpret_cast<const bf16x8*>(sXT + swz8(16 * j + lr, kk * 4 + lq));
          Y[j] = __builtin_amdgcn_mfma_f32_16x16x32_bf16(ma, xb, Y[j], 0, 0, 0);
        }
      }
#pragma unroll
      for (int kk = 0; kk < 4; ++kk)
#pragma unroll
        for (int j = 0; j < 4; ++j) {
          bf16x8 hb = *reinterpret_cast<const bf16x8*>(sHb + swz16(16 * j + lr, kk * 4 + lq));
          Yo[j] = __builtin_amdgcn_mfma_f32_16x16x32_bf16(ca[kk], hb, Yo[j], 0, 0, 0);
        }
      float syl[4];
#pragma unroll
      for (int r = 0; r < 4; ++r) syl[r] = sy[16 * w + lq * 4 + r];
#pragma unroll
      for (int j = 0; j < 4; ++j)
#pragma unroll
        for (int r = 0; r < 4; ++r) {
          const int l = 16 * w + lq * 4 + r;
          yo[(trow0 + l) * 1024 + h * 64 + 16 * j + lr] = Y[j][r] + syl[r] * Yo[j][r];
        }
    }
    {
      const float dec = __expf(etot);
#pragma unroll
      for (int j = 0; j < 8; ++j) H[j] *= dec;
#pragma unroll
      for (int kk = 0; kk < 2; ++kk) {
        bf16x8 xa = *reinterpret_cast<const bf16x8*>(sXT + swz8(16 * w + lr, kk * 4 + lq));
        const int s0 = kk * 32 + lq * 8;
        const float4 w0 = *reinterpret_cast<const float4*>(sw + s0), w1 = *reinterpret_cast<const float4*>(sw + s0 + 4);
        bf16x8 xs;
        xs[0] = (short)f2bf(bf2f((bf16_t)xa[0]) * w0.x); xs[1] = (short)f2bf(bf2f((bf16_t)xa[1]) * w0.y);
        xs[2] = (short)f2bf(bf2f((bf16_t)xa[2]) * w0.z); xs[3] = (short)f2bf(bf2f((bf16_t)xa[3]) * w0.w);
        xs[4] = (short)f2bf(bf2f((bf16_t)xa[4]) * w1.x); xs[5] = (short)f2bf(bf2f((bf16_t)xa[5]) * w1.y);
        xs[6] = (short)f2bf(bf2f((bf16_t)xa[6]) * w1.z); xs[7] = (short)f2bf(bf2f((bf16_t)xa[7]) * w1.w);
#pragma unroll
        for (int j = 0; j < 8; ++j) {
          bf16x8 bt = *reinterpret_cast<const bf16x8*>(sBT + swz8(16 * j + lr, kk * 4 + lq));
          H[j] = __builtin_amdgcn_mfma_f32_16x16x32_bf16(xs, bt, H[j], 0, 0, 0);
        }
      }
    }
    __syncthreads();
#pragma unroll
    for (int j = 0; j < 8; ++j) {
      const int n = 16 * j + lr;
#pragma unroll
      for (int r = 0; r < 4; ++r) {
        const int pr = 16 * w + lq * 4 + r;
        *reinterpret_cast<bf16_t*>(sHb + swz16(pr, n >> 3) + (n & 7) * 2) = f2bf(H[j][r]);
      }
    }
  }
}

__device__ void phase_ssd_dft(const Params& p, int bid, int nb, char* smem) {
  for (int t = bid; t < 128; t += nb) ssd_task(p, t, smem);
  int* stile = reinterpret_cast<int*>(smem + 75776);
  for (;;) {
    __syncthreads();
    if (threadIdx.x == 0) *stile = (int)atomicAdd(p.ctr, 1u);
    __syncthreads();
    const int t = *stile;
    if (t >= 4 * 16 * 8) break;
    int b = t >> 7, tm = (t & 127) >> 3, tn = t & 7;
    EpiBf16 epi{p.ycat + (size_t)b * L * D, D};
    gemm_tile(p.dftm, 4096, p.ABt + (size_t)b * 1024 * 4096, 4096, 4096, tm * 128, tn * 128, epi, smem);
  }
}

__device__ void phase_ssm_post(const Params& p, int bid, int nb, char* smem) {
  float* red = reinterpret_cast<float*>(smem);
  const int tid = threadIdx.x, w = tid >> 6;
  for (int t = bid; t < T; t += nb) {
    const int c0 = tid * 4;
    const int h = c0 >> 6;
    const float dsk = p.d_skip_f[h] + p.d_skip_b[h];
    float4 a = *reinterpret_cast<const float4*>(p.yf + (size_t)t * 1024 + c0);
    float4 bq = *reinterpret_cast<const float4*>(p.yb + (size_t)t * 1024 + c0);
    uint2 xq = *reinterpret_cast<const uint2*>(p.act_tm + (size_t)t * DXBC + c0);
    float xs[4] = {bflo(xq.x), bfhi(xq.x), bflo(xq.y), bfhi(xq.y)};
    uint2 zz = *reinterpret_cast<const uint2*>(p.z + (size_t)t * 1024 + c0);
    float zf[4] = {bflo(zz.x), bfhi(zz.x), bflo(zz.y), bfhi(zz.y)};
    float y[4] = {a.x + bq.x + dsk * xs[0], a.y + bq.y + dsk * xs[1], a.z + bq.z + dsk * xs[2], a.w + bq.w + dsk * xs[3]};
    float ss = 0.f;
#pragma unroll
    for (int e = 0; e < 4; ++e) { y[e] *= silu_f(zf[e]); ss += y[e] * y[e]; }
    ss = wave_sum(ss);
    __syncthreads();
    if ((tid & 63) == 0) red[w] = ss;
    __syncthreads();
    float gs = (w < 2) ? (red[0] + red[1]) : (red[2] + red[3]);
    float rstd = rsqrtf(gs * (1.f / 512.f) + EPS);
    float4 nw = *reinterpret_cast<const float4*>(p.ssm_norm_w + c0);
    uint2 o; o.x = pack2(y[0] * rstd * nw.x, y[1] * rstd * nw.y); o.y = pack2(y[2] * rstd * nw.z, y[3] * rstd * nw.w);
    *reinterpret_cast<uint2*>(p.ycat + (size_t)t * D + 1024 + c0) = o;
  }
}

__device__ void phase_outproj(const Params& p, int bid, int nb, char* smem) {
  for (int t = bid; t < 64 * 16; t += nb) {
    EpiF32 epi{p.y_x, D};
    gemm_tile(p.ycat, D, p.w_out_t, D, D, (t >> 4) * 128, (t & 15) * 128, epi, smem);
  }
}
__device__ void phase_postmix(const Params& p, int bid, int nb, char* smem) {
  float* red = reinterpret_cast<float*>(smem);
  const int tid = threadIdx.x;
  for (int t = bid; t < T; t += nb) {
    const int b = t / L;
    const float* yr = p.y_x + (size_t)t * D + tid * 8;
    const float* xr = p.x + (size_t)t * D + tid * 8;
    float y[8], xv[8];
    *reinterpret_cast<float4*>(y) = *reinterpret_cast<const float4*>(yr);
    *reinterpret_cast<float4*>(y + 4) = *reinterpret_cast<const float4*>(yr + 4);
    *reinterpret_cast<float4*>(xv) = *reinterpret_cast<const float4*>(xr);
    *reinterpret_cast<float4*>(xv + 4) = *reinterpret_cast<const float4*>(xr + 4);
    float ss = 0.f;
#pragma unroll
    for (int e = 0; e < 8; ++e) ss += y[e] * y[e];
    ss = block_sum(ss, red);
    float rstd = rsqrtf(ss * (1.f / D) + EPS);
    const float* gm = p.mod + (size_t)b * NMOD + 2 * D + tid * 8;
    const float* gp = p.g_post_mix + tid * 8;
    float x1[8]; float ss1 = 0.f;
#pragma unroll
    for (int e = 0; e < 8; ++e) { x1[e] = xv[e] + gm[e] * (y[e] * rstd * gp[e]); ss1 += x1[e] * x1[e]; }
    ss1 = block_sum(ss1, red);
    float rstd1 = rsqrtf(ss1 * (1.f / D) + EPS);
    float* o = p.out + (size_t)t * D + tid * 8;
    *reinterpret_cast<float4*>(o) = *reinterpret_cast<float4*>(x1);
    *reinterpret_cast<float4*>(o + 4) = *reinterpret_cast<float4*>(x1 + 4);
    const float* sf = p.mod + (size_t)b * NMOD + 3 * D + tid * 8;
    const float* cf = p.mod + (size_t)b * NMOD + 4 * D + tid * 8;
    const float* gf = p.g_pre_ffn + tid * 8;
    float h2[8];
#pragma unroll
    for (int e = 0; e < 8; ++e) h2[e] = x1[e] * rstd1 * gf[e] * (1.f + cf[e]) + sf[e];
    uint4 pk; pk.x = pack2(h2[0], h2[1]); pk.y = pack2(h2[2], h2[3]); pk.z = pack2(h2[4], h2[5]); pk.w = pack2(h2[6], h2[7]);
    *reinterpret_cast<uint4*>(p.hx + (size_t)t * D + tid * 8) = pk;
  }
}

__device__ __forceinline__ uint32_t mono_key(float f) {
  uint32_t u = __float_as_uint(f);
  return (u & 0x80000000u) ? ~u : (u | 0x80000000u);
}
__device__ __forceinline__ void ins16(uint32_t (&Lk)[16], uint32_t x) {
#pragma unroll
  for (int i = 0; i < 16; ++i) { uint32_t hi = max(Lk[i], x); x = min(Lk[i], x); Lk[i] = hi; }
}
__device__ __forceinline__ float unmono_key(uint32_t k) {
  return __uint_as_float((k & 0x80000000u) ? (k ^ 0x80000000u) : ~k);
}
typedef __attribute__((ext_vector_type(16))) float f32x16;
__device__ void phase_q_route(const Params& p, int bid, int nb, char* smem) {
  const int tid = threadIdx.x, lane = tid & 63, w = tid >> 6;
  const int wm = w >> 1, wn = w & 1, lr = lane & 15, lq = lane >> 4;
  const int l31 = lane & 31, lh = lane >> 5;
  for (int tile = bid; tile < 512; tile += nb) {
    const int h = tile & 7, m0 = (tile >> 3) * 128;
    {
      f32x4 acc[4][4];
      gemm_mainloop(p.hx, D, p.w_q_t, D, D, m0, h * 128, acc, smem);
#pragma unroll
      for (int i = 0; i < 4; ++i)
#pragma unroll
        for (int j = 0; j < 4; ++j)
#pragma unroll
          for (int r = 0; r < 4; ++r) {
            const int row = wm * 64 + i * 16 + lq * 4 + r, col = wn * 64 + j * 16 + lr;
            *reinterpret_cast<bf16_t*>(smem + swz16(row, col >> 3) + (col & 7) * 2) = f2bf(acc[i][j][r]);
          }
    }
#pragma unroll 4
    for (int r = 0; r < 16; ++r) {
      const int id = tid + 256 * r, row = id >> 4, c4 = id & 15;
      const float* src = ((row < 128) ? p.sk1 : p.sk2) + ((size_t)(h * 128 + (row & 127)) * 64 + c4 * 4);
      const float4 v = *reinterpret_cast<const float4*>(src);
      uint2 pk; pk.x = pack2(v.x, v.y); pk.y = pack2(v.z, v.w);
      *reinterpret_cast<uint2*>(smem + 32768 + swz8(row, c4 >> 1) + (c4 & 1) * 8) = pk;
    }
    __syncthreads();
    uint32_t L1[16], L2[16];
#pragma unroll
    for (int sd = 0; sd < 2; ++sd) {
      uint32_t Lk[16];
#pragma unroll
      for (int i = 0; i < 16; ++i) Lk[i] = 0u;
      const uint32_t kb = (uint32_t)(lh * 4);
#pragma unroll
      for (int ih = 0; ih < 2; ++ih) {
        f32x16 Sa[2];
#pragma unroll
        for (int i = 0; i < 2; ++i)
#pragma unroll
          for (int g2 = 0; g2 < 16; ++g2) Sa[i][g2] = 0.f;
#pragma unroll
        for (int ks = 0; ks < 4; ++ks) {
          const bf16x8 qb = *reinterpret_cast<const bf16x8*>(smem + swz16(w * 32 + l31, sd * 8 + ks * 2 + lh));
#pragma unroll
          for (int i = 0; i < 2; ++i) {
            const bf16x8 ka = *reinterpret_cast<const bf16x8*>(smem + 32768 + swz8(sd * 128 + (ih * 2 + i) * 32 + l31, ks * 2 + lh));
            Sa[i] = __builtin_amdgcn_mfma_f32_32x32x16_bf16(ka, qb, Sa[i], 0, 0, 0);
          }
        }
#pragma unroll
        for (int i = 0; i < 2; ++i)
#pragma unroll
          for (int g2 = 0; g2 < 16; ++g2)
            ins16(Lk, (mono_key(Sa[i][g2]) & ~0x7Fu) | (uint32_t)((ih * 2 + i) * 32 + (g2 & 3) + 8 * (g2 >> 2)) | kb);
      }
      uint32_t o[16];
#pragma unroll
      for (int r = 0; r < 16; ++r) o[r] = (uint32_t)__shfl_xor((int)Lk[r], 32);
#pragma unroll
      for (int r = 0; r < 16; ++r) ins16(Lk, o[r]);
#pragma unroll
      for (int r = 0; r < 16; ++r) { if (sd == 0) L1[r] = Lk[r]; else L2[r] = Lk[r]; }
    }
    __syncthreads();
    uint32_t* ib = reinterpret_cast<uint32_t*>(smem) + w * 1088 + l31 * 34;
    if (lh == 0) {
#pragma unroll
      for (int r = 0; r < 16; ++r) { ib[r] = L1[r] & 127u; ib[16 + r] = L2[r] & 127u; }
    }
    float v1[16], v2[16];
#pragma unroll
    for (int r = 0; r < 16; ++r) { v1[r] = unmono_key(L1[r] & ~0x7Fu); v2[r] = unmono_key(L2[r] & ~0x7Fu); }
    uint32_t C[16];
#pragma unroll
    for (int i = 0; i < 16; ++i) C[i] = 0u;
#pragma unroll
    for (int a = 0; a < 16; ++a)
#pragma unroll
      for (int bq = 0; bq < 16; ++bq)
        if ((a + 1) * (bq + 1) <= 16) ins16(C, (mono_key(v1[a] + v2[bq]) & ~0xFFu) | (uint32_t)(a * 16 + bq));
    float ts[16]; int te[16];
    __builtin_amdgcn_wave_barrier();
#pragma unroll
    for (int r = 0; r < 16; ++r) {
      const uint32_t code = C[r] & 0xFFu;
      te[r] = (int)(ib[code >> 4] * 128u + ib[16 + (code & 15u)]);
      ts[r] = unmono_key(C[r] & ~0xFFu);
    }
    const float mx = ts[0];
    float den = 0.f;
#pragma unroll
    for (int r = 0; r < 16; ++r) { ts[r] = __expf(ts[r] - mx); den += ts[r]; }
    const float inv = 1.f / den;
    const size_t ob = (size_t)(m0 + w * 32 + l31) * 128 + h * 16;
    if (lh == 0) {
#pragma unroll
      for (int r = 0; r < 16; r += 4) *reinterpret_cast<int4*>(p.idx + ob + r) = int4{te[r], te[r + 1], te[r + 2], te[r + 3]};
    } else {
#pragma unroll
      for (int r = 0; r < 16; r += 4)
        *reinterpret_cast<float4*>(p.gate + ob + r) = float4{ts[r] * inv, ts[r + 1] * inv, ts[r + 2] * inv, ts[r + 3] * inv};
    }
    __syncthreads();
  }
}

__device__ void phase_experts(const Params& p, int bid, int nb) {
  const int lane = threadIdx.x & 63, w = threadIdx.x >> 6;
  for (int t = bid * 4 + w; t < T; t += nb * 4) {
    const int b = t / L;
    uint4 hq[4];
#pragma unroll
    for (int c = 0; c < 4; ++c) hq[c] = *reinterpret_cast<const uint4*>(p.hx + (size_t)t * D + c * 512 + lane * 8);
    float hf[32];
#pragma unroll
    for (int c = 0; c < 4; ++c) {
      hf[c * 8 + 0] = bflo(hq[c].x); hf[c * 8 + 1] = bfhi(hq[c].x); hf[c * 8 + 2] = bflo(hq[c].y); hf[c * 8 + 3] = bfhi(hq[c].y);
      hf[c * 8 + 4] = bflo(hq[c].z); hf[c * 8 + 5] = bfhi(hq[c].z); hf[c * 8 + 6] = bflo(hq[c].w); hf[c * 8 + 7] = bfhi(hq[c].w);
    }
    float acc[32];
#pragma unroll
    for (int e = 0; e < 32; ++e) acc[e] = 0.f;
    const int* ip = p.idx + (size_t)t * 128;
    const float* gp = p.gate + (size_t)t * 128;
    for (int j0 = 0; j0 < 128; j0 += 2) {
      int e0 = __builtin_amdgcn_readfirstlane(ip[j0]), e1 = __builtin_amdgcn_readfirstlane(ip[j0 + 1]);
      float g0 = gp[j0], g1 = gp[j0 + 1];
      uint4 u0[4], u1[4], v0[4], v1[4];
#pragma unroll
      for (int c = 0; c < 4; ++c) {
        u0[c] = *reinterpret_cast<const uint4*>(p.Ubf + (size_t)e0 * D + c * 512 + lane * 8);
        u1[c] = *reinterpret_cast<const uint4*>(p.Ubf + (size_t)e1 * D + c * 512 + lane * 8);
        v0[c] = *reinterpret_cast<const uint4*>(p.Vbf + (size_t)e0 * D + c * 512 + lane * 8);
        v1[c] = *reinterpret_cast<const uint4*>(p.Vbf + (size_t)e1 * D + c * 512 + lane * 8);
      }
      float d0 = 0.f, d1 = 0.f;
#pragma unroll
      for (int c = 0; c < 4; ++c) {
        d0 += hf[c * 8 + 0] * bflo(u0[c].x) + hf[c * 8 + 1] * bfhi(u0[c].x) + hf[c * 8 + 2] * bflo(u0[c].y) + hf[c * 8 + 3] * bfhi(u0[c].y) +
              hf[c * 8 + 4] * bflo(u0[c].z) + hf[c * 8 + 5] * bfhi(u0[c].z) + hf[c * 8 + 6] * bflo(u0[c].w) + hf[c * 8 + 7] * bfhi(u0[c].w);
        d1 += hf[c * 8 + 0] * bflo(u1[c].x) + hf[c * 8 + 1] * bfhi(u1[c].x) + hf[c * 8 + 2] * bflo(u1[c].y) + hf[c * 8 + 3] * bfhi(u1[c].y) +
              hf[c * 8 + 4] * bflo(u1[c].z) + hf[c * 8 + 5] * bfhi(u1[c].z) + hf[c * 8 + 6] * bflo(u1[c].w) + hf[c * 8 + 7] * bfhi(u1[c].w);
      }
      d0 = wave_sum(d0); d1 = wave_sum(d1);
      float c0 = g0 * 0.5f * d0 * (1.f + erff(d0 * 0.70710678118654752f));
      float c1 = g1 * 0.5f * d1 * (1.f + erff(d1 * 0.70710678118654752f));
#pragma unroll
      for (int c = 0; c < 4; ++c) {
        acc[c * 8 + 0] += c0 * bflo(v0[c].x) + c1 * bflo(v1[c].x); acc[c * 8 + 1] += c0 * bfhi(v0[c].x) + c1 * bfhi(v1[c].x);
        acc[c * 8 + 2] += c0 * bflo(v0[c].y) + c1 * bflo(v1[c].y); acc[c * 8 + 3] += c0 * bfhi(v0[c].y) + c1 * bfhi(v1[c].y);
        acc[c * 8 + 4] += c0 * bflo(v0[c].z) + c1 * bflo(v1[c].z); acc[c * 8 + 5] += c0 * bfhi(v0[c].z) + c1 * bfhi(v1[c].z);
        acc[c * 8 + 6] += c0 * bflo(v0[c].w) + c1 * bflo(v1[c].w); acc[c * 8 + 7] += c0 * bfhi(v0[c].w) + c1 * bfhi(v1[c].w);
      }
    }
    float ss = 0.f;
#pragma unroll
    for (int e = 0; e < 32; ++e) ss += acc[e] * acc[e];
    ss = wave_sum(ss);
    float rstd = rsqrtf(ss * (1.f / D) + EPS);
    const float* gfx = p.mod + (size_t)b * NMOD + 5 * D;
#pragma unroll
    for (int c = 0; c < 4; ++c) {
      int e0 = c * 512 + lane * 8;
      float* o = p.out + (size_t)t * D + e0;
      float4 x0 = *reinterpret_cast<const float4*>(o), x1v = *reinterpret_cast<const float4*>(o + 4);
      float4 gA = *reinterpret_cast<const float4*>(gfx + e0), gB = *reinterpret_cast<const float4*>(gfx + e0 + 4);
      float4 pA = *reinterpret_cast<const float4*>(p.g_post_ffn + e0), pB = *reinterpret_cast<const float4*>(p.g_post_ffn + e0 + 4);
      x0.x += gA.x * acc[c * 8 + 0] * rstd * pA.x; x0.y += gA.y * acc[c * 8 + 1] * rstd * pA.y;
      x0.z += gA.z * acc[c * 8 + 2] * rstd * pA.z; x0.w += gA.w * acc[c * 8 + 3] * rstd * pA.w;
      x1v.x += gB.x * acc[c * 8 + 4] * rstd * pB.x; x1v.y += gB.y * acc[c * 8 + 5] * rstd * pB.y;
      x1v.z += gB.z * acc[c * 8 + 6] * rstd * pB.z; x1v.w += gB.w * acc[c * 8 + 7] * rstd * pB.w;
      *reinterpret_cast<float4*>(o) = x0; *reinterpret_cast<float4*>(o + 4) = x1v;
    }
  }
}


#define XB_TMO      128
#define XB_XCNT(j)  (256  + 64 * (j))
#define XB_XSUB(j)  (1280 + 64 * (j))
#define XB_XGEN(j)  (2304 + 64 * (j))
#define XB_TOP      3328
#define XB_TOPGEN   3392
#define XCD_BAR_WORDS 3456
#define XB_SPIN_CAP (1u << 22)
#define LAS __attribute__((address_space(3)))
__device__ __forceinline__ unsigned xb_ld(unsigned* p)              { return __hip_atomic_load(p, __ATOMIC_RELAXED, __HIP_MEMORY_SCOPE_AGENT); }
__device__ __forceinline__ unsigned xb_add(unsigned* p, unsigned v) { return __hip_atomic_fetch_add(p, v, __ATOMIC_RELAXED, __HIP_MEMORY_SCOPE_AGENT); }
__device__ __forceinline__ unsigned xb_xcc_id() { return (unsigned)__builtin_amdgcn_s_getreg((3 << 11) | 20) & 0xFu; }
#define XB_SPIN(cond, bar) do { unsigned _sp = 0; while (cond) { __builtin_amdgcn_s_sleep(1); \
    if ((++_sp & 255u) == 0u) { if (xb_ld(&(bar)[XB_TMO])) break; if (_sp > XB_SPIN_CAP) { atomicAdd(&(bar)[XB_TMO], 1u); break; } } } } while (0)
struct XcdBarrier { unsigned* bar; unsigned x; volatile LAS unsigned* st; };
__device__ __forceinline__ XcdBarrier xcd_barrier_post(unsigned* bar, volatile LAS unsigned* st) {
  XcdBarrier b; b.bar = bar; b.x = xb_xcc_id(); b.st = st;
  if (threadIdx.x == 0) (void)xb_add(&bar[XB_XCNT(b.x)], 1u);
  return b;
}
__device__ __forceinline__ void xcd_barrier_complete(unsigned* bar, unsigned x, unsigned& nloc, unsigned& nx) {
  const unsigned G = gridDim.x * gridDim.y * gridDim.z;
  unsigned sum, cnt, mine, sp = 0u;
  for (;;) {
    sum = 0u; cnt = 0u; mine = 0u;
#pragma unroll
    for (unsigned j = 0; j < 16; ++j) { const unsigned c = xb_ld(&bar[XB_XCNT(j)]); sum += c; cnt += (c > 0u) ? 1u : 0u; mine = (j == x) ? c : mine; }
    if (sum == G) break;
    __builtin_amdgcn_s_sleep(1);
    if ((++sp & 255u) == 0u) { if (xb_ld(&bar[XB_TMO])) break; if (sp > XB_SPIN_CAP) { atomicAdd(&bar[XB_TMO], 1u); break; } }
  }
  nloc = mine > 0u ? mine : 1u; nx = cnt > 0u ? cnt : 1u;
}
__device__ __forceinline__ void xcd_barrier(const XcdBarrier& b) {
  asm volatile("s_waitcnt vmcnt(0)" ::: "memory");
  __syncthreads();
  if (threadIdx.x == 0) {
    unsigned* bar = b.bar;
    __builtin_amdgcn_s_waitcnt(0);
    unsigned nloc = b.st[0], nx = b.st[1];
    if (nloc == 0u) { xcd_barrier_complete(bar, b.x, nloc, nx); b.st[0] = nloc; b.st[1] = nx; }
    const unsigned old = xb_add(&bar[XB_XSUB(b.x)], 1u);
    const unsigned gen = old / nloc;
    if (old + 1u == (gen + 1u) * nloc) {
      __builtin_amdgcn_fence(__ATOMIC_RELEASE, "agent");
      asm volatile("s_waitcnt vmcnt(0)" ::: "memory");
      const unsigned og = xb_add(&bar[XB_TOP], 1u);
      const unsigned tg = og / nx;
      if (og + 1u == (tg + 1u) * nx) xb_add(&bar[XB_TOPGEN], 1u);
      else XB_SPIN(xb_ld(&bar[XB_TOPGEN]) == tg, bar);
      __builtin_amdgcn_fence(__ATOMIC_ACQUIRE, "agent");
      xb_add(&bar[XB_XGEN(b.x)], 1u);
      asm volatile("s_waitcnt vmcnt(0)" ::: "memory");
    } else {
      XB_SPIN(xb_ld(&bar[XB_XGEN(b.x)]) == gen, bar);
      __builtin_amdgcn_fence(__ATOMIC_ACQUIRE, "agent");
      asm volatile("s_waitcnt vmcnt(0)" ::: "memory");
    }
  }
  __syncthreads();
}

__global__ void __launch_bounds__(NTHREADS, 2) fwd_mega(Params p) {
  __shared__ __attribute__((aligned(16))) char smem[75808];
  const int bid = blockIdx.x, nb = gridDim.x;
  volatile LAS unsigned* st = (volatile LAS unsigned*)(smem + 75792);
  if (threadIdx.x == 0) { st[0] = 0u; st[1] = 0u; }
  __syncthreads();
  const XcdBarrier bar = xcd_barrier_post(p.bar, st);
  phase_prep(p, bid, nb, smem);        xcd_barrier(bar);
  phase_fold(p, bid, nb, smem);        xcd_barrier(bar);
  phase_norm_mod(p, bid, nb, smem);    xcd_barrier(bar);
  phase_inproj(p, bid, nb, smem);      xcd_barrier(bar);
  phase_ssm_pre(p, bid, nb, smem);     xcd_barrier(bar);
  phase_ssd_dft(p, bid, nb, smem);     xcd_barrier(bar);
  phase_ssm_post(p, bid, nb, smem);    xcd_barrier(bar);
  phase_outproj(p, bid, nb, smem);     xcd_barrier(bar);
  phase_postmix(p, bid, nb, smem);     xcd_barrier(bar);
  phase_q_route(p, bid, nb, smem);     xcd_barrier(bar);
  phase_experts(p, bid, nb);
}

}

extern "C" void kernel_launch(void* const* d_in, const int* in_sizes, int n_in, void* d_out, int out_size, void* d_ws,
                              size_t ws_size, hipStream_t stream) {
  Params p{};
  const float** fp = reinterpret_cast<const float**>(&p);
  for (int i = 0; i < 27; ++i) fp[i] = (const float*)d_in[i];
  p.out = (float*)d_out;
  char* ws = (char*)d_ws;
  size_t off = 0;
  auto take = [&](size_t bytes) { char* r = ws + off; off += (bytes + 255) & ~(size_t)255; return r; };
  p.Ubf = (bf16_t*)take((size_t)16384 * D * 2);
  p.Vbf = (bf16_t*)take((size_t)16384 * D * 2);
  p.w_in_t = (bf16_t*)take((size_t)NPROJ * D * 2);
  p.w_out_t = (bf16_t*)take((size_t)D * D * 2);
  p.w_q_t = (bf16_t*)take((size_t)1024 * D * 2);
  p.w_in_f = (bf16_t*)take((size_t)D * 1024 * 2);
  p.WcsT = (bf16_t*)take((size_t)4 * 512 * 256 * 2);
  p.dftm = (bf16_t*)take((size_t)2048 * 4096 * 2);
  p.partial = (float*)take((size_t)KSPLIT * 5 * NMOD * 4);
  p.mod = (float*)take((size_t)5 * NMOD * 4);
  p.hx = (bf16_t*)take((size_t)T * D * 2);
  p.hc = (bf16_t*)take((size_t)TC * D * 2);
  p.ABt = (bf16_t*)take((size_t)NB * 1024 * 4096 * 2);
  p.q = (float*)p.ABt;
  p.z = (bf16_t*)take((size_t)T * 1024 * 2);
  char* r1 = take(0);
  p.xbcraw = (float*)take((size_t)T * DXBC * 4);
  p.xbcraw_c = (float*)take((size_t)TC * DXBC * 4);
  p.act_tm = (bf16_t*)take((size_t)(T + TC) * DXBC * 2);
  p.act_cm_x = (bf16_t*)take((size_t)NB * 1280 * L * 2);
  p.act_cm_c = (bf16_t*)take((size_t)NB * 1280 * CTX * 2);
  p.y_x = (float*)r1;
  p.dtraw = (float*)take((size_t)T * 32 * 4);
  p.dtraw_c = (float*)take((size_t)TC * 32 * 4);
  p.dtf = (float*)take((size_t)T * 16 * 4);
  p.dtb = (float*)take((size_t)T * 16 * 4);
  p.dtf_c = (float*)take((size_t)TC * 16 * 4);
  p.dtb_c = (float*)take((size_t)TC * 16 * 4);
  p.yf = (float*)take((size_t)T * 1024 * 4);
  p.yb = (float*)take((size_t)T * 1024 * 4);
  p.ctr = (unsigned*)take(256);
  p.bar = (unsigned*)take((size_t)XCD_BAR_WORDS * 4);
  p.ycat = (bf16_t*)take((size_t)T * D * 2);
  p.idx = (int*)take((size_t)T * 128 * 4);
  p.gate = (float*)take((size_t)T * 128 * 4);
  if (off > ws_size) { fprintf(stderr, "kernel_launch: workspace too small: need %zu have %zu\n", off, ws_size); return; }
  static int grid_blocks = 0;
  if (!grid_blocks) {
    int dev = 0, cus = 0, per_cu = 0;
    hipGetDevice(&dev);
    hipDeviceGetAttribute(&cus, hipDeviceAttributeMultiprocessorCount, dev);
    hipOccupancyMaxActiveBlocksPerMultiprocessor(&per_cu, fwd_mega, NTHREADS, 0);
    if (per_cu > 2) per_cu = 2;
    grid_blocks = cus * per_cu;
    if (grid_blocks <= 0) { fprintf(stderr, "kernel_launch: occupancy query gave %d x %d\n", cus, per_cu); grid_blocks = -1; }
  }
  if (grid_blocks < 0) return;
  (void)hipMemsetAsync(p.bar, 0, (size_t)XCD_BAR_WORDS * 4, stream);
  void* args[] = {&p};
  hipError_t e = hipLaunchCooperativeKernel((void*)fwd_mega, dim3(grid_blocks), dim3(NTHREADS), args, 0, stream);
  if (e != hipSuccess) fprintf(stderr, "cooperative launch failed: %s (grid %d)\n", hipGetErrorString(e), grid_blocks);
}
```

```cpp
#include <hip/hip_runtime.h>
#include <hip/hip_cooperative_groups.h>
#include <stdint.h>
#include <stdio.h>

namespace cg = cooperative_groups;
namespace {

typedef __attribute__((ext_vector_type(8))) short bf16x8;
typedef __attribute__((ext_vector_type(4))) float f32x4;
typedef unsigned short bf16_t;

constexpr int D = 2048, NB = 4, L = 2048, T = NB * L, CTX = 256, TC = NB * CTX;
constexpr int NMOD = 6 * D;
constexpr int NH = 16, HP = 64, NS = 128, DXBC = 1536;
constexpr int DIN = 3616;
constexpr int NPROJ = 4736;
constexpr int KSPLIT = 32;
constexpr float EPS = 1e-6f;
constexpr int NTHREADS = 256;

__device__ __forceinline__ bf16_t f2bf(float f) {
  uint32_t u = __float_as_uint(f);
  u += 0x7fffu + ((u >> 16) & 1u);
  return (bf16_t)(u >> 16);
}
__device__ __forceinline__ float bf2f(bf16_t h) { return __uint_as_float(((uint32_t)h) << 16); }
__device__ __forceinline__ uint32_t pack2(float a, float b) { return (uint32_t)f2bf(a) | ((uint32_t)f2bf(b) << 16); }
__device__ __forceinline__ float bflo(uint32_t w) { return __uint_as_float(w << 16); }
__device__ __forceinline__ float bfhi(uint32_t w) { return __uint_as_float(w & 0xffff0000u); }
__device__ __forceinline__ float silu_f(float v) { return v / (1.f + __expf(-v)); }
__device__ __forceinline__ float softplus_f(float v) { return v > 20.f ? v : log1pf(__expf(v)); }

__device__ __forceinline__ float wave_sum(float v) {
#pragma unroll
  for (int o = 32; o > 0; o >>= 1) v += __shfl_xor(v, o);
  return v;
}
__device__ __forceinline__ float wave_max(float v) {
#pragma unroll
  for (int o = 32; o > 0; o >>= 1) v = fmaxf(v, __shfl_xor(v, o));
  return v;
}
__device__ __forceinline__ float block_sum(float v, float* red) {
  v = wave_sum(v);
  __syncthreads();
  if ((threadIdx.x & 63) == 0) red[threadIdx.x >> 6] = v;
  __syncthreads();
  return red[0] + red[1] + red[2] + red[3];
}

struct Params {
  const float *x, *c, *ctx, *c_ctx, *w_mod, *b_mod, *g_pre_mix, *g_post_mix, *g_pre_ffn, *g_post_ffn;
  const float *w_in, *w_fmix, *conv_w, *conv_b, *dt_bias_f, *dt_bias_b, *a_log_f, *a_log_b, *d_skip_f, *d_skip_b;
  const float *ssm_norm_w, *w_out, *w_query, *sk1, *sk2, *eu, *ev;
  float* out;
  uint8_t *U8, *V8;
  bf16_t *w_in_t, *w_out_t, *w_q_t, *w_in_f, *WcsT, *dftm;
  float *partial, *mod;
  bf16_t *hx, *hc, *ABt, *z;
  float *xbcraw, *xbcraw_c, *dtraw, *dtraw_c, *dtf, *dtb, *dtf_c, *dtb_c;
  bf16_t *act_tm, *act_cm_x, *act_cm_c;
  float *yf, *yb;
  unsigned* ctr; unsigned* bar;
  bf16_t* ycat;
  float *y_x, *q, *gate;
  int* idx;
  int pad0, pad1;
};

__device__ __forceinline__ void gemm_mainloop(const bf16_t* __restrict__ A, int lda, const bf16_t* __restrict__ Bt, int ldb,
                                              int K, int m0, int n0, f32x4 (&acc)[4][4], char* smem) {
  const int tid = threadIdx.x, lane = tid & 63, w = tid >> 6;
  const int wm = w >> 1, wn = w & 1;
#pragma unroll
  for (int i = 0; i < 4; ++i)
#pragma unroll
    for (int j = 0; j < 4; ++j) acc[i][j] = f32x4{0.f, 0.f, 0.f, 0.f};

  uint4 ra0, ra1, ra2, ra3, rb0, rb1, rb2, rb3;
  const int nk = K / 64;
  const int lrow = tid >> 3, lch = tid & 7;
  const bf16_t* gA = A + (size_t)(m0 + lrow) * lda + lch * 8;
  const bf16_t* gB = Bt + (size_t)(n0 + lrow) * ldb + lch * 8;
  const int soff = lrow * 128 + ((lch ^ (lrow & 7)) << 4);
#define GLOAD(kt_)                                                                  \
  do {                                                                              \
    ra0 = *reinterpret_cast<const uint4*>(gA + (kt_) * 64);                         \
    ra1 = *reinterpret_cast<const uint4*>(gA + (size_t)32 * lda + (kt_) * 64);      \
    ra2 = *reinterpret_cast<const uint4*>(gA + (size_t)64 * lda + (kt_) * 64);      \
    ra3 = *reinterpret_cast<const uint4*>(gA + (size_t)96 * lda + (kt_) * 64);      \
    rb0 = *reinterpret_cast<const uint4*>(gB + (kt_) * 64);                         \
    rb1 = *reinterpret_cast<const uint4*>(gB + (size_t)32 * ldb + (kt_) * 64);      \
    rb2 = *reinterpret_cast<const uint4*>(gB + (size_t)64 * ldb + (kt_) * 64);      \
    rb3 = *reinterpret_cast<const uint4*>(gB + (size_t)96 * ldb + (kt_) * 64);      \
  } while (0)
  GLOAD(0);
  for (int kt = 0; kt < nk; ++kt) {
    char* sA = smem + (kt & 1) * 32768;
    char* sB = sA + 16384;
    *reinterpret_cast<uint4*>(sA + soff) = ra0;
    *reinterpret_cast<uint4*>(sA + soff + 4096) = ra1;
    *reinterpret_cast<uint4*>(sA + soff + 8192) = ra2;
    *reinterpret_cast<uint4*>(sA + soff + 12288) = ra3;
    *reinterpret_cast<uint4*>(sB + soff) = rb0;
    *reinterpret_cast<uint4*>(sB + soff + 4096) = rb1;
    *reinterpret_cast<uint4*>(sB + soff + 8192) = rb2;
    *reinterpret_cast<uint4*>(sB + soff + 12288) = rb3;
    __syncthreads();
    if (kt + 1 < nk) GLOAD(kt + 1);
#pragma unroll
    for (int kk = 0; kk < 2; ++kk) {
      bf16x8 af[4], bfr[4];
      const int ch = kk * 4 + (lane >> 4);
#pragma unroll
      for (int i = 0; i < 4; ++i) {
        int row = wm * 64 + i * 16 + (lane & 15);
        af[i] = *reinterpret_cast<const bf16x8*>(sA + row * 128 + ((ch ^ (row & 7)) << 4));
        int col = wn * 64 + i * 16 + (lane & 15);
        bfr[i] = *reinterpret_cast<const bf16x8*>(sB + col * 128 + ((ch ^ (col & 7)) << 4));
      }
#pragma unroll
      for (int i = 0; i < 4; ++i)
#pragma unroll
        for (int j = 0; j < 4; ++j) acc[i][j] = __builtin_amdgcn_mfma_f32_16x16x32_bf16(af[i], bfr[j], acc[i][j], 0, 0, 0);
    }
  }
#undef GLOAD
  __syncthreads();
}
template <class Epi>
__device__ __forceinline__ void gemm_tile(const bf16_t* __restrict__ A, int lda, const bf16_t* __restrict__ Bt, int ldb,
                                          int K, int m0, int n0, const Epi& epi, char* smem) {
  const int lane = threadIdx.x & 63, w = threadIdx.x >> 6;
  const int wm = w >> 1, wn = w & 1;
  f32x4 acc[4][4];
  gemm_mainloop(A, lda, Bt, ldb, K, m0, n0, acc, smem);
#pragma unroll
  for (int i = 0; i < 4; ++i)
#pragma unroll
    for (int j = 0; j < 4; ++j) {
      int row = m0 + wm * 64 + i * 16 + (lane >> 4) * 4;
      int col = n0 + wn * 64 + j * 16 + (lane & 15);
      epi(row, col, acc[i][j]);
    }
}

struct EpiF32 {
  float* C; int ldc;
  __device__ __forceinline__ void operator()(int row, int col, f32x4 v) const {
#pragma unroll
    for (int r = 0; r < 4; ++r) C[(size_t)(row + r) * ldc + col] = v[r];
  }
};
struct EpiBf16 {
  bf16_t* C; int ldc;
  __device__ __forceinline__ void operator()(int row, int col, f32x4 v) const {
#pragma unroll
    for (int r = 0; r < 4; ++r) C[(size_t)(row + r) * ldc + col] = f2bf(v[r]);
  }
};
struct EpiBf16T {
  bf16_t* Ct; int ldc;
  __device__ __forceinline__ void operator()(int row, int col, f32x4 v) const {
    uint2 pk; pk.x = pack2(v[0], v[1]); pk.y = pack2(v[2], v[3]);
    *reinterpret_cast<uint2*>(Ct + (size_t)col * ldc + row) = pk;
  }
};
struct EpiInProj {
  bf16_t* ABt; bf16_t* z; float* xbcraw; float* dtraw; int seqlen;
  __device__ __forceinline__ void operator()(int row, int col, f32x4 v) const {
    if (col < 2048) {
      int ch = col & 1023, half = col >> 10;
      int b = row / seqlen, l = row - b * seqlen;
      uint2 pk; pk.x = pack2(v[0], v[1]); pk.y = pack2(v[2], v[3]);
      *reinterpret_cast<uint2*>(ABt + ((size_t)(b * 1024 + ch) * 4096 + half * 2048 + l)) = pk;
    } else if (col < 3072) {
#pragma unroll
      for (int r = 0; r < 4; ++r) z[(size_t)(row + r) * 1024 + (col - 2048)] = f2bf(v[r]);
    } else if (col < 4608) {
#pragma unroll
      for (int r = 0; r < 4; ++r) xbcraw[(size_t)(row + r) * DXBC + (col - 3072)] = v[r];
    } else if (col < 4640) {
#pragma unroll
      for (int r = 0; r < 4; ++r) dtraw[(size_t)(row + r) * 32 + (col - 4608)] = v[r];
    }
  }
};

__device__ void adaln_partial_task(const Params& p, int task, float* sm) {
  const int cb = task % 48, ks = task / 48, tid = threadIdx.x;
  float* sc = sm;
  __syncthreads();
  for (int i = tid; i < 5 * 64; i += NTHREADS) {
    int r = i >> 6, kk = i & 63;
    int k = ks * 64 + kk;
    float cv = (r < 4) ? p.c[r * D + k] : p.c_ctx[k];
    sc[i] = silu_f(cv);
  }
  __syncthreads();
  const int col = cb * 256 + tid;
  float a0 = 0, a1 = 0, a2 = 0, a3 = 0, a4 = 0;
  const float* wp = p.w_mod + (size_t)(ks * 64) * NMOD + col;
#pragma unroll 8
  for (int kk = 0; kk < 64; ++kk) {
    float wv = wp[(size_t)kk * NMOD];
    a0 += sc[kk] * wv; a1 += sc[64 + kk] * wv; a2 += sc[128 + kk] * wv; a3 += sc[192 + kk] * wv; a4 += sc[256 + kk] * wv;
  }
  float* pp = p.partial + (size_t)ks * 5 * NMOD + col;
  pp[0] = a0; pp[NMOD] = a1; pp[2 * NMOD] = a2; pp[3 * NMOD] = a3; pp[4 * NMOD] = a4;
}

__device__ void transpose_convert_task(const float* __restrict__ src, int ld, int c0, int rows, bf16_t* __restrict__ dst,
                                       int tr, int tc, float* sm) {
  float (*tile)[65] = reinterpret_cast<float (*)[65]>(sm);
  const int tid = threadIdx.x;
  __syncthreads();
  for (int i = tid; i < 64 * 64; i += NTHREADS) {
    int r = i >> 6, cc = i & 63;
    tile[r][cc] = src[(size_t)(tr * 64 + r) * ld + c0 + tc * 64 + cc];
  }
  __syncthreads();
  for (int i = tid; i < 64 * 32; i += NTHREADS) {
    int cc = i >> 5, r2 = (i & 31) * 2;
    uint32_t pk = pack2(tile[r2][cc], tile[r2 + 1][cc]);
    *reinterpret_cast<uint32_t*>(dst + (size_t)(tc * 64 + cc) * rows + tr * 64 + r2) = pk;
  }
}

__device__ void phase_prep(const Params& p, int bid, int nb, char* smem) {
  float* sm = reinterpret_cast<float*>(smem);
  const int tid = threadIdx.x;
  if (bid == 0 && tid == 0) p.ctr[0] = 0u;
  for (int t = bid; t < 48 * KSPLIT; t += nb) adaln_partial_task(p, t, sm);
  {
    const size_t n16 = (size_t)16384 * D / 16;
    for (size_t i = (size_t)bid * NTHREADS + tid; i < 2 * n16; i += (size_t)nb * NTHREADS) {
      const float* s = (i < n16) ? p.eu : p.ev;
      uint8_t* d = (i < n16) ? p.U8 : p.V8;
      const size_t j = (i < n16) ? i : i - n16;
      uint32_t o[4];
#pragma unroll
      for (int q4 = 0; q4 < 4; ++q4) {
        const float4 v = *reinterpret_cast<const float4*>(s + j * 16 + q4 * 4);
        int pk = 0;
        pk = __builtin_amdgcn_cvt_pk_fp8_f32(v.x * 512.f, v.y * 512.f, pk, false);
        pk = __builtin_amdgcn_cvt_pk_fp8_f32(v.z * 512.f, v.w * 512.f, pk, true);
        o[q4] = (uint32_t)pk;
      }
      *reinterpret_cast<uint4*>(d + j * 16) = uint4{o[0], o[1], o[2], o[3]};
    }
  }
  {
    const int nct = 41, nrt = 32;
    for (int t = bid; t < nct * nrt; t += nb) {
      int tc = t % nct, tr = t / nct;
      if (tc < 40) transpose_convert_task(p.w_in, DIN, 1024, D, p.w_in_t + (size_t)2048 * D, tr, tc, sm);
      else {
        float (*tile)[65] = reinterpret_cast<float (*)[65]>(sm);
        __syncthreads();
        for (int i = tid; i < 64 * 32; i += NTHREADS) {
          int r = i >> 5, cc = i & 31;
          tile[r][cc] = p.w_in[(size_t)(tr * 64 + r) * DIN + 1024 + 2560 + cc];
        }
        __syncthreads();
        for (int i = tid; i < 32 * 32; i += NTHREADS) {
          int cc = i >> 5, r2 = (i & 31) * 2;
          uint32_t pk = pack2(tile[r2][cc], tile[r2 + 1][cc]);
          *reinterpret_cast<uint32_t*>(p.w_in_t + (size_t)(2048 + 2560 + cc) * D + tr * 64 + r2) = pk;
        }
      }
    }
    for (int t = bid; t < 32 * 32; t += nb) transpose_convert_task(p.w_out, D, 0, D, p.w_out_t, t / 32, t % 32, sm);
    for (int t = bid; t < 16 * 32; t += nb) transpose_convert_task(p.w_query, 1024, 0, D, p.w_q_t, t / 16, t % 16, sm);
    for (size_t i = (size_t)bid * NTHREADS + tid; i < (size_t)96 * D / 8; i += (size_t)nb * NTHREADS)
      reinterpret_cast<uint4*>(p.w_in_t + (size_t)4640 * D)[i] = uint4{0, 0, 0, 0};
  }
  for (size_t i = (size_t)bid * NTHREADS + tid; i < (size_t)D * 1024 / 4; i += (size_t)nb * NTHREADS) {
    int k = (int)(i / 256), c4 = (int)(i % 256) * 4;
    float4 v = *reinterpret_cast<const float4*>(p.w_in + (size_t)k * DIN + c4);
    uint2 o; o.x = pack2(v.x, v.y); o.y = pack2(v.z, v.w);
    *reinterpret_cast<uint2*>(p.w_in_f + (size_t)k * 1024 + c4) = o;
  }
  {
    const float scale = 1.0f / sqrtf((float)L * 256.f);
    for (int i = bid * NTHREADS + tid; i < 4 * 256 * 256; i += nb * NTHREADS) {
      int d = i & 255, c = (i >> 8) & 255, g = i >> 16;
      float sc_ = 0.f, ss_ = 0.f;
      for (int m = 0; m < 256; ++m) {
        int ph = (m * c) & 255;
        float sv, cv;
        sincospif((float)ph * (1.0f / 128.f), &sv, &cv);
        float wv = p.w_fmix[((size_t)g * 256 + m) * 256 + d];
        sc_ += cv * wv; ss_ += sv * wv;
      }
      p.WcsT[((size_t)g * 512 + d) * 256 + c] = f2bf(sc_ * scale);
      p.WcsT[((size_t)g * 512 + 256 + d) * 256 + c] = f2bf(ss_ * scale);
    }
  }
  for (size_t i = (size_t)bid * NTHREADS + tid; i < (size_t)2048 * 4096 / 2; i += (size_t)nb * NTHREADS) {
    int k = (int)(i / 2048), j = (int)(i % 2048) * 2;
    float o[2];
#pragma unroll
    for (int e = 0; e < 2; ++e) {
      int jj = j + e;
      int l = jj & 2047;
      int ph = (k * l) & 2047;
      float sv, cv;
      sincospif((float)ph * (1.0f / 1024.f), &sv, &cv);
      o[e] = (jj < 2048) ? cv : -sv;
    }
    *reinterpret_cast<uint32_t*>(p.dftm + (size_t)k * 4096 + j) = pack2(o[0], o[1]);
  }
}

__device__ void phase_fold(const Params& p, int bid, int nb, char* smem) {
  const int tid = threadIdx.x;
  for (int i = bid * NTHREADS + tid; i < 5 * NMOD; i += nb * NTHREADS) {
    int col = i % NMOD;
    float s = p.b_mod[col];
    for (int ks = 0; ks < KSPLIT; ++ks) s += p.partial[(size_t)ks * 5 * NMOD + i];
    p.mod[i] = s;
  }
  for (int t = bid; t < 256; t += nb) {
    int g = t >> 6, tm = (t & 63) >> 2, tn = t & 3;
    int n0 = tn * 128;
    int rowbase = (n0 < 256) ? (g * 256 + n0) : (1024 + g * 256 + (n0 - 256));
    EpiBf16T epi{p.w_in_t + (size_t)(rowbase - n0) * D, D};
    gemm_tile(p.w_in_f + g * 256, 1024, p.WcsT + (size_t)g * 512 * 256, 256, 256, tm * 128, n0, epi, smem);
  }
}

__device__ void phase_norm_mod(const Params& p, int bid, int nb, char* smem) {
  float* red = reinterpret_cast<float*>(smem);
  const int tid = threadIdx.x;
  for (int t = bid; t < T + TC; t += nb) {
    const bool isx = t < T;
    const float* src = isx ? (p.x + (size_t)t * D) : (p.ctx + (size_t)(t - T) * D);
    const int mrow = isx ? (t / L) : 4;
    bf16_t* dst = isx ? (p.hx + (size_t)t * D) : (p.hc + (size_t)(t - T) * D);
    float4 v0 = *reinterpret_cast<const float4*>(src + tid * 8);
    float4 v1 = *reinterpret_cast<const float4*>(src + tid * 8 + 4);
    float ss = v0.x * v0.x + v0.y * v0.y + v0.z * v0.z + v0.w * v0.w + v1.x * v1.x + v1.y * v1.y + v1.z * v1.z + v1.w * v1.w;
    ss = block_sum(ss, red);
    float rstd = rsqrtf(ss * (1.f / D) + EPS);
    const float* sh = p.mod + (size_t)mrow * NMOD + 0 * D + tid * 8;
    const float* sc = p.mod + (size_t)mrow * NMOD + 1 * D + tid * 8;
    const float* g = p.g_pre_mix + tid * 8;
    float vv[8] = {v0.x, v0.y, v0.z, v0.w, v1.x, v1.y, v1.z, v1.w};
    float o[8];
#pragma unroll
    for (int e = 0; e < 8; ++e) o[e] = vv[e] * rstd * g[e] * (1.f + sc[e]) + sh[e];
    uint4 pk; pk.x = pack2(o[0], o[1]); pk.y = pack2(o[2], o[3]); pk.z = pack2(o[4], o[5]); pk.w = pack2(o[6], o[7]);
    *reinterpret_cast<uint4*>(dst + tid * 8) = pk;
  }
}

__device__ void phase_inproj(const Params& p, int bid, int nb, char* smem) {
  const int ntx = 64 * 37, ntc = 8 * 13;
  for (int t = bid; t < ntx + ntc; t += nb) {
    if (t < ntx) {
      int tm = t / 37, tn = t % 37;
      EpiInProj epi{p.ABt, p.z, p.xbcraw, p.dtraw, L};
      gemm_tile(p.hx, D, p.w_in_t, D, D, tm * 128, tn * 128, epi, smem);
    } else {
      int u = t - ntx;
      int tm = u / 13, tn = u % 13;
      EpiInProj epi{nullptr, nullptr, p.xbcraw_c, p.dtraw_c, CTX};
      gemm_tile(p.hc, D, p.w_in_t, D, D, tm * 128, 3072 + tn * 128, epi, smem);
    }
  }
}

__device__ void ssm_pre_tile(const Params& p, int task, char* smem) {
  const bool isx = task < 3072;
  const int u = isx ? task : task - 3072;
  const int ntt = isx ? 32 : 4;
  const int ct = u % 24, tt = (u / 24) % ntt, b = u / (24 * ntt);
  const int seqlen = isx ? L : CTX;
  const float* raw = (isx ? p.xbcraw : p.xbcraw_c) + (size_t)b * seqlen * DXBC;
  const int l0 = tt * 64, c0 = ct * 64, tid = threadIdx.x;
  float (*rt)[65] = reinterpret_cast<float (*)[65]>(smem);
  float (*at)[65] = reinterpret_cast<float (*)[65]>(smem + 66 * 65 * 4);
  __syncthreads();
  for (int i = tid; i < 66 * 64; i += NTHREADS) {
    int r = i >> 6, cc = i & 63, l = l0 - 1 + r;
    rt[r][cc] = (l >= 0 && l < seqlen) ? raw[(size_t)l * DXBC + c0 + cc] : 0.f;
  }
  __syncthreads();
  for (int i = tid; i < 64 * 64; i += NTHREADS) {
    int r = i >> 6, cc = i & 63, c = c0 + cc;
    float acc = p.conv_b[c] + rt[r][cc] * p.conv_w[c] + rt[r + 1][cc] * p.conv_w[DXBC + c] + rt[r + 2][cc] * p.conv_w[2 * DXBC + c];
    at[r][cc] = silu_f(acc);
  }
  __syncthreads();
  const size_t trow0 = isx ? ((size_t)b * L + l0) : ((size_t)T + (size_t)b * CTX + l0);
  for (int i = tid; i < 64 * 32; i += NTHREADS) {
    int r = i >> 5, c2 = (i & 31) * 2;
    *reinterpret_cast<uint32_t*>(p.act_tm + (trow0 + r) * DXBC + c0 + c2) = pack2(at[r][c2], at[r][c2 + 1]);
  }
  if (c0 < 1280) {
    bf16_t* cm = (isx ? p.act_cm_x : p.act_cm_c) + (size_t)b * 1280 * seqlen;
    for (int i = tid; i < 64 * 32; i += NTHREADS) {
      int cc = i >> 5, r2 = (i & 31) * 2;
      *reinterpret_cast<uint32_t*>(cm + (size_t)(c0 + cc) * seqlen + l0 + r2) = pack2(at[r2][cc], at[r2 + 1][cc]);
    }
  }
}
__device__ void phase_ssm_pre(const Params& p, int bid, int nb, char* smem) {
  const int tid = threadIdx.x;
  for (int t = bid; t < 3072 + 384; t += nb) ssm_pre_tile(p, t, smem);
  for (int i = bid * NTHREADS + tid; i < (T + TC) * 32; i += nb * NTHREADS) {
    const bool isx = i < T * 32;
    const int ii = isx ? i : i - T * 32;
    const int t = ii >> 5, j = ii & 31;
    const float v = (isx ? p.dtraw : p.dtraw_c)[ii];
    float* df = isx ? p.dtf : p.dtf_c;
    float* db = isx ? p.dtb : p.dtb_c;
    if (j < 16) df[t * 16 + j] = softplus_f(v + p.dt_bias_f[j]);
    else db[t * 16 + (j - 16)] = softplus_f(v + p.dt_bias_b[j - 16]);
  }
}

__device__ __forceinline__ int swz16(int row, int chunk) { return row * 256 + ((chunk ^ (row & 15)) << 4); }
__device__ __forceinline__ int swz8(int row, int chunk) { return row * 128 + ((chunk ^ (row & 7)) << 4); }

__device__ void ssd_task(const Params& p, int task, char* smem) {
  const int dir = task & 1, h = (task >> 1) & 15, b = task >> 5;
  const int tid = threadIdx.x, lane = tid & 63, w = tid >> 6;
  const int g = h >> 3, lr0 = lane & 15, lq0 = lane >> 4;
  const float a = -__expf(dir ? p.a_log_b[h] : p.a_log_f[h]);
  char* sCc = smem; char* sBc = smem + 16384; char* sBT = smem + 32768; char* sXT = smem + 49152; char* sHb = smem + 57344;
  float* se = reinterpret_cast<float*>(smem + 73728);
  float* sdt = se + 64; float* sw = se + 128; float* sy = se + 192; float* stot = se + 256;
  float* yo = dir ? p.yb : p.yf;
  f32x4 H[8];
#pragma unroll
  for (int j = 0; j < 8; ++j) H[j] = f32x4{0.f, 0.f, 0.f, 0.f};
  __syncthreads();
  for (int i = tid; i < 1024; i += NTHREADS) reinterpret_cast<uint4*>(sHb)[i] = uint4{0, 0, 0, 0};
  for (int step = 0; step < 36; ++step) {
    const bool isctx = step < 4;
    const int nch = isctx ? 4 : 32, ci = isctx ? step : step - 4;
    const int c = dir ? (nch - 1 - ci) : ci;
    const int seqlen = isctx ? CTX : L;
    const size_t trow0 = isctx ? ((size_t)T + (size_t)b * CTX + c * 64) : ((size_t)b * L + c * 64);
    const size_t drow0 = (size_t)b * seqlen + c * 64;
    const float* dtp = isctx ? (dir ? p.dtb_c : p.dtf_c) : (dir ? p.dtb : p.dtf);
    const bf16_t* cm = (isctx ? p.act_cm_c : p.act_cm_x) + (size_t)b * 1280 * seqlen + c * 64;
    int lr = lr0, lq = lq0;
    asm volatile("" : "+v"(lr), "+v"(lq));
    __syncthreads();
    if (w == 0) {
      const float dtv = dtp[(drow0 + lane) * 16 + h];
      float v = a * dtv;
      if (!dir) {
#pragma unroll
        for (int o = 1; o < 64; o <<= 1) { float n = __shfl_up(v, o); v += (lane >= o) ? n : 0.f; }
      } else {
#pragma unroll
        for (int o = 1; o < 64; o <<= 1) { float n = __shfl_down(v, o); v += (lane + o < 64) ? n : 0.f; }
      }
      const float etot = __shfl(v, dir ? 0 : 63);
      se[lane] = v; sdt[lane] = dtv; sw[lane] = dtv * __expf(etot - v); sy[lane] = __expf(v);
      if (lane == 0) stot[0] = etot;
    }
    if (!isctx) {
#pragma unroll
      for (int r = 0; r < 4; ++r) {
        const int id = tid + 256 * r, row = id >> 4, ch = id & 15;
        const bf16_t* src = p.act_tm + (trow0 + row) * DXBC + g * 128 + ch * 8;
        *reinterpret_cast<uint4*>(sCc + swz16(row, ch)) = *reinterpret_cast<const uint4*>(src + 1280);
        *reinterpret_cast<uint4*>(sBc + swz16(row, ch)) = *reinterpret_cast<const uint4*>(src + 1024);
      }
    }
#pragma unroll
    for (int r = 0; r < 4; ++r) {
      const int id = tid + 256 * r, row = id >> 3, ch = id & 7;
      *reinterpret_cast<uint4*>(sBT + swz8(row, ch)) = *reinterpret_cast<const uint4*>(cm + (size_t)(1024 + g * 128 + row) * seqlen + ch * 8);
    }
#pragma unroll
    for (int r = 0; r < 2; ++r) {
      const int id = tid + 256 * r, row = id >> 3, ch = id & 7;
      *reinterpret_cast<uint4*>(sXT + swz8(row, ch)) = *reinterpret_cast<const uint4*>(cm + (size_t)(h * 64 + row) * seqlen + ch * 8);
    }
    __syncthreads();
    const float etot = stot[0];
    if (!isctx) {
      f32x4 G[4];
      bf16x8 ca[4];
#pragma unroll
      for (int j = 0; j < 4; ++j) G[j] = f32x4{0.f, 0.f, 0.f, 0.f};
#pragma unroll
      for (int kk = 0; kk < 4; ++kk) ca[kk] = *reinterpret_cast<const bf16x8*>(sCc + swz16(16 * w + lr, kk * 4 + lq));
#pragma unroll
      for (int kk = 0; kk < 4; ++kk)
#pragma unroll
        for (int j = 0; j < 4; ++j) {
          bf16x8 bb = *reinterpret_cast<const bf16x8*>(sBc + swz16(16 * j + lr, kk * 4 + lq));
          G[j] = __builtin_amdgcn_mfma_f32_16x16x32_bf16(ca[kk], bb, G[j], 0, 0, 0);
        }
      __syncthreads();
      float el[4];
#pragma unroll
      for (int r = 0; r < 4; ++r) el[r] = se[16 * w + lq * 4 + r];
#pragma unroll
      for (int j = 0; j < 4; ++j) {
        const int s_ = 16 * j + lr;
        const float es = se[s_], ds = sdt[s_];
#pragma unroll
        for (int r = 0; r < 4; ++r) {
          const int l = 16 * w + lq * 4 + r;
          const bool keep = dir ? (s_ >= l) : (s_ <= l);
          const float m = keep ? G[j][r] * __expf(el[r] - es) * ds : 0.f;
          *reinterpret_cast<bf16_t*>(sBc + swz8(l, s_ >> 3) + (s_ & 7) * 2) = f2bf(m);
        }
      }
      __syncthreads();
      f32x4 Y[4], Yo[4];
#pragma unroll
      for (int j = 0; j < 4; ++j) { Y[j] = f32x4{0.f, 0.f, 0.f, 0.f}; Yo[j] = f32x4{0.f, 0.f, 0.f, 0.f}; }
#pragma unroll
      for (int kk = 0; kk < 2; ++kk) {
        bf16x8 ma = *reinterpret_cast<const bf16x8*>(sBc + swz8(16 * w + lr, kk * 4 + lq));
#pragma unroll
        for (int j = 0; j < 4; ++j) {
          bf16x8 xb = *reinterpret_cast<const bf16x8*>(sXT + swz8(16 * j + lr, kk * 4 + lq));
          Y[j] = __builtin_amdgcn_mfma_f32_16x16x32_bf16(ma, xb, Y[j], 0, 0, 0);
        }
      }
#pragma unroll
      for (int kk = 0; kk < 4; ++kk)
#pragma unroll
        for (int j = 0; j < 4; ++j) {
          bf16x8 hb = *reinterpret_cast<const bf16x8*>(sHb + swz16(16 * j + lr, kk * 4 + lq));
          Yo[j] = __builtin_amdgcn_mfma_f32_16x16x32_bf16(ca[kk], hb, Yo[j], 0, 0, 0);
        }
      float syl[4];
#pragma unroll
      for (int r = 0; r < 4; ++r) syl[r] = sy[16 * w + lq * 4 + r];
#pragma unroll
      for (int j = 0; j < 4; ++j)
#pragma unroll
        for (int r = 0; r < 4; ++r) {
          const int l = 16 * w + lq * 4 + r;
          yo[(trow0 + l) * 1024 + h * 64 + 16 * j + lr] = Y[j][r] + syl[r] * Yo[j][r];
        }
    }
    {
      const float dec = __expf(etot);
#pragma unroll
      for (int j = 0; j < 8; ++j) H[j] *= dec;
#pragma unroll
      for (int kk = 0; kk < 2; ++kk) {
        bf16x8 xa = *reinterpret_cast<const bf16x8*>(sXT + swz8(16 * w + lr, kk * 4 + lq));
        const int s0 = kk * 32 + lq * 8;
        const float4 w0 = *reinterpret_cast<const float4*>(sw + s0), w1 = *reinterpret_cast<const float4*>(sw + s0 + 4);
        bf16x8 xs;
        xs[0] = (short)f2bf(bf2f((bf16_t)xa[0]) * w0.x); xs[1] = (short)f2bf(bf2f((bf16_t)xa[1]) * w0.y);
        xs[2] = (short)f2bf(bf2f((bf16_t)xa[2]) * w0.z); xs[3] = (short)f2bf(bf2f((bf16_t)xa[3]) * w0.w);
        xs[4] = (short)f2bf(bf2f((bf16_t)xa[4]) * w1.x); xs[5] = (short)f2bf(bf2f((bf16_t)xa[5]) * w1.y);
        xs[6] = (short)f2bf(bf2f((bf16_t)xa[6]) * w1.z); xs[7] = (short)f2bf(bf2f((bf16_t)xa[7]) * w1.w);
#pragma unroll
        for (int j = 0; j < 8; ++j) {
          bf16x8 bt = *reinterpret_cast<const bf16x8*>(sBT + swz8(16 * j + lr, kk * 4 + lq));
          H[j] = __builtin_amdgcn_mfma_f32_16x16x32_bf16(xs, bt, H[j], 0, 0, 0);
        }
      }
    }
    __syncthreads();
#pragma unroll
    for (int j = 0; j < 8; ++j) {
      const int n = 16 * j + lr;
#pragma unroll
      for (int r = 0; r < 4; ++r) {
        const int pr = 16 * w + lq * 4 + r;
        *reinterpret_cast<bf16_t*>(sHb + swz16(pr, n >> 3) + (n & 7) * 2) = f2bf(H[j][r]);
      }
    }
  }
}

__device__ void phase_ssd_dft(const Params& p, int bid, int nb, char* smem) {
  for (int t = bid; t < 128; t += nb) ssd_task(p, t, smem);
  int* stile = reinterpret_cast<int*>(smem + 75776);
  for (;;) {
    __syncthreads();
    if (threadIdx.x == 0) *stile = (int)atomicAdd(p.ctr, 1u);
    __syncthreads();
    const int t = *stile;
    if (t >= 4 * 16 * 8) break;
    int b = t >> 7, tm = (t & 127) >> 3, tn = t & 7;
    EpiBf16 epi{p.ycat + (size_t)b * L * D, D};
    gemm_tile(p.dftm, 4096, p.ABt + (size_t)b * 1024 * 4096, 4096, 4096, tm * 128, tn * 128, epi, smem);
  }
}

__device__ void phase_ssm_post(const Params& p, int bid, int nb, char* smem) {
  float* red = reinterpret_cast<float*>(smem);
  const int tid = threadIdx.x, w = tid >> 6;
  for (int t = bid; t < T; t += nb) {
    const int c0 = tid * 4;
    const int h = c0 >> 6;
    const float dsk = p.d_skip_f[h] + p.d_skip_b[h];
    float4 a = *reinterpret_cast<const float4*>(p.yf + (size_t)t * 1024 + c0);
    float4 bq = *reinterpret_cast<const float4*>(p.yb + (size_t)t * 1024 + c0);
    uint2 xq = *reinterpret_cast<const uint2*>(p.act_tm + (size_t)t * DXBC + c0);
    float xs[4] = {bflo(xq.x), bfhi(xq.x), bflo(xq.y), bfhi(xq.y)};
    uint2 zz = *reinterpret_cast<const uint2*>(p.z + (size_t)t * 1024 + c0);
    float zf[4] = {bflo(zz.x), bfhi(zz.x), bflo(zz.y), bfhi(zz.y)};
    float y[4] = {a.x + bq.x + dsk * xs[0], a.y + bq.y + dsk * xs[1], a.z + bq.z + dsk * xs[2], a.w + bq.w + dsk * xs[3]};
    float ss = 0.f;
#pragma unroll
    for (int e = 0; e < 4; ++e) { y[e] *= silu_f(zf[e]); ss += y[e] * y[e]; }
    ss = wave_sum(ss);
    __syncthreads();
    if ((tid & 63) == 0) red[w] = ss;
    __syncthreads();
    float gs = (w < 2) ? (red[0] + red[1]) : (red[2] + red[3]);
    float rstd = rsqrtf(gs * (1.f / 512.f) + EPS);
    float4 nw = *reinterpret_cast<const float4*>(p.ssm_norm_w + c0);
    uint2 o; o.x = pack2(y[0] * rstd * nw.x, y[1] * rstd * nw.y); o.y = pack2(y[2] * rstd * nw.z, y[3] * rstd * nw.w);
    *reinterpret_cast<uint2*>(p.ycat + (size_t)t * D + 1024 + c0) = o;
  }
}

__device__ void phase_outproj(const Params& p, int bid, int nb, char* smem) {
  for (int t = bid; t < 64 * 16; t += nb) {
    EpiF32 epi{p.y_x, D};
    gemm_tile(p.ycat, D, p.w_out_t, D, D, (t >> 4) * 128, (t & 15) * 128, epi, smem);
  }
}
__device__ void phase_postmix(const Params& p, int bid, int nb, char* smem) {
  float* red = reinterpret_cast<float*>(smem);
  const int tid = threadIdx.x;
  for (int t = bid; t < T; t += nb) {
    const int b = t / L;
    const float* yr = p.y_x + (size_t)t * D + tid * 8;
    const float* xr = p.x + (size_t)t * D + tid * 8;
    float y[8], xv[8];
    *reinterpret_cast<float4*>(y) = *reinterpret_cast<const float4*>(yr);
    *reinterpret_cast<float4*>(y + 4) = *reinterpret_cast<const float4*>(yr + 4);
    *reinterpret_cast<float4*>(xv) = *reinterpret_cast<const float4*>(xr);
    *reinterpret_cast<float4*>(xv + 4) = *reinterpret_cast<const float4*>(xr + 4);
    float ss = 0.f;
#pragma unroll
    for (int e = 0; e < 8; ++e) ss += y[e] * y[e];
    ss = block_sum(ss, red);
    float rstd = rsqrtf(ss * (1.f / D) + EPS);
    const float* gm = p.mod + (size_t)b * NMOD + 2 * D + tid * 8;
    const float* gp = p.g_post_mix + tid * 8;
    float x1[8]; float ss1 = 0.f;
#pragma unroll
    for (int e = 0; e < 8; ++e) { x1[e] = xv[e] + gm[e] * (y[e] * rstd * gp[e]); ss1 += x1[e] * x1[e]; }
    ss1 = block_sum(ss1, red);
    float rstd1 = rsqrtf(ss1 * (1.f / D) + EPS);
    float* o = p.out + (size_t)t * D + tid * 8;
    *reinterpret_cast<float4*>(o) = *reinterpret_cast<float4*>(x1);
    *reinterpret_cast<float4*>(o + 4) = *reinterpret_cast<float4*>(x1 + 4);
    const float* sf = p.mod + (size_t)b * NMOD + 3 * D + tid * 8;
    const float* cf = p.mod + (size_t)b * NMOD + 4 * D + tid * 8;
    const float* gf = p.g_pre_ffn + tid * 8;
    float h2[8];
#pragma unroll
    for (int e = 0; e < 8; ++e) h2[e] = x1[e] * rstd1 * gf[e] * (1.f + cf[e]) + sf[e];
    uint4 pk; pk.x = pack2(h2[0], h2[1]); pk.y = pack2(h2[2], h2[3]); pk.z = pack2(h2[4], h2[5]); pk.w = pack2(h2[6], h2[7]);
    *reinterpret_cast<uint4*>(p.hx + (size_t)t * D + tid * 8) = pk;
  }
}

__device__ __forceinline__ uint32_t mono_key(float f) {
  uint32_t u = __float_as_uint(f);
  return (u & 0x80000000u) ? ~u : (u | 0x80000000u);
}
__device__ __forceinline__ void ins16(uint32_t (&Lk)[16], uint32_t x) {
#pragma unroll
  for (int i = 0; i < 16; ++i) { uint32_t hi = max(Lk[i], x); x = min(Lk[i], x); Lk[i] = hi; }
}
__device__ __forceinline__ float unmono_key(uint32_t k) {
  return __uint_as_float((k & 0x80000000u) ? (k ^ 0x80000000u) : ~k);
}
typedef __attribute__((ext_vector_type(16))) float f32x16;
__device__ void phase_q_route(const Params& p, int bid, int nb, char* smem) {
  const int tid = threadIdx.x, lane = tid & 63, w = tid >> 6;
  const int wm = w >> 1, wn = w & 1, lr = lane & 15, lq = lane >> 4;
  const int l31 = lane & 31, lh = lane >> 5;
  for (int tile = bid; tile < 512; tile += nb) {
    const int h = tile & 7, m0 = (tile >> 3) * 128;
    {
      f32x4 acc[4][4];
      gemm_mainloop(p.hx, D, p.w_q_t, D, D, m0, h * 128, acc, smem);
#pragma unroll
      for (int i = 0; i < 4; ++i)
#pragma unroll
        for (int j = 0; j < 4; ++j)
#pragma unroll
          for (int r = 0; r < 4; ++r) {
            const int row = wm * 64 + i * 16 + lq * 4 + r, col = wn * 64 + j * 16 + lr;
            *reinterpret_cast<bf16_t*>(smem + swz16(row, col >> 3) + (col & 7) * 2) = f2bf(acc[i][j][r]);
          }
    }
#pragma unroll 4
    for (int r = 0; r < 16; ++r) {
      const int id = tid + 256 * r, row = id >> 4, c4 = id & 15;
      const float* src = ((row < 128) ? p.sk1 : p.sk2) + ((size_t)(h * 128 + (row & 127)) * 64 + c4 * 4);
      const float4 v = *reinterpret_cast<const float4*>(src);
      uint2 pk; pk.x = pack2(v.x, v.y); pk.y = pack2(v.z, v.w);
      *reinterpret_cast<uint2*>(smem + 32768 + swz8(row, c4 >> 1) + (c4 & 1) * 8) = pk;
    }
    __syncthreads();
    uint32_t L1[16], L2[16];
#pragma unroll
    for (int sd = 0; sd < 2; ++sd) {
      uint32_t Lk[16];
#pragma unroll
      for (int i = 0; i < 16; ++i) Lk[i] = 0u;
      const uint32_t kb = (uint32_t)(lh * 4);
#pragma unroll
      for (int ih = 0; ih < 2; ++ih) {
        f32x16 Sa[2];
#pragma unroll
        for (int i = 0; i < 2; ++i)
#pragma unroll
          for (int g2 = 0; g2 < 16; ++g2) Sa[i][g2] = 0.f;
#pragma unroll
        for (int ks = 0; ks < 4; ++ks) {
          const bf16x8 qb = *reinterpret_cast<const bf16x8*>(smem + swz16(w * 32 + l31, sd * 8 + ks * 2 + lh));
#pragma unroll
          for (int i = 0; i < 2; ++i) {
            const bf16x8 ka = *reinterpret_cast<const bf16x8*>(smem + 32768 + swz8(sd * 128 + (ih * 2 + i) * 32 + l31, ks * 2 + lh));
            Sa[i] = __builtin_amdgcn_mfma_f32_32x32x16_bf16(ka, qb, Sa[i], 0, 0, 0);
          }
        }
#pragma unroll
        for (int i = 0; i < 2; ++i)
#pragma unroll
          for (int g2 = 0; g2 < 16; ++g2)
            ins16(Lk, (mono_key(Sa[i][g2]) & ~0x7Fu) | (uint32_t)((ih * 2 + i) * 32 + (g2 & 3) + 8 * (g2 >> 2)) | kb);
      }
      uint32_t o[16];
#pragma unroll
      for (int r = 0; r < 16; ++r) o[r] = (uint32_t)__shfl_xor((int)Lk[r], 32);
#pragma unroll
      for (int r = 0; r < 16; ++r) ins16(Lk, o[r]);
#pragma unroll
      for (int r = 0; r < 16; ++r) { if (sd == 0) L1[r] = Lk[r]; else L2[r] = Lk[r]; }
    }
    __syncthreads();
    uint32_t* ib = reinterpret_cast<uint32_t*>(smem) + w * 1088 + l31 * 34;
    if (lh == 0) {
#pragma unroll
      for (int r = 0; r < 16; ++r) { ib[r] = L1[r] & 127u; ib[16 + r] = L2[r] & 127u; }
    }
    float v1[16], v2[16];
#pragma unroll
    for (int r = 0; r < 16; ++r) { v1[r] = unmono_key(L1[r] & ~0x7Fu); v2[r] = unmono_key(L2[r] & ~0x7Fu); }
    uint32_t C[16];
#pragma unroll
    for (int i = 0; i < 16; ++i) C[i] = 0u;
#pragma unroll
    for (int a = 0; a < 16; ++a)
#pragma unroll
      for (int bq = 0; bq < 16; ++bq)
        if ((a + 1) * (bq + 1) <= 16) ins16(C, (mono_key(v1[a] + v2[bq]) & ~0xFFu) | (uint32_t)(a * 16 + bq));
    float ts[16]; int te[16];
    __builtin_amdgcn_wave_barrier();
#pragma unroll
    for (int r = 0; r < 16; ++r) {
      const uint32_t code = C[r] & 0xFFu;
      te[r] = (int)(ib[code >> 4] * 128u + ib[16 + (code & 15u)]);
      ts[r] = unmono_key(C[r] & ~0xFFu);
    }
    const float mx = ts[0];
    float den = 0.f;
#pragma unroll
    for (int r = 0; r < 16; ++r) { ts[r] = __expf(ts[r] - mx); den += ts[r]; }
    const float inv = 1.f / den;
    const size_t ob = (size_t)(m0 + w * 32 + l31) * 128 + h * 16;
    if (lh == 0) {
#pragma unroll
      for (int r = 0; r < 16; r += 4) *reinterpret_cast<int4*>(p.idx + ob + r) = int4{te[r], te[r + 1], te[r + 2], te[r + 3]};
    } else {
#pragma unroll
      for (int r = 0; r < 16; r += 4)
        *reinterpret_cast<float4*>(p.gate + ob + r) = float4{ts[r] * inv, ts[r + 1] * inv, ts[r + 2] * inv, ts[r + 3] * inv};
    }
    __syncthreads();
  }
}

typedef __attribute__((ext_vector_type(2))) float f32x2;
__device__ __forceinline__ void fp8x16_to_f32(const uint4 q, f32x2 (&o)[8]) {
  o[0] = __builtin_amdgcn_cvt_pk_f32_fp8((int)q.x, false); o[1] = __builtin_amdgcn_cvt_pk_f32_fp8((int)q.x, true);
  o[2] = __builtin_amdgcn_cvt_pk_f32_fp8((int)q.y, false); o[3] = __builtin_amdgcn_cvt_pk_f32_fp8((int)q.y, true);
  o[4] = __builtin_amdgcn_cvt_pk_f32_fp8((int)q.z, false); o[5] = __builtin_amdgcn_cvt_pk_f32_fp8((int)q.z, true);
  o[6] = __builtin_amdgcn_cvt_pk_f32_fp8((int)q.w, false); o[7] = __builtin_amdgcn_cvt_pk_f32_fp8((int)q.w, true);
}
__device__ void phase_experts(const Params& p, int bid, int nb) {
  const int lane = threadIdx.x & 63, w = threadIdx.x >> 6;
  for (int t = bid * 4 + w; t < T; t += nb * 4) {
    const int b = t / L;
    f32x2 hf[16];
#pragma unroll
    for (int c = 0; c < 2; ++c)
#pragma unroll
      for (int q2 = 0; q2 < 2; ++q2) {
        const uint4 hq = *reinterpret_cast<const uint4*>(p.hx + (size_t)t * D + c * 1024 + lane * 16 + q2 * 8);
        hf[c * 8 + q2 * 4 + 0] = f32x2{bflo(hq.x), bfhi(hq.x)}; hf[c * 8 + q2 * 4 + 1] = f32x2{bflo(hq.y), bfhi(hq.y)};
        hf[c * 8 + q2 * 4 + 2] = f32x2{bflo(hq.z), bfhi(hq.z)}; hf[c * 8 + q2 * 4 + 3] = f32x2{bflo(hq.w), bfhi(hq.w)};
      }
    f32x2 acc[16];
#pragma unroll
    for (int e = 0; e < 16; ++e) acc[e] = f32x2{0.f, 0.f};
    const int* ip = p.idx + (size_t)t * 128;
    const float* gp = p.gate + (size_t)t * 128;
    for (int j0 = 0; j0 < 128; j0 += 4) {
      int ee[4]; float gg[4];
#pragma unroll
      for (int k = 0; k < 4; ++k) { ee[k] = __builtin_amdgcn_readfirstlane(ip[j0 + k]); gg[k] = gp[j0 + k]; }
      uint4 uq[4][2], vq[4][2];
#pragma unroll
      for (int k = 0; k < 4; ++k)
#pragma unroll
        for (int c = 0; c < 2; ++c) {
          uq[k][c] = *reinterpret_cast<const uint4*>(p.U8 + (size_t)ee[k] * D + c * 1024 + lane * 16);
          vq[k][c] = *reinterpret_cast<const uint4*>(p.V8 + (size_t)ee[k] * D + c * 1024 + lane * 16);
        }
      float dd[4];
#pragma unroll
      for (int k = 0; k < 4; ++k) {
        f32x2 d2 = f32x2{0.f, 0.f};
#pragma unroll
        for (int c = 0; c < 2; ++c) {
          f32x2 uf[8];
          fp8x16_to_f32(uq[k][c], uf);
#pragma unroll
          for (int e = 0; e < 8; ++e) d2 += hf[c * 8 + e] * uf[e];
        }
        dd[k] = d2.x + d2.y;
      }
#pragma unroll
      for (int k = 0; k < 4; ++k) dd[k] = wave_sum(dd[k]) * (1.f / 512.f);
#pragma unroll
      for (int k = 0; k < 4; ++k) {
        const float cf = gg[k] * 0.5f * dd[k] * (1.f + erff(dd[k] * 0.70710678118654752f));
        const f32x2 c2 = f32x2{cf, cf};
#pragma unroll
        for (int c = 0; c < 2; ++c) {
          f32x2 vf[8];
          fp8x16_to_f32(vq[k][c], vf);
#pragma unroll
          for (int e = 0; e < 8; ++e) acc[c * 8 + e] += c2 * vf[e];
        }
      }
    }
    float ss = 0.f;
#pragma unroll
    for (int e = 0; e < 16; ++e) ss += acc[e].x * acc[e].x + acc[e].y * acc[e].y;
    ss = wave_sum(ss);
    const float inv512 = 1.f / 512.f;
    const float rstd = rsqrtf(ss * (inv512 * inv512) * (1.f / D) + EPS) * inv512;
    const float* gfx = p.mod + (size_t)b * NMOD + 5 * D;
#pragma unroll
    for (int c = 0; c < 2; ++c)
#pragma unroll
      for (int q4 = 0; q4 < 4; ++q4) {
        const int e0 = c * 1024 + lane * 16 + q4 * 4;
        float* o = p.out + (size_t)t * D + e0;
        float4 x0 = *reinterpret_cast<const float4*>(o);
        const float4 gA = *reinterpret_cast<const float4*>(gfx + e0);
        const float4 pA = *reinterpret_cast<const float4*>(p.g_post_ffn + e0);
        x0.x += gA.x * acc[c * 8 + q4 * 2 + 0].x * rstd * pA.x; x0.y += gA.y * acc[c * 8 + q4 * 2 + 0].y * rstd * pA.y;
        x0.z += gA.z * acc[c * 8 + q4 * 2 + 1].x * rstd * pA.z; x0.w += gA.w * acc[c * 8 + q4 * 2 + 1].y * rstd * pA.w;
        *reinterpret_cast<float4*>(o) = x0;
      }
  }
}

#define XB_TMO      128
#define XB_XCNT(j)  (256  + 64 * (j))
#define XB_XSUB(j)  (1280 + 64 * (j))
#define XB_XGEN(j)  (2304 + 64 * (j))
#define XB_TOP      3328
#define XB_TOPGEN   3392
#define XCD_BAR_WORDS 3456
#define XB_SPIN_CAP (1u << 22)
#define LAS __attribute__((address_space(3)))
__device__ __forceinline__ unsigned xb_ld(unsigned* p)              { return __hip_atomic_load(p, __ATOMIC_RELAXED, __HIP_MEMORY_SCOPE_AGENT); }
__device__ __forceinline__ unsigned xb_add(unsigned* p, unsigned v) { return __hip_atomic_fetch_add(p, v, __ATOMIC_RELAXED, __HIP_MEMORY_SCOPE_AGENT); }
__device__ __forceinline__ unsigned xb_xcc_id() { return (unsigned)__builtin_amdgcn_s_getreg((3 << 11) | 20) & 0xFu; }
#define XB_SPIN(cond, bar) do { unsigned _sp = 0; while (cond) { __builtin_amdgcn_s_sleep(1); \
    if ((++_sp & 255u) == 0u) { if (xb_ld(&(bar)[XB_TMO])) break; if (_sp > XB_SPIN_CAP) { atomicAdd(&(bar)[XB_TMO], 1u); break; } } } } while (0)
struct XcdBarrier { unsigned* bar; unsigned x; volatile LAS unsigned* st; };
__device__ __forceinline__ XcdBarrier xcd_barrier_post(unsigned* bar, volatile LAS unsigned* st) {
  XcdBarrier b; b.bar = bar; b.x = xb_xcc_id(); b.st = st;
  if (threadIdx.x == 0) (void)xb_add(&bar[XB_XCNT(b.x)], 1u);
  return b;
}
__device__ __forceinline__ void xcd_barrier_complete(unsigned* bar, unsigned x, unsigned& nloc, unsigned& nx) {
  const unsigned G = gridDim.x * gridDim.y * gridDim.z;
  unsigned sum, cnt, mine, sp = 0u;
  for (;;) {
    sum = 0u; cnt = 0u; mine = 0u;
#pragma unroll
    for (unsigned j = 0; j < 16; ++j) { const unsigned c = xb_ld(&bar[XB_XCNT(j)]); sum += c; cnt += (c > 0u) ? 1u : 0u; mine = (j == x) ? c : mine; }
    if (sum == G) break;
    __builtin_amdgcn_s_sleep(1);
    if ((++sp & 255u) == 0u) { if (xb_ld(&bar[XB_TMO])) break; if (sp > XB_SPIN_CAP) { atomicAdd(&bar[XB_TMO], 1u); break; } }
  }
  nloc = mine > 0u ? mine : 1u; nx = cnt > 0u ? cnt : 1u;
}
__device__ __forceinline__ void xcd_barrier(const XcdBarrier& b) {
  asm volatile("s_waitcnt vmcnt(0)" ::: "memory");
  __syncthreads();
  if (threadIdx.x == 0) {
    unsigned* bar = b.bar;
    __builtin_amdgcn_s_waitcnt(0);
    unsigned nloc = b.st[0], nx = b.st[1];
    if (nloc == 0u) { xcd_barrier_complete(bar, b.x, nloc, nx); b.st[0] = nloc; b.st[1] = nx; }
    const unsigned old = xb_add(&bar[XB_XSUB(b.x)], 1u);
    const unsigned gen = old / nloc;
    if (old + 1u == (gen + 1u) * nloc) {
      __builtin_amdgcn_fence(__ATOMIC_RELEASE, "agent");
      asm volatile("s_waitcnt vmcnt(0)" ::: "memory");
      const unsigned og = xb_add(&bar[XB_TOP], 1u);
      const unsigned tg = og / nx;
      if (og + 1u == (tg + 1u) * nx) xb_add(&bar[XB_TOPGEN], 1u);
      else XB_SPIN(xb_ld(&bar[XB_TOPGEN]) == tg, bar);
      __builtin_amdgcn_fence(__ATOMIC_ACQUIRE, "agent");
      xb_add(&bar[XB_XGEN(b.x)], 1u);
      asm volatile("s_waitcnt vmcnt(0)" ::: "memory");
    } else {
      XB_SPIN(xb_ld(&bar[XB_XGEN(b.x)]) == gen, bar);
      __builtin_amdgcn_fence(__ATOMIC_ACQUIRE, "agent");
      asm volatile("s_waitcnt vmcnt(0)" ::: "memory");
    }
  }
  __syncthreads();
}

__global__ void __launch_bounds__(NTHREADS, 2) fwd_mega(Params p) {
  __shared__ __attribute__((aligned(16))) char smem[75808];
  const int bid = blockIdx.x, nb = gridDim.x;
  volatile LAS unsigned* st = (volatile LAS unsigned*)(smem + 75792);
  if (threadIdx.x == 0) { st[0] = 0u; st[1] = 0u; }
  __syncthreads();
  const XcdBarrier bar = xcd_barrier_post(p.bar, st);
  phase_prep(p, bid, nb, smem);        xcd_barrier(bar);
  phase_fold(p, bid, nb, smem);        xcd_barrier(bar);
  phase_norm_mod(p, bid, nb, smem);    xcd_barrier(bar);
  phase_inproj(p, bid, nb, smem);      xcd_barrier(bar);
  phase_ssm_pre(p, bid, nb, smem);     xcd_barrier(bar);
  phase_ssd_dft(p, bid, nb, smem);     xcd_barrier(bar);
  phase_ssm_post(p, bid, nb, smem);    xcd_barrier(bar);
  phase_outproj(p, bid, nb, smem);     xcd_barrier(bar);
  phase_postmix(p, bid, nb, smem);     xcd_barrier(bar);
  phase_q_route(p, bid, nb, smem);     xcd_barrier(bar);
  phase_experts(p, bid, nb);
}

}

extern "C" void kernel_launch(void* const* d_in, const int* in_sizes, int n_in, void* d_out, int out_size, void* d_ws,
                              size_t ws_size, hipStream_t stream) {
  Params p{};
  const float** fp = reinterpret_cast<const float**>(&p);
  for (int i = 0; i < 27; ++i) fp[i] = (const float*)d_in[i];
  p.out = (float*)d_out;
  char* ws = (char*)d_ws;
  size_t off = 0;
  auto take = [&](size_t bytes) { char* r = ws + off; off += (bytes + 255) & ~(size_t)255; return r; };
  p.U8 = (uint8_t*)take((size_t)16384 * D);
  p.V8 = (uint8_t*)take((size_t)16384 * D);
  p.w_in_t = (bf16_t*)take((size_t)NPROJ * D * 2);
  p.w_out_t = (bf16_t*)take((size_t)D * D * 2);
  p.w_q_t = (bf16_t*)take((size_t)1024 * D * 2);
  p.w_in_f = (bf16_t*)take((size_t)D * 1024 * 2);
  p.WcsT = (bf16_t*)take((size_t)4 * 512 * 256 * 2);
  p.dftm = (bf16_t*)take((size_t)2048 * 4096 * 2);
  p.partial = (float*)take((size_t)KSPLIT * 5 * NMOD * 4);
  p.mod = (float*)take((size_t)5 * NMOD * 4);
  p.hx = (bf16_t*)take((size_t)T * D * 2);
  p.hc = (bf16_t*)take((size_t)TC * D * 2);
  p.ABt = (bf16_t*)take((size_t)NB * 1024 * 4096 * 2);
  p.q = (float*)p.ABt;
  p.z = (bf16_t*)take((size_t)T * 1024 * 2);
  char* r1 = take(0);
  p.xbcraw = (float*)take((size_t)T * DXBC * 4);
  p.xbcraw_c = (float*)take((size_t)TC * DXBC * 4);
  p.act_tm = (bf16_t*)take((size_t)(T + TC) * DXBC * 2);
  p.act_cm_x = (bf16_t*)take((size_t)NB * 1280 * L * 2);
  p.act_cm_c = (bf16_t*)take((size_t)NB * 1280 * CTX * 2);
  p.y_x = (float*)r1;
  p.dtraw = (float*)take((size_t)T * 32 * 4);
  p.dtraw_c = (float*)take((size_t)TC * 32 * 4);
  p.dtf = (float*)take((size_t)T * 16 * 4);
  p.dtb = (float*)take((size_t)T * 16 * 4);
  p.dtf_c = (float*)take((size_t)TC * 16 * 4);
  p.dtb_c = (float*)take((size_t)TC * 16 * 4);
  p.yf = (float*)take((size_t)T * 1024 * 4);
  p.yb = (float*)take((size_t)T * 1024 * 4);
  p.ctr = (unsigned*)take(256);
  p.bar = (unsigned*)take((size_t)XCD_BAR_WORDS * 4);
  p.ycat = (bf16_t*)take((size_t)T * D * 2);
  p.idx = (int*)take((size_t)T * 128 * 4);
  p.gate = (float*)take((size_t)T * 128 * 4);
  if (off > ws_size) { fprintf(stderr, "kernel_launch: workspace too small: need %zu have %zu\n", off, ws_size); return; }
  static int grid_blocks = 0;
  if (!grid_blocks) {
    int dev = 0, cus = 0, per_cu = 0;
    hipGetDevice(&dev);
    hipDeviceGetAttribute(&cus, hipDeviceAttributeMultiprocessorCount, dev);
    hipOccupancyMaxActiveBlocksPerMultiprocessor(&per_cu, fwd_mega, NTHREADS, 0);
    if (per_cu > 2) per_cu = 2;
    grid_blocks = cus * per_cu;
    if (grid_blocks <= 0) { fprintf(stderr, "kernel_launch: occupancy query gave %d x %d\n", cus, per_cu); grid_blocks = -1; }
  }
  if (grid_blocks < 0) return;
  (void)hipMemsetAsync(p.bar, 0, (size_t)XCD_BAR_WORDS * 4, stream);
  void* args[] = {&p};
  hipError_t e = hipLaunchCooperativeKernel((void*)fwd_mega, dim3(grid_blocks), dim3(NTHREADS), args, 0, stream);
  if (e != hipSuccess) fprintf(stderr, "cooperative launch failed: %s (grid %d)\n", hipGetErrorString(e), grid_blocks);
}
```

```cpp
#include <hip/hip_runtime.h>
#include <hip/hip_cooperative_groups.h>
#include <stdint.h>
#include <stdio.h>

namespace cg = cooperative_groups;
namespace {

typedef __attribute__((ext_vector_type(8))) short bf16x8;
typedef __attribute__((ext_vector_type(4))) float f32x4;
typedef unsigned short bf16_t;

constexpr int D = 2048, NB = 4, L = 2048, T = NB * L, CTX = 256, TC = NB * CTX;
constexpr int NMOD = 6 * D;
constexpr int NH = 16, HP = 64, NS = 128, DXBC = 1536;
constexpr int DIN = 3616;
constexpr int NPROJ = 4736;
constexpr int KSPLIT = 32;
constexpr float EPS = 1e-6f;
constexpr int NTHREADS = 256;

__device__ __forceinline__ bf16_t f2bf(float f) {
  uint32_t u = __float_as_uint(f);
  u += 0x7fffu + ((u >> 16) & 1u);
  return (bf16_t)(u >> 16);
}
__device__ __forceinline__ float bf2f(bf16_t h) { return __uint_as_float(((uint32_t)h) << 16); }
__device__ __forceinline__ uint32_t pack2(float a, float b) { return (uint32_t)f2bf(a) | ((uint32_t)f2bf(b) << 16); }
__device__ __forceinline__ float bflo(uint32_t w) { return __uint_as_float(w << 16); }
__device__ __forceinline__ float bfhi(uint32_t w) { return __uint_as_float(w & 0xffff0000u); }
__device__ __forceinline__ float silu_f(float v) { return v / (1.f + __expf(-v)); }
__device__ __forceinline__ float softplus_f(float v) { return v > 20.f ? v : log1pf(__expf(v)); }

__device__ __forceinline__ float wave_sum(float v) {
#pragma unroll
  for (int o = 32; o > 0; o >>= 1) v += __shfl_xor(v, o);
  return v;
}
__device__ __forceinline__ float wave_max(float v) {
#pragma unroll
  for (int o = 32; o > 0; o >>= 1) v = fmaxf(v, __shfl_xor(v, o));
  return v;
}
__device__ __forceinline__ float block_sum(float v, float* red) {
  v = wave_sum(v);
  __syncthreads();
  if ((threadIdx.x & 63) == 0) red[threadIdx.x >> 6] = v;
  __syncthreads();
  return red[0] + red[1] + red[2] + red[3];
}

struct Params {
  const float *x, *c, *ctx, *c_ctx, *w_mod, *b_mod, *g_pre_mix, *g_post_mix, *g_pre_ffn, *g_post_ffn;
  const float *w_in, *w_fmix, *conv_w, *conv_b, *dt_bias_f, *dt_bias_b, *a_log_f, *a_log_b, *d_skip_f, *d_skip_b;
  const float *ssm_norm_w, *w_out, *w_query, *sk1, *sk2, *eu, *ev;
  float* out;
  uint8_t *U8, *V8;
  bf16_t *w_in_t, *w_out_t, *w_q_t, *w_in_f, *WcsT, *dftm;
  float *partial, *mod;
  bf16_t *hx, *hc, *ABt, *z;
  float *xbcraw, *xbcraw_c, *dtraw, *dtraw_c, *dtf, *dtb, *dtf_c, *dtb_c;
  bf16_t *act_tm, *act_cm_x, *act_cm_c;
  float *yf, *yb;
  unsigned* ctr; unsigned* bar;
  bf16_t* ycat;
  float *y_x, *q, *gate;
  int* idx;
  int pad0, pad1;
};

__device__ __forceinline__ void gemm_mainloop(const bf16_t* __restrict__ A, int lda, const bf16_t* __restrict__ Bt, int ldb,
                                              int K, int m0, int n0, f32x4 (&acc)[4][4], char* smem) {
  const int tid = threadIdx.x, lane = tid & 63, w = tid >> 6;
  const int wm = w >> 1, wn = w & 1;
#pragma unroll
  for (int i = 0; i < 4; ++i)
#pragma unroll
    for (int j = 0; j < 4; ++j) acc[i][j] = f32x4{0.f, 0.f, 0.f, 0.f};

  const int nk = K / 64;
  const int rowoff = lane >> 3, lch = (lane & 7) ^ rowoff;
  const bf16_t* gA = A + (size_t)(m0 + w * 8 + rowoff) * lda + lch * 8;
  const bf16_t* gB = Bt + (size_t)(n0 + w * 8 + rowoff) * ldb + lch * 8;
#define GSTAGE(buf_, kt_)                                                                                               \
  do {                                                                                                                  \
    _Pragma("unroll") for (int i_ = 0; i_ < 4; ++i_) {                                                                  \
      __builtin_amdgcn_global_load_lds((const unsigned*)(gA + (size_t)(i_ * 32) * lda + (kt_) * 64),                    \
                                       (unsigned*)(smem + (buf_) * 32768 + (i_ * 4 + w) * 1024), 16, 0, 0);             \
      __builtin_amdgcn_global_load_lds((const unsigned*)(gB + (size_t)(i_ * 32) * ldb + (kt_) * 64),                    \
                                       (unsigned*)(smem + (buf_) * 32768 + 16384 + (i_ * 4 + w) * 1024), 16, 0, 0);     \
    }                                                                                                                   \
  } while (0)
  GSTAGE(0, 0);
  asm volatile("s_waitcnt vmcnt(0)" ::: "memory");
  __syncthreads();
  for (int kt = 0; kt < nk; ++kt) {
    const int cur = kt & 1;
    if (kt + 1 < nk) GSTAGE(cur ^ 1, kt + 1);
    const char* sA = smem + cur * 32768;
    const char* sB = sA + 16384;
#pragma unroll
    for (int kk = 0; kk < 2; ++kk) {
      bf16x8 af[4], bfr[4];
      const int ch = kk * 4 + (lane >> 4);
#pragma unroll
      for (int i = 0; i < 4; ++i) {
        int row = wm * 64 + i * 16 + (lane & 15);
        af[i] = *reinterpret_cast<const bf16x8*>(sA + row * 128 + ((ch ^ (row & 7)) << 4));
        int col = wn * 64 + i * 16 + (lane & 15);
        bfr[i] = *reinterpret_cast<const bf16x8*>(sB + col * 128 + ((ch ^ (col & 7)) << 4));
      }
#pragma unroll
      for (int i = 0; i < 4; ++i)
#pragma unroll
        for (int j = 0; j < 4; ++j) acc[i][j] = __builtin_amdgcn_mfma_f32_16x16x32_bf16(af[i], bfr[j], acc[i][j], 0, 0, 0);
    }
    asm volatile("s_waitcnt vmcnt(0)" ::: "memory");
    __syncthreads();
  }
#undef GSTAGE
}

template <class Epi>
__device__ __forceinline__ void gemm_tile(const bf16_t* __restrict__ A, int lda, const bf16_t* __restrict__ Bt, int ldb,
                                          int K, int m0, int n0, const Epi& epi, char* smem) {
  const int lane = threadIdx.x & 63, w = threadIdx.x >> 6;
  const int wm = w >> 1, wn = w & 1;
  f32x4 acc[4][4];
  gemm_mainloop(A, lda, Bt, ldb, K, m0, n0, acc, smem);
#pragma unroll
  for (int i = 0; i < 4; ++i)
#pragma unroll
    for (int j = 0; j < 4; ++j) {
      int row = m0 + wm * 64 + i * 16 + (lane >> 4) * 4;
      int col = n0 + wn * 64 + j * 16 + (lane & 15);
      epi(row, col, acc[i][j]);
    }
}

struct EpiF32 {
  float* C; int ldc;
  __device__ __forceinline__ void operator()(int row, int col, f32x4 v) const {
#pragma unroll
    for (int r = 0; r < 4; ++r) C[(size_t)(row + r) * ldc + col] = v[r];
  }
};
struct EpiBf16 {
  bf16_t* C; int ldc;
  __device__ __forceinline__ void operator()(int row, int col, f32x4 v) const {
#pragma unroll
    for (int r = 0; r < 4; ++r) C[(size_t)(row + r) * ldc + col] = f2bf(v[r]);
  }
};
struct EpiBf16T {
  bf16_t* Ct; int ldc;
  __device__ __forceinline__ void operator()(int row, int col, f32x4 v) const {
    uint2 pk; pk.x = pack2(v[0], v[1]); pk.y = pack2(v[2], v[3]);
    *reinterpret_cast<uint2*>(Ct + (size_t)col * ldc + row) = pk;
  }
};
struct EpiInProj {
  bf16_t* ABt; bf16_t* z; float* xbcraw; float* dtraw; int seqlen;
  __device__ __forceinline__ void operator()(int row, int col, f32x4 v) const {
    if (col < 2048) {
      int ch = col & 1023, half = col >> 10;
      int b = row / seqlen, l = row - b * seqlen;
      uint2 pk; pk.x = pack2(v[0], v[1]); pk.y = pack2(v[2], v[3]);
      *reinterpret_cast<uint2*>(ABt + ((size_t)(b * 1024 + ch) * 4096 + half * 2048 + l)) = pk;
    } else if (col < 3072) {
#pragma unroll
      for (int r = 0; r < 4; ++r) z[(size_t)(row + r) * 1024 + (col - 2048)] = f2bf(v[r]);
    } else if (col < 4608) {
#pragma unroll
      for (int r = 0; r < 4; ++r) xbcraw[(size_t)(row + r) * DXBC + (col - 3072)] = v[r];
    } else if (col < 4640) {
#pragma unroll
      for (int r = 0; r < 4; ++r) dtraw[(size_t)(row + r) * 32 + (col - 4608)] = v[r];
    }
  }
};

__device__ void adaln_partial_task(const Params& p, int task, float* sm) {
  const int cb = task % 48, ks = task / 48, tid = threadIdx.x;
  float* sc = sm;
  __syncthreads();
  for (int i = tid; i < 5 * 64; i += NTHREADS) {
    int r = i >> 6, kk = i & 63;
    int k = ks * 64 + kk;
    float cv = (r < 4) ? p.c[r * D + k] : p.c_ctx[k];
    sc[i] = silu_f(cv);
  }
  __syncthreads();
  const int col = cb * 256 + tid;
  float a0 = 0, a1 = 0, a2 = 0, a3 = 0, a4 = 0;
  const float* wp = p.w_mod + (size_t)(ks * 64) * NMOD + col;
#pragma unroll 8
  for (int kk = 0; kk < 64; ++kk) {
    float wv = wp[(size_t)kk * NMOD];
    a0 += sc[kk] * wv; a1 += sc[64 + kk] * wv; a2 += sc[128 + kk] * wv; a3 += sc[192 + kk] * wv; a4 += sc[256 + kk] * wv;
  }
  float* pp = p.partial + (size_t)ks * 5 * NMOD + col;
  pp[0] = a0; pp[NMOD] = a1; pp[2 * NMOD] = a2; pp[3 * NMOD] = a3; pp[4 * NMOD] = a4;
}

__device__ void transpose_convert_task(const float* __restrict__ src, int ld, int c0, int rows, bf16_t* __restrict__ dst,
                                       int tr, int tc, float* sm) {
  float (*tile)[65] = reinterpret_cast<float (*)[65]>(sm);
  const int tid = threadIdx.x;
  __syncthreads();
  for (int i = tid; i < 64 * 64; i += NTHREADS) {
    int r = i >> 6, cc = i & 63;
    tile[r][cc] = src[(size_t)(tr * 64 + r) * ld + c0 + tc * 64 + cc];
  }
  __syncthreads();
  for (int i = tid; i < 64 * 32; i += NTHREADS) {
    int cc = i >> 5, r2 = (i & 31) * 2;
    uint32_t pk = pack2(tile[r2][cc], tile[r2 + 1][cc]);
    *reinterpret_cast<uint32_t*>(dst + (size_t)(tc * 64 + cc) * rows + tr * 64 + r2) = pk;
  }
}

__device__ void phase_prep(const Params& p, int bid, int nb, char* smem) {
  float* sm = reinterpret_cast<float*>(smem);
  const int tid = threadIdx.x;
  if (bid == 0 && tid == 0) p.ctr[0] = 0u;
  {
    float* t256 = reinterpret_cast<float*>(smem + 20480);
    float* t2048 = reinterpret_cast<float*>(smem + 24576);
    t256[tid] = cospif((float)tid * (1.0f / 128.f));
    for (int i = tid; i < 2048; i += NTHREADS) t2048[i] = cospif((float)i * (1.0f / 1024.f));
    __syncthreads();
  }
  for (int t = bid; t < 48 * KSPLIT; t += nb) adaln_partial_task(p, t, sm);
  {
    const size_t n16 = (size_t)16384 * D / 16;
    for (size_t i = (size_t)bid * NTHREADS + tid; i < 2 * n16; i += (size_t)nb * NTHREADS) {
      const float* s = (i < n16) ? p.eu : p.ev;
      uint8_t* d = (i < n16) ? p.U8 : p.V8;
      const size_t j = (i < n16) ? i : i - n16;
      uint32_t o[4];
#pragma unroll
      for (int q4 = 0; q4 < 4; ++q4) {
        const float4 v = *reinterpret_cast<const float4*>(s + j * 16 + q4 * 4);
        int pk = 0;
        pk = __builtin_amdgcn_cvt_pk_fp8_f32(v.x * 512.f, v.y * 512.f, pk, false);
        pk = __builtin_amdgcn_cvt_pk_fp8_f32(v.z * 512.f, v.w * 512.f, pk, true);
        o[q4] = (uint32_t)pk;
      }
      *reinterpret_cast<uint4*>(d + j * 16) = uint4{o[0], o[1], o[2], o[3]};
    }
  }
  {
    const int nct = 41, nrt = 32;
    for (int t = bid; t < nct * nrt; t += nb) {
      int tc = t % nct, tr = t / nct;
      if (tc < 40) transpose_convert_task(p.w_in, DIN, 1024, D, p.w_in_t + (size_t)2048 * D, tr, tc, sm);
      else {
        float (*tile)[65] = reinterpret_cast<float (*)[65]>(sm);
        __syncthreads();
        for (int i = tid; i < 64 * 32; i += NTHREADS) {
          int r = i >> 5, cc = i & 31;
          tile[r][cc] = p.w_in[(size_t)(tr * 64 + r) * DIN + 1024 + 2560 + cc];
        }
        __syncthreads();
        for (int i = tid; i < 32 * 32; i += NTHREADS) {
          int cc = i >> 5, r2 = (i & 31) * 2;
          uint32_t pk = pack2(tile[r2][cc], tile[r2 + 1][cc]);
          *reinterpret_cast<uint32_t*>(p.w_in_t + (size_t)(2048 + 2560 + cc) * D + tr * 64 + r2) = pk;
        }
      }
    }
    for (int t = bid; t < 32 * 32; t += nb) transpose_convert_task(p.w_out, D, 0, D, p.w_out_t, t / 32, t % 32, sm);
    for (int t = bid; t < 16 * 32; t += nb) transpose_convert_task(p.w_query, 1024, 0, D, p.w_q_t, t / 16, t % 16, sm);
    for (size_t i = (size_t)bid * NTHREADS + tid; i < (size_t)96 * D / 8; i += (size_t)nb * NTHREADS)
      reinterpret_cast<uint4*>(p.w_in_t + (size_t)4640 * D)[i] = uint4{0, 0, 0, 0};
  }
  for (size_t i = (size_t)bid * NTHREADS + tid; i < (size_t)D * 1024 / 4; i += (size_t)nb * NTHREADS) {
    int k = (int)(i / 256), c4 = (int)(i % 256) * 4;
    float4 v = *reinterpret_cast<const float4*>(p.w_in + (size_t)k * DIN + c4);
    uint2 o; o.x = pack2(v.x, v.y); o.y = pack2(v.z, v.w);
    *reinterpret_cast<uint2*>(p.w_in_f + (size_t)k * 1024 + c4) = o;
  }
  {
    const float* t256 = reinterpret_cast<const float*>(smem + 20480);
    const float scale = 1.0f / sqrtf((float)L * 256.f);
    for (int i = bid * NTHREADS + tid; i < 4 * 256 * 256; i += nb * NTHREADS) {
      int d = i & 255, c = (i >> 8) & 255, g = i >> 16;
      float sc_ = 0.f, ss_ = 0.f;
      const float* wp = p.w_fmix + (size_t)g * 65536 + d;
#pragma unroll 8
      for (int m = 0; m < 256; ++m) {
        const int ph = (m * c) & 255;
        const float wv = wp[m * 256];
        sc_ += t256[ph] * wv; ss_ += t256[(ph - 64) & 255] * wv;
      }
      p.WcsT[((size_t)g * 512 + d) * 256 + c] = f2bf(sc_ * scale);
      p.WcsT[((size_t)g * 512 + 256 + d) * 256 + c] = f2bf(ss_ * scale);
    }
  }
  {
    const float* t2048 = reinterpret_cast<const float*>(smem + 24576);
    for (size_t i = (size_t)bid * NTHREADS + tid; i < (size_t)2048 * 4096 / 8; i += (size_t)nb * NTHREADS) {
      const int k = (int)(i / 512), j = (int)(i % 512) * 8;
      const bool iss = j >= 2048;
      float o[8];
#pragma unroll
      for (int e = 0; e < 8; ++e) {
        const int l = (j + e) & 2047;
        const int ph = (k * l) & 2047;
        o[e] = iss ? -t2048[(ph - 512) & 2047] : t2048[ph];
      }
      uint4 pk; pk.x = pack2(o[0], o[1]); pk.y = pack2(o[2], o[3]); pk.z = pack2(o[4], o[5]); pk.w = pack2(o[6], o[7]);
      *reinterpret_cast<uint4*>(p.dftm + (size_t)k * 4096 + j) = pk;
    }
  }
}

__device__ void phase_fold(const Params& p, int bid, int nb, char* smem) {
  const int tid = threadIdx.x;
  for (int i = bid * NTHREADS + tid; i < 5 * NMOD; i += nb * NTHREADS) {
    int col = i % NMOD;
    float s = p.b_mod[col];
    for (int ks = 0; ks < KSPLIT; ++ks) s += p.partial[(size_t)ks * 5 * NMOD + i];
    p.mod[i] = s;
  }
  for (int t = bid; t < 256; t += nb) {
    int g = t >> 6, tm = (t & 63) >> 2, tn = t & 3;
    int n0 = tn * 128;
    int rowbase = (n0 < 256) ? (g * 256 + n0) : (1024 + g * 256 + (n0 - 256));
    EpiBf16T epi{p.w_in_t + (size_t)(rowbase - n0) * D, D};
    gemm_tile(p.w_in_f + g * 256, 1024, p.WcsT + (size_t)g * 512 * 256, 256, 256, tm * 128, n0, epi, smem);
  }
}

__device__ void phase_norm_mod(const Params& p, int bid, int nb, char* smem) {
  float* red = reinterpret_cast<float*>(smem);
  const int tid = threadIdx.x;
  for (int t = bid; t < T + TC; t += nb) {
    const bool isx = t < T;
    const float* src = isx ? (p.x + (size_t)t * D) : (p.ctx + (size_t)(t - T) * D);
    const int mrow = isx ? (t / L) : 4;
    bf16_t* dst = isx ? (p.hx + (size_t)t * D) : (p.hc + (size_t)(t - T) * D);
    float4 v0 = *reinterpret_cast<const float4*>(src + tid * 8);
    float4 v1 = *reinterpret_cast<const float4*>(src + tid * 8 + 4);
    float ss = v0.x * v0.x + v0.y * v0.y + v0.z * v0.z + v0.w * v0.w + v1.x * v1.x + v1.y * v1.y + v1.z * v1.z + v1.w * v1.w;
    ss = block_sum(ss, red);
    float rstd = rsqrtf(ss * (1.f / D) + EPS);
    const float* sh = p.mod + (size_t)mrow * NMOD + 0 * D + tid * 8;
    const float* sc = p.mod + (size_t)mrow * NMOD + 1 * D + tid * 8;
    const float* g = p.g_pre_mix + tid * 8;
    float vv[8] = {v0.x, v0.y, v0.z, v0.w, v1.x, v1.y, v1.z, v1.w};
    float o[8];
#pragma unroll
    for (int e = 0; e < 8; ++e) o[e] = vv[e] * rstd * g[e] * (1.f + sc[e]) + sh[e];
    uint4 pk; pk.x = pack2(o[0], o[1]); pk.y = pack2(o[2], o[3]); pk.z = pack2(o[4], o[5]); pk.w = pack2(o[6], o[7]);
    *reinterpret_cast<uint4*>(dst + tid * 8) = pk;
  }
}

__device__ void phase_inproj(const Params& p, int bid, int nb, char* smem) {
  const int ntx = 64 * 37, ntc = 8 * 13;
  for (int t = bid; t < ntx + ntc; t += nb) {
    if (t < ntx) {
      int tm = t / 37, tn = t % 37;
      EpiInProj epi{p.ABt, p.z, p.xbcraw, p.dtraw, L};
      gemm_tile(p.hx, D, p.w_in_t, D, D, tm * 128, tn * 128, epi, smem);
    } else {
      int u = t - ntx;
      int tm = u / 13, tn = u % 13;
      EpiInProj epi{nullptr, nullptr, p.xbcraw_c, p.dtraw_c, CTX};
      gemm_tile(p.hc, D, p.w_in_t, D, D, tm * 128, 3072 + tn * 128, epi, smem);
    }
  }
}

__device__ void ssm_pre_tile(const Params& p, int task, char* smem) {
  const bool isx = task < 3072;
  const int u = isx ? task : task - 3072;
  const int ntt = isx ? 32 : 4;
  const int ct = u % 24, tt = (u / 24) % ntt, b = u / (24 * ntt);
  const int seqlen = isx ? L : CTX;
  const float* raw = (isx ? p.xbcraw : p.xbcraw_c) + (size_t)b * seqlen * DXBC;
  const int l0 = tt * 64, c0 = ct * 64, tid = threadIdx.x;
  float (*rt)[65] = reinterpret_cast<float (*)[65]>(smem);
  float (*at)[65] = reinterpret_cast<float (*)[65]>(smem + 66 * 65 * 4);
  __syncthreads();
  for (int i = tid; i < 66 * 64; i += NTHREADS) {
    int r = i >> 6, cc = i & 63, l = l0 - 1 + r;
    rt[r][cc] = (l >= 0 && l < seqlen) ? raw[(size_t)l * DXBC + c0 + cc] : 0.f;
  }
  __syncthreads();
  for (int i = tid; i < 64 * 64; i += NTHREADS) {
    int r = i >> 6, cc = i & 63, c = c0 + cc;
    float acc = p.conv_b[c] + rt[r][cc] * p.conv_w[c] + rt[r + 1][cc] * p.conv_w[DXBC + c] + rt[r + 2][cc] * p.conv_w[2 * DXBC + c];
    at[r][cc] = silu_f(acc);
  }
  __syncthreads();
  const size_t trow0 = isx ? ((size_t)b * L + l0) : ((size_t)T + (size_t)b * CTX + l0);
  for (int i = tid; i < 64 * 32; i += NTHREADS) {
    int r = i >> 5, c2 = (i & 31) * 2;
    *reinterpret_cast<uint32_t*>(p.act_tm + (trow0 + r) * DXBC + c0 + c2) = pack2(at[r][c2], at[r][c2 + 1]);
  }
  if (c0 < 1280) {
    bf16_t* cm = (isx ? p.act_cm_x : p.act_cm_c) + (size_t)b * 1280 * seqlen;
    for (int i = tid; i < 64 * 32; i += NTHREADS) {
      int cc = i >> 5, r2 = (i & 31) * 2;
      *reinterpret_cast<uint32_t*>(cm + (size_t)(c0 + cc) * seqlen + l0 + r2) = pack2(at[r2][cc], at[r2 + 1][cc]);
    }
  }
}
__device__ void phase_ssm_pre(const Params& p, int bid, int nb, char* smem) {
  const int tid = threadIdx.x;
  for (int t = bid; t < 3072 + 384; t += nb) ssm_pre_tile(p, t, smem);
  for (int i = bid * NTHREADS + tid; i < (T + TC) * 32; i += nb * NTHREADS) {
    const bool isx = i < T * 32;
    const int ii = isx ? i : i - T * 32;
    const int t = ii >> 5, j = ii & 31;
    const float v = (isx ? p.dtraw : p.dtraw_c)[ii];
    float* df = isx ? p.dtf : p.dtf_c;
    float* db = isx ? p.dtb : p.dtb_c;
    if (j < 16) df[t * 16 + j] = softplus_f(v + p.dt_bias_f[j]);
    else db[t * 16 + (j - 16)] = softplus_f(v + p.dt_bias_b[j - 16]);
  }
}

__device__ __forceinline__ int swz16(int row, int chunk) { return row * 256 + ((chunk ^ (row & 15)) << 4); }
__device__ __forceinline__ int swz8(int row, int chunk) { return row * 128 + ((chunk ^ (row & 7)) << 4); }

__device__ void ssd_task(const Params& p, int task, char* smem) {
  const int dir = task & 1, h = (task >> 1) & 15, b = task >> 5;
  const int tid = threadIdx.x, lane = tid & 63, w = tid >> 6;
  const int g = h >> 3, lr0 = lane & 15, lq0 = lane >> 4;
  const float a = -__expf(dir ? p.a_log_b[h] : p.a_log_f[h]);
  char* sCc = smem; char* sBc = smem + 16384; char* sBT = smem + 32768; char* sXT = smem + 49152; char* sHb = smem + 57344;
  float* se = reinterpret_cast<float*>(smem + 73728);
  float* sdt = se + 64; float* sw = se + 128; float* sy = se + 192; float* stot = se + 256;
  float* yo = dir ? p.yb : p.yf;
  f32x4 H[8];
#pragma unroll
  for (int j = 0; j < 8; ++j) H[j] = f32x4{0.f, 0.f, 0.f, 0.f};
  __syncthreads();
  for (int i = tid; i < 1024; i += NTHREADS) reinterpret_cast<uint4*>(sHb)[i] = uint4{0, 0, 0, 0};
  for (int step = 0; step < 36; ++step) {
    const bool isctx = step < 4;
    const int nch = isctx ? 4 : 32, ci = isctx ? step : step - 4;
    const int c = dir ? (nch - 1 - ci) : ci;
    const int seqlen = isctx ? CTX : L;
    const size_t trow0 = isctx ? ((size_t)T + (size_t)b * CTX + c * 64) : ((size_t)b * L + c * 64);
    const size_t drow0 = (size_t)b * seqlen + c * 64;
    const float* dtp = isctx ? (dir ? p.dtb_c : p.dtf_c) : (dir ? p.dtb : p.dtf);
    const bf16_t* cm = (isctx ? p.act_cm_c : p.act_cm_x) + (size_t)b * 1280 * seqlen + c * 64;
    int lr = lr0, lq = lq0;
    asm volatile("" : "+v"(lr), "+v"(lq));
    __syncthreads();
    if (w == 0) {
      const float dtv = dtp[(drow0 + lane) * 16 + h];
      float v = a * dtv;
      if (!dir) {
#pragma unroll
        for (int o = 1; o < 64; o <<= 1) { float n = __shfl_up(v, o); v += (lane >= o) ? n : 0.f; }
      } else {
#pragma unroll
        for (int o = 1; o < 64; o <<= 1) { float n = __shfl_down(v, o); v += (lane + o < 64) ? n : 0.f; }
      }
      const float etot = __shfl(v, dir ? 0 : 63);
      se[lane] = v; sdt[lane] = dtv; sw[lane] = dtv * __expf(etot - v); sy[lane] = __expf(v);
      if (lane == 0) stot[0] = etot;
    }
    if (!isctx) {
#pragma unroll
      for (int r = 0; r < 4; ++r) {
        const int id = tid + 256 * r, row = id >> 4, ch = id & 15;
        const bf16_t* src = p.act_tm + (trow0 + row) * DXBC + g * 128 + ch * 8;
        *reinterpret_cast<uint4*>(sCc + swz16(row, ch)) = *reinterpret_cast<const uint4*>(src + 1280);
        *reinterpret_cast<uint4*>(sBc + swz16(row, ch)) = *reinterpret_cast<const uint4*>(src + 1024);
      }
    }
#pragma unroll
    for (int r = 0; r < 4; ++r) {
      const int id = tid + 256 * r, row = id >> 3, ch = id & 7;
      *reinterpret_cast<uint4*>(sBT + swz8(row, ch)) = *reinterpret_cast<const uint4*>(cm + (size_t)(1024 + g * 128 + row) * seqlen + ch * 8);
    }
#pragma unroll
    for (int r = 0; r < 2; ++r) {
      const int id = tid + 256 * r, row = id >> 3, ch = id & 7;
      *reinterpret_cast<uint4*>(sXT + swz8(row, ch)) = *reinterpret_cast<const uint4*>(cm + (size_t)(h * 64 + row) * seqlen + ch * 8);
    }
    __syncthreads();
    const float etot = stot[0];
    if (!isctx) {
      f32x4 G[4];
      bf16x8 ca[4];
#pragma unroll
      for (int j = 0; j < 4; ++j) G[j] = f32x4{0.f, 0.f, 0.f, 0.f};
#pragma unroll
      for (int kk = 0; kk < 4; ++kk) ca[kk] = *reinterpret_cast<const bf16x8*>(sCc + swz16(16 * w + lr, kk * 4 + lq));
#pragma unroll
      for (int kk = 0; kk < 4; ++kk)
#pragma unroll
        for (int j = 0; j < 4; ++j) {
          bf16x8 bb = *reinterpret_cast<const bf16x8*>(sBc + swz16(16 * j + lr, kk * 4 + lq));
          G[j] = __builtin_amdgcn_mfma_f32_16x16x32_bf16(ca[kk], bb, G[j], 0, 0, 0);
        }
      __syncthreads();
      float el[4];
#pragma unroll
      for (int r = 0; r < 4; ++r) el[r] = se[16 * w + lq * 4 + r];
#pragma unroll
      for (int j = 0; j < 4; ++j) {
        const int s_ = 16 * j + lr;
        const float es = se[s_], ds = sdt[s_];
#pragma unroll
        for (int r = 0; r < 4; ++r) {
          const int l = 16 * w + lq * 4 + r;
          const bool keep = dir ? (s_ >= l) : (s_ <= l);
          const float m = keep ? G[j][r] * __expf(el[r] - es) * ds : 0.f;
          *reinterpret_cast<bf16_t*>(sBc + swz8(l, s_ >> 3) + (s_ & 7) * 2) = f2bf(m);
        }
      }
      __syncthreads();
      f32x4 Y[4], Yo[4];
#pragma unroll
      for (int j = 0; j < 4; ++j) { Y[j] = f32x4{0.f, 0.f, 0.f, 0.f}; Yo[j] = f32x4{0.f, 0.f, 0.f, 0.f}; }
#pragma unroll
      for (int kk = 0; kk < 2; ++kk) {
        bf16x8 ma = *reinterpret_cast<const bf16x8*>(sBc + swz8(16 * w + lr, kk * 4 + lq));
#pragma unroll
        for (int j = 0; j < 4; ++j) {
          bf16x8 xb = *reinterpret_cast<const bf16x8*>(sXT + swz8(16 * j + lr, kk * 4 + lq));
          Y[j] = __builtin_amdgcn_mfma_f32_16x16x32_bf16(ma, xb, Y[j], 0, 0, 0);
        }
      }
#pragma unroll
      for (int kk = 0; kk < 4; ++kk)
#pragma unroll
        for (int j = 0; j < 4; ++j) {
          bf16x8 hb = *reinterpret_cast<const bf16x8*>(sHb + swz16(16 * j + lr, kk * 4 + lq));
          Yo[j] = __builtin_amdgcn_mfma_f32_16x16x32_bf16(ca[kk], hb, Yo[j], 0, 0, 0);
        }
      float syl[4];
#pragma unroll
      for (int r = 0; r < 4; ++r) syl[r] = sy[16 * w + lq * 4 + r];
#pragma unroll
      for (int j = 0; j < 4; ++j)
#pragma unroll
        for (int r = 0; r < 4; ++r) {
          const int l = 16 * w + lq * 4 + r;
          yo[(trow0 + l) * 1024 + h * 64 + 16 * j + lr] = Y[j][r] + syl[r] * Yo[j][r];
        }
    }
    {
      const float dec = __expf(etot);
#pragma unroll
      for (int j = 0; j < 8; ++j) H[j] *= dec;
#pragma unroll
      for (int kk = 0; kk < 2; ++kk) {
        bf16x8 xa = *reinterpret_cast<const bf16x8*>(sXT + swz8(16 * w + lr, kk * 4 + lq));
        const int s0 = kk * 32 + lq * 8;
        const float4 w0 = *reinterpret_cast<const float4*>(sw + s0), w1 = *reinterpret_cast<const float4*>(sw + s0 + 4);
        bf16x8 xs;
        xs[0] = (short)f2bf(bf2f((bf16_t)xa[0]) * w0.x); xs[1] = (short)f2bf(bf2f((bf16_t)xa[1]) * w0.y);
        xs[2] = (short)f2bf(bf2f((bf16_t)xa[2]) * w0.z); xs[3] = (short)f2bf(bf2f((bf16_t)xa[3]) * w0.w);
        xs[4] = (short)f2bf(bf2f((bf16_t)xa[4]) * w1.x); xs[5] = (short)f2bf(bf2f((bf16_t)xa[5]) * w1.y);
        xs[6] = (short)f2bf(bf2f((bf16_t)xa[6]) * w1.z); xs[7] = (short)f2bf(bf2f((bf16_t)xa[7]) * w1.w);
#pragma unroll
        for (int j = 0; j < 8; ++j) {
          bf16x8 bt = *reinterpret_cast<const bf16x8*>(sBT + swz8(16 * j + lr, kk * 4 + lq));
          H[j] = __builtin_amdgcn_mfma_f32_16x16x32_bf16(xs, bt, H[j], 0, 0, 0);
        }
      }
    }
    __syncthreads();
#pragma unroll
    for (int j = 0; j < 8; ++j) {
      const int n = 16 * j + lr;
#pragma unroll
      for (int r = 0; r < 4; ++r) {
        const int pr = 16 * w + lq * 4 + r;
        *reinterpret_cast<bf16_t*>(sHb + swz16(pr, n >> 3) + (n & 7) * 2) = f2bf(H[j][r]);
      }
    }
  }
}

__device__ void phase_ssd_dft(const Params& p, int bid, int nb, char* smem) {
  for (int t = bid; t < 128; t += nb) ssd_task(p, t, smem);
  int* stile = reinterpret_cast<int*>(smem + 75776);
  for (;;) {
    __syncthreads();
    if (threadIdx.x == 0) *stile = (int)atomicAdd(p.ctr, 1u);
    __syncthreads();
    const int t = *stile;
    if (t >= 4 * 16 * 8) break;
    int b = t >> 7, tm = (t & 127) >> 3, tn = t & 7;
    EpiBf16 epi{p.ycat + (size_t)b * L * D, D};
    gemm_tile(p.dftm, 4096, p.ABt + (size_t)b * 1024 * 4096, 4096, 4096, tm * 128, tn * 128, epi, smem);
  }
}

__device__ void phase_ssm_post(const Params& p, int bid, int nb, char* smem) {
  float* red = reinterpret_cast<float*>(smem);
  const int tid = threadIdx.x, w = tid >> 6;
  for (int t = bid; t < T; t += nb) {
    const int c0 = tid * 4;
    const int h = c0 >> 6;
    const float dsk = p.d_skip_f[h] + p.d_skip_b[h];
    float4 a = *reinterpret_cast<const float4*>(p.yf + (size_t)t * 1024 + c0);
    float4 bq = *reinterpret_cast<const float4*>(p.yb + (size_t)t * 1024 + c0);
    uint2 xq = *reinterpret_cast<const uint2*>(p.act_tm + (size_t)t * DXBC + c0);
    float xs[4] = {bflo(xq.x), bfhi(xq.x), bflo(xq.y), bfhi(xq.y)};
    uint2 zz = *reinterpret_cast<const uint2*>(p.z + (size_t)t * 1024 + c0);
    float zf[4] = {bflo(zz.x), bfhi(zz.x), bflo(zz.y), bfhi(zz.y)};
    float y[4] = {a.x + bq.x + dsk * xs[0], a.y + bq.y + dsk * xs[1], a.z + bq.z + dsk * xs[2], a.w + bq.w + dsk * xs[3]};
    float ss = 0.f;
#pragma unroll
    for (int e = 0; e < 4; ++e) { y[e] *= silu_f(zf[e]); ss += y[e] * y[e]; }
    ss = wave_sum(ss);
    __syncthreads();
    if ((tid & 63) == 0) red[w] = ss;
    __syncthreads();
    float gs = (w < 2) ? (red[0] + red[1]) : (red[2] + red[3]);
    float rstd = rsqrtf(gs * (1.f / 512.f) + EPS);
    float4 nw = *reinterpret_cast<const float4*>(p.ssm_norm_w + c0);
    uint2 o; o.x = pack2(y[0] * rstd * nw.x, y[1] * rstd * nw.y); o.y = pack2(y[2] * rstd * nw.z, y[3] * rstd * nw.w);
    *reinterpret_cast<uint2*>(p.ycat + (size_t)t * D + 1024 + c0) = o;
  }
}

__device__ void phase_outproj(const Params& p, int bid, int nb, char* smem) {
  for (int t = bid; t < 64 * 16; t += nb) {
    EpiF32 epi{p.y_x, D};
    gemm_tile(p.ycat, D, p.w_out_t, D, D, (t >> 4) * 128, (t & 15) * 128, epi, smem);
  }
}
__device__ void phase_postmix(const Params& p, int bid, int nb, char* smem) {
  float* red = reinterpret_cast<float*>(smem);
  const int tid = threadIdx.x;
  for (int t = bid; t < T; t += nb) {
    const int b = t / L;
    const float* yr = p.y_x + (size_t)t * D + tid * 8;
    const float* xr = p.x + (size_t)t * D + tid * 8;
    float y[8], xv[8];
    *reinterpret_cast<float4*>(y) = *reinterpret_cast<const float4*>(yr);
    *reinterpret_cast<float4*>(y + 4) = *reinterpret_cast<const float4*>(yr + 4);
    *reinterpret_cast<float4*>(xv) = *reinterpret_cast<const float4*>(xr);
    *reinterpret_cast<float4*>(xv + 4) = *reinterpret_cast<const float4*>(xr + 4);
    float ss = 0.f;
#pragma unroll
    for (int e = 0; e < 8; ++e) ss += y[e] * y[e];
    ss = block_sum(ss, red);
    float rstd = rsqrtf(ss * (1.f / D) + EPS);
    const float* gm = p.mod + (size_t)b * NMOD + 2 * D + tid * 8;
    const float* gp = p.g_post_mix + tid * 8;
    float x1[8]; float ss1 = 0.f;
#pragma unroll
    for (int e = 0; e < 8; ++e) { x1[e] = xv[e] + gm[e] * (y[e] * rstd * gp[e]); ss1 += x1[e] * x1[e]; }
    ss1 = block_sum(ss1, red);
    float rstd1 = rsqrtf(ss1 * (1.f / D) + EPS);
    float* o = p.out + (size_t)t * D + tid * 8;
    *reinterpret_cast<float4*>(o) = *reinterpret_cast<float4*>(x1);
    *reinterpret_cast<float4*>(o + 4) = *reinterpret_cast<float4*>(x1 + 4);
    const float* sf = p.mod + (size_t)b * NMOD + 3 * D + tid * 8;
    const float* cf = p.mod + (size_t)b * NMOD + 4 * D + tid * 8;
    const float* gf = p.g_pre_ffn + tid * 8;
    float h2[8];
#pragma unroll
    for (int e = 0; e < 8; ++e) h2[e] = x1[e] * rstd1 * gf[e] * (1.f + cf[e]) + sf[e];
    uint4 pk; pk.x = pack2(h2[0], h2[1]); pk.y = pack2(h2[2], h2[3]); pk.z = pack2(h2[4], h2[5]); pk.w = pack2(h2[6], h2[7]);
    *reinterpret_cast<uint4*>(p.hx + (size_t)t * D + tid * 8) = pk;
  }
}

__device__ __forceinline__ uint32_t mono_key(float f) {
  uint32_t u = __float_as_uint(f);
  return (u & 0x80000000u) ? ~u : (u | 0x80000000u);
}
__device__ __forceinline__ void ins16(uint32_t (&Lk)[16], uint32_t x) {
#pragma unroll
  for (int i = 0; i < 16; ++i) { uint32_t hi = max(Lk[i], x); x = min(Lk[i], x); Lk[i] = hi; }
}
__device__ __forceinline__ float unmono_key(uint32_t k) {
  return __uint_as_float((k & 0x80000000u) ? (k ^ 0x80000000u) : ~k);
}
typedef __attribute__((ext_vector_type(16))) float f32x16;
__device__ void phase_q_route(const Params& p, int bid, int nb, char* smem) {
  const int tid = threadIdx.x, lane = tid & 63, w = tid >> 6;
  const int wm = w >> 1, wn = w & 1, lr = lane & 15, lq = lane >> 4;
  const int l31 = lane & 31, lh = lane >> 5;
  for (int tile = bid; tile < 512; tile += nb) {
    const int h = tile & 7, m0 = (tile >> 3) * 128;
    {
      f32x4 acc[4][4];
      gemm_mainloop(p.hx, D, p.w_q_t, D, D, m0, h * 128, acc, smem);
#pragma unroll
      for (int i = 0; i < 4; ++i)
#pragma unroll
        for (int j = 0; j < 4; ++j)
#pragma unroll
          for (int r = 0; r < 4; ++r) {
            const int row = wm * 64 + i * 16 + lq * 4 + r, col = wn * 64 + j * 16 + lr;
            *reinterpret_cast<bf16_t*>(smem + swz16(row, col >> 3) + (col & 7) * 2) = f2bf(acc[i][j][r]);
          }
    }
#pragma unroll 4
    for (int r = 0; r < 16; ++r) {
      const int id = tid + 256 * r, row = id >> 4, c4 = id & 15;
      const float* src = ((row < 128) ? p.sk1 : p.sk2) + ((size_t)(h * 128 + (row & 127)) * 64 + c4 * 4);
      const float4 v = *reinterpret_cast<const float4*>(src);
      uint2 pk; pk.x = pack2(v.x, v.y); pk.y = pack2(v.z, v.w);
      *reinterpret_cast<uint2*>(smem + 32768 + swz8(row, c4 >> 1) + (c4 & 1) * 8) = pk;
    }
    __syncthreads();
    uint32_t L1[16], L2[16];
#pragma unroll
    for (int sd = 0; sd < 2; ++sd) {
      uint32_t Lk[16];
#pragma unroll
      for (int i = 0; i < 16; ++i) Lk[i] = 0u;
      const uint32_t kb = (uint32_t)(lh * 4);
#pragma unroll
      for (int ih = 0; ih < 2; ++ih) {
        f32x16 Sa[2];
#pragma unroll
        for (int i = 0; i < 2; ++i)
#pragma unroll
          for (int g2 = 0; g2 < 16; ++g2) Sa[i][g2] = 0.f;
#pragma unroll
        for (int ks = 0; ks < 4; ++ks) {
          const bf16x8 qb = *reinterpret_cast<const bf16x8*>(smem + swz16(w * 32 + l31, sd * 8 + ks * 2 + lh));
#pragma unroll
          for (int i = 0; i < 2; ++i) {
            const bf16x8 ka = *reinterpret_cast<const bf16x8*>(smem + 32768 + swz8(sd * 128 + (ih * 2 + i) * 32 + l31, ks * 2 + lh));
            Sa[i] = __builtin_amdgcn_mfma_f32_32x32x16_bf16(ka, qb, Sa[i], 0, 0, 0);
          }
        }
#pragma unroll
        for (int i = 0; i < 2; ++i)
#pragma unroll
          for (int g2 = 0; g2 < 16; ++g2)
            ins16(Lk, (mono_key(Sa[i][g2]) & ~0x7Fu) | (uint32_t)((ih * 2 + i) * 32 + (g2 & 3) + 8 * (g2 >> 2)) | kb);
      }
      uint32_t o[16];
#pragma unroll
      for (int r = 0; r < 16; ++r) o[r] = (uint32_t)__shfl_xor((int)Lk[r], 32);
#pragma unroll
      for (int r = 0; r < 16; ++r) ins16(Lk, o[r]);
#pragma unroll
      for (int r = 0; r < 16; ++r) { if (sd == 0) L1[r] = Lk[r]; else L2[r] = Lk[r]; }
    }
    __syncthreads();
    uint32_t* ib = reinterpret_cast<uint32_t*>(smem) + w * 1088 + l31 * 34;
    if (lh == 0) {
#pragma unroll
      for (int r = 0; r < 16; ++r) { ib[r] = L1[r] & 127u; ib[16 + r] = L2[r] & 127u; }
    }
    float v1[16], v2[16];
#pragma unroll
    for (int r = 0; r < 16; ++r) { v1[r] = unmono_key(L1[r] & ~0x7Fu); v2[r] = unmono_key(L2[r] & ~0x7Fu); }
    uint32_t C[16];
#pragma unroll
    for (int i = 0; i < 16; ++i) C[i] = 0u;
#pragma unroll
    for (int a = 0; a < 16; ++a)
#pragma unroll
      for (int bq = 0; bq < 16; ++bq)
        if ((a + 1) * (bq + 1) <= 16) ins16(C, (mono_key(v1[a] + v2[bq]) & ~0xFFu) | (uint32_t)(a * 16 + bq));
    float ts[16]; int te[16];
    __builtin_amdgcn_wave_barrier();
#pragma unroll
    for (int r = 0; r < 16; ++r) {
      const uint32_t code = C[r] & 0xFFu;
      te[r] = (int)(ib[code >> 4] * 128u + ib[16 + (code & 15u)]);
      ts[r] = unmono_key(C[r] & ~0xFFu);
    }
    const float mx = ts[0];
    float den = 0.f;
#pragma unroll
    for (int r = 0; r < 16; ++r) { ts[r] = __expf(ts[r] - mx); den += ts[r]; }
    const float inv = 1.f / den;
    const size_t ob = (size_t)(m0 + w * 32 + l31) * 128 + h * 16;
    if (lh == 0) {
#pragma unroll
      for (int r = 0; r < 16; r += 4) *reinterpret_cast<int4*>(p.idx + ob + r) = int4{te[r], te[r + 1], te[r + 2], te[r + 3]};
    } else {
#pragma unroll
      for (int r = 0; r < 16; r += 4)
        *reinterpret_cast<float4*>(p.gate + ob + r) = float4{ts[r] * inv, ts[r + 1] * inv, ts[r + 2] * inv, ts[r + 3] * inv};
    }
    __syncthreads();
  }
}

typedef __attribute__((ext_vector_type(2))) float f32x2;
__device__ __forceinline__ void fp8x16_to_f32(const uint4 q, f32x2 (&o)[8]) {
  o[0] = __builtin_amdgcn_cvt_pk_f32_fp8((int)q.x, false); o[1] = __builtin_amdgcn_cvt_pk_f32_fp8((int)q.x, true);
  o[2] = __builtin_amdgcn_cvt_pk_f32_fp8((int)q.y, false); o[3] = __builtin_amdgcn_cvt_pk_f32_fp8((int)q.y, true);
  o[4] = __builtin_amdgcn_cvt_pk_f32_fp8((int)q.z, false); o[5] = __builtin_amdgcn_cvt_pk_f32_fp8((int)q.z, true);
  o[6] = __builtin_amdgcn_cvt_pk_f32_fp8((int)q.w, false); o[7] = __builtin_amdgcn_cvt_pk_f32_fp8((int)q.w, true);
}
__device__ void phase_experts(const Params& p, int bid, int nb) {
  const int lane = threadIdx.x & 63, w = threadIdx.x >> 6;
  for (int t = bid * 4 + w; t < T; t += nb * 4) {
    const int b = t / L;
    f32x2 hf[16];
#pragma unroll
    for (int c = 0; c < 2; ++c)
#pragma unroll
      for (int q2 = 0; q2 < 2; ++q2) {
        const uint4 hq = *reinterpret_cast<const uint4*>(p.hx + (size_t)t * D + c * 1024 + lane * 16 + q2 * 8);
        hf[c * 8 + q2 * 4 + 0] = f32x2{bflo(hq.x), bfhi(hq.x)}; hf[c * 8 + q2 * 4 + 1] = f32x2{bflo(hq.y), bfhi(hq.y)};
        hf[c * 8 + q2 * 4 + 2] = f32x2{bflo(hq.z), bfhi(hq.z)}; hf[c * 8 + q2 * 4 + 3] = f32x2{bflo(hq.w), bfhi(hq.w)};
      }
    f32x2 acc[16];
#pragma unroll
    for (int e = 0; e < 16; ++e) acc[e] = f32x2{0.f, 0.f};
    const int* ip = p.idx + (size_t)t * 128;
    const float* gp = p.gate + (size_t)t * 128;
    for (int j0 = 0; j0 < 128; j0 += 4) {
      int ee[4]; float gg[4];
#pragma unroll
      for (int k = 0; k < 4; ++k) { ee[k] = __builtin_amdgcn_readfirstlane(ip[j0 + k]); gg[k] = gp[j0 + k]; }
      uint4 uq[4][2], vq[4][2];
#pragma unroll
      for (int k = 0; k < 4; ++k)
#pragma unroll
        for (int c = 0; c < 2; ++c) {
          uq[k][c] = *reinterpret_cast<const uint4*>(p.U8 + (size_t)ee[k] * D + c * 1024 + lane * 16);
          vq[k][c] = *reinterpret_cast<const uint4*>(p.V8 + (size_t)ee[k] * D + c * 1024 + lane * 16);
        }
      float dd[4];
#pragma unroll
      for (int k = 0; k < 4; ++k) {
        f32x2 d2 = f32x2{0.f, 0.f};
#pragma unroll
        for (int c = 0; c < 2; ++c) {
          f32x2 uf[8];
          fp8x16_to_f32(uq[k][c], uf);
#pragma unroll
          for (int e = 0; e < 8; ++e) d2 += hf[c * 8 + e] * uf[e];
        }
        dd[k] = d2.x + d2.y;
      }
#pragma unroll
      for (int k = 0; k < 4; ++k) dd[k] = wave_sum(dd[k]) * (1.f / 512.f);
#pragma unroll
      for (int k = 0; k < 4; ++k) {
        const float cf = gg[k] * 0.5f * dd[k] * (1.f + erff(dd[k] * 0.70710678118654752f));
        const f32x2 c2 = f32x2{cf, cf};
#pragma unroll
        for (int c = 0; c < 2; ++c) {
          f32x2 vf[8];
          fp8x16_to_f32(vq[k][c], vf);
#pragma unroll
          for (int e = 0; e < 8; ++e) acc[c * 8 + e] += c2 * vf[e];
        }
      }
    }
    float ss = 0.f;
#pragma unroll
    for (int e = 0; e < 16; ++e) ss += acc[e].x * acc[e].x + acc[e].y * acc[e].y;
    ss = wave_sum(ss);
    const float inv512 = 1.f / 512.f;
    const float rstd = rsqrtf(ss * (inv512 * inv512) * (1.f / D) + EPS) * inv512;
    const float* gfx = p.mod + (size_t)b * NMOD + 5 * D;
#pragma unroll
    for (int c = 0; c < 2; ++c)
#pragma unroll
      for (int q4 = 0; q4 < 4; ++q4) {
        const int e0 = c * 1024 + lane * 16 + q4 * 4;
        float* o = p.out + (size_t)t * D + e0;
        float4 x0 = *reinterpret_cast<const float4*>(o);
        const float4 gA = *reinterpret_cast<const float4*>(gfx + e0);
        const float4 pA = *reinterpret_cast<const float4*>(p.g_post_ffn + e0);
        x0.x += gA.x * acc[c * 8 + q4 * 2 + 0].x * rstd * pA.x; x0.y += gA.y * acc[c * 8 + q4 * 2 + 0].y * rstd * pA.y;
        x0.z += gA.z * acc[c * 8 + q4 * 2 + 1].x * rstd * pA.z; x0.w += gA.w * acc[c * 8 + q4 * 2 + 1].y * rstd * pA.w;
        *reinterpret_cast<float4*>(o) = x0;
      }
  }
}

#define XB_TMO      128
#define XB_XCNT(j)  (256  + 64 * (j))
#define XB_XSUB(j)  (1280 + 64 * (j))
#define XB_XGEN(j)  (2304 + 64 * (j))
#define XB_TOP      3328
#define XB_TOPGEN   3392
#define XCD_BAR_WORDS 3456
#define XB_SPIN_CAP (1u << 22)
#define LAS __attribute__((address_space(3)))
__device__ __forceinline__ unsigned xb_ld(unsigned* p)              { return __hip_atomic_load(p, __ATOMIC_RELAXED, __HIP_MEMORY_SCOPE_AGENT); }
__device__ __forceinline__ unsigned xb_add(unsigned* p, unsigned v) { return __hip_atomic_fetch_add(p, v, __ATOMIC_RELAXED, __HIP_MEMORY_SCOPE_AGENT); }
__device__ __forceinline__ unsigned xb_xcc_id() { return (unsigned)__builtin_amdgcn_s_getreg((3 << 11) | 20) & 0xFu; }
#define XB_SPIN(cond, bar) do { unsigned _sp = 0; while (cond) { __builtin_amdgcn_s_sleep(1); \
    if ((++_sp & 255u) == 0u) { if (xb_ld(&(bar)[XB_TMO])) break; if (_sp > XB_SPIN_CAP) { atomicAdd(&(bar)[XB_TMO], 1u); break; } } } } while (0)
struct XcdBarrier { unsigned* bar; unsigned x; volatile LAS unsigned* st; };
__device__ __forceinline__ XcdBarrier xcd_barrier_post(unsigned* bar, volatile LAS unsigned* st) {
  XcdBarrier b; b.bar = bar; b.x = xb_xcc_id(); b.st = st;
  if (threadIdx.x == 0) (void)xb_add(&bar[XB_XCNT(b.x)], 1u);
  return b;
}
__device__ __forceinline__ void xcd_barrier_complete(unsigned* bar, unsigned x, unsigned& nloc, unsigned& nx) {
  const unsigned G = gridDim.x * gridDim.y * gridDim.z;
  unsigned sum, cnt, mine, sp = 0u;
  for (;;) {
    sum = 0u; cnt = 0u; mine = 0u;
#pragma unroll
    for (unsigned j = 0; j < 16; ++j) { const unsigned c = xb_ld(&bar[XB_XCNT(j)]); sum += c; cnt += (c > 0u) ? 1u : 0u; mine = (j == x) ? c : mine; }
    if (sum == G) break;
    __builtin_amdgcn_s_sleep(1);
    if ((++sp & 255u) == 0u) { if (xb_ld(&bar[XB_TMO])) break; if (sp > XB_SPIN_CAP) { atomicAdd(&bar[XB_TMO], 1u); break; } }
  }
  nloc = mine > 0u ? mine : 1u; nx = cnt > 0u ? cnt : 1u;
}
__device__ __forceinline__ void xcd_barrier(const XcdBarrier& b) {
  asm volatile("s_waitcnt vmcnt(0)" ::: "memory");
  __syncthreads();
  if (threadIdx.x == 0) {
    unsigned* bar = b.bar;
    __builtin_amdgcn_s_waitcnt(0);
    unsigned nloc = b.st[0], nx = b.st[1];
    if (nloc == 0u) { xcd_barrier_complete(bar, b.x, nloc, nx); b.st[0] = nloc; b.st[1] = nx; }
    const unsigned old = xb_add(&bar[XB_XSUB(b.x)], 1u);
    const unsigned gen = old / nloc;
    if (old + 1u == (gen + 1u) * nloc) {
      __builtin_amdgcn_fence(__ATOMIC_RELEASE, "agent");
      asm volatile("s_waitcnt vmcnt(0)" ::: "memory");
      const unsigned og = xb_add(&bar[XB_TOP], 1u);
      const unsigned tg = og / nx;
      if (og + 1u == (tg + 1u) * nx) xb_add(&bar[XB_TOPGEN], 1u);
      else XB_SPIN(xb_ld(&bar[XB_TOPGEN]) == tg, bar);
      __builtin_amdgcn_fence(__ATOMIC_ACQUIRE, "agent");
      xb_add(&bar[XB_XGEN(b.x)], 1u);
      asm volatile("s_waitcnt vmcnt(0)" ::: "memory");
    } else {
      XB_SPIN(xb_ld(&bar[XB_XGEN(b.x)]) == gen, bar);
      __builtin_amdgcn_fence(__ATOMIC_ACQUIRE, "agent");
      asm volatile("s_waitcnt vmcnt(0)" ::: "memory");
    }
  }
  __syncthreads();
}

__global__ void __launch_bounds__(NTHREADS, 2) fwd_mega(Params p) {
  __shared__ __attribute__((aligned(16))) char smem[75808];
  const int bid = blockIdx.x, nb = gridDim.x;
  volatile LAS unsigned* st = (volatile LAS unsigned*)(smem + 75792);
  if (threadIdx.x == 0) { st[0] = 0u; st[1] = 0u; }
  __syncthreads();
  const XcdBarrier bar = xcd_barrier_post(p.bar, st);
  phase_prep(p, bid, nb, smem);        xcd_barrier(bar);
  phase_fold(p, bid, nb, smem);        xcd_barrier(bar);
  phase_norm_mod(p, bid, nb, smem);    xcd_barrier(bar);
  phase_inproj(p, bid, nb, smem);      xcd_barrier(bar);
  phase_ssm_pre(p, bid, nb, smem);     xcd_barrier(bar);
  phase_ssd_dft(p, bid, nb, smem);     xcd_barrier(bar);
  phase_ssm_post(p, bid, nb, smem);    xcd_barrier(bar);
  phase_outproj(p, bid, nb, smem);     xcd_barrier(bar);
  phase_postmix(p, bid, nb, smem);     xcd_barrier(bar);
  phase_q_route(p, bid, nb, smem);     xcd_barrier(bar);
  phase_experts(p, bid, nb);
}

}

extern "C" void kernel_launch(void* const* d_in, const int* in_sizes, int n_in, void* d_out, int out_size, void* d_ws,
                              size_t ws_size, hipStream_t stream) {
  Params p{};
  const float** fp = reinterpret_cast<const float**>(&p);
  for (int i = 0; i < 27; ++i) fp[i] = (const float*)d_in[i];
  p.out = (float*)d_out;
  char* ws = (char*)d_ws;
  size_t off = 0;
  auto take = [&](size_t bytes) { char* r = ws + off; off += (bytes + 255) & ~(size_t)255; return r; };
  p.U8 = (uint8_t*)take((size_t)16384 * D);
  p.V8 = (uint8_t*)take((size_t)16384 * D);
  p.w_in_t = (bf16_t*)take((size_t)NPROJ * D * 2);
  p.w_out_t = (bf16_t*)take((size_t)D * D * 2);
  p.w_q_t = (bf16_t*)take((size_t)1024 * D * 2);
  p.w_in_f = (bf16_t*)take((size_t)D * 1024 * 2);
  p.WcsT = (bf16_t*)take((size_t)4 * 512 * 256 * 2);
  p.dftm = (bf16_t*)take((size_t)2048 * 4096 * 2);
  p.partial = (float*)take((size_t)KSPLIT * 5 * NMOD * 4);
  p.mod = (float*)take((size_t)5 * NMOD * 4);
  p.hx = (bf16_t*)take((size_t)T * D * 2);
  p.hc = (bf16_t*)take((size_t)TC * D * 2);
  p.ABt = (bf16_t*)take((size_t)NB * 1024 * 4096 * 2);
  p.q = (float*)p.ABt;
  p.z = (bf16_t*)take((size_t)T * 1024 * 2);
  char* r1 = take(0);
  p.xbcraw = (float*)take((size_t)T * DXBC * 4);
  p.xbcraw_c = (float*)take((size_t)TC * DXBC * 4);
  p.act_tm = (bf16_t*)take((size_t)(T + TC) * DXBC * 2);
  p.act_cm_x = (bf16_t*)take((size_t)NB * 1280 * L * 2);
  p.act_cm_c = (bf16_t*)take((size_t)NB * 1280 * CTX * 2);
  p.y_x = (float*)r1;
  p.dtraw = (float*)take((size_t)T * 32 * 4);
  p.dtraw_c = (float*)take((size_t)TC * 32 * 4);
  p.dtf = (float*)take((size_t)T * 16 * 4);
  p.dtb = (float*)take((size_t)T * 16 * 4);
  p.dtf_c = (float*)take((size_t)TC * 16 * 4);
  p.dtb_c = (float*)take((size_t)TC * 16 * 4);
  p.yf = (float*)take((size_t)T * 1024 * 4);
  p.yb = (float*)take((size_t)T * 1024 * 4);
  p.ctr = (unsigned*)take(256);
  p.bar = (unsigned*)take((size_t)XCD_BAR_WORDS * 4);
  p.ycat = (bf16_t*)take((size_t)T * D * 2);
  p.idx = (int*)take((size_t)T * 128 * 4);
  p.gate = (float*)take((size_t)T * 128 * 4);
  if (off > ws_size) { fprintf(stderr, "kernel_launch: workspace too small: need %zu have %zu\n", off, ws_size); return; }
  static int grid_blocks = 0;
  if (!grid_blocks) {
    int dev = 0, cus = 0, per_cu = 0;
    hipGetDevice(&dev);
    hipDeviceGetAttribute(&cus, hipDeviceAttributeMultiprocessorCount, dev);
    hipOccupancyMaxActiveBlocksPerMultiprocessor(&per_cu, fwd_mega, NTHREADS, 0);
    if (per_cu > 2) per_cu = 2;
    grid_blocks = cus * per_cu;
    if (grid_blocks <= 0) { fprintf(stderr, "kernel_launch: occupancy query gave %d x %d\n", cus, per_cu); grid_blocks = -1; }
  }
  if (grid_blocks < 0) return;
  (void)hipMemsetAsync(p.bar, 0, (size_t)XCD_BAR_WORDS * 4, stream);
  void* args[] = {&p};
  hipError_t e = hipLaunchCooperativeKernel((void*)fwd_mega, dim3(grid_blocks), dim3(NTHREADS), args, 0, stream);
  if (e != hipSuccess) fprintf(stderr, "cooperative launch failed: %s (grid %d)\n", hipGetErrorString(e), grid_blocks);
}
```

```cpp
#include <hip/hip_runtime.h>
#include <hip/hip_cooperative_groups.h>
#include <stdint.h>
#include <stdio.h>

namespace cg = cooperative_groups;
namespace {

typedef __attribute__((ext_vector_type(8))) short bf16x8;
typedef __attribute__((ext_vector_type(4))) float f32x4;
typedef unsigned short bf16_t;

constexpr int D = 2048, NB = 4, L = 2048, T = NB * L, CTX = 256, TC = NB * CTX;
constexpr int NMOD = 6 * D;
constexpr int NH = 16, HP = 64, NS = 128, DXBC = 1536;
constexpr int DIN = 3616;
constexpr int NPROJ = 4736;
constexpr int KSPLIT = 32;
constexpr float EPS = 1e-6f;
constexpr int NTHREADS = 256;

__device__ __forceinline__ bf16_t f2bf(float f) {
  uint32_t u = __float_as_uint(f);
  u += 0x7fffu + ((u >> 16) & 1u);
  return (bf16_t)(u >> 16);
}
__device__ __forceinline__ float bf2f(bf16_t h) { return __uint_as_float(((uint32_t)h) << 16); }
__device__ __forceinline__ uint32_t pack2(float a, float b) { return (uint32_t)f2bf(a) | ((uint32_t)f2bf(b) << 16); }
__device__ __forceinline__ float bflo(uint32_t w) { return __uint_as_float(w << 16); }
__device__ __forceinline__ float bfhi(uint32_t w) { return __uint_as_float(w & 0xffff0000u); }
__device__ __forceinline__ float silu_f(float v) { return v / (1.f + __expf(-v)); }
__device__ __forceinline__ float softplus_f(float v) { return v > 20.f ? v : log1pf(__expf(v)); }

__device__ __forceinline__ float wave_sum(float v) {
#pragma unroll
  for (int o = 32; o > 0; o >>= 1) v += __shfl_xor(v, o);
  return v;
}
__device__ __forceinline__ float wave_max(float v) {
#pragma unroll
  for (int o = 32; o > 0; o >>= 1) v = fmaxf(v, __shfl_xor(v, o));
  return v;
}
__device__ __forceinline__ float block_sum(float v, float* red) {
  v = wave_sum(v);
  __syncthreads();
  if ((threadIdx.x & 63) == 0) red[threadIdx.x >> 6] = v;
  __syncthreads();
  return red[0] + red[1] + red[2] + red[3];
}

struct Params {
  const float *x, *c, *ctx, *c_ctx, *w_mod, *b_mod, *g_pre_mix, *g_post_mix, *g_pre_ffn, *g_post_ffn;
  const float *w_in, *w_fmix, *conv_w, *conv_b, *dt_bias_f, *dt_bias_b, *a_log_f, *a_log_b, *d_skip_f, *d_skip_b;
  const float *ssm_norm_w, *w_out, *w_query, *sk1, *sk2, *eu, *ev;
  float* out;
  uint8_t *U8, *V8;
  bf16_t *w_in_t, *w_out_t, *w_q_t, *w_in_f, *WcsT, *dftm;
  float *partial, *mod;
  bf16_t *hx, *hc, *ABt, *z;
  float *xbcraw, *xbcraw_c, *dtraw, *dtraw_c, *dtf, *dtb, *dtf_c, *dtb_c;
  bf16_t *act_tm, *act_cm_x, *act_cm_c;
  float *yf, *yb;
  unsigned* ctr; unsigned* bar;
  bf16_t* ycat;
  float *y_x, *q, *gate;
  int* idx;
  int pad0, pad1;
};

__device__ __forceinline__ void gemm_mainloop(const bf16_t* __restrict__ A, int lda, const bf16_t* __restrict__ Bt, int ldb,
                                              int K, int m0, int n0, f32x4 (&acc)[4][4], char* smem) {
  const int tid = threadIdx.x, lane = tid & 63, w = tid >> 6;
  const int wm = w >> 1, wn = w & 1;
#pragma unroll
  for (int i = 0; i < 4; ++i)
#pragma unroll
    for (int j = 0; j < 4; ++j) acc[i][j] = f32x4{0.f, 0.f, 0.f, 0.f};

  const int nk = K / 64;
  const int rowoff = lane >> 3, lch = (lane & 7) ^ rowoff;
  const bf16_t* gA = A + (size_t)(m0 + w * 8 + rowoff) * lda + lch * 8;
  const bf16_t* gB = Bt + (size_t)(n0 + w * 8 + rowoff) * ldb + lch * 8;
#define GSTAGE(buf_, kt_)                                                                                               \
  do {                                                                                                                  \
    _Pragma("unroll") for (int i_ = 0; i_ < 4; ++i_) {                                                                  \
      __builtin_amdgcn_global_load_lds((const unsigned*)(gA + (size_t)(i_ * 32) * lda + (kt_) * 64),                    \
                                       (unsigned*)(smem + (buf_) * 32768 + (i_ * 4 + w) * 1024), 16, 0, 0);             \
      __builtin_amdgcn_global_load_lds((const unsigned*)(gB + (size_t)(i_ * 32) * ldb + (kt_) * 64),                    \
                                       (unsigned*)(smem + (buf_) * 32768 + 16384 + (i_ * 4 + w) * 1024), 16, 0, 0);     \
    }                                                                                                                   \
  } while (0)
  GSTAGE(0, 0);
  asm volatile("s_waitcnt vmcnt(0)" ::: "memory");
  __syncthreads();
  for (int kt = 0; kt < nk; ++kt) {
    const int cur = kt & 1;
    if (kt + 1 < nk) GSTAGE(cur ^ 1, kt + 1);
    const char* sA = smem + cur * 32768;
    const char* sB = sA + 16384;
#pragma unroll
    for (int kk = 0; kk < 2; ++kk) {
      bf16x8 af[4], bfr[4];
      const int ch = kk * 4 + (lane >> 4);
#pragma unroll
      for (int i = 0; i < 4; ++i) {
        int row = wm * 64 + i * 16 + (lane & 15);
        af[i] = *reinterpret_cast<const bf16x8*>(sA + row * 128 + ((ch ^ (row & 7)) << 4));
        int col = wn * 64 + i * 16 + (lane & 15);
        bfr[i] = *reinterpret_cast<const bf16x8*>(sB + col * 128 + ((ch ^ (col & 7)) << 4));
      }
#pragma unroll
      for (int i = 0; i < 4; ++i)
#pragma unroll
        for (int j = 0; j < 4; ++j) acc[i][j] = __builtin_amdgcn_mfma_f32_16x16x32_bf16(af[i], bfr[j], acc[i][j], 0, 0, 0);
    }
    asm volatile("s_waitcnt vmcnt(0)" ::: "memory");
    __syncthreads();
  }
#undef GSTAGE
}

template <class Epi>
__device__ __forceinline__ void gemm_tile(const bf16_t* __restrict__ A, int lda, const bf16_t* __restrict__ Bt, int ldb,
                                          int K, int m0, int n0, const Epi& epi, char* smem) {
  const int lane = threadIdx.x & 63, w = threadIdx.x >> 6;
  const int wm = w >> 1, wn = w & 1;
  f32x4 acc[4][4];
  gemm_mainloop(A, lda, Bt, ldb, K, m0, n0, acc, smem);
#pragma unroll
  for (int i = 0; i < 4; ++i)
#pragma unroll
    for (int j = 0; j < 4; ++j) {
      int row = m0 + wm * 64 + i * 16 + (lane >> 4) * 4;
      int col = n0 + wn * 64 + j * 16 + (lane & 15);
      epi(row, col, acc[i][j]);
    }
}

struct EpiF32 {
  float* C; int ldc;
  __device__ __forceinline__ void operator()(int row, int col, f32x4 v) const {
#pragma unroll
    for (int r = 0; r < 4; ++r) C[(size_t)(row + r) * ldc + col] = v[r];
  }
};
struct EpiBf16 {
  bf16_t* C; int ldc;
  __device__ __forceinline__ void operator()(int row, int col, f32x4 v) const {
#pragma unroll
    for (int r = 0; r < 4; ++r) C[(size_t)(row + r) * ldc + col] = f2bf(v[r]);
  }
};
struct EpiBf16T {
  bf16_t* Ct; int ldc;
  __device__ __forceinline__ void operator()(int row, int col, f32x4 v) const {
    uint2 pk; pk.x = pack2(v[0], v[1]); pk.y = pack2(v[2], v[3]);
    *reinterpret_cast<uint2*>(Ct + (size_t)col * ldc + row) = pk;
  }
};
struct EpiInProj {
  bf16_t* ABt; bf16_t* z; float* xbcraw; float* dtraw; int seqlen;
  __device__ __forceinline__ void operator()(int row, int col, f32x4 v) const {
    if (col < 2048) {
      int ch = col & 1023, half = col >> 10;
      int b = row / seqlen, l = row - b * seqlen;
      uint2 pk; pk.x = pack2(v[0], v[1]); pk.y = pack2(v[2], v[3]);
      *reinterpret_cast<uint2*>(ABt + ((size_t)(b * 1024 + ch) * 4096 + half * 2048 + l)) = pk;
    } else if (col < 3072) {
#pragma unroll
      for (int r = 0; r < 4; ++r) z[(size_t)(row + r) * 1024 + (col - 2048)] = f2bf(v[r]);
    } else if (col < 4608) {
#pragma unroll
      for (int r = 0; r < 4; ++r) xbcraw[(size_t)(row + r) * DXBC + (col - 3072)] = v[r];
    } else if (col < 4640) {
#pragma unroll
      for (int r = 0; r < 4; ++r) dtraw[(size_t)(row + r) * 32 + (col - 4608)] = v[r];
    }
  }
};

__device__ void adaln_partial_task(const Params& p, int task, float* sm) {
  const int cb = task % 48, ks = task / 48, tid = threadIdx.x;
  float* sc = sm;
  __syncthreads();
  for (int i = tid; i < 5 * 64; i += NTHREADS) {
    int r = i >> 6, kk = i & 63;
    int k = ks * 64 + kk;
    float cv = (r < 4) ? p.c[r * D + k] : p.c_ctx[k];
    sc[i] = silu_f(cv);
  }
  __syncthreads();
  const int col = cb * 256 + tid;
  float a0 = 0, a1 = 0, a2 = 0, a3 = 0, a4 = 0;
  const float* wp = p.w_mod + (size_t)(ks * 64) * NMOD + col;
#pragma unroll 8
  for (int kk = 0; kk < 64; ++kk) {
    float wv = wp[(size_t)kk * NMOD];
    a0 += sc[kk] * wv; a1 += sc[64 + kk] * wv; a2 += sc[128 + kk] * wv; a3 += sc[192 + kk] * wv; a4 += sc[256 + kk] * wv;
  }
  float* pp = p.partial + (size_t)ks * 5 * NMOD + col;
  pp[0] = a0; pp[NMOD] = a1; pp[2 * NMOD] = a2; pp[3 * NMOD] = a3; pp[4 * NMOD] = a4;
}

__device__ void transpose_convert_task(const float* __restrict__ src, int ld, int c0, int rows, bf16_t* __restrict__ dst,
                                       int tr, int tc, float* sm) {
  float (*tile)[65] = reinterpret_cast<float (*)[65]>(sm);
  const int tid = threadIdx.x;
  __syncthreads();
  for (int i = tid; i < 64 * 64; i += NTHREADS) {
    int r = i >> 6, cc = i & 63;
    tile[r][cc] = src[(size_t)(tr * 64 + r) * ld + c0 + tc * 64 + cc];
  }
  __syncthreads();
  for (int i = tid; i < 64 * 32; i += NTHREADS) {
    int cc = i >> 5, r2 = (i & 31) * 2;
    uint32_t pk = pack2(tile[r2][cc], tile[r2 + 1][cc]);
    *reinterpret_cast<uint32_t*>(dst + (size_t)(tc * 64 + cc) * rows + tr * 64 + r2) = pk;
  }
}

__device__ void phase_prep(const Params& p, int bid, int nb, char* smem) {
  float* sm = reinterpret_cast<float*>(smem);
  const int tid = threadIdx.x;
  if (bid == 0 && tid < 64) p.ctr[tid] = 0u;
  {
    float* t256 = reinterpret_cast<float*>(smem + 20480);
    float* t2048 = reinterpret_cast<float*>(smem + 24576);
    t256[tid] = cospif((float)tid * (1.0f / 128.f));
    for (int i = tid; i < 2048; i += NTHREADS) t2048[i] = cospif((float)i * (1.0f / 1024.f));
    __syncthreads();
  }
  for (int t = bid; t < 48 * KSPLIT; t += nb) adaln_partial_task(p, t, sm);
  {
    const size_t n16 = (size_t)16384 * D / 16;
    for (size_t i = (size_t)bid * NTHREADS + tid; i < 2 * n16; i += (size_t)nb * NTHREADS) {
      const float* s = (i < n16) ? p.eu : p.ev;
      uint8_t* d = (i < n16) ? p.U8 : p.V8;
      const size_t j = (i < n16) ? i : i - n16;
      uint32_t o[4];
#pragma unroll
      for (int q4 = 0; q4 < 4; ++q4) {
        const float4 v = *reinterpret_cast<const float4*>(s + j * 16 + q4 * 4);
        int pk = 0;
        pk = __builtin_amdgcn_cvt_pk_fp8_f32(v.x * 512.f, v.y * 512.f, pk, false);
        pk = __builtin_amdgcn_cvt_pk_fp8_f32(v.z * 512.f, v.w * 512.f, pk, true);
        o[q4] = (uint32_t)pk;
      }
      *reinterpret_cast<uint4*>(d + j * 16) = uint4{o[0], o[1], o[2], o[3]};
    }
  }
  {
    const int nct = 41, nrt = 32;
    for (int t = bid; t < nct * nrt; t += nb) {
      int tc = t % nct, tr = t / nct;
      if (tc < 40) transpose_convert_task(p.w_in, DIN, 1024, D, p.w_in_t + (size_t)2048 * D, tr, tc, sm);
      else {
        float (*tile)[65] = reinterpret_cast<float (*)[65]>(sm);
        __syncthreads();
        for (int i = tid; i < 64 * 32; i += NTHREADS) {
          int r = i >> 5, cc = i & 31;
          tile[r][cc] = p.w_in[(size_t)(tr * 64 + r) * DIN + 1024 + 2560 + cc];
        }
        __syncthreads();
        for (int i = tid; i < 32 * 32; i += NTHREADS) {
          int cc = i >> 5, r2 = (i & 31) * 2;
          uint32_t pk = pack2(tile[r2][cc], tile[r2 + 1][cc]);
          *reinterpret_cast<uint32_t*>(p.w_in_t + (size_t)(2048 + 2560 + cc) * D + tr * 64 + r2) = pk;
        }
      }
    }
    for (int t = bid; t < 32 * 32; t += nb) transpose_convert_task(p.w_out, D, 0, D, p.w_out_t, t / 32, t % 32, sm);
    for (int t = bid; t < 16 * 32; t += nb) transpose_convert_task(p.w_query, 1024, 0, D, p.w_q_t, t / 16, t % 16, sm);
    for (size_t i = (size_t)bid * NTHREADS + tid; i < (size_t)96 * D / 8; i += (size_t)nb * NTHREADS)
      reinterpret_cast<uint4*>(p.w_in_t + (size_t)4640 * D)[i] = uint4{0, 0, 0, 0};
  }
  for (size_t i = (size_t)bid * NTHREADS + tid; i < (size_t)D * 1024 / 4; i += (size_t)nb * NTHREADS) {
    int k = (int)(i / 256), c4 = (int)(i % 256) * 4;
    float4 v = *reinterpret_cast<const float4*>(p.w_in + (size_t)k * DIN + c4);
    uint2 o; o.x = pack2(v.x, v.y); o.y = pack2(v.z, v.w);
    *reinterpret_cast<uint2*>(p.w_in_f + (size_t)k * 1024 + c4) = o;
  }
  {
    const float* t256 = reinterpret_cast<const float*>(smem + 20480);
    const float scale = 1.0f / sqrtf((float)L * 256.f);
    for (int i = bid * NTHREADS + tid; i < 4 * 256 * 256; i += nb * NTHREADS) {
      int d = i & 255, c = (i >> 8) & 255, g = i >> 16;
      float sc_ = 0.f, ss_ = 0.f;
      const float* wp = p.w_fmix + (size_t)g * 65536 + d;
#pragma unroll 8
      for (int m = 0; m < 256; ++m) {
        const int ph = (m * c) & 255;
        const float wv = wp[m * 256];
        sc_ += t256[ph] * wv; ss_ += t256[(ph - 64) & 255] * wv;
      }
      p.WcsT[((size_t)g * 512 + d) * 256 + c] = f2bf(sc_ * scale);
      p.WcsT[((size_t)g * 512 + 256 + d) * 256 + c] = f2bf(ss_ * scale);
    }
  }
  {
    const float* t2048 = reinterpret_cast<const float*>(smem + 24576);
    for (size_t i = (size_t)bid * NTHREADS + tid; i < (size_t)2048 * 4096 / 8; i += (size_t)nb * NTHREADS) {
      const int k = (int)(i / 512), j = (int)(i % 512) * 8;
      const bool iss = j >= 2048;
      float o[8];
#pragma unroll
      for (int e = 0; e < 8; ++e) {
        const int l = (j + e) & 2047;
        const int ph = (k * l) & 2047;
        o[e] = iss ? -t2048[(ph - 512) & 2047] : t2048[ph];
      }
      uint4 pk; pk.x = pack2(o[0], o[1]); pk.y = pack2(o[2], o[3]); pk.z = pack2(o[4], o[5]); pk.w = pack2(o[6], o[7]);
      *reinterpret_cast<uint4*>(p.dftm + (size_t)k * 4096 + j) = pk;
    }
  }
}

__device__ void phase_fold(const Params& p, int bid, int nb, char* smem) {
  const int tid = threadIdx.x;
  for (int i = bid * NTHREADS + tid; i < 5 * NMOD; i += nb * NTHREADS) {
    int col = i % NMOD;
    float s = p.b_mod[col];
    for (int ks = 0; ks < KSPLIT; ++ks) s += p.partial[(size_t)ks * 5 * NMOD + i];
    p.mod[i] = s;
  }
  for (int t = bid; t < 256; t += nb) {
    int g = t >> 6, tm = (t & 63) >> 2, tn = t & 3;
    int n0 = tn * 128;
    int rowbase = (n0 < 256) ? (g * 256 + n0) : (1024 + g * 256 + (n0 - 256));
    EpiBf16T epi{p.w_in_t + (size_t)(rowbase - n0) * D, D};
    gemm_tile(p.w_in_f + g * 256, 1024, p.WcsT + (size_t)g * 512 * 256, 256, 256, tm * 128, n0, epi, smem);
  }
}

__device__ void phase_norm_mod(const Params& p, int bid, int nb, char* smem) {
  float* red = reinterpret_cast<float*>(smem);
  const int tid = threadIdx.x;
  for (int t = bid; t < T + TC; t += nb) {
    const bool isx = t < T;
    const float* src = isx ? (p.x + (size_t)t * D) : (p.ctx + (size_t)(t - T) * D);
    const int mrow = isx ? (t / L) : 4;
    bf16_t* dst = isx ? (p.hx + (size_t)t * D) : (p.hc + (size_t)(t - T) * D);
    float4 v0 = *reinterpret_cast<const float4*>(src + tid * 8);
    float4 v1 = *reinterpret_cast<const float4*>(src + tid * 8 + 4);
    float ss = v0.x * v0.x + v0.y * v0.y + v0.z * v0.z + v0.w * v0.w + v1.x * v1.x + v1.y * v1.y + v1.z * v1.z + v1.w * v1.w;
    ss = block_sum(ss, red);
    float rstd = rsqrtf(ss * (1.f / D) + EPS);
    const float* sh = p.mod + (size_t)mrow * NMOD + 0 * D + tid * 8;
    const float* sc = p.mod + (size_t)mrow * NMOD + 1 * D + tid * 8;
    const float* g = p.g_pre_mix + tid * 8;
    float vv[8] = {v0.x, v0.y, v0.z, v0.w, v1.x, v1.y, v1.z, v1.w};
    float o[8];
#pragma unroll
    for (int e = 0; e < 8; ++e) o[e] = vv[e] * rstd * g[e] * (1.f + sc[e]) + sh[e];
    uint4 pk; pk.x = pack2(o[0], o[1]); pk.y = pack2(o[2], o[3]); pk.z = pack2(o[4], o[5]); pk.w = pack2(o[6], o[7]);
    *reinterpret_cast<uint4*>(dst + tid * 8) = pk;
  }
}

__device__ void phase_inproj(const Params& p, int bid, int nb, char* smem) {
  const int ntx = 64 * 37, ntc = 8 * 13;
  for (int t = bid; t < ntx + ntc; t += nb) {
    if (t < ntx) {
      int tm = t / 37, tn = t % 37;
      EpiInProj epi{p.ABt, p.z, p.xbcraw, p.dtraw, L};
      gemm_tile(p.hx, D, p.w_in_t, D, D, tm * 128, tn * 128, epi, smem);
    } else {
      int u = t - ntx;
      int tm = u / 13, tn = u % 13;
      EpiInProj epi{nullptr, nullptr, p.xbcraw_c, p.dtraw_c, CTX};
      gemm_tile(p.hc, D, p.w_in_t, D, D, tm * 128, 3072 + tn * 128, epi, smem);
    }
  }
}

__device__ void ssm_pre_tile(const Params& p, int task, char* smem) {
  const bool isx = task < 3072;
  const int u = isx ? task : task - 3072;
  const int ntt = isx ? 32 : 4;
  const int ct = u % 24, tt = (u / 24) % ntt, b = u / (24 * ntt);
  const int seqlen = isx ? L : CTX;
  const float* raw = (isx ? p.xbcraw : p.xbcraw_c) + (size_t)b * seqlen * DXBC;
  const int l0 = tt * 64, c0 = ct * 64, tid = threadIdx.x;
  float (*rt)[65] = reinterpret_cast<float (*)[65]>(smem);
  float (*at)[65] = reinterpret_cast<float (*)[65]>(smem + 66 * 65 * 4);
  __syncthreads();
  for (int i = tid; i < 66 * 64; i += NTHREADS) {
    int r = i >> 6, cc = i & 63, l = l0 - 1 + r;
    rt[r][cc] = (l >= 0 && l < seqlen) ? raw[(size_t)l * DXBC + c0 + cc] : 0.f;
  }
  __syncthreads();
  for (int i = tid; i < 64 * 64; i += NTHREADS) {
    int r = i >> 6, cc = i & 63, c = c0 + cc;
    float acc = p.conv_b[c] + rt[r][cc] * p.conv_w[c] + rt[r + 1][cc] * p.conv_w[DXBC + c] + rt[r + 2][cc] * p.conv_w[2 * DXBC + c];
    at[r][cc] = silu_f(acc);
  }
  __syncthreads();
  const size_t trow0 = isx ? ((size_t)b * L + l0) : ((size_t)T + (size_t)b * CTX + l0);
  for (int i = tid; i < 64 * 32; i += NTHREADS) {
    int r = i >> 5, c2 = (i & 31) * 2;
    *reinterpret_cast<uint32_t*>(p.act_tm + (trow0 + r) * DXBC + c0 + c2) = pack2(at[r][c2], at[r][c2 + 1]);
  }
  if (c0 < 1280) {
    bf16_t* cm = (isx ? p.act_cm_x : p.act_cm_c) + (size_t)b * 1280 * seqlen;
    for (int i = tid; i < 64 * 32; i += NTHREADS) {
      int cc = i >> 5, r2 = (i & 31) * 2;
      *reinterpret_cast<uint32_t*>(cm + (size_t)(c0 + cc) * seqlen + l0 + r2) = pack2(at[r2][cc], at[r2 + 1][cc]);
    }
  }
}
__device__ void phase_ssm_pre(const Params& p, int bid, int nb, char* smem) {
  const int tid = threadIdx.x;
  for (int t = bid; t < 3072 + 384; t += nb) ssm_pre_tile(p, t, smem);
  for (int i = bid * NTHREADS + tid; i < (T + TC) * 32; i += nb * NTHREADS) {
    const bool isx = i < T * 32;
    const int ii = isx ? i : i - T * 32;
    const int t = ii >> 5, j = ii & 31;
    const float v = (isx ? p.dtraw : p.dtraw_c)[ii];
    float* df = isx ? p.dtf : p.dtf_c;
    float* db = isx ? p.dtb : p.dtb_c;
    if (j < 16) df[t * 16 + j] = softplus_f(v + p.dt_bias_f[j]);
    else db[t * 16 + (j - 16)] = softplus_f(v + p.dt_bias_b[j - 16]);
  }
}

__device__ __forceinline__ int swz16(int row, int chunk) { return row * 256 + ((chunk ^ (row & 15)) << 4); }
__device__ __forceinline__ int swz8(int row, int chunk) { return row * 128 + ((chunk ^ (row & 7)) << 4); }

__device__ void ssd_task(const Params& p, int task, char* smem) {
  const int dir = task & 1, h = (task >> 1) & 15, b = task >> 5;
  const int tid = threadIdx.x, lane = tid & 63, w = tid >> 6;
  const int g = h >> 3, lr0 = lane & 15, lq0 = lane >> 4;
  const float a = -__expf(dir ? p.a_log_b[h] : p.a_log_f[h]);
  char* sCc = smem; char* sBc = smem + 16384; char* sBT = smem + 32768; char* sXT = smem + 49152; char* sHb = smem + 57344;
  float* se = reinterpret_cast<float*>(smem + 73728);
  float* sdt = se + 64; float* sw = se + 128; float* sy = se + 192; float* stot = se + 256;
  float* yo = dir ? p.yb : p.yf;
  f32x4 H[8];
#pragma unroll
  for (int j = 0; j < 8; ++j) H[j] = f32x4{0.f, 0.f, 0.f, 0.f};
  __syncthreads();
  for (int i = tid; i < 1024; i += NTHREADS) reinterpret_cast<uint4*>(sHb)[i] = uint4{0, 0, 0, 0};
  for (int step = 0; step < 36; ++step) {
    const bool isctx = step < 4;
    const int nch = isctx ? 4 : 32, ci = isctx ? step : step - 4;
    const int c = dir ? (nch - 1 - ci) : ci;
    const int seqlen = isctx ? CTX : L;
    const size_t trow0 = isctx ? ((size_t)T + (size_t)b * CTX + c * 64) : ((size_t)b * L + c * 64);
    const size_t drow0 = (size_t)b * seqlen + c * 64;
    const float* dtp = isctx ? (dir ? p.dtb_c : p.dtf_c) : (dir ? p.dtb : p.dtf);
    const bf16_t* cm = (isctx ? p.act_cm_c : p.act_cm_x) + (size_t)b * 1280 * seqlen + c * 64;
    int lr = lr0, lq = lq0;
    asm volatile("" : "+v"(lr), "+v"(lq));
    __syncthreads();
    if (w == 0) {
      const float dtv = dtp[(drow0 + lane) * 16 + h];
      float v = a * dtv;
      if (!dir) {
#pragma unroll
        for (int o = 1; o < 64; o <<= 1) { float n = __shfl_up(v, o); v += (lane >= o) ? n : 0.f; }
      } else {
#pragma unroll
        for (int o = 1; o < 64; o <<= 1) { float n = __shfl_down(v, o); v += (lane + o < 64) ? n : 0.f; }
      }
      const float etot = __shfl(v, dir ? 0 : 63);
      se[lane] = v; sdt[lane] = dtv; sw[lane] = dtv * __expf(etot - v); sy[lane] = __expf(v);
      if (lane == 0) stot[0] = etot;
    }
    if (!isctx) {
#pragma unroll
      for (int r = 0; r < 4; ++r) {
        const int id = tid + 256 * r, row = id >> 4, ch = id & 15;
        const bf16_t* src = p.act_tm + (trow0 + row) * DXBC + g * 128 + ch * 8;
        *reinterpret_cast<uint4*>(sCc + swz16(row, ch)) = *reinterpret_cast<const uint4*>(src + 1280);
        *reinterpret_cast<uint4*>(sBc + swz16(row, ch)) = *reinterpret_cast<const uint4*>(src + 1024);
      }
    }
#pragma unroll
    for (int r = 0; r < 4; ++r) {
      const int id = tid + 256 * r, row = id >> 3, ch = id & 7;
      *reinterpret_cast<uint4*>(sBT + swz8(row, ch)) = *reinterpret_cast<const uint4*>(cm + (size_t)(1024 + g * 128 + row) * seqlen + ch * 8);
    }
#pragma unroll
    for (int r = 0; r < 2; ++r) {
      const int id = tid + 256 * r, row = id >> 3, ch = id & 7;
      *reinterpret_cast<uint4*>(sXT + swz8(row, ch)) = *reinterpret_cast<const uint4*>(cm + (size_t)(h * 64 + row) * seqlen + ch * 8);
    }
    __syncthreads();
    const float etot = stot[0];
    if (!isctx) {
      f32x4 G[4];
      bf16x8 ca[4];
#pragma unroll
      for (int j = 0; j < 4; ++j) G[j] = f32x4{0.f, 0.f, 0.f, 0.f};
#pragma unroll
      for (int kk = 0; kk < 4; ++kk) ca[kk] = *reinterpret_cast<const bf16x8*>(sCc + swz16(16 * w + lr, kk * 4 + lq));
#pragma unroll
      for (int kk = 0; kk < 4; ++kk)
#pragma unroll
        for (int j = 0; j < 4; ++j) {
          bf16x8 bb = *reinterpret_cast<const bf16x8*>(sBc + swz16(16 * j + lr, kk * 4 + lq));
          G[j] = __builtin_amdgcn_mfma_f32_16x16x32_bf16(ca[kk], bb, G[j], 0, 0, 0);
        }
      __syncthreads();
      float el[4];
#pragma unroll
      for (int r = 0; r < 4; ++r) el[r] = se[16 * w + lq * 4 + r];
#pragma unroll
      for (int j = 0; j < 4; ++j) {
        const int s_ = 16 * j + lr;
        const float es = se[s_], ds = sdt[s_];
#pragma unroll
        for (int r = 0; r < 4; ++r) {
          const int l = 16 * w + lq * 4 + r;
          const bool keep = dir ? (s_ >= l) : (s_ <= l);
          const float m = keep ? G[j][r] * __expf(el[r] - es) * ds : 0.f;
          *reinterpret_cast<bf16_t*>(sBc + swz8(l, s_ >> 3) + (s_ & 7) * 2) = f2bf(m);
        }
      }
      __syncthreads();
      f32x4 Y[4], Yo[4];
#pragma unroll
      for (int j = 0; j < 4; ++j) { Y[j] = f32x4{0.f, 0.f, 0.f, 0.f}; Yo[j] = f32x4{0.f, 0.f, 0.f, 0.f}; }
#pragma unroll
      for (int kk = 0; kk < 2; ++kk) {
        bf16x8 ma = *reinterpret_cast<const bf16x8*>(sBc + swz8(16 * w + lr, kk * 4 + lq));
#pragma unroll
        for (int j = 0; j < 4; ++j) {
          bf16x8 xb = *reinterpret_cast<const bf16x8*>(sXT + swz8(16 * j + lr, kk * 4 + lq));
          Y[j] = __builtin_amdgcn_mfma_f32_16x16x32_bf16(ma, xb, Y[j], 0, 0, 0);
        }
      }
#pragma unroll
      for (int kk = 0; kk < 4; ++kk)
#pragma unroll
        for (int j = 0; j < 4; ++j) {
          bf16x8 hb = *reinterpret_cast<const bf16x8*>(sHb + swz16(16 * j + lr, kk * 4 + lq));
          Yo[j] = __builtin_amdgcn_mfma_f32_16x16x32_bf16(ca[kk], hb, Yo[j], 0, 0, 0);
        }
      float syl[4];
#pragma unroll
      for (int r = 0; r < 4; ++r) syl[r] = sy[16 * w + lq * 4 + r];
#pragma unroll
      for (int j = 0; j < 4; ++j)
#pragma unroll
        for (int r = 0; r < 4; ++r) {
          const int l = 16 * w + lq * 4 + r;
          yo[(trow0 + l) * 1024 + h * 64 + 16 * j + lr] = Y[j][r] + syl[r] * Yo[j][r];
        }
    }
    {
      const float dec = __expf(etot);
#pragma unroll
      for (int j = 0; j < 8; ++j) H[j] *= dec;
#pragma unroll
      for (int kk = 0; kk < 2; ++kk) {
        bf16x8 xa = *reinterpret_cast<const bf16x8*>(sXT + swz8(16 * w + lr, kk * 4 + lq));
        const int s0 = kk * 32 + lq * 8;
        const float4 w0 = *reinterpret_cast<const float4*>(sw + s0), w1 = *reinterpret_cast<const float4*>(sw + s0 + 4);
        bf16x8 xs;
        xs[0] = (short)f2bf(bf2f((bf16_t)xa[0]) * w0.x); xs[1] = (short)f2bf(bf2f((bf16_t)xa[1]) * w0.y);
        xs[2] = (short)f2bf(bf2f((bf16_t)xa[2]) * w0.z); xs[3] = (short)f2bf(bf2f((bf16_t)xa[3]) * w0.w);
        xs[4] = (short)f2bf(bf2f((bf16_t)xa[4]) * w1.x); xs[5] = (short)f2bf(bf2f((bf16_t)xa[5]) * w1.y);
        xs[6] = (short)f2bf(bf2f((bf16_t)xa[6]) * w1.z); xs[7] = (short)f2bf(bf2f((bf16_t)xa[7]) * w1.w);
#pragma unroll
        for (int j = 0; j < 8; ++j) {
          bf16x8 bt = *reinterpret_cast<const bf16x8*>(sBT + swz8(16 * j + lr, kk * 4 + lq));
          H[j] = __builtin_amdgcn_mfma_f32_16x16x32_bf16(xs, bt, H[j], 0, 0, 0);
        }
      }
    }
    __syncthreads();
#pragma unroll
    for (int j = 0; j < 8; ++j) {
      const int n = 16 * j + lr;
#pragma unroll
      for (int r = 0; r < 4; ++r) {
        const int pr = 16 * w + lq * 4 + r;
        *reinterpret_cast<bf16_t*>(sHb + swz16(pr, n >> 3) + (n & 7) * 2) = f2bf(H[j][r]);
      }
    }
  }
}

__device__ void phase_ssd_dft(const Params& p, int bid, int nb, char* smem) {
  for (int t = bid; t < 128; t += nb) ssd_task(p, t, smem);
  int* stile = reinterpret_cast<int*>(smem + 75776);
  for (;;) {
    __syncthreads();
    if (threadIdx.x == 0) *stile = (int)atomicAdd(p.ctr, 1u);
    __syncthreads();
    const int t = *stile;
    if (t >= 4 * 16 * 8) break;
    int b = t >> 7, tm = (t & 127) >> 3, tn = t & 7;
    EpiBf16 epi{p.ycat + (size_t)b * L * D, D};
    gemm_tile(p.dftm, 4096, p.ABt + (size_t)b * 1024 * 4096, 4096, 4096, tm * 128, tn * 128, epi, smem);
  }
}

__device__ void phase_ssm_post(const Params& p, int bid, int nb, char* smem) {
  float* red = reinterpret_cast<float*>(smem);
  const int tid = threadIdx.x, w = tid >> 6;
  for (int t = bid; t < T; t += nb) {
    const int c0 = tid * 4;
    const int h = c0 >> 6;
    const float dsk = p.d_skip_f[h] + p.d_skip_b[h];
    float4 a = *reinterpret_cast<const float4*>(p.yf + (size_t)t * 1024 + c0);
    float4 bq = *reinterpret_cast<const float4*>(p.yb + (size_t)t * 1024 + c0);
    uint2 xq = *reinterpret_cast<const uint2*>(p.act_tm + (size_t)t * DXBC + c0);
    float xs[4] = {bflo(xq.x), bfhi(xq.x), bflo(xq.y), bfhi(xq.y)};
    uint2 zz = *reinterpret_cast<const uint2*>(p.z + (size_t)t * 1024 + c0);
    float zf[4] = {bflo(zz.x), bfhi(zz.x), bflo(zz.y), bfhi(zz.y)};
    float y[4] = {a.x + bq.x + dsk * xs[0], a.y + bq.y + dsk * xs[1], a.z + bq.z + dsk * xs[2], a.w + bq.w + dsk * xs[3]};
    float ss = 0.f;
#pragma unroll
    for (int e = 0; e < 4; ++e) { y[e] *= silu_f(zf[e]); ss += y[e] * y[e]; }
    ss = wave_sum(ss);
    __syncthreads();
    if ((tid & 63) == 0) red[w] = ss;
    __syncthreads();
    float gs = (w < 2) ? (red[0] + red[1]) : (red[2] + red[3]);
    float rstd = rsqrtf(gs * (1.f / 512.f) + EPS);
    float4 nw = *reinterpret_cast<const float4*>(p.ssm_norm_w + c0);
    uint2 o; o.x = pack2(y[0] * rstd * nw.x, y[1] * rstd * nw.y); o.y = pack2(y[2] * rstd * nw.z, y[3] * rstd * nw.w);
    *reinterpret_cast<uint2*>(p.ycat + (size_t)t * D + 1024 + c0) = o;
  }
}

__device__ void phase_outproj(const Params& p, int bid, int nb, char* smem) {
  for (int t = bid; t < 64 * 16; t += nb) {
    EpiF32 epi{p.y_x, D};
    gemm_tile(p.ycat, D, p.w_out_t, D, D, (t >> 4) * 128, (t & 15) * 128, epi, smem);
  }
}
__device__ void phase_postmix(const Params& p, int bid, int nb, char* smem) {
  float* red = reinterpret_cast<float*>(smem);
  const int tid = threadIdx.x;
  for (int t = bid; t < T; t += nb) {
    const int b = t / L;
    const float* yr = p.y_x + (size_t)t * D + tid * 8;
    const float* xr = p.x + (size_t)t * D + tid * 8;
    float y[8], xv[8];
    *reinterpret_cast<float4*>(y) = *reinterpret_cast<const float4*>(yr);
    *reinterpret_cast<float4*>(y + 4) = *reinterpret_cast<const float4*>(yr + 4);
    *reinterpret_cast<float4*>(xv) = *reinterpret_cast<const float4*>(xr);
    *reinterpret_cast<float4*>(xv + 4) = *reinterpret_cast<const float4*>(xr + 4);
    float ss = 0.f;
#pragma unroll
    for (int e = 0; e < 8; ++e) ss += y[e] * y[e];
    ss = block_sum(ss, red);
    float rstd = rsqrtf(ss * (1.f / D) + EPS);
    const float* gm = p.mod + (size_t)b * NMOD + 2 * D + tid * 8;
    const float* gp = p.g_post_mix + tid * 8;
    float x1[8]; float ss1 = 0.f;
#pragma unroll
    for (int e = 0; e < 8; ++e) { x1[e] = xv[e] + gm[e] * (y[e] * rstd * gp[e]); ss1 += x1[e] * x1[e]; }
    ss1 = block_sum(ss1, red);
    float rstd1 = rsqrtf(ss1 * (1.f / D) + EPS);
    float* o = p.out + (size_t)t * D + tid * 8;
    *reinterpret_cast<float4*>(o) = *reinterpret_cast<float4*>(x1);
    *reinterpret_cast<float4*>(o + 4) = *reinterpret_cast<float4*>(x1 + 4);
    const float* sf = p.mod + (size_t)b * NMOD + 3 * D + tid * 8;
    const float* cf = p.mod + (size_t)b * NMOD + 4 * D + tid * 8;
    const float* gf = p.g_pre_ffn + tid * 8;
    float h2[8];
#pragma unroll
    for (int e = 0; e < 8; ++e) h2[e] = x1[e] * rstd1 * gf[e] * (1.f + cf[e]) + sf[e];
    uint4 pk; pk.x = pack2(h2[0], h2[1]); pk.y = pack2(h2[2], h2[3]); pk.z = pack2(h2[4], h2[5]); pk.w = pack2(h2[6], h2[7]);
    *reinterpret_cast<uint4*>(p.hx + (size_t)t * D + tid * 8) = pk;
  }
}

__device__ __forceinline__ uint32_t mono_key(float f) {
  uint32_t u = __float_as_uint(f);
  return (u & 0x80000000u) ? ~u : (u | 0x80000000u);
}
__device__ __forceinline__ void ins16(uint32_t (&Lk)[16], uint32_t x) {
#pragma unroll
  for (int i = 0; i < 16; ++i) { uint32_t hi = max(Lk[i], x); x = min(Lk[i], x); Lk[i] = hi; }
}
__device__ __forceinline__ float unmono_key(uint32_t k) {
  return __uint_as_float((k & 0x80000000u) ? (k ^ 0x80000000u) : ~k);
}
typedef __attribute__((ext_vector_type(16))) float f32x16;
__device__ void phase_q_route(const Params& p, int bid, int nb, char* smem) {
  const int tid = threadIdx.x, lane = tid & 63, w = tid >> 6;
  const int wm = w >> 1, wn = w & 1, lr = lane & 15, lq = lane >> 4;
  const int l31 = lane & 31, lh = lane >> 5;
  for (int tile = bid; tile < 512; tile += nb) {
    const int h = tile & 7, m0 = (tile >> 3) * 128;
    {
      f32x4 acc[4][4];
      gemm_mainloop(p.hx, D, p.w_q_t, D, D, m0, h * 128, acc, smem);
#pragma unroll
      for (int i = 0; i < 4; ++i)
#pragma unroll
        for (int j = 0; j < 4; ++j)
#pragma unroll
          for (int r = 0; r < 4; ++r) {
            const int row = wm * 64 + i * 16 + lq * 4 + r, col = wn * 64 + j * 16 + lr;
            *reinterpret_cast<bf16_t*>(smem + swz16(row, col >> 3) + (col & 7) * 2) = f2bf(acc[i][j][r]);
          }
    }
#pragma unroll 4
    for (int r = 0; r < 16; ++r) {
      const int id = tid + 256 * r, row = id >> 4, c4 = id & 15;
      const float* src = ((row < 128) ? p.sk1 : p.sk2) + ((size_t)(h * 128 + (row & 127)) * 64 + c4 * 4);
      const float4 v = *reinterpret_cast<const float4*>(src);
      uint2 pk; pk.x = pack2(v.x, v.y); pk.y = pack2(v.z, v.w);
      *reinterpret_cast<uint2*>(smem + 32768 + swz8(row, c4 >> 1) + (c4 & 1) * 8) = pk;
    }
    __syncthreads();
    uint32_t L1[16], L2[16];
#pragma unroll
    for (int sd = 0; sd < 2; ++sd) {
      uint32_t Lk[16];
#pragma unroll
      for (int i = 0; i < 16; ++i) Lk[i] = 0u;
      const uint32_t kb = (uint32_t)(lh * 4);
#pragma unroll
      for (int ih = 0; ih < 2; ++ih) {
        f32x16 Sa[2];
#pragma unroll
        for (int i = 0; i < 2; ++i)
#pragma unroll
          for (int g2 = 0; g2 < 16; ++g2) Sa[i][g2] = 0.f;
#pragma unroll
        for (int ks = 0; ks < 4; ++ks) {
          const bf16x8 qb = *reinterpret_cast<const bf16x8*>(smem + swz16(w * 32 + l31, sd * 8 + ks * 2 + lh));
#pragma unroll
          for (int i = 0; i < 2; ++i) {
            const bf16x8 ka = *reinterpret_cast<const bf16x8*>(smem + 32768 + swz8(sd * 128 + (ih * 2 + i) * 32 + l31, ks * 2 + lh));
            Sa[i] = __builtin_amdgcn_mfma_f32_32x32x16_bf16(ka, qb, Sa[i], 0, 0, 0);
          }
        }
#pragma unroll
        for (int i = 0; i < 2; ++i)
#pragma unroll
          for (int g2 = 0; g2 < 16; ++g2)
            ins16(Lk, (mono_key(Sa[i][g2]) & ~0x7Fu) | (uint32_t)((ih * 2 + i) * 32 + (g2 & 3) + 8 * (g2 >> 2)) | kb);
      }
      uint32_t o[16];
#pragma unroll
      for (int r = 0; r < 16; ++r) o[r] = (uint32_t)__shfl_xor((int)Lk[r], 32);
#pragma unroll
      for (int r = 0; r < 16; ++r) ins16(Lk, o[r]);
#pragma unroll
      for (int r = 0; r < 16; ++r) { if (sd == 0) L1[r] = Lk[r]; else L2[r] = Lk[r]; }
    }
    __syncthreads();
    uint32_t* ib = reinterpret_cast<uint32_t*>(smem) + w * 1088 + l31 * 34;
    if (lh == 0) {
#pragma unroll
      for (int r = 0; r < 16; ++r) { ib[r] = L1[r] & 127u; ib[16 + r] = L2[r] & 127u; }
    }
    float v1[16], v2[16];
#pragma unroll
    for (int r = 0; r < 16; ++r) { v1[r] = unmono_key(L1[r] & ~0x7Fu); v2[r] = unmono_key(L2[r] & ~0x7Fu); }
    uint32_t C[16];
#pragma unroll
    for (int i = 0; i < 16; ++i) C[i] = 0u;
#pragma unroll
    for (int a = 0; a < 16; ++a)
#pragma unroll
      for (int bq = 0; bq < 16; ++bq)
        if ((a + 1) * (bq + 1) <= 16) ins16(C, (mono_key(v1[a] + v2[bq]) & ~0xFFu) | (uint32_t)(a * 16 + bq));
    float ts[16]; int te[16];
    __builtin_amdgcn_wave_barrier();
#pragma unroll
    for (int r = 0; r < 16; ++r) {
      const uint32_t code = C[r] & 0xFFu;
      te[r] = (int)(ib[code >> 4] * 128u + ib[16 + (code & 15u)]);
      ts[r] = unmono_key(C[r] & ~0xFFu);
    }
    const float mx = ts[0];
    float den = 0.f;
#pragma unroll
    for (int r = 0; r < 16; ++r) { ts[r] = __expf(ts[r] - mx); den += ts[r]; }
    const float inv = 1.f / den;
    const size_t ob = (size_t)(m0 + w * 32 + l31) * 128 + h * 16;
    if (lh == 0) {
#pragma unroll
      for (int r = 0; r < 16; r += 4) *reinterpret_cast<int4*>(p.idx + ob + r) = int4{te[r], te[r + 1], te[r + 2], te[r + 3]};
    } else {
#pragma unroll
      for (int r = 0; r < 16; r += 4)
        *reinterpret_cast<float4*>(p.gate + ob + r) = float4{ts[r] * inv, ts[r + 1] * inv, ts[r + 2] * inv, ts[r + 3] * inv};
    }
    __syncthreads();
  }
}

typedef __attribute__((ext_vector_type(2))) float f32x2;
__device__ __forceinline__ void fp8x16_to_f32(const uint4 q, f32x2 (&o)[8]) {
  o[0] = __builtin_amdgcn_cvt_pk_f32_fp8((int)q.x, false); o[1] = __builtin_amdgcn_cvt_pk_f32_fp8((int)q.x, true);
  o[2] = __builtin_amdgcn_cvt_pk_f32_fp8((int)q.y, false); o[3] = __builtin_amdgcn_cvt_pk_f32_fp8((int)q.y, true);
  o[4] = __builtin_amdgcn_cvt_pk_f32_fp8((int)q.z, false); o[5] = __builtin_amdgcn_cvt_pk_f32_fp8((int)q.z, true);
  o[6] = __builtin_amdgcn_cvt_pk_f32_fp8((int)q.w, false); o[7] = __builtin_amdgcn_cvt_pk_f32_fp8((int)q.w, true);
}
template <int CTRL>
__device__ __forceinline__ float dpp_mov(float v) {
  return __int_as_float(__builtin_amdgcn_update_dpp(0, __float_as_int(v), CTRL, 0xF, 0xF, true));
}
__device__ __forceinline__ unsigned my_xcc_id() { return (unsigned)__builtin_amdgcn_s_getreg((3 << 11) | 20) & 7u; }

__device__ void phase_exp_u(const Params& p, char* smem) {
  const int tid = threadIdx.x, lane = tid & 63, w = tid >> 6;
  const int sub = lane >> 4, cc = lane & 15;
  const unsigned myx = my_xcc_id();
  int* sh = reinterpret_cast<int*>(smem);
  int* si = reinterpret_cast<int*>(smem + 64) + w * 256;
  float* pbuf = reinterpret_cast<float*>(p.ycat);
  for (unsigned qi = 0; qi < 8; ++qi) {
    const unsigned x = (myx + qi) & 7u;
    for (;;) {
      __syncthreads();
      if (tid == 0) sh[0] = (int)atomicAdd(&p.ctr[16 + x], 1u);
      __syncthreads();
      const int chunk = sh[0];
      if (chunk >= 512) break;
      for (int tt = 0; tt < 4; ++tt) {
        const int t = chunk * 16 + w * 4 + tt;
        __builtin_amdgcn_wave_barrier();
        si[lane] = p.idx[(size_t)t * 128 + lane]; si[64 + lane] = p.idx[(size_t)t * 128 + 64 + lane];
        __builtin_amdgcn_wave_barrier();
        f32x2 hf[8];
#pragma unroll
        for (int q2 = 0; q2 < 2; ++q2) {
          const uint4 hq = *reinterpret_cast<const uint4*>(p.hx + (size_t)t * D + x * 256 + cc * 16 + q2 * 8);
          hf[q2 * 4 + 0] = f32x2{bflo(hq.x), bfhi(hq.x)}; hf[q2 * 4 + 1] = f32x2{bflo(hq.y), bfhi(hq.y)};
          hf[q2 * 4 + 2] = f32x2{bflo(hq.z), bfhi(hq.z)}; hf[q2 * 4 + 3] = f32x2{bflo(hq.w), bfhi(hq.w)};
        }
        const uint8_t* ub = p.U8 + x * 256 + cc * 16;
#pragma unroll 1
        for (int j0 = 0; j0 < 32; j0 += 16) {
          uint4 uq[16];
#pragma unroll
          for (int k = 0; k < 16; ++k) uq[k] = *reinterpret_cast<const uint4*>(ub + (size_t)si[(j0 + k) * 4 + sub] * D);
          float mine = 0.f;
#pragma unroll
          for (int k = 0; k < 16; ++k) {
            f32x2 uf[8];
            fp8x16_to_f32(uq[k], uf);
            f32x2 d2 = hf[0] * uf[0];
#pragma unroll
            for (int e = 1; e < 8; ++e) d2 += hf[e] * uf[e];
            float d = d2.x + d2.y;
            d += dpp_mov<0xB1>(d); d += dpp_mov<0x4E>(d); d += dpp_mov<0x124>(d); d += dpp_mov<0x128>(d);
            mine = (cc == k) ? d : mine;
          }
          pbuf[((size_t)x * T + t) * 128 + (j0 + cc) * 4 + sub] = mine * (1.f / 512.f);
        }
      }
    }
  }
}

__device__ void phase_exp_v(const Params& p, char* smem) {
  const int tid = threadIdx.x, lane = tid & 63, w = tid >> 6;
  const int sub = lane >> 4, cc = lane & 15;
  const unsigned myx = my_xcc_id();
  int* sh = reinterpret_cast<int*>(smem);
  int* si = reinterpret_cast<int*>(smem + 64) + w * 256;
  float* sc = reinterpret_cast<float*>(si + 128);
  float* yf = p.y_x;
  for (unsigned qi = 0; qi < 8; ++qi) {
    const unsigned x = (myx + qi) & 7u;
    for (;;) {
      __syncthreads();
      if (tid == 0) sh[0] = (int)atomicAdd(&p.ctr[32 + x], 1u);
      __syncthreads();
      const int chunk = sh[0];
      if (chunk >= 512) break;
      for (int tt = 0; tt < 4; ++tt) {
        const int t = chunk * 16 + w * 4 + tt;
        __builtin_amdgcn_wave_barrier();
        si[lane] = p.idx[(size_t)t * 128 + lane]; si[64 + lane] = p.idx[(size_t)t * 128 + 64 + lane];
        {
          const float* pb = reinterpret_cast<const float*>(p.ycat) + (size_t)t * 128;
          float d0 = 0.f, d1 = 0.f;
#pragma unroll
          for (int xs = 0; xs < 8; ++xs) { d0 += pb[(size_t)xs * T * 128 + lane]; d1 += pb[(size_t)xs * T * 128 + 64 + lane]; }
          sc[lane] = p.gate[(size_t)t * 128 + lane] * 0.5f * d0 * (1.f + erff(d0 * 0.70710678118654752f));
          sc[64 + lane] = p.gate[(size_t)t * 128 + 64 + lane] * 0.5f * d1 * (1.f + erff(d1 * 0.70710678118654752f));
        }
        __builtin_amdgcn_wave_barrier();
        f32x2 acc[8];
#pragma unroll
        for (int e = 0; e < 8; ++e) acc[e] = f32x2{0.f, 0.f};
        const uint8_t* vb = p.V8 + x * 256 + cc * 16;
#pragma unroll 1
        for (int j0 = 0; j0 < 32; j0 += 16) {
          uint4 vq[16]; float cf[16];
#pragma unroll
          for (int k = 0; k < 16; ++k) {
            const int j = (j0 + k) * 4 + sub;
            vq[k] = *reinterpret_cast<const uint4*>(vb + (size_t)si[j] * D);
            cf[k] = sc[j];
          }
#pragma unroll
          for (int k = 0; k < 16; ++k) {
            f32x2 vf[8];
            fp8x16_to_f32(vq[k], vf);
            const f32x2 c2 = f32x2{cf[k], cf[k]};
#pragma unroll
            for (int e = 0; e < 8; ++e) acc[e] += c2 * vf[e];
          }
        }
        {
          float* red = reinterpret_cast<float*>(smem + 8192) + w * 1280;
          float* mr = red + (sub * 16 + cc) * 20;
#pragma unroll
          for (int q4 = 0; q4 < 4; ++q4)
            *reinterpret_cast<float4*>(mr + q4 * 4) = float4{acc[q4 * 2].x, acc[q4 * 2].y, acc[q4 * 2 + 1].x, acc[q4 * 2 + 1].y};
          __builtin_amdgcn_wave_barrier();
          const int part = sub;
          float4 r0 = *reinterpret_cast<const float4*>(red + (0 * 16 + cc) * 20 + part * 4);
          float4 r1 = *reinterpret_cast<const float4*>(red + (1 * 16 + cc) * 20 + part * 4);
          float4 r2 = *reinterpret_cast<const float4*>(red + (2 * 16 + cc) * 20 + part * 4);
          float4 r3 = *reinterpret_cast<const float4*>(red + (3 * 16 + cc) * 20 + part * 4);
          const float sc512 = 1.f / 512.f;
          float4 o4 = float4{(r0.x + r1.x + r2.x + r3.x) * sc512, (r0.y + r1.y + r2.y + r3.y) * sc512,
                             (r0.z + r1.z + r2.z + r3.z) * sc512, (r0.w + r1.w + r2.w + r3.w) * sc512};
          *reinterpret_cast<float4*>(yf + (size_t)t * D + x * 256 + cc * 16 + part * 4) = o4;
          __builtin_amdgcn_wave_barrier();
        }
      }
    }
  }
}

__device__ void phase_exp_final(const Params& p, int bid, int nb, char* smem) {
  float* red = reinterpret_cast<float*>(smem);
  const int tid = threadIdx.x;
  const float* yf = p.y_x;
  for (int t = bid; t < T; t += nb) {
    const int b = t / L;
    const float* yr = yf + (size_t)t * D + tid * 8;
    float y[8];
    *reinterpret_cast<float4*>(y) = *reinterpret_cast<const float4*>(yr);
    *reinterpret_cast<float4*>(y + 4) = *reinterpret_cast<const float4*>(yr + 4);
    float ss = 0.f;
#pragma unroll
    for (int e = 0; e < 8; ++e) ss += y[e] * y[e];
    ss = block_sum(ss, red);
    const float rstd = rsqrtf(ss * (1.f / D) + EPS);
    const float* gfx = p.mod + (size_t)b * NMOD + 5 * D + tid * 8;
    const float* gp = p.g_post_ffn + tid * 8;
    float* o = p.out + (size_t)t * D + tid * 8;
    float xo[8];
    *reinterpret_cast<float4*>(xo) = *reinterpret_cast<const float4*>(o);
    *reinterpret_cast<float4*>(xo + 4) = *reinterpret_cast<const float4*>(o + 4);
#pragma unroll
    for (int e = 0; e < 8; ++e) xo[e] += gfx[e] * (y[e] * rstd * gp[e]);
    *reinterpret_cast<float4*>(o) = *reinterpret_cast<float4*>(xo);
    *reinterpret_cast<float4*>(o + 4) = *reinterpret_cast<float4*>(xo + 4);
  }
}

#define XB_TMO      128
#define XB_XCNT(j)  (256  + 64 * (j))
#define XB_XSUB(j)  (1280 + 64 * (j))
#define XB_XGEN(j)  (2304 + 64 * (j))
#define XB_TOP      3328
#define XB_TOPGEN   3392
#define XCD_BAR_WORDS 3456
#define XB_SPIN_CAP (1u << 22)
#define LAS __attribute__((address_space(3)))
__device__ __forceinline__ unsigned xb_ld(unsigned* p)              { return __hip_atomic_load(p, __ATOMIC_RELAXED, __HIP_MEMORY_SCOPE_AGENT); }
__device__ __forceinline__ unsigned xb_add(unsigned* p, unsigned v) { return __hip_atomic_fetch_add(p, v, __ATOMIC_RELAXED, __HIP_MEMORY_SCOPE_AGENT); }
__device__ __forceinline__ unsigned xb_xcc_id() { return (unsigned)__builtin_amdgcn_s_getreg((3 << 11) | 20) & 0xFu; }
#define XB_SPIN(cond, bar) do { unsigned _sp = 0; while (cond) { __builtin_amdgcn_s_sleep(1); \
    if ((++_sp & 255u) == 0u) { if (xb_ld(&(bar)[XB_TMO])) break; if (_sp > XB_SPIN_CAP) { atomicAdd(&(bar)[XB_TMO], 1u); break; } } } } while (0)
struct XcdBarrier { unsigned* bar; unsigned x; volatile LAS unsigned* st; };
__device__ __forceinline__ XcdBarrier xcd_barrier_post(unsigned* bar, volatile LAS unsigned* st) {
  XcdBarrier b; b.bar = bar; b.x = xb_xcc_id(); b.st = st;
  if (threadIdx.x == 0) (void)xb_add(&bar[XB_XCNT(b.x)], 1u);
  return b;
}
__device__ __forceinline__ void xcd_barrier_complete(unsigned* bar, unsigned x, unsigned& nloc, unsigned& nx) {
  const unsigned G = gridDim.x * gridDim.y * gridDim.z;
  unsigned sum, cnt, mine, sp = 0u;
  for (;;) {
    sum = 0u; cnt = 0u; mine = 0u;
#pragma unroll
    for (unsigned j = 0; j < 16; ++j) { const unsigned c = xb_ld(&bar[XB_XCNT(j)]); sum += c; cnt += (c > 0u) ? 1u : 0u; mine = (j == x) ? c : mine; }
    if (sum == G) break;
    __builtin_amdgcn_s_sleep(1);
    if ((++sp & 255u) == 0u) { if (xb_ld(&bar[XB_TMO])) break; if (sp > XB_SPIN_CAP) { atomicAdd(&bar[XB_TMO], 1u); break; } }
  }
  nloc = mine > 0u ? mine : 1u; nx = cnt > 0u ? cnt : 1u;
}
__device__ __forceinline__ void xcd_barrier(const XcdBarrier& b) {
  asm volatile("s_waitcnt vmcnt(0)" ::: "memory");
  __syncthreads();
  if (threadIdx.x == 0) {
    unsigned* bar = b.bar;
    __builtin_amdgcn_s_waitcnt(0);
    unsigned nloc = b.st[0], nx = b.st[1];
    if (nloc == 0u) { xcd_barrier_complete(bar, b.x, nloc, nx); b.st[0] = nloc; b.st[1] = nx; }
    const unsigned old = xb_add(&bar[XB_XSUB(b.x)], 1u);
    const unsigned gen = old / nloc;
    if (old + 1u == (gen + 1u) * nloc) {
      __builtin_amdgcn_fence(__ATOMIC_RELEASE, "agent");
      asm volatile("s_waitcnt vmcnt(0)" ::: "memory");
      const unsigned og = xb_add(&bar[XB_TOP], 1u);
      const unsigned tg = og / nx;
      if (og + 1u == (tg + 1u) * nx) xb_add(&bar[XB_TOPGEN], 1u);
      else XB_SPIN(xb_ld(&bar[XB_TOPGEN]) == tg, bar);
      __builtin_amdgcn_fence(__ATOMIC_ACQUIRE, "agent");
      xb_add(&bar[XB_XGEN(b.x)], 1u);
      asm volatile("s_waitcnt vmcnt(0)" ::: "memory");
    } else {
      XB_SPIN(xb_ld(&bar[XB_XGEN(b.x)]) == gen, bar);
      __builtin_amdgcn_fence(__ATOMIC_ACQUIRE, "agent");
      asm volatile("s_waitcnt vmcnt(0)" ::: "memory");
    }
  }
  __syncthreads();
}

__global__ void __launch_bounds__(NTHREADS, 2) fwd_mega(Params p) {
  __shared__ __attribute__((aligned(16))) char smem[75808];
  const int bid = blockIdx.x, nb = gridDim.x;
  volatile LAS unsigned* st = (volatile LAS unsigned*)(smem + 75792);
  if (threadIdx.x == 0) { st[0] = 0u; st[1] = 0u; }
  __syncthreads();
  const XcdBarrier bar = xcd_barrier_post(p.bar, st);
  phase_prep(p, bid, nb, smem);        xcd_barrier(bar);
  phase_fold(p, bid, nb, smem);        xcd_barrier(bar);
  phase_norm_mod(p, bid, nb, smem);    xcd_barrier(bar);
  phase_inproj(p, bid, nb, smem);      xcd_barrier(bar);
  phase_ssm_pre(p, bid, nb, smem);     xcd_barrier(bar);
  phase_ssd_dft(p, bid, nb, smem);     xcd_barrier(bar);
  phase_ssm_post(p, bid, nb, smem);    xcd_barrier(bar);
  phase_outproj(p, bid, nb, smem);     xcd_barrier(bar);
  phase_postmix(p, bid, nb, smem);     xcd_barrier(bar);
  phase_q_route(p, bid, nb, smem);     xcd_barrier(bar);
  phase_exp_u(p, smem);                xcd_barrier(bar);
  phase_exp_v(p, smem);                xcd_barrier(bar);
  phase_exp_final(p, bid, nb, smem);
}

}

extern "C" void kernel_launch(void* const* d_in, const int* in_sizes, int n_in, void* d_out, int out_size, void* d_ws,
                              size_t ws_size, hipStream_t stream) {
  Params p{};
  const float** fp = reinterpret_cast<const float**>(&p);
  for (int i = 0; i < 27; ++i) fp[i] = (const float*)d_in[i];
  p.out = (float*)d_out;
  char* ws = (char*)d_ws;
  size_t off = 0;
  auto take = [&](size_t bytes) { char* r = ws + off; off += (bytes + 255) & ~(size_t)255; return r; };
  p.U8 = (uint8_t*)take((size_t)16384 * D);
  p.V8 = (uint8_t*)take((size_t)16384 * D);
  p.w_in_t = (bf16_t*)take((size_t)NPROJ * D * 2);
  p.w_out_t = (bf16_t*)take((size_t)D * D * 2);
  p.w_q_t = (bf16_t*)take((size_t)1024 * D * 2);
  p.w_in_f = (bf16_t*)take((size_t)D * 1024 * 2);
  p.WcsT = (bf16_t*)take((size_t)4 * 512 * 256 * 2);
  p.dftm = (bf16_t*)take((size_t)2048 * 4096 * 2);
  p.partial = (float*)take((size_t)KSPLIT * 5 * NMOD * 4);
  p.mod = (float*)take((size_t)5 * NMOD * 4);
  p.hx = (bf16_t*)take((size_t)T * D * 2);
  p.hc = (bf16_t*)take((size_t)TC * D * 2);
  p.ABt = (bf16_t*)take((size_t)NB * 1024 * 4096 * 2);
  p.q = (float*)p.ABt;
  p.z = (bf16_t*)take((size_t)T * 1024 * 2);
  char* r1 = take(0);
  p.xbcraw = (float*)take((size_t)T * DXBC * 4);
  p.xbcraw_c = (float*)take((size_t)TC * DXBC * 4);
  p.act_tm = (bf16_t*)take((size_t)(T + TC) * DXBC * 2);
  p.act_cm_x = (bf16_t*)take((size_t)NB * 1280 * L * 2);
  p.act_cm_c = (bf16_t*)take((size_t)NB * 1280 * CTX * 2);
  p.y_x = (float*)r1;
  p.dtraw = (float*)take((size_t)T * 32 * 4);
  p.dtraw_c = (float*)take((size_t)TC * 32 * 4);
  p.dtf = (float*)take((size_t)T * 16 * 4);
  p.dtb = (float*)take((size_t)T * 16 * 4);
  p.dtf_c = (float*)take((size_t)TC * 16 * 4);
  p.dtb_c = (float*)take((size_t)TC * 16 * 4);
  p.yf = (float*)take((size_t)T * 1024 * 4);
  p.yb = (float*)take((size_t)T * 1024 * 4);
  p.ctr = (unsigned*)take(256);
  p.bar = (unsigned*)take((size_t)XCD_BAR_WORDS * 4);
  p.ycat = (bf16_t*)take((size_t)T * D * 2);
  p.idx = (int*)take((size_t)T * 128 * 4);
  p.gate = (float*)take((size_t)T * 128 * 4);
  if (off > ws_size) { fprintf(stderr, "kernel_launch: workspace too small: need %zu have %zu\n", off, ws_size); return; }
  static int grid_blocks = 0;
  if (!grid_blocks) {
    int dev = 0, cus = 0, per_cu = 0;
    hipGetDevice(&dev);
    hipDeviceGetAttribute(&cus, hipDeviceAttributeMultiprocessorCount, dev);
    hipOccupancyMaxActiveBlocksPerMultiprocessor(&per_cu, fwd_mega, NTHREADS, 0);
    if (per_cu > 2) per_cu = 2;
    grid_blocks = cus * per_cu;
    if (grid_blocks <= 0) { fprintf(stderr, "kernel_launch: occupancy query gave %d x %d\n", cus, per_cu); grid_blocks = -1; }
  }
  if (grid_blocks < 0) return;
  (void)hipMemsetAsync(p.bar, 0, (size_t)XCD_BAR_WORDS * 4, stream);
  void* args[] = {&p};
  hipError_t e = hipLaunchCooperativeKernel((void*)fwd_mega, dim3(grid_blocks), dim3(NTHREADS), args, 0, stream);
  if (e != hipSuccess) fprintf(stderr, "cooperative launch failed: %s (grid %d)\n", hipGetErrorString(e), grid_blocks);
}
```

```cpp
#include <hip/hip_runtime.h>
#include <hip/hip_cooperative_groups.h>
#include <stdint.h>
#include <stdio.h>

namespace cg = cooperative_groups;
namespace {

typedef __attribute__((ext_vector_type(8))) short bf16x8;
typedef __attribute__((ext_vector_type(4))) float f32x4;
typedef unsigned short bf16_t;

constexpr int D = 2048, NB = 4, L = 2048, T = NB * L, CTX = 256, TC = NB * CTX;
constexpr int NMOD = 6 * D;
constexpr int NH = 16, HP = 64, NS = 128, DXBC = 1536;
constexpr int DIN = 3616;
constexpr int NPROJ = 4736;
constexpr int KSPLIT = 32;
constexpr float EPS = 1e-6f;
constexpr int NTHREADS = 256;

__device__ __forceinline__ bf16_t f2bf(float f) {
  uint32_t u = __float_as_uint(f);
  u += 0x7fffu + ((u >> 16) & 1u);
  return (bf16_t)(u >> 16);
}
__device__ __forceinline__ float bf2f(bf16_t h) { return __uint_as_float(((uint32_t)h) << 16); }
__device__ __forceinline__ uint32_t pack2(float a, float b) { return (uint32_t)f2bf(a) | ((uint32_t)f2bf(b) << 16); }
__device__ __forceinline__ float bflo(uint32_t w) { return __uint_as_float(w << 16); }
__device__ __forceinline__ float bfhi(uint32_t w) { return __uint_as_float(w & 0xffff0000u); }
__device__ __forceinline__ float silu_f(float v) { return v / (1.f + __expf(-v)); }
__device__ __forceinline__ float softplus_f(float v) { return v > 20.f ? v : log1pf(__expf(v)); }

__device__ __forceinline__ int opaque_tid() { int t = threadIdx.x; asm volatile("" : "+v"(t)); return t; }
__device__ __forceinline__ float wave_sum(float v) {
#pragma unroll
  for (int o = 32; o > 0; o >>= 1) v += __shfl_xor(v, o);
  return v;
}
__device__ __forceinline__ float wave_max(float v) {
#pragma unroll
  for (int o = 32; o > 0; o >>= 1) v = fmaxf(v, __shfl_xor(v, o));
  return v;
}
__device__ __forceinline__ float block_sum(float v, float* red) {
  v = wave_sum(v);
  __syncthreads();
  if ((threadIdx.x & 63) == 0) red[threadIdx.x >> 6] = v;
  __syncthreads();
  return red[0] + red[1] + red[2] + red[3];
}

struct Params {
  const float *x, *c, *ctx, *c_ctx, *w_mod, *b_mod, *g_pre_mix, *g_post_mix, *g_pre_ffn, *g_post_ffn;
  const float *w_in, *w_fmix, *conv_w, *conv_b, *dt_bias_f, *dt_bias_b, *a_log_f, *a_log_b, *d_skip_f, *d_skip_b;
  const float *ssm_norm_w, *w_out, *w_query, *sk1, *sk2, *eu, *ev;
  float* out;
  uint8_t *U8, *V8;
  bf16_t *w_in_t, *w_out_t, *w_q_t, *w_in_f, *WcsT, *dftm, *Fs;
  float *partial, *mod;
  bf16_t *hx, *hc, *ABt, *z;
  float *xbcraw, *xbcraw_c, *dtraw, *dtraw_c, *dtf, *dtb, *dtf_c, *dtb_c;
  bf16_t *act_tm, *act_cm_x, *act_cm_c;
  float *yf, *yb;
  unsigned* ctr; unsigned* bar;
  bf16_t* ycat;
  float *y_x, *q, *gate;
  int* idx;
  int pad0, pad1;
};

__device__ __forceinline__ void gemm_mainloop(const bf16_t* __restrict__ A, int lda, const bf16_t* __restrict__ Bt, int ldb,
                                              int K, int m0, int n0, f32x4 (&acc)[4][4], char* smem) {
  const int tid = opaque_tid(), lane = tid & 63, w = tid >> 6;
  const int wm = w >> 1, wn = w & 1;
#pragma unroll
  for (int i = 0; i < 4; ++i)
#pragma unroll
    for (int j = 0; j < 4; ++j) acc[i][j] = f32x4{0.f, 0.f, 0.f, 0.f};

  const int nk = K / 64;
  const int rowoff = lane >> 3, lch = (lane & 7) ^ rowoff;
  const bf16_t* gA = A + (size_t)(m0 + w * 8 + rowoff) * lda + lch * 8;
  const bf16_t* gB = Bt + (size_t)(n0 + w * 8 + rowoff) * ldb + lch * 8;
#define GSTAGE(buf_, kt_)                                                                                               \
  do {                                                                                                                  \
    _Pragma("unroll") for (int i_ = 0; i_ < 4; ++i_) {                                                                  \
      __builtin_amdgcn_global_load_lds((const unsigned*)(gA + (size_t)(i_ * 32) * lda + (kt_) * 64),                    \
                                       (unsigned*)(smem + (buf_) * 32768 + (i_ * 4 + w) * 1024), 16, 0, 0);             \
      __builtin_amdgcn_global_load_lds((const unsigned*)(gB + (size_t)(i_ * 32) * ldb + (kt_) * 64),                    \
                                       (unsigned*)(smem + (buf_) * 32768 + 16384 + (i_ * 4 + w) * 1024), 16, 0, 0);     \
    }                                                                                                                   \
  } while (0)
  GSTAGE(0, 0);
  asm volatile("s_waitcnt vmcnt(0)" ::: "memory");
  __syncthreads();
  for (int kt = 0; kt < nk; ++kt) {
    const int cur = kt & 1;
    if (kt + 1 < nk) GSTAGE(cur ^ 1, kt + 1);
    const char* sA = smem + cur * 32768;
    const char* sB = sA + 16384;
#pragma unroll
    for (int kk = 0; kk < 2; ++kk) {
      bf16x8 af[4], bfr[4];
      const int ch = kk * 4 + (lane >> 4);
#pragma unroll
      for (int i = 0; i < 4; ++i) {
        int row = wm * 64 + i * 16 + (lane & 15);
        af[i] = *reinterpret_cast<const bf16x8*>(sA + row * 128 + ((ch ^ (row & 7)) << 4));
        int col = wn * 64 + i * 16 + (lane & 15);
        bfr[i] = *reinterpret_cast<const bf16x8*>(sB + col * 128 + ((ch ^ (col & 7)) << 4));
      }
#pragma unroll
      for (int i = 0; i < 4; ++i)
#pragma unroll
        for (int j = 0; j < 4; ++j) acc[i][j] = __builtin_amdgcn_mfma_f32_16x16x32_bf16(af[i], bfr[j], acc[i][j], 0, 0, 0);
    }
    asm volatile("s_waitcnt vmcnt(0)" ::: "memory");
    __syncthreads();
  }
#undef GSTAGE
}

template <class Epi>
__device__ __forceinline__ void gemm_tile(const bf16_t* __restrict__ A, int lda, const bf16_t* __restrict__ Bt, int ldb,
                                          int K, int m0, int n0, const Epi& epi, char* smem) {
  const int lane = threadIdx.x & 63, w = threadIdx.x >> 6;
  const int wm = w >> 1, wn = w & 1;
  f32x4 acc[4][4];
  gemm_mainloop(A, lda, Bt, ldb, K, m0, n0, acc, smem);
#pragma unroll
  for (int i = 0; i < 4; ++i)
#pragma unroll
    for (int j = 0; j < 4; ++j) {
      int row = m0 + wm * 64 + i * 16 + (lane >> 4) * 4;
      int col = n0 + wn * 64 + j * 16 + (lane & 15);
      epi(row, col, acc[i][j]);
    }
}

struct EpiF32 {
  float* C; int ldc;
  __device__ __forceinline__ void operator()(int row, int col, f32x4 v) const {
#pragma unroll
    for (int r = 0; r < 4; ++r) C[(size_t)(row + r) * ldc + col] = v[r];
  }
};
struct EpiBf16 {
  bf16_t* C; int ldc;
  __device__ __forceinline__ void operator()(int row, int col, f32x4 v) const {
#pragma unroll
    for (int r = 0; r < 4; ++r) C[(size_t)(row + r) * ldc + col] = f2bf(v[r]);
  }
};
struct EpiBf16T {
  bf16_t* Ct; int ldc;
  __device__ __forceinline__ void operator()(int row, int col, f32x4 v) const {
    uint2 pk; pk.x = pack2(v[0], v[1]); pk.y = pack2(v[2], v[3]);
    *reinterpret_cast<uint2*>(Ct + (size_t)col * ldc + row) = pk;
  }
};
struct EpiInProj {
  bf16_t* ABt; bf16_t* z; float* xbcraw; float* dtraw; int seqlen;
  __device__ __forceinline__ void operator()(int row, int col, f32x4 v) const {
    if (col < 2048) {
      int ch = col & 1023, half = col >> 10;
      int b = row / seqlen, l = row - b * seqlen;
      uint2 pk; pk.x = pack2(v[0], v[1]); pk.y = pack2(v[2], v[3]);
      *reinterpret_cast<uint2*>(ABt + ((size_t)(b * 1024 + ch) * 4096 + half * 2048 + l)) = pk;
    } else if (col < 3072) {
#pragma unroll
      for (int r = 0; r < 4; ++r) z[(size_t)(row + r) * 1024 + (col - 2048)] = f2bf(v[r]);
    } else if (col < 4608) {
#pragma unroll
      for (int r = 0; r < 4; ++r) xbcraw[(size_t)(row + r) * DXBC + (col - 3072)] = v[r];
    } else if (col < 4640) {
#pragma unroll
      for (int r = 0; r < 4; ++r) dtraw[(size_t)(row + r) * 32 + (col - 4608)] = v[r];
    }
  }
};

__device__ void adaln_partial_task(const Params& p, int task, float* sm) {
  const int cb = task % 48, ks = task / 48, tid = threadIdx.x;
  float* sc = sm;
  __syncthreads();
  for (int i = tid; i < 5 * 64; i += NTHREADS) {
    int r = i >> 6, kk = i & 63;
    int k = ks * 64 + kk;
    float cv = (r < 4) ? p.c[r * D + k] : p.c_ctx[k];
    sc[i] = silu_f(cv);
  }
  __syncthreads();
  const int col = cb * 256 + tid;
  float a0 = 0, a1 = 0, a2 = 0, a3 = 0, a4 = 0;
  const float* wp = p.w_mod + (size_t)(ks * 64) * NMOD + col;
#pragma unroll 8
  for (int kk = 0; kk < 64; ++kk) {
    float wv = wp[(size_t)kk * NMOD];
    a0 += sc[kk] * wv; a1 += sc[64 + kk] * wv; a2 += sc[128 + kk] * wv; a3 += sc[192 + kk] * wv; a4 += sc[256 + kk] * wv;
  }
  float* pp = p.partial + (size_t)ks * 5 * NMOD + col;
  pp[0] = a0; pp[NMOD] = a1; pp[2 * NMOD] = a2; pp[3 * NMOD] = a3; pp[4 * NMOD] = a4;
}

__device__ void transpose_convert_task(const float* __restrict__ src, int ld, int c0, int rows, bf16_t* __restrict__ dst,
                                       int tr, int tc, float* sm) {
  float (*tile)[65] = reinterpret_cast<float (*)[65]>(sm);
  const int tid = threadIdx.x;
  __syncthreads();
  for (int i = tid; i < 64 * 64; i += NTHREADS) {
    int r = i >> 6, cc = i & 63;
    tile[r][cc] = src[(size_t)(tr * 64 + r) * ld + c0 + tc * 64 + cc];
  }
  __syncthreads();
  for (int i = tid; i < 64 * 32; i += NTHREADS) {
    int cc = i >> 5, r2 = (i & 31) * 2;
    uint32_t pk = pack2(tile[r2][cc], tile[r2 + 1][cc]);
    *reinterpret_cast<uint32_t*>(dst + (size_t)(tc * 64 + cc) * rows + tr * 64 + r2) = pk;
  }
}

__device__ void phase_prep(const Params& p, int bid, int nb, char* smem) {
  float* sm = reinterpret_cast<float*>(smem);
  const int tid = threadIdx.x;
  if (bid == 0 && tid < 64) p.ctr[tid] = 0u;
  {
    float* t256 = reinterpret_cast<float*>(smem + 20480);
    float* t2048 = reinterpret_cast<float*>(smem + 24576);
    t256[tid] = cospif((float)tid * (1.0f / 128.f));
    for (int i = tid; i < 2048; i += NTHREADS) t2048[i] = cospif((float)i * (1.0f / 1024.f));
    __syncthreads();
  }
  for (int t = bid; t < 48 * KSPLIT; t += nb) adaln_partial_task(p, t, sm);
  {
    const int nct = 41, nrt = 32;
    for (int t = bid; t < nct * nrt; t += nb) {
      int tc = t % nct, tr = t / nct;
      if (tc < 40) transpose_convert_task(p.w_in, DIN, 1024, D, p.w_in_t + (size_t)2048 * D, tr, tc, sm);
      else {
        float (*tile)[65] = reinterpret_cast<float (*)[65]>(sm);
        __syncthreads();
        for (int i = tid; i < 64 * 32; i += NTHREADS) {
          int r = i >> 5, cc = i & 31;
          tile[r][cc] = p.w_in[(size_t)(tr * 64 + r) * DIN + 1024 + 2560 + cc];
        }
        __syncthreads();
        for (int i = tid; i < 32 * 32; i += NTHREADS) {
          int cc = i >> 5, r2 = (i & 31) * 2;
          uint32_t pk = pack2(tile[r2][cc], tile[r2 + 1][cc]);
          *reinterpret_cast<uint32_t*>(p.w_in_t + (size_t)(2048 + 2560 + cc) * D + tr * 64 + r2) = pk;
        }
      }
    }
    for (size_t i = (size_t)bid * NTHREADS + tid; i < (size_t)96 * D / 8; i += (size_t)nb * NTHREADS)
      reinterpret_cast<uint4*>(p.w_in_t + (size_t)4640 * D)[i] = uint4{0, 0, 0, 0};
  }
  for (size_t i = (size_t)bid * NTHREADS + tid; i < (size_t)D * 1024 / 4; i += (size_t)nb * NTHREADS) {
    int k = (int)(i / 256), c4 = (int)(i % 256) * 4;
    float4 v = *reinterpret_cast<const float4*>(p.w_in + (size_t)k * DIN + c4);
    uint2 o; o.x = pack2(v.x, v.y); o.y = pack2(v.z, v.w);
    *reinterpret_cast<uint2*>(p.w_in_f + (size_t)k * 1024 + c4) = o;
  }
  {
    const float* t256 = reinterpret_cast<const float*>(smem + 20480);
    const float scale = 1.0f / sqrtf((float)L * 256.f);
    for (int i = bid * NTHREADS + tid; i < 4 * 256 * 256; i += nb * NTHREADS) {
      int d = i & 255, c = (i >> 8) & 255, g = i >> 16;
      float sc_ = 0.f, ss_ = 0.f;
      const float* wp = p.w_fmix + (size_t)g * 65536 + d;
#pragma unroll 8
      for (int m = 0; m < 256; ++m) {
        const int ph = (m * c) & 255;
        const float wv = wp[m * 256];
        sc_ += t256[ph] * wv; ss_ += t256[(ph - 64) & 255] * wv;
      }
      p.WcsT[((size_t)g * 512 + d) * 256 + c] = f2bf(sc_ * scale);
      p.WcsT[((size_t)g * 512 + 256 + d) * 256 + c] = f2bf(ss_ * scale);
    }
  }
  {
    const float* t2048 = reinterpret_cast<const float*>(smem + 24576);
    for (size_t i = (size_t)bid * NTHREADS + tid; i < (size_t)1024 * 2048 / 8; i += (size_t)nb * NTHREADS) {
      const int k = (int)(i / 256), j = (int)(i % 256) * 8;
      const bool iss = j >= 1024;
      float o[8];
#pragma unroll
      for (int e = 0; e < 8; ++e) {
        const int l = (j + e) & 1023;
        const int ph = (k * l) & 2047;
        o[e] = iss ? t2048[(ph - 512) & 2047] : t2048[ph];
      }
      uint4 pk; pk.x = pack2(o[0], o[1]); pk.y = pack2(o[2], o[3]); pk.z = pack2(o[4], o[5]); pk.w = pack2(o[6], o[7]);
      *reinterpret_cast<uint4*>(p.dftm + (size_t)k * 2048 + j) = pk;
    }
  }
}

__device__ void phase_fold(const Params& p, int bid, int nb, char* smem) {
  const int tid = threadIdx.x;
  for (int i = bid * NTHREADS + tid; i < 5 * NMOD; i += nb * NTHREADS) {
    int col = i % NMOD;
    float s = p.b_mod[col];
    for (int ks = 0; ks < KSPLIT; ++ks) s += p.partial[(size_t)ks * 5 * NMOD + i];
    p.mod[i] = s;
  }
  for (int t = bid; t < 256; t += nb) {
    int g = t >> 6, tm = (t & 63) >> 2, tn = t & 3;
    int n0 = tn * 128;
    int rowbase = (n0 < 256) ? (g * 256 + n0) : (1024 + g * 256 + (n0 - 256));
    EpiBf16T epi{p.w_in_t + (size_t)(rowbase - n0) * D, D};
    gemm_tile(p.w_in_f + g * 256, 1024, p.WcsT + (size_t)g * 512 * 256, 256, 256, tm * 128, n0, epi, smem);
  }
}

__device__ void phase_norm_mod(const Params& p, int bid, int nb, char* smem) {
  float* red = reinterpret_cast<float*>(smem);
  const int tid = threadIdx.x;
  for (int t = bid; t < T + TC; t += nb) {
    const bool isx = t < T;
    const float* src = isx ? (p.x + (size_t)t * D) : (p.ctx + (size_t)(t - T) * D);
    const int mrow = isx ? (t / L) : 4;
    bf16_t* dst = isx ? (p.hx + (size_t)t * D) : (p.hc + (size_t)(t - T) * D);
    float4 v0 = *reinterpret_cast<const float4*>(src + tid * 8);
    float4 v1 = *reinterpret_cast<const float4*>(src + tid * 8 + 4);
    float ss = v0.x * v0.x + v0.y * v0.y + v0.z * v0.z + v0.w * v0.w + v1.x * v1.x + v1.y * v1.y + v1.z * v1.z + v1.w * v1.w;
    ss = block_sum(ss, red);
    float rstd = rsqrtf(ss * (1.f / D) + EPS);
    const float* sh = p.mod + (size_t)mrow * NMOD + 0 * D + tid * 8;
    const float* sc = p.mod + (size_t)mrow * NMOD + 1 * D + tid * 8;
    const float* g = p.g_pre_mix + tid * 8;
    float vv[8] = {v0.x, v0.y, v0.z, v0.w, v1.x, v1.y, v1.z, v1.w};
    float o[8];
#pragma unroll
    for (int e = 0; e < 8; ++e) o[e] = vv[e] * rstd * g[e] * (1.f + sc[e]) + sh[e];
    uint4 pk; pk.x = pack2(o[0], o[1]); pk.y = pack2(o[2], o[3]); pk.z = pack2(o[4], o[5]); pk.w = pack2(o[6], o[7]);
    *reinterpret_cast<uint4*>(dst + tid * 8) = pk;
  }
}

__device__ __forceinline__ void convert_uv_units(const Params& p, size_t u0, size_t u1) {
  const size_t n16 = (size_t)16384 * D / 16;
  for (size_t i = u0 + threadIdx.x; i < u1; i += NTHREADS) {
    const float* s = (i < n16) ? p.eu : p.ev;
    uint8_t* d = (i < n16) ? p.U8 : p.V8;
    const size_t j = (i < n16) ? i : i - n16;
    uint32_t o[4];
#pragma unroll
    for (int q4 = 0; q4 < 4; ++q4) {
      const float4 v = *reinterpret_cast<const float4*>(s + j * 16 + q4 * 4);
      int pk = 0;
      pk = __builtin_amdgcn_cvt_pk_fp8_f32(v.x * 512.f, v.y * 512.f, pk, false);
      pk = __builtin_amdgcn_cvt_pk_fp8_f32(v.z * 512.f, v.w * 512.f, pk, true);
      o[q4] = (uint32_t)pk;
    }
    *reinterpret_cast<uint4*>(d + j * 16) = uint4{o[0], o[1], o[2], o[3]};
  }
}
__device__ void phase_inproj(const Params& p, int bid, int nb, char* smem) {
  const int ntx = 64 * 37, ntc = 8 * 13;
  for (int t = bid; t < ntx + ntc; t += nb) {
    if (t < ntx) {
      int tm = t / 37, tn = t % 37;
      EpiInProj epi{p.ABt, p.z, p.xbcraw, p.dtraw, L};
      gemm_tile(p.hx, D, p.w_in_t, D, D, tm * 128, tn * 128, epi, smem);
    } else {
      int u = t - ntx;
      int tm = u / 13, tn = u % 13;
      EpiInProj epi{nullptr, nullptr, p.xbcraw_c, p.dtraw_c, CTX};
      gemm_tile(p.hc, D, p.w_in_t, D, D, tm * 128, 3072 + tn * 128, epi, smem);
    }
  }
}

__device__ void ssm_pre_tile(const Params& p, int task, char* smem) {
  const bool isx = task < 3072;
  const int u = isx ? task : task - 3072;
  const int ntt = isx ? 32 : 4;
  const int ct = u % 24, tt = (u / 24) % ntt, b = u / (24 * ntt);
  const int seqlen = isx ? L : CTX;
  const float* raw = (isx ? p.xbcraw : p.xbcraw_c) + (size_t)b * seqlen * DXBC;
  const int l0 = tt * 64, c0 = ct * 64, tid = threadIdx.x;
  float (*rt)[65] = reinterpret_cast<float (*)[65]>(smem);
  float (*at)[65] = reinterpret_cast<float (*)[65]>(smem + 66 * 65 * 4);
  __syncthreads();
  for (int i = tid; i < 66 * 64; i += NTHREADS) {
    int r = i >> 6, cc = i & 63, l = l0 - 1 + r;
    rt[r][cc] = (l >= 0 && l < seqlen) ? raw[(size_t)l * DXBC + c0 + cc] : 0.f;
  }
  __syncthreads();
  for (int i = tid; i < 64 * 64; i += NTHREADS) {
    int r = i >> 6, cc = i & 63, c = c0 + cc;
    float acc = p.conv_b[c] + rt[r][cc] * p.conv_w[c] + rt[r + 1][cc] * p.conv_w[DXBC + c] + rt[r + 2][cc] * p.conv_w[2 * DXBC + c];
    at[r][cc] = silu_f(acc);
  }
  __syncthreads();
  const size_t trow0 = isx ? ((size_t)b * L + l0) : ((size_t)T + (size_t)b * CTX + l0);
  for (int i = tid; i < 64 * 32; i += NTHREADS) {
    int r = i >> 5, c2 = (i & 31) * 2;
    *reinterpret_cast<uint32_t*>(p.act_tm + (trow0 + r) * DXBC + c0 + c2) = pack2(at[r][c2], at[r][c2 + 1]);
  }
  if (c0 < 1280) {
    bf16_t* cm = (isx ? p.act_cm_x : p.act_cm_c) + (size_t)b * 1280 * seqlen;
    for (int i = tid; i < 64 * 32; i += NTHREADS) {
      int cc = i >> 5, r2 = (i & 31) * 2;
      *reinterpret_cast<uint32_t*>(cm + (size_t)(c0 + cc) * seqlen + l0 + r2) = pack2(at[r2][cc], at[r2 + 1][cc]);
    }
  }
}
__device__ void dft_fold_rows(const Params& p, int bid, int nb) {
  const int lane = threadIdx.x & 63, w = threadIdx.x >> 6;
  for (int row = bid * 4 + w; row < NB * 1024; row += nb * 4) {
    const bf16_t* A = p.ABt + (size_t)row * 4096;
    const bf16_t* Bv = A + 2048;
    bf16_t* F = p.Fs + (size_t)row * 2048;
    float alt = 0.f;
#pragma unroll 4
    for (int i = 0; i < 16; ++i) {
      const int l = i * 64 + lane;
      const float a = bf2f(A[l]), bb = bf2f(Bv[l]);
      const float ar = (l == 0) ? 0.f : bf2f(A[2048 - l]), br = (l == 0) ? bb : bf2f(Bv[2048 - l]);
      const float as = a + ar, bs = bb - br;
      F[l] = f2bf(as); F[1024 + l] = f2bf(bs);
      alt += (l & 1) ? -as : as;
    }
    alt = wave_sum(alt) + bf2f(A[1024]);
    if (lane == 0) { const int b = row >> 10, ch = row & 1023; p.ycat[((size_t)b * L + 1024) * D + ch] = f2bf(alt); }
  }
}
__device__ void phase_ssm_pre(const Params& p, int bid, int nb, char* smem) {
  const int tid = threadIdx.x;
  dft_fold_rows(p, bid, nb);
  for (int t = bid; t < 3072 + 384; t += nb) ssm_pre_tile(p, t, smem);
  for (int i = bid * NTHREADS + tid; i < (T + TC) * 32; i += nb * NTHREADS) {
    const bool isx = i < T * 32;
    const int ii = isx ? i : i - T * 32;
    const int t = ii >> 5, j = ii & 31;
    const float v = (isx ? p.dtraw : p.dtraw_c)[ii];
    float* df = isx ? p.dtf : p.dtf_c;
    float* db = isx ? p.dtb : p.dtb_c;
    if (j < 16) df[t * 16 + j] = softplus_f(v + p.dt_bias_f[j]);
    else db[t * 16 + (j - 16)] = softplus_f(v + p.dt_bias_b[j - 16]);
  }
}

__device__ __forceinline__ int swz16(int row, int chunk) { return row * 256 + ((chunk ^ (row & 15)) << 4); }
__device__ __forceinline__ int swz8(int row, int chunk) { return row * 128 + ((chunk ^ (row & 7)) << 4); }

#define LDS_BARRIER() asm volatile("s_waitcnt lgkmcnt(0)\n\ts_barrier" ::: "memory")
__device__ void ssd_task(const Params& p, int task, char* smem) {
  const int dir = task & 1, ph = (task >> 1) & 1, h = (task >> 2) & 15, b = task >> 6;
  const int tid = opaque_tid(), lane = tid & 63, w = tid >> 6;
  const int g = h >> 3, lr0 = lane & 15, lq0 = lane >> 4;
  const float a = -__expf(dir ? p.a_log_b[h] : p.a_log_f[h]);
  char* sCc = smem; char* sBc = smem + 16384; char* sBT = smem + 32768; char* sXT = smem + 49152; char* sHb = smem + 57344;
  float* se = reinterpret_cast<float*>(smem + 73728);
  float* sdt = se + 64; float* sw = se + 128; float* sy = se + 192; float* stot = se + 256;
  float* yo = dir ? p.yb : p.yf;
  f32x4 H[2][2];
#pragma unroll
  for (int i = 0; i < 2; ++i)
#pragma unroll
    for (int j = 0; j < 2; ++j) H[i][j] = f32x4{0.f, 0.f, 0.f, 0.f};
  __syncthreads();
  for (int i = tid; i < 512; i += NTHREADS) reinterpret_cast<uint4*>(sHb)[i] = uint4{0, 0, 0, 0};

  const int crow = tid >> 4, cch = tid & 15;
  const int trow = tid >> 3, tch = tid & 7;
  uint4 rC0, rC1, rC2, rC3, rB0, rB1, rB2, rB3, rT0, rT1, rT2, rT3, rX;
  rC0 = rC1 = rC2 = rC3 = rB0 = rB1 = rB2 = rB3 = uint4{0, 0, 0, 0};
  float rdt = 0.f;
#define SSD_PARAMS(st_)                                                                                                   \
  const bool isctx_ = (st_) < 4;                                                                                          \
  const int nch_ = isctx_ ? 4 : 32, ci_ = isctx_ ? (st_) : (st_) - 4;                                                     \
  const int c_ = dir ? (nch_ - 1 - ci_) : ci_;                                                                            \
  const int seqlen_ = isctx_ ? CTX : L;                                                                                   \
  const size_t trow0_ = isctx_ ? ((size_t)T + (size_t)b * CTX + c_ * 64) : ((size_t)b * L + c_ * 64);                     \
  const size_t drow0_ = (size_t)b * seqlen_ + c_ * 64;                                                                    \
  const float* dtp_ = isctx_ ? (dir ? p.dtb_c : p.dtf_c) : (dir ? p.dtb : p.dtf);                                         \
  const bf16_t* cm_ = (isctx_ ? p.act_cm_c : p.act_cm_x) + (size_t)b * 1280 * seqlen_ + c_ * 64;
#define SSD_PREFETCH(st_)                                                                                                 \
  do {                                                                                                                    \
    SSD_PARAMS(st_)                                                                                                       \
    if (w == 0) rdt = dtp_[(drow0_ + lane) * 16 + h];                                                                     \
    if (!isctx_) {                                                                                                        \
      const bf16_t* src = p.act_tm + (trow0_ + crow) * DXBC + g * 128 + cch * 8;                                          \
      rC0 = *reinterpret_cast<const uint4*>(src + 1280);             rB0 = *reinterpret_cast<const uint4*>(src + 1024);   \
      rC1 = *reinterpret_cast<const uint4*>(src + 16 * DXBC + 1280); rB1 = *reinterpret_cast<const uint4*>(src + 16 * DXBC + 1024); \
      rC2 = *reinterpret_cast<const uint4*>(src + 32 * DXBC + 1280); rB2 = *reinterpret_cast<const uint4*>(src + 32 * DXBC + 1024); \
      rC3 = *reinterpret_cast<const uint4*>(src + 48 * DXBC + 1280); rB3 = *reinterpret_cast<const uint4*>(src + 48 * DXBC + 1024); \
    }                                                                                                                     \
    const bf16_t* srt = cm_ + (size_t)(1024 + g * 128 + trow) * seqlen_ + tch * 8;                                        \
    rT0 = *reinterpret_cast<const uint4*>(srt);                                                                           \
    rT1 = *reinterpret_cast<const uint4*>(srt + (size_t)32 * seqlen_);                                                    \
    rT2 = *reinterpret_cast<const uint4*>(srt + (size_t)64 * seqlen_);                                                    \
    rT3 = *reinterpret_cast<const uint4*>(srt + (size_t)96 * seqlen_);                                                    \
    rX = *reinterpret_cast<const uint4*>(cm_ + (size_t)(h * 64 + ph * 32 + trow) * seqlen_ + tch * 8);                    \
  } while (0)

  for (int step = 0; step < 36; ++step) {
    SSD_PREFETCH(step);
    const bool isctx = step < 4;
    const int c = dir ? ((isctx ? 4 : 32) - 1 - (isctx ? step : step - 4)) : (isctx ? step : step - 4);
    const size_t trow0 = (size_t)b * L + c * 64;
    int lr = lr0, lq = lq0;
    asm volatile("" : "+v"(lr), "+v"(lq));
    LDS_BARRIER();
    if (w == 0) {
      const float dtv = rdt;
      float v = a * dtv;
      if (!dir) {
#pragma unroll
        for (int o = 1; o < 64; o <<= 1) { float n = __shfl_up(v, o); v += (lane >= o) ? n : 0.f; }
      } else {
#pragma unroll
        for (int o = 1; o < 64; o <<= 1) { float n = __shfl_down(v, o); v += (lane + o < 64) ? n : 0.f; }
      }
      const float etot = __shfl(v, dir ? 0 : 63);
      se[lane] = v; sdt[lane] = dtv; sw[lane] = dtv * __expf(etot - v); sy[lane] = __expf(v);
      if (lane == 0) stot[0] = etot;
    }
    if (!isctx) {
      const int oc = swz16(crow, cch);
      *reinterpret_cast<uint4*>(sCc + oc) = rC0;         *reinterpret_cast<uint4*>(sBc + oc) = rB0;
      *reinterpret_cast<uint4*>(sCc + oc + 4096) = rC1;  *reinterpret_cast<uint4*>(sBc + oc + 4096) = rB1;
      *reinterpret_cast<uint4*>(sCc + oc + 8192) = rC2;  *reinterpret_cast<uint4*>(sBc + oc + 8192) = rB2;
      *reinterpret_cast<uint4*>(sCc + oc + 12288) = rC3; *reinterpret_cast<uint4*>(sBc + oc + 12288) = rB3;
    }
    {
      const int ot = swz8(trow, tch);
      *reinterpret_cast<uint4*>(sBT + ot) = rT0;
      *reinterpret_cast<uint4*>(sBT + ot + 4096) = rT1;
      *reinterpret_cast<uint4*>(sBT + ot + 8192) = rT2;
      *reinterpret_cast<uint4*>(sBT + ot + 12288) = rT3;
      *reinterpret_cast<uint4*>(sXT + ot) = rX;
    }
    LDS_BARRIER();
    const float etot = stot[0];
    if (!isctx) {
      f32x4 G[4];
      bf16x8 ca[4];
#pragma unroll
      for (int j = 0; j < 4; ++j) G[j] = f32x4{0.f, 0.f, 0.f, 0.f};
#pragma unroll
      for (int kk = 0; kk < 4; ++kk) ca[kk] = *reinterpret_cast<const bf16x8*>(sCc + swz16(16 * w + lr, kk * 4 + lq));
#pragma unroll
      for (int kk = 0; kk < 4; ++kk)
#pragma unroll
        for (int j = 0; j < 4; ++j) {
          bf16x8 bb = *reinterpret_cast<const bf16x8*>(sBc + swz16(16 * j + lr, kk * 4 + lq));
          G[j] = __builtin_amdgcn_mfma_f32_16x16x32_bf16(ca[kk], bb, G[j], 0, 0, 0);
        }
      LDS_BARRIER();
      float el[4];
#pragma unroll
      for (int r = 0; r < 4; ++r) el[r] = se[16 * w + lq * 4 + r];
#pragma unroll
      for (int j = 0; j < 4; ++j) {
        const int s_ = 16 * j + lr;
        const float es = se[s_], ds = sdt[s_];
#pragma unroll
        for (int r = 0; r < 4; ++r) {
          const int l = 16 * w + lq * 4 + r;
          const bool keep = dir ? (s_ >= l) : (s_ <= l);
          const float m = keep ? G[j][r] * __expf(el[r] - es) * ds : 0.f;
          *reinterpret_cast<bf16_t*>(sBc + swz8(l, s_ >> 3) + (s_ & 7) * 2) = f2bf(m);
        }
      }
      LDS_BARRIER();
      f32x4 Y[2], Yo[2];
#pragma unroll
      for (int j = 0; j < 2; ++j) { Y[j] = f32x4{0.f, 0.f, 0.f, 0.f}; Yo[j] = f32x4{0.f, 0.f, 0.f, 0.f}; }
#pragma unroll
      for (int kk = 0; kk < 2; ++kk) {
        bf16x8 ma = *reinterpret_cast<const bf16x8*>(sBc + swz8(16 * w + lr, kk * 4 + lq));
#pragma unroll
        for (int j = 0; j < 2; ++j) {
          bf16x8 xb = *reinterpret_cast<const bf16x8*>(sXT + swz8(16 * j + lr, kk * 4 + lq));
          Y[j] = __builtin_amdgcn_mfma_f32_16x16x32_bf16(ma, xb, Y[j], 0, 0, 0);
        }
      }
#pragma unroll
      for (int kk = 0; kk < 4; ++kk)
#pragma unroll
        for (int j = 0; j < 2; ++j) {
          bf16x8 hb = *reinterpret_cast<const bf16x8*>(sHb + swz16(16 * j + lr, kk * 4 + lq));
          Yo[j] = __builtin_amdgcn_mfma_f32_16x16x32_bf16(ca[kk], hb, Yo[j], 0, 0, 0);
        }
      float syl[4];
#pragma unroll
      for (int r = 0; r < 4; ++r) syl[r] = sy[16 * w + lq * 4 + r];
#pragma unroll
      for (int j = 0; j < 2; ++j)
#pragma unroll
        for (int r = 0; r < 4; ++r) {
          const int l = 16 * w + lq * 4 + r;
          yo[(trow0 + l) * 1024 + h * 64 + ph * 32 + 16 * j + lr] = Y[j][r] + syl[r] * Yo[j][r];
        }
    }
    {
      const float dec = __expf(etot);
#pragma unroll
      for (int i = 0; i < 2; ++i)
#pragma unroll
        for (int j = 0; j < 2; ++j) H[i][j] *= dec;
#pragma unroll
      for (int kk = 0; kk < 2; ++kk) {
        const int s0 = kk * 32 + lq * 8;
        const float4 w0 = *reinterpret_cast<const float4*>(sw + s0), w1 = *reinterpret_cast<const float4*>(sw + s0 + 4);
        bf16x8 xs[2];
#pragma unroll
        for (int i = 0; i < 2; ++i) {
          const bf16x8 xa = *reinterpret_cast<const bf16x8*>(sXT + swz8(16 * i + lr, kk * 4 + lq));
          xs[i][0] = (short)f2bf(bf2f((bf16_t)xa[0]) * w0.x); xs[i][1] = (short)f2bf(bf2f((bf16_t)xa[1]) * w0.y);
          xs[i][2] = (short)f2bf(bf2f((bf16_t)xa[2]) * w0.z); xs[i][3] = (short)f2bf(bf2f((bf16_t)xa[3]) * w0.w);
          xs[i][4] = (short)f2bf(bf2f((bf16_t)xa[4]) * w1.x); xs[i][5] = (short)f2bf(bf2f((bf16_t)xa[5]) * w1.y);
          xs[i][6] = (short)f2bf(bf2f((bf16_t)xa[6]) * w1.z); xs[i][7] = (short)f2bf(bf2f((bf16_t)xa[7]) * w1.w);
        }
#pragma unroll
        for (int j = 0; j < 2; ++j) {
          const bf16x8 bt = *reinterpret_cast<const bf16x8*>(sBT + swz8(16 * (2 * w + j) + lr, kk * 4 + lq));
#pragma unroll
          for (int i = 0; i < 2; ++i) H[i][j] = __builtin_amdgcn_mfma_f32_16x16x32_bf16(xs[i], bt, H[i][j], 0, 0, 0);
        }
      }
    }
    LDS_BARRIER();
#pragma unroll
    for (int i = 0; i < 2; ++i)
#pragma unroll
      for (int j = 0; j < 2; ++j) {
        const int n = 16 * (2 * w + j) + lr;
#pragma unroll
        for (int r = 0; r < 4; ++r) {
          const int pr = 16 * i + lq * 4 + r;
          *reinterpret_cast<bf16_t*>(sHb + swz16(pr, n >> 3) + (n & 7) * 2) = f2bf(H[i][j][r]);
        }
      }
  }
#undef SSD_PREFETCH
#undef SSD_PARAMS
}

#undef LDS_BARRIER
__device__ void phase_ssd_dft(const Params& p, int bid, int nb, char* smem) {
  for (int t = bid; t < 256; t += nb) ssd_task(p, t, smem);
  int* stile = reinterpret_cast<int*>(smem + 75776);
  for (;;) {
    __syncthreads();
    if (threadIdx.x == 0) *stile = (int)atomicAdd(p.ctr, 1u);
    __syncthreads();
    const int t = *stile;
    if (t >= 4 * 8 * 8) break;
    const int b = t >> 6, tm = (t & 63) >> 3, tn = t & 7;
    const bf16_t* Fb = p.Fs + (size_t)b * 1024 * 2048;
    f32x4 accC[4][4], accS[4][4];
    gemm_mainloop(p.dftm, 2048, Fb, 2048, 1024, tm * 128, tn * 128, accC, smem);
    gemm_mainloop(p.dftm + 1024, 2048, Fb + 1024, 2048, 1024, tm * 128, tn * 128, accS, smem);
    const int lane = threadIdx.x & 63, w = threadIdx.x >> 6, wm = w >> 1, wn = w & 1;
#pragma unroll
    for (int i = 0; i < 4; ++i) {
      int lq_ = lane >> 4, lr_ = lane & 15;
      asm volatile("" : "+v"(lq_), "+v"(lr_));
#pragma unroll
      for (int j = 0; j < 4; ++j) {
        const int k0 = tm * 128 + wm * 64 + i * 16 + lq_ * 4;
        const int ch = tn * 128 + wn * 64 + j * 16 + lr_;
        const float a = bf2f(p.ABt[((size_t)b * 1024 + ch) * 4096 + 1024]);
#pragma unroll
        for (int r = 0; r < 4; ++r) {
          const int k = k0 + r;
          const float as = (k & 1) ? -a : a;
          const float c = accC[i][j][r], sn = accS[i][j][r];
          p.ycat[((size_t)b * L + k) * D + ch] = f2bf(c - sn + as);
          if (k > 0) p.ycat[((size_t)b * L + (L - k)) * D + ch] = f2bf(c + sn + as);
        }
      }
    }
  }
  for (;;) {
    __syncthreads();
    if (threadIdx.x == 0) *stile = (int)atomicAdd(p.ctr + 8, 1u);
    __syncthreads();
    const int q = *stile;
    if (q >= 1024 + 1536) break;
    if (q < 1024) convert_uv_units(p, (size_t)q * 4096, (size_t)(q + 1) * 4096);
    else if (q < 1024 + 1024) { const int q1 = q - 1024; transpose_convert_task(p.w_out, D, 0, D, p.w_out_t, q1 / 32, q1 % 32, reinterpret_cast<float*>(smem)); }
    else { const int q2 = q - 2048; transpose_convert_task(p.w_query, 1024, 0, D, p.w_q_t, q2 / 16, q2 % 16, reinterpret_cast<float*>(smem)); }
  }
}

__device__ void phase_ssm_post(const Params& p, int bid, int nb, char* smem) {
  float* red = reinterpret_cast<float*>(smem);
  const int tid = threadIdx.x, w = tid >> 6;
  for (int t = bid; t < T; t += nb) {
    const int c0 = tid * 4;
    const int h = c0 >> 6;
    const float dsk = p.d_skip_f[h] + p.d_skip_b[h];
    float4 a = *reinterpret_cast<const float4*>(p.yf + (size_t)t * 1024 + c0);
    float4 bq = *reinterpret_cast<const float4*>(p.yb + (size_t)t * 1024 + c0);
    uint2 xq = *reinterpret_cast<const uint2*>(p.act_tm + (size_t)t * DXBC + c0);
    float xs[4] = {bflo(xq.x), bfhi(xq.x), bflo(xq.y), bfhi(xq.y)};
    uint2 zz = *reinterpret_cast<const uint2*>(p.z + (size_t)t * 1024 + c0);
    float zf[4] = {bflo(zz.x), bfhi(zz.x), bflo(zz.y), bfhi(zz.y)};
    float y[4] = {a.x + bq.x + dsk * xs[0], a.y + bq.y + dsk * xs[1], a.z + bq.z + dsk * xs[2], a.w + bq.w + dsk * xs[3]};
    float ss = 0.f;
#pragma unroll
    for (int e = 0; e < 4; ++e) { y[e] *= silu_f(zf[e]); ss += y[e] * y[e]; }
    ss = wave_sum(ss);
    __syncthreads();
    if ((tid & 63) == 0) red[w] = ss;
    __syncthreads();
    float gs = (w < 2) ? (red[0] + red[1]) : (red[2] + red[3]);
    float rstd = rsqrtf(gs * (1.f / 512.f) + EPS);
    float4 nw = *reinterpret_cast<const float4*>(p.ssm_norm_w + c0);
    uint2 o; o.x = pack2(y[0] * rstd * nw.x, y[1] * rstd * nw.y); o.y = pack2(y[2] * rstd * nw.z, y[3] * rstd * nw.w);
    *reinterpret_cast<uint2*>(p.ycat + (size_t)t * D + 1024 + c0) = o;
  }
}

__device__ void phase_outproj(const Params& p, int bid, int nb, char* smem) {
  for (int t = bid; t < 64 * 16; t += nb) {
    EpiF32 epi{p.y_x, D};
    gemm_tile(p.ycat, D, p.w_out_t, D, D, (t >> 4) * 128, (t & 15) * 128, epi, smem);
  }
}
__device__ void phase_postmix(const Params& p, int bid, int nb, char* smem) {
  float* red = reinterpret_cast<float*>(smem);
  const int tid = threadIdx.x;
  for (int t = bid; t < T; t += nb) {
    const int b = t / L;
    const float* yr = p.y_x + (size_t)t * D + tid * 8;
    const float* xr = p.x + (size_t)t * D + tid * 8;
    float y[8], xv[8];
    *reinterpret_cast<float4*>(y) = *reinterpret_cast<const float4*>(yr);
    *reinterpret_cast<float4*>(y + 4) = *reinterpret_cast<const float4*>(yr + 4);
    *reinterpret_cast<float4*>(xv) = *reinterpret_cast<const float4*>(xr);
    *reinterpret_cast<float4*>(xv + 4) = *reinterpret_cast<const float4*>(xr + 4);
    float ss = 0.f;
#pragma unroll
    for (int e = 0; e < 8; ++e) ss += y[e] * y[e];
    ss = block_sum(ss, red);
    float rstd = rsqrtf(ss * (1.f / D) + EPS);
    const float* gm = p.mod + (size_t)b * NMOD + 2 * D + tid * 8;
    const float* gp = p.g_post_mix + tid * 8;
    float x1[8]; float ss1 = 0.f;
#pragma unroll
    for (int e = 0; e < 8; ++e) { x1[e] = xv[e] + gm[e] * (y[e] * rstd * gp[e]); ss1 += x1[e] * x1[e]; }
    ss1 = block_sum(ss1, red);
    float rstd1 = rsqrtf(ss1 * (1.f / D) + EPS);
    float* o = p.out + (size_t)t * D + tid * 8;
    *reinterpret_cast<float4*>(o) = *reinterpret_cast<float4*>(x1);
    *reinterpret_cast<float4*>(o + 4) = *reinterpret_cast<float4*>(x1 + 4);
    const float* sf = p.mod + (size_t)b * NMOD + 3 * D + tid * 8;
    const float* cf = p.mod + (size_t)b * NMOD + 4 * D + tid * 8;
    const float* gf = p.g_pre_ffn + tid * 8;
    float h2[8];
#pragma unroll
    for (int e = 0; e < 8; ++e) h2[e] = x1[e] * rstd1 * gf[e] * (1.f + cf[e]) + sf[e];
    uint4 pk; pk.x = pack2(h2[0], h2[1]); pk.y = pack2(h2[2], h2[3]); pk.z = pack2(h2[4], h2[5]); pk.w = pack2(h2[6], h2[7]);
    *reinterpret_cast<uint4*>(p.hx + (size_t)t * D + tid * 8) = pk;
  }
}

__device__ __forceinline__ uint32_t mono_key(float f) {
  uint32_t u = __float_as_uint(f);
  return (u & 0x80000000u) ? ~u : (u | 0x80000000u);
}
__device__ __forceinline__ void ins16(uint32_t (&Lk)[16], uint32_t x) {
#pragma unroll
  for (int i = 0; i < 16; ++i) { uint32_t hi = max(Lk[i], x); x = min(Lk[i], x); Lk[i] = hi; }
}
__device__ __forceinline__ float unmono_key(uint32_t k) {
  return __uint_as_float((k & 0x80000000u) ? (k ^ 0x80000000u) : ~k);
}
typedef __attribute__((ext_vector_type(16))) float f32x16;
__device__ void phase_q_route(const Params& p, int bid, int nb, char* smem) {
  const int tid = opaque_tid(), lane = tid & 63, w = tid >> 6;
  const int wm = w >> 1, wn = w & 1, lr = lane & 15, lq = lane >> 4;
  const int l31 = lane & 31, lh = lane >> 5;
  for (int tile = bid; tile < 512; tile += nb) {
    const int h = tile & 7, m0 = (tile >> 3) * 128;
    {
      f32x4 acc[4][4];
      gemm_mainloop(p.hx, D, p.w_q_t, D, D, m0, h * 128, acc, smem);
#pragma unroll
      for (int i = 0; i < 4; ++i)
#pragma unroll
        for (int j = 0; j < 4; ++j)
#pragma unroll
          for (int r = 0; r < 4; ++r) {
            const int row = wm * 64 + i * 16 + lq * 4 + r, col = wn * 64 + j * 16 + lr;
            *reinterpret_cast<bf16_t*>(smem + swz16(row, col >> 3) + (col & 7) * 2) = f2bf(acc[i][j][r]);
          }
    }
#pragma unroll 4
    for (int r = 0; r < 16; ++r) {
      const int id = tid + 256 * r, row = id >> 4, c4 = id & 15;
      const float* src = ((row < 128) ? p.sk1 : p.sk2) + ((size_t)(h * 128 + (row & 127)) * 64 + c4 * 4);
      const float4 v = *reinterpret_cast<const float4*>(src);
      uint2 pk; pk.x = pack2(v.x, v.y); pk.y = pack2(v.z, v.w);
      *reinterpret_cast<uint2*>(smem + 32768 + swz8(row, c4 >> 1) + (c4 & 1) * 8) = pk;
    }
    __syncthreads();
    uint32_t L1[16], L2[16];
#pragma unroll
    for (int sd = 0; sd < 2; ++sd) {
      uint32_t Lk[16];
#pragma unroll
      for (int i = 0; i < 16; ++i) Lk[i] = 0u;
      const uint32_t kb = (uint32_t)(lh * 4);
#pragma unroll
      for (int ih = 0; ih < 2; ++ih) {
        f32x16 Sa[2];
#pragma unroll
        for (int i = 0; i < 2; ++i)
#pragma unroll
          for (int g2 = 0; g2 < 16; ++g2) Sa[i][g2] = 0.f;
#pragma unroll
        for (int ks = 0; ks < 4; ++ks) {
          const bf16x8 qb = *reinterpret_cast<const bf16x8*>(smem + swz16(w * 32 + l31, sd * 8 + ks * 2 + lh));
#pragma unroll
          for (int i = 0; i < 2; ++i) {
            const bf16x8 ka = *reinterpret_cast<const bf16x8*>(smem + 32768 + swz8(sd * 128 + (ih * 2 + i) * 32 + l31, ks * 2 + lh));
            Sa[i] = __builtin_amdgcn_mfma_f32_32x32x16_bf16(ka, qb, Sa[i], 0, 0, 0);
          }
        }
#pragma unroll
        for (int i = 0; i < 2; ++i)
#pragma unroll
          for (int g2 = 0; g2 < 16; ++g2)
            ins16(Lk, (mono_key(Sa[i][g2]) & ~0x7Fu) | (uint32_t)((ih * 2 + i) * 32 + (g2 & 3) + 8 * (g2 >> 2)) | kb);
      }
#pragma unroll
      for (int i = 0; i < 8; ++i) {
        const uint32_t t1 = (uint32_t)__shfl_xor((int)Lk[15 - i], 32), t2 = (uint32_t)__shfl_xor((int)Lk[i], 32);
        Lk[i] = max(Lk[i], t1); Lk[15 - i] = max(Lk[15 - i], t2);
      }
#pragma unroll
      for (int dd = 8; dd >= 1; dd >>= 1)
#pragma unroll
        for (int i = 0; i < 16; ++i)
          if ((i & dd) == 0) { const uint32_t hi = max(Lk[i], Lk[i + dd]), lo = min(Lk[i], Lk[i + dd]); Lk[i] = hi; Lk[i + dd] = lo; }
#pragma unroll
      for (int r = 0; r < 16; ++r) { if (sd == 0) L1[r] = Lk[r]; else L2[r] = Lk[r]; }
    }
    __syncthreads();
    uint32_t* ib = reinterpret_cast<uint32_t*>(smem) + w * 1088 + l31 * 34;
    if (lh == 0) {
#pragma unroll
      for (int r = 0; r < 16; ++r) { ib[r] = L1[r] & 127u; ib[16 + r] = L2[r] & 127u; }
    }
    float v1[16], v2[16];
#pragma unroll
    for (int r = 0; r < 16; ++r) { v1[r] = unmono_key(L1[r] & ~0x7Fu); v2[r] = unmono_key(L2[r] & ~0x7Fu); }
    uint32_t C[16];
#pragma unroll
    for (int i = 0; i < 16; ++i) C[i] = 0u;
#pragma unroll
    for (int a = 0; a < 16; ++a)
#pragma unroll
      for (int bq = 0; bq < 16; ++bq)
        if ((a + 1) * (bq + 1) <= 16) ins16(C, (mono_key(v1[a] + v2[bq]) & ~0xFFu) | (uint32_t)(a * 16 + bq));
    float ts[16]; int te[16];
    __builtin_amdgcn_wave_barrier();
#pragma unroll
    for (int r = 0; r < 16; ++r) {
      const uint32_t code = C[r] & 0xFFu;
      te[r] = (int)(ib[code >> 4] * 128u + ib[16 + (code & 15u)]);
      ts[r] = unmono_key(C[r] & ~0xFFu);
    }
    const float mx = ts[0];
    float den = 0.f;
#pragma unroll
    for (int r = 0; r < 16; ++r) { ts[r] = __expf(ts[r] - mx); den += ts[r]; }
    const float inv = 1.f / den;
    const size_t ob = (size_t)(m0 + w * 32 + l31) * 128 + h * 16;
    if (lh == 0) {
#pragma unroll
      for (int r = 0; r < 16; r += 4) *reinterpret_cast<int4*>(p.idx + ob + r) = int4{te[r], te[r + 1], te[r + 2], te[r + 3]};
    } else {
#pragma unroll
      for (int r = 0; r < 16; r += 4)
        *reinterpret_cast<float4*>(p.gate + ob + r) = float4{ts[r] * inv, ts[r + 1] * inv, ts[r + 2] * inv, ts[r + 3] * inv};
    }
    __syncthreads();
  }
}

typedef __attribute__((ext_vector_type(2))) float f32x2;
__device__ __forceinline__ void fp8x16_to_f32(const uint4 q, f32x2 (&o)[8]) {
  o[0] = __builtin_amdgcn_cvt_pk_f32_fp8((int)q.x, false); o[1] = __builtin_amdgcn_cvt_pk_f32_fp8((int)q.x, true);
  o[2] = __builtin_amdgcn_cvt_pk_f32_fp8((int)q.y, false); o[3] = __builtin_amdgcn_cvt_pk_f32_fp8((int)q.y, true);
  o[4] = __builtin_amdgcn_cvt_pk_f32_fp8((int)q.z, false); o[5] = __builtin_amdgcn_cvt_pk_f32_fp8((int)q.z, true);
  o[6] = __builtin_amdgcn_cvt_pk_f32_fp8((int)q.w, false); o[7] = __builtin_amdgcn_cvt_pk_f32_fp8((int)q.w, true);
}
template <int CTRL>
__device__ __forceinline__ float dpp_mov(float v) {
  return __int_as_float(__builtin_amdgcn_update_dpp(0, __float_as_int(v), CTRL, 0xF, 0xF, true));
}
__device__ __forceinline__ unsigned my_xcc_id() { return (unsigned)__builtin_amdgcn_s_getreg((3 << 11) | 20) & 7u; }

__device__ void phase_exp_u(const Params& p, char* smem) {
  const int tid = opaque_tid(), lane = tid & 63, w = tid >> 6;
  const int sub = lane >> 4, cc = lane & 15;
  const unsigned myx = my_xcc_id();
  int* sh = reinterpret_cast<int*>(smem);
  int* si = reinterpret_cast<int*>(smem + 64) + w * 256;
  float* pbuf = reinterpret_cast<float*>(p.ycat);
  for (unsigned qi = 0; qi < 8; ++qi) {
    const unsigned x = (myx + qi) & 7u;
    for (;;) {
      __syncthreads();
      if (tid == 0) sh[0] = (int)atomicAdd(&p.ctr[16 + x], 1u);
      __syncthreads();
      const int chunk = sh[0];
      if (chunk >= 512) break;
      for (int tt = 0; tt < 4; ++tt) {
        const int t = chunk * 16 + w * 4 + tt;
        __builtin_amdgcn_wave_barrier();
        si[lane] = p.idx[(size_t)t * 128 + lane]; si[64 + lane] = p.idx[(size_t)t * 128 + 64 + lane];
        __builtin_amdgcn_wave_barrier();
        f32x2 hf[8];
#pragma unroll
        for (int q2 = 0; q2 < 2; ++q2) {
          const uint4 hq = *reinterpret_cast<const uint4*>(p.hx + (size_t)t * D + x * 256 + cc * 16 + q2 * 8);
          hf[q2 * 4 + 0] = f32x2{bflo(hq.x), bfhi(hq.x)}; hf[q2 * 4 + 1] = f32x2{bflo(hq.y), bfhi(hq.y)};
          hf[q2 * 4 + 2] = f32x2{bflo(hq.z), bfhi(hq.z)}; hf[q2 * 4 + 3] = f32x2{bflo(hq.w), bfhi(hq.w)};
        }
        const uint8_t* ub = p.U8 + x * 256 + cc * 16;
#pragma unroll 1
        for (int j0 = 0; j0 < 32; j0 += 16) {
          uint4 uq[16];
#pragma unroll
          for (int k = 0; k < 16; ++k) uq[k] = *reinterpret_cast<const uint4*>(ub + (size_t)si[(j0 + k) * 4 + sub] * D);
          float mine = 0.f;
#pragma unroll
          for (int k = 0; k < 16; ++k) {
            f32x2 uf[8];
            fp8x16_to_f32(uq[k], uf);
            f32x2 d2 = hf[0] * uf[0];
#pragma unroll
            for (int e = 1; e < 8; ++e) d2 += hf[e] * uf[e];
            float d = d2.x + d2.y;
            d += dpp_mov<0xB1>(d); d += dpp_mov<0x4E>(d); d += dpp_mov<0x124>(d); d += dpp_mov<0x128>(d);
            mine = (cc == k) ? d : mine;
          }
          pbuf[((size_t)x * T + t) * 128 + (j0 + cc) * 4 + sub] = mine * (1.f / 512.f);
        }
      }
    }
  }
}

__device__ void phase_exp_v(const Params& p, char* smem) {
  const int tid = opaque_tid(), lane = tid & 63, w = tid >> 6;
  const int sub = lane >> 4, cc = lane & 15;
  const unsigned myx = my_xcc_id();
  int* sh = reinterpret_cast<int*>(smem);
  int* si = reinterpret_cast<int*>(smem + 64) + w * 256;
  float* sc = reinterpret_cast<float*>(si + 128);
  float* yf = p.y_x;
  for (unsigned qi = 0; qi < 8; ++qi) {
    const unsigned x = (myx + qi) & 7u;
    for (;;) {
      __syncthreads();
      if (tid == 0) sh[0] = (int)atomicAdd(&p.ctr[32 + x], 1u);
      __syncthreads();
      const int chunk = sh[0];
      if (chunk >= 512) break;
      for (int tt = 0; tt < 4; ++tt) {
        const int t = chunk * 16 + w * 4 + tt;
        __builtin_amdgcn_wave_barrier();
        si[lane] = p.idx[(size_t)t * 128 + lane]; si[64 + lane] = p.idx[(size_t)t * 128 + 64 + lane];
        {
          const float* pb = reinterpret_cast<const float*>(p.ycat) + (size_t)t * 128;
          float d0 = 0.f, d1 = 0.f;
#pragma unroll
          for (int xs = 0; xs < 8; ++xs) { d0 += pb[(size_t)xs * T * 128 + lane]; d1 += pb[(size_t)xs * T * 128 + 64 + lane]; }
          sc[lane] = p.gate[(size_t)t * 128 + lane] * 0.5f * d0 * (1.f + erff(d0 * 0.70710678118654752f));
          sc[64 + lane] = p.gate[(size_t)t * 128 + 64 + lane] * 0.5f * d1 * (1.f + erff(d1 * 0.70710678118654752f));
        }
        __builtin_amdgcn_wave_barrier();
        f32x2 acc[8];
#pragma unroll
        for (int e = 0; e < 8; ++e) acc[e] = f32x2{0.f, 0.f};
        const uint8_t* vb = p.V8 + x * 256 + cc * 16;
#pragma unroll 1
        for (int j0 = 0; j0 < 32; j0 += 16) {
          uint4 vq[16]; float cf[16];
#pragma unroll
          for (int k = 0; k < 16; ++k) {
            const int j = (j0 + k) * 4 + sub;
            vq[k] = *reinterpret_cast<const uint4*>(vb + (size_t)si[j] * D);
            cf[k] = sc[j];
          }
#pragma unroll
          for (int k = 0; k < 16; ++k) {
            f32x2 vf[8];
            fp8x16_to_f32(vq[k], vf);
            const f32x2 c2 = f32x2{cf[k], cf[k]};
#pragma unroll
            for (int e = 0; e < 8; ++e) acc[e] += c2 * vf[e];
          }
        }
        {
          float* red = reinterpret_cast<float*>(smem + 8192) + w * 1280;
          float* mr = red + (sub * 16 + cc) * 20;
#pragma unroll
          for (int q4 = 0; q4 < 4; ++q4)
            *reinterpret_cast<float4*>(mr + q4 * 4) = float4{acc[q4 * 2].x, acc[q4 * 2].y, acc[q4 * 2 + 1].x, acc[q4 * 2 + 1].y};
          __builtin_amdgcn_wave_barrier();
          const int part = sub;
          float4 r0 = *reinterpret_cast<const float4*>(red + (0 * 16 + cc) * 20 + part * 4);
          float4 r1 = *reinterpret_cast<const float4*>(red + (1 * 16 + cc) * 20 + part * 4);
          float4 r2 = *reinterpret_cast<const float4*>(red + (2 * 16 + cc) * 20 + part * 4);
          float4 r3 = *reinterpret_cast<const float4*>(red + (3 * 16 + cc) * 20 + part * 4);
          const float sc512 = 1.f / 512.f;
          float4 o4 = float4{(r0.x + r1.x + r2.x + r3.x) * sc512, (r0.y + r1.y + r2.y + r3.y) * sc512,
                             (r0.z + r1.z + r2.z + r3.z) * sc512, (r0.w + r1.w + r2.w + r3.w) * sc512};
          *reinterpret_cast<float4*>(yf + (size_t)t * D + x * 256 + cc * 16 + part * 4) = o4;
          __builtin_amdgcn_wave_barrier();
        }
      }
    }
  }
}

__device__ void phase_exp_final(const Params& p, int bid, int nb, char* smem) {
  float* red = reinterpret_cast<float*>(smem);
  const int tid = threadIdx.x;
  const float* yf = p.y_x;
  for (int t = bid; t < T; t += nb) {
    const int b = t / L;
    const float* yr = yf + (size_t)t * D + tid * 8;
    float y[8];
    *reinterpret_cast<float4*>(y) = *reinterpret_cast<const float4*>(yr);
    *reinterpret_cast<float4*>(y + 4) = *reinterpret_cast<const float4*>(yr + 4);
    float ss = 0.f;
#pragma unroll
    for (int e = 0; e < 8; ++e) ss += y[e] * y[e];
    ss = block_sum(ss, red);
    const float rstd = rsqrtf(ss * (1.f / D) + EPS);
    const float* gfx = p.mod + (size_t)b * NMOD + 5 * D + tid * 8;
    const float* gp = p.g_post_ffn + tid * 8;
    float* o = p.out + (size_t)t * D + tid * 8;
    float xo[8];
    *reinterpret_cast<float4*>(xo) = *reinterpret_cast<const float4*>(o);
    *reinterpret_cast<float4*>(xo + 4) = *reinterpret_cast<const float4*>(o + 4);
#pragma unroll
    for (int e = 0; e < 8; ++e) xo[e] += gfx[e] * (y[e] * rstd * gp[e]);
    *reinterpret_cast<float4*>(o) = *reinterpret_cast<float4*>(xo);
    *reinterpret_cast<float4*>(o + 4) = *reinterpret_cast<float4*>(xo + 4);
  }
}

#define XB_TMO      128
#define XB_XCNT(j)  (256  + 64 * (j))
#define XB_XSUB(j)  (1280 + 64 * (j))
#define XB_XGEN(j)  (2304 + 64 * (j))
#define XB_TOP      3328
#define XB_TOPGEN   3392
#define XCD_BAR_WORDS 3456
#define XB_SPIN_CAP (1u << 22)
#define LAS __attribute__((address_space(3)))
__device__ __forceinline__ unsigned xb_ld(unsigned* p)              { return __hip_atomic_load(p, __ATOMIC_RELAXED, __HIP_MEMORY_SCOPE_AGENT); }
__device__ __forceinline__ unsigned xb_add(unsigned* p, unsigned v) { return __hip_atomic_fetch_add(p, v, __ATOMIC_RELAXED, __HIP_MEMORY_SCOPE_AGENT); }
__device__ __forceinline__ unsigned xb_xcc_id() { return (unsigned)__builtin_amdgcn_s_getreg((3 << 11) | 20) & 0xFu; }
#define XB_SPIN(cond, bar) do { unsigned _sp = 0; while (cond) { __builtin_amdgcn_s_sleep(1); \
    if ((++_sp & 255u) == 0u) { if (xb_ld(&(bar)[XB_TMO])) break; if (_sp > XB_SPIN_CAP) { atomicAdd(&(bar)[XB_TMO], 1u); break; } } } } while (0)
struct XcdBarrier { unsigned* bar; unsigned x; volatile LAS unsigned* st; };
__device__ __forceinline__ XcdBarrier xcd_barrier_post(unsigned* bar, volatile LAS unsigned* st) {
  XcdBarrier b; b.bar = bar; b.x = xb_xcc_id(); b.st = st;
  if (threadIdx.x == 0) (void)xb_add(&bar[XB_XCNT(b.x)], 1u);
  return b;
}
__device__ __forceinline__ void xcd_barrier_complete(unsigned* bar, unsigned x, unsigned& nloc, unsigned& nx) {
  const unsigned G = gridDim.x * gridDim.y * gridDim.z;
  unsigned sum, cnt, mine, sp = 0u;
  for (;;) {
    sum = 0u; cnt = 0u; mine = 0u;
#pragma unroll
    for (unsigned j = 0; j < 16; ++j) { const unsigned c = xb_ld(&bar[XB_XCNT(j)]); sum += c; cnt += (c > 0u) ? 1u : 0u; mine = (j == x) ? c : mine; }
    if (sum == G) break;
    __builtin_amdgcn_s_sleep(1);
    if ((++sp & 255u) == 0u) { if (xb_ld(&bar[XB_TMO])) break; if (sp > XB_SPIN_CAP) { atomicAdd(&bar[XB_TMO], 1u); break; } }
  }
  nloc = mine > 0u ? mine : 1u; nx = cnt > 0u ? cnt : 1u;
}
__device__ __forceinline__ void xcd_barrier(const XcdBarrier& b) {
  asm volatile("s_waitcnt vmcnt(0)" ::: "memory");
  __syncthreads();
  if (threadIdx.x == 0) {
    unsigned* bar = b.bar;
    __builtin_amdgcn_s_waitcnt(0);
    unsigned nloc = b.st[0], nx = b.st[1];
    if (nloc == 0u) { xcd_barrier_complete(bar, b.x, nloc, nx); b.st[0] = nloc; b.st[1] = nx; }
    const unsigned old = xb_add(&bar[XB_XSUB(b.x)], 1u);
    const unsigned gen = old / nloc;
    if (old + 1u == (gen + 1u) * nloc) {
      __builtin_amdgcn_fence(__ATOMIC_RELEASE, "agent");
      asm volatile("s_waitcnt vmcnt(0)" ::: "memory");
      const unsigned og = xb_add(&bar[XB_TOP], 1u);
      const unsigned tg = og / nx;
      if (og + 1u == (tg + 1u) * nx) xb_add(&bar[XB_TOPGEN], 1u);
      else XB_SPIN(xb_ld(&bar[XB_TOPGEN]) == tg, bar);
      __builtin_amdgcn_fence(__ATOMIC_ACQUIRE, "agent");
      xb_add(&bar[XB_XGEN(b.x)], 1u);
      asm volatile("s_waitcnt vmcnt(0)" ::: "memory");
    } else {
      XB_SPIN(xb_ld(&bar[XB_XGEN(b.x)]) == gen, bar);
      __builtin_amdgcn_fence(__ATOMIC_ACQUIRE, "agent");
      asm volatile("s_waitcnt vmcnt(0)" ::: "memory");
    }
  }
  __syncthreads();
}

__global__ void __launch_bounds__(NTHREADS, 2) fwd_mega(Params p) {
  __shared__ __attribute__((aligned(16))) char smem[75808];
  const int bid = blockIdx.x, nb = gridDim.x;
  volatile LAS unsigned* st = (volatile LAS unsigned*)(smem + 75792);
  if (threadIdx.x == 0) { st[0] = 0u; st[1] = 0u; }
  __syncthreads();
  const XcdBarrier bar = xcd_barrier_post(p.bar, st);
  phase_prep(p, bid, nb, smem);        xcd_barrier(bar);
  phase_fold(p, bid, nb, smem);        xcd_barrier(bar);
  phase_norm_mod(p, bid, nb, smem);    xcd_barrier(bar);
  phase_inproj(p, bid, nb, smem);      xcd_barrier(bar);
  phase_ssm_pre(p, bid, nb, smem);     xcd_barrier(bar);
  phase_ssd_dft(p, bid, nb, smem);     xcd_barrier(bar);
  phase_ssm_post(p, bid, nb, smem);    xcd_barrier(bar);
  phase_outproj(p, bid, nb, smem);     xcd_barrier(bar);
  phase_postmix(p, bid, nb, smem);     xcd_barrier(bar);
  phase_q_route(p, bid, nb, smem);     xcd_barrier(bar);
  phase_exp_u(p, smem);                xcd_barrier(bar);
  phase_exp_v(p, smem);                xcd_barrier(bar);
  phase_exp_final(p, bid, nb, smem);
}

}

extern "C" void kernel_launch(void* const* d_in, const int* in_sizes, int n_in, void* d_out, int out_size, void* d_ws,
                              size_t ws_size, hipStream_t stream) {
  Params p{};
  const float** fp = reinterpret_cast<const float**>(&p);
  for (int i = 0; i < 27; ++i) fp[i] = (const float*)d_in[i];
  p.out = (float*)d_out;
  char* ws = (char*)d_ws;
  size_t off = 0;
  auto take = [&](size_t bytes) { char* r = ws + off; off += (bytes + 255) & ~(size_t)255; return r; };
  p.U8 = (uint8_t*)take((size_t)16384 * D);
  p.V8 = (uint8_t*)take((size_t)16384 * D);
  p.w_in_t = (bf16_t*)take((size_t)NPROJ * D * 2);
  p.w_out_t = (bf16_t*)take((size_t)D * D * 2);
  p.w_q_t = (bf16_t*)take((size_t)1024 * D * 2);
  p.w_in_f = (bf16_t*)take((size_t)D * 1024 * 2);
  p.WcsT = (bf16_t*)take((size_t)4 * 512 * 256 * 2);
  p.dftm = (bf16_t*)take((size_t)1024 * 2048 * 2);
  p.Fs = (bf16_t*)take((size_t)NB * 1024 * 2048 * 2);
  p.partial = (float*)take((size_t)KSPLIT * 5 * NMOD * 4);
  p.mod = (float*)take((size_t)5 * NMOD * 4);
  p.hx = (bf16_t*)take((size_t)T * D * 2);
  p.hc = (bf16_t*)take((size_t)TC * D * 2);
  p.ABt = (bf16_t*)take((size_t)NB * 1024 * 4096 * 2);
  p.q = (float*)p.ABt;
  p.z = (bf16_t*)take((size_t)T * 1024 * 2);
  char* r1 = take(0);
  p.xbcraw = (float*)take((size_t)T * DXBC * 4);
  p.xbcraw_c = (float*)take((size_t)TC * DXBC * 4);
  p.act_tm = (bf16_t*)take((size_t)(T + TC) * DXBC * 2);
  p.act_cm_x = (bf16_t*)take((size_t)NB * 1280 * L * 2);
  p.act_cm_c = (bf16_t*)take((size_t)NB * 1280 * CTX * 2);
  p.y_x = (float*)r1;
  p.dtraw = (float*)take((size_t)T * 32 * 4);
  p.dtraw_c = (float*)take((size_t)TC * 32 * 4);
  p.dtf = (float*)take((size_t)T * 16 * 4);
  p.dtb = (float*)take((size_t)T * 16 * 4);
  p.dtf_c = (float*)take((size_t)TC * 16 * 4);
  p.dtb_c = (float*)take((size_t)TC * 16 * 4);
  p.yf = (float*)take((size_t)T * 1024 * 4);
  p.yb = (float*)take((size_t)T * 1024 * 4);
  p.ctr = (unsigned*)take(256);
  p.bar = (unsigned*)take((size_t)XCD_BAR_WORDS * 4);
  p.ycat = (bf16_t*)take((size_t)T * D * 2);
  p.idx = (int*)take((size_t)T * 128 * 4);
  p.gate = (float*)take((size_t)T * 128 * 4);
  if (off > ws_size) { fprintf(stderr, "kernel_launch: workspace too small: need %zu have %zu\n", off, ws_size); return; }
  static int grid_blocks = 0;
  if (!grid_blocks) {
    int dev = 0, cus = 0, per_cu = 0;
    hipGetDevice(&dev);
    hipDeviceGetAttribute(&cus, hipDeviceAttributeMultiprocessorCount, dev);
    hipOccupancyMaxActiveBlocksPerMultiprocessor(&per_cu, fwd_mega, NTHREADS, 0);
    if (per_cu > 2) per_cu = 2;
    grid_blocks = cus * per_cu;
    if (grid_blocks <= 0) { fprintf(stderr, "kernel_launch: occupancy query gave %d x %d\n", cus, per_cu); grid_blocks = -1; }
  }
  if (grid_blocks < 0) return;
  (void)hipMemsetAsync(p.bar, 0, (size_t)XCD_BAR_WORDS * 4, stream);
  void* args[] = {&p};
  hipError_t e = hipLaunchCooperativeKernel((void*)fwd_mega, dim3(grid_blocks), dim3(NTHREADS), args, 0, stream);
  if (e != hipSuccess) fprintf(stderr, "cooperative launch failed: %s (grid %d)\n", hipGetErrorString(e), grid_blocks);
}
```

```cpp
#include <hip/hip_runtime.h>
#include <hip/hip_cooperative_groups.h>
#include <stdint.h>
#include <stdio.h>

namespace cg = cooperative_groups;
namespace {

typedef __attribute__((ext_vector_type(8))) short bf16x8;
typedef __attribute__((ext_vector_type(4))) float f32x4;
typedef unsigned short bf16_t;

constexpr int D = 2048, NB = 4, L = 2048, T = NB * L, CTX = 256, TC = NB * CTX;
constexpr int NMOD = 6 * D;
constexpr int NH = 16, HP = 64, NS = 128, DXBC = 1536;
constexpr int DIN = 3616;
constexpr int NPROJ = 4736;
constexpr int KSPLIT = 32;
constexpr float EPS = 1e-6f;
constexpr int NTHREADS = 256;

__device__ __forceinline__ bf16_t f2bf(float f) {
  uint32_t u = __float_as_uint(f);
  u += 0x7fffu + ((u >> 16) & 1u);
  return (bf16_t)(u >> 16);
}
__device__ __forceinline__ float bf2f(bf16_t h) { return __uint_as_float(((uint32_t)h) << 16); }
__device__ __forceinline__ uint32_t pack2(float a, float b) { return (uint32_t)f2bf(a) | ((uint32_t)f2bf(b) << 16); }
__device__ __forceinline__ float bflo(uint32_t w) { return __uint_as_float(w << 16); }
__device__ __forceinline__ float bfhi(uint32_t w) { return __uint_as_float(w & 0xffff0000u); }
__device__ __forceinline__ float silu_f(float v) { return v / (1.f + __expf(-v)); }
__device__ __forceinline__ float softplus_f(float v) { return v > 20.f ? v : log1pf(__expf(v)); }

__device__ __forceinline__ int opaque_tid() { int t = threadIdx.x; asm volatile("" : "+v"(t)); return t; }
__device__ __forceinline__ float wave_sum(float v) {
#pragma unroll
  for (int o = 32; o > 0; o >>= 1) v += __shfl_xor(v, o);
  return v;
}
__device__ __forceinline__ float wave_max(float v) {
#pragma unroll
  for (int o = 32; o > 0; o >>= 1) v = fmaxf(v, __shfl_xor(v, o));
  return v;
}
__device__ __forceinline__ float block_sum(float v, float* red) {
  v = wave_sum(v);
  __syncthreads();
  if ((threadIdx.x & 63) == 0) red[threadIdx.x >> 6] = v;
  __syncthreads();
  return red[0] + red[1] + red[2] + red[3];
}

struct Params {
  const float *x, *c, *ctx, *c_ctx, *w_mod, *b_mod, *g_pre_mix, *g_post_mix, *g_pre_ffn, *g_post_ffn;
  const float *w_in, *w_fmix, *conv_w, *conv_b, *dt_bias_f, *dt_bias_b, *a_log_f, *a_log_b, *d_skip_f, *d_skip_b;
  const float *ssm_norm_w, *w_out, *w_query, *sk1, *sk2, *eu, *ev;
  float* out;
  uint8_t *U8, *V8;
  bf16_t *w_in_t, *w_out_t, *w_q_t, *w_in_f, *WcsT, *dftm, *Fs;
  float *partial, *mod;
  bf16_t *hx, *hc, *ABt, *z;
  float *xbcraw, *xbcraw_c, *dtraw, *dtraw_c, *dtf, *dtb, *dtf_c, *dtb_c;
  bf16_t *act_tm, *act_cm_x, *act_cm_c;
  float *yf, *yb;
  unsigned* ctr; unsigned* bar;
  bf16_t* ycat;
  float *y_x, *q, *gate;
  int* idx;
  int pad0, pad1;
};

__device__ __forceinline__ void gemm_mainloop(const bf16_t* __restrict__ A, int lda, const bf16_t* __restrict__ Bt, int ldb,
                                              int K, int m0, int n0, f32x4 (&acc)[4][4], char* smem) {
  const int tid = opaque_tid(), lane = tid & 63, w = tid >> 6;
  const int wm = w >> 1, wn = w & 1;
#pragma unroll
  for (int i = 0; i < 4; ++i)
#pragma unroll
    for (int j = 0; j < 4; ++j) acc[i][j] = f32x4{0.f, 0.f, 0.f, 0.f};

  const int nk = K / 64;
  const int rowoff = lane >> 3, lch = (lane & 7) ^ rowoff;
  const bf16_t* gA = A + (size_t)(m0 + w * 8 + rowoff) * lda + lch * 8;
  const bf16_t* gB = Bt + (size_t)(n0 + w * 8 + rowoff) * ldb + lch * 8;
#define GSTAGE(buf_, kt_)                                                                                               \
  do {                                                                                                                  \
    _Pragma("unroll") for (int i_ = 0; i_ < 4; ++i_) {                                                                  \
      __builtin_amdgcn_global_load_lds((const unsigned*)(gA + (size_t)(i_ * 32) * lda + (kt_) * 64),                    \
                                       (unsigned*)(smem + (buf_) * 32768 + (i_ * 4 + w) * 1024), 16, 0, 0);             \
      __builtin_amdgcn_global_load_lds((const unsigned*)(gB + (size_t)(i_ * 32) * ldb + (kt_) * 64),                    \
                                       (unsigned*)(smem + (buf_) * 32768 + 16384 + (i_ * 4 + w) * 1024), 16, 0, 0);     \
    }                                                                                                                   \
  } while (0)
  GSTAGE(0, 0);
  asm volatile("s_waitcnt vmcnt(0)" ::: "memory");
  __syncthreads();
  for (int kt = 0; kt < nk; ++kt) {
    const int cur = kt & 1;
    if (kt + 1 < nk) GSTAGE(cur ^ 1, kt + 1);
    const char* sA = smem + cur * 32768;
    const char* sB = sA + 16384;
#pragma unroll
    for (int kk = 0; kk < 2; ++kk) {
      bf16x8 af[4], bfr[4];
      const int ch = kk * 4 + (lane >> 4);
#pragma unroll
      for (int i = 0; i < 4; ++i) {
        int row = wm * 64 + i * 16 + (lane & 15);
        af[i] = *reinterpret_cast<const bf16x8*>(sA + row * 128 + ((ch ^ (row & 7)) << 4));
        int col = wn * 64 + i * 16 + (lane & 15);
        bfr[i] = *reinterpret_cast<const bf16x8*>(sB + col * 128 + ((ch ^ (col & 7)) << 4));
      }
#pragma unroll
      for (int i = 0; i < 4; ++i)
#pragma unroll
        for (int j = 0; j < 4; ++j) acc[i][j] = __builtin_amdgcn_mfma_f32_16x16x32_bf16(af[i], bfr[j], acc[i][j], 0, 0, 0);
    }
    asm volatile("s_waitcnt vmcnt(0)" ::: "memory");
    __syncthreads();
  }
#undef GSTAGE
}

template <class Epi>
__device__ __forceinline__ void gemm_tile(const bf16_t* __restrict__ A, int lda, const bf16_t* __restrict__ Bt, int ldb,
                                          int K, int m0, int n0, const Epi& epi, char* smem) {
  const int lane = threadIdx.x & 63, w = threadIdx.x >> 6;
  const int wm = w >> 1, wn = w & 1;
  f32x4 acc[4][4];
  gemm_mainloop(A, lda, Bt, ldb, K, m0, n0, acc, smem);
#pragma unroll
  for (int i = 0; i < 4; ++i)
#pragma unroll
    for (int j = 0; j < 4; ++j) {
      int row = m0 + wm * 64 + i * 16 + (lane >> 4) * 4;
      int col = n0 + wn * 64 + j * 16 + (lane & 15);
      epi(row, col, acc[i][j]);
    }
}

struct EpiF32 {
  float* C; int ldc;
  __device__ __forceinline__ void operator()(int row, int col, f32x4 v) const {
#pragma unroll
    for (int r = 0; r < 4; ++r) C[(size_t)(row + r) * ldc + col] = v[r];
  }
};
struct EpiBf16 {
  bf16_t* C; int ldc;
  __device__ __forceinline__ void operator()(int row, int col, f32x4 v) const {
#pragma unroll
    for (int r = 0; r < 4; ++r) C[(size_t)(row + r) * ldc + col] = f2bf(v[r]);
  }
};
struct EpiBf16T {
  bf16_t* Ct; int ldc;
  __device__ __forceinline__ void operator()(int row, int col, f32x4 v) const {
    uint2 pk; pk.x = pack2(v[0], v[1]); pk.y = pack2(v[2], v[3]);
    *reinterpret_cast<uint2*>(Ct + (size_t)col * ldc + row) = pk;
  }
};
struct EpiInProj {
  bf16_t* ABt; bf16_t* z; float* xbcraw; float* dtraw; int seqlen;
  __device__ __forceinline__ void operator()(int row, int col, f32x4 v) const {
    if (col < 2048) {
      int ch = col & 1023, half = col >> 10;
      int b = row / seqlen, l = row - b * seqlen;
      uint2 pk; pk.x = pack2(v[0], v[1]); pk.y = pack2(v[2], v[3]);
      *reinterpret_cast<uint2*>(ABt + ((size_t)(b * 1024 + ch) * 4096 + half * 2048 + l)) = pk;
    } else if (col < 3072) {
#pragma unroll
      for (int r = 0; r < 4; ++r) z[(size_t)(row + r) * 1024 + (col - 2048)] = f2bf(v[r]);
    } else if (col < 4608) {
#pragma unroll
      for (int r = 0; r < 4; ++r) xbcraw[(size_t)(row + r) * DXBC + (col - 3072)] = v[r];
    } else if (col < 4640) {
#pragma unroll
      for (int r = 0; r < 4; ++r) dtraw[(size_t)(row + r) * 32 + (col - 4608)] = v[r];
    }
  }
};

__device__ void adaln_partial_task(const Params& p, int task, float* sm) {
  const int cb = task % 48, ks = task / 48, tid = threadIdx.x;
  float* sc = sm;
  __syncthreads();
  for (int i = tid; i < 5 * 64; i += NTHREADS) {
    int r = i >> 6, kk = i & 63;
    int k = ks * 64 + kk;
    float cv = (r < 4) ? p.c[r * D + k] : p.c_ctx[k];
    sc[i] = silu_f(cv);
  }
  __syncthreads();
  const int col = cb * 256 + tid;
  float a0 = 0, a1 = 0, a2 = 0, a3 = 0, a4 = 0;
  const float* wp = p.w_mod + (size_t)(ks * 64) * NMOD + col;
#pragma unroll 8
  for (int kk = 0; kk < 64; ++kk) {
    float wv = wp[(size_t)kk * NMOD];
    a0 += sc[kk] * wv; a1 += sc[64 + kk] * wv; a2 += sc[128 + kk] * wv; a3 += sc[192 + kk] * wv; a4 += sc[256 + kk] * wv;
  }
  float* pp = p.partial + (size_t)ks * 5 * NMOD + col;
  pp[0] = a0; pp[NMOD] = a1; pp[2 * NMOD] = a2; pp[3 * NMOD] = a3; pp[4 * NMOD] = a4;
}

__device__ void transpose_convert_task(const float* __restrict__ src, int ld, int c0, int rows, bf16_t* __restrict__ dst,
                                       int tr, int tc, float* sm) {
  float (*tile)[65] = reinterpret_cast<float (*)[65]>(sm);
  const int tid = threadIdx.x;
  __syncthreads();
  for (int i = tid; i < 64 * 64; i += NTHREADS) {
    int r = i >> 6, cc = i & 63;
    tile[r][cc] = src[(size_t)(tr * 64 + r) * ld + c0 + tc * 64 + cc];
  }
  __syncthreads();
  for (int i = tid; i < 64 * 32; i += NTHREADS) {
    int cc = i >> 5, r2 = (i & 31) * 2;
    uint32_t pk = pack2(tile[r2][cc], tile[r2 + 1][cc]);
    *reinterpret_cast<uint32_t*>(dst + (size_t)(tc * 64 + cc) * rows + tr * 64 + r2) = pk;
  }
}

__device__ void phase_prep(const Params& p, int bid, int nb, char* smem) {
  float* sm = reinterpret_cast<float*>(smem);
  const int tid = threadIdx.x;
  if (bid == 0 && tid < 64) p.ctr[tid] = 0u;
  {
    float* t256 = reinterpret_cast<float*>(smem + 20480);
    float* t2048 = reinterpret_cast<float*>(smem + 24576);
    t256[tid] = cospif((float)tid * (1.0f / 128.f));
    for (int i = tid; i < 2048; i += NTHREADS) t2048[i] = cospif((float)i * (1.0f / 1024.f));
    __syncthreads();
  }
  for (int t = bid; t < 48 * KSPLIT; t += nb) adaln_partial_task(p, t, sm);
  {
    const int nct = 41, nrt = 32;
    for (int t = bid; t < nct * nrt; t += nb) {
      int tc = t % nct, tr = t / nct;
      if (tc < 40) transpose_convert_task(p.w_in, DIN, 1024, D, p.w_in_t + (size_t)2048 * D, tr, tc, sm);
      else {
        float (*tile)[65] = reinterpret_cast<float (*)[65]>(sm);
        __syncthreads();
        for (int i = tid; i < 64 * 32; i += NTHREADS) {
          int r = i >> 5, cc = i & 31;
          tile[r][cc] = p.w_in[(size_t)(tr * 64 + r) * DIN + 1024 + 2560 + cc];
        }
        __syncthreads();
        for (int i = tid; i < 32 * 32; i += NTHREADS) {
          int cc = i >> 5, r2 = (i & 31) * 2;
          uint32_t pk = pack2(tile[r2][cc], tile[r2 + 1][cc]);
          *reinterpret_cast<uint32_t*>(p.w_in_t + (size_t)(2048 + 2560 + cc) * D + tr * 64 + r2) = pk;
        }
      }
    }
    for (size_t i = (size_t)bid * NTHREADS + tid; i < (size_t)96 * D / 8; i += (size_t)nb * NTHREADS)
      reinterpret_cast<uint4*>(p.w_in_t + (size_t)4640 * D)[i] = uint4{0, 0, 0, 0};
  }
  for (size_t i = (size_t)bid * NTHREADS + tid; i < (size_t)D * 1024 / 4; i += (size_t)nb * NTHREADS) {
    int k = (int)(i / 256), c4 = (int)(i % 256) * 4;
    float4 v = *reinterpret_cast<const float4*>(p.w_in + (size_t)k * DIN + c4);
    uint2 o; o.x = pack2(v.x, v.y); o.y = pack2(v.z, v.w);
    *reinterpret_cast<uint2*>(p.w_in_f + (size_t)k * 1024 + c4) = o;
  }
  {
    const float* t256 = reinterpret_cast<const float*>(smem + 20480);
    const float scale = 1.0f / sqrtf((float)L * 256.f);
    for (int i = bid * NTHREADS + tid; i < 4 * 256 * 256; i += nb * NTHREADS) {
      int d = i & 255, c = (i >> 8) & 255, g = i >> 16;
      float sc_ = 0.f, ss_ = 0.f;
      const float* wp = p.w_fmix + (size_t)g * 65536 + d;
#pragma unroll 8
      for (int m = 0; m < 256; ++m) {
        const int ph = (m * c) & 255;
        const float wv = wp[m * 256];
        sc_ += t256[ph] * wv; ss_ += t256[(ph - 64) & 255] * wv;
      }
      p.WcsT[((size_t)g * 512 + d) * 256 + c] = f2bf(sc_ * scale);
      p.WcsT[((size_t)g * 512 + 256 + d) * 256 + c] = f2bf(ss_ * scale);
    }
  }
  {
    const float* t2048 = reinterpret_cast<const float*>(smem + 24576);
    for (size_t i = (size_t)bid * NTHREADS + tid; i < (size_t)1024 * 2048 / 8; i += (size_t)nb * NTHREADS) {
      const int k = (int)(i / 256), j = (int)(i % 256) * 8;
      const bool iss = j >= 1024;
      float o[8];
#pragma unroll
      for (int e = 0; e < 8; ++e) {
        const int l = (j + e) & 1023;
        const int ph = (k * l) & 2047;
        o[e] = iss ? t2048[(ph - 512) & 2047] : t2048[ph];
      }
      uint4 pk; pk.x = pack2(o[0], o[1]); pk.y = pack2(o[2], o[3]); pk.z = pack2(o[4], o[5]); pk.w = pack2(o[6], o[7]);
      *reinterpret_cast<uint4*>(p.dftm + (size_t)k * 2048 + j) = pk;
    }
  }
}

__device__ void phase_fold(const Params& p, int bid, int nb, char* smem) {
  const int tid = threadIdx.x;
  for (int i = bid * NTHREADS + tid; i < 5 * NMOD; i += nb * NTHREADS) {
    int col = i % NMOD;
    float s = p.b_mod[col];
    for (int ks = 0; ks < KSPLIT; ++ks) s += p.partial[(size_t)ks * 5 * NMOD + i];
    p.mod[i] = s;
  }
  for (int t = bid; t < 256; t += nb) {
    int g = t >> 6, tm = (t & 63) >> 2, tn = t & 3;
    int n0 = tn * 128;
    int rowbase = (n0 < 256) ? (g * 256 + n0) : (1024 + g * 256 + (n0 - 256));
    EpiBf16T epi{p.w_in_t + (size_t)(rowbase - n0) * D, D};
    gemm_tile(p.w_in_f + g * 256, 1024, p.WcsT + (size_t)g * 512 * 256, 256, 256, tm * 128, n0, epi, smem);
  }
}

__device__ void phase_norm_mod(const Params& p, int bid, int nb, char* smem) {
  float* red = reinterpret_cast<float*>(smem);
  const int tid = threadIdx.x;
  for (int t = bid; t < T + TC; t += nb) {
    const bool isx = t < T;
    const float* src = isx ? (p.x + (size_t)t * D) : (p.ctx + (size_t)(t - T) * D);
    const int mrow = isx ? (t / L) : 4;
    bf16_t* dst = isx ? (p.hx + (size_t)t * D) : (p.hc + (size_t)(t - T) * D);
    float4 v0 = *reinterpret_cast<const float4*>(src + tid * 8);
    float4 v1 = *reinterpret_cast<const float4*>(src + tid * 8 + 4);
    float ss = v0.x * v0.x + v0.y * v0.y + v0.z * v0.z + v0.w * v0.w + v1.x * v1.x + v1.y * v1.y + v1.z * v1.z + v1.w * v1.w;
    ss = block_sum(ss, red);
    float rstd = rsqrtf(ss * (1.f / D) + EPS);
    const float* sh = p.mod + (size_t)mrow * NMOD + 0 * D + tid * 8;
    const float* sc = p.mod + (size_t)mrow * NMOD + 1 * D + tid * 8;
    const float* g = p.g_pre_mix + tid * 8;
    float vv[8] = {v0.x, v0.y, v0.z, v0.w, v1.x, v1.y, v1.z, v1.w};
    float o[8];
#pragma unroll
    for (int e = 0; e < 8; ++e) o[e] = vv[e] * rstd * g[e] * (1.f + sc[e]) + sh[e];
    uint4 pk; pk.x = pack2(o[0], o[1]); pk.y = pack2(o[2], o[3]); pk.z = pack2(o[4], o[5]); pk.w = pack2(o[6], o[7]);
    *reinterpret_cast<uint4*>(dst + tid * 8) = pk;
  }
}

__device__ __forceinline__ void convert_uv_units(const Params& p, size_t u0, size_t u1) {
  const size_t n16 = (size_t)16384 * D / 16;
  for (size_t i = u0 + threadIdx.x; i < u1; i += NTHREADS) {
    const float* s = (i < n16) ? p.eu : p.ev;
    uint8_t* d = (i < n16) ? p.U8 : p.V8;
    const size_t j = (i < n16) ? i : i - n16;
    uint32_t o[4];
#pragma unroll
    for (int q4 = 0; q4 < 4; ++q4) {
      const float4 v = *reinterpret_cast<const float4*>(s + j * 16 + q4 * 4);
      int pk = 0;
      pk = __builtin_amdgcn_cvt_pk_fp8_f32(v.x * 512.f, v.y * 512.f, pk, false);
      pk = __builtin_amdgcn_cvt_pk_fp8_f32(v.z * 512.f, v.w * 512.f, pk, true);
      o[q4] = (uint32_t)pk;
    }
    *reinterpret_cast<uint4*>(d + j * 16) = uint4{o[0], o[1], o[2], o[3]};
  }
}
__device__ void phase_inproj(const Params& p, int bid, int nb, char* smem) {
  if ((nb & 7) == 0) {
    const int x = bid & 7, rank = bid >> 3, per = nb >> 3;
    for (int s_ = rank; s_ < 296 + 13; s_ += per) {
      if (s_ < 296) {
        const int g = s_ >> 6, i = s_ & 63;
        int tm, tn;
        if (g < 4) { tm = 8 * x + (i & 7); tn = g * 8 + (i >> 3); }
        else { tm = 8 * x + (i & 7); tn = 32 + (i >> 3); }
        EpiInProj epi{p.ABt, p.z, p.xbcraw, p.dtraw, L};
        gemm_tile(p.hx, D, p.w_in_t, D, D, tm * 128, tn * 128, epi, smem);
      } else {
        const int u = x * 13 + (s_ - 296);
        EpiInProj epi{nullptr, nullptr, p.xbcraw_c, p.dtraw_c, CTX};
        gemm_tile(p.hc, D, p.w_in_t, D, D, (u / 13) * 128, 3072 + (u % 13) * 128, epi, smem);
      }
    }
    return;
  }
  const int ntx = 64 * 37, ntc = 8 * 13;
  for (int t = bid; t < ntx + ntc; t += nb) {
    if (t < ntx) {
      int tm = t / 37, tn = t % 37;
      EpiInProj epi{p.ABt, p.z, p.xbcraw, p.dtraw, L};
      gemm_tile(p.hx, D, p.w_in_t, D, D, tm * 128, tn * 128, epi, smem);
    } else {
      int u = t - ntx;
      int tm = u / 13, tn = u % 13;
      EpiInProj epi{nullptr, nullptr, p.xbcraw_c, p.dtraw_c, CTX};
      gemm_tile(p.hc, D, p.w_in_t, D, D, tm * 128, 3072 + tn * 128, epi, smem);
    }
  }
}

__device__ void ssm_pre_tile(const Params& p, int task, char* smem) {
  const bool isx = task < 3072;
  const int u = isx ? task : task - 3072;
  const int ntt = isx ? 32 : 4;
  const int ct = u % 24, tt = (u / 24) % ntt, b = u / (24 * ntt);
  const int seqlen = isx ? L : CTX;
  const float* raw = (isx ? p.xbcraw : p.xbcraw_c) + (size_t)b * seqlen * DXBC;
  const int l0 = tt * 64, c0 = ct * 64, tid = threadIdx.x;
  float (*rt)[65] = reinterpret_cast<float (*)[65]>(smem);
  float (*at)[65] = reinterpret_cast<float (*)[65]>(smem + 66 * 65 * 4);
  __syncthreads();
  for (int i = tid; i < 66 * 64; i += NTHREADS) {
    int r = i >> 6, cc = i & 63, l = l0 - 1 + r;
    rt[r][cc] = (l >= 0 && l < seqlen) ? raw[(size_t)l * DXBC + c0 + cc] : 0.f;
  }
  __syncthreads();
  for (int i = tid; i < 64 * 64; i += NTHREADS) {
    int r = i >> 6, cc = i & 63, c = c0 + cc;
    float acc = p.conv_b[c] + rt[r][cc] * p.conv_w[c] + rt[r + 1][cc] * p.conv_w[DXBC + c] + rt[r + 2][cc] * p.conv_w[2 * DXBC + c];
    at[r][cc] = silu_f(acc);
  }
  __syncthreads();
  const size_t trow0 = isx ? ((size_t)b * L + l0) : ((size_t)T + (size_t)b * CTX + l0);
  for (int i = tid; i < 64 * 32; i += NTHREADS) {
    int r = i >> 5, c2 = (i & 31) * 2;
    *reinterpret_cast<uint32_t*>(p.act_tm + (trow0 + r) * DXBC + c0 + c2) = pack2(at[r][c2], at[r][c2 + 1]);
  }
  if (c0 < 1280) {
    bf16_t* cm = (isx ? p.act_cm_x : p.act_cm_c) + (size_t)b * 1280 * seqlen;
    for (int i = tid; i < 64 * 32; i += NTHREADS) {
      int cc = i >> 5, r2 = (i & 31) * 2;
      *reinterpret_cast<uint32_t*>(cm + (size_t)(c0 + cc) * seqlen + l0 + r2) = pack2(at[r2][cc], at[r2 + 1][cc]);
    }
  }
}
__device__ void dft_fold_rows(const Params& p, int bid, int nb) {
  const int lane = threadIdx.x & 63, w = threadIdx.x >> 6;
  for (int row = bid * 4 + w; row < NB * 1024; row += nb * 4) {
    const bf16_t* A = p.ABt + (size_t)row * 4096;
    const bf16_t* Bv = A + 2048;
    bf16_t* F = p.Fs + (size_t)row * 2048;
    float alt = 0.f;
#pragma unroll 4
    for (int i = 0; i < 16; ++i) {
      const int l = i * 64 + lane;
      const float a = bf2f(A[l]), bb = bf2f(Bv[l]);
      const float ar = (l == 0) ? 0.f : bf2f(A[2048 - l]), br = (l == 0) ? bb : bf2f(Bv[2048 - l]);
      const float as = a + ar, bs = bb - br;
      F[l] = f2bf(as); F[1024 + l] = f2bf(bs);
      alt += (l & 1) ? -as : as;
    }
    alt = wave_sum(alt) + bf2f(A[1024]);
    if (lane == 0) { const int b = row >> 10, ch = row & 1023; p.ycat[((size_t)b * L + 1024) * D + ch] = f2bf(alt); }
  }
}
__device__ void phase_ssm_pre(const Params& p, int bid, int nb, char* smem) {
  const int tid = threadIdx.x;
  dft_fold_rows(p, bid, nb);
  for (int t = bid; t < 3072 + 384; t += nb) ssm_pre_tile(p, t, smem);
  for (int i = bid * NTHREADS + tid; i < (T + TC) * 32; i += nb * NTHREADS) {
    const bool isx = i < T * 32;
    const int ii = isx ? i : i - T * 32;
    const int t = ii >> 5, j = ii & 31;
    const float v = (isx ? p.dtraw : p.dtraw_c)[ii];
    float* df = isx ? p.dtf : p.dtf_c;
    float* db = isx ? p.dtb : p.dtb_c;
    if (j < 16) df[t * 16 + j] = softplus_f(v + p.dt_bias_f[j]);
    else db[t * 16 + (j - 16)] = softplus_f(v + p.dt_bias_b[j - 16]);
  }
}

__device__ __forceinline__ int swz16(int row, int chunk) { return row * 256 + ((chunk ^ (row & 15)) << 4); }
__device__ __forceinline__ int swz8(int row, int chunk) { return row * 128 + ((chunk ^ (row & 7)) << 4); }

#define LDS_BARRIER() asm volatile("s_waitcnt lgkmcnt(0)\n\ts_barrier" ::: "memory")
__device__ void ssd_task(const Params& p, int task, char* smem) {
  const int dir = task & 1, ph = (task >> 1) & 1, h = (task >> 2) & 15, b = task >> 6;
  const int tid = opaque_tid(), lane = tid & 63, w = tid >> 6;
  const int g = h >> 3, lr0 = lane & 15, lq0 = lane >> 4;
  const float a = -__expf(dir ? p.a_log_b[h] : p.a_log_f[h]);
  char* sCc = smem; char* sBc = smem + 16384; char* sBT = smem + 32768; char* sXT = smem + 49152; char* sHb = smem + 57344;
  float* se = reinterpret_cast<float*>(smem + 73728);
  float* sdt = se + 64; float* sw = se + 128; float* sy = se + 192; float* stot = se + 256;
  float* yo = dir ? p.yb : p.yf;
  f32x4 H[2][2];
#pragma unroll
  for (int i = 0; i < 2; ++i)
#pragma unroll
    for (int j = 0; j < 2; ++j) H[i][j] = f32x4{0.f, 0.f, 0.f, 0.f};
  __syncthreads();
  for (int i = tid; i < 512; i += NTHREADS) reinterpret_cast<uint4*>(sHb)[i] = uint4{0, 0, 0, 0};

  const int crow = tid >> 4, cch = tid & 15;
  const int trow = tid >> 3, tch = tid & 7;
  uint4 rC0, rC1, rC2, rC3, rB0, rB1, rB2, rB3, rT0, rT1, rT2, rT3, rX;
  rC0 = rC1 = rC2 = rC3 = rB0 = rB1 = rB2 = rB3 = uint4{0, 0, 0, 0};
  float rdt = 0.f;
#define SSD_PARAMS(st_)                                                                                                   \
  const bool isctx_ = (st_) < 4;                                                                                          \
  const int nch_ = isctx_ ? 4 : 32, ci_ = isctx_ ? (st_) : (st_) - 4;                                                     \
  const int c_ = dir ? (nch_ - 1 - ci_) : ci_;                                                                            \
  const int seqlen_ = isctx_ ? CTX : L;                                                                                   \
  const size_t trow0_ = isctx_ ? ((size_t)T + (size_t)b * CTX + c_ * 64) : ((size_t)b * L + c_ * 64);                     \
  const size_t drow0_ = (size_t)b * seqlen_ + c_ * 64;                                                                    \
  const float* dtp_ = isctx_ ? (dir ? p.dtb_c : p.dtf_c) : (dir ? p.dtb : p.dtf);                                         \
  const bf16_t* cm_ = (isctx_ ? p.act_cm_c : p.act_cm_x) + (size_t)b * 1280 * seqlen_ + c_ * 64;
#define SSD_PREFETCH(st_)                                                                                                 \
  do {                                                                                                                    \
    SSD_PARAMS(st_)                                                                                                       \
    if (w == 0) rdt = dtp_[(drow0_ + lane) * 16 + h];                                                                     \
    if (!isctx_) {                                                                                                        \
      const bf16_t* src = p.act_tm + (trow0_ + crow) * DXBC + g * 128 + cch * 8;                                          \
      rC0 = *reinterpret_cast<const uint4*>(src + 1280);             rB0 = *reinterpret_cast<const uint4*>(src + 1024);   \
      rC1 = *reinterpret_cast<const uint4*>(src + 16 * DXBC + 1280); rB1 = *reinterpret_cast<const uint4*>(src + 16 * DXBC + 1024); \
      rC2 = *reinterpret_cast<const uint4*>(src + 32 * DXBC + 1280); rB2 = *reinterpret_cast<const uint4*>(src + 32 * DXBC + 1024); \
      rC3 = *reinterpret_cast<const uint4*>(src + 48 * DXBC + 1280); rB3 = *reinterpret_cast<const uint4*>(src + 48 * DXBC + 1024); \
    }                                                                                                                     \
    const bf16_t* srt = cm_ + (size_t)(1024 + g * 128 + trow) * seqlen_ + tch * 8;                                        \
    rT0 = *reinterpret_cast<const uint4*>(srt);                                                                           \
    rT1 = *reinterpret_cast<const uint4*>(srt + (size_t)32 * seqlen_);                                                    \
    rT2 = *reinterpret_cast<const uint4*>(srt + (size_t)64 * seqlen_);                                                    \
    rT3 = *reinterpret_cast<const uint4*>(srt + (size_t)96 * seqlen_);                                                    \
    rX = *reinterpret_cast<const uint4*>(cm_ + (size_t)(h * 64 + ph * 32 + trow) * seqlen_ + tch * 8);                    \
  } while (0)

  for (int step = 0; step < 36; ++step) {
    SSD_PREFETCH(step);
    const bool isctx = step < 4;
    const int c = dir ? ((isctx ? 4 : 32) - 1 - (isctx ? step : step - 4)) : (isctx ? step : step - 4);
    const size_t trow0 = (size_t)b * L + c * 64;
    int lr = lr0, lq = lq0;
    asm volatile("" : "+v"(lr), "+v"(lq));
    LDS_BARRIER();
    if (w == 0) {
      const float dtv = rdt;
      float v = a * dtv;
      if (!dir) {
#pragma unroll
        for (int o = 1; o < 64; o <<= 1) { float n = __shfl_up(v, o); v += (lane >= o) ? n : 0.f; }
      } else {
#pragma unroll
        for (int o = 1; o < 64; o <<= 1) { float n = __shfl_down(v, o); v += (lane + o < 64) ? n : 0.f; }
      }
      const float etot = __shfl(v, dir ? 0 : 63);
      se[lane] = v; sdt[lane] = dtv; sw[lane] = dtv * __expf(etot - v); sy[lane] = __expf(v);
      if (lane == 0) stot[0] = etot;
    }
    if (!isctx) {
      const int oc = swz16(crow, cch);
      *reinterpret_cast<uint4*>(sCc + oc) = rC0;         *reinterpret_cast<uint4*>(sBc + oc) = rB0;
      *reinterpret_cast<uint4*>(sCc + oc + 4096) = rC1;  *reinterpret_cast<uint4*>(sBc + oc + 4096) = rB1;
      *reinterpret_cast<uint4*>(sCc + oc + 8192) = rC2;  *reinterpret_cast<uint4*>(sBc + oc + 8192) = rB2;
      *reinterpret_cast<uint4*>(sCc + oc + 12288) = rC3; *reinterpret_cast<uint4*>(sBc + oc + 12288) = rB3;
    }
    {
      const int ot = swz8(trow, tch);
      *reinterpret_cast<uint4*>(sBT + ot) = rT0;
      *reinterpret_cast<uint4*>(sBT + ot + 4096) = rT1;
      *reinterpret_cast<uint4*>(sBT + ot + 8192) = rT2;
      *reinterpret_cast<uint4*>(sBT + ot + 12288) = rT3;
      *reinterpret_cast<uint4*>(sXT + ot) = rX;
    }
    LDS_BARRIER();
    const float etot = stot[0];
    if (!isctx) {
      f32x4 G[4];
      bf16x8 ca[4];
#pragma unroll
      for (int j = 0; j < 4; ++j) G[j] = f32x4{0.f, 0.f, 0.f, 0.f};
#pragma unroll
      for (int kk = 0; kk < 4; ++kk) ca[kk] = *reinterpret_cast<const bf16x8*>(sCc + swz16(16 * w + lr, kk * 4 + lq));
#pragma unroll
      for (int kk = 0; kk < 4; ++kk)
#pragma unroll
        for (int j = 0; j < 4; ++j) {
          bf16x8 bb = *reinterpret_cast<const bf16x8*>(sBc + swz16(16 * j + lr, kk * 4 + lq));
          G[j] = __builtin_amdgcn_mfma_f32_16x16x32_bf16(ca[kk], bb, G[j], 0, 0, 0);
        }
      LDS_BARRIER();
      float el[4];
#pragma unroll
      for (int r = 0; r < 4; ++r) el[r] = se[16 * w + lq * 4 + r];
#pragma unroll
      for (int j = 0; j < 4; ++j) {
        const int s_ = 16 * j + lr;
        const float es = se[s_], ds = sdt[s_];
#pragma unroll
        for (int r = 0; r < 4; ++r) {
          const int l = 16 * w + lq * 4 + r;
          const bool keep = dir ? (s_ >= l) : (s_ <= l);
          const float m = keep ? G[j][r] * __expf(el[r] - es) * ds : 0.f;
          *reinterpret_cast<bf16_t*>(sBc + swz8(l, s_ >> 3) + (s_ & 7) * 2) = f2bf(m);
        }
      }
      LDS_BARRIER();
      f32x4 Y[2], Yo[2];
#pragma unroll
      for (int j = 0; j < 2; ++j) { Y[j] = f32x4{0.f, 0.f, 0.f, 0.f}; Yo[j] = f32x4{0.f, 0.f, 0.f, 0.f}; }
#pragma unroll
      for (int kk = 0; kk < 2; ++kk) {
        bf16x8 ma = *reinterpret_cast<const bf16x8*>(sBc + swz8(16 * w + lr, kk * 4 + lq));
#pragma unroll
        for (int j = 0; j < 2; ++j) {
          bf16x8 xb = *reinterpret_cast<const bf16x8*>(sXT + swz8(16 * j + lr, kk * 4 + lq));
          Y[j] = __builtin_amdgcn_mfma_f32_16x16x32_bf16(ma, xb, Y[j], 0, 0, 0);
        }
      }
#pragma unroll
      for (int kk = 0; kk < 4; ++kk)
#pragma unroll
        for (int j = 0; j < 2; ++j) {
          bf16x8 hb = *reinterpret_cast<const bf16x8*>(sHb + swz16(16 * j + lr, kk * 4 + lq));
          Yo[j] = __builtin_amdgcn_mfma_f32_16x16x32_bf16(ca[kk], hb, Yo[j], 0, 0, 0);
        }
      float syl[4];
#pragma unroll
      for (int r = 0; r < 4; ++r) syl[r] = sy[16 * w + lq * 4 + r];
#pragma unroll
      for (int j = 0; j < 2; ++j)
#pragma unroll
        for (int r = 0; r < 4; ++r) {
          const int l = 16 * w + lq * 4 + r;
          yo[(trow0 + l) * 1024 + h * 64 + ph * 32 + 16 * j + lr] = Y[j][r] + syl[r] * Yo[j][r];
        }
    }
    {
      const float dec = __expf(etot);
#pragma unroll
      for (int i = 0; i < 2; ++i)
#pragma unroll
        for (int j = 0; j < 2; ++j) H[i][j] *= dec;
#pragma unroll
      for (int kk = 0; kk < 2; ++kk) {
        const int s0 = kk * 32 + lq * 8;
        const float4 w0 = *reinterpret_cast<const float4*>(sw + s0), w1 = *reinterpret_cast<const float4*>(sw + s0 + 4);
        bf16x8 xs[2];
#pragma unroll
        for (int i = 0; i < 2; ++i) {
          const bf16x8 xa = *reinterpret_cast<const bf16x8*>(sXT + swz8(16 * i + lr, kk * 4 + lq));
          xs[i][0] = (short)f2bf(bf2f((bf16_t)xa[0]) * w0.x); xs[i][1] = (short)f2bf(bf2f((bf16_t)xa[1]) * w0.y);
          xs[i][2] = (short)f2bf(bf2f((bf16_t)xa[2]) * w0.z); xs[i][3] = (short)f2bf(bf2f((bf16_t)xa[3]) * w0.w);
          xs[i][4] = (short)f2bf(bf2f((bf16_t)xa[4]) * w1.x); xs[i][5] = (short)f2bf(bf2f((bf16_t)xa[5]) * w1.y);
          xs[i][6] = (short)f2bf(bf2f((bf16_t)xa[6]) * w1.z); xs[i][7] = (short)f2bf(bf2f((bf16_t)xa[7]) * w1.w);
        }
#pragma unroll
        for (int j = 0; j < 2; ++j) {
          const bf16x8 bt = *reinterpret_cast<const bf16x8*>(sBT + swz8(16 * (2 * w + j) + lr, kk * 4 + lq));
#pragma unroll
          for (int i = 0; i < 2; ++i) H[i][j] = __builtin_amdgcn_mfma_f32_16x16x32_bf16(xs[i], bt, H[i][j], 0, 0, 0);
        }
      }
    }
    LDS_BARRIER();
#pragma unroll
    for (int i = 0; i < 2; ++i)
#pragma unroll
      for (int j = 0; j < 2; ++j) {
        const int n = 16 * (2 * w + j) + lr;
#pragma unroll
        for (int r = 0; r < 4; ++r) {
          const int pr = 16 * i + lq * 4 + r;
          *reinterpret_cast<bf16_t*>(sHb + swz16(pr, n >> 3) + (n & 7) * 2) = f2bf(H[i][j][r]);
        }
      }
  }
#undef SSD_PREFETCH
#undef SSD_PARAMS
}

#undef LDS_BARRIER
__device__ void phase_ssd_dft(const Params& p, int bid, int nb, char* smem) {
  for (int t = bid; t < 256; t += nb) ssd_task(p, t, smem);
  int* stile = reinterpret_cast<int*>(smem + 75776);
  for (;;) {
    __syncthreads();
    if (threadIdx.x == 0) *stile = (int)atomicAdd(p.ctr, 1u);
    __syncthreads();
    const int t = *stile;
    if (t >= 4 * 8 * 8) break;
    const int b = t >> 6, tm = (t & 63) >> 3, tn = t & 7;
    const bf16_t* Fb = p.Fs + (size_t)b * 1024 * 2048;
    f32x4 accC[4][4], accS[4][4];
    gemm_mainloop(p.dftm, 2048, Fb, 2048, 1024, tm * 128, tn * 128, accC, smem);
    gemm_mainloop(p.dftm + 1024, 2048, Fb + 1024, 2048, 1024, tm * 128, tn * 128, accS, smem);
    const int lane = threadIdx.x & 63, w = threadIdx.x >> 6, wm = w >> 1, wn = w & 1;
#pragma unroll
    for (int i = 0; i < 4; ++i) {
      int lq_ = lane >> 4, lr_ = lane & 15;
      asm volatile("" : "+v"(lq_), "+v"(lr_));
#pragma unroll
      for (int j = 0; j < 4; ++j) {
        const int k0 = tm * 128 + wm * 64 + i * 16 + lq_ * 4;
        const int ch = tn * 128 + wn * 64 + j * 16 + lr_;
        const float a = bf2f(p.ABt[((size_t)b * 1024 + ch) * 4096 + 1024]);
#pragma unroll
        for (int r = 0; r < 4; ++r) {
          const int k = k0 + r;
          const float as = (k & 1) ? -a : a;
          const float c = accC[i][j][r], sn = accS[i][j][r];
          p.ycat[((size_t)b * L + k) * D + ch] = f2bf(c - sn + as);
          if (k > 0) p.ycat[((size_t)b * L + (L - k)) * D + ch] = f2bf(c + sn + as);
        }
      }
    }
  }
  for (;;) {
    __syncthreads();
    if (threadIdx.x == 0) *stile = (int)atomicAdd(p.ctr + 8, 1u);
    __syncthreads();
    const int q = *stile;
    if (q >= 1024 + 1536) break;
    if (q < 1024) convert_uv_units(p, (size_t)q * 4096, (size_t)(q + 1) * 4096);
    else if (q < 1024 + 1024) { const int q1 = q - 1024; transpose_convert_task(p.w_out, D, 0, D, p.w_out_t, q1 / 32, q1 % 32, reinterpret_cast<float*>(smem)); }
    else { const int q2 = q - 2048; transpose_convert_task(p.w_query, 1024, 0, D, p.w_q_t, q2 / 16, q2 % 16, reinterpret_cast<float*>(smem)); }
  }
}

__device__ void phase_ssm_post(const Params& p, int bid, int nb, char* smem) {
  float* red = reinterpret_cast<float*>(smem);
  const int tid = threadIdx.x, w = tid >> 6;
  for (int t = bid; t < T; t += nb) {
    const int c0 = tid * 4;
    const int h = c0 >> 6;
    const float dsk = p.d_skip_f[h] + p.d_skip_b[h];
    float4 a = *reinterpret_cast<const float4*>(p.yf + (size_t)t * 1024 + c0);
    float4 bq = *reinterpret_cast<const float4*>(p.yb + (size_t)t * 1024 + c0);
    uint2 xq = *reinterpret_cast<const uint2*>(p.act_tm + (size_t)t * DXBC + c0);
    float xs[4] = {bflo(xq.x), bfhi(xq.x), bflo(xq.y), bfhi(xq.y)};
    uint2 zz = *reinterpret_cast<const uint2*>(p.z + (size_t)t * 1024 + c0);
    float zf[4] = {bflo(zz.x), bfhi(zz.x), bflo(zz.y), bfhi(zz.y)};
    float y[4] = {a.x + bq.x + dsk * xs[0], a.y + bq.y + dsk * xs[1], a.z + bq.z + dsk * xs[2], a.w + bq.w + dsk * xs[3]};
    float ss = 0.f;
#pragma unroll
    for (int e = 0; e < 4; ++e) { y[e] *= silu_f(zf[e]); ss += y[e] * y[e]; }
    ss = wave_sum(ss);
    __syncthreads();
    if ((tid & 63) == 0) red[w] = ss;
    __syncthreads();
    float gs = (w < 2) ? (red[0] + red[1]) : (red[2] + red[3]);
    float rstd = rsqrtf(gs * (1.f / 512.f) + EPS);
    float4 nw = *reinterpret_cast<const float4*>(p.ssm_norm_w + c0);
    uint2 o; o.x = pack2(y[0] * rstd * nw.x, y[1] * rstd * nw.y); o.y = pack2(y[2] * rstd * nw.z, y[3] * rstd * nw.w);
    *reinterpret_cast<uint2*>(p.ycat + (size_t)t * D + 1024 + c0) = o;
  }
}

__device__ void phase_outproj(const Params& p, int bid, int nb, char* smem) {
  if ((nb & 7) == 0) {
    const int x = bid & 7, rank = bid >> 3, per = nb >> 3;
    for (int s_ = rank; s_ < 128; s_ += per) {
      const int g = s_ >> 6, i = s_ & 63;
      EpiF32 epi{p.y_x, D};
      gemm_tile(p.ycat, D, p.w_out_t, D, D, (8 * x + (i & 7)) * 128, (g * 8 + (i >> 3)) * 128, epi, smem);
    }
    return;
  }
  for (int t = bid; t < 64 * 16; t += nb) {
    EpiF32 epi{p.y_x, D};
    gemm_tile(p.ycat, D, p.w_out_t, D, D, (t >> 4) * 128, (t & 15) * 128, epi, smem);
  }
}
__device__ void phase_postmix(const Params& p, int bid, int nb, char* smem) {
  float* red = reinterpret_cast<float*>(smem);
  const int tid = threadIdx.x;
  for (int t = bid; t < T; t += nb) {
    const int b = t / L;
    const float* yr = p.y_x + (size_t)t * D + tid * 8;
    const float* xr = p.x + (size_t)t * D + tid * 8;
    float y[8], xv[8];
    *reinterpret_cast<float4*>(y) = *reinterpret_cast<const float4*>(yr);
    *reinterpret_cast<float4*>(y + 4) = *reinterpret_cast<const float4*>(yr + 4);
    *reinterpret_cast<float4*>(xv) = *reinterpret_cast<const float4*>(xr);
    *reinterpret_cast<float4*>(xv + 4) = *reinterpret_cast<const float4*>(xr + 4);
    float ss = 0.f;
#pragma unroll
    for (int e = 0; e < 8; ++e) ss += y[e] * y[e];
    ss = block_sum(ss, red);
    float rstd = rsqrtf(ss * (1.f / D) + EPS);
    const float* gm = p.mod + (size_t)b * NMOD + 2 * D + tid * 8;
    const float* gp = p.g_post_mix + tid * 8;
    float x1[8]; float ss1 = 0.f;
#pragma unroll
    for (int e = 0; e < 8; ++e) { x1[e] = xv[e] + gm[e] * (y[e] * rstd * gp[e]); ss1 += x1[e] * x1[e]; }
    ss1 = block_sum(ss1, red);
    float rstd1 = rsqrtf(ss1 * (1.f / D) + EPS);
    float* o = p.out + (size_t)t * D + tid * 8;
    *reinterpret_cast<float4*>(o) = *reinterpret_cast<float4*>(x1);
    *reinterpret_cast<float4*>(o + 4) = *reinterpret_cast<float4*>(x1 + 4);
    const float* sf = p.mod + (size_t)b * NMOD + 3 * D + tid * 8;
    const float* cf = p.mod + (size_t)b * NMOD + 4 * D + tid * 8;
    const float* gf = p.g_pre_ffn + tid * 8;
    float h2[8];
#pragma unroll
    for (int e = 0; e < 8; ++e) h2[e] = x1[e] * rstd1 * gf[e] * (1.f + cf[e]) + sf[e];
    uint4 pk; pk.x = pack2(h2[0], h2[1]); pk.y = pack2(h2[2], h2[3]); pk.z = pack2(h2[4], h2[5]); pk.w = pack2(h2[6], h2[7]);
    *reinterpret_cast<uint4*>(p.hx + (size_t)t * D + tid * 8) = pk;
  }
}

__device__ __forceinline__ uint32_t mono_key(float f) {
  uint32_t u = __float_as_uint(f);
  return (u & 0x80000000u) ? ~u : (u | 0x80000000u);
}
__device__ __forceinline__ void ins16(uint32_t (&Lk)[16], uint32_t x) {
#pragma unroll
  for (int i = 0; i < 16; ++i) { uint32_t hi = max(Lk[i], x); x = min(Lk[i], x); Lk[i] = hi; }
}
__device__ __forceinline__ float unmono_key(uint32_t k) {
  return __uint_as_float((k & 0x80000000u) ? (k ^ 0x80000000u) : ~k);
}
typedef __attribute__((ext_vector_type(16))) float f32x16;
__device__ void phase_q_route(const Params& p, int bid, int nb, char* smem) {
  const int tid = opaque_tid(), lane = tid & 63, w = tid >> 6;
  const int wm = w >> 1, wn = w & 1, lr = lane & 15, lq = lane >> 4;
  const int l31 = lane & 31, lh = lane >> 5;
  for (int tile0 = bid; tile0 < 512; tile0 += nb) {
    const int tile = ((nb & 7) == 0 && nb >= 512) ? (((tile0 & 7) * 8 + ((tile0 >> 3) & 7)) * 8 + (tile0 >> 6)) : tile0;
    const int h = tile & 7, m0 = (tile >> 3) * 128;
    {
      f32x4 acc[4][4];
      gemm_mainloop(p.hx, D, p.w_q_t, D, D, m0, h * 128, acc, smem);
#pragma unroll
      for (int i = 0; i < 4; ++i)
#pragma unroll
        for (int j = 0; j < 4; ++j)
#pragma unroll
          for (int r = 0; r < 4; ++r) {
            const int row = wm * 64 + i * 16 + lq * 4 + r, col = wn * 64 + j * 16 + lr;
            *reinterpret_cast<bf16_t*>(smem + swz16(row, col >> 3) + (col & 7) * 2) = f2bf(acc[i][j][r]);
          }
    }
#pragma unroll 4
    for (int r = 0; r < 16; ++r) {
      const int id = tid + 256 * r, row = id >> 4, c4 = id & 15;
      const float* src = ((row < 128) ? p.sk1 : p.sk2) + ((size_t)(h * 128 + (row & 127)) * 64 + c4 * 4);
      const float4 v = *reinterpret_cast<const float4*>(src);
      uint2 pk; pk.x = pack2(v.x, v.y); pk.y = pack2(v.z, v.w);
      *reinterpret_cast<uint2*>(smem + 32768 + swz8(row, c4 >> 1) + (c4 & 1) * 8) = pk;
    }
    __syncthreads();
    uint32_t L1[16], L2[16];
#pragma unroll
    for (int sd = 0; sd < 2; ++sd) {
      uint32_t Lk[16];
#pragma unroll
      for (int i = 0; i < 16; ++i) Lk[i] = 0u;
      const uint32_t kb = (uint32_t)(lh * 4);
#pragma unroll
      for (int ih = 0; ih < 2; ++ih) {
        f32x16 Sa[2];
#pragma unroll
        for (int i = 0; i < 2; ++i)
#pragma unroll
          for (int g2 = 0; g2 < 16; ++g2) Sa[i][g2] = 0.f;
#pragma unroll
        for (int ks = 0; ks < 4; ++ks) {
          const bf16x8 qb = *reinterpret_cast<const bf16x8*>(smem + swz16(w * 32 + l31, sd * 8 + ks * 2 + lh));
#pragma unroll
          for (int i = 0; i < 2; ++i) {
            const bf16x8 ka = *reinterpret_cast<const bf16x8*>(smem + 32768 + swz8(sd * 128 + (ih * 2 + i) * 32 + l31, ks * 2 + lh));
            Sa[i] = __builtin_amdgcn_mfma_f32_32x32x16_bf16(ka, qb, Sa[i], 0, 0, 0);
          }
        }
#pragma unroll
        for (int i = 0; i < 2; ++i)
#pragma unroll
          for (int g2 = 0; g2 < 16; ++g2)
            ins16(Lk, (mono_key(Sa[i][g2]) & ~0x7Fu) | (uint32_t)((ih * 2 + i) * 32 + (g2 & 3) + 8 * (g2 >> 2)) | kb);
      }
#pragma unroll
      for (int i = 0; i < 8; ++i) {
        const uint32_t t1 = (uint32_t)__shfl_xor((int)Lk[15 - i], 32), t2 = (uint32_t)__shfl_xor((int)Lk[i], 32);
        Lk[i] = max(Lk[i], t1); Lk[15 - i] = max(Lk[15 - i], t2);
      }
#pragma unroll
      for (int dd = 8; dd >= 1; dd >>= 1)
#pragma unroll
        for (int i = 0; i < 16; ++i)
          if ((i & dd) == 0) { const uint32_t hi = max(Lk[i], Lk[i + dd]), lo = min(Lk[i], Lk[i + dd]); Lk[i] = hi; Lk[i + dd] = lo; }
#pragma unroll
      for (int r = 0; r < 16; ++r) { if (sd == 0) L1[r] = Lk[r]; else L2[r] = Lk[r]; }
    }
    __syncthreads();
    uint32_t* ib = reinterpret_cast<uint32_t*>(smem) + w * 1088 + l31 * 34;
    if (lh == 0) {
#pragma unroll
      for (int r = 0; r < 16; ++r) { ib[r] = L1[r] & 127u; ib[16 + r] = L2[r] & 127u; }
    }
    float v1[16], v2[16];
#pragma unroll
    for (int r = 0; r < 16; ++r) { v1[r] = unmono_key(L1[r] & ~0x7Fu); v2[r] = unmono_key(L2[r] & ~0x7Fu); }
    uint32_t C[16];
#pragma unroll
    for (int i = 0; i < 16; ++i) C[i] = 0u;
#pragma unroll
    for (int a = 0; a < 16; ++a)
#pragma unroll
      for (int bq = 0; bq < 16; ++bq)
        if ((a + 1) * (bq + 1) <= 16) ins16(C, (mono_key(v1[a] + v2[bq]) & ~0xFFu) | (uint32_t)(a * 16 + bq));
    float ts[16]; int te[16];
    __builtin_amdgcn_wave_barrier();
#pragma unroll
    for (int r = 0; r < 16; ++r) {
      const uint32_t code = C[r] & 0xFFu;
      te[r] = (int)(ib[code >> 4] * 128u + ib[16 + (code & 15u)]);
      ts[r] = unmono_key(C[r] & ~0xFFu);
    }
    const float mx = ts[0];
    float den = 0.f;
#pragma unroll
    for (int r = 0; r < 16; ++r) { ts[r] = __expf(ts[r] - mx); den += ts[r]; }
    const float inv = 1.f / den;
    const size_t ob = (size_t)(m0 + w * 32 + l31) * 128 + h * 16;
    if (lh == 0) {
#pragma unroll
      for (int r = 0; r < 16; r += 4) *reinterpret_cast<int4*>(p.idx + ob + r) = int4{te[r], te[r + 1], te[r + 2], te[r + 3]};
    } else {
#pragma unroll
      for (int r = 0; r < 16; r += 4)
        *reinterpret_cast<float4*>(p.gate + ob + r) = float4{ts[r] * inv, ts[r + 1] * inv, ts[r + 2] * inv, ts[r + 3] * inv};
    }
    __syncthreads();
  }
}

typedef __attribute__((ext_vector_type(2))) float f32x2;
__device__ __forceinline__ void fp8x16_to_f32(const uint4 q, f32x2 (&o)[8]) {
  o[0] = __builtin_amdgcn_cvt_pk_f32_fp8((int)q.x, false); o[1] = __builtin_amdgcn_cvt_pk_f32_fp8((int)q.x, true);
  o[2] = __builtin_amdgcn_cvt_pk_f32_fp8((int)q.y, false); o[3] = __builtin_amdgcn_cvt_pk_f32_fp8((int)q.y, true);
  o[4] = __builtin_amdgcn_cvt_pk_f32_fp8((int)q.z, false); o[5] = __builtin_amdgcn_cvt_pk_f32_fp8((int)q.z, true);
  o[6] = __builtin_amdgcn_cvt_pk_f32_fp8((int)q.w, false); o[7] = __builtin_amdgcn_cvt_pk_f32_fp8((int)q.w, true);
}
template <int CTRL>
__device__ __forceinline__ float dpp_mov(float v) {
  return __int_as_float(__builtin_amdgcn_update_dpp(0, __float_as_int(v), CTRL, 0xF, 0xF, true));
}
__device__ __forceinline__ unsigned my_xcc_id() { return (unsigned)__builtin_amdgcn_s_getreg((3 << 11) | 20) & 7u; }

__device__ void phase_exp_u(const Params& p, char* smem) {
  const int tid = opaque_tid(), lane = tid & 63, w = tid >> 6;
  const int sub = lane >> 4, cc = lane & 15;
  const unsigned myx = my_xcc_id();
  int* sh = reinterpret_cast<int*>(smem);
  int* si = reinterpret_cast<int*>(smem + 64) + w * 256;
  float* pbuf = reinterpret_cast<float*>(p.ycat);
  {
    unsigned qcur = 0;
    for (;;) {
      __syncthreads();
      if (tid == 0) {
        int found = -1; unsigned fx = 0;
        for (; qcur < 8; ++qcur) {
          fx = (myx + qcur) & 7u;
          const int c = (int)atomicAdd(&p.ctr[16 + fx], 1u);
          if (c < 512) { found = c; break; }
        }
        sh[0] = found; sh[1] = (int)fx;
      }
      __syncthreads();
      const int chunk = sh[0];
      const unsigned x = (unsigned)sh[1];
      if (chunk < 0) break;
      for (int tt = 0; tt < 4; ++tt) {
        const int t = chunk * 16 + w * 4 + tt;
        __builtin_amdgcn_wave_barrier();
        si[lane] = p.idx[(size_t)t * 128 + lane]; si[64 + lane] = p.idx[(size_t)t * 128 + 64 + lane];
        __builtin_amdgcn_wave_barrier();
        f32x2 hf[8];
#pragma unroll
        for (int q2 = 0; q2 < 2; ++q2) {
          const uint4 hq = *reinterpret_cast<const uint4*>(p.hx + (size_t)t * D + x * 256 + cc * 16 + q2 * 8);
          hf[q2 * 4 + 0] = f32x2{bflo(hq.x), bfhi(hq.x)}; hf[q2 * 4 + 1] = f32x2{bflo(hq.y), bfhi(hq.y)};
          hf[q2 * 4 + 2] = f32x2{bflo(hq.z), bfhi(hq.z)}; hf[q2 * 4 + 3] = f32x2{bflo(hq.w), bfhi(hq.w)};
        }
        const uint8_t* ub = p.U8 + x * 256 + cc * 16;
#pragma unroll 1
        for (int j0 = 0; j0 < 32; j0 += 16) {
          uint4 uq[16];
#pragma unroll
          for (int k = 0; k < 16; ++k) uq[k] = *reinterpret_cast<const uint4*>(ub + (size_t)si[(j0 + k) * 4 + sub] * D);
          float mine = 0.f;
#pragma unroll
          for (int k = 0; k < 16; ++k) {
            f32x2 uf[8];
            fp8x16_to_f32(uq[k], uf);
            f32x2 d2 = hf[0] * uf[0];
#pragma unroll
            for (int e = 1; e < 8; ++e) d2 += hf[e] * uf[e];
            float d = d2.x + d2.y;
            d += dpp_mov<0xB1>(d); d += dpp_mov<0x4E>(d); d += dpp_mov<0x124>(d); d += dpp_mov<0x128>(d);
            mine = (cc == k) ? d : mine;
          }
          pbuf[((size_t)x * T + t) * 128 + (j0 + cc) * 4 + sub] = mine * (1.f / 512.f);
        }
      }
    }
  }
}

__device__ void phase_exp_v(const Params& p, char* smem) {
  const int tid = opaque_tid(), lane = tid & 63, w = tid >> 6;
  const int sub = lane >> 4, cc = lane & 15;
  const unsigned myx = my_xcc_id();
  int* sh = reinterpret_cast<int*>(smem);
  int* si = reinterpret_cast<int*>(smem + 64) + w * 256;
  float* sc = reinterpret_cast<float*>(si + 128);
  float* yf = p.y_x;
  {
    unsigned qcur = 0;
    for (;;) {
      __syncthreads();
      if (tid == 0) {
        int found = -1; unsigned fx = 0;
        for (; qcur < 8; ++qcur) {
          fx = (myx + qcur) & 7u;
          const int c = (int)atomicAdd(&p.ctr[32 + fx], 1u);
          if (c < 512) { found = c; break; }
        }
        sh[0] = found; sh[1] = (int)fx;
      }
      __syncthreads();
      const int chunk = sh[0];
      const unsigned x = (unsigned)sh[1];
      if (chunk < 0) break;
      for (int tt = 0; tt < 4; ++tt) {
        const int t = chunk * 16 + w * 4 + tt;
        __builtin_amdgcn_wave_barrier();
        si[lane] = p.idx[(size_t)t * 128 + lane]; si[64 + lane] = p.idx[(size_t)t * 128 + 64 + lane];
        {
          const float* pb = reinterpret_cast<const float*>(p.ycat) + (size_t)t * 128;
          float d0 = 0.f, d1 = 0.f;
#pragma unroll
          for (int xs = 0; xs < 8; ++xs) { d0 += pb[(size_t)xs * T * 128 + lane]; d1 += pb[(size_t)xs * T * 128 + 64 + lane]; }
          sc[lane] = p.gate[(size_t)t * 128 + lane] * 0.5f * d0 * (1.f + erff(d0 * 0.70710678118654752f));
          sc[64 + lane] = p.gate[(size_t)t * 128 + 64 + lane] * 0.5f * d1 * (1.f + erff(d1 * 0.70710678118654752f));
        }
        __builtin_amdgcn_wave_barrier();
        f32x2 acc[8];
#pragma unroll
        for (int e = 0; e < 8; ++e) acc[e] = f32x2{0.f, 0.f};
        const uint8_t* vb = p.V8 + x * 256 + cc * 16;
#pragma unroll 1
        for (int j0 = 0; j0 < 32; j0 += 16) {
          uint4 vq[16]; float cf[16];
#pragma unroll
          for (int k = 0; k < 16; ++k) {
            const int j = (j0 + k) * 4 + sub;
            vq[k] = *reinterpret_cast<const uint4*>(vb + (size_t)si[j] * D);
            cf[k] = sc[j];
          }
#pragma unroll
          for (int k = 0; k < 16; ++k) {
            f32x2 vf[8];
            fp8x16_to_f32(vq[k], vf);
            const f32x2 c2 = f32x2{cf[k], cf[k]};
#pragma unroll
            for (int e = 0; e < 8; ++e) acc[e] += c2 * vf[e];
          }
        }
        {
          float* red = reinterpret_cast<float*>(smem + 8192) + w * 1280;
          float* mr = red + (sub * 16 + cc) * 20;
#pragma unroll
          for (int q4 = 0; q4 < 4; ++q4)
            *reinterpret_cast<float4*>(mr + q4 * 4) = float4{acc[q4 * 2].x, acc[q4 * 2].y, acc[q4 * 2 + 1].x, acc[q4 * 2 + 1].y};
          __builtin_amdgcn_wave_barrier();
          const int part = sub;
          float4 r0 = *reinterpret_cast<const float4*>(red + (0 * 16 + cc) * 20 + part * 4);
          float4 r1 = *reinterpret_cast<const float4*>(red + (1 * 16 + cc) * 20 + part * 4);
          float4 r2 = *reinterpret_cast<const float4*>(red + (2 * 16 + cc) * 20 + part * 4);
          float4 r3 = *reinterpret_cast<const float4*>(red + (3 * 16 + cc) * 20 + part * 4);
          const float sc512 = 1.f / 512.f;
          float4 o4 = float4{(r0.x + r1.x + r2.x + r3.x) * sc512, (r0.y + r1.y + r2.y + r3.y) * sc512,
                             (r0.z + r1.z + r2.z + r3.z) * sc512, (r0.w + r1.w + r2.w + r3.w) * sc512};
          *reinterpret_cast<float4*>(yf + (size_t)t * D + x * 256 + cc * 16 + part * 4) = o4;
          __builtin_amdgcn_wave_barrier();
        }
      }
    }
  }
}

__device__ void phase_exp_final(const Params& p, int bid, int nb, char* smem) {
  float* red = reinterpret_cast<float*>(smem);
  const int tid = threadIdx.x;
  const float* yf = p.y_x;
  for (int t = bid; t < T; t += nb) {
    const int b = t / L;
    const float* yr = yf + (size_t)t * D + tid * 8;
    float y[8];
    *reinterpret_cast<float4*>(y) = *reinterpret_cast<const float4*>(yr);
    *reinterpret_cast<float4*>(y + 4) = *reinterpret_cast<const float4*>(yr + 4);
    float ss = 0.f;
#pragma unroll
    for (int e = 0; e < 8; ++e) ss += y[e] * y[e];
    ss = block_sum(ss, red);
    const float rstd = rsqrtf(ss * (1.f / D) + EPS);
    const float* gfx = p.mod + (size_t)b * NMOD + 5 * D + tid * 8;
    const float* gp = p.g_post_ffn + tid * 8;
    float* o = p.out + (size_t)t * D + tid * 8;
    float xo[8];
    *reinterpret_cast<float4*>(xo) = *reinterpret_cast<const float4*>(o);
    *reinterpret_cast<float4*>(xo + 4) = *reinterpret_cast<const float4*>(o + 4);
#pragma unroll
    for (int e = 0; e < 8; ++e) xo[e] += gfx[e] * (y[e] * rstd * gp[e]);
    *reinterpret_cast<float4*>(o) = *reinterpret_cast<float4*>(xo);
    *reinterpret_cast<float4*>(o + 4) = *reinterpret_cast<float4*>(xo + 4);
  }
}

#define XB_TMO      128
#define XB_XCNT(j)  (256  + 64 * (j))
#define XB_XSUB(j)  (1280 + 64 * (j))
#define XB_XGEN(j)  (2304 + 64 * (j))
#define XB_TOP      3328
#define XB_TOPGEN   3392
#define XCD_BAR_WORDS 3456
#define XB_SPIN_CAP (1u << 22)
#define LAS __attribute__((address_space(3)))
__device__ __forceinline__ unsigned xb_ld(unsigned* p)              { return __hip_atomic_load(p, __ATOMIC_RELAXED, __HIP_MEMORY_SCOPE_AGENT); }
__device__ __forceinline__ unsigned xb_add(unsigned* p, unsigned v) { return __hip_atomic_fetch_add(p, v, __ATOMIC_RELAXED, __HIP_MEMORY_SCOPE_AGENT); }
__device__ __forceinline__ unsigned xb_xcc_id() { return (unsigned)__builtin_amdgcn_s_getreg((3 << 11) | 20) & 0xFu; }
#define XB_SPIN(cond, bar) do { unsigned _sp = 0; while (cond) { __builtin_amdgcn_s_sleep(1); \
    if ((++_sp & 255u) == 0u) { if (xb_ld(&(bar)[XB_TMO])) break; if (_sp > XB_SPIN_CAP) { atomicAdd(&(bar)[XB_TMO], 1u); break; } } } } while (0)
struct XcdBarrier { unsigned* bar; unsigned x; volatile LAS unsigned* st; };
__device__ __forceinline__ XcdBarrier xcd_barrier_post(unsigned* bar, volatile LAS unsigned* st) {
  XcdBarrier b; b.bar = bar; b.x = xb_xcc_id(); b.st = st;
  if (threadIdx.x == 0) (void)xb_add(&bar[XB_XCNT(b.x)], 1u);
  return b;
}
__device__ __forceinline__ void xcd_barrier_complete(unsigned* bar, unsigned x, unsigned& nloc, unsigned& nx) {
  const unsigned G = gridDim.x * gridDim.y * gridDim.z;
  unsigned sum, cnt, mine, sp = 0u;
  for (;;) {
    sum = 0u; cnt = 0u; mine = 0u;
#pragma unroll
    for (unsigned j = 0; j < 16; ++j) { const unsigned c = xb_ld(&bar[XB_XCNT(j)]); sum += c; cnt += (c > 0u) ? 1u : 0u; mine = (j == x) ? c : mine; }
    if (sum == G) break;
    __builtin_amdgcn_s_sleep(1);
    if ((++sp & 255u) == 0u) { if (xb_ld(&bar[XB_TMO])) break; if (sp > XB_SPIN_CAP) { atomicAdd(&bar[XB_TMO], 1u); break; } }
  }
  nloc = mine > 0u ? mine : 1u; nx = cnt > 0u ? cnt : 1u;
}
__device__ __forceinline__ void xcd_barrier(const XcdBarrier& b) {
  asm volatile("s_waitcnt vmcnt(0)" ::: "memory");
  __syncthreads();
  if (threadIdx.x == 0) {
    unsigned* bar = b.bar;
    __builtin_amdgcn_s_waitcnt(0);
    unsigned nloc = b.st[0], nx = b.st[1];
    if (nloc == 0u) { xcd_barrier_complete(bar, b.x, nloc, nx); b.st[0] = nloc; b.st[1] = nx; }
    const unsigned old = xb_add(&bar[XB_XSUB(b.x)], 1u);
    const unsigned gen = old / nloc;
    if (old + 1u == (gen + 1u) * nloc) {
      __builtin_amdgcn_fence(__ATOMIC_RELEASE, "agent");
      asm volatile("s_waitcnt vmcnt(0)" ::: "memory");
      const unsigned og = xb_add(&bar[XB_TOP], 1u);
      const unsigned tg = og / nx;
      if (og + 1u == (tg + 1u) * nx) xb_add(&bar[XB_TOPGEN], 1u);
      else XB_SPIN(xb_ld(&bar[XB_TOPGEN]) == tg, bar);
      __builtin_amdgcn_fence(__ATOMIC_ACQUIRE, "agent");
      xb_add(&bar[XB_XGEN(b.x)], 1u);
      asm volatile("s_waitcnt vmcnt(0)" ::: "memory");
    } else {
      XB_SPIN(xb_ld(&bar[XB_XGEN(b.x)]) == gen, bar);
      __builtin_amdgcn_fence(__ATOMIC_ACQUIRE, "agent");
      asm volatile("s_waitcnt vmcnt(0)" ::: "memory");
    }
  }
  __syncthreads();
}

__global__ void __launch_bounds__(NTHREADS, 2) fwd_mega(Params p) {
  __shared__ __attribute__((aligned(16))) char smem[75808];
  const int bid = blockIdx.x, nb = gridDim.x;
  volatile LAS unsigned* st = (volatile LAS unsigned*)(smem + 75792);
  if (threadIdx.x == 0) { st[0] = 0u; st[1] = 0u; }
  __syncthreads();
  const XcdBarrier bar = xcd_barrier_post(p.bar, st);
  phase_prep(p, bid, nb, smem);        xcd_barrier(bar);
  phase_fold(p, bid, nb, smem);        xcd_barrier(bar);
  phase_norm_mod(p, bid, nb, smem);    xcd_barrier(bar);
  phase_inproj(p, bid, nb, smem);      xcd_barrier(bar);
  phase_ssm_pre(p, bid, nb, smem);     xcd_barrier(bar);
  phase_ssd_dft(p, bid, nb, smem);     xcd_barrier(bar);
  phase_ssm_post(p, bid, nb, smem);    xcd_barrier(bar);
  phase_outproj(p, bid, nb, smem);     xcd_barrier(bar);
  phase_postmix(p, bid, nb, smem);     xcd_barrier(bar);
  phase_q_route(p, bid, nb, smem);     xcd_barrier(bar);
  phase_exp_u(p, smem);                xcd_barrier(bar);
  phase_exp_v(p, smem);                xcd_barrier(bar);
  phase_exp_final(p, bid, nb, smem);
}

}

extern "C" void kernel_launch(void* const* d_in, const int* in_sizes, int n_in, void* d_out, int out_size, void* d_ws,
                              size_t ws_size, hipStream_t stream) {
  Params p{};
  const float** fp = reinterpret_cast<const float**>(&p);
  for (int i = 0; i < 27; ++i) fp[i] = (const float*)d_in[i];
  p.out = (float*)d_out;
  char* ws = (char*)d_ws;
  size_t off = 0;
  auto take = [&](size_t bytes) { char* r = ws + off; off += (bytes + 255) & ~(size_t)255; return r; };
  p.U8 = (uint8_t*)take((size_t)16384 * D);
  p.V8 = (uint8_t*)take((size_t)16384 * D);
  p.w_in_t = (bf16_t*)take((size_t)NPROJ * D * 2);
  p.w_out_t = (bf16_t*)take((size_t)D * D * 2);
  p.w_q_t = (bf16_t*)take((size_t)1024 * D * 2);
  p.w_in_f = (bf16_t*)take((size_t)D * 1024 * 2);
  p.WcsT = (bf16_t*)take((size_t)4 * 512 * 256 * 2);
  p.dftm = (bf16_t*)take((size_t)1024 * 2048 * 2);
  p.Fs = (bf16_t*)take((size_t)NB * 1024 * 2048 * 2);
  p.partial = (float*)take((size_t)KSPLIT * 5 * NMOD * 4);
  p.mod = (float*)take((size_t)5 * NMOD * 4);
  p.hx = (bf16_t*)take((size_t)T * D * 2);
  p.hc = (bf16_t*)take((size_t)TC * D * 2);
  p.ABt = (bf16_t*)take((size_t)NB * 1024 * 4096 * 2);
  p.q = (float*)p.ABt;
  p.z = (bf16_t*)take((size_t)T * 1024 * 2);
  char* r1 = take(0);
  p.xbcraw = (float*)take((size_t)T * DXBC * 4);
  p.xbcraw_c = (float*)take((size_t)TC * DXBC * 4);
  p.act_tm = (bf16_t*)take((size_t)(T + TC) * DXBC * 2);
  p.act_cm_x = (bf16_t*)take((size_t)NB * 1280 * L * 2);
  p.act_cm_c = (bf16_t*)take((size_t)NB * 1280 * CTX * 2);
  p.y_x = (float*)r1;
  p.dtraw = (float*)take((size_t)T * 32 * 4);
  p.dtraw_c = (float*)take((size_t)TC * 32 * 4);
  p.dtf = (float*)take((size_t)T * 16 * 4);
  p.dtb = (float*)take((size_t)T * 16 * 4);
  p.dtf_c = (float*)take((size_t)TC * 16 * 4);
  p.dtb_c = (float*)take((size_t)TC * 16 * 4);
  p.yf = (float*)take((size_t)T * 1024 * 4);
  p.yb = (float*)take((size_t)T * 1024 * 4);
  p.ctr = (unsigned*)take(256);
  p.bar = (unsigned*)take((size_t)XCD_BAR_WORDS * 4);
  p.ycat = (bf16_t*)take((size_t)T * D * 2);
  p.idx = (int*)take((size_t)T * 128 * 4);
  p.gate = (float*)take((size_t)T * 128 * 4);
  if (off > ws_size) { fprintf(stderr, "kernel_launch: workspace too small: need %zu have %zu\n", off, ws_size); return; }
  static int grid_blocks = 0;
  if (!grid_blocks) {
    int dev = 0, cus = 0, per_cu = 0;
    hipGetDevice(&dev);
    hipDeviceGetAttribute(&cus, hipDeviceAttributeMultiprocessorCount, dev);
    hipOccupancyMaxActiveBlocksPerMultiprocessor(&per_cu, fwd_mega, NTHREADS, 0);
    if (per_cu > 2) per_cu = 2;
    grid_blocks = cus * per_cu;
    if (grid_blocks <= 0) { fprintf(stderr, "kernel_launch: occupancy query gave %d x %d\n", cus, per_cu); grid_blocks = -1; }
  }
  if (grid_blocks < 0) return;
  (void)hipMemsetAsync(p.bar, 0, (size_t)XCD_BAR_WORDS * 4, stream);
  void* args[] = {&p};
  hipError_t e = hipLaunchCooperativeKernel((void*)fwd_mega, dim3(grid_blocks), dim3(NTHREADS), args, 0, stream);
  if (e != hipSuccess) fprintf(stderr, "cooperative launch failed: %s (grid %d)\n", hipGetErrorString(e), grid_blocks);
}
```

```cpp
#include <hip/hip_runtime.h>
#include <hip/hip_cooperative_groups.h>
#include <stdint.h>
#include <stdio.h>

namespace cg = cooperative_groups;
namespace {

typedef __attribute__((ext_vector_type(8))) short bf16x8;
typedef __attribute__((ext_vector_type(4))) float f32x4;
typedef unsigned short bf16_t;

constexpr int D = 2048, NB = 4, L = 2048, T = NB * L, CTX = 256, TC = NB * CTX;
constexpr int NMOD = 6 * D;
constexpr int NH = 16, HP = 64, NS = 128, DXBC = 1536;
constexpr int DIN = 3616;
constexpr int NPROJ = 4736;
constexpr int KSPLIT = 32;
constexpr float EPS = 1e-6f;
constexpr int NTHREADS = 256;

__device__ __forceinline__ bf16_t f2bf(float f) {
  uint32_t u = __float_as_uint(f);
  u += 0x7fffu + ((u >> 16) & 1u);
  return (bf16_t)(u >> 16);
}
__device__ __forceinline__ float bf2f(bf16_t h) { return __uint_as_float(((uint32_t)h) << 16); }
__device__ __forceinline__ uint32_t pack2(float a, float b) { return (uint32_t)f2bf(a) | ((uint32_t)f2bf(b) << 16); }
__device__ __forceinline__ float bflo(uint32_t w) { return __uint_as_float(w << 16); }
__device__ __forceinline__ float bfhi(uint32_t w) { return __uint_as_float(w & 0xffff0000u); }
__device__ __forceinline__ float silu_f(float v) { return v / (1.f + __expf(-v)); }
__device__ __forceinline__ float softplus_f(float v) { return v > 20.f ? v : log1pf(__expf(v)); }

__device__ __forceinline__ int opaque_tid() { int t = threadIdx.x; asm volatile("" : "+v"(t)); return t; }
__device__ __forceinline__ float wave_sum(float v) {
#pragma unroll
  for (int o = 32; o > 0; o >>= 1) v += __shfl_xor(v, o);
  return v;
}
template <int CTRL>
__device__ __forceinline__ float dpp_mov(float v) {
  return __int_as_float(__builtin_amdgcn_update_dpp(0, __float_as_int(v), CTRL, 0xF, 0xF, true));
}
__device__ __forceinline__ float wave_sum_fast(float v) {
  v += dpp_mov<0xB1>(v); v += dpp_mov<0x4E>(v); v += dpp_mov<0x124>(v); v += dpp_mov<0x128>(v);
  v += __shfl_xor(v, 16); v += __shfl_xor(v, 32);
  return v;
}
__device__ __forceinline__ float wave_max(float v) {
#pragma unroll
  for (int o = 32; o > 0; o >>= 1) v = fmaxf(v, __shfl_xor(v, o));
  return v;
}
__device__ __forceinline__ float block_sum(float v, float* red) {
  v = wave_sum(v);
  __syncthreads();
  if ((threadIdx.x & 63) == 0) red[threadIdx.x >> 6] = v;
  __syncthreads();
  return red[0] + red[1] + red[2] + red[3];
}

struct Params {
  const float *x, *c, *ctx, *c_ctx, *w_mod, *b_mod, *g_pre_mix, *g_post_mix, *g_pre_ffn, *g_post_ffn;
  const float *w_in, *w_fmix, *conv_w, *conv_b, *dt_bias_f, *dt_bias_b, *a_log_f, *a_log_b, *d_skip_f, *d_skip_b;
  const float *ssm_norm_w, *w_out, *w_query, *sk1, *sk2, *eu, *ev;
  float* out;
  uint8_t *U8, *V8;
  bf16_t *w_in_t, *w_out_t, *w_q_t, *w_in_f, *WcsT, *dftm, *Fs;
  float *partial, *mod;
  bf16_t *hx, *hc, *ABt, *z;
  float *xbcraw, *xbcraw_c, *dtraw, *dtraw_c, *dtf, *dtb, *dtf_c, *dtb_c;
  bf16_t *act_tm, *act_cm_x, *act_cm_c;
  float *yf, *yb;
  unsigned* ctr; unsigned* bar;
  bf16_t* ycat;
  float *y_x, *q, *gate;
  int* idx;
  int pad0, pad1;
};

__device__ __forceinline__ void gemm_mainloop(const bf16_t* __restrict__ A, int lda, const bf16_t* __restrict__ Bt, int ldb,
                                              int K, int m0, int n0, f32x4 (&acc)[4][4], char* smem) {
  const int tid = opaque_tid(), lane = tid & 63, w = tid >> 6;
  const int wm = w >> 1, wn = w & 1;
#pragma unroll
  for (int i = 0; i < 4; ++i)
#pragma unroll
    for (int j = 0; j < 4; ++j) acc[i][j] = f32x4{0.f, 0.f, 0.f, 0.f};

  const int nk = K / 64;
  const int rowoff = lane >> 3, lch = (lane & 7) ^ rowoff;
  const bf16_t* gA = A + (size_t)(m0 + w * 8 + rowoff) * lda + lch * 8;
  const bf16_t* gB = Bt + (size_t)(n0 + w * 8 + rowoff) * ldb + lch * 8;
#define GSTAGE(buf_, kt_)                                                                                               \
  do {                                                                                                                  \
    _Pragma("unroll") for (int i_ = 0; i_ < 4; ++i_) {                                                                  \
      __builtin_amdgcn_global_load_lds((const unsigned*)(gA + (size_t)(i_ * 32) * lda + (kt_) * 64),                    \
                                       (unsigned*)(smem + (buf_) * 32768 + (i_ * 4 + w) * 1024), 16, 0, 0);             \
      __builtin_amdgcn_global_load_lds((const unsigned*)(gB + (size_t)(i_ * 32) * ldb + (kt_) * 64),                    \
                                       (unsigned*)(smem + (buf_) * 32768 + 16384 + (i_ * 4 + w) * 1024), 16, 0, 0);     \
    }                                                                                                                   \
  } while (0)
  GSTAGE(0, 0);
  asm volatile("s_waitcnt vmcnt(0)" ::: "memory");
  __syncthreads();
  for (int kt = 0; kt < nk; ++kt) {
    const int cur = kt & 1;
    if (kt + 1 < nk) GSTAGE(cur ^ 1, kt + 1);
    const char* sA = smem + cur * 32768;
    const char* sB = sA + 16384;
#pragma unroll
    for (int kk = 0; kk < 2; ++kk) {
      bf16x8 af[4], bfr[4];
      const int ch = kk * 4 + (lane >> 4);
#pragma unroll
      for (int i = 0; i < 4; ++i) {
        int row = wm * 64 + i * 16 + (lane & 15);
        af[i] = *reinterpret_cast<const bf16x8*>(sA + row * 128 + ((ch ^ (row & 7)) << 4));
        int col = wn * 64 + i * 16 + (lane & 15);
        bfr[i] = *reinterpret_cast<const bf16x8*>(sB + col * 128 + ((ch ^ (col & 7)) << 4));
      }
#pragma unroll
      for (int i = 0; i < 4; ++i)
#pragma unroll
        for (int j = 0; j < 4; ++j) acc[i][j] = __builtin_amdgcn_mfma_f32_16x16x32_bf16(af[i], bfr[j], acc[i][j], 0, 0, 0);
    }
    asm volatile("s_waitcnt vmcnt(0)" ::: "memory");
    __syncthreads();
  }
#undef GSTAGE
}

template <class Epi>
__device__ __forceinline__ void gemm_tile(const bf16_t* __restrict__ A, int lda, const bf16_t* __restrict__ Bt, int ldb,
                                          int K, int m0, int n0, const Epi& epi, char* smem) {
  const int lane = threadIdx.x & 63, w = threadIdx.x >> 6;
  const int wm = w >> 1, wn = w & 1;
  f32x4 acc[4][4];
  gemm_mainloop(A, lda, Bt, ldb, K, m0, n0, acc, smem);
#pragma unroll
  for (int i = 0; i < 4; ++i)
#pragma unroll
    for (int j = 0; j < 4; ++j) {
      int row = m0 + wm * 64 + i * 16 + (lane >> 4) * 4;
      int col = n0 + wn * 64 + j * 16 + (lane & 15);
      epi(row, col, acc[i][j]);
    }
}

struct EpiF32 {
  float* C; int ldc;
  __device__ __forceinline__ void operator()(int row, int col, f32x4 v) const {
#pragma unroll
    for (int r = 0; r < 4; ++r) C[(size_t)(row + r) * ldc + col] = v[r];
  }
};
struct EpiBf16 {
  bf16_t* C; int ldc;
  __device__ __forceinline__ void operator()(int row, int col, f32x4 v) const {
#pragma unroll
    for (int r = 0; r < 4; ++r) C[(size_t)(row + r) * ldc + col] = f2bf(v[r]);
  }
};
struct EpiBf16T {
  bf16_t* Ct; int ldc;
  __device__ __forceinline__ void operator()(int row, int col, f32x4 v) const {
    uint2 pk; pk.x = pack2(v[0], v[1]); pk.y = pack2(v[2], v[3]);
    *reinterpret_cast<uint2*>(Ct + (size_t)col * ldc + row) = pk;
  }
};
struct EpiInProj {
  bf16_t* ABt; bf16_t* z; float* xbcraw; float* dtraw; int seqlen;
  __device__ __forceinline__ void operator()(int row, int col, f32x4 v) const {
    if (col < 2048) {
      int ch = col & 1023, half = col >> 10;
      int b = row / seqlen, l = row - b * seqlen;
      uint2 pk; pk.x = pack2(v[0], v[1]); pk.y = pack2(v[2], v[3]);
      *reinterpret_cast<uint2*>(ABt + ((size_t)(b * 1024 + ch) * 4096 + half * 2048 + l)) = pk;
    } else if (col < 3072) {
#pragma unroll
      for (int r = 0; r < 4; ++r) z[(size_t)(row + r) * 1024 + (col - 2048)] = f2bf(v[r]);
    } else if (col < 4608) {
#pragma unroll
      for (int r = 0; r < 4; ++r) xbcraw[(size_t)(row + r) * DXBC + (col - 3072)] = v[r];
    } else if (col < 4640) {
#pragma unroll
      for (int r = 0; r < 4; ++r) dtraw[(size_t)(row + r) * 32 + (col - 4608)] = v[r];
    }
  }
};

__device__ void adaln_partial_task(const Params& p, int task, float* sm) {
  const int cb = task % 48, ks = task / 48, tid = threadIdx.x;
  float* sc = sm;
  __syncthreads();
  for (int i = tid; i < 5 * 64; i += NTHREADS) {
    int r = i >> 6, kk = i & 63;
    int k = ks * 64 + kk;
    float cv = (r < 4) ? p.c[r * D + k] : p.c_ctx[k];
    sc[i] = silu_f(cv);
  }
  __syncthreads();
  const int col = cb * 256 + tid;
  float a0 = 0, a1 = 0, a2 = 0, a3 = 0, a4 = 0;
  const float* wp = p.w_mod + (size_t)(ks * 64) * NMOD + col;
#pragma unroll 8
  for (int kk = 0; kk < 64; ++kk) {
    float wv = wp[(size_t)kk * NMOD];
    a0 += sc[kk] * wv; a1 += sc[64 + kk] * wv; a2 += sc[128 + kk] * wv; a3 += sc[192 + kk] * wv; a4 += sc[256 + kk] * wv;
  }
  float* pp = p.partial + (size_t)ks * 5 * NMOD + col;
  pp[0] = a0; pp[NMOD] = a1; pp[2 * NMOD] = a2; pp[3 * NMOD] = a3; pp[4 * NMOD] = a4;
}

__device__ void transpose_convert_task(const float* __restrict__ src, int ld, int c0, int rows, bf16_t* __restrict__ dst,
                                       int tr, int tc, float* sm) {
  float (*tile)[65] = reinterpret_cast<float (*)[65]>(sm);
  const int tid = threadIdx.x;
  __syncthreads();
  for (int i = tid; i < 64 * 64; i += NTHREADS) {
    int r = i >> 6, cc = i & 63;
    tile[r][cc] = src[(size_t)(tr * 64 + r) * ld + c0 + tc * 64 + cc];
  }
  __syncthreads();
  for (int i = tid; i < 64 * 32; i += NTHREADS) {
    int cc = i >> 5, r2 = (i & 31) * 2;
    uint32_t pk = pack2(tile[r2][cc], tile[r2 + 1][cc]);
    *reinterpret_cast<uint32_t*>(dst + (size_t)(tc * 64 + cc) * rows + tr * 64 + r2) = pk;
  }
}

__device__ void phase_prep(const Params& p, int bid, int nb, char* smem) {
  float* sm = reinterpret_cast<float*>(smem);
  const int tid = threadIdx.x;
  if (bid == 0 && tid < 64) p.ctr[tid] = 0u;
  {
    float* t256 = reinterpret_cast<float*>(smem + 20480);
    float* t2048 = reinterpret_cast<float*>(smem + 24576);
    t256[tid] = cospif((float)tid * (1.0f / 128.f));
    for (int i = tid; i < 2048; i += NTHREADS) t2048[i] = cospif((float)i * (1.0f / 1024.f));
    __syncthreads();
  }
  for (int t = bid; t < 48 * KSPLIT; t += nb) adaln_partial_task(p, t, sm);
  {
    const int nct = 41, nrt = 32;
    for (int t = bid; t < nct * nrt; t += nb) {
      int tc = t % nct, tr = t / nct;
      if (tc < 40) transpose_convert_task(p.w_in, DIN, 1024, D, p.w_in_t + (size_t)2048 * D, tr, tc, sm);
      else {
        float (*tile)[65] = reinterpret_cast<float (*)[65]>(sm);
        __syncthreads();
        for (int i = tid; i < 64 * 32; i += NTHREADS) {
          int r = i >> 5, cc = i & 31;
          tile[r][cc] = p.w_in[(size_t)(tr * 64 + r) * DIN + 1024 + 2560 + cc];
        }
        __syncthreads();
        for (int i = tid; i < 32 * 32; i += NTHREADS) {
          int cc = i >> 5, r2 = (i & 31) * 2;
          uint32_t pk = pack2(tile[r2][cc], tile[r2 + 1][cc]);
          *reinterpret_cast<uint32_t*>(p.w_in_t + (size_t)(2048 + 2560 + cc) * D + tr * 64 + r2) = pk;
        }
      }
    }
    for (size_t i = (size_t)bid * NTHREADS + tid; i < (size_t)96 * D / 8; i += (size_t)nb * NTHREADS)
      reinterpret_cast<uint4*>(p.w_in_t + (size_t)4640 * D)[i] = uint4{0, 0, 0, 0};
  }
  for (size_t i = (size_t)bid * NTHREADS + tid; i < (size_t)D * 1024 / 4; i += (size_t)nb * NTHREADS) {
    int k = (int)(i / 256), c4 = (int)(i % 256) * 4;
    float4 v = *reinterpret_cast<const float4*>(p.w_in + (size_t)k * DIN + c4);
    uint2 o; o.x = pack2(v.x, v.y); o.y = pack2(v.z, v.w);
    *reinterpret_cast<uint2*>(p.w_in_f + (size_t)k * 1024 + c4) = o;
  }
  {
    const float* t256 = reinterpret_cast<const float*>(smem + 20480);
    const float scale = 1.0f / sqrtf((float)L * 256.f);
    for (int i = bid * NTHREADS + tid; i < 4 * 256 * 256; i += nb * NTHREADS) {
      int d = i & 255, c = (i >> 8) & 255, g = i >> 16;
      float sc_ = 0.f, ss_ = 0.f;
      const float* wp = p.w_fmix + (size_t)g * 65536 + d;
#pragma unroll 8
      for (int m = 0; m < 256; ++m) {
        const int ph = (m * c) & 255;
        const float wv = wp[m * 256];
        sc_ += t256[ph] * wv; ss_ += t256[(ph - 64) & 255] * wv;
      }
      p.WcsT[((size_t)g * 512 + d) * 256 + c] = f2bf(sc_ * scale);
      p.WcsT[((size_t)g * 512 + 256 + d) * 256 + c] = f2bf(ss_ * scale);
    }
  }
  {
    const float* t2048 = reinterpret_cast<const float*>(smem + 24576);
    for (size_t i = (size_t)bid * NTHREADS + tid; i < (size_t)1024 * 2048 / 8; i += (size_t)nb * NTHREADS) {
      const int k = (int)(i / 256), j = (int)(i % 256) * 8;
      const bool iss = j >= 1024;
      float o[8];
#pragma unroll
      for (int e = 0; e < 8; ++e) {
        const int l = (j + e) & 1023;
        const int ph = (k * l) & 2047;
        o[e] = iss ? t2048[(ph - 512) & 2047] : t2048[ph];
      }
      uint4 pk; pk.x = pack2(o[0], o[1]); pk.y = pack2(o[2], o[3]); pk.z = pack2(o[4], o[5]); pk.w = pack2(o[6], o[7]);
      *reinterpret_cast<uint4*>(p.dftm + (size_t)k * 2048 + j) = pk;
    }
  }
}

__device__ void phase_fold(const Params& p, int bid, int nb, char* smem) {
  const int tid = threadIdx.x;
  for (int i = bid * NTHREADS + tid; i < 5 * NMOD; i += nb * NTHREADS) {
    int col = i % NMOD;
    float s = p.b_mod[col];
    for (int ks = 0; ks < KSPLIT; ++ks) s += p.partial[(size_t)ks * 5 * NMOD + i];
    p.mod[i] = s;
  }
  for (int t = bid; t < 256; t += nb) {
    int g = t >> 6, tm = (t & 63) >> 2, tn = t & 3;
    int n0 = tn * 128;
    int rowbase = (n0 < 256) ? (g * 256 + n0) : (1024 + g * 256 + (n0 - 256));
    EpiBf16T epi{p.w_in_t + (size_t)(rowbase - n0) * D, D};
    gemm_tile(p.w_in_f + g * 256, 1024, p.WcsT + (size_t)g * 512 * 256, 256, 256, tm * 128, n0, epi, smem);
  }
}

__device__ void phase_norm_mod(const Params& p, int bid, int nb, char* smem) {
  const int lane = threadIdx.x & 63, w = threadIdx.x >> 6;
  for (int t = bid * 4 + w; t < T + TC; t += nb * 4) {
    const bool isx = t < T;
    const float* src = isx ? (p.x + (size_t)t * D) : (p.ctx + (size_t)(t - T) * D);
    const int mrow = isx ? (t / L) : 4;
    bf16_t* dst = isx ? (p.hx + (size_t)t * D) : (p.hc + (size_t)(t - T) * D);
    float4 v[8];
    float ss = 0.f;
#pragma unroll
    for (int c = 0; c < 8; ++c) {
      v[c] = *reinterpret_cast<const float4*>(src + c * 256 + lane * 4);
      ss += v[c].x * v[c].x + v[c].y * v[c].y + v[c].z * v[c].z + v[c].w * v[c].w;
    }
    ss = wave_sum_fast(ss);
    const float rstd = rsqrtf(ss * (1.f / D) + EPS);
    const float* sh = p.mod + (size_t)mrow * NMOD + 0 * D;
    const float* sc = p.mod + (size_t)mrow * NMOD + 1 * D;
#pragma unroll
    for (int c = 0; c < 8; ++c) {
      const int e0 = c * 256 + lane * 4;
      const float4 g = *reinterpret_cast<const float4*>(p.g_pre_mix + e0);
      const float4 s4 = *reinterpret_cast<const float4*>(sc + e0), h4 = *reinterpret_cast<const float4*>(sh + e0);
      uint2 pk;
      pk.x = pack2(v[c].x * rstd * g.x * (1.f + s4.x) + h4.x, v[c].y * rstd * g.y * (1.f + s4.y) + h4.y);
      pk.y = pack2(v[c].z * rstd * g.z * (1.f + s4.z) + h4.z, v[c].w * rstd * g.w * (1.f + s4.w) + h4.w);
      *reinterpret_cast<uint2*>(dst + e0) = pk;
    }
  }
}

__device__ __forceinline__ void convert_uv_units(const Params& p, size_t u0, size_t u1) {
  const size_t n16 = (size_t)16384 * D / 16;
  for (size_t i = u0 + threadIdx.x; i < u1; i += NTHREADS) {
    const float* s = (i < n16) ? p.eu : p.ev;
    uint8_t* d = (i < n16) ? p.U8 : p.V8;
    const size_t j = (i < n16) ? i : i - n16;
    uint32_t o[4];
#pragma unroll
    for (int q4 = 0; q4 < 4; ++q4) {
      const float4 v = *reinterpret_cast<const float4*>(s + j * 16 + q4 * 4);
      int pk = 0;
      pk = __builtin_amdgcn_cvt_pk_fp8_f32(v.x * 512.f, v.y * 512.f, pk, false);
      pk = __builtin_amdgcn_cvt_pk_fp8_f32(v.z * 512.f, v.w * 512.f, pk, true);
      o[q4] = (uint32_t)pk;
    }
    *reinterpret_cast<uint4*>(d + j * 16) = uint4{o[0], o[1], o[2], o[3]};
  }
}
__device__ void phase_inproj(const Params& p, int bid, int nb, char* smem) {
  if ((nb & 7) == 0) {
    const int x = bid & 7, rank = bid >> 3, per = nb >> 3;
    for (int s_ = rank; s_ < 296 + 13; s_ += per) {
      if (s_ < 296) {
        const int g = s_ >> 6, i = s_ & 63;
        int tm, tn;
        if (g < 4) { tm = 8 * x + (i & 7); tn = g * 8 + (i >> 3); }
        else { tm = 8 * x + (i & 7); tn = 32 + (i >> 3); }
        EpiInProj epi{p.ABt, p.z, p.xbcraw, p.dtraw, L};
        gemm_tile(p.hx, D, p.w_in_t, D, D, tm * 128, tn * 128, epi, smem);
      } else {
        const int u = x * 13 + (s_ - 296);
        EpiInProj epi{nullptr, nullptr, p.xbcraw_c, p.dtraw_c, CTX};
        gemm_tile(p.hc, D, p.w_in_t, D, D, (u / 13) * 128, 3072 + (u % 13) * 128, epi, smem);
      }
    }
    return;
  }
  const int ntx = 64 * 37, ntc = 8 * 13;
  for (int t = bid; t < ntx + ntc; t += nb) {
    if (t < ntx) {
      int tm = t / 37, tn = t % 37;
      EpiInProj epi{p.ABt, p.z, p.xbcraw, p.dtraw, L};
      gemm_tile(p.hx, D, p.w_in_t, D, D, tm * 128, tn * 128, epi, smem);
    } else {
      int u = t - ntx;
      int tm = u / 13, tn = u % 13;
      EpiInProj epi{nullptr, nullptr, p.xbcraw_c, p.dtraw_c, CTX};
      gemm_tile(p.hc, D, p.w_in_t, D, D, tm * 128, 3072 + tn * 128, epi, smem);
    }
  }
}

__device__ void ssm_pre_tile(const Params& p, int task, char* smem) {
  const bool isx = task < 3072;
  const int u = isx ? task : task - 3072;
  const int ntt = isx ? 32 : 4;
  const int ct = u % 24, tt = (u / 24) % ntt, b = u / (24 * ntt);
  const int seqlen = isx ? L : CTX;
  const float* raw = (isx ? p.xbcraw : p.xbcraw_c) + (size_t)b * seqlen * DXBC;
  const int l0 = tt * 64, c0 = ct * 64, tid = threadIdx.x;
  float (*rt)[65] = reinterpret_cast<float (*)[65]>(smem);
  float (*at)[65] = reinterpret_cast<float (*)[65]>(smem + 66 * 65 * 4);
  __syncthreads();
  for (int i = tid; i < 66 * 64; i += NTHREADS) {
    int r = i >> 6, cc = i & 63, l = l0 - 1 + r;
    rt[r][cc] = (l >= 0 && l < seqlen) ? raw[(size_t)l * DXBC + c0 + cc] : 0.f;
  }
  __syncthreads();
  for (int i = tid; i < 64 * 64; i += NTHREADS) {
    int r = i >> 6, cc = i & 63, c = c0 + cc;
    float acc = p.conv_b[c] + rt[r][cc] * p.conv_w[c] + rt[r + 1][cc] * p.conv_w[DXBC + c] + rt[r + 2][cc] * p.conv_w[2 * DXBC + c];
    at[r][cc] = silu_f(acc);
  }
  __syncthreads();
  const size_t trow0 = isx ? ((size_t)b * L + l0) : ((size_t)T + (size_t)b * CTX + l0);
  for (int i = tid; i < 64 * 32; i += NTHREADS) {
    int r = i >> 5, c2 = (i & 31) * 2;
    *reinterpret_cast<uint32_t*>(p.act_tm + (trow0 + r) * DXBC + c0 + c2) = pack2(at[r][c2], at[r][c2 + 1]);
  }
  if (c0 < 1280) {
    bf16_t* cm = (isx ? p.act_cm_x : p.act_cm_c) + (size_t)b * 1280 * seqlen;
    for (int i = tid; i < 64 * 32; i += NTHREADS) {
      int cc = i >> 5, r2 = (i & 31) * 2;
      *reinterpret_cast<uint32_t*>(cm + (size_t)(c0 + cc) * seqlen + l0 + r2) = pack2(at[r2][cc], at[r2 + 1][cc]);
    }
  }
}
__device__ void dft_fold_rows(const Params& p, int bid, int nb) {
  const int lane = threadIdx.x & 63, w = threadIdx.x >> 6;
  for (int row = bid * 4 + w; row < NB * 1024; row += nb * 4) {
    const bf16_t* A = p.ABt + (size_t)row * 4096;
    const bf16_t* Bv = A + 2048;
    bf16_t* F = p.Fs + (size_t)row * 2048;
    float alt = 0.f;
#pragma unroll 4
    for (int i = 0; i < 16; ++i) {
      const int l = i * 64 + lane;
      const float a = bf2f(A[l]), bb = bf2f(Bv[l]);
      const float ar = (l == 0) ? 0.f : bf2f(A[2048 - l]), br = (l == 0) ? bb : bf2f(Bv[2048 - l]);
      const float as = a + ar, bs = bb - br;
      F[l] = f2bf(as); F[1024 + l] = f2bf(bs);
      alt += (l & 1) ? -as : as;
    }
    alt = wave_sum(alt) + bf2f(A[1024]);
    if (lane == 0) { const int b = row >> 10, ch = row & 1023; p.ycat[((size_t)b * L + 1024) * D + ch] = f2bf(alt); }
  }
}
__device__ void phase_ssm_pre(const Params& p, int bid, int nb, char* smem) {
  const int tid = threadIdx.x;
  dft_fold_rows(p, bid, nb);
  for (int t = bid; t < 3072 + 384; t += nb) ssm_pre_tile(p, t, smem);
  for (int i = bid * NTHREADS + tid; i < (T + TC) * 32; i += nb * NTHREADS) {
    const bool isx = i < T * 32;
    const int ii = isx ? i : i - T * 32;
    const int t = ii >> 5, j = ii & 31;
    const float v = (isx ? p.dtraw : p.dtraw_c)[ii];
    float* df = isx ? p.dtf : p.dtf_c;
    float* db = isx ? p.dtb : p.dtb_c;
    if (j < 16) df[t * 16 + j] = softplus_f(v + p.dt_bias_f[j]);
    else db[t * 16 + (j - 16)] = softplus_f(v + p.dt_bias_b[j - 16]);
  }
}

__device__ __forceinline__ int swz16(int row, int chunk) { return row * 256 + ((chunk ^ (row & 15)) << 4); }
__device__ __forceinline__ int swz8(int row, int chunk) { return row * 128 + ((chunk ^ (row & 7)) << 4); }

#define LDS_BARRIER() asm volatile("s_waitcnt lgkmcnt(0)\n\ts_barrier" ::: "memory")
__device__ void ssd_task(const Params& p, int task, char* smem) {
  const int dir = task & 1, ph = (task >> 1) & 1, h = (task >> 2) & 15, b = task >> 6;
  const int tid = opaque_tid(), lane = tid & 63, w = tid >> 6;
  const int g = h >> 3, lr0 = lane & 15, lq0 = lane >> 4;
  const float a = -__expf(dir ? p.a_log_b[h] : p.a_log_f[h]);
  char* sCc = smem; char* sBc = smem + 16384; char* sBT = smem + 32768; char* sXT = smem + 49152; char* sHb = smem + 57344;
  float* se = reinterpret_cast<float*>(smem + 73728);
  float* sdt = se + 64; float* sw = se + 128; float* sy = se + 192; float* stot = se + 256;
  float* yo = dir ? p.yb : p.yf;
  f32x4 H[2][2];
#pragma unroll
  for (int i = 0; i < 2; ++i)
#pragma unroll
    for (int j = 0; j < 2; ++j) H[i][j] = f32x4{0.f, 0.f, 0.f, 0.f};
  __syncthreads();
  for (int i = tid; i < 512; i += NTHREADS) reinterpret_cast<uint4*>(sHb)[i] = uint4{0, 0, 0, 0};

  const int crow = tid >> 4, cch = tid & 15;
  const int trow = tid >> 3, tch = tid & 7;
  uint4 rC0, rC1, rC2, rC3, rB0, rB1, rB2, rB3, rT0, rT1, rT2, rT3, rX;
  rC0 = rC1 = rC2 = rC3 = rB0 = rB1 = rB2 = rB3 = uint4{0, 0, 0, 0};
  float rdt = 0.f;
#define SSD_PARAMS(st_)                                                                                                   \
  const bool isctx_ = (st_) < 4;                                                                                          \
  const int nch_ = isctx_ ? 4 : 32, ci_ = isctx_ ? (st_) : (st_) - 4;                                                     \
  const int c_ = dir ? (nch_ - 1 - ci_) : ci_;                                                                            \
  const int seqlen_ = isctx_ ? CTX : L;                                                                                   \
  const size_t trow0_ = isctx_ ? ((size_t)T + (size_t)b * CTX + c_ * 64) : ((size_t)b * L + c_ * 64);                     \
  const size_t drow0_ = (size_t)b * seqlen_ + c_ * 64;                                                                    \
  const float* dtp_ = isctx_ ? (dir ? p.dtb_c : p.dtf_c) : (dir ? p.dtb : p.dtf);                                         \
  const bf16_t* cm_ = (isctx_ ? p.act_cm_c : p.act_cm_x) + (size_t)b * 1280 * seqlen_ + c_ * 64;
#define SSD_PREFETCH(st_)                                                                                                 \
  do {                                                                                                                    \
    SSD_PARAMS(st_)                                                                                                       \
    if (w == 0) rdt = dtp_[(drow0_ + lane) * 16 + h];                                                                     \
    if (!isctx_) {                                                                                                        \
      const bf16_t* src = p.act_tm + (trow0_ + crow) * DXBC + g * 128 + cch * 8;                                          \
      rC0 = *reinterpret_cast<const uint4*>(src + 1280);             rB0 = *reinterpret_cast<const uint4*>(src + 1024);   \
      rC1 = *reinterpret_cast<const uint4*>(src + 16 * DXBC + 1280); rB1 = *reinterpret_cast<const uint4*>(src + 16 * DXBC + 1024); \
      rC2 = *reinterpret_cast<const uint4*>(src + 32 * DXBC + 1280); rB2 = *reinterpret_cast<const uint4*>(src + 32 * DXBC + 1024); \
      rC3 = *reinterpret_cast<const uint4*>(src + 48 * DXBC + 1280); rB3 = *reinterpret_cast<const uint4*>(src + 48 * DXBC + 1024); \
    }                                                                                                                     \
    const bf16_t* srt = cm_ + (size_t)(1024 + g * 128 + trow) * seqlen_ + tch * 8;                                        \
    rT0 = *reinterpret_cast<const uint4*>(srt);                                                                           \
    rT1 = *reinterpret_cast<const uint4*>(srt + (size_t)32 * seqlen_);                                                    \
    rT2 = *reinterpret_cast<const uint4*>(srt + (size_t)64 * seqlen_);                                                    \
    rT3 = *reinterpret_cast<const uint4*>(srt + (size_t)96 * seqlen_);                                                    \
    rX = *reinterpret_cast<const uint4*>(cm_ + (size_t)(h * 64 + ph * 32 + trow) * seqlen_ + tch * 8);                    \
  } while (0)

  for (int step = 0; step < 36; ++step) {
    SSD_PREFETCH(step);
    const bool isctx = step < 4;
    const int c = dir ? ((isctx ? 4 : 32) - 1 - (isctx ? step : step - 4)) : (isctx ? step : step - 4);
    const size_t trow0 = (size_t)b * L + c * 64;
    int lr = lr0, lq = lq0;
    asm volatile("" : "+v"(lr), "+v"(lq));
    LDS_BARRIER();
    if (w == 0) {
      const float dtv = rdt;
      float v = a * dtv;
      if (!dir) {
#pragma unroll
        for (int o = 1; o < 64; o <<= 1) { float n = __shfl_up(v, o); v += (lane >= o) ? n : 0.f; }
      } else {
#pragma unroll
        for (int o = 1; o < 64; o <<= 1) { float n = __shfl_down(v, o); v += (lane + o < 64) ? n : 0.f; }
      }
      const float etot = __shfl(v, dir ? 0 : 63);
      se[lane] = v; sdt[lane] = dtv; sw[lane] = dtv * __expf(etot - v); sy[lane] = __expf(v);
      if (lane == 0) stot[0] = etot;
    }
    if (!isctx) {
      const int oc = swz16(crow, cch);
      *reinterpret_cast<uint4*>(sCc + oc) = rC0;         *reinterpret_cast<uint4*>(sBc + oc) = rB0;
      *reinterpret_cast<uint4*>(sCc + oc + 4096) = rC1;  *reinterpret_cast<uint4*>(sBc + oc + 4096) = rB1;
      *reinterpret_cast<uint4*>(sCc + oc + 8192) = rC2;  *reinterpret_cast<uint4*>(sBc + oc + 8192) = rB2;
      *reinterpret_cast<uint4*>(sCc + oc + 12288) = rC3; *reinterpret_cast<uint4*>(sBc + oc + 12288) = rB3;
    }
    {
      const int ot = swz8(trow, tch);
      *reinterpret_cast<uint4*>(sBT + ot) = rT0;
      *reinterpret_cast<uint4*>(sBT + ot + 4096) = rT1;
      *reinterpret_cast<uint4*>(sBT + ot + 8192) = rT2;
      *reinterpret_cast<uint4*>(sBT + ot + 12288) = rT3;
      *reinterpret_cast<uint4*>(sXT + ot) = rX;
    }
    LDS_BARRIER();
    const float etot = stot[0];
    if (!isctx) {
      f32x4 G[4];
      bf16x8 ca[4];
#pragma unroll
      for (int j = 0; j < 4; ++j) G[j] = f32x4{0.f, 0.f, 0.f, 0.f};
#pragma unroll
      for (int kk = 0; kk < 4; ++kk) ca[kk] = *reinterpret_cast<const bf16x8*>(sCc + swz16(16 * w + lr, kk * 4 + lq));
#pragma unroll
      for (int kk = 0; kk < 4; ++kk)
#pragma unroll
        for (int j = 0; j < 4; ++j) {
          bf16x8 bb = *reinterpret_cast<const bf16x8*>(sBc + swz16(16 * j + lr, kk * 4 + lq));
          G[j] = __builtin_amdgcn_mfma_f32_16x16x32_bf16(ca[kk], bb, G[j], 0, 0, 0);
        }
      LDS_BARRIER();
      float el[4];
#pragma unroll
      for (int r = 0; r < 4; ++r) el[r] = se[16 * w + lq * 4 + r];
#pragma unroll
      for (int j = 0; j < 4; ++j) {
        const int s_ = 16 * j + lr;
        const float es = se[s_], ds = sdt[s_];
#pragma unroll
        for (int r = 0; r < 4; ++r) {
          const int l = 16 * w + lq * 4 + r;
          const bool keep = dir ? (s_ >= l) : (s_ <= l);
          const float m = keep ? G[j][r] * __expf(el[r] - es) * ds : 0.f;
          *reinterpret_cast<bf16_t*>(sBc + swz8(l, s_ >> 3) + (s_ & 7) * 2) = f2bf(m);
        }
      }
      LDS_BARRIER();
      f32x4 Y[2], Yo[2];
#pragma unroll
      for (int j = 0; j < 2; ++j) { Y[j] = f32x4{0.f, 0.f, 0.f, 0.f}; Yo[j] = f32x4{0.f, 0.f, 0.f, 0.f}; }
#pragma unroll
      for (int kk = 0; kk < 2; ++kk) {
        bf16x8 ma = *reinterpret_cast<const bf16x8*>(sBc + swz8(16 * w + lr, kk * 4 + lq));
#pragma unroll
        for (int j = 0; j < 2; ++j) {
          bf16x8 xb = *reinterpret_cast<const bf16x8*>(sXT + swz8(16 * j + lr, kk * 4 + lq));
          Y[j] = __builtin_amdgcn_mfma_f32_16x16x32_bf16(ma, xb, Y[j], 0, 0, 0);
        }
      }
#pragma unroll
      for (int kk = 0; kk < 4; ++kk)
#pragma unroll
        for (int j = 0; j < 2; ++j) {
          bf16x8 hb = *reinterpret_cast<const bf16x8*>(sHb + swz16(16 * j + lr, kk * 4 + lq));
          Yo[j] = __builtin_amdgcn_mfma_f32_16x16x32_bf16(ca[kk], hb, Yo[j], 0, 0, 0);
        }
      float syl[4];
#pragma unroll
      for (int r = 0; r < 4; ++r) syl[r] = sy[16 * w + lq * 4 + r];
#pragma unroll
      for (int j = 0; j < 2; ++j)
#pragma unroll
        for (int r = 0; r < 4; ++r) {
          const int l = 16 * w + lq * 4 + r;
          yo[(trow0 + l) * 1024 + h * 64 + ph * 32 + 16 * j + lr] = Y[j][r] + syl[r] * Yo[j][r];
        }
    }
    {
      const float dec = __expf(etot);
#pragma unroll
      for (int i = 0; i < 2; ++i)
#pragma unroll
        for (int j = 0; j < 2; ++j) H[i][j] *= dec;
#pragma unroll
      for (int kk = 0; kk < 2; ++kk) {
        const int s0 = kk * 32 + lq * 8;
        const float4 w0 = *reinterpret_cast<const float4*>(sw + s0), w1 = *reinterpret_cast<const float4*>(sw + s0 + 4);
        bf16x8 xs[2];
#pragma unroll
        for (int i = 0; i < 2; ++i) {
          const bf16x8 xa = *reinterpret_cast<const bf16x8*>(sXT + swz8(16 * i + lr, kk * 4 + lq));
          xs[i][0] = (short)f2bf(bf2f((bf16_t)xa[0]) * w0.x); xs[i][1] = (short)f2bf(bf2f((bf16_t)xa[1]) * w0.y);
          xs[i][2] = (short)f2bf(bf2f((bf16_t)xa[2]) * w0.z); xs[i][3] = (short)f2bf(bf2f((bf16_t)xa[3]) * w0.w);
          xs[i][4] = (short)f2bf(bf2f((bf16_t)xa[4]) * w1.x); xs[i][5] = (short)f2bf(bf2f((bf16_t)xa[5]) * w1.y);
          xs[i][6] = (short)f2bf(bf2f((bf16_t)xa[6]) * w1.z); xs[i][7] = (short)f2bf(bf2f((bf16_t)xa[7]) * w1.w);
        }
#pragma unroll
        for (int j = 0; j < 2; ++j) {
          const bf16x8 bt = *reinterpret_cast<const bf16x8*>(sBT + swz8(16 * (2 * w + j) + lr, kk * 4 + lq));
#pragma unroll
          for (int i = 0; i < 2; ++i) H[i][j] = __builtin_amdgcn_mfma_f32_16x16x32_bf16(xs[i], bt, H[i][j], 0, 0, 0);
        }
      }
    }
    LDS_BARRIER();
#pragma unroll
    for (int i = 0; i < 2; ++i)
#pragma unroll
      for (int j = 0; j < 2; ++j) {
        const int n = 16 * (2 * w + j) + lr;
#pragma unroll
        for (int r = 0; r < 4; ++r) {
          const int pr = 16 * i + lq * 4 + r;
          *reinterpret_cast<bf16_t*>(sHb + swz16(pr, n >> 3) + (n & 7) * 2) = f2bf(H[i][j][r]);
        }
      }
  }
#undef SSD_PREFETCH
#undef SSD_PARAMS
}

#undef LDS_BARRIER
__device__ void phase_ssd_dft(const Params& p, int bid, int nb, char* smem) {
  for (int t = bid; t < 256; t += nb) ssd_task(p, t, smem);
  int* stile = reinterpret_cast<int*>(smem + 75776);
  for (;;) {
    __syncthreads();
    if (threadIdx.x == 0) *stile = (int)atomicAdd(p.ctr, 1u);
    __syncthreads();
    const int t = *stile;
    if (t >= 4 * 8 * 8) break;
    const int b = t >> 6, tm = (t & 63) >> 3, tn = t & 7;
    const bf16_t* Fb = p.Fs + (size_t)b * 1024 * 2048;
    f32x4 accC[4][4], accS[4][4];
    gemm_mainloop(p.dftm, 2048, Fb, 2048, 1024, tm * 128, tn * 128, accC, smem);
    gemm_mainloop(p.dftm + 1024, 2048, Fb + 1024, 2048, 1024, tm * 128, tn * 128, accS, smem);
    const int lane = threadIdx.x & 63, w = threadIdx.x >> 6, wm = w >> 1, wn = w & 1;
#pragma unroll
    for (int i = 0; i < 4; ++i) {
      int lq_ = lane >> 4, lr_ = lane & 15;
      asm volatile("" : "+v"(lq_), "+v"(lr_));
#pragma unroll
      for (int j = 0; j < 4; ++j) {
        const int k0 = tm * 128 + wm * 64 + i * 16 + lq_ * 4;
        const int ch = tn * 128 + wn * 64 + j * 16 + lr_;
        const float a = bf2f(p.ABt[((size_t)b * 1024 + ch) * 4096 + 1024]);
#pragma unroll
        for (int r = 0; r < 4; ++r) {
          const int k = k0 + r;
          const float as = (k & 1) ? -a : a;
          const float c = accC[i][j][r], sn = accS[i][j][r];
          p.ycat[((size_t)b * L + k) * D + ch] = f2bf(c - sn + as);
          if (k > 0) p.ycat[((size_t)b * L + (L - k)) * D + ch] = f2bf(c + sn + as);
        }
      }
    }
  }
  for (;;) {
    __syncthreads();
    if (threadIdx.x == 0) *stile = (int)atomicAdd(p.ctr + 8, 1u);
    __syncthreads();
    const int q = *stile;
    if (q >= 1024 + 1536) break;
    if (q < 1024) convert_uv_units(p, (size_t)q * 4096, (size_t)(q + 1) * 4096);
    else if (q < 1024 + 1024) { const int q1 = q - 1024; transpose_convert_task(p.w_out, D, 0, D, p.w_out_t, q1 / 32, q1 % 32, reinterpret_cast<float*>(smem)); }
    else { const int q2 = q - 2048; transpose_convert_task(p.w_query, 1024, 0, D, p.w_q_t, q2 / 16, q2 % 16, reinterpret_cast<float*>(smem)); }
  }
}

__device__ void phase_ssm_post(const Params& p, int bid, int nb, char* smem) {
  const int lane = threadIdx.x & 63, w = threadIdx.x >> 6;
  for (int t = bid * 4 + w; t < T; t += nb * 4) {
    float y[4][4];
    float ss0 = 0.f, ss1 = 0.f;
#pragma unroll
    for (int c = 0; c < 4; ++c) {
      const int c0 = c * 256 + lane * 4;
      const int h = c0 >> 6;
      const float dsk = p.d_skip_f[h] + p.d_skip_b[h];
      const float4 a = *reinterpret_cast<const float4*>(p.yf + (size_t)t * 1024 + c0);
      const float4 bq = *reinterpret_cast<const float4*>(p.yb + (size_t)t * 1024 + c0);
      const uint2 xq = *reinterpret_cast<const uint2*>(p.act_tm + (size_t)t * DXBC + c0);
      const uint2 zz = *reinterpret_cast<const uint2*>(p.z + (size_t)t * 1024 + c0);
      y[c][0] = (a.x + bq.x + dsk * bflo(xq.x)) * silu_f(bflo(zz.x));
      y[c][1] = (a.y + bq.y + dsk * bfhi(xq.x)) * silu_f(bfhi(zz.x));
      y[c][2] = (a.z + bq.z + dsk * bflo(xq.y)) * silu_f(bflo(zz.y));
      y[c][3] = (a.w + bq.w + dsk * bfhi(xq.y)) * silu_f(bfhi(zz.y));
      const float q = y[c][0] * y[c][0] + y[c][1] * y[c][1] + y[c][2] * y[c][2] + y[c][3] * y[c][3];
      if (c < 2) ss0 += q; else ss1 += q;
    }
    ss0 = wave_sum_fast(ss0); ss1 = wave_sum_fast(ss1);
    const float r0 = rsqrtf(ss0 * (1.f / 512.f) + EPS), r1 = rsqrtf(ss1 * (1.f / 512.f) + EPS);
#pragma unroll
    for (int c = 0; c < 4; ++c) {
      const int c0 = c * 256 + lane * 4;
      const float rstd = (c < 2) ? r0 : r1;
      const float4 nw = *reinterpret_cast<const float4*>(p.ssm_norm_w + c0);
      uint2 o; o.x = pack2(y[c][0] * rstd * nw.x, y[c][1] * rstd * nw.y); o.y = pack2(y[c][2] * rstd * nw.z, y[c][3] * rstd * nw.w);
      *reinterpret_cast<uint2*>(p.ycat + (size_t)t * D + 1024 + c0) = o;
    }
  }
}

__device__ void phase_outproj(const Params& p, int bid, int nb, char* smem) {
  if ((nb & 7) == 0) {
    const int x = bid & 7, rank = bid >> 3, per = nb >> 3;
    for (int s_ = rank; s_ < 128; s_ += per) {
      const int g = s_ >> 6, i = s_ & 63;
      EpiF32 epi{p.y_x, D};
      gemm_tile(p.ycat, D, p.w_out_t, D, D, (8 * x + (i & 7)) * 128, (g * 8 + (i >> 3)) * 128, epi, smem);
    }
    return;
  }
  for (int t = bid; t < 64 * 16; t += nb) {
    EpiF32 epi{p.y_x, D};
    gemm_tile(p.ycat, D, p.w_out_t, D, D, (t >> 4) * 128, (t & 15) * 128, epi, smem);
  }
}
__device__ void phase_postmix(const Params& p, int bid, int nb, char* smem) {
  const int lane = threadIdx.x & 63, w = threadIdx.x >> 6;
  for (int t = bid * 4 + w; t < T; t += nb * 4) {
    const int b = t / L;
    float4 y[8];
    float ss = 0.f;
#pragma unroll
    for (int c = 0; c < 8; ++c) {
      y[c] = *reinterpret_cast<const float4*>(p.y_x + (size_t)t * D + c * 256 + lane * 4);
      ss += y[c].x * y[c].x + y[c].y * y[c].y + y[c].z * y[c].z + y[c].w * y[c].w;
    }
    ss = wave_sum_fast(ss);
    const float rstd = rsqrtf(ss * (1.f / D) + EPS);
    const float* gm = p.mod + (size_t)b * NMOD + 2 * D;
    float ss1 = 0.f;
#pragma unroll
    for (int c = 0; c < 8; ++c) {
      const int e0 = c * 256 + lane * 4;
      const float4 xv = *reinterpret_cast<const float4*>(p.x + (size_t)t * D + e0);
      const float4 g4 = *reinterpret_cast<const float4*>(gm + e0), gp = *reinterpret_cast<const float4*>(p.g_post_mix + e0);
      y[c].x = xv.x + g4.x * (y[c].x * rstd * gp.x); y[c].y = xv.y + g4.y * (y[c].y * rstd * gp.y);
      y[c].z = xv.z + g4.z * (y[c].z * rstd * gp.z); y[c].w = xv.w + g4.w * (y[c].w * rstd * gp.w);
      ss1 += y[c].x * y[c].x + y[c].y * y[c].y + y[c].z * y[c].z + y[c].w * y[c].w;
      *reinterpret_cast<float4*>(p.out + (size_t)t * D + e0) = y[c];
    }
    ss1 = wave_sum_fast(ss1);
    const float rstd1 = rsqrtf(ss1 * (1.f / D) + EPS);
    const float* sf = p.mod + (size_t)b * NMOD + 3 * D;
    const float* cf = p.mod + (size_t)b * NMOD + 4 * D;
#pragma unroll
    for (int c = 0; c < 8; ++c) {
      const int e0 = c * 256 + lane * 4;
      const float4 g = *reinterpret_cast<const float4*>(p.g_pre_ffn + e0);
      const float4 s4 = *reinterpret_cast<const float4*>(cf + e0), h4 = *reinterpret_cast<const float4*>(sf + e0);
      uint2 pk;
      pk.x = pack2(y[c].x * rstd1 * g.x * (1.f + s4.x) + h4.x, y[c].y * rstd1 * g.y * (1.f + s4.y) + h4.y);
      pk.y = pack2(y[c].z * rstd1 * g.z * (1.f + s4.z) + h4.z, y[c].w * rstd1 * g.w * (1.f + s4.w) + h4.w);
      *reinterpret_cast<uint2*>(p.hx + (size_t)t * D + e0) = pk;
    }
  }
}

__device__ __forceinline__ uint32_t mono_key(float f) {
  uint32_t u = __float_as_uint(f);
  return (u & 0x80000000u) ? ~u : (u | 0x80000000u);
}
__device__ __forceinline__ void ins16(uint32_t (&Lk)[16], uint32_t x) {
#pragma unroll
  for (int i = 0; i < 16; ++i) { uint32_t hi = max(Lk[i], x); x = min(Lk[i], x); Lk[i] = hi; }
}
__device__ __forceinline__ float unmono_key(uint32_t k) {
  return __uint_as_float((k & 0x80000000u) ? (k ^ 0x80000000u) : ~k);
}
typedef __attribute__((ext_vector_type(16))) float f32x16;
__device__ void phase_q_route(const Params& p, int bid, int nb, char* smem) {
  const int tid = opaque_tid(), lane = tid & 63, w = tid >> 6;
  const int wm = w >> 1, wn = w & 1, lr = lane & 15, lq = lane >> 4;
  const int l31 = lane & 31, lh = lane >> 5;
  for (int tile0 = bid; tile0 < 512; tile0 += nb) {
    const int tile = ((nb & 7) == 0 && nb >= 512) ? (((tile0 & 7) * 8 + ((tile0 >> 3) & 7)) * 8 + (tile0 >> 6)) : tile0;
    const int h = tile & 7, m0 = (tile >> 3) * 128;
    {
      f32x4 acc[4][4];
      gemm_mainloop(p.hx, D, p.w_q_t, D, D, m0, h * 128, acc, smem);
#pragma unroll
      for (int i = 0; i < 4; ++i)
#pragma unroll
        for (int j = 0; j < 4; ++j)
#pragma unroll
          for (int r = 0; r < 4; ++r) {
            const int row = wm * 64 + i * 16 + lq * 4 + r, col = wn * 64 + j * 16 + lr;
            *reinterpret_cast<bf16_t*>(smem + swz16(row, col >> 3) + (col & 7) * 2) = f2bf(acc[i][j][r]);
          }
    }
#pragma unroll 4
    for (int r = 0; r < 16; ++r) {
      const int id = tid + 256 * r, row = id >> 4, c4 = id & 15;
      const float* src = ((row < 128) ? p.sk1 : p.sk2) + ((size_t)(h * 128 + (row & 127)) * 64 + c4 * 4);
      const float4 v = *reinterpret_cast<const float4*>(src);
      uint2 pk; pk.x = pack2(v.x, v.y); pk.y = pack2(v.z, v.w);
      *reinterpret_cast<uint2*>(smem + 32768 + swz8(row, c4 >> 1) + (c4 & 1) * 8) = pk;
    }
    __syncthreads();
    uint32_t L1[16], L2[16];
#pragma unroll
    for (int sd = 0; sd < 2; ++sd) {
      uint32_t Lk[16];
#pragma unroll
      for (int i = 0; i < 16; ++i) Lk[i] = 0u;
      const uint32_t kb = (uint32_t)(lh * 4);
#pragma unroll
      for (int ih = 0; ih < 2; ++ih) {
        f32x16 Sa[2];
#pragma unroll
        for (int i = 0; i < 2; ++i)
#pragma unroll
          for (int g2 = 0; g2 < 16; ++g2) Sa[i][g2] = 0.f;
#pragma unroll
        for (int ks = 0; ks < 4; ++ks) {
          const bf16x8 qb = *reinterpret_cast<const bf16x8*>(smem + swz16(w * 32 + l31, sd * 8 + ks * 2 + lh));
#pragma unroll
          for (int i = 0; i < 2; ++i) {
            const bf16x8 ka = *reinterpret_cast<const bf16x8*>(smem + 32768 + swz8(sd * 128 + (ih * 2 + i) * 32 + l31, ks * 2 + lh));
            Sa[i] = __builtin_amdgcn_mfma_f32_32x32x16_bf16(ka, qb, Sa[i], 0, 0, 0);
          }
        }
#pragma unroll
        for (int i = 0; i < 2; ++i)
#pragma unroll
          for (int g2 = 0; g2 < 16; ++g2)
            ins16(Lk, (mono_key(Sa[i][g2]) & ~0x7Fu) | (uint32_t)((ih * 2 + i) * 32 + (g2 & 3) + 8 * (g2 >> 2)) | kb);
      }
#pragma unroll
      for (int i = 0; i < 8; ++i) {
        const uint32_t t1 = (uint32_t)__shfl_xor((int)Lk[15 - i], 32), t2 = (uint32_t)__shfl_xor((int)Lk[i], 32);
        Lk[i] = max(Lk[i], t1); Lk[15 - i] = max(Lk[15 - i], t2);
      }
#pragma unroll
      for (int dd = 8; dd >= 1; dd >>= 1)
#pragma unroll
        for (int i = 0; i < 16; ++i)
          if ((i & dd) == 0) { const uint32_t hi = max(Lk[i], Lk[i + dd]), lo = min(Lk[i], Lk[i + dd]); Lk[i] = hi; Lk[i + dd] = lo; }
#pragma unroll
      for (int r = 0; r < 16; ++r) { if (sd == 0) L1[r] = Lk[r]; else L2[r] = Lk[r]; }
    }
    __syncthreads();
    uint32_t* ib = reinterpret_cast<uint32_t*>(smem) + w * 1088 + l31 * 34;
    if (lh == 0) {
#pragma unroll
      for (int r = 0; r < 16; ++r) { ib[r] = L1[r] & 127u; ib[16 + r] = L2[r] & 127u; }
    }
    float v1[16], v2[16];
#pragma unroll
    for (int r = 0; r < 16; ++r) { v1[r] = unmono_key(L1[r] & ~0x7Fu); v2[r] = unmono_key(L2[r] & ~0x7Fu); }
    uint32_t C[16];
#pragma unroll
    for (int i = 0; i < 16; ++i) C[i] = 0u;
#pragma unroll
    for (int a = 0; a < 16; ++a)
#pragma unroll
      for (int bq = 0; bq < 16; ++bq)
        if ((a + 1) * (bq + 1) <= 16) ins16(C, (mono_key(v1[a] + v2[bq]) & ~0xFFu) | (uint32_t)(a * 16 + bq));
    float ts[16]; int te[16];
    __builtin_amdgcn_wave_barrier();
#pragma unroll
    for (int r = 0; r < 16; ++r) {
      const uint32_t code = C[r] & 0xFFu;
      te[r] = (int)(ib[code >> 4] * 128u + ib[16 + (code & 15u)]);
      ts[r] = unmono_key(C[r] & ~0xFFu);
    }
    const float mx = ts[0];
    float den = 0.f;
#pragma unroll
    for (int r = 0; r < 16; ++r) { ts[r] = __expf(ts[r] - mx); den += ts[r]; }
    const float inv = 1.f / den;
    const size_t ob = (size_t)(m0 + w * 32 + l31) * 128 + h * 16;
    if (lh == 0) {
#pragma unroll
      for (int r = 0; r < 16; r += 4) *reinterpret_cast<int4*>(p.idx + ob + r) = int4{te[r], te[r + 1], te[r + 2], te[r + 3]};
    } else {
#pragma unroll
      for (int r = 0; r < 16; r += 4)
        *reinterpret_cast<float4*>(p.gate + ob + r) = float4{ts[r] * inv, ts[r + 1] * inv, ts[r + 2] * inv, ts[r + 3] * inv};
    }
    __syncthreads();
  }
}

typedef __attribute__((ext_vector_type(2))) float f32x2;
__device__ __forceinline__ void fp8x16_to_f32(const uint4 q, f32x2 (&o)[8]) {
  o[0] = __builtin_amdgcn_cvt_pk_f32_fp8((int)q.x, false); o[1] = __builtin_amdgcn_cvt_pk_f32_fp8((int)q.x, true);
  o[2] = __builtin_amdgcn_cvt_pk_f32_fp8((int)q.y, false); o[3] = __builtin_amdgcn_cvt_pk_f32_fp8((int)q.y, true);
  o[4] = __builtin_amdgcn_cvt_pk_f32_fp8((int)q.z, false); o[5] = __builtin_amdgcn_cvt_pk_f32_fp8((int)q.z, true);
  o[6] = __builtin_amdgcn_cvt_pk_f32_fp8((int)q.w, false); o[7] = __builtin_amdgcn_cvt_pk_f32_fp8((int)q.w, true);
}
__device__ __forceinline__ unsigned my_xcc_id() { return (unsigned)__builtin_amdgcn_s_getreg((3 << 11) | 20) & 7u; }

__device__ void phase_exp_u(const Params& p, char* smem) {
  const int tid = opaque_tid(), lane = tid & 63, w = tid >> 6;
  const int sub = lane >> 4, cc = lane & 15;
  const unsigned myx = my_xcc_id();
  int* sh = reinterpret_cast<int*>(smem);
  int* si = reinterpret_cast<int*>(smem + 64) + w * 256;
  float* pbuf = reinterpret_cast<float*>(p.ycat);
  {
    unsigned qcur = 0;
    for (;;) {
      __syncthreads();
      if (tid == 0) {
        int found = -1; unsigned fx = 0;
        for (; qcur < 8; ++qcur) {
          fx = (myx + qcur) & 7u;
          const int c = (int)atomicAdd(&p.ctr[16 + fx], 1u);
          if (c < 512) { found = c; break; }
        }
        sh[0] = found; sh[1] = (int)fx;
      }
      __syncthreads();
      const int chunk = sh[0];
      const unsigned x = (unsigned)sh[1];
      if (chunk < 0) break;
      for (int tt = 0; tt < 4; ++tt) {
        const int t = chunk * 16 + w * 4 + tt;
        __builtin_amdgcn_wave_barrier();
        si[lane] = p.idx[(size_t)t * 128 + lane]; si[64 + lane] = p.idx[(size_t)t * 128 + 64 + lane];
        __builtin_amdgcn_wave_barrier();
        f32x2 hf[8];
#pragma unroll
        for (int q2 = 0; q2 < 2; ++q2) {
          const uint4 hq = *reinterpret_cast<const uint4*>(p.hx + (size_t)t * D + x * 256 + cc * 16 + q2 * 8);
          hf[q2 * 4 + 0] = f32x2{bflo(hq.x), bfhi(hq.x)}; hf[q2 * 4 + 1] = f32x2{bflo(hq.y), bfhi(hq.y)};
          hf[q2 * 4 + 2] = f32x2{bflo(hq.z), bfhi(hq.z)}; hf[q2 * 4 + 3] = f32x2{bflo(hq.w), bfhi(hq.w)};
        }
        const uint8_t* ub = p.U8 + x * 256 + cc * 16;
        uint4 qa[8], qb[8];
#define EU_LOAD(q_, bt_) _Pragma("unroll") for (int k = 0; k < 8; ++k) q_[k] = *reinterpret_cast<const uint4*>(ub + (size_t)si[((bt_) * 8 + k) * 4 + sub] * D)
#define EU_COMP(q_, kb_)                                                                                                \
  _Pragma("unroll") for (int k = 0; k < 8; ++k) {                                                                       \
    f32x2 uf[8];                                                                                                        \
    fp8x16_to_f32(q_[k], uf);                                                                                           \
    f32x2 d2 = hf[0] * uf[0];                                                                                           \
    _Pragma("unroll") for (int e = 1; e < 8; ++e) d2 += hf[e] * uf[e];                                                  \
    float d = d2.x + d2.y;                                                                                              \
    d += dpp_mov<0xB1>(d); d += dpp_mov<0x4E>(d); d += dpp_mov<0x124>(d); d += dpp_mov<0x128>(d);                       \
    mine = (cc == (kb_) + k) ? d : mine;                                                                                \
  }
        float mine = 0.f;
        EU_LOAD(qa, 0); EU_LOAD(qb, 1);
        EU_COMP(qa, 0); EU_LOAD(qa, 2);
        EU_COMP(qb, 8); EU_LOAD(qb, 3);
        pbuf[((size_t)x * T + t) * 128 + cc * 4 + sub] = mine * (1.f / 512.f);
        mine = 0.f;
        EU_COMP(qa, 0);
        EU_COMP(qb, 8);
        pbuf[((size_t)x * T + t) * 128 + (16 + cc) * 4 + sub] = mine * (1.f / 512.f);
#undef EU_LOAD
#undef EU_COMP
      }
    }
  }
}

__device__ void phase_exp_v(const Params& p, char* smem) {
  const int tid = opaque_tid(), lane = tid & 63, w = tid >> 6;
  const int sub = lane >> 4, cc = lane & 15;
  const unsigned myx = my_xcc_id();
  int* sh = reinterpret_cast<int*>(smem);
  int* si = reinterpret_cast<int*>(smem + 64) + w * 256;
  float* sc = reinterpret_cast<float*>(si + 128);
  float* yf = p.y_x;
  {
    unsigned qcur = 0;
    for (;;) {
      __syncthreads();
      if (tid == 0) {
        int found = -1; unsigned fx = 0;
        for (; qcur < 8; ++qcur) {
          fx = (myx + qcur) & 7u;
          const int c = (int)atomicAdd(&p.ctr[32 + fx], 1u);
          if (c < 512) { found = c; break; }
        }
        sh[0] = found; sh[1] = (int)fx;
      }
      __syncthreads();
      const int chunk = sh[0];
      const unsigned x = (unsigned)sh[1];
      if (chunk < 0) break;
      for (int tt = 0; tt < 4; ++tt) {
        const int t = chunk * 16 + w * 4 + tt;
        __builtin_amdgcn_wave_barrier();
        si[lane] = p.idx[(size_t)t * 128 + lane]; si[64 + lane] = p.idx[(size_t)t * 128 + 64 + lane];
        {
          const float* pb = reinterpret_cast<const float*>(p.ycat) + (size_t)t * 128;
          float d0 = 0.f, d1 = 0.f;
#pragma unroll
          for (int xs = 0; xs < 8; ++xs) { d0 += pb[(size_t)xs * T * 128 + lane]; d1 += pb[(size_t)xs * T * 128 + 64 + lane]; }
          sc[lane] = p.gate[(size_t)t * 128 + lane] * 0.5f * d0 * (1.f + erff(d0 * 0.70710678118654752f));
          sc[64 + lane] = p.gate[(size_t)t * 128 + 64 + lane] * 0.5f * d1 * (1.f + erff(d1 * 0.70710678118654752f));
        }
        __builtin_amdgcn_wave_barrier();
        f32x2 acc[8];
#pragma unroll
        for (int e = 0; e < 8; ++e) acc[e] = f32x2{0.f, 0.f};
        const uint8_t* vb = p.V8 + x * 256 + cc * 16;
        uint4 qa[8], qb[8];
#define EV_LOAD(q_, bt_) _Pragma("unroll") for (int k = 0; k < 8; ++k) q_[k] = *reinterpret_cast<const uint4*>(vb + (size_t)si[((bt_) * 8 + k) * 4 + sub] * D)
#define EV_COMP(q_, bt_)                                                                                                \
  _Pragma("unroll") for (int k = 0; k < 8; ++k) {                                                                       \
    f32x2 vf[8];                                                                                                        \
    fp8x16_to_f32(q_[k], vf);                                                                                           \
    const float cfk = sc[((bt_) * 8 + k) * 4 + sub];                                                                    \
    const f32x2 c2 = f32x2{cfk, cfk};                                                                                   \
    _Pragma("unroll") for (int e = 0; e < 8; ++e) acc[e] += c2 * vf[e];                                                 \
  }
        EV_LOAD(qa, 0); EV_LOAD(qb, 1);
        EV_COMP(qa, 0); EV_LOAD(qa, 2);
        EV_COMP(qb, 1); EV_LOAD(qb, 3);
        EV_COMP(qa, 2);
        EV_COMP(qb, 3);
#undef EV_LOAD
#undef EV_COMP
        {
          float* red = reinterpret_cast<float*>(smem + 8192) + w * 1280;
          float* mr = red + (sub * 16 + cc) * 20;
#pragma unroll
          for (int q4 = 0; q4 < 4; ++q4)
            *reinterpret_cast<float4*>(mr + q4 * 4) = float4{acc[q4 * 2].x, acc[q4 * 2].y, acc[q4 * 2 + 1].x, acc[q4 * 2 + 1].y};
          __builtin_amdgcn_wave_barrier();
          const int part = sub;
          float4 r0 = *reinterpret_cast<const float4*>(red + (0 * 16 + cc) * 20 + part * 4);
          float4 r1 = *reinterpret_cast<const float4*>(red + (1 * 16 + cc) * 20 + part * 4);
          float4 r2 = *reinterpret_cast<const float4*>(red + (2 * 16 + cc) * 20 + part * 4);
          float4 r3 = *reinterpret_cast<const float4*>(red + (3 * 16 + cc) * 20 + part * 4);
          const float sc512 = 1.f / 512.f;
          float4 o4 = float4{(r0.x + r1.x + r2.x + r3.x) * sc512, (r0.y + r1.y + r2.y + r3.y) * sc512,
                             (r0.z + r1.z + r2.z + r3.z) * sc512, (r0.w + r1.w + r2.w + r3.w) * sc512};
          *reinterpret_cast<float4*>(yf + (size_t)t * D + x * 256 + cc * 16 + part * 4) = o4;
          __builtin_amdgcn_wave_barrier();
        }
      }
    }
  }
}

__device__ void phase_exp_final(const Params& p, int bid, int nb, char* smem) {
  const int lane = threadIdx.x & 63, w = threadIdx.x >> 6;
  const float* yf = p.y_x;
  for (int t = bid * 4 + w; t < T; t += nb * 4) {
    const int b = t / L;
    float4 y[8];
    float ss = 0.f;
#pragma unroll
    for (int c = 0; c < 8; ++c) {
      y[c] = *reinterpret_cast<const float4*>(yf + (size_t)t * D + c * 256 + lane * 4);
      ss += y[c].x * y[c].x + y[c].y * y[c].y + y[c].z * y[c].z + y[c].w * y[c].w;
    }
    ss = wave_sum_fast(ss);
    const float rstd = rsqrtf(ss * (1.f / D) + EPS);
    const float* gfx = p.mod + (size_t)b * NMOD + 5 * D;
#pragma unroll
    for (int c = 0; c < 8; ++c) {
      const int e0 = c * 256 + lane * 4;
      float* o = p.out + (size_t)t * D + e0;
      float4 xo = *reinterpret_cast<const float4*>(o);
      const float4 g4 = *reinterpret_cast<const float4*>(gfx + e0), gp = *reinterpret_cast<const float4*>(p.g_post_ffn + e0);
      xo.x += g4.x * (y[c].x * rstd * gp.x); xo.y += g4.y * (y[c].y * rstd * gp.y);
      xo.z += g4.z * (y[c].z * rstd * gp.z); xo.w += g4.w * (y[c].w * rstd * gp.w);
      *reinterpret_cast<float4*>(o) = xo;
    }
  }
}

#define XB_TMO      128
#define XB_XCNT(j)  (256  + 64 * (j))
#define XB_XSUB(j)  (1280 + 64 * (j))
#define XB_XGEN(j)  (2304 + 64 * (j))
#define XB_TOP      3328
#define XB_TOPGEN   3392
#define XCD_BAR_WORDS 3456
#define XB_SPIN_CAP (1u << 22)
#define LAS __attribute__((address_space(3)))
__device__ __forceinline__ unsigned xb_ld(unsigned* p)              { return __hip_atomic_load(p, __ATOMIC_RELAXED, __HIP_MEMORY_SCOPE_AGENT); }
__device__ __forceinline__ unsigned xb_add(unsigned* p, unsigned v) { return __hip_atomic_fetch_add(p, v, __ATOMIC_RELAXED, __HIP_MEMORY_SCOPE_AGENT); }
__device__ __forceinline__ unsigned xb_xcc_id() { return (unsigned)__builtin_amdgcn_s_getreg((3 << 11) | 20) & 0xFu; }
#define XB_SPIN(cond, bar) do { unsigned _sp = 0; while (cond) { __builtin_amdgcn_s_sleep(1); \
    if ((++_sp & 255u) == 0u) { if (xb_ld(&(bar)[XB_TMO])) break; if (_sp > XB_SPIN_CAP) { atomicAdd(&(bar)[XB_TMO], 1u); break; } } } } while (0)
struct XcdBarrier { unsigned* bar; unsigned x; volatile LAS unsigned* st; };
__device__ __forceinline__ XcdBarrier xcd_barrier_post(unsigned* bar, volatile LAS unsigned* st) {
  XcdBarrier b; b.bar = bar; b.x = xb_xcc_id(); b.st = st;
  if (threadIdx.x == 0) (void)xb_add(&bar[XB_XCNT(b.x)], 1u);
  return b;
}
__device__ __forceinline__ void xcd_barrier_complete(unsigned* bar, unsigned x, unsigned& nloc, unsigned& nx) {
  const unsigned G = gridDim.x * gridDim.y * gridDim.z;
  unsigned sum, cnt, mine, sp = 0u;
  for (;;) {
    sum = 0u; cnt = 0u; mine = 0u;
#pragma unroll
    for (unsigned j = 0; j < 16; ++j) { const unsigned c = xb_ld(&bar[XB_XCNT(j)]); sum += c; cnt += (c > 0u) ? 1u : 0u; mine = (j == x) ? c : mine; }
    if (sum == G) break;
    __builtin_amdgcn_s_sleep(1);
    if ((++sp & 255u) == 0u) { if (xb_ld(&bar[XB_TMO])) break; if (sp > XB_SPIN_CAP) { atomicAdd(&bar[XB_TMO], 1u); break; } }
  }
  nloc = mine > 0u ? mine : 1u; nx = cnt > 0u ? cnt : 1u;
}
__device__ __forceinline__ void xcd_barrier(const XcdBarrier& b) {
  asm volatile("s_waitcnt vmcnt(0)" ::: "memory");
  __syncthreads();
  if (threadIdx.x == 0) {
    unsigned* bar = b.bar;
    __builtin_amdgcn_s_waitcnt(0);
    unsigned nloc = b.st[0], nx = b.st[1];
    if (nloc == 0u) { xcd_barrier_complete(bar, b.x, nloc, nx); b.st[0] = nloc; b.st[1] = nx; }
    const unsigned old = xb_add(&bar[XB_XSUB(b.x)], 1u);
    const unsigned gen = old / nloc;
    if (old + 1u == (gen + 1u) * nloc) {
      __builtin_amdgcn_fence(__ATOMIC_RELEASE, "agent");
      asm volatile("s_waitcnt vmcnt(0)" ::: "memory");
      const unsigned og = xb_add(&bar[XB_TOP], 1u);
      const unsigned tg = og / nx;
      if (og + 1u == (tg + 1u) * nx) xb_add(&bar[XB_TOPGEN], 1u);
      else XB_SPIN(xb_ld(&bar[XB_TOPGEN]) == tg, bar);
      __builtin_amdgcn_fence(__ATOMIC_ACQUIRE, "agent");
      xb_add(&bar[XB_XGEN(b.x)], 1u);
      asm volatile("s_waitcnt vmcnt(0)" ::: "memory");
    } else {
      XB_SPIN(xb_ld(&bar[XB_XGEN(b.x)]) == gen, bar);
      __builtin_amdgcn_fence(__ATOMIC_ACQUIRE, "agent");
      asm volatile("s_waitcnt vmcnt(0)" ::: "memory");
    }
  }
  __syncthreads();
}

__global__ void __launch_bounds__(NTHREADS, 2) fwd_mega(Params p) {
  __shared__ __attribute__((aligned(16))) char smem[75808];
  const int bid = blockIdx.x, nb = gridDim.x;
  volatile LAS unsigned* st = (volatile LAS unsigned*)(smem + 75792);
  if (threadIdx.x == 0) { st[0] = 0u; st[1] = 0u; }
  __syncthreads();
  const XcdBarrier bar = xcd_barrier_post(p.bar, st);
  phase_prep(p, bid, nb, smem);        xcd_barrier(bar);
  phase_fold(p, bid, nb, smem);        xcd_barrier(bar);
  phase_norm_mod(p, bid, nb, smem);    xcd_barrier(bar);
  phase_inproj(p, bid, nb, smem);      xcd_barrier(bar);
  phase_ssm_pre(p, bid, nb, smem);     xcd_barrier(bar);
  phase_ssd_dft(p, bid, nb, smem);     xcd_barrier(bar);
  phase_ssm_post(p, bid, nb, smem);    xcd_barrier(bar);
  phase_outproj(p, bid, nb, smem);     xcd_barrier(bar);
  phase_postmix(p, bid, nb, smem);     xcd_barrier(bar);
  phase_q_route(p, bid, nb, smem);     xcd_barrier(bar);
  phase_exp_u(p, smem);                xcd_barrier(bar);
  phase_exp_v(p, smem);                xcd_barrier(bar);
  phase_exp_final(p, bid, nb, smem);
}

}

extern "C" void kernel_launch(void* const* d_in, const int* in_sizes, int n_in, void* d_out, int out_size, void* d_ws,
                              size_t ws_size, hipStream_t stream) {
  Params p{};
  const float** fp = reinterpret_cast<const float**>(&p);
  for (int i = 0; i < 27; ++i) fp[i] = (const float*)d_in[i];
  p.out = (float*)d_out;
  char* ws = (char*)d_ws;
  size_t off = 0;
  auto take = [&](size_t bytes) { char* r = ws + off; off += (bytes + 255) & ~(size_t)255; return r; };
  p.U8 = (uint8_t*)take((size_t)16384 * D);
  p.V8 = (uint8_t*)take((size_t)16384 * D);
  p.w_in_t = (bf16_t*)take((size_t)NPROJ * D * 2);
  p.w_out_t = (bf16_t*)take((size_t)D * D * 2);
  p.w_q_t = (bf16_t*)take((size_t)1024 * D * 2);
  p.w_in_f = (bf16_t*)take((size_t)D * 1024 * 2);
  p.WcsT = (bf16_t*)take((size_t)4 * 512 * 256 * 2);
  p.dftm = (bf16_t*)take((size_t)1024 * 2048 * 2);
  p.Fs = (bf16_t*)take((size_t)NB * 1024 * 2048 * 2);
  p.partial = (float*)take((size_t)KSPLIT * 5 * NMOD * 4);
  p.mod = (float*)take((size_t)5 * NMOD * 4);
  p.hx = (bf16_t*)take((size_t)T * D * 2);
  p.hc = (bf16_t*)take((size_t)TC * D * 2);
  p.ABt = (bf16_t*)take((size_t)NB * 1024 * 4096 * 2);
  p.q = (float*)p.ABt;
  p.z = (bf16_t*)take((size_t)T * 1024 * 2);
  char* r1 = take(0);
  p.xbcraw = (float*)take((size_t)T * DXBC * 4);
  p.xbcraw_c = (float*)take((size_t)TC * DXBC * 4);
  p.act_tm = (bf16_t*)take((size_t)(T + TC) * DXBC * 2);
  p.act_cm_x = (bf16_t*)take((size_t)NB * 1280 * L * 2);
  p.act_cm_c = (bf16_t*)take((size_t)NB * 1280 * CTX * 2);
  p.y_x = (float*)r1;
  p.dtraw = (float*)take((size_t)T * 32 * 4);
  p.dtraw_c = (float*)take((size_t)TC * 32 * 4);
  p.dtf = (float*)take((size_t)T * 16 * 4);
  p.dtb = (float*)take((size_t)T * 16 * 4);
  p.dtf_c = (float*)take((size_t)TC * 16 * 4);
  p.dtb_c = (float*)take((size_t)TC * 16 * 4);
  p.yf = (float*)take((size_t)T * 1024 * 4);
  p.yb = (float*)take((size_t)T * 1024 * 4);
  p.ctr = (unsigned*)take(256);
  p.bar = (unsigned*)take((size_t)XCD_BAR_WORDS * 4);
  p.ycat = (bf16_t*)take((size_t)T * D * 2);
  p.idx = (int*)take((size_t)T * 128 * 4);
  p.gate = (float*)take((size_t)T * 128 * 4);
  if (off > ws_size) { fprintf(stderr, "kernel_launch: workspace too small: need %zu have %zu\n", off, ws_size); return; }
  static int grid_blocks = 0;
  if (!grid_blocks) {
    int dev = 0, cus = 0, per_cu = 0;
    hipGetDevice(&dev);
    hipDeviceGetAttribute(&cus, hipDeviceAttributeMultiprocessorCount, dev);
    hipOccupancyMaxActiveBlocksPerMultiprocessor(&per_cu, fwd_mega, NTHREADS, 0);
    if (per_cu > 2) per_cu = 2;
    grid_blocks = cus * per_cu;
    if (grid_blocks <= 0) { fprintf(stderr, "kernel_launch: occupancy query gave %d x %d\n", cus, per_cu); grid_blocks = -1; }
  }
  if (grid_blocks < 0) return;
  (void)hipMemsetAsync(p.bar, 0, (size_t)XCD_BAR_WORDS * 4, stream);
  void* args[] = {&p};
  hipError_t e = hipLaunchCooperativeKernel((void*)fwd_mega, dim3(grid_blocks), dim3(NTHREADS), args, 0, stream);
  if (e != hipSuccess) fprintf(stderr, "cooperative launch failed: %s (grid %d)\n", hipGetErrorString(e), grid_blocks);
}
```

```cpp
#include <hip/hip_runtime.h>
#include <hip/hip_cooperative_groups.h>
#include <stdint.h>
#include <stdio.h>

namespace cg = cooperative_groups;
namespace {

typedef __attribute__((ext_vector_type(8))) short bf16x8;
typedef __attribute__((ext_vector_type(4))) float f32x4;
typedef unsigned short bf16_t;

constexpr int D = 2048, NB = 4, L = 2048, T = NB * L, CTX = 256, TC = NB * CTX;
constexpr int NMOD = 6 * D;
constexpr int NH = 16, HP = 64, NS = 128, DXBC = 1536;
constexpr int DIN = 3616;
constexpr int NPROJ = 4736;
constexpr int KSPLIT = 32;
constexpr float EPS = 1e-6f;
constexpr int NTHREADS = 256;

__device__ __forceinline__ bf16_t f2bf(float f) { __bf16 h = (__bf16)f; return __builtin_bit_cast(unsigned short, h); }
__device__ __forceinline__ float bf2f(bf16_t h) { return __uint_as_float(((uint32_t)h) << 16); }
__device__ __forceinline__ uint32_t pack2(float a, float b) {
  typedef __attribute__((ext_vector_type(2))) __bf16 bf16x2_t;
  typedef __attribute__((ext_vector_type(2))) float f32x2_t;
  const f32x2_t v = {a, b};
  return __builtin_bit_cast(uint32_t, __builtin_convertvector(v, bf16x2_t));
}
__device__ __forceinline__ float bflo(uint32_t w) { return __uint_as_float(w << 16); }
__device__ __forceinline__ float bfhi(uint32_t w) { return __uint_as_float(w & 0xffff0000u); }
__device__ __forceinline__ float silu_f(float v) { return v / (1.f + __expf(-v)); }
__device__ __forceinline__ float softplus_f(float v) { return v > 20.f ? v : log1pf(__expf(v)); }

__device__ __forceinline__ int opaque_tid() { int t = threadIdx.x; asm volatile("" : "+v"(t)); return t; }
__device__ __forceinline__ float wave_sum(float v) {
#pragma unroll
  for (int o = 32; o > 0; o >>= 1) v += __shfl_xor(v, o);
  return v;
}
template <int CTRL>
__device__ __forceinline__ float dpp_mov(float v) {
  return __int_as_float(__builtin_amdgcn_update_dpp(0, __float_as_int(v), CTRL, 0xF, 0xF, true));
}
__device__ __forceinline__ float wave_sum_fast(float v) {
  v += dpp_mov<0xB1>(v); v += dpp_mov<0x4E>(v); v += dpp_mov<0x124>(v); v += dpp_mov<0x128>(v);
  v += __shfl_xor(v, 16); v += __shfl_xor(v, 32);
  return v;
}
__device__ __forceinline__ float wave_max(float v) {
#pragma unroll
  for (int o = 32; o > 0; o >>= 1) v = fmaxf(v, __shfl_xor(v, o));
  return v;
}
__device__ __forceinline__ float block_sum(float v, float* red) {
  v = wave_sum(v);
  __syncthreads();
  if ((threadIdx.x & 63) == 0) red[threadIdx.x >> 6] = v;
  __syncthreads();
  return red[0] + red[1] + red[2] + red[3];
}

struct Params {
  const float *x, *c, *ctx, *c_ctx, *w_mod, *b_mod, *g_pre_mix, *g_post_mix, *g_pre_ffn, *g_post_ffn;
  const float *w_in, *w_fmix, *conv_w, *conv_b, *dt_bias_f, *dt_bias_b, *a_log_f, *a_log_b, *d_skip_f, *d_skip_b;
  const float *ssm_norm_w, *w_out, *w_query, *sk1, *sk2, *eu, *ev;
  float* out;
  uint8_t *U8, *V8;
  bf16_t *w_in_t, *w_out_t, *w_q_t, *w_in_f, *WcsT, *dftm, *Fs;
  float *partial, *mod;
  bf16_t *hx, *hc, *ABt, *z;
  float *xbcraw, *xbcraw_c, *dtraw, *dtraw_c, *dtf, *dtb, *dtf_c, *dtb_c;
  bf16_t *act_tm, *act_cm_x, *act_cm_c;
  float *yf, *yb;
  unsigned* ctr; unsigned* bar;
  bf16_t* ycat;
  float *y_x, *q, *gate;
  int* idx;
  int pad0, pad1;
};

__device__ __forceinline__ void gemm_mainloop(const bf16_t* __restrict__ A, int lda, const bf16_t* __restrict__ Bt, int ldb,
                                              int K, int m0, int n0, f32x4 (&acc)[4][4], char* smem) {
  const int tid = opaque_tid(), lane = tid & 63, w = tid >> 6;
  const int wm = w >> 1, wn = w & 1;
#pragma unroll
  for (int i = 0; i < 4; ++i)
#pragma unroll
    for (int j = 0; j < 4; ++j) acc[i][j] = f32x4{0.f, 0.f, 0.f, 0.f};

  const int nk = K / 64;
  const int rowoff = lane >> 3, lch = (lane & 7) ^ rowoff;
  const bf16_t* gA = A + (size_t)(m0 + w * 8 + rowoff) * lda + lch * 8;
  const bf16_t* gB = Bt + (size_t)(n0 + w * 8 + rowoff) * ldb + lch * 8;
#define GSTAGE(buf_, kt_)                                                                                               \
  do {                                                                                                                  \
    _Pragma("unroll") for (int i_ = 0; i_ < 4; ++i_) {                                                                  \
      __builtin_amdgcn_global_load_lds((const unsigned*)(gA + (size_t)(i_ * 32) * lda + (kt_) * 64),                    \
                                       (unsigned*)(smem + (buf_) * 32768 + (i_ * 4 + w) * 1024), 16, 0, 0);             \
      __builtin_amdgcn_global_load_lds((const unsigned*)(gB + (size_t)(i_ * 32) * ldb + (kt_) * 64),                    \
                                       (unsigned*)(smem + (buf_) * 32768 + 16384 + (i_ * 4 + w) * 1024), 16, 0, 0);     \
    }                                                                                                                   \
  } while (0)
  GSTAGE(0, 0);
  asm volatile("s_waitcnt vmcnt(0)" ::: "memory");
  __syncthreads();
  for (int kt = 0; kt < nk; ++kt) {
    const int cur = kt & 1;
    if (kt + 1 < nk) GSTAGE(cur ^ 1, kt + 1);
    const char* sA = smem + cur * 32768;
    const char* sB = sA + 16384;
#pragma unroll
    for (int kk = 0; kk < 2; ++kk) {
      bf16x8 af[4], bfr[4];
      const int ch = kk * 4 + (lane >> 4);
#pragma unroll
      for (int i = 0; i < 4; ++i) {
        int row = wm * 64 + i * 16 + (lane & 15);
        af[i] = *reinterpret_cast<const bf16x8*>(sA + row * 128 + ((ch ^ (row & 7)) << 4));
        int col = wn * 64 + i * 16 + (lane & 15);
        bfr[i] = *reinterpret_cast<const bf16x8*>(sB + col * 128 + ((ch ^ (col & 7)) << 4));
      }
#pragma unroll
      for (int i = 0; i < 4; ++i)
#pragma unroll
        for (int j = 0; j < 4; ++j) acc[i][j] = __builtin_amdgcn_mfma_f32_16x16x32_bf16(af[i], bfr[j], acc[i][j], 0, 0, 0);
    }
    asm volatile("s_waitcnt vmcnt(0)" ::: "memory");
    __syncthreads();
  }
#undef GSTAGE
}

template <class Epi>
__device__ __forceinline__ void gemm_tile(const bf16_t* __restrict__ A, int lda, const bf16_t* __restrict__ Bt, int ldb,
                                          int K, int m0, int n0, const Epi& epi, char* smem) {
  const int lane = threadIdx.x & 63, w = threadIdx.x >> 6;
  const int wm = w >> 1, wn = w & 1;
  f32x4 acc[4][4];
  gemm_mainloop(A, lda, Bt, ldb, K, m0, n0, acc, smem);
#pragma unroll
  for (int i = 0; i < 4; ++i)
#pragma unroll
    for (int j = 0; j < 4; ++j) {
      int row = m0 + wm * 64 + i * 16 + (lane >> 4) * 4;
      int col = n0 + wn * 64 + j * 16 + (lane & 15);
      epi(row, col, acc[i][j]);
    }
}

__device__ __forceinline__ void gemm_mainloop_n256(const bf16_t* __restrict__ A, int lda, const bf16_t* __restrict__ Bt, int ldb,
                                                   int K, int m0, int n0, f32x4 (&acc)[4][8], char* smem) {
  const int tid = opaque_tid(), lane = tid & 63, w = tid >> 6;
  const int wm = w >> 1, wn = w & 1;
#pragma unroll
  for (int i = 0; i < 4; ++i)
#pragma unroll
    for (int j = 0; j < 8; ++j) acc[i][j] = f32x4{0.f, 0.f, 0.f, 0.f};
  const int nk = K / 64;
  const int rowoff = lane >> 3, lch = (lane & 7) ^ rowoff;
  const bf16_t* gA = A + (size_t)(m0 + w * 8 + rowoff) * lda + lch * 8;
  const bf16_t* gB = Bt + (size_t)(n0 + w * 8 + rowoff) * ldb + lch * 8;
  const int fr = lane & 15, fq = lane >> 4;
  for (int kt = 0; kt < nk; ++kt) {
#pragma unroll
    for (int i_ = 0; i_ < 4; ++i_)
      __builtin_amdgcn_global_load_lds((const unsigned*)(gA + (size_t)(i_ * 32) * lda + kt * 64),
                                       (unsigned*)(smem + (i_ * 4 + w) * 1024), 16, 0, 0);
#pragma unroll
    for (int i_ = 0; i_ < 8; ++i_)
      __builtin_amdgcn_global_load_lds((const unsigned*)(gB + (size_t)(i_ * 32) * ldb + kt * 64),
                                       (unsigned*)(smem + 16384 + (i_ * 4 + w) * 1024), 16, 0, 0);
    asm volatile("s_waitcnt vmcnt(0)" ::: "memory");
    __syncthreads();
    const char* sA = smem;
    const char* sB = smem + 16384;
#pragma unroll
    for (int kk = 0; kk < 2; ++kk) {
      bf16x8 af[4], bfr[8];
      const int ch = kk * 4 + fq;
#pragma unroll
      for (int i = 0; i < 4; ++i) {
        const int row = wm * 64 + i * 16 + fr;
        af[i] = *reinterpret_cast<const bf16x8*>(sA + row * 128 + ((ch ^ (row & 7)) << 4));
      }
#pragma unroll
      for (int j = 0; j < 8; ++j) {
        const int col = wn * 128 + j * 16 + fr;
        bfr[j] = *reinterpret_cast<const bf16x8*>(sB + col * 128 + ((ch ^ (col & 7)) << 4));
      }
#pragma unroll
      for (int i = 0; i < 4; ++i)
#pragma unroll
        for (int j = 0; j < 8; ++j) acc[i][j] = __builtin_amdgcn_mfma_f32_16x16x32_bf16(af[i], bfr[j], acc[i][j], 0, 0, 0);
    }
    __syncthreads();
  }
}
template <class Epi>
__device__ __forceinline__ void gemm_tile_n256(const bf16_t* __restrict__ A, int lda, const bf16_t* __restrict__ Bt, int ldb,
                                               int K, int m0, int n0, const Epi& epi, char* smem) {
  const int lane = threadIdx.x & 63, w = threadIdx.x >> 6;
  const int wm = w >> 1, wn = w & 1;
  f32x4 acc[4][8];
  gemm_mainloop_n256(A, lda, Bt, ldb, K, m0, n0, acc, smem);
#pragma unroll
  for (int i = 0; i < 4; ++i)
#pragma unroll
    for (int j = 0; j < 8; ++j) {
      int row = m0 + wm * 64 + i * 16 + (lane >> 4) * 4;
      int col = n0 + wn * 128 + j * 16 + (lane & 15);
      epi(row, col, acc[i][j]);
    }
}

struct EpiF32 {
  float* C; int ldc;
  __device__ __forceinline__ void operator()(int row, int col, f32x4 v) const {
#pragma unroll
    for (int r = 0; r < 4; ++r) C[(size_t)(row + r) * ldc + col] = v[r];
  }
};
struct EpiBf16 {
  bf16_t* C; int ldc;
  __device__ __forceinline__ void operator()(int row, int col, f32x4 v) const {
#pragma unroll
    for (int r = 0; r < 4; ++r) C[(size_t)(row + r) * ldc + col] = f2bf(v[r]);
  }
};
struct EpiBf16T {
  bf16_t* Ct; int ldc;
  __device__ __forceinline__ void operator()(int row, int col, f32x4 v) const {
    uint2 pk; pk.x = pack2(v[0], v[1]); pk.y = pack2(v[2], v[3]);
    *reinterpret_cast<uint2*>(Ct + (size_t)col * ldc + row) = pk;
  }
};
struct EpiInAB {
  bf16_t* ABt; int seqlen;
  __device__ __forceinline__ void operator()(int row, int col, f32x4 v) const {
    const int ch = col & 1023, half = col >> 10;
    const int b = row / seqlen, l = row - b * seqlen;
    uint2 pk; pk.x = pack2(v[0], v[1]); pk.y = pack2(v[2], v[3]);
    *reinterpret_cast<uint2*>(ABt + ((size_t)(b * 1024 + ch) * 4096 + half * 2048 + l)) = pk;
  }
};
struct EpiInZ {
  bf16_t* z;
  __device__ __forceinline__ void operator()(int row, int col, f32x4 v) const {
#pragma unroll
    for (int r = 0; r < 4; ++r) z[(size_t)(row + r) * 1024 + (col - 2048)] = f2bf(v[r]);
  }
};
struct EpiInXbc {
  float* xbcraw;
  __device__ __forceinline__ void operator()(int row, int col, f32x4 v) const {
#pragma unroll
    for (int r = 0; r < 4; ++r) xbcraw[(size_t)(row + r) * DXBC + (col - 3072)] = v[r];
  }
};
struct EpiInProj {
  bf16_t* ABt; bf16_t* z; float* xbcraw; float* dtraw; int seqlen;
  __device__ __forceinline__ void operator()(int row, int col, f32x4 v) const {
    if (col < 2048) {
      int ch = col & 1023, half = col >> 10;
      int b = row / seqlen, l = row - b * seqlen;
      uint2 pk; pk.x = pack2(v[0], v[1]); pk.y = pack2(v[2], v[3]);
      *reinterpret_cast<uint2*>(ABt + ((size_t)(b * 1024 + ch) * 4096 + half * 2048 + l)) = pk;
    } else if (col < 3072) {
#pragma unroll
      for (int r = 0; r < 4; ++r) z[(size_t)(row + r) * 1024 + (col - 2048)] = f2bf(v[r]);
    } else if (col < 4608) {
#pragma unroll
      for (int r = 0; r < 4; ++r) xbcraw[(size_t)(row + r) * DXBC + (col - 3072)] = v[r];
    } else if (col < 4640) {
#pragma unroll
      for (int r = 0; r < 4; ++r) dtraw[(size_t)(row + r) * 32 + (col - 4608)] = v[r];
    }
  }
};

__device__ void adaln_partial_task(const Params& p, int task, float* sm) {
  const int cb = task % 48, ks = task / 48, tid = threadIdx.x;
  float* sc = sm;
  __syncthreads();
  for (int i = tid; i < 5 * 64; i += NTHREADS) {
    int r = i >> 6, kk = i & 63;
    int k = ks * 64 + kk;
    float cv = (r < 4) ? p.c[r * D + k] : p.c_ctx[k];
    sc[i] = silu_f(cv);
  }
  __syncthreads();
  const int col = cb * 256 + tid;
  float a0 = 0, a1 = 0, a2 = 0, a3 = 0, a4 = 0;
  const float* wp = p.w_mod + (size_t)(ks * 64) * NMOD + col;
#pragma unroll 8
  for (int kk = 0; kk < 64; ++kk) {
    float wv = wp[(size_t)kk * NMOD];
    a0 += sc[kk] * wv; a1 += sc[64 + kk] * wv; a2 += sc[128 + kk] * wv; a3 += sc[192 + kk] * wv; a4 += sc[256 + kk] * wv;
  }
  float* pp = p.partial + (size_t)ks * 5 * NMOD + col;
  pp[0] = a0; pp[NMOD] = a1; pp[2 * NMOD] = a2; pp[3 * NMOD] = a3; pp[4 * NMOD] = a4;
}

__device__ void transpose_convert_task(const float* __restrict__ src, int ld, int c0, int rows, bf16_t* __restrict__ dst,
                                       int tr, int tc, float* sm) {
  float (*tile)[65] = reinterpret_cast<float (*)[65]>(sm);
  const int tid = threadIdx.x;
  __syncthreads();
  for (int i = tid; i < 64 * 64; i += NTHREADS) {
    int r = i >> 6, cc = i & 63;
    tile[r][cc] = src[(size_t)(tr * 64 + r) * ld + c0 + tc * 64 + cc];
  }
  __syncthreads();
  for (int i = tid; i < 64 * 32; i += NTHREADS) {
    int cc = i >> 5, r2 = (i & 31) * 2;
    uint32_t pk = pack2(tile[r2][cc], tile[r2 + 1][cc]);
    *reinterpret_cast<uint32_t*>(dst + (size_t)(tc * 64 + cc) * rows + tr * 64 + r2) = pk;
  }
}

__device__ void phase_prep(const Params& p, int bid, int nb, char* smem) {
  float* sm = reinterpret_cast<float*>(smem);
  const int tid = threadIdx.x;
  if (bid == 0 && tid < 64) p.ctr[tid] = 0u;
  {
    float* t256 = reinterpret_cast<float*>(smem + 20480);
    float* t2048 = reinterpret_cast<float*>(smem + 24576);
    t256[tid] = cospif((float)tid * (1.0f / 128.f));
    for (int i = tid; i < 2048; i += NTHREADS) t2048[i] = cospif((float)i * (1.0f / 1024.f));
    __syncthreads();
  }
  for (int t = bid; t < 48 * KSPLIT; t += nb) adaln_partial_task(p, t, sm);
  {
    const int nct = 41, nrt = 32;
    for (int t = bid; t < nct * nrt; t += nb) {
      int tc = t % nct, tr = t / nct;
      if (tc < 40) transpose_convert_task(p.w_in, DIN, 1024, D, p.w_in_t + (size_t)2048 * D, tr, tc, sm);
      else {
        float (*tile)[65] = reinterpret_cast<float (*)[65]>(sm);
        __syncthreads();
        for (int i = tid; i < 64 * 32; i += NTHREADS) {
          int r = i >> 5, cc = i & 31;
          tile[r][cc] = p.w_in[(size_t)(tr * 64 + r) * DIN + 1024 + 2560 + cc];
        }
        __syncthreads();
        for (int i = tid; i < 32 * 32; i += NTHREADS) {
          int cc = i >> 5, r2 = (i & 31) * 2;
          uint32_t pk = pack2(tile[r2][cc], tile[r2 + 1][cc]);
          *reinterpret_cast<uint32_t*>(p.w_in_t + (size_t)(2048 + 2560 + cc) * D + tr * 64 + r2) = pk;
        }
      }
    }
    for (size_t i = (size_t)bid * NTHREADS + tid; i < (size_t)96 * D / 8; i += (size_t)nb * NTHREADS)
      reinterpret_cast<uint4*>(p.w_in_t + (size_t)4640 * D)[i] = uint4{0, 0, 0, 0};
  }
  for (size_t i = (size_t)bid * NTHREADS + tid; i < (size_t)D * 1024 / 4; i += (size_t)nb * NTHREADS) {
    int k = (int)(i / 256), c4 = (int)(i % 256) * 4;
    float4 v = *reinterpret_cast<const float4*>(p.w_in + (size_t)k * DIN + c4);
    uint2 o; o.x = pack2(v.x, v.y); o.y = pack2(v.z, v.w);
    *reinterpret_cast<uint2*>(p.w_in_f + (size_t)k * 1024 + c4) = o;
  }
  {
    const float* t256 = reinterpret_cast<const float*>(smem + 20480);
    const float scale = 1.0f / sqrtf((float)L * 256.f);
    for (int i = bid * NTHREADS + tid; i < 4 * 256 * 256; i += nb * NTHREADS) {
      int d = i & 255, c = (i >> 8) & 255, g = i >> 16;
      float sc_ = 0.f, ss_ = 0.f;
      const float* wp = p.w_fmix + (size_t)g * 65536 + d;
#pragma unroll 8
      for (int m = 0; m < 256; ++m) {
        const int ph = (m * c) & 255;
        const float wv = wp[m * 256];
        sc_ += t256[ph] * wv; ss_ += t256[(ph - 64) & 255] * wv;
      }
      p.WcsT[((size_t)g * 512 + d) * 256 + c] = f2bf(sc_ * scale);
      p.WcsT[((size_t)g * 512 + 256 + d) * 256 + c] = f2bf(ss_ * scale);
    }
  }
  {
    const float* t2048 = reinterpret_cast<const float*>(smem + 24576);
    for (size_t i = (size_t)bid * NTHREADS + tid; i < (size_t)1024 * 2048 / 8; i += (size_t)nb * NTHREADS) {
      const int k = (int)(i / 256), j = (int)(i % 256) * 8;
      const bool iss = j >= 1024;
      float o[8];
#pragma unroll
      for (int e = 0; e < 8; ++e) {
        const int l = (j + e) & 1023;
        const int ph = (k * l) & 2047;
        o[e] = iss ? t2048[(ph - 512) & 2047] : t2048[ph];
      }
      uint4 pk; pk.x = pack2(o[0], o[1]); pk.y = pack2(o[2], o[3]); pk.z = pack2(o[4], o[5]); pk.w = pack2(o[6], o[7]);
      *reinterpret_cast<uint4*>(p.dftm + (size_t)k * 2048 + j) = pk;
    }
  }
}

__device__ void phase_fold(const Params& p, int bid, int nb, char* smem) {
  const int tid = threadIdx.x;
  for (int i = bid * NTHREADS + tid; i < 5 * NMOD; i += nb * NTHREADS) {
    int col = i % NMOD;
    float s = p.b_mod[col];
    for (int ks = 0; ks < KSPLIT; ++ks) s += p.partial[(size_t)ks * 5 * NMOD + i];
    p.mod[i] = s;
  }
  for (int t = bid; t < 256; t += nb) {
    int g = t >> 6, tm = (t & 63) >> 2, tn = t & 3;
    int n0 = tn * 128;
    int rowbase = (n0 < 256) ? (g * 256 + n0) : (1024 + g * 256 + (n0 - 256));
    EpiBf16T epi{p.w_in_t + (size_t)(rowbase - n0) * D, D};
    gemm_tile(p.w_in_f + g * 256, 1024, p.WcsT + (size_t)g * 512 * 256, 256, 256, tm * 128, n0, epi, smem);
  }
}

__device__ void phase_norm_mod(const Params& p, int bid, int nb, char* smem) {
  const int lane = threadIdx.x & 63, w = threadIdx.x >> 6;
  for (int t = bid * 4 + w; t < T + TC; t += nb * 4) {
    const bool isx = t < T;
    const float* src = isx ? (p.x + (size_t)t * D) : (p.ctx + (size_t)(t - T) * D);
    const int mrow = isx ? (t / L) : 4;
    bf16_t* dst = isx ? (p.hx + (size_t)t * D) : (p.hc + (size_t)(t - T) * D);
    float4 v[8];
    float ss = 0.f;
#pragma unroll
    for (int c = 0; c < 8; ++c) {
      v[c] = *reinterpret_cast<const float4*>(src + c * 256 + lane * 4);
      ss += v[c].x * v[c].x + v[c].y * v[c].y + v[c].z * v[c].z + v[c].w * v[c].w;
    }
    ss = wave_sum_fast(ss);
    const float rstd = rsqrtf(ss * (1.f / D) + EPS);
    const float* sh = p.mod + (size_t)mrow * NMOD + 0 * D;
    const float* sc = p.mod + (size_t)mrow * NMOD + 1 * D;
#pragma unroll
    for (int c = 0; c < 8; ++c) {
      const int e0 = c * 256 + lane * 4;
      const float4 g = *reinterpret_cast<const float4*>(p.g_pre_mix + e0);
      const float4 s4 = *reinterpret_cast<const float4*>(sc + e0), h4 = *reinterpret_cast<const float4*>(sh + e0);
      uint2 pk;
      pk.x = pack2(v[c].x * rstd * g.x * (1.f + s4.x) + h4.x, v[c].y * rstd * g.y * (1.f + s4.y) + h4.y);
      pk.y = pack2(v[c].z * rstd * g.z * (1.f + s4.z) + h4.z, v[c].w * rstd * g.w * (1.f + s4.w) + h4.w);
      *reinterpret_cast<uint2*>(dst + e0) = pk;
    }
  }
}

__device__ __forceinline__ void convert_uv_units(const Params& p, size_t u0, size_t u1) {
  const size_t n16 = (size_t)16384 * D / 16;
  for (size_t i = u0 + threadIdx.x; i < u1; i += NTHREADS) {
    const float* s = (i < n16) ? p.eu : p.ev;
    uint8_t* d = (i < n16) ? p.U8 : p.V8;
    const size_t j = (i < n16) ? i : i - n16;
    uint32_t o[4];
#pragma unroll
    for (int q4 = 0; q4 < 4; ++q4) {
      const float4 v = *reinterpret_cast<const float4*>(s + j * 16 + q4 * 4);
      int pk = 0;
      pk = __builtin_amdgcn_cvt_pk_fp8_f32(v.x * 512.f, v.y * 512.f, pk, false);
      pk = __builtin_amdgcn_cvt_pk_fp8_f32(v.z * 512.f, v.w * 512.f, pk, true);
      o[q4] = (uint32_t)pk;
    }
    *reinterpret_cast<uint4*>(d + j * 16) = uint4{o[0], o[1], o[2], o[3]};
  }
}
__device__ void phase_inproj(const Params& p, int bid, int nb, char* smem) {
  if ((nb & 7) == 0) {
    const int x = bid & 7, rank = bid >> 3, per = nb >> 3;
    for (int s_ = rank; s_ < 128 + 53; s_ += per) {
      if (s_ < 128) {
        const int tn2 = s_ >> 3, m0_ = (8 * x + (s_ & 7)) * 128;
        if (tn2 < 8) { EpiInAB epi{p.ABt, L}; gemm_tile_n256(p.hx, D, p.w_in_t, D, D, m0_, tn2 * 256, epi, smem); }
        else if (tn2 < 12) { EpiInZ epi{p.z}; gemm_tile_n256(p.hx, D, p.w_in_t, D, D, m0_, tn2 * 256, epi, smem); }
        else { EpiInXbc epi{p.xbcraw}; gemm_tile_n256(p.hx, D, p.w_in_t, D, D, m0_, tn2 * 256, epi, smem); }
      } else if (s_ < 128 + 40) {
        const int i = s_ - 128;
        EpiInProj epi{p.ABt, p.z, p.xbcraw, p.dtraw, L};
        gemm_tile(p.hx, D, p.w_in_t, D, D, (8 * x + (i & 7)) * 128, (32 + (i >> 3)) * 128, epi, smem);
      } else {
        const int u = x * 13 + (s_ - 168);
        EpiInProj epi{nullptr, nullptr, p.xbcraw_c, p.dtraw_c, CTX};
        gemm_tile(p.hc, D, p.w_in_t, D, D, (u / 13) * 128, 3072 + (u % 13) * 128, epi, smem);
      }
    }
    return;
  }
  const int ntx = 64 * 37, ntc = 8 * 13;
  for (int t = bid; t < ntx + ntc; t += nb) {
    if (t < ntx) {
      int tm = t / 37, tn = t % 37;
      EpiInProj epi{p.ABt, p.z, p.xbcraw, p.dtraw, L};
      gemm_tile(p.hx, D, p.w_in_t, D, D, tm * 128, tn * 128, epi, smem);
    } else {
      int u = t - ntx;
      int tm = u / 13, tn = u % 13;
      EpiInProj epi{nullptr, nullptr, p.xbcraw_c, p.dtraw_c, CTX};
      gemm_tile(p.hc, D, p.w_in_t, D, D, tm * 128, 3072 + tn * 128, epi, smem);
    }
  }
}

__device__ void ssm_pre_tile(const Params& p, int task, char* smem) {
  const bool isx = task < 3072;
  const int u = isx ? task : task - 3072;
  const int ntt = isx ? 32 : 4;
  const int ct = u % 24, tt = (u / 24) % ntt, b = u / (24 * ntt);
  const int seqlen = isx ? L : CTX;
  const float* raw = (isx ? p.xbcraw : p.xbcraw_c) + (size_t)b * seqlen * DXBC;
  const int l0 = tt * 64, c0 = ct * 64, tid = threadIdx.x;
  float (*rt)[65] = reinterpret_cast<float (*)[65]>(smem);
  float (*at)[65] = reinterpret_cast<float (*)[65]>(smem + 66 * 65 * 4);
  __syncthreads();
  for (int i = tid; i < 66 * 64; i += NTHREADS) {
    int r = i >> 6, cc = i & 63, l = l0 - 1 + r;
    rt[r][cc] = (l >= 0 && l < seqlen) ? raw[(size_t)l * DXBC + c0 + cc] : 0.f;
  }
  __syncthreads();
  for (int i = tid; i < 64 * 64; i += NTHREADS) {
    int r = i >> 6, cc = i & 63, c = c0 + cc;
    float acc = p.conv_b[c] + rt[r][cc] * p.conv_w[c] + rt[r + 1][cc] * p.conv_w[DXBC + c] + rt[r + 2][cc] * p.conv_w[2 * DXBC + c];
    at[r][cc] = silu_f(acc);
  }
  __syncthreads();
  const size_t trow0 = isx ? ((size_t)b * L + l0) : ((size_t)T + (size_t)b * CTX + l0);
  for (int i = tid; i < 64 * 32; i += NTHREADS) {
    int r = i >> 5, c2 = (i & 31) * 2;
    *reinterpret_cast<uint32_t*>(p.act_tm + (trow0 + r) * DXBC + c0 + c2) = pack2(at[r][c2], at[r][c2 + 1]);
  }
  if (c0 < 1280) {
    bf16_t* cm = (isx ? p.act_cm_x : p.act_cm_c) + (size_t)b * 1280 * seqlen;
    for (int i = tid; i < 64 * 32; i += NTHREADS) {
      int cc = i >> 5, r2 = (i & 31) * 2;
      *reinterpret_cast<uint32_t*>(cm + (size_t)(c0 + cc) * seqlen + l0 + r2) = pack2(at[r2][cc], at[r2 + 1][cc]);
    }
  }
}
__device__ void dft_fold_rows(const Params& p, int bid, int nb) {
  const int lane = threadIdx.x & 63, w = threadIdx.x >> 6;
  for (int row = bid * 4 + w; row < NB * 1024; row += nb * 4) {
    const bf16_t* A = p.ABt + (size_t)row * 4096;
    const bf16_t* Bv = A + 2048;
    bf16_t* F = p.Fs + (size_t)row * 2048;
    float alt = 0.f;
#pragma unroll 4
    for (int i = 0; i < 16; ++i) {
      const int l = i * 64 + lane;
      const float a = bf2f(A[l]), bb = bf2f(Bv[l]);
      const float ar = (l == 0) ? 0.f : bf2f(A[2048 - l]), br = (l == 0) ? bb : bf2f(Bv[2048 - l]);
      const float as = a + ar, bs = bb - br;
      F[l] = f2bf(as); F[1024 + l] = f2bf(bs);
      alt += (l & 1) ? -as : as;
    }
    alt = wave_sum(alt) + bf2f(A[1024]);
    if (lane == 0) { const int b = row >> 10, ch = row & 1023; p.ycat[((size_t)b * L + 1024) * D + ch] = f2bf(alt); }
  }
}
__device__ void phase_ssm_pre(const Params& p, int bid, int nb, char* smem) {
  const int tid = threadIdx.x;
  dft_fold_rows(p, bid, nb);
  for (int t = bid; t < 3072 + 384; t += nb) ssm_pre_tile(p, t, smem);
  for (int i = bid * NTHREADS + tid; i < (T + TC) * 32; i += nb * NTHREADS) {
    const bool isx = i < T * 32;
    const int ii = isx ? i : i - T * 32;
    const int t = ii >> 5, j = ii & 31;
    const float v = (isx ? p.dtraw : p.dtraw_c)[ii];
    float* df = isx ? p.dtf : p.dtf_c;
    float* db = isx ? p.dtb : p.dtb_c;
    if (j < 16) df[t * 16 + j] = softplus_f(v + p.dt_bias_f[j]);
    else db[t * 16 + (j - 16)] = softplus_f(v + p.dt_bias_b[j - 16]);
  }
}

__device__ __forceinline__ int swz16(int row, int chunk) { return row * 256 + ((chunk ^ (row & 15)) << 4); }
__device__ __forceinline__ int swz8(int row, int chunk) { return row * 128 + ((chunk ^ (row & 7)) << 4); }

#define LDS_BARRIER() asm volatile("s_waitcnt lgkmcnt(0)\n\ts_barrier" ::: "memory")
__device__ void ssd_task(const Params& p, int task, char* smem) {
  const int dir = task & 1, ph = (task >> 1) & 1, h = (task >> 2) & 15, b = task >> 6;
  const int tid = opaque_tid(), lane = tid & 63, w = tid >> 6;
  const int g = h >> 3, lr0 = lane & 15, lq0 = lane >> 4;
  const float a = -__expf(dir ? p.a_log_b[h] : p.a_log_f[h]);
  char* sCc = smem; char* sBc = smem + 16384; char* sBT = smem + 32768; char* sXT = smem + 49152; char* sHb = smem + 57344;
  float* se = reinterpret_cast<float*>(smem + 73728);
  float* sdt = se + 64; float* sw = se + 128; float* sy = se + 192; float* stot = se + 256;
  float* yo = dir ? p.yb : p.yf;
  f32x4 H[2][2];
#pragma unroll
  for (int i = 0; i < 2; ++i)
#pragma unroll
    for (int j = 0; j < 2; ++j) H[i][j] = f32x4{0.f, 0.f, 0.f, 0.f};
  __syncthreads();
  for (int i = tid; i < 512; i += NTHREADS) reinterpret_cast<uint4*>(sHb)[i] = uint4{0, 0, 0, 0};

  const int crow = tid >> 4, cch = tid & 15;
  const int trow = tid >> 3, tch = tid & 7;
  uint4 rC0, rC1, rC2, rC3, rB0, rB1, rB2, rB3, rT0, rT1, rT2, rT3, rX;
  rC0 = rC1 = rC2 = rC3 = rB0 = rB1 = rB2 = rB3 = uint4{0, 0, 0, 0};
  float rdt = 0.f;
#define SSD_PARAMS(st_)                                                                                                   \
  const bool isctx_ = (st_) < 4;                                                                                          \
  const int nch_ = isctx_ ? 4 : 32, ci_ = isctx_ ? (st_) : (st_) - 4;                                                     \
  const int c_ = dir ? (nch_ - 1 - ci_) : ci_;                                                                            \
  const int seqlen_ = isctx_ ? CTX : L;                                                                                   \
  const size_t trow0_ = isctx_ ? ((size_t)T + (size_t)b * CTX + c_ * 64) : ((size_t)b * L + c_ * 64);                     \
  const size_t drow0_ = (size_t)b * seqlen_ + c_ * 64;                                                                    \
  const float* dtp_ = isctx_ ? (dir ? p.dtb_c : p.dtf_c) : (dir ? p.dtb : p.dtf);                                         \
  const bf16_t* cm_ = (isctx_ ? p.act_cm_c : p.act_cm_x) + (size_t)b * 1280 * seqlen_ + c_ * 64;
#define SSD_PREFETCH(st_)                                                                                                 \
  do {                                                                                                                    \
    SSD_PARAMS(st_)                                                                                                       \
    if (w == 0) rdt = dtp_[(drow0_ + lane) * 16 + h];                                                                     \
    if (!isctx_) {                                                                                                        \
      const bf16_t* src = p.act_tm + (trow0_ + crow) * DXBC + g * 128 + cch * 8;                                          \
      rC0 = *reinterpret_cast<const uint4*>(src + 1280);             rB0 = *reinterpret_cast<const uint4*>(src + 1024);   \
      rC1 = *reinterpret_cast<const uint4*>(src + 16 * DXBC + 1280); rB1 = *reinterpret_cast<const uint4*>(src + 16 * DXBC + 1024); \
      rC2 = *reinterpret_cast<const uint4*>(src + 32 * DXBC + 1280); rB2 = *reinterpret_cast<const uint4*>(src + 32 * DXBC + 1024); \
      rC3 = *reinterpret_cast<const uint4*>(src + 48 * DXBC + 1280); rB3 = *reinterpret_cast<const uint4*>(src + 48 * DXBC + 1024); \
    }                                                                                                                     \
    const bf16_t* srt = cm_ + (size_t)(1024 + g * 128 + trow) * seqlen_ + tch * 8;                                        \
    rT0 = *reinterpret_cast<const uint4*>(srt);                                                                           \
    rT1 = *reinterpret_cast<const uint4*>(srt + (size_t)32 * seqlen_);                                                    \
    rT2 = *reinterpret_cast<const uint4*>(srt + (size_t)64 * seqlen_);                                                    \
    rT3 = *reinterpret_cast<const uint4*>(srt + (size_t)96 * seqlen_);                                                    \
    rX = *reinterpret_cast<const uint4*>(cm_ + (size_t)(h * 64 + ph * 32 + trow) * seqlen_ + tch * 8);                    \
  } while (0)

  for (int step = 0; step < 36; ++step) {
    SSD_PREFETCH(step);
    const bool isctx = step < 4;
    const int c = dir ? ((isctx ? 4 : 32) - 1 - (isctx ? step : step - 4)) : (isctx ? step : step - 4);
    const size_t trow0 = (size_t)b * L + c * 64;
    int lr = lr0, lq = lq0;
    asm volatile("" : "+v"(lr), "+v"(lq));
    LDS_BARRIER();
    if (w == 0) {
      const float dtv = rdt;
      float v = a * dtv;
      if (!dir) {
#pragma unroll
        for (int o = 1; o < 64; o <<= 1) { float n = __shfl_up(v, o); v += (lane >= o) ? n : 0.f; }
      } else {
#pragma unroll
        for (int o = 1; o < 64; o <<= 1) { float n = __shfl_down(v, o); v += (lane + o < 64) ? n : 0.f; }
      }
      const float etot = __shfl(v, dir ? 0 : 63);
      se[lane] = v; sdt[lane] = dtv; sw[lane] = dtv * __expf(etot - v); sy[lane] = __expf(v);
      if (lane == 0) stot[0] = etot;
    }
    if (!isctx) {
      const int oc = swz16(crow, cch);
      *reinterpret_cast<uint4*>(sCc + oc) = rC0;         *reinterpret_cast<uint4*>(sBc + oc) = rB0;
      *reinterpret_cast<uint4*>(sCc + oc + 4096) = rC1;  *reinterpret_cast<uint4*>(sBc + oc + 4096) = rB1;
      *reinterpret_cast<uint4*>(sCc + oc + 8192) = rC2;  *reinterpret_cast<uint4*>(sBc + oc + 8192) = rB2;
      *reinterpret_cast<uint4*>(sCc + oc + 12288) = rC3; *reinterpret_cast<uint4*>(sBc + oc + 12288) = rB3;
    }
    {
      const int ot = swz8(trow, tch);
      *reinterpret_cast<uint4*>(sBT + ot) = rT0;
      *reinterpret_cast<uint4*>(sBT + ot + 4096) = rT1;
      *reinterpret_cast<uint4*>(sBT + ot + 8192) = rT2;
      *reinterpret_cast<uint4*>(sBT + ot + 12288) = rT3;
      *reinterpret_cast<uint4*>(sXT + ot) = rX;
    }
    LDS_BARRIER();
    const float etot = stot[0];
    if (!isctx) {
      f32x4 G[4];
      bf16x8 ca[4];
#pragma unroll
      for (int j = 0; j < 4; ++j) G[j] = f32x4{0.f, 0.f, 0.f, 0.f};
#pragma unroll
      for (int kk = 0; kk < 4; ++kk) ca[kk] = *reinterpret_cast<const bf16x8*>(sCc + swz16(16 * w + lr, kk * 4 + lq));
#pragma unroll
      for (int kk = 0; kk < 4; ++kk)
#pragma unroll
        for (int j = 0; j < 4; ++j) {
          bf16x8 bb = *reinterpret_cast<const bf16x8*>(sBc + swz16(16 * j + lr, kk * 4 + lq));
          G[j] = __builtin_amdgcn_mfma_f32_16x16x32_bf16(ca[kk], bb, G[j], 0, 0, 0);
        }
      LDS_BARRIER();
      float el[4];
#pragma unroll
      for (int r = 0; r < 4; ++r) el[r] = se[16 * w + lq * 4 + r];
#pragma unroll
      for (int j = 0; j < 4; ++j) {
        const int s_ = 16 * j + lr;
        const float es = se[s_], ds = sdt[s_];
#pragma unroll
        for (int r = 0; r < 4; ++r) {
          const int l = 16 * w + lq * 4 + r;
          const bool keep = dir ? (s_ >= l) : (s_ <= l);
          const float m = keep ? G[j][r] * __expf(el[r] - es) * ds : 0.f;
          *reinterpret_cast<bf16_t*>(sBc + swz8(l, s_ >> 3) + (s_ & 7) * 2) = f2bf(m);
        }
      }
      LDS_BARRIER();
      f32x4 Y[2], Yo[2];
#pragma unroll
      for (int j = 0; j < 2; ++j) { Y[j] = f32x4{0.f, 0.f, 0.f, 0.f}; Yo[j] = f32x4{0.f, 0.f, 0.f, 0.f}; }
#pragma unroll
      for (int kk = 0; kk < 2; ++kk) {
        bf16x8 ma = *reinterpret_cast<const bf16x8*>(sBc + swz8(16 * w + lr, kk * 4 + lq));
#pragma unroll
        for (int j = 0; j < 2; ++j) {
          bf16x8 xb = *reinterpret_cast<const bf16x8*>(sXT + swz8(16 * j + lr, kk * 4 + lq));
          Y[j] = __builtin_amdgcn_mfma_f32_16x16x32_bf16(ma, xb, Y[j], 0, 0, 0);
        }
      }
#pragma unroll
      for (int kk = 0; kk < 4; ++kk)
#pragma unroll
        for (int j = 0; j < 2; ++j) {
          bf16x8 hb = *reinterpret_cast<const bf16x8*>(sHb + swz16(16 * j + lr, kk * 4 + lq));
          Yo[j] = __builtin_amdgcn_mfma_f32_16x16x32_bf16(ca[kk], hb, Yo[j], 0, 0, 0);
        }
      float syl[4];
#pragma unroll
      for (int r = 0; r < 4; ++r) syl[r] = sy[16 * w + lq * 4 + r];
#pragma unroll
      for (int j = 0; j < 2; ++j)
#pragma unroll
        for (int r = 0; r < 4; ++r) {
          const int l = 16 * w + lq * 4 + r;
          yo[(trow0 + l) * 1024 + h * 64 + ph * 32 + 16 * j + lr] = Y[j][r] + syl[r] * Yo[j][r];
        }
    }
    {
      const float dec = __expf(etot);
#pragma unroll
      for (int i = 0; i < 2; ++i)
#pragma unroll
        for (int j = 0; j < 2; ++j) H[i][j] *= dec;
#pragma unroll
      for (int kk = 0; kk < 2; ++kk) {
        const int s0 = kk * 32 + lq * 8;
        const float4 w0 = *reinterpret_cast<const float4*>(sw + s0), w1 = *reinterpret_cast<const float4*>(sw + s0 + 4);
        bf16x8 xs[2];
#pragma unroll
        for (int i = 0; i < 2; ++i) {
          const bf16x8 xa = *reinterpret_cast<const bf16x8*>(sXT + swz8(16 * i + lr, kk * 4 + lq));
          xs[i][0] = (short)f2bf(bf2f((bf16_t)xa[0]) * w0.x); xs[i][1] = (short)f2bf(bf2f((bf16_t)xa[1]) * w0.y);
          xs[i][2] = (short)f2bf(bf2f((bf16_t)xa[2]) * w0.z); xs[i][3] = (short)f2bf(bf2f((bf16_t)xa[3]) * w0.w);
          xs[i][4] = (short)f2bf(bf2f((bf16_t)xa[4]) * w1.x); xs[i][5] = (short)f2bf(bf2f((bf16_t)xa[5]) * w1.y);
          xs[i][6] = (short)f2bf(bf2f((bf16_t)xa[6]) * w1.z); xs[i][7] = (short)f2bf(bf2f((bf16_t)xa[7]) * w1.w);
        }
#pragma unroll
        for (int j = 0; j < 2; ++j) {
          const bf16x8 bt = *reinterpret_cast<const bf16x8*>(sBT + swz8(16 * (2 * w + j) + lr, kk * 4 + lq));
#pragma unroll
          for (int i = 0; i < 2; ++i) H[i][j] = __builtin_amdgcn_mfma_f32_16x16x32_bf16(xs[i], bt, H[i][j], 0, 0, 0);
        }
      }
    }
    LDS_BARRIER();
#pragma unroll
    for (int i = 0; i < 2; ++i)
#pragma unroll
      for (int j = 0; j < 2; ++j) {
        const int n = 16 * (2 * w + j) + lr;
#pragma unroll
        for (int r = 0; r < 4; ++r) {
          const int pr = 16 * i + lq * 4 + r;
          *reinterpret_cast<bf16_t*>(sHb + swz16(pr, n >> 3) + (n & 7) * 2) = f2bf(H[i][j][r]);
        }
      }
  }
#undef SSD_PREFETCH
#undef SSD_PARAMS
}

#undef LDS_BARRIER
__device__ void phase_ssd_dft(const Params& p, int bid, int nb, char* smem) {
  for (int t = bid; t < 256; t += nb) ssd_task(p, t, smem);
  int* stile = reinterpret_cast<int*>(smem + 75776);
  for (;;) {
    __syncthreads();
    if (threadIdx.x == 0) *stile = (int)atomicAdd(p.ctr, 1u);
    __syncthreads();
    const int t = *stile;
    if (t >= 4 * 8 * 8) break;
    const int b = t >> 6, tm = (t & 63) >> 3, tn = t & 7;
    const bf16_t* Fb = p.Fs + (size_t)b * 1024 * 2048;
    f32x4 accC[4][4], accS[4][4];
    gemm_mainloop(p.dftm, 2048, Fb, 2048, 1024, tm * 128, tn * 128, accC, smem);
    gemm_mainloop(p.dftm + 1024, 2048, Fb + 1024, 2048, 1024, tm * 128, tn * 128, accS, smem);
    const int lane = threadIdx.x & 63, w = threadIdx.x >> 6, wm = w >> 1, wn = w & 1;
#pragma unroll
    for (int i = 0; i < 4; ++i) {
      int lq_ = lane >> 4, lr_ = lane & 15;
      asm volatile("" : "+v"(lq_), "+v"(lr_));
#pragma unroll
      for (int j = 0; j < 4; ++j) {
        const int k0 = tm * 128 + wm * 64 + i * 16 + lq_ * 4;
        const int ch = tn * 128 + wn * 64 + j * 16 + lr_;
        const float a = bf2f(p.ABt[((size_t)b * 1024 + ch) * 4096 + 1024]);
#pragma unroll
        for (int r = 0; r < 4; ++r) {
          const int k = k0 + r;
          const float as = (k & 1) ? -a : a;
          const float c = accC[i][j][r], sn = accS[i][j][r];
          p.ycat[((size_t)b * L + k) * D + ch] = f2bf(c - sn + as);
          if (k > 0) p.ycat[((size_t)b * L + (L - k)) * D + ch] = f2bf(c + sn + as);
        }
      }
    }
  }
  for (;;) {
    __syncthreads();
    if (threadIdx.x == 0) *stile = (int)atomicAdd(p.ctr + 8, 1u);
    __syncthreads();
    const int q = *stile;
    if (q >= 1024 + 1536) break;
    if (q < 1024) convert_uv_units(p, (size_t)q * 4096, (size_t)(q + 1) * 4096);
    else if (q < 1024 + 1024) { const int q1 = q - 1024; transpose_convert_task(p.w_out, D, 0, D, p.w_out_t, q1 / 32, q1 % 32, reinterpret_cast<float*>(smem)); }
    else { const int q2 = q - 2048; transpose_convert_task(p.w_query, 1024, 0, D, p.w_q_t, q2 / 16, q2 % 16, reinterpret_cast<float*>(smem)); }
  }
}

__device__ void phase_ssm_post(const Params& p, int bid, int nb, char* smem) {
  const int lane = threadIdx.x & 63, w = threadIdx.x >> 6;
  for (int t = bid * 4 + w; t < T; t += nb * 4) {
    float y[4][4];
    float ss0 = 0.f, ss1 = 0.f;
#pragma unroll
    for (int c = 0; c < 4; ++c) {
      const int c0 = c * 256 + lane * 4;
      const int h = c0 >> 6;
      const float dsk = p.d_skip_f[h] + p.d_skip_b[h];
      const float4 a = *reinterpret_cast<const float4*>(p.yf + (size_t)t * 1024 + c0);
      const float4 bq = *reinterpret_cast<const float4*>(p.yb + (size_t)t * 1024 + c0);
      const uint2 xq = *reinterpret_cast<const uint2*>(p.act_tm + (size_t)t * DXBC + c0);
      const uint2 zz = *reinterpret_cast<const uint2*>(p.z + (size_t)t * 1024 + c0);
      y[c][0] = (a.x + bq.x + dsk * bflo(xq.x)) * silu_f(bflo(zz.x));
      y[c][1] = (a.y + bq.y + dsk * bfhi(xq.x)) * silu_f(bfhi(zz.x));
      y[c][2] = (a.z + bq.z + dsk * bflo(xq.y)) * silu_f(bflo(zz.y));
      y[c][3] = (a.w + bq.w + dsk * bfhi(xq.y)) * silu_f(bfhi(zz.y));
      const float q = y[c][0] * y[c][0] + y[c][1] * y[c][1] + y[c][2] * y[c][2] + y[c][3] * y[c][3];
      if (c < 2) ss0 += q; else ss1 += q;
    }
    ss0 = wave_sum_fast(ss0); ss1 = wave_sum_fast(ss1);
    const float r0 = rsqrtf(ss0 * (1.f / 512.f) + EPS), r1 = rsqrtf(ss1 * (1.f / 512.f) + EPS);
#pragma unroll
    for (int c = 0; c < 4; ++c) {
      const int c0 = c * 256 + lane * 4;
      const float rstd = (c < 2) ? r0 : r1;
      const float4 nw = *reinterpret_cast<const float4*>(p.ssm_norm_w + c0);
      uint2 o; o.x = pack2(y[c][0] * rstd * nw.x, y[c][1] * rstd * nw.y); o.y = pack2(y[c][2] * rstd * nw.z, y[c][3] * rstd * nw.w);
      *reinterpret_cast<uint2*>(p.ycat + (size_t)t * D + 1024 + c0) = o;
    }
  }
}

__device__ void phase_outproj(const Params& p, int bid, int nb, char* smem) {
  if ((nb & 7) == 0) {
    const int x = bid & 7, rank = bid >> 3, per = nb >> 3;
    for (int s_ = rank; s_ < 64; s_ += per) {
      EpiF32 epi{p.y_x, D};
      gemm_tile_n256(p.ycat, D, p.w_out_t, D, D, (8 * x + (s_ & 7)) * 128, (s_ >> 3) * 256, epi, smem);
    }
    return;
  }
  for (int t = bid; t < 64 * 16; t += nb) {
    EpiF32 epi{p.y_x, D};
    gemm_tile(p.ycat, D, p.w_out_t, D, D, (t >> 4) * 128, (t & 15) * 128, epi, smem);
  }
}
__device__ void phase_postmix(const Params& p, int bid, int nb, char* smem) {
  const int lane = threadIdx.x & 63, w = threadIdx.x >> 6;
  for (int t = bid * 4 + w; t < T; t += nb * 4) {
    const int b = t / L;
    float4 y[8];
    float ss = 0.f;
#pragma unroll
    for (int c = 0; c < 8; ++c) {
      y[c] = *reinterpret_cast<const float4*>(p.y_x + (size_t)t * D + c * 256 + lane * 4);
      ss += y[c].x * y[c].x + y[c].y * y[c].y + y[c].z * y[c].z + y[c].w * y[c].w;
    }
    ss = wave_sum_fast(ss);
    const float rstd = rsqrtf(ss * (1.f / D) + EPS);
    const float* gm = p.mod + (size_t)b * NMOD + 2 * D;
    float ss1 = 0.f;
#pragma unroll
    for (int c = 0; c < 8; ++c) {
      const int e0 = c * 256 + lane * 4;
      const float4 xv = *reinterpret_cast<const float4*>(p.x + (size_t)t * D + e0);
      const float4 g4 = *reinterpret_cast<const float4*>(gm + e0), gp = *reinterpret_cast<const float4*>(p.g_post_mix + e0);
      y[c].x = xv.x + g4.x * (y[c].x * rstd * gp.x); y[c].y = xv.y + g4.y * (y[c].y * rstd * gp.y);
      y[c].z = xv.z + g4.z * (y[c].z * rstd * gp.z); y[c].w = xv.w + g4.w * (y[c].w * rstd * gp.w);
      ss1 += y[c].x * y[c].x + y[c].y * y[c].y + y[c].z * y[c].z + y[c].w * y[c].w;
      *reinterpret_cast<float4*>(p.out + (size_t)t * D + e0) = y[c];
    }
    ss1 = wave_sum_fast(ss1);
    const float rstd1 = rsqrtf(ss1 * (1.f / D) + EPS);
    const float* sf = p.mod + (size_t)b * NMOD + 3 * D;
    const float* cf = p.mod + (size_t)b * NMOD + 4 * D;
#pragma unroll
    for (int c = 0; c < 8; ++c) {
      const int e0 = c * 256 + lane * 4;
      const float4 g = *reinterpret_cast<const float4*>(p.g_pre_ffn + e0);
      const float4 s4 = *reinterpret_cast<const float4*>(cf + e0), h4 = *reinterpret_cast<const float4*>(sf + e0);
      uint2 pk;
      pk.x = pack2(y[c].x * rstd1 * g.x * (1.f + s4.x) + h4.x, y[c].y * rstd1 * g.y * (1.f + s4.y) + h4.y);
      pk.y = pack2(y[c].z * rstd1 * g.z * (1.f + s4.z) + h4.z, y[c].w * rstd1 * g.w * (1.f + s4.w) + h4.w);
      *reinterpret_cast<uint2*>(p.hx + (size_t)t * D + e0) = pk;
    }
  }
}

__device__ __forceinline__ uint32_t mono_key(float f) {
  uint32_t u = __float_as_uint(f);
  return (u & 0x80000000u) ? ~u : (u | 0x80000000u);
}
__device__ __forceinline__ void ins16(uint32_t (&Lk)[16], uint32_t x) {
#pragma unroll
  for (int i = 0; i < 16; ++i) { uint32_t hi = max(Lk[i], x); x = min(Lk[i], x); Lk[i] = hi; }
}
__device__ __forceinline__ float unmono_key(uint32_t k) {
  return __uint_as_float((k & 0x80000000u) ? (k ^ 0x80000000u) : ~k);
}
typedef __attribute__((ext_vector_type(16))) float f32x16;
__device__ void phase_q_route(const Params& p, int bid, int nb, char* smem) {
  const int tid = opaque_tid(), lane = tid & 63, w = tid >> 6;
  const int wm = w >> 1, wn = w & 1, lr = lane & 15, lq = lane >> 4;
  const int l31 = lane & 31, lh = lane >> 5;
  for (int tile0 = bid; tile0 < 512; tile0 += nb) {
    const int tile = ((nb & 7) == 0 && nb >= 512) ? (((tile0 & 7) * 8 + ((tile0 >> 3) & 7)) * 8 + (tile0 >> 6)) : tile0;
    const int h = tile & 7, m0 = (tile >> 3) * 128;
    {
      f32x4 acc[4][4];
      gemm_mainloop(p.hx, D, p.w_q_t, D, D, m0, h * 128, acc, smem);
#pragma unroll
      for (int i = 0; i < 4; ++i)
#pragma unroll
        for (int j = 0; j < 4; ++j)
#pragma unroll
          for (int r = 0; r < 4; ++r) {
            const int row = wm * 64 + i * 16 + lq * 4 + r, col = wn * 64 + j * 16 + lr;
            *reinterpret_cast<bf16_t*>(smem + swz16(row, col >> 3) + (col & 7) * 2) = f2bf(acc[i][j][r]);
          }
    }
#pragma unroll 4
    for (int r = 0; r < 16; ++r) {
      const int id = tid + 256 * r, row = id >> 4, c4 = id & 15;
      const float* src = ((row < 128) ? p.sk1 : p.sk2) + ((size_t)(h * 128 + (row & 127)) * 64 + c4 * 4);
      const float4 v = *reinterpret_cast<const float4*>(src);
      uint2 pk; pk.x = pack2(v.x, v.y); pk.y = pack2(v.z, v.w);
      *reinterpret_cast<uint2*>(smem + 32768 + swz8(row, c4 >> 1) + (c4 & 1) * 8) = pk;
    }
    __syncthreads();
    uint32_t L1[16], L2[16];
#pragma unroll
    for (int sd = 0; sd < 2; ++sd) {
      uint32_t Lk[16];
#pragma unroll
      for (int i = 0; i < 16; ++i) Lk[i] = 0u;
      const uint32_t kb = (uint32_t)(lh * 4);
#pragma unroll
      for (int ih = 0; ih < 2; ++ih) {
        f32x16 Sa[2];
#pragma unroll
        for (int i = 0; i < 2; ++i)
#pragma unroll
          for (int g2 = 0; g2 < 16; ++g2) Sa[i][g2] = 0.f;
#pragma unroll
        for (int ks = 0; ks < 4; ++ks) {
          const bf16x8 qb = *reinterpret_cast<const bf16x8*>(smem + swz16(w * 32 + l31, sd * 8 + ks * 2 + lh));
#pragma unroll
          for (int i = 0; i < 2; ++i) {
            const bf16x8 ka = *reinterpret_cast<const bf16x8*>(smem + 32768 + swz8(sd * 128 + (ih * 2 + i) * 32 + l31, ks * 2 + lh));
            Sa[i] = __builtin_amdgcn_mfma_f32_32x32x16_bf16(ka, qb, Sa[i], 0, 0, 0);
          }
        }
#pragma unroll
        for (int i = 0; i < 2; ++i)
#pragma unroll
          for (int g2 = 0; g2 < 16; ++g2)
            ins16(Lk, (mono_key(Sa[i][g2]) & ~0x7Fu) | (uint32_t)((ih * 2 + i) * 32 + (g2 & 3) + 8 * (g2 >> 2)) | kb);
      }
#pragma unroll
      for (int i = 0; i < 8; ++i) {
        const uint32_t t1 = (uint32_t)__shfl_xor((int)Lk[15 - i], 32), t2 = (uint32_t)__shfl_xor((int)Lk[i], 32);
        Lk[i] = max(Lk[i], t1); Lk[15 - i] = max(Lk[15 - i], t2);
      }
#pragma unroll
      for (int dd = 8; dd >= 1; dd >>= 1)
#pragma unroll
        for (int i = 0; i < 16; ++i)
          if ((i & dd) == 0) { const uint32_t hi = max(Lk[i], Lk[i + dd]), lo = min(Lk[i], Lk[i + dd]); Lk[i] = hi; Lk[i + dd] = lo; }
#pragma unroll
      for (int r = 0; r < 16; ++r) { if (sd == 0) L1[r] = Lk[r]; else L2[r] = Lk[r]; }
    }
    __syncthreads();
    uint32_t* ib = reinterpret_cast<uint32_t*>(smem) + w * 1088 + l31 * 34;
    if (lh == 0) {
#pragma unroll
      for (int r = 0; r < 16; ++r) { ib[r] = L1[r] & 127u; ib[16 + r] = L2[r] & 127u; }
    }
    float v1[16], v2[16];
#pragma unroll
    for (int r = 0; r < 16; ++r) { v1[r] = unmono_key(L1[r] & ~0x7Fu); v2[r] = unmono_key(L2[r] & ~0x7Fu); }
    uint32_t C[16];
#pragma unroll
    for (int i = 0; i < 16; ++i) C[i] = 0u;
#pragma unroll
    for (int a = 0; a < 16; ++a)
#pragma unroll
      for (int bq = 0; bq < 16; ++bq)
        if ((a + 1) * (bq + 1) <= 16) ins16(C, (mono_key(v1[a] + v2[bq]) & ~0xFFu) | (uint32_t)(a * 16 + bq));
    float ts[16]; int te[16];
    __builtin_amdgcn_wave_barrier();
#pragma unroll
    for (int r = 0; r < 16; ++r) {
      const uint32_t code = C[r] & 0xFFu;
      te[r] = (int)(ib[code >> 4] * 128u + ib[16 + (code & 15u)]);
      ts[r] = unmono_key(C[r] & ~0xFFu);
    }
    const float mx = ts[0];
    float den = 0.f;
#pragma unroll
    for (int r = 0; r < 16; ++r) { ts[r] = __expf(ts[r] - mx); den += ts[r]; }
    const float inv = 1.f / den;
    const size_t ob = (size_t)(m0 + w * 32 + l31) * 128 + h * 16;
    if (lh == 0) {
#pragma unroll
      for (int r = 0; r < 16; r += 4) *reinterpret_cast<int4*>(p.idx + ob + r) = int4{te[r], te[r + 1], te[r + 2], te[r + 3]};
    } else {
#pragma unroll
      for (int r = 0; r < 16; r += 4)
        *reinterpret_cast<float4*>(p.gate + ob + r) = float4{ts[r] * inv, ts[r + 1] * inv, ts[r + 2] * inv, ts[r + 3] * inv};
    }
    __syncthreads();
  }
}

typedef __attribute__((ext_vector_type(2))) float f32x2;
__device__ __forceinline__ void fp8x16_to_f32(const uint4 q, f32x2 (&o)[8]) {
  o[0] = __builtin_amdgcn_cvt_pk_f32_fp8((int)q.x, false); o[1] = __builtin_amdgcn_cvt_pk_f32_fp8((int)q.x, true);
  o[2] = __builtin_amdgcn_cvt_pk_f32_fp8((int)q.y, false); o[3] = __builtin_amdgcn_cvt_pk_f32_fp8((int)q.y, true);
  o[4] = __builtin_amdgcn_cvt_pk_f32_fp8((int)q.z, false); o[5] = __builtin_amdgcn_cvt_pk_f32_fp8((int)q.z, true);
  o[6] = __builtin_amdgcn_cvt_pk_f32_fp8((int)q.w, false); o[7] = __builtin_amdgcn_cvt_pk_f32_fp8((int)q.w, true);
}
__device__ __forceinline__ unsigned my_xcc_id() { return (unsigned)__builtin_amdgcn_s_getreg((3 << 11) | 20) & 7u; }

__device__ void phase_exp_u(const Params& p, char* smem) {
  const int tid = opaque_tid(), lane = tid & 63, w = tid >> 6;
  const int sub = lane >> 4, cc = lane & 15;
  const unsigned myx = my_xcc_id();
  int* sh = reinterpret_cast<int*>(smem);
  int* si = reinterpret_cast<int*>(smem + 64) + w * 256;
  float* pbuf = reinterpret_cast<float*>(p.ycat);
  {
    unsigned qcur = 0;
    for (;;) {
      __syncthreads();
      if (tid == 0) {
        int found = -1; unsigned fx = 0;
        for (; qcur < 8; ++qcur) {
          fx = (myx + qcur) & 7u;
          const int c = (int)atomicAdd(&p.ctr[16 + fx], 1u);
          if (c < 256) { found = c; break; }
        }
        sh[0] = found; sh[1] = (int)fx;
      }
      __syncthreads();
      const int chunk = sh[0];
      const unsigned x = (unsigned)sh[1];
      if (chunk < 0) break;
      for (int tt = 0; tt < 8; ++tt) {
        const int t = chunk * 32 + w * 8 + tt;
        __builtin_amdgcn_wave_barrier();
        si[lane] = p.idx[(size_t)t * 128 + lane]; si[64 + lane] = p.idx[(size_t)t * 128 + 64 + lane];
        __builtin_amdgcn_wave_barrier();
        f32x2 hf[8];
#pragma unroll
        for (int q2 = 0; q2 < 2; ++q2) {
          const uint4 hq = *reinterpret_cast<const uint4*>(p.hx + (size_t)t * D + x * 256 + cc * 16 + q2 * 8);
          hf[q2 * 4 + 0] = f32x2{bflo(hq.x), bfhi(hq.x)}; hf[q2 * 4 + 1] = f32x2{bflo(hq.y), bfhi(hq.y)};
          hf[q2 * 4 + 2] = f32x2{bflo(hq.z), bfhi(hq.z)}; hf[q2 * 4 + 3] = f32x2{bflo(hq.w), bfhi(hq.w)};
        }
        const uint8_t* ub = p.U8 + x * 256 + cc * 16;
        uint4 qa[8], qb[8];
#define EU_LOAD(q_, bt_) _Pragma("unroll") for (int k = 0; k < 8; ++k) q_[k] = *reinterpret_cast<const uint4*>(ub + (size_t)si[((bt_) * 8 + k) * 4 + sub] * D)
#define EU_COMP(q_, kb_)                                                                                                \
  _Pragma("unroll") for (int k = 0; k < 8; ++k) {                                                                       \
    f32x2 uf[8];                                                                                                        \
    fp8x16_to_f32(q_[k], uf);                                                                                           \
    f32x2 d2 = hf[0] * uf[0];                                                                                           \
    _Pragma("unroll") for (int e = 1; e < 8; ++e) d2 += hf[e] * uf[e];                                                  \
    float d = d2.x + d2.y;                                                                                              \
    d += dpp_mov<0xB1>(d); d += dpp_mov<0x4E>(d); d += dpp_mov<0x124>(d); d += dpp_mov<0x128>(d);                       \
    mine = (cc == (kb_) + k) ? d : mine;                                                                                \
  }
        float mine = 0.f;
        EU_LOAD(qa, 0); EU_LOAD(qb, 1);
        EU_COMP(qa, 0); EU_LOAD(qa, 2);
        EU_COMP(qb, 8); EU_LOAD(qb, 3);
        pbuf[((size_t)x * T + t) * 128 + cc * 4 + sub] = mine * (1.f / 512.f);
        mine = 0.f;
        EU_COMP(qa, 0);
        EU_COMP(qb, 8);
        pbuf[((size_t)x * T + t) * 128 + (16 + cc) * 4 + sub] = mine * (1.f / 512.f);
#undef EU_LOAD
#undef EU_COMP
      }
    }
  }
}

__device__ void phase_exp_v(const Params& p, char* smem) {
  const int tid = opaque_tid(), lane = tid & 63, w = tid >> 6;
  const int sub = lane >> 4, cc = lane & 15;
  const unsigned myx = my_xcc_id();
  int* sh = reinterpret_cast<int*>(smem);
  int* si = reinterpret_cast<int*>(smem + 64) + w * 256;
  float* sc = reinterpret_cast<float*>(si + 128);
  float* yf = p.y_x;
  {
    unsigned qcur = 0;
    for (;;) {
      __syncthreads();
      if (tid == 0) {
        int found = -1; unsigned fx = 0;
        for (; qcur < 8; ++qcur) {
          fx = (myx + qcur) & 7u;
          const int c = (int)atomicAdd(&p.ctr[32 + fx], 1u);
          if (c < 256) { found = c; break; }
        }
        sh[0] = found; sh[1] = (int)fx;
      }
      __syncthreads();
      const int chunk = sh[0];
      const unsigned x = (unsigned)sh[1];
      if (chunk < 0) break;
      for (int tt = 0; tt < 8; ++tt) {
        const int t = chunk * 32 + w * 8 + tt;
        __builtin_amdgcn_wave_barrier();
        si[lane] = p.idx[(size_t)t * 128 + lane]; si[64 + lane] = p.idx[(size_t)t * 128 + 64 + lane];
        {
          const float* pb = reinterpret_cast<const float*>(p.ycat) + (size_t)t * 128;
          float d0 = 0.f, d1 = 0.f;
#pragma unroll
          for (int xs = 0; xs < 8; ++xs) { d0 += pb[(size_t)xs * T * 128 + lane]; d1 += pb[(size_t)xs * T * 128 + 64 + lane]; }
          sc[lane] = p.gate[(size_t)t * 128 + lane] * 0.5f * d0 * (1.f + erff(d0 * 0.70710678118654752f));
          sc[64 + lane] = p.gate[(size_t)t * 128 + 64 + lane] * 0.5f * d1 * (1.f + erff(d1 * 0.70710678118654752f));
        }
        __builtin_amdgcn_wave_barrier();
        f32x2 acc[8];
#pragma unroll
        for (int e = 0; e < 8; ++e) acc[e] = f32x2{0.f, 0.f};
        const uint8_t* vb = p.V8 + x * 256 + cc * 16;
        uint4 qa[8], qb[8];
#define EV_LOAD(q_, bt_) _Pragma("unroll") for (int k = 0; k < 8; ++k) q_[k] = *reinterpret_cast<const uint4*>(vb + (size_t)si[((bt_) * 8 + k) * 4 + sub] * D)
#define EV_COMP(q_, bt_)                                                                                                \
  _Pragma("unroll") for (int k = 0; k < 8; ++k) {                                                                       \
    f32x2 vf[8];                                                                                                        \
    fp8x16_to_f32(q_[k], vf);                                                                                           \
    const float cfk = sc[((bt_) * 8 + k) * 4 + sub];                                                                    \
    const f32x2 c2 = f32x2{cfk, cfk};                                                                                   \
    _Pragma("unroll") for (int e = 0; e < 8; ++e) acc[e] += c2 * vf[e];                                                 \
  }
        EV_LOAD(qa, 0); EV_LOAD(qb, 1);
        EV_COMP(qa, 0); EV_LOAD(qa, 2);
        EV_COMP(qb, 1); EV_LOAD(qb, 3);
        EV_COMP(qa, 2);
        EV_COMP(qb, 3);
#undef EV_LOAD
#undef EV_COMP
        {
          float* red = reinterpret_cast<float*>(smem + 8192) + w * 1280;
          float* mr = red + (sub * 16 + cc) * 20;
#pragma unroll
          for (int q4 = 0; q4 < 4; ++q4)
            *reinterpret_cast<float4*>(mr + q4 * 4) = float4{acc[q4 * 2].x, acc[q4 * 2].y, acc[q4 * 2 + 1].x, acc[q4 * 2 + 1].y};
          __builtin_amdgcn_wave_barrier();
          const int part = sub;
          float4 r0 = *reinterpret_cast<const float4*>(red + (0 * 16 + cc) * 20 + part * 4);
          float4 r1 = *reinterpret_cast<const float4*>(red + (1 * 16 + cc) * 20 + part * 4);
          float4 r2 = *reinterpret_cast<const float4*>(red + (2 * 16 + cc) * 20 + part * 4);
          float4 r3 = *reinterpret_cast<const float4*>(red + (3 * 16 + cc) * 20 + part * 4);
          const float sc512 = 1.f / 512.f;
          float4 o4 = float4{(r0.x + r1.x + r2.x + r3.x) * sc512, (r0.y + r1.y + r2.y + r3.y) * sc512,
                             (r0.z + r1.z + r2.z + r3.z) * sc512, (r0.w + r1.w + r2.w + r3.w) * sc512};
          *reinterpret_cast<float4*>(yf + (size_t)t * D + x * 256 + cc * 16 + part * 4) = o4;
          __builtin_amdgcn_wave_barrier();
        }
      }
    }
  }
}

__device__ void phase_exp_final(const Params& p, int bid, int nb, char* smem) {
  const int lane = threadIdx.x & 63, w = threadIdx.x >> 6;
  const float* yf = p.y_x;
  for (int t = bid * 4 + w; t < T; t += nb * 4) {
    const int b = t / L;
    float4 y[8];
    float ss = 0.f;
#pragma unroll
    for (int c = 0; c < 8; ++c) {
      y[c] = *reinterpret_cast<const float4*>(yf + (size_t)t * D + c * 256 + lane * 4);
      ss += y[c].x * y[c].x + y[c].y * y[c].y + y[c].z * y[c].z + y[c].w * y[c].w;
    }
    ss = wave_sum_fast(ss);
    const float rstd = rsqrtf(ss * (1.f / D) + EPS);
    const float* gfx = p.mod + (size_t)b * NMOD + 5 * D;
#pragma unroll
    for (int c = 0; c < 8; ++c) {
      const int e0 = c * 256 + lane * 4;
      float* o = p.out + (size_t)t * D + e0;
      float4 xo = *reinterpret_cast<const float4*>(o);
      const float4 g4 = *reinterpret_cast<const float4*>(gfx + e0), gp = *reinterpret_cast<const float4*>(p.g_post_ffn + e0);
      xo.x += g4.x * (y[c].x * rstd * gp.x); xo.y += g4.y * (y[c].y * rstd * gp.y);
      xo.z += g4.z * (y[c].z * rstd * gp.z); xo.w += g4.w * (y[c].w * rstd * gp.w);
      *reinterpret_cast<float4*>(o) = xo;
    }
  }
}

#define XB_TMO      128
#define XB_XCNT(j)  (256  + 64 * (j))
#define XB_XSUB(j)  (1280 + 64 * (j))
#define XB_XGEN(j)  (2304 + 64 * (j))
#define XB_TOP      3328
#define XB_TOPGEN   3392
#define XCD_BAR_WORDS 3456
#define XB_SPIN_CAP (1u << 22)
#define LAS __attribute__((address_space(3)))
__device__ __forceinline__ unsigned xb_ld(unsigned* p)              { return __hip_atomic_load(p, __ATOMIC_RELAXED, __HIP_MEMORY_SCOPE_AGENT); }
__device__ __forceinline__ unsigned xb_add(unsigned* p, unsigned v) { return __hip_atomic_fetch_add(p, v, __ATOMIC_RELAXED, __HIP_MEMORY_SCOPE_AGENT); }
__device__ __forceinline__ unsigned xb_xcc_id() { return (unsigned)__builtin_amdgcn_s_getreg((3 << 11) | 20) & 0xFu; }
#define XB_SPIN(cond, bar) do { unsigned _sp = 0; while (cond) { __builtin_amdgcn_s_sleep(1); \
    if ((++_sp & 255u) == 0u) { if (xb_ld(&(bar)[XB_TMO])) break; if (_sp > XB_SPIN_CAP) { atomicAdd(&(bar)[XB_TMO], 1u); break; } } } } while (0)
struct XcdBarrier { unsigned* bar; unsigned x; volatile LAS unsigned* st; };
__device__ __forceinline__ XcdBarrier xcd_barrier_post(unsigned* bar, volatile LAS unsigned* st) {
  XcdBarrier b; b.bar = bar; b.x = xb_xcc_id(); b.st = st;
  if (threadIdx.x == 0) (void)xb_add(&bar[XB_XCNT(b.x)], 1u);
  return b;
}
__device__ __forceinline__ void xcd_barrier_complete(unsigned* bar, unsigned x, unsigned& nloc, unsigned& nx) {
  const unsigned G = gridDim.x * gridDim.y * gridDim.z;
  unsigned sum, cnt, mine, sp = 0u;
  for (;;) {
    sum = 0u; cnt = 0u; mine = 0u;
#pragma unroll
    for (unsigned j = 0; j < 16; ++j) { const unsigned c = xb_ld(&bar[XB_XCNT(j)]); sum += c; cnt += (c > 0u) ? 1u : 0u; mine = (j == x) ? c : mine; }
    if (sum == G) break;
    __builtin_amdgcn_s_sleep(1);
    if ((++sp & 255u) == 0u) { if (xb_ld(&bar[XB_TMO])) break; if (sp > XB_SPIN_CAP) { atomicAdd(&bar[XB_TMO], 1u); break; } }
  }
  nloc = mine > 0u ? mine : 1u; nx = cnt > 0u ? cnt : 1u;
}
__device__ __forceinline__ void xcd_barrier(const XcdBarrier& b) {
  asm volatile("s_waitcnt vmcnt(0)" ::: "memory");
  __syncthreads();
  if (threadIdx.x == 0) {
    unsigned* bar = b.bar;
    __builtin_amdgcn_s_waitcnt(0);
    unsigned nloc = b.st[0], nx = b.st[1];
    if (nloc == 0u) { xcd_barrier_complete(bar, b.x, nloc, nx); b.st[0] = nloc; b.st[1] = nx; }
    const unsigned old = xb_add(&bar[XB_XSUB(b.x)], 1u);
    const unsigned gen = old / nloc;
    if (old + 1u == (gen + 1u) * nloc) {
      __builtin_amdgcn_fence(__ATOMIC_RELEASE, "agent");
      asm volatile("s_waitcnt vmcnt(0)" ::: "memory");
      const unsigned og = xb_add(&bar[XB_TOP], 1u);
      const unsigned tg = og / nx;
      if (og + 1u == (tg + 1u) * nx) xb_add(&bar[XB_TOPGEN], 1u);
      else XB_SPIN(xb_ld(&bar[XB_TOPGEN]) == tg, bar);
      __builtin_amdgcn_fence(__ATOMIC_ACQUIRE, "agent");
      xb_add(&bar[XB_XGEN(b.x)], 1u);
      asm volatile("s_waitcnt vmcnt(0)" ::: "memory");
    } else {
      XB_SPIN(xb_ld(&bar[XB_XGEN(b.x)]) == gen, bar);
      __builtin_amdgcn_fence(__ATOMIC_ACQUIRE, "agent");
      asm volatile("s_waitcnt vmcnt(0)" ::: "memory");
    }
  }
  __syncthreads();
}

__global__ void __launch_bounds__(NTHREADS, 2) fwd_mega(Params p) {
  __shared__ __attribute__((aligned(16))) char smem[75808];
  const int bid = blockIdx.x, nb = gridDim.x;
  volatile LAS unsigned* st = (volatile LAS unsigned*)(smem + 75792);
  if (threadIdx.x == 0) { st[0] = 0u; st[1] = 0u; }
  __syncthreads();
  const XcdBarrier bar = xcd_barrier_post(p.bar, st);
  phase_prep(p, bid, nb, smem);        xcd_barrier(bar);
  phase_fold(p, bid, nb, smem);        xcd_barrier(bar);
  phase_norm_mod(p, bid, nb, smem);    xcd_barrier(bar);
  phase_inproj(p, bid, nb, smem);      xcd_barrier(bar);
  phase_ssm_pre(p, bid, nb, smem);     xcd_barrier(bar);
  phase_ssd_dft(p, bid, nb, smem);     xcd_barrier(bar);
  phase_ssm_post(p, bid, nb, smem);    xcd_barrier(bar);
  phase_outproj(p, bid, nb, smem);     xcd_barrier(bar);
  phase_postmix(p, bid, nb, smem);     xcd_barrier(bar);
  phase_q_route(p, bid, nb, smem);     xcd_barrier(bar);
  phase_exp_u(p, smem);                xcd_barrier(bar);
  phase_exp_v(p, smem);                xcd_barrier(bar);
  phase_exp_final(p, bid, nb, smem);
}

}

extern "C" void kernel_launch(void* const* d_in, const int* in_sizes, int n_in, void* d_out, int out_size, void* d_ws,
                              size_t ws_size, hipStream_t stream) {
  Params p{};
  const float** fp = reinterpret_cast<const float**>(&p);
  for (int i = 0; i < 27; ++i) fp[i] = (const float*)d_in[i];
  p.out = (float*)d_out;
  char* ws = (char*)d_ws;
  size_t off = 0;
  auto take = [&](size_t bytes) { char* r = ws + off; off += (bytes + 255) & ~(size_t)255; return r; };
  p.U8 = (uint8_t*)take((size_t)16384 * D);
  p.V8 = (uint8_t*)take((size_t)16384 * D);
  p.w_in_t = (bf16_t*)take((size_t)NPROJ * D * 2);
  p.w_out_t = (bf16_t*)take((size_t)D * D * 2);
  p.w_q_t = (bf16_t*)take((size_t)1024 * D * 2);
  p.w_in_f = (bf16_t*)take((size_t)D * 1024 * 2);
  p.WcsT = (bf16_t*)take((size_t)4 * 512 * 256 * 2);
  p.dftm = (bf16_t*)take((size_t)1024 * 2048 * 2);
  p.Fs = (bf16_t*)take((size_t)NB * 1024 * 2048 * 2);
  p.partial = (float*)take((size_t)KSPLIT * 5 * NMOD * 4);
  p.mod = (float*)take((size_t)5 * NMOD * 4);
  p.hx = (bf16_t*)take((size_t)T * D * 2);
  p.hc = (bf16_t*)take((size_t)TC * D * 2);
  p.ABt = (bf16_t*)take((size_t)NB * 1024 * 4096 * 2);
  p.q = (float*)p.ABt;
  p.z = (bf16_t*)take((size_t)T * 1024 * 2);
  char* r1 = take(0);
  p.xbcraw = (float*)take((size_t)T * DXBC * 4);
  p.xbcraw_c = (float*)take((size_t)TC * DXBC * 4);
  p.act_tm = (bf16_t*)take((size_t)(T + TC) * DXBC * 2);
  p.act_cm_x = (bf16_t*)take((size_t)NB * 1280 * L * 2);
  p.act_cm_c = (bf16_t*)take((size_t)NB * 1280 * CTX * 2);
  p.y_x = (float*)r1;
  p.dtraw = (float*)take((size_t)T * 32 * 4);
  p.dtraw_c = (float*)take((size_t)TC * 32 * 4);
  p.dtf = (float*)take((size_t)T * 16 * 4);
  p.dtb = (float*)take((size_t)T * 16 * 4);
  p.dtf_c = (float*)take((size_t)TC * 16 * 4);
  p.dtb_c = (float*)take((size_t)TC * 16 * 4);
  p.yf = (float*)take((size_t)T * 1024 * 4);
  p.yb = (float*)take((size_t)T * 1024 * 4);
  p.ctr = (unsigned*)take(256);
  p.bar = (unsigned*)take((size_t)XCD_BAR_WORDS * 4);
  p.ycat = (bf16_t*)take((size_t)T * D * 2);
  p.idx = (int*)take((size_t)T * 128 * 4);
  p.gate = (float*)take((size_t)T * 128 * 4);
  if (off > ws_size) { fprintf(stderr, "kernel_launch: workspace too small: need %zu have %zu\n", off, ws_size); return; }
  static int grid_blocks = 0;
  if (!grid_blocks) {
    int dev = 0, cus = 0, per_cu = 0;
    hipGetDevice(&dev);
    hipDeviceGetAttribute(&cus, hipDeviceAttributeMultiprocessorCount, dev);
    hipOccupancyMaxActiveBlocksPerMultiprocessor(&per_cu, fwd_mega, NTHREADS, 0);
    if (per_cu > 2) per_cu = 2;
    grid_blocks = cus * per_cu;
    if (grid_blocks <= 0) { fprintf(stderr, "kernel_launch: occupancy query gave %d x %d\n", cus, per_cu); grid_blocks = -1; }
  }
  if (grid_blocks < 0) return;
  (void)hipMemsetAsync(p.bar, 0, (size_t)XCD_BAR_WORDS * 4, stream);
  void* args[] = {&p};
  hipError_t e = hipLaunchCooperativeKernel((void*)fwd_mega, dim3(grid_blocks), dim3(NTHREADS), args, 0, stream);
  if (e != hipSuccess) fprintf(stderr, "cooperative launch failed: %s (grid %d)\n", hipGetErrorString(e), grid_blocks);
}
```

```cpp
#include <hip/hip_runtime.h>
#include <hip/hip_cooperative_groups.h>
#include <stdint.h>
#include <stdio.h>

namespace cg = cooperative_groups;
namespace {

typedef __attribute__((ext_vector_type(8))) short bf16x8;
typedef __attribute__((ext_vector_type(4))) float f32x4;
typedef unsigned short bf16_t;

constexpr int D = 2048, NB = 4, L = 2048, T = NB * L, CTX = 256, TC = NB * CTX;
constexpr int NMOD = 6 * D;
constexpr int NH = 16, HP = 64, NS = 128, DXBC = 1536;
constexpr int DIN = 3616;
constexpr int NPROJ = 4736;
constexpr int KSPLIT = 32;
constexpr float EPS = 1e-6f;
constexpr int NTHREADS = 256;

__device__ __forceinline__ bf16_t f2bf(float f) { __bf16 h = (__bf16)f; return __builtin_bit_cast(unsigned short, h); }
__device__ __forceinline__ float bf2f(bf16_t h) { return __uint_as_float(((uint32_t)h) << 16); }
__device__ __forceinline__ uint32_t pack2(float a, float b) {
  typedef __attribute__((ext_vector_type(2))) __bf16 bf16x2_t;
  typedef __attribute__((ext_vector_type(2))) float f32x2_t;
  const f32x2_t v = {a, b};
  return __builtin_bit_cast(uint32_t, __builtin_convertvector(v, bf16x2_t));
}
__device__ __forceinline__ float bflo(uint32_t w) { return __uint_as_float(w << 16); }
__device__ __forceinline__ float bfhi(uint32_t w) { return __uint_as_float(w & 0xffff0000u); }
__device__ __forceinline__ float silu_f(float v) { return v / (1.f + __expf(-v)); }
__device__ __forceinline__ float softplus_f(float v) { return v > 20.f ? v : log1pf(__expf(v)); }

__device__ __forceinline__ int opaque_tid() { int t = threadIdx.x; asm volatile("" : "+v"(t)); return t; }
__device__ __forceinline__ float wave_sum(float v) {
#pragma unroll
  for (int o = 32; o > 0; o >>= 1) v += __shfl_xor(v, o);
  return v;
}
template <int CTRL>
__device__ __forceinline__ float dpp_mov(float v) {
  return __int_as_float(__builtin_amdgcn_update_dpp(0, __float_as_int(v), CTRL, 0xF, 0xF, true));
}
__device__ __forceinline__ float wave_sum_fast(float v) {
  v += dpp_mov<0xB1>(v); v += dpp_mov<0x4E>(v); v += dpp_mov<0x124>(v); v += dpp_mov<0x128>(v);
  v += __shfl_xor(v, 16); v += __shfl_xor(v, 32);
  return v;
}
__device__ __forceinline__ float wave_max(float v) {
#pragma unroll
  for (int o = 32; o > 0; o >>= 1) v = fmaxf(v, __shfl_xor(v, o));
  return v;
}
__device__ __forceinline__ float block_sum(float v, float* red) {
  v = wave_sum(v);
  __syncthreads();
  if ((threadIdx.x & 63) == 0) red[threadIdx.x >> 6] = v;
  __syncthreads();
  return red[0] + red[1] + red[2] + red[3];
}

struct Params {
  const float *x, *c, *ctx, *c_ctx, *w_mod, *b_mod, *g_pre_mix, *g_post_mix, *g_pre_ffn, *g_post_ffn;
  const float *w_in, *w_fmix, *conv_w, *conv_b, *dt_bias_f, *dt_bias_b, *a_log_f, *a_log_b, *d_skip_f, *d_skip_b;
  const float *ssm_norm_w, *w_out, *w_query, *sk1, *sk2, *eu, *ev;
  float* out;
  uint8_t *U8, *V8;
  bf16_t *w_in_t, *w_out_t, *w_q_t, *w_in_f, *WcsT, *dftm, *Fs;
  float *partial, *mod;
  bf16_t *hx, *hc, *ABt, *z;
  float *xbcraw, *xbcraw_c, *dtraw, *dtraw_c, *dtf, *dtb, *dtf_c, *dtb_c;
  bf16_t *act_tm, *act_cm_x, *act_cm_c;
  float *yf, *yb;
  unsigned* ctr; unsigned* bar;
  bf16_t* ycat;
  float *y_x, *q, *gate;
  int* idx;
  int pad0, pad1;
};

__device__ __forceinline__ void gemm_mainloop(const bf16_t* __restrict__ A, int lda, const bf16_t* __restrict__ Bt, int ldb,
                                              int K, int m0, int n0, f32x4 (&acc)[4][4], char* smem) {
  const int tid = opaque_tid(), lane = tid & 63, w = tid >> 6;
  const int wm = w >> 1, wn = w & 1;
#pragma unroll
  for (int i = 0; i < 4; ++i)
#pragma unroll
    for (int j = 0; j < 4; ++j) acc[i][j] = f32x4{0.f, 0.f, 0.f, 0.f};

  const int nk = K / 64;
  const int rowoff = lane >> 3, lch = (lane & 7) ^ rowoff;
  const bf16_t* gA = A + (size_t)(m0 + w * 8 + rowoff) * lda + lch * 8;
  const bf16_t* gB = Bt + (size_t)(n0 + w * 8 + rowoff) * ldb + lch * 8;
#define GSTAGE(buf_, kt_)                                                                                               \
  do {                                                                                                                  \
    _Pragma("unroll") for (int i_ = 0; i_ < 4; ++i_) {                                                                  \
      __builtin_amdgcn_global_load_lds((const unsigned*)(gA + (size_t)(i_ * 32) * lda + (kt_) * 64),                    \
                                       (unsigned*)(smem + (buf_) * 32768 + (i_ * 4 + w) * 1024), 16, 0, 0);             \
      __builtin_amdgcn_global_load_lds((const unsigned*)(gB + (size_t)(i_ * 32) * ldb + (kt_) * 64),                    \
                                       (unsigned*)(smem + (buf_) * 32768 + 16384 + (i_ * 4 + w) * 1024), 16, 0, 0);     \
    }                                                                                                                   \
  } while (0)
  GSTAGE(0, 0);
  asm volatile("s_waitcnt vmcnt(0)" ::: "memory");
  __syncthreads();
  for (int kt = 0; kt < nk; ++kt) {
    const int cur = kt & 1;
    if (kt + 1 < nk) GSTAGE(cur ^ 1, kt + 1);
    const char* sA = smem + cur * 32768;
    const char* sB = sA + 16384;
#pragma unroll
    for (int kk = 0; kk < 2; ++kk) {
      bf16x8 af[4], bfr[4];
      const int ch = kk * 4 + (lane >> 4);
#pragma unroll
      for (int i = 0; i < 4; ++i) {
        int row = wm * 64 + i * 16 + (lane & 15);
        af[i] = *reinterpret_cast<const bf16x8*>(sA + row * 128 + ((ch ^ (row & 7)) << 4));
        int col = wn * 64 + i * 16 + (lane & 15);
        bfr[i] = *reinterpret_cast<const bf16x8*>(sB + col * 128 + ((ch ^ (col & 7)) << 4));
      }
#pragma unroll
      for (int i = 0; i < 4; ++i)
#pragma unroll
        for (int j = 0; j < 4; ++j) acc[i][j] = __builtin_amdgcn_mfma_f32_16x16x32_bf16(af[i], bfr[j], acc[i][j], 0, 0, 0);
    }
    asm volatile("s_waitcnt vmcnt(0)" ::: "memory");
    __syncthreads();
  }
#undef GSTAGE
}

template <class Epi>
__device__ __forceinline__ void gemm_tile(const bf16_t* __restrict__ A, int lda, const bf16_t* __restrict__ Bt, int ldb,
                                          int K, int m0, int n0, const Epi& epi, char* smem) {
  const int lane = threadIdx.x & 63, w = threadIdx.x >> 6;
  const int wm = w >> 1, wn = w & 1;
  f32x4 acc[4][4];
  gemm_mainloop(A, lda, Bt, ldb, K, m0, n0, acc, smem);
#pragma unroll
  for (int i = 0; i < 4; ++i)
#pragma unroll
    for (int j = 0; j < 4; ++j) {
      int row = m0 + wm * 64 + i * 16 + (lane >> 4) * 4;
      int col = n0 + wn * 64 + j * 16 + (lane & 15);
      epi(row, col, acc[i][j]);
    }
}

__device__ __forceinline__ void gemm_mainloop_n256(const bf16_t* __restrict__ A, int lda, const bf16_t* __restrict__ Bt, int ldb,
                                                   int K, int m0, int n0, f32x4 (&acc)[4][8], char* smem) {
  const int tid = opaque_tid(), lane = tid & 63, w = tid >> 6;
  const int wm = w >> 1, wn = w & 1;
#pragma unroll
  for (int i = 0; i < 4; ++i)
#pragma unroll
    for (int j = 0; j < 8; ++j) acc[i][j] = f32x4{0.f, 0.f, 0.f, 0.f};
  const int nk = K / 64;
  const int rowoff = lane >> 3, lch = (lane & 7) ^ rowoff;
  const bf16_t* gA = A + (size_t)(m0 + w * 8 + rowoff) * lda + lch * 8;
  const bf16_t* gB = Bt + (size_t)(n0 + w * 8 + rowoff) * ldb + lch * 8;
  const int fr = lane & 15, fq = lane >> 4;
  for (int kt = 0; kt < nk; ++kt) {
#pragma unroll
    for (int i_ = 0; i_ < 4; ++i_)
      __builtin_amdgcn_global_load_lds((const unsigned*)(gA + (size_t)(i_ * 32) * lda + kt * 64),
                                       (unsigned*)(smem + (i_ * 4 + w) * 1024), 16, 0, 0);
#pragma unroll
    for (int i_ = 0; i_ < 8; ++i_)
      __builtin_amdgcn_global_load_lds((const unsigned*)(gB + (size_t)(i_ * 32) * ldb + kt * 64),
                                       (unsigned*)(smem + 16384 + (i_ * 4 + w) * 1024), 16, 0, 0);
    asm volatile("s_waitcnt vmcnt(0)" ::: "memory");
    __syncthreads();
    const char* sA = smem;
    const char* sB = smem + 16384;
#pragma unroll
    for (int kk = 0; kk < 2; ++kk) {
      bf16x8 af[4], bfr[8];
      const int ch = kk * 4 + fq;
#pragma unroll
      for (int i = 0; i < 4; ++i) {
        const int row = wm * 64 + i * 16 + fr;
        af[i] = *reinterpret_cast<const bf16x8*>(sA + row * 128 + ((ch ^ (row & 7)) << 4));
      }
#pragma unroll
      for (int j = 0; j < 8; ++j) {
        const int col = wn * 128 + j * 16 + fr;
        bfr[j] = *reinterpret_cast<const bf16x8*>(sB + col * 128 + ((ch ^ (col & 7)) << 4));
      }
#pragma unroll
      for (int i = 0; i < 4; ++i)
#pragma unroll
        for (int j = 0; j < 8; ++j) acc[i][j] = __builtin_amdgcn_mfma_f32_16x16x32_bf16(af[i], bfr[j], acc[i][j], 0, 0, 0);
    }
    __syncthreads();
  }
}
template <class Epi>
__device__ __forceinline__ void gemm_tile_n256(const bf16_t* __restrict__ A, int lda, const bf16_t* __restrict__ Bt, int ldb,
                                               int K, int m0, int n0, const Epi& epi, char* smem) {
  const int lane = threadIdx.x & 63, w = threadIdx.x >> 6;
  const int wm = w >> 1, wn = w & 1;
  f32x4 acc[4][8];
  gemm_mainloop_n256(A, lda, Bt, ldb, K, m0, n0, acc, smem);
#pragma unroll
  for (int i = 0; i < 4; ++i)
#pragma unroll
    for (int j = 0; j < 8; ++j) {
      int row = m0 + wm * 64 + i * 16 + (lane >> 4) * 4;
      int col = n0 + wn * 128 + j * 16 + (lane & 15);
      epi(row, col, acc[i][j]);
    }
}

struct EpiF32 {
  float* C; int ldc;
  __device__ __forceinline__ void operator()(int row, int col, f32x4 v) const {
#pragma unroll
    for (int r = 0; r < 4; ++r) C[(size_t)(row + r) * ldc + col] = v[r];
  }
};
struct EpiBf16 {
  bf16_t* C; int ldc;
  __device__ __forceinline__ void operator()(int row, int col, f32x4 v) const {
#pragma unroll
    for (int r = 0; r < 4; ++r) C[(size_t)(row + r) * ldc + col] = f2bf(v[r]);
  }
};
struct EpiBf16T {
  bf16_t* Ct; int ldc;
  __device__ __forceinline__ void operator()(int row, int col, f32x4 v) const {
    uint2 pk; pk.x = pack2(v[0], v[1]); pk.y = pack2(v[2], v[3]);
    *reinterpret_cast<uint2*>(Ct + (size_t)col * ldc + row) = pk;
  }
};
struct EpiInAB {
  bf16_t* ABt; int seqlen;
  __device__ __forceinline__ void operator()(int row, int col, f32x4 v) const {
    const int ch = col & 1023, half = col >> 10;
    const int b = row / seqlen, l = row - b * seqlen;
    uint2 pk; pk.x = pack2(v[0], v[1]); pk.y = pack2(v[2], v[3]);
    *reinterpret_cast<uint2*>(ABt + ((size_t)(b * 1024 + ch) * 4096 + half * 2048 + l)) = pk;
  }
};
struct EpiInZ {
  bf16_t* z;
  __device__ __forceinline__ void operator()(int row, int col, f32x4 v) const {
#pragma unroll
    for (int r = 0; r < 4; ++r) z[(size_t)(row + r) * 1024 + (col - 2048)] = f2bf(v[r]);
  }
};
struct EpiInXbc {
  float* xbcraw;
  __device__ __forceinline__ void operator()(int row, int col, f32x4 v) const {
#pragma unroll
    for (int r = 0; r < 4; ++r) xbcraw[(size_t)(row + r) * DXBC + (col - 3072)] = v[r];
  }
};
struct EpiInProj {
  bf16_t* ABt; bf16_t* z; float* xbcraw; float* dtraw; int seqlen;
  __device__ __forceinline__ void operator()(int row, int col, f32x4 v) const {
    if (col < 2048) {
      int ch = col & 1023, half = col >> 10;
      int b = row / seqlen, l = row - b * seqlen;
      uint2 pk; pk.x = pack2(v[0], v[1]); pk.y = pack2(v[2], v[3]);
      *reinterpret_cast<uint2*>(ABt + ((size_t)(b * 1024 + ch) * 4096 + half * 2048 + l)) = pk;
    } else if (col < 3072) {
#pragma unroll
      for (int r = 0; r < 4; ++r) z[(size_t)(row + r) * 1024 + (col - 2048)] = f2bf(v[r]);
    } else if (col < 4608) {
#pragma unroll
      for (int r = 0; r < 4; ++r) xbcraw[(size_t)(row + r) * DXBC + (col - 3072)] = v[r];
    } else if (col < 4640) {
#pragma unroll
      for (int r = 0; r < 4; ++r) dtraw[(size_t)(row + r) * 32 + (col - 4608)] = v[r];
    }
  }
};

__device__ void adaln_partial_task(const Params& p, int task, float* sm) {
  const int cb = task % 48, ks = task / 48, tid = threadIdx.x;
  float* sc = sm;
  __syncthreads();
  for (int i = tid; i < 5 * 64; i += NTHREADS) {
    int r = i >> 6, kk = i & 63;
    int k = ks * 64 + kk;
    float cv = (r < 4) ? p.c[r * D + k] : p.c_ctx[k];
    sc[i] = silu_f(cv);
  }
  __syncthreads();
  const int col = cb * 256 + tid;
  float a0 = 0, a1 = 0, a2 = 0, a3 = 0, a4 = 0;
  const float* wp = p.w_mod + (size_t)(ks * 64) * NMOD + col;
#pragma unroll
  for (int h2 = 0; h2 < 2; ++h2) {
    float wv[32];
#pragma unroll
    for (int kk = 0; kk < 32; ++kk) wv[kk] = __builtin_nontemporal_load(wp + (size_t)(h2 * 32 + kk) * NMOD);
#pragma unroll
    for (int kk = 0; kk < 32; ++kk) {
      const int k = h2 * 32 + kk;
      a0 += sc[k] * wv[kk]; a1 += sc[64 + k] * wv[kk]; a2 += sc[128 + k] * wv[kk]; a3 += sc[192 + k] * wv[kk]; a4 += sc[256 + k] * wv[kk];
    }
  }
  float* pp = p.partial + (size_t)ks * 5 * NMOD + col;
  pp[0] = a0; pp[NMOD] = a1; pp[2 * NMOD] = a2; pp[3 * NMOD] = a3; pp[4 * NMOD] = a4;
}

__device__ void transpose_convert_task(const float* __restrict__ src, int ld, int c0, int rows, bf16_t* __restrict__ dst,
                                       int tr, int tc, float* sm) {
  float (*tile)[65] = reinterpret_cast<float (*)[65]>(sm);
  const int tid = threadIdx.x;
  __syncthreads();
  for (int i = tid; i < 64 * 64; i += NTHREADS) {
    int r = i >> 6, cc = i & 63;
    tile[r][cc] = src[(size_t)(tr * 64 + r) * ld + c0 + tc * 64 + cc];
  }
  __syncthreads();
  for (int i = tid; i < 64 * 32; i += NTHREADS) {
    int cc = i >> 5, r2 = (i & 31) * 2;
    uint32_t pk = pack2(tile[r2][cc], tile[r2 + 1][cc]);
    *reinterpret_cast<uint32_t*>(dst + (size_t)(tc * 64 + cc) * rows + tr * 64 + r2) = pk;
  }
}

__device__ void phase_prep(const Params& p, int bid, int nb, char* smem) {
  float* sm = reinterpret_cast<float*>(smem);
  const int tid = threadIdx.x;
  if (bid == 0 && tid < 64) p.ctr[tid] = 0u;
  {
    float* t256 = reinterpret_cast<float*>(smem + 20480);
    float* t2048 = reinterpret_cast<float*>(smem + 24576);
    t256[tid] = cospif((float)tid * (1.0f / 128.f));
    for (int i = tid; i < 2048; i += NTHREADS) t2048[i] = cospif((float)i * (1.0f / 1024.f));
    __syncthreads();
  }
  for (int t = bid; t < 48 * KSPLIT; t += nb) adaln_partial_task(p, t, sm);
  {
    const int nct = 41, nrt = 32;
    for (int t = bid; t < nct * nrt; t += nb) {
      int tc = t % nct, tr = t / nct;
      if (tc < 40) transpose_convert_task(p.w_in, DIN, 1024, D, p.w_in_t + (size_t)2048 * D, tr, tc, sm);
      else {
        float (*tile)[65] = reinterpret_cast<float (*)[65]>(sm);
        __syncthreads();
        for (int i = tid; i < 64 * 32; i += NTHREADS) {
          int r = i >> 5, cc = i & 31;
          tile[r][cc] = p.w_in[(size_t)(tr * 64 + r) * DIN + 1024 + 2560 + cc];
        }
        __syncthreads();
        for (int i = tid; i < 32 * 32; i += NTHREADS) {
          int cc = i >> 5, r2 = (i & 31) * 2;
          uint32_t pk = pack2(tile[r2][cc], tile[r2 + 1][cc]);
          *reinterpret_cast<uint32_t*>(p.w_in_t + (size_t)(2048 + 2560 + cc) * D + tr * 64 + r2) = pk;
        }
      }
    }
    for (size_t i = (size_t)bid * NTHREADS + tid; i < (size_t)96 * D / 8; i += (size_t)nb * NTHREADS)
      reinterpret_cast<uint4*>(p.w_in_t + (size_t)4640 * D)[i] = uint4{0, 0, 0, 0};
  }
  for (size_t i = (size_t)bid * NTHREADS + tid; i < (size_t)D * 1024 / 4; i += (size_t)nb * NTHREADS) {
    int k = (int)(i / 256), c4 = (int)(i % 256) * 4;
    float4 v = *reinterpret_cast<const float4*>(p.w_in + (size_t)k * DIN + c4);
    uint2 o; o.x = pack2(v.x, v.y); o.y = pack2(v.z, v.w);
    *reinterpret_cast<uint2*>(p.w_in_f + (size_t)k * 1024 + c4) = o;
  }
  {
    const float* t256 = reinterpret_cast<const float*>(smem + 20480);
    const float scale = 1.0f / sqrtf((float)L * 256.f);
    for (int i = bid * NTHREADS + tid; i < 4 * 256 * 256; i += nb * NTHREADS) {
      int d = i & 255, c = (i >> 8) & 255, g = i >> 16;
      float sc_ = 0.f, ss_ = 0.f;
      const float* wp = p.w_fmix + (size_t)g * 65536 + d;
#pragma unroll 8
      for (int m = 0; m < 256; ++m) {
        const int ph = (m * c) & 255;
        const float wv = wp[m * 256];
        sc_ += t256[ph] * wv; ss_ += t256[(ph - 64) & 255] * wv;
      }
      p.WcsT[((size_t)g * 512 + d) * 256 + c] = f2bf(sc_ * scale);
      p.WcsT[((size_t)g * 512 + 256 + d) * 256 + c] = f2bf(ss_ * scale);
    }
  }
  {
    const float* t2048 = reinterpret_cast<const float*>(smem + 24576);
    for (size_t i = (size_t)bid * NTHREADS + tid; i < (size_t)1024 * 2048 / 8; i += (size_t)nb * NTHREADS) {
      const int k = (int)(i / 256), j = (int)(i % 256) * 8;
      const bool iss = j >= 1024;
      float o[8];
#pragma unroll
      for (int e = 0; e < 8; ++e) {
        const int l = (j + e) & 1023;
        const int ph = (k * l) & 2047;
        o[e] = iss ? t2048[(ph - 512) & 2047] : t2048[ph];
      }
      uint4 pk; pk.x = pack2(o[0], o[1]); pk.y = pack2(o[2], o[3]); pk.z = pack2(o[4], o[5]); pk.w = pack2(o[6], o[7]);
      *reinterpret_cast<uint4*>(p.dftm + (size_t)k * 2048 + j) = pk;
    }
  }
}

__device__ void phase_fold(const Params& p, int bid, int nb, char* smem) {
  const int tid = threadIdx.x;
  for (int i = bid * NTHREADS + tid; i < 5 * NMOD; i += nb * NTHREADS) {
    int col = i % NMOD;
    float s = p.b_mod[col];
    for (int ks = 0; ks < KSPLIT; ++ks) s += p.partial[(size_t)ks * 5 * NMOD + i];
    p.mod[i] = s;
  }
  for (int t = bid; t < 256; t += nb) {
    int g = t >> 6, tm = (t & 63) >> 2, tn = t & 3;
    int n0 = tn * 128;
    int rowbase = (n0 < 256) ? (g * 256 + n0) : (1024 + g * 256 + (n0 - 256));
    EpiBf16T epi{p.w_in_t + (size_t)(rowbase - n0) * D, D};
    gemm_tile(p.w_in_f + g * 256, 1024, p.WcsT + (size_t)g * 512 * 256, 256, 256, tm * 128, n0, epi, smem);
  }
}

__device__ void phase_norm_mod(const Params& p, int bid, int nb, char* smem) {
  const int lane = threadIdx.x & 63, w = threadIdx.x >> 6;
  for (int t = bid * 4 + w; t < T + TC; t += nb * 4) {
    const bool isx = t < T;
    const float* src = isx ? (p.x + (size_t)t * D) : (p.ctx + (size_t)(t - T) * D);
    const int mrow = isx ? (t / L) : 4;
    bf16_t* dst = isx ? (p.hx + (size_t)t * D) : (p.hc + (size_t)(t - T) * D);
    float4 v[8];
    float ss = 0.f;
#pragma unroll
    for (int c = 0; c < 8; ++c) {
      v[c] = *reinterpret_cast<const float4*>(src + c * 256 + lane * 4);
      ss += v[c].x * v[c].x + v[c].y * v[c].y + v[c].z * v[c].z + v[c].w * v[c].w;
    }
    ss = wave_sum_fast(ss);
    const float rstd = rsqrtf(ss * (1.f / D) + EPS);
    const float* sh = p.mod + (size_t)mrow * NMOD + 0 * D;
    const float* sc = p.mod + (size_t)mrow * NMOD + 1 * D;
#pragma unroll
    for (int c = 0; c < 8; ++c) {
      const int e0 = c * 256 + lane * 4;
      const float4 g = *reinterpret_cast<const float4*>(p.g_pre_mix + e0);
      const float4 s4 = *reinterpret_cast<const float4*>(sc + e0), h4 = *reinterpret_cast<const float4*>(sh + e0);
      uint2 pk;
      pk.x = pack2(v[c].x * rstd * g.x * (1.f + s4.x) + h4.x, v[c].y * rstd * g.y * (1.f + s4.y) + h4.y);
      pk.y = pack2(v[c].z * rstd * g.z * (1.f + s4.z) + h4.z, v[c].w * rstd * g.w * (1.f + s4.w) + h4.w);
      *reinterpret_cast<uint2*>(dst + e0) = pk;
    }
  }
}

__device__ __forceinline__ void convert_uv_units(const Params& p, size_t u0, size_t u1) {
  const size_t n16 = (size_t)16384 * D / 16;
  for (size_t i = u0 + threadIdx.x; i < u1; i += NTHREADS) {
    const float* s = (i < n16) ? p.eu : p.ev;
    uint8_t* d = (i < n16) ? p.U8 : p.V8;
    const size_t j = (i < n16) ? i : i - n16;
    uint32_t o[4];
#pragma unroll
    for (int q4 = 0; q4 < 4; ++q4) {
      const float4 v = *reinterpret_cast<const float4*>(s + j * 16 + q4 * 4);
      int pk = 0;
      pk = __builtin_amdgcn_cvt_pk_fp8_f32(v.x * 512.f, v.y * 512.f, pk, false);
      pk = __builtin_amdgcn_cvt_pk_fp8_f32(v.z * 512.f, v.w * 512.f, pk, true);
      o[q4] = (uint32_t)pk;
    }
    *reinterpret_cast<uint4*>(d + j * 16) = uint4{o[0], o[1], o[2], o[3]};
  }
}
__device__ void phase_inproj(const Params& p, int bid, int nb, char* smem) {
  if ((nb & 7) == 0) {
    const int x = bid & 7, rank = bid >> 3, per = nb >> 3;
    for (int s_ = rank; s_ < 128 + 53; s_ += per) {
      if (s_ < 128) {
        const int tn2 = s_ >> 3, m0_ = (8 * x + (s_ & 7)) * 128;
        if (tn2 < 8) { EpiInAB epi{p.ABt, L}; gemm_tile_n256(p.hx, D, p.w_in_t, D, D, m0_, tn2 * 256, epi, smem); }
        else if (tn2 < 12) { EpiInZ epi{p.z}; gemm_tile_n256(p.hx, D, p.w_in_t, D, D, m0_, tn2 * 256, epi, smem); }
        else { EpiInXbc epi{p.xbcraw}; gemm_tile_n256(p.hx, D, p.w_in_t, D, D, m0_, tn2 * 256, epi, smem); }
      } else if (s_ < 128 + 40) {
        const int i = s_ - 128;
        EpiInProj epi{p.ABt, p.z, p.xbcraw, p.dtraw, L};
        gemm_tile(p.hx, D, p.w_in_t, D, D, (8 * x + (i & 7)) * 128, (32 + (i >> 3)) * 128, epi, smem);
      } else {
        const int u = x * 13 + (s_ - 168);
        EpiInProj epi{nullptr, nullptr, p.xbcraw_c, p.dtraw_c, CTX};
        gemm_tile(p.hc, D, p.w_in_t, D, D, (u / 13) * 128, 3072 + (u % 13) * 128, epi, smem);
      }
    }
    return;
  }
  const int ntx = 64 * 37, ntc = 8 * 13;
  for (int t = bid; t < ntx + ntc; t += nb) {
    if (t < ntx) {
      int tm = t / 37, tn = t % 37;
      EpiInProj epi{p.ABt, p.z, p.xbcraw, p.dtraw, L};
      gemm_tile(p.hx, D, p.w_in_t, D, D, tm * 128, tn * 128, epi, smem);
    } else {
      int u = t - ntx;
      int tm = u / 13, tn = u % 13;
      EpiInProj epi{nullptr, nullptr, p.xbcraw_c, p.dtraw_c, CTX};
      gemm_tile(p.hc, D, p.w_in_t, D, D, tm * 128, 3072 + tn * 128, epi, smem);
    }
  }
}

__device__ void ssm_pre_tile(const Params& p, int task, char* smem) {
  const bool isx = task < 3072;
  const int u = isx ? task : task - 3072;
  const int ntt = isx ? 32 : 4;
  const int ct = u % 24, tt = (u / 24) % ntt, b = u / (24 * ntt);
  const int seqlen = isx ? L : CTX;
  const float* raw = (isx ? p.xbcraw : p.xbcraw_c) + (size_t)b * seqlen * DXBC;
  const int l0 = tt * 64, c0 = ct * 64, tid = threadIdx.x;
  float (*rt)[68] = reinterpret_cast<float (*)[68]>(smem);
  float (*at)[65] = reinterpret_cast<float (*)[65]>(smem + 66 * 68 * 4);
  __syncthreads();
  {
    float4 v[5];
#pragma unroll
    for (int k = 0; k < 5; ++k) {
      const int i = tid + k * NTHREADS, r = i >> 4, c4 = i & 15, l = l0 - 1 + r;
      v[k] = (i < 66 * 16 && l >= 0 && l < seqlen) ? *reinterpret_cast<const float4*>(raw + (size_t)l * DXBC + c0 + c4 * 4) : float4{0.f, 0.f, 0.f, 0.f};
    }
#pragma unroll
    for (int k = 0; k < 5; ++k) {
      const int i = tid + k * NTHREADS, r = i >> 4, c4 = i & 15;
      if (i < 66 * 16) *reinterpret_cast<float4*>(&rt[r][c4 * 4]) = v[k];
    }
  }
  __syncthreads();
  {
    const int cc = tid & 63, c = c0 + cc;
    const float w0 = p.conv_w[c], w1 = p.conv_w[DXBC + c], w2 = p.conv_w[2 * DXBC + c], cb = p.conv_b[c];
#pragma unroll 4
    for (int r = tid >> 6; r < 64; r += 4) at[r][cc] = silu_f(cb + rt[r][cc] * w0 + rt[r + 1][cc] * w1 + rt[r + 2][cc] * w2);
  }
  __syncthreads();
  const size_t trow0 = isx ? ((size_t)b * L + l0) : ((size_t)T + (size_t)b * CTX + l0);
#pragma unroll
  for (int k = 0; k < 4; ++k) {
    const int i = tid + k * NTHREADS, r = i >> 4, c4 = (i & 15) * 4;
    uint2 o; o.x = pack2(at[r][c4], at[r][c4 + 1]); o.y = pack2(at[r][c4 + 2], at[r][c4 + 3]);
    *reinterpret_cast<uint2*>(p.act_tm + (trow0 + r) * DXBC + c0 + c4) = o;
  }
  if (c0 < 1280) {
    bf16_t* cm = (isx ? p.act_cm_x : p.act_cm_c) + (size_t)b * 1280 * seqlen;
#pragma unroll
    for (int k = 0; k < 4; ++k) {
      const int i = tid + k * NTHREADS, cc = i >> 4, r4 = (i & 15) * 4;
      uint2 o; o.x = pack2(at[r4][cc], at[r4 + 1][cc]); o.y = pack2(at[r4 + 2][cc], at[r4 + 3][cc]);
      *reinterpret_cast<uint2*>(cm + (size_t)(c0 + cc) * seqlen + l0 + r4) = o;
    }
  }
}
__device__ void dft_fold_rows(const Params& p, int bid, int nb, char* smem) {
  const int lane = threadIdx.x & 63, w = threadIdx.x >> 6;
  bf16_t* sr = reinterpret_cast<bf16_t*>(smem + w * 8192);
  for (int row = bid * 4 + w; row < NB * 1024; row += nb * 4) {
    const bf16_t* A = p.ABt + (size_t)row * 4096;
    bf16_t* F = p.Fs + (size_t)row * 2048;
    __builtin_amdgcn_wave_barrier();
    {
      const uint4 q0 = *reinterpret_cast<const uint4*>(A + (0 * 64 + lane) * 8), q1 = *reinterpret_cast<const uint4*>(A + (1 * 64 + lane) * 8);
      const uint4 q2 = *reinterpret_cast<const uint4*>(A + (2 * 64 + lane) * 8), q3 = *reinterpret_cast<const uint4*>(A + (3 * 64 + lane) * 8);
      const uint4 q4 = *reinterpret_cast<const uint4*>(A + (4 * 64 + lane) * 8), q5 = *reinterpret_cast<const uint4*>(A + (5 * 64 + lane) * 8);
      const uint4 q6 = *reinterpret_cast<const uint4*>(A + (6 * 64 + lane) * 8), q7 = *reinterpret_cast<const uint4*>(A + (7 * 64 + lane) * 8);
      *reinterpret_cast<uint4*>(sr + (0 * 64 + lane) * 8) = q0; *reinterpret_cast<uint4*>(sr + (1 * 64 + lane) * 8) = q1;
      *reinterpret_cast<uint4*>(sr + (2 * 64 + lane) * 8) = q2; *reinterpret_cast<uint4*>(sr + (3 * 64 + lane) * 8) = q3;
      *reinterpret_cast<uint4*>(sr + (4 * 64 + lane) * 8) = q4; *reinterpret_cast<uint4*>(sr + (5 * 64 + lane) * 8) = q5;
      *reinterpret_cast<uint4*>(sr + (6 * 64 + lane) * 8) = q6; *reinterpret_cast<uint4*>(sr + (7 * 64 + lane) * 8) = q7;
    }
    __builtin_amdgcn_wave_barrier();
    const int l0 = lane * 16;
    float alt = 0.f;
    uint32_t oa[8], ob[8];
#pragma unroll
    for (int half = 0; half < 2; ++half) {
      const bf16_t* base = sr + half * 2048;
      const uint4 fa = *reinterpret_cast<const uint4*>(base + l0), fb = *reinterpret_cast<const uint4*>(base + l0 + 8);
      const uint4 ra = *reinterpret_cast<const uint4*>(base + 2032 - l0), rb = *reinterpret_cast<const uint4*>(base + 2040 - l0);
      const float r16 = (lane > 0) ? bf2f(base[2048 - l0]) : 0.f;
      const uint32_t fw[8] = {fa.x, fa.y, fa.z, fa.w, fb.x, fb.y, fb.z, fb.w};
      const uint32_t rw[8] = {ra.x, ra.y, ra.z, ra.w, rb.x, rb.y, rb.z, rb.w};
      float v[16];
#pragma unroll
      for (int i = 0; i < 16; ++i) {
        const float fwv = (i & 1) ? bfhi(fw[i >> 1]) : bflo(fw[i >> 1]);
        const int j = 16 - i;
        const float rv = (i == 0) ? r16 : ((j & 1) ? bfhi(rw[j >> 1]) : bflo(rw[j >> 1]));
        if (half == 0) v[i] = (lane == 0 && i == 0) ? fwv : fwv + rv;
        else v[i] = (lane == 0 && i == 0) ? 0.f : fwv - rv;
      }
      if (half == 0) {
#pragma unroll
        for (int i = 0; i < 16; ++i) alt += (i & 1) ? -v[i] : v[i];
#pragma unroll
        for (int i = 0; i < 8; ++i) oa[i] = pack2(v[2 * i], v[2 * i + 1]);
      } else {
#pragma unroll
        for (int i = 0; i < 8; ++i) ob[i] = pack2(v[2 * i], v[2 * i + 1]);
      }
    }
    *reinterpret_cast<uint4*>(F + l0) = uint4{oa[0], oa[1], oa[2], oa[3]};
    *reinterpret_cast<uint4*>(F + l0 + 8) = uint4{oa[4], oa[5], oa[6], oa[7]};
    *reinterpret_cast<uint4*>(F + 1024 + l0) = uint4{ob[0], ob[1], ob[2], ob[3]};
    *reinterpret_cast<uint4*>(F + 1024 + l0 + 8) = uint4{ob[4], ob[5], ob[6], ob[7]};
    alt = wave_sum_fast(alt) + bf2f(sr[1024]);
    if (lane == 0) { const int b = row >> 10, ch = row & 1023; p.ycat[((size_t)b * L + 1024) * D + ch] = f2bf(alt); }
  }
}
__device__ void phase_ssm_pre(const Params& p, int bid, int nb, char* smem) {
  const int tid = threadIdx.x;
  dft_fold_rows(p, bid, nb, smem);
  for (int t = bid; t < 3072 + 384; t += nb) ssm_pre_tile(p, t, smem);
  for (int i = bid * NTHREADS + tid; i < (T + TC) * 32; i += nb * NTHREADS) {
    const bool isx = i < T * 32;
    const int ii = isx ? i : i - T * 32;
    const int t = ii >> 5, j = ii & 31;
    const float v = (isx ? p.dtraw : p.dtraw_c)[ii];
    float* df = isx ? p.dtf : p.dtf_c;
    float* db = isx ? p.dtb : p.dtb_c;
    if (j < 16) df[t * 16 + j] = softplus_f(v + p.dt_bias_f[j]);
    else db[t * 16 + (j - 16)] = softplus_f(v + p.dt_bias_b[j - 16]);
  }
}

__device__ __forceinline__ int swz16(int row, int chunk) { return row * 256 + ((chunk ^ (row & 15)) << 4); }
__device__ __forceinline__ int swz8(int row, int chunk) { return row * 128 + ((chunk ^ (row & 7)) << 4); }

#define LDS_BARRIER() asm volatile("s_waitcnt lgkmcnt(0)\n\ts_barrier" ::: "memory")
__device__ void ssd_task(const Params& p, int task, char* smem) {
  const int dir = task & 1, ph = (task >> 1) & 1, h = (task >> 2) & 15, b = task >> 6;
  const int tid = opaque_tid(), lane = tid & 63, w = tid >> 6;
  const int g = h >> 3, lr0 = lane & 15, lq0 = lane >> 4;
  const float a = -__expf(dir ? p.a_log_b[h] : p.a_log_f[h]);
  char* sCc = smem; char* sBc = smem + 16384; char* sBT = smem + 32768; char* sXT = smem + 49152; char* sHb = smem + 57344;
  float* se = reinterpret_cast<float*>(smem + 73728);
  float* sdt = se + 64; float* sw = se + 128; float* sy = se + 192; float* stot = se + 256;
  float* yo = dir ? p.yb : p.yf;
  f32x4 H[2][2];
#pragma unroll
  for (int i = 0; i < 2; ++i)
#pragma unroll
    for (int j = 0; j < 2; ++j) H[i][j] = f32x4{0.f, 0.f, 0.f, 0.f};
  __syncthreads();
  for (int i = tid; i < 512; i += NTHREADS) reinterpret_cast<uint4*>(sHb)[i] = uint4{0, 0, 0, 0};

  const int crow = tid >> 4, cch = tid & 15;
  const int trow = tid >> 3, tch = tid & 7;
  uint4 rC0, rC1, rC2, rC3, rB0, rB1, rB2, rB3, rT0, rT1, rT2, rT3, rX;
  rC0 = rC1 = rC2 = rC3 = rB0 = rB1 = rB2 = rB3 = uint4{0, 0, 0, 0};
  float rdt = 0.f;
#define SSD_PARAMS(st_)                                                                                                   \
  const bool isctx_ = (st_) < 4;                                                                                          \
  const int nch_ = isctx_ ? 4 : 32, ci_ = isctx_ ? (st_) : (st_) - 4;                                                     \
  const int c_ = dir ? (nch_ - 1 - ci_) : ci_;                                                                            \
  const int seqlen_ = isctx_ ? CTX : L;                                                                                   \
  const size_t trow0_ = isctx_ ? ((size_t)T + (size_t)b * CTX + c_ * 64) : ((size_t)b * L + c_ * 64);                     \
  const size_t drow0_ = (size_t)b * seqlen_ + c_ * 64;                                                                    \
  const float* dtp_ = isctx_ ? (dir ? p.dtb_c : p.dtf_c) : (dir ? p.dtb : p.dtf);                                         \
  const bf16_t* cm_ = (isctx_ ? p.act_cm_c : p.act_cm_x) + (size_t)b * 1280 * seqlen_ + c_ * 64;
#define SSD_PREFETCH(st_)                                                                                                 \
  do {                                                                                                                    \
    SSD_PARAMS(st_)                                                                                                       \
    if (w == 0) rdt = dtp_[(drow0_ + lane) * 16 + h];                                                                     \
    if (!isctx_) {                                                                                                        \
      const bf16_t* src = p.act_tm + (trow0_ + crow) * DXBC + g * 128 + cch * 8;                                          \
      rC0 = *reinterpret_cast<const uint4*>(src + 1280);             rB0 = *reinterpret_cast<const uint4*>(src + 1024);   \
      rC1 = *reinterpret_cast<const uint4*>(src + 16 * DXBC + 1280); rB1 = *reinterpret_cast<const uint4*>(src + 16 * DXBC + 1024); \
      rC2 = *reinterpret_cast<const uint4*>(src + 32 * DXBC + 1280); rB2 = *reinterpret_cast<const uint4*>(src + 32 * DXBC + 1024); \
      rC3 = *reinterpret_cast<const uint4*>(src + 48 * DXBC + 1280); rB3 = *reinterpret_cast<const uint4*>(src + 48 * DXBC + 1024); \
    }                                                                                                                     \
    const bf16_t* srt = cm_ + (size_t)(1024 + g * 128 + trow) * seqlen_ + tch * 8;                                        \
    rT0 = *reinterpret_cast<const uint4*>(srt);                                                                           \
    rT1 = *reinterpret_cast<const uint4*>(srt + (size_t)32 * seqlen_);                                                    \
    rT2 = *reinterpret_cast<const uint4*>(srt + (size_t)64 * seqlen_);                                                    \
    rT3 = *reinterpret_cast<const uint4*>(srt + (size_t)96 * seqlen_);                                                    \
    rX = *reinterpret_cast<const uint4*>(cm_ + (size_t)(h * 64 + ph * 32 + trow) * seqlen_ + tch * 8);                    \
  } while (0)

  for (int step = 0; step < 36; ++step) {
    SSD_PREFETCH(step);
    const bool isctx = step < 4;
    const int c = dir ? ((isctx ? 4 : 32) - 1 - (isctx ? step : step - 4)) : (isctx ? step : step - 4);
    const size_t trow0 = (size_t)b * L + c * 64;
    int lr = lr0, lq = lq0;
    asm volatile("" : "+v"(lr), "+v"(lq));
    LDS_BARRIER();
    if (w == 0) {
      const float dtv = rdt;
      float v = a * dtv;
      if (!dir) {
#pragma unroll
        for (int o = 1; o < 64; o <<= 1) { float n = __shfl_up(v, o); v += (lane >= o) ? n : 0.f; }
      } else {
#pragma unroll
        for (int o = 1; o < 64; o <<= 1) { float n = __shfl_down(v, o); v += (lane + o < 64) ? n : 0.f; }
      }
      const float etot = __shfl(v, dir ? 0 : 63);
      se[lane] = v; sdt[lane] = dtv; sw[lane] = dtv * __expf(etot - v); sy[lane] = __expf(v);
      if (lane == 0) stot[0] = etot;
    }
    if (!isctx) {
      const int oc = swz16(crow, cch);
      *reinterpret_cast<uint4*>(sCc + oc) = rC0;         *reinterpret_cast<uint4*>(sBc + oc) = rB0;
      *reinterpret_cast<uint4*>(sCc + oc + 4096) = rC1;  *reinterpret_cast<uint4*>(sBc + oc + 4096) = rB1;
      *reinterpret_cast<uint4*>(sCc + oc + 8192) = rC2;  *reinterpret_cast<uint4*>(sBc + oc + 8192) = rB2;
      *reinterpret_cast<uint4*>(sCc + oc + 12288) = rC3; *reinterpret_cast<uint4*>(sBc + oc + 12288) = rB3;
    }
    {
      const int ot = swz8(trow, tch);
      *reinterpret_cast<uint4*>(sBT + ot) = rT0;
      *reinterpret_cast<uint4*>(sBT + ot + 4096) = rT1;
      *reinterpret_cast<uint4*>(sBT + ot + 8192) = rT2;
      *reinterpret_cast<uint4*>(sBT + ot + 12288) = rT3;
      *reinterpret_cast<uint4*>(sXT + ot) = rX;
    }
    LDS_BARRIER();
    const float etot = stot[0];
    if (!isctx) {
      f32x4 G[4];
      bf16x8 ca[4];
#pragma unroll
      for (int j = 0; j < 4; ++j) G[j] = f32x4{0.f, 0.f, 0.f, 0.f};
#pragma unroll
      for (int kk = 0; kk < 4; ++kk) ca[kk] = *reinterpret_cast<const bf16x8*>(sCc + swz16(16 * w + lr, kk * 4 + lq));
#pragma unroll
      for (int kk = 0; kk < 4; ++kk)
#pragma unroll
        for (int j = 0; j < 4; ++j) {
          bf16x8 bb = *reinterpret_cast<const bf16x8*>(sBc + swz16(16 * j + lr, kk * 4 + lq));
          G[j] = __builtin_amdgcn_mfma_f32_16x16x32_bf16(ca[kk], bb, G[j], 0, 0, 0);
        }
      LDS_BARRIER();
      float el[4];
#pragma unroll
      for (int r = 0; r < 4; ++r) el[r] = se[16 * w + lq * 4 + r];
#pragma unroll
      for (int j = 0; j < 4; ++j) {
        const int s_ = 16 * j + lr;
        const float es = se[s_], ds = sdt[s_];
#pragma unroll
        for (int r = 0; r < 4; ++r) {
          const int l = 16 * w + lq * 4 + r;
          const bool keep = dir ? (s_ >= l) : (s_ <= l);
          const float m = keep ? G[j][r] * __expf(el[r] - es) * ds : 0.f;
          *reinterpret_cast<bf16_t*>(sBc + swz8(l, s_ >> 3) + (s_ & 7) * 2) = f2bf(m);
        }
      }
      LDS_BARRIER();
      f32x4 Y[2], Yo[2];
#pragma unroll
      for (int j = 0; j < 2; ++j) { Y[j] = f32x4{0.f, 0.f, 0.f, 0.f}; Yo[j] = f32x4{0.f, 0.f, 0.f, 0.f}; }
#pragma unroll
      for (int kk = 0; kk < 2; ++kk) {
        bf16x8 ma = *reinterpret_cast<const bf16x8*>(sBc + swz8(16 * w + lr, kk * 4 + lq));
#pragma unroll
        for (int j = 0; j < 2; ++j) {
          bf16x8 xb = *reinterpret_cast<const bf16x8*>(sXT + swz8(16 * j + lr, kk * 4 + lq));
          Y[j] = __builtin_amdgcn_mfma_f32_16x16x32_bf16(ma, xb, Y[j], 0, 0, 0);
        }
      }
#pragma unroll
      for (int kk = 0; kk < 4; ++kk)
#pragma unroll
        for (int j = 0; j < 2; ++j) {
          bf16x8 hb = *reinterpret_cast<const bf16x8*>(sHb + swz16(16 * j + lr, kk * 4 + lq));
          Yo[j] = __builtin_amdgcn_mfma_f32_16x16x32_bf16(ca[kk], hb, Yo[j], 0, 0, 0);
        }
      float syl[4];
#pragma unroll
      for (int r = 0; r < 4; ++r) syl[r] = sy[16 * w + lq * 4 + r];
#pragma unroll
      for (int j = 0; j < 2; ++j)
#pragma unroll
        for (int r = 0; r < 4; ++r) {
          const int l = 16 * w + lq * 4 + r;
          yo[(trow0 + l) * 1024 + h * 64 + ph * 32 + 16 * j + lr] = Y[j][r] + syl[r] * Yo[j][r];
        }
    }
    {
      const float dec = __expf(etot);
#pragma unroll
      for (int i = 0; i < 2; ++i)
#pragma unroll
        for (int j = 0; j < 2; ++j) H[i][j] *= dec;
#pragma unroll
      for (int kk = 0; kk < 2; ++kk) {
        const int s0 = kk * 32 + lq * 8;
        const float4 w0 = *reinterpret_cast<const float4*>(sw + s0), w1 = *reinterpret_cast<const float4*>(sw + s0 + 4);
        bf16x8 xs[2];
#pragma unroll
        for (int i = 0; i < 2; ++i) {
          const bf16x8 xa = *reinterpret_cast<const bf16x8*>(sXT + swz8(16 * i + lr, kk * 4 + lq));
          xs[i][0] = (short)f2bf(bf2f((bf16_t)xa[0]) * w0.x); xs[i][1] = (short)f2bf(bf2f((bf16_t)xa[1]) * w0.y);
          xs[i][2] = (short)f2bf(bf2f((bf16_t)xa[2]) * w0.z); xs[i][3] = (short)f2bf(bf2f((bf16_t)xa[3]) * w0.w);
          xs[i][4] = (short)f2bf(bf2f((bf16_t)xa[4]) * w1.x); xs[i][5] = (short)f2bf(bf2f((bf16_t)xa[5]) * w1.y);
          xs[i][6] = (short)f2bf(bf2f((bf16_t)xa[6]) * w1.z); xs[i][7] = (short)f2bf(bf2f((bf16_t)xa[7]) * w1.w);
        }
#pragma unroll
        for (int j = 0; j < 2; ++j) {
          const bf16x8 bt = *reinterpret_cast<const bf16x8*>(sBT + swz8(16 * (2 * w + j) + lr, kk * 4 + lq));
#pragma unroll
          for (int i = 0; i < 2; ++i) H[i][j] = __builtin_amdgcn_mfma_f32_16x16x32_bf16(xs[i], bt, H[i][j], 0, 0, 0);
        }
      }
    }
    LDS_BARRIER();
#pragma unroll
    for (int i = 0; i < 2; ++i)
#pragma unroll
      for (int j = 0; j < 2; ++j) {
        const int n = 16 * (2 * w + j) + lr;
#pragma unroll
        for (int r = 0; r < 4; ++r) {
          const int pr = 16 * i + lq * 4 + r;
          *reinterpret_cast<bf16_t*>(sHb + swz16(pr, n >> 3) + (n & 7) * 2) = f2bf(H[i][j][r]);
        }
      }
  }
#undef SSD_PREFETCH
#undef SSD_PARAMS
}

#undef LDS_BARRIER
__device__ void phase_ssd_dft(const Params& p, int bid, int nb, char* smem) {
  for (int t = bid; t < 256; t += nb) ssd_task(p, t, smem);
  int* stile = reinterpret_cast<int*>(smem + 75776);
  for (;;) {
    __syncthreads();
    if (threadIdx.x == 0) *stile = (int)atomicAdd(p.ctr, 1u);
    __syncthreads();
    const int t = *stile;
    if (t >= 4 * 8 * 8) break;
    const int b = t >> 6, tm = (t & 63) >> 3, tn = t & 7;
    const bf16_t* Fb = p.Fs + (size_t)b * 1024 * 2048;
    f32x4 accC[4][4], accS[4][4];
    gemm_mainloop(p.dftm, 2048, Fb, 2048, 1024, tm * 128, tn * 128, accC, smem);
    gemm_mainloop(p.dftm + 1024, 2048, Fb + 1024, 2048, 1024, tm * 128, tn * 128, accS, smem);
    const int lane = threadIdx.x & 63, w = threadIdx.x >> 6, wm = w >> 1, wn = w & 1;
#pragma unroll
    for (int i = 0; i < 4; ++i) {
      int lq_ = lane >> 4, lr_ = lane & 15;
      asm volatile("" : "+v"(lq_), "+v"(lr_));
#pragma unroll
      for (int j = 0; j < 4; ++j) {
        const int k0 = tm * 128 + wm * 64 + i * 16 + lq_ * 4;
        const int ch = tn * 128 + wn * 64 + j * 16 + lr_;
        const float a = bf2f(p.ABt[((size_t)b * 1024 + ch) * 4096 + 1024]);
#pragma unroll
        for (int r = 0; r < 4; ++r) {
          const int k = k0 + r;
          const float as = (k & 1) ? -a : a;
          const float c = accC[i][j][r], sn = accS[i][j][r];
          p.ycat[((size_t)b * L + k) * D + ch] = f2bf(c - sn + as);
          if (k > 0) p.ycat[((size_t)b * L + (L - k)) * D + ch] = f2bf(c + sn + as);
        }
      }
    }
  }
  for (;;) {
    __syncthreads();
    if (threadIdx.x == 0) *stile = (int)atomicAdd(p.ctr + 8, 1u);
    __syncthreads();
    const int q = *stile;
    if (q >= 1024 + 1536) break;
    if (q < 1024) convert_uv_units(p, (size_t)q * 4096, (size_t)(q + 1) * 4096);
    else if (q < 1024 + 1024) { const int q1 = q - 1024; transpose_convert_task(p.w_out, D, 0, D, p.w_out_t, q1 / 32, q1 % 32, reinterpret_cast<float*>(smem)); }
    else { const int q2 = q - 2048; transpose_convert_task(p.w_query, 1024, 0, D, p.w_q_t, q2 / 16, q2 % 16, reinterpret_cast<float*>(smem)); }
  }
}

__device__ void phase_ssm_post(const Params& p, int bid, int nb, char* smem) {
  const int lane = threadIdx.x & 63, w = threadIdx.x >> 6;
  for (int t = bid * 4 + w; t < T; t += nb * 4) {
    float y[4][4];
    float ss0 = 0.f, ss1 = 0.f;
#pragma unroll
    for (int c = 0; c < 4; ++c) {
      const int c0 = c * 256 + lane * 4;
      const int h = c0 >> 6;
      const float dsk = p.d_skip_f[h] + p.d_skip_b[h];
      const float4 a = *reinterpret_cast<const float4*>(p.yf + (size_t)t * 1024 + c0);
      const float4 bq = *reinterpret_cast<const float4*>(p.yb + (size_t)t * 1024 + c0);
      const uint2 xq = *reinterpret_cast<const uint2*>(p.act_tm + (size_t)t * DXBC + c0);
      const uint2 zz = *reinterpret_cast<const uint2*>(p.z + (size_t)t * 1024 + c0);
      y[c][0] = (a.x + bq.x + dsk * bflo(xq.x)) * silu_f(bflo(zz.x));
      y[c][1] = (a.y + bq.y + dsk * bfhi(xq.x)) * silu_f(bfhi(zz.x));
      y[c][2] = (a.z + bq.z + dsk * bflo(xq.y)) * silu_f(bflo(zz.y));
      y[c][3] = (a.w + bq.w + dsk * bfhi(xq.y)) * silu_f(bfhi(zz.y));
      const float q = y[c][0] * y[c][0] + y[c][1] * y[c][1] + y[c][2] * y[c][2] + y[c][3] * y[c][3];
      if (c < 2) ss0 += q; else ss1 += q;
    }
    ss0 = wave_sum_fast(ss0); ss1 = wave_sum_fast(ss1);
    const float r0 = rsqrtf(ss0 * (1.f / 512.f) + EPS), r1 = rsqrtf(ss1 * (1.f / 512.f) + EPS);
#pragma unroll
    for (int c = 0; c < 4; ++c) {
      const int c0 = c * 256 + lane * 4;
      const float rstd = (c < 2) ? r0 : r1;
      const float4 nw = *reinterpret_cast<const float4*>(p.ssm_norm_w + c0);
      uint2 o; o.x = pack2(y[c][0] * rstd * nw.x, y[c][1] * rstd * nw.y); o.y = pack2(y[c][2] * rstd * nw.z, y[c][3] * rstd * nw.w);
      *reinterpret_cast<uint2*>(p.ycat + (size_t)t * D + 1024 + c0) = o;
    }
  }
}

__device__ void phase_outproj(const Params& p, int bid, int nb, char* smem) {
  if ((nb & 7) == 0) {
    const int x = bid & 7, rank = bid >> 3, per = nb >> 3;
    for (int s_ = rank; s_ < 64; s_ += per) {
      EpiF32 epi{p.y_x, D};
      gemm_tile_n256(p.ycat, D, p.w_out_t, D, D, (8 * x + (s_ & 7)) * 128, (s_ >> 3) * 256, epi, smem);
    }
    return;
  }
  for (int t = bid; t < 64 * 16; t += nb) {
    EpiF32 epi{p.y_x, D};
    gemm_tile(p.ycat, D, p.w_out_t, D, D, (t >> 4) * 128, (t & 15) * 128, epi, smem);
  }
}
__device__ void phase_postmix(const Params& p, int bid, int nb, char* smem) {
  const int lane = threadIdx.x & 63, w = threadIdx.x >> 6;
  for (int t = bid * 4 + w; t < T; t += nb * 4) {
    const int b = t / L;
    float4 y[8];
    float ss = 0.f;
#pragma unroll
    for (int c = 0; c < 8; ++c) {
      y[c] = *reinterpret_cast<const float4*>(p.y_x + (size_t)t * D + c * 256 + lane * 4);
      ss += y[c].x * y[c].x + y[c].y * y[c].y + y[c].z * y[c].z + y[c].w * y[c].w;
    }
    ss = wave_sum_fast(ss);
    const float rstd = rsqrtf(ss * (1.f / D) + EPS);
    const float* gm = p.mod + (size_t)b * NMOD + 2 * D;
    float ss1 = 0.f;
#pragma unroll
    for (int c = 0; c < 8; ++c) {
      const int e0 = c * 256 + lane * 4;
      const float4 xv = *reinterpret_cast<const float4*>(p.x + (size_t)t * D + e0);
      const float4 g4 = *reinterpret_cast<const float4*>(gm + e0), gp = *reinterpret_cast<const float4*>(p.g_post_mix + e0);
      y[c].x = xv.x + g4.x * (y[c].x * rstd * gp.x); y[c].y = xv.y + g4.y * (y[c].y * rstd * gp.y);
      y[c].z = xv.z + g4.z * (y[c].z * rstd * gp.z); y[c].w = xv.w + g4.w * (y[c].w * rstd * gp.w);
      ss1 += y[c].x * y[c].x + y[c].y * y[c].y + y[c].z * y[c].z + y[c].w * y[c].w;
      *reinterpret_cast<float4*>(p.out + (size_t)t * D + e0) = y[c];
    }
    ss1 = wave_sum_fast(ss1);
    const float rstd1 = rsqrtf(ss1 * (1.f / D) + EPS);
    const float* sf = p.mod + (size_t)b * NMOD + 3 * D;
    const float* cf = p.mod + (size_t)b * NMOD + 4 * D;
#pragma unroll
    for (int c = 0; c < 8; ++c) {
      const int e0 = c * 256 + lane * 4;
      const float4 g = *reinterpret_cast<const float4*>(p.g_pre_ffn + e0);
      const float4 s4 = *reinterpret_cast<const float4*>(cf + e0), h4 = *reinterpret_cast<const float4*>(sf + e0);
      uint2 pk;
      pk.x = pack2(y[c].x * rstd1 * g.x * (1.f + s4.x) + h4.x, y[c].y * rstd1 * g.y * (1.f + s4.y) + h4.y);
      pk.y = pack2(y[c].z * rstd1 * g.z * (1.f + s4.z) + h4.z, y[c].w * rstd1 * g.w * (1.f + s4.w) + h4.w);
      *reinterpret_cast<uint2*>(p.hx + (size_t)t * D + e0) = pk;
    }
  }
}

__device__ __forceinline__ uint32_t mono_key(float f) {
  uint32_t u = __float_as_uint(f);
  return (u & 0x80000000u) ? ~u : (u | 0x80000000u);
}
__device__ __forceinline__ void ins16(uint32_t (&Lk)[16], uint32_t x) {
#pragma unroll
  for (int i = 0; i < 16; ++i) { uint32_t hi = max(Lk[i], x); x = min(Lk[i], x); Lk[i] = hi; }
}
__device__ __forceinline__ float unmono_key(uint32_t k) {
  return __uint_as_float((k & 0x80000000u) ? (k ^ 0x80000000u) : ~k);
}
typedef __attribute__((ext_vector_type(16))) float f32x16;
__device__ void phase_q_route(const Params& p, int bid, int nb, char* smem) {
  const int tid = opaque_tid(), lane = tid & 63, w = tid >> 6;
  const int wm = w >> 1, wn = w & 1, lr = lane & 15, lq = lane >> 4;
  const int l31 = lane & 31, lh = lane >> 5;
  for (int tile0 = bid; tile0 < 512; tile0 += nb) {
    const int tile = ((nb & 7) == 0 && nb >= 512) ? (((tile0 & 7) * 8 + ((tile0 >> 3) & 7)) * 8 + (tile0 >> 6)) : tile0;
    const int h = tile & 7, m0 = (tile >> 3) * 128;
    {
      f32x4 acc[4][4];
      gemm_mainloop(p.hx, D, p.w_q_t, D, D, m0, h * 128, acc, smem);
#pragma unroll
      for (int i = 0; i < 4; ++i)
#pragma unroll
        for (int j = 0; j < 4; ++j)
#pragma unroll
          for (int r = 0; r < 4; ++r) {
            const int row = wm * 64 + i * 16 + lq * 4 + r, col = wn * 64 + j * 16 + lr;
            *reinterpret_cast<bf16_t*>(smem + swz16(row, col >> 3) + (col & 7) * 2) = f2bf(acc[i][j][r]);
          }
    }
#pragma unroll 4
    for (int r = 0; r < 16; ++r) {
      const int id = tid + 256 * r, row = id >> 4, c4 = id & 15;
      const float* src = ((row < 128) ? p.sk1 : p.sk2) + ((size_t)(h * 128 + (row & 127)) * 64 + c4 * 4);
      const float4 v = *reinterpret_cast<const float4*>(src);
      uint2 pk; pk.x = pack2(v.x, v.y); pk.y = pack2(v.z, v.w);
      *reinterpret_cast<uint2*>(smem + 32768 + swz8(row, c4 >> 1) + (c4 & 1) * 8) = pk;
    }
    __syncthreads();
    uint32_t L1[16], L2[16];
#pragma unroll
    for (int sd = 0; sd < 2; ++sd) {
      uint32_t Lk[16];
#pragma unroll
      for (int i = 0; i < 16; ++i) Lk[i] = 0u;
      const uint32_t kb = (uint32_t)(lh * 4);
#pragma unroll
      for (int ih = 0; ih < 2; ++ih) {
        f32x16 Sa[2];
#pragma unroll
        for (int i = 0; i < 2; ++i)
#pragma unroll
          for (int g2 = 0; g2 < 16; ++g2) Sa[i][g2] = 0.f;
#pragma unroll
        for (int ks = 0; ks < 4; ++ks) {
          const bf16x8 qb = *reinterpret_cast<const bf16x8*>(smem + swz16(w * 32 + l31, sd * 8 + ks * 2 + lh));
#pragma unroll
          for (int i = 0; i < 2; ++i) {
            const bf16x8 ka = *reinterpret_cast<const bf16x8*>(smem + 32768 + swz8(sd * 128 + (ih * 2 + i) * 32 + l31, ks * 2 + lh));
            Sa[i] = __builtin_amdgcn_mfma_f32_32x32x16_bf16(ka, qb, Sa[i], 0, 0, 0);
          }
        }
#pragma unroll
        for (int i = 0; i < 2; ++i)
#pragma unroll
          for (int g2 = 0; g2 < 16; ++g2)
            ins16(Lk, (mono_key(Sa[i][g2]) & ~0x7Fu) | (uint32_t)((ih * 2 + i) * 32 + (g2 & 3) + 8 * (g2 >> 2)) | kb);
      }
#pragma unroll
      for (int i = 0; i < 8; ++i) {
        const uint32_t t1 = (uint32_t)__shfl_xor((int)Lk[15 - i], 32), t2 = (uint32_t)__shfl_xor((int)Lk[i], 32);
        Lk[i] = max(Lk[i], t1); Lk[15 - i] = max(Lk[15 - i], t2);
      }
#pragma unroll
      for (int dd = 8; dd >= 1; dd >>= 1)
#pragma unroll
        for (int i = 0; i < 16; ++i)
          if ((i & dd) == 0) { const uint32_t hi = max(Lk[i], Lk[i + dd]), lo = min(Lk[i], Lk[i + dd]); Lk[i] = hi; Lk[i + dd] = lo; }
#pragma unroll
      for (int r = 0; r < 16; ++r) { if (sd == 0) L1[r] = Lk[r]; else L2[r] = Lk[r]; }
    }
    __syncthreads();
    uint32_t* ib = reinterpret_cast<uint32_t*>(smem) + w * 1088 + l31 * 34;
    if (lh == 0) {
#pragma unroll
      for (int r = 0; r < 16; ++r) { ib[r] = L1[r] & 127u; ib[16 + r] = L2[r] & 127u; }
    }
    float v1[16], v2[16];
#pragma unroll
    for (int r = 0; r < 16; ++r) { v1[r] = unmono_key(L1[r] & ~0x7Fu); v2[r] = unmono_key(L2[r] & ~0x7Fu); }
    uint32_t C[16];
#pragma unroll
    for (int i = 0; i < 16; ++i) C[i] = 0u;
#pragma unroll
    for (int a = 0; a < 16; ++a)
#pragma unroll
      for (int bq = 0; bq < 16; ++bq)
        if ((a + 1) * (bq + 1) <= 16) ins16(C, (mono_key(v1[a] + v2[bq]) & ~0xFFu) | (uint32_t)(a * 16 + bq));
    float ts[16]; int te[16];
    __builtin_amdgcn_wave_barrier();
#pragma unroll
    for (int r = 0; r < 16; ++r) {
      const uint32_t code = C[r] & 0xFFu;
      te[r] = (int)(ib[code >> 4] * 128u + ib[16 + (code & 15u)]);
      ts[r] = unmono_key(C[r] & ~0xFFu);
    }
    const float mx = ts[0];
    float den = 0.f;
#pragma unroll
    for (int r = 0; r < 16; ++r) { ts[r] = __expf(ts[r] - mx); den += ts[r]; }
    const float inv = 1.f / den;
    const size_t ob = (size_t)(m0 + w * 32 + l31) * 128 + h * 16;
    if (lh == 0) {
#pragma unroll
      for (int r = 0; r < 16; r += 4) *reinterpret_cast<int4*>(p.idx + ob + r) = int4{te[r], te[r + 1], te[r + 2], te[r + 3]};
    } else {
#pragma unroll
      for (int r = 0; r < 16; r += 4)
        *reinterpret_cast<float4*>(p.gate + ob + r) = float4{ts[r] * inv, ts[r + 1] * inv, ts[r + 2] * inv, ts[r + 3] * inv};
    }
    __syncthreads();
  }
}

typedef __attribute__((ext_vector_type(2))) float f32x2;
__device__ __forceinline__ void fp8x16_to_f32(const uint4 q, f32x2 (&o)[8]) {
  o[0] = __builtin_amdgcn_cvt_pk_f32_fp8((int)q.x, false); o[1] = __builtin_amdgcn_cvt_pk_f32_fp8((int)q.x, true);
  o[2] = __builtin_amdgcn_cvt_pk_f32_fp8((int)q.y, false); o[3] = __builtin_amdgcn_cvt_pk_f32_fp8((int)q.y, true);
  o[4] = __builtin_amdgcn_cvt_pk_f32_fp8((int)q.z, false); o[5] = __builtin_amdgcn_cvt_pk_f32_fp8((int)q.z, true);
  o[6] = __builtin_amdgcn_cvt_pk_f32_fp8((int)q.w, false); o[7] = __builtin_amdgcn_cvt_pk_f32_fp8((int)q.w, true);
}
__device__ __forceinline__ unsigned my_xcc_id() { return (unsigned)__builtin_amdgcn_s_getreg((3 << 11) | 20) & 7u; }

__device__ void phase_exp_u(const Params& p, char* smem) {
  const int tid = opaque_tid(), lane = tid & 63, w = tid >> 6;
  const int sub = lane >> 4, cc = lane & 15;
  const unsigned myx = my_xcc_id();
  int* sh = reinterpret_cast<int*>(smem);
  int* si = reinterpret_cast<int*>(smem + 64) + w * 256;
  float* pbuf = reinterpret_cast<float*>(p.ycat);
  {
    unsigned qcur = 0;
    for (;;) {
      __syncthreads();
      if (tid == 0) {
        int found = -1; unsigned fx = 0;
        for (; qcur < 8; ++qcur) {
          fx = (myx + qcur) & 7u;
          const int c = (int)atomicAdd(&p.ctr[16 + fx], 1u);
          if (c < 256) { found = c; break; }
        }
        sh[0] = found; sh[1] = (int)fx;
      }
      __syncthreads();
      const int chunk = sh[0];
      const unsigned x = (unsigned)sh[1];
      if (chunk < 0) break;
      for (int tt = 0; tt < 8; ++tt) {
        const int t = chunk * 32 + w * 8 + tt;
        __builtin_amdgcn_wave_barrier();
        si[lane] = p.idx[(size_t)t * 128 + lane]; si[64 + lane] = p.idx[(size_t)t * 128 + 64 + lane];
        __builtin_amdgcn_wave_barrier();
        f32x2 hf[8];
#pragma unroll
        for (int q2 = 0; q2 < 2; ++q2) {
          const uint4 hq = *reinterpret_cast<const uint4*>(p.hx + (size_t)t * D + x * 256 + cc * 16 + q2 * 8);
          hf[q2 * 4 + 0] = f32x2{bflo(hq.x), bfhi(hq.x)}; hf[q2 * 4 + 1] = f32x2{bflo(hq.y), bfhi(hq.y)};
          hf[q2 * 4 + 2] = f32x2{bflo(hq.z), bfhi(hq.z)}; hf[q2 * 4 + 3] = f32x2{bflo(hq.w), bfhi(hq.w)};
        }
        const uint8_t* ub = p.U8 + x * 256 + cc * 16;
        uint4 qa[8], qb[8];
#define EU_LOAD(q_, bt_) _Pragma("unroll") for (int k = 0; k < 8; ++k) q_[k] = *reinterpret_cast<const uint4*>(ub + (size_t)si[((bt_) * 8 + k) * 4 + sub] * D)
#define EU_COMP(q_, kb_)                                                                                                \
  _Pragma("unroll") for (int k = 0; k < 8; ++k) {                                                                       \
    f32x2 uf[8];                                                                                                        \
    fp8x16_to_f32(q_[k], uf);                                                                                           \
    f32x2 d2 = hf[0] * uf[0];                                                                                           \
    _Pragma("unroll") for (int e = 1; e < 8; ++e) d2 += hf[e] * uf[e];                                                  \
    float d = d2.x + d2.y;                                                                                              \
    d += dpp_mov<0xB1>(d); d += dpp_mov<0x4E>(d); d += dpp_mov<0x124>(d); d += dpp_mov<0x128>(d);                       \
    mine = (cc == (kb_) + k) ? d : mine;                                                                                \
  }
        float mine = 0.f;
        EU_LOAD(qa, 0); EU_LOAD(qb, 1);
        EU_COMP(qa, 0); EU_LOAD(qa, 2);
        EU_COMP(qb, 8); EU_LOAD(qb, 3);
        pbuf[((size_t)x * T + t) * 128 + cc * 4 + sub] = mine * (1.f / 512.f);
        mine = 0.f;
        EU_COMP(qa, 0);
        EU_COMP(qb, 8);
        pbuf[((size_t)x * T + t) * 128 + (16 + cc) * 4 + sub] = mine * (1.f / 512.f);
#undef EU_LOAD
#undef EU_COMP
      }
    }
  }
}

__device__ void phase_exp_v(const Params& p, char* smem) {
  const int tid = opaque_tid(), lane = tid & 63, w = tid >> 6;
  const int sub = lane >> 4, cc = lane & 15;
  const unsigned myx = my_xcc_id();
  int* sh = reinterpret_cast<int*>(smem);
  int* si = reinterpret_cast<int*>(smem + 64) + w * 256;
  float* sc = reinterpret_cast<float*>(si + 128);
  float* yf = p.y_x;
  {
    unsigned qcur = 0;
    for (;;) {
      __syncthreads();
      if (tid == 0) {
        int found = -1; unsigned fx = 0;
        for (; qcur < 8; ++qcur) {
          fx = (myx + qcur) & 7u;
          const int c = (int)atomicAdd(&p.ctr[32 + fx], 1u);
          if (c < 256) { found = c; break; }
        }
        sh[0] = found; sh[1] = (int)fx;
      }
      __syncthreads();
      const int chunk = sh[0];
      const unsigned x = (unsigned)sh[1];
      if (chunk < 0) break;
      for (int tt = 0; tt < 8; ++tt) {
        const int t = chunk * 32 + w * 8 + tt;
        __builtin_amdgcn_wave_barrier();
        si[lane] = p.idx[(size_t)t * 128 + lane]; si[64 + lane] = p.idx[(size_t)t * 128 + 64 + lane];
        {
          const float* pb = reinterpret_cast<const float*>(p.ycat) + (size_t)t * 128;
          float d0 = 0.f, d1 = 0.f;
#pragma unroll
          for (int xs = 0; xs < 8; ++xs) { d0 += pb[(size_t)xs * T * 128 + lane]; d1 += pb[(size_t)xs * T * 128 + 64 + lane]; }
          sc[lane] = p.gate[(size_t)t * 128 + lane] * 0.5f * d0 * (1.f + erff(d0 * 0.70710678118654752f));
          sc[64 + lane] = p.gate[(size_t)t * 128 + 64 + lane] * 0.5f * d1 * (1.f + erff(d1 * 0.70710678118654752f));
        }
        __builtin_amdgcn_wave_barrier();
        f32x2 acc[8];
#pragma unroll
        for (int e = 0; e < 8; ++e) acc[e] = f32x2{0.f, 0.f};
        const uint8_t* vb = p.V8 + x * 256 + cc * 16;
        uint4 qa[8], qb[8];
#define EV_LOAD(q_, bt_) _Pragma("unroll") for (int k = 0; k < 8; ++k) q_[k] = *reinterpret_cast<const uint4*>(vb + (size_t)si[((bt_) * 8 + k) * 4 + sub] * D)
#define EV_COMP(q_, bt_)                                                                                                \
  _Pragma("unroll") for (int k = 0; k < 8; ++k) {                                                                       \
    f32x2 vf[8];                                                                                                        \
    fp8x16_to_f32(q_[k], vf);                                                                                           \
    const float cfk = sc[((bt_) * 8 + k) * 4 + sub];                                                                    \
    const f32x2 c2 = f32x2{cfk, cfk};                                                                                   \
    _Pragma("unroll") for (int e = 0; e < 8; ++e) acc[e] += c2 * vf[e];                                                 \
  }
        EV_LOAD(qa, 0); EV_LOAD(qb, 1);
        EV_COMP(qa, 0); EV_LOAD(qa, 2);
        EV_COMP(qb, 1); EV_LOAD(qb, 3);
        EV_COMP(qa, 2);
        EV_COMP(qb, 3);
#undef EV_LOAD
#undef EV_COMP
        {
          float* red = reinterpret_cast<float*>(smem + 8192) + w * 1280;
          float* mr = red + (sub * 16 + cc) * 20;
#pragma unroll
          for (int q4 = 0; q4 < 4; ++q4)
            *reinterpret_cast<float4*>(mr + q4 * 4) = float4{acc[q4 * 2].x, acc[q4 * 2].y, acc[q4 * 2 + 1].x, acc[q4 * 2 + 1].y};
          __builtin_amdgcn_wave_barrier();
          const int part = sub;
          float4 r0 = *reinterpret_cast<const float4*>(red + (0 * 16 + cc) * 20 + part * 4);
          float4 r1 = *reinterpret_cast<const float4*>(red + (1 * 16 + cc) * 20 + part * 4);
          float4 r2 = *reinterpret_cast<const float4*>(red + (2 * 16 + cc) * 20 + part * 4);
          float4 r3 = *reinterpret_cast<const float4*>(red + (3 * 16 + cc) * 20 + part * 4);
          const float sc512 = 1.f / 512.f;
          float4 o4 = float4{(r0.x + r1.x + r2.x + r3.x) * sc512, (r0.y + r1.y + r2.y + r3.y) * sc512,
                             (r0.z + r1.z + r2.z + r3.z) * sc512, (r0.w + r1.w + r2.w + r3.w) * sc512};
          *reinterpret_cast<float4*>(yf + (size_t)t * D + x * 256 + cc * 16 + part * 4) = o4;
          __builtin_amdgcn_wave_barrier();
        }
      }
    }
  }
}

__device__ void phase_exp_final(const Params& p, int bid, int nb, char* smem) {
  const int lane = threadIdx.x & 63, w = threadIdx.x >> 6;
  const float* yf = p.y_x;
  for (int t = bid * 4 + w; t < T; t += nb * 4) {
    const int b = t / L;
    float4 y[8];
    float ss = 0.f;
#pragma unroll
    for (int c = 0; c < 8; ++c) {
      y[c] = *reinterpret_cast<const float4*>(yf + (size_t)t * D + c * 256 + lane * 4);
      ss += y[c].x * y[c].x + y[c].y * y[c].y + y[c].z * y[c].z + y[c].w * y[c].w;
    }
    ss = wave_sum_fast(ss);
    const float rstd = rsqrtf(ss * (1.f / D) + EPS);
    const float* gfx = p.mod + (size_t)b * NMOD + 5 * D;
#pragma unroll
    for (int c = 0; c < 8; ++c) {
      const int e0 = c * 256 + lane * 4;
      float* o = p.out + (size_t)t * D + e0;
      float4 xo = *reinterpret_cast<const float4*>(o);
      const float4 g4 = *reinterpret_cast<const float4*>(gfx + e0), gp = *reinterpret_cast<const float4*>(p.g_post_ffn + e0);
      xo.x += g4.x * (y[c].x * rstd * gp.x); xo.y += g4.y * (y[c].y * rstd * gp.y);
      xo.z += g4.z * (y[c].z * rstd * gp.z); xo.w += g4.w * (y[c].w * rstd * gp.w);
      *reinterpret_cast<float4*>(o) = xo;
    }
  }
}

#define XB_TMO      128
#define XB_XCNT(j)  (256  + 64 * (j))
#define XB_XSUB(j)  (1280 + 64 * (j))
#define XB_XGEN(j)  (2304 + 64 * (j))
#define XB_TOP      3328
#define XB_TOPGEN   3392
#define XCD_BAR_WORDS 3456
#define XB_SPIN_CAP (1u << 22)
#define LAS __attribute__((address_space(3)))
__device__ __forceinline__ unsigned xb_ld(unsigned* p)              { return __hip_atomic_load(p, __ATOMIC_RELAXED, __HIP_MEMORY_SCOPE_AGENT); }
__device__ __forceinline__ unsigned xb_add(unsigned* p, unsigned v) { return __hip_atomic_fetch_add(p, v, __ATOMIC_RELAXED, __HIP_MEMORY_SCOPE_AGENT); }
__device__ __forceinline__ unsigned xb_xcc_id() { return (unsigned)__builtin_amdgcn_s_getreg((3 << 11) | 20) & 0xFu; }
#define XB_SPIN(cond, bar) do { unsigned _sp = 0; while (cond) { __builtin_amdgcn_s_sleep(1); \
    if ((++_sp & 255u) == 0u) { if (xb_ld(&(bar)[XB_TMO])) break; if (_sp > XB_SPIN_CAP) { atomicAdd(&(bar)[XB_TMO], 1u); break; } } } } while (0)
struct XcdBarrier { unsigned* bar; unsigned x; volatile LAS unsigned* st; };
__device__ __forceinline__ XcdBarrier xcd_barrier_post(unsigned* bar, volatile LAS unsigned* st) {
  XcdBarrier b; b.bar = bar; b.x = xb_xcc_id(); b.st = st;
  if (threadIdx.x == 0) (void)xb_add(&bar[XB_XCNT(b.x)], 1u);
  return b;
}
__device__ __forceinline__ void xcd_barrier_complete(unsigned* bar, unsigned x, unsigned& nloc, unsigned& nx) {
  const unsigned G = gridDim.x * gridDim.y * gridDim.z;
  unsigned sum, cnt, mine, sp = 0u;
  for (;;) {
    sum = 0u; cnt = 0u; mine = 0u;
#pragma unroll
    for (unsigned j = 0; j < 16; ++j) { const unsigned c = xb_ld(&bar[XB_XCNT(j)]); sum += c; cnt += (c > 0u) ? 1u : 0u; mine = (j == x) ? c : mine; }
    if (sum == G) break;
    __builtin_amdgcn_s_sleep(1);
    if ((++sp & 255u) == 0u) { if (xb_ld(&bar[XB_TMO])) break; if (sp > XB_SPIN_CAP) { atomicAdd(&bar[XB_TMO], 1u); break; } }
  }
  nloc = mine > 0u ? mine : 1u; nx = cnt > 0u ? cnt : 1u;
}
__device__ __forceinline__ void xcd_barrier(const XcdBarrier& b) {
  asm volatile("s_waitcnt vmcnt(0)" ::: "memory");
  __syncthreads();
  if (threadIdx.x == 0) {
    unsigned* bar = b.bar;
    __builtin_amdgcn_s_waitcnt(0);
    unsigned nloc = b.st[0], nx = b.st[1];
    if (nloc == 0u) { xcd_barrier_complete(bar, b.x, nloc, nx); b.st[0] = nloc; b.st[1] = nx; }
    const unsigned old = xb_add(&bar[XB_XSUB(b.x)], 1u);
    const unsigned gen = old / nloc;
    if (old + 1u == (gen + 1u) * nloc) {
      __builtin_amdgcn_fence(__ATOMIC_RELEASE, "agent");
      asm volatile("s_waitcnt vmcnt(0)" ::: "memory");
      const unsigned og = xb_add(&bar[XB_TOP], 1u);
      const unsigned tg = og / nx;
      if (og + 1u == (tg + 1u) * nx) xb_add(&bar[XB_TOPGEN], 1u);
      else XB_SPIN(xb_ld(&bar[XB_TOPGEN]) == tg, bar);
      __builtin_amdgcn_fence(__ATOMIC_ACQUIRE, "agent");
      xb_add(&bar[XB_XGEN(b.x)], 1u);
      asm volatile("s_waitcnt vmcnt(0)" ::: "memory");
    } else {
      XB_SPIN(xb_ld(&bar[XB_XGEN(b.x)]) == gen, bar);
      __builtin_amdgcn_fence(__ATOMIC_ACQUIRE, "agent");
      asm volatile("s_waitcnt vmcnt(0)" ::: "memory");
    }
  }
  __syncthreads();
}

__global__ void __launch_bounds__(NTHREADS, 2) fwd_mega(Params p) {
  __shared__ __attribute__((aligned(16))) char smem[75808];
  const int bid = blockIdx.x, nb = gridDim.x;
  volatile LAS unsigned* st = (volatile LAS unsigned*)(smem + 75792);
  if (threadIdx.x == 0) { st[0] = 0u; st[1] = 0u; }
  __syncthreads();
  const XcdBarrier bar = xcd_barrier_post(p.bar, st);
  phase_prep(p, bid, nb, smem);        xcd_barrier(bar);
  phase_fold(p, bid, nb, smem);        xcd_barrier(bar);
  phase_norm_mod(p, bid, nb, smem);    xcd_barrier(bar);
  phase_inproj(p, bid, nb, smem);      xcd_barrier(bar);
  phase_ssm_pre(p, bid, nb, smem);     xcd_barrier(bar);
  phase_ssd_dft(p, bid, nb, smem);     xcd_barrier(bar);
  phase_ssm_post(p, bid, nb, smem);    xcd_barrier(bar);
  phase_outproj(p, bid, nb, smem);     xcd_barrier(bar);
  phase_postmix(p, bid, nb, smem);     xcd_barrier(bar);
  phase_q_route(p, bid, nb, smem);     xcd_barrier(bar);
  phase_exp_u(p, smem);                xcd_barrier(bar);
  phase_exp_v(p, smem);                xcd_barrier(bar);
  phase_exp_final(p, bid, nb, smem);
}

}

extern "C" void kernel_launch(void* const* d_in, const int* in_sizes, int n_in, void* d_out, int out_size, void* d_ws,
                              size_t ws_size, hipStream_t stream) {
  Params p{};
  const float** fp = reinterpret_cast<const float**>(&p);
  for (int i = 0; i < 27; ++i) fp[i] = (const float*)d_in[i];
  p.out = (float*)d_out;
  char* ws = (char*)d_ws;
  size_t off = 0;
  auto take = [&](size_t bytes) { char* r = ws + off; off += (bytes + 255) & ~(size_t)255; return r; };
  p.U8 = (uint8_t*)take((size_t)16384 * D);
  p.V8 = (uint8_t*)take((size_t)16384 * D);
  p.w_in_t = (bf16_t*)take((size_t)NPROJ * D * 2);
  p.w_out_t = (bf16_t*)take((size_t)D * D * 2);
  p.w_q_t = (bf16_t*)take((size_t)1024 * D * 2);
  p.w_in_f = (bf16_t*)take((size_t)D * 1024 * 2);
  p.WcsT = (bf16_t*)take((size_t)4 * 512 * 256 * 2);
  p.dftm = (bf16_t*)take((size_t)1024 * 2048 * 2);
  p.Fs = (bf16_t*)take((size_t)NB * 1024 * 2048 * 2);
  p.partial = (float*)take((size_t)KSPLIT * 5 * NMOD * 4);
  p.mod = (float*)take((size_t)5 * NMOD * 4);
  p.hx = (bf16_t*)take((size_t)T * D * 2);
  p.hc = (bf16_t*)take((size_t)TC * D * 2);
  p.ABt = (bf16_t*)take((size_t)NB * 1024 * 4096 * 2);
  p.q = (float*)p.ABt;
  p.z = (bf16_t*)take((size_t)T * 1024 * 2);
  char* r1 = take(0);
  p.xbcraw = (float*)take((size_t)T * DXBC * 4);
  p.xbcraw_c = (float*)take((size_t)TC * DXBC * 4);
  p.act_tm = (bf16_t*)take((size_t)(T + TC) * DXBC * 2);
  p.act_cm_x = (bf16_t*)take((size_t)NB * 1280 * L * 2);
  p.act_cm_c = (bf16_t*)take((size_t)NB * 1280 * CTX * 2);
  p.y_x = (float*)r1;
  p.dtraw = (float*)take((size_t)T * 32 * 4);
  p.dtraw_c = (float*)take((size_t)TC * 32 * 4);
  p.dtf = (float*)take((size_t)T * 16 * 4);
  p.dtb = (float*)take((size_t)T * 16 * 4);
  p.dtf_c = (float*)take((size_t)TC * 16 * 4);
  p.dtb_c = (float*)take((size_t)TC * 16 * 4);
  p.yf = (float*)take((size_t)T * 1024 * 4);
  p.yb = (float*)take((size_t)T * 1024 * 4);
  p.ctr = (unsigned*)take(256);
  p.bar = (unsigned*)take((size_t)XCD_BAR_WORDS * 4);
  p.ycat = (bf16_t*)take((size_t)T * D * 2);
  p.idx = (int*)take((size_t)T * 128 * 4);
  p.gate = (float*)take((size_t)T * 128 * 4);
  if (off > ws_size) { fprintf(stderr, "kernel_launch: workspace too small: need %zu have %zu\n", off, ws_size); return; }
  static int grid_blocks = 0;
  if (!grid_blocks) {
    int dev = 0, cus = 0, per_cu = 0;
    hipGetDevice(&dev);
    hipDeviceGetAttribute(&cus, hipDeviceAttributeMultiprocessorCount, dev);
    hipOccupancyMaxActiveBlocksPerMultiprocessor(&per_cu, fwd_mega, NTHREADS, 0);
    if (per_cu > 2) per_cu = 2;
    grid_blocks = cus * per_cu;
    if (grid_blocks <= 0) { fprintf(stderr, "kernel_launch: occupancy query gave %d x %d\n", cus, per_cu); grid_blocks = -1; }
  }
  if (grid_blocks < 0) return;
  (void)hipMemsetAsync(p.bar, 0, (size_t)XCD_BAR_WORDS * 4, stream);
  void* args[] = {&p};
  hipError_t e = hipLaunchCooperativeKernel((void*)fwd_mega, dim3(grid_blocks), dim3(NTHREADS), args, 0, stream);
  if (e != hipSuccess) fprintf(stderr, "cooperative launch failed: %s (grid %d)\n", hipGetErrorString(e), grid_blocks);
}
```

```cpp
#include <hip/hip_runtime.h>
#include <hip/hip_cooperative_groups.h>
#include <stdint.h>
#include <stdio.h>

namespace cg = cooperative_groups;
namespace {

typedef __attribute__((ext_vector_type(8))) short bf16x8;
typedef __attribute__((ext_vector_type(4))) float f32x4;
typedef unsigned short bf16_t;

constexpr int D = 2048, NB = 4, L = 2048, T = NB * L, CTX = 256, TC = NB * CTX;
constexpr int NMOD = 6 * D;
constexpr int NH = 16, HP = 64, NS = 128, DXBC = 1536;
constexpr int DIN = 3616;
constexpr int NPROJ = 4736;
constexpr int KSPLIT = 32;
constexpr float EPS = 1e-6f;
constexpr int NTHREADS = 256;

__device__ __forceinline__ bf16_t f2bf(float f) { __bf16 h = (__bf16)f; return __builtin_bit_cast(unsigned short, h); }
__device__ __forceinline__ float bf2f(bf16_t h) { return __uint_as_float(((uint32_t)h) << 16); }
__device__ __forceinline__ uint32_t pack2(float a, float b) {
  typedef __attribute__((ext_vector_type(2))) __bf16 bf16x2_t;
  typedef __attribute__((ext_vector_type(2))) float f32x2_t;
  const f32x2_t v = {a, b};
  return __builtin_bit_cast(uint32_t, __builtin_convertvector(v, bf16x2_t));
}
__device__ __forceinline__ float bflo(uint32_t w) { return __uint_as_float(w << 16); }
__device__ __forceinline__ float bfhi(uint32_t w) { return __uint_as_float(w & 0xffff0000u); }
__device__ __forceinline__ float silu_f(float v) { return v / (1.f + __expf(-v)); }
__device__ __forceinline__ float softplus_f(float v) { return v > 20.f ? v : log1pf(__expf(v)); }

__device__ __forceinline__ int opaque_tid() { int t = threadIdx.x; asm volatile("" : "+v"(t)); return t; }
__device__ __forceinline__ float wave_sum(float v) {
#pragma unroll
  for (int o = 32; o > 0; o >>= 1) v += __shfl_xor(v, o);
  return v;
}
template <int CTRL>
__device__ __forceinline__ float dpp_mov(float v) {
  return __int_as_float(__builtin_amdgcn_update_dpp(0, __float_as_int(v), CTRL, 0xF, 0xF, true));
}
__device__ __forceinline__ float wave_sum_fast(float v) {
  v += dpp_mov<0xB1>(v); v += dpp_mov<0x4E>(v); v += dpp_mov<0x124>(v); v += dpp_mov<0x128>(v);
  v += __shfl_xor(v, 16); v += __shfl_xor(v, 32);
  return v;
}
__device__ __forceinline__ float wave_max(float v) {
#pragma unroll
  for (int o = 32; o > 0; o >>= 1) v = fmaxf(v, __shfl_xor(v, o));
  return v;
}
__device__ __forceinline__ float block_sum(float v, float* red) {
  v = wave_sum(v);
  __syncthreads();
  if ((threadIdx.x & 63) == 0) red[threadIdx.x >> 6] = v;
  __syncthreads();
  return red[0] + red[1] + red[2] + red[3];
}

struct Params {
  const float *x, *c, *ctx, *c_ctx, *w_mod, *b_mod, *g_pre_mix, *g_post_mix, *g_pre_ffn, *g_post_ffn;
  const float *w_in, *w_fmix, *conv_w, *conv_b, *dt_bias_f, *dt_bias_b, *a_log_f, *a_log_b, *d_skip_f, *d_skip_b;
  const float *ssm_norm_w, *w_out, *w_query, *sk1, *sk2, *eu, *ev;
  float* out;
  uint8_t *U8, *V8;
  bf16_t *w_in_t, *w_out_t, *w_q_t, *w_in_f, *WcsT, *dftm, *Fs;
  float *partial, *mod;
  bf16_t *hx, *hc, *ABt, *z;
  float *xbcraw, *xbcraw_c, *dtraw, *dtraw_c, *dtf, *dtb, *dtf_c, *dtb_c;
  bf16_t *act_tm, *act_cm_x, *act_cm_c;
  float *yf, *yb;
  unsigned* ctr; unsigned* bar;
  bf16_t* ycat;
  float *y_x, *q, *gate;
  int* idx;
  int pad0, pad1;
};

__device__ __forceinline__ void gemm_mainloop(const bf16_t* __restrict__ A, int lda, const bf16_t* __restrict__ Bt, int ldb,
                                              int K, int m0, int n0, f32x4 (&acc)[4][4], char* smem) {
  const int tid = opaque_tid(), lane = tid & 63, w = tid >> 6;
  const int wm = w >> 1, wn = w & 1;
#pragma unroll
  for (int i = 0; i < 4; ++i)
#pragma unroll
    for (int j = 0; j < 4; ++j) acc[i][j] = f32x4{0.f, 0.f, 0.f, 0.f};

  const int nk = K / 64;
  const int rowoff = lane >> 3, lch = (lane & 7) ^ rowoff;
  const bf16_t* gA = A + (size_t)(m0 + w * 8 + rowoff) * lda + lch * 8;
  const bf16_t* gB = Bt + (size_t)(n0 + w * 8 + rowoff) * ldb + lch * 8;
#define GSTAGE(buf_, kt_)                                                                                               \
  do {                                                                                                                  \
    _Pragma("unroll") for (int i_ = 0; i_ < 4; ++i_) {                                                                  \
      __builtin_amdgcn_global_load_lds((const unsigned*)(gA + (size_t)(i_ * 32) * lda + (kt_) * 64),                    \
                                       (unsigned*)(smem + (buf_) * 32768 + (i_ * 4 + w) * 1024), 16, 0, 0);             \
      __builtin_amdgcn_global_load_lds((const unsigned*)(gB + (size_t)(i_ * 32) * ldb + (kt_) * 64),                    \
                                       (unsigned*)(smem + (buf_) * 32768 + 16384 + (i_ * 4 + w) * 1024), 16, 0, 0);     \
    }                                                                                                                   \
  } while (0)
  GSTAGE(0, 0);
  asm volatile("s_waitcnt vmcnt(0)" ::: "memory");
  __syncthreads();
  for (int kt = 0; kt < nk; ++kt) {
    const int cur = kt & 1;
    if (kt + 1 < nk) GSTAGE(cur ^ 1, kt + 1);
    const char* sA = smem + cur * 32768;
    const char* sB = sA + 16384;
#pragma unroll
    for (int kk = 0; kk < 2; ++kk) {
      bf16x8 af[4], bfr[4];
      const int ch = kk * 4 + (lane >> 4);
#pragma unroll
      for (int i = 0; i < 4; ++i) {
        int row = wm * 64 + i * 16 + (lane & 15);
        af[i] = *reinterpret_cast<const bf16x8*>(sA + row * 128 + ((ch ^ (row & 7)) << 4));
        int col = wn * 64 + i * 16 + (lane & 15);
        bfr[i] = *reinterpret_cast<const bf16x8*>(sB + col * 128 + ((ch ^ (col & 7)) << 4));
      }
#pragma unroll
      for (int i = 0; i < 4; ++i)
#pragma unroll
        for (int j = 0; j < 4; ++j) acc[i][j] = __builtin_amdgcn_mfma_f32_16x16x32_bf16(af[i], bfr[j], acc[i][j], 0, 0, 0);
    }
    asm volatile("s_waitcnt vmcnt(0)" ::: "memory");
    __syncthreads();
  }
#undef GSTAGE
}

template <class Epi>
__device__ __forceinline__ void gemm_tile(const bf16_t* __restrict__ A, int lda, const bf16_t* __restrict__ Bt, int ldb,
                                          int K, int m0, int n0, const Epi& epi, char* smem) {
  const int lane = threadIdx.x & 63, w = threadIdx.x >> 6;
  const int wm = w >> 1, wn = w & 1;
  f32x4 acc[4][4];
  gemm_mainloop(A, lda, Bt, ldb, K, m0, n0, acc, smem);
#pragma unroll
  for (int i = 0; i < 4; ++i)
#pragma unroll
    for (int j = 0; j < 4; ++j) {
      int row = m0 + wm * 64 + i * 16 + (lane >> 4) * 4;
      int col = n0 + wn * 64 + j * 16 + (lane & 15);
      epi(row, col, acc[i][j]);
    }
}

__device__ __forceinline__ void gemm_mainloop_n256(const bf16_t* __restrict__ A, int lda, const bf16_t* __restrict__ Bt, int ldb,
                                                   int K, int m0, int n0, f32x4 (&acc)[4][8], char* smem) {
  const int tid = opaque_tid(), lane = tid & 63, w = tid >> 6;
  const int wm = w >> 1, wn = w & 1;
#pragma unroll
  for (int i = 0; i < 4; ++i)
#pragma unroll
    for (int j = 0; j < 8; ++j) acc[i][j] = f32x4{0.f, 0.f, 0.f, 0.f};
  const int nk = K / 64;
  const int rowoff = lane >> 3, lch = (lane & 7) ^ rowoff;
  const bf16_t* gA = A + (size_t)(m0 + w * 8 + rowoff) * lda + lch * 8;
  const bf16_t* gB = Bt + (size_t)(n0 + w * 8 + rowoff) * ldb + lch * 8;
  const int fr = lane & 15, fq = lane >> 4;
  for (int kt = 0; kt < nk; ++kt) {
#pragma unroll
    for (int i_ = 0; i_ < 4; ++i_)
      __builtin_amdgcn_global_load_lds((const unsigned*)(gA + (size_t)(i_ * 32) * lda + kt * 64),
                                       (unsigned*)(smem + (i_ * 4 + w) * 1024), 16, 0, 0);
#pragma unroll
    for (int i_ = 0; i_ < 8; ++i_)
      __builtin_amdgcn_global_load_lds((const unsigned*)(gB + (size_t)(i_ * 32) * ldb + kt * 64),
                                       (unsigned*)(smem + 16384 + (i_ * 4 + w) * 1024), 16, 0, 0);
    asm volatile("s_waitcnt vmcnt(0)" ::: "memory");
    __syncthreads();
    const char* sA = smem;
    const char* sB = smem + 16384;
#pragma unroll
    for (int kk = 0; kk < 2; ++kk) {
      bf16x8 af[4], bfr[8];
      const int ch = kk * 4 + fq;
#pragma unroll
      for (int i = 0; i < 4; ++i) {
        const int row = wm * 64 + i * 16 + fr;
        af[i] = *reinterpret_cast<const bf16x8*>(sA + row * 128 + ((ch ^ (row & 7)) << 4));
      }
#pragma unroll
      for (int j = 0; j < 8; ++j) {
        const int col = wn * 128 + j * 16 + fr;
        bfr[j] = *reinterpret_cast<const bf16x8*>(sB + col * 128 + ((ch ^ (col & 7)) << 4));
      }
#pragma unroll
      for (int i = 0; i < 4; ++i)
#pragma unroll
        for (int j = 0; j < 8; ++j) acc[i][j] = __builtin_amdgcn_mfma_f32_16x16x32_bf16(af[i], bfr[j], acc[i][j], 0, 0, 0);
    }
    __syncthreads();
  }
}
template <class Epi>
__device__ __forceinline__ void gemm_tile_n256(const bf16_t* __restrict__ A, int lda, const bf16_t* __restrict__ Bt, int ldb,
                                               int K, int m0, int n0, const Epi& epi, char* smem) {
  const int lane = threadIdx.x & 63, w = threadIdx.x >> 6;
  const int wm = w >> 1, wn = w & 1;
  f32x4 acc[4][8];
  gemm_mainloop_n256(A, lda, Bt, ldb, K, m0, n0, acc, smem);
#pragma unroll
  for (int i = 0; i < 4; ++i)
#pragma unroll
    for (int j = 0; j < 8; ++j) {
      int row = m0 + wm * 64 + i * 16 + (lane >> 4) * 4;
      int col = n0 + wn * 128 + j * 16 + (lane & 15);
      epi(row, col, acc[i][j]);
    }
}

struct EpiF32 {
  float* C; int ldc;
  __device__ __forceinline__ void operator()(int row, int col, f32x4 v) const {
#pragma unroll
    for (int r = 0; r < 4; ++r) C[(size_t)(row + r) * ldc + col] = v[r];
  }
};
struct EpiBf16 {
  bf16_t* C; int ldc;
  __device__ __forceinline__ void operator()(int row, int col, f32x4 v) const {
#pragma unroll
    for (int r = 0; r < 4; ++r) C[(size_t)(row + r) * ldc + col] = f2bf(v[r]);
  }
};
struct EpiBf16T {
  bf16_t* Ct; int ldc;
  __device__ __forceinline__ void operator()(int row, int col, f32x4 v) const {
    uint2 pk; pk.x = pack2(v[0], v[1]); pk.y = pack2(v[2], v[3]);
    *reinterpret_cast<uint2*>(Ct + (size_t)col * ldc + row) = pk;
  }
};
struct EpiInAB {
  bf16_t* ABt; int seqlen;
  __device__ __forceinline__ void operator()(int row, int col, f32x4 v) const {
    const int ch = col & 1023, half = col >> 10;
    const int b = row / seqlen, l = row - b * seqlen;
    uint2 pk; pk.x = pack2(v[0], v[1]); pk.y = pack2(v[2], v[3]);
    *reinterpret_cast<uint2*>(ABt + ((size_t)(b * 1024 + ch) * 4096 + half * 2048 + l)) = pk;
  }
};
struct EpiInZ {
  bf16_t* z;
  __device__ __forceinline__ void operator()(int row, int col, f32x4 v) const {
#pragma unroll
    for (int r = 0; r < 4; ++r) z[(size_t)(row + r) * 1024 + (col - 2048)] = f2bf(v[r]);
  }
};
struct EpiInXbc {
  float* xbcraw;
  __device__ __forceinline__ void operator()(int row, int col, f32x4 v) const {
#pragma unroll
    for (int r = 0; r < 4; ++r) xbcraw[(size_t)(row + r) * DXBC + (col - 3072)] = v[r];
  }
};
struct EpiInProj {
  bf16_t* ABt; bf16_t* z; float* xbcraw; float* dtraw; int seqlen;
  __device__ __forceinline__ void operator()(int row, int col, f32x4 v) const {
    if (col < 2048) {
      int ch = col & 1023, half = col >> 10;
      int b = row / seqlen, l = row - b * seqlen;
      uint2 pk; pk.x = pack2(v[0], v[1]); pk.y = pack2(v[2], v[3]);
      *reinterpret_cast<uint2*>(ABt + ((size_t)(b * 1024 + ch) * 4096 + half * 2048 + l)) = pk;
    } else if (col < 3072) {
#pragma unroll
      for (int r = 0; r < 4; ++r) z[(size_t)(row + r) * 1024 + (col - 2048)] = f2bf(v[r]);
    } else if (col < 4608) {
#pragma unroll
      for (int r = 0; r < 4; ++r) xbcraw[(size_t)(row + r) * DXBC + (col - 3072)] = v[r];
    } else if (col < 4640) {
#pragma unroll
      for (int r = 0; r < 4; ++r) dtraw[(size_t)(row + r) * 32 + (col - 4608)] = v[r];
    }
  }
};

__device__ void adaln_partial_task(const Params& p, int task, float* sm) {
  const int cb = task % 48, ks = task / 48, tid = threadIdx.x;
  float* sc = sm;
  __syncthreads();
  for (int i = tid; i < 5 * 64; i += NTHREADS) {
    int r = i >> 6, kk = i & 63;
    int k = ks * 64 + kk;
    float cv = (r < 4) ? p.c[r * D + k] : p.c_ctx[k];
    sc[i] = silu_f(cv);
  }
  __syncthreads();
  const int col = cb * 256 + tid;
  float a0 = 0, a1 = 0, a2 = 0, a3 = 0, a4 = 0;
  const float* wp = p.w_mod + (size_t)(ks * 64) * NMOD + col;
#pragma unroll
  for (int h2 = 0; h2 < 2; ++h2) {
    float wv[32];
#pragma unroll
    for (int kk = 0; kk < 32; ++kk) wv[kk] = __builtin_nontemporal_load(wp + (size_t)(h2 * 32 + kk) * NMOD);
#pragma unroll
    for (int kk = 0; kk < 32; ++kk) {
      const int k = h2 * 32 + kk;
      a0 += sc[k] * wv[kk]; a1 += sc[64 + k] * wv[kk]; a2 += sc[128 + k] * wv[kk]; a3 += sc[192 + k] * wv[kk]; a4 += sc[256 + k] * wv[kk];
    }
  }
  float* pp = p.partial + (size_t)ks * 5 * NMOD + col;
  pp[0] = a0; pp[NMOD] = a1; pp[2 * NMOD] = a2; pp[3 * NMOD] = a3; pp[4 * NMOD] = a4;
}

__device__ void transpose_convert_task(const float* __restrict__ src, int ld, int c0, int rows, bf16_t* __restrict__ dst,
                                       int tr, int tc, float* sm) {
  float (*tile)[68] = reinterpret_cast<float (*)[68]>(sm);
  const int tid = threadIdx.x;
  __syncthreads();
  {
    float4 v[4];
#pragma unroll
    for (int k = 0; k < 4; ++k) {
      const int i = tid + k * NTHREADS, r = i >> 4, c4 = i & 15;
      v[k] = *reinterpret_cast<const float4*>(src + (size_t)(tr * 64 + r) * ld + c0 + tc * 64 + c4 * 4);
    }
#pragma unroll
    for (int k = 0; k < 4; ++k) {
      const int i = tid + k * NTHREADS, r = i >> 4, c4 = i & 15;
      *reinterpret_cast<float4*>(&tile[r][c4 * 4]) = v[k];
    }
  }
  __syncthreads();
#pragma unroll
  for (int k = 0; k < 4; ++k) {
    const int i = tid + k * NTHREADS, cc = i >> 4, r4 = (i & 15) * 4;
    uint2 o; o.x = pack2(tile[r4][cc], tile[r4 + 1][cc]); o.y = pack2(tile[r4 + 2][cc], tile[r4 + 3][cc]);
    *reinterpret_cast<uint2*>(dst + (size_t)(tc * 64 + cc) * rows + tr * 64 + r4) = o;
  }
}

__device__ void phase_prep(const Params& p, int bid, int nb, char* smem) {
  float* sm = reinterpret_cast<float*>(smem);
  const int tid = threadIdx.x;
  if (bid == 0 && tid < 64) p.ctr[tid] = 0u;
  {
    float* t256 = reinterpret_cast<float*>(smem + 20480);
    float* t2048 = reinterpret_cast<float*>(smem + 24576);
    t256[tid] = cospif((float)tid * (1.0f / 128.f));
    for (int i = tid; i < 2048; i += NTHREADS) t2048[i] = cospif((float)i * (1.0f / 1024.f));
    __syncthreads();
  }
  for (int t = bid; t < 48 * KSPLIT; t += nb) adaln_partial_task(p, t, sm);
  {
    const int nct = 41, nrt = 32;
    for (int t = bid; t < nct * nrt; t += nb) {
      int tc = t % nct, tr = t / nct;
      if (tc < 40) transpose_convert_task(p.w_in, DIN, 1024, D, p.w_in_t + (size_t)2048 * D, tr, tc, sm);
      else {
        float (*tile)[65] = reinterpret_cast<float (*)[65]>(sm);
        __syncthreads();
        for (int i = tid; i < 64 * 32; i += NTHREADS) {
          int r = i >> 5, cc = i & 31;
          tile[r][cc] = p.w_in[(size_t)(tr * 64 + r) * DIN + 1024 + 2560 + cc];
        }
        __syncthreads();
        for (int i = tid; i < 32 * 32; i += NTHREADS) {
          int cc = i >> 5, r2 = (i & 31) * 2;
          uint32_t pk = pack2(tile[r2][cc], tile[r2 + 1][cc]);
          *reinterpret_cast<uint32_t*>(p.w_in_t + (size_t)(2048 + 2560 + cc) * D + tr * 64 + r2) = pk;
        }
      }
    }
    for (size_t i = (size_t)bid * NTHREADS + tid; i < (size_t)96 * D / 8; i += (size_t)nb * NTHREADS)
      reinterpret_cast<uint4*>(p.w_in_t + (size_t)4640 * D)[i] = uint4{0, 0, 0, 0};
  }
  for (size_t i = (size_t)bid * NTHREADS + tid; i < (size_t)D * 1024 / 4; i += (size_t)nb * NTHREADS) {
    int k = (int)(i / 256), c4 = (int)(i % 256) * 4;
    float4 v = *reinterpret_cast<const float4*>(p.w_in + (size_t)k * DIN + c4);
    uint2 o; o.x = pack2(v.x, v.y); o.y = pack2(v.z, v.w);
    *reinterpret_cast<uint2*>(p.w_in_f + (size_t)k * 1024 + c4) = o;
  }
  {
    const float* t256 = reinterpret_cast<const float*>(smem + 20480);
    const float scale = 1.0f / sqrtf((float)L * 256.f);
    for (int i = bid * NTHREADS + tid; i < 4 * 64 * 256; i += nb * NTHREADS) {
      const int d = i & 255, cg = (i >> 8) & 63, g = i >> 14;
      float sc_[4] = {0.f, 0.f, 0.f, 0.f}, ss_[4] = {0.f, 0.f, 0.f, 0.f};
      const float* wp = p.w_fmix + (size_t)g * 65536 + d;
#pragma unroll 4
      for (int m = 0; m < 256; ++m) {
        const float wv = wp[m * 256];
#pragma unroll
        for (int j = 0; j < 4; ++j) {
          const int ph = (m * (cg * 4 + j)) & 255;
          sc_[j] += t256[ph] * wv; ss_[j] += t256[(ph - 64) & 255] * wv;
        }
      }
#pragma unroll
      for (int j = 0; j < 4; ++j) {
        const int c = cg * 4 + j;
        p.WcsT[((size_t)g * 512 + d) * 256 + c] = f2bf(sc_[j] * scale);
        p.WcsT[((size_t)g * 512 + 256 + d) * 256 + c] = f2bf(ss_[j] * scale);
      }
    }
  }
  {
    const float* t2048 = reinterpret_cast<const float*>(smem + 24576);
    for (size_t i = (size_t)bid * NTHREADS + tid; i < (size_t)1024 * 2048 / 8; i += (size_t)nb * NTHREADS) {
      const int k = (int)(i / 256), j = (int)(i % 256) * 8;
      const bool iss = j >= 1024;
      float o[8];
#pragma unroll
      for (int e = 0; e < 8; ++e) {
        const int l = (j + e) & 1023;
        const int ph = (k * l) & 2047;
        o[e] = iss ? t2048[(ph - 512) & 2047] : t2048[ph];
      }
      uint4 pk; pk.x = pack2(o[0], o[1]); pk.y = pack2(o[2], o[3]); pk.z = pack2(o[4], o[5]); pk.w = pack2(o[6], o[7]);
      *reinterpret_cast<uint4*>(p.dftm + (size_t)k * 2048 + j) = pk;
    }
  }
}

__device__ void phase_fold(const Params& p, int bid, int nb, char* smem) {
  const int tid = threadIdx.x;
  for (int i = bid * NTHREADS + tid; i < 5 * NMOD; i += nb * NTHREADS) {
    int col = i % NMOD;
    float s = p.b_mod[col];
    for (int ks = 0; ks < KSPLIT; ++ks) s += p.partial[(size_t)ks * 5 * NMOD + i];
    p.mod[i] = s;
  }
  for (int t = bid; t < 256; t += nb) {
    int g = t >> 6, tm = (t & 63) >> 2, tn = t & 3;
    int n0 = tn * 128;
    int rowbase = (n0 < 256) ? (g * 256 + n0) : (1024 + g * 256 + (n0 - 256));
    EpiBf16T epi{p.w_in_t + (size_t)(rowbase - n0) * D, D};
    gemm_tile(p.w_in_f + g * 256, 1024, p.WcsT + (size_t)g * 512 * 256, 256, 256, tm * 128, n0, epi, smem);
  }
}

__device__ void phase_norm_mod(const Params& p, int bid, int nb, char* smem) {
  const int lane = threadIdx.x & 63, w = threadIdx.x >> 6;
  for (int t = bid * 4 + w; t < T + TC; t += nb * 4) {
    const bool isx = t < T;
    const float* src = isx ? (p.x + (size_t)t * D) : (p.ctx + (size_t)(t - T) * D);
    const int mrow = isx ? (t / L) : 4;
    bf16_t* dst = isx ? (p.hx + (size_t)t * D) : (p.hc + (size_t)(t - T) * D);
    float4 v[8];
    float ss = 0.f;
#pragma unroll
    for (int c = 0; c < 8; ++c) {
      v[c] = *reinterpret_cast<const float4*>(src + c * 256 + lane * 4);
      ss += v[c].x * v[c].x + v[c].y * v[c].y + v[c].z * v[c].z + v[c].w * v[c].w;
    }
    ss = wave_sum_fast(ss);
    const float rstd = rsqrtf(ss * (1.f / D) + EPS);
    const float* sh = p.mod + (size_t)mrow * NMOD + 0 * D;
    const float* sc = p.mod + (size_t)mrow * NMOD + 1 * D;
#pragma unroll
    for (int c = 0; c < 8; ++c) {
      const int e0 = c * 256 + lane * 4;
      const float4 g = *reinterpret_cast<const float4*>(p.g_pre_mix + e0);
      const float4 s4 = *reinterpret_cast<const float4*>(sc + e0), h4 = *reinterpret_cast<const float4*>(sh + e0);
      uint2 pk;
      pk.x = pack2(v[c].x * rstd * g.x * (1.f + s4.x) + h4.x, v[c].y * rstd * g.y * (1.f + s4.y) + h4.y);
      pk.y = pack2(v[c].z * rstd * g.z * (1.f + s4.z) + h4.z, v[c].w * rstd * g.w * (1.f + s4.w) + h4.w);
      *reinterpret_cast<uint2*>(dst + e0) = pk;
    }
  }
}

__device__ __forceinline__ void convert_uv_units(const Params& p, size_t u0, size_t u1) {
  const size_t n16 = (size_t)16384 * D / 16;
  for (size_t i = u0 + threadIdx.x; i < u1; i += NTHREADS) {
    const float* s = (i < n16) ? p.eu : p.ev;
    uint8_t* d = (i < n16) ? p.U8 : p.V8;
    const size_t j = (i < n16) ? i : i - n16;
    uint32_t o[4];
#pragma unroll
    for (int q4 = 0; q4 < 4; ++q4) {
      const float4 v = *reinterpret_cast<const float4*>(s + j * 16 + q4 * 4);
      int pk = 0;
      pk = __builtin_amdgcn_cvt_pk_fp8_f32(v.x * 512.f, v.y * 512.f, pk, false);
      pk = __builtin_amdgcn_cvt_pk_fp8_f32(v.z * 512.f, v.w * 512.f, pk, true);
      o[q4] = (uint32_t)pk;
    }
    *reinterpret_cast<uint4*>(d + j * 16) = uint4{o[0], o[1], o[2], o[3]};
  }
}
__device__ void phase_inproj(const Params& p, int bid, int nb, char* smem) {
  if ((nb & 7) == 0) {
    const int x = bid & 7, rank = bid >> 3, per = nb >> 3;
    for (int s_ = rank; s_ < 128 + 53; s_ += per) {
      if (s_ < 128) {
        const int tn2 = s_ >> 3, m0_ = (8 * x + (s_ & 7)) * 128;
        if (tn2 < 8) { EpiInAB epi{p.ABt, L}; gemm_tile_n256(p.hx, D, p.w_in_t, D, D, m0_, tn2 * 256, epi, smem); }
        else if (tn2 < 12) { EpiInZ epi{p.z}; gemm_tile_n256(p.hx, D, p.w_in_t, D, D, m0_, tn2 * 256, epi, smem); }
        else { EpiInXbc epi{p.xbcraw}; gemm_tile_n256(p.hx, D, p.w_in_t, D, D, m0_, tn2 * 256, epi, smem); }
      } else if (s_ < 128 + 40) {
        const int i = s_ - 128;
        EpiInProj epi{p.ABt, p.z, p.xbcraw, p.dtraw, L};
        gemm_tile(p.hx, D, p.w_in_t, D, D, (8 * x + (i & 7)) * 128, (32 + (i >> 3)) * 128, epi, smem);
      } else {
        const int u = x * 13 + (s_ - 168);
        EpiInProj epi{nullptr, nullptr, p.xbcraw_c, p.dtraw_c, CTX};
        gemm_tile(p.hc, D, p.w_in_t, D, D, (u / 13) * 128, 3072 + (u % 13) * 128, epi, smem);
      }
    }
    return;
  }
  const int ntx = 64 * 37, ntc = 8 * 13;
  for (int t = bid; t < ntx + ntc; t += nb) {
    if (t < ntx) {
      int tm = t / 37, tn = t % 37;
      EpiInProj epi{p.ABt, p.z, p.xbcraw, p.dtraw, L};
      gemm_tile(p.hx, D, p.w_in_t, D, D, tm * 128, tn * 128, epi, smem);
    } else {
      int u = t - ntx;
      int tm = u / 13, tn = u % 13;
      EpiInProj epi{nullptr, nullptr, p.xbcraw_c, p.dtraw_c, CTX};
      gemm_tile(p.hc, D, p.w_in_t, D, D, tm * 128, 3072 + tn * 128, epi, smem);
    }
  }
}

__device__ void ssm_pre_tile(const Params& p, int task, char* smem) {
  const bool isx = task < 3072;
  const int u = isx ? task : task - 3072;
  const int ntt = isx ? 32 : 4;
  const int ct = u % 24, tt = (u / 24) % ntt, b = u / (24 * ntt);
  const int seqlen = isx ? L : CTX;
  const float* raw = (isx ? p.xbcraw : p.xbcraw_c) + (size_t)b * seqlen * DXBC;
  const int l0 = tt * 64, c0 = ct * 64, tid = threadIdx.x;
  float (*rt)[68] = reinterpret_cast<float (*)[68]>(smem);
  float (*at)[65] = reinterpret_cast<float (*)[65]>(smem + 66 * 68 * 4);
  __syncthreads();
  {
    float4 v[5];
#pragma unroll
    for (int k = 0; k < 5; ++k) {
      const int i = tid + k * NTHREADS, r = i >> 4, c4 = i & 15, l = l0 - 1 + r;
      v[k] = (i < 66 * 16 && l >= 0 && l < seqlen) ? *reinterpret_cast<const float4*>(raw + (size_t)l * DXBC + c0 + c4 * 4) : float4{0.f, 0.f, 0.f, 0.f};
    }
#pragma unroll
    for (int k = 0; k < 5; ++k) {
      const int i = tid + k * NTHREADS, r = i >> 4, c4 = i & 15;
      if (i < 66 * 16) *reinterpret_cast<float4*>(&rt[r][c4 * 4]) = v[k];
    }
  }
  __syncthreads();
  {
    const int cc = tid & 63, c = c0 + cc;
    const float w0 = p.conv_w[c], w1 = p.conv_w[DXBC + c], w2 = p.conv_w[2 * DXBC + c], cb = p.conv_b[c];
#pragma unroll 4
    for (int r = tid >> 6; r < 64; r += 4) at[r][cc] = silu_f(cb + rt[r][cc] * w0 + rt[r + 1][cc] * w1 + rt[r + 2][cc] * w2);
  }
  __syncthreads();
  const size_t trow0 = isx ? ((size_t)b * L + l0) : ((size_t)T + (size_t)b * CTX + l0);
#pragma unroll
  for (int k = 0; k < 4; ++k) {
    const int i = tid + k * NTHREADS, r = i >> 4, c4 = (i & 15) * 4;
    uint2 o; o.x = pack2(at[r][c4], at[r][c4 + 1]); o.y = pack2(at[r][c4 + 2], at[r][c4 + 3]);
    *reinterpret_cast<uint2*>(p.act_tm + (trow0 + r) * DXBC + c0 + c4) = o;
  }
  if (c0 < 1280) {
    bf16_t* cm = (isx ? p.act_cm_x : p.act_cm_c) + (size_t)b * 1280 * seqlen;
#pragma unroll
    for (int k = 0; k < 4; ++k) {
      const int i = tid + k * NTHREADS, cc = i >> 4, r4 = (i & 15) * 4;
      uint2 o; o.x = pack2(at[r4][cc], at[r4 + 1][cc]); o.y = pack2(at[r4 + 2][cc], at[r4 + 3][cc]);
      *reinterpret_cast<uint2*>(cm + (size_t)(c0 + cc) * seqlen + l0 + r4) = o;
    }
  }
}
__device__ void dft_fold_rows(const Params& p, int bid, int nb, char* smem) {
  const int lane = threadIdx.x & 63, w = threadIdx.x >> 6;
  bf16_t* sr = reinterpret_cast<bf16_t*>(smem + w * 8192);
  for (int row = bid * 4 + w; row < NB * 1024; row += nb * 4) {
    const bf16_t* A = p.ABt + (size_t)row * 4096;
    bf16_t* F = p.Fs + (size_t)row * 2048;
    __builtin_amdgcn_wave_barrier();
    {
      const uint4 q0 = *reinterpret_cast<const uint4*>(A + (0 * 64 + lane) * 8), q1 = *reinterpret_cast<const uint4*>(A + (1 * 64 + lane) * 8);
      const uint4 q2 = *reinterpret_cast<const uint4*>(A + (2 * 64 + lane) * 8), q3 = *reinterpret_cast<const uint4*>(A + (3 * 64 + lane) * 8);
      const uint4 q4 = *reinterpret_cast<const uint4*>(A + (4 * 64 + lane) * 8), q5 = *reinterpret_cast<const uint4*>(A + (5 * 64 + lane) * 8);
      const uint4 q6 = *reinterpret_cast<const uint4*>(A + (6 * 64 + lane) * 8), q7 = *reinterpret_cast<const uint4*>(A + (7 * 64 + lane) * 8);
      *reinterpret_cast<uint4*>(sr + (0 * 64 + lane) * 8) = q0; *reinterpret_cast<uint4*>(sr + (1 * 64 + lane) * 8) = q1;
      *reinterpret_cast<uint4*>(sr + (2 * 64 + lane) * 8) = q2; *reinterpret_cast<uint4*>(sr + (3 * 64 + lane) * 8) = q3;
      *reinterpret_cast<uint4*>(sr + (4 * 64 + lane) * 8) = q4; *reinterpret_cast<uint4*>(sr + (5 * 64 + lane) * 8) = q5;
      *reinterpret_cast<uint4*>(sr + (6 * 64 + lane) * 8) = q6; *reinterpret_cast<uint4*>(sr + (7 * 64 + lane) * 8) = q7;
    }
    __builtin_amdgcn_wave_barrier();
    const int l0 = lane * 16;
    float alt = 0.f;
    uint32_t oa[8], ob[8];
#pragma unroll
    for (int half = 0; half < 2; ++half) {
      const bf16_t* base = sr + half * 2048;
      const uint4 fa = *reinterpret_cast<const uint4*>(base + l0), fb = *reinterpret_cast<const uint4*>(base + l0 + 8);
      const uint4 ra = *reinterpret_cast<const uint4*>(base + 2032 - l0), rb = *reinterpret_cast<const uint4*>(base + 2040 - l0);
      const float r16 = (lane > 0) ? bf2f(base[2048 - l0]) : 0.f;
      const uint32_t fw[8] = {fa.x, fa.y, fa.z, fa.w, fb.x, fb.y, fb.z, fb.w};
      const uint32_t rw[8] = {ra.x, ra.y, ra.z, ra.w, rb.x, rb.y, rb.z, rb.w};
      float v[16];
#pragma unroll
      for (int i = 0; i < 16; ++i) {
        const float fwv = (i & 1) ? bfhi(fw[i >> 1]) : bflo(fw[i >> 1]);
        const int j = 16 - i;
        const float rv = (i == 0) ? r16 : ((j & 1) ? bfhi(rw[j >> 1]) : bflo(rw[j >> 1]));
        if (half == 0) v[i] = (lane == 0 && i == 0) ? fwv : fwv + rv;
        else v[i] = (lane == 0 && i == 0) ? 0.f : fwv - rv;
      }
      if (half == 0) {
#pragma unroll
        for (int i = 0; i < 16; ++i) alt += (i & 1) ? -v[i] : v[i];
#pragma unroll
        for (int i = 0; i < 8; ++i) oa[i] = pack2(v[2 * i], v[2 * i + 1]);
      } else {
#pragma unroll
        for (int i = 0; i < 8; ++i) ob[i] = pack2(v[2 * i], v[2 * i + 1]);
      }
    }
    *reinterpret_cast<uint4*>(F + l0) = uint4{oa[0], oa[1], oa[2], oa[3]};
    *reinterpret_cast<uint4*>(F + l0 + 8) = uint4{oa[4], oa[5], oa[6], oa[7]};
    *reinterpret_cast<uint4*>(F + 1024 + l0) = uint4{ob[0], ob[1], ob[2], ob[3]};
    *reinterpret_cast<uint4*>(F + 1024 + l0 + 8) = uint4{ob[4], ob[5], ob[6], ob[7]};
    alt = wave_sum_fast(alt) + bf2f(sr[1024]);
    if (lane == 0) { const int b = row >> 10, ch = row & 1023; p.ycat[((size_t)b * L + 1024) * D + ch] = f2bf(alt); }
  }
}
__device__ void phase_ssm_pre(const Params& p, int bid, int nb, char* smem) {
  const int tid = threadIdx.x;
  dft_fold_rows(p, bid, nb, smem);
  for (int t = bid; t < 3072 + 384; t += nb) ssm_pre_tile(p, t, smem);
  for (int i = bid * NTHREADS + tid; i < (T + TC) * 32; i += nb * NTHREADS) {
    const bool isx = i < T * 32;
    const int ii = isx ? i : i - T * 32;
    const int t = ii >> 5, j = ii & 31;
    const float v = (isx ? p.dtraw : p.dtraw_c)[ii];
    float* df = isx ? p.dtf : p.dtf_c;
    float* db = isx ? p.dtb : p.dtb_c;
    if (j < 16) df[t * 16 + j] = softplus_f(v + p.dt_bias_f[j]);
    else db[t * 16 + (j - 16)] = softplus_f(v + p.dt_bias_b[j - 16]);
  }
}

__device__ __forceinline__ int swz16(int row, int chunk) { return row * 256 + ((chunk ^ (row & 15)) << 4); }
__device__ __forceinline__ int swz8(int row, int chunk) { return row * 128 + ((chunk ^ (row & 7)) << 4); }

#define LDS_BARRIER() asm volatile("s_waitcnt lgkmcnt(0)\n\ts_barrier" ::: "memory")
__device__ void ssd_task(const Params& p, int task, char* smem) {
  const int dir = task & 1, ph = (task >> 1) & 1, h = (task >> 2) & 15, b = task >> 6;
  const int tid = opaque_tid(), lane = tid & 63, w = tid >> 6;
  const int g = h >> 3, lr0 = lane & 15, lq0 = lane >> 4;
  const float a = -__expf(dir ? p.a_log_b[h] : p.a_log_f[h]);
  char* sCc = smem; char* sBc = smem + 16384; char* sBT = smem + 32768; char* sXT = smem + 49152; char* sHb = smem + 57344;
  float* se = reinterpret_cast<float*>(smem + 73728);
  float* sdt = se + 64; float* sw = se + 128; float* sy = se + 192; float* stot = se + 256;
  float* yo = dir ? p.yb : p.yf;
  f32x4 H[2][2];
#pragma unroll
  for (int i = 0; i < 2; ++i)
#pragma unroll
    for (int j = 0; j < 2; ++j) H[i][j] = f32x4{0.f, 0.f, 0.f, 0.f};
  __syncthreads();
  for (int i = tid; i < 512; i += NTHREADS) reinterpret_cast<uint4*>(sHb)[i] = uint4{0, 0, 0, 0};

  const int crow = tid >> 4, cch = tid & 15;
  const int trow = tid >> 3, tch = tid & 7;
  uint4 rC0, rC1, rC2, rC3, rB0, rB1, rB2, rB3, rT0, rT1, rT2, rT3, rX;
  rC0 = rC1 = rC2 = rC3 = rB0 = rB1 = rB2 = rB3 = uint4{0, 0, 0, 0};
  float rdt = 0.f;
#define SSD_PARAMS(st_)                                                                                                   \
  const bool isctx_ = (st_) < 4;                                                                                          \
  const int nch_ = isctx_ ? 4 : 32, ci_ = isctx_ ? (st_) : (st_) - 4;                                                     \
  const int c_ = dir ? (nch_ - 1 - ci_) : ci_;                                                                            \
  const int seqlen_ = isctx_ ? CTX : L;                                                                                   \
  const size_t trow0_ = isctx_ ? ((size_t)T + (size_t)b * CTX + c_ * 64) : ((size_t)b * L + c_ * 64);                     \
  const size_t drow0_ = (size_t)b * seqlen_ + c_ * 64;                                                                    \
  const float* dtp_ = isctx_ ? (dir ? p.dtb_c : p.dtf_c) : (dir ? p.dtb : p.dtf);                                         \
  const bf16_t* cm_ = (isctx_ ? p.act_cm_c : p.act_cm_x) + (size_t)b * 1280 * seqlen_ + c_ * 64;
#define SSD_PREFETCH(st_)                                                                                                 \
  do {                                                                                                                    \
    SSD_PARAMS(st_)                                                                                                       \
    if (w == 0) rdt = dtp_[(drow0_ + lane) * 16 + h];                                                                     \
    if (!isctx_) {                                                                                                        \
      const bf16_t* src = p.act_tm + (trow0_ + crow) * DXBC + g * 128 + cch * 8;                                          \
      rC0 = *reinterpret_cast<const uint4*>(src + 1280);             rB0 = *reinterpret_cast<const uint4*>(src + 1024);   \
      rC1 = *reinterpret_cast<const uint4*>(src + 16 * DXBC + 1280); rB1 = *reinterpret_cast<const uint4*>(src + 16 * DXBC + 1024); \
      rC2 = *reinterpret_cast<const uint4*>(src + 32 * DXBC + 1280); rB2 = *reinterpret_cast<const uint4*>(src + 32 * DXBC + 1024); \
      rC3 = *reinterpret_cast<const uint4*>(src + 48 * DXBC + 1280); rB3 = *reinterpret_cast<const uint4*>(src + 48 * DXBC + 1024); \
    }                                                                                                                     \
    const bf16_t* srt = cm_ + (size_t)(1024 + g * 128 + trow) * seqlen_ + tch * 8;                                        \
    rT0 = *reinterpret_cast<const uint4*>(srt);                                                                           \
    rT1 = *reinterpret_cast<const uint4*>(srt + (size_t)32 * seqlen_);                                                    \
    rT2 = *reinterpret_cast<const uint4*>(srt + (size_t)64 * seqlen_);                                                    \
    rT3 = *reinterpret_cast<const uint4*>(srt + (size_t)96 * seqlen_);                                                    \
    rX = *reinterpret_cast<const uint4*>(cm_ + (size_t)(h * 64 + ph * 32 + trow) * seqlen_ + tch * 8);                    \
  } while (0)

  for (int step = 0; step < 36; ++step) {
    SSD_PREFETCH(step);
    const bool isctx = step < 4;
    const int c = dir ? ((isctx ? 4 : 32) - 1 - (isctx ? step : step - 4)) : (isctx ? step : step - 4);
    const size_t trow0 = (size_t)b * L + c * 64;
    int lr = lr0, lq = lq0;
    asm volatile("" : "+v"(lr), "+v"(lq));
    LDS_BARRIER();
    if (w == 0) {
      const float dtv = rdt;
      float v = a * dtv;
      if (!dir) {
#pragma unroll
        for (int o = 1; o < 64; o <<= 1) { float n = __shfl_up(v, o); v += (lane >= o) ? n : 0.f; }
      } else {
#pragma unroll
        for (int o = 1; o < 64; o <<= 1) { float n = __shfl_down(v, o); v += (lane + o < 64) ? n : 0.f; }
      }
      const float etot = __shfl(v, dir ? 0 : 63);
      se[lane] = v; sdt[lane] = dtv; sw[lane] = dtv * __expf(etot - v); sy[lane] = __expf(v);
      if (lane == 0) stot[0] = etot;
    }
    if (!isctx) {
      const int oc = swz16(crow, cch);
      *reinterpret_cast<uint4*>(sCc + oc) = rC0;         *reinterpret_cast<uint4*>(sBc + oc) = rB0;
      *reinterpret_cast<uint4*>(sCc + oc + 4096) = rC1;  *reinterpret_cast<uint4*>(sBc + oc + 4096) = rB1;
      *reinterpret_cast<uint4*>(sCc + oc + 8192) = rC2;  *reinterpret_cast<uint4*>(sBc + oc + 8192) = rB2;
      *reinterpret_cast<uint4*>(sCc + oc + 12288) = rC3; *reinterpret_cast<uint4*>(sBc + oc + 12288) = rB3;
    }
    {
      const int ot = swz8(trow, tch);
      *reinterpret_cast<uint4*>(sBT + ot) = rT0;
      *reinterpret_cast<uint4*>(sBT + ot + 4096) = rT1;
      *reinterpret_cast<uint4*>(sBT + ot + 8192) = rT2;
      *reinterpret_cast<uint4*>(sBT + ot + 12288) = rT3;
      *reinterpret_cast<uint4*>(sXT + ot) = rX;
    }
    LDS_BARRIER();
    const float etot = stot[0];
    if (!isctx) {
      f32x4 G[4];
      bf16x8 ca[4];
#pragma unroll
      for (int j = 0; j < 4; ++j) G[j] = f32x4{0.f, 0.f, 0.f, 0.f};
#pragma unroll
      for (int kk = 0; kk < 4; ++kk) ca[kk] = *reinterpret_cast<const bf16x8*>(sCc + swz16(16 * w + lr, kk * 4 + lq));
#pragma unroll
      for (int kk = 0; kk < 4; ++kk)
#pragma unroll
        for (int j = 0; j < 4; ++j) {
          bf16x8 bb = *reinterpret_cast<const bf16x8*>(sBc + swz16(16 * j + lr, kk * 4 + lq));
          G[j] = __builtin_amdgcn_mfma_f32_16x16x32_bf16(ca[kk], bb, G[j], 0, 0, 0);
        }
      LDS_BARRIER();
      float el[4];
#pragma unroll
      for (int r = 0; r < 4; ++r) el[r] = se[16 * w + lq * 4 + r];
#pragma unroll
      for (int j = 0; j < 4; ++j) {
        const int s_ = 16 * j + lr;
        const float es = se[s_], ds = sdt[s_];
#pragma unroll
        for (int r = 0; r < 4; ++r) {
          const int l = 16 * w + lq * 4 + r;
          const bool keep = dir ? (s_ >= l) : (s_ <= l);
          const float m = keep ? G[j][r] * __expf(el[r] - es) * ds : 0.f;
          *reinterpret_cast<bf16_t*>(sBc + swz8(l, s_ >> 3) + (s_ & 7) * 2) = f2bf(m);
        }
      }
      LDS_BARRIER();
      f32x4 Y[2], Yo[2];
#pragma unroll
      for (int j = 0; j < 2; ++j) { Y[j] = f32x4{0.f, 0.f, 0.f, 0.f}; Yo[j] = f32x4{0.f, 0.f, 0.f, 0.f}; }
#pragma unroll
      for (int kk = 0; kk < 2; ++kk) {
        bf16x8 ma = *reinterpret_cast<const bf16x8*>(sBc + swz8(16 * w + lr, kk * 4 + lq));
#pragma unroll
        for (int j = 0; j < 2; ++j) {
          bf16x8 xb = *reinterpret_cast<const bf16x8*>(sXT + swz8(16 * j + lr, kk * 4 + lq));
          Y[j] = __builtin_amdgcn_mfma_f32_16x16x32_bf16(ma, xb, Y[j], 0, 0, 0);
        }
      }
#pragma unroll
      for (int kk = 0; kk < 4; ++kk)
#pragma unroll
        for (int j = 0; j < 2; ++j) {
          bf16x8 hb = *reinterpret_cast<const bf16x8*>(sHb + swz16(16 * j + lr, kk * 4 + lq));
          Yo[j] = __builtin_amdgcn_mfma_f32_16x16x32_bf16(ca[kk], hb, Yo[j], 0, 0, 0);
        }
      float syl[4];
#pragma unroll
      for (int r = 0; r < 4; ++r) syl[r] = sy[16 * w + lq * 4 + r];
#pragma unroll
      for (int j = 0; j < 2; ++j)
#pragma unroll
        for (int r = 0; r < 4; ++r) {
          const int l = 16 * w + lq * 4 + r;
          yo[(trow0 + l) * 1024 + h * 64 + ph * 32 + 16 * j + lr] = Y[j][r] + syl[r] * Yo[j][r];
        }
    }
    {
      const float dec = __expf(etot);
#pragma unroll
      for (int i = 0; i < 2; ++i)
#pragma unroll
        for (int j = 0; j < 2; ++j) H[i][j] *= dec;
#pragma unroll
      for (int kk = 0; kk < 2; ++kk) {
        const int s0 = kk * 32 + lq * 8;
        const float4 w0 = *reinterpret_cast<const float4*>(sw + s0), w1 = *reinterpret_cast<const float4*>(sw + s0 + 4);
        bf16x8 xs[2];
#pragma unroll
        for (int i = 0; i < 2; ++i) {
          const bf16x8 xa = *reinterpret_cast<const bf16x8*>(sXT + swz8(16 * i + lr, kk * 4 + lq));
          xs[i][0] = (short)f2bf(bf2f((bf16_t)xa[0]) * w0.x); xs[i][1] = (short)f2bf(bf2f((bf16_t)xa[1]) * w0.y);
          xs[i][2] = (short)f2bf(bf2f((bf16_t)xa[2]) * w0.z); xs[i][3] = (short)f2bf(bf2f((bf16_t)xa[3]) * w0.w);
          xs[i][4] = (short)f2bf(bf2f((bf16_t)xa[4]) * w1.x); xs[i][5] = (short)f2bf(bf2f((bf16_t)xa[5]) * w1.y);
          xs[i][6] = (short)f2bf(bf2f((bf16_t)xa[6]) * w1.z); xs[i][7] = (short)f2bf(bf2f((bf16_t)xa[7]) * w1.w);
        }
#pragma unroll
        for (int j = 0; j < 2; ++j) {
          const bf16x8 bt = *reinterpret_cast<const bf16x8*>(sBT + swz8(16 * (2 * w + j) + lr, kk * 4 + lq));
#pragma unroll
          for (int i = 0; i < 2; ++i) H[i][j] = __builtin_amdgcn_mfma_f32_16x16x32_bf16(xs[i], bt, H[i][j], 0, 0, 0);
        }
      }
    }
    LDS_BARRIER();
#pragma unroll
    for (int i = 0; i < 2; ++i)
#pragma unroll
      for (int j = 0; j < 2; ++j) {
        const int n = 16 * (2 * w + j) + lr;
#pragma unroll
        for (int r = 0; r < 4; ++r) {
          const int pr = 16 * i + lq * 4 + r;
          *reinterpret_cast<bf16_t*>(sHb + swz16(pr, n >> 3) + (n & 7) * 2) = f2bf(H[i][j][r]);
        }
      }
  }
#undef SSD_PREFETCH
#undef SSD_PARAMS
}

#undef LDS_BARRIER
__device__ void phase_ssd_dft(const Params& p, int bid, int nb, char* smem) {
  for (int t = bid; t < 256; t += nb) ssd_task(p, t, smem);
  int* stile = reinterpret_cast<int*>(smem + 75776);
  for (;;) {
    __syncthreads();
    if (threadIdx.x == 0) *stile = (int)atomicAdd(p.ctr, 1u);
    __syncthreads();
    const int t = *stile;
    if (t >= 4 * 8 * 8) break;
    const int b = t >> 6, tm = (t & 63) >> 3, tn = t & 7;
    const bf16_t* Fb = p.Fs + (size_t)b * 1024 * 2048;
    f32x4 accC[4][4], accS[4][4];
    gemm_mainloop(p.dftm, 2048, Fb, 2048, 1024, tm * 128, tn * 128, accC, smem);
    gemm_mainloop(p.dftm + 1024, 2048, Fb + 1024, 2048, 1024, tm * 128, tn * 128, accS, smem);
    const int lane = threadIdx.x & 63, w = threadIdx.x >> 6, wm = w >> 1, wn = w & 1;
#pragma unroll
    for (int i = 0; i < 4; ++i) {
      int lq_ = lane >> 4, lr_ = lane & 15;
      asm volatile("" : "+v"(lq_), "+v"(lr_));
#pragma unroll
      for (int j = 0; j < 4; ++j) {
        const int k0 = tm * 128 + wm * 64 + i * 16 + lq_ * 4;
        const int ch = tn * 128 + wn * 64 + j * 16 + lr_;
        const float a = bf2f(p.ABt[((size_t)b * 1024 + ch) * 4096 + 1024]);
#pragma unroll
        for (int r = 0; r < 4; ++r) {
          const int k = k0 + r;
          const float as = (k & 1) ? -a : a;
          const float c = accC[i][j][r], sn = accS[i][j][r];
          p.ycat[((size_t)b * L + k) * D + ch] = f2bf(c - sn + as);
          if (k > 0) p.ycat[((size_t)b * L + (L - k)) * D + ch] = f2bf(c + sn + as);
        }
      }
    }
  }
  for (;;) {
    __syncthreads();
    if (threadIdx.x == 0) *stile = (int)atomicAdd(p.ctr + 8, 1u);
    __syncthreads();
    const int q = *stile;
    if (q >= 1024 + 1536) break;
    if (q < 1024) convert_uv_units(p, (size_t)q * 4096, (size_t)(q + 1) * 4096);
    else if (q < 1024 + 1024) { const int q1 = q - 1024; transpose_convert_task(p.w_out, D, 0, D, p.w_out_t, q1 / 32, q1 % 32, reinterpret_cast<float*>(smem)); }
    else { const int q2 = q - 2048; transpose_convert_task(p.w_query, 1024, 0, D, p.w_q_t, q2 / 16, q2 % 16, reinterpret_cast<float*>(smem)); }
  }
}

__device__ void phase_ssm_post(const Params& p, int bid, int nb, char* smem) {
  const int lane = threadIdx.x & 63, w = threadIdx.x >> 6;
  for (int t = bid * 4 + w; t < T; t += nb * 4) {
    float y[4][4];
    float ss0 = 0.f, ss1 = 0.f;
#pragma unroll
    for (int c = 0; c < 4; ++c) {
      const int c0 = c * 256 + lane * 4;
      const int h = c0 >> 6;
      const float dsk = p.d_skip_f[h] + p.d_skip_b[h];
      const float4 a = *reinterpret_cast<const float4*>(p.yf + (size_t)t * 1024 + c0);
      const float4 bq = *reinterpret_cast<const float4*>(p.yb + (size_t)t * 1024 + c0);
      const uint2 xq = *reinterpret_cast<const uint2*>(p.act_tm + (size_t)t * DXBC + c0);
      const uint2 zz = *reinterpret_cast<const uint2*>(p.z + (size_t)t * 1024 + c0);
      y[c][0] = (a.x + bq.x + dsk * bflo(xq.x)) * silu_f(bflo(zz.x));
      y[c][1] = (a.y + bq.y + dsk * bfhi(xq.x)) * silu_f(bfhi(zz.x));
      y[c][2] = (a.z + bq.z + dsk * bflo(xq.y)) * silu_f(bflo(zz.y));
      y[c][3] = (a.w + bq.w + dsk * bfhi(xq.y)) * silu_f(bfhi(zz.y));
      const float q = y[c][0] * y[c][0] + y[c][1] * y[c][1] + y[c][2] * y[c][2] + y[c][3] * y[c][3];
      if (c < 2) ss0 += q; else ss1 += q;
    }
    ss0 = wave_sum_fast(ss0); ss1 = wave_sum_fast(ss1);
    const float r0 = rsqrtf(ss0 * (1.f / 512.f) + EPS), r1 = rsqrtf(ss1 * (1.f / 512.f) + EPS);
#pragma unroll
    for (int c = 0; c < 4; ++c) {
      const int c0 = c * 256 + lane * 4;
      const float rstd = (c < 2) ? r0 : r1;
      const float4 nw = *reinterpret_cast<const float4*>(p.ssm_norm_w + c0);
      uint2 o; o.x = pack2(y[c][0] * rstd * nw.x, y[c][1] * rstd * nw.y); o.y = pack2(y[c][2] * rstd * nw.z, y[c][3] * rstd * nw.w);
      *reinterpret_cast<uint2*>(p.ycat + (size_t)t * D + 1024 + c0) = o;
    }
  }
}

__device__ void phase_outproj(const Params& p, int bid, int nb, char* smem) {
  if ((nb & 7) == 0) {
    const int x = bid & 7, rank = bid >> 3, per = nb >> 3;
    for (int s_ = rank; s_ < 64; s_ += per) {
      EpiF32 epi{p.y_x, D};
      gemm_tile_n256(p.ycat, D, p.w_out_t, D, D, (8 * x + (s_ & 7)) * 128, (s_ >> 3) * 256, epi, smem);
    }
    return;
  }
  for (int t = bid; t < 64 * 16; t += nb) {
    EpiF32 epi{p.y_x, D};
    gemm_tile(p.ycat, D, p.w_out_t, D, D, (t >> 4) * 128, (t & 15) * 128, epi, smem);
  }
}
__device__ void phase_postmix(const Params& p, int bid, int nb, char* smem) {
  const int lane = threadIdx.x & 63, w = threadIdx.x >> 6;
  for (int t = bid * 4 + w; t < T; t += nb * 4) {
    const int b = t / L;
    float4 y[8];
    float ss = 0.f;
#pragma unroll
    for (int c = 0; c < 8; ++c) {
      y[c] = *reinterpret_cast<const float4*>(p.y_x + (size_t)t * D + c * 256 + lane * 4);
      ss += y[c].x * y[c].x + y[c].y * y[c].y + y[c].z * y[c].z + y[c].w * y[c].w;
    }
    ss = wave_sum_fast(ss);
    const float rstd = rsqrtf(ss * (1.f / D) + EPS);
    const float* gm = p.mod + (size_t)b * NMOD + 2 * D;
    float ss1 = 0.f;
#pragma unroll
    for (int c = 0; c < 8; ++c) {
      const int e0 = c * 256 + lane * 4;
      const float4 xv = *reinterpret_cast<const float4*>(p.x + (size_t)t * D + e0);
      const float4 g4 = *reinterpret_cast<const float4*>(gm + e0), gp = *reinterpret_cast<const float4*>(p.g_post_mix + e0);
      y[c].x = xv.x + g4.x * (y[c].x * rstd * gp.x); y[c].y = xv.y + g4.y * (y[c].y * rstd * gp.y);
      y[c].z = xv.z + g4.z * (y[c].z * rstd * gp.z); y[c].w = xv.w + g4.w * (y[c].w * rstd * gp.w);
      ss1 += y[c].x * y[c].x + y[c].y * y[c].y + y[c].z * y[c].z + y[c].w * y[c].w;
      *reinterpret_cast<float4*>(p.out + (size_t)t * D + e0) = y[c];
    }
    ss1 = wave_sum_fast(ss1);
    const float rstd1 = rsqrtf(ss1 * (1.f / D) + EPS);
    const float* sf = p.mod + (size_t)b * NMOD + 3 * D;
    const float* cf = p.mod + (size_t)b * NMOD + 4 * D;
#pragma unroll
    for (int c = 0; c < 8; ++c) {
      const int e0 = c * 256 + lane * 4;
      const float4 g = *reinterpret_cast<const float4*>(p.g_pre_ffn + e0);
      const float4 s4 = *reinterpret_cast<const float4*>(cf + e0), h4 = *reinterpret_cast<const float4*>(sf + e0);
      uint2 pk;
      pk.x = pack2(y[c].x * rstd1 * g.x * (1.f + s4.x) + h4.x, y[c].y * rstd1 * g.y * (1.f + s4.y) + h4.y);
      pk.y = pack2(y[c].z * rstd1 * g.z * (1.f + s4.z) + h4.z, y[c].w * rstd1 * g.w * (1.f + s4.w) + h4.w);
      *reinterpret_cast<uint2*>(p.hx + (size_t)t * D + e0) = pk;
    }
  }
}

__device__ __forceinline__ uint32_t mono_key(float f) {
  uint32_t u = __float_as_uint(f);
  return (u & 0x80000000u) ? ~u : (u | 0x80000000u);
}
__device__ __forceinline__ void ins16(uint32_t (&Lk)[16], uint32_t x) {
#pragma unroll
  for (int i = 0; i < 16; ++i) { uint32_t hi = max(Lk[i], x); x = min(Lk[i], x); Lk[i] = hi; }
}
__device__ __forceinline__ float unmono_key(uint32_t k) {
  return __uint_as_float((k & 0x80000000u) ? (k ^ 0x80000000u) : ~k);
}
typedef __attribute__((ext_vector_type(16))) float f32x16;
__device__ void phase_q_route(const Params& p, int bid, int nb, char* smem) {
  const int tid = opaque_tid(), lane = tid & 63, w = tid >> 6;
  const int wm = w >> 1, wn = w & 1, lr = lane & 15, lq = lane >> 4;
  const int l31 = lane & 31, lh = lane >> 5;
  for (int tile0 = bid; tile0 < 512; tile0 += nb) {
    const int tile = ((nb & 7) == 0 && nb >= 512) ? (((tile0 & 7) * 8 + ((tile0 >> 3) & 7)) * 8 + (tile0 >> 6)) : tile0;
    const int h = tile & 7, m0 = (tile >> 3) * 128;
    {
      f32x4 acc[4][4];
      gemm_mainloop(p.hx, D, p.w_q_t, D, D, m0, h * 128, acc, smem);
#pragma unroll
      for (int i = 0; i < 4; ++i)
#pragma unroll
        for (int j = 0; j < 4; ++j)
#pragma unroll
          for (int r = 0; r < 4; ++r) {
            const int row = wm * 64 + i * 16 + lq * 4 + r, col = wn * 64 + j * 16 + lr;
            *reinterpret_cast<bf16_t*>(smem + swz16(row, col >> 3) + (col & 7) * 2) = f2bf(acc[i][j][r]);
          }
    }
#pragma unroll 4
    for (int r = 0; r < 16; ++r) {
      const int id = tid + 256 * r, row = id >> 4, c4 = id & 15;
      const float* src = ((row < 128) ? p.sk1 : p.sk2) + ((size_t)(h * 128 + (row & 127)) * 64 + c4 * 4);
      const float4 v = *reinterpret_cast<const float4*>(src);
      uint2 pk; pk.x = pack2(v.x, v.y); pk.y = pack2(v.z, v.w);
      *reinterpret_cast<uint2*>(smem + 32768 + swz8(row, c4 >> 1) + (c4 & 1) * 8) = pk;
    }
    __syncthreads();
    uint32_t L1[16], L2[16];
#pragma unroll
    for (int sd = 0; sd < 2; ++sd) {
      uint32_t Lk[16];
#pragma unroll
      for (int i = 0; i < 16; ++i) Lk[i] = 0u;
      const uint32_t kb = (uint32_t)(lh * 4);
#pragma unroll
      for (int ih = 0; ih < 2; ++ih) {
        f32x16 Sa[2];
#pragma unroll
        for (int i = 0; i < 2; ++i)
#pragma unroll
          for (int g2 = 0; g2 < 16; ++g2) Sa[i][g2] = 0.f;
#pragma unroll
        for (int ks = 0; ks < 4; ++ks) {
          const bf16x8 qb = *reinterpret_cast<const bf16x8*>(smem + swz16(w * 32 + l31, sd * 8 + ks * 2 + lh));
#pragma unroll
          for (int i = 0; i < 2; ++i) {
            const bf16x8 ka = *reinterpret_cast<const bf16x8*>(smem + 32768 + swz8(sd * 128 + (ih * 2 + i) * 32 + l31, ks * 2 + lh));
            Sa[i] = __builtin_amdgcn_mfma_f32_32x32x16_bf16(ka, qb, Sa[i], 0, 0, 0);
          }
        }
#pragma unroll
        for (int i = 0; i < 2; ++i)
#pragma unroll
          for (int g2 = 0; g2 < 16; ++g2)
            ins16(Lk, (mono_key(Sa[i][g2]) & ~0x7Fu) | (uint32_t)((ih * 2 + i) * 32 + (g2 & 3) + 8 * (g2 >> 2)) | kb);
      }
#pragma unroll
      for (int i = 0; i < 8; ++i) {
        const uint32_t t1 = (uint32_t)__shfl_xor((int)Lk[15 - i], 32), t2 = (uint32_t)__shfl_xor((int)Lk[i], 32);
        Lk[i] = max(Lk[i], t1); Lk[15 - i] = max(Lk[15 - i], t2);
      }
#pragma unroll
      for (int dd = 8; dd >= 1; dd >>= 1)
#pragma unroll
        for (int i = 0; i < 16; ++i)
          if ((i & dd) == 0) { const uint32_t hi = max(Lk[i], Lk[i + dd]), lo = min(Lk[i], Lk[i + dd]); Lk[i] = hi; Lk[i + dd] = lo; }
#pragma unroll
      for (int r = 0; r < 16; ++r) { if (sd == 0) L1[r] = Lk[r]; else L2[r] = Lk[r]; }
    }
    __syncthreads();
    uint32_t* ib = reinterpret_cast<uint32_t*>(smem) + w * 1088 + l31 * 34;
    if (lh == 0) {
#pragma unroll
      for (int r = 0; r < 16; ++r) { ib[r] = L1[r] & 127u; ib[16 + r] = L2[r] & 127u; }
    }
    float v1[16], v2[16];
#pragma unroll
    for (int r = 0; r < 16; ++r) { v1[r] = unmono_key(L1[r] & ~0x7Fu); v2[r] = unmono_key(L2[r] & ~0x7Fu); }
    uint32_t C[16];
#pragma unroll
    for (int i = 0; i < 16; ++i) C[i] = 0u;
#pragma unroll
    for (int a = 0; a < 16; ++a)
#pragma unroll
      for (int bq = 0; bq < 16; ++bq)
        if ((a + 1) * (bq + 1) <= 16) ins16(C, (mono_key(v1[a] + v2[bq]) & ~0xFFu) | (uint32_t)(a * 16 + bq));
    float ts[16]; int te[16];
    __builtin_amdgcn_wave_barrier();
#pragma unroll
    for (int r = 0; r < 16; ++r) {
      const uint32_t code = C[r] & 0xFFu;
      te[r] = (int)(ib[code >> 4] * 128u + ib[16 + (code & 15u)]);
      ts[r] = unmono_key(C[r] & ~0xFFu);
    }
    const float mx = ts[0];
    float den = 0.f;
#pragma unroll
    for (int r = 0; r < 16; ++r) { ts[r] = __expf(ts[r] - mx); den += ts[r]; }
    const float inv = 1.f / den;
    const size_t ob = (size_t)(m0 + w * 32 + l31) * 128 + h * 16;
    if (lh == 0) {
#pragma unroll
      for (int r = 0; r < 16; r += 4) *reinterpret_cast<int4*>(p.idx + ob + r) = int4{te[r], te[r + 1], te[r + 2], te[r + 3]};
    } else {
#pragma unroll
      for (int r = 0; r < 16; r += 4)
        *reinterpret_cast<float4*>(p.gate + ob + r) = float4{ts[r] * inv, ts[r + 1] * inv, ts[r + 2] * inv, ts[r + 3] * inv};
    }
    __syncthreads();
  }
}

typedef __attribute__((ext_vector_type(2))) float f32x2;
__device__ __forceinline__ void fp8x16_to_f32(const uint4 q, f32x2 (&o)[8]) {
  o[0] = __builtin_amdgcn_cvt_pk_f32_fp8((int)q.x, false); o[1] = __builtin_amdgcn_cvt_pk_f32_fp8((int)q.x, true);
  o[2] = __builtin_amdgcn_cvt_pk_f32_fp8((int)q.y, false); o[3] = __builtin_amdgcn_cvt_pk_f32_fp8((int)q.y, true);
  o[4] = __builtin_amdgcn_cvt_pk_f32_fp8((int)q.z, false); o[5] = __builtin_amdgcn_cvt_pk_f32_fp8((int)q.z, true);
  o[6] = __builtin_amdgcn_cvt_pk_f32_fp8((int)q.w, false); o[7] = __builtin_amdgcn_cvt_pk_f32_fp8((int)q.w, true);
}
__device__ __forceinline__ unsigned my_xcc_id() { return (unsigned)__builtin_amdgcn_s_getreg((3 << 11) | 20) & 7u; }

__device__ void phase_exp_u(const Params& p, char* smem) {
  const int tid = opaque_tid(), lane = tid & 63, w = tid >> 6;
  const int sub = lane >> 4, cc = lane & 15;
  const unsigned myx = my_xcc_id();
  int* sh = reinterpret_cast<int*>(smem);
  int* si = reinterpret_cast<int*>(smem + 64) + w * 256;
  float* pbuf = reinterpret_cast<float*>(p.ycat);
  {
    unsigned qcur = 0;
    for (;;) {
      __syncthreads();
      if (tid == 0) {
        int found = -1; unsigned fx = 0;
        for (; qcur < 8; ++qcur) {
          fx = (myx + qcur) & 7u;
          const int c = (int)atomicAdd(&p.ctr[16 + fx], 1u);
          if (c < 256) { found = c; break; }
        }
        sh[0] = found; sh[1] = (int)fx;
      }
      __syncthreads();
      const int chunk = sh[0];
      const unsigned x = (unsigned)sh[1];
      if (chunk < 0) break;
      for (int tt = 0; tt < 8; ++tt) {
        const int t = chunk * 32 + w * 8 + tt;
        __builtin_amdgcn_wave_barrier();
        si[lane] = p.idx[(size_t)t * 128 + lane]; si[64 + lane] = p.idx[(size_t)t * 128 + 64 + lane];
        __builtin_amdgcn_wave_barrier();
        f32x2 hf[8];
#pragma unroll
        for (int q2 = 0; q2 < 2; ++q2) {
          const uint4 hq = *reinterpret_cast<const uint4*>(p.hx + (size_t)t * D + x * 256 + cc * 16 + q2 * 8);
          hf[q2 * 4 + 0] = f32x2{bflo(hq.x), bfhi(hq.x)}; hf[q2 * 4 + 1] = f32x2{bflo(hq.y), bfhi(hq.y)};
          hf[q2 * 4 + 2] = f32x2{bflo(hq.z), bfhi(hq.z)}; hf[q2 * 4 + 3] = f32x2{bflo(hq.w), bfhi(hq.w)};
        }
        const uint8_t* ub = p.U8 + x * 256 + cc * 16;
        uint4 qa[8], qb[8];
#define EU_LOAD(q_, bt_) _Pragma("unroll") for (int k = 0; k < 8; ++k) q_[k] = *reinterpret_cast<const uint4*>(ub + (size_t)si[((bt_) * 8 + k) * 4 + sub] * D)
#define EU_COMP(q_, kb_)                                                                                                \
  _Pragma("unroll") for (int k = 0; k < 8; ++k) {                                                                       \
    f32x2 uf[8];                                                                                                        \
    fp8x16_to_f32(q_[k], uf);                                                                                           \
    f32x2 d2 = hf[0] * uf[0];                                                                                           \
    _Pragma("unroll") for (int e = 1; e < 8; ++e) d2 += hf[e] * uf[e];                                                  \
    float d = d2.x + d2.y;                                                                                              \
    d += dpp_mov<0xB1>(d); d += dpp_mov<0x4E>(d); d += dpp_mov<0x124>(d); d += dpp_mov<0x128>(d);                       \
    mine = (cc == (kb_) + k) ? d : mine;                                                                                \
  }
        float mine = 0.f;
        EU_LOAD(qa, 0); EU_LOAD(qb, 1);
        EU_COMP(qa, 0); EU_LOAD(qa, 2);
        EU_COMP(qb, 8); EU_LOAD(qb, 3);
        pbuf[((size_t)x * T + t) * 128 + cc * 4 + sub] = mine * (1.f / 512.f);
        mine = 0.f;
        EU_COMP(qa, 0);
        EU_COMP(qb, 8);
        pbuf[((size_t)x * T + t) * 128 + (16 + cc) * 4 + sub] = mine * (1.f / 512.f);
#undef EU_LOAD
#undef EU_COMP
      }
    }
  }
}

__device__ void phase_exp_v(const Params& p, char* smem) {
  const int tid = opaque_tid(), lane = tid & 63, w = tid >> 6;
  const int sub = lane >> 4, cc = lane & 15;
  const unsigned myx = my_xcc_id();
  int* sh = reinterpret_cast<int*>(smem);
  int* si = reinterpret_cast<int*>(smem + 64) + w * 256;
  float* sc = reinterpret_cast<float*>(si + 128);
  float* yf = p.y_x;
  {
    unsigned qcur = 0;
    for (;;) {
      __syncthreads();
      if (tid == 0) {
        int found = -1; unsigned fx = 0;
        for (; qcur < 8; ++qcur) {
          fx = (myx + qcur) & 7u;
          const int c = (int)atomicAdd(&p.ctr[32 + fx], 1u);
          if (c < 256) { found = c; break; }
        }
        sh[0] = found; sh[1] = (int)fx;
      }
      __syncthreads();
      const int chunk = sh[0];
      const unsigned x = (unsigned)sh[1];
      if (chunk < 0) break;
      for (int tt = 0; tt < 8; ++tt) {
        const int t = chunk * 32 + w * 8 + tt;
        __builtin_amdgcn_wave_barrier();
        si[lane] = p.idx[(size_t)t * 128 + lane]; si[64 + lane] = p.idx[(size_t)t * 128 + 64 + lane];
        {
          const float* pb = reinterpret_cast<const float*>(p.ycat) + (size_t)t * 128;
          float d0 = 0.f, d1 = 0.f;
#pragma unroll
          for (int xs = 0; xs < 8; ++xs) { d0 += pb[(size_t)xs * T * 128 + lane]; d1 += pb[(size_t)xs * T * 128 + 64 + lane]; }
          sc[lane] = p.gate[(size_t)t * 128 + lane] * 0.5f * d0 * (1.f + erff(d0 * 0.70710678118654752f));
          sc[64 + lane] = p.gate[(size_t)t * 128 + 64 + lane] * 0.5f * d1 * (1.f + erff(d1 * 0.70710678118654752f));
        }
        __builtin_amdgcn_wave_barrier();
        f32x2 acc[8];
#pragma unroll
        for (int e = 0; e < 8; ++e) acc[e] = f32x2{0.f, 0.f};
        const uint8_t* vb = p.V8 + x * 256 + cc * 16;
        uint4 qa[8], qb[8];
#define EV_LOAD(q_, bt_) _Pragma("unroll") for (int k = 0; k < 8; ++k) q_[k] = *reinterpret_cast<const uint4*>(vb + (size_t)si[((bt_) * 8 + k) * 4 + sub] * D)
#define EV_COMP(q_, bt_)                                                                                                \
  _Pragma("unroll") for (int k = 0; k < 8; ++k) {                                                                       \
    f32x2 vf[8];                                                                                                        \
    fp8x16_to_f32(q_[k], vf);                                                                                           \
    const float cfk = sc[((bt_) * 8 + k) * 4 + sub];                                                                    \
    const f32x2 c2 = f32x2{cfk, cfk};                                                                                   \
    _Pragma("unroll") for (int e = 0; e < 8; ++e) acc[e] += c2 * vf[e];                                                 \
  }
        EV_LOAD(qa, 0); EV_LOAD(qb, 1);
        EV_COMP(qa, 0); EV_LOAD(qa, 2);
        EV_COMP(qb, 1); EV_LOAD(qb, 3);
        EV_COMP(qa, 2);
        EV_COMP(qb, 3);
#undef EV_LOAD
#undef EV_COMP
        {
          float* red = reinterpret_cast<float*>(smem + 8192) + w * 1280;
          float* mr = red + (sub * 16 + cc) * 20;
#pragma unroll
          for (int q4 = 0; q4 < 4; ++q4)
            *reinterpret_cast<float4*>(mr + q4 * 4) = float4{acc[q4 * 2].x, acc[q4 * 2].y, acc[q4 * 2 + 1].x, acc[q4 * 2 + 1].y};
          __builtin_amdgcn_wave_barrier();
          const int part = sub;
          float4 r0 = *reinterpret_cast<const float4*>(red + (0 * 16 + cc) * 20 + part * 4);
          float4 r1 = *reinterpret_cast<const float4*>(red + (1 * 16 + cc) * 20 + part * 4);
          float4 r2 = *reinterpret_cast<const float4*>(red + (2 * 16 + cc) * 20 + part * 4);
          float4 r3 = *reinterpret_cast<const float4*>(red + (3 * 16 + cc) * 20 + part * 4);
          const float sc512 = 1.f / 512.f;
          float4 o4 = float4{(r0.x + r1.x + r2.x + r3.x) * sc512, (r0.y + r1.y + r2.y + r3.y) * sc512,
                             (r0.z + r1.z + r2.z + r3.z) * sc512, (r0.w + r1.w + r2.w + r3.w) * sc512};
          *reinterpret_cast<float4*>(yf + (size_t)t * D + x * 256 + cc * 16 + part * 4) = o4;
          __builtin_amdgcn_wave_barrier();
        }
      }
    }
  }
}

__device__ void phase_exp_final(const Params& p, int bid, int nb, char* smem) {
  const int lane = threadIdx.x & 63, w = threadIdx.x >> 6;
  const float* yf = p.y_x;
  for (int t = bid * 4 + w; t < T; t += nb * 4) {
    const int b = t / L;
    float4 y[8];
    float ss = 0.f;
#pragma unroll
    for (int c = 0; c < 8; ++c) {
      y[c] = *reinterpret_cast<const float4*>(yf + (size_t)t * D + c * 256 + lane * 4);
      ss += y[c].x * y[c].x + y[c].y * y[c].y + y[c].z * y[c].z + y[c].w * y[c].w;
    }
    ss = wave_sum_fast(ss);
    const float rstd = rsqrtf(ss * (1.f / D) + EPS);
    const float* gfx = p.mod + (size_t)b * NMOD + 5 * D;
#pragma unroll
    for (int c = 0; c < 8; ++c) {
      const int e0 = c * 256 + lane * 4;
      float* o = p.out + (size_t)t * D + e0;
      float4 xo = *reinterpret_cast<const float4*>(o);
      const float4 g4 = *reinterpret_cast<const float4*>(gfx + e0), gp = *reinterpret_cast<const float4*>(p.g_post_ffn + e0);
      xo.x += g4.x * (y[c].x * rstd * gp.x); xo.y += g4.y * (y[c].y * rstd * gp.y);
      xo.z += g4.z * (y[c].z * rstd * gp.z); xo.w += g4.w * (y[c].w * rstd * gp.w);
      *reinterpret_cast<float4*>(o) = xo;
    }
  }
}

#define XB_TMO      128
#define XB_XCNT(j)  (256  + 64 * (j))
#define XB_XSUB(j)  (1280 + 64 * (j))
#define XB_XGEN(j)  (2304 + 64 * (j))
#define XB_TOP      3328
#define XB_TOPGEN   3392
#define XCD_BAR_WORDS 3456
#define XB_SPIN_CAP (1u << 22)
#define LAS __attribute__((address_space(3)))
__device__ __forceinline__ unsigned xb_ld(unsigned* p)              { return __hip_atomic_load(p, __ATOMIC_RELAXED, __HIP_MEMORY_SCOPE_AGENT); }
__device__ __forceinline__ unsigned xb_add(unsigned* p, unsigned v) { return __hip_atomic_fetch_add(p, v, __ATOMIC_RELAXED, __HIP_MEMORY_SCOPE_AGENT); }
__device__ __forceinline__ unsigned xb_xcc_id() { return (unsigned)__builtin_amdgcn_s_getreg((3 << 11) | 20) & 0xFu; }
#define XB_SPIN(cond, bar) do { unsigned _sp = 0; while (cond) { __builtin_amdgcn_s_sleep(1); \
    if ((++_sp & 255u) == 0u) { if (xb_ld(&(bar)[XB_TMO])) break; if (_sp > XB_SPIN_CAP) { atomicAdd(&(bar)[XB_TMO], 1u); break; } } } } while (0)
struct XcdBarrier { unsigned* bar; unsigned x; volatile LAS unsigned* st; };
__device__ __forceinline__ XcdBarrier xcd_barrier_post(unsigned* bar, volatile LAS unsigned* st) {
  XcdBarrier b; b.bar = bar; b.x = xb_xcc_id(); b.st = st;
  if (threadIdx.x == 0) (void)xb_add(&bar[XB_XCNT(b.x)], 1u);
  return b;
}
__device__ __forceinline__ void xcd_barrier_complete(unsigned* bar, unsigned x, unsigned& nloc, unsigned& nx) {
  const unsigned G = gridDim.x * gridDim.y * gridDim.z;
  unsigned sum, cnt, mine, sp = 0u;
  for (;;) {
    sum = 0u; cnt = 0u; mine = 0u;
#pragma unroll
    for (unsigned j = 0; j < 16; ++j) { const unsigned c = xb_ld(&bar[XB_XCNT(j)]); sum += c; cnt += (c > 0u) ? 1u : 0u; mine = (j == x) ? c : mine; }
    if (sum == G) break;
    __builtin_amdgcn_s_sleep(1);
    if ((++sp & 255u) == 0u) { if (xb_ld(&bar[XB_TMO])) break; if (sp > XB_SPIN_CAP) { atomicAdd(&bar[XB_TMO], 1u); break; } }
  }
  nloc = mine > 0u ? mine : 1u; nx = cnt > 0u ? cnt : 1u;
}
__device__ __forceinline__ void xcd_barrier(const XcdBarrier& b) {
  asm volatile("s_waitcnt vmcnt(0)" ::: "memory");
  __syncthreads();
  if (threadIdx.x == 0) {
    unsigned* bar = b.bar;
    __builtin_amdgcn_s_waitcnt(0);
    unsigned nloc = b.st[0], nx = b.st[1];
    if (nloc == 0u) { xcd_barrier_complete(bar, b.x, nloc, nx); b.st[0] = nloc; b.st[1] = nx; }
    const unsigned old = xb_add(&bar[XB_XSUB(b.x)], 1u);
    const unsigned gen = old / nloc;
    if (old + 1u == (gen + 1u) * nloc) {
      __builtin_amdgcn_fence(__ATOMIC_RELEASE, "agent");
      asm volatile("s_waitcnt vmcnt(0)" ::: "memory");
      const unsigned og = xb_add(&bar[XB_TOP], 1u);
      const unsigned tg = og / nx;
      if (og + 1u == (tg + 1u) * nx) xb_add(&bar[XB_TOPGEN], 1u);
      else XB_SPIN(xb_ld(&bar[XB_TOPGEN]) == tg, bar);
      __builtin_amdgcn_fence(__ATOMIC_ACQUIRE, "agent");
      xb_add(&bar[XB_XGEN(b.x)], 1u);
      asm volatile("s_waitcnt vmcnt(0)" ::: "memory");
    } else {
      XB_SPIN(xb_ld(&bar[XB_XGEN(b.x)]) == gen, bar);
      __builtin_amdgcn_fence(__ATOMIC_ACQUIRE, "agent");
      asm volatile("s_waitcnt vmcnt(0)" ::: "memory");
    }
  }
  __syncthreads();
}

__global__ void __launch_bounds__(NTHREADS, 2) fwd_mega(Params p) {
  __shared__ __attribute__((aligned(16))) char smem[75808];
  const int bid = blockIdx.x, nb = gridDim.x;
  volatile LAS unsigned* st = (volatile LAS unsigned*)(smem + 75792);
  if (threadIdx.x == 0) { st[0] = 0u; st[1] = 0u; }
  __syncthreads();
  const XcdBarrier bar = xcd_barrier_post(p.bar, st);
  phase_prep(p, bid, nb, smem);        xcd_barrier(bar);
  phase_fold(p, bid, nb, smem);        xcd_barrier(bar);
  phase_norm_mod(p, bid, nb, smem);    xcd_barrier(bar);
  phase_inproj(p, bid, nb, smem);      xcd_barrier(bar);
  phase_ssm_pre(p, bid, nb, smem);     xcd_barrier(bar);
  phase_ssd_dft(p, bid, nb, smem);     xcd_barrier(bar);
  phase_ssm_post(p, bid, nb, smem);    xcd_barrier(bar);
  phase_outproj(p, bid, nb, smem);     xcd_barrier(bar);
  phase_postmix(p, bid, nb, smem);     xcd_barrier(bar);
  phase_q_route(p, bid, nb, smem);     xcd_barrier(bar);
  phase_exp_u(p, smem);                xcd_barrier(bar);
  phase_exp_v(p, smem);                xcd_barrier(bar);
  phase_exp_final(p, bid, nb, smem);
}

}

extern "C" void kernel_launch(void* const* d_in, const int* in_sizes, int n_in, void* d_out, int out_size, void* d_ws,
                              size_t ws_size, hipStream_t stream) {
  Params p{};
  const float** fp = reinterpret_cast<const float**>(&p);
  for (int i = 0; i < 27; ++i) fp[i] = (const float*)d_in[i];
  p.out = (float*)d_out;
  char* ws = (char*)d_ws;
  size_t off = 0;
  auto take = [&](size_t bytes) { char* r = ws + off; off += (bytes + 255) & ~(size_t)255; return r; };
  p.U8 = (uint8_t*)take((size_t)16384 * D);
  p.V8 = (uint8_t*)take((size_t)16384 * D);
  p.w_in_t = (bf16_t*)take((size_t)NPROJ * D * 2);
  p.w_out_t = (bf16_t*)take((size_t)D * D * 2);
  p.w_q_t = (bf16_t*)take((size_t)1024 * D * 2);
  p.w_in_f = (bf16_t*)take((size_t)D * 1024 * 2);
  p.WcsT = (bf16_t*)take((size_t)4 * 512 * 256 * 2);
  p.dftm = (bf16_t*)take((size_t)1024 * 2048 * 2);
  p.Fs = (bf16_t*)take((size_t)NB * 1024 * 2048 * 2);
  p.partial = (float*)take((size_t)KSPLIT * 5 * NMOD * 4);
  p.mod = (float*)take((size_t)5 * NMOD * 4);
  p.hx = (bf16_t*)take((size_t)T * D * 2);
  p.hc = (bf16_t*)take((size_t)TC * D * 2);
  p.ABt = (bf16_t*)take((size_t)NB * 1024 * 4096 * 2);
  p.q = (float*)p.ABt;
  p.z = (bf16_t*)take((size_t)T * 1024 * 2);
  char* r1 = take(0);
  p.xbcraw = (float*)take((size_t)T * DXBC * 4);
  p.xbcraw_c = (float*)take((size_t)TC * DXBC * 4);
  p.act_tm = (bf16_t*)take((size_t)(T + TC) * DXBC * 2);
  p.act_cm_x = (bf16_t*)take((size_t)NB * 1280 * L * 2);
  p.act_cm_c = (bf16_t*)take((size_t)NB * 1280 * CTX * 2);
  p.y_x = (float*)r1;
  p.dtraw = (float*)take((size_t)T * 32 * 4);
  p.dtraw_c = (float*)take((size_t)TC * 32 * 4);
  p.dtf = (float*)take((size_t)T * 16 * 4);
  p.dtb = (float*)take((size_t)T * 16 * 4);
  p.dtf_c = (float*)take((size_t)TC * 16 * 4);
  p.dtb_c = (float*)take((size_t)TC * 16 * 4);
  p.yf = (float*)take((size_t)T * 1024 * 4);
  p.yb = (float*)take((size_t)T * 1024 * 4);
  p.ctr = (unsigned*)take(256);
  p.bar = (unsigned*)take((size_t)XCD_BAR_WORDS * 4);
  p.ycat = (bf16_t*)take((size_t)T * D * 2);
  p.idx = (int*)take((size_t)T * 128 * 4);
  p.gate = (float*)take((size_t)T * 128 * 4);
  if (off > ws_size) { fprintf(stderr, "kernel_launch: workspace too small: need %zu have %zu\n", off, ws_size); return; }
  static int grid_blocks = 0;
  if (!grid_blocks) {
    int dev = 0, cus = 0, per_cu = 0;
    hipGetDevice(&dev);
    hipDeviceGetAttribute(&cus, hipDeviceAttributeMultiprocessorCount, dev);
    hipOccupancyMaxActiveBlocksPerMultiprocessor(&per_cu, fwd_mega, NTHREADS, 0);
    if (per_cu > 2) per_cu = 2;
    grid_blocks = cus * per_cu;
    if (grid_blocks <= 0) { fprintf(stderr, "kernel_launch: occupancy query gave %d x %d\n", cus, per_cu); grid_blocks = -1; }
  }
  if (grid_blocks < 0) return;
  (void)hipMemsetAsync(p.bar, 0, (size_t)XCD_BAR_WORDS * 4, stream);
  void* args[] = {&p};
  hipError_t e = hipLaunchCooperativeKernel((void*)fwd_mega, dim3(grid_blocks), dim3(NTHREADS), args, 0, stream);
  if (e != hipSuccess) fprintf(stderr, "cooperative launch failed: %s (grid %d)\n", hipGetErrorString(e), grid_blocks);
}
```

```cpp
#include <hip/hip_runtime.h>
#include <hip/hip_cooperative_groups.h>
#include <stdint.h>
#include <stdio.h>

namespace cg = cooperative_groups;
namespace {

typedef __attribute__((ext_vector_type(8))) short bf16x8;
typedef __attribute__((ext_vector_type(4))) float f32x4;
typedef unsigned short bf16_t;

constexpr int D = 2048, NB = 4, L = 2048, T = NB * L, CTX = 256, TC = NB * CTX;
constexpr int NMOD = 6 * D;
constexpr int NH = 16, HP = 64, NS = 128, DXBC = 1536;
constexpr int DIN = 3616;
constexpr int NPROJ = 4736;
constexpr int KSPLIT = 32;
constexpr float EPS = 1e-6f;
constexpr int NTHREADS = 256;

__device__ __forceinline__ bf16_t f2bf(float f) { __bf16 h = (__bf16)f; return __builtin_bit_cast(unsigned short, h); }
__device__ __forceinline__ float bf2f(bf16_t h) { return __uint_as_float(((uint32_t)h) << 16); }
__device__ __forceinline__ uint32_t pack2(float a, float b) {
  typedef __attribute__((ext_vector_type(2))) __bf16 bf16x2_t;
  typedef __attribute__((ext_vector_type(2))) float f32x2_t;
  const f32x2_t v = {a, b};
  return __builtin_bit_cast(uint32_t, __builtin_convertvector(v, bf16x2_t));
}
__device__ __forceinline__ float bflo(uint32_t w) { return __uint_as_float(w << 16); }
__device__ __forceinline__ float bfhi(uint32_t w) { return __uint_as_float(w & 0xffff0000u); }
__device__ __forceinline__ float silu_f(float v) { return v / (1.f + __expf(-v)); }
__device__ __forceinline__ float softplus_f(float v) { return v > 20.f ? v : log1pf(__expf(v)); }

__device__ __forceinline__ int opaque_tid() { int t = threadIdx.x; asm volatile("" : "+v"(t)); return t; }
__device__ __forceinline__ float wave_sum(float v) {
#pragma unroll
  for (int o = 32; o > 0; o >>= 1) v += __shfl_xor(v, o);
  return v;
}
template <int CTRL>
__device__ __forceinline__ float dpp_mov(float v) {
  return __int_as_float(__builtin_amdgcn_update_dpp(0, __float_as_int(v), CTRL, 0xF, 0xF, true));
}
__device__ __forceinline__ float wave_sum_fast(float v) {
  v += dpp_mov<0xB1>(v); v += dpp_mov<0x4E>(v); v += dpp_mov<0x124>(v); v += dpp_mov<0x128>(v);
  v += __shfl_xor(v, 16); v += __shfl_xor(v, 32);
  return v;
}
__device__ __forceinline__ float wave_max(float v) {
#pragma unroll
  for (int o = 32; o > 0; o >>= 1) v = fmaxf(v, __shfl_xor(v, o));
  return v;
}
__device__ __forceinline__ float block_sum(float v, float* red) {
  v = wave_sum(v);
  __syncthreads();
  if ((threadIdx.x & 63) == 0) red[threadIdx.x >> 6] = v;
  __syncthreads();
  return red[0] + red[1] + red[2] + red[3];
}

struct Params {
  const float *x, *c, *ctx, *c_ctx, *w_mod, *b_mod, *g_pre_mix, *g_post_mix, *g_pre_ffn, *g_post_ffn;
  const float *w_in, *w_fmix, *conv_w, *conv_b, *dt_bias_f, *dt_bias_b, *a_log_f, *a_log_b, *d_skip_f, *d_skip_b;
  const float *ssm_norm_w, *w_out, *w_query, *sk1, *sk2, *eu, *ev;
  float* out;
  uint8_t *U8, *V8;
  bf16_t *w_in_t, *w_out_t, *w_q_t, *w_in_f, *WcsT, *dftm, *Fs;
  float *partial, *mod;
  bf16_t *hx, *hc, *ABt, *z;
  float *xbcraw, *xbcraw_c, *dtraw, *dtraw_c, *dtf, *dtb, *dtf_c, *dtb_c;
  bf16_t *act_tm, *act_cm_x, *act_cm_c;
  float *yf, *yb;
  unsigned* ctr; unsigned* bar;
  bf16_t* ycat;
  float *y_x, *q, *gate;
  int* idx;
  int pad0, pad1;
};

__device__ __forceinline__ void gemm_mainloop(const bf16_t* __restrict__ A, int lda, const bf16_t* __restrict__ Bt, int ldb,
                                              int K, int m0, int n0, f32x4 (&acc)[4][4], char* smem) {
  const int tid = opaque_tid(), lane = tid & 63, w = tid >> 6;
  const int wm = w >> 1, wn = w & 1;
#pragma unroll
  for (int i = 0; i < 4; ++i)
#pragma unroll
    for (int j = 0; j < 4; ++j) acc[i][j] = f32x4{0.f, 0.f, 0.f, 0.f};

  const int nk = K / 64;
  const int rowoff = lane >> 3, lch = (lane & 7) ^ rowoff;
  const bf16_t* gA = A + (size_t)(m0 + w * 8 + rowoff) * lda + lch * 8;
  const bf16_t* gB = Bt + (size_t)(n0 + w * 8 + rowoff) * ldb + lch * 8;
#define GSTAGE(buf_, kt_)                                                                                               \
  do {                                                                                                                  \
    _Pragma("unroll") for (int i_ = 0; i_ < 4; ++i_) {                                                                  \
      __builtin_amdgcn_global_load_lds((const unsigned*)(gA + (size_t)(i_ * 32) * lda + (kt_) * 64),                    \
                                       (unsigned*)(smem + (buf_) * 32768 + (i_ * 4 + w) * 1024), 16, 0, 0);             \
      __builtin_amdgcn_global_load_lds((const unsigned*)(gB + (size_t)(i_ * 32) * ldb + (kt_) * 64),                    \
                                       (unsigned*)(smem + (buf_) * 32768 + 16384 + (i_ * 4 + w) * 1024), 16, 0, 0);     \
    }                                                                                                                   \
  } while (0)
  GSTAGE(0, 0);
  asm volatile("s_waitcnt vmcnt(0)" ::: "memory");
  __syncthreads();
  for (int kt = 0; kt < nk; ++kt) {
    const int cur = kt & 1;
    if (kt + 1 < nk) GSTAGE(cur ^ 1, kt + 1);
    const char* sA = smem + cur * 32768;
    const char* sB = sA + 16384;
#pragma unroll
    for (int kk = 0; kk < 2; ++kk) {
      bf16x8 af[4], bfr[4];
      const int ch = kk * 4 + (lane >> 4);
#pragma unroll
      for (int i = 0; i < 4; ++i) {
        int row = wm * 64 + i * 16 + (lane & 15);
        af[i] = *reinterpret_cast<const bf16x8*>(sA + row * 128 + ((ch ^ (row & 7)) << 4));
        int col = wn * 64 + i * 16 + (lane & 15);
        bfr[i] = *reinterpret_cast<const bf16x8*>(sB + col * 128 + ((ch ^ (col & 7)) << 4));
      }
#pragma unroll
      for (int i = 0; i < 4; ++i)
#pragma unroll
        for (int j = 0; j < 4; ++j) acc[i][j] = __builtin_amdgcn_mfma_f32_16x16x32_bf16(af[i], bfr[j], acc[i][j], 0, 0, 0);
    }
    asm volatile("s_waitcnt vmcnt(0)" ::: "memory");
    __syncthreads();
  }
#undef GSTAGE
}

template <class Epi>
__device__ __forceinline__ void gemm_tile(const bf16_t* __restrict__ A, int lda, const bf16_t* __restrict__ Bt, int ldb,
                                          int K, int m0, int n0, const Epi& epi, char* smem) {
  const int lane = threadIdx.x & 63, w = threadIdx.x >> 6;
  const int wm = w >> 1, wn = w & 1;
  f32x4 acc[4][4];
  gemm_mainloop(A, lda, Bt, ldb, K, m0, n0, acc, smem);
#pragma unroll
  for (int i = 0; i < 4; ++i)
#pragma unroll
    for (int j = 0; j < 4; ++j) {
      int row = m0 + wm * 64 + i * 16 + (lane >> 4) * 4;
      int col = n0 + wn * 64 + j * 16 + (lane & 15);
      epi(row, col, acc[i][j]);
    }
}

__device__ __forceinline__ void gemm_mainloop_n256(const bf16_t* __restrict__ A, int lda, const bf16_t* __restrict__ Bt, int ldb,
                                                   int K, int m0, int n0, f32x4 (&acc)[4][8], char* smem) {
  const int tid = opaque_tid(), lane = tid & 63, w = tid >> 6;
  const int wm = w >> 1, wn = w & 1;
#pragma unroll
  for (int i = 0; i < 4; ++i)
#pragma unroll
    for (int j = 0; j < 8; ++j) acc[i][j] = f32x4{0.f, 0.f, 0.f, 0.f};
  const int nk = K / 64;
  const int rowoff = lane >> 3, lch = (lane & 7) ^ rowoff;
  const bf16_t* gA = A + (size_t)(m0 + w * 8 + rowoff) * lda + lch * 8;
  const bf16_t* gB = Bt + (size_t)(n0 + w * 8 + rowoff) * ldb + lch * 8;
  const int fr = lane & 15, fq = lane >> 4;
  for (int kt = 0; kt < nk; ++kt) {
#pragma unroll
    for (int i_ = 0; i_ < 4; ++i_)
      __builtin_amdgcn_global_load_lds((const unsigned*)(gA + (size_t)(i_ * 32) * lda + kt * 64),
                                       (unsigned*)(smem + (i_ * 4 + w) * 1024), 16, 0, 0);
#pragma unroll
    for (int i_ = 0; i_ < 8; ++i_)
      __builtin_amdgcn_global_load_lds((const unsigned*)(gB + (size_t)(i_ * 32) * ldb + kt * 64),
                                       (unsigned*)(smem + 16384 + (i_ * 4 + w) * 1024), 16, 0, 0);
    asm volatile("s_waitcnt vmcnt(0)" ::: "memory");
    __syncthreads();
    const char* sA = smem;
    const char* sB = smem + 16384;
#pragma unroll
    for (int kk = 0; kk < 2; ++kk) {
      bf16x8 af[4], bfr[8];
      const int ch = kk * 4 + fq;
#pragma unroll
      for (int i = 0; i < 4; ++i) {
        const int row = wm * 64 + i * 16 + fr;
        af[i] = *reinterpret_cast<const bf16x8*>(sA + row * 128 + ((ch ^ (row & 7)) << 4));
      }
#pragma unroll
      for (int j = 0; j < 8; ++j) {
        const int col = wn * 128 + j * 16 + fr;
        bfr[j] = *reinterpret_cast<const bf16x8*>(sB + col * 128 + ((ch ^ (col & 7)) << 4));
      }
#pragma unroll
      for (int i = 0; i < 4; ++i)
#pragma unroll
        for (int j = 0; j < 8; ++j) acc[i][j] = __builtin_amdgcn_mfma_f32_16x16x32_bf16(af[i], bfr[j], acc[i][j], 0, 0, 0);
    }
    __syncthreads();
  }
}
template <class Epi>
__device__ __forceinline__ void gemm_tile_n256(const bf16_t* __restrict__ A, int lda, const bf16_t* __restrict__ Bt, int ldb,
                                               int K, int m0, int n0, const Epi& epi, char* smem) {
  const int lane = threadIdx.x & 63, w = threadIdx.x >> 6;
  const int wm = w >> 1, wn = w & 1;
  f32x4 acc[4][8];
  gemm_mainloop_n256(A, lda, Bt, ldb, K, m0, n0, acc, smem);
#pragma unroll
  for (int i = 0; i < 4; ++i)
#pragma unroll
    for (int j = 0; j < 8; ++j) {
      int row = m0 + wm * 64 + i * 16 + (lane >> 4) * 4;
      int col = n0 + wn * 128 + j * 16 + (lane & 15);
      epi(row, col, acc[i][j]);
    }
}

struct EpiF32 {
  float* C; int ldc;
  __device__ __forceinline__ void operator()(int row, int col, f32x4 v) const {
#pragma unroll
    for (int r = 0; r < 4; ++r) C[(size_t)(row + r) * ldc + col] = v[r];
  }
};
struct EpiBf16 {
  bf16_t* C; int ldc;
  __device__ __forceinline__ void operator()(int row, int col, f32x4 v) const {
#pragma unroll
    for (int r = 0; r < 4; ++r) C[(size_t)(row + r) * ldc + col] = f2bf(v[r]);
  }
};
struct EpiBf16T {
  bf16_t* Ct; int ldc;
  __device__ __forceinline__ void operator()(int row, int col, f32x4 v) const {
    uint2 pk; pk.x = pack2(v[0], v[1]); pk.y = pack2(v[2], v[3]);
    *reinterpret_cast<uint2*>(Ct + (size_t)col * ldc + row) = pk;
  }
};
struct EpiInAB {
  bf16_t* ABt; int seqlen;
  __device__ __forceinline__ void operator()(int row, int col, f32x4 v) const {
    const int ch = col & 1023, half = col >> 10;
    const int b = row / seqlen, l = row - b * seqlen;
    uint2 pk; pk.x = pack2(v[0], v[1]); pk.y = pack2(v[2], v[3]);
    *reinterpret_cast<uint2*>(ABt + ((size_t)(b * 1024 + ch) * 4096 + half * 2048 + l)) = pk;
  }
};
struct EpiInZ {
  bf16_t* z;
  __device__ __forceinline__ void operator()(int row, int col, f32x4 v) const {
#pragma unroll
    for (int r = 0; r < 4; ++r) z[(size_t)(row + r) * 1024 + (col - 2048)] = f2bf(v[r]);
  }
};
struct EpiInXbc {
  float* xbcraw;
  __device__ __forceinline__ void operator()(int row, int col, f32x4 v) const {
#pragma unroll
    for (int r = 0; r < 4; ++r) xbcraw[(size_t)(row + r) * DXBC + (col - 3072)] = v[r];
  }
};
struct EpiInProj {
  bf16_t* ABt; bf16_t* z; float* xbcraw; float* dtraw; int seqlen;
  __device__ __forceinline__ void operator()(int row, int col, f32x4 v) const {
    if (col < 2048) {
      int ch = col & 1023, half = col >> 10;
      int b = row / seqlen, l = row - b * seqlen;
      uint2 pk; pk.x = pack2(v[0], v[1]); pk.y = pack2(v[2], v[3]);
      *reinterpret_cast<uint2*>(ABt + ((size_t)(b * 1024 + ch) * 4096 + half * 2048 + l)) = pk;
    } else if (col < 3072) {
#pragma unroll
      for (int r = 0; r < 4; ++r) z[(size_t)(row + r) * 1024 + (col - 2048)] = f2bf(v[r]);
    } else if (col < 4608) {
#pragma unroll
      for (int r = 0; r < 4; ++r) xbcraw[(size_t)(row + r) * DXBC + (col - 3072)] = v[r];
    } else if (col < 4640) {
#pragma unroll
      for (int r = 0; r < 4; ++r) dtraw[(size_t)(row + r) * 32 + (col - 4608)] = v[r];
    }
  }
};

__device__ void adaln_partial_task(const Params& p, int task, float* sm) {
  const int cb = task % 48, ks = task / 48, tid = threadIdx.x;
  float* sc = sm;
  __syncthreads();
  for (int i = tid; i < 5 * 64; i += NTHREADS) {
    int r = i >> 6, kk = i & 63;
    int k = ks * 64 + kk;
    float cv = (r < 4) ? p.c[r * D + k] : p.c_ctx[k];
    sc[i] = silu_f(cv);
  }
  __syncthreads();
  const int col = cb * 256 + tid;
  float a0 = 0, a1 = 0, a2 = 0, a3 = 0, a4 = 0;
  const float* wp = p.w_mod + (size_t)(ks * 64) * NMOD + col;
#pragma unroll
  for (int h2 = 0; h2 < 2; ++h2) {
    float wv[32];
#pragma unroll
    for (int kk = 0; kk < 32; ++kk) wv[kk] = __builtin_nontemporal_load(wp + (size_t)(h2 * 32 + kk) * NMOD);
#pragma unroll
    for (int kk = 0; kk < 32; ++kk) {
      const int k = h2 * 32 + kk;
      a0 += sc[k] * wv[kk]; a1 += sc[64 + k] * wv[kk]; a2 += sc[128 + k] * wv[kk]; a3 += sc[192 + k] * wv[kk]; a4 += sc[256 + k] * wv[kk];
    }
  }
  float* pp = p.partial + (size_t)ks * 5 * NMOD + col;
  pp[0] = a0; pp[NMOD] = a1; pp[2 * NMOD] = a2; pp[3 * NMOD] = a3; pp[4 * NMOD] = a4;
}

__device__ void transpose_convert_task(const float* __restrict__ src, int ld, int c0, int rows, bf16_t* __restrict__ dst,
                                       int tr, int tc, float* sm) {
  float (*tile)[68] = reinterpret_cast<float (*)[68]>(sm);
  const int tid = threadIdx.x;
  __syncthreads();
  {
    float4 v[4];
#pragma unroll
    for (int k = 0; k < 4; ++k) {
      const int i = tid + k * NTHREADS, r = i >> 4, c4 = i & 15;
      v[k] = *reinterpret_cast<const float4*>(src + (size_t)(tr * 64 + r) * ld + c0 + tc * 64 + c4 * 4);
    }
#pragma unroll
    for (int k = 0; k < 4; ++k) {
      const int i = tid + k * NTHREADS, r = i >> 4, c4 = i & 15;
      *reinterpret_cast<float4*>(&tile[r][c4 * 4]) = v[k];
    }
  }
  __syncthreads();
#pragma unroll
  for (int k = 0; k < 4; ++k) {
    const int i = tid + k * NTHREADS, cc = i >> 4, r4 = (i & 15) * 4;
    uint2 o; o.x = pack2(tile[r4][cc], tile[r4 + 1][cc]); o.y = pack2(tile[r4 + 2][cc], tile[r4 + 3][cc]);
    *reinterpret_cast<uint2*>(dst + (size_t)(tc * 64 + cc) * rows + tr * 64 + r4) = o;
  }
}

__device__ void phase_prep(const Params& p, int bid, int nb, char* smem) {
  float* sm = reinterpret_cast<float*>(smem);
  const int tid = threadIdx.x;
  if (bid == 0 && tid < 64) p.ctr[tid] = 0u;
  {
    float* t256 = reinterpret_cast<float*>(smem + 20480);
    float* t2048 = reinterpret_cast<float*>(smem + 24576);
    t256[tid] = cospif((float)tid * (1.0f / 128.f));
    for (int i = tid; i < 2048; i += NTHREADS) t2048[i] = cospif((float)i * (1.0f / 1024.f));
    __syncthreads();
  }
  for (int t = bid; t < 48 * KSPLIT; t += nb) adaln_partial_task(p, t, sm);
  {
    const int nct = 41, nrt = 32;
    for (int t = bid; t < nct * nrt; t += nb) {
      int tc = t % nct, tr = t / nct;
      if (tc < 40) transpose_convert_task(p.w_in, DIN, 1024, D, p.w_in_t + (size_t)2048 * D, tr, tc, sm);
      else {
        float (*tile)[65] = reinterpret_cast<float (*)[65]>(sm);
        __syncthreads();
        for (int i = tid; i < 64 * 32; i += NTHREADS) {
          int r = i >> 5, cc = i & 31;
          tile[r][cc] = p.w_in[(size_t)(tr * 64 + r) * DIN + 1024 + 2560 + cc];
        }
        __syncthreads();
        for (int i = tid; i < 32 * 32; i += NTHREADS) {
          int cc = i >> 5, r2 = (i & 31) * 2;
          uint32_t pk = pack2(tile[r2][cc], tile[r2 + 1][cc]);
          *reinterpret_cast<uint32_t*>(p.w_in_t + (size_t)(2048 + 2560 + cc) * D + tr * 64 + r2) = pk;
        }
      }
    }
    for (size_t i = (size_t)bid * NTHREADS + tid; i < (size_t)96 * D / 8; i += (size_t)nb * NTHREADS)
      reinterpret_cast<uint4*>(p.w_in_t + (size_t)4640 * D)[i] = uint4{0, 0, 0, 0};
  }
  for (size_t i = (size_t)bid * NTHREADS + tid; i < (size_t)D * 1024 / 4; i += (size_t)nb * NTHREADS) {
    int k = (int)(i / 256), c4 = (int)(i % 256) * 4;
    float4 v = *reinterpret_cast<const float4*>(p.w_in + (size_t)k * DIN + c4);
    uint2 o; o.x = pack2(v.x, v.y); o.y = pack2(v.z, v.w);
    *reinterpret_cast<uint2*>(p.w_in_f + (size_t)k * 1024 + c4) = o;
  }
  {
    const float* t256 = reinterpret_cast<const float*>(smem + 20480);
    const float scale = 1.0f / sqrtf((float)L * 256.f);
    for (int i = bid * NTHREADS + tid; i < 4 * 64 * 256; i += nb * NTHREADS) {
      const int d = i & 255, cg = (i >> 8) & 63, g = i >> 14;
      float sc_[4] = {0.f, 0.f, 0.f, 0.f}, ss_[4] = {0.f, 0.f, 0.f, 0.f};
      const float* wp = p.w_fmix + (size_t)g * 65536 + d;
#pragma unroll 4
      for (int m = 0; m < 256; ++m) {
        const float wv = wp[m * 256];
#pragma unroll
        for (int j = 0; j < 4; ++j) {
          const int ph = (m * (cg * 4 + j)) & 255;
          sc_[j] += t256[ph] * wv; ss_[j] += t256[(ph - 64) & 255] * wv;
        }
      }
#pragma unroll
      for (int j = 0; j < 4; ++j) {
        const int c = cg * 4 + j;
        p.WcsT[((size_t)g * 512 + d) * 256 + c] = f2bf(sc_[j] * scale);
        p.WcsT[((size_t)g * 512 + 256 + d) * 256 + c] = f2bf(ss_[j] * scale);
      }
    }
  }
  {
    const float* t2048 = reinterpret_cast<const float*>(smem + 24576);
    for (size_t i = (size_t)bid * NTHREADS + tid; i < (size_t)1024 * 2048 / 8; i += (size_t)nb * NTHREADS) {
      const int k = (int)(i / 256), j = (int)(i % 256) * 8;
      const bool iss = j >= 1024;
      float o[8];
#pragma unroll
      for (int e = 0; e < 8; ++e) {
        const int l = (j + e) & 1023;
        const int ph = (k * l) & 2047;
        o[e] = iss ? t2048[(ph - 512) & 2047] : t2048[ph];
      }
      uint4 pk; pk.x = pack2(o[0], o[1]); pk.y = pack2(o[2], o[3]); pk.z = pack2(o[4], o[5]); pk.w = pack2(o[6], o[7]);
      *reinterpret_cast<uint4*>(p.dftm + (size_t)k * 2048 + j) = pk;
    }
  }
}

__device__ void phase_fold(const Params& p, int bid, int nb, char* smem) {
  const int tid = threadIdx.x;
  for (int i = bid * NTHREADS + tid; i < 5 * NMOD; i += nb * NTHREADS) {
    int col = i % NMOD;
    float s = p.b_mod[col];
    for (int ks = 0; ks < KSPLIT; ++ks) s += p.partial[(size_t)ks * 5 * NMOD + i];
    p.mod[i] = s;
  }
  for (int t = bid; t < 256; t += nb) {
    int g = t >> 6, tm = (t & 63) >> 2, tn = t & 3;
    int n0 = tn * 128;
    int rowbase = (n0 < 256) ? (g * 256 + n0) : (1024 + g * 256 + (n0 - 256));
    EpiBf16T epi{p.w_in_t + (size_t)(rowbase - n0) * D, D};
    gemm_tile(p.w_in_f + g * 256, 1024, p.WcsT + (size_t)g * 512 * 256, 256, 256, tm * 128, n0, epi, smem);
  }
}

__device__ void phase_norm_mod(const Params& p, int bid, int nb, char* smem) {
  const int lane = threadIdx.x & 63, w = threadIdx.x >> 6;
  for (int t = bid * 4 + w; t < T + TC; t += nb * 4) {
    const bool isx = t < T;
    const float* src = isx ? (p.x + (size_t)t * D) : (p.ctx + (size_t)(t - T) * D);
    const int mrow = isx ? (t / L) : 4;
    bf16_t* dst = isx ? (p.hx + (size_t)t * D) : (p.hc + (size_t)(t - T) * D);
    float4 v[8];
    float ss = 0.f;
#pragma unroll
    for (int c = 0; c < 8; ++c) {
      v[c] = *reinterpret_cast<const float4*>(src + c * 256 + lane * 4);
      ss += v[c].x * v[c].x + v[c].y * v[c].y + v[c].z * v[c].z + v[c].w * v[c].w;
    }
    ss = wave_sum_fast(ss);
    const float rstd = rsqrtf(ss * (1.f / D) + EPS);
    const float* sh = p.mod + (size_t)mrow * NMOD + 0 * D;
    const float* sc = p.mod + (size_t)mrow * NMOD + 1 * D;
#pragma unroll
    for (int c = 0; c < 8; ++c) {
      const int e0 = c * 256 + lane * 4;
      const float4 g = *reinterpret_cast<const float4*>(p.g_pre_mix + e0);
      const float4 s4 = *reinterpret_cast<const float4*>(sc + e0), h4 = *reinterpret_cast<const float4*>(sh + e0);
      uint2 pk;
      pk.x = pack2(v[c].x * rstd * g.x * (1.f + s4.x) + h4.x, v[c].y * rstd * g.y * (1.f + s4.y) + h4.y);
      pk.y = pack2(v[c].z * rstd * g.z * (1.f + s4.z) + h4.z, v[c].w * rstd * g.w * (1.f + s4.w) + h4.w);
      *reinterpret_cast<uint2*>(dst + e0) = pk;
    }
  }
}

__device__ __forceinline__ void convert_uv_units(const Params& p, size_t u0, size_t u1) {
  const size_t n16 = (size_t)16384 * D / 16;
  for (size_t i = u0 + threadIdx.x; i < u1; i += NTHREADS) {
    const float* s = (i < n16) ? p.eu : p.ev;
    uint8_t* d = (i < n16) ? p.U8 : p.V8;
    const size_t j = (i < n16) ? i : i - n16;
    uint32_t o[4];
#pragma unroll
    for (int q4 = 0; q4 < 4; ++q4) {
      const float4 v = *reinterpret_cast<const float4*>(s + j * 16 + q4 * 4);
      int pk = 0;
      pk = __builtin_amdgcn_cvt_pk_fp8_f32(v.x * 512.f, v.y * 512.f, pk, false);
      pk = __builtin_amdgcn_cvt_pk_fp8_f32(v.z * 512.f, v.w * 512.f, pk, true);
      o[q4] = (uint32_t)pk;
    }
    const size_t e_ = j >> 7, r_ = j & 127;
    *reinterpret_cast<uint4*>(d + (r_ >> 4) * ((size_t)16384 * 256) + e_ * 256 + (r_ & 15) * 16) = uint4{o[0], o[1], o[2], o[3]};
  }
}
__device__ void phase_inproj(const Params& p, int bid, int nb, char* smem) {
  if ((nb & 7) == 0) {
    const int x = bid & 7, rank = bid >> 3, per = nb >> 3;
    for (int s_ = rank; s_ < 128 + 53; s_ += per) {
      if (s_ < 128) {
        const int tn2 = s_ >> 3, m0_ = (8 * x + (s_ & 7)) * 128;
        if (tn2 < 8) { EpiInAB epi{p.ABt, L}; gemm_tile_n256(p.hx, D, p.w_in_t, D, D, m0_, tn2 * 256, epi, smem); }
        else if (tn2 < 12) { EpiInZ epi{p.z}; gemm_tile_n256(p.hx, D, p.w_in_t, D, D, m0_, tn2 * 256, epi, smem); }
        else { EpiInXbc epi{p.xbcraw}; gemm_tile_n256(p.hx, D, p.w_in_t, D, D, m0_, tn2 * 256, epi, smem); }
      } else if (s_ < 128 + 40) {
        const int i = s_ - 128;
        EpiInProj epi{p.ABt, p.z, p.xbcraw, p.dtraw, L};
        gemm_tile(p.hx, D, p.w_in_t, D, D, (8 * x + (i & 7)) * 128, (32 + (i >> 3)) * 128, epi, smem);
      } else {
        const int u = x * 13 + (s_ - 168);
        EpiInProj epi{nullptr, nullptr, p.xbcraw_c, p.dtraw_c, CTX};
        gemm_tile(p.hc, D, p.w_in_t, D, D, (u / 13) * 128, 3072 + (u % 13) * 128, epi, smem);
      }
    }
    return;
  }
  const int ntx = 64 * 37, ntc = 8 * 13;
  for (int t = bid; t < ntx + ntc; t += nb) {
    if (t < ntx) {
      int tm = t / 37, tn = t % 37;
      EpiInProj epi{p.ABt, p.z, p.xbcraw, p.dtraw, L};
      gemm_tile(p.hx, D, p.w_in_t, D, D, tm * 128, tn * 128, epi, smem);
    } else {
      int u = t - ntx;
      int tm = u / 13, tn = u % 13;
      EpiInProj epi{nullptr, nullptr, p.xbcraw_c, p.dtraw_c, CTX};
      gemm_tile(p.hc, D, p.w_in_t, D, D, tm * 128, 3072 + tn * 128, epi, smem);
    }
  }
}

__device__ void ssm_pre_tile(const Params& p, int task, char* smem) {
  const bool isx = task < 3072;
  const int u = isx ? task : task - 3072;
  const int ntt = isx ? 32 : 4;
  const int ct = u % 24, tt = (u / 24) % ntt, b = u / (24 * ntt);
  const int seqlen = isx ? L : CTX;
  const float* raw = (isx ? p.xbcraw : p.xbcraw_c) + (size_t)b * seqlen * DXBC;
  const int l0 = tt * 64, c0 = ct * 64, tid = threadIdx.x;
  float (*rt)[68] = reinterpret_cast<float (*)[68]>(smem);
  float (*at)[65] = reinterpret_cast<float (*)[65]>(smem + 66 * 68 * 4);
  __syncthreads();
  {
    float4 v[5];
#pragma unroll
    for (int k = 0; k < 5; ++k) {
      const int i = tid + k * NTHREADS, r = i >> 4, c4 = i & 15, l = l0 - 1 + r;
      v[k] = (i < 66 * 16 && l >= 0 && l < seqlen) ? *reinterpret_cast<const float4*>(raw + (size_t)l * DXBC + c0 + c4 * 4) : float4{0.f, 0.f, 0.f, 0.f};
    }
#pragma unroll
    for (int k = 0; k < 5; ++k) {
      const int i = tid + k * NTHREADS, r = i >> 4, c4 = i & 15;
      if (i < 66 * 16) *reinterpret_cast<float4*>(&rt[r][c4 * 4]) = v[k];
    }
  }
  __syncthreads();
  {
    const int cc = tid & 63, c = c0 + cc;
    const float w0 = p.conv_w[c], w1 = p.conv_w[DXBC + c], w2 = p.conv_w[2 * DXBC + c], cb = p.conv_b[c];
#pragma unroll 4
    for (int r = tid >> 6; r < 64; r += 4) at[r][cc] = silu_f(cb + rt[r][cc] * w0 + rt[r + 1][cc] * w1 + rt[r + 2][cc] * w2);
  }
  __syncthreads();
  const size_t trow0 = isx ? ((size_t)b * L + l0) : ((size_t)T + (size_t)b * CTX + l0);
#pragma unroll
  for (int k = 0; k < 4; ++k) {
    const int i = tid + k * NTHREADS, r = i >> 4, c4 = (i & 15) * 4;
    uint2 o; o.x = pack2(at[r][c4], at[r][c4 + 1]); o.y = pack2(at[r][c4 + 2], at[r][c4 + 3]);
    *reinterpret_cast<uint2*>(p.act_tm + (trow0 + r) * DXBC + c0 + c4) = o;
  }
  if (c0 < 1280) {
    bf16_t* cm = (isx ? p.act_cm_x : p.act_cm_c) + (size_t)b * 1280 * seqlen;
#pragma unroll
    for (int k = 0; k < 4; ++k) {
      const int i = tid + k * NTHREADS, cc = i >> 4, r4 = (i & 15) * 4;
      uint2 o; o.x = pack2(at[r4][cc], at[r4 + 1][cc]); o.y = pack2(at[r4 + 2][cc], at[r4 + 3][cc]);
      *reinterpret_cast<uint2*>(cm + (size_t)(c0 + cc) * seqlen + l0 + r4) = o;
    }
  }
}
__device__ void dft_fold_rows(const Params& p, int bid, int nb, char* smem) {
  const int lane = threadIdx.x & 63, w = threadIdx.x >> 6;
  bf16_t* sr = reinterpret_cast<bf16_t*>(smem + w * 8192);
  for (int row = bid * 4 + w; row < NB * 1024; row += nb * 4) {
    const bf16_t* A = p.ABt + (size_t)row * 4096;
    bf16_t* F = p.Fs + (size_t)row * 2048;
    __builtin_amdgcn_wave_barrier();
    {
      const uint4 q0 = *reinterpret_cast<const uint4*>(A + (0 * 64 + lane) * 8), q1 = *reinterpret_cast<const uint4*>(A + (1 * 64 + lane) * 8);
      const uint4 q2 = *reinterpret_cast<const uint4*>(A + (2 * 64 + lane) * 8), q3 = *reinterpret_cast<const uint4*>(A + (3 * 64 + lane) * 8);
      const uint4 q4 = *reinterpret_cast<const uint4*>(A + (4 * 64 + lane) * 8), q5 = *reinterpret_cast<const uint4*>(A + (5 * 64 + lane) * 8);
      const uint4 q6 = *reinterpret_cast<const uint4*>(A + (6 * 64 + lane) * 8), q7 = *reinterpret_cast<const uint4*>(A + (7 * 64 + lane) * 8);
      *reinterpret_cast<uint4*>(sr + (0 * 64 + lane) * 8) = q0; *reinterpret_cast<uint4*>(sr + (1 * 64 + lane) * 8) = q1;
      *reinterpret_cast<uint4*>(sr + (2 * 64 + lane) * 8) = q2; *reinterpret_cast<uint4*>(sr + (3 * 64 + lane) * 8) = q3;
      *reinterpret_cast<uint4*>(sr + (4 * 64 + lane) * 8) = q4; *reinterpret_cast<uint4*>(sr + (5 * 64 + lane) * 8) = q5;
      *reinterpret_cast<uint4*>(sr + (6 * 64 + lane) * 8) = q6; *reinterpret_cast<uint4*>(sr + (7 * 64 + lane) * 8) = q7;
    }
    __builtin_amdgcn_wave_barrier();
    const int l0 = lane * 16;
    float alt = 0.f;
    uint32_t oa[8], ob[8];
#pragma unroll
    for (int half = 0; half < 2; ++half) {
      const bf16_t* base = sr + half * 2048;
      const uint4 fa = *reinterpret_cast<const uint4*>(base + l0), fb = *reinterpret_cast<const uint4*>(base + l0 + 8);
      const uint4 ra = *reinterpret_cast<const uint4*>(base + 2032 - l0), rb = *reinterpret_cast<const uint4*>(base + 2040 - l0);
      const float r16 = (lane > 0) ? bf2f(base[2048 - l0]) : 0.f;
      const uint32_t fw[8] = {fa.x, fa.y, fa.z, fa.w, fb.x, fb.y, fb.z, fb.w};
      const uint32_t rw[8] = {ra.x, ra.y, ra.z, ra.w, rb.x, rb.y, rb.z, rb.w};
      float v[16];
#pragma unroll
      for (int i = 0; i < 16; ++i) {
        const float fwv = (i & 1) ? bfhi(fw[i >> 1]) : bflo(fw[i >> 1]);
        const int j = 16 - i;
        const float rv = (i == 0) ? r16 : ((j & 1) ? bfhi(rw[j >> 1]) : bflo(rw[j >> 1]));
        if (half == 0) v[i] = (lane == 0 && i == 0) ? fwv : fwv + rv;
        else v[i] = (lane == 0 && i == 0) ? 0.f : fwv - rv;
      }
      if (half == 0) {
#pragma unroll
        for (int i = 0; i < 16; ++i) alt += (i & 1) ? -v[i] : v[i];
#pragma unroll
        for (int i = 0; i < 8; ++i) oa[i] = pack2(v[2 * i], v[2 * i + 1]);
      } else {
#pragma unroll
        for (int i = 0; i < 8; ++i) ob[i] = pack2(v[2 * i], v[2 * i + 1]);
      }
    }
    *reinterpret_cast<uint4*>(F + l0) = uint4{oa[0], oa[1], oa[2], oa[3]};
    *reinterpret_cast<uint4*>(F + l0 + 8) = uint4{oa[4], oa[5], oa[6], oa[7]};
    *reinterpret_cast<uint4*>(F + 1024 + l0) = uint4{ob[0], ob[1], ob[2], ob[3]};
    *reinterpret_cast<uint4*>(F + 1024 + l0 + 8) = uint4{ob[4], ob[5], ob[6], ob[7]};
    alt = wave_sum_fast(alt) + bf2f(sr[1024]);
    if (lane == 0) { const int b = row >> 10, ch = row & 1023; p.ycat[((size_t)b * L + 1024) * D + ch] = f2bf(alt); }
  }
}
__device__ void phase_ssm_pre(const Params& p, int bid, int nb, char* smem) {
  const int tid = threadIdx.x;
  dft_fold_rows(p, bid, nb, smem);
  for (int t = bid; t < 3072 + 384; t += nb) ssm_pre_tile(p, t, smem);
  for (int i = bid * NTHREADS + tid; i < (T + TC) * 32; i += nb * NTHREADS) {
    const bool isx = i < T * 32;
    const int ii = isx ? i : i - T * 32;
    const int t = ii >> 5, j = ii & 31;
    const float v = (isx ? p.dtraw : p.dtraw_c)[ii];
    float* df = isx ? p.dtf : p.dtf_c;
    float* db = isx ? p.dtb : p.dtb_c;
    if (j < 16) df[t * 16 + j] = softplus_f(v + p.dt_bias_f[j]);
    else db[t * 16 + (j - 16)] = softplus_f(v + p.dt_bias_b[j - 16]);
  }
}

__device__ __forceinline__ int swz16(int row, int chunk) { return row * 256 + ((chunk ^ (row & 15)) << 4); }
__device__ __forceinline__ int swz8(int row, int chunk) { return row * 128 + ((chunk ^ (row & 7)) << 4); }

#define LDS_BARRIER() asm volatile("s_waitcnt lgkmcnt(0)\n\ts_barrier" ::: "memory")
__device__ void ssd_task(const Params& p, int task, char* smem) {
  const int dir = task & 1, ph = (task >> 1) & 1, h = (task >> 2) & 15, b = task >> 6;
  const int tid = opaque_tid(), lane = tid & 63, w = tid >> 6;
  const int g = h >> 3, lr0 = lane & 15, lq0 = lane >> 4;
  const float a = -__expf(dir ? p.a_log_b[h] : p.a_log_f[h]);
  char* sCc = smem; char* sBc = smem + 16384; char* sBT = smem + 32768; char* sXT = smem + 49152; char* sHb = smem + 57344;
  float* se = reinterpret_cast<float*>(smem + 73728);
  float* sdt = se + 64; float* sw = se + 128; float* sy = se + 192; float* stot = se + 256;
  float* yo = dir ? p.yb : p.yf;
  f32x4 H[2][2];
#pragma unroll
  for (int i = 0; i < 2; ++i)
#pragma unroll
    for (int j = 0; j < 2; ++j) H[i][j] = f32x4{0.f, 0.f, 0.f, 0.f};
  __syncthreads();
  for (int i = tid; i < 512; i += NTHREADS) reinterpret_cast<uint4*>(sHb)[i] = uint4{0, 0, 0, 0};

  const int crow = tid >> 4, cch = tid & 15;
  const int trow = tid >> 3, tch = tid & 7;
  uint4 rC0, rC1, rC2, rC3, rB0, rB1, rB2, rB3, rT0, rT1, rT2, rT3, rX;
  rC0 = rC1 = rC2 = rC3 = rB0 = rB1 = rB2 = rB3 = uint4{0, 0, 0, 0};
  float rdt = 0.f;
#define SSD_PARAMS(st_)                                                                                                   \
  const bool isctx_ = (st_) < 4;                                                                                          \
  const int nch_ = isctx_ ? 4 : 32, ci_ = isctx_ ? (st_) : (st_) - 4;                                                     \
  const int c_ = dir ? (nch_ - 1 - ci_) : ci_;                                                                            \
  const int seqlen_ = isctx_ ? CTX : L;                                                                                   \
  const size_t trow0_ = isctx_ ? ((size_t)T + (size_t)b * CTX + c_ * 64) : ((size_t)b * L + c_ * 64);                     \
  const size_t drow0_ = (size_t)b * seqlen_ + c_ * 64;                                                                    \
  const float* dtp_ = isctx_ ? (dir ? p.dtb_c : p.dtf_c) : (dir ? p.dtb : p.dtf);                                         \
  const bf16_t* cm_ = (isctx_ ? p.act_cm_c : p.act_cm_x) + (size_t)b * 1280 * seqlen_ + c_ * 64;
#define SSD_PREFETCH(st_)                                                                                                 \
  do {                                                                                                                    \
    SSD_PARAMS(st_)                                                                                                       \
    if (w == 0) rdt = dtp_[(drow0_ + lane) * 16 + h];                                                                     \
    if (!isctx_) {                                                                                                        \
      const bf16_t* src = p.act_tm + (trow0_ + crow) * DXBC + g * 128 + cch * 8;                                          \
      rC0 = *reinterpret_cast<const uint4*>(src + 1280);             rB0 = *reinterpret_cast<const uint4*>(src + 1024);   \
      rC1 = *reinterpret_cast<const uint4*>(src + 16 * DXBC + 1280); rB1 = *reinterpret_cast<const uint4*>(src + 16 * DXBC + 1024); \
      rC2 = *reinterpret_cast<const uint4*>(src + 32 * DXBC + 1280); rB2 = *reinterpret_cast<const uint4*>(src + 32 * DXBC + 1024); \
      rC3 = *reinterpret_cast<const uint4*>(src + 48 * DXBC + 1280); rB3 = *reinterpret_cast<const uint4*>(src + 48 * DXBC + 1024); \
    }                                                                                                                     \
    const bf16_t* srt = cm_ + (size_t)(1024 + g * 128 + trow) * seqlen_ + tch * 8;                                        \
    rT0 = *reinterpret_cast<const uint4*>(srt);                                                                           \
    rT1 = *reinterpret_cast<const uint4*>(srt + (size_t)32 * seqlen_);                                                    \
    rT2 = *reinterpret_cast<const uint4*>(srt + (size_t)64 * seqlen_);                                                    \
    rT3 = *reinterpret_cast<const uint4*>(srt + (size_t)96 * seqlen_);                                                    \
    rX = *reinterpret_cast<const uint4*>(cm_ + (size_t)(h * 64 + ph * 32 + trow) * seqlen_ + tch * 8);                    \
  } while (0)

  for (int step = 0; step < 36; ++step) {
    SSD_PREFETCH(step);
    const bool isctx = step < 4;
    const int c = dir ? ((isctx ? 4 : 32) - 1 - (isctx ? step : step - 4)) : (isctx ? step : step - 4);
    const size_t trow0 = (size_t)b * L + c * 64;
    int lr = lr0, lq = lq0;
    asm volatile("" : "+v"(lr), "+v"(lq));
    LDS_BARRIER();
    if (w == 0) {
      const float dtv = rdt;
      float v = a * dtv;
      if (!dir) {
#pragma unroll
        for (int o = 1; o < 64; o <<= 1) { float n = __shfl_up(v, o); v += (lane >= o) ? n : 0.f; }
      } else {
#pragma unroll
        for (int o = 1; o < 64; o <<= 1) { float n = __shfl_down(v, o); v += (lane + o < 64) ? n : 0.f; }
      }
      const float etot = __shfl(v, dir ? 0 : 63);
      se[lane] = v; sdt[lane] = dtv; sw[lane] = dtv * __expf(etot - v); sy[lane] = __expf(v);
      if (lane == 0) stot[0] = etot;
    }
    if (!isctx) {
      const int oc = swz16(crow, cch);
      *reinterpret_cast<uint4*>(sCc + oc) = rC0;         *reinterpret_cast<uint4*>(sBc + oc) = rB0;
      *reinterpret_cast<uint4*>(sCc + oc + 4096) = rC1;  *reinterpret_cast<uint4*>(sBc + oc + 4096) = rB1;
      *reinterpret_cast<uint4*>(sCc + oc + 8192) = rC2;  *reinterpret_cast<uint4*>(sBc + oc + 8192) = rB2;
      *reinterpret_cast<uint4*>(sCc + oc + 12288) = rC3; *reinterpret_cast<uint4*>(sBc + oc + 12288) = rB3;
    }
    {
      const int ot = swz8(trow, tch);
      *reinterpret_cast<uint4*>(sBT + ot) = rT0;
      *reinterpret_cast<uint4*>(sBT + ot + 4096) = rT1;
      *reinterpret_cast<uint4*>(sBT + ot + 8192) = rT2;
      *reinterpret_cast<uint4*>(sBT + ot + 12288) = rT3;
      *reinterpret_cast<uint4*>(sXT + ot) = rX;
    }
    LDS_BARRIER();
    const float etot = stot[0];
    if (!isctx) {
      f32x4 G[4];
      bf16x8 ca[4];
#pragma unroll
      for (int j = 0; j < 4; ++j) G[j] = f32x4{0.f, 0.f, 0.f, 0.f};
#pragma unroll
      for (int kk = 0; kk < 4; ++kk) ca[kk] = *reinterpret_cast<const bf16x8*>(sCc + swz16(16 * w + lr, kk * 4 + lq));
#pragma unroll
      for (int kk = 0; kk < 4; ++kk)
#pragma unroll
        for (int j = 0; j < 4; ++j) {
          bf16x8 bb = *reinterpret_cast<const bf16x8*>(sBc + swz16(16 * j + lr, kk * 4 + lq));
          G[j] = __builtin_amdgcn_mfma_f32_16x16x32_bf16(ca[kk], bb, G[j], 0, 0, 0);
        }
      LDS_BARRIER();
      float el[4];
#pragma unroll
      for (int r = 0; r < 4; ++r) el[r] = se[16 * w + lq * 4 + r];
#pragma unroll
      for (int j = 0; j < 4; ++j) {
        const int s_ = 16 * j + lr;
        const float es = se[s_], ds = sdt[s_];
#pragma unroll
        for (int r = 0; r < 4; ++r) {
          const int l = 16 * w + lq * 4 + r;
          const bool keep = dir ? (s_ >= l) : (s_ <= l);
          const float m = keep ? G[j][r] * __expf(el[r] - es) * ds : 0.f;
          *reinterpret_cast<bf16_t*>(sBc + swz8(l, s_ >> 3) + (s_ & 7) * 2) = f2bf(m);
        }
      }
      LDS_BARRIER();
      f32x4 Y[2], Yo[2];
#pragma unroll
      for (int j = 0; j < 2; ++j) { Y[j] = f32x4{0.f, 0.f, 0.f, 0.f}; Yo[j] = f32x4{0.f, 0.f, 0.f, 0.f}; }
#pragma unroll
      for (int kk = 0; kk < 2; ++kk) {
        bf16x8 ma = *reinterpret_cast<const bf16x8*>(sBc + swz8(16 * w + lr, kk * 4 + lq));
#pragma unroll
        for (int j = 0; j < 2; ++j) {
          bf16x8 xb = *reinterpret_cast<const bf16x8*>(sXT + swz8(16 * j + lr, kk * 4 + lq));
          Y[j] = __builtin_amdgcn_mfma_f32_16x16x32_bf16(ma, xb, Y[j], 0, 0, 0);
        }
      }
#pragma unroll
      for (int kk = 0; kk < 4; ++kk)
#pragma unroll
        for (int j = 0; j < 2; ++j) {
          bf16x8 hb = *reinterpret_cast<const bf16x8*>(sHb + swz16(16 * j + lr, kk * 4 + lq));
          Yo[j] = __builtin_amdgcn_mfma_f32_16x16x32_bf16(ca[kk], hb, Yo[j], 0, 0, 0);
        }
      float syl[4];
#pragma unroll
      for (int r = 0; r < 4; ++r) syl[r] = sy[16 * w + lq * 4 + r];
#pragma unroll
      for (int j = 0; j < 2; ++j)
#pragma unroll
        for (int r = 0; r < 4; ++r) {
          const int l = 16 * w + lq * 4 + r;
          yo[(trow0 + l) * 1024 + h * 64 + ph * 32 + 16 * j + lr] = Y[j][r] + syl[r] * Yo[j][r];
        }
    }
    {
      const float dec = __expf(etot);
#pragma unroll
      for (int i = 0; i < 2; ++i)
#pragma unroll
        for (int j = 0; j < 2; ++j) H[i][j] *= dec;
#pragma unroll
      for (int kk = 0; kk < 2; ++kk) {
        const int s0 = kk * 32 + lq * 8;
        const float4 w0 = *reinterpret_cast<const float4*>(sw + s0), w1 = *reinterpret_cast<const float4*>(sw + s0 + 4);
        bf16x8 xs[2];
#pragma unroll
        for (int i = 0; i < 2; ++i) {
          const bf16x8 xa = *reinterpret_cast<const bf16x8*>(sXT + swz8(16 * i + lr, kk * 4 + lq));
          xs[i][0] = (short)f2bf(bf2f((bf16_t)xa[0]) * w0.x); xs[i][1] = (short)f2bf(bf2f((bf16_t)xa[1]) * w0.y);
          xs[i][2] = (short)f2bf(bf2f((bf16_t)xa[2]) * w0.z); xs[i][3] = (short)f2bf(bf2f((bf16_t)xa[3]) * w0.w);
          xs[i][4] = (short)f2bf(bf2f((bf16_t)xa[4]) * w1.x); xs[i][5] = (short)f2bf(bf2f((bf16_t)xa[5]) * w1.y);
          xs[i][6] = (short)f2bf(bf2f((bf16_t)xa[6]) * w1.z); xs[i][7] = (short)f2bf(bf2f((bf16_t)xa[7]) * w1.w);
        }
#pragma unroll
        for (int j = 0; j < 2; ++j) {
          const bf16x8 bt = *reinterpret_cast<const bf16x8*>(sBT + swz8(16 * (2 * w + j) + lr, kk * 4 + lq));
#pragma unroll
          for (int i = 0; i < 2; ++i) H[i][j] = __builtin_amdgcn_mfma_f32_16x16x32_bf16(xs[i], bt, H[i][j], 0, 0, 0);
        }
      }
    }
    LDS_BARRIER();
#pragma unroll
    for (int i = 0; i < 2; ++i)
#pragma unroll
      for (int j = 0; j < 2; ++j) {
        const int n = 16 * (2 * w + j) + lr;
#pragma unroll
        for (int r = 0; r < 4; ++r) {
          const int pr = 16 * i + lq * 4 + r;
          *reinterpret_cast<bf16_t*>(sHb + swz16(pr, n >> 3) + (n & 7) * 2) = f2bf(H[i][j][r]);
        }
      }
  }
#undef SSD_PREFETCH
#undef SSD_PARAMS
}

#undef LDS_BARRIER
__device__ void phase_ssd_dft(const Params& p, int bid, int nb, char* smem) {
  for (int t = bid; t < 256; t += nb) ssd_task(p, t, smem);
  int* stile = reinterpret_cast<int*>(smem + 75776);
  for (;;) {
    __syncthreads();
    if (threadIdx.x == 0) *stile = (int)atomicAdd(p.ctr, 1u);
    __syncthreads();
    const int t = *stile;
    if (t >= 4 * 8 * 8) break;
    const int b = t >> 6, tm = (t & 63) >> 3, tn = t & 7;
    const bf16_t* Fb = p.Fs + (size_t)b * 1024 * 2048;
    f32x4 accC[4][4], accS[4][4];
    gemm_mainloop(p.dftm, 2048, Fb, 2048, 1024, tm * 128, tn * 128, accC, smem);
    gemm_mainloop(p.dftm + 1024, 2048, Fb + 1024, 2048, 1024, tm * 128, tn * 128, accS, smem);
    const int lane = threadIdx.x & 63, w = threadIdx.x >> 6, wm = w >> 1, wn = w & 1;
#pragma unroll
    for (int i = 0; i < 4; ++i) {
      int lq_ = lane >> 4, lr_ = lane & 15;
      asm volatile("" : "+v"(lq_), "+v"(lr_));
#pragma unroll
      for (int j = 0; j < 4; ++j) {
        const int k0 = tm * 128 + wm * 64 + i * 16 + lq_ * 4;
        const int ch = tn * 128 + wn * 64 + j * 16 + lr_;
        const float a = bf2f(p.ABt[((size_t)b * 1024 + ch) * 4096 + 1024]);
#pragma unroll
        for (int r = 0; r < 4; ++r) {
          const int k = k0 + r;
          const float as = (k & 1) ? -a : a;
          const float c = accC[i][j][r], sn = accS[i][j][r];
          p.ycat[((size_t)b * L + k) * D + ch] = f2bf(c - sn + as);
          if (k > 0) p.ycat[((size_t)b * L + (L - k)) * D + ch] = f2bf(c + sn + as);
        }
      }
    }
  }
  for (;;) {
    __syncthreads();
    if (threadIdx.x == 0) *stile = (int)atomicAdd(p.ctr + 8, 1u);
    __syncthreads();
    const int q = *stile;
    if (q >= 1024 + 1536) break;
    if (q < 1024) convert_uv_units(p, (size_t)q * 4096, (size_t)(q + 1) * 4096);
    else if (q < 1024 + 1024) { const int q1 = q - 1024; transpose_convert_task(p.w_out, D, 0, D, p.w_out_t, q1 / 32, q1 % 32, reinterpret_cast<float*>(smem)); }
    else { const int q2 = q - 2048; transpose_convert_task(p.w_query, 1024, 0, D, p.w_q_t, q2 / 16, q2 % 16, reinterpret_cast<float*>(smem)); }
  }
}

__device__ void phase_ssm_post(const Params& p, int bid, int nb, char* smem) {
  const int lane = threadIdx.x & 63, w = threadIdx.x >> 6;
  for (int t = bid * 4 + w; t < T; t += nb * 4) {
    float y[4][4];
    float ss0 = 0.f, ss1 = 0.f;
#pragma unroll
    for (int c = 0; c < 4; ++c) {
      const int c0 = c * 256 + lane * 4;
      const int h = c0 >> 6;
      const float dsk = p.d_skip_f[h] + p.d_skip_b[h];
      const float4 a = *reinterpret_cast<const float4*>(p.yf + (size_t)t * 1024 + c0);
      const float4 bq = *reinterpret_cast<const float4*>(p.yb + (size_t)t * 1024 + c0);
      const uint2 xq = *reinterpret_cast<const uint2*>(p.act_tm + (size_t)t * DXBC + c0);
      const uint2 zz = *reinterpret_cast<const uint2*>(p.z + (size_t)t * 1024 + c0);
      y[c][0] = (a.x + bq.x + dsk * bflo(xq.x)) * silu_f(bflo(zz.x));
      y[c][1] = (a.y + bq.y + dsk * bfhi(xq.x)) * silu_f(bfhi(zz.x));
      y[c][2] = (a.z + bq.z + dsk * bflo(xq.y)) * silu_f(bflo(zz.y));
      y[c][3] = (a.w + bq.w + dsk * bfhi(xq.y)) * silu_f(bfhi(zz.y));
      const float q = y[c][0] * y[c][0] + y[c][1] * y[c][1] + y[c][2] * y[c][2] + y[c][3] * y[c][3];
      if (c < 2) ss0 += q; else ss1 += q;
    }
    ss0 = wave_sum_fast(ss0); ss1 = wave_sum_fast(ss1);
    const float r0 = rsqrtf(ss0 * (1.f / 512.f) + EPS), r1 = rsqrtf(ss1 * (1.f / 512.f) + EPS);
#pragma unroll
    for (int c = 0; c < 4; ++c) {
      const int c0 = c * 256 + lane * 4;
      const float rstd = (c < 2) ? r0 : r1;
      const float4 nw = *reinterpret_cast<const float4*>(p.ssm_norm_w + c0);
      uint2 o; o.x = pack2(y[c][0] * rstd * nw.x, y[c][1] * rstd * nw.y); o.y = pack2(y[c][2] * rstd * nw.z, y[c][3] * rstd * nw.w);
      *reinterpret_cast<uint2*>(p.ycat + (size_t)t * D + 1024 + c0) = o;
    }
  }
}

__device__ void phase_outproj(const Params& p, int bid, int nb, char* smem) {
  if ((nb & 7) == 0) {
    const int x = bid & 7, rank = bid >> 3, per = nb >> 3;
    for (int s_ = rank; s_ < 64; s_ += per) {
      EpiF32 epi{p.y_x, D};
      gemm_tile_n256(p.ycat, D, p.w_out_t, D, D, (8 * x + (s_ & 7)) * 128, (s_ >> 3) * 256, epi, smem);
    }
    return;
  }
  for (int t = bid; t < 64 * 16; t += nb) {
    EpiF32 epi{p.y_x, D};
    gemm_tile(p.ycat, D, p.w_out_t, D, D, (t >> 4) * 128, (t & 15) * 128, epi, smem);
  }
}
__device__ void phase_postmix(const Params& p, int bid, int nb, char* smem) {
  const int lane = threadIdx.x & 63, w = threadIdx.x >> 6;
  for (int t = bid * 4 + w; t < T; t += nb * 4) {
    const int b = t / L;
    float4 y[8];
    float ss = 0.f;
#pragma unroll
    for (int c = 0; c < 8; ++c) {
      y[c] = *reinterpret_cast<const float4*>(p.y_x + (size_t)t * D + c * 256 + lane * 4);
      ss += y[c].x * y[c].x + y[c].y * y[c].y + y[c].z * y[c].z + y[c].w * y[c].w;
    }
    ss = wave_sum_fast(ss);
    const float rstd = rsqrtf(ss * (1.f / D) + EPS);
    const float* gm = p.mod + (size_t)b * NMOD + 2 * D;
    float ss1 = 0.f;
#pragma unroll
    for (int c = 0; c < 8; ++c) {
      const int e0 = c * 256 + lane * 4;
      const float4 xv = *reinterpret_cast<const float4*>(p.x + (size_t)t * D + e0);
      const float4 g4 = *reinterpret_cast<const float4*>(gm + e0), gp = *reinterpret_cast<const float4*>(p.g_post_mix + e0);
      y[c].x = xv.x + g4.x * (y[c].x * rstd * gp.x); y[c].y = xv.y + g4.y * (y[c].y * rstd * gp.y);
      y[c].z = xv.z + g4.z * (y[c].z * rstd * gp.z); y[c].w = xv.w + g4.w * (y[c].w * rstd * gp.w);
      ss1 += y[c].x * y[c].x + y[c].y * y[c].y + y[c].z * y[c].z + y[c].w * y[c].w;
      *reinterpret_cast<float4*>(p.out + (size_t)t * D + e0) = y[c];
    }
    ss1 = wave_sum_fast(ss1);
    const float rstd1 = rsqrtf(ss1 * (1.f / D) + EPS);
    const float* sf = p.mod + (size_t)b * NMOD + 3 * D;
    const float* cf = p.mod + (size_t)b * NMOD + 4 * D;
#pragma unroll
    for (int c = 0; c < 8; ++c) {
      const int e0 = c * 256 + lane * 4;
      const float4 g = *reinterpret_cast<const float4*>(p.g_pre_ffn + e0);
      const float4 s4 = *reinterpret_cast<const float4*>(cf + e0), h4 = *reinterpret_cast<const float4*>(sf + e0);
      uint2 pk;
      pk.x = pack2(y[c].x * rstd1 * g.x * (1.f + s4.x) + h4.x, y[c].y * rstd1 * g.y * (1.f + s4.y) + h4.y);
      pk.y = pack2(y[c].z * rstd1 * g.z * (1.f + s4.z) + h4.z, y[c].w * rstd1 * g.w * (1.f + s4.w) + h4.w);
      *reinterpret_cast<uint2*>(p.hx + (size_t)t * D + e0) = pk;
    }
  }
}

__device__ __forceinline__ uint32_t mono_key(float f) {
  uint32_t u = __float_as_uint(f);
  return (u & 0x80000000u) ? ~u : (u | 0x80000000u);
}
__device__ __forceinline__ void ins16(uint32_t (&Lk)[16], uint32_t x) {
#pragma unroll
  for (int i = 0; i < 16; ++i) { uint32_t hi = max(Lk[i], x); x = min(Lk[i], x); Lk[i] = hi; }
}
__device__ __forceinline__ float unmono_key(uint32_t k) {
  return __uint_as_float((k & 0x80000000u) ? (k ^ 0x80000000u) : ~k);
}
typedef __attribute__((ext_vector_type(16))) float f32x16;
__device__ void phase_q_route(const Params& p, int bid, int nb, char* smem) {
  const int tid = opaque_tid(), lane = tid & 63, w = tid >> 6;
  const int wm = w >> 1, wn = w & 1, lr = lane & 15, lq = lane >> 4;
  const int l31 = lane & 31, lh = lane >> 5;
  for (int tile0 = bid; tile0 < 512; tile0 += nb) {
    const int tile = ((nb & 7) == 0 && nb >= 512) ? (((tile0 & 7) * 8 + ((tile0 >> 3) & 7)) * 8 + (tile0 >> 6)) : tile0;
    const int h = tile & 7, m0 = (tile >> 3) * 128;
    {
      f32x4 acc[4][4];
      gemm_mainloop(p.hx, D, p.w_q_t, D, D, m0, h * 128, acc, smem);
#pragma unroll
      for (int i = 0; i < 4; ++i)
#pragma unroll
        for (int j = 0; j < 4; ++j)
#pragma unroll
          for (int r = 0; r < 4; ++r) {
            const int row = wm * 64 + i * 16 + lq * 4 + r, col = wn * 64 + j * 16 + lr;
            *reinterpret_cast<bf16_t*>(smem + swz16(row, col >> 3) + (col & 7) * 2) = f2bf(acc[i][j][r]);
          }
    }
#pragma unroll 4
    for (int r = 0; r < 16; ++r) {
      const int id = tid + 256 * r, row = id >> 4, c4 = id & 15;
      const float* src = ((row < 128) ? p.sk1 : p.sk2) + ((size_t)(h * 128 + (row & 127)) * 64 + c4 * 4);
      const float4 v = *reinterpret_cast<const float4*>(src);
      uint2 pk; pk.x = pack2(v.x, v.y); pk.y = pack2(v.z, v.w);
      *reinterpret_cast<uint2*>(smem + 32768 + swz8(row, c4 >> 1) + (c4 & 1) * 8) = pk;
    }
    __syncthreads();
    uint32_t L1[16], L2[16];
#pragma unroll
    for (int sd = 0; sd < 2; ++sd) {
      uint32_t Lk[16];
#pragma unroll
      for (int i = 0; i < 16; ++i) Lk[i] = 0u;
      const uint32_t kb = (uint32_t)(lh * 4);
#pragma unroll
      for (int ih = 0; ih < 2; ++ih) {
        f32x16 Sa[2];
#pragma unroll
        for (int i = 0; i < 2; ++i)
#pragma unroll
          for (int g2 = 0; g2 < 16; ++g2) Sa[i][g2] = 0.f;
#pragma unroll
        for (int ks = 0; ks < 4; ++ks) {
          const bf16x8 qb = *reinterpret_cast<const bf16x8*>(smem + swz16(w * 32 + l31, sd * 8 + ks * 2 + lh));
#pragma unroll
          for (int i = 0; i < 2; ++i) {
            const bf16x8 ka = *reinterpret_cast<const bf16x8*>(smem + 32768 + swz8(sd * 128 + (ih * 2 + i) * 32 + l31, ks * 2 + lh));
            Sa[i] = __builtin_amdgcn_mfma_f32_32x32x16_bf16(ka, qb, Sa[i], 0, 0, 0);
          }
        }
#pragma unroll
        for (int i = 0; i < 2; ++i)
#pragma unroll
          for (int g2 = 0; g2 < 16; ++g2)
            ins16(Lk, (mono_key(Sa[i][g2]) & ~0x7Fu) | (uint32_t)((ih * 2 + i) * 32 + (g2 & 3) + 8 * (g2 >> 2)) | kb);
      }
#pragma unroll
      for (int i = 0; i < 8; ++i) {
        const uint32_t t1 = (uint32_t)__shfl_xor((int)Lk[15 - i], 32), t2 = (uint32_t)__shfl_xor((int)Lk[i], 32);
        Lk[i] = max(Lk[i], t1); Lk[15 - i] = max(Lk[15 - i], t2);
      }
#pragma unroll
      for (int dd = 8; dd >= 1; dd >>= 1)
#pragma unroll
        for (int i = 0; i < 16; ++i)
          if ((i & dd) == 0) { const uint32_t hi = max(Lk[i], Lk[i + dd]), lo = min(Lk[i], Lk[i + dd]); Lk[i] = hi; Lk[i + dd] = lo; }
#pragma unroll
      for (int r = 0; r < 16; ++r) { if (sd == 0) L1[r] = Lk[r]; else L2[r] = Lk[r]; }
    }
    __syncthreads();
    uint32_t* ib = reinterpret_cast<uint32_t*>(smem) + w * 1088 + l31 * 34;
    if (lh == 0) {
#pragma unroll
      for (int r = 0; r < 16; ++r) { ib[r] = L1[r] & 127u; ib[16 + r] = L2[r] & 127u; }
    }
    float v1[16], v2[16];
#pragma unroll
    for (int r = 0; r < 16; ++r) { v1[r] = unmono_key(L1[r] & ~0x7Fu); v2[r] = unmono_key(L2[r] & ~0x7Fu); }
    uint32_t C[16];
#pragma unroll
    for (int i = 0; i < 16; ++i) C[i] = 0u;
#pragma unroll
    for (int a = 0; a < 16; ++a)
#pragma unroll
      for (int bq = 0; bq < 16; ++bq)
        if ((a + 1) * (bq + 1) <= 16) ins16(C, (mono_key(v1[a] + v2[bq]) & ~0xFFu) | (uint32_t)(a * 16 + bq));
    float ts[16]; int te[16];
    __builtin_amdgcn_wave_barrier();
#pragma unroll
    for (int r = 0; r < 16; ++r) {
      const uint32_t code = C[r] & 0xFFu;
      te[r] = (int)(ib[code >> 4] * 128u + ib[16 + (code & 15u)]);
      ts[r] = unmono_key(C[r] & ~0xFFu);
    }
    const float mx = ts[0];
    float den = 0.f;
#pragma unroll
    for (int r = 0; r < 16; ++r) { ts[r] = __expf(ts[r] - mx); den += ts[r]; }
    const float inv = 1.f / den;
    const size_t ob = (size_t)(m0 + w * 32 + l31) * 128 + h * 16;
    if (lh == 0) {
#pragma unroll
      for (int r = 0; r < 16; r += 4) *reinterpret_cast<int4*>(p.idx + ob + r) = int4{te[r], te[r + 1], te[r + 2], te[r + 3]};
    } else {
#pragma unroll
      for (int r = 0; r < 16; r += 4)
        *reinterpret_cast<float4*>(p.gate + ob + r) = float4{ts[r] * inv, ts[r + 1] * inv, ts[r + 2] * inv, ts[r + 3] * inv};
    }
    __syncthreads();
  }
}

typedef __attribute__((ext_vector_type(2))) float f32x2;
__device__ __forceinline__ void fp8x16_to_f32(const uint4 q, f32x2 (&o)[8]) {
  o[0] = __builtin_amdgcn_cvt_pk_f32_fp8((int)q.x, false); o[1] = __builtin_amdgcn_cvt_pk_f32_fp8((int)q.x, true);
  o[2] = __builtin_amdgcn_cvt_pk_f32_fp8((int)q.y, false); o[3] = __builtin_amdgcn_cvt_pk_f32_fp8((int)q.y, true);
  o[4] = __builtin_amdgcn_cvt_pk_f32_fp8((int)q.z, false); o[5] = __builtin_amdgcn_cvt_pk_f32_fp8((int)q.z, true);
  o[6] = __builtin_amdgcn_cvt_pk_f32_fp8((int)q.w, false); o[7] = __builtin_amdgcn_cvt_pk_f32_fp8((int)q.w, true);
}
__device__ __forceinline__ unsigned my_xcc_id() { return (unsigned)__builtin_amdgcn_s_getreg((3 << 11) | 20) & 7u; }

__device__ void phase_exp_u(const Params& p, char* smem) {
  const int tid = opaque_tid(), lane = tid & 63, w = tid >> 6;
  const int sub = lane >> 4, cc = lane & 15;
  const unsigned myx = my_xcc_id();
  int* sh = reinterpret_cast<int*>(smem);
  int* si = reinterpret_cast<int*>(smem + 64) + w * 256;
  float* pbuf = reinterpret_cast<float*>(p.ycat);
  {
    unsigned qcur = 0;
    for (;;) {
      __syncthreads();
      if (tid == 0) {
        int found = -1; unsigned fx = 0;
        for (; qcur < 8; ++qcur) {
          fx = (myx + qcur) & 7u;
          const int c = (int)atomicAdd(&p.ctr[16 + fx], 1u);
          if (c < 256) { found = c; break; }
        }
        sh[0] = found; sh[1] = (int)fx;
      }
      __syncthreads();
      const int chunk = sh[0];
      const unsigned x = (unsigned)sh[1];
      if (chunk < 0) break;
      for (int tt = 0; tt < 8; ++tt) {
        const int t = chunk * 32 + w * 8 + tt;
        __builtin_amdgcn_wave_barrier();
        si[lane] = p.idx[(size_t)t * 128 + lane]; si[64 + lane] = p.idx[(size_t)t * 128 + 64 + lane];
        __builtin_amdgcn_wave_barrier();
        f32x2 hf[8];
#pragma unroll
        for (int q2 = 0; q2 < 2; ++q2) {
          const uint4 hq = *reinterpret_cast<const uint4*>(p.hx + (size_t)t * D + x * 256 + cc * 16 + q2 * 8);
          hf[q2 * 4 + 0] = f32x2{bflo(hq.x), bfhi(hq.x)}; hf[q2 * 4 + 1] = f32x2{bflo(hq.y), bfhi(hq.y)};
          hf[q2 * 4 + 2] = f32x2{bflo(hq.z), bfhi(hq.z)}; hf[q2 * 4 + 3] = f32x2{bflo(hq.w), bfhi(hq.w)};
        }
        const uint8_t* ub = p.U8 + (size_t)x * ((size_t)16384 * 256) + cc * 16;
        uint4 qa[8], qb[8];
#define EU_LOAD(q_, bt_) _Pragma("unroll") for (int k = 0; k < 8; ++k) q_[k] = *reinterpret_cast<const uint4*>(ub + (size_t)si[((bt_) * 8 + k) * 4 + sub] * 256)
#define EU_COMP(q_, kb_)                                                                                                \
  _Pragma("unroll") for (int k = 0; k < 8; ++k) {                                                                       \
    f32x2 uf[8];                                                                                                        \
    fp8x16_to_f32(q_[k], uf);                                                                                           \
    f32x2 d2 = hf[0] * uf[0];                                                                                           \
    _Pragma("unroll") for (int e = 1; e < 8; ++e) d2 += hf[e] * uf[e];                                                  \
    float d = d2.x + d2.y;                                                                                              \
    d += dpp_mov<0xB1>(d); d += dpp_mov<0x4E>(d); d += dpp_mov<0x124>(d); d += dpp_mov<0x128>(d);                       \
    mine = (cc == (kb_) + k) ? d : mine;                                                                                \
  }
        float mine = 0.f;
        EU_LOAD(qa, 0); EU_LOAD(qb, 1);
        EU_COMP(qa, 0); EU_LOAD(qa, 2);
        EU_COMP(qb, 8); EU_LOAD(qb, 3);
        pbuf[((size_t)x * T + t) * 128 + cc * 4 + sub] = mine * (1.f / 512.f);
        mine = 0.f;
        EU_COMP(qa, 0);
        EU_COMP(qb, 8);
        pbuf[((size_t)x * T + t) * 128 + (16 + cc) * 4 + sub] = mine * (1.f / 512.f);
#undef EU_LOAD
#undef EU_COMP
      }
    }
  }
}

__device__ void phase_exp_v(const Params& p, char* smem) {
  const int tid = opaque_tid(), lane = tid & 63, w = tid >> 6;
  const int sub = lane >> 4, cc = lane & 15;
  const unsigned myx = my_xcc_id();
  int* sh = reinterpret_cast<int*>(smem);
  int* si = reinterpret_cast<int*>(smem + 64) + w * 256;
  float* sc = reinterpret_cast<float*>(si + 128);
  float* yf = p.y_x;
  {
    unsigned qcur = 0;
    for (;;) {
      __syncthreads();
      if (tid == 0) {
        int found = -1; unsigned fx = 0;
        for (; qcur < 8; ++qcur) {
          fx = (myx + qcur) & 7u;
          const int c = (int)atomicAdd(&p.ctr[32 + fx], 1u);
          if (c < 256) { found = c; break; }
        }
        sh[0] = found; sh[1] = (int)fx;
      }
      __syncthreads();
      const int chunk = sh[0];
      const unsigned x = (unsigned)sh[1];
      if (chunk < 0) break;
      for (int tt = 0; tt < 8; ++tt) {
        const int t = chunk * 32 + w * 8 + tt;
        __builtin_amdgcn_wave_barrier();
        si[lane] = p.idx[(size_t)t * 128 + lane]; si[64 + lane] = p.idx[(size_t)t * 128 + 64 + lane];
        {
          const float* pb = reinterpret_cast<const float*>(p.ycat) + (size_t)t * 128;
          float d0 = 0.f, d1 = 0.f;
#pragma unroll
          for (int xs = 0; xs < 8; ++xs) { d0 += pb[(size_t)xs * T * 128 + lane]; d1 += pb[(size_t)xs * T * 128 + 64 + lane]; }
          sc[lane] = p.gate[(size_t)t * 128 + lane] * 0.5f * d0 * (1.f + erff(d0 * 0.70710678118654752f));
          sc[64 + lane] = p.gate[(size_t)t * 128 + 64 + lane] * 0.5f * d1 * (1.f + erff(d1 * 0.70710678118654752f));
        }
        __builtin_amdgcn_wave_barrier();
        f32x2 acc[8];
#pragma unroll
        for (int e = 0; e < 8; ++e) acc[e] = f32x2{0.f, 0.f};
        const uint8_t* vb = p.V8 + (size_t)x * ((size_t)16384 * 256) + cc * 16;
        uint4 qa[8], qb[8];
#define EV_LOAD(q_, bt_) _Pragma("unroll") for (int k = 0; k < 8; ++k) q_[k] = *reinterpret_cast<const uint4*>(vb + (size_t)si[((bt_) * 8 + k) * 4 + sub] * 256)
#define EV_COMP(q_, bt_)                                                                                                \
  _Pragma("unroll") for (int k = 0; k < 8; ++k) {                                                                       \
    f32x2 vf[8];                                                                                                        \
    fp8x16_to_f32(q_[k], vf);                                                                                           \
    const float cfk = sc[((bt_) * 8 + k) * 4 + sub];                                                                    \
    const f32x2 c2 = f32x2{cfk, cfk};                                                                                   \
    _Pragma("unroll") for (int e = 0; e < 8; ++e) acc[e] += c2 * vf[e];                                                 \
  }
        EV_LOAD(qa, 0); EV_LOAD(qb, 1);
        EV_COMP(qa, 0); EV_LOAD(qa, 2);
        EV_COMP(qb, 1); EV_LOAD(qb, 3);
        EV_COMP(qa, 2);
        EV_COMP(qb, 3);
#undef EV_LOAD
#undef EV_COMP
        {
          float* red = reinterpret_cast<float*>(smem + 8192) + w * 1280;
          float* mr = red + (sub * 16 + cc) * 20;
#pragma unroll
          for (int q4 = 0; q4 < 4; ++q4)
            *reinterpret_cast<float4*>(mr + q4 * 4) = float4{acc[q4 * 2].x, acc[q4 * 2].y, acc[q4 * 2 + 1].x, acc[q4 * 2 + 1].y};
          __builtin_amdgcn_wave_barrier();
          const int part = sub;
          float4 r0 = *reinterpret_cast<const float4*>(red + (0 * 16 + cc) * 20 + part * 4);
          float4 r1 = *reinterpret_cast<const float4*>(red + (1 * 16 + cc) * 20 + part * 4);
          float4 r2 = *reinterpret_cast<const float4*>(red + (2 * 16 + cc) * 20 + part * 4);
          float4 r3 = *reinterpret_cast<const float4*>(red + (3 * 16 + cc) * 20 + part * 4);
          const float sc512 = 1.f / 512.f;
          float4 o4 = float4{(r0.x + r1.x + r2.x + r3.x) * sc512, (r0.y + r1.y + r2.y + r3.y) * sc512,
                             (r0.z + r1.z + r2.z + r3.z) * sc512, (r0.w + r1.w + r2.w + r3.w) * sc512};
          *reinterpret_cast<float4*>(yf + (size_t)t * D + x * 256 + cc * 16 + part * 4) = o4;
          __builtin_amdgcn_wave_barrier();
        }
      }
    }
  }
}

__device__ void phase_exp_final(const Params& p, int bid, int nb, char* smem) {
  const int lane = threadIdx.x & 63, w = threadIdx.x >> 6;
  const float* yf = p.y_x;
  for (int t = bid * 4 + w; t < T; t += nb * 4) {
    const int b = t / L;
    float4 y[8];
    float ss = 0.f;
#pragma unroll
    for (int c = 0; c < 8; ++c) {
      y[c] = *reinterpret_cast<const float4*>(yf + (size_t)t * D + c * 256 + lane * 4);
      ss += y[c].x * y[c].x + y[c].y * y[c].y + y[c].z * y[c].z + y[c].w * y[c].w;
    }
    ss = wave_sum_fast(ss);
    const float rstd = rsqrtf(ss * (1.f / D) + EPS);
    const float* gfx = p.mod + (size_t)b * NMOD + 5 * D;
#pragma unroll
    for (int c = 0; c < 8; ++c) {
      const int e0 = c * 256 + lane * 4;
      float* o = p.out + (size_t)t * D + e0;
      float4 xo = *reinterpret_cast<const float4*>(o);
      const float4 g4 = *reinterpret_cast<const float4*>(gfx + e0), gp = *reinterpret_cast<const float4*>(p.g_post_ffn + e0);
      xo.x += g4.x * (y[c].x * rstd * gp.x); xo.y += g4.y * (y[c].y * rstd * gp.y);
      xo.z += g4.z * (y[c].z * rstd * gp.z); xo.w += g4.w * (y[c].w * rstd * gp.w);
      *reinterpret_cast<float4*>(o) = xo;
    }
  }
}

#define XB_TMO      128
#define XB_XCNT(j)  (256  + 64 * (j))
#define XB_XSUB(j)  (1280 + 64 * (j))
#define XB_XGEN(j)  (2304 + 64 * (j))
#define XB_TOP      3328
#define XB_TOPGEN   3392
#define XCD_BAR_WORDS 3456
#define XB_SPIN_CAP (1u << 22)
#define LAS __attribute__((address_space(3)))
__device__ __forceinline__ unsigned xb_ld(unsigned* p)              { return __hip_atomic_load(p, __ATOMIC_RELAXED, __HIP_MEMORY_SCOPE_AGENT); }
__device__ __forceinline__ unsigned xb_add(unsigned* p, unsigned v) { return __hip_atomic_fetch_add(p, v, __ATOMIC_RELAXED, __HIP_MEMORY_SCOPE_AGENT); }
__device__ __forceinline__ unsigned xb_xcc_id() { return (unsigned)__builtin_amdgcn_s_getreg((3 << 11) | 20) & 0xFu; }
#define XB_SPIN(cond, bar) do { unsigned _sp = 0; while (cond) { __builtin_amdgcn_s_sleep(1); \
    if ((++_sp & 255u) == 0u) { if (xb_ld(&(bar)[XB_TMO])) break; if (_sp > XB_SPIN_CAP) { atomicAdd(&(bar)[XB_TMO], 1u); break; } } } } while (0)
struct XcdBarrier { unsigned* bar; unsigned x; volatile LAS unsigned* st; };
__device__ __forceinline__ XcdBarrier xcd_barrier_post(unsigned* bar, volatile LAS unsigned* st) {
  XcdBarrier b; b.bar = bar; b.x = xb_xcc_id(); b.st = st;
  if (threadIdx.x == 0) (void)xb_add(&bar[XB_XCNT(b.x)], 1u);
  return b;
}
__device__ __forceinline__ void xcd_barrier_complete(unsigned* bar, unsigned x, unsigned& nloc, unsigned& nx) {
  const unsigned G = gridDim.x * gridDim.y * gridDim.z;
  unsigned sum, cnt, mine, sp = 0u;
  for (;;) {
    sum = 0u; cnt = 0u; mine = 0u;
#pragma unroll
    for (unsigned j = 0; j < 16; ++j) { const unsigned c = xb_ld(&bar[XB_XCNT(j)]); sum += c; cnt += (c > 0u) ? 1u : 0u; mine = (j == x) ? c : mine; }
    if (sum == G) break;
    __builtin_amdgcn_s_sleep(1);
    if ((++sp & 255u) == 0u) { if (xb_ld(&bar[XB_TMO])) break; if (sp > XB_SPIN_CAP) { atomicAdd(&bar[XB_TMO], 1u); break; } }
  }
  nloc = mine > 0u ? mine : 1u; nx = cnt > 0u ? cnt : 1u;
}
__device__ __forceinline__ void xcd_barrier(const XcdBarrier& b) {
  asm volatile("s_waitcnt vmcnt(0)" ::: "memory");
  __syncthreads();
  if (threadIdx.x == 0) {
    unsigned* bar = b.bar;
    __builtin_amdgcn_s_waitcnt(0);
    unsigned nloc = b.st[0], nx = b.st[1];
    if (nloc == 0u) { xcd_barrier_complete(bar, b.x, nloc, nx); b.st[0] = nloc; b.st[1] = nx; }
    const unsigned old = xb_add(&bar[XB_XSUB(b.x)], 1u);
    const unsigned gen = old / nloc;
    if (old + 1u == (gen + 1u) * nloc) {
      __builtin_amdgcn_fence(__ATOMIC_RELEASE, "agent");
      asm volatile("s_waitcnt vmcnt(0)" ::: "memory");
      const unsigned og = xb_add(&bar[XB_TOP], 1u);
      const unsigned tg = og / nx;
      if (og + 1u == (tg + 1u) * nx) xb_add(&bar[XB_TOPGEN], 1u);
      else XB_SPIN(xb_ld(&bar[XB_TOPGEN]) == tg, bar);
      __builtin_amdgcn_fence(__ATOMIC_ACQUIRE, "agent");
      xb_add(&bar[XB_XGEN(b.x)], 1u);
      asm volatile("s_waitcnt vmcnt(0)" ::: "memory");
    } else {
      XB_SPIN(xb_ld(&bar[XB_XGEN(b.x)]) == gen, bar);
      __builtin_amdgcn_fence(__ATOMIC_ACQUIRE, "agent");
      asm volatile("s_waitcnt vmcnt(0)" ::: "memory");
    }
  }
  __syncthreads();
}

__global__ void __launch_bounds__(NTHREADS, 2) fwd_mega(Params p) {
  __shared__ __attribute__((aligned(16))) char smem[75808];
  const int bid = blockIdx.x, nb = gridDim.x;
  volatile LAS unsigned* st = (volatile LAS unsigned*)(smem + 75792);
  if (threadIdx.x == 0) { st[0] = 0u; st[1] = 0u; }
  __syncthreads();
  const XcdBarrier bar = xcd_barrier_post(p.bar, st);
  phase_prep(p, bid, nb, smem);        xcd_barrier(bar);
  phase_fold(p, bid, nb, smem);        xcd_barrier(bar);
  phase_norm_mod(p, bid, nb, smem);    xcd_barrier(bar);
  phase_inproj(p, bid, nb, smem);      xcd_barrier(bar);
  phase_ssm_pre(p, bid, nb, smem);     xcd_barrier(bar);
  phase_ssd_dft(p, bid, nb, smem);     xcd_barrier(bar);
  phase_ssm_post(p, bid, nb, smem);    xcd_barrier(bar);
  phase_outproj(p, bid, nb, smem);     xcd_barrier(bar);
  phase_postmix(p, bid, nb, smem);     xcd_barrier(bar);
  phase_q_route(p, bid, nb, smem);     xcd_barrier(bar);
  phase_exp_u(p, smem);                xcd_barrier(bar);
  phase_exp_v(p, smem);                xcd_barrier(bar);
  phase_exp_final(p, bid, nb, smem);
}

}

extern "C" void kernel_launch(void* const* d_in, const int* in_sizes, int n_in, void* d_out, int out_size, void* d_ws,
                              size_t ws_size, hipStream_t stream) {
  Params p{};
  const float** fp = reinterpret_cast<const float**>(&p);
  for (int i = 0; i < 27; ++i) fp[i] = (const float*)d_in[i];
  p.out = (float*)d_out;
  char* ws = (char*)d_ws;
  size_t off = 0;
  auto take = [&](size_t bytes) { char* r = ws + off; off += (bytes + 255) & ~(size_t)255; return r; };
  p.U8 = (uint8_t*)take((size_t)16384 * D);
  p.V8 = (uint8_t*)take((size_t)16384 * D);
  p.w_in_t = (bf16_t*)take((size_t)NPROJ * D * 2);
  p.w_out_t = (bf16_t*)take((size_t)D * D * 2);
  p.w_q_t = (bf16_t*)take((size_t)1024 * D * 2);
  p.w_in_f = (bf16_t*)take((size_t)D * 1024 * 2);
  p.WcsT = (bf16_t*)take((size_t)4 * 512 * 256 * 2);
  p.dftm = (bf16_t*)take((size_t)1024 * 2048 * 2);
  p.Fs = (bf16_t*)take((size_t)NB * 1024 * 2048 * 2);
  p.partial = (float*)take((size_t)KSPLIT * 5 * NMOD * 4);
  p.mod = (float*)take((size_t)5 * NMOD * 4);
  p.hx = (bf16_t*)take((size_t)T * D * 2);
  p.hc = (bf16_t*)take((size_t)TC * D * 2);
  p.ABt = (bf16_t*)take((size_t)NB * 1024 * 4096 * 2);
  p.q = (float*)p.ABt;
  p.z = (bf16_t*)take((size_t)T * 1024 * 2);
  char* r1 = take(0);
  p.xbcraw = (float*)take((size_t)T * DXBC * 4);
  p.xbcraw_c = (float*)take((size_t)TC * DXBC * 4);
  p.act_tm = (bf16_t*)take((size_t)(T + TC) * DXBC * 2);
  p.act_cm_x = (bf16_t*)take((size_t)NB * 1280 * L * 2);
  p.act_cm_c = (bf16_t*)take((size_t)NB * 1280 * CTX * 2);
  p.y_x = (float*)r1;
  p.dtraw = (float*)take((size_t)T * 32 * 4);
  p.dtraw_c = (float*)take((size_t)TC * 32 * 4);
  p.dtf = (float*)take((size_t)T * 16 * 4);
  p.dtb = (float*)take((size_t)T * 16 * 4);
  p.dtf_c = (float*)take((size_t)TC * 16 * 4);
  p.dtb_c = (float*)take((size_t)TC * 16 * 4);
  p.yf = (float*)take((size_t)T * 1024 * 4);
  p.yb = (float*)take((size_t)T * 1024 * 4);
  p.ctr = (unsigned*)take(256);
  p.bar = (unsigned*)take((size_t)XCD_BAR_WORDS * 4);
  p.ycat = (bf16_t*)take((size_t)T * D * 2);
  p.idx = (int*)take((size_t)T * 128 * 4);
  p.gate = (float*)take((size_t)T * 128 * 4);
  if (off > ws_size) { fprintf(stderr, "kernel_launch: workspace too small: need %zu have %zu\n", off, ws_size); return; }
  static int grid_blocks = 0;
  if (!grid_blocks) {
    int dev = 0, cus = 0, per_cu = 0;
    hipGetDevice(&dev);
    hipDeviceGetAttribute(&cus, hipDeviceAttributeMultiprocessorCount, dev);
    hipOccupancyMaxActiveBlocksPerMultiprocessor(&per_cu, fwd_mega, NTHREADS, 0);
    if (per_cu > 2) per_cu = 2;
    grid_blocks = cus * per_cu;
    if (grid_blocks <= 0) { fprintf(stderr, "kernel_launch: occupancy query gave %d x %d\n", cus, per_cu); grid_blocks = -1; }
  }
  if (grid_blocks < 0) return;
  (void)hipMemsetAsync(p.bar, 0, (size_t)XCD_BAR_WORDS * 4, stream);
  void* args[] = {&p};
  hipError_t e = hipLaunchCooperativeKernel((void*)fwd_mega, dim3(grid_blocks), dim3(NTHREADS), args, 0, stream);
  if (e != hipSuccess) fprintf(stderr, "cooperative launch failed: %s (grid %d)\n", hipGetErrorString(e), grid_blocks);
}
```

```cpp
#include <hip/hip_runtime.h>
#include <hip/hip_cooperative_groups.h>
#include <stdint.h>
#include <stdio.h>

namespace cg = cooperative_groups;
namespace {

typedef __attribute__((ext_vector_type(8))) short bf16x8;
typedef __attribute__((ext_vector_type(4))) float f32x4;
typedef unsigned short bf16_t;

constexpr int D = 2048, NB = 4, L = 2048, T = NB * L, CTX = 256, TC = NB * CTX;
constexpr int NMOD = 6 * D;
constexpr int NH = 16, HP = 64, NS = 128, DXBC = 1536;
constexpr int DIN = 3616;
constexpr int NPROJ = 4736;
constexpr int KSPLIT = 32;
constexpr float EPS = 1e-6f;
constexpr int NTHREADS = 256;

__device__ __forceinline__ bf16_t f2bf(float f) { __bf16 h = (__bf16)f; return __builtin_bit_cast(unsigned short, h); }
__device__ __forceinline__ float bf2f(bf16_t h) { return __uint_as_float(((uint32_t)h) << 16); }
__device__ __forceinline__ uint32_t pack2(float a, float b) {
  typedef __attribute__((ext_vector_type(2))) __bf16 bf16x2_t;
  typedef __attribute__((ext_vector_type(2))) float f32x2_t;
  const f32x2_t v = {a, b};
  return __builtin_bit_cast(uint32_t, __builtin_convertvector(v, bf16x2_t));
}
__device__ __forceinline__ float bflo(uint32_t w) { return __uint_as_float(w << 16); }
__device__ __forceinline__ float bfhi(uint32_t w) { return __uint_as_float(w & 0xffff0000u); }
__device__ __forceinline__ float silu_f(float v) { return v / (1.f + __expf(-v)); }
__device__ __forceinline__ float softplus_f(float v) { return v > 20.f ? v : log1pf(__expf(v)); }

__device__ __forceinline__ int opaque_tid() { int t = threadIdx.x; asm volatile("" : "+v"(t)); return t; }
__device__ __forceinline__ float wave_sum(float v) {
#pragma unroll
  for (int o = 32; o > 0; o >>= 1) v += __shfl_xor(v, o);
  return v;
}
template <int CTRL>
__device__ __forceinline__ float dpp_mov(float v) {
  return __int_as_float(__builtin_amdgcn_update_dpp(0, __float_as_int(v), CTRL, 0xF, 0xF, true));
}
__device__ __forceinline__ float wave_sum_fast(float v) {
  v += dpp_mov<0xB1>(v); v += dpp_mov<0x4E>(v); v += dpp_mov<0x124>(v); v += dpp_mov<0x128>(v);
  v += __shfl_xor(v, 16); v += __shfl_xor(v, 32);
  return v;
}
__device__ __forceinline__ float wave_max(float v) {
#pragma unroll
  for (int o = 32; o > 0; o >>= 1) v = fmaxf(v, __shfl_xor(v, o));
  return v;
}
__device__ __forceinline__ float block_sum(float v, float* red) {
  v = wave_sum(v);
  __syncthreads();
  if ((threadIdx.x & 63) == 0) red[threadIdx.x >> 6] = v;
  __syncthreads();
  return red[0] + red[1] + red[2] + red[3];
}

struct Params {
  const float *x, *c, *ctx, *c_ctx, *w_mod, *b_mod, *g_pre_mix, *g_post_mix, *g_pre_ffn, *g_post_ffn;
  const float *w_in, *w_fmix, *conv_w, *conv_b, *dt_bias_f, *dt_bias_b, *a_log_f, *a_log_b, *d_skip_f, *d_skip_b;
  const float *ssm_norm_w, *w_out, *w_query, *sk1, *sk2, *eu, *ev;
  float* out;
  uint8_t *U8, *V8;
  bf16_t *w_in_t, *w_out_t, *w_q_t, *w_in_f, *WcsT, *dftm, *Fs;
  float *partial, *mod;
  bf16_t *hx, *hc, *ABt, *z;
  bf16_t *xbcraw, *xbcraw_c;
  float *dtraw, *dtraw_c, *dtf, *dtb, *dtf_c, *dtb_c;
  bf16_t *act_tm, *act_cm_x, *act_cm_c;
  float *yf, *yb;
  unsigned* ctr; unsigned* bar;
  bf16_t* ycat;
  float *y_x, *q, *gate;
  int* idx;
  int pad0, pad1;
};

__device__ __forceinline__ void gemm_mainloop(const bf16_t* __restrict__ A, int lda, const bf16_t* __restrict__ Bt, int ldb,
                                              int K, int m0, int n0, f32x4 (&acc)[4][4], char* smem) {
  const int tid = opaque_tid(), lane = tid & 63, w = tid >> 6;
  const int wm = w >> 1, wn = w & 1;
#pragma unroll
  for (int i = 0; i < 4; ++i)
#pragma unroll
    for (int j = 0; j < 4; ++j) acc[i][j] = f32x4{0.f, 0.f, 0.f, 0.f};

  const int nk = K / 64;
  const int rowoff = lane >> 3, lch = (lane & 7) ^ rowoff;
  const bf16_t* gA = A + (size_t)(m0 + w * 8 + rowoff) * lda + lch * 8;
  const bf16_t* gB = Bt + (size_t)(n0 + w * 8 + rowoff) * ldb + lch * 8;
#define GSTAGE(buf_, kt_)                                                                                               \
  do {                                                                                                                  \
    _Pragma("unroll") for (int i_ = 0; i_ < 4; ++i_) {                                                                  \
      __builtin_amdgcn_global_load_lds((const unsigned*)(gA + (size_t)(i_ * 32) * lda + (kt_) * 64),                    \
                                       (unsigned*)(smem + (buf_) * 32768 + (i_ * 4 + w) * 1024), 16, 0, 0);             \
      __builtin_amdgcn_global_load_lds((const unsigned*)(gB + (size_t)(i_ * 32) * ldb + (kt_) * 64),                    \
                                       (unsigned*)(smem + (buf_) * 32768 + 16384 + (i_ * 4 + w) * 1024), 16, 0, 0);     \
    }                                                                                                                   \
  } while (0)
  GSTAGE(0, 0);
  asm volatile("s_waitcnt vmcnt(0)" ::: "memory");
  __syncthreads();
  for (int kt = 0; kt < nk; ++kt) {
    const int cur = kt & 1;
    if (kt + 1 < nk) GSTAGE(cur ^ 1, kt + 1);
    const char* sA = smem + cur * 32768;
    const char* sB = sA + 16384;
#pragma unroll
    for (int kk = 0; kk < 2; ++kk) {
      bf16x8 af[4], bfr[4];
      const int ch = kk * 4 + (lane >> 4);
#pragma unroll
      for (int i = 0; i < 4; ++i) {
        int row = wm * 64 + i * 16 + (lane & 15);
        af[i] = *reinterpret_cast<const bf16x8*>(sA + row * 128 + ((ch ^ (row & 7)) << 4));
        int col = wn * 64 + i * 16 + (lane & 15);
        bfr[i] = *reinterpret_cast<const bf16x8*>(sB + col * 128 + ((ch ^ (col & 7)) << 4));
      }
#pragma unroll
      for (int i = 0; i < 4; ++i)
#pragma unroll
        for (int j = 0; j < 4; ++j) acc[i][j] = __builtin_amdgcn_mfma_f32_16x16x32_bf16(af[i], bfr[j], acc[i][j], 0, 0, 0);
    }
    asm volatile("s_waitcnt vmcnt(0)" ::: "memory");
    __syncthreads();
  }
#undef GSTAGE
}

template <class Epi>
__device__ __forceinline__ void gemm_tile(const bf16_t* __restrict__ A, int lda, const bf16_t* __restrict__ Bt, int ldb,
                                          int K, int m0, int n0, const Epi& epi, char* smem) {
  const int lane = threadIdx.x & 63, w = threadIdx.x >> 6;
  const int wm = w >> 1, wn = w & 1;
  f32x4 acc[4][4];
  gemm_mainloop(A, lda, Bt, ldb, K, m0, n0, acc, smem);
#pragma unroll
  for (int i = 0; i < 4; ++i)
#pragma unroll
    for (int j = 0; j < 4; ++j) {
      int row = m0 + wm * 64 + i * 16 + (lane >> 4) * 4;
      int col = n0 + wn * 64 + j * 16 + (lane & 15);
      epi(row, col, acc[i][j]);
    }
}

__device__ __forceinline__ void gemm_mainloop_n256(const bf16_t* __restrict__ A, int lda, const bf16_t* __restrict__ Bt, int ldb,
                                                   int K, int m0, int n0, f32x4 (&acc)[4][8], char* smem) {
  const int tid = opaque_tid(), lane = tid & 63, w = tid >> 6;
  const int wm = w >> 1, wn = w & 1;
#pragma unroll
  for (int i = 0; i < 4; ++i)
#pragma unroll
    for (int j = 0; j < 8; ++j) acc[i][j] = f32x4{0.f, 0.f, 0.f, 0.f};
  const int nk = K / 64;
  const int rowoff = lane >> 3, lch = (lane & 7) ^ rowoff;
  const bf16_t* gA = A + (size_t)(m0 + w * 8 + rowoff) * lda + lch * 8;
  const bf16_t* gB = Bt + (size_t)(n0 + w * 8 + rowoff) * ldb + lch * 8;
  const int fr = lane & 15, fq = lane >> 4;
  for (int kt = 0; kt < nk; ++kt) {
#pragma unroll
    for (int i_ = 0; i_ < 4; ++i_)
      __builtin_amdgcn_global_load_lds((const unsigned*)(gA + (size_t)(i_ * 32) * lda + kt * 64),
                                       (unsigned*)(smem + (i_ * 4 + w) * 1024), 16, 0, 0);
#pragma unroll
    for (int i_ = 0; i_ < 8; ++i_)
      __builtin_amdgcn_global_load_lds((const unsigned*)(gB + (size_t)(i_ * 32) * ldb + kt * 64),
                                       (unsigned*)(smem + 16384 + (i_ * 4 + w) * 1024), 16, 0, 0);
    asm volatile("s_waitcnt vmcnt(0)" ::: "memory");
    __syncthreads();
    const char* sA = smem;
    const char* sB = smem + 16384;
#pragma unroll
    for (int kk = 0; kk < 2; ++kk) {
      bf16x8 af[4], bfr[8];
      const int ch = kk * 4 + fq;
#pragma unroll
      for (int i = 0; i < 4; ++i) {
        const int row = wm * 64 + i * 16 + fr;
        af[i] = *reinterpret_cast<const bf16x8*>(sA + row * 128 + ((ch ^ (row & 7)) << 4));
      }
#pragma unroll
      for (int j = 0; j < 8; ++j) {
        const int col = wn * 128 + j * 16 + fr;
        bfr[j] = *reinterpret_cast<const bf16x8*>(sB + col * 128 + ((ch ^ (col & 7)) << 4));
      }
#pragma unroll
      for (int i = 0; i < 4; ++i)
#pragma unroll
        for (int j = 0; j < 8; ++j) acc[i][j] = __builtin_amdgcn_mfma_f32_16x16x32_bf16(af[i], bfr[j], acc[i][j], 0, 0, 0);
    }
    __syncthreads();
  }
}
template <class Epi>
__device__ __forceinline__ void gemm_tile_n256(const bf16_t* __restrict__ A, int lda, const bf16_t* __restrict__ Bt, int ldb,
                                               int K, int m0, int n0, const Epi& epi, char* smem) {
  const int lane = threadIdx.x & 63, w = threadIdx.x >> 6;
  const int wm = w >> 1, wn = w & 1;
  f32x4 acc[4][8];
  gemm_mainloop_n256(A, lda, Bt, ldb, K, m0, n0, acc, smem);
#pragma unroll
  for (int i = 0; i < 4; ++i)
#pragma unroll
    for (int j = 0; j < 8; ++j) {
      int row = m0 + wm * 64 + i * 16 + (lane >> 4) * 4;
      int col = n0 + wn * 128 + j * 16 + (lane & 15);
      epi(row, col, acc[i][j]);
    }
}

struct EpiF32 {
  float* C; int ldc;
  __device__ __forceinline__ void operator()(int row, int col, f32x4 v) const {
#pragma unroll
    for (int r = 0; r < 4; ++r) C[(size_t)(row + r) * ldc + col] = v[r];
  }
};
struct EpiBf16 {
  bf16_t* C; int ldc;
  __device__ __forceinline__ void operator()(int row, int col, f32x4 v) const {
#pragma unroll
    for (int r = 0; r < 4; ++r) C[(size_t)(row + r) * ldc + col] = f2bf(v[r]);
  }
};
struct EpiBf16T {
  bf16_t* Ct; int ldc;
  __device__ __forceinline__ void operator()(int row, int col, f32x4 v) const {
    uint2 pk; pk.x = pack2(v[0], v[1]); pk.y = pack2(v[2], v[3]);
    *reinterpret_cast<uint2*>(Ct + (size_t)col * ldc + row) = pk;
  }
};
struct EpiInAB {
  bf16_t* ABt; int seqlen;
  __device__ __forceinline__ void operator()(int row, int col, f32x4 v) const {
    const int ch = col & 1023, half = col >> 10;
    const int b = row / seqlen, l = row - b * seqlen;
    uint2 pk; pk.x = pack2(v[0], v[1]); pk.y = pack2(v[2], v[3]);
    *reinterpret_cast<uint2*>(ABt + ((size_t)(b * 1024 + ch) * 4096 + half * 2048 + l)) = pk;
  }
};
struct EpiInZ {
  bf16_t* z;
  __device__ __forceinline__ void operator()(int row, int col, f32x4 v) const {
#pragma unroll
    for (int r = 0; r < 4; ++r) z[(size_t)(row + r) * 1024 + (col - 2048)] = f2bf(v[r]);
  }
};
struct EpiInXbc {
  bf16_t* xbcraw;
  __device__ __forceinline__ void operator()(int row, int col, f32x4 v) const {
#pragma unroll
    for (int r = 0; r < 4; ++r) xbcraw[(size_t)(row + r) * DXBC + (col - 3072)] = f2bf(v[r]);
  }
};
struct EpiInProj {
  bf16_t* ABt; bf16_t* z; bf16_t* xbcraw; float* dtraw; int seqlen;
  __device__ __forceinline__ void operator()(int row, int col, f32x4 v) const {
    if (col < 2048) {
      int ch = col & 1023, half = col >> 10;
      int b = row / seqlen, l = row - b * seqlen;
      uint2 pk; pk.x = pack2(v[0], v[1]); pk.y = pack2(v[2], v[3]);
      *reinterpret_cast<uint2*>(ABt + ((size_t)(b * 1024 + ch) * 4096 + half * 2048 + l)) = pk;
    } else if (col < 3072) {
#pragma unroll
      for (int r = 0; r < 4; ++r) z[(size_t)(row + r) * 1024 + (col - 2048)] = f2bf(v[r]);
    } else if (col < 4608) {
#pragma unroll
      for (int r = 0; r < 4; ++r) xbcraw[(size_t)(row + r) * DXBC + (col - 3072)] = f2bf(v[r]);
    } else if (col < 4640) {
#pragma unroll
      for (int r = 0; r < 4; ++r) dtraw[(size_t)(row + r) * 32 + (col - 4608)] = v[r];
    }
  }
};

__device__ void adaln_partial_task(const Params& p, int task, float* sm) {
  const int cb = task % 48, ks = task / 48, tid = threadIdx.x;
  float* sc = sm;
  __syncthreads();
  for (int i = tid; i < 5 * 64; i += NTHREADS) {
    int r = i >> 6, kk = i & 63;
    int k = ks * 64 + kk;
    float cv = (r < 4) ? p.c[r * D + k] : p.c_ctx[k];
    sc[i] = silu_f(cv);
  }
  __syncthreads();
  const int col = cb * 256 + tid;
  float a0 = 0, a1 = 0, a2 = 0, a3 = 0, a4 = 0;
  const float* wp = p.w_mod + (size_t)(ks * 64) * NMOD + col;
#pragma unroll
  for (int h2 = 0; h2 < 2; ++h2) {
    float wv[32];
#pragma unroll
    for (int kk = 0; kk < 32; ++kk) wv[kk] = __builtin_nontemporal_load(wp + (size_t)(h2 * 32 + kk) * NMOD);
#pragma unroll
    for (int kk = 0; kk < 32; ++kk) {
      const int k = h2 * 32 + kk;
      a0 += sc[k] * wv[kk]; a1 += sc[64 + k] * wv[kk]; a2 += sc[128 + k] * wv[kk]; a3 += sc[192 + k] * wv[kk]; a4 += sc[256 + k] * wv[kk];
    }
  }
  float* pp = p.partial + (size_t)ks * 5 * NMOD + col;
  pp[0] = a0; pp[NMOD] = a1; pp[2 * NMOD] = a2; pp[3 * NMOD] = a3; pp[4 * NMOD] = a4;
}

__device__ void transpose_convert_task(const float* __restrict__ src, int ld, int c0, int rows, bf16_t* __restrict__ dst,
                                       int tr, int tc, float* sm) {
  float (*tile)[68] = reinterpret_cast<float (*)[68]>(sm);
  const int tid = threadIdx.x;
  __syncthreads();
  {
    float4 v[4];
#pragma unroll
    for (int k = 0; k < 4; ++k) {
      const int i = tid + k * NTHREADS, r = i >> 4, c4 = i & 15;
      v[k] = *reinterpret_cast<const float4*>(src + (size_t)(tr * 64 + r) * ld + c0 + tc * 64 + c4 * 4);
    }
#pragma unroll
    for (int k = 0; k < 4; ++k) {
      const int i = tid + k * NTHREADS, r = i >> 4, c4 = i & 15;
      *reinterpret_cast<float4*>(&tile[r][c4 * 4]) = v[k];
    }
  }
  __syncthreads();
#pragma unroll
  for (int k = 0; k < 4; ++k) {
    const int i = tid + k * NTHREADS, cc = i >> 4, r4 = (i & 15) * 4;
    uint2 o; o.x = pack2(tile[r4][cc], tile[r4 + 1][cc]); o.y = pack2(tile[r4 + 2][cc], tile[r4 + 3][cc]);
    *reinterpret_cast<uint2*>(dst + (size_t)(tc * 64 + cc) * rows + tr * 64 + r4) = o;
  }
}

__device__ void phase_prep(const Params& p, int bid, int nb, char* smem) {
  float* sm = reinterpret_cast<float*>(smem);
  const int tid = threadIdx.x;
  if (bid == 0 && tid < 64) p.ctr[tid] = 0u;
  {
    float* t256 = reinterpret_cast<float*>(smem + 20480);
    float* t2048 = reinterpret_cast<float*>(smem + 24576);
    t256[tid] = cospif((float)tid * (1.0f / 128.f));
    for (int i = tid; i < 2048; i += NTHREADS) t2048[i] = cospif((float)i * (1.0f / 1024.f));
    __syncthreads();
  }
  for (int t = bid; t < 48 * KSPLIT; t += nb) adaln_partial_task(p, t, sm);
  {
    const int nct = 41, nrt = 32;
    for (int t = bid; t < nct * nrt; t += nb) {
      int tc = t % nct, tr = t / nct;
      if (tc < 40) transpose_convert_task(p.w_in, DIN, 1024, D, p.w_in_t + (size_t)2048 * D, tr, tc, sm);
      else {
        float (*tile)[65] = reinterpret_cast<float (*)[65]>(sm);
        __syncthreads();
        for (int i = tid; i < 64 * 32; i += NTHREADS) {
          int r = i >> 5, cc = i & 31;
          tile[r][cc] = p.w_in[(size_t)(tr * 64 + r) * DIN + 1024 + 2560 + cc];
        }
        __syncthreads();
        for (int i = tid; i < 32 * 32; i += NTHREADS) {
          int cc = i >> 5, r2 = (i & 31) * 2;
          uint32_t pk = pack2(tile[r2][cc], tile[r2 + 1][cc]);
          *reinterpret_cast<uint32_t*>(p.w_in_t + (size_t)(2048 + 2560 + cc) * D + tr * 64 + r2) = pk;
        }
      }
    }
    for (size_t i = (size_t)bid * NTHREADS + tid; i < (size_t)96 * D / 8; i += (size_t)nb * NTHREADS)
      reinterpret_cast<uint4*>(p.w_in_t + (size_t)4640 * D)[i] = uint4{0, 0, 0, 0};
  }
  for (size_t i = (size_t)bid * NTHREADS + tid; i < (size_t)D * 1024 / 4; i += (size_t)nb * NTHREADS) {
    int k = (int)(i / 256), c4 = (int)(i % 256) * 4;
    float4 v = *reinterpret_cast<const float4*>(p.w_in + (size_t)k * DIN + c4);
    uint2 o; o.x = pack2(v.x, v.y); o.y = pack2(v.z, v.w);
    *reinterpret_cast<uint2*>(p.w_in_f + (size_t)k * 1024 + c4) = o;
  }
  {
    const float* t256 = reinterpret_cast<const float*>(smem + 20480);
    const float scale = 1.0f / sqrtf((float)L * 256.f);
    for (int i = bid * NTHREADS + tid; i < 4 * 64 * 256; i += nb * NTHREADS) {
      const int d = i & 255, cg = (i >> 8) & 63, g = i >> 14;
      float sc_[4] = {0.f, 0.f, 0.f, 0.f}, ss_[4] = {0.f, 0.f, 0.f, 0.f};
      const float* wp = p.w_fmix + (size_t)g * 65536 + d;
#pragma unroll 4
      for (int m = 0; m < 256; ++m) {
        const float wv = wp[m * 256];
#pragma unroll
        for (int j = 0; j < 4; ++j) {
          const int ph = (m * (cg * 4 + j)) & 255;
          sc_[j] += t256[ph] * wv; ss_[j] += t256[(ph - 64) & 255] * wv;
        }
      }
#pragma unroll
      for (int j = 0; j < 4; ++j) {
        const int c = cg * 4 + j;
        p.WcsT[((size_t)g * 512 + d) * 256 + c] = f2bf(sc_[j] * scale);
        p.WcsT[((size_t)g * 512 + 256 + d) * 256 + c] = f2bf(ss_[j] * scale);
      }
    }
  }
  {
    const float* t2048 = reinterpret_cast<const float*>(smem + 24576);
    for (size_t i = (size_t)bid * NTHREADS + tid; i < (size_t)1024 * 2048 / 8; i += (size_t)nb * NTHREADS) {
      const int k = (int)(i / 256), j = (int)(i % 256) * 8;
      const bool iss = j >= 1024;
      float o[8];
#pragma unroll
      for (int e = 0; e < 8; ++e) {
        const int l = (j + e) & 1023;
        const int ph = (k * l) & 2047;
        o[e] = iss ? t2048[(ph - 512) & 2047] : t2048[ph];
      }
      uint4 pk; pk.x = pack2(o[0], o[1]); pk.y = pack2(o[2], o[3]); pk.z = pack2(o[4], o[5]); pk.w = pack2(o[6], o[7]);
      *reinterpret_cast<uint4*>(p.dftm + (size_t)k * 2048 + j) = pk;
    }
  }
}

__device__ void phase_fold(const Params& p, int bid, int nb, char* smem) {
  const int tid = threadIdx.x;
  for (int i = bid * NTHREADS + tid; i < 5 * NMOD; i += nb * NTHREADS) {
    int col = i % NMOD;
    float s = p.b_mod[col];
    for (int ks = 0; ks < KSPLIT; ++ks) s += p.partial[(size_t)ks * 5 * NMOD + i];
    p.mod[i] = s;
  }
  for (int t = bid; t < 256; t += nb) {
    int g = t >> 6, tm = (t & 63) >> 2, tn = t & 3;
    int n0 = tn * 128;
    int rowbase = (n0 < 256) ? (g * 256 + n0) : (1024 + g * 256 + (n0 - 256));
    EpiBf16T epi{p.w_in_t + (size_t)(rowbase - n0) * D, D};
    gemm_tile(p.w_in_f + g * 256, 1024, p.WcsT + (size_t)g * 512 * 256, 256, 256, tm * 128, n0, epi, smem);
  }
}

__device__ void phase_norm_mod(const Params& p, int bid, int nb, char* smem) {
  const int lane = threadIdx.x & 63, w = threadIdx.x >> 6;
  for (int t = bid * 4 + w; t < T + TC; t += nb * 4) {
    const bool isx = t < T;
    const float* src = isx ? (p.x + (size_t)t * D) : (p.ctx + (size_t)(t - T) * D);
    const int mrow = isx ? (t / L) : 4;
    bf16_t* dst = isx ? (p.hx + (size_t)t * D) : (p.hc + (size_t)(t - T) * D);
    float4 v[8];
    float ss = 0.f;
#pragma unroll
    for (int c = 0; c < 8; ++c) {
      v[c] = *reinterpret_cast<const float4*>(src + c * 256 + lane * 4);
      ss += v[c].x * v[c].x + v[c].y * v[c].y + v[c].z * v[c].z + v[c].w * v[c].w;
    }
    ss = wave_sum_fast(ss);
    const float rstd = rsqrtf(ss * (1.f / D) + EPS);
    const float* sh = p.mod + (size_t)mrow * NMOD + 0 * D;
    const float* sc = p.mod + (size_t)mrow * NMOD + 1 * D;
#pragma unroll
    for (int c = 0; c < 8; ++c) {
      const int e0 = c * 256 + lane * 4;
      const float4 g = *reinterpret_cast<const float4*>(p.g_pre_mix + e0);
      const float4 s4 = *reinterpret_cast<const float4*>(sc + e0), h4 = *reinterpret_cast<const float4*>(sh + e0);
      uint2 pk;
      pk.x = pack2(v[c].x * rstd * g.x * (1.f + s4.x) + h4.x, v[c].y * rstd * g.y * (1.f + s4.y) + h4.y);
      pk.y = pack2(v[c].z * rstd * g.z * (1.f + s4.z) + h4.z, v[c].w * rstd * g.w * (1.f + s4.w) + h4.w);
      *reinterpret_cast<uint2*>(dst + e0) = pk;
    }
  }
}

__device__ __forceinline__ void convert_uv_units(const Params& p, size_t u0, size_t u1) {
  const size_t n16 = (size_t)16384 * D / 16;
  for (size_t i = u0 + threadIdx.x; i < u1; i += NTHREADS) {
    const float* s = (i < n16) ? p.eu : p.ev;
    uint8_t* d = (i < n16) ? p.U8 : p.V8;
    const size_t j = (i < n16) ? i : i - n16;
    uint32_t o[4];
#pragma unroll
    for (int q4 = 0; q4 < 4; ++q4) {
      const float4 v = *reinterpret_cast<const float4*>(s + j * 16 + q4 * 4);
      int pk = 0;
      pk = __builtin_amdgcn_cvt_pk_fp8_f32(v.x * 512.f, v.y * 512.f, pk, false);
      pk = __builtin_amdgcn_cvt_pk_fp8_f32(v.z * 512.f, v.w * 512.f, pk, true);
      o[q4] = (uint32_t)pk;
    }
    const size_t e_ = j >> 7, r_ = j & 127;
    *reinterpret_cast<uint4*>(d + (r_ >> 4) * ((size_t)16384 * 256) + e_ * 256 + (r_ & 15) * 16) = uint4{o[0], o[1], o[2], o[3]};
  }
}
__device__ void phase_inproj(const Params& p, int bid, int nb, char* smem) {
  if ((nb & 7) == 0) {
    const int x = bid & 7, rank = bid >> 3, per = nb >> 3;
    for (int s_ = rank; s_ < 128 + 53; s_ += per) {
      if (s_ < 128) {
        const int tn2 = s_ >> 3, m0_ = (8 * x + (s_ & 7)) * 128;
        if (tn2 < 8) { EpiInAB epi{p.ABt, L}; gemm_tile_n256(p.hx, D, p.w_in_t, D, D, m0_, tn2 * 256, epi, smem); }
        else if (tn2 < 12) { EpiInZ epi{p.z}; gemm_tile_n256(p.hx, D, p.w_in_t, D, D, m0_, tn2 * 256, epi, smem); }
        else { EpiInXbc epi{p.xbcraw}; gemm_tile_n256(p.hx, D, p.w_in_t, D, D, m0_, tn2 * 256, epi, smem); }
      } else if (s_ < 128 + 40) {
        const int i = s_ - 128;
        EpiInProj epi{p.ABt, p.z, p.xbcraw, p.dtraw, L};
        gemm_tile(p.hx, D, p.w_in_t, D, D, (8 * x + (i & 7)) * 128, (32 + (i >> 3)) * 128, epi, smem);
      } else {
        const int u = x * 13 + (s_ - 168);
        EpiInProj epi{nullptr, nullptr, p.xbcraw_c, p.dtraw_c, CTX};
        gemm_tile(p.hc, D, p.w_in_t, D, D, (u / 13) * 128, 3072 + (u % 13) * 128, epi, smem);
      }
    }
    return;
  }
  const int ntx = 64 * 37, ntc = 8 * 13;
  for (int t = bid; t < ntx + ntc; t += nb) {
    if (t < ntx) {
      int tm = t / 37, tn = t % 37;
      EpiInProj epi{p.ABt, p.z, p.xbcraw, p.dtraw, L};
      gemm_tile(p.hx, D, p.w_in_t, D, D, tm * 128, tn * 128, epi, smem);
    } else {
      int u = t - ntx;
      int tm = u / 13, tn = u % 13;
      EpiInProj epi{nullptr, nullptr, p.xbcraw_c, p.dtraw_c, CTX};
      gemm_tile(p.hc, D, p.w_in_t, D, D, tm * 128, 3072 + tn * 128, epi, smem);
    }
  }
}

__device__ void ssm_pre_tile(const Params& p, int task, char* smem) {
  const bool isx = task < 3072;
  const int u = isx ? task : task - 3072;
  const int ntt = isx ? 32 : 4;
  const int ct = u % 24, tt = (u / 24) % ntt, b = u / (24 * ntt);
  const int seqlen = isx ? L : CTX;
  const bf16_t* raw = (isx ? p.xbcraw : p.xbcraw_c) + (size_t)b * seqlen * DXBC;
  const int l0 = tt * 64, c0 = ct * 64, tid = threadIdx.x;
  float (*rt)[68] = reinterpret_cast<float (*)[68]>(smem);
  float (*at)[65] = reinterpret_cast<float (*)[65]>(smem + 66 * 68 * 4);
  __syncthreads();
  {
    uint2 v[5];
#pragma unroll
    for (int k = 0; k < 5; ++k) {
      const int i = tid + k * NTHREADS, r = i >> 4, c4 = i & 15, l = l0 - 1 + r;
      v[k] = (i < 66 * 16 && l >= 0 && l < seqlen) ? *reinterpret_cast<const uint2*>(raw + (size_t)l * DXBC + c0 + c4 * 4) : uint2{0u, 0u};
    }
#pragma unroll
    for (int k = 0; k < 5; ++k) {
      const int i = tid + k * NTHREADS, r = i >> 4, c4 = i & 15;
      if (i < 66 * 16) *reinterpret_cast<float4*>(&rt[r][c4 * 4]) = float4{bflo(v[k].x), bfhi(v[k].x), bflo(v[k].y), bfhi(v[k].y)};
    }
  }
  __syncthreads();
  {
    const int cc = tid & 63, c = c0 + cc;
    const float w0 = p.conv_w[c], w1 = p.conv_w[DXBC + c], w2 = p.conv_w[2 * DXBC + c], cb = p.conv_b[c];
#pragma unroll 4
    for (int r = tid >> 6; r < 64; r += 4) at[r][cc] = silu_f(cb + rt[r][cc] * w0 + rt[r + 1][cc] * w1 + rt[r + 2][cc] * w2);
  }
  __syncthreads();
  const size_t trow0 = isx ? ((size_t)b * L + l0) : ((size_t)T + (size_t)b * CTX + l0);
#pragma unroll
  for (int k = 0; k < 4; ++k) {
    const int i = tid + k * NTHREADS, r = i >> 4, c4 = (i & 15) * 4;
    uint2 o; o.x = pack2(at[r][c4], at[r][c4 + 1]); o.y = pack2(at[r][c4 + 2], at[r][c4 + 3]);
    *reinterpret_cast<uint2*>(p.act_tm + (trow0 + r) * DXBC + c0 + c4) = o;
  }
  if (c0 < 1280) {
    bf16_t* cm = (isx ? p.act_cm_x : p.act_cm_c) + (size_t)b * 1280 * seqlen;
#pragma unroll
    for (int k = 0; k < 4; ++k) {
      const int i = tid + k * NTHREADS, cc = i >> 4, r4 = (i & 15) * 4;
      uint2 o; o.x = pack2(at[r4][cc], at[r4 + 1][cc]); o.y = pack2(at[r4 + 2][cc], at[r4 + 3][cc]);
      *reinterpret_cast<uint2*>(cm + (size_t)(c0 + cc) * seqlen + l0 + r4) = o;
    }
  }
}
__device__ void dft_fold_rows(const Params& p, int bid, int nb, char* smem) {
  const int lane = threadIdx.x & 63, w = threadIdx.x >> 6;
  bf16_t* sr = reinterpret_cast<bf16_t*>(smem + w * 8192);
  for (int row = bid * 4 + w; row < NB * 1024; row += nb * 4) {
    const bf16_t* A = p.ABt + (size_t)row * 4096;
    bf16_t* F = p.Fs + (size_t)row * 2048;
    __builtin_amdgcn_wave_barrier();
    {
      const uint4 q0 = *reinterpret_cast<const uint4*>(A + (0 * 64 + lane) * 8), q1 = *reinterpret_cast<const uint4*>(A + (1 * 64 + lane) * 8);
      const uint4 q2 = *reinterpret_cast<const uint4*>(A + (2 * 64 + lane) * 8), q3 = *reinterpret_cast<const uint4*>(A + (3 * 64 + lane) * 8);
      const uint4 q4 = *reinterpret_cast<const uint4*>(A + (4 * 64 + lane) * 8), q5 = *reinterpret_cast<const uint4*>(A + (5 * 64 + lane) * 8);
      const uint4 q6 = *reinterpret_cast<const uint4*>(A + (6 * 64 + lane) * 8), q7 = *reinterpret_cast<const uint4*>(A + (7 * 64 + lane) * 8);
      *reinterpret_cast<uint4*>(sr + (0 * 64 + lane) * 8) = q0; *reinterpret_cast<uint4*>(sr + (1 * 64 + lane) * 8) = q1;
      *reinterpret_cast<uint4*>(sr + (2 * 64 + lane) * 8) = q2; *reinterpret_cast<uint4*>(sr + (3 * 64 + lane) * 8) = q3;
      *reinterpret_cast<uint4*>(sr + (4 * 64 + lane) * 8) = q4; *reinterpret_cast<uint4*>(sr + (5 * 64 + lane) * 8) = q5;
      *reinterpret_cast<uint4*>(sr + (6 * 64 + lane) * 8) = q6; *reinterpret_cast<uint4*>(sr + (7 * 64 + lane) * 8) = q7;
    }
    __builtin_amdgcn_wave_barrier();
    const int l0 = lane * 16;
    float alt = 0.f;
    uint32_t oa[8], ob[8];
#pragma unroll
    for (int half = 0; half < 2; ++half) {
      const bf16_t* base = sr + half * 2048;
      const uint4 fa = *reinterpret_cast<const uint4*>(base + l0), fb = *reinterpret_cast<const uint4*>(base + l0 + 8);
      const uint4 ra = *reinterpret_cast<const uint4*>(base + 2032 - l0), rb = *reinterpret_cast<const uint4*>(base + 2040 - l0);
      const float r16 = (lane > 0) ? bf2f(base[2048 - l0]) : 0.f;
      const uint32_t fw[8] = {fa.x, fa.y, fa.z, fa.w, fb.x, fb.y, fb.z, fb.w};
      const uint32_t rw[8] = {ra.x, ra.y, ra.z, ra.w, rb.x, rb.y, rb.z, rb.w};
      float v[16];
#pragma unroll
      for (int i = 0; i < 16; ++i) {
        const float fwv = (i & 1) ? bfhi(fw[i >> 1]) : bflo(fw[i >> 1]);
        const int j = 16 - i;
        const float rv = (i == 0) ? r16 : ((j & 1) ? bfhi(rw[j >> 1]) : bflo(rw[j >> 1]));
        if (half == 0) v[i] = (lane == 0 && i == 0) ? fwv : fwv + rv;
        else v[i] = (lane == 0 && i == 0) ? 0.f : fwv - rv;
      }
      if (half == 0) {
#pragma unroll
        for (int i = 0; i < 16; ++i) alt += (i & 1) ? -v[i] : v[i];
#pragma unroll
        for (int i = 0; i < 8; ++i) oa[i] = pack2(v[2 * i], v[2 * i + 1]);
      } else {
#pragma unroll
        for (int i = 0; i < 8; ++i) ob[i] = pack2(v[2 * i], v[2 * i + 1]);
      }
    }
    *reinterpret_cast<uint4*>(F + l0) = uint4{oa[0], oa[1], oa[2], oa[3]};
    *reinterpret_cast<uint4*>(F + l0 + 8) = uint4{oa[4], oa[5], oa[6], oa[7]};
    *reinterpret_cast<uint4*>(F + 1024 + l0) = uint4{ob[0], ob[1], ob[2], ob[3]};
    *reinterpret_cast<uint4*>(F + 1024 + l0 + 8) = uint4{ob[4], ob[5], ob[6], ob[7]};
    alt = wave_sum_fast(alt) + bf2f(sr[1024]);
    if (lane == 0) { const int b = row >> 10, ch = row & 1023; p.ycat[((size_t)b * L + 1024) * D + ch] = f2bf(alt); }
  }
}
__device__ void phase_ssm_pre(const Params& p, int bid, int nb, char* smem) {
  const int tid = threadIdx.x;
  dft_fold_rows(p, bid, nb, smem);
  for (int t = bid; t < 3072 + 384; t += nb) ssm_pre_tile(p, t, smem);
  for (int i = bid * NTHREADS + tid; i < (T + TC) * 32; i += nb * NTHREADS) {
    const bool isx = i < T * 32;
    const int ii = isx ? i : i - T * 32;
    const int t = ii >> 5, j = ii & 31;
    const float v = (isx ? p.dtraw : p.dtraw_c)[ii];
    float* df = isx ? p.dtf : p.dtf_c;
    float* db = isx ? p.dtb : p.dtb_c;
    if (j < 16) df[t * 16 + j] = softplus_f(v + p.dt_bias_f[j]);
    else db[t * 16 + (j - 16)] = softplus_f(v + p.dt_bias_b[j - 16]);
  }
}

__device__ __forceinline__ int swz16(int row, int chunk) { return row * 256 + ((chunk ^ (row & 15)) << 4); }
__device__ __forceinline__ int swz8(int row, int chunk) { return row * 128 + ((chunk ^ (row & 7)) << 4); }

#define LDS_BARRIER() asm volatile("s_waitcnt lgkmcnt(0)\n\ts_barrier" ::: "memory")
__device__ void ssd_task(const Params& p, int task, char* smem) {
  const int dir = task & 1, ph = (task >> 1) & 1, h = (task >> 2) & 15, b = task >> 6;
  const int tid = opaque_tid(), lane = tid & 63, w = tid >> 6;
  const int g = h >> 3, lr0 = lane & 15, lq0 = lane >> 4;
  const float a = -__expf(dir ? p.a_log_b[h] : p.a_log_f[h]);
  char* sCc = smem; char* sBc = smem + 16384; char* sBT = smem + 32768; char* sXT = smem + 49152; char* sHb = smem + 57344;
  float* se = reinterpret_cast<float*>(smem + 73728);
  float* sdt = se + 64; float* sw = se + 128; float* sy = se + 192; float* stot = se + 256;
  bf16_t* yo = reinterpret_cast<bf16_t*>(dir ? p.yb : p.yf);
  f32x4 H[2][2];
#pragma unroll
  for (int i = 0; i < 2; ++i)
#pragma unroll
    for (int j = 0; j < 2; ++j) H[i][j] = f32x4{0.f, 0.f, 0.f, 0.f};
  __syncthreads();
  for (int i = tid; i < 512; i += NTHREADS) reinterpret_cast<uint4*>(sHb)[i] = uint4{0, 0, 0, 0};

  const int crow = tid >> 4, cch = tid & 15;
  const int trow = tid >> 3, tch = tid & 7;
  uint4 rC0, rC1, rC2, rC3, rB0, rB1, rB2, rB3, rT0, rT1, rT2, rT3, rX;
  rC0 = rC1 = rC2 = rC3 = rB0 = rB1 = rB2 = rB3 = uint4{0, 0, 0, 0};
  float rdt = 0.f;
#define SSD_PARAMS(st_)                                                                                                   \
  const bool isctx_ = (st_) < 4;                                                                                          \
  const int nch_ = isctx_ ? 4 : 32, ci_ = isctx_ ? (st_) : (st_) - 4;                                                     \
  const int c_ = dir ? (nch_ - 1 - ci_) : ci_;                                                                            \
  const int seqlen_ = isctx_ ? CTX : L;                                                                                   \
  const size_t trow0_ = isctx_ ? ((size_t)T + (size_t)b * CTX + c_ * 64) : ((size_t)b * L + c_ * 64);                     \
  const size_t drow0_ = (size_t)b * seqlen_ + c_ * 64;                                                                    \
  const float* dtp_ = isctx_ ? (dir ? p.dtb_c : p.dtf_c) : (dir ? p.dtb : p.dtf);                                         \
  const bf16_t* cm_ = (isctx_ ? p.act_cm_c : p.act_cm_x) + (size_t)b * 1280 * seqlen_ + c_ * 64;
#define SSD_PREFETCH(st_)                                                                                                 \
  do {                                                                                                                    \
    SSD_PARAMS(st_)                                                                                                       \
    if (w == 0) rdt = dtp_[(drow0_ + lane) * 16 + h];                                                                     \
    if (!isctx_) {                                                                                                        \
      const bf16_t* src = p.act_tm + (trow0_ + crow) * DXBC + g * 128 + cch * 8;                                          \
      rC0 = *reinterpret_cast<const uint4*>(src + 1280);             rB0 = *reinterpret_cast<const uint4*>(src + 1024);   \
      rC1 = *reinterpret_cast<const uint4*>(src + 16 * DXBC + 1280); rB1 = *reinterpret_cast<const uint4*>(src + 16 * DXBC + 1024); \
      rC2 = *reinterpret_cast<const uint4*>(src + 32 * DXBC + 1280); rB2 = *reinterpret_cast<const uint4*>(src + 32 * DXBC + 1024); \
      rC3 = *reinterpret_cast<const uint4*>(src + 48 * DXBC + 1280); rB3 = *reinterpret_cast<const uint4*>(src + 48 * DXBC + 1024); \
    }                                                                                                                     \
    const bf16_t* srt = cm_ + (size_t)(1024 + g * 128 + trow) * seqlen_ + tch * 8;                                        \
    rT0 = *reinterpret_cast<const uint4*>(srt);                                                                           \
    rT1 = *reinterpret_cast<const uint4*>(srt + (size_t)32 * seqlen_);                                                    \
    rT2 = *reinterpret_cast<const uint4*>(srt + (size_t)64 * seqlen_);                                                    \
    rT3 = *reinterpret_cast<const uint4*>(srt + (size_t)96 * seqlen_);                                                    \
    rX = *reinterpret_cast<const uint4*>(cm_ + (size_t)(h * 64 + ph * 32 + trow) * seqlen_ + tch * 8);                    \
  } while (0)

  for (int step = 0; step < 36; ++step) {
    SSD_PREFETCH(step);
    const bool isctx = step < 4;
    const int c = dir ? ((isctx ? 4 : 32) - 1 - (isctx ? step : step - 4)) : (isctx ? step : step - 4);
    const size_t trow0 = (size_t)b * L + c * 64;
    int lr = lr0, lq = lq0;
    asm volatile("" : "+v"(lr), "+v"(lq));
    LDS_BARRIER();
    if (w == 0) {
      const float dtv = rdt;
      float v = a * dtv;
      if (!dir) {
#pragma unroll
        for (int o = 1; o < 64; o <<= 1) { float n = __shfl_up(v, o); v += (lane >= o) ? n : 0.f; }
      } else {
#pragma unroll
        for (int o = 1; o < 64; o <<= 1) { float n = __shfl_down(v, o); v += (lane + o < 64) ? n : 0.f; }
      }
      const float etot = __shfl(v, dir ? 0 : 63);
      se[lane] = v; sdt[lane] = dtv; sw[lane] = dtv * __expf(etot - v); sy[lane] = __expf(v);
      if (lane == 0) stot[0] = etot;
    }
    if (!isctx) {
      const int oc = swz16(crow, cch);
      *reinterpret_cast<uint4*>(sCc + oc) = rC0;         *reinterpret_cast<uint4*>(sBc + oc) = rB0;
      *reinterpret_cast<uint4*>(sCc + oc + 4096) = rC1;  *reinterpret_cast<uint4*>(sBc + oc + 4096) = rB1;
      *reinterpret_cast<uint4*>(sCc + oc + 8192) = rC2;  *reinterpret_cast<uint4*>(sBc + oc + 8192) = rB2;
      *reinterpret_cast<uint4*>(sCc + oc + 12288) = rC3; *reinterpret_cast<uint4*>(sBc + oc + 12288) = rB3;
    }
    {
      const int ot = swz8(trow, tch);
      *reinterpret_cast<uint4*>(sBT + ot) = rT0;
      *reinterpret_cast<uint4*>(sBT + ot + 4096) = rT1;
      *reinterpret_cast<uint4*>(sBT + ot + 8192) = rT2;
      *reinterpret_cast<uint4*>(sBT + ot + 12288) = rT3;
      *reinterpret_cast<uint4*>(sXT + ot) = rX;
    }
    LDS_BARRIER();
    const float etot = stot[0];
    if (!isctx) {
      f32x4 G[4];
      bf16x8 ca[4];
#pragma unroll
      for (int j = 0; j < 4; ++j) G[j] = f32x4{0.f, 0.f, 0.f, 0.f};
#pragma unroll
      for (int kk = 0; kk < 4; ++kk) ca[kk] = *reinterpret_cast<const bf16x8*>(sCc + swz16(16 * w + lr, kk * 4 + lq));
#pragma unroll
      for (int kk = 0; kk < 4; ++kk)
#pragma unroll
        for (int j = 0; j < 4; ++j) {
          bf16x8 bb = *reinterpret_cast<const bf16x8*>(sBc + swz16(16 * j + lr, kk * 4 + lq));
          G[j] = __builtin_amdgcn_mfma_f32_16x16x32_bf16(ca[kk], bb, G[j], 0, 0, 0);
        }
      LDS_BARRIER();
      float el[4];
#pragma unroll
      for (int r = 0; r < 4; ++r) el[r] = se[16 * w + lq * 4 + r];
#pragma unroll
      for (int j = 0; j < 4; ++j) {
        const int s_ = 16 * j + lr;
        const float es = se[s_], ds = sdt[s_];
#pragma unroll
        for (int r = 0; r < 4; ++r) {
          const int l = 16 * w + lq * 4 + r;
          const bool keep = dir ? (s_ >= l) : (s_ <= l);
          const float m = keep ? G[j][r] * __expf(el[r] - es) * ds : 0.f;
          *reinterpret_cast<bf16_t*>(sBc + swz8(l, s_ >> 3) + (s_ & 7) * 2) = f2bf(m);
        }
      }
      LDS_BARRIER();
      f32x4 Y[2], Yo[2];
#pragma unroll
      for (int j = 0; j < 2; ++j) { Y[j] = f32x4{0.f, 0.f, 0.f, 0.f}; Yo[j] = f32x4{0.f, 0.f, 0.f, 0.f}; }
#pragma unroll
      for (int kk = 0; kk < 2; ++kk) {
        bf16x8 ma = *reinterpret_cast<const bf16x8*>(sBc + swz8(16 * w + lr, kk * 4 + lq));
#pragma unroll
        for (int j = 0; j < 2; ++j) {
          bf16x8 xb = *reinterpret_cast<const bf16x8*>(sXT + swz8(16 * j + lr, kk * 4 + lq));
          Y[j] = __builtin_amdgcn_mfma_f32_16x16x32_bf16(ma, xb, Y[j], 0, 0, 0);
        }
      }
#pragma unroll
      for (int kk = 0; kk < 4; ++kk)
#pragma unroll
        for (int j = 0; j < 2; ++j) {
          bf16x8 hb = *reinterpret_cast<const bf16x8*>(sHb + swz16(16 * j + lr, kk * 4 + lq));
          Yo[j] = __builtin_amdgcn_mfma_f32_16x16x32_bf16(ca[kk], hb, Yo[j], 0, 0, 0);
        }
      float syl[4];
#pragma unroll
      for (int r = 0; r < 4; ++r) syl[r] = sy[16 * w + lq * 4 + r];
#pragma unroll
      for (int j = 0; j < 2; ++j)
#pragma unroll
        for (int r = 0; r < 4; ++r) {
          const int l = 16 * w + lq * 4 + r;
          yo[(trow0 + l) * 1024 + h * 64 + ph * 32 + 16 * j + lr] = f2bf(Y[j][r] + syl[r] * Yo[j][r]);
        }
    }
    {
      const float dec = __expf(etot);
#pragma unroll
      for (int i = 0; i < 2; ++i)
#pragma unroll
        for (int j = 0; j < 2; ++j) H[i][j] *= dec;
#pragma unroll
      for (int kk = 0; kk < 2; ++kk) {
        const int s0 = kk * 32 + lq * 8;
        const float4 w0 = *reinterpret_cast<const float4*>(sw + s0), w1 = *reinterpret_cast<const float4*>(sw + s0 + 4);
        bf16x8 xs[2];
#pragma unroll
        for (int i = 0; i < 2; ++i) {
          const bf16x8 xa = *reinterpret_cast<const bf16x8*>(sXT + swz8(16 * i + lr, kk * 4 + lq));
          xs[i][0] = (short)f2bf(bf2f((bf16_t)xa[0]) * w0.x); xs[i][1] = (short)f2bf(bf2f((bf16_t)xa[1]) * w0.y);
          xs[i][2] = (short)f2bf(bf2f((bf16_t)xa[2]) * w0.z); xs[i][3] = (short)f2bf(bf2f((bf16_t)xa[3]) * w0.w);
          xs[i][4] = (short)f2bf(bf2f((bf16_t)xa[4]) * w1.x); xs[i][5] = (short)f2bf(bf2f((bf16_t)xa[5]) * w1.y);
          xs[i][6] = (short)f2bf(bf2f((bf16_t)xa[6]) * w1.z); xs[i][7] = (short)f2bf(bf2f((bf16_t)xa[7]) * w1.w);
        }
#pragma unroll
        for (int j = 0; j < 2; ++j) {
          const bf16x8 bt = *reinterpret_cast<const bf16x8*>(sBT + swz8(16 * (2 * w + j) + lr, kk * 4 + lq));
#pragma unroll
          for (int i = 0; i < 2; ++i) H[i][j] = __builtin_amdgcn_mfma_f32_16x16x32_bf16(xs[i], bt, H[i][j], 0, 0, 0);
        }
      }
    }
    LDS_BARRIER();
#pragma unroll
    for (int i = 0; i < 2; ++i)
#pragma unroll
      for (int j = 0; j < 2; ++j) {
        const int n = 16 * (2 * w + j) + lr;
#pragma unroll
        for (int r = 0; r < 4; ++r) {
          const int pr = 16 * i + lq * 4 + r;
          *reinterpret_cast<bf16_t*>(sHb + swz16(pr, n >> 3) + (n & 7) * 2) = f2bf(H[i][j][r]);
        }
      }
  }
#undef SSD_PREFETCH
#undef SSD_PARAMS
}

#undef LDS_BARRIER
__device__ void phase_ssd_dft(const Params& p, int bid, int nb, char* smem) {
  for (int t = bid; t < 256; t += nb) ssd_task(p, t, smem);
  int* stile = reinterpret_cast<int*>(smem + 75776);
  for (;;) {
    __syncthreads();
    if (threadIdx.x == 0) *stile = (int)atomicAdd(p.ctr, 1u);
    __syncthreads();
    const int t = *stile;
    if (t >= 4 * 8 * 8) break;
    const int b = t >> 6, tm = (t & 63) >> 3, tn = t & 7;
    const bf16_t* Fb = p.Fs + (size_t)b * 1024 * 2048;
    f32x4 accC[4][4], accS[4][4];
    gemm_mainloop(p.dftm, 2048, Fb, 2048, 1024, tm * 128, tn * 128, accC, smem);
    gemm_mainloop(p.dftm + 1024, 2048, Fb + 1024, 2048, 1024, tm * 128, tn * 128, accS, smem);
    const int lane = threadIdx.x & 63, w = threadIdx.x >> 6, wm = w >> 1, wn = w & 1;
#pragma unroll
    for (int i = 0; i < 4; ++i) {
      int lq_ = lane >> 4, lr_ = lane & 15;
      asm volatile("" : "+v"(lq_), "+v"(lr_));
#pragma unroll
      for (int j = 0; j < 4; ++j) {
        const int k0 = tm * 128 + wm * 64 + i * 16 + lq_ * 4;
        const int ch = tn * 128 + wn * 64 + j * 16 + lr_;
        const float a = bf2f(p.ABt[((size_t)b * 1024 + ch) * 4096 + 1024]);
#pragma unroll
        for (int r = 0; r < 4; ++r) {
          const int k = k0 + r;
          const float as = (k & 1) ? -a : a;
          const float c = accC[i][j][r], sn = accS[i][j][r];
          p.ycat[((size_t)b * L + k) * D + ch] = f2bf(c - sn + as);
          if (k > 0) p.ycat[((size_t)b * L + (L - k)) * D + ch] = f2bf(c + sn + as);
        }
      }
    }
  }
  for (;;) {
    __syncthreads();
    if (threadIdx.x == 0) *stile = (int)atomicAdd(p.ctr + 8, 1u);
    __syncthreads();
    const int q = *stile;
    if (q >= 1024 + 1536) break;
    if (q < 1024) convert_uv_units(p, (size_t)q * 4096, (size_t)(q + 1) * 4096);
    else if (q < 1024 + 1024) { const int q1 = q - 1024; transpose_convert_task(p.w_out, D, 0, D, p.w_out_t, q1 / 32, q1 % 32, reinterpret_cast<float*>(smem)); }
    else { const int q2 = q - 2048; transpose_convert_task(p.w_query, 1024, 0, D, p.w_q_t, q2 / 16, q2 % 16, reinterpret_cast<float*>(smem)); }
  }
}

__device__ void phase_ssm_post(const Params& p, int bid, int nb, char* smem) {
  const int lane = threadIdx.x & 63, w = threadIdx.x >> 6;
  for (int t = bid * 4 + w; t < T; t += nb * 4) {
    float y[4][4];
    float ss0 = 0.f, ss1 = 0.f;
#pragma unroll
    for (int c = 0; c < 4; ++c) {
      const int c0 = c * 256 + lane * 4;
      const int h = c0 >> 6;
      const float dsk = p.d_skip_f[h] + p.d_skip_b[h];
      const uint2 aq = *reinterpret_cast<const uint2*>(reinterpret_cast<const bf16_t*>(p.yf) + (size_t)t * 1024 + c0);
      const uint2 bb = *reinterpret_cast<const uint2*>(reinterpret_cast<const bf16_t*>(p.yb) + (size_t)t * 1024 + c0);
      const float4 a = float4{bflo(aq.x), bfhi(aq.x), bflo(aq.y), bfhi(aq.y)};
      const float4 bq = float4{bflo(bb.x), bfhi(bb.x), bflo(bb.y), bfhi(bb.y)};
      const uint2 xq = *reinterpret_cast<const uint2*>(p.act_tm + (size_t)t * DXBC + c0);
      const uint2 zz = *reinterpret_cast<const uint2*>(p.z + (size_t)t * 1024 + c0);
      y[c][0] = (a.x + bq.x + dsk * bflo(xq.x)) * silu_f(bflo(zz.x));
      y[c][1] = (a.y + bq.y + dsk * bfhi(xq.x)) * silu_f(bfhi(zz.x));
      y[c][2] = (a.z + bq.z + dsk * bflo(xq.y)) * silu_f(bflo(zz.y));
      y[c][3] = (a.w + bq.w + dsk * bfhi(xq.y)) * silu_f(bfhi(zz.y));
      const float q = y[c][0] * y[c][0] + y[c][1] * y[c][1] + y[c][2] * y[c][2] + y[c][3] * y[c][3];
      if (c < 2) ss0 += q; else ss1 += q;
    }
    ss0 = wave_sum_fast(ss0); ss1 = wave_sum_fast(ss1);
    const float r0 = rsqrtf(ss0 * (1.f / 512.f) + EPS), r1 = rsqrtf(ss1 * (1.f / 512.f) + EPS);
#pragma unroll
    for (int c = 0; c < 4; ++c) {
      const int c0 = c * 256 + lane * 4;
      const float rstd = (c < 2) ? r0 : r1;
      const float4 nw = *reinterpret_cast<const float4*>(p.ssm_norm_w + c0);
      uint2 o; o.x = pack2(y[c][0] * rstd * nw.x, y[c][1] * rstd * nw.y); o.y = pack2(y[c][2] * rstd * nw.z, y[c][3] * rstd * nw.w);
      *reinterpret_cast<uint2*>(p.ycat + (size_t)t * D + 1024 + c0) = o;
    }
  }
}

__device__ void phase_outproj(const Params& p, int bid, int nb, char* smem) {
  if ((nb & 7) == 0) {
    const int x = bid & 7, rank = bid >> 3, per = nb >> 3;
    for (int s_ = rank; s_ < 64; s_ += per) {
      EpiBf16 epi{reinterpret_cast<bf16_t*>(p.y_x), D};
      gemm_tile_n256(p.ycat, D, p.w_out_t, D, D, (8 * x + (s_ & 7)) * 128, (s_ >> 3) * 256, epi, smem);
    }
    return;
  }
  for (int t = bid; t < 64 * 16; t += nb) {
    EpiBf16 epi{reinterpret_cast<bf16_t*>(p.y_x), D};
    gemm_tile(p.ycat, D, p.w_out_t, D, D, (t >> 4) * 128, (t & 15) * 128, epi, smem);
  }
}
__device__ void phase_postmix(const Params& p, int bid, int nb, char* smem) {
  const int lane = threadIdx.x & 63, w = threadIdx.x >> 6;
  for (int t = bid * 4 + w; t < T; t += nb * 4) {
    const int b = t / L;
    float4 y[8];
    float ss = 0.f;
#pragma unroll
    for (int c = 0; c < 8; ++c) {
      {
        const uint2 yq = *reinterpret_cast<const uint2*>(reinterpret_cast<const bf16_t*>(p.y_x) + (size_t)t * D + c * 256 + lane * 4);
        y[c] = float4{bflo(yq.x), bfhi(yq.x), bflo(yq.y), bfhi(yq.y)};
      }
      ss += y[c].x * y[c].x + y[c].y * y[c].y + y[c].z * y[c].z + y[c].w * y[c].w;
    }
    ss = wave_sum_fast(ss);
    const float rstd = rsqrtf(ss * (1.f / D) + EPS);
    const float* gm = p.mod + (size_t)b * NMOD + 2 * D;
    float ss1 = 0.f;
#pragma unroll
    for (int c = 0; c < 8; ++c) {
      const int e0 = c * 256 + lane * 4;
      const float4 xv = *reinterpret_cast<const float4*>(p.x + (size_t)t * D + e0);
      const float4 g4 = *reinterpret_cast<const float4*>(gm + e0), gp = *reinterpret_cast<const float4*>(p.g_post_mix + e0);
      y[c].x = xv.x + g4.x * (y[c].x * rstd * gp.x); y[c].y = xv.y + g4.y * (y[c].y * rstd * gp.y);
      y[c].z = xv.z + g4.z * (y[c].z * rstd * gp.z); y[c].w = xv.w + g4.w * (y[c].w * rstd * gp.w);
      ss1 += y[c].x * y[c].x + y[c].y * y[c].y + y[c].z * y[c].z + y[c].w * y[c].w;
    }
    if (lane == 0) p.partial[t] = rstd;
    ss1 = wave_sum_fast(ss1);
    const float rstd1 = rsqrtf(ss1 * (1.f / D) + EPS);
    const float* sf = p.mod + (size_t)b * NMOD + 3 * D;
    const float* cf = p.mod + (size_t)b * NMOD + 4 * D;
#pragma unroll
    for (int c = 0; c < 8; ++c) {
      const int e0 = c * 256 + lane * 4;
      const float4 g = *reinterpret_cast<const float4*>(p.g_pre_ffn + e0);
      const float4 s4 = *reinterpret_cast<const float4*>(cf + e0), h4 = *reinterpret_cast<const float4*>(sf + e0);
      uint2 pk;
      pk.x = pack2(y[c].x * rstd1 * g.x * (1.f + s4.x) + h4.x, y[c].y * rstd1 * g.y * (1.f + s4.y) + h4.y);
      pk.y = pack2(y[c].z * rstd1 * g.z * (1.f + s4.z) + h4.z, y[c].w * rstd1 * g.w * (1.f + s4.w) + h4.w);
      *reinterpret_cast<uint2*>(p.hx + (size_t)t * D + e0) = pk;
    }
  }
}

__device__ __forceinline__ uint32_t mono_key(float f) {
  uint32_t u = __float_as_uint(f);
  return (u & 0x80000000u) ? ~u : (u | 0x80000000u);
}
__device__ __forceinline__ void ins16(uint32_t (&Lk)[16], uint32_t x) {
#pragma unroll
  for (int i = 0; i < 16; ++i) { uint32_t hi = max(Lk[i], x); x = min(Lk[i], x); Lk[i] = hi; }
}
__device__ __forceinline__ float unmono_key(uint32_t k) {
  return __uint_as_float((k & 0x80000000u) ? (k ^ 0x80000000u) : ~k);
}
typedef __attribute__((ext_vector_type(16))) float f32x16;
__device__ void phase_q_route(const Params& p, int bid, int nb, char* smem) {
  const int tid = opaque_tid(), lane = tid & 63, w = tid >> 6;
  const int wm = w >> 1, wn = w & 1, lr = lane & 15, lq = lane >> 4;
  const int l31 = lane & 31, lh = lane >> 5;
  for (int tile0 = bid; tile0 < 512; tile0 += nb) {
    const int tile = ((nb & 7) == 0 && nb >= 512) ? (((tile0 & 7) * 8 + ((tile0 >> 3) & 7)) * 8 + (tile0 >> 6)) : tile0;
    const int h = tile & 7, m0 = (tile >> 3) * 128;
    {
      f32x4 acc[4][4];
      gemm_mainloop(p.hx, D, p.w_q_t, D, D, m0, h * 128, acc, smem);
#pragma unroll
      for (int i = 0; i < 4; ++i)
#pragma unroll
        for (int j = 0; j < 4; ++j)
#pragma unroll
          for (int r = 0; r < 4; ++r) {
            const int row = wm * 64 + i * 16 + lq * 4 + r, col = wn * 64 + j * 16 + lr;
            *reinterpret_cast<bf16_t*>(smem + swz16(row, col >> 3) + (col & 7) * 2) = f2bf(acc[i][j][r]);
          }
    }
#pragma unroll 4
    for (int r = 0; r < 16; ++r) {
      const int id = tid + 256 * r, row = id >> 4, c4 = id & 15;
      const float* src = ((row < 128) ? p.sk1 : p.sk2) + ((size_t)(h * 128 + (row & 127)) * 64 + c4 * 4);
      const float4 v = *reinterpret_cast<const float4*>(src);
      uint2 pk; pk.x = pack2(v.x, v.y); pk.y = pack2(v.z, v.w);
      *reinterpret_cast<uint2*>(smem + 32768 + swz8(row, c4 >> 1) + (c4 & 1) * 8) = pk;
    }
    __syncthreads();
    uint32_t L1[16], L2[16];
#pragma unroll
    for (int sd = 0; sd < 2; ++sd) {
      uint32_t Lk[16];
#pragma unroll
      for (int i = 0; i < 16; ++i) Lk[i] = 0u;
      const uint32_t kb = (uint32_t)(lh * 4);
#pragma unroll
      for (int ih = 0; ih < 2; ++ih) {
        f32x16 Sa[2];
#pragma unroll
        for (int i = 0; i < 2; ++i)
#pragma unroll
          for (int g2 = 0; g2 < 16; ++g2) Sa[i][g2] = 0.f;
#pragma unroll
        for (int ks = 0; ks < 4; ++ks) {
          const bf16x8 qb = *reinterpret_cast<const bf16x8*>(smem + swz16(w * 32 + l31, sd * 8 + ks * 2 + lh));
#pragma unroll
          for (int i = 0; i < 2; ++i) {
            const bf16x8 ka = *reinterpret_cast<const bf16x8*>(smem + 32768 + swz8(sd * 128 + (ih * 2 + i) * 32 + l31, ks * 2 + lh));
            Sa[i] = __builtin_amdgcn_mfma_f32_32x32x16_bf16(ka, qb, Sa[i], 0, 0, 0);
          }
        }
#pragma unroll
        for (int i = 0; i < 2; ++i)
#pragma unroll
          for (int g2 = 0; g2 < 16; ++g2)
            ins16(Lk, (mono_key(Sa[i][g2]) & ~0x7Fu) | (uint32_t)((ih * 2 + i) * 32 + (g2 & 3) + 8 * (g2 >> 2)) | kb);
      }
#pragma unroll
      for (int i = 0; i < 8; ++i) {
        const uint32_t t1 = (uint32_t)__shfl_xor((int)Lk[15 - i], 32), t2 = (uint32_t)__shfl_xor((int)Lk[i], 32);
        Lk[i] = max(Lk[i], t1); Lk[15 - i] = max(Lk[15 - i], t2);
      }
#pragma unroll
      for (int dd = 8; dd >= 1; dd >>= 1)
#pragma unroll
        for (int i = 0; i < 16; ++i)
          if ((i & dd) == 0) { const uint32_t hi = max(Lk[i], Lk[i + dd]), lo = min(Lk[i], Lk[i + dd]); Lk[i] = hi; Lk[i + dd] = lo; }
#pragma unroll
      for (int r = 0; r < 16; ++r) { if (sd == 0) L1[r] = Lk[r]; else L2[r] = Lk[r]; }
    }
    __syncthreads();
    uint32_t* ib = reinterpret_cast<uint32_t*>(smem) + w * 1088 + l31 * 34;
    if (lh == 0) {
#pragma unroll
      for (int r = 0; r < 16; ++r) { ib[r] = L1[r] & 127u; ib[16 + r] = L2[r] & 127u; }
    }
    float v1[16], v2[16];
#pragma unroll
    for (int r = 0; r < 16; ++r) { v1[r] = unmono_key(L1[r] & ~0x7Fu); v2[r] = unmono_key(L2[r] & ~0x7Fu); }
    uint32_t C[16];
#pragma unroll
    for (int i = 0; i < 16; ++i) C[i] = 0u;
#pragma unroll
    for (int a = 0; a < 16; ++a)
#pragma unroll
      for (int bq = 0; bq < 16; ++bq)
        if ((a + 1) * (bq + 1) <= 16) ins16(C, (mono_key(v1[a] + v2[bq]) & ~0xFFu) | (uint32_t)(a * 16 + bq));
    float ts[16]; int te[16];
    __builtin_amdgcn_wave_barrier();
#pragma unroll
    for (int r = 0; r < 16; ++r) {
      const uint32_t code = C[r] & 0xFFu;
      te[r] = (int)(ib[code >> 4] * 128u + ib[16 + (code & 15u)]);
      ts[r] = unmono_key(C[r] & ~0xFFu);
    }
    const float mx = ts[0];
    float den = 0.f;
#pragma unroll
    for (int r = 0; r < 16; ++r) { ts[r] = __expf(ts[r] - mx); den += ts[r]; }
    const float inv = 1.f / den;
    const size_t ob = (size_t)(m0 + w * 32 + l31) * 128 + h * 16;
    if (lh == 0) {
#pragma unroll
      for (int r = 0; r < 16; r += 4) *reinterpret_cast<int4*>(p.idx + ob + r) = int4{te[r], te[r + 1], te[r + 2], te[r + 3]};
    } else {
#pragma unroll
      for (int r = 0; r < 16; r += 4)
        *reinterpret_cast<float4*>(p.gate + ob + r) = float4{ts[r] * inv, ts[r + 1] * inv, ts[r + 2] * inv, ts[r + 3] * inv};
    }
    __syncthreads();
  }
}

typedef __attribute__((ext_vector_type(2))) float f32x2;
__device__ __forceinline__ void fp8x16_to_f32(const uint4 q, f32x2 (&o)[8]) {
  o[0] = __builtin_amdgcn_cvt_pk_f32_fp8((int)q.x, false); o[1] = __builtin_amdgcn_cvt_pk_f32_fp8((int)q.x, true);
  o[2] = __builtin_amdgcn_cvt_pk_f32_fp8((int)q.y, false); o[3] = __builtin_amdgcn_cvt_pk_f32_fp8((int)q.y, true);
  o[4] = __builtin_amdgcn_cvt_pk_f32_fp8((int)q.z, false); o[5] = __builtin_amdgcn_cvt_pk_f32_fp8((int)q.z, true);
  o[6] = __builtin_amdgcn_cvt_pk_f32_fp8((int)q.w, false); o[7] = __builtin_amdgcn_cvt_pk_f32_fp8((int)q.w, true);
}
__device__ __forceinline__ unsigned my_xcc_id() { return (unsigned)__builtin_amdgcn_s_getreg((3 << 11) | 20) & 7u; }

__device__ void phase_exp_u(const Params& p, char* smem) {
  const int tid = opaque_tid(), lane = tid & 63, w = tid >> 6;
  const int sub = lane >> 4, cc = lane & 15;
  const unsigned myx = my_xcc_id();
  int* sh = reinterpret_cast<int*>(smem);
  int* si = reinterpret_cast<int*>(smem + 64) + w * 256;
  float* pbuf = reinterpret_cast<float*>(p.ycat);
  {
    unsigned qcur = 0;
    for (;;) {
      __syncthreads();
      if (tid == 0) {
        int found = -1; unsigned fx = 0;
        for (; qcur < 8; ++qcur) {
          fx = (myx + qcur) & 7u;
          const int c = (int)atomicAdd(&p.ctr[16 + fx], 1u);
          if (c < 256) { found = c; break; }
        }
        sh[0] = found; sh[1] = (int)fx;
      }
      __syncthreads();
      const int chunk = sh[0];
      const unsigned x = (unsigned)sh[1];
      if (chunk < 0) break;
      for (int tt = 0; tt < 8; ++tt) {
        const int t = chunk * 32 + w * 8 + tt;
        __builtin_amdgcn_wave_barrier();
        si[lane] = p.idx[(size_t)t * 128 + lane]; si[64 + lane] = p.idx[(size_t)t * 128 + 64 + lane];
        __builtin_amdgcn_wave_barrier();
        f32x2 hf[8];
#pragma unroll
        for (int q2 = 0; q2 < 2; ++q2) {
          const uint4 hq = *reinterpret_cast<const uint4*>(p.hx + (size_t)t * D + x * 256 + cc * 16 + q2 * 8);
          hf[q2 * 4 + 0] = f32x2{bflo(hq.x), bfhi(hq.x)}; hf[q2 * 4 + 1] = f32x2{bflo(hq.y), bfhi(hq.y)};
          hf[q2 * 4 + 2] = f32x2{bflo(hq.z), bfhi(hq.z)}; hf[q2 * 4 + 3] = f32x2{bflo(hq.w), bfhi(hq.w)};
        }
        const uint8_t* ub = p.U8 + (size_t)x * ((size_t)16384 * 256) + cc * 16;
        uint4 qa[8], qb[8];
#define EU_LOAD(q_, bt_) _Pragma("unroll") for (int k = 0; k < 8; ++k) q_[k] = *reinterpret_cast<const uint4*>(ub + (size_t)si[((bt_) * 8 + k) * 4 + sub] * 256)
#define EU_COMP(q_, kb_)                                                                                                \
  _Pragma("unroll") for (int k = 0; k < 8; ++k) {                                                                       \
    f32x2 uf[8];                                                                                                        \
    fp8x16_to_f32(q_[k], uf);                                                                                           \
    f32x2 d2 = hf[0] * uf[0];                                                                                           \
    _Pragma("unroll") for (int e = 1; e < 8; ++e) d2 += hf[e] * uf[e];                                                  \
    float d = d2.x + d2.y;                                                                                              \
    d += dpp_mov<0xB1>(d); d += dpp_mov<0x4E>(d); d += dpp_mov<0x124>(d); d += dpp_mov<0x128>(d);                       \
    mine = (cc == (kb_) + k) ? d : mine;                                                                                \
  }
        float mine = 0.f;
        EU_LOAD(qa, 0); EU_LOAD(qb, 1);
        EU_COMP(qa, 0); EU_LOAD(qa, 2);
        EU_COMP(qb, 8); EU_LOAD(qb, 3);
        pbuf[((size_t)x * T + t) * 128 + cc * 4 + sub] = mine * (1.f / 512.f);
        mine = 0.f;
        EU_COMP(qa, 0);
        EU_COMP(qb, 8);
        pbuf[((size_t)x * T + t) * 128 + (16 + cc) * 4 + sub] = mine * (1.f / 512.f);
#undef EU_LOAD
#undef EU_COMP
      }
    }
  }
}

__device__ void phase_exp_v(const Params& p, char* smem) {
  const int tid = opaque_tid(), lane = tid & 63, w = tid >> 6;
  const int sub = lane >> 4, cc = lane & 15;
  const unsigned myx = my_xcc_id();
  int* sh = reinterpret_cast<int*>(smem);
  int* si = reinterpret_cast<int*>(smem + 64) + w * 256;
  float* sc = reinterpret_cast<float*>(si + 128);
  bf16_t* yfb = reinterpret_cast<bf16_t*>(p.y_x) + (size_t)T * D;
  {
    unsigned qcur = 0;
    for (;;) {
      __syncthreads();
      if (tid == 0) {
        int found = -1; unsigned fx = 0;
        for (; qcur < 8; ++qcur) {
          fx = (myx + qcur) & 7u;
          const int c = (int)atomicAdd(&p.ctr[32 + fx], 1u);
          if (c < 256) { found = c; break; }
        }
        sh[0] = found; sh[1] = (int)fx;
      }
      __syncthreads();
      const int chunk = sh[0];
      const unsigned x = (unsigned)sh[1];
      if (chunk < 0) break;
      for (int tt = 0; tt < 8; ++tt) {
        const int t = chunk * 32 + w * 8 + tt;
        __builtin_amdgcn_wave_barrier();
        si[lane] = p.idx[(size_t)t * 128 + lane]; si[64 + lane] = p.idx[(size_t)t * 128 + 64 + lane];
        {
          const float* pb = reinterpret_cast<const float*>(p.ycat) + (size_t)t * 128;
          float d0 = 0.f, d1 = 0.f;
#pragma unroll
          for (int xs = 0; xs < 8; ++xs) { d0 += pb[(size_t)xs * T * 128 + lane]; d1 += pb[(size_t)xs * T * 128 + 64 + lane]; }
          sc[lane] = p.gate[(size_t)t * 128 + lane] * 0.5f * d0 * (1.f + erff(d0 * 0.70710678118654752f));
          sc[64 + lane] = p.gate[(size_t)t * 128 + 64 + lane] * 0.5f * d1 * (1.f + erff(d1 * 0.70710678118654752f));
        }
        __builtin_amdgcn_wave_barrier();
        f32x2 acc[8];
#pragma unroll
        for (int e = 0; e < 8; ++e) acc[e] = f32x2{0.f, 0.f};
        const uint8_t* vb = p.V8 + (size_t)x * ((size_t)16384 * 256) + cc * 16;
        uint4 qa[8], qb[8];
#define EV_LOAD(q_, bt_) _Pragma("unroll") for (int k = 0; k < 8; ++k) q_[k] = *reinterpret_cast<const uint4*>(vb + (size_t)si[((bt_) * 8 + k) * 4 + sub] * 256)
#define EV_COMP(q_, bt_)                                                                                                \
  _Pragma("unroll") for (int k = 0; k < 8; ++k) {                                                                       \
    f32x2 vf[8];                                                                                                        \
    fp8x16_to_f32(q_[k], vf);                                                                                           \
    const float cfk = sc[((bt_) * 8 + k) * 4 + sub];                                                                    \
    const f32x2 c2 = f32x2{cfk, cfk};                                                                                   \
    _Pragma("unroll") for (int e = 0; e < 8; ++e) acc[e] += c2 * vf[e];                                                 \
  }
        EV_LOAD(qa, 0); EV_LOAD(qb, 1);
        EV_COMP(qa, 0); EV_LOAD(qa, 2);
        EV_COMP(qb, 1); EV_LOAD(qb, 3);
        EV_COMP(qa, 2);
        EV_COMP(qb, 3);
#undef EV_LOAD
#undef EV_COMP
        {
          float* red = reinterpret_cast<float*>(smem + 8192) + w * 1280;
          float* mr = red + (sub * 16 + cc) * 20;
#pragma unroll
          for (int q4 = 0; q4 < 4; ++q4)
            *reinterpret_cast<float4*>(mr + q4 * 4) = float4{acc[q4 * 2].x, acc[q4 * 2].y, acc[q4 * 2 + 1].x, acc[q4 * 2 + 1].y};
          __builtin_amdgcn_wave_barrier();
          const int part = sub;
          float4 r0 = *reinterpret_cast<const float4*>(red + (0 * 16 + cc) * 20 + part * 4);
          float4 r1 = *reinterpret_cast<const float4*>(red + (1 * 16 + cc) * 20 + part * 4);
          float4 r2 = *reinterpret_cast<const float4*>(red + (2 * 16 + cc) * 20 + part * 4);
          float4 r3 = *reinterpret_cast<const float4*>(red + (3 * 16 + cc) * 20 + part * 4);
          const float sc512 = 1.f / 512.f;
          uint2 o4;
          o4.x = pack2((r0.x + r1.x + r2.x + r3.x) * sc512, (r0.y + r1.y + r2.y + r3.y) * sc512);
          o4.y = pack2((r0.z + r1.z + r2.z + r3.z) * sc512, (r0.w + r1.w + r2.w + r3.w) * sc512);
          *reinterpret_cast<uint2*>(yfb + (size_t)t * D + x * 256 + cc * 16 + part * 4) = o4;
          __builtin_amdgcn_wave_barrier();
        }
      }
    }
  }
}

__device__ void phase_exp_final(const Params& p, int bid, int nb, char* smem) {
  const int lane = threadIdx.x & 63, w = threadIdx.x >> 6;
  const bf16_t* ymix = reinterpret_cast<const bf16_t*>(p.y_x);
  const bf16_t* yf = reinterpret_cast<const bf16_t*>(p.y_x) + (size_t)T * D;
  for (int t = bid * 4 + w; t < T; t += nb * 4) {
    const int b = t / L;
    float4 y[8], xo[8];
#pragma unroll
    for (int c = 0; c < 8; ++c) {
      const uint2 yq = *reinterpret_cast<const uint2*>(yf + (size_t)t * D + c * 256 + lane * 4);
      y[c] = float4{bflo(yq.x), bfhi(yq.x), bflo(yq.y), bfhi(yq.y)};
      xo[c] = *reinterpret_cast<const float4*>(p.x + (size_t)t * D + c * 256 + lane * 4);
    }
    const float rmix = p.partial[t];
    float ss = 0.f;
#pragma unroll
    for (int c = 0; c < 8; ++c) ss += y[c].x * y[c].x + y[c].y * y[c].y + y[c].z * y[c].z + y[c].w * y[c].w;
    ss = wave_sum_fast(ss);
    const float rstd = rsqrtf(ss * (1.f / D) + EPS);
    const float* gfx = p.mod + (size_t)b * NMOD + 5 * D;
    const float* gm = p.mod + (size_t)b * NMOD + 2 * D;
#pragma unroll
    for (int c = 0; c < 8; ++c) {
      const int e0 = c * 256 + lane * 4;
      const uint2 mq = *reinterpret_cast<const uint2*>(ymix + (size_t)t * D + e0);
      const float4 m4 = float4{bflo(mq.x), bfhi(mq.x), bflo(mq.y), bfhi(mq.y)};
      const float4 g4 = *reinterpret_cast<const float4*>(gfx + e0), gp = *reinterpret_cast<const float4*>(p.g_post_ffn + e0);
      const float4 h4 = *reinterpret_cast<const float4*>(gm + e0), hp = *reinterpret_cast<const float4*>(p.g_post_mix + e0);
      xo[c].x += h4.x * (m4.x * rmix * hp.x) + g4.x * (y[c].x * rstd * gp.x);
      xo[c].y += h4.y * (m4.y * rmix * hp.y) + g4.y * (y[c].y * rstd * gp.y);
      xo[c].z += h4.z * (m4.z * rmix * hp.z) + g4.z * (y[c].z * rstd * gp.z);
      xo[c].w += h4.w * (m4.w * rmix * hp.w) + g4.w * (y[c].w * rstd * gp.w);
      *reinterpret_cast<float4*>(p.out + (size_t)t * D + e0) = xo[c];
    }
  }
}

#define XB_TMO      128
#define XB_XCNT(j)  (256  + 64 * (j))
#define XB_XSUB(j)  (1280 + 64 * (j))
#define XB_XGEN(j)  (2304 + 64 * (j))
#define XB_TOP      3328
#define XB_TOPGEN   3392
#define XCD_BAR_WORDS 3456
#define XB_SPIN_CAP (1u << 22)
#define LAS __attribute__((address_space(3)))
__device__ __forceinline__ unsigned xb_ld(unsigned* p)              { return __hip_atomic_load(p, __ATOMIC_RELAXED, __HIP_MEMORY_SCOPE_AGENT); }
__device__ __forceinline__ unsigned xb_add(unsigned* p, unsigned v) { return __hip_atomic_fetch_add(p, v, __ATOMIC_RELAXED, __HIP_MEMORY_SCOPE_AGENT); }
__device__ __forceinline__ unsigned xb_xcc_id() { return (unsigned)__builtin_amdgcn_s_getreg((3 << 11) | 20) & 0xFu; }
#define XB_SPIN(cond, bar) do { unsigned _sp = 0; while (cond) { __builtin_amdgcn_s_sleep(1); \
    if ((++_sp & 255u) == 0u) { if (xb_ld(&(bar)[XB_TMO])) break; if (_sp > XB_SPIN_CAP) { atomicAdd(&(bar)[XB_TMO], 1u); break; } } } } while (0)
struct XcdBarrier { unsigned* bar; unsigned x; volatile LAS unsigned* st; };
__device__ __forceinline__ XcdBarrier xcd_barrier_post(unsigned* bar, volatile LAS unsigned* st) {
  XcdBarrier b; b.bar = bar; b.x = xb_xcc_id(); b.st = st;
  if (threadIdx.x == 0) (void)xb_add(&bar[XB_XCNT(b.x)], 1u);
  return b;
}
__device__ __forceinline__ void xcd_barrier_complete(unsigned* bar, unsigned x, unsigned& nloc, unsigned& nx) {
  const unsigned G = gridDim.x * gridDim.y * gridDim.z;
  unsigned sum, cnt, mine, sp = 0u;
  for (;;) {
    sum = 0u; cnt = 0u; mine = 0u;
#pragma unroll
    for (unsigned j = 0; j < 16; ++j) { const unsigned c = xb_ld(&bar[XB_XCNT(j)]); sum += c; cnt += (c > 0u) ? 1u : 0u; mine = (j == x) ? c : mine; }
    if (sum == G) break;
    __builtin_amdgcn_s_sleep(1);
    if ((++sp & 255u) == 0u) { if (xb_ld(&bar[XB_TMO])) break; if (sp > XB_SPIN_CAP) { atomicAdd(&bar[XB_TMO], 1u); break; } }
  }
  nloc = mine > 0u ? mine : 1u; nx = cnt > 0u ? cnt : 1u;
}
__device__ __forceinline__ void xcd_barrier(const XcdBarrier& b) {
  asm volatile("s_waitcnt vmcnt(0)" ::: "memory");
  __syncthreads();
  if (threadIdx.x == 0) {
    unsigned* bar = b.bar;
    __builtin_amdgcn_s_waitcnt(0);
    unsigned nloc = b.st[0], nx = b.st[1];
    if (nloc == 0u) { xcd_barrier_complete(bar, b.x, nloc, nx); b.st[0] = nloc; b.st[1] = nx; }
    const unsigned old = xb_add(&bar[XB_XSUB(b.x)], 1u);
    const unsigned gen = old / nloc;
    if (old + 1u == (gen + 1u) * nloc) {
      __builtin_amdgcn_fence(__ATOMIC_RELEASE, "agent");
      asm volatile("s_waitcnt vmcnt(0)" ::: "memory");
      const unsigned og = xb_add(&bar[XB_TOP], 1u);
      const unsigned tg = og / nx;
      if (og + 1u == (tg + 1u) * nx) xb_add(&bar[XB_TOPGEN], 1u);
      else XB_SPIN(xb_ld(&bar[XB_TOPGEN]) == tg, bar);
      __builtin_amdgcn_fence(__ATOMIC_ACQUIRE, "agent");
      xb_add(&bar[XB_XGEN(b.x)], 1u);
      asm volatile("s_waitcnt vmcnt(0)" ::: "memory");
    } else {
      XB_SPIN(xb_ld(&bar[XB_XGEN(b.x)]) == gen, bar);
      __builtin_amdgcn_fence(__ATOMIC_ACQUIRE, "agent");
      asm volatile("s_waitcnt vmcnt(0)" ::: "memory");
    }
  }
  __syncthreads();
}

__global__ void __launch_bounds__(NTHREADS, 2) fwd_mega(Params p) {
  __shared__ __attribute__((aligned(16))) char smem[75808];
  const int bid = blockIdx.x, nb = gridDim.x;
  volatile LAS unsigned* st = (volatile LAS unsigned*)(smem + 75792);
  if (threadIdx.x == 0) { st[0] = 0u; st[1] = 0u; }
  __syncthreads();
  const XcdBarrier bar = xcd_barrier_post(p.bar, st);
  phase_prep(p, bid, nb, smem);        xcd_barrier(bar);
  phase_fold(p, bid, nb, smem);        xcd_barrier(bar);
  phase_norm_mod(p, bid, nb, smem);    xcd_barrier(bar);
  phase_inproj(p, bid, nb, smem);      xcd_barrier(bar);
  phase_ssm_pre(p, bid, nb, smem);     xcd_barrier(bar);
  phase_ssd_dft(p, bid, nb, smem);     xcd_barrier(bar);
  phase_ssm_post(p, bid, nb, smem);    xcd_barrier(bar);
  phase_outproj(p, bid, nb, smem);     xcd_barrier(bar);
  phase_postmix(p, bid, nb, smem);     xcd_barrier(bar);
  phase_q_route(p, bid, nb, smem);     xcd_barrier(bar);
  phase_exp_u(p, smem);                xcd_barrier(bar);
  phase_exp_v(p, smem);                xcd_barrier(bar);
  phase_exp_final(p, bid, nb, smem);
}

}

extern "C" void kernel_launch(void* const* d_in, const int* in_sizes, int n_in, void* d_out, int out_size, void* d_ws,
                              size_t ws_size, hipStream_t stream) {
  Params p{};
  const float** fp = reinterpret_cast<const float**>(&p);
  for (int i = 0; i < 27; ++i) fp[i] = (const float*)d_in[i];
  p.out = (float*)d_out;
  char* ws = (char*)d_ws;
  size_t off = 0;
  auto take = [&](size_t bytes) { char* r = ws + off; off += (bytes + 255) & ~(size_t)255; return r; };
  p.U8 = (uint8_t*)take((size_t)16384 * D);
  p.V8 = (uint8_t*)take((size_t)16384 * D);
  p.w_in_t = (bf16_t*)take((size_t)NPROJ * D * 2);
  p.w_out_t = (bf16_t*)take((size_t)D * D * 2);
  p.w_q_t = (bf16_t*)take((size_t)1024 * D * 2);
  p.w_in_f = (bf16_t*)take((size_t)D * 1024 * 2);
  p.WcsT = (bf16_t*)take((size_t)4 * 512 * 256 * 2);
  p.dftm = (bf16_t*)take((size_t)1024 * 2048 * 2);
  p.Fs = (bf16_t*)take((size_t)NB * 1024 * 2048 * 2);
  p.partial = (float*)take((size_t)KSPLIT * 5 * NMOD * 4);
  p.mod = (float*)take((size_t)5 * NMOD * 4);
  p.hx = (bf16_t*)take((size_t)T * D * 2);
  p.hc = (bf16_t*)take((size_t)TC * D * 2);
  p.ABt = (bf16_t*)take((size_t)NB * 1024 * 4096 * 2);
  p.q = (float*)p.ABt;
  p.z = (bf16_t*)take((size_t)T * 1024 * 2);
  char* r1 = take(0);
  p.xbcraw = (bf16_t*)take((size_t)T * DXBC * 4);
  p.xbcraw_c = (bf16_t*)take((size_t)TC * DXBC * 4);
  p.act_tm = (bf16_t*)take((size_t)(T + TC) * DXBC * 2);
  p.act_cm_x = (bf16_t*)take((size_t)NB * 1280 * L * 2);
  p.act_cm_c = (bf16_t*)take((size_t)NB * 1280 * CTX * 2);
  p.y_x = (float*)r1;
  p.dtraw = (float*)take((size_t)T * 32 * 4);
  p.dtraw_c = (float*)take((size_t)TC * 32 * 4);
  p.dtf = (float*)take((size_t)T * 16 * 4);
  p.dtb = (float*)take((size_t)T * 16 * 4);
  p.dtf_c = (float*)take((size_t)TC * 16 * 4);
  p.dtb_c = (float*)take((size_t)TC * 16 * 4);
  p.yf = (float*)take((size_t)T * 1024 * 4);
  p.yb = (float*)take((size_t)T * 1024 * 4);
  p.ctr = (unsigned*)take(256);
  p.bar = (unsigned*)take((size_t)XCD_BAR_WORDS * 4);
  p.ycat = (bf16_t*)take((size_t)T * D * 2);
  p.idx = (int*)take((size_t)T * 128 * 4);
  p.gate = (float*)take((size_t)T * 128 * 4);
  if (off > ws_size) { fprintf(stderr, "kernel_launch: workspace too small: need %zu have %zu\n", off, ws_size); return; }
  static int grid_blocks = 0;
  if (!grid_blocks) {
    int dev = 0, cus = 0, per_cu = 0;
    hipGetDevice(&dev);
    hipDeviceGetAttribute(&cus, hipDeviceAttributeMultiprocessorCount, dev);
    hipOccupancyMaxActiveBlocksPerMultiprocessor(&per_cu, fwd_mega, NTHREADS, 0);
    if (per_cu > 2) per_cu = 2;
    grid_blocks = cus * per_cu;
    if (grid_blocks <= 0) { fprintf(stderr, "kernel_launch: occupancy query gave %d x %d\n", cus, per_cu); grid_blocks = -1; }
  }
  if (grid_blocks < 0) return;
  (void)hipMemsetAsync(p.bar, 0, (size_t)XCD_BAR_WORDS * 4, stream);
  void* args[] = {&p};
  hipError_t e = hipLaunchCooperativeKernel((void*)fwd_mega, dim3(grid_blocks), dim3(NTHREADS), args, 0, stream);
  if (e != hipSuccess) fprintf(stderr, "cooperative launch failed: %s (grid %d)\n", hipGetErrorString(e), grid_blocks);
}
```

```cpp
#include <hip/hip_runtime.h>
#include <hip/hip_cooperative_groups.h>
#include <stdint.h>
#include <stdio.h>

namespace cg = cooperative_groups;
namespace {

typedef __attribute__((ext_vector_type(8))) short bf16x8;
typedef __attribute__((ext_vector_type(4))) float f32x4;
typedef unsigned short bf16_t;

constexpr int D = 2048, NB = 4, L = 2048, T = NB * L, CTX = 256, TC = NB * CTX;
constexpr int NMOD = 6 * D;
constexpr int NH = 16, HP = 64, NS = 128, DXBC = 1536;
constexpr int DIN = 3616;
constexpr int NPROJ = 4736;
constexpr int KSPLIT = 32;
constexpr float EPS = 1e-6f;
constexpr int NTHREADS = 256;

__device__ __forceinline__ bf16_t f2bf(float f) { __bf16 h = (__bf16)f; return __builtin_bit_cast(unsigned short, h); }
__device__ __forceinline__ float bf2f(bf16_t h) { return __uint_as_float(((uint32_t)h) << 16); }
__device__ __forceinline__ uint32_t pack2(float a, float b) {
  typedef __attribute__((ext_vector_type(2))) __bf16 bf16x2_t;
  typedef __attribute__((ext_vector_type(2))) float f32x2_t;
  const f32x2_t v = {a, b};
  return __builtin_bit_cast(uint32_t, __builtin_convertvector(v, bf16x2_t));
}
__device__ __forceinline__ float bflo(uint32_t w) { return __uint_as_float(w << 16); }
__device__ __forceinline__ float bfhi(uint32_t w) { return __uint_as_float(w & 0xffff0000u); }
__device__ __forceinline__ float silu_f(float v) { return v / (1.f + __expf(-v)); }
__device__ __forceinline__ float softplus_f(float v) { return v > 20.f ? v : log1pf(__expf(v)); }

__device__ __forceinline__ int opaque_tid() { int t = threadIdx.x; asm volatile("" : "+v"(t)); return t; }
__device__ __forceinline__ float wave_sum(float v) {
#pragma unroll
  for (int o = 32; o > 0; o >>= 1) v += __shfl_xor(v, o);
  return v;
}
template <int CTRL>
__device__ __forceinline__ float dpp_mov(float v) {
  return __int_as_float(__builtin_amdgcn_update_dpp(0, __float_as_int(v), CTRL, 0xF, 0xF, true));
}
__device__ __forceinline__ float wave_sum_fast(float v) {
  v += dpp_mov<0xB1>(v); v += dpp_mov<0x4E>(v); v += dpp_mov<0x124>(v); v += dpp_mov<0x128>(v);
  v += __shfl_xor(v, 16); v += __shfl_xor(v, 32);
  return v;
}
__device__ __forceinline__ float wave_max(float v) {
#pragma unroll
  for (int o = 32; o > 0; o >>= 1) v = fmaxf(v, __shfl_xor(v, o));
  return v;
}
__device__ __forceinline__ float block_sum(float v, float* red) {
  v = wave_sum(v);
  __syncthreads();
  if ((threadIdx.x & 63) == 0) red[threadIdx.x >> 6] = v;
  __syncthreads();
  return red[0] + red[1] + red[2] + red[3];
}

struct Params {
  const float *x, *c, *ctx, *c_ctx, *w_mod, *b_mod, *g_pre_mix, *g_post_mix, *g_pre_ffn, *g_post_ffn;
  const float *w_in, *w_fmix, *conv_w, *conv_b, *dt_bias_f, *dt_bias_b, *a_log_f, *a_log_b, *d_skip_f, *d_skip_b;
  const float *ssm_norm_w, *w_out, *w_query, *sk1, *sk2, *eu, *ev;
  float* out;
  uint8_t *U8, *V8;
  int8_t *hx8a, *w8;
  float *ascale, *wscale;
  bf16_t *w_in_t, *w_out_t, *w_q_t, *w_in_f, *WcsT, *dftm, *Fs;
  float *partial, *mod;
  bf16_t *hx, *hc, *ABt, *z;
  bf16_t *xbcraw, *xbcraw_c;
  float *dtraw, *dtraw_c, *dtf, *dtb, *dtf_c, *dtb_c;
  bf16_t *act_tm, *act_cm_x, *act_cm_c;
  float *yf, *yb;
  unsigned* ctr; unsigned* bar;
  bf16_t* ycat;
  float *y_x, *q, *gate;
  int* idx;
  int pad0, pad1;
};

__device__ __forceinline__ void gemm_mainloop(const bf16_t* __restrict__ A, int lda, const bf16_t* __restrict__ Bt, int ldb,
                                              int K, int m0, int n0, f32x4 (&acc)[4][4], char* smem) {
  const int tid = opaque_tid(), lane = tid & 63, w = tid >> 6;
  const int wm = w >> 1, wn = w & 1;
#pragma unroll
  for (int i = 0; i < 4; ++i)
#pragma unroll
    for (int j = 0; j < 4; ++j) acc[i][j] = f32x4{0.f, 0.f, 0.f, 0.f};

  const int nk = K / 64;
  const int rowoff = lane >> 3, lch = (lane & 7) ^ rowoff;
  const bf16_t* gA = A + (size_t)(m0 + w * 8 + rowoff) * lda + lch * 8;
  const bf16_t* gB = Bt + (size_t)(n0 + w * 8 + rowoff) * ldb + lch * 8;
#define GSTAGE(buf_, kt_)                                                                                               \
  do {                                                                                                                  \
    _Pragma("unroll") for (int i_ = 0; i_ < 4; ++i_) {                                                                  \
      __builtin_amdgcn_global_load_lds((const unsigned*)(gA + (size_t)(i_ * 32) * lda + (kt_) * 64),                    \
                                       (unsigned*)(smem + (buf_) * 32768 + (i_ * 4 + w) * 1024), 16, 0, 0);             \
      __builtin_amdgcn_global_load_lds((const unsigned*)(gB + (size_t)(i_ * 32) * ldb + (kt_) * 64),                    \
                                       (unsigned*)(smem + (buf_) * 32768 + 16384 + (i_ * 4 + w) * 1024), 16, 0, 0);     \
    }                                                                                                                   \
  } while (0)
  GSTAGE(0, 0);
  asm volatile("s_waitcnt vmcnt(0)" ::: "memory");
  __syncthreads();
  for (int kt = 0; kt < nk; ++kt) {
    const int cur = kt & 1;
    if (kt + 1 < nk) GSTAGE(cur ^ 1, kt + 1);
    const char* sA = smem + cur * 32768;
    const char* sB = sA + 16384;
#pragma unroll
    for (int kk = 0; kk < 2; ++kk) {
      bf16x8 af[4], bfr[4];
      const int ch = kk * 4 + (lane >> 4);
#pragma unroll
      for (int i = 0; i < 4; ++i) {
        int row = wm * 64 + i * 16 + (lane & 15);
        af[i] = *reinterpret_cast<const bf16x8*>(sA + row * 128 + ((ch ^ (row & 7)) << 4));
        int col = wn * 64 + i * 16 + (lane & 15);
        bfr[i] = *reinterpret_cast<const bf16x8*>(sB + col * 128 + ((ch ^ (col & 7)) << 4));
      }
#pragma unroll
      for (int i = 0; i < 4; ++i)
#pragma unroll
        for (int j = 0; j < 4; ++j) acc[i][j] = __builtin_amdgcn_mfma_f32_16x16x32_bf16(af[i], bfr[j], acc[i][j], 0, 0, 0);
    }
    asm volatile("s_waitcnt vmcnt(0)" ::: "memory");
    __syncthreads();
  }
#undef GSTAGE
}

template <class Epi>
__device__ __forceinline__ void gemm_tile(const bf16_t* __restrict__ A, int lda, const bf16_t* __restrict__ Bt, int ldb,
                                          int K, int m0, int n0, const Epi& epi, char* smem) {
  const int lane = threadIdx.x & 63, w = threadIdx.x >> 6;
  const int wm = w >> 1, wn = w & 1;
  f32x4 acc[4][4];
  gemm_mainloop(A, lda, Bt, ldb, K, m0, n0, acc, smem);
#pragma unroll
  for (int i = 0; i < 4; ++i)
#pragma unroll
    for (int j = 0; j < 4; ++j) {
      int row = m0 + wm * 64 + i * 16 + (lane >> 4) * 4;
      int col = n0 + wn * 64 + j * 16 + (lane & 15);
      epi(row, col, acc[i][j]);
    }
}

template <bool I8>
__device__ __forceinline__ void gemm_mainloop_n256(const bf16_t* __restrict__ A, int lda, const bf16_t* __restrict__ Bt, int ldb,
                                                   int K, int m0, int n0, f32x4 (&acc)[4][8], char* smem) {
  const int tid = opaque_tid(), lane = tid & 63, w = tid >> 6;
  const int wm = w >> 1, wn = w & 1;
#pragma unroll
  for (int i = 0; i < 4; ++i)
#pragma unroll
    for (int j = 0; j < 8; ++j) acc[i][j] = f32x4{0.f, 0.f, 0.f, 0.f};
  const int nk = K / 64;
  const int rowoff = lane >> 3, lch = (lane & 7) ^ rowoff;
  const bf16_t* gA = A + (size_t)(m0 + w * 8 + rowoff) * lda + lch * 8;
  const bf16_t* gB = Bt + (size_t)(n0 + w * 8 + rowoff) * ldb + lch * 8;
  const int fr = lane & 15, fq = lane >> 4;
  for (int kt = 0; kt < nk; ++kt) {
#pragma unroll
    for (int i_ = 0; i_ < 4; ++i_)
      __builtin_amdgcn_global_load_lds((const unsigned*)(gA + (size_t)(i_ * 32) * lda + kt * 64),
                                       (unsigned*)(smem + (i_ * 4 + w) * 1024), 16, 0, 0);
#pragma unroll
    for (int i_ = 0; i_ < 8; ++i_)
      __builtin_amdgcn_global_load_lds((const unsigned*)(gB + (size_t)(i_ * 32) * ldb + kt * 64),
                                       (unsigned*)(smem + 16384 + (i_ * 4 + w) * 1024), 16, 0, 0);
    asm volatile("s_waitcnt vmcnt(0)" ::: "memory");
    __syncthreads();
    const char* sA = smem;
    const char* sB = smem + 16384;
#pragma unroll
    for (int kk = 0; kk < 2; ++kk) {
      bf16x8 af[4], bfr[8];
      const int ch = kk * 4 + fq;
#pragma unroll
      for (int i = 0; i < 4; ++i) {
        const int row = wm * 64 + i * 16 + fr;
        af[i] = *reinterpret_cast<const bf16x8*>(sA + row * 128 + ((ch ^ (row & 7)) << 4));
      }
#pragma unroll
      for (int j = 0; j < 8; ++j) {
        const int col = wn * 128 + j * 16 + fr;
        bfr[j] = *reinterpret_cast<const bf16x8*>(sB + col * 128 + ((ch ^ (col & 7)) << 4));
      }
#pragma unroll
      for (int i = 0; i < 4; ++i)
#pragma unroll
        for (int j = 0; j < 8; ++j) {
          if (I8) {
            typedef __attribute__((ext_vector_type(4))) int i32x4;
            acc[i][j] = __builtin_bit_cast(f32x4, __builtin_amdgcn_mfma_i32_16x16x64_i8(__builtin_bit_cast(i32x4, af[i]), __builtin_bit_cast(i32x4, bfr[j]),
                                                                                         __builtin_bit_cast(i32x4, acc[i][j]), 0, 0, 0));
          } else {
            acc[i][j] = __builtin_amdgcn_mfma_f32_16x16x32_bf16(af[i], bfr[j], acc[i][j], 0, 0, 0);
          }
        }
    }
    __syncthreads();
  }
}
template <bool I8, class Epi>
__device__ __forceinline__ void gemm_tile_n256(const bf16_t* __restrict__ A, int lda, const bf16_t* __restrict__ Bt, int ldb,
                                               int K, int m0, int n0, const Epi& epi, char* smem,
                                               const float* __restrict__ rscale = nullptr, const float* __restrict__ cscale = nullptr) {
  const int lane = threadIdx.x & 63, w = threadIdx.x >> 6;
  const int wm = w >> 1, wn = w & 1;
  f32x4 acc[4][8];
  gemm_mainloop_n256<I8>(A, lda, Bt, ldb, K, m0, n0, acc, smem);
#pragma unroll
  for (int i = 0; i < 4; ++i) {
    const int row = m0 + wm * 64 + i * 16 + (lane >> 4) * 4;
    float4 rs = float4{1.f, 1.f, 1.f, 1.f};
    if (I8) rs = *reinterpret_cast<const float4*>(rscale + row);
#pragma unroll
    for (int j = 0; j < 8; ++j) {
      const int col = n0 + wn * 128 + j * 16 + (lane & 15);
      if (I8) {
        typedef __attribute__((ext_vector_type(4))) int i32x4;
        const i32x4 ia = __builtin_bit_cast(i32x4, acc[i][j]);
        const float cs = cscale[col];
        epi(row, col, f32x4{(float)ia[0] * rs.x * cs, (float)ia[1] * rs.y * cs, (float)ia[2] * rs.z * cs, (float)ia[3] * rs.w * cs});
      } else {
        epi(row, col, acc[i][j]);
      }
    }
  }
}

__device__ __forceinline__ float wave_max_fast(float v) {
  v = fmaxf(v, dpp_mov<0xB1>(v)); v = fmaxf(v, dpp_mov<0x4E>(v)); v = fmaxf(v, dpp_mov<0x124>(v)); v = fmaxf(v, dpp_mov<0x128>(v));
  v = fmaxf(v, __shfl_xor(v, 16)); v = fmaxf(v, __shfl_xor(v, 32));
  return v;
}
__device__ __forceinline__ uint32_t pack_i8x4(float a, float b, float c, float d) {
  const int ia = __float2int_rn(a), ib = __float2int_rn(b), ic = __float2int_rn(c), id = __float2int_rn(d);
  return (uint32_t)(ia & 255) | ((uint32_t)(ib & 255) << 8) | ((uint32_t)(ic & 255) << 16) | ((uint32_t)id << 24);
}
struct EpiF32 {
  float* C; int ldc;
  __device__ __forceinline__ void operator()(int row, int col, f32x4 v) const {
#pragma unroll
    for (int r = 0; r < 4; ++r) C[(size_t)(row + r) * ldc + col] = v[r];
  }
};
struct EpiBf16 {
  bf16_t* C; int ldc;
  __device__ __forceinline__ void operator()(int row, int col, f32x4 v) const {
#pragma unroll
    for (int r = 0; r < 4; ++r) C[(size_t)(row + r) * ldc + col] = f2bf(v[r]);
  }
};
struct EpiBf16T {
  bf16_t* Ct; int ldc;
  __device__ __forceinline__ void operator()(int row, int col, f32x4 v) const {
    uint2 pk; pk.x = pack2(v[0], v[1]); pk.y = pack2(v[2], v[3]);
    *reinterpret_cast<uint2*>(Ct + (size_t)col * ldc + row) = pk;
  }
};
struct EpiInAB {
  bf16_t* ABt; int seqlen;
  __device__ __forceinline__ void operator()(int row, int col, f32x4 v) const {
    const int ch = col & 1023, half = col >> 10;
    const int b = row / seqlen, l = row - b * seqlen;
    uint2 pk; pk.x = pack2(v[0], v[1]); pk.y = pack2(v[2], v[3]);
    *reinterpret_cast<uint2*>(ABt + ((size_t)(b * 1024 + ch) * 4096 + half * 2048 + l)) = pk;
  }
};
struct EpiInZ {
  bf16_t* z;
  __device__ __forceinline__ void operator()(int row, int col, f32x4 v) const {
#pragma unroll
    for (int r = 0; r < 4; ++r) z[(size_t)(row + r) * 1024 + (col - 2048)] = f2bf(v[r]);
  }
};
struct EpiInXbc {
  bf16_t* xbcraw;
  __device__ __forceinline__ void operator()(int row, int col, f32x4 v) const {
#pragma unroll
    for (int r = 0; r < 4; ++r) xbcraw[(size_t)(row + r) * DXBC + (col - 3072)] = f2bf(v[r]);
  }
};
struct EpiInProj {
  bf16_t* ABt; bf16_t* z; bf16_t* xbcraw; float* dtraw; int seqlen;
  __device__ __forceinline__ void operator()(int row, int col, f32x4 v) const {
    if (col < 2048) {
      int ch = col & 1023, half = col >> 10;
      int b = row / seqlen, l = row - b * seqlen;
      uint2 pk; pk.x = pack2(v[0], v[1]); pk.y = pack2(v[2], v[3]);
      *reinterpret_cast<uint2*>(ABt + ((size_t)(b * 1024 + ch) * 4096 + half * 2048 + l)) = pk;
    } else if (col < 3072) {
#pragma unroll
      for (int r = 0; r < 4; ++r) z[(size_t)(row + r) * 1024 + (col - 2048)] = f2bf(v[r]);
    } else if (col < 4608) {
#pragma unroll
      for (int r = 0; r < 4; ++r) xbcraw[(size_t)(row + r) * DXBC + (col - 3072)] = f2bf(v[r]);
    } else if (col < 4640) {
#pragma unroll
      for (int r = 0; r < 4; ++r) dtraw[(size_t)(row + r) * 32 + (col - 4608)] = v[r];
    }
  }
};

__device__ void adaln_partial_task(const Params& p, int task, float* sm) {
  const int cb = task % 48, ks = task / 48, tid = threadIdx.x;
  float* sc = sm;
  __syncthreads();
  for (int i = tid; i < 5 * 64; i += NTHREADS) {
    int r = i >> 6, kk = i & 63;
    int k = ks * 64 + kk;
    float cv = (r < 4) ? p.c[r * D + k] : p.c_ctx[k];
    sc[i] = silu_f(cv);
  }
  __syncthreads();
  const int col = cb * 256 + tid;
  float a0 = 0, a1 = 0, a2 = 0, a3 = 0, a4 = 0;
  const float* wp = p.w_mod + (size_t)(ks * 64) * NMOD + col;
#pragma unroll
  for (int h2 = 0; h2 < 2; ++h2) {
    float wv[32];
#pragma unroll
    for (int kk = 0; kk < 32; ++kk) wv[kk] = __builtin_nontemporal_load(wp + (size_t)(h2 * 32 + kk) * NMOD);
#pragma unroll
    for (int kk = 0; kk < 32; ++kk) {
      const int k = h2 * 32 + kk;
      a0 += sc[k] * wv[kk]; a1 += sc[64 + k] * wv[kk]; a2 += sc[128 + k] * wv[kk]; a3 += sc[192 + k] * wv[kk]; a4 += sc[256 + k] * wv[kk];
    }
  }
  float* pp = p.partial + (size_t)ks * 5 * NMOD + col;
  pp[0] = a0; pp[NMOD] = a1; pp[2 * NMOD] = a2; pp[3 * NMOD] = a3; pp[4 * NMOD] = a4;
}

__device__ void transpose_convert_task(const float* __restrict__ src, int ld, int c0, int rows, bf16_t* __restrict__ dst,
                                       int tr, int tc, float* sm) {
  float (*tile)[68] = reinterpret_cast<float (*)[68]>(sm);
  const int tid = threadIdx.x;
  __syncthreads();
  {
    float4 v[4];
#pragma unroll
    for (int k = 0; k < 4; ++k) {
      const int i = tid + k * NTHREADS, r = i >> 4, c4 = i & 15;
      v[k] = *reinterpret_cast<const float4*>(src + (size_t)(tr * 64 + r) * ld + c0 + tc * 64 + c4 * 4);
    }
#pragma unroll
    for (int k = 0; k < 4; ++k) {
      const int i = tid + k * NTHREADS, r = i >> 4, c4 = i & 15;
      *reinterpret_cast<float4*>(&tile[r][c4 * 4]) = v[k];
    }
  }
  __syncthreads();
#pragma unroll
  for (int k = 0; k < 4; ++k) {
    const int i = tid + k * NTHREADS, cc = i >> 4, r4 = (i & 15) * 4;
    uint2 o; o.x = pack2(tile[r4][cc], tile[r4 + 1][cc]); o.y = pack2(tile[r4 + 2][cc], tile[r4 + 3][cc]);
    *reinterpret_cast<uint2*>(dst + (size_t)(tc * 64 + cc) * rows + tr * 64 + r4) = o;
  }
}

__device__ void phase_prep(const Params& p, int bid, int nb, char* smem) {
  float* sm = reinterpret_cast<float*>(smem);
  const int tid = threadIdx.x;
  if (bid == 0 && tid < 64) p.ctr[tid] = 0u;
  {
    float* t256 = reinterpret_cast<float*>(smem + 20480);
    float* t2048 = reinterpret_cast<float*>(smem + 24576);
    t256[tid] = cospif((float)tid * (1.0f / 128.f));
    for (int i = tid; i < 2048; i += NTHREADS) t2048[i] = cospif((float)i * (1.0f / 1024.f));
    __syncthreads();
  }
  for (int t = bid; t < 48 * KSPLIT; t += nb) adaln_partial_task(p, t, sm);
  {
    const int nct = 41, nrt = 32;
    for (int t = bid; t < nct * nrt; t += nb) {
      int tc = t % nct, tr = t / nct;
      if (tc < 40) transpose_convert_task(p.w_in, DIN, 1024, D, p.w_in_t + (size_t)2048 * D, tr, tc, sm);
      else {
        float (*tile)[65] = reinterpret_cast<float (*)[65]>(sm);
        __syncthreads();
        for (int i = tid; i < 64 * 32; i += NTHREADS) {
          int r = i >> 5, cc = i & 31;
          tile[r][cc] = p.w_in[(size_t)(tr * 64 + r) * DIN + 1024 + 2560 + cc];
        }
        __syncthreads();
        for (int i = tid; i < 32 * 32; i += NTHREADS) {
          int cc = i >> 5, r2 = (i & 31) * 2;
          uint32_t pk = pack2(tile[r2][cc], tile[r2 + 1][cc]);
          *reinterpret_cast<uint32_t*>(p.w_in_t + (size_t)(2048 + 2560 + cc) * D + tr * 64 + r2) = pk;
        }
      }
    }
    for (size_t i = (size_t)bid * NTHREADS + tid; i < (size_t)96 * D / 8; i += (size_t)nb * NTHREADS)
      reinterpret_cast<uint4*>(p.w_in_t + (size_t)4640 * D)[i] = uint4{0, 0, 0, 0};
  }
  for (size_t i = (size_t)bid * NTHREADS + tid; i < (size_t)D * 1024 / 4; i += (size_t)nb * NTHREADS) {
    int k = (int)(i / 256), c4 = (int)(i % 256) * 4;
    float4 v = *reinterpret_cast<const float4*>(p.w_in + (size_t)k * DIN + c4);
    uint2 o; o.x = pack2(v.x, v.y); o.y = pack2(v.z, v.w);
    *reinterpret_cast<uint2*>(p.w_in_f + (size_t)k * 1024 + c4) = o;
  }
  {
    const float* t256 = reinterpret_cast<const float*>(smem + 20480);
    const float scale = 1.0f / sqrtf((float)L * 256.f);
    for (int i = bid * NTHREADS + tid; i < 4 * 64 * 256; i += nb * NTHREADS) {
      const int d = i & 255, cg = (i >> 8) & 63, g = i >> 14;
      float sc_[4] = {0.f, 0.f, 0.f, 0.f}, ss_[4] = {0.f, 0.f, 0.f, 0.f};
      const float* wp = p.w_fmix + (size_t)g * 65536 + d;
#pragma unroll 4
      for (int m = 0; m < 256; ++m) {
        const float wv = wp[m * 256];
#pragma unroll
        for (int j = 0; j < 4; ++j) {
          const int ph = (m * (cg * 4 + j)) & 255;
          sc_[j] += t256[ph] * wv; ss_[j] += t256[(ph - 64) & 255] * wv;
        }
      }
#pragma unroll
      for (int j = 0; j < 4; ++j) {
        const int c = cg * 4 + j;
        p.WcsT[((size_t)g * 512 + d) * 256 + c] = f2bf(sc_[j] * scale);
        p.WcsT[((size_t)g * 512 + 256 + d) * 256 + c] = f2bf(ss_[j] * scale);
      }
    }
  }
  {
    const float* t2048 = reinterpret_cast<const float*>(smem + 24576);
    for (size_t i = (size_t)bid * NTHREADS + tid; i < (size_t)1024 * 2048 / 8; i += (size_t)nb * NTHREADS) {
      const int k = (int)(i / 256), j = (int)(i % 256) * 8;
      const bool iss = j >= 1024;
      float o[8];
#pragma unroll
      for (int e = 0; e < 8; ++e) {
        const int l = (j + e) & 1023;
        const int ph = (k * l) & 2047;
        o[e] = iss ? t2048[(ph - 512) & 2047] : t2048[ph];
      }
      uint4 pk; pk.x = pack2(o[0], o[1]); pk.y = pack2(o[2], o[3]); pk.z = pack2(o[4], o[5]); pk.w = pack2(o[6], o[7]);
      *reinterpret_cast<uint4*>(p.dftm + (size_t)k * 2048 + j) = pk;
    }
  }
}

__device__ void phase_fold(const Params& p, int bid, int nb, char* smem) {
  const int tid = threadIdx.x;
  for (int i = bid * NTHREADS + tid; i < 5 * NMOD; i += nb * NTHREADS) {
    int col = i % NMOD;
    float s = p.b_mod[col];
    for (int ks = 0; ks < KSPLIT; ++ks) s += p.partial[(size_t)ks * 5 * NMOD + i];
    p.mod[i] = s;
  }
  for (int t = bid; t < 256; t += nb) {
    int g = t >> 6, tm = (t & 63) >> 2, tn = t & 3;
    int n0 = tn * 128;
    int rowbase = (n0 < 256) ? (g * 256 + n0) : (1024 + g * 256 + (n0 - 256));
    EpiBf16T epi{p.w_in_t + (size_t)(rowbase - n0) * D, D};
    gemm_tile(p.w_in_f + g * 256, 1024, p.WcsT + (size_t)g * 512 * 256, 256, 256, tm * 128, n0, epi, smem);
  }
}

__device__ void phase_norm_mod(const Params& p, int bid, int nb, char* smem) {
  const int lane = threadIdx.x & 63, w = threadIdx.x >> 6;
  for (int t = bid * 4 + w; t < T + TC; t += nb * 4) {
    const bool isx = t < T;
    const float* src = isx ? (p.x + (size_t)t * D) : (p.ctx + (size_t)(t - T) * D);
    const int mrow = isx ? (t / L) : 4;
    bf16_t* dst = isx ? (p.hx + (size_t)t * D) : (p.hc + (size_t)(t - T) * D);
    float4 v[8];
    float ss = 0.f;
#pragma unroll
    for (int c = 0; c < 8; ++c) {
      v[c] = *reinterpret_cast<const float4*>(src + c * 256 + lane * 4);
      ss += v[c].x * v[c].x + v[c].y * v[c].y + v[c].z * v[c].z + v[c].w * v[c].w;
    }
    ss = wave_sum_fast(ss);
    const float rstd = rsqrtf(ss * (1.f / D) + EPS);
    const float* sh = p.mod + (size_t)mrow * NMOD + 0 * D;
    const float* sc = p.mod + (size_t)mrow * NMOD + 1 * D;
    float am = 0.f;
#pragma unroll
    for (int c = 0; c < 8; ++c) {
      const int e0 = c * 256 + lane * 4;
      const float4 g = *reinterpret_cast<const float4*>(p.g_pre_mix + e0);
      const float4 s4 = *reinterpret_cast<const float4*>(sc + e0), h4 = *reinterpret_cast<const float4*>(sh + e0);
      v[c].x = v[c].x * rstd * g.x * (1.f + s4.x) + h4.x; v[c].y = v[c].y * rstd * g.y * (1.f + s4.y) + h4.y;
      v[c].z = v[c].z * rstd * g.z * (1.f + s4.z) + h4.z; v[c].w = v[c].w * rstd * g.w * (1.f + s4.w) + h4.w;
      am = fmaxf(am, fmaxf(fmaxf(fabsf(v[c].x), fabsf(v[c].y)), fmaxf(fabsf(v[c].z), fabsf(v[c].w))));
      uint2 pk;
      pk.x = pack2(v[c].x, v[c].y);
      pk.y = pack2(v[c].z, v[c].w);
      *reinterpret_cast<uint2*>(dst + e0) = pk;
    }
    if (isx) {
      am = wave_max_fast(am);
      const float inv = (am > 0.f) ? 127.f / am : 0.f;
#pragma unroll
      for (int c = 0; c < 8; ++c)
        *reinterpret_cast<uint32_t*>(p.hx8a + (size_t)t * D + c * 256 + lane * 4) = pack_i8x4(v[c].x * inv, v[c].y * inv, v[c].z * inv, v[c].w * inv);
      if (lane == 0) p.ascale[t] = am * (1.f / 127.f);
    }
  }
  for (int n = bid * 4 + w; n < 4096; n += nb * 4) {
    const bf16_t* wr = p.w_in_t + (size_t)n * D;
    uint4 q[4];
#pragma unroll
    for (int c = 0; c < 4; ++c) q[c] = *reinterpret_cast<const uint4*>(wr + c * 512 + lane * 8);
    float am = 0.f;
#pragma unroll
    for (int c = 0; c < 4; ++c) {
      am = fmaxf(am, fmaxf(fmaxf(fabsf(bflo(q[c].x)), fabsf(bfhi(q[c].x))), fmaxf(fabsf(bflo(q[c].y)), fabsf(bfhi(q[c].y)))));
      am = fmaxf(am, fmaxf(fmaxf(fabsf(bflo(q[c].z)), fabsf(bfhi(q[c].z))), fmaxf(fabsf(bflo(q[c].w)), fabsf(bfhi(q[c].w)))));
    }
    am = wave_max_fast(am);
    const float inv = (am > 0.f) ? 127.f / am : 0.f;
#pragma unroll
    for (int c = 0; c < 4; ++c) {
      uint2 o;
      o.x = pack_i8x4(bflo(q[c].x) * inv, bfhi(q[c].x) * inv, bflo(q[c].y) * inv, bfhi(q[c].y) * inv);
      o.y = pack_i8x4(bflo(q[c].z) * inv, bfhi(q[c].z) * inv, bflo(q[c].w) * inv, bfhi(q[c].w) * inv);
      *reinterpret_cast<uint2*>(p.w8 + (size_t)n * D + c * 512 + lane * 8) = o;
    }
    if (lane == 0) p.wscale[n] = am * (1.f / 127.f);
  }
}

__device__ __forceinline__ void convert_uv_units(const Params& p, size_t u0, size_t u1) {
  const size_t n16 = (size_t)16384 * D / 16;
  for (size_t i = u0 + threadIdx.x; i < u1; i += NTHREADS) {
    const float* s = (i < n16) ? p.eu : p.ev;
    uint8_t* d = (i < n16) ? p.U8 : p.V8;
    const size_t j = (i < n16) ? i : i - n16;
    uint32_t o[4];
#pragma unroll
    for (int q4 = 0; q4 < 4; ++q4) {
      const float4 v = *reinterpret_cast<const float4*>(s + j * 16 + q4 * 4);
      int pk = 0;
      pk = __builtin_amdgcn_cvt_pk_fp8_f32(v.x * 512.f, v.y * 512.f, pk, false);
      pk = __builtin_amdgcn_cvt_pk_fp8_f32(v.z * 512.f, v.w * 512.f, pk, true);
      o[q4] = (uint32_t)pk;
    }
    const size_t e_ = j >> 7, r_ = j & 127;
    *reinterpret_cast<uint4*>(d + (r_ >> 4) * ((size_t)16384 * 256) + e_ * 256 + (r_ & 15) * 16) = uint4{o[0], o[1], o[2], o[3]};
  }
}
__device__ void phase_inproj(const Params& p, int bid, int nb, char* smem) {
  if ((nb & 7) == 0) {
    const int x = bid & 7, rank = bid >> 3, per = nb >> 3;
    for (int s_ = rank; s_ < 128 + 53; s_ += per) {
      if (s_ < 128) {
        const int tn2 = s_ >> 3, m0_ = (8 * x + (s_ & 7)) * 128;
        const bf16_t* a8 = reinterpret_cast<const bf16_t*>(p.hx8a);
        const bf16_t* b8 = reinterpret_cast<const bf16_t*>(p.w8);
        if (tn2 < 8) { EpiInAB epi{p.ABt, L}; gemm_tile_n256<true>(a8, D / 2, b8, D / 2, D / 2, m0_, tn2 * 256, epi, smem, p.ascale, p.wscale); }
        else if (tn2 < 12) { EpiInZ epi{p.z}; gemm_tile_n256<true>(a8, D / 2, b8, D / 2, D / 2, m0_, tn2 * 256, epi, smem, p.ascale, p.wscale); }
        else { EpiInXbc epi{p.xbcraw}; gemm_tile_n256<true>(a8, D / 2, b8, D / 2, D / 2, m0_, tn2 * 256, epi, smem, p.ascale, p.wscale); }
      } else if (s_ < 128 + 40) {
        const int i = s_ - 128;
        EpiInProj epi{p.ABt, p.z, p.xbcraw, p.dtraw, L};
        gemm_tile(p.hx, D, p.w_in_t, D, D, (8 * x + (i & 7)) * 128, (32 + (i >> 3)) * 128, epi, smem);
      } else {
        const int u = x * 13 + (s_ - 168);
        EpiInProj epi{nullptr, nullptr, p.xbcraw_c, p.dtraw_c, CTX};
        gemm_tile(p.hc, D, p.w_in_t, D, D, (u / 13) * 128, 3072 + (u % 13) * 128, epi, smem);
      }
    }
    return;
  }
  const int ntx = 64 * 37, ntc = 8 * 13;
  for (int t = bid; t < ntx + ntc; t += nb) {
    if (t < ntx) {
      int tm = t / 37, tn = t % 37;
      EpiInProj epi{p.ABt, p.z, p.xbcraw, p.dtraw, L};
      gemm_tile(p.hx, D, p.w_in_t, D, D, tm * 128, tn * 128, epi, smem);
    } else {
      int u = t - ntx;
      int tm = u / 13, tn = u % 13;
      EpiInProj epi{nullptr, nullptr, p.xbcraw_c, p.dtraw_c, CTX};
      gemm_tile(p.hc, D, p.w_in_t, D, D, tm * 128, 3072 + tn * 128, epi, smem);
    }
  }
}

__device__ void ssm_pre_tile(const Params& p, int task, char* smem) {
  const bool isx = task < 3072;
  const int u = isx ? task : task - 3072;
  const int ntt = isx ? 32 : 4;
  const int ct = u % 24, tt = (u / 24) % ntt, b = u / (24 * ntt);
  const int seqlen = isx ? L : CTX;
  const bf16_t* raw = (isx ? p.xbcraw : p.xbcraw_c) + (size_t)b * seqlen * DXBC;
  const int l0 = tt * 64, c0 = ct * 64, tid = threadIdx.x;
  float (*rt)[68] = reinterpret_cast<float (*)[68]>(smem);
  float (*at)[65] = reinterpret_cast<float (*)[65]>(smem + 66 * 68 * 4);
  __syncthreads();
  {
    uint2 v[5];
#pragma unroll
    for (int k = 0; k < 5; ++k) {
      const int i = tid + k * NTHREADS, r = i >> 4, c4 = i & 15, l = l0 - 1 + r;
      v[k] = (i < 66 * 16 && l >= 0 && l < seqlen) ? *reinterpret_cast<const uint2*>(raw + (size_t)l * DXBC + c0 + c4 * 4) : uint2{0u, 0u};
    }
#pragma unroll
    for (int k = 0; k < 5; ++k) {
      const int i = tid + k * NTHREADS, r = i >> 4, c4 = i & 15;
      if (i < 66 * 16) *reinterpret_cast<float4*>(&rt[r][c4 * 4]) = float4{bflo(v[k].x), bfhi(v[k].x), bflo(v[k].y), bfhi(v[k].y)};
    }
  }
  __syncthreads();
  {
    const int cc = tid & 63, c = c0 + cc;
    const float w0 = p.conv_w[c], w1 = p.conv_w[DXBC + c], w2 = p.conv_w[2 * DXBC + c], cb = p.conv_b[c];
#pragma unroll 4
    for (int r = tid >> 6; r < 64; r += 4) at[r][cc] = silu_f(cb + rt[r][cc] * w0 + rt[r + 1][cc] * w1 + rt[r + 2][cc] * w2);
  }
  __syncthreads();
  const size_t trow0 = isx ? ((size_t)b * L + l0) : ((size_t)T + (size_t)b * CTX + l0);
#pragma unroll
  for (int k = 0; k < 4; ++k) {
    const int i = tid + k * NTHREADS, r = i >> 4, c4 = (i & 15) * 4;
    uint2 o; o.x = pack2(at[r][c4], at[r][c4 + 1]); o.y = pack2(at[r][c4 + 2], at[r][c4 + 3]);
    *reinterpret_cast<uint2*>(p.act_tm + (trow0 + r) * DXBC + c0 + c4) = o;
  }
  if (c0 < 1280) {
    bf16_t* cm = (isx ? p.act_cm_x : p.act_cm_c) + (size_t)b * 1280 * seqlen;
#pragma unroll
    for (int k = 0; k < 4; ++k) {
      const int i = tid + k * NTHREADS, cc = i >> 4, r4 = (i & 15) * 4;
      uint2 o; o.x = pack2(at[r4][cc], at[r4 + 1][cc]); o.y = pack2(at[r4 + 2][cc], at[r4 + 3][cc]);
      *reinterpret_cast<uint2*>(cm + (size_t)(c0 + cc) * seqlen + l0 + r4) = o;
    }
  }
}
__device__ void dft_fold_rows(const Params& p, int bid, int nb, char* smem) {
  const int lane = threadIdx.x & 63, w = threadIdx.x >> 6;
  bf16_t* sr = reinterpret_cast<bf16_t*>(smem + w * 8192);
  for (int row = bid * 4 + w; row < NB * 1024; row += nb * 4) {
    const bf16_t* A = p.ABt + (size_t)row * 4096;
    bf16_t* F = p.Fs + (size_t)row * 2048;
    __builtin_amdgcn_wave_barrier();
    {
      const uint4 q0 = *reinterpret_cast<const uint4*>(A + (0 * 64 + lane) * 8), q1 = *reinterpret_cast<const uint4*>(A + (1 * 64 + lane) * 8);
      const uint4 q2 = *reinterpret_cast<const uint4*>(A + (2 * 64 + lane) * 8), q3 = *reinterpret_cast<const uint4*>(A + (3 * 64 + lane) * 8);
      const uint4 q4 = *reinterpret_cast<const uint4*>(A + (4 * 64 + lane) * 8), q5 = *reinterpret_cast<const uint4*>(A + (5 * 64 + lane) * 8);
      const uint4 q6 = *reinterpret_cast<const uint4*>(A + (6 * 64 + lane) * 8), q7 = *reinterpret_cast<const uint4*>(A + (7 * 64 + lane) * 8);
      *reinterpret_cast<uint4*>(sr + (0 * 64 + lane) * 8) = q0; *reinterpret_cast<uint4*>(sr + (1 * 64 + lane) * 8) = q1;
      *reinterpret_cast<uint4*>(sr + (2 * 64 + lane) * 8) = q2; *reinterpret_cast<uint4*>(sr + (3 * 64 + lane) * 8) = q3;
      *reinterpret_cast<uint4*>(sr + (4 * 64 + lane) * 8) = q4; *reinterpret_cast<uint4*>(sr + (5 * 64 + lane) * 8) = q5;
      *reinterpret_cast<uint4*>(sr + (6 * 64 + lane) * 8) = q6; *reinterpret_cast<uint4*>(sr + (7 * 64 + lane) * 8) = q7;
    }
    __builtin_amdgcn_wave_barrier();
    const int l0 = lane * 16;
    float alt = 0.f;
    uint32_t oa[8], ob[8];
#pragma unroll
    for (int half = 0; half < 2; ++half) {
      const bf16_t* base = sr + half * 2048;
      const uint4 fa = *reinterpret_cast<const uint4*>(base + l0), fb = *reinterpret_cast<const uint4*>(base + l0 + 8);
      const uint4 ra = *reinterpret_cast<const uint4*>(base + 2032 - l0), rb = *reinterpret_cast<const uint4*>(base + 2040 - l0);
      const float r16 = (lane > 0) ? bf2f(base[2048 - l0]) : 0.f;
      const uint32_t fw[8] = {fa.x, fa.y, fa.z, fa.w, fb.x, fb.y, fb.z, fb.w};
      const uint32_t rw[8] = {ra.x, ra.y, ra.z, ra.w, rb.x, rb.y, rb.z, rb.w};
      float v[16];
#pragma unroll
      for (int i = 0; i < 16; ++i) {
        const float fwv = (i & 1) ? bfhi(fw[i >> 1]) : bflo(fw[i >> 1]);
        const int j = 16 - i;
        const float rv = (i == 0) ? r16 : ((j & 1) ? bfhi(rw[j >> 1]) : bflo(rw[j >> 1]));
        if (half == 0) v[i] = (lane == 0 && i == 0) ? fwv : fwv + rv;
        else v[i] = (lane == 0 && i == 0) ? 0.f : fwv - rv;
      }
      if (half == 0) {
#pragma unroll
        for (int i = 0; i < 16; ++i) alt += (i & 1) ? -v[i] : v[i];
#pragma unroll
        for (int i = 0; i < 8; ++i) oa[i] = pack2(v[2 * i], v[2 * i + 1]);
      } else {
#pragma unroll
        for (int i = 0; i < 8; ++i) ob[i] = pack2(v[2 * i], v[2 * i + 1]);
      }
    }
    *reinterpret_cast<uint4*>(F + l0) = uint4{oa[0], oa[1], oa[2], oa[3]};
    *reinterpret_cast<uint4*>(F + l0 + 8) = uint4{oa[4], oa[5], oa[6], oa[7]};
    *reinterpret_cast<uint4*>(F + 1024 + l0) = uint4{ob[0], ob[1], ob[2], ob[3]};
    *reinterpret_cast<uint4*>(F + 1024 + l0 + 8) = uint4{ob[4], ob[5], ob[6], ob[7]};
    alt = wave_sum_fast(alt) + bf2f(sr[1024]);
    if (lane == 0) { const int b = row >> 10, ch = row & 1023; p.ycat[((size_t)b * L + 1024) * D + ch] = f2bf(alt); }
  }
}
__device__ void phase_ssm_pre(const Params& p, int bid, int nb, char* smem) {
  const int tid = threadIdx.x;
  dft_fold_rows(p, bid, nb, smem);
  for (int t = bid; t < 3072 + 384; t += nb) ssm_pre_tile(p, t, smem);
  for (int i = bid * NTHREADS + tid; i < (T + TC) * 32; i += nb * NTHREADS) {
    const bool isx = i < T * 32;
    const int ii = isx ? i : i - T * 32;
    const int t = ii >> 5, j = ii & 31;
    const float v = (isx ? p.dtraw : p.dtraw_c)[ii];
    float* df = isx ? p.dtf : p.dtf_c;
    float* db = isx ? p.dtb : p.dtb_c;
    if (j < 16) df[t * 16 + j] = softplus_f(v + p.dt_bias_f[j]);
    else db[t * 16 + (j - 16)] = softplus_f(v + p.dt_bias_b[j - 16]);
  }
}

__device__ __forceinline__ int swz16(int row, int chunk) { return row * 256 + ((chunk ^ (row & 15)) << 4); }
__device__ __forceinline__ int swz8(int row, int chunk) { return row * 128 + ((chunk ^ (row & 7)) << 4); }

#define LDS_BARRIER() asm volatile("s_waitcnt lgkmcnt(0)\n\ts_barrier" ::: "memory")
__device__ void ssd_task(const Params& p, int task, char* smem) {
  const int dir = task & 1, ph = (task >> 1) & 1, h = (task >> 2) & 15, b = task >> 6;
  const int tid = opaque_tid(), lane = tid & 63, w = tid >> 6;
  const int g = h >> 3, lr0 = lane & 15, lq0 = lane >> 4;
  const float a = -__expf(dir ? p.a_log_b[h] : p.a_log_f[h]);
  char* sCc = smem; char* sBc = smem + 16384; char* sBT = smem + 32768; char* sXT = smem + 49152; char* sHb = smem + 57344;
  float* se = reinterpret_cast<float*>(smem + 73728);
  float* sdt = se + 64; float* sw = se + 128; float* sy = se + 192; float* stot = se + 256;
  bf16_t* yo = reinterpret_cast<bf16_t*>(dir ? p.yb : p.yf);
  f32x4 H[2][2];
#pragma unroll
  for (int i = 0; i < 2; ++i)
#pragma unroll
    for (int j = 0; j < 2; ++j) H[i][j] = f32x4{0.f, 0.f, 0.f, 0.f};
  __syncthreads();
  for (int i = tid; i < 512; i += NTHREADS) reinterpret_cast<uint4*>(sHb)[i] = uint4{0, 0, 0, 0};

  const int crow = tid >> 4, cch = tid & 15;
  const int trow = tid >> 3, tch = tid & 7;
  uint4 rC0, rC1, rC2, rC3, rB0, rB1, rB2, rB3, rT0, rT1, rT2, rT3, rX;
  rC0 = rC1 = rC2 = rC3 = rB0 = rB1 = rB2 = rB3 = uint4{0, 0, 0, 0};
  float rdt = 0.f;
#define SSD_PARAMS(st_)                                                                                                   \
  const bool isctx_ = (st_) < 4;                                                                                          \
  const int nch_ = isctx_ ? 4 : 32, ci_ = isctx_ ? (st_) : (st_) - 4;                                                     \
  const int c_ = dir ? (nch_ - 1 - ci_) : ci_;                                                                            \
  const int seqlen_ = isctx_ ? CTX : L;                                                                                   \
  const size_t trow0_ = isctx_ ? ((size_t)T + (size_t)b * CTX + c_ * 64) : ((size_t)b * L + c_ * 64);                     \
  const size_t drow0_ = (size_t)b * seqlen_ + c_ * 64;                                                                    \
  const float* dtp_ = isctx_ ? (dir ? p.dtb_c : p.dtf_c) : (dir ? p.dtb : p.dtf);                                         \
  const bf16_t* cm_ = (isctx_ ? p.act_cm_c : p.act_cm_x) + (size_t)b * 1280 * seqlen_ + c_ * 64;
#define SSD_PREFETCH(st_)                                                                                                 \
  do {                                                                                                                    \
    SSD_PARAMS(st_)                                                                                                       \
    if (w == 0) rdt = dtp_[(drow0_ + lane) * 16 + h];                                                                     \
    if (!isctx_) {                                                                                                        \
      const bf16_t* src = p.act_tm + (trow0_ + crow) * DXBC + g * 128 + cch * 8;                                          \
      rC0 = *reinterpret_cast<const uint4*>(src + 1280);             rB0 = *reinterpret_cast<const uint4*>(src + 1024);   \
      rC1 = *reinterpret_cast<const uint4*>(src + 16 * DXBC + 1280); rB1 = *reinterpret_cast<const uint4*>(src + 16 * DXBC + 1024); \
      rC2 = *reinterpret_cast<const uint4*>(src + 32 * DXBC + 1280); rB2 = *reinterpret_cast<const uint4*>(src + 32 * DXBC + 1024); \
      rC3 = *reinterpret_cast<const uint4*>(src + 48 * DXBC + 1280); rB3 = *reinterpret_cast<const uint4*>(src + 48 * DXBC + 1024); \
    }                                                                                                                     \
    const bf16_t* srt = cm_ + (size_t)(1024 + g * 128 + trow) * seqlen_ + tch * 8;                                        \
    rT0 = *reinterpret_cast<const uint4*>(srt);                                                                           \
    rT1 = *reinterpret_cast<const uint4*>(srt + (size_t)32 * seqlen_);                                                    \
    rT2 = *reinterpret_cast<const uint4*>(srt + (size_t)64 * seqlen_);                                                    \
    rT3 = *reinterpret_cast<const uint4*>(srt + (size_t)96 * seqlen_);                                                    \
    rX = *reinterpret_cast<const uint4*>(cm_ + (size_t)(h * 64 + ph * 32 + trow) * seqlen_ + tch * 8);                    \
  } while (0)

  for (int step = 0; step < 36; ++step) {
    SSD_PREFETCH(step);
    const bool isctx = step < 4;
    const int c = dir ? ((isctx ? 4 : 32) - 1 - (isctx ? step : step - 4)) : (isctx ? step : step - 4);
    const size_t trow0 = (size_t)b * L + c * 64;
    int lr = lr0, lq = lq0;
    asm volatile("" : "+v"(lr), "+v"(lq));
    LDS_BARRIER();
    if (w == 0) {
      const float dtv = rdt;
      float v = a * dtv;
      if (!dir) {
#pragma unroll
        for (int o = 1; o < 64; o <<= 1) { float n = __shfl_up(v, o); v += (lane >= o) ? n : 0.f; }
      } else {
#pragma unroll
        for (int o = 1; o < 64; o <<= 1) { float n = __shfl_down(v, o); v += (lane + o < 64) ? n : 0.f; }
      }
      const float etot = __shfl(v, dir ? 0 : 63);
      se[lane] = v; sdt[lane] = dtv; sw[lane] = dtv * __expf(etot - v); sy[lane] = __expf(v);
      if (lane == 0) stot[0] = etot;
    }
    if (!isctx) {
      const int oc = swz16(crow, cch);
      *reinterpret_cast<uint4*>(sCc + oc) = rC0;         *reinterpret_cast<uint4*>(sBc + oc) = rB0;
      *reinterpret_cast<uint4*>(sCc + oc + 4096) = rC1;  *reinterpret_cast<uint4*>(sBc + oc + 4096) = rB1;
      *reinterpret_cast<uint4*>(sCc + oc + 8192) = rC2;  *reinterpret_cast<uint4*>(sBc + oc + 8192) = rB2;
      *reinterpret_cast<uint4*>(sCc + oc + 12288) = rC3; *reinterpret_cast<uint4*>(sBc + oc + 12288) = rB3;
    }
    {
      const int ot = swz8(trow, tch);
      *reinterpret_cast<uint4*>(sBT + ot) = rT0;
      *reinterpret_cast<uint4*>(sBT + ot + 4096) = rT1;
      *reinterpret_cast<uint4*>(sBT + ot + 8192) = rT2;
      *reinterpret_cast<uint4*>(sBT + ot + 12288) = rT3;
      *reinterpret_cast<uint4*>(sXT + ot) = rX;
    }
    LDS_BARRIER();
    const float etot = stot[0];
    if (!isctx) {
      f32x4 G[4];
      bf16x8 ca[4];
#pragma unroll
      for (int j = 0; j < 4; ++j) G[j] = f32x4{0.f, 0.f, 0.f, 0.f};
#pragma unroll
      for (int kk = 0; kk < 4; ++kk) ca[kk] = *reinterpret_cast<const bf16x8*>(sCc + swz16(16 * w + lr, kk * 4 + lq));
#pragma unroll
      for (int kk = 0; kk < 4; ++kk)
#pragma unroll
        for (int j = 0; j < 4; ++j) {
          bf16x8 bb = *reinterpret_cast<const bf16x8*>(sBc + swz16(16 * j + lr, kk * 4 + lq));
          G[j] = __builtin_amdgcn_mfma_f32_16x16x32_bf16(ca[kk], bb, G[j], 0, 0, 0);
        }
      LDS_BARRIER();
      float el[4];
#pragma unroll
      for (int r = 0; r < 4; ++r) el[r] = se[16 * w + lq * 4 + r];
#pragma unroll
      for (int j = 0; j < 4; ++j) {
        const int s_ = 16 * j + lr;
        const float es = se[s_], ds = sdt[s_];
#pragma unroll
        for (int r = 0; r < 4; ++r) {
          const int l = 16 * w + lq * 4 + r;
          const bool keep = dir ? (s_ >= l) : (s_ <= l);
          const float m = keep ? G[j][r] * __expf(el[r] - es) * ds : 0.f;
          *reinterpret_cast<bf16_t*>(sBc + swz8(l, s_ >> 3) + (s_ & 7) * 2) = f2bf(m);
        }
      }
      LDS_BARRIER();
      f32x4 Y[2], Yo[2];
#pragma unroll
      for (int j = 0; j < 2; ++j) { Y[j] = f32x4{0.f, 0.f, 0.f, 0.f}; Yo[j] = f32x4{0.f, 0.f, 0.f, 0.f}; }
#pragma unroll
      for (int kk = 0; kk < 2; ++kk) {
        bf16x8 ma = *reinterpret_cast<const bf16x8*>(sBc + swz8(16 * w + lr, kk * 4 + lq));
#pragma unroll
        for (int j = 0; j < 2; ++j) {
          bf16x8 xb = *reinterpret_cast<const bf16x8*>(sXT + swz8(16 * j + lr, kk * 4 + lq));
          Y[j] = __builtin_amdgcn_mfma_f32_16x16x32_bf16(ma, xb, Y[j], 0, 0, 0);
        }
      }
#pragma unroll
      for (int kk = 0; kk < 4; ++kk)
#pragma unroll
        for (int j = 0; j < 2; ++j) {
          bf16x8 hb = *reinterpret_cast<const bf16x8*>(sHb + swz16(16 * j + lr, kk * 4 + lq));
          Yo[j] = __builtin_amdgcn_mfma_f32_16x16x32_bf16(ca[kk], hb, Yo[j], 0, 0, 0);
        }
      float syl[4];
#pragma unroll
      for (int r = 0; r < 4; ++r) syl[r] = sy[16 * w + lq * 4 + r];
#pragma unroll
      for (int j = 0; j < 2; ++j)
#pragma unroll
        for (int r = 0; r < 4; ++r) {
          const int l = 16 * w + lq * 4 + r;
          yo[(trow0 + l) * 1024 + h * 64 + ph * 32 + 16 * j + lr] = f2bf(Y[j][r] + syl[r] * Yo[j][r]);
        }
    }
    {
      const float dec = __expf(etot);
#pragma unroll
      for (int i = 0; i < 2; ++i)
#pragma unroll
        for (int j = 0; j < 2; ++j) H[i][j] *= dec;
#pragma unroll
      for (int kk = 0; kk < 2; ++kk) {
        const int s0 = kk * 32 + lq * 8;
        const float4 w0 = *reinterpret_cast<const float4*>(sw + s0), w1 = *reinterpret_cast<const float4*>(sw + s0 + 4);
        bf16x8 xs[2];
#pragma unroll
        for (int i = 0; i < 2; ++i) {
          const bf16x8 xa = *reinterpret_cast<const bf16x8*>(sXT + swz8(16 * i + lr, kk * 4 + lq));
          xs[i][0] = (short)f2bf(bf2f((bf16_t)xa[0]) * w0.x); xs[i][1] = (short)f2bf(bf2f((bf16_t)xa[1]) * w0.y);
          xs[i][2] = (short)f2bf(bf2f((bf16_t)xa[2]) * w0.z); xs[i][3] = (short)f2bf(bf2f((bf16_t)xa[3]) * w0.w);
          xs[i][4] = (short)f2bf(bf2f((bf16_t)xa[4]) * w1.x); xs[i][5] = (short)f2bf(bf2f((bf16_t)xa[5]) * w1.y);
          xs[i][6] = (short)f2bf(bf2f((bf16_t)xa[6]) * w1.z); xs[i][7] = (short)f2bf(bf2f((bf16_t)xa[7]) * w1.w);
        }
#pragma unroll
        for (int j = 0; j < 2; ++j) {
          const bf16x8 bt = *reinterpret_cast<const bf16x8*>(sBT + swz8(16 * (2 * w + j) + lr, kk * 4 + lq));
#pragma unroll
          for (int i = 0; i < 2; ++i) H[i][j] = __builtin_amdgcn_mfma_f32_16x16x32_bf16(xs[i], bt, H[i][j], 0, 0, 0);
        }
      }
    }
    LDS_BARRIER();
#pragma unroll
    for (int i = 0; i < 2; ++i)
#pragma unroll
      for (int j = 0; j < 2; ++j) {
        const int n = 16 * (2 * w + j) + lr;
#pragma unroll
        for (int r = 0; r < 4; ++r) {
          const int pr = 16 * i + lq * 4 + r;
          *reinterpret_cast<bf16_t*>(sHb + swz16(pr, n >> 3) + (n & 7) * 2) = f2bf(H[i][j][r]);
        }
      }
  }
#undef SSD_PREFETCH
#undef SSD_PARAMS
}

#undef LDS_BARRIER
__device__ void phase_ssd_dft(const Params& p, int bid, int nb, char* smem) {
  for (int t = bid; t < 256; t += nb) ssd_task(p, t, smem);
  int* stile = reinterpret_cast<int*>(smem + 75776);
  for (;;) {
    __syncthreads();
    if (threadIdx.x == 0) *stile = (int)atomicAdd(p.ctr, 1u);
    __syncthreads();
    const int t = *stile;
    if (t >= 4 * 8 * 8) break;
    const int b = t >> 6, tm = (t & 63) >> 3, tn = t & 7;
    const bf16_t* Fb = p.Fs + (size_t)b * 1024 * 2048;
    f32x4 accC[4][4], accS[4][4];
    gemm_mainloop(p.dftm, 2048, Fb, 2048, 1024, tm * 128, tn * 128, accC, smem);
    gemm_mainloop(p.dftm + 1024, 2048, Fb + 1024, 2048, 1024, tm * 128, tn * 128, accS, smem);
    const int lane = threadIdx.x & 63, w = threadIdx.x >> 6, wm = w >> 1, wn = w & 1;
#pragma unroll
    for (int i = 0; i < 4; ++i) {
      int lq_ = lane >> 4, lr_ = lane & 15;
      asm volatile("" : "+v"(lq_), "+v"(lr_));
#pragma unroll
      for (int j = 0; j < 4; ++j) {
        const int k0 = tm * 128 + wm * 64 + i * 16 + lq_ * 4;
        const int ch = tn * 128 + wn * 64 + j * 16 + lr_;
        const float a = bf2f(p.ABt[((size_t)b * 1024 + ch) * 4096 + 1024]);
#pragma unroll
        for (int r = 0; r < 4; ++r) {
          const int k = k0 + r;
          const float as = (k & 1) ? -a : a;
          const float c = accC[i][j][r], sn = accS[i][j][r];
          p.ycat[((size_t)b * L + k) * D + ch] = f2bf(c - sn + as);
          if (k > 0) p.ycat[((size_t)b * L + (L - k)) * D + ch] = f2bf(c + sn + as);
        }
      }
    }
  }
  for (;;) {
    __syncthreads();
    if (threadIdx.x == 0) *stile = (int)atomicAdd(p.ctr + 8, 1u);
    __syncthreads();
    const int q = *stile;
    if (q >= 1024 + 1536) break;
    if (q < 1024) convert_uv_units(p, (size_t)q * 4096, (size_t)(q + 1) * 4096);
    else if (q < 1024 + 1024) { const int q1 = q - 1024; transpose_convert_task(p.w_out, D, 0, D, p.w_out_t, q1 / 32, q1 % 32, reinterpret_cast<float*>(smem)); }
    else { const int q2 = q - 2048; transpose_convert_task(p.w_query, 1024, 0, D, p.w_q_t, q2 / 16, q2 % 16, reinterpret_cast<float*>(smem)); }
  }
}

__device__ void phase_ssm_post(const Params& p, int bid, int nb, char* smem) {
  const int lane = threadIdx.x & 63, w = threadIdx.x >> 6;
  for (int t = bid * 4 + w; t < T; t += nb * 4) {
    float y[4][4];
    float ss0 = 0.f, ss1 = 0.f;
#pragma unroll
    for (int c = 0; c < 4; ++c) {
      const int c0 = c * 256 + lane * 4;
      const int h = c0 >> 6;
      const float dsk = p.d_skip_f[h] + p.d_skip_b[h];
      const uint2 aq = *reinterpret_cast<const uint2*>(reinterpret_cast<const bf16_t*>(p.yf) + (size_t)t * 1024 + c0);
      const uint2 bb = *reinterpret_cast<const uint2*>(reinterpret_cast<const bf16_t*>(p.yb) + (size_t)t * 1024 + c0);
      const float4 a = float4{bflo(aq.x), bfhi(aq.x), bflo(aq.y), bfhi(aq.y)};
      const float4 bq = float4{bflo(bb.x), bfhi(bb.x), bflo(bb.y), bfhi(bb.y)};
      const uint2 xq = *reinterpret_cast<const uint2*>(p.act_tm + (size_t)t * DXBC + c0);
      const uint2 zz = *reinterpret_cast<const uint2*>(p.z + (size_t)t * 1024 + c0);
      y[c][0] = (a.x + bq.x + dsk * bflo(xq.x)) * silu_f(bflo(zz.x));
      y[c][1] = (a.y + bq.y + dsk * bfhi(xq.x)) * silu_f(bfhi(zz.x));
      y[c][2] = (a.z + bq.z + dsk * bflo(xq.y)) * silu_f(bflo(zz.y));
      y[c][3] = (a.w + bq.w + dsk * bfhi(xq.y)) * silu_f(bfhi(zz.y));
      const float q = y[c][0] * y[c][0] + y[c][1] * y[c][1] + y[c][2] * y[c][2] + y[c][3] * y[c][3];
      if (c < 2) ss0 += q; else ss1 += q;
    }
    ss0 = wave_sum_fast(ss0); ss1 = wave_sum_fast(ss1);
    const float r0 = rsqrtf(ss0 * (1.f / 512.f) + EPS), r1 = rsqrtf(ss1 * (1.f / 512.f) + EPS);
#pragma unroll
    for (int c = 0; c < 4; ++c) {
      const int c0 = c * 256 + lane * 4;
      const float rstd = (c < 2) ? r0 : r1;
      const float4 nw = *reinterpret_cast<const float4*>(p.ssm_norm_w + c0);
      uint2 o; o.x = pack2(y[c][0] * rstd * nw.x, y[c][1] * rstd * nw.y); o.y = pack2(y[c][2] * rstd * nw.z, y[c][3] * rstd * nw.w);
      *reinterpret_cast<uint2*>(p.ycat + (size_t)t * D + 1024 + c0) = o;
    }
  }
}

__device__ void phase_outproj(const Params& p, int bid, int nb, char* smem) {
  if ((nb & 7) == 0) {
    const int x = bid & 7, rank = bid >> 3, per = nb >> 3;
    for (int s_ = rank; s_ < 64; s_ += per) {
      EpiBf16 epi{reinterpret_cast<bf16_t*>(p.y_x), D};
      gemm_tile_n256<false>(p.ycat, D, p.w_out_t, D, D, (8 * x + (s_ & 7)) * 128, (s_ >> 3) * 256, epi, smem);
    }
    return;
  }
  for (int t = bid; t < 64 * 16; t += nb) {
    EpiBf16 epi{reinterpret_cast<bf16_t*>(p.y_x), D};
    gemm_tile(p.ycat, D, p.w_out_t, D, D, (t >> 4) * 128, (t & 15) * 128, epi, smem);
  }
}
__device__ void phase_postmix(const Params& p, int bid, int nb, char* smem) {
  const int lane = threadIdx.x & 63, w = threadIdx.x >> 6;
  for (int t = bid * 4 + w; t < T; t += nb * 4) {
    const int b = t / L;
    float4 y[8];
    float ss = 0.f;
#pragma unroll
    for (int c = 0; c < 8; ++c) {
      {
        const uint2 yq = *reinterpret_cast<const uint2*>(reinterpret_cast<const bf16_t*>(p.y_x) + (size_t)t * D + c * 256 + lane * 4);
        y[c] = float4{bflo(yq.x), bfhi(yq.x), bflo(yq.y), bfhi(yq.y)};
      }
      ss += y[c].x * y[c].x + y[c].y * y[c].y + y[c].z * y[c].z + y[c].w * y[c].w;
    }
    ss = wave_sum_fast(ss);
    const float rstd = rsqrtf(ss * (1.f / D) + EPS);
    const float* gm = p.mod + (size_t)b * NMOD + 2 * D;
    float ss1 = 0.f;
#pragma unroll
    for (int c = 0; c < 8; ++c) {
      const int e0 = c * 256 + lane * 4;
      const float4 xv = *reinterpret_cast<const float4*>(p.x + (size_t)t * D + e0);
      const float4 g4 = *reinterpret_cast<const float4*>(gm + e0), gp = *reinterpret_cast<const float4*>(p.g_post_mix + e0);
      y[c].x = xv.x + g4.x * (y[c].x * rstd * gp.x); y[c].y = xv.y + g4.y * (y[c].y * rstd * gp.y);
      y[c].z = xv.z + g4.z * (y[c].z * rstd * gp.z); y[c].w = xv.w + g4.w * (y[c].w * rstd * gp.w);
      ss1 += y[c].x * y[c].x + y[c].y * y[c].y + y[c].z * y[c].z + y[c].w * y[c].w;
    }
    if (lane == 0) p.partial[t] = rstd;
    ss1 = wave_sum_fast(ss1);
    const float rstd1 = rsqrtf(ss1 * (1.f / D) + EPS);
    const float* sf = p.mod + (size_t)b * NMOD + 3 * D;
    const float* cf = p.mod + (size_t)b * NMOD + 4 * D;
#pragma unroll
    for (int c = 0; c < 8; ++c) {
      const int e0 = c * 256 + lane * 4;
      const float4 g = *reinterpret_cast<const float4*>(p.g_pre_ffn + e0);
      const float4 s4 = *reinterpret_cast<const float4*>(cf + e0), h4 = *reinterpret_cast<const float4*>(sf + e0);
      uint2 pk;
      pk.x = pack2(y[c].x * rstd1 * g.x * (1.f + s4.x) + h4.x, y[c].y * rstd1 * g.y * (1.f + s4.y) + h4.y);
      pk.y = pack2(y[c].z * rstd1 * g.z * (1.f + s4.z) + h4.z, y[c].w * rstd1 * g.w * (1.f + s4.w) + h4.w);
      *reinterpret_cast<uint2*>(p.hx + (size_t)t * D + e0) = pk;
    }
  }
}

__device__ __forceinline__ uint32_t mono_key(float f) {
  uint32_t u = __float_as_uint(f);
  return (u & 0x80000000u) ? ~u : (u | 0x80000000u);
}
__device__ __forceinline__ void ins16(uint32_t (&Lk)[16], uint32_t x) {
#pragma unroll
  for (int i = 0; i < 16; ++i) { uint32_t hi = max(Lk[i], x); x = min(Lk[i], x); Lk[i] = hi; }
}
__device__ __forceinline__ float unmono_key(uint32_t k) {
  return __uint_as_float((k & 0x80000000u) ? (k ^ 0x80000000u) : ~k);
}
typedef __attribute__((ext_vector_type(16))) float f32x16;
__device__ void phase_q_route(const Params& p, int bid, int nb, char* smem) {
  const int tid = opaque_tid(), lane = tid & 63, w = tid >> 6;
  const int wm = w >> 1, wn = w & 1, lr = lane & 15, lq = lane >> 4;
  const int l31 = lane & 31, lh = lane >> 5;
  for (int tile0 = bid; tile0 < 512; tile0 += nb) {
    const int tile = ((nb & 7) == 0 && nb >= 512) ? (((tile0 & 7) * 8 + ((tile0 >> 3) & 7)) * 8 + (tile0 >> 6)) : tile0;
    const int h = tile & 7, m0 = (tile >> 3) * 128;
    {
      f32x4 acc[4][4];
      gemm_mainloop(p.hx, D, p.w_q_t, D, D, m0, h * 128, acc, smem);
#pragma unroll
      for (int i = 0; i < 4; ++i)
#pragma unroll
        for (int j = 0; j < 4; ++j)
#pragma unroll
          for (int r = 0; r < 4; ++r) {
            const int row = wm * 64 + i * 16 + lq * 4 + r, col = wn * 64 + j * 16 + lr;
            *reinterpret_cast<bf16_t*>(smem + swz16(row, col >> 3) + (col & 7) * 2) = f2bf(acc[i][j][r]);
          }
    }
#pragma unroll 4
    for (int r = 0; r < 16; ++r) {
      const int id = tid + 256 * r, row = id >> 4, c4 = id & 15;
      const float* src = ((row < 128) ? p.sk1 : p.sk2) + ((size_t)(h * 128 + (row & 127)) * 64 + c4 * 4);
      const float4 v = *reinterpret_cast<const float4*>(src);
      uint2 pk; pk.x = pack2(v.x, v.y); pk.y = pack2(v.z, v.w);
      *reinterpret_cast<uint2*>(smem + 32768 + swz8(row, c4 >> 1) + (c4 & 1) * 8) = pk;
    }
    __syncthreads();
    uint32_t L1[16], L2[16];
#pragma unroll
    for (int sd = 0; sd < 2; ++sd) {
      uint32_t Lk[16];
#pragma unroll
      for (int i = 0; i < 16; ++i) Lk[i] = 0u;
      const uint32_t kb = (uint32_t)(lh * 4);
#pragma unroll
      for (int ih = 0; ih < 2; ++ih) {
        f32x16 Sa[2];
#pragma unroll
        for (int i = 0; i < 2; ++i)
#pragma unroll
          for (int g2 = 0; g2 < 16; ++g2) Sa[i][g2] = 0.f;
#pragma unroll
        for (int ks = 0; ks < 4; ++ks) {
          const bf16x8 qb = *reinterpret_cast<const bf16x8*>(smem + swz16(w * 32 + l31, sd * 8 + ks * 2 + lh));
#pragma unroll
          for (int i = 0; i < 2; ++i) {
            const bf16x8 ka = *reinterpret_cast<const bf16x8*>(smem + 32768 + swz8(sd * 128 + (ih * 2 + i) * 32 + l31, ks * 2 + lh));
            Sa[i] = __builtin_amdgcn_mfma_f32_32x32x16_bf16(ka, qb, Sa[i], 0, 0, 0);
          }
        }
#pragma unroll
        for (int i = 0; i < 2; ++i)
#pragma unroll
          for (int g2 = 0; g2 < 16; ++g2)
            ins16(Lk, (mono_key(Sa[i][g2]) & ~0x7Fu) | (uint32_t)((ih * 2 + i) * 32 + (g2 & 3) + 8 * (g2 >> 2)) | kb);
      }
#pragma unroll
      for (int i = 0; i < 8; ++i) {
        const uint32_t t1 = (uint32_t)__shfl_xor((int)Lk[15 - i], 32), t2 = (uint32_t)__shfl_xor((int)Lk[i], 32);
        Lk[i] = max(Lk[i], t1); Lk[15 - i] = max(Lk[15 - i], t2);
      }
#pragma unroll
      for (int dd = 8; dd >= 1; dd >>= 1)
#pragma unroll
        for (int i = 0; i < 16; ++i)
          if ((i & dd) == 0) { const uint32_t hi = max(Lk[i], Lk[i + dd]), lo = min(Lk[i], Lk[i + dd]); Lk[i] = hi; Lk[i + dd] = lo; }
#pragma unroll
      for (int r = 0; r < 16; ++r) { if (sd == 0) L1[r] = Lk[r]; else L2[r] = Lk[r]; }
    }
    __syncthreads();
    uint32_t* ib = reinterpret_cast<uint32_t*>(smem) + w * 1088 + l31 * 34;
    if (lh == 0) {
#pragma unroll
      for (int r = 0; r < 16; ++r) { ib[r] = L1[r] & 127u; ib[16 + r] = L2[r] & 127u; }
    }
    float v1[16], v2[16];
#pragma unroll
    for (int r = 0; r < 16; ++r) { v1[r] = unmono_key(L1[r] & ~0x7Fu); v2[r] = unmono_key(L2[r] & ~0x7Fu); }
    uint32_t C[16];
#pragma unroll
    for (int i = 0; i < 16; ++i) C[i] = 0u;
#pragma unroll
    for (int a = 0; a < 16; ++a)
#pragma unroll
      for (int bq = 0; bq < 16; ++bq)
        if ((a + 1) * (bq + 1) <= 16) ins16(C, (mono_key(v1[a] + v2[bq]) & ~0xFFu) | (uint32_t)(a * 16 + bq));
    float ts[16]; int te[16];
    __builtin_amdgcn_wave_barrier();
#pragma unroll
    for (int r = 0; r < 16; ++r) {
      const uint32_t code = C[r] & 0xFFu;
      te[r] = (int)(ib[code >> 4] * 128u + ib[16 + (code & 15u)]);
      ts[r] = unmono_key(C[r] & ~0xFFu);
    }
    const float mx = ts[0];
    float den = 0.f;
#pragma unroll
    for (int r = 0; r < 16; ++r) { ts[r] = __expf(ts[r] - mx); den += ts[r]; }
    const float inv = 1.f / den;
    const size_t ob = (size_t)(m0 + w * 32 + l31) * 128 + h * 16;
    if (lh == 0) {
#pragma unroll
      for (int r = 0; r < 16; r += 4) *reinterpret_cast<int4*>(p.idx + ob + r) = int4{te[r], te[r + 1], te[r + 2], te[r + 3]};
    } else {
#pragma unroll
      for (int r = 0; r < 16; r += 4)
        *reinterpret_cast<float4*>(p.gate + ob + r) = float4{ts[r] * inv, ts[r + 1] * inv, ts[r + 2] * inv, ts[r + 3] * inv};
    }
    __syncthreads();
  }
}

typedef __attribute__((ext_vector_type(2))) float f32x2;
__device__ __forceinline__ void fp8x16_to_f32(const uint4 q, f32x2 (&o)[8]) {
  o[0] = __builtin_amdgcn_cvt_pk_f32_fp8((int)q.x, false); o[1] = __builtin_amdgcn_cvt_pk_f32_fp8((int)q.x, true);
  o[2] = __builtin_amdgcn_cvt_pk_f32_fp8((int)q.y, false); o[3] = __builtin_amdgcn_cvt_pk_f32_fp8((int)q.y, true);
  o[4] = __builtin_amdgcn_cvt_pk_f32_fp8((int)q.z, false); o[5] = __builtin_amdgcn_cvt_pk_f32_fp8((int)q.z, true);
  o[6] = __builtin_amdgcn_cvt_pk_f32_fp8((int)q.w, false); o[7] = __builtin_amdgcn_cvt_pk_f32_fp8((int)q.w, true);
}
__device__ __forceinline__ unsigned my_xcc_id() { return (unsigned)__builtin_amdgcn_s_getreg((3 << 11) | 20) & 7u; }

__device__ void phase_exp_u(const Params& p, char* smem) {
  const int tid = opaque_tid(), lane = tid & 63, w = tid >> 6;
  const int sub = lane >> 4, cc = lane & 15;
  const unsigned myx = my_xcc_id();
  int* sh = reinterpret_cast<int*>(smem);
  int* si = reinterpret_cast<int*>(smem + 64) + w * 256;
  float* pbuf = reinterpret_cast<float*>(p.ycat);
  {
    unsigned qcur = 0;
    for (;;) {
      __syncthreads();
      if (tid == 0) {
        int found = -1; unsigned fx = 0;
        for (; qcur < 8; ++qcur) {
          fx = (myx + qcur) & 7u;
          const int c = (int)atomicAdd(&p.ctr[16 + fx], 1u);
          if (c < 256) { found = c; break; }
        }
        sh[0] = found; sh[1] = (int)fx;
      }
      __syncthreads();
      const int chunk = sh[0];
      const unsigned x = (unsigned)sh[1];
      if (chunk < 0) break;
      for (int tt = 0; tt < 8; ++tt) {
        const int t = chunk * 32 + w * 8 + tt;
        __builtin_amdgcn_wave_barrier();
        si[lane] = p.idx[(size_t)t * 128 + lane]; si[64 + lane] = p.idx[(size_t)t * 128 + 64 + lane];
        __builtin_amdgcn_wave_barrier();
        f32x2 hf[8];
#pragma unroll
        for (int q2 = 0; q2 < 2; ++q2) {
          const uint4 hq = *reinterpret_cast<const uint4*>(p.hx + (size_t)t * D + x * 256 + cc * 16 + q2 * 8);
          hf[q2 * 4 + 0] = f32x2{bflo(hq.x), bfhi(hq.x)}; hf[q2 * 4 + 1] = f32x2{bflo(hq.y), bfhi(hq.y)};
          hf[q2 * 4 + 2] = f32x2{bflo(hq.z), bfhi(hq.z)}; hf[q2 * 4 + 3] = f32x2{bflo(hq.w), bfhi(hq.w)};
        }
        const uint8_t* ub = p.U8 + (size_t)x * ((size_t)16384 * 256) + cc * 16;
        uint4 qa[8], qb[8];
#define EU_LOAD(q_, bt_) _Pragma("unroll") for (int k = 0; k < 8; ++k) q_[k] = *reinterpret_cast<const uint4*>(ub + (size_t)si[((bt_) * 8 + k) * 4 + sub] * 256)
#define EU_COMP(q_, kb_)                                                                                                \
  _Pragma("unroll") for (int k = 0; k < 8; ++k) {                                                                       \
    f32x2 uf[8];                                                                                                        \
    fp8x16_to_f32(q_[k], uf);                                                                                           \
    f32x2 d2 = hf[0] * uf[0];                                                                                           \
    _Pragma("unroll") for (int e = 1; e < 8; ++e) d2 += hf[e] * uf[e];                                                  \
    float d = d2.x + d2.y;                                                                                              \
    d += dpp_mov<0xB1>(d); d += dpp_mov<0x4E>(d); d += dpp_mov<0x124>(d); d += dpp_mov<0x128>(d);                       \
    mine = (cc == (kb_) + k) ? d : mine;                                                                                \
  }
        float mine = 0.f;
        EU_LOAD(qa, 0); EU_LOAD(qb, 1);
        EU_COMP(qa, 0); EU_LOAD(qa, 2);
        EU_COMP(qb, 8); EU_LOAD(qb, 3);
        pbuf[((size_t)x * T + t) * 128 + cc * 4 + sub] = mine * (1.f / 512.f);
        mine = 0.f;
        EU_COMP(qa, 0);
        EU_COMP(qb, 8);
        pbuf[((size_t)x * T + t) * 128 + (16 + cc) * 4 + sub] = mine * (1.f / 512.f);
#undef EU_LOAD
#undef EU_COMP
      }
    }
  }
}

__device__ void phase_exp_v(const Params& p, char* smem) {
  const int tid = opaque_tid(), lane = tid & 63, w = tid >> 6;
  const int sub = lane >> 4, cc = lane & 15;
  const unsigned myx = my_xcc_id();
  int* sh = reinterpret_cast<int*>(smem);
  int* si = reinterpret_cast<int*>(smem + 64) + w * 256;
  float* sc = reinterpret_cast<float*>(si + 128);
  bf16_t* yfb = reinterpret_cast<bf16_t*>(p.y_x) + (size_t)T * D;
  {
    unsigned qcur = 0;
    for (;;) {
      __syncthreads();
      if (tid == 0) {
        int found = -1; unsigned fx = 0;
        for (; qcur < 8; ++qcur) {
          fx = (myx + qcur) & 7u;
          const int c = (int)atomicAdd(&p.ctr[32 + fx], 1u);
          if (c < 256) { found = c; break; }
        }
        sh[0] = found; sh[1] = (int)fx;
      }
      __syncthreads();
      const int chunk = sh[0];
      const unsigned x = (unsigned)sh[1];
      if (chunk < 0) break;
      for (int tt = 0; tt < 8; ++tt) {
        const int t = chunk * 32 + w * 8 + tt;
        __builtin_amdgcn_wave_barrier();
        si[lane] = p.idx[(size_t)t * 128 + lane]; si[64 + lane] = p.idx[(size_t)t * 128 + 64 + lane];
        {
          const float* pb = reinterpret_cast<const float*>(p.ycat) + (size_t)t * 128;
          float d0 = 0.f, d1 = 0.f;
#pragma unroll
          for (int xs = 0; xs < 8; ++xs) { d0 += pb[(size_t)xs * T * 128 + lane]; d1 += pb[(size_t)xs * T * 128 + 64 + lane]; }
          sc[lane] = p.gate[(size_t)t * 128 + lane] * 0.5f * d0 * (1.f + erff(d0 * 0.70710678118654752f));
          sc[64 + lane] = p.gate[(size_t)t * 128 + 64 + lane] * 0.5f * d1 * (1.f + erff(d1 * 0.70710678118654752f));
        }
        __builtin_amdgcn_wave_barrier();
        f32x2 acc[8];
#pragma unroll
        for (int e = 0; e < 8; ++e) acc[e] = f32x2{0.f, 0.f};
        const uint8_t* vb = p.V8 + (size_t)x * ((size_t)16384 * 256) + cc * 16;
        uint4 qa[8], qb[8];
#define EV_LOAD(q_, bt_) _Pragma("unroll") for (int k = 0; k < 8; ++k) q_[k] = *reinterpret_cast<const uint4*>(vb + (size_t)si[((bt_) * 8 + k) * 4 + sub] * 256)
#define EV_COMP(q_, bt_)                                                                                                \
  _Pragma("unroll") for (int k = 0; k < 8; ++k) {                                                                       \
    f32x2 vf[8];                                                                                                        \
    fp8x16_to_f32(q_[k], vf);                                                                                           \
    const float cfk = sc[((bt_) * 8 + k) * 4 + sub];                                                                    \
    const f32x2 c2 = f32x2{cfk, cfk};                                                                                   \
    _Pragma("unroll") for (int e = 0; e < 8; ++e) acc[e] += c2 * vf[e];                                                 \
  }
        EV_LOAD(qa, 0); EV_LOAD(qb, 1);
        EV_COMP(qa, 0); EV_LOAD(qa, 2);
        EV_COMP(qb, 1); EV_LOAD(qb, 3);
        EV_COMP(qa, 2);
        EV_COMP(qb, 3);
#undef EV_LOAD
#undef EV_COMP
        {
          float* red = reinterpret_cast<float*>(smem + 8192) + w * 1280;
          float* mr = red + (sub * 16 + cc) * 20;
#pragma unroll
          for (int q4 = 0; q4 < 4; ++q4)
            *reinterpret_cast<float4*>(mr + q4 * 4) = float4{acc[q4 * 2].x, acc[q4 * 2].y, acc[q4 * 2 + 1].x, acc[q4 * 2 + 1].y};
          __builtin_amdgcn_wave_barrier();
          const int part = sub;
          float4 r0 = *reinterpret_cast<const float4*>(red + (0 * 16 + cc) * 20 + part * 4);
          float4 r1 = *reinterpret_cast<const float4*>(red + (1 * 16 + cc) * 20 + part * 4);
          float4 r2 = *reinterpret_cast<const float4*>(red + (2 * 16 + cc) * 20 + part * 4);
          float4 r3 = *reinterpret_cast<const float4*>(red + (3 * 16 + cc) * 20 + part * 4);
          const float sc512 = 1.f / 512.f;
          uint2 o4;
          o4.x = pack2((r0.x + r1.x + r2.x + r3.x) * sc512, (r0.y + r1.y + r2.y + r3.y) * sc512);
          o4.y = pack2((r0.z + r1.z + r2.z + r3.z) * sc512, (r0.w + r1.w + r2.w + r3.w) * sc512);
          *reinterpret_cast<uint2*>(yfb + (size_t)t * D + x * 256 + cc * 16 + part * 4) = o4;
          __builtin_amdgcn_wave_barrier();
        }
      }
    }
  }
}

__device__ void phase_exp_final(const Params& p, int bid, int nb, char* smem) {
  const int lane = threadIdx.x & 63, w = threadIdx.x >> 6;
  const bf16_t* ymix = reinterpret_cast<const bf16_t*>(p.y_x);
  const bf16_t* yf = reinterpret_cast<const bf16_t*>(p.y_x) + (size_t)T * D;
  for (int t = bid * 4 + w; t < T; t += nb * 4) {
    const int b = t / L;
    float4 y[8], xo[8];
#pragma unroll
    for (int c = 0; c < 8; ++c) {
      const uint2 yq = *reinterpret_cast<const uint2*>(yf + (size_t)t * D + c * 256 + lane * 4);
      y[c] = float4{bflo(yq.x), bfhi(yq.x), bflo(yq.y), bfhi(yq.y)};
      xo[c] = *reinterpret_cast<const float4*>(p.x + (size_t)t * D + c * 256 + lane * 4);
    }
    const float rmix = p.partial[t];
    float ss = 0.f;
#pragma unroll
    for (int c = 0; c < 8; ++c) ss += y[c].x * y[c].x + y[c].y * y[c].y + y[c].z * y[c].z + y[c].w * y[c].w;
    ss = wave_sum_fast(ss);
    const float rstd = rsqrtf(ss * (1.f / D) + EPS);
    const float* gfx = p.mod + (size_t)b * NMOD + 5 * D;
    const float* gm = p.mod + (size_t)b * NMOD + 2 * D;
#pragma unroll
    for (int c = 0; c < 8; ++c) {
      const int e0 = c * 256 + lane * 4;
      const uint2 mq = *reinterpret_cast<const uint2*>(ymix + (size_t)t * D + e0);
      const float4 m4 = float4{bflo(mq.x), bfhi(mq.x), bflo(mq.y), bfhi(mq.y)};
      const float4 g4 = *reinterpret_cast<const float4*>(gfx + e0), gp = *reinterpret_cast<const float4*>(p.g_post_ffn + e0);
      const float4 h4 = *reinterpret_cast<const float4*>(gm + e0), hp = *reinterpret_cast<const float4*>(p.g_post_mix + e0);
      xo[c].x += h4.x * (m4.x * rmix * hp.x) + g4.x * (y[c].x * rstd * gp.x);
      xo[c].y += h4.y * (m4.y * rmix * hp.y) + g4.y * (y[c].y * rstd * gp.y);
      xo[c].z += h4.z * (m4.z * rmix * hp.z) + g4.z * (y[c].z * rstd * gp.z);
      xo[c].w += h4.w * (m4.w * rmix * hp.w) + g4.w * (y[c].w * rstd * gp.w);
      *reinterpret_cast<float4*>(p.out + (size_t)t * D + e0) = xo[c];
    }
  }
}

#define XB_TMO      128
#define XB_XCNT(j)  (256  + 64 * (j))
#define XB_XSUB(j)  (1280 + 64 * (j))
#define XB_XGEN(j)  (2304 + 64 * (j))
#define XB_TOP      3328
#define XB_TOPGEN   3392
#define XCD_BAR_WORDS 3456
#define XB_SPIN_CAP (1u << 22)
#define LAS __attribute__((address_space(3)))
__device__ __forceinline__ unsigned xb_ld(unsigned* p)              { return __hip_atomic_load(p, __ATOMIC_RELAXED, __HIP_MEMORY_SCOPE_AGENT); }
__device__ __forceinline__ unsigned xb_add(unsigned* p, unsigned v) { return __hip_atomic_fetch_add(p, v, __ATOMIC_RELAXED, __HIP_MEMORY_SCOPE_AGENT); }
__device__ __forceinline__ unsigned xb_xcc_id() { return (unsigned)__builtin_amdgcn_s_getreg((3 << 11) | 20) & 0xFu; }
#define XB_SPIN(cond, bar) do { unsigned _sp = 0; while (cond) { __builtin_amdgcn_s_sleep(1); \
    if ((++_sp & 255u) == 0u) { if (xb_ld(&(bar)[XB_TMO])) break; if (_sp > XB_SPIN_CAP) { atomicAdd(&(bar)[XB_TMO], 1u); break; } } } } while (0)
struct XcdBarrier { unsigned* bar; unsigned x; volatile LAS unsigned* st; };
__device__ __forceinline__ XcdBarrier xcd_barrier_post(unsigned* bar, volatile LAS unsigned* st) {
  XcdBarrier b; b.bar = bar; b.x = xb_xcc_id(); b.st = st;
  if (threadIdx.x == 0) (void)xb_add(&bar[XB_XCNT(b.x)], 1u);
  return b;
}
__device__ __forceinline__ void xcd_barrier_complete(unsigned* bar, unsigned x, unsigned& nloc, unsigned& nx) {
  const unsigned G = gridDim.x * gridDim.y * gridDim.z;
  unsigned sum, cnt, mine, sp = 0u;
  for (;;) {
    sum = 0u; cnt = 0u; mine = 0u;
#pragma unroll
    for (unsigned j = 0; j < 16; ++j) { const unsigned c = xb_ld(&bar[XB_XCNT(j)]); sum += c; cnt += (c > 0u) ? 1u : 0u; mine = (j == x) ? c : mine; }
    if (sum == G) break;
    __builtin_amdgcn_s_sleep(1);
    if ((++sp & 255u) == 0u) { if (xb_ld(&bar[XB_TMO])) break; if (sp > XB_SPIN_CAP) { atomicAdd(&bar[XB_TMO], 1u); break; } }
  }
  nloc = mine > 0u ? mine : 1u; nx = cnt > 0u ? cnt : 1u;
}
__device__ __forceinline__ void xcd_barrier(const XcdBarrier& b) {
  asm volatile("s_waitcnt vmcnt(0)" ::: "memory");
  __syncthreads();
  if (threadIdx.x == 0) {
    unsigned* bar = b.bar;
    __builtin_amdgcn_s_waitcnt(0);
    unsigned nloc = b.st[0], nx = b.st[1];
    if (nloc == 0u) { xcd_barrier_complete(bar, b.x, nloc, nx); b.st[0] = nloc; b.st[1] = nx; }
    const unsigned old = xb_add(&bar[XB_XSUB(b.x)], 1u);
    const unsigned gen = old / nloc;
    if (old + 1u == (gen + 1u) * nloc) {
      __builtin_amdgcn_fence(__ATOMIC_RELEASE, "agent");
      asm volatile("s_waitcnt vmcnt(0)" ::: "memory");
      const unsigned og = xb_add(&bar[XB_TOP], 1u);
      const unsigned tg = og / nx;
      if (og + 1u == (tg + 1u) * nx) xb_add(&bar[XB_TOPGEN], 1u);
      else XB_SPIN(xb_ld(&bar[XB_TOPGEN]) == tg, bar);
      __builtin_amdgcn_fence(__ATOMIC_ACQUIRE, "agent");
      xb_add(&bar[XB_XGEN(b.x)], 1u);
      asm volatile("s_waitcnt vmcnt(0)" ::: "memory");
    } else {
      XB_SPIN(xb_ld(&bar[XB_XGEN(b.x)]) == gen, bar);
      __builtin_amdgcn_fence(__ATOMIC_ACQUIRE, "agent");
      asm volatile("s_waitcnt vmcnt(0)" ::: "memory");
    }
  }
  __syncthreads();
}

__global__ void __launch_bounds__(NTHREADS, 2) fwd_mega(Params p) {
  __shared__ __attribute__((aligned(16))) char smem[75808];
  const int bid = blockIdx.x, nb = gridDim.x;
  volatile LAS unsigned* st = (volatile LAS unsigned*)(smem + 75792);
  if (threadIdx.x == 0) { st[0] = 0u; st[1] = 0u; }
  __syncthreads();
  const XcdBarrier bar = xcd_barrier_post(p.bar, st);
  phase_prep(p, bid, nb, smem);        xcd_barrier(bar);
  phase_fold(p, bid, nb, smem);        xcd_barrier(bar);
  phase_norm_mod(p, bid, nb, smem);    xcd_barrier(bar);
  phase_inproj(p, bid, nb, smem);      xcd_barrier(bar);
  phase_ssm_pre(p, bid, nb, smem);     xcd_barrier(bar);
  phase_ssd_dft(p, bid, nb, smem);     xcd_barrier(bar);
  phase_ssm_post(p, bid, nb, smem);    xcd_barrier(bar);
  phase_outproj(p, bid, nb, smem);     xcd_barrier(bar);
  phase_postmix(p, bid, nb, smem);     xcd_barrier(bar);
  phase_q_route(p, bid, nb, smem);     xcd_barrier(bar);
  phase_exp_u(p, smem);                xcd_barrier(bar);
  phase_exp_v(p, smem);                xcd_barrier(bar);
  phase_exp_final(p, bid, nb, smem);
}

}

extern "C" void kernel_launch(void* const* d_in, const int* in_sizes, int n_in, void* d_out, int out_size, void* d_ws,
                              size_t ws_size, hipStream_t stream) {
  Params p{};
  const float** fp = reinterpret_cast<const float**>(&p);
  for (int i = 0; i < 27; ++i) fp[i] = (const float*)d_in[i];
  p.out = (float*)d_out;
  char* ws = (char*)d_ws;
  size_t off = 0;
  auto take = [&](size_t bytes) { char* r = ws + off; off += (bytes + 255) & ~(size_t)255; return r; };
  p.U8 = (uint8_t*)take((size_t)16384 * D);
  p.V8 = (uint8_t*)take((size_t)16384 * D);
  p.hx8a = (int8_t*)take((size_t)T * D);
  p.w8 = (int8_t*)take((size_t)4096 * D);
  p.ascale = (float*)take((size_t)T * 4);
  p.wscale = (float*)take((size_t)4096 * 4);
  p.w_in_t = (bf16_t*)take((size_t)NPROJ * D * 2);
  p.w_out_t = (bf16_t*)take((size_t)D * D * 2);
  p.w_q_t = (bf16_t*)take((size_t)1024 * D * 2);
  p.w_in_f = (bf16_t*)take((size_t)D * 1024 * 2);
  p.WcsT = (bf16_t*)take((size_t)4 * 512 * 256 * 2);
  p.dftm = (bf16_t*)take((size_t)1024 * 2048 * 2);
  p.Fs = (bf16_t*)take((size_t)NB * 1024 * 2048 * 2);
  p.partial = (float*)take((size_t)KSPLIT * 5 * NMOD * 4);
  p.mod = (float*)take((size_t)5 * NMOD * 4);
  p.hx = (bf16_t*)take((size_t)T * D * 2);
  p.hc = (bf16_t*)take((size_t)TC * D * 2);
  p.ABt = (bf16_t*)take((size_t)NB * 1024 * 4096 * 2);
  p.q = (float*)p.ABt;
  p.z = (bf16_t*)take((size_t)T * 1024 * 2);
  char* r1 = take(0);
  p.xbcraw = (bf16_t*)take((size_t)T * DXBC * 4);
  p.xbcraw_c = (bf16_t*)take((size_t)TC * DXBC * 4);
  p.act_tm = (bf16_t*)take((size_t)(T + TC) * DXBC * 2);
  p.act_cm_x = (bf16_t*)take((size_t)NB * 1280 * L * 2);
  p.act_cm_c = (bf16_t*)take((size_t)NB * 1280 * CTX * 2);
  p.y_x = (float*)r1;
  p.dtraw = (float*)take((size_t)T * 32 * 4);
  p.dtraw_c = (float*)take((size_t)TC * 32 * 4);
  p.dtf = (float*)take((size_t)T * 16 * 4);
  p.dtb = (float*)take((size_t)T * 16 * 4);
  p.dtf_c = (float*)take((size_t)TC * 16 * 4);
  p.dtb_c = (float*)take((size_t)TC * 16 * 4);
  p.yf = (float*)take((size_t)T * 1024 * 4);
  p.yb = (float*)take((size_t)T * 1024 * 4);
  p.ctr = (unsigned*)take(256);
  p.bar = (unsigned*)take((size_t)XCD_BAR_WORDS * 4);
  p.ycat = (bf16_t*)take((size_t)T * D * 2);
  p.idx = (int*)take((size_t)T * 128 * 4);
  p.gate = (float*)take((size_t)T * 128 * 4);
  if (off > ws_size) { fprintf(stderr, "kernel_launch: workspace too small: need %zu have %zu\n", off, ws_size); return; }
  static int grid_blocks = 0;
  if (!grid_blocks) {
    int dev = 0, cus = 0, per_cu = 0;
    hipGetDevice(&dev);
    hipDeviceGetAttribute(&cus, hipDeviceAttributeMultiprocessorCount, dev);
    hipOccupancyMaxActiveBlocksPerMultiprocessor(&per_cu, fwd_mega, NTHREADS, 0);
    if (per_cu > 2) per_cu = 2;
    grid_blocks = cus * per_cu;
    if (grid_blocks <= 0) { fprintf(stderr, "kernel_launch: occupancy query gave %d x %d\n", cus, per_cu); grid_blocks = -1; }
  }
  if (grid_blocks < 0) return;
  (void)hipMemsetAsync(p.bar, 0, (size_t)XCD_BAR_WORDS * 4, stream);
  void* args[] = {&p};
  hipError_t e = hipLaunchCooperativeKernel((void*)fwd_mega, dim3(grid_blocks), dim3(NTHREADS), args, 0, stream);
  if (e != hipSuccess) fprintf(stderr, "cooperative launch failed: %s (grid %d)\n", hipGetErrorString(e), grid_blocks);
}
```

```cpp
#include <hip/hip_runtime.h>
#include <hip/hip_cooperative_groups.h>
#include <stdint.h>
#include <stdio.h>

namespace cg = cooperative_groups;
namespace {

typedef __attribute__((ext_vector_type(8))) short bf16x8;
typedef __attribute__((ext_vector_type(4))) float f32x4;
typedef unsigned short bf16_t;

constexpr int D = 2048, NB = 4, L = 2048, T = NB * L, CTX = 256, TC = NB * CTX;
constexpr int NMOD = 6 * D;
constexpr int NH = 16, HP = 64, NS = 128, DXBC = 1536;
constexpr int DIN = 3616;
constexpr int NPROJ = 4736;
constexpr int KSPLIT = 32;
constexpr float EPS = 1e-6f;
constexpr int NTHREADS = 256;

__device__ __forceinline__ bf16_t f2bf(float f) { __bf16 h = (__bf16)f; return __builtin_bit_cast(unsigned short, h); }
__device__ __forceinline__ float bf2f(bf16_t h) { return __uint_as_float(((uint32_t)h) << 16); }
__device__ __forceinline__ uint32_t pack2(float a, float b) {
  typedef __attribute__((ext_vector_type(2))) __bf16 bf16x2_t;
  typedef __attribute__((ext_vector_type(2))) float f32x2_t;
  const f32x2_t v = {a, b};
  return __builtin_bit_cast(uint32_t, __builtin_convertvector(v, bf16x2_t));
}
__device__ __forceinline__ float bflo(uint32_t w) { return __uint_as_float(w << 16); }
__device__ __forceinline__ float bfhi(uint32_t w) { return __uint_as_float(w & 0xffff0000u); }
__device__ __forceinline__ float silu_f(float v) { return v / (1.f + __expf(-v)); }
__device__ __forceinline__ float softplus_f(float v) { return v > 20.f ? v : log1pf(__expf(v)); }

__device__ __forceinline__ int opaque_tid() { int t = threadIdx.x; asm volatile("" : "+v"(t)); return t; }
__device__ __forceinline__ float wave_sum(float v) {
#pragma unroll
  for (int o = 32; o > 0; o >>= 1) v += __shfl_xor(v, o);
  return v;
}
template <int CTRL>
__device__ __forceinline__ float dpp_mov(float v) {
  return __int_as_float(__builtin_amdgcn_update_dpp(0, __float_as_int(v), CTRL, 0xF, 0xF, true));
}
__device__ __forceinline__ float wave_sum_fast(float v) {
  v += dpp_mov<0xB1>(v); v += dpp_mov<0x4E>(v); v += dpp_mov<0x124>(v); v += dpp_mov<0x128>(v);
  v += __shfl_xor(v, 16); v += __shfl_xor(v, 32);
  return v;
}
__device__ __forceinline__ float wave_max(float v) {
#pragma unroll
  for (int o = 32; o > 0; o >>= 1) v = fmaxf(v, __shfl_xor(v, o));
  return v;
}
__device__ __forceinline__ float block_sum(float v, float* red) {
  v = wave_sum(v);
  __syncthreads();
  if ((threadIdx.x & 63) == 0) red[threadIdx.x >> 6] = v;
  __syncthreads();
  return red[0] + red[1] + red[2] + red[3];
}

struct Params {
  const float *x, *c, *ctx, *c_ctx, *w_mod, *b_mod, *g_pre_mix, *g_post_mix, *g_pre_ffn, *g_post_ffn;
  const float *w_in, *w_fmix, *conv_w, *conv_b, *dt_bias_f, *dt_bias_b, *a_log_f, *a_log_b, *d_skip_f, *d_skip_b;
  const float *ssm_norm_w, *w_out, *w_query, *sk1, *sk2, *eu, *ev;
  float* out;
  uint8_t *U8, *V8;
  int8_t *hx8a, *w8;
  float *ascale, *wscale;
  int8_t *ycat8, *wo8;
  float *yscale, *woscale;
  bf16_t *w_in_t, *w_out_t, *w_q_t, *w_in_f, *WcsT, *dftm, *Fs;
  float *partial, *mod;
  bf16_t *hx, *hc, *ABt, *z;
  bf16_t *xbcraw, *xbcraw_c;
  float *dtraw, *dtraw_c, *dtf, *dtb, *dtf_c, *dtb_c;
  bf16_t *act_tm, *act_cm_x, *act_cm_c;
  float *yf, *yb;
  unsigned* ctr; unsigned* bar;
  bf16_t* ycat;
  float *y_x, *q, *gate;
  int* idx;
  int pad0, pad1;
};

__device__ __forceinline__ void gemm_mainloop(const bf16_t* __restrict__ A, int lda, const bf16_t* __restrict__ Bt, int ldb,
                                              int K, int m0, int n0, f32x4 (&acc)[4][4], char* smem) {
  const int tid = opaque_tid(), lane = tid & 63, w = tid >> 6;
  const int wm = w >> 1, wn = w & 1;
#pragma unroll
  for (int i = 0; i < 4; ++i)
#pragma unroll
    for (int j = 0; j < 4; ++j) acc[i][j] = f32x4{0.f, 0.f, 0.f, 0.f};

  const int nk = K / 64;
  const int rowoff = lane >> 3, lch = (lane & 7) ^ rowoff;
  const bf16_t* gA = A + (size_t)(m0 + w * 8 + rowoff) * lda + lch * 8;
  const bf16_t* gB = Bt + (size_t)(n0 + w * 8 + rowoff) * ldb + lch * 8;
#define GSTAGE(buf_, kt_)                                                                                               \
  do {                                                                                                                  \
    _Pragma("unroll") for (int i_ = 0; i_ < 4; ++i_) {                                                                  \
      __builtin_amdgcn_global_load_lds((const unsigned*)(gA + (size_t)(i_ * 32) * lda + (kt_) * 64),                    \
                                       (unsigned*)(smem + (buf_) * 32768 + (i_ * 4 + w) * 1024), 16, 0, 0);             \
      __builtin_amdgcn_global_load_lds((const unsigned*)(gB + (size_t)(i_ * 32) * ldb + (kt_) * 64),                    \
                                       (unsigned*)(smem + (buf_) * 32768 + 16384 + (i_ * 4 + w) * 1024), 16, 0, 0);     \
    }                                                                                                                   \
  } while (0)
  GSTAGE(0, 0);
  asm volatile("s_waitcnt vmcnt(0)" ::: "memory");
  __syncthreads();
  for (int kt = 0; kt < nk; ++kt) {
    const int cur = kt & 1;
    if (kt + 1 < nk) GSTAGE(cur ^ 1, kt + 1);
    const char* sA = smem + cur * 32768;
    const char* sB = sA + 16384;
#pragma unroll
    for (int kk = 0; kk < 2; ++kk) {
      bf16x8 af[4], bfr[4];
      const int ch = kk * 4 + (lane >> 4);
#pragma unroll
      for (int i = 0; i < 4; ++i) {
        int row = wm * 64 + i * 16 + (lane & 15);
        af[i] = *reinterpret_cast<const bf16x8*>(sA + row * 128 + ((ch ^ (row & 7)) << 4));
        int col = wn * 64 + i * 16 + (lane & 15);
        bfr[i] = *reinterpret_cast<const bf16x8*>(sB + col * 128 + ((ch ^ (col & 7)) << 4));
      }
#pragma unroll
      for (int i = 0; i < 4; ++i)
#pragma unroll
        for (int j = 0; j < 4; ++j) acc[i][j] = __builtin_amdgcn_mfma_f32_16x16x32_bf16(af[i], bfr[j], acc[i][j], 0, 0, 0);
    }
    asm volatile("s_waitcnt vmcnt(0)" ::: "memory");
    __syncthreads();
  }
#undef GSTAGE
}

template <class Epi>
__device__ __forceinline__ void gemm_tile(const bf16_t* __restrict__ A, int lda, const bf16_t* __restrict__ Bt, int ldb,
                                          int K, int m0, int n0, const Epi& epi, char* smem) {
  const int lane = threadIdx.x & 63, w = threadIdx.x >> 6;
  const int wm = w >> 1, wn = w & 1;
  f32x4 acc[4][4];
  gemm_mainloop(A, lda, Bt, ldb, K, m0, n0, acc, smem);
#pragma unroll
  for (int i = 0; i < 4; ++i)
#pragma unroll
    for (int j = 0; j < 4; ++j) {
      int row = m0 + wm * 64 + i * 16 + (lane >> 4) * 4;
      int col = n0 + wn * 64 + j * 16 + (lane & 15);
      epi(row, col, acc[i][j]);
    }
}

template <bool I8>
__device__ __forceinline__ void gemm_mainloop_n256(const bf16_t* __restrict__ A, int lda, const bf16_t* __restrict__ Bt, int ldb,
                                                   int K, int m0, int n0, f32x4 (&acc)[4][8], char* smem) {
  const int tid = opaque_tid(), lane = tid & 63, w = tid >> 6;
  const int wm = w >> 1, wn = w & 1;
#pragma unroll
  for (int i = 0; i < 4; ++i)
#pragma unroll
    for (int j = 0; j < 8; ++j) acc[i][j] = f32x4{0.f, 0.f, 0.f, 0.f};
  const int nk = K / 64;
  const int rowoff = lane >> 3, lch = (lane & 7) ^ rowoff;
  const bf16_t* gA = A + (size_t)(m0 + w * 8 + rowoff) * lda + lch * 8;
  const bf16_t* gB = Bt + (size_t)(n0 + w * 8 + rowoff) * ldb + lch * 8;
  const int fr = lane & 15, fq = lane >> 4;
  for (int kt = 0; kt < nk; ++kt) {
#pragma unroll
    for (int i_ = 0; i_ < 4; ++i_)
      __builtin_amdgcn_global_load_lds((const unsigned*)(gA + (size_t)(i_ * 32) * lda + kt * 64),
                                       (unsigned*)(smem + (i_ * 4 + w) * 1024), 16, 0, 0);
#pragma unroll
    for (int i_ = 0; i_ < 8; ++i_)
      __builtin_amdgcn_global_load_lds((const unsigned*)(gB + (size_t)(i_ * 32) * ldb + kt * 64),
                                       (unsigned*)(smem + 16384 + (i_ * 4 + w) * 1024), 16, 0, 0);
    asm volatile("s_waitcnt vmcnt(0)" ::: "memory");
    __syncthreads();
    const char* sA = smem;
    const char* sB = smem + 16384;
#pragma unroll
    for (int kk = 0; kk < 2; ++kk) {
      bf16x8 af[4], bfr[8];
      const int ch = kk * 4 + fq;
#pragma unroll
      for (int i = 0; i < 4; ++i) {
        const int row = wm * 64 + i * 16 + fr;
        af[i] = *reinterpret_cast<const bf16x8*>(sA + row * 128 + ((ch ^ (row & 7)) << 4));
      }
#pragma unroll
      for (int j = 0; j < 8; ++j) {
        const int col = wn * 128 + j * 16 + fr;
        bfr[j] = *reinterpret_cast<const bf16x8*>(sB + col * 128 + ((ch ^ (col & 7)) << 4));
      }
#pragma unroll
      for (int i = 0; i < 4; ++i)
#pragma unroll
        for (int j = 0; j < 8; ++j) {
          if (I8) {
            typedef __attribute__((ext_vector_type(4))) int i32x4;
            acc[i][j] = __builtin_bit_cast(f32x4, __builtin_amdgcn_mfma_i32_16x16x64_i8(__builtin_bit_cast(i32x4, af[i]), __builtin_bit_cast(i32x4, bfr[j]),
                                                                                         __builtin_bit_cast(i32x4, acc[i][j]), 0, 0, 0));
          } else {
            acc[i][j] = __builtin_amdgcn_mfma_f32_16x16x32_bf16(af[i], bfr[j], acc[i][j], 0, 0, 0);
          }
        }
    }
    __syncthreads();
  }
}
template <bool I8, class Epi>
__device__ __forceinline__ void gemm_tile_n256(const bf16_t* __restrict__ A, int lda, const bf16_t* __restrict__ Bt, int ldb,
                                               int K, int m0, int n0, const Epi& epi, char* smem,
                                               const float* __restrict__ rscale = nullptr, const float* __restrict__ cscale = nullptr) {
  const int lane = threadIdx.x & 63, w = threadIdx.x >> 6;
  const int wm = w >> 1, wn = w & 1;
  f32x4 acc[4][8];
  gemm_mainloop_n256<I8>(A, lda, Bt, ldb, K, m0, n0, acc, smem);
#pragma unroll
  for (int i = 0; i < 4; ++i) {
    const int row = m0 + wm * 64 + i * 16 + (lane >> 4) * 4;
    float4 rs = float4{1.f, 1.f, 1.f, 1.f};
    if (I8) rs = *reinterpret_cast<const float4*>(rscale + row);
#pragma unroll
    for (int j = 0; j < 8; ++j) {
      const int col = n0 + wn * 128 + j * 16 + (lane & 15);
      if (I8) {
        typedef __attribute__((ext_vector_type(4))) int i32x4;
        const i32x4 ia = __builtin_bit_cast(i32x4, acc[i][j]);
        const float cs = cscale[col];
        epi(row, col, f32x4{(float)ia[0] * rs.x * cs, (float)ia[1] * rs.y * cs, (float)ia[2] * rs.z * cs, (float)ia[3] * rs.w * cs});
      } else {
        epi(row, col, acc[i][j]);
      }
    }
  }
}

__device__ __forceinline__ float wave_max_fast(float v) {
  v = fmaxf(v, dpp_mov<0xB1>(v)); v = fmaxf(v, dpp_mov<0x4E>(v)); v = fmaxf(v, dpp_mov<0x124>(v)); v = fmaxf(v, dpp_mov<0x128>(v));
  v = fmaxf(v, __shfl_xor(v, 16)); v = fmaxf(v, __shfl_xor(v, 32));
  return v;
}
__device__ __forceinline__ uint32_t pack_i8x4(float a, float b, float c, float d) {
  const int ia = __float2int_rn(a), ib = __float2int_rn(b), ic = __float2int_rn(c), id = __float2int_rn(d);
  return (uint32_t)(ia & 255) | ((uint32_t)(ib & 255) << 8) | ((uint32_t)(ic & 255) << 16) | ((uint32_t)id << 24);
}
struct EpiF32 {
  float* C; int ldc;
  __device__ __forceinline__ void operator()(int row, int col, f32x4 v) const {
#pragma unroll
    for (int r = 0; r < 4; ++r) C[(size_t)(row + r) * ldc + col] = v[r];
  }
};
struct EpiBf16 {
  bf16_t* C; int ldc;
  __device__ __forceinline__ void operator()(int row, int col, f32x4 v) const {
#pragma unroll
    for (int r = 0; r < 4; ++r) C[(size_t)(row + r) * ldc + col] = f2bf(v[r]);
  }
};
struct EpiBf16T {
  bf16_t* Ct; int ldc;
  __device__ __forceinline__ void operator()(int row, int col, f32x4 v) const {
    uint2 pk; pk.x = pack2(v[0], v[1]); pk.y = pack2(v[2], v[3]);
    *reinterpret_cast<uint2*>(Ct + (size_t)col * ldc + row) = pk;
  }
};
struct EpiInAB {
  bf16_t* ABt; int seqlen;
  __device__ __forceinline__ void operator()(int row, int col, f32x4 v) const {
    const int ch = col & 1023, half = col >> 10;
    const int b = row / seqlen, l = row - b * seqlen;
    uint2 pk; pk.x = pack2(v[0], v[1]); pk.y = pack2(v[2], v[3]);
    *reinterpret_cast<uint2*>(ABt + ((size_t)(b * 1024 + ch) * 4096 + half * 2048 + l)) = pk;
  }
};
struct EpiInZ {
  bf16_t* z;
  __device__ __forceinline__ void operator()(int row, int col, f32x4 v) const {
#pragma unroll
    for (int r = 0; r < 4; ++r) z[(size_t)(row + r) * 1024 + (col - 2048)] = f2bf(v[r]);
  }
};
struct EpiInXbc {
  bf16_t* xbcraw;
  __device__ __forceinline__ void operator()(int row, int col, f32x4 v) const {
#pragma unroll
    for (int r = 0; r < 4; ++r) xbcraw[(size_t)(row + r) * DXBC + (col - 3072)] = f2bf(v[r]);
  }
};
struct EpiInProj {
  bf16_t* ABt; bf16_t* z; bf16_t* xbcraw; float* dtraw; int seqlen;
  __device__ __forceinline__ void operator()(int row, int col, f32x4 v) const {
    if (col < 2048) {
      int ch = col & 1023, half = col >> 10;
      int b = row / seqlen, l = row - b * seqlen;
      uint2 pk; pk.x = pack2(v[0], v[1]); pk.y = pack2(v[2], v[3]);
      *reinterpret_cast<uint2*>(ABt + ((size_t)(b * 1024 + ch) * 4096 + half * 2048 + l)) = pk;
    } else if (col < 3072) {
#pragma unroll
      for (int r = 0; r < 4; ++r) z[(size_t)(row + r) * 1024 + (col - 2048)] = f2bf(v[r]);
    } else if (col < 4608) {
#pragma unroll
      for (int r = 0; r < 4; ++r) xbcraw[(size_t)(row + r) * DXBC + (col - 3072)] = f2bf(v[r]);
    } else if (col < 4640) {
#pragma unroll
      for (int r = 0; r < 4; ++r) dtraw[(size_t)(row + r) * 32 + (col - 4608)] = v[r];
    }
  }
};

__device__ void adaln_partial_task(const Params& p, int task, float* sm) {
  const int cb = task % 48, ks = task / 48, tid = threadIdx.x;
  float* sc = sm;
  __syncthreads();
  for (int i = tid; i < 5 * 64; i += NTHREADS) {
    int r = i >> 6, kk = i & 63;
    int k = ks * 64 + kk;
    float cv = (r < 4) ? p.c[r * D + k] : p.c_ctx[k];
    sc[i] = silu_f(cv);
  }
  __syncthreads();
  const int col = cb * 256 + tid;
  float a0 = 0, a1 = 0, a2 = 0, a3 = 0, a4 = 0;
  const float* wp = p.w_mod + (size_t)(ks * 64) * NMOD + col;
#pragma unroll
  for (int h2 = 0; h2 < 2; ++h2) {
    float wv[32];
#pragma unroll
    for (int kk = 0; kk < 32; ++kk) wv[kk] = __builtin_nontemporal_load(wp + (size_t)(h2 * 32 + kk) * NMOD);
#pragma unroll
    for (int kk = 0; kk < 32; ++kk) {
      const int k = h2 * 32 + kk;
      a0 += sc[k] * wv[kk]; a1 += sc[64 + k] * wv[kk]; a2 += sc[128 + k] * wv[kk]; a3 += sc[192 + k] * wv[kk]; a4 += sc[256 + k] * wv[kk];
    }
  }
  float* pp = p.partial + (size_t)ks * 5 * NMOD + col;
  pp[0] = a0; pp[NMOD] = a1; pp[2 * NMOD] = a2; pp[3 * NMOD] = a3; pp[4 * NMOD] = a4;
}

__device__ void transpose_convert_task(const float* __restrict__ src, int ld, int c0, int rows, bf16_t* __restrict__ dst,
                                       int tr, int tc, float* sm) {
  float (*tile)[68] = reinterpret_cast<float (*)[68]>(sm);
  const int tid = threadIdx.x;
  __syncthreads();
  {
    float4 v[4];
#pragma unroll
    for (int k = 0; k < 4; ++k) {
      const int i = tid + k * NTHREADS, r = i >> 4, c4 = i & 15;
      v[k] = *reinterpret_cast<const float4*>(src + (size_t)(tr * 64 + r) * ld + c0 + tc * 64 + c4 * 4);
    }
#pragma unroll
    for (int k = 0; k < 4; ++k) {
      const int i = tid + k * NTHREADS, r = i >> 4, c4 = i & 15;
      *reinterpret_cast<float4*>(&tile[r][c4 * 4]) = v[k];
    }
  }
  __syncthreads();
#pragma unroll
  for (int k = 0; k < 4; ++k) {
    const int i = tid + k * NTHREADS, cc = i >> 4, r4 = (i & 15) * 4;
    uint2 o; o.x = pack2(tile[r4][cc], tile[r4 + 1][cc]); o.y = pack2(tile[r4 + 2][cc], tile[r4 + 3][cc]);
    *reinterpret_cast<uint2*>(dst + (size_t)(tc * 64 + cc) * rows + tr * 64 + r4) = o;
  }
}

__device__ void phase_prep(const Params& p, int bid, int nb, char* smem) {
  float* sm = reinterpret_cast<float*>(smem);
  const int tid = threadIdx.x;
  if (bid == 0 && tid < 64) p.ctr[tid] = 0u;
  {
    float* t256 = reinterpret_cast<float*>(smem + 20480);
    float* t2048 = reinterpret_cast<float*>(smem + 24576);
    t256[tid] = cospif((float)tid * (1.0f / 128.f));
    for (int i = tid; i < 2048; i += NTHREADS) t2048[i] = cospif((float)i * (1.0f / 1024.f));
    __syncthreads();
  }
  for (int t = bid; t < 48 * KSPLIT; t += nb) adaln_partial_task(p, t, sm);
  {
    const int nct = 41, nrt = 32;
    for (int t = bid; t < nct * nrt; t += nb) {
      int tc = t % nct, tr = t / nct;
      if (tc < 40) transpose_convert_task(p.w_in, DIN, 1024, D, p.w_in_t + (size_t)2048 * D, tr, tc, sm);
      else {
        float (*tile)[65] = reinterpret_cast<float (*)[65]>(sm);
        __syncthreads();
        for (int i = tid; i < 64 * 32; i += NTHREADS) {
          int r = i >> 5, cc = i & 31;
          tile[r][cc] = p.w_in[(size_t)(tr * 64 + r) * DIN + 1024 + 2560 + cc];
        }
        __syncthreads();
        for (int i = tid; i < 32 * 32; i += NTHREADS) {
          int cc = i >> 5, r2 = (i & 31) * 2;
          uint32_t pk = pack2(tile[r2][cc], tile[r2 + 1][cc]);
          *reinterpret_cast<uint32_t*>(p.w_in_t + (size_t)(2048 + 2560 + cc) * D + tr * 64 + r2) = pk;
        }
      }
    }
    for (size_t i = (size_t)bid * NTHREADS + tid; i < (size_t)96 * D / 8; i += (size_t)nb * NTHREADS)
      reinterpret_cast<uint4*>(p.w_in_t + (size_t)4640 * D)[i] = uint4{0, 0, 0, 0};
  }
  for (size_t i = (size_t)bid * NTHREADS + tid; i < (size_t)D * 1024 / 4; i += (size_t)nb * NTHREADS) {
    int k = (int)(i / 256), c4 = (int)(i % 256) * 4;
    float4 v = *reinterpret_cast<const float4*>(p.w_in + (size_t)k * DIN + c4);
    uint2 o; o.x = pack2(v.x, v.y); o.y = pack2(v.z, v.w);
    *reinterpret_cast<uint2*>(p.w_in_f + (size_t)k * 1024 + c4) = o;
  }
  {
    const float* t256 = reinterpret_cast<const float*>(smem + 20480);
    const float scale = 1.0f / sqrtf((float)L * 256.f);
    for (int i = bid * NTHREADS + tid; i < 4 * 64 * 256; i += nb * NTHREADS) {
      const int d = i & 255, cg = (i >> 8) & 63, g = i >> 14;
      float sc_[4] = {0.f, 0.f, 0.f, 0.f}, ss_[4] = {0.f, 0.f, 0.f, 0.f};
      const float* wp = p.w_fmix + (size_t)g * 65536 + d;
#pragma unroll 4
      for (int m = 0; m < 256; ++m) {
        const float wv = wp[m * 256];
#pragma unroll
        for (int j = 0; j < 4; ++j) {
          const int ph = (m * (cg * 4 + j)) & 255;
          sc_[j] += t256[ph] * wv; ss_[j] += t256[(ph - 64) & 255] * wv;
        }
      }
#pragma unroll
      for (int j = 0; j < 4; ++j) {
        const int c = cg * 4 + j;
        p.WcsT[((size_t)g * 512 + d) * 256 + c] = f2bf(sc_[j] * scale);
        p.WcsT[((size_t)g * 512 + 256 + d) * 256 + c] = f2bf(ss_[j] * scale);
      }
    }
  }
  {
    const float* t2048 = reinterpret_cast<const float*>(smem + 24576);
    for (size_t i = (size_t)bid * NTHREADS + tid; i < (size_t)1024 * 2048 / 8; i += (size_t)nb * NTHREADS) {
      const int k = (int)(i / 256), j = (int)(i % 256) * 8;
      const bool iss = j >= 1024;
      float o[8];
#pragma unroll
      for (int e = 0; e < 8; ++e) {
        const int l = (j + e) & 1023;
        const int ph = (k * l) & 2047;
        o[e] = iss ? t2048[(ph - 512) & 2047] : t2048[ph];
      }
      uint4 pk; pk.x = pack2(o[0], o[1]); pk.y = pack2(o[2], o[3]); pk.z = pack2(o[4], o[5]); pk.w = pack2(o[6], o[7]);
      *reinterpret_cast<uint4*>(p.dftm + (size_t)k * 2048 + j) = pk;
    }
  }
}

__device__ void phase_fold(const Params& p, int bid, int nb, char* smem) {
  const int tid = threadIdx.x;
  for (int i = bid * NTHREADS + tid; i < 5 * NMOD; i += nb * NTHREADS) {
    int col = i % NMOD;
    float s = p.b_mod[col];
    for (int ks = 0; ks < KSPLIT; ++ks) s += p.partial[(size_t)ks * 5 * NMOD + i];
    p.mod[i] = s;
  }
  for (int t = bid; t < 256; t += nb) {
    int g = t >> 6, tm = (t & 63) >> 2, tn = t & 3;
    int n0 = tn * 128;
    int rowbase = (n0 < 256) ? (g * 256 + n0) : (1024 + g * 256 + (n0 - 256));
    EpiBf16T epi{p.w_in_t + (size_t)(rowbase - n0) * D, D};
    gemm_tile(p.w_in_f + g * 256, 1024, p.WcsT + (size_t)g * 512 * 256, 256, 256, tm * 128, n0, epi, smem);
  }
}

__device__ __forceinline__ void quant_weight_rows_i8(const bf16_t* __restrict__ src, int8_t* __restrict__ dst, float* __restrict__ scl,
                                                     int nrows, int bid, int nb) {
  const int lane = threadIdx.x & 63, w = threadIdx.x >> 6;
  for (int n = bid * 4 + w; n < nrows; n += nb * 4) {
    const bf16_t* wr = src + (size_t)n * D;
    uint4 q[4];
#pragma unroll
    for (int c = 0; c < 4; ++c) q[c] = *reinterpret_cast<const uint4*>(wr + c * 512 + lane * 8);
    float am = 0.f;
#pragma unroll
    for (int c = 0; c < 4; ++c) {
      am = fmaxf(am, fmaxf(fmaxf(fabsf(bflo(q[c].x)), fabsf(bfhi(q[c].x))), fmaxf(fabsf(bflo(q[c].y)), fabsf(bfhi(q[c].y)))));
      am = fmaxf(am, fmaxf(fmaxf(fabsf(bflo(q[c].z)), fabsf(bfhi(q[c].z))), fmaxf(fabsf(bflo(q[c].w)), fabsf(bfhi(q[c].w)))));
    }
    am = wave_max_fast(am);
    const float inv = (am > 0.f) ? 127.f / am : 0.f;
#pragma unroll
    for (int c = 0; c < 4; ++c) {
      uint2 o;
      o.x = pack_i8x4(bflo(q[c].x) * inv, bfhi(q[c].x) * inv, bflo(q[c].y) * inv, bfhi(q[c].y) * inv);
      o.y = pack_i8x4(bflo(q[c].z) * inv, bfhi(q[c].z) * inv, bflo(q[c].w) * inv, bfhi(q[c].w) * inv);
      *reinterpret_cast<uint2*>(dst + (size_t)n * D + c * 512 + lane * 8) = o;
    }
    if (lane == 0) scl[n] = am * (1.f / 127.f);
  }
}

__device__ void phase_norm_mod(const Params& p, int bid, int nb, char* smem) {
  const int lane = threadIdx.x & 63, w = threadIdx.x >> 6;
  for (int t = bid * 4 + w; t < T + TC; t += nb * 4) {
    const bool isx = t < T;
    const float* src = isx ? (p.x + (size_t)t * D) : (p.ctx + (size_t)(t - T) * D);
    const int mrow = isx ? (t / L) : 4;
    bf16_t* dst = isx ? (p.hx + (size_t)t * D) : (p.hc + (size_t)(t - T) * D);
    float4 v[8];
    float ss = 0.f;
#pragma unroll
    for (int c = 0; c < 8; ++c) {
      v[c] = *reinterpret_cast<const float4*>(src + c * 256 + lane * 4);
      ss += v[c].x * v[c].x + v[c].y * v[c].y + v[c].z * v[c].z + v[c].w * v[c].w;
    }
    ss = wave_sum_fast(ss);
    const float rstd = rsqrtf(ss * (1.f / D) + EPS);
    const float* sh = p.mod + (size_t)mrow * NMOD + 0 * D;
    const float* sc = p.mod + (size_t)mrow * NMOD + 1 * D;
    float am = 0.f;
#pragma unroll
    for (int c = 0; c < 8; ++c) {
      const int e0 = c * 256 + lane * 4;
      const float4 g = *reinterpret_cast<const float4*>(p.g_pre_mix + e0);
      const float4 s4 = *reinterpret_cast<const float4*>(sc + e0), h4 = *reinterpret_cast<const float4*>(sh + e0);
      v[c].x = v[c].x * rstd * g.x * (1.f + s4.x) + h4.x; v[c].y = v[c].y * rstd * g.y * (1.f + s4.y) + h4.y;
      v[c].z = v[c].z * rstd * g.z * (1.f + s4.z) + h4.z; v[c].w = v[c].w * rstd * g.w * (1.f + s4.w) + h4.w;
      am = fmaxf(am, fmaxf(fmaxf(fabsf(v[c].x), fabsf(v[c].y)), fmaxf(fabsf(v[c].z), fabsf(v[c].w))));
      uint2 pk;
      pk.x = pack2(v[c].x, v[c].y);
      pk.y = pack2(v[c].z, v[c].w);
      *reinterpret_cast<uint2*>(dst + e0) = pk;
    }
    if (isx) {
      am = wave_max_fast(am);
      const float inv = (am > 0.f) ? 127.f / am : 0.f;
#pragma unroll
      for (int c = 0; c < 8; ++c)
        *reinterpret_cast<uint32_t*>(p.hx8a + (size_t)t * D + c * 256 + lane * 4) = pack_i8x4(v[c].x * inv, v[c].y * inv, v[c].z * inv, v[c].w * inv);
      if (lane == 0) p.ascale[t] = am * (1.f / 127.f);
    }
  }
  quant_weight_rows_i8(p.w_in_t, p.w8, p.wscale, 4096, bid, nb);
}

__device__ __forceinline__ void convert_uv_units(const Params& p, size_t u0, size_t u1) {
  const size_t n16 = (size_t)16384 * D / 16;
  for (size_t i = u0 + threadIdx.x; i < u1; i += NTHREADS) {
    const float* s = (i < n16) ? p.eu : p.ev;
    uint8_t* d = (i < n16) ? p.U8 : p.V8;
    const size_t j = (i < n16) ? i : i - n16;
    uint32_t o[4];
#pragma unroll
    for (int q4 = 0; q4 < 4; ++q4) {
      const float4 v = *reinterpret_cast<const float4*>(s + j * 16 + q4 * 4);
      int pk = 0;
      pk = __builtin_amdgcn_cvt_pk_fp8_f32(v.x * 512.f, v.y * 512.f, pk, false);
      pk = __builtin_amdgcn_cvt_pk_fp8_f32(v.z * 512.f, v.w * 512.f, pk, true);
      o[q4] = (uint32_t)pk;
    }
    const size_t e_ = j >> 7, r_ = j & 127;
    *reinterpret_cast<uint4*>(d + (r_ >> 4) * ((size_t)16384 * 256) + e_ * 256 + (r_ & 15) * 16) = uint4{o[0], o[1], o[2], o[3]};
  }
}
__device__ void phase_inproj(const Params& p, int bid, int nb, char* smem) {
  if ((nb & 7) == 0) {
    const int x = bid & 7, rank = bid >> 3, per = nb >> 3;
    for (int s_ = rank; s_ < 128 + 53; s_ += per) {
      if (s_ < 128) {
        const int tn2 = s_ >> 3, m0_ = (8 * x + (s_ & 7)) * 128;
        const bf16_t* a8 = reinterpret_cast<const bf16_t*>(p.hx8a);
        const bf16_t* b8 = reinterpret_cast<const bf16_t*>(p.w8);
        if (tn2 < 8) { EpiInAB epi{p.ABt, L}; gemm_tile_n256<true>(a8, D / 2, b8, D / 2, D / 2, m0_, tn2 * 256, epi, smem, p.ascale, p.wscale); }
        else if (tn2 < 12) { EpiInZ epi{p.z}; gemm_tile_n256<true>(a8, D / 2, b8, D / 2, D / 2, m0_, tn2 * 256, epi, smem, p.ascale, p.wscale); }
        else { EpiInXbc epi{p.xbcraw}; gemm_tile_n256<true>(a8, D / 2, b8, D / 2, D / 2, m0_, tn2 * 256, epi, smem, p.ascale, p.wscale); }
      } else if (s_ < 128 + 40) {
        const int i = s_ - 128;
        EpiInProj epi{p.ABt, p.z, p.xbcraw, p.dtraw, L};
        gemm_tile(p.hx, D, p.w_in_t, D, D, (8 * x + (i & 7)) * 128, (32 + (i >> 3)) * 128, epi, smem);
      } else {
        const int u = x * 13 + (s_ - 168);
        EpiInProj epi{nullptr, nullptr, p.xbcraw_c, p.dtraw_c, CTX};
        gemm_tile(p.hc, D, p.w_in_t, D, D, (u / 13) * 128, 3072 + (u % 13) * 128, epi, smem);
      }
    }
    return;
  }
  const int ntx = 64 * 37, ntc = 8 * 13;
  for (int t = bid; t < ntx + ntc; t += nb) {
    if (t < ntx) {
      int tm = t / 37, tn = t % 37;
      EpiInProj epi{p.ABt, p.z, p.xbcraw, p.dtraw, L};
      gemm_tile(p.hx, D, p.w_in_t, D, D, tm * 128, tn * 128, epi, smem);
    } else {
      int u = t - ntx;
      int tm = u / 13, tn = u % 13;
      EpiInProj epi{nullptr, nullptr, p.xbcraw_c, p.dtraw_c, CTX};
      gemm_tile(p.hc, D, p.w_in_t, D, D, tm * 128, 3072 + tn * 128, epi, smem);
    }
  }
}

__device__ void ssm_pre_tile(const Params& p, int task, char* smem) {
  const bool isx = task < 3072;
  const int u = isx ? task : task - 3072;
  const int ntt = isx ? 32 : 4;
  const int ct = u % 24, tt = (u / 24) % ntt, b = u / (24 * ntt);
  const int seqlen = isx ? L : CTX;
  const bf16_t* raw = (isx ? p.xbcraw : p.xbcraw_c) + (size_t)b * seqlen * DXBC;
  const int l0 = tt * 64, c0 = ct * 64, tid = threadIdx.x;
  float (*rt)[68] = reinterpret_cast<float (*)[68]>(smem);
  float (*at)[65] = reinterpret_cast<float (*)[65]>(smem + 66 * 68 * 4);
  __syncthreads();
  {
    uint2 v[5];
#pragma unroll
    for (int k = 0; k < 5; ++k) {
      const int i = tid + k * NTHREADS, r = i >> 4, c4 = i & 15, l = l0 - 1 + r;
      v[k] = (i < 66 * 16 && l >= 0 && l < seqlen) ? *reinterpret_cast<const uint2*>(raw + (size_t)l * DXBC + c0 + c4 * 4) : uint2{0u, 0u};
    }
#pragma unroll
    for (int k = 0; k < 5; ++k) {
      const int i = tid + k * NTHREADS, r = i >> 4, c4 = i & 15;
      if (i < 66 * 16) *reinterpret_cast<float4*>(&rt[r][c4 * 4]) = float4{bflo(v[k].x), bfhi(v[k].x), bflo(v[k].y), bfhi(v[k].y)};
    }
  }
  __syncthreads();
  {
    const int cc = tid & 63, c = c0 + cc;
    const float w0 = p.conv_w[c], w1 = p.conv_w[DXBC + c], w2 = p.conv_w[2 * DXBC + c], cb = p.conv_b[c];
#pragma unroll 4
    for (int r = tid >> 6; r < 64; r += 4) at[r][cc] = silu_f(cb + rt[r][cc] * w0 + rt[r + 1][cc] * w1 + rt[r + 2][cc] * w2);
  }
  __syncthreads();
  const size_t trow0 = isx ? ((size_t)b * L + l0) : ((size_t)T + (size_t)b * CTX + l0);
#pragma unroll
  for (int k = 0; k < 4; ++k) {
    const int i = tid + k * NTHREADS, r = i >> 4, c4 = (i & 15) * 4;
    uint2 o; o.x = pack2(at[r][c4], at[r][c4 + 1]); o.y = pack2(at[r][c4 + 2], at[r][c4 + 3]);
    *reinterpret_cast<uint2*>(p.act_tm + (trow0 + r) * DXBC + c0 + c4) = o;
  }
  if (c0 < 1280) {
    bf16_t* cm = (isx ? p.act_cm_x : p.act_cm_c) + (size_t)b * 1280 * seqlen;
#pragma unroll
    for (int k = 0; k < 4; ++k) {
      const int i = tid + k * NTHREADS, cc = i >> 4, r4 = (i & 15) * 4;
      uint2 o; o.x = pack2(at[r4][cc], at[r4 + 1][cc]); o.y = pack2(at[r4 + 2][cc], at[r4 + 3][cc]);
      *reinterpret_cast<uint2*>(cm + (size_t)(c0 + cc) * seqlen + l0 + r4) = o;
    }
  }
}
__device__ void dft_fold_rows(const Params& p, int bid, int nb, char* smem) {
  const int lane = threadIdx.x & 63, w = threadIdx.x >> 6;
  bf16_t* sr = reinterpret_cast<bf16_t*>(smem + w * 8192);
  for (int row = bid * 4 + w; row < NB * 1024; row += nb * 4) {
    const bf16_t* A = p.ABt + (size_t)row * 4096;
    bf16_t* F = p.Fs + (size_t)row * 2048;
    __builtin_amdgcn_wave_barrier();
    {
      const uint4 q0 = *reinterpret_cast<const uint4*>(A + (0 * 64 + lane) * 8), q1 = *reinterpret_cast<const uint4*>(A + (1 * 64 + lane) * 8);
      const uint4 q2 = *reinterpret_cast<const uint4*>(A + (2 * 64 + lane) * 8), q3 = *reinterpret_cast<const uint4*>(A + (3 * 64 + lane) * 8);
      const uint4 q4 = *reinterpret_cast<const uint4*>(A + (4 * 64 + lane) * 8), q5 = *reinterpret_cast<const uint4*>(A + (5 * 64 + lane) * 8);
      const uint4 q6 = *reinterpret_cast<const uint4*>(A + (6 * 64 + lane) * 8), q7 = *reinterpret_cast<const uint4*>(A + (7 * 64 + lane) * 8);
      *reinterpret_cast<uint4*>(sr + (0 * 64 + lane) * 8) = q0; *reinterpret_cast<uint4*>(sr + (1 * 64 + lane) * 8) = q1;
      *reinterpret_cast<uint4*>(sr + (2 * 64 + lane) * 8) = q2; *reinterpret_cast<uint4*>(sr + (3 * 64 + lane) * 8) = q3;
      *reinterpret_cast<uint4*>(sr + (4 * 64 + lane) * 8) = q4; *reinterpret_cast<uint4*>(sr + (5 * 64 + lane) * 8) = q5;
      *reinterpret_cast<uint4*>(sr + (6 * 64 + lane) * 8) = q6; *reinterpret_cast<uint4*>(sr + (7 * 64 + lane) * 8) = q7;
    }
    __builtin_amdgcn_wave_barrier();
    const int l0 = lane * 16;
    float alt = 0.f;
    uint32_t oa[8], ob[8];
#pragma unroll
    for (int half = 0; half < 2; ++half) {
      const bf16_t* base = sr + half * 2048;
      const uint4 fa = *reinterpret_cast<const uint4*>(base + l0), fb = *reinterpret_cast<const uint4*>(base + l0 + 8);
      const uint4 ra = *reinterpret_cast<const uint4*>(base + 2032 - l0), rb = *reinterpret_cast<const uint4*>(base + 2040 - l0);
      const float r16 = (lane > 0) ? bf2f(base[2048 - l0]) : 0.f;
      const uint32_t fw[8] = {fa.x, fa.y, fa.z, fa.w, fb.x, fb.y, fb.z, fb.w};
      const uint32_t rw[8] = {ra.x, ra.y, ra.z, ra.w, rb.x, rb.y, rb.z, rb.w};
      float v[16];
#pragma unroll
      for (int i = 0; i < 16; ++i) {
        const float fwv = (i & 1) ? bfhi(fw[i >> 1]) : bflo(fw[i >> 1]);
        const int j = 16 - i;
        const float rv = (i == 0) ? r16 : ((j & 1) ? bfhi(rw[j >> 1]) : bflo(rw[j >> 1]));
        if (half == 0) v[i] = (lane == 0 && i == 0) ? fwv : fwv + rv;
        else v[i] = (lane == 0 && i == 0) ? 0.f : fwv - rv;
      }
      if (half == 0) {
#pragma unroll
        for (int i = 0; i < 16; ++i) alt += (i & 1) ? -v[i] : v[i];
#pragma unroll
        for (int i = 0; i < 8; ++i) oa[i] = pack2(v[2 * i], v[2 * i + 1]);
      } else {
#pragma unroll
        for (int i = 0; i < 8; ++i) ob[i] = pack2(v[2 * i], v[2 * i + 1]);
      }
    }
    *reinterpret_cast<uint4*>(F + l0) = uint4{oa[0], oa[1], oa[2], oa[3]};
    *reinterpret_cast<uint4*>(F + l0 + 8) = uint4{oa[4], oa[5], oa[6], oa[7]};
    *reinterpret_cast<uint4*>(F + 1024 + l0) = uint4{ob[0], ob[1], ob[2], ob[3]};
    *reinterpret_cast<uint4*>(F + 1024 + l0 + 8) = uint4{ob[4], ob[5], ob[6], ob[7]};
    alt = wave_sum_fast(alt) + bf2f(sr[1024]);
    if (lane == 0) { const int b = row >> 10, ch = row & 1023; p.ycat[((size_t)b * L + 1024) * D + ch] = f2bf(alt); }
  }
}
__device__ void phase_ssm_pre(const Params& p, int bid, int nb, char* smem) {
  const int tid = threadIdx.x;
  dft_fold_rows(p, bid, nb, smem);
  for (int t = bid; t < 3072 + 384; t += nb) ssm_pre_tile(p, t, smem);
  for (int i = bid * NTHREADS + tid; i < (T + TC) * 32; i += nb * NTHREADS) {
    const bool isx = i < T * 32;
    const int ii = isx ? i : i - T * 32;
    const int t = ii >> 5, j = ii & 31;
    const float v = (isx ? p.dtraw : p.dtraw_c)[ii];
    float* df = isx ? p.dtf : p.dtf_c;
    float* db = isx ? p.dtb : p.dtb_c;
    if (j < 16) df[t * 16 + j] = softplus_f(v + p.dt_bias_f[j]);
    else db[t * 16 + (j - 16)] = softplus_f(v + p.dt_bias_b[j - 16]);
  }
}

__device__ __forceinline__ int swz16(int row, int chunk) { return row * 256 + ((chunk ^ (row & 15)) << 4); }
__device__ __forceinline__ int swz8(int row, int chunk) { return row * 128 + ((chunk ^ (row & 7)) << 4); }

#define LDS_BARRIER() asm volatile("s_waitcnt lgkmcnt(0)\n\ts_barrier" ::: "memory")
__device__ void ssd_task(const Params& p, int task, char* smem) {
  const int dir = task & 1, ph = (task >> 1) & 1, h = (task >> 2) & 15, b = task >> 6;
  const int tid = opaque_tid(), lane = tid & 63, w = tid >> 6;
  const int g = h >> 3, lr0 = lane & 15, lq0 = lane >> 4;
  const float a = -__expf(dir ? p.a_log_b[h] : p.a_log_f[h]);
  char* sCc = smem; char* sBc = smem + 16384; char* sBT = smem + 32768; char* sXT = smem + 49152; char* sHb = smem + 57344;
  float* se = reinterpret_cast<float*>(smem + 73728);
  float* sdt = se + 64; float* sw = se + 128; float* sy = se + 192; float* stot = se + 256;
  bf16_t* yo = reinterpret_cast<bf16_t*>(dir ? p.yb : p.yf);
  f32x4 H[2][2];
#pragma unroll
  for (int i = 0; i < 2; ++i)
#pragma unroll
    for (int j = 0; j < 2; ++j) H[i][j] = f32x4{0.f, 0.f, 0.f, 0.f};
  __syncthreads();
  for (int i = tid; i < 512; i += NTHREADS) reinterpret_cast<uint4*>(sHb)[i] = uint4{0, 0, 0, 0};

  const int crow = tid >> 4, cch = tid & 15;
  const int trow = tid >> 3, tch = tid & 7;
  uint4 rC0, rC1, rC2, rC3, rB0, rB1, rB2, rB3, rT0, rT1, rT2, rT3, rX;
  rC0 = rC1 = rC2 = rC3 = rB0 = rB1 = rB2 = rB3 = uint4{0, 0, 0, 0};
  float rdt = 0.f;
#define SSD_PARAMS(st_)                                                                                                   \
  const bool isctx_ = (st_) < 4;                                                                                          \
  const int nch_ = isctx_ ? 4 : 32, ci_ = isctx_ ? (st_) : (st_) - 4;                                                     \
  const int c_ = dir ? (nch_ - 1 - ci_) : ci_;                                                                            \
  const int seqlen_ = isctx_ ? CTX : L;                                                                                   \
  const size_t trow0_ = isctx_ ? ((size_t)T + (size_t)b * CTX + c_ * 64) : ((size_t)b * L + c_ * 64);                     \
  const size_t drow0_ = (size_t)b * seqlen_ + c_ * 64;                                                                    \
  const float* dtp_ = isctx_ ? (dir ? p.dtb_c : p.dtf_c) : (dir ? p.dtb : p.dtf);                                         \
  const bf16_t* cm_ = (isctx_ ? p.act_cm_c : p.act_cm_x) + (size_t)b * 1280 * seqlen_ + c_ * 64;
#define SSD_PREFETCH(st_)                                                                                                 \
  do {                                                                                                                    \
    SSD_PARAMS(st_)                                                                                                       \
    if (w == 0) rdt = dtp_[(drow0_ + lane) * 16 + h];                                                                     \
    if (!isctx_) {                                                                                                        \
      const bf16_t* src = p.act_tm + (trow0_ + crow) * DXBC + g * 128 + cch * 8;                                          \
      rC0 = *reinterpret_cast<const uint4*>(src + 1280);             rB0 = *reinterpret_cast<const uint4*>(src + 1024);   \
      rC1 = *reinterpret_cast<const uint4*>(src + 16 * DXBC + 1280); rB1 = *reinterpret_cast<const uint4*>(src + 16 * DXBC + 1024); \
      rC2 = *reinterpret_cast<const uint4*>(src + 32 * DXBC + 1280); rB2 = *reinterpret_cast<const uint4*>(src + 32 * DXBC + 1024); \
      rC3 = *reinterpret_cast<const uint4*>(src + 48 * DXBC + 1280); rB3 = *reinterpret_cast<const uint4*>(src + 48 * DXBC + 1024); \
    }                                                                                                                     \
    const bf16_t* srt = cm_ + (size_t)(1024 + g * 128 + trow) * seqlen_ + tch * 8;                                        \
    rT0 = *reinterpret_cast<const uint4*>(srt);                                                                           \
    rT1 = *reinterpret_cast<const uint4*>(srt + (size_t)32 * seqlen_);                                                    \
    rT2 = *reinterpret_cast<const uint4*>(srt + (size_t)64 * seqlen_);                                                    \
    rT3 = *reinterpret_cast<const uint4*>(srt + (size_t)96 * seqlen_);                                                    \
    rX = *reinterpret_cast<const uint4*>(cm_ + (size_t)(h * 64 + ph * 32 + trow) * seqlen_ + tch * 8);                    \
  } while (0)

  for (int step = 0; step < 36; ++step) {
    SSD_PREFETCH(step);
    const bool isctx = step < 4;
    const int c = dir ? ((isctx ? 4 : 32) - 1 - (isctx ? step : step - 4)) : (isctx ? step : step - 4);
    const size_t trow0 = (size_t)b * L + c * 64;
    int lr = lr0, lq = lq0;
    asm volatile("" : "+v"(lr), "+v"(lq));
    LDS_BARRIER();
    if (w == 0) {
      const float dtv = rdt;
      float v = a * dtv;
      if (!dir) {
#pragma unroll
        for (int o = 1; o < 64; o <<= 1) { float n = __shfl_up(v, o); v += (lane >= o) ? n : 0.f; }
      } else {
#pragma unroll
        for (int o = 1; o < 64; o <<= 1) { float n = __shfl_down(v, o); v += (lane + o < 64) ? n : 0.f; }
      }
      const float etot = __shfl(v, dir ? 0 : 63);
      se[lane] = v; sdt[lane] = dtv; sw[lane] = dtv * __expf(etot - v); sy[lane] = __expf(v);
      if (lane == 0) stot[0] = etot;
    }
    if (!isctx) {
      const int oc = swz16(crow, cch);
      *reinterpret_cast<uint4*>(sCc + oc) = rC0;         *reinterpret_cast<uint4*>(sBc + oc) = rB0;
      *reinterpret_cast<uint4*>(sCc + oc + 4096) = rC1;  *reinterpret_cast<uint4*>(sBc + oc + 4096) = rB1;
      *reinterpret_cast<uint4*>(sCc + oc + 8192) = rC2;  *reinterpret_cast<uint4*>(sBc + oc + 8192) = rB2;
      *reinterpret_cast<uint4*>(sCc + oc + 12288) = rC3; *reinterpret_cast<uint4*>(sBc + oc + 12288) = rB3;
    }
    {
      const int ot = swz8(trow, tch);
      *reinterpret_cast<uint4*>(sBT + ot) = rT0;
      *reinterpret_cast<uint4*>(sBT + ot + 4096) = rT1;
      *reinterpret_cast<uint4*>(sBT + ot + 8192) = rT2;
      *reinterpret_cast<uint4*>(sBT + ot + 12288) = rT3;
      *reinterpret_cast<uint4*>(sXT + ot) = rX;
    }
    LDS_BARRIER();
    const float etot = stot[0];
    if (!isctx) {
      f32x4 G[4];
      bf16x8 ca[4];
#pragma unroll
      for (int j = 0; j < 4; ++j) G[j] = f32x4{0.f, 0.f, 0.f, 0.f};
#pragma unroll
      for (int kk = 0; kk < 4; ++kk) ca[kk] = *reinterpret_cast<const bf16x8*>(sCc + swz16(16 * w + lr, kk * 4 + lq));
#pragma unroll
      for (int kk = 0; kk < 4; ++kk)
#pragma unroll
        for (int j = 0; j < 4; ++j) {
          bf16x8 bb = *reinterpret_cast<const bf16x8*>(sBc + swz16(16 * j + lr, kk * 4 + lq));
          G[j] = __builtin_amdgcn_mfma_f32_16x16x32_bf16(ca[kk], bb, G[j], 0, 0, 0);
        }
      LDS_BARRIER();
      float el[4];
#pragma unroll
      for (int r = 0; r < 4; ++r) el[r] = se[16 * w + lq * 4 + r];
#pragma unroll
      for (int j = 0; j < 4; ++j) {
        const int s_ = 16 * j + lr;
        const float es = se[s_], ds = sdt[s_];
#pragma unroll
        for (int r = 0; r < 4; ++r) {
          const int l = 16 * w + lq * 4 + r;
          const bool keep = dir ? (s_ >= l) : (s_ <= l);
          const float m = keep ? G[j][r] * __expf(el[r] - es) * ds : 0.f;
          *reinterpret_cast<bf16_t*>(sBc + swz8(l, s_ >> 3) + (s_ & 7) * 2) = f2bf(m);
        }
      }
      LDS_BARRIER();
      f32x4 Y[2], Yo[2];
#pragma unroll
      for (int j = 0; j < 2; ++j) { Y[j] = f32x4{0.f, 0.f, 0.f, 0.f}; Yo[j] = f32x4{0.f, 0.f, 0.f, 0.f}; }
#pragma unroll
      for (int kk = 0; kk < 2; ++kk) {
        bf16x8 ma = *reinterpret_cast<const bf16x8*>(sBc + swz8(16 * w + lr, kk * 4 + lq));
#pragma unroll
        for (int j = 0; j < 2; ++j) {
          bf16x8 xb = *reinterpret_cast<const bf16x8*>(sXT + swz8(16 * j + lr, kk * 4 + lq));
          Y[j] = __builtin_amdgcn_mfma_f32_16x16x32_bf16(ma, xb, Y[j], 0, 0, 0);
        }
      }
#pragma unroll
      for (int kk = 0; kk < 4; ++kk)
#pragma unroll
        for (int j = 0; j < 2; ++j) {
          bf16x8 hb = *reinterpret_cast<const bf16x8*>(sHb + swz16(16 * j + lr, kk * 4 + lq));
          Yo[j] = __builtin_amdgcn_mfma_f32_16x16x32_bf16(ca[kk], hb, Yo[j], 0, 0, 0);
        }
      float syl[4];
#pragma unroll
      for (int r = 0; r < 4; ++r) syl[r] = sy[16 * w + lq * 4 + r];
#pragma unroll
      for (int j = 0; j < 2; ++j)
#pragma unroll
        for (int r = 0; r < 4; ++r) {
          const int l = 16 * w + lq * 4 + r;
          yo[(trow0 + l) * 1024 + h * 64 + ph * 32 + 16 * j + lr] = f2bf(Y[j][r] + syl[r] * Yo[j][r]);
        }
    }
    {
      const float dec = __expf(etot);
#pragma unroll
      for (int i = 0; i < 2; ++i)
#pragma unroll
        for (int j = 0; j < 2; ++j) H[i][j] *= dec;
#pragma unroll
      for (int kk = 0; kk < 2; ++kk) {
        const int s0 = kk * 32 + lq * 8;
        const float4 w0 = *reinterpret_cast<const float4*>(sw + s0), w1 = *reinterpret_cast<const float4*>(sw + s0 + 4);
        bf16x8 xs[2];
#pragma unroll
        for (int i = 0; i < 2; ++i) {
          const bf16x8 xa = *reinterpret_cast<const bf16x8*>(sXT + swz8(16 * i + lr, kk * 4 + lq));
          xs[i][0] = (short)f2bf(bf2f((bf16_t)xa[0]) * w0.x); xs[i][1] = (short)f2bf(bf2f((bf16_t)xa[1]) * w0.y);
          xs[i][2] = (short)f2bf(bf2f((bf16_t)xa[2]) * w0.z); xs[i][3] = (short)f2bf(bf2f((bf16_t)xa[3]) * w0.w);
          xs[i][4] = (short)f2bf(bf2f((bf16_t)xa[4]) * w1.x); xs[i][5] = (short)f2bf(bf2f((bf16_t)xa[5]) * w1.y);
          xs[i][6] = (short)f2bf(bf2f((bf16_t)xa[6]) * w1.z); xs[i][7] = (short)f2bf(bf2f((bf16_t)xa[7]) * w1.w);
        }
#pragma unroll
        for (int j = 0; j < 2; ++j) {
          const bf16x8 bt = *reinterpret_cast<const bf16x8*>(sBT + swz8(16 * (2 * w + j) + lr, kk * 4 + lq));
#pragma unroll
          for (int i = 0; i < 2; ++i) H[i][j] = __builtin_amdgcn_mfma_f32_16x16x32_bf16(xs[i], bt, H[i][j], 0, 0, 0);
        }
      }
    }
    LDS_BARRIER();
#pragma unroll
    for (int i = 0; i < 2; ++i)
#pragma unroll
      for (int j = 0; j < 2; ++j) {
        const int n = 16 * (2 * w + j) + lr;
#pragma unroll
        for (int r = 0; r < 4; ++r) {
          const int pr = 16 * i + lq * 4 + r;
          *reinterpret_cast<bf16_t*>(sHb + swz16(pr, n >> 3) + (n & 7) * 2) = f2bf(H[i][j][r]);
        }
      }
  }
#undef SSD_PREFETCH
#undef SSD_PARAMS
}

#undef LDS_BARRIER
__device__ void phase_ssd_dft(const Params& p, int bid, int nb, char* smem) {
  for (int t = bid; t < 256; t += nb) ssd_task(p, t, smem);
  int* stile = reinterpret_cast<int*>(smem + 75776);
  for (;;) {
    __syncthreads();
    if (threadIdx.x == 0) *stile = (int)atomicAdd(p.ctr, 1u);
    __syncthreads();
    const int t = *stile;
    if (t >= 4 * 8 * 8) break;
    const int b = t >> 6, tm = (t & 63) >> 3, tn = t & 7;
    const bf16_t* Fb = p.Fs + (size_t)b * 1024 * 2048;
    f32x4 accC[4][4], accS[4][4];
    gemm_mainloop(p.dftm, 2048, Fb, 2048, 1024, tm * 128, tn * 128, accC, smem);
    gemm_mainloop(p.dftm + 1024, 2048, Fb + 1024, 2048, 1024, tm * 128, tn * 128, accS, smem);
    const int lane = threadIdx.x & 63, w = threadIdx.x >> 6, wm = w >> 1, wn = w & 1;
#pragma unroll
    for (int i = 0; i < 4; ++i) {
      int lq_ = lane >> 4, lr_ = lane & 15;
      asm volatile("" : "+v"(lq_), "+v"(lr_));
#pragma unroll
      for (int j = 0; j < 4; ++j) {
        const int k0 = tm * 128 + wm * 64 + i * 16 + lq_ * 4;
        const int ch = tn * 128 + wn * 64 + j * 16 + lr_;
        const float a = bf2f(p.ABt[((size_t)b * 1024 + ch) * 4096 + 1024]);
#pragma unroll
        for (int r = 0; r < 4; ++r) {
          const int k = k0 + r;
          const float as = (k & 1) ? -a : a;
          const float c = accC[i][j][r], sn = accS[i][j][r];
          p.ycat[((size_t)b * L + k) * D + ch] = f2bf(c - sn + as);
          if (k > 0) p.ycat[((size_t)b * L + (L - k)) * D + ch] = f2bf(c + sn + as);
        }
      }
    }
  }
  for (;;) {
    __syncthreads();
    if (threadIdx.x == 0) *stile = (int)atomicAdd(p.ctr + 8, 1u);
    __syncthreads();
    const int q = *stile;
    if (q >= 1024 + 1536) break;
    if (q < 1024) convert_uv_units(p, (size_t)q * 4096, (size_t)(q + 1) * 4096);
    else if (q < 1024 + 1024) { const int q1 = q - 1024; transpose_convert_task(p.w_out, D, 0, D, p.w_out_t, q1 / 32, q1 % 32, reinterpret_cast<float*>(smem)); }
    else { const int q2 = q - 2048; transpose_convert_task(p.w_query, 1024, 0, D, p.w_q_t, q2 / 16, q2 % 16, reinterpret_cast<float*>(smem)); }
  }
}

__device__ void phase_ssm_post(const Params& p, int bid, int nb, char* smem) {
  const int lane = threadIdx.x & 63, w = threadIdx.x >> 6;
  for (int t = bid * 4 + w; t < T; t += nb * 4) {
    float y[4][4];
    float ss0 = 0.f, ss1 = 0.f;
#pragma unroll
    for (int c = 0; c < 4; ++c) {
      const int c0 = c * 256 + lane * 4;
      const int h = c0 >> 6;
      const float dsk = p.d_skip_f[h] + p.d_skip_b[h];
      const uint2 aq = *reinterpret_cast<const uint2*>(reinterpret_cast<const bf16_t*>(p.yf) + (size_t)t * 1024 + c0);
      const uint2 bb = *reinterpret_cast<const uint2*>(reinterpret_cast<const bf16_t*>(p.yb) + (size_t)t * 1024 + c0);
      const float4 a = float4{bflo(aq.x), bfhi(aq.x), bflo(aq.y), bfhi(aq.y)};
      const float4 bq = float4{bflo(bb.x), bfhi(bb.x), bflo(bb.y), bfhi(bb.y)};
      const uint2 xq = *reinterpret_cast<const uint2*>(p.act_tm + (size_t)t * DXBC + c0);
      const uint2 zz = *reinterpret_cast<const uint2*>(p.z + (size_t)t * 1024 + c0);
      y[c][0] = (a.x + bq.x + dsk * bflo(xq.x)) * silu_f(bflo(zz.x));
      y[c][1] = (a.y + bq.y + dsk * bfhi(xq.x)) * silu_f(bfhi(zz.x));
      y[c][2] = (a.z + bq.z + dsk * bflo(xq.y)) * silu_f(bflo(zz.y));
      y[c][3] = (a.w + bq.w + dsk * bfhi(xq.y)) * silu_f(bfhi(zz.y));
      const float q = y[c][0] * y[c][0] + y[c][1] * y[c][1] + y[c][2] * y[c][2] + y[c][3] * y[c][3];
      if (c < 2) ss0 += q; else ss1 += q;
    }
    ss0 = wave_sum_fast(ss0); ss1 = wave_sum_fast(ss1);
    const float r0 = rsqrtf(ss0 * (1.f / 512.f) + EPS), r1 = rsqrtf(ss1 * (1.f / 512.f) + EPS);
    uint2 fq[4];
    float am = 0.f;
#pragma unroll
    for (int c = 0; c < 4; ++c) {
      const int c0 = c * 256 + lane * 4;
      fq[c] = *reinterpret_cast<const uint2*>(p.ycat + (size_t)t * D + c0);
      am = fmaxf(am, fmaxf(fmaxf(fabsf(bflo(fq[c].x)), fabsf(bfhi(fq[c].x))), fmaxf(fabsf(bflo(fq[c].y)), fabsf(bfhi(fq[c].y)))));
      const float rstd = (c < 2) ? r0 : r1;
      const float4 nw = *reinterpret_cast<const float4*>(p.ssm_norm_w + c0);
      y[c][0] *= rstd * nw.x; y[c][1] *= rstd * nw.y; y[c][2] *= rstd * nw.z; y[c][3] *= rstd * nw.w;
      am = fmaxf(am, fmaxf(fmaxf(fabsf(y[c][0]), fabsf(y[c][1])), fmaxf(fabsf(y[c][2]), fabsf(y[c][3]))));
    }
    am = wave_max_fast(am);
    const float inv = (am > 0.f) ? 127.f / am : 0.f;
#pragma unroll
    for (int c = 0; c < 4; ++c) {
      const int c0 = c * 256 + lane * 4;
      *reinterpret_cast<uint32_t*>(p.ycat8 + (size_t)t * D + c0) =
          pack_i8x4(bflo(fq[c].x) * inv, bfhi(fq[c].x) * inv, bflo(fq[c].y) * inv, bfhi(fq[c].y) * inv);
      *reinterpret_cast<uint32_t*>(p.ycat8 + (size_t)t * D + 1024 + c0) = pack_i8x4(y[c][0] * inv, y[c][1] * inv, y[c][2] * inv, y[c][3] * inv);
    }
    if (lane == 0) p.yscale[t] = am * (1.f / 127.f);
  }
  quant_weight_rows_i8(p.w_out_t, p.wo8, p.woscale, D, bid, nb);
}

__device__ void phase_outproj(const Params& p, int bid, int nb, char* smem) {
  const bool aware = (nb & 7) == 0;
  const int start = aware ? (bid >> 3) : bid, step = aware ? (nb >> 3) : nb, end = aware ? 64 : 512;
  const bf16_t* a8 = reinterpret_cast<const bf16_t*>(p.ycat8);
  const bf16_t* b8 = reinterpret_cast<const bf16_t*>(p.wo8);
  for (int it = start; it < end; it += step) {
    const int x = aware ? (bid & 7) : (it >> 6), s_ = aware ? it : (it & 63);
    EpiBf16 epi{reinterpret_cast<bf16_t*>(p.y_x), D};
    gemm_tile_n256<true>(a8, D / 2, b8, D / 2, D / 2, (8 * x + (s_ & 7)) * 128, (s_ >> 3) * 256, epi, smem, p.yscale, p.woscale);
  }
}
__device__ void phase_postmix(const Params& p, int bid, int nb, char* smem) {
  const int lane = threadIdx.x & 63, w = threadIdx.x >> 6;
  for (int t = bid * 4 + w; t < T; t += nb * 4) {
    const int b = t / L;
    float4 y[8];
    float ss = 0.f;
#pragma unroll
    for (int c = 0; c < 8; ++c) {
      {
        const uint2 yq = *reinterpret_cast<const uint2*>(reinterpret_cast<const bf16_t*>(p.y_x) + (size_t)t * D + c * 256 + lane * 4);
        y[c] = float4{bflo(yq.x), bfhi(yq.x), bflo(yq.y), bfhi(yq.y)};
      }
      ss += y[c].x * y[c].x + y[c].y * y[c].y + y[c].z * y[c].z + y[c].w * y[c].w;
    }
    ss = wave_sum_fast(ss);
    const float rstd = rsqrtf(ss * (1.f / D) + EPS);
    const float* gm = p.mod + (size_t)b * NMOD + 2 * D;
    float ss1 = 0.f;
#pragma unroll
    for (int c = 0; c < 8; ++c) {
      const int e0 = c * 256 + lane * 4;
      const float4 xv = *reinterpret_cast<const float4*>(p.x + (size_t)t * D + e0);
      const float4 g4 = *reinterpret_cast<const float4*>(gm + e0), gp = *reinterpret_cast<const float4*>(p.g_post_mix + e0);
      y[c].x = xv.x + g4.x * (y[c].x * rstd * gp.x); y[c].y = xv.y + g4.y * (y[c].y * rstd * gp.y);
      y[c].z = xv.z + g4.z * (y[c].z * rstd * gp.z); y[c].w = xv.w + g4.w * (y[c].w * rstd * gp.w);
      ss1 += y[c].x * y[c].x + y[c].y * y[c].y + y[c].z * y[c].z + y[c].w * y[c].w;
    }
    if (lane == 0) p.partial[t] = rstd;
    ss1 = wave_sum_fast(ss1);
    const float rstd1 = rsqrtf(ss1 * (1.f / D) + EPS);
    const float* sf = p.mod + (size_t)b * NMOD + 3 * D;
    const float* cf = p.mod + (size_t)b * NMOD + 4 * D;
#pragma unroll
    for (int c = 0; c < 8; ++c) {
      const int e0 = c * 256 + lane * 4;
      const float4 g = *reinterpret_cast<const float4*>(p.g_pre_ffn + e0);
      const float4 s4 = *reinterpret_cast<const float4*>(cf + e0), h4 = *reinterpret_cast<const float4*>(sf + e0);
      uint2 pk;
      pk.x = pack2(y[c].x * rstd1 * g.x * (1.f + s4.x) + h4.x, y[c].y * rstd1 * g.y * (1.f + s4.y) + h4.y);
      pk.y = pack2(y[c].z * rstd1 * g.z * (1.f + s4.z) + h4.z, y[c].w * rstd1 * g.w * (1.f + s4.w) + h4.w);
      *reinterpret_cast<uint2*>(p.hx + (size_t)t * D + e0) = pk;
    }
  }
}

__device__ __forceinline__ uint32_t mono_key(float f) {
  uint32_t u = __float_as_uint(f);
  return (u & 0x80000000u) ? ~u : (u | 0x80000000u);
}
__device__ __forceinline__ void ins16(uint32_t (&Lk)[16], uint32_t x) {
#pragma unroll
  for (int i = 0; i < 16; ++i) { uint32_t hi = max(Lk[i], x); x = min(Lk[i], x); Lk[i] = hi; }
}
__device__ __forceinline__ float unmono_key(uint32_t k) {
  return __uint_as_float((k & 0x80000000u) ? (k ^ 0x80000000u) : ~k);
}
typedef __attribute__((ext_vector_type(16))) float f32x16;
__device__ void phase_q_route(const Params& p, int bid, int nb, char* smem) {
  const int tid = opaque_tid(), lane = tid & 63, w = tid >> 6;
  const int wm = w >> 1, wn = w & 1, lr = lane & 15, lq = lane >> 4;
  const int l31 = lane & 31, lh = lane >> 5;
  for (int tile0 = bid; tile0 < 512; tile0 += nb) {
    const int tile = ((nb & 7) == 0 && nb >= 512) ? (((tile0 & 7) * 8 + ((tile0 >> 3) & 7)) * 8 + (tile0 >> 6)) : tile0;
    const int h = tile & 7, m0 = (tile >> 3) * 128;
    {
      f32x4 acc[4][4];
      gemm_mainloop(p.hx, D, p.w_q_t, D, D, m0, h * 128, acc, smem);
#pragma unroll
      for (int i = 0; i < 4; ++i)
#pragma unroll
        for (int j = 0; j < 4; ++j)
#pragma unroll
          for (int r = 0; r < 4; ++r) {
            const int row = wm * 64 + i * 16 + lq * 4 + r, col = wn * 64 + j * 16 + lr;
            *reinterpret_cast<bf16_t*>(smem + swz16(row, col >> 3) + (col & 7) * 2) = f2bf(acc[i][j][r]);
          }
    }
#pragma unroll 4
    for (int r = 0; r < 16; ++r) {
      const int id = tid + 256 * r, row = id >> 4, c4 = id & 15;
      const float* src = ((row < 128) ? p.sk1 : p.sk2) + ((size_t)(h * 128 + (row & 127)) * 64 + c4 * 4);
      const float4 v = *reinterpret_cast<const float4*>(src);
      uint2 pk; pk.x = pack2(v.x, v.y); pk.y = pack2(v.z, v.w);
      *reinterpret_cast<uint2*>(smem + 32768 + swz8(row, c4 >> 1) + (c4 & 1) * 8) = pk;
    }
    __syncthreads();
    uint32_t L1[16], L2[16];
#pragma unroll
    for (int sd = 0; sd < 2; ++sd) {
      uint32_t Lk[16];
#pragma unroll
      for (int i = 0; i < 16; ++i) Lk[i] = 0u;
      const uint32_t kb = (uint32_t)(lh * 4);
#pragma unroll
      for (int ih = 0; ih < 2; ++ih) {
        f32x16 Sa[2];
#pragma unroll
        for (int i = 0; i < 2; ++i)
#pragma unroll
          for (int g2 = 0; g2 < 16; ++g2) Sa[i][g2] = 0.f;
#pragma unroll
        for (int ks = 0; ks < 4; ++ks) {
          const bf16x8 qb = *reinterpret_cast<const bf16x8*>(smem + swz16(w * 32 + l31, sd * 8 + ks * 2 + lh));
#pragma unroll
          for (int i = 0; i < 2; ++i) {
            const bf16x8 ka = *reinterpret_cast<const bf16x8*>(smem + 32768 + swz8(sd * 128 + (ih * 2 + i) * 32 + l31, ks * 2 + lh));
            Sa[i] = __builtin_amdgcn_mfma_f32_32x32x16_bf16(ka, qb, Sa[i], 0, 0, 0);
          }
        }
#pragma unroll
        for (int i = 0; i < 2; ++i)
#pragma unroll
          for (int g2 = 0; g2 < 16; ++g2)
            ins16(Lk, (mono_key(Sa[i][g2]) & ~0x7Fu) | (uint32_t)((ih * 2 + i) * 32 + (g2 & 3) + 8 * (g2 >> 2)) | kb);
      }
#pragma unroll
      for (int i = 0; i < 8; ++i) {
        const uint32_t t1 = (uint32_t)__shfl_xor((int)Lk[15 - i], 32), t2 = (uint32_t)__shfl_xor((int)Lk[i], 32);
        Lk[i] = max(Lk[i], t1); Lk[15 - i] = max(Lk[15 - i], t2);
      }
#pragma unroll
      for (int dd = 8; dd >= 1; dd >>= 1)
#pragma unroll
        for (int i = 0; i < 16; ++i)
          if ((i & dd) == 0) { const uint32_t hi = max(Lk[i], Lk[i + dd]), lo = min(Lk[i], Lk[i + dd]); Lk[i] = hi; Lk[i + dd] = lo; }
#pragma unroll
      for (int r = 0; r < 16; ++r) { if (sd == 0) L1[r] = Lk[r]; else L2[r] = Lk[r]; }
    }
    __syncthreads();
    uint32_t* ib = reinterpret_cast<uint32_t*>(smem) + w * 1088 + l31 * 34;
    if (lh == 0) {
#pragma unroll
      for (int r = 0; r < 16; ++r) { ib[r] = L1[r] & 127u; ib[16 + r] = L2[r] & 127u; }
    }
    float v1[16], v2[16];
#pragma unroll
    for (int r = 0; r < 16; ++r) { v1[r] = unmono_key(L1[r] & ~0x7Fu); v2[r] = unmono_key(L2[r] & ~0x7Fu); }
    uint32_t C[16];
#pragma unroll
    for (int i = 0; i < 16; ++i) C[i] = 0u;
#pragma unroll
    for (int a = 0; a < 16; ++a)
#pragma unroll
      for (int bq = 0; bq < 16; ++bq)
        if ((a + 1) * (bq + 1) <= 16) ins16(C, (mono_key(v1[a] + v2[bq]) & ~0xFFu) | (uint32_t)(a * 16 + bq));
    float ts[16]; int te[16];
    __builtin_amdgcn_wave_barrier();
#pragma unroll
    for (int r = 0; r < 16; ++r) {
      const uint32_t code = C[r] & 0xFFu;
      te[r] = (int)(ib[code >> 4] * 128u + ib[16 + (code & 15u)]);
      ts[r] = unmono_key(C[r] & ~0xFFu);
    }
    const float mx = ts[0];
    float den = 0.f;
#pragma unroll
    for (int r = 0; r < 16; ++r) { ts[r] = __expf(ts[r] - mx); den += ts[r]; }
    const float inv = 1.f / den;
    const size_t ob = (size_t)(m0 + w * 32 + l31) * 128 + h * 16;
    if (lh == 0) {
#pragma unroll
      for (int r = 0; r < 16; r += 4) *reinterpret_cast<int4*>(p.idx + ob + r) = int4{te[r], te[r + 1], te[r + 2], te[r + 3]};
    } else {
#pragma unroll
      for (int r = 0; r < 16; r += 4)
        *reinterpret_cast<float4*>(p.gate + ob + r) = float4{ts[r] * inv, ts[r + 1] * inv, ts[r + 2] * inv, ts[r + 3] * inv};
    }
    __syncthreads();
  }
}

typedef __attribute__((ext_vector_type(2))) float f32x2;
__device__ __forceinline__ void fp8x16_to_f32(const uint4 q, f32x2 (&o)[8]) {
  o[0] = __builtin_amdgcn_cvt_pk_f32_fp8((int)q.x, false); o[1] = __builtin_amdgcn_cvt_pk_f32_fp8((int)q.x, true);
  o[2] = __builtin_amdgcn_cvt_pk_f32_fp8((int)q.y, false); o[3] = __builtin_amdgcn_cvt_pk_f32_fp8((int)q.y, true);
  o[4] = __builtin_amdgcn_cvt_pk_f32_fp8((int)q.z, false); o[5] = __builtin_amdgcn_cvt_pk_f32_fp8((int)q.z, true);
  o[6] = __builtin_amdgcn_cvt_pk_f32_fp8((int)q.w, false); o[7] = __builtin_amdgcn_cvt_pk_f32_fp8((int)q.w, true);
}
__device__ __forceinline__ unsigned my_xcc_id() { return (unsigned)__builtin_amdgcn_s_getreg((3 << 11) | 20) & 7u; }

__device__ void phase_exp_u(const Params& p, char* smem) {
  const int tid = opaque_tid(), lane = tid & 63, w = tid >> 6;
  const int sub = lane >> 4, cc = lane & 15;
  const unsigned myx = my_xcc_id();
  int* sh = reinterpret_cast<int*>(smem);
  int* si = reinterpret_cast<int*>(smem + 64) + w * 256;
  float* pbuf = reinterpret_cast<float*>(p.ycat);
  {
    unsigned qcur = 0;
    for (;;) {
      __syncthreads();
      if (tid == 0) {
        int found = -1; unsigned fx = 0;
        for (; qcur < 8; ++qcur) {
          fx = (myx + qcur) & 7u;
          const int c = (int)atomicAdd(&p.ctr[16 + fx], 1u);
          if (c < 256) { found = c; break; }
        }
        sh[0] = found; sh[1] = (int)fx;
      }
      __syncthreads();
      const int chunk = sh[0];
      const unsigned x = (unsigned)sh[1];
      if (chunk < 0) break;
      for (int tt = 0; tt < 8; ++tt) {
        const int t = chunk * 32 + w * 8 + tt;
        __builtin_amdgcn_wave_barrier();
        si[lane] = p.idx[(size_t)t * 128 + lane]; si[64 + lane] = p.idx[(size_t)t * 128 + 64 + lane];
        __builtin_amdgcn_wave_barrier();
        f32x2 hf[8];
#pragma unroll
        for (int q2 = 0; q2 < 2; ++q2) {
          const uint4 hq = *reinterpret_cast<const uint4*>(p.hx + (size_t)t * D + x * 256 + cc * 16 + q2 * 8);
          hf[q2 * 4 + 0] = f32x2{bflo(hq.x), bfhi(hq.x)}; hf[q2 * 4 + 1] = f32x2{bflo(hq.y), bfhi(hq.y)};
          hf[q2 * 4 + 2] = f32x2{bflo(hq.z), bfhi(hq.z)}; hf[q2 * 4 + 3] = f32x2{bflo(hq.w), bfhi(hq.w)};
        }
        const uint8_t* ub = p.U8 + (size_t)x * ((size_t)16384 * 256) + cc * 16;
        uint4 qa[8], qb[8];
#define EU_LOAD(q_, bt_) _Pragma("unroll") for (int k = 0; k < 8; ++k) q_[k] = *reinterpret_cast<const uint4*>(ub + (size_t)si[((bt_) * 8 + k) * 4 + sub] * 256)
#define EU_COMP(q_, kb_)                                                                                                \
  _Pragma("unroll") for (int k = 0; k < 8; ++k) {                                                                       \
    f32x2 uf[8];                                                                                                        \
    fp8x16_to_f32(q_[k], uf);                                                                                           \
    f32x2 d2 = hf[0] * uf[0];                                                                                           \
    _Pragma("unroll") for (int e = 1; e < 8; ++e) d2 += hf[e] * uf[e];                                                  \
    float d = d2.x + d2.y;                                                                                              \
    d += dpp_mov<0xB1>(d); d += dpp_mov<0x4E>(d); d += dpp_mov<0x124>(d); d += dpp_mov<0x128>(d);                       \
    mine = (cc == (kb_) + k) ? d : mine;                                                                                \
  }
        float mine = 0.f;
        EU_LOAD(qa, 0); EU_LOAD(qb, 1);
        EU_COMP(qa, 0); EU_LOAD(qa, 2);
        EU_COMP(qb, 8); EU_LOAD(qb, 3);
        pbuf[((size_t)x * T + t) * 128 + cc * 4 + sub] = mine * (1.f / 512.f);
        mine = 0.f;
        EU_COMP(qa, 0);
        EU_COMP(qb, 8);
        pbuf[((size_t)x * T + t) * 128 + (16 + cc) * 4 + sub] = mine * (1.f / 512.f);
#undef EU_LOAD
#undef EU_COMP
      }
    }
  }
}

__device__ void phase_exp_v(const Params& p, char* smem) {
  const int tid = opaque_tid(), lane = tid & 63, w = tid >> 6;
  const int sub = lane >> 4, cc = lane & 15;
  const unsigned myx = my_xcc_id();
  int* sh = reinterpret_cast<int*>(smem);
  int* si = reinterpret_cast<int*>(smem + 64) + w * 256;
  float* sc = reinterpret_cast<float*>(si + 128);
  bf16_t* yfb = reinterpret_cast<bf16_t*>(p.y_x) + (size_t)T * D;
  {
    unsigned qcur = 0;
    for (;;) {
      __syncthreads();
      if (tid == 0) {
        int found = -1; unsigned fx = 0;
        for (; qcur < 8; ++qcur) {
          fx = (myx + qcur) & 7u;
          const int c = (int)atomicAdd(&p.ctr[32 + fx], 1u);
          if (c < 256) { found = c; break; }
        }
        sh[0] = found; sh[1] = (int)fx;
      }
      __syncthreads();
      const int chunk = sh[0];
      const unsigned x = (unsigned)sh[1];
      if (chunk < 0) break;
      for (int tt = 0; tt < 8; ++tt) {
        const int t = chunk * 32 + w * 8 + tt;
        __builtin_amdgcn_wave_barrier();
        si[lane] = p.idx[(size_t)t * 128 + lane]; si[64 + lane] = p.idx[(size_t)t * 128 + 64 + lane];
        {
          const float* pb = reinterpret_cast<const float*>(p.ycat) + (size_t)t * 128;
          float d0 = 0.f, d1 = 0.f;
#pragma unroll
          for (int xs = 0; xs < 8; ++xs) { d0 += pb[(size_t)xs * T * 128 + lane]; d1 += pb[(size_t)xs * T * 128 + 64 + lane]; }
          sc[lane] = p.gate[(size_t)t * 128 + lane] * 0.5f * d0 * (1.f + erff(d0 * 0.70710678118654752f));
          sc[64 + lane] = p.gate[(size_t)t * 128 + 64 + lane] * 0.5f * d1 * (1.f + erff(d1 * 0.70710678118654752f));
        }
        __builtin_amdgcn_wave_barrier();
        f32x2 acc[8];
#pragma unroll
        for (int e = 0; e < 8; ++e) acc[e] = f32x2{0.f, 0.f};
        const uint8_t* vb = p.V8 + (size_t)x * ((size_t)16384 * 256) + cc * 16;
        uint4 qa[8], qb[8];
#define EV_LOAD(q_, bt_) _Pragma("unroll") for (int k = 0; k < 8; ++k) q_[k] = *reinterpret_cast<const uint4*>(vb + (size_t)si[((bt_) * 8 + k) * 4 + sub] * 256)
#define EV_COMP(q_, bt_)                                                                                                \
  _Pragma("unroll") for (int k = 0; k < 8; ++k) {                                                                       \
    f32x2 vf[8];                                                                                                        \
    fp8x16_to_f32(q_[k], vf);                                                                                           \
    const float cfk = sc[((bt_) * 8 + k) * 4 + sub];                                                                    \
    const f32x2 c2 = f32x2{cfk, cfk};                                                                                   \
    _Pragma("unroll") for (int e = 0; e < 8; ++e) acc[e] += c2 * vf[e];                                                 \
  }
        EV_LOAD(qa, 0); EV_LOAD(qb, 1);
        EV_COMP(qa, 0); EV_LOAD(qa, 2);
        EV_COMP(qb, 1); EV_LOAD(qb, 3);
        EV_COMP(qa, 2);
        EV_COMP(qb, 3);
#undef EV_LOAD
#undef EV_COMP
        {
          float* red = reinterpret_cast<float*>(smem + 8192) + w * 1280;
          float* mr = red + (sub * 16 + cc) * 20;
#pragma unroll
          for (int q4 = 0; q4 < 4; ++q4)
            *reinterpret_cast<float4*>(mr + q4 * 4) = float4{acc[q4 * 2].x, acc[q4 * 2].y, acc[q4 * 2 + 1].x, acc[q4 * 2 + 1].y};
          __builtin_amdgcn_wave_barrier();
          const int part = sub;
          float4 r0 = *reinterpret_cast<const float4*>(red + (0 * 16 + cc) * 20 + part * 4);
          float4 r1 = *reinterpret_cast<const float4*>(red + (1 * 16 + cc) * 20 + part * 4);
          float4 r2 = *reinterpret_cast<const float4*>(red + (2 * 16 + cc) * 20 + part * 4);
          float4 r3 = *reinterpret_cast<const float4*>(red + (3 * 16 + cc) * 20 + part * 4);
          const float sc512 = 1.f / 512.f;
          uint2 o4;
          o4.x = pack2((r0.x + r1.x + r2.x + r3.x) * sc512, (r0.y + r1.y + r2.y + r3.y) * sc512);
          o4.y = pack2((r0.z + r1.z + r2.z + r3.z) * sc512, (r0.w + r1.w + r2.w + r3.w) * sc512);
          *reinterpret_cast<uint2*>(yfb + (size_t)t * D + x * 256 + cc * 16 + part * 4) = o4;
          __builtin_amdgcn_wave_barrier();
        }
      }
    }
  }
}

__device__ void phase_exp_final(const Params& p, int bid, int nb, char* smem) {
  const int lane = threadIdx.x & 63, w = threadIdx.x >> 6;
  const bf16_t* ymix = reinterpret_cast<const bf16_t*>(p.y_x);
  const bf16_t* yf = reinterpret_cast<const bf16_t*>(p.y_x) + (size_t)T * D;
  for (int t = bid * 4 + w; t < T; t += nb * 4) {
    const int b = t / L;
    float4 y[8], xo[8];
#pragma unroll
    for (int c = 0; c < 8; ++c) {
      const uint2 yq = *reinterpret_cast<const uint2*>(yf + (size_t)t * D + c * 256 + lane * 4);
      y[c] = float4{bflo(yq.x), bfhi(yq.x), bflo(yq.y), bfhi(yq.y)};
      xo[c] = *reinterpret_cast<const float4*>(p.x + (size_t)t * D + c * 256 + lane * 4);
    }
    const float rmix = p.partial[t];
    float ss = 0.f;
#pragma unroll
    for (int c = 0; c < 8; ++c) ss += y[c].x * y[c].x + y[c].y * y[c].y + y[c].z * y[c].z + y[c].w * y[c].w;
    ss = wave_sum_fast(ss);
    const float rstd = rsqrtf(ss * (1.f / D) + EPS);
    const float* gfx = p.mod + (size_t)b * NMOD + 5 * D;
    const float* gm = p.mod + (size_t)b * NMOD + 2 * D;
#pragma unroll
    for (int c = 0; c < 8; ++c) {
      const int e0 = c * 256 + lane * 4;
      const uint2 mq = *reinterpret_cast<const uint2*>(ymix + (size_t)t * D + e0);
      const float4 m4 = float4{bflo(mq.x), bfhi(mq.x), bflo(mq.y), bfhi(mq.y)};
      const float4 g4 = *reinterpret_cast<const float4*>(gfx + e0), gp = *reinterpret_cast<const float4*>(p.g_post_ffn + e0);
      const float4 h4 = *reinterpret_cast<const float4*>(gm + e0), hp = *reinterpret_cast<const float4*>(p.g_post_mix + e0);
      xo[c].x += h4.x * (m4.x * rmix * hp.x) + g4.x * (y[c].x * rstd * gp.x);
      xo[c].y += h4.y * (m4.y * rmix * hp.y) + g4.y * (y[c].y * rstd * gp.y);
      xo[c].z += h4.z * (m4.z * rmix * hp.z) + g4.z * (y[c].z * rstd * gp.z);
      xo[c].w += h4.w * (m4.w * rmix * hp.w) + g4.w * (y[c].w * rstd * gp.w);
      *reinterpret_cast<float4*>(p.out + (size_t)t * D + e0) = xo[c];
    }
  }
}

#define XB_TMO      128
#define XB_XCNT(j)  (256  + 64 * (j))
#define XB_XSUB(j)  (1280 + 64 * (j))
#define XB_XGEN(j)  (2304 + 64 * (j))
#define XB_TOP      3328
#define XB_TOPGEN   3392
#define XCD_BAR_WORDS 3456
#define XB_SPIN_CAP (1u << 22)
#define LAS __attribute__((address_space(3)))
__device__ __forceinline__ unsigned xb_ld(unsigned* p)              { return __hip_atomic_load(p, __ATOMIC_RELAXED, __HIP_MEMORY_SCOPE_AGENT); }
__device__ __forceinline__ unsigned xb_add(unsigned* p, unsigned v) { return __hip_atomic_fetch_add(p, v, __ATOMIC_RELAXED, __HIP_MEMORY_SCOPE_AGENT); }
__device__ __forceinline__ unsigned xb_xcc_id() { return (unsigned)__builtin_amdgcn_s_getreg((3 << 11) | 20) & 0xFu; }
#define XB_SPIN(cond, bar) do { unsigned _sp = 0; while (cond) { __builtin_amdgcn_s_sleep(1); \
    if ((++_sp & 255u) == 0u) { if (xb_ld(&(bar)[XB_TMO])) break; if (_sp > XB_SPIN_CAP) { atomicAdd(&(bar)[XB_TMO], 1u); break; } } } } while (0)
struct XcdBarrier { unsigned* bar; unsigned x; volatile LAS unsigned* st; };
__device__ __forceinline__ XcdBarrier xcd_barrier_post(unsigned* bar, volatile LAS unsigned* st) {
  XcdBarrier b; b.bar = bar; b.x = xb_xcc_id(); b.st = st;
  if (threadIdx.x == 0) (void)xb_add(&bar[XB_XCNT(b.x)], 1u);
  return b;
}
__device__ __forceinline__ void xcd_barrier_complete(unsigned* bar, unsigned x, unsigned& nloc, unsigned& nx) {
  const unsigned G = gridDim.x * gridDim.y * gridDim.z;
  unsigned sum, cnt, mine, sp = 0u;
  for (;;) {
    sum = 0u; cnt = 0u; mine = 0u;
#pragma unroll
    for (unsigned j = 0; j < 16; ++j) { const unsigned c = xb_ld(&bar[XB_XCNT(j)]); sum += c; cnt += (c > 0u) ? 1u : 0u; mine = (j == x) ? c : mine; }
    if (sum == G) break;
    __builtin_amdgcn_s_sleep(1);
    if ((++sp & 255u) == 0u) { if (xb_ld(&bar[XB_TMO])) break; if (sp > XB_SPIN_CAP) { atomicAdd(&bar[XB_TMO], 1u); break; } }
  }
  nloc = mine > 0u ? mine : 1u; nx = cnt > 0u ? cnt : 1u;
}
__device__ __forceinline__ void xcd_barrier(const XcdBarrier& b) {
  asm volatile("s_waitcnt vmcnt(0)" ::: "memory");
  __syncthreads();
  if (threadIdx.x == 0) {
    unsigned* bar = b.bar;
    __builtin_amdgcn_s_waitcnt(0);
    unsigned nloc = b.st[0], nx = b.st[1];
    if (nloc == 0u) { xcd_barrier_complete(bar, b.x, nloc, nx); b.st[0] = nloc; b.st[1] = nx; }
    const unsigned old = xb_add(&bar[XB_XSUB(b.x)], 1u);
    const unsigned gen = old / nloc;
    if (old + 1u == (gen + 1u) * nloc) {
      __builtin_amdgcn_fence(__ATOMIC_RELEASE, "agent");
      asm volatile("s_waitcnt vmcnt(0)" ::: "memory");
      const unsigned og = xb_add(&bar[XB_TOP], 1u);
      const unsigned tg = og / nx;
      if (og + 1u == (tg + 1u) * nx) xb_add(&bar[XB_TOPGEN], 1u);
      else XB_SPIN(xb_ld(&bar[XB_TOPGEN]) == tg, bar);
      __builtin_amdgcn_fence(__ATOMIC_ACQUIRE, "agent");
      xb_add(&bar[XB_XGEN(b.x)], 1u);
      asm volatile("s_waitcnt vmcnt(0)" ::: "memory");
    } else {
      XB_SPIN(xb_ld(&bar[XB_XGEN(b.x)]) == gen, bar);
      __builtin_amdgcn_fence(__ATOMIC_ACQUIRE, "agent");
      asm volatile("s_waitcnt vmcnt(0)" ::: "memory");
    }
  }
  __syncthreads();
}

__global__ void __launch_bounds__(NTHREADS, 2) fwd_mega(Params p) {
  __shared__ __attribute__((aligned(16))) char smem[75808];
  const int bid = blockIdx.x, nb = gridDim.x;
  volatile LAS unsigned* st = (volatile LAS unsigned*)(smem + 75792);
  if (threadIdx.x == 0) { st[0] = 0u; st[1] = 0u; }
  __syncthreads();
  const XcdBarrier bar = xcd_barrier_post(p.bar, st);
  phase_prep(p, bid, nb, smem);        xcd_barrier(bar);
  phase_fold(p, bid, nb, smem);        xcd_barrier(bar);
  phase_norm_mod(p, bid, nb, smem);    xcd_barrier(bar);
  phase_inproj(p, bid, nb, smem);      xcd_barrier(bar);
  phase_ssm_pre(p, bid, nb, smem);     xcd_barrier(bar);
  phase_ssd_dft(p, bid, nb, smem);     xcd_barrier(bar);
  phase_ssm_post(p, bid, nb, smem);    xcd_barrier(bar);
  phase_outproj(p, bid, nb, smem);     xcd_barrier(bar);
  phase_postmix(p, bid, nb, smem);     xcd_barrier(bar);
  phase_q_route(p, bid, nb, smem);     xcd_barrier(bar);
  phase_exp_u(p, smem);                xcd_barrier(bar);
  phase_exp_v(p, smem);                xcd_barrier(bar);
  phase_exp_final(p, bid, nb, smem);
}

}

extern "C" void kernel_launch(void* const* d_in, const int* in_sizes, int n_in, void* d_out, int out_size, void* d_ws,
                              size_t ws_size, hipStream_t stream) {
  Params p{};
  const float** fp = reinterpret_cast<const float**>(&p);
  for (int i = 0; i < 27; ++i) fp[i] = (const float*)d_in[i];
  p.out = (float*)d_out;
  char* ws = (char*)d_ws;
  size_t off = 0;
  auto take = [&](size_t bytes) { char* r = ws + off; off += (bytes + 255) & ~(size_t)255; return r; };
  p.U8 = (uint8_t*)take((size_t)16384 * D);
  p.V8 = (uint8_t*)take((size_t)16384 * D);
  p.hx8a = (int8_t*)take((size_t)T * D);
  p.w8 = (int8_t*)take((size_t)4096 * D);
  p.ascale = (float*)take((size_t)T * 4);
  p.wscale = (float*)take((size_t)4096 * 4);
  p.ycat8 = (int8_t*)take((size_t)T * D);
  p.wo8 = (int8_t*)take((size_t)D * D);
  p.yscale = (float*)take((size_t)T * 4);
  p.woscale = (float*)take((size_t)D * 4);
  p.w_in_t = (bf16_t*)take((size_t)NPROJ * D * 2);
  p.w_out_t = (bf16_t*)take((size_t)D * D * 2);
  p.w_q_t = (bf16_t*)take((size_t)1024 * D * 2);
  p.w_in_f = (bf16_t*)take((size_t)D * 1024 * 2);
  p.WcsT = (bf16_t*)take((size_t)4 * 512 * 256 * 2);
  p.dftm = (bf16_t*)take((size_t)1024 * 2048 * 2);
  p.Fs = (bf16_t*)take((size_t)NB * 1024 * 2048 * 2);
  p.partial = (float*)take((size_t)KSPLIT * 5 * NMOD * 4);
  p.mod = (float*)take((size_t)5 * NMOD * 4);
  p.hx = (bf16_t*)take((size_t)T * D * 2);
  p.hc = (bf16_t*)take((size_t)TC * D * 2);
  p.ABt = (bf16_t*)take((size_t)NB * 1024 * 4096 * 2);
  p.q = (float*)p.ABt;
  p.z = (bf16_t*)take((size_t)T * 1024 * 2);
  char* r1 = take(0);
  p.xbcraw = (bf16_t*)take((size_t)T * DXBC * 4);
  p.xbcraw_c = (bf16_t*)take((size_t)TC * DXBC * 4);
  p.act_tm = (bf16_t*)take((size_t)(T + TC) * DXBC * 2);
  p.act_cm_x = (bf16_t*)take((size_t)NB * 1280 * L * 2);
  p.act_cm_c = (bf16_t*)take((size_t)NB * 1280 * CTX * 2);
  p.y_x = (float*)r1;
  p.dtraw = (float*)take((size_t)T * 32 * 4);
  p.dtraw_c = (float*)take((size_t)TC * 32 * 4);
  p.dtf = (float*)take((size_t)T * 16 * 4);
  p.dtb = (float*)take((size_t)T * 16 * 4);
  p.dtf_c = (float*)take((size_t)TC * 16 * 4);
  p.dtb_c = (float*)take((size_t)TC * 16 * 4);
  p.yf = (float*)take((size_t)T * 1024 * 4);
  p.yb = (float*)take((size_t)T * 1024 * 4);
  p.ctr = (unsigned*)take(256);
  p.bar = (unsigned*)take((size_t)XCD_BAR_WORDS * 4);
  p.ycat = (bf16_t*)take((size_t)T * D * 2);
  p.idx = (int*)take((size_t)T * 128 * 4);
  p.gate = (float*)take((size_t)T * 128 * 4);
  if (off > ws_size) { fprintf(stderr, "kernel_launch: workspace too small: need %zu have %zu\n", off, ws_size); return; }
  static int grid_blocks = 0;
  if (!grid_blocks) {
    int dev = 0, cus = 0, per_cu = 0;
    hipGetDevice(&dev);
    hipDeviceGetAttribute(&cus, hipDeviceAttributeMultiprocessorCount, dev);
    hipOccupancyMaxActiveBlocksPerMultiprocessor(&per_cu, fwd_mega, NTHREADS, 0);
    if (per_cu > 2) per_cu = 2;
    grid_blocks = cus * per_cu;
    if (grid_blocks <= 0) { fprintf(stderr, "kernel_launch: occupancy query gave %d x %d\n", cus, per_cu); grid_blocks = -1; }
  }
  if (grid_blocks < 0) return;
  (void)hipMemsetAsync(p.bar, 0, (size_t)XCD_BAR_WORDS * 4, stream);
  void* args[] = {&p};
  hipError_t e = hipLaunchCooperativeKernel((void*)fwd_mega, dim3(grid_blocks), dim3(NTHREADS), args, 0, stream);
  if (e != hipSuccess) fprintf(stderr, "cooperative launch failed: %s (grid %d)\n", hipGetErrorString(e), grid_blocks);
}
```

```cpp
#include <hip/hip_runtime.h>
#include <hip/hip_cooperative_groups.h>
#include <stdint.h>
#include <stdio.h>

namespace cg = cooperative_groups;
namespace {

typedef __attribute__((ext_vector_type(8))) short bf16x8;
typedef __attribute__((ext_vector_type(4))) float f32x4;
typedef unsigned short bf16_t;

constexpr int D = 2048, NB = 4, L = 2048, T = NB * L, CTX = 256, TC = NB * CTX;
constexpr int NMOD = 6 * D;
constexpr int NH = 16, HP = 64, NS = 128, DXBC = 1536;
constexpr int DIN = 3616;
constexpr int NPROJ = 4736;
constexpr int KSPLIT = 32;
constexpr float EPS = 1e-6f;
constexpr int NTHREADS = 256;

__device__ __forceinline__ bf16_t f2bf(float f) { __bf16 h = (__bf16)f; return __builtin_bit_cast(unsigned short, h); }
__device__ __forceinline__ float bf2f(bf16_t h) { return __uint_as_float(((uint32_t)h) << 16); }
__device__ __forceinline__ uint32_t pack2(float a, float b) {
  typedef __attribute__((ext_vector_type(2))) __bf16 bf16x2_t;
  typedef __attribute__((ext_vector_type(2))) float f32x2_t;
  const f32x2_t v = {a, b};
  return __builtin_bit_cast(uint32_t, __builtin_convertvector(v, bf16x2_t));
}
__device__ __forceinline__ float bflo(uint32_t w) { return __uint_as_float(w << 16); }
__device__ __forceinline__ float bfhi(uint32_t w) { return __uint_as_float(w & 0xffff0000u); }
__device__ __forceinline__ float silu_f(float v) { return v / (1.f + __expf(-v)); }
__device__ __forceinline__ float softplus_f(float v) { return v > 20.f ? v : log1pf(__expf(v)); }

__device__ __forceinline__ int opaque_tid() { int t = threadIdx.x; asm volatile("" : "+v"(t)); return t; }
__device__ __forceinline__ float wave_sum(float v) {
#pragma unroll
  for (int o = 32; o > 0; o >>= 1) v += __shfl_xor(v, o);
  return v;
}
template <int CTRL>
__device__ __forceinline__ float dpp_mov(float v) {
  return __int_as_float(__builtin_amdgcn_update_dpp(0, __float_as_int(v), CTRL, 0xF, 0xF, true));
}
__device__ __forceinline__ float wave_sum_fast(float v) {
  v += dpp_mov<0xB1>(v); v += dpp_mov<0x4E>(v); v += dpp_mov<0x124>(v); v += dpp_mov<0x128>(v);
  v += __shfl_xor(v, 16); v += __shfl_xor(v, 32);
  return v;
}
__device__ __forceinline__ float wave_max(float v) {
#pragma unroll
  for (int o = 32; o > 0; o >>= 1) v = fmaxf(v, __shfl_xor(v, o));
  return v;
}
__device__ __forceinline__ float block_sum(float v, float* red) {
  v = wave_sum(v);
  __syncthreads();
  if ((threadIdx.x & 63) == 0) red[threadIdx.x >> 6] = v;
  __syncthreads();
  return red[0] + red[1] + red[2] + red[3];
}

struct Params {
  const float *x, *c, *ctx, *c_ctx, *w_mod, *b_mod, *g_pre_mix, *g_post_mix, *g_pre_ffn, *g_post_ffn;
  const float *w_in, *w_fmix, *conv_w, *conv_b, *dt_bias_f, *dt_bias_b, *a_log_f, *a_log_b, *d_skip_f, *d_skip_b;
  const float *ssm_norm_w, *w_out, *w_query, *sk1, *sk2, *eu, *ev;
  float* out;
  uint8_t *U8, *V8;
  int8_t *hx8a, *w8;
  float *ascale, *wscale;
  int8_t *ycat8, *wo8;
  float *yscale, *woscale;
  bf16_t *w_in_t, *w_out_t, *w_q_t, *w_in_f, *WcsT, *dftm, *Fs;
  float *partial, *mod;
  bf16_t *hx, *hc, *ABt, *z;
  bf16_t *xbcraw, *xbcraw_c;
  float *dtraw, *dtraw_c, *dtf, *dtb, *dtf_c, *dtb_c;
  bf16_t *act_tm, *act_cm_x, *act_cm_c;
  float *yf, *yb;
  unsigned* ctr; unsigned* bar;
  bf16_t* ycat;
  float *y_x, *q, *gate;
  int* idx;
  int pad0, pad1;
};

template <bool I8 = false>
__device__ __forceinline__ void gemm_mainloop(const bf16_t* __restrict__ A, int lda, const bf16_t* __restrict__ Bt, int ldb,
                                              int K, int m0, int n0, f32x4 (&acc)[4][4], char* smem) {
  const int tid = opaque_tid(), lane = tid & 63, w = tid >> 6;
  const int wm = w >> 1, wn = w & 1;
#pragma unroll
  for (int i = 0; i < 4; ++i)
#pragma unroll
    for (int j = 0; j < 4; ++j) acc[i][j] = f32x4{0.f, 0.f, 0.f, 0.f};

  const int nk = K / 64;
  const int rowoff = lane >> 3, lch = (lane & 7) ^ rowoff;
  const bf16_t* gA = A + (size_t)(m0 + w * 8 + rowoff) * lda + lch * 8;
  const bf16_t* gB = Bt + (size_t)(n0 + w * 8 + rowoff) * ldb + lch * 8;
#define GSTAGE(buf_, kt_)                                                                                               \
  do {                                                                                                                  \
    _Pragma("unroll") for (int i_ = 0; i_ < 4; ++i_) {                                                                  \
      __builtin_amdgcn_global_load_lds((const unsigned*)(gA + (size_t)(i_ * 32) * lda + (kt_) * 64),                    \
                                       (unsigned*)(smem + (buf_) * 32768 + (i_ * 4 + w) * 1024), 16, 0, 0);             \
      __builtin_amdgcn_global_load_lds((const unsigned*)(gB + (size_t)(i_ * 32) * ldb + (kt_) * 64),                    \
                                       (unsigned*)(smem + (buf_) * 32768 + 16384 + (i_ * 4 + w) * 1024), 16, 0, 0);     \
    }                                                                                                                   \
  } while (0)
  GSTAGE(0, 0);
  asm volatile("s_waitcnt vmcnt(0)" ::: "memory");
  __syncthreads();
  for (int kt = 0; kt < nk; ++kt) {
    const int cur = kt & 1;
    if (kt + 1 < nk) GSTAGE(cur ^ 1, kt + 1);
    const char* sA = smem + cur * 32768;
    const char* sB = sA + 16384;
#pragma unroll
    for (int kk = 0; kk < 2; ++kk) {
      bf16x8 af[4], bfr[4];
      const int ch = kk * 4 + (lane >> 4);
#pragma unroll
      for (int i = 0; i < 4; ++i) {
        int row = wm * 64 + i * 16 + (lane & 15);
        af[i] = *reinterpret_cast<const bf16x8*>(sA + row * 128 + ((ch ^ (row & 7)) << 4));
        int col = wn * 64 + i * 16 + (lane & 15);
        bfr[i] = *reinterpret_cast<const bf16x8*>(sB + col * 128 + ((ch ^ (col & 7)) << 4));
      }
#pragma unroll
      for (int i = 0; i < 4; ++i)
#pragma unroll
        for (int j = 0; j < 4; ++j) {
          if (I8) {
            typedef __attribute__((ext_vector_type(4))) int i32x4;
            acc[i][j] = __builtin_bit_cast(f32x4, __builtin_amdgcn_mfma_i32_16x16x64_i8(__builtin_bit_cast(i32x4, af[i]), __builtin_bit_cast(i32x4, bfr[j]),
                                                                                         __builtin_bit_cast(i32x4, acc[i][j]), 0, 0, 0));
          } else {
            acc[i][j] = __builtin_amdgcn_mfma_f32_16x16x32_bf16(af[i], bfr[j], acc[i][j], 0, 0, 0);
          }
        }
    }
    asm volatile("s_waitcnt vmcnt(0)" ::: "memory");
    __syncthreads();
  }
#undef GSTAGE
}

template <bool I8 = false, class Epi>
__device__ __forceinline__ void gemm_tile(const bf16_t* __restrict__ A, int lda, const bf16_t* __restrict__ Bt, int ldb,
                                          int K, int m0, int n0, const Epi& epi, char* smem,
                                          const float* __restrict__ rscale = nullptr, const float* __restrict__ cscale = nullptr) {
  const int lane = threadIdx.x & 63, w = threadIdx.x >> 6;
  const int wm = w >> 1, wn = w & 1;
  f32x4 acc[4][4];
  gemm_mainloop<I8>(A, lda, Bt, ldb, K, m0, n0, acc, smem);
#pragma unroll
  for (int i = 0; i < 4; ++i) {
    const int row = m0 + wm * 64 + i * 16 + (lane >> 4) * 4;
    float4 rs = float4{1.f, 1.f, 1.f, 1.f};
    if (I8) rs = *reinterpret_cast<const float4*>(rscale + row);
#pragma unroll
    for (int j = 0; j < 4; ++j) {
      const int col = n0 + wn * 64 + j * 16 + (lane & 15);
      if (I8) {
        typedef __attribute__((ext_vector_type(4))) int i32x4;
        const i32x4 ia = __builtin_bit_cast(i32x4, acc[i][j]);
        const float cs = cscale[col];
        epi(row, col, f32x4{(float)ia[0] * rs.x * cs, (float)ia[1] * rs.y * cs, (float)ia[2] * rs.z * cs, (float)ia[3] * rs.w * cs});
      } else {
        epi(row, col, acc[i][j]);
      }
    }
  }
}

template <bool I8>
__device__ __forceinline__ void gemm_mainloop_n256(const bf16_t* __restrict__ A, int lda, const bf16_t* __restrict__ Bt, int ldb,
                                                   int K, int m0, int n0, f32x4 (&acc)[4][8], char* smem) {
  const int tid = opaque_tid(), lane = tid & 63, w = tid >> 6;
  const int wm = w >> 1, wn = w & 1;
#pragma unroll
  for (int i = 0; i < 4; ++i)
#pragma unroll
    for (int j = 0; j < 8; ++j) acc[i][j] = f32x4{0.f, 0.f, 0.f, 0.f};
  const int nk = K / 64;
  const int rowoff = lane >> 3, lch = (lane & 7) ^ rowoff;
  const bf16_t* gA = A + (size_t)(m0 + w * 8 + rowoff) * lda + lch * 8;
  const bf16_t* gB = Bt + (size_t)(n0 + w * 8 + rowoff) * ldb + lch * 8;
  const int fr = lane & 15, fq = lane >> 4;
  for (int kt = 0; kt < nk; ++kt) {
#pragma unroll
    for (int i_ = 0; i_ < 4; ++i_)
      __builtin_amdgcn_global_load_lds((const unsigned*)(gA + (size_t)(i_ * 32) * lda + kt * 64),
                                       (unsigned*)(smem + (i_ * 4 + w) * 1024), 16, 0, 0);
#pragma unroll
    for (int i_ = 0; i_ < 8; ++i_)
      __builtin_amdgcn_global_load_lds((const unsigned*)(gB + (size_t)(i_ * 32) * ldb + kt * 64),
                                       (unsigned*)(smem + 16384 + (i_ * 4 + w) * 1024), 16, 0, 0);
    asm volatile("s_waitcnt vmcnt(0)" ::: "memory");
    __syncthreads();
    const char* sA = smem;
    const char* sB = smem + 16384;
#pragma unroll
    for (int kk = 0; kk < 2; ++kk) {
      bf16x8 af[4], bfr[8];
      const int ch = kk * 4 + fq;
#pragma unroll
      for (int i = 0; i < 4; ++i) {
        const int row = wm * 64 + i * 16 + fr;
        af[i] = *reinterpret_cast<const bf16x8*>(sA + row * 128 + ((ch ^ (row & 7)) << 4));
      }
#pragma unroll
      for (int j = 0; j < 8; ++j) {
        const int col = wn * 128 + j * 16 + fr;
        bfr[j] = *reinterpret_cast<const bf16x8*>(sB + col * 128 + ((ch ^ (col & 7)) << 4));
      }
#pragma unroll
      for (int i = 0; i < 4; ++i)
#pragma unroll
        for (int j = 0; j < 8; ++j) {
          if (I8) {
            typedef __attribute__((ext_vector_type(4))) int i32x4;
            acc[i][j] = __builtin_bit_cast(f32x4, __builtin_amdgcn_mfma_i32_16x16x64_i8(__builtin_bit_cast(i32x4, af[i]), __builtin_bit_cast(i32x4, bfr[j]),
                                                                                         __builtin_bit_cast(i32x4, acc[i][j]), 0, 0, 0));
          } else {
            acc[i][j] = __builtin_amdgcn_mfma_f32_16x16x32_bf16(af[i], bfr[j], acc[i][j], 0, 0, 0);
          }
        }
    }
    __syncthreads();
  }
}
template <bool I8, class Epi>
__device__ __forceinline__ void gemm_tile_n256(const bf16_t* __restrict__ A, int lda, const bf16_t* __restrict__ Bt, int ldb,
                                               int K, int m0, int n0, const Epi& epi, char* smem,
                                               const float* __restrict__ rscale = nullptr, const float* __restrict__ cscale = nullptr) {
  const int lane = threadIdx.x & 63, w = threadIdx.x >> 6;
  const int wm = w >> 1, wn = w & 1;
  f32x4 acc[4][8];
  gemm_mainloop_n256<I8>(A, lda, Bt, ldb, K, m0, n0, acc, smem);
#pragma unroll
  for (int i = 0; i < 4; ++i) {
    const int row = m0 + wm * 64 + i * 16 + (lane >> 4) * 4;
    float4 rs = float4{1.f, 1.f, 1.f, 1.f};
    if (I8) rs = *reinterpret_cast<const float4*>(rscale + row);
#pragma unroll
    for (int j = 0; j < 8; ++j) {
      const int col = n0 + wn * 128 + j * 16 + (lane & 15);
      if (I8) {
        typedef __attribute__((ext_vector_type(4))) int i32x4;
        const i32x4 ia = __builtin_bit_cast(i32x4, acc[i][j]);
        const float cs = cscale[col];
        epi(row, col, f32x4{(float)ia[0] * rs.x * cs, (float)ia[1] * rs.y * cs, (float)ia[2] * rs.z * cs, (float)ia[3] * rs.w * cs});
      } else {
        epi(row, col, acc[i][j]);
      }
    }
  }
}

__device__ __forceinline__ float wave_max_fast(float v) {
  v = fmaxf(v, dpp_mov<0xB1>(v)); v = fmaxf(v, dpp_mov<0x4E>(v)); v = fmaxf(v, dpp_mov<0x124>(v)); v = fmaxf(v, dpp_mov<0x128>(v));
  v = fmaxf(v, __shfl_xor(v, 16)); v = fmaxf(v, __shfl_xor(v, 32));
  return v;
}
__device__ __forceinline__ uint32_t pack_i8x4(float a, float b, float c, float d) {
  const int ia = __float2int_rn(a), ib = __float2int_rn(b), ic = __float2int_rn(c), id = __float2int_rn(d);
  return (uint32_t)(ia & 255) | ((uint32_t)(ib & 255) << 8) | ((uint32_t)(ic & 255) << 16) | ((uint32_t)id << 24);
}
struct EpiF32 {
  float* C; int ldc;
  __device__ __forceinline__ void operator()(int row, int col, f32x4 v) const {
#pragma unroll
    for (int r = 0; r < 4; ++r) C[(size_t)(row + r) * ldc + col] = v[r];
  }
};
struct EpiBf16 {
  bf16_t* C; int ldc;
  __device__ __forceinline__ void operator()(int row, int col, f32x4 v) const {
#pragma unroll
    for (int r = 0; r < 4; ++r) C[(size_t)(row + r) * ldc + col] = f2bf(v[r]);
  }
};
struct EpiBf16T {
  bf16_t* Ct; int ldc;
  __device__ __forceinline__ void operator()(int row, int col, f32x4 v) const {
    uint2 pk; pk.x = pack2(v[0], v[1]); pk.y = pack2(v[2], v[3]);
    *reinterpret_cast<uint2*>(Ct + (size_t)col * ldc + row) = pk;
  }
};
struct EpiInAB {
  bf16_t* ABt; int seqlen;
  __device__ __forceinline__ void operator()(int row, int col, f32x4 v) const {
    const int ch = col & 1023, half = col >> 10;
    const int b = row / seqlen, l = row - b * seqlen;
    uint2 pk; pk.x = pack2(v[0], v[1]); pk.y = pack2(v[2], v[3]);
    *reinterpret_cast<uint2*>(ABt + ((size_t)(b * 1024 + ch) * 4096 + half * 2048 + l)) = pk;
  }
};
struct EpiInZ {
  bf16_t* z;
  __device__ __forceinline__ void operator()(int row, int col, f32x4 v) const {
#pragma unroll
    for (int r = 0; r < 4; ++r) z[(size_t)(row + r) * 1024 + (col - 2048)] = f2bf(v[r]);
  }
};
struct EpiInXbc {
  bf16_t* xbcraw;
  __device__ __forceinline__ void operator()(int row, int col, f32x4 v) const {
#pragma unroll
    for (int r = 0; r < 4; ++r) xbcraw[(size_t)(row + r) * DXBC + (col - 3072)] = f2bf(v[r]);
  }
};
struct EpiInProj {
  bf16_t* ABt; bf16_t* z; bf16_t* xbcraw; float* dtraw; int seqlen;
  __device__ __forceinline__ void operator()(int row, int col, f32x4 v) const {
    if (col < 2048) {
      int ch = col & 1023, half = col >> 10;
      int b = row / seqlen, l = row - b * seqlen;
      uint2 pk; pk.x = pack2(v[0], v[1]); pk.y = pack2(v[2], v[3]);
      *reinterpret_cast<uint2*>(ABt + ((size_t)(b * 1024 + ch) * 4096 + half * 2048 + l)) = pk;
    } else if (col < 3072) {
#pragma unroll
      for (int r = 0; r < 4; ++r) z[(size_t)(row + r) * 1024 + (col - 2048)] = f2bf(v[r]);
    } else if (col < 4608) {
#pragma unroll
      for (int r = 0; r < 4; ++r) xbcraw[(size_t)(row + r) * DXBC + (col - 3072)] = f2bf(v[r]);
    } else if (col < 4640) {
#pragma unroll
      for (int r = 0; r < 4; ++r) dtraw[(size_t)(row + r) * 32 + (col - 4608)] = v[r];
    }
  }
};

__device__ void adaln_partial_task(const Params& p, int task, float* sm) {
  const int cb = task % 48, ks = task / 48, tid = threadIdx.x;
  float* sc = sm;
  __syncthreads();
  for (int i = tid; i < 5 * 64; i += NTHREADS) {
    int r = i >> 6, kk = i & 63;
    int k = ks * 64 + kk;
    float cv = (r < 4) ? p.c[r * D + k] : p.c_ctx[k];
    sc[i] = silu_f(cv);
  }
  __syncthreads();
  const int col = cb * 256 + tid;
  float a0 = 0, a1 = 0, a2 = 0, a3 = 0, a4 = 0;
  const float* wp = p.w_mod + (size_t)(ks * 64) * NMOD + col;
#pragma unroll
  for (int h2 = 0; h2 < 2; ++h2) {
    float wv[32];
#pragma unroll
    for (int kk = 0; kk < 32; ++kk) wv[kk] = __builtin_nontemporal_load(wp + (size_t)(h2 * 32 + kk) * NMOD);
#pragma unroll
    for (int kk = 0; kk < 32; ++kk) {
      const int k = h2 * 32 + kk;
      a0 += sc[k] * wv[kk]; a1 += sc[64 + k] * wv[kk]; a2 += sc[128 + k] * wv[kk]; a3 += sc[192 + k] * wv[kk]; a4 += sc[256 + k] * wv[kk];
    }
  }
  float* pp = p.partial + (size_t)ks * 5 * NMOD + col;
  pp[0] = a0; pp[NMOD] = a1; pp[2 * NMOD] = a2; pp[3 * NMOD] = a3; pp[4 * NMOD] = a4;
}

__device__ void transpose_convert_task(const float* __restrict__ src, int ld, int c0, int rows, bf16_t* __restrict__ dst,
                                       int tr, int tc, float* sm) {
  float (*tile)[68] = reinterpret_cast<float (*)[68]>(sm);
  const int tid = threadIdx.x;
  __syncthreads();
  {
    float4 v[4];
#pragma unroll
    for (int k = 0; k < 4; ++k) {
      const int i = tid + k * NTHREADS, r = i >> 4, c4 = i & 15;
      v[k] = *reinterpret_cast<const float4*>(src + (size_t)(tr * 64 + r) * ld + c0 + tc * 64 + c4 * 4);
    }
#pragma unroll
    for (int k = 0; k < 4; ++k) {
      const int i = tid + k * NTHREADS, r = i >> 4, c4 = i & 15;
      *reinterpret_cast<float4*>(&tile[r][c4 * 4]) = v[k];
    }
  }
  __syncthreads();
#pragma unroll
  for (int k = 0; k < 4; ++k) {
    const int i = tid + k * NTHREADS, cc = i >> 4, r4 = (i & 15) * 4;
    uint2 o; o.x = pack2(tile[r4][cc], tile[r4 + 1][cc]); o.y = pack2(tile[r4 + 2][cc], tile[r4 + 3][cc]);
    *reinterpret_cast<uint2*>(dst + (size_t)(tc * 64 + cc) * rows + tr * 64 + r4) = o;
  }
}

__device__ void phase_prep(const Params& p, int bid, int nb, char* smem) {
  float* sm = reinterpret_cast<float*>(smem);
  const int tid = threadIdx.x;
  if (bid == 0 && tid < 64) p.ctr[tid] = 0u;
  {
    float* t256 = reinterpret_cast<float*>(smem + 20480);
    float* t2048 = reinterpret_cast<float*>(smem + 24576);
    t256[tid] = cospif((float)tid * (1.0f / 128.f));
    for (int i = tid; i < 2048; i += NTHREADS) t2048[i] = cospif((float)i * (1.0f / 1024.f));
    __syncthreads();
  }
  for (int t = bid; t < 48 * KSPLIT; t += nb) adaln_partial_task(p, t, sm);
  {
    const int nct = 41, nrt = 32;
    for (int t = bid; t < nct * nrt; t += nb) {
      int tc = t % nct, tr = t / nct;
      if (tc < 40) transpose_convert_task(p.w_in, DIN, 1024, D, p.w_in_t + (size_t)2048 * D, tr, tc, sm);
      else {
        float (*tile)[65] = reinterpret_cast<float (*)[65]>(sm);
        __syncthreads();
        for (int i = tid; i < 64 * 32; i += NTHREADS) {
          int r = i >> 5, cc = i & 31;
          tile[r][cc] = p.w_in[(size_t)(tr * 64 + r) * DIN + 1024 + 2560 + cc];
        }
        __syncthreads();
        for (int i = tid; i < 32 * 32; i += NTHREADS) {
          int cc = i >> 5, r2 = (i & 31) * 2;
          uint32_t pk = pack2(tile[r2][cc], tile[r2 + 1][cc]);
          *reinterpret_cast<uint32_t*>(p.w_in_t + (size_t)(2048 + 2560 + cc) * D + tr * 64 + r2) = pk;
        }
      }
    }
    for (size_t i = (size_t)bid * NTHREADS + tid; i < (size_t)96 * D / 8; i += (size_t)nb * NTHREADS)
      reinterpret_cast<uint4*>(p.w_in_t + (size_t)4640 * D)[i] = uint4{0, 0, 0, 0};
  }
  for (size_t i = (size_t)bid * NTHREADS + tid; i < (size_t)D * 1024 / 4; i += (size_t)nb * NTHREADS) {
    int k = (int)(i / 256), c4 = (int)(i % 256) * 4;
    float4 v = *reinterpret_cast<const float4*>(p.w_in + (size_t)k * DIN + c4);
    uint2 o; o.x = pack2(v.x, v.y); o.y = pack2(v.z, v.w);
    *reinterpret_cast<uint2*>(p.w_in_f + (size_t)k * 1024 + c4) = o;
  }
  {
    const float* t256 = reinterpret_cast<const float*>(smem + 20480);
    const float scale = 1.0f / sqrtf((float)L * 256.f);
    for (int i = bid * NTHREADS + tid; i < 4 * 64 * 256; i += nb * NTHREADS) {
      const int d = i & 255, cg = (i >> 8) & 63, g = i >> 14;
      float sc_[4] = {0.f, 0.f, 0.f, 0.f}, ss_[4] = {0.f, 0.f, 0.f, 0.f};
      const float* wp = p.w_fmix + (size_t)g * 65536 + d;
#pragma unroll 4
      for (int m = 0; m < 256; ++m) {
        const float wv = wp[m * 256];
#pragma unroll
        for (int j = 0; j < 4; ++j) {
          const int ph = (m * (cg * 4 + j)) & 255;
          sc_[j] += t256[ph] * wv; ss_[j] += t256[(ph - 64) & 255] * wv;
        }
      }
#pragma unroll
      for (int j = 0; j < 4; ++j) {
        const int c = cg * 4 + j;
        p.WcsT[((size_t)g * 512 + d) * 256 + c] = f2bf(sc_[j] * scale);
        p.WcsT[((size_t)g * 512 + 256 + d) * 256 + c] = f2bf(ss_[j] * scale);
      }
    }
  }
  {
    const float* t2048 = reinterpret_cast<const float*>(smem + 24576);
    for (size_t i = (size_t)bid * NTHREADS + tid; i < (size_t)1024 * 2048 / 8; i += (size_t)nb * NTHREADS) {
      const int k = (int)(i / 256), j = (int)(i % 256) * 8;
      const bool iss = j >= 1024;
      float o[8];
#pragma unroll
      for (int e = 0; e < 8; ++e) {
        const int l = (j + e) & 1023;
        const int ph = (k * l) & 2047;
        o[e] = iss ? t2048[(ph - 512) & 2047] : t2048[ph];
      }
      uint4 pk; pk.x = pack2(o[0], o[1]); pk.y = pack2(o[2], o[3]); pk.z = pack2(o[4], o[5]); pk.w = pack2(o[6], o[7]);
      *reinterpret_cast<uint4*>(p.dftm + (size_t)k * 2048 + j) = pk;
    }
  }
}

__device__ void phase_fold(const Params& p, int bid, int nb, char* smem) {
  const int tid = threadIdx.x;
  for (int i = bid * NTHREADS + tid; i < 5 * NMOD; i += nb * NTHREADS) {
    int col = i % NMOD;
    float s = p.b_mod[col];
    for (int ks = 0; ks < KSPLIT; ++ks) s += p.partial[(size_t)ks * 5 * NMOD + i];
    p.mod[i] = s;
  }
  for (int t = bid; t < 256; t += nb) {
    int g = t >> 6, tm = (t & 63) >> 2, tn = t & 3;
    int n0 = tn * 128;
    int rowbase = (n0 < 256) ? (g * 256 + n0) : (1024 + g * 256 + (n0 - 256));
    EpiBf16T epi{p.w_in_t + (size_t)(rowbase - n0) * D, D};
    gemm_tile(p.w_in_f + g * 256, 1024, p.WcsT + (size_t)g * 512 * 256, 256, 256, tm * 128, n0, epi, smem);
  }
}

__device__ __forceinline__ void quant_weight_rows_i8(const bf16_t* __restrict__ src, int8_t* __restrict__ dst, float* __restrict__ scl,
                                                     int nrows, int bid, int nb) {
  const int lane = threadIdx.x & 63, w = threadIdx.x >> 6;
  for (int n = bid * 4 + w; n < nrows; n += nb * 4) {
    const bf16_t* wr = src + (size_t)n * D;
    uint4 q[4];
#pragma unroll
    for (int c = 0; c < 4; ++c) q[c] = *reinterpret_cast<const uint4*>(wr + c * 512 + lane * 8);
    float am = 0.f;
#pragma unroll
    for (int c = 0; c < 4; ++c) {
      am = fmaxf(am, fmaxf(fmaxf(fabsf(bflo(q[c].x)), fabsf(bfhi(q[c].x))), fmaxf(fabsf(bflo(q[c].y)), fabsf(bfhi(q[c].y)))));
      am = fmaxf(am, fmaxf(fmaxf(fabsf(bflo(q[c].z)), fabsf(bfhi(q[c].z))), fmaxf(fabsf(bflo(q[c].w)), fabsf(bfhi(q[c].w)))));
    }
    am = wave_max_fast(am);
    const float inv = (am > 0.f) ? 127.f / am : 0.f;
#pragma unroll
    for (int c = 0; c < 4; ++c) {
      uint2 o;
      o.x = pack_i8x4(bflo(q[c].x) * inv, bfhi(q[c].x) * inv, bflo(q[c].y) * inv, bfhi(q[c].y) * inv);
      o.y = pack_i8x4(bflo(q[c].z) * inv, bfhi(q[c].z) * inv, bflo(q[c].w) * inv, bfhi(q[c].w) * inv);
      *reinterpret_cast<uint2*>(dst + (size_t)n * D + c * 512 + lane * 8) = o;
    }
    if (lane == 0) scl[n] = am * (1.f / 127.f);
  }
}

__device__ void phase_norm_mod(const Params& p, int bid, int nb, char* smem) {
  const int lane = threadIdx.x & 63, w = threadIdx.x >> 6;
  for (int t = bid * 4 + w; t < T + TC; t += nb * 4) {
    const bool isx = t < T;
    const float* src = isx ? (p.x + (size_t)t * D) : (p.ctx + (size_t)(t - T) * D);
    const int mrow = isx ? (t / L) : 4;
    bf16_t* dst = isx ? (p.hx + (size_t)t * D) : (p.hc + (size_t)(t - T) * D);
    float4 v[8];
    float ss = 0.f;
#pragma unroll
    for (int c = 0; c < 8; ++c) {
      v[c] = *reinterpret_cast<const float4*>(src + c * 256 + lane * 4);
      ss += v[c].x * v[c].x + v[c].y * v[c].y + v[c].z * v[c].z + v[c].w * v[c].w;
    }
    ss = wave_sum_fast(ss);
    const float rstd = rsqrtf(ss * (1.f / D) + EPS);
    const float* sh = p.mod + (size_t)mrow * NMOD + 0 * D;
    const float* sc = p.mod + (size_t)mrow * NMOD + 1 * D;
    float am = 0.f;
#pragma unroll
    for (int c = 0; c < 8; ++c) {
      const int e0 = c * 256 + lane * 4;
      const float4 g = *reinterpret_cast<const float4*>(p.g_pre_mix + e0);
      const float4 s4 = *reinterpret_cast<const float4*>(sc + e0), h4 = *reinterpret_cast<const float4*>(sh + e0);
      v[c].x = v[c].x * rstd * g.x * (1.f + s4.x) + h4.x; v[c].y = v[c].y * rstd * g.y * (1.f + s4.y) + h4.y;
      v[c].z = v[c].z * rstd * g.z * (1.f + s4.z) + h4.z; v[c].w = v[c].w * rstd * g.w * (1.f + s4.w) + h4.w;
      am = fmaxf(am, fmaxf(fmaxf(fabsf(v[c].x), fabsf(v[c].y)), fmaxf(fabsf(v[c].z), fabsf(v[c].w))));
      uint2 pk;
      pk.x = pack2(v[c].x, v[c].y);
      pk.y = pack2(v[c].z, v[c].w);
      *reinterpret_cast<uint2*>(dst + e0) = pk;
    }
    {
      am = wave_max_fast(am);
      const float inv = (am > 0.f) ? 127.f / am : 0.f;
#pragma unroll
      for (int c = 0; c < 8; ++c)
        *reinterpret_cast<uint32_t*>(p.hx8a + (size_t)t * D + c * 256 + lane * 4) = pack_i8x4(v[c].x * inv, v[c].y * inv, v[c].z * inv, v[c].w * inv);
      if (lane == 0) p.ascale[t] = am * (1.f / 127.f);
    }
  }
  quant_weight_rows_i8(p.w_in_t, p.w8, p.wscale, NPROJ, bid, nb);
}

__device__ __forceinline__ void convert_uv_units(const Params& p, size_t u0, size_t u1) {
  const size_t n16 = (size_t)16384 * D / 16;
  for (size_t i = u0 + threadIdx.x; i < u1; i += NTHREADS) {
    const float* s = (i < n16) ? p.eu : p.ev;
    uint8_t* d = (i < n16) ? p.U8 : p.V8;
    const size_t j = (i < n16) ? i : i - n16;
    uint32_t o[4];
#pragma unroll
    for (int q4 = 0; q4 < 4; ++q4) {
      const float4 v = *reinterpret_cast<const float4*>(s + j * 16 + q4 * 4);
      int pk = 0;
      pk = __builtin_amdgcn_cvt_pk_fp8_f32(v.x * 512.f, v.y * 512.f, pk, false);
      pk = __builtin_amdgcn_cvt_pk_fp8_f32(v.z * 512.f, v.w * 512.f, pk, true);
      o[q4] = (uint32_t)pk;
    }
    const size_t e_ = j >> 7, r_ = j & 127;
    *reinterpret_cast<uint4*>(d + (r_ >> 4) * ((size_t)16384 * 256) + e_ * 256 + (r_ & 15) * 16) = uint4{o[0], o[1], o[2], o[3]};
  }
}
__device__ void phase_inproj(const Params& p, int bid, int nb, char* smem) {
  if ((nb & 7) == 0) {
    const int x = bid & 7, rank = bid >> 3, per = nb >> 3;
    const bf16_t* a8 = reinterpret_cast<const bf16_t*>(p.hx8a);
    const bf16_t* b8 = reinterpret_cast<const bf16_t*>(p.w8);
    for (int s_ = rank; s_ < 128 + 53; s_ += per) {
      if (s_ < 128) {
        const int tn2 = s_ >> 3, m0_ = (8 * x + (s_ & 7)) * 128;
        if (tn2 < 8) { EpiInAB epi{p.ABt, L}; gemm_tile_n256<true>(a8, D / 2, b8, D / 2, D / 2, m0_, tn2 * 256, epi, smem, p.ascale, p.wscale); }
        else if (tn2 < 12) { EpiInZ epi{p.z}; gemm_tile_n256<true>(a8, D / 2, b8, D / 2, D / 2, m0_, tn2 * 256, epi, smem, p.ascale, p.wscale); }
        else { EpiInXbc epi{p.xbcraw}; gemm_tile_n256<true>(a8, D / 2, b8, D / 2, D / 2, m0_, tn2 * 256, epi, smem, p.ascale, p.wscale); }
      } else if (s_ < 128 + 40) {
        const int i = s_ - 128;
        EpiInProj epi{p.ABt, p.z, p.xbcraw, p.dtraw, L};
        gemm_tile<true>(a8, D / 2, b8, D / 2, D / 2, (8 * x + (i & 7)) * 128, (32 + (i >> 3)) * 128, epi, smem, p.ascale, p.wscale);
      } else {
        const int u = x * 13 + (s_ - 168);
        EpiInProj epi{nullptr, nullptr, p.xbcraw_c, p.dtraw_c, CTX};
        gemm_tile<true>(reinterpret_cast<const bf16_t*>(p.hx8a + (size_t)T * D), D / 2, b8, D / 2, D / 2, (u / 13) * 128, 3072 + (u % 13) * 128, epi, smem,
                        p.ascale + T, p.wscale);
      }
    }
    return;
  }
  const int ntx = 64 * 37, ntc = 8 * 13;
  for (int t = bid; t < ntx + ntc; t += nb) {
    if (t < ntx) {
      int tm = t / 37, tn = t % 37;
      EpiInProj epi{p.ABt, p.z, p.xbcraw, p.dtraw, L};
      gemm_tile(p.hx, D, p.w_in_t, D, D, tm * 128, tn * 128, epi, smem);
    } else {
      int u = t - ntx;
      int tm = u / 13, tn = u % 13;
      EpiInProj epi{nullptr, nullptr, p.xbcraw_c, p.dtraw_c, CTX};
      gemm_tile(p.hc, D, p.w_in_t, D, D, tm * 128, 3072 + tn * 128, epi, smem);
    }
  }
}

__device__ void ssm_pre_tile(const Params& p, int task, char* smem) {
  const bool isx = task < 3072;
  const int u = isx ? task : task - 3072;
  const int ntt = isx ? 32 : 4;
  const int ct = u % 24, tt = (u / 24) % ntt, b = u / (24 * ntt);
  const int seqlen = isx ? L : CTX;
  const bf16_t* raw = (isx ? p.xbcraw : p.xbcraw_c) + (size_t)b * seqlen * DXBC;
  const int l0 = tt * 64, c0 = ct * 64, tid = threadIdx.x;
  float (*rt)[68] = reinterpret_cast<float (*)[68]>(smem);
  float (*at)[65] = reinterpret_cast<float (*)[65]>(smem + 66 * 68 * 4);
  __syncthreads();
  {
    uint2 v[5];
#pragma unroll
    for (int k = 0; k < 5; ++k) {
      const int i = tid + k * NTHREADS, r = i >> 4, c4 = i & 15, l = l0 - 1 + r;
      v[k] = (i < 66 * 16 && l >= 0 && l < seqlen) ? *reinterpret_cast<const uint2*>(raw + (size_t)l * DXBC + c0 + c4 * 4) : uint2{0u, 0u};
    }
#pragma unroll
    for (int k = 0; k < 5; ++k) {
      const int i = tid + k * NTHREADS, r = i >> 4, c4 = i & 15;
      if (i < 66 * 16) *reinterpret_cast<float4*>(&rt[r][c4 * 4]) = float4{bflo(v[k].x), bfhi(v[k].x), bflo(v[k].y), bfhi(v[k].y)};
    }
  }
  __syncthreads();
  {
    const int cc = tid & 63, c = c0 + cc;
    const float w0 = p.conv_w[c], w1 = p.conv_w[DXBC + c], w2 = p.conv_w[2 * DXBC + c], cb = p.conv_b[c];
#pragma unroll 4
    for (int r = tid >> 6; r < 64; r += 4) at[r][cc] = silu_f(cb + rt[r][cc] * w0 + rt[r + 1][cc] * w1 + rt[r + 2][cc] * w2);
  }
  __syncthreads();
  const size_t trow0 = isx ? ((size_t)b * L + l0) : ((size_t)T + (size_t)b * CTX + l0);
#pragma unroll
  for (int k = 0; k < 4; ++k) {
    const int i = tid + k * NTHREADS, r = i >> 4, c4 = (i & 15) * 4;
    uint2 o; o.x = pack2(at[r][c4], at[r][c4 + 1]); o.y = pack2(at[r][c4 + 2], at[r][c4 + 3]);
    *reinterpret_cast<uint2*>(p.act_tm + (trow0 + r) * DXBC + c0 + c4) = o;
  }
  if (c0 < 1280) {
    bf16_t* cm = (isx ? p.act_cm_x : p.act_cm_c) + (size_t)b * 1280 * seqlen;
#pragma unroll
    for (int k = 0; k < 4; ++k) {
      const int i = tid + k * NTHREADS, cc = i >> 4, r4 = (i & 15) * 4;
      uint2 o; o.x = pack2(at[r4][cc], at[r4 + 1][cc]); o.y = pack2(at[r4 + 2][cc], at[r4 + 3][cc]);
      *reinterpret_cast<uint2*>(cm + (size_t)(c0 + cc) * seqlen + l0 + r4) = o;
    }
  }
}
__device__ void dft_fold_rows(const Params& p, int bid, int nb, char* smem) {
  const int lane = threadIdx.x & 63, w = threadIdx.x >> 6;
  bf16_t* sr = reinterpret_cast<bf16_t*>(smem + w * 8192);
  for (int row = bid * 4 + w; row < NB * 1024; row += nb * 4) {
    const bf16_t* A = p.ABt + (size_t)row * 4096;
    bf16_t* F = p.Fs + (size_t)row * 2048;
    __builtin_amdgcn_wave_barrier();
    {
      const uint4 q0 = *reinterpret_cast<const uint4*>(A + (0 * 64 + lane) * 8), q1 = *reinterpret_cast<const uint4*>(A + (1 * 64 + lane) * 8);
      const uint4 q2 = *reinterpret_cast<const uint4*>(A + (2 * 64 + lane) * 8), q3 = *reinterpret_cast<const uint4*>(A + (3 * 64 + lane) * 8);
      const uint4 q4 = *reinterpret_cast<const uint4*>(A + (4 * 64 + lane) * 8), q5 = *reinterpret_cast<const uint4*>(A + (5 * 64 + lane) * 8);
      const uint4 q6 = *reinterpret_cast<const uint4*>(A + (6 * 64 + lane) * 8), q7 = *reinterpret_cast<const uint4*>(A + (7 * 64 + lane) * 8);
      *reinterpret_cast<uint4*>(sr + (0 * 64 + lane) * 8) = q0; *reinterpret_cast<uint4*>(sr + (1 * 64 + lane) * 8) = q1;
      *reinterpret_cast<uint4*>(sr + (2 * 64 + lane) * 8) = q2; *reinterpret_cast<uint4*>(sr + (3 * 64 + lane) * 8) = q3;
      *reinterpret_cast<uint4*>(sr + (4 * 64 + lane) * 8) = q4; *reinterpret_cast<uint4*>(sr + (5 * 64 + lane) * 8) = q5;
      *reinterpret_cast<uint4*>(sr + (6 * 64 + lane) * 8) = q6; *reinterpret_cast<uint4*>(sr + (7 * 64 + lane) * 8) = q7;
    }
    __builtin_amdgcn_wave_barrier();
    const int l0 = lane * 16;
    float alt = 0.f;
    uint32_t oa[8], ob[8];
#pragma unroll
    for (int half = 0; half < 2; ++half) {
      const bf16_t* base = sr + half * 2048;
      const uint4 fa = *reinterpret_cast<const uint4*>(base + l0), fb = *reinterpret_cast<const uint4*>(base + l0 + 8);
      const uint4 ra = *reinterpret_cast<const uint4*>(base + 2032 - l0), rb = *reinterpret_cast<const uint4*>(base + 2040 - l0);
      const float r16 = (lane > 0) ? bf2f(base[2048 - l0]) : 0.f;
      const uint32_t fw[8] = {fa.x, fa.y, fa.z, fa.w, fb.x, fb.y, fb.z, fb.w};
      const uint32_t rw[8] = {ra.x, ra.y, ra.z, ra.w, rb.x, rb.y, rb.z, rb.w};
      float v[16];
#pragma unroll
      for (int i = 0; i < 16; ++i) {
        const float fwv = (i & 1) ? bfhi(fw[i >> 1]) : bflo(fw[i >> 1]);
        const int j = 16 - i;
        const float rv = (i == 0) ? r16 : ((j & 1) ? bfhi(rw[j >> 1]) : bflo(rw[j >> 1]));
        if (half == 0) v[i] = (lane == 0 && i == 0) ? fwv : fwv + rv;
        else v[i] = (lane == 0 && i == 0) ? 0.f : fwv - rv;
      }
      if (half == 0) {
#pragma unroll
        for (int i = 0; i < 16; ++i) alt += (i & 1) ? -v[i] : v[i];
#pragma unroll
        for (int i = 0; i < 8; ++i) oa[i] = pack2(v[2 * i], v[2 * i + 1]);
      } else {
#pragma unroll
        for (int i = 0; i < 8; ++i) ob[i] = pack2(v[2 * i], v[2 * i + 1]);
      }
    }
    *reinterpret_cast<uint4*>(F + l0) = uint4{oa[0], oa[1], oa[2], oa[3]};
    *reinterpret_cast<uint4*>(F + l0 + 8) = uint4{oa[4], oa[5], oa[6], oa[7]};
    *reinterpret_cast<uint4*>(F + 1024 + l0) = uint4{ob[0], ob[1], ob[2], ob[3]};
    *reinterpret_cast<uint4*>(F + 1024 + l0 + 8) = uint4{ob[4], ob[5], ob[6], ob[7]};
    alt = wave_sum_fast(alt) + bf2f(sr[1024]);
    if (lane == 0) { const int b = row >> 10, ch = row & 1023; p.ycat[((size_t)b * L + 1024) * D + ch] = f2bf(alt); }
  }
}
__device__ void phase_ssm_pre(const Params& p, int bid, int nb, char* smem) {
  const int tid = threadIdx.x;
  dft_fold_rows(p, bid, nb, smem);
  for (int t = bid; t < 3072 + 384; t += nb) ssm_pre_tile(p, t, smem);
  for (int i = bid * NTHREADS + tid; i < (T + TC) * 32; i += nb * NTHREADS) {
    const bool isx = i < T * 32;
    const int ii = isx ? i : i - T * 32;
    const int t = ii >> 5, j = ii & 31;
    const float v = (isx ? p.dtraw : p.dtraw_c)[ii];
    float* df = isx ? p.dtf : p.dtf_c;
    float* db = isx ? p.dtb : p.dtb_c;
    if (j < 16) df[t * 16 + j] = softplus_f(v + p.dt_bias_f[j]);
    else db[t * 16 + (j - 16)] = softplus_f(v + p.dt_bias_b[j - 16]);
  }
}

__device__ __forceinline__ int swz16(int row, int chunk) { return row * 256 + ((chunk ^ (row & 15)) << 4); }
__device__ __forceinline__ int swz8(int row, int chunk) { return row * 128 + ((chunk ^ (row & 7)) << 4); }

#define LDS_BARRIER() asm volatile("s_waitcnt lgkmcnt(0)\n\ts_barrier" ::: "memory")
__device__ void ssd_task(const Params& p, int task, char* smem) {
  const int dir = task & 1, ph = (task >> 1) & 1, h = (task >> 2) & 15, b = task >> 6;
  const int tid = opaque_tid(), lane = tid & 63, w = tid >> 6;
  const int g = h >> 3, lr0 = lane & 15, lq0 = lane >> 4;
  const float a = -__expf(dir ? p.a_log_b[h] : p.a_log_f[h]);
  char* sCc = smem; char* sBc = smem + 16384; char* sBT = smem + 32768; char* sXT = smem + 49152; char* sHb = smem + 57344;
  float* se = reinterpret_cast<float*>(smem + 73728);
  float* sdt = se + 64; float* sw = se + 128; float* sy = se + 192; float* stot = se + 256;
  bf16_t* yo = reinterpret_cast<bf16_t*>(dir ? p.yb : p.yf);
  f32x4 H[2][2];
#pragma unroll
  for (int i = 0; i < 2; ++i)
#pragma unroll
    for (int j = 0; j < 2; ++j) H[i][j] = f32x4{0.f, 0.f, 0.f, 0.f};
  __syncthreads();
  for (int i = tid; i < 512; i += NTHREADS) reinterpret_cast<uint4*>(sHb)[i] = uint4{0, 0, 0, 0};

  const int crow = tid >> 4, cch = tid & 15;
  const int trow = tid >> 3, tch = tid & 7;
  uint4 rC0, rC1, rC2, rC3, rB0, rB1, rB2, rB3, rT0, rT1, rT2, rT3, rX;
  rC0 = rC1 = rC2 = rC3 = rB0 = rB1 = rB2 = rB3 = uint4{0, 0, 0, 0};
  float rdt = 0.f;
#define SSD_PARAMS(st_)                                                                                                   \
  const bool isctx_ = (st_) < 4;                                                                                          \
  const int nch_ = isctx_ ? 4 : 32, ci_ = isctx_ ? (st_) : (st_) - 4;                                                     \
  const int c_ = dir ? (nch_ - 1 - ci_) : ci_;                                                                            \
  const int seqlen_ = isctx_ ? CTX : L;                                                                                   \
  const size_t trow0_ = isctx_ ? ((size_t)T + (size_t)b * CTX + c_ * 64) : ((size_t)b * L + c_ * 64);                     \
  const size_t drow0_ = (size_t)b * seqlen_ + c_ * 64;                                                                    \
  const float* dtp_ = isctx_ ? (dir ? p.dtb_c : p.dtf_c) : (dir ? p.dtb : p.dtf);                                         \
  const bf16_t* cm_ = (isctx_ ? p.act_cm_c : p.act_cm_x) + (size_t)b * 1280 * seqlen_ + c_ * 64;
#define SSD_PREFETCH(st_)                                                                                                 \
  do {                                                                                                                    \
    SSD_PARAMS(st_)                                                                                                       \
    if (w == 0) rdt = dtp_[(drow0_ + lane) * 16 + h];                                                                     \
    if (!isctx_) {                                                                                                        \
      const bf16_t* src = p.act_tm + (trow0_ + crow) * DXBC + g * 128 + cch * 8;                                          \
      rC0 = *reinterpret_cast<const uint4*>(src + 1280);             rB0 = *reinterpret_cast<const uint4*>(src + 1024);   \
      rC1 = *reinterpret_cast<const uint4*>(src + 16 * DXBC + 1280); rB1 = *reinterpret_cast<const uint4*>(src + 16 * DXBC + 1024); \
      rC2 = *reinterpret_cast<const uint4*>(src + 32 * DXBC + 1280); rB2 = *reinterpret_cast<const uint4*>(src + 32 * DXBC + 1024); \
      rC3 = *reinterpret_cast<const uint4*>(src + 48 * DXBC + 1280); rB3 = *reinterpret_cast<const uint4*>(src + 48 * DXBC + 1024); \
    }                                                                                                                     \
    const bf16_t* srt = cm_ + (size_t)(1024 + g * 128 + trow) * seqlen_ + tch * 8;                                        \
    rT0 = *reinterpret_cast<const uint4*>(srt);                                                                           \
    rT1 = *reinterpret_cast<const uint4*>(srt + (size_t)32 * seqlen_);                                                    \
    rT2 = *reinterpret_cast<const uint4*>(srt + (size_t)64 * seqlen_);                                                    \
    rT3 = *reinterpret_cast<const uint4*>(srt + (size_t)96 * seqlen_);                                                    \
    rX = *reinterpret_cast<const uint4*>(cm_ + (size_t)(h * 64 + ph * 32 + trow) * seqlen_ + tch * 8);                    \
  } while (0)

  for (int step = 0; step < 36; ++step) {
    SSD_PREFETCH(step);
    const bool isctx = step < 4;
    const int c = dir ? ((isctx ? 4 : 32) - 1 - (isctx ? step : step - 4)) : (isctx ? step : step - 4);
    const size_t trow0 = (size_t)b * L + c * 64;
    int lr = lr0, lq = lq0;
    asm volatile("" : "+v"(lr), "+v"(lq));
    LDS_BARRIER();
    if (w == 0) {
      const float dtv = rdt;
      float v = a * dtv;
      if (!dir) {
#pragma unroll
        for (int o = 1; o < 64; o <<= 1) { float n = __shfl_up(v, o); v += (lane >= o) ? n : 0.f; }
      } else {
#pragma unroll
        for (int o = 1; o < 64; o <<= 1) { float n = __shfl_down(v, o); v += (lane + o < 64) ? n : 0.f; }
      }
      const float etot = __shfl(v, dir ? 0 : 63);
      se[lane] = v; sdt[lane] = dtv; sw[lane] = dtv * __expf(etot - v); sy[lane] = __expf(v);
      if (lane == 0) stot[0] = etot;
    }
    if (!isctx) {
      const int oc = swz16(crow, cch);
      *reinterpret_cast<uint4*>(sCc + oc) = rC0;         *reinterpret_cast<uint4*>(sBc + oc) = rB0;
      *reinterpret_cast<uint4*>(sCc + oc + 4096) = rC1;  *reinterpret_cast<uint4*>(sBc + oc + 4096) = rB1;
      *reinterpret_cast<uint4*>(sCc + oc + 8192) = rC2;  *reinterpret_cast<uint4*>(sBc + oc + 8192) = rB2;
      *reinterpret_cast<uint4*>(sCc + oc + 12288) = rC3; *reinterpret_cast<uint4*>(sBc + oc + 12288) = rB3;
    }
    {
      const int ot = swz8(trow, tch);
      *reinterpret_cast<uint4*>(sBT + ot) = rT0;
      *reinterpret_cast<uint4*>(sBT + ot + 4096) = rT1;
      *reinterpret_cast<uint4*>(sBT + ot + 8192) = rT2;
      *reinterpret_cast<uint4*>(sBT + ot + 12288) = rT3;
      *reinterpret_cast<uint4*>(sXT + ot) = rX;
    }
    LDS_BARRIER();
    const float etot = stot[0];
    if (!isctx) {
      f32x4 G[4];
      bf16x8 ca[4];
#pragma unroll
      for (int j = 0; j < 4; ++j) G[j] = f32x4{0.f, 0.f, 0.f, 0.f};
#pragma unroll
      for (int kk = 0; kk < 4; ++kk) ca[kk] = *reinterpret_cast<const bf16x8*>(sCc + swz16(16 * w + lr, kk * 4 + lq));
#pragma unroll
      for (int kk = 0; kk < 4; ++kk)
#pragma unroll
        for (int j = 0; j < 4; ++j) {
          bf16x8 bb = *reinterpret_cast<const bf16x8*>(sBc + swz16(16 * j + lr, kk * 4 + lq));
          G[j] = __builtin_amdgcn_mfma_f32_16x16x32_bf16(ca[kk], bb, G[j], 0, 0, 0);
        }
      LDS_BARRIER();
      float el[4];
#pragma unroll
      for (int r = 0; r < 4; ++r) el[r] = se[16 * w + lq * 4 + r];
#pragma unroll
      for (int j = 0; j < 4; ++j) {
        const int s_ = 16 * j + lr;
        const float es = se[s_], ds = sdt[s_];
#pragma unroll
        for (int r = 0; r < 4; ++r) {
          const int l = 16 * w + lq * 4 + r;
          const bool keep = dir ? (s_ >= l) : (s_ <= l);
          const float m = keep ? G[j][r] * __expf(el[r] - es) * ds : 0.f;
          *reinterpret_cast<bf16_t*>(sBc + swz8(l, s_ >> 3) + (s_ & 7) * 2) = f2bf(m);
        }
      }
      LDS_BARRIER();
      f32x4 Y[2], Yo[2];
#pragma unroll
      for (int j = 0; j < 2; ++j) { Y[j] = f32x4{0.f, 0.f, 0.f, 0.f}; Yo[j] = f32x4{0.f, 0.f, 0.f, 0.f}; }
#pragma unroll
      for (int kk = 0; kk < 2; ++kk) {
        bf16x8 ma = *reinterpret_cast<const bf16x8*>(sBc + swz8(16 * w + lr, kk * 4 + lq));
#pragma unroll
        for (int j = 0; j < 2; ++j) {
          bf16x8 xb = *reinterpret_cast<const bf16x8*>(sXT + swz8(16 * j + lr, kk * 4 + lq));
          Y[j] = __builtin_amdgcn_mfma_f32_16x16x32_bf16(ma, xb, Y[j], 0, 0, 0);
        }
      }
#pragma unroll
      for (int kk = 0; kk < 4; ++kk)
#pragma unroll
        for (int j = 0; j < 2; ++j) {
          bf16x8 hb = *reinterpret_cast<const bf16x8*>(sHb + swz16(16 * j + lr, kk * 4 + lq));
          Yo[j] = __builtin_amdgcn_mfma_f32_16x16x32_bf16(ca[kk], hb, Yo[j], 0, 0, 0);
        }
      float syl[4];
#pragma unroll
      for (int r = 0; r < 4; ++r) syl[r] = sy[16 * w + lq * 4 + r];
#pragma unroll
      for (int j = 0; j < 2; ++j)
#pragma unroll
        for (int r = 0; r < 4; ++r) {
          const int l = 16 * w + lq * 4 + r;
          yo[(trow0 + l) * 1024 + h * 64 + ph * 32 + 16 * j + lr] = f2bf(Y[j][r] + syl[r] * Yo[j][r]);
        }
    }
    {
      const float dec = __expf(etot);
#pragma unroll
      for (int i = 0; i < 2; ++i)
#pragma unroll
        for (int j = 0; j < 2; ++j) H[i][j] *= dec;
#pragma unroll
      for (int kk = 0; kk < 2; ++kk) {
        const int s0 = kk * 32 + lq * 8;
        const float4 w0 = *reinterpret_cast<const float4*>(sw + s0), w1 = *reinterpret_cast<const float4*>(sw + s0 + 4);
        bf16x8 xs[2];
#pragma unroll
        for (int i = 0; i < 2; ++i) {
          const bf16x8 xa = *reinterpret_cast<const bf16x8*>(sXT + swz8(16 * i + lr, kk * 4 + lq));
          xs[i][0] = (short)f2bf(bf2f((bf16_t)xa[0]) * w0.x); xs[i][1] = (short)f2bf(bf2f((bf16_t)xa[1]) * w0.y);
          xs[i][2] = (short)f2bf(bf2f((bf16_t)xa[2]) * w0.z); xs[i][3] = (short)f2bf(bf2f((bf16_t)xa[3]) * w0.w);
          xs[i][4] = (short)f2bf(bf2f((bf16_t)xa[4]) * w1.x); xs[i][5] = (short)f2bf(bf2f((bf16_t)xa[5]) * w1.y);
          xs[i][6] = (short)f2bf(bf2f((bf16_t)xa[6]) * w1.z); xs[i][7] = (short)f2bf(bf2f((bf16_t)xa[7]) * w1.w);
        }
#pragma unroll
        for (int j = 0; j < 2; ++j) {
          const bf16x8 bt = *reinterpret_cast<const bf16x8*>(sBT + swz8(16 * (2 * w + j) + lr, kk * 4 + lq));
#pragma unroll
          for (int i = 0; i < 2; ++i) H[i][j] = __builtin_amdgcn_mfma_f32_16x16x32_bf16(xs[i], bt, H[i][j], 0, 0, 0);
        }
      }
    }
    LDS_BARRIER();
#pragma unroll
    for (int i = 0; i < 2; ++i)
#pragma unroll
      for (int j = 0; j < 2; ++j) {
        const int n = 16 * (2 * w + j) + lr;
#pragma unroll
        for (int r = 0; r < 4; ++r) {
          const int pr = 16 * i + lq * 4 + r;
          *reinterpret_cast<bf16_t*>(sHb + swz16(pr, n >> 3) + (n & 7) * 2) = f2bf(H[i][j][r]);
        }
      }
  }
#undef SSD_PREFETCH
#undef SSD_PARAMS
}

#undef LDS_BARRIER
__device__ void phase_ssd_dft(const Params& p, int bid, int nb, char* smem) {
  for (int t = bid; t < 256; t += nb) ssd_task(p, t, smem);
  int* stile = reinterpret_cast<int*>(smem + 75776);
  for (;;) {
    __syncthreads();
    if (threadIdx.x == 0) *stile = (int)atomicAdd(p.ctr, 1u);
    __syncthreads();
    const int t = *stile;
    if (t >= 4 * 8 * 8) break;
    const int b = t >> 6, tm = (t & 63) >> 3, tn = t & 7;
    const bf16_t* Fb = p.Fs + (size_t)b * 1024 * 2048;
    f32x4 accC[4][4], accS[4][4];
    gemm_mainloop(p.dftm, 2048, Fb, 2048, 1024, tm * 128, tn * 128, accC, smem);
    gemm_mainloop(p.dftm + 1024, 2048, Fb + 1024, 2048, 1024, tm * 128, tn * 128, accS, smem);
    const int lane = threadIdx.x & 63, w = threadIdx.x >> 6, wm = w >> 1, wn = w & 1;
#pragma unroll
    for (int i = 0; i < 4; ++i) {
      int lq_ = lane >> 4, lr_ = lane & 15;
      asm volatile("" : "+v"(lq_), "+v"(lr_));
#pragma unroll
      for (int j = 0; j < 4; ++j) {
        const int k0 = tm * 128 + wm * 64 + i * 16 + lq_ * 4;
        const int ch = tn * 128 + wn * 64 + j * 16 + lr_;
        const float a = bf2f(p.ABt[((size_t)b * 1024 + ch) * 4096 + 1024]);
#pragma unroll
        for (int r = 0; r < 4; ++r) {
          const int k = k0 + r;
          const float as = (k & 1) ? -a : a;
          const float c = accC[i][j][r], sn = accS[i][j][r];
          p.ycat[((size_t)b * L + k) * D + ch] = f2bf(c - sn + as);
          if (k > 0) p.ycat[((size_t)b * L + (L - k)) * D + ch] = f2bf(c + sn + as);
        }
      }
    }
  }
  for (;;) {
    __syncthreads();
    if (threadIdx.x == 0) *stile = (int)atomicAdd(p.ctr + 8, 1u);
    __syncthreads();
    const int q = *stile;
    if (q >= 1024 + 1536) break;
    if (q < 1024) convert_uv_units(p, (size_t)q * 4096, (size_t)(q + 1) * 4096);
    else if (q < 1024 + 1024) { const int q1 = q - 1024; transpose_convert_task(p.w_out, D, 0, D, p.w_out_t, q1 / 32, q1 % 32, reinterpret_cast<float*>(smem)); }
    else { const int q2 = q - 2048; transpose_convert_task(p.w_query, 1024, 0, D, p.w_q_t, q2 / 16, q2 % 16, reinterpret_cast<float*>(smem)); }
  }
}

__device__ void phase_ssm_post(const Params& p, int bid, int nb, char* smem) {
  const int lane = threadIdx.x & 63, w = threadIdx.x >> 6;
  for (int t = bid * 4 + w; t < T; t += nb * 4) {
    float y[4][4];
    float ss0 = 0.f, ss1 = 0.f;
#pragma unroll
    for (int c = 0; c < 4; ++c) {
      const int c0 = c * 256 + lane * 4;
      const int h = c0 >> 6;
      const float dsk = p.d_skip_f[h] + p.d_skip_b[h];
      const uint2 aq = *reinterpret_cast<const uint2*>(reinterpret_cast<const bf16_t*>(p.yf) + (size_t)t * 1024 + c0);
      const uint2 bb = *reinterpret_cast<const uint2*>(reinterpret_cast<const bf16_t*>(p.yb) + (size_t)t * 1024 + c0);
      const float4 a = float4{bflo(aq.x), bfhi(aq.x), bflo(aq.y), bfhi(aq.y)};
      const float4 bq = float4{bflo(bb.x), bfhi(bb.x), bflo(bb.y), bfhi(bb.y)};
      const uint2 xq = *reinterpret_cast<const uint2*>(p.act_tm + (size_t)t * DXBC + c0);
      const uint2 zz = *reinterpret_cast<const uint2*>(p.z + (size_t)t * 1024 + c0);
      y[c][0] = (a.x + bq.x + dsk * bflo(xq.x)) * silu_f(bflo(zz.x));
      y[c][1] = (a.y + bq.y + dsk * bfhi(xq.x)) * silu_f(bfhi(zz.x));
      y[c][2] = (a.z + bq.z + dsk * bflo(xq.y)) * silu_f(bflo(zz.y));
      y[c][3] = (a.w + bq.w + dsk * bfhi(xq.y)) * silu_f(bfhi(zz.y));
      const float q = y[c][0] * y[c][0] + y[c][1] * y[c][1] + y[c][2] * y[c][2] + y[c][3] * y[c][3];
      if (c < 2) ss0 += q; else ss1 += q;
    }
    ss0 = wave_sum_fast(ss0); ss1 = wave_sum_fast(ss1);
    const float r0 = rsqrtf(ss0 * (1.f / 512.f) + EPS), r1 = rsqrtf(ss1 * (1.f / 512.f) + EPS);
    uint2 fq[4];
    float am = 0.f;
#pragma unroll
    for (int c = 0; c < 4; ++c) {
      const int c0 = c * 256 + lane * 4;
      fq[c] = *reinterpret_cast<const uint2*>(p.ycat + (size_t)t * D + c0);
      am = fmaxf(am, fmaxf(fmaxf(fabsf(bflo(fq[c].x)), fabsf(bfhi(fq[c].x))), fmaxf(fabsf(bflo(fq[c].y)), fabsf(bfhi(fq[c].y)))));
      const float rstd = (c < 2) ? r0 : r1;
      const float4 nw = *reinterpret_cast<const float4*>(p.ssm_norm_w + c0);
      y[c][0] *= rstd * nw.x; y[c][1] *= rstd * nw.y; y[c][2] *= rstd * nw.z; y[c][3] *= rstd * nw.w;
      am = fmaxf(am, fmaxf(fmaxf(fabsf(y[c][0]), fabsf(y[c][1])), fmaxf(fabsf(y[c][2]), fabsf(y[c][3]))));
    }
    am = wave_max_fast(am);
    const float inv = (am > 0.f) ? 127.f / am : 0.f;
#pragma unroll
    for (int c = 0; c < 4; ++c) {
      const int c0 = c * 256 + lane * 4;
      *reinterpret_cast<uint32_t*>(p.ycat8 + (size_t)t * D + c0) =
          pack_i8x4(bflo(fq[c].x) * inv, bfhi(fq[c].x) * inv, bflo(fq[c].y) * inv, bfhi(fq[c].y) * inv);
      *reinterpret_cast<uint32_t*>(p.ycat8 + (size_t)t * D + 1024 + c0) = pack_i8x4(y[c][0] * inv, y[c][1] * inv, y[c][2] * inv, y[c][3] * inv);
    }
    if (lane == 0) p.yscale[t] = am * (1.f / 127.f);
  }
  quant_weight_rows_i8(p.w_out_t, p.wo8, p.woscale, D, bid, nb);
}

__device__ void phase_outproj(const Params& p, int bid, int nb, char* smem) {
  const bool aware = (nb & 7) == 0;
  const int start = aware ? (bid >> 3) : bid, step = aware ? (nb >> 3) : nb, end = aware ? 64 : 512;
  const bf16_t* a8 = reinterpret_cast<const bf16_t*>(p.ycat8);
  const bf16_t* b8 = reinterpret_cast<const bf16_t*>(p.wo8);
  for (int it = start; it < end; it += step) {
    const int x = aware ? (bid & 7) : (it >> 6), s_ = aware ? it : (it & 63);
    EpiBf16 epi{reinterpret_cast<bf16_t*>(p.y_x), D};
    gemm_tile_n256<true>(a8, D / 2, b8, D / 2, D / 2, (8 * x + (s_ & 7)) * 128, (s_ >> 3) * 256, epi, smem, p.yscale, p.woscale);
  }
}
__device__ void phase_postmix(const Params& p, int bid, int nb, char* smem) {
  const int lane = threadIdx.x & 63, w = threadIdx.x >> 6;
  for (int t = bid * 4 + w; t < T; t += nb * 4) {
    const int b = t / L;
    float4 y[8];
    float ss = 0.f;
#pragma unroll
    for (int c = 0; c < 8; ++c) {
      {
        const uint2 yq = *reinterpret_cast<const uint2*>(reinterpret_cast<const bf16_t*>(p.y_x) + (size_t)t * D + c * 256 + lane * 4);
        y[c] = float4{bflo(yq.x), bfhi(yq.x), bflo(yq.y), bfhi(yq.y)};
      }
      ss += y[c].x * y[c].x + y[c].y * y[c].y + y[c].z * y[c].z + y[c].w * y[c].w;
    }
    ss = wave_sum_fast(ss);
    const float rstd = rsqrtf(ss * (1.f / D) + EPS);
    const float* gm = p.mod + (size_t)b * NMOD + 2 * D;
    float ss1 = 0.f;
#pragma unroll
    for (int c = 0; c < 8; ++c) {
      const int e0 = c * 256 + lane * 4;
      const float4 xv = *reinterpret_cast<const float4*>(p.x + (size_t)t * D + e0);
      const float4 g4 = *reinterpret_cast<const float4*>(gm + e0), gp = *reinterpret_cast<const float4*>(p.g_post_mix + e0);
      y[c].x = xv.x + g4.x * (y[c].x * rstd * gp.x); y[c].y = xv.y + g4.y * (y[c].y * rstd * gp.y);
      y[c].z = xv.z + g4.z * (y[c].z * rstd * gp.z); y[c].w = xv.w + g4.w * (y[c].w * rstd * gp.w);
      ss1 += y[c].x * y[c].x + y[c].y * y[c].y + y[c].z * y[c].z + y[c].w * y[c].w;
    }
    if (lane == 0) p.partial[t] = rstd;
    ss1 = wave_sum_fast(ss1);
    const float rstd1 = rsqrtf(ss1 * (1.f / D) + EPS);
    const float* sf = p.mod + (size_t)b * NMOD + 3 * D;
    const float* cf = p.mod + (size_t)b * NMOD + 4 * D;
#pragma unroll
    for (int c = 0; c < 8; ++c) {
      const int e0 = c * 256 + lane * 4;
      const float4 g = *reinterpret_cast<const float4*>(p.g_pre_ffn + e0);
      const float4 s4 = *reinterpret_cast<const float4*>(cf + e0), h4 = *reinterpret_cast<const float4*>(sf + e0);
      uint2 pk;
      pk.x = pack2(y[c].x * rstd1 * g.x * (1.f + s4.x) + h4.x, y[c].y * rstd1 * g.y * (1.f + s4.y) + h4.y);
      pk.y = pack2(y[c].z * rstd1 * g.z * (1.f + s4.z) + h4.z, y[c].w * rstd1 * g.w * (1.f + s4.w) + h4.w);
      *reinterpret_cast<uint2*>(p.hx + (size_t)t * D + e0) = pk;
    }
  }
}

__device__ __forceinline__ uint32_t mono_key(float f) {
  uint32_t u = __float_as_uint(f);
  return (u & 0x80000000u) ? ~u : (u | 0x80000000u);
}
__device__ __forceinline__ void ins16(uint32_t (&Lk)[16], uint32_t x) {
#pragma unroll
  for (int i = 0; i < 16; ++i) { uint32_t hi = max(Lk[i], x); x = min(Lk[i], x); Lk[i] = hi; }
}
__device__ __forceinline__ float unmono_key(uint32_t k) {
  return __uint_as_float((k & 0x80000000u) ? (k ^ 0x80000000u) : ~k);
}
typedef __attribute__((ext_vector_type(16))) float f32x16;
__device__ void phase_q_route(const Params& p, int bid, int nb, char* smem) {
  const int tid = opaque_tid(), lane = tid & 63, w = tid >> 6;
  const int wm = w >> 1, wn = w & 1, lr = lane & 15, lq = lane >> 4;
  const int l31 = lane & 31, lh = lane >> 5;
  for (int tile0 = bid; tile0 < 512; tile0 += nb) {
    const int tile = ((nb & 7) == 0 && nb >= 512) ? (((tile0 & 7) * 8 + ((tile0 >> 3) & 7)) * 8 + (tile0 >> 6)) : tile0;
    const int h = tile & 7, m0 = (tile >> 3) * 128;
    {
      f32x4 acc[4][4];
      gemm_mainloop(p.hx, D, p.w_q_t, D, D, m0, h * 128, acc, smem);
#pragma unroll
      for (int i = 0; i < 4; ++i)
#pragma unroll
        for (int j = 0; j < 4; ++j)
#pragma unroll
          for (int r = 0; r < 4; ++r) {
            const int row = wm * 64 + i * 16 + lq * 4 + r, col = wn * 64 + j * 16 + lr;
            *reinterpret_cast<bf16_t*>(smem + swz16(row, col >> 3) + (col & 7) * 2) = f2bf(acc[i][j][r]);
          }
    }
#pragma unroll 4
    for (int r = 0; r < 16; ++r) {
      const int id = tid + 256 * r, row = id >> 4, c4 = id & 15;
      const float* src = ((row < 128) ? p.sk1 : p.sk2) + ((size_t)(h * 128 + (row & 127)) * 64 + c4 * 4);
      const float4 v = *reinterpret_cast<const float4*>(src);
      uint2 pk; pk.x = pack2(v.x, v.y); pk.y = pack2(v.z, v.w);
      *reinterpret_cast<uint2*>(smem + 32768 + swz8(row, c4 >> 1) + (c4 & 1) * 8) = pk;
    }
    __syncthreads();
    uint32_t L1[16], L2[16];
#pragma unroll
    for (int sd = 0; sd < 2; ++sd) {
      uint32_t Lk[16];
#pragma unroll
      for (int i = 0; i < 16; ++i) Lk[i] = 0u;
      const uint32_t kb = (uint32_t)(lh * 4);
#pragma unroll
      for (int ih = 0; ih < 2; ++ih) {
        f32x16 Sa[2];
#pragma unroll
        for (int i = 0; i < 2; ++i)
#pragma unroll
          for (int g2 = 0; g2 < 16; ++g2) Sa[i][g2] = 0.f;
#pragma unroll
        for (int ks = 0; ks < 4; ++ks) {
          const bf16x8 qb = *reinterpret_cast<const bf16x8*>(smem + swz16(w * 32 + l31, sd * 8 + ks * 2 + lh));
#pragma unroll
          for (int i = 0; i < 2; ++i) {
            const bf16x8 ka = *reinterpret_cast<const bf16x8*>(smem + 32768 + swz8(sd * 128 + (ih * 2 + i) * 32 + l31, ks * 2 + lh));
            Sa[i] = __builtin_amdgcn_mfma_f32_32x32x16_bf16(ka, qb, Sa[i], 0, 0, 0);
          }
        }
#pragma unroll
        for (int i = 0; i < 2; ++i)
#pragma unroll
          for (int g2 = 0; g2 < 16; ++g2)
            ins16(Lk, (mono_key(Sa[i][g2]) & ~0x7Fu) | (uint32_t)((ih * 2 + i) * 32 + (g2 & 3) + 8 * (g2 >> 2)) | kb);
      }
#pragma unroll
      for (int i = 0; i < 8; ++i) {
        const uint32_t t1 = (uint32_t)__shfl_xor((int)Lk[15 - i], 32), t2 = (uint32_t)__shfl_xor((int)Lk[i], 32);
        Lk[i] = max(Lk[i], t1); Lk[15 - i] = max(Lk[15 - i], t2);
      }
#pragma unroll
      for (int dd = 8; dd >= 1; dd >>= 1)
#pragma unroll
        for (int i = 0; i < 16; ++i)
          if ((i & dd) == 0) { const uint32_t hi = max(Lk[i], Lk[i + dd]), lo = min(Lk[i], Lk[i + dd]); Lk[i] = hi; Lk[i + dd] = lo; }
#pragma unroll
      for (int r = 0; r < 16; ++r) { if (sd == 0) L1[r] = Lk[r]; else L2[r] = Lk[r]; }
    }
    __syncthreads();
    uint32_t* ib = reinterpret_cast<uint32_t*>(smem) + w * 1088 + l31 * 34;
    if (lh == 0) {
#pragma unroll
      for (int r = 0; r < 16; ++r) { ib[r] = L1[r] & 127u; ib[16 + r] = L2[r] & 127u; }
    }
    float v1[16], v2[16];
#pragma unroll
    for (int r = 0; r < 16; ++r) { v1[r] = unmono_key(L1[r] & ~0x7Fu); v2[r] = unmono_key(L2[r] & ~0x7Fu); }
    uint32_t C[16];
#pragma unroll
    for (int i = 0; i < 16; ++i) C[i] = 0u;
#pragma unroll
    for (int a = 0; a < 16; ++a)
#pragma unroll
      for (int bq = 0; bq < 16; ++bq)
        if ((a + 1) * (bq + 1) <= 16) ins16(C, (mono_key(v1[a] + v2[bq]) & ~0xFFu) | (uint32_t)(a * 16 + bq));
    float ts[16]; int te[16];
    __builtin_amdgcn_wave_barrier();
#pragma unroll
    for (int r = 0; r < 16; ++r) {
      const uint32_t code = C[r] & 0xFFu;
      te[r] = (int)(ib[code >> 4] * 128u + ib[16 + (code & 15u)]);
      ts[r] = unmono_key(C[r] & ~0xFFu);
    }
    const float mx = ts[0];
    float den = 0.f;
#pragma unroll
    for (int r = 0; r < 16; ++r) { ts[r] = __expf(ts[r] - mx); den += ts[r]; }
    const float inv = 1.f / den;
    const size_t ob = (size_t)(m0 + w * 32 + l31) * 128 + h * 16;
    if (lh == 0) {
#pragma unroll
      for (int r = 0; r < 16; r += 4) *reinterpret_cast<int4*>(p.idx + ob + r) = int4{te[r], te[r + 1], te[r + 2], te[r + 3]};
    } else {
#pragma unroll
      for (int r = 0; r < 16; r += 4)
        *reinterpret_cast<float4*>(p.gate + ob + r) = float4{ts[r] * inv, ts[r + 1] * inv, ts[r + 2] * inv, ts[r + 3] * inv};
    }
    __syncthreads();
  }
}

typedef __attribute__((ext_vector_type(2))) float f32x2;
__device__ __forceinline__ void fp8x16_to_f32(const uint4 q, f32x2 (&o)[8]) {
  o[0] = __builtin_amdgcn_cvt_pk_f32_fp8((int)q.x, false); o[1] = __builtin_amdgcn_cvt_pk_f32_fp8((int)q.x, true);
  o[2] = __builtin_amdgcn_cvt_pk_f32_fp8((int)q.y, false); o[3] = __builtin_amdgcn_cvt_pk_f32_fp8((int)q.y, true);
  o[4] = __builtin_amdgcn_cvt_pk_f32_fp8((int)q.z, false); o[5] = __builtin_amdgcn_cvt_pk_f32_fp8((int)q.z, true);
  o[6] = __builtin_amdgcn_cvt_pk_f32_fp8((int)q.w, false); o[7] = __builtin_amdgcn_cvt_pk_f32_fp8((int)q.w, true);
}
__device__ __forceinline__ unsigned my_xcc_id() { return (unsigned)__builtin_amdgcn_s_getreg((3 << 11) | 20) & 7u; }

__device__ void phase_exp_u(const Params& p, char* smem) {
  const int tid = opaque_tid(), lane = tid & 63, w = tid >> 6;
  const int sub = lane >> 4, cc = lane & 15;
  const unsigned myx = my_xcc_id();
  int* sh = reinterpret_cast<int*>(smem);
  int* si = reinterpret_cast<int*>(smem + 64) + w * 256;
  float* pbuf = reinterpret_cast<float*>(p.ycat);
  {
    unsigned qcur = 0;
    for (;;) {
      __syncthreads();
      if (tid == 0) {
        int found = -1; unsigned fx = 0;
        for (; qcur < 8; ++qcur) {
          fx = (myx + qcur) & 7u;
          const int c = (int)atomicAdd(&p.ctr[16 + fx], 1u);
          if (c < 256) { found = c; break; }
        }
        sh[0] = found; sh[1] = (int)fx;
      }
      __syncthreads();
      const int chunk = sh[0];
      const unsigned x = (unsigned)sh[1];
      if (chunk < 0) break;
      for (int tt = 0; tt < 8; ++tt) {
        const int t = chunk * 32 + w * 8 + tt;
        __builtin_amdgcn_wave_barrier();
        si[lane] = p.idx[(size_t)t * 128 + lane]; si[64 + lane] = p.idx[(size_t)t * 128 + 64 + lane];
        __builtin_amdgcn_wave_barrier();
        f32x2 hf[8];
#pragma unroll
        for (int q2 = 0; q2 < 2; ++q2) {
          const uint4 hq = *reinterpret_cast<const uint4*>(p.hx + (size_t)t * D + x * 256 + cc * 16 + q2 * 8);
          hf[q2 * 4 + 0] = f32x2{bflo(hq.x), bfhi(hq.x)}; hf[q2 * 4 + 1] = f32x2{bflo(hq.y), bfhi(hq.y)};
          hf[q2 * 4 + 2] = f32x2{bflo(hq.z), bfhi(hq.z)}; hf[q2 * 4 + 3] = f32x2{bflo(hq.w), bfhi(hq.w)};
        }
        const uint8_t* ub = p.U8 + (size_t)x * ((size_t)16384 * 256) + cc * 16;
        uint4 qa[8], qb[8];
#define EU_LOAD(q_, bt_) _Pragma("unroll") for (int k = 0; k < 8; ++k) q_[k] = *reinterpret_cast<const uint4*>(ub + (size_t)si[((bt_) * 8 + k) * 4 + sub] * 256)
#define EU_COMP(q_, kb_)                                                                                                \
  _Pragma("unroll") for (int k = 0; k < 8; ++k) {                                                                       \
    f32x2 uf[8];                                                                                                        \
    fp8x16_to_f32(q_[k], uf);                                                                                           \
    f32x2 d2 = hf[0] * uf[0];                                                                                           \
    _Pragma("unroll") for (int e = 1; e < 8; ++e) d2 += hf[e] * uf[e];                                                  \
    float d = d2.x + d2.y;                                                                                              \
    d += dpp_mov<0xB1>(d); d += dpp_mov<0x4E>(d); d += dpp_mov<0x124>(d); d += dpp_mov<0x128>(d);                       \
    mine = (cc == (kb_) + k) ? d : mine;                                                                                \
  }
        float mine = 0.f;
        EU_LOAD(qa, 0); EU_LOAD(qb, 1);
        EU_COMP(qa, 0); EU_LOAD(qa, 2);
        EU_COMP(qb, 8); EU_LOAD(qb, 3);
        pbuf[((size_t)x * T + t) * 128 + cc * 4 + sub] = mine * (1.f / 512.f);
        mine = 0.f;
        EU_COMP(qa, 0);
        EU_COMP(qb, 8);
        pbuf[((size_t)x * T + t) * 128 + (16 + cc) * 4 + sub] = mine * (1.f / 512.f);
#undef EU_LOAD
#undef EU_COMP
      }
    }
  }
}

__device__ void phase_exp_v(const Params& p, char* smem) {
  const int tid = opaque_tid(), lane = tid & 63, w = tid >> 6;
  const int sub = lane >> 4, cc = lane & 15;
  const unsigned myx = my_xcc_id();
  int* sh = reinterpret_cast<int*>(smem);
  int* si = reinterpret_cast<int*>(smem + 64) + w * 256;
  float* sc = reinterpret_cast<float*>(si + 128);
  bf16_t* yfb = reinterpret_cast<bf16_t*>(p.y_x) + (size_t)T * D;
  {
    unsigned qcur = 0;
    for (;;) {
      __syncthreads();
      if (tid == 0) {
        int found = -1; unsigned fx = 0;
        for (; qcur < 8; ++qcur) {
          fx = (myx + qcur) & 7u;
          const int c = (int)atomicAdd(&p.ctr[32 + fx], 1u);
          if (c < 256) { found = c; break; }
        }
        sh[0] = found; sh[1] = (int)fx;
      }
      __syncthreads();
      const int chunk = sh[0];
      const unsigned x = (unsigned)sh[1];
      if (chunk < 0) break;
      for (int tt = 0; tt < 8; ++tt) {
        const int t = chunk * 32 + w * 8 + tt;
        __builtin_amdgcn_wave_barrier();
        si[lane] = p.idx[(size_t)t * 128 + lane]; si[64 + lane] = p.idx[(size_t)t * 128 + 64 + lane];
        {
          const float* pb = reinterpret_cast<const float*>(p.ycat) + (size_t)t * 128;
          float d0 = 0.f, d1 = 0.f;
#pragma unroll
          for (int xs = 0; xs < 8; ++xs) { d0 += pb[(size_t)xs * T * 128 + lane]; d1 += pb[(size_t)xs * T * 128 + 64 + lane]; }
          sc[lane] = p.gate[(size_t)t * 128 + lane] * 0.5f * d0 * (1.f + erff(d0 * 0.70710678118654752f));
          sc[64 + lane] = p.gate[(size_t)t * 128 + 64 + lane] * 0.5f * d1 * (1.f + erff(d1 * 0.70710678118654752f));
        }
        __builtin_amdgcn_wave_barrier();
        f32x2 acc[8];
#pragma unroll
        for (int e = 0; e < 8; ++e) acc[e] = f32x2{0.f, 0.f};
        const uint8_t* vb = p.V8 + (size_t)x * ((size_t)16384 * 256) + cc * 16;
        uint4 qa[8], qb[8];
#define EV_LOAD(q_, bt_) _Pragma("unroll") for (int k = 0; k < 8; ++k) q_[k] = *reinterpret_cast<const uint4*>(vb + (size_t)si[((bt_) * 8 + k) * 4 + sub] * 256)
#define EV_COMP(q_, bt_)                                                                                                \
  _Pragma("unroll") for (int k = 0; k < 8; ++k) {                                                                       \
    f32x2 vf[8];                                                                                                        \
    fp8x16_to_f32(q_[k], vf);                                                                                           \
    const float cfk = sc[((bt_) * 8 + k) * 4 + sub];                                                                    \
    const f32x2 c2 = f32x2{cfk, cfk};                                                                                   \
    _Pragma("unroll") for (int e = 0; e < 8; ++e) acc[e] += c2 * vf[e];                                                 \
  }
        EV_LOAD(qa, 0); EV_LOAD(qb, 1);
        EV_COMP(qa, 0); EV_LOAD(qa, 2);
        EV_COMP(qb, 1); EV_LOAD(qb, 3);
        EV_COMP(qa, 2);
        EV_COMP(qb, 3);
#undef EV_LOAD
#undef EV_COMP
        {
          float* red = reinterpret_cast<float*>(smem + 8192) + w * 1280;
          float* mr = red + (sub * 16 + cc) * 20;
#pragma unroll
          for (int q4 = 0; q4 < 4; ++q4)
            *reinterpret_cast<float4*>(mr + q4 * 4) = float4{acc[q4 * 2].x, acc[q4 * 2].y, acc[q4 * 2 + 1].x, acc[q4 * 2 + 1].y};
          __builtin_amdgcn_wave_barrier();
          const int part = sub;
          float4 r0 = *reinterpret_cast<const float4*>(red + (0 * 16 + cc) * 20 + part * 4);
          float4 r1 = *reinterpret_cast<const float4*>(red + (1 * 16 + cc) * 20 + part * 4);
          float4 r2 = *reinterpret_cast<const float4*>(red + (2 * 16 + cc) * 20 + part * 4);
          float4 r3 = *reinterpret_cast<const float4*>(red + (3 * 16 + cc) * 20 + part * 4);
          const float sc512 = 1.f / 512.f;
          uint2 o4;
          o4.x = pack2((r0.x + r1.x + r2.x + r3.x) * sc512, (r0.y + r1.y + r2.y + r3.y) * sc512);
          o4.y = pack2((r0.z + r1.z + r2.z + r3.z) * sc512, (r0.w + r1.w + r2.w + r3.w) * sc512);
          *reinterpret_cast<uint2*>(yfb + (size_t)t * D + x * 256 + cc * 16 + part * 4) = o4;
          __builtin_amdgcn_wave_barrier();
        }
      }
    }
  }
}

__device__ void phase_exp_final(const Params& p, int bid, int nb, char* smem) {
  const int lane = threadIdx.x & 63, w = threadIdx.x >> 6;
  const bf16_t* ymix = reinterpret_cast<const bf16_t*>(p.y_x);
  const bf16_t* yf = reinterpret_cast<const bf16_t*>(p.y_x) + (size_t)T * D;
  for (int t = bid * 4 + w; t < T; t += nb * 4) {
    const int b = t / L;
    float4 y[8], xo[8];
#pragma unroll
    for (int c = 0; c < 8; ++c) {
      const uint2 yq = *reinterpret_cast<const uint2*>(yf + (size_t)t * D + c * 256 + lane * 4);
      y[c] = float4{bflo(yq.x), bfhi(yq.x), bflo(yq.y), bfhi(yq.y)};
      xo[c] = *reinterpret_cast<const float4*>(p.x + (size_t)t * D + c * 256 + lane * 4);
    }
    const float rmix = p.partial[t];
    float ss = 0.f;
#pragma unroll
    for (int c = 0; c < 8; ++c) ss += y[c].x * y[c].x + y[c].y * y[c].y + y[c].z * y[c].z + y[c].w * y[c].w;
    ss = wave_sum_fast(ss);
    const float rstd = rsqrtf(ss * (1.f / D) + EPS);
    const float* gfx = p.mod + (size_t)b * NMOD + 5 * D;
    const float* gm = p.mod + (size_t)b * NMOD + 2 * D;
#pragma unroll
    for (int c = 0; c < 8; ++c) {
      const int e0 = c * 256 + lane * 4;
      const uint2 mq = *reinterpret_cast<const uint2*>(ymix + (size_t)t * D + e0);
      const float4 m4 = float4{bflo(mq.x), bfhi(mq.x), bflo(mq.y), bfhi(mq.y)};
      const float4 g4 = *reinterpret_cast<const float4*>(gfx + e0), gp = *reinterpret_cast<const float4*>(p.g_post_ffn + e0);
      const float4 h4 = *reinterpret_cast<const float4*>(gm + e0), hp = *reinterpret_cast<const float4*>(p.g_post_mix + e0);
      xo[c].x += h4.x * (m4.x * rmix * hp.x) + g4.x * (y[c].x * rstd * gp.x);
      xo[c].y += h4.y * (m4.y * rmix * hp.y) + g4.y * (y[c].y * rstd * gp.y);
      xo[c].z += h4.z * (m4.z * rmix * hp.z) + g4.z * (y[c].z * rstd * gp.z);
      xo[c].w += h4.w * (m4.w * rmix * hp.w) + g4.w * (y[c].w * rstd * gp.w);
      *reinterpret_cast<float4*>(p.out + (size_t)t * D + e0) = xo[c];
    }
  }
}

#define XB_TMO      128
#define XB_XCNT(j)  (256  + 64 * (j))
#define XB_XSUB(j)  (1280 + 64 * (j))
#define XB_XGEN(j)  (2304 + 64 * (j))
#define XB_TOP      3328
#define XB_TOPGEN   3392
#define XCD_BAR_WORDS 3456
#define XB_SPIN_CAP (1u << 22)
#define LAS __attribute__((address_space(3)))
__device__ __forceinline__ unsigned xb_ld(unsigned* p)              { return __hip_atomic_load(p, __ATOMIC_RELAXED, __HIP_MEMORY_SCOPE_AGENT); }
__device__ __forceinline__ unsigned xb_add(unsigned* p, unsigned v) { return __hip_atomic_fetch_add(p, v, __ATOMIC_RELAXED, __HIP_MEMORY_SCOPE_AGENT); }
__device__ __forceinline__ unsigned xb_xcc_id() { return (unsigned)__builtin_amdgcn_s_getreg((3 << 11) | 20) & 0xFu; }
#define XB_SPIN(cond, bar) do { unsigned _sp = 0; while (cond) { __builtin_amdgcn_s_sleep(1); \
    if ((++_sp & 255u) == 0u) { if (xb_ld(&(bar)[XB_TMO])) break; if (_sp > XB_SPIN_CAP) { atomicAdd(&(bar)[XB_TMO], 1u); break; } } } } while (0)
struct XcdBarrier { unsigned* bar; unsigned x; volatile LAS unsigned* st; };
__device__ __forceinline__ XcdBarrier xcd_barrier_post(unsigned* bar, volatile LAS unsigned* st) {
  XcdBarrier b; b.bar = bar; b.x = xb_xcc_id(); b.st = st;
  if (threadIdx.x == 0) (void)xb_add(&bar[XB_XCNT(b.x)], 1u);
  return b;
}
__device__ __forceinline__ void xcd_barrier_complete(unsigned* bar, unsigned x, unsigned& nloc, unsigned& nx) {
  const unsigned G = gridDim.x * gridDim.y * gridDim.z;
  unsigned sum, cnt, mine, sp = 0u;
  for (;;) {
    sum = 0u; cnt = 0u; mine = 0u;
#pragma unroll
    for (unsigned j = 0; j < 16; ++j) { const unsigned c = xb_ld(&bar[XB_XCNT(j)]); sum += c; cnt += (c > 0u) ? 1u : 0u; mine = (j == x) ? c : mine; }
    if (sum == G) break;
    __builtin_amdgcn_s_sleep(1);
    if ((++sp & 255u) == 0u) { if (xb_ld(&bar[XB_TMO])) break; if (sp > XB_SPIN_CAP) { atomicAdd(&bar[XB_TMO], 1u); break; } }
  }
  nloc = mine > 0u ? mine : 1u; nx = cnt > 0u ? cnt : 1u;
}
__device__ __forceinline__ void xcd_barrier(const XcdBarrier& b) {
  asm volatile("s_waitcnt vmcnt(0)" ::: "memory");
  __syncthreads();
  if (threadIdx.x == 0) {
    unsigned* bar = b.bar;
    __builtin_amdgcn_s_waitcnt(0);
    unsigned nloc = b.st[0], nx = b.st[1];
    if (nloc == 0u) { xcd_barrier_complete(bar, b.x, nloc, nx); b.st[0] = nloc; b.st[1] = nx; }
    const unsigned old = xb_add(&bar[XB_XSUB(b.x)], 1u);
    const unsigned gen = old / nloc;
    if (old + 1u == (gen + 1u) * nloc) {
      __builtin_amdgcn_fence(__ATOMIC_RELEASE, "agent");
      asm volatile("s_waitcnt vmcnt(0)" ::: "memory");
      const unsigned og = xb_add(&bar[XB_TOP], 1u);
      const unsigned tg = og / nx;
      if (og + 1u == (tg + 1u) * nx) xb_add(&bar[XB_TOPGEN], 1u);
      else XB_SPIN(xb_ld(&bar[XB_TOPGEN]) == tg, bar);
      __builtin_amdgcn_fence(__ATOMIC_ACQUIRE, "agent");
      xb_add(&bar[XB_XGEN(b.x)], 1u);
      asm volatile("s_waitcnt vmcnt(0)" ::: "memory");
    } else {
      XB_SPIN(xb_ld(&bar[XB_XGEN(b.x)]) == gen, bar);
      __builtin_amdgcn_fence(__ATOMIC_ACQUIRE, "agent");
      asm volatile("s_waitcnt vmcnt(0)" ::: "memory");
    }
  }
  __syncthreads();
}

__global__ void __launch_bounds__(NTHREADS, 2) fwd_mega(Params p) {
  __shared__ __attribute__((aligned(16))) char smem[75808];
  const int bid = blockIdx.x, nb = gridDim.x;
  volatile LAS unsigned* st = (volatile LAS unsigned*)(smem + 75792);
  if (threadIdx.x == 0) { st[0] = 0u; st[1] = 0u; }
  __syncthreads();
  const XcdBarrier bar = xcd_barrier_post(p.bar, st);
  phase_prep(p, bid, nb, smem);        xcd_barrier(bar);
  phase_fold(p, bid, nb, smem);        xcd_barrier(bar);
  phase_norm_mod(p, bid, nb, smem);    xcd_barrier(bar);
  phase_inproj(p, bid, nb, smem);      xcd_barrier(bar);
  phase_ssm_pre(p, bid, nb, smem);     xcd_barrier(bar);
  phase_ssd_dft(p, bid, nb, smem);     xcd_barrier(bar);
  phase_ssm_post(p, bid, nb, smem);    xcd_barrier(bar);
  phase_outproj(p, bid, nb, smem);     xcd_barrier(bar);
  phase_postmix(p, bid, nb, smem);     xcd_barrier(bar);
  phase_q_route(p, bid, nb, smem);     xcd_barrier(bar);
  phase_exp_u(p, smem);                xcd_barrier(bar);
  phase_exp_v(p, smem);                xcd_barrier(bar);
  phase_exp_final(p, bid, nb, smem);
}

}

extern "C" void kernel_launch(void* const* d_in, const int* in_sizes, int n_in, void* d_out, int out_size, void* d_ws,
                              size_t ws_size, hipStream_t stream) {
  Params p{};
  const float** fp = reinterpret_cast<const float**>(&p);
  for (int i = 0; i < 27; ++i) fp[i] = (const float*)d_in[i];
  p.out = (float*)d_out;
  char* ws = (char*)d_ws;
  size_t off = 0;
  auto take = [&](size_t bytes) { char* r = ws + off; off += (bytes + 255) & ~(size_t)255; return r; };
  p.U8 = (uint8_t*)take((size_t)16384 * D);
  p.V8 = (uint8_t*)take((size_t)16384 * D);
  p.hx8a = (int8_t*)take((size_t)(T + TC) * D);
  p.w8 = (int8_t*)take((size_t)NPROJ * D);
  p.ascale = (float*)take((size_t)(T + TC) * 4);
  p.wscale = (float*)take((size_t)NPROJ * 4);
  p.ycat8 = (int8_t*)take((size_t)T * D);
  p.wo8 = (int8_t*)take((size_t)D * D);
  p.yscale = (float*)take((size_t)T * 4);
  p.woscale = (float*)take((size_t)D * 4);
  p.w_in_t = (bf16_t*)take((size_t)NPROJ * D * 2);
  p.w_out_t = (bf16_t*)take((size_t)D * D * 2);
  p.w_q_t = (bf16_t*)take((size_t)1024 * D * 2);
  p.w_in_f = (bf16_t*)take((size_t)D * 1024 * 2);
  p.WcsT = (bf16_t*)take((size_t)4 * 512 * 256 * 2);
  p.dftm = (bf16_t*)take((size_t)1024 * 2048 * 2);
  p.Fs = (bf16_t*)take((size_t)NB * 1024 * 2048 * 2);
  p.partial = (float*)take((size_t)KSPLIT * 5 * NMOD * 4);
  p.mod = (float*)take((size_t)5 * NMOD * 4);
  p.hx = (bf16_t*)take((size_t)T * D * 2);
  p.hc = (bf16_t*)take((size_t)TC * D * 2);
  p.ABt = (bf16_t*)take((size_t)NB * 1024 * 4096 * 2);
  p.q = (float*)p.ABt;
  p.z = (bf16_t*)take((size_t)T * 1024 * 2);
  char* r1 = take(0);
  p.xbcraw = (bf16_t*)take((size_t)T * DXBC * 4);
  p.xbcraw_c = (bf16_t*)take((size_t)TC * DXBC * 4);
  p.act_tm = (bf16_t*)take((size_t)(T + TC) * DXBC * 2);
  p.act_cm_x = (bf16_t*)take((size_t)NB * 1280 * L * 2);
  p.act_cm_c = (bf16_t*)take((size_t)NB * 1280 * CTX * 2);
  p.y_x = (float*)r1;
  p.dtraw = (float*)take((size_t)T * 32 * 4);
  p.dtraw_c = (float*)take((size_t)TC * 32 * 4);
  p.dtf = (float*)take((size_t)T * 16 * 4);
  p.dtb = (float*)take((size_t)T * 16 * 4);
  p.dtf_c = (float*)take((size_t)TC * 16 * 4);
  p.dtb_c = (float*)take((size_t)TC * 16 * 4);
  p.yf = (float*)take((size_t)T * 1024 * 4);
  p.yb = (float*)take((size_t)T * 1024 * 4);
  p.ctr = (unsigned*)take(256);
  p.bar = (unsigned*)take((size_t)XCD_BAR_WORDS * 4);
  p.ycat = (bf16_t*)take((size_t)T * D * 2);
  p.idx = (int*)take((size_t)T * 128 * 4);
  p.gate = (float*)take((size_t)T * 128 * 4);
  if (off > ws_size) { fprintf(stderr, "kernel_launch: workspace too small: need %zu have %zu\n", off, ws_size); return; }
  static int grid_blocks = 0;
  if (!grid_blocks) {
    int dev = 0, cus = 0, per_cu = 0;
    hipGetDevice(&dev);
    hipDeviceGetAttribute(&cus, hipDeviceAttributeMultiprocessorCount, dev);
    hipOccupancyMaxActiveBlocksPerMultiprocessor(&per_cu, fwd_mega, NTHREADS, 0);
    if (per_cu > 2) per_cu = 2;
    grid_blocks = cus * per_cu;
    if (grid_blocks <= 0) { fprintf(stderr, "kernel_launch: occupancy query gave %d x %d\n", cus, per_cu); grid_blocks = -1; }
  }
  if (grid_blocks < 0) return;
  (void)hipMemsetAsync(p.bar, 0, (size_t)XCD_BAR_WORDS * 4, stream);
  void* args[] = {&p};
  hipError_t e = hipLaunchCooperativeKernel((void*)fwd_mega, dim3(grid_blocks), dim3(NTHREADS), args, 0, stream);
  if (e != hipSuccess) fprintf(stderr, "cooperative launch failed: %s (grid %d)\n", hipGetErrorString(e), grid_blocks);
}
```

```cpp
#include <hip/hip_runtime.h>
#include <hip/hip_cooperative_groups.h>
#include <stdint.h>
#include <stdio.h>

namespace cg = cooperative_groups;
namespace {

typedef __attribute__((ext_vector_type(8))) short bf16x8;
typedef __attribute__((ext_vector_type(4))) float f32x4;
typedef unsigned short bf16_t;

constexpr int D = 2048, NB = 4, L = 2048, T = NB * L, CTX = 256, TC = NB * CTX;
constexpr int NMOD = 6 * D;
constexpr int NH = 16, HP = 64, NS = 128, DXBC = 1536;
constexpr int DIN = 3616;
constexpr int NPROJ = 4736;
constexpr int KSPLIT = 32;
constexpr float EPS = 1e-6f;
constexpr int NTHREADS = 256;

__device__ __forceinline__ bf16_t f2bf(float f) { __bf16 h = (__bf16)f; return __builtin_bit_cast(unsigned short, h); }
__device__ __forceinline__ float bf2f(bf16_t h) { return __uint_as_float(((uint32_t)h) << 16); }
__device__ __forceinline__ uint32_t pack2(float a, float b) {
  typedef __attribute__((ext_vector_type(2))) __bf16 bf16x2_t;
  typedef __attribute__((ext_vector_type(2))) float f32x2_t;
  const f32x2_t v = {a, b};
  return __builtin_bit_cast(uint32_t, __builtin_convertvector(v, bf16x2_t));
}
__device__ __forceinline__ float bflo(uint32_t w) { return __uint_as_float(w << 16); }
__device__ __forceinline__ float bfhi(uint32_t w) { return __uint_as_float(w & 0xffff0000u); }
__device__ __forceinline__ float silu_f(float v) { return v / (1.f + __expf(-v)); }
__device__ __forceinline__ float softplus_f(float v) { return v > 20.f ? v : log1pf(__expf(v)); }

__device__ __forceinline__ int opaque_tid() { int t = threadIdx.x; asm volatile("" : "+v"(t)); return t; }
__device__ __forceinline__ float wave_sum(float v) {
#pragma unroll
  for (int o = 32; o > 0; o >>= 1) v += __shfl_xor(v, o);
  return v;
}
template <int CTRL>
__device__ __forceinline__ float dpp_mov(float v) {
  return __int_as_float(__builtin_amdgcn_update_dpp(0, __float_as_int(v), CTRL, 0xF, 0xF, true));
}
template <int CTRL>
__device__ __forceinline__ int dpp_movi(int v) { return __builtin_amdgcn_update_dpp(0, v, CTRL, 0xF, 0xF, true); }
__device__ __forceinline__ float wave_sum_fast(float v) {
  v += dpp_mov<0xB1>(v); v += dpp_mov<0x4E>(v); v += dpp_mov<0x124>(v); v += dpp_mov<0x128>(v);
  v += __shfl_xor(v, 16); v += __shfl_xor(v, 32);
  return v;
}
__device__ __forceinline__ float wave_max(float v) {
#pragma unroll
  for (int o = 32; o > 0; o >>= 1) v = fmaxf(v, __shfl_xor(v, o));
  return v;
}
__device__ __forceinline__ float block_sum(float v, float* red) {
  v = wave_sum(v);
  __syncthreads();
  if ((threadIdx.x & 63) == 0) red[threadIdx.x >> 6] = v;
  __syncthreads();
  return red[0] + red[1] + red[2] + red[3];
}

struct Params {
  const float *x, *c, *ctx, *c_ctx, *w_mod, *b_mod, *g_pre_mix, *g_post_mix, *g_pre_ffn, *g_post_ffn;
  const float *w_in, *w_fmix, *conv_w, *conv_b, *dt_bias_f, *dt_bias_b, *a_log_f, *a_log_b, *d_skip_f, *d_skip_b;
  const float *ssm_norm_w, *w_out, *w_query, *sk1, *sk2, *eu, *ev;
  float* out;
  uint8_t *U8, *V8;
  float* uscale;
  int8_t *hx8a, *w8;
  float *ascale, *wscale;
  int8_t *ycat8, *wo8;
  float *yscale, *woscale;
  bf16_t *w_in_t, *w_out_t, *w_q_t, *w_in_f, *WcsT, *dftm, *Fs;
  float *partial, *mod;
  bf16_t *hx, *hc, *ABt, *z;
  bf16_t *xbcraw, *xbcraw_c;
  float *dtraw, *dtraw_c, *dtf, *dtb, *dtf_c, *dtb_c;
  bf16_t *act_tm, *act_cm_x, *act_cm_c;
  float *yf, *yb;
  unsigned* ctr; unsigned* bar;
  bf16_t* ycat;
  float *y_x, *q, *gate;
  int* idx;
  int pad0, pad1;
};

template <bool I8 = false>
__device__ __forceinline__ void gemm_mainloop(const bf16_t* __restrict__ A, int lda, const bf16_t* __restrict__ Bt, int ldb,
                                              int K, int m0, int n0, f32x4 (&acc)[4][4], char* smem) {
  const int tid = opaque_tid(), lane = tid & 63, w = tid >> 6;
  const int wm = w >> 1, wn = w & 1;
#pragma unroll
  for (int i = 0; i < 4; ++i)
#pragma unroll
    for (int j = 0; j < 4; ++j) acc[i][j] = f32x4{0.f, 0.f, 0.f, 0.f};

  const int nk = K / 64;
  const int rowoff = lane >> 3, lch = (lane & 7) ^ rowoff;
  const bf16_t* gA = A + (size_t)(m0 + w * 8 + rowoff) * lda + lch * 8;
  const bf16_t* gB = Bt + (size_t)(n0 + w * 8 + rowoff) * ldb + lch * 8;
#define GSTAGE(buf_, kt_)                                                                                               \
  do {                                                                                                                  \
    _Pragma("unroll") for (int i_ = 0; i_ < 4; ++i_) {                                                                  \
      __builtin_amdgcn_global_load_lds((const unsigned*)(gA + (size_t)(i_ * 32) * lda + (kt_) * 64),                    \
                                       (unsigned*)(smem + (buf_) * 32768 + (i_ * 4 + w) * 1024), 16, 0, 0);             \
      __builtin_amdgcn_global_load_lds((const unsigned*)(gB + (size_t)(i_ * 32) * ldb + (kt_) * 64),                    \
                                       (unsigned*)(smem + (buf_) * 32768 + 16384 + (i_ * 4 + w) * 1024), 16, 0, 0);     \
    }                                                                                                                   \
  } while (0)
  GSTAGE(0, 0);
  asm volatile("s_waitcnt vmcnt(0)" ::: "memory");
  __syncthreads();
  for (int kt = 0; kt < nk; ++kt) {
    const int cur = kt & 1;
    if (kt + 1 < nk) GSTAGE(cur ^ 1, kt + 1);
    const char* sA = smem + cur * 32768;
    const char* sB = sA + 16384;
#pragma unroll
    for (int kk = 0; kk < 2; ++kk) {
      bf16x8 af[4], bfr[4];
      const int ch = kk * 4 + (lane >> 4);
#pragma unroll
      for (int i = 0; i < 4; ++i) {
        int row = wm * 64 + i * 16 + (lane & 15);
        af[i] = *reinterpret_cast<const bf16x8*>(sA + row * 128 + ((ch ^ (row & 7)) << 4));
        int col = wn * 64 + i * 16 + (lane & 15);
        bfr[i] = *reinterpret_cast<const bf16x8*>(sB + col * 128 + ((ch ^ (col & 7)) << 4));
      }
#pragma unroll
      for (int i = 0; i < 4; ++i)
#pragma unroll
        for (int j = 0; j < 4; ++j) {
          if (I8) {
            typedef __attribute__((ext_vector_type(4))) int i32x4;
            acc[i][j] = __builtin_bit_cast(f32x4, __builtin_amdgcn_mfma_i32_16x16x64_i8(__builtin_bit_cast(i32x4, af[i]), __builtin_bit_cast(i32x4, bfr[j]),
                                                                                         __builtin_bit_cast(i32x4, acc[i][j]), 0, 0, 0));
          } else {
            acc[i][j] = __builtin_amdgcn_mfma_f32_16x16x32_bf16(af[i], bfr[j], acc[i][j], 0, 0, 0);
          }
        }
    }
    asm volatile("s_waitcnt vmcnt(0)" ::: "memory");
    __syncthreads();
  }
#undef GSTAGE
}

template <bool I8 = false, class Epi>
__device__ __forceinline__ void gemm_tile(const bf16_t* __restrict__ A, int lda, const bf16_t* __restrict__ Bt, int ldb,
                                          int K, int m0, int n0, const Epi& epi, char* smem,
                                          const float* __restrict__ rscale = nullptr, const float* __restrict__ cscale = nullptr) {
  const int lane = threadIdx.x & 63, w = threadIdx.x >> 6;
  const int wm = w >> 1, wn = w & 1;
  f32x4 acc[4][4];
  gemm_mainloop<I8>(A, lda, Bt, ldb, K, m0, n0, acc, smem);
#pragma unroll
  for (int i = 0; i < 4; ++i) {
    const int row = m0 + wm * 64 + i * 16 + (lane >> 4) * 4;
    float4 rs = float4{1.f, 1.f, 1.f, 1.f};
    if (I8) rs = *reinterpret_cast<const float4*>(rscale + row);
#pragma unroll
    for (int j = 0; j < 4; ++j) {
      const int col = n0 + wn * 64 + j * 16 + (lane & 15);
      if (I8) {
        typedef __attribute__((ext_vector_type(4))) int i32x4;
        const i32x4 ia = __builtin_bit_cast(i32x4, acc[i][j]);
        const float cs = cscale[col];
        epi(row, col, f32x4{(float)ia[0] * rs.x * cs, (float)ia[1] * rs.y * cs, (float)ia[2] * rs.z * cs, (float)ia[3] * rs.w * cs});
      } else {
        epi(row, col, acc[i][j]);
      }
    }
  }
}

template <bool I8>
__device__ __forceinline__ void gemm_mainloop_n256(const bf16_t* __restrict__ A, int lda, const bf16_t* __restrict__ Bt, int ldb,
                                                   int K, int m0, int n0, f32x4 (&acc)[4][8], char* smem) {
  const int tid = opaque_tid(), lane = tid & 63, w = tid >> 6;
  const int wm = w >> 1, wn = w & 1;
#pragma unroll
  for (int i = 0; i < 4; ++i)
#pragma unroll
    for (int j = 0; j < 8; ++j) acc[i][j] = f32x4{0.f, 0.f, 0.f, 0.f};
  const int nk = K / 64;
  const int rowoff = lane >> 3, lch = (lane & 7) ^ rowoff;
  const bf16_t* gA = A + (size_t)(m0 + w * 8 + rowoff) * lda + lch * 8;
  const bf16_t* gB = Bt + (size_t)(n0 + w * 8 + rowoff) * ldb + lch * 8;
  const int fr = lane & 15, fq = lane >> 4;
  for (int kt = 0; kt < nk; ++kt) {
#pragma unroll
    for (int i_ = 0; i_ < 4; ++i_)
      __builtin_amdgcn_global_load_lds((const unsigned*)(gA + (size_t)(i_ * 32) * lda + kt * 64),
                                       (unsigned*)(smem + (i_ * 4 + w) * 1024), 16, 0, 0);
#pragma unroll
    for (int i_ = 0; i_ < 8; ++i_)
      __builtin_amdgcn_global_load_lds((const unsigned*)(gB + (size_t)(i_ * 32) * ldb + kt * 64),
                                       (unsigned*)(smem + 16384 + (i_ * 4 + w) * 1024), 16, 0, 0);
    asm volatile("s_waitcnt vmcnt(0)" ::: "memory");
    __syncthreads();
    const char* sA = smem;
    const char* sB = smem + 16384;
#pragma unroll
    for (int kk = 0; kk < 2; ++kk) {
      bf16x8 af[4], bfr[8];
      const int ch = kk * 4 + fq;
#pragma unroll
      for (int i = 0; i < 4; ++i) {
        const int row = wm * 64 + i * 16 + fr;
        af[i] = *reinterpret_cast<const bf16x8*>(sA + row * 128 + ((ch ^ (row & 7)) << 4));
      }
#pragma unroll
      for (int j = 0; j < 8; ++j) {
        const int col = wn * 128 + j * 16 + fr;
        bfr[j] = *reinterpret_cast<const bf16x8*>(sB + col * 128 + ((ch ^ (col & 7)) << 4));
      }
#pragma unroll
      for (int i = 0; i < 4; ++i)
#pragma unroll
        for (int j = 0; j < 8; ++j) {
          if (I8) {
            typedef __attribute__((ext_vector_type(4))) int i32x4;
            acc[i][j] = __builtin_bit_cast(f32x4, __builtin_amdgcn_mfma_i32_16x16x64_i8(__builtin_bit_cast(i32x4, af[i]), __builtin_bit_cast(i32x4, bfr[j]),
                                                                                         __builtin_bit_cast(i32x4, acc[i][j]), 0, 0, 0));
          } else {
            acc[i][j] = __builtin_amdgcn_mfma_f32_16x16x32_bf16(af[i], bfr[j], acc[i][j], 0, 0, 0);
          }
        }
    }
    __syncthreads();
  }
}
template <bool I8, class Epi>
__device__ __forceinline__ void gemm_tile_n256(const bf16_t* __restrict__ A, int lda, const bf16_t* __restrict__ Bt, int ldb,
                                               int K, int m0, int n0, const Epi& epi, char* smem,
                                               const float* __restrict__ rscale = nullptr, const float* __restrict__ cscale = nullptr) {
  const int lane = threadIdx.x & 63, w = threadIdx.x >> 6;
  const int wm = w >> 1, wn = w & 1;
  f32x4 acc[4][8];
  gemm_mainloop_n256<I8>(A, lda, Bt, ldb, K, m0, n0, acc, smem);
#pragma unroll
  for (int i = 0; i < 4; ++i) {
    const int row = m0 + wm * 64 + i * 16 + (lane >> 4) * 4;
    float4 rs = float4{1.f, 1.f, 1.f, 1.f};
    if (I8) rs = *reinterpret_cast<const float4*>(rscale + row);
#pragma unroll
    for (int j = 0; j < 8; ++j) {
      const int col = n0 + wn * 128 + j * 16 + (lane & 15);
      if (I8) {
        typedef __attribute__((ext_vector_type(4))) int i32x4;
        const i32x4 ia = __builtin_bit_cast(i32x4, acc[i][j]);
        const float cs = cscale[col];
        epi(row, col, f32x4{(float)ia[0] * rs.x * cs, (float)ia[1] * rs.y * cs, (float)ia[2] * rs.z * cs, (float)ia[3] * rs.w * cs});
      } else {
        epi(row, col, acc[i][j]);
      }
    }
  }
}

__device__ __forceinline__ float wave_max_fast(float v) {
  v = fmaxf(v, dpp_mov<0xB1>(v)); v = fmaxf(v, dpp_mov<0x4E>(v)); v = fmaxf(v, dpp_mov<0x124>(v)); v = fmaxf(v, dpp_mov<0x128>(v));
  v = fmaxf(v, __shfl_xor(v, 16)); v = fmaxf(v, __shfl_xor(v, 32));
  return v;
}
__device__ __forceinline__ uint32_t pack_i8x4(float a, float b, float c, float d) {
  const int ia = __float2int_rn(a), ib = __float2int_rn(b), ic = __float2int_rn(c), id = __float2int_rn(d);
  return (uint32_t)(ia & 255) | ((uint32_t)(ib & 255) << 8) | ((uint32_t)(ic & 255) << 16) | ((uint32_t)id << 24);
}
struct EpiF32 {
  float* C; int ldc;
  __device__ __forceinline__ void operator()(int row, int col, f32x4 v) const {
#pragma unroll
    for (int r = 0; r < 4; ++r) C[(size_t)(row + r) * ldc + col] = v[r];
  }
};
struct EpiBf16 {
  bf16_t* C; int ldc;
  __device__ __forceinline__ void operator()(int row, int col, f32x4 v) const {
#pragma unroll
    for (int r = 0; r < 4; ++r) C[(size_t)(row + r) * ldc + col] = f2bf(v[r]);
  }
};
struct EpiBf16T {
  bf16_t* Ct; int ldc;
  __device__ __forceinline__ void operator()(int row, int col, f32x4 v) const {
    uint2 pk; pk.x = pack2(v[0], v[1]); pk.y = pack2(v[2], v[3]);
    *reinterpret_cast<uint2*>(Ct + (size_t)col * ldc + row) = pk;
  }
};
struct EpiInAB {
  bf16_t* ABt; int seqlen;
  __device__ __forceinline__ void operator()(int row, int col, f32x4 v) const {
    const int ch = col & 1023, half = col >> 10;
    const int b = row / seqlen, l = row - b * seqlen;
    uint2 pk; pk.x = pack2(v[0], v[1]); pk.y = pack2(v[2], v[3]);
    *reinterpret_cast<uint2*>(ABt + ((size_t)(b * 1024 + ch) * 4096 + half * 2048 + l)) = pk;
  }
};
struct EpiInZ {
  bf16_t* z;
  __device__ __forceinline__ void operator()(int row, int col, f32x4 v) const {
#pragma unroll
    for (int r = 0; r < 4; ++r) z[(size_t)(row + r) * 1024 + (col - 2048)] = f2bf(v[r]);
  }
};
struct EpiInXbc {
  bf16_t* xbcraw;
  __device__ __forceinline__ void operator()(int row, int col, f32x4 v) const {
#pragma unroll
    for (int r = 0; r < 4; ++r) xbcraw[(size_t)(row + r) * DXBC + (col - 3072)] = f2bf(v[r]);
  }
};
struct EpiInProj {
  bf16_t* ABt; bf16_t* z; bf16_t* xbcraw; float* dtraw; int seqlen;
  __device__ __forceinline__ void operator()(int row, int col, f32x4 v) const {
    if (col < 2048) {
      int ch = col & 1023, half = col >> 10;
      int b = row / seqlen, l = row - b * seqlen;
      uint2 pk; pk.x = pack2(v[0], v[1]); pk.y = pack2(v[2], v[3]);
      *reinterpret_cast<uint2*>(ABt + ((size_t)(b * 1024 + ch) * 4096 + half * 2048 + l)) = pk;
    } else if (col < 3072) {
#pragma unroll
      for (int r = 0; r < 4; ++r) z[(size_t)(row + r) * 1024 + (col - 2048)] = f2bf(v[r]);
    } else if (col < 4608) {
#pragma unroll
      for (int r = 0; r < 4; ++r) xbcraw[(size_t)(row + r) * DXBC + (col - 3072)] = f2bf(v[r]);
    } else if (col < 4640) {
#pragma unroll
      for (int r = 0; r < 4; ++r) dtraw[(size_t)(row + r) * 32 + (col - 4608)] = v[r];
    }
  }
};

__device__ void adaln_partial_task(const Params& p, int task, float* sm) {
  const int cb = task % 48, ks = task / 48, tid = threadIdx.x;
  float* sc = sm;
  __syncthreads();
  for (int i = tid; i < 5 * 64; i += NTHREADS) {
    int r = i >> 6, kk = i & 63;
    int k = ks * 64 + kk;
    float cv = (r < 4) ? p.c[r * D + k] : p.c_ctx[k];
    sc[i] = silu_f(cv);
  }
  __syncthreads();
  const int col = cb * 256 + tid;
  float a0 = 0, a1 = 0, a2 = 0, a3 = 0, a4 = 0;
  const float* wp = p.w_mod + (size_t)(ks * 64) * NMOD + col;
#pragma unroll
  for (int h2 = 0; h2 < 2; ++h2) {
    float wv[32];
#pragma unroll
    for (int kk = 0; kk < 32; ++kk) wv[kk] = __builtin_nontemporal_load(wp + (size_t)(h2 * 32 + kk) * NMOD);
#pragma unroll
    for (int kk = 0; kk < 32; ++kk) {
      const int k = h2 * 32 + kk;
      a0 += sc[k] * wv[kk]; a1 += sc[64 + k] * wv[kk]; a2 += sc[128 + k] * wv[kk]; a3 += sc[192 + k] * wv[kk]; a4 += sc[256 + k] * wv[kk];
    }
  }
  float* pp = p.partial + (size_t)ks * 5 * NMOD + col;
  pp[0] = a0; pp[NMOD] = a1; pp[2 * NMOD] = a2; pp[3 * NMOD] = a3; pp[4 * NMOD] = a4;
}

__device__ void transpose_convert_task(const float* __restrict__ src, int ld, int c0, int rows, bf16_t* __restrict__ dst,
                                       int tr, int tc, float* sm) {
  float (*tile)[68] = reinterpret_cast<float (*)[68]>(sm);
  const int tid = threadIdx.x;
  __syncthreads();
  {
    float4 v[4];
#pragma unroll
    for (int k = 0; k < 4; ++k) {
      const int i = tid + k * NTHREADS, r = i >> 4, c4 = i & 15;
      v[k] = *reinterpret_cast<const float4*>(src + (size_t)(tr * 64 + r) * ld + c0 + tc * 64 + c4 * 4);
    }
#pragma unroll
    for (int k = 0; k < 4; ++k) {
      const int i = tid + k * NTHREADS, r = i >> 4, c4 = i & 15;
      *reinterpret_cast<float4*>(&tile[r][c4 * 4]) = v[k];
    }
  }
  __syncthreads();
#pragma unroll
  for (int k = 0; k < 4; ++k) {
    const int i = tid + k * NTHREADS, cc = i >> 4, r4 = (i & 15) * 4;
    uint2 o; o.x = pack2(tile[r4][cc], tile[r4 + 1][cc]); o.y = pack2(tile[r4 + 2][cc], tile[r4 + 3][cc]);
    *reinterpret_cast<uint2*>(dst + (size_t)(tc * 64 + cc) * rows + tr * 64 + r4) = o;
  }
}

__device__ void phase_prep(const Params& p, int bid, int nb, char* smem) {
  float* sm = reinterpret_cast<float*>(smem);
  const int tid = threadIdx.x;
  if (bid == 0 && tid < 64) p.ctr[tid] = 0u;
  {
    float* t256 = reinterpret_cast<float*>(smem + 20480);
    float* t2048 = reinterpret_cast<float*>(smem + 24576);
    t256[tid] = cospif((float)tid * (1.0f / 128.f));
    for (int i = tid; i < 2048; i += NTHREADS) t2048[i] = cospif((float)i * (1.0f / 1024.f));
    __syncthreads();
  }
  for (int t = bid; t < 48 * KSPLIT; t += nb) adaln_partial_task(p, t, sm);
  {
    const int nct = 41, nrt = 32;
    for (int t = bid; t < nct * nrt; t += nb) {
      int tc = t % nct, tr = t / nct;
      if (tc < 40) transpose_convert_task(p.w_in, DIN, 1024, D, p.w_in_t + (size_t)2048 * D, tr, tc, sm);
      else {
        float (*tile)[65] = reinterpret_cast<float (*)[65]>(sm);
        __syncthreads();
        for (int i = tid; i < 64 * 32; i += NTHREADS) {
          int r = i >> 5, cc = i & 31;
          tile[r][cc] = p.w_in[(size_t)(tr * 64 + r) * DIN + 1024 + 2560 + cc];
        }
        __syncthreads();
        for (int i = tid; i < 32 * 32; i += NTHREADS) {
          int cc = i >> 5, r2 = (i & 31) * 2;
          uint32_t pk = pack2(tile[r2][cc], tile[r2 + 1][cc]);
          *reinterpret_cast<uint32_t*>(p.w_in_t + (size_t)(2048 + 2560 + cc) * D + tr * 64 + r2) = pk;
        }
      }
    }
    for (size_t i = (size_t)bid * NTHREADS + tid; i < (size_t)96 * D / 8; i += (size_t)nb * NTHREADS)
      reinterpret_cast<uint4*>(p.w_in_t + (size_t)4640 * D)[i] = uint4{0, 0, 0, 0};
  }
  for (size_t i = (size_t)bid * NTHREADS + tid; i < (size_t)D * 1024 / 4; i += (size_t)nb * NTHREADS) {
    int k = (int)(i / 256), c4 = (int)(i % 256) * 4;
    float4 v = *reinterpret_cast<const float4*>(p.w_in + (size_t)k * DIN + c4);
    uint2 o; o.x = pack2(v.x, v.y); o.y = pack2(v.z, v.w);
    *reinterpret_cast<uint2*>(p.w_in_f + (size_t)k * 1024 + c4) = o;
  }
  {
    const float* t256 = reinterpret_cast<const float*>(smem + 20480);
    const float scale = 1.0f / sqrtf((float)L * 256.f);
    for (int i = bid * NTHREADS + tid; i < 4 * 64 * 256; i += nb * NTHREADS) {
      const int d = i & 255, cg = (i >> 8) & 63, g = i >> 14;
      float sc_[4] = {0.f, 0.f, 0.f, 0.f}, ss_[4] = {0.f, 0.f, 0.f, 0.f};
      const float* wp = p.w_fmix + (size_t)g * 65536 + d;
#pragma unroll 4
      for (int m = 0; m < 256; ++m) {
        const float wv = wp[m * 256];
#pragma unroll
        for (int j = 0; j < 4; ++j) {
          const int ph = (m * (cg * 4 + j)) & 255;
          sc_[j] += t256[ph] * wv; ss_[j] += t256[(ph - 64) & 255] * wv;
        }
      }
#pragma unroll
      for (int j = 0; j < 4; ++j) {
        const int c = cg * 4 + j;
        p.WcsT[((size_t)g * 512 + d) * 256 + c] = f2bf(sc_[j] * scale);
        p.WcsT[((size_t)g * 512 + 256 + d) * 256 + c] = f2bf(ss_[j] * scale);
      }
    }
  }
  {
    const float* t2048 = reinterpret_cast<const float*>(smem + 24576);
    for (size_t i = (size_t)bid * NTHREADS + tid; i < (size_t)1024 * 2048 / 8; i += (size_t)nb * NTHREADS) {
      const int k = (int)(i / 256), j = (int)(i % 256) * 8;
      const bool iss = j >= 1024;
      float o[8];
#pragma unroll
      for (int e = 0; e < 8; ++e) {
        const int l = (j + e) & 1023;
        const int ph = (k * l) & 2047;
        o[e] = iss ? t2048[(ph - 512) & 2047] : t2048[ph];
      }
      uint4 pk; pk.x = pack2(o[0], o[1]); pk.y = pack2(o[2], o[3]); pk.z = pack2(o[4], o[5]); pk.w = pack2(o[6], o[7]);
      *reinterpret_cast<uint4*>(p.dftm + (size_t)k * 2048 + j) = pk;
    }
  }
}

__device__ void phase_fold(const Params& p, int bid, int nb, char* smem) {
  const int tid = threadIdx.x;
  for (int i = bid * NTHREADS + tid; i < 5 * NMOD; i += nb * NTHREADS) {
    int col = i % NMOD;
    float s = p.b_mod[col];
    for (int ks = 0; ks < KSPLIT; ++ks) s += p.partial[(size_t)ks * 5 * NMOD + i];
    p.mod[i] = s;
  }
  for (int t = bid; t < 256; t += nb) {
    int g = t >> 6, tm = (t & 63) >> 2, tn = t & 3;
    int n0 = tn * 128;
    int rowbase = (n0 < 256) ? (g * 256 + n0) : (1024 + g * 256 + (n0 - 256));
    EpiBf16T epi{p.w_in_t + (size_t)(rowbase - n0) * D, D};
    gemm_tile(p.w_in_f + g * 256, 1024, p.WcsT + (size_t)g * 512 * 256, 256, 256, tm * 128, n0, epi, smem);
  }
}

__device__ __forceinline__ void quant_weight_rows_i8(const bf16_t* __restrict__ src, int8_t* __restrict__ dst, float* __restrict__ scl,
                                                     int nrows, int bid, int nb) {
  const int lane = threadIdx.x & 63, w = threadIdx.x >> 6;
  for (int n = bid * 4 + w; n < nrows; n += nb * 4) {
    const bf16_t* wr = src + (size_t)n * D;
    uint4 q[4];
#pragma unroll
    for (int c = 0; c < 4; ++c) q[c] = *reinterpret_cast<const uint4*>(wr + c * 512 + lane * 8);
    float am = 0.f;
#pragma unroll
    for (int c = 0; c < 4; ++c) {
      am = fmaxf(am, fmaxf(fmaxf(fabsf(bflo(q[c].x)), fabsf(bfhi(q[c].x))), fmaxf(fabsf(bflo(q[c].y)), fabsf(bfhi(q[c].y)))));
      am = fmaxf(am, fmaxf(fmaxf(fabsf(bflo(q[c].z)), fabsf(bfhi(q[c].z))), fmaxf(fabsf(bflo(q[c].w)), fabsf(bfhi(q[c].w)))));
    }
    am = wave_max_fast(am);
    const float inv = (am > 0.f) ? 127.f / am : 0.f;
#pragma unroll
    for (int c = 0; c < 4; ++c) {
      uint2 o;
      o.x = pack_i8x4(bflo(q[c].x) * inv, bfhi(q[c].x) * inv, bflo(q[c].y) * inv, bfhi(q[c].y) * inv);
      o.y = pack_i8x4(bflo(q[c].z) * inv, bfhi(q[c].z) * inv, bflo(q[c].w) * inv, bfhi(q[c].w) * inv);
      *reinterpret_cast<uint2*>(dst + (size_t)n * D + c * 512 + lane * 8) = o;
    }
    if (lane == 0) scl[n] = am * (1.f / 127.f);
  }
}

__device__ void phase_norm_mod(const Params& p, int bid, int nb, char* smem) {
  const int lane = threadIdx.x & 63, w = threadIdx.x >> 6;
  for (int t = bid * 4 + w; t < T + TC; t += nb * 4) {
    const bool isx = t < T;
    const float* src = isx ? (p.x + (size_t)t * D) : (p.ctx + (size_t)(t - T) * D);
    const int mrow = isx ? (t / L) : 4;
    bf16_t* dst = isx ? (p.hx + (size_t)t * D) : (p.hc + (size_t)(t - T) * D);
    float4 v[8];
    float ss = 0.f;
#pragma unroll
    for (int c = 0; c < 8; ++c) {
      v[c] = *reinterpret_cast<const float4*>(src + c * 256 + lane * 4);
      ss += v[c].x * v[c].x + v[c].y * v[c].y + v[c].z * v[c].z + v[c].w * v[c].w;
    }
    ss = wave_sum_fast(ss);
    const float rstd = rsqrtf(ss * (1.f / D) + EPS);
    const float* sh = p.mod + (size_t)mrow * NMOD + 0 * D;
    const float* sc = p.mod + (size_t)mrow * NMOD + 1 * D;
    float am = 0.f;
#pragma unroll
    for (int c = 0; c < 8; ++c) {
      const int e0 = c * 256 + lane * 4;
      const float4 g = *reinterpret_cast<const float4*>(p.g_pre_mix + e0);
      const float4 s4 = *reinterpret_cast<const float4*>(sc + e0), h4 = *reinterpret_cast<const float4*>(sh + e0);
      v[c].x = v[c].x * rstd * g.x * (1.f + s4.x) + h4.x; v[c].y = v[c].y * rstd * g.y * (1.f + s4.y) + h4.y;
      v[c].z = v[c].z * rstd * g.z * (1.f + s4.z) + h4.z; v[c].w = v[c].w * rstd * g.w * (1.f + s4.w) + h4.w;
      am = fmaxf(am, fmaxf(fmaxf(fabsf(v[c].x), fabsf(v[c].y)), fmaxf(fabsf(v[c].z), fabsf(v[c].w))));
      uint2 pk;
      pk.x = pack2(v[c].x, v[c].y);
      pk.y = pack2(v[c].z, v[c].w);
      *reinterpret_cast<uint2*>(dst + e0) = pk;
    }
    {
      am = wave_max_fast(am);
      const float inv = (am > 0.f) ? 127.f / am : 0.f;
#pragma unroll
      for (int c = 0; c < 8; ++c)
        *reinterpret_cast<uint32_t*>(p.hx8a + (size_t)t * D + c * 256 + lane * 4) = pack_i8x4(v[c].x * inv, v[c].y * inv, v[c].z * inv, v[c].w * inv);
      if (lane == 0) p.ascale[t] = am * (1.f / 127.f);
    }
  }
  quant_weight_rows_i8(p.w_in_t, p.w8, p.wscale, NPROJ, bid, nb);
}

__device__ __forceinline__ void convert_v_units(const Params& p, size_t u0, size_t u1) {
  for (size_t j = u0 + threadIdx.x; j < u1; j += NTHREADS) {
    uint32_t o[4];
#pragma unroll
    for (int q4 = 0; q4 < 4; ++q4) {
      const float4 v = *reinterpret_cast<const float4*>(p.ev + j * 16 + q4 * 4);
      int pk = 0;
      pk = __builtin_amdgcn_cvt_pk_fp8_f32(v.x * 512.f, v.y * 512.f, pk, false);
      pk = __builtin_amdgcn_cvt_pk_fp8_f32(v.z * 512.f, v.w * 512.f, pk, true);
      o[q4] = (uint32_t)pk;
    }
    const size_t e_ = j >> 7, r_ = j & 127;
    *reinterpret_cast<uint4*>(p.V8 + (r_ >> 4) * ((size_t)16384 * 256) + e_ * 256 + (r_ & 15) * 16) = uint4{o[0], o[1], o[2], o[3]};
  }
}
__device__ __forceinline__ void convert_u_rows(const Params& p, int q) {
  const int lane = threadIdx.x & 63, w = threadIdx.x >> 6;
  const int row0 = q * 32 + w * 8;
#pragma unroll 1
  for (int rr = 0; rr < 8; rr += 2) {
    f32x4 va[8], vb[8];
#pragma unroll
    for (int k = 0; k < 8; ++k) va[k] = __builtin_nontemporal_load(reinterpret_cast<const f32x4*>(p.eu + (size_t)(row0 + rr) * D + k * 256 + lane * 4));
#pragma unroll
    for (int k = 0; k < 8; ++k) vb[k] = __builtin_nontemporal_load(reinterpret_cast<const f32x4*>(p.eu + (size_t)(row0 + rr + 1) * D + k * 256 + lane * 4));
#define CONV_U_EMIT(v_, row_)                                                                                           \
    {                                                                                                                   \
      float m = 0.f;                                                                                                    \
      _Pragma("unroll") for (int k = 0; k < 8; ++k)                                                                     \
        m = fmaxf(m, fmaxf(fmaxf(fabsf(v_[k][0]), fabsf(v_[k][1])), fmaxf(fabsf(v_[k][2]), fabsf(v_[k][3]))));        \
      m = wave_max_fast(m);                                                                                             \
      const float inv = (m > 0.f) ? 127.f / m : 0.f;                                                                    \
      _Pragma("unroll") for (int k = 0; k < 8; ++k)                                                                     \
        *reinterpret_cast<uint32_t*>(p.U8 + (size_t)k * ((size_t)16384 * 256) + (size_t)(row_) * 256 + lane * 4) =      \
            pack_i8x4(v_[k][0] * inv, v_[k][1] * inv, v_[k][2] * inv, v_[k][3] * inv);                                  \
      if (lane == 0) p.uscale[row_] = m * (1.f / 127.f);                                                                \
    }
    CONV_U_EMIT(va, row0 + rr);
    CONV_U_EMIT(vb, row0 + rr + 1);
#undef CONV_U_EMIT
  }
}
__device__ void phase_inproj(const Params& p, int bid, int nb, char* smem) {
  if ((nb & 7) == 0) {
    const int x = bid & 7, rank = bid >> 3, per = nb >> 3;
    const bf16_t* a8 = reinterpret_cast<const bf16_t*>(p.hx8a);
    const bf16_t* b8 = reinterpret_cast<const bf16_t*>(p.w8);
    for (int s_ = rank; s_ < 128 + 53; s_ += per) {
      if (s_ < 128) {
        const int tn2 = s_ >> 3, m0_ = (8 * x + (s_ & 7)) * 128;
        if (tn2 < 8) { EpiInAB epi{p.ABt, L}; gemm_tile_n256<true>(a8, D / 2, b8, D / 2, D / 2, m0_, tn2 * 256, epi, smem, p.ascale, p.wscale); }
        else if (tn2 < 12) { EpiInZ epi{p.z}; gemm_tile_n256<true>(a8, D / 2, b8, D / 2, D / 2, m0_, tn2 * 256, epi, smem, p.ascale, p.wscale); }
        else { EpiInXbc epi{p.xbcraw}; gemm_tile_n256<true>(a8, D / 2, b8, D / 2, D / 2, m0_, tn2 * 256, epi, smem, p.ascale, p.wscale); }
      } else if (s_ < 128 + 40) {
        const int i = s_ - 128;
        EpiInProj epi{p.ABt, p.z, p.xbcraw, p.dtraw, L};
        gemm_tile<true>(a8, D / 2, b8, D / 2, D / 2, (8 * x + (i & 7)) * 128, (32 + (i >> 3)) * 128, epi, smem, p.ascale, p.wscale);
      } else {
        const int u = x * 13 + (s_ - 168);
        EpiInProj epi{nullptr, nullptr, p.xbcraw_c, p.dtraw_c, CTX};
        gemm_tile<true>(reinterpret_cast<const bf16_t*>(p.hx8a + (size_t)T * D), D / 2, b8, D / 2, D / 2, (u / 13) * 128, 3072 + (u % 13) * 128, epi, smem,
                        p.ascale + T, p.wscale);
      }
    }
    return;
  }
  const int ntx = 64 * 37, ntc = 8 * 13;
  for (int t = bid; t < ntx + ntc; t += nb) {
    if (t < ntx) {
      int tm = t / 37, tn = t % 37;
      EpiInProj epi{p.ABt, p.z, p.xbcraw, p.dtraw, L};
      gemm_tile(p.hx, D, p.w_in_t, D, D, tm * 128, tn * 128, epi, smem);
    } else {
      int u = t - ntx;
      int tm = u / 13, tn = u % 13;
      EpiInProj epi{nullptr, nullptr, p.xbcraw_c, p.dtraw_c, CTX};
      gemm_tile(p.hc, D, p.w_in_t, D, D, tm * 128, 3072 + tn * 128, epi, smem);
    }
  }
}

__device__ void ssm_pre_tile(const Params& p, int task, char* smem) {
  const bool isx = task < 3072;
  const int u = isx ? task : task - 3072;
  const int ntt = isx ? 32 : 4;
  const int ct = u % 24, tt = (u / 24) % ntt, b = u / (24 * ntt);
  const int seqlen = isx ? L : CTX;
  const bf16_t* raw = (isx ? p.xbcraw : p.xbcraw_c) + (size_t)b * seqlen * DXBC;
  const int l0 = tt * 64, c0 = ct * 64, tid = threadIdx.x;
  float (*rt)[68] = reinterpret_cast<float (*)[68]>(smem);
  float (*at)[65] = reinterpret_cast<float (*)[65]>(smem + 66 * 68 * 4);
  __syncthreads();
  {
    uint2 v[5];
#pragma unroll
    for (int k = 0; k < 5; ++k) {
      const int i = tid + k * NTHREADS, r = i >> 4, c4 = i & 15, l = l0 - 1 + r;
      v[k] = (i < 66 * 16 && l >= 0 && l < seqlen) ? *reinterpret_cast<const uint2*>(raw + (size_t)l * DXBC + c0 + c4 * 4) : uint2{0u, 0u};
    }
#pragma unroll
    for (int k = 0; k < 5; ++k) {
      const int i = tid + k * NTHREADS, r = i >> 4, c4 = i & 15;
      if (i < 66 * 16) *reinterpret_cast<float4*>(&rt[r][c4 * 4]) = float4{bflo(v[k].x), bfhi(v[k].x), bflo(v[k].y), bfhi(v[k].y)};
    }
  }
  __syncthreads();
  {
    const int cc = tid & 63, c = c0 + cc;
    const float w0 = p.conv_w[c], w1 = p.conv_w[DXBC + c], w2 = p.conv_w[2 * DXBC + c], cb = p.conv_b[c];
#pragma unroll 4
    for (int r = tid >> 6; r < 64; r += 4) at[r][cc] = silu_f(cb + rt[r][cc] * w0 + rt[r + 1][cc] * w1 + rt[r + 2][cc] * w2);
  }
  __syncthreads();
  const size_t trow0 = isx ? ((size_t)b * L + l0) : ((size_t)T + (size_t)b * CTX + l0);
#pragma unroll
  for (int k = 0; k < 4; ++k) {
    const int i = tid + k * NTHREADS, r = i >> 4, c4 = (i & 15) * 4;
    uint2 o; o.x = pack2(at[r][c4], at[r][c4 + 1]); o.y = pack2(at[r][c4 + 2], at[r][c4 + 3]);
    *reinterpret_cast<uint2*>(p.act_tm + (trow0 + r) * DXBC + c0 + c4) = o;
  }
  if (c0 < 1280) {
    bf16_t* cm = (isx ? p.act_cm_x : p.act_cm_c) + (size_t)b * 1280 * seqlen;
#pragma unroll
    for (int k = 0; k < 4; ++k) {
      const int i = tid + k * NTHREADS, cc = i >> 4, r4 = (i & 15) * 4;
      uint2 o; o.x = pack2(at[r4][cc], at[r4 + 1][cc]); o.y = pack2(at[r4 + 2][cc], at[r4 + 3][cc]);
      *reinterpret_cast<uint2*>(cm + (size_t)(c0 + cc) * seqlen + l0 + r4) = o;
    }
  }
}
__device__ void dft_fold_rows(const Params& p, int bid, int nb, char* smem) {
  const int lane = threadIdx.x & 63, w = threadIdx.x >> 6;
  bf16_t* sr = reinterpret_cast<bf16_t*>(smem + w * 8192);
  for (int row = bid * 4 + w; row < NB * 1024; row += nb * 4) {
    const bf16_t* A = p.ABt + (size_t)row * 4096;
    bf16_t* F = p.Fs + (size_t)row * 2048;
    __builtin_amdgcn_wave_barrier();
    {
      const uint4 q0 = *reinterpret_cast<const uint4*>(A + (0 * 64 + lane) * 8), q1 = *reinterpret_cast<const uint4*>(A + (1 * 64 + lane) * 8);
      const uint4 q2 = *reinterpret_cast<const uint4*>(A + (2 * 64 + lane) * 8), q3 = *reinterpret_cast<const uint4*>(A + (3 * 64 + lane) * 8);
      const uint4 q4 = *reinterpret_cast<const uint4*>(A + (4 * 64 + lane) * 8), q5 = *reinterpret_cast<const uint4*>(A + (5 * 64 + lane) * 8);
      const uint4 q6 = *reinterpret_cast<const uint4*>(A + (6 * 64 + lane) * 8), q7 = *reinterpret_cast<const uint4*>(A + (7 * 64 + lane) * 8);
      *reinterpret_cast<uint4*>(sr + (0 * 64 + lane) * 8) = q0; *reinterpret_cast<uint4*>(sr + (1 * 64 + lane) * 8) = q1;
      *reinterpret_cast<uint4*>(sr + (2 * 64 + lane) * 8) = q2; *reinterpret_cast<uint4*>(sr + (3 * 64 + lane) * 8) = q3;
      *reinterpret_cast<uint4*>(sr + (4 * 64 + lane) * 8) = q4; *reinterpret_cast<uint4*>(sr + (5 * 64 + lane) * 8) = q5;
      *reinterpret_cast<uint4*>(sr + (6 * 64 + lane) * 8) = q6; *reinterpret_cast<uint4*>(sr + (7 * 64 + lane) * 8) = q7;
    }
    __builtin_amdgcn_wave_barrier();
    const int l0 = lane * 16;
    float alt = 0.f;
    uint32_t oa[8], ob[8];
#pragma unroll
    for (int half = 0; half < 2; ++half) {
      const bf16_t* base = sr + half * 2048;
      const uint4 fa = *reinterpret_cast<const uint4*>(base + l0), fb = *reinterpret_cast<const uint4*>(base + l0 + 8);
      const uint4 ra = *reinterpret_cast<const uint4*>(base + 2032 - l0), rb = *reinterpret_cast<const uint4*>(base + 2040 - l0);
      const float r16 = (lane > 0) ? bf2f(base[2048 - l0]) : 0.f;
      const uint32_t fw[8] = {fa.x, fa.y, fa.z, fa.w, fb.x, fb.y, fb.z, fb.w};
      const uint32_t rw[8] = {ra.x, ra.y, ra.z, ra.w, rb.x, rb.y, rb.z, rb.w};
      float v[16];
#pragma unroll
      for (int i = 0; i < 16; ++i) {
        const float fwv = (i & 1) ? bfhi(fw[i >> 1]) : bflo(fw[i >> 1]);
        const int j = 16 - i;
        const float rv = (i == 0) ? r16 : ((j & 1) ? bfhi(rw[j >> 1]) : bflo(rw[j >> 1]));
        if (half == 0) v[i] = (lane == 0 && i == 0) ? fwv : fwv + rv;
        else v[i] = (lane == 0 && i == 0) ? 0.f : fwv - rv;
      }
      if (half == 0) {
#pragma unroll
        for (int i = 0; i < 16; ++i) alt += (i & 1) ? -v[i] : v[i];
#pragma unroll
        for (int i = 0; i < 8; ++i) oa[i] = pack2(v[2 * i], v[2 * i + 1]);
      } else {
#pragma unroll
        for (int i = 0; i < 8; ++i) ob[i] = pack2(v[2 * i], v[2 * i + 1]);
      }
    }
    *reinterpret_cast<uint4*>(F + l0) = uint4{oa[0], oa[1], oa[2], oa[3]};
    *reinterpret_cast<uint4*>(F + l0 + 8) = uint4{oa[4], oa[5], oa[6], oa[7]};
    *reinterpret_cast<uint4*>(F + 1024 + l0) = uint4{ob[0], ob[1], ob[2], ob[3]};
    *reinterpret_cast<uint4*>(F + 1024 + l0 + 8) = uint4{ob[4], ob[5], ob[6], ob[7]};
    alt = wave_sum_fast(alt) + bf2f(sr[1024]);
    if (lane == 0) { const int b = row >> 10, ch = row & 1023; p.ycat[((size_t)b * L + 1024) * D + ch] = f2bf(alt); }
  }
}
__device__ void phase_ssm_pre(const Params& p, int bid, int nb, char* smem) {
  const int tid = threadIdx.x;
  dft_fold_rows(p, bid, nb, smem);
  for (int t = bid; t < 3072 + 384; t += nb) ssm_pre_tile(p, t, smem);
  for (int i = bid * NTHREADS + tid; i < (T + TC) * 32; i += nb * NTHREADS) {
    const bool isx = i < T * 32;
    const int ii = isx ? i : i - T * 32;
    const int t = ii >> 5, j = ii & 31;
    const float v = (isx ? p.dtraw : p.dtraw_c)[ii];
    float* df = isx ? p.dtf : p.dtf_c;
    float* db = isx ? p.dtb : p.dtb_c;
    if (j < 16) df[t * 16 + j] = softplus_f(v + p.dt_bias_f[j]);
    else db[t * 16 + (j - 16)] = softplus_f(v + p.dt_bias_b[j - 16]);
  }
}

__device__ __forceinline__ int swz16(int row, int chunk) { return row * 256 + ((chunk ^ (row & 15)) << 4); }
__device__ __forceinline__ int swz8(int row, int chunk) { return row * 128 + ((chunk ^ (row & 7)) << 4); }

#define LDS_BARRIER() asm volatile("s_waitcnt lgkmcnt(0)\n\ts_barrier" ::: "memory")
__device__ void ssd_task(const Params& p, int task, char* smem) {
  const int dir = task & 1, ph = (task >> 1) & 1, h = (task >> 2) & 15, b = task >> 6;
  const int tid = opaque_tid(), lane = tid & 63, w = tid >> 6;
  const int g = h >> 3, lr0 = lane & 15, lq0 = lane >> 4;
  const float a = -__expf(dir ? p.a_log_b[h] : p.a_log_f[h]);
  char* sCc = smem; char* sBc = smem + 16384; char* sBT = smem + 32768; char* sXT = smem + 49152; char* sHb = smem + 57344;
  float* se = reinterpret_cast<float*>(smem + 73728);
  float* sdt = se + 64; float* sw = se + 128; float* sy = se + 192; float* stot = se + 256;
  bf16_t* yo = reinterpret_cast<bf16_t*>(dir ? p.yb : p.yf);
  f32x4 H[2][2];
#pragma unroll
  for (int i = 0; i < 2; ++i)
#pragma unroll
    for (int j = 0; j < 2; ++j) H[i][j] = f32x4{0.f, 0.f, 0.f, 0.f};
  __syncthreads();
  for (int i = tid; i < 512; i += NTHREADS) reinterpret_cast<uint4*>(sHb)[i] = uint4{0, 0, 0, 0};

  const int crow = tid >> 4, cch = tid & 15;
  const int trow = tid >> 3, tch = tid & 7;
  uint4 rC0, rC1, rC2, rC3, rB0, rB1, rB2, rB3, rT0, rT1, rT2, rT3, rX;
  rC0 = rC1 = rC2 = rC3 = rB0 = rB1 = rB2 = rB3 = uint4{0, 0, 0, 0};
  float rdt = 0.f;
#define SSD_PARAMS(st_)                                                                                                   \
  const bool isctx_ = (st_) < 4;                                                                                          \
  const int nch_ = isctx_ ? 4 : 32, ci_ = isctx_ ? (st_) : (st_) - 4;                                                     \
  const int c_ = dir ? (nch_ - 1 - ci_) : ci_;                                                                            \
  const int seqlen_ = isctx_ ? CTX : L;                                                                                   \
  const size_t trow0_ = isctx_ ? ((size_t)T + (size_t)b * CTX + c_ * 64) : ((size_t)b * L + c_ * 64);                     \
  const size_t drow0_ = (size_t)b * seqlen_ + c_ * 64;                                                                    \
  const float* dtp_ = isctx_ ? (dir ? p.dtb_c : p.dtf_c) : (dir ? p.dtb : p.dtf);                                         \
  const bf16_t* cm_ = (isctx_ ? p.act_cm_c : p.act_cm_x) + (size_t)b * 1280 * seqlen_ + c_ * 64;
#define SSD_PREFETCH(st_)                                                                                                 \
  do {                                                                                                                    \
    SSD_PARAMS(st_)                                                                                                       \
    if (w == 0) rdt = dtp_[(drow0_ + lane) * 16 + h];                                                                     \
    if (!isctx_) {                                                                                                        \
      const bf16_t* src = p.act_tm + (trow0_ + crow) * DXBC + g * 128 + cch * 8;                                          \
      rC0 = *reinterpret_cast<const uint4*>(src + 1280);             rB0 = *reinterpret_cast<const uint4*>(src + 1024);   \
      rC1 = *reinterpret_cast<const uint4*>(src + 16 * DXBC + 1280); rB1 = *reinterpret_cast<const uint4*>(src + 16 * DXBC + 1024); \
      rC2 = *reinterpret_cast<const uint4*>(src + 32 * DXBC + 1280); rB2 = *reinterpret_cast<const uint4*>(src + 32 * DXBC + 1024); \
      rC3 = *reinterpret_cast<const uint4*>(src + 48 * DXBC + 1280); rB3 = *reinterpret_cast<const uint4*>(src + 48 * DXBC + 1024); \
    }                                                                                                                     \
    const bf16_t* srt = cm_ + (size_t)(1024 + g * 128 + trow) * seqlen_ + tch * 8;                                        \
    rT0 = *reinterpret_cast<const uint4*>(srt);                                                                           \
    rT1 = *reinterpret_cast<const uint4*>(srt + (size_t)32 * seqlen_);                                                    \
    rT2 = *reinterpret_cast<const uint4*>(srt + (size_t)64 * seqlen_);                                                    \
    rT3 = *reinterpret_cast<const uint4*>(srt + (size_t)96 * seqlen_);                                                    \
    rX = *reinterpret_cast<const uint4*>(cm_ + (size_t)(h * 64 + ph * 32 + trow) * seqlen_ + tch * 8);                    \
  } while (0)

  for (int step = 0; step < 36; ++step) {
    SSD_PREFETCH(step);
    const bool isctx = step < 4;
    const int c = dir ? ((isctx ? 4 : 32) - 1 - (isctx ? step : step - 4)) : (isctx ? step : step - 4);
    const size_t trow0 = (size_t)b * L + c * 64;
    int lr = lr0, lq = lq0;
    asm volatile("" : "+v"(lr), "+v"(lq));
    LDS_BARRIER();
    if (w == 0) {
      const float dtv = rdt;
      float v = a * dtv;
      if (!dir) {
#pragma unroll
        for (int o = 1; o < 64; o <<= 1) { float n = __shfl_up(v, o); v += (lane >= o) ? n : 0.f; }
      } else {
#pragma unroll
        for (int o = 1; o < 64; o <<= 1) { float n = __shfl_down(v, o); v += (lane + o < 64) ? n : 0.f; }
      }
      const float etot = __shfl(v, dir ? 0 : 63);
      se[lane] = v; sdt[lane] = dtv; sw[lane] = dtv * __expf(etot - v); sy[lane] = __expf(v);
      if (lane == 0) stot[0] = etot;
    }
    if (!isctx) {
      const int oc = swz16(crow, cch);
      *reinterpret_cast<uint4*>(sCc + oc) = rC0;         *reinterpret_cast<uint4*>(sBc + oc) = rB0;
      *reinterpret_cast<uint4*>(sCc + oc + 4096) = rC1;  *reinterpret_cast<uint4*>(sBc + oc + 4096) = rB1;
      *reinterpret_cast<uint4*>(sCc + oc + 8192) = rC2;  *reinterpret_cast<uint4*>(sBc + oc + 8192) = rB2;
      *reinterpret_cast<uint4*>(sCc + oc + 12288) = rC3; *reinterpret_cast<uint4*>(sBc + oc + 12288) = rB3;
    }
    {
      const int ot = swz8(trow, tch);
      *reinterpret_cast<uint4*>(sBT + ot) = rT0;
      *reinterpret_cast<uint4*>(sBT + ot + 4096) = rT1;
      *reinterpret_cast<uint4*>(sBT + ot + 8192) = rT2;
      *reinterpret_cast<uint4*>(sBT + ot + 12288) = rT3;
      *reinterpret_cast<uint4*>(sXT + ot) = rX;
    }
    LDS_BARRIER();
    const float etot = stot[0];
    if (!isctx) {
      f32x4 G[4];
      bf16x8 ca[4];
#pragma unroll
      for (int j = 0; j < 4; ++j) G[j] = f32x4{0.f, 0.f, 0.f, 0.f};
#pragma unroll
      for (int kk = 0; kk < 4; ++kk) ca[kk] = *reinterpret_cast<const bf16x8*>(sCc + swz16(16 * w + lr, kk * 4 + lq));
#pragma unroll
      for (int kk = 0; kk < 4; ++kk)
#pragma unroll
        for (int j = 0; j < 4; ++j) {
          bf16x8 bb = *reinterpret_cast<const bf16x8*>(sBc + swz16(16 * j + lr, kk * 4 + lq));
          G[j] = __builtin_amdgcn_mfma_f32_16x16x32_bf16(ca[kk], bb, G[j], 0, 0, 0);
        }
      LDS_BARRIER();
      float el[4];
#pragma unroll
      for (int r = 0; r < 4; ++r) el[r] = se[16 * w + lq * 4 + r];
#pragma unroll
      for (int j = 0; j < 4; ++j) {
        const int s_ = 16 * j + lr;
        const float es = se[s_], ds = sdt[s_];
#pragma unroll
        for (int r = 0; r < 4; ++r) {
          const int l = 16 * w + lq * 4 + r;
          const bool keep = dir ? (s_ >= l) : (s_ <= l);
          const float m = keep ? G[j][r] * __expf(el[r] - es) * ds : 0.f;
          *reinterpret_cast<bf16_t*>(sBc + swz8(l, s_ >> 3) + (s_ & 7) * 2) = f2bf(m);
        }
      }
      LDS_BARRIER();
      f32x4 Y[2], Yo[2];
#pragma unroll
      for (int j = 0; j < 2; ++j) { Y[j] = f32x4{0.f, 0.f, 0.f, 0.f}; Yo[j] = f32x4{0.f, 0.f, 0.f, 0.f}; }
#pragma unroll
      for (int kk = 0; kk < 2; ++kk) {
        bf16x8 ma = *reinterpret_cast<const bf16x8*>(sBc + swz8(16 * w + lr, kk * 4 + lq));
#pragma unroll
        for (int j = 0; j < 2; ++j) {
          bf16x8 xb = *reinterpret_cast<const bf16x8*>(sXT + swz8(16 * j + lr, kk * 4 + lq));
          Y[j] = __builtin_amdgcn_mfma_f32_16x16x32_bf16(ma, xb, Y[j], 0, 0, 0);
        }
      }
#pragma unroll
      for (int kk = 0; kk < 4; ++kk)
#pragma unroll
        for (int j = 0; j < 2; ++j) {
          bf16x8 hb = *reinterpret_cast<const bf16x8*>(sHb + swz16(16 * j + lr, kk * 4 + lq));
          Yo[j] = __builtin_amdgcn_mfma_f32_16x16x32_bf16(ca[kk], hb, Yo[j], 0, 0, 0);
        }
      float syl[4];
#pragma unroll
      for (int r = 0; r < 4; ++r) syl[r] = sy[16 * w + lq * 4 + r];
#pragma unroll
      for (int j = 0; j < 2; ++j)
#pragma unroll
        for (int r = 0; r < 4; ++r) {
          const int l = 16 * w + lq * 4 + r;
          yo[(trow0 + l) * 1024 + h * 64 + ph * 32 + 16 * j + lr] = f2bf(Y[j][r] + syl[r] * Yo[j][r]);
        }
    }
    {
      const float dec = __expf(etot);
#pragma unroll
      for (int i = 0; i < 2; ++i)
#pragma unroll
        for (int j = 0; j < 2; ++j) H[i][j] *= dec;
#pragma unroll
      for (int kk = 0; kk < 2; ++kk) {
        const int s0 = kk * 32 + lq * 8;
        const float4 w0 = *reinterpret_cast<const float4*>(sw + s0), w1 = *reinterpret_cast<const float4*>(sw + s0 + 4);
        bf16x8 xs[2];
#pragma unroll
        for (int i = 0; i < 2; ++i) {
          const bf16x8 xa = *reinterpret_cast<const bf16x8*>(sXT + swz8(16 * i + lr, kk * 4 + lq));
          xs[i][0] = (short)f2bf(bf2f((bf16_t)xa[0]) * w0.x); xs[i][1] = (short)f2bf(bf2f((bf16_t)xa[1]) * w0.y);
          xs[i][2] = (short)f2bf(bf2f((bf16_t)xa[2]) * w0.z); xs[i][3] = (short)f2bf(bf2f((bf16_t)xa[3]) * w0.w);
          xs[i][4] = (short)f2bf(bf2f((bf16_t)xa[4]) * w1.x); xs[i][5] = (short)f2bf(bf2f((bf16_t)xa[5]) * w1.y);
          xs[i][6] = (short)f2bf(bf2f((bf16_t)xa[6]) * w1.z); xs[i][7] = (short)f2bf(bf2f((bf16_t)xa[7]) * w1.w);
        }
#pragma unroll
        for (int j = 0; j < 2; ++j) {
          const bf16x8 bt = *reinterpret_cast<const bf16x8*>(sBT + swz8(16 * (2 * w + j) + lr, kk * 4 + lq));
#pragma unroll
          for (int i = 0; i < 2; ++i) H[i][j] = __builtin_amdgcn_mfma_f32_16x16x32_bf16(xs[i], bt, H[i][j], 0, 0, 0);
        }
      }
    }
    LDS_BARRIER();
#pragma unroll
    for (int i = 0; i < 2; ++i)
#pragma unroll
      for (int j = 0; j < 2; ++j) {
        const int n = 16 * (2 * w + j) + lr;
#pragma unroll
        for (int r = 0; r < 4; ++r) {
          const int pr = 16 * i + lq * 4 + r;
          *reinterpret_cast<bf16_t*>(sHb + swz16(pr, n >> 3) + (n & 7) * 2) = f2bf(H[i][j][r]);
        }
      }
  }
#undef SSD_PREFETCH
#undef SSD_PARAMS
}

#undef LDS_BARRIER
__device__ void phase_ssd_dft(const Params& p, int bid, int nb, char* smem) {
  for (int t = bid; t < 256; t += nb) ssd_task(p, t, smem);
  int* stile = reinterpret_cast<int*>(smem + 75776);
  for (;;) {
    __syncthreads();
    if (threadIdx.x == 0) *stile = (int)atomicAdd(p.ctr, 1u);
    __syncthreads();
    const int t = *stile;
    if (t >= 4 * 8 * 8) break;
    const int b = t >> 6, tm = (t & 63) >> 3, tn = t & 7;
    const bf16_t* Fb = p.Fs + (size_t)b * 1024 * 2048;
    f32x4 accC[4][4], accS[4][4];
    gemm_mainloop(p.dftm, 2048, Fb, 2048, 1024, tm * 128, tn * 128, accC, smem);
    gemm_mainloop(p.dftm + 1024, 2048, Fb + 1024, 2048, 1024, tm * 128, tn * 128, accS, smem);
    const int lane = threadIdx.x & 63, w = threadIdx.x >> 6, wm = w >> 1, wn = w & 1;
#pragma unroll
    for (int i = 0; i < 4; ++i) {
      int lq_ = lane >> 4, lr_ = lane & 15;
      asm volatile("" : "+v"(lq_), "+v"(lr_));
#pragma unroll
      for (int j = 0; j < 4; ++j) {
        const int k0 = tm * 128 + wm * 64 + i * 16 + lq_ * 4;
        const int ch = tn * 128 + wn * 64 + j * 16 + lr_;
        const float a = bf2f(p.ABt[((size_t)b * 1024 + ch) * 4096 + 1024]);
#pragma unroll
        for (int r = 0; r < 4; ++r) {
          const int k = k0 + r;
          const float as = (k & 1) ? -a : a;
          const float c = accC[i][j][r], sn = accS[i][j][r];
          p.ycat[((size_t)b * L + k) * D + ch] = f2bf(c - sn + as);
          if (k > 0) p.ycat[((size_t)b * L + (L - k)) * D + ch] = f2bf(c + sn + as);
        }
      }
    }
  }
  for (;;) {
    __syncthreads();
    if (threadIdx.x == 0) *stile = (int)atomicAdd(p.ctr + 8, 1u);
    __syncthreads();
    const int q = *stile;
    if (q >= 1024 + 1536) break;
    if (q < 512) convert_u_rows(p, q);
    else if (q < 1024) convert_v_units(p, (size_t)(q - 512) * 4096, (size_t)(q - 511) * 4096);
    else if (q < 1024 + 1024) { const int q1 = q - 1024; transpose_convert_task(p.w_out, D, 0, D, p.w_out_t, q1 / 32, q1 % 32, reinterpret_cast<float*>(smem)); }
    else { const int q2 = q - 2048; transpose_convert_task(p.w_query, 1024, 0, D, p.w_q_t, q2 / 16, q2 % 16, reinterpret_cast<float*>(smem)); }
  }
}

__device__ void phase_ssm_post(const Params& p, int bid, int nb, char* smem) {
  const int lane = threadIdx.x & 63, w = threadIdx.x >> 6;
  for (int t = bid * 4 + w; t < T; t += nb * 4) {
    float y[4][4];
    float ss0 = 0.f, ss1 = 0.f;
#pragma unroll
    for (int c = 0; c < 4; ++c) {
      const int c0 = c * 256 + lane * 4;
      const int h = c0 >> 6;
      const float dsk = p.d_skip_f[h] + p.d_skip_b[h];
      const uint2 aq = *reinterpret_cast<const uint2*>(reinterpret_cast<const bf16_t*>(p.yf) + (size_t)t * 1024 + c0);
      const uint2 bb = *reinterpret_cast<const uint2*>(reinterpret_cast<const bf16_t*>(p.yb) + (size_t)t * 1024 + c0);
      const float4 a = float4{bflo(aq.x), bfhi(aq.x), bflo(aq.y), bfhi(aq.y)};
      const float4 bq = float4{bflo(bb.x), bfhi(bb.x), bflo(bb.y), bfhi(bb.y)};
      const uint2 xq = *reinterpret_cast<const uint2*>(p.act_tm + (size_t)t * DXBC + c0);
      const uint2 zz = *reinterpret_cast<const uint2*>(p.z + (size_t)t * 1024 + c0);
      y[c][0] = (a.x + bq.x + dsk * bflo(xq.x)) * silu_f(bflo(zz.x));
      y[c][1] = (a.y + bq.y + dsk * bfhi(xq.x)) * silu_f(bfhi(zz.x));
      y[c][2] = (a.z + bq.z + dsk * bflo(xq.y)) * silu_f(bflo(zz.y));
      y[c][3] = (a.w + bq.w + dsk * bfhi(xq.y)) * silu_f(bfhi(zz.y));
      const float q = y[c][0] * y[c][0] + y[c][1] * y[c][1] + y[c][2] * y[c][2] + y[c][3] * y[c][3];
      if (c < 2) ss0 += q; else ss1 += q;
    }
    ss0 = wave_sum_fast(ss0); ss1 = wave_sum_fast(ss1);
    const float r0 = rsqrtf(ss0 * (1.f / 512.f) + EPS), r1 = rsqrtf(ss1 * (1.f / 512.f) + EPS);
    uint2 fq[4];
    float am = 0.f;
#pragma unroll
    for (int c = 0; c < 4; ++c) {
      const int c0 = c * 256 + lane * 4;
      fq[c] = *reinterpret_cast<const uint2*>(p.ycat + (size_t)t * D + c0);
      am = fmaxf(am, fmaxf(fmaxf(fabsf(bflo(fq[c].x)), fabsf(bfhi(fq[c].x))), fmaxf(fabsf(bflo(fq[c].y)), fabsf(bfhi(fq[c].y)))));
      const float rstd = (c < 2) ? r0 : r1;
      const float4 nw = *reinterpret_cast<const float4*>(p.ssm_norm_w + c0);
      y[c][0] *= rstd * nw.x; y[c][1] *= rstd * nw.y; y[c][2] *= rstd * nw.z; y[c][3] *= rstd * nw.w;
      am = fmaxf(am, fmaxf(fmaxf(fabsf(y[c][0]), fabsf(y[c][1])), fmaxf(fabsf(y[c][2]), fabsf(y[c][3]))));
    }
    am = wave_max_fast(am);
    const float inv = (am > 0.f) ? 127.f / am : 0.f;
#pragma unroll
    for (int c = 0; c < 4; ++c) {
      const int c0 = c * 256 + lane * 4;
      *reinterpret_cast<uint32_t*>(p.ycat8 + (size_t)t * D + c0) =
          pack_i8x4(bflo(fq[c].x) * inv, bfhi(fq[c].x) * inv, bflo(fq[c].y) * inv, bfhi(fq[c].y) * inv);
      *reinterpret_cast<uint32_t*>(p.ycat8 + (size_t)t * D + 1024 + c0) = pack_i8x4(y[c][0] * inv, y[c][1] * inv, y[c][2] * inv, y[c][3] * inv);
    }
    if (lane == 0) p.yscale[t] = am * (1.f / 127.f);
  }
  quant_weight_rows_i8(p.w_out_t, p.wo8, p.woscale, D, bid, nb);
}

__device__ void phase_outproj(const Params& p, int bid, int nb, char* smem) {
  const bool aware = (nb & 7) == 0;
  const int start = aware ? (bid >> 3) : bid, step = aware ? (nb >> 3) : nb, end = aware ? 64 : 512;
  const bf16_t* a8 = reinterpret_cast<const bf16_t*>(p.ycat8);
  const bf16_t* b8 = reinterpret_cast<const bf16_t*>(p.wo8);
  for (int it = start; it < end; it += step) {
    const int x = aware ? (bid & 7) : (it >> 6), s_ = aware ? it : (it & 63);
    EpiBf16 epi{reinterpret_cast<bf16_t*>(p.y_x), D};
    gemm_tile_n256<true>(a8, D / 2, b8, D / 2, D / 2, (8 * x + (s_ & 7)) * 128, (s_ >> 3) * 256, epi, smem, p.yscale, p.woscale);
  }
}
__device__ void phase_postmix(const Params& p, int bid, int nb, char* smem) {
  const int lane = threadIdx.x & 63, w = threadIdx.x >> 6;
  for (int t = bid * 4 + w; t < T; t += nb * 4) {
    const int b = t / L;
    float4 y[8];
    float ss = 0.f;
#pragma unroll
    for (int c = 0; c < 8; ++c) {
      {
        const uint2 yq = *reinterpret_cast<const uint2*>(reinterpret_cast<const bf16_t*>(p.y_x) + (size_t)t * D + c * 256 + lane * 4);
        y[c] = float4{bflo(yq.x), bfhi(yq.x), bflo(yq.y), bfhi(yq.y)};
      }
      ss += y[c].x * y[c].x + y[c].y * y[c].y + y[c].z * y[c].z + y[c].w * y[c].w;
    }
    ss = wave_sum_fast(ss);
    const float rstd = rsqrtf(ss * (1.f / D) + EPS);
    const float* gm = p.mod + (size_t)b * NMOD + 2 * D;
    float ss1 = 0.f;
#pragma unroll
    for (int c = 0; c < 8; ++c) {
      const int e0 = c * 256 + lane * 4;
      const float4 xv = *reinterpret_cast<const float4*>(p.x + (size_t)t * D + e0);
      const float4 g4 = *reinterpret_cast<const float4*>(gm + e0), gp = *reinterpret_cast<const float4*>(p.g_post_mix + e0);
      y[c].x = xv.x + g4.x * (y[c].x * rstd * gp.x); y[c].y = xv.y + g4.y * (y[c].y * rstd * gp.y);
      y[c].z = xv.z + g4.z * (y[c].z * rstd * gp.z); y[c].w = xv.w + g4.w * (y[c].w * rstd * gp.w);
      ss1 += y[c].x * y[c].x + y[c].y * y[c].y + y[c].z * y[c].z + y[c].w * y[c].w;
    }
    if (lane == 0) p.partial[t] = rstd;
    ss1 = wave_sum_fast(ss1);
    const float rstd1 = rsqrtf(ss1 * (1.f / D) + EPS);
    const float* sf = p.mod + (size_t)b * NMOD + 3 * D;
    const float* cf = p.mod + (size_t)b * NMOD + 4 * D;
    float am = 0.f;
#pragma unroll
    for (int c = 0; c < 8; ++c) {
      const int e0 = c * 256 + lane * 4;
      const float4 g = *reinterpret_cast<const float4*>(p.g_pre_ffn + e0);
      const float4 s4 = *reinterpret_cast<const float4*>(cf + e0), h4 = *reinterpret_cast<const float4*>(sf + e0);
      y[c].x = y[c].x * rstd1 * g.x * (1.f + s4.x) + h4.x; y[c].y = y[c].y * rstd1 * g.y * (1.f + s4.y) + h4.y;
      y[c].z = y[c].z * rstd1 * g.z * (1.f + s4.z) + h4.z; y[c].w = y[c].w * rstd1 * g.w * (1.f + s4.w) + h4.w;
      am = fmaxf(am, fmaxf(fmaxf(fabsf(y[c].x), fabsf(y[c].y)), fmaxf(fabsf(y[c].z), fabsf(y[c].w))));
      uint2 pk;
      pk.x = pack2(y[c].x, y[c].y);
      pk.y = pack2(y[c].z, y[c].w);
      *reinterpret_cast<uint2*>(p.hx + (size_t)t * D + e0) = pk;
    }
    am = wave_max_fast(am);
    const float inv = (am > 0.f) ? 127.f / am : 0.f;
#pragma unroll
    for (int c = 0; c < 8; ++c)
      *reinterpret_cast<uint32_t*>(p.hx8a + (size_t)t * D + c * 256 + lane * 4) = pack_i8x4(y[c].x * inv, y[c].y * inv, y[c].z * inv, y[c].w * inv);
    if (lane == 0) p.ascale[t] = am * (1.f / 127.f);
  }
}

__device__ __forceinline__ uint32_t mono_key(float f) {
  uint32_t u = __float_as_uint(f);
  return (u & 0x80000000u) ? ~u : (u | 0x80000000u);
}
__device__ __forceinline__ void ins16(uint32_t (&Lk)[16], uint32_t x) {
#pragma unroll
  for (int i = 0; i < 16; ++i) { uint32_t hi = max(Lk[i], x); x = min(Lk[i], x); Lk[i] = hi; }
}
__device__ __forceinline__ float unmono_key(uint32_t k) {
  return __uint_as_float((k & 0x80000000u) ? (k ^ 0x80000000u) : ~k);
}
typedef __attribute__((ext_vector_type(16))) float f32x16;
__device__ void phase_q_route(const Params& p, int bid, int nb, char* smem) {
  const int tid = opaque_tid(), lane = tid & 63, w = tid >> 6;
  const int wm = w >> 1, wn = w & 1, lr = lane & 15, lq = lane >> 4;
  const int l31 = lane & 31, lh = lane >> 5;
  for (int tile0 = bid; tile0 < 512; tile0 += nb) {
    const int tile = ((nb & 7) == 0 && nb >= 512) ? (((tile0 & 7) * 8 + ((tile0 >> 3) & 7)) * 8 + (tile0 >> 6)) : tile0;
    const int h = tile & 7, m0 = (tile >> 3) * 128;
    {
      f32x4 acc[4][4];
      gemm_mainloop(p.hx, D, p.w_q_t, D, D, m0, h * 128, acc, smem);
#pragma unroll
      for (int i = 0; i < 4; ++i)
#pragma unroll
        for (int j = 0; j < 4; ++j)
#pragma unroll
          for (int r = 0; r < 4; ++r) {
            const int row = wm * 64 + i * 16 + lq * 4 + r, col = wn * 64 + j * 16 + lr;
            *reinterpret_cast<bf16_t*>(smem + swz16(row, col >> 3) + (col & 7) * 2) = f2bf(acc[i][j][r]);
          }
    }
#pragma unroll 4
    for (int r = 0; r < 16; ++r) {
      const int id = tid + 256 * r, row = id >> 4, c4 = id & 15;
      const float* src = ((row < 128) ? p.sk1 : p.sk2) + ((size_t)(h * 128 + (row & 127)) * 64 + c4 * 4);
      const float4 v = *reinterpret_cast<const float4*>(src);
      uint2 pk; pk.x = pack2(v.x, v.y); pk.y = pack2(v.z, v.w);
      *reinterpret_cast<uint2*>(smem + 32768 + swz8(row, c4 >> 1) + (c4 & 1) * 8) = pk;
    }
    __syncthreads();
    uint32_t L1[16], L2[16];
#pragma unroll
    for (int sd = 0; sd < 2; ++sd) {
      uint32_t Lk[16];
#pragma unroll
      for (int i = 0; i < 16; ++i) Lk[i] = 0u;
      const uint32_t kb = (uint32_t)(lh * 4);
#pragma unroll
      for (int ih = 0; ih < 2; ++ih) {
        f32x16 Sa[2];
#pragma unroll
        for (int i = 0; i < 2; ++i)
#pragma unroll
          for (int g2 = 0; g2 < 16; ++g2) Sa[i][g2] = 0.f;
#pragma unroll
        for (int ks = 0; ks < 4; ++ks) {
          const bf16x8 qb = *reinterpret_cast<const bf16x8*>(smem + swz16(w * 32 + l31, sd * 8 + ks * 2 + lh));
#pragma unroll
          for (int i = 0; i < 2; ++i) {
            const bf16x8 ka = *reinterpret_cast<const bf16x8*>(smem + 32768 + swz8(sd * 128 + (ih * 2 + i) * 32 + l31, ks * 2 + lh));
            Sa[i] = __builtin_amdgcn_mfma_f32_32x32x16_bf16(ka, qb, Sa[i], 0, 0, 0);
          }
        }
#pragma unroll
        for (int i = 0; i < 2; ++i)
#pragma unroll
          for (int g2 = 0; g2 < 16; ++g2)
            ins16(Lk, (mono_key(Sa[i][g2]) & ~0x7Fu) | (uint32_t)((ih * 2 + i) * 32 + (g2 & 3) + 8 * (g2 >> 2)) | kb);
      }
#pragma unroll
      for (int i = 0; i < 8; ++i) {
        const uint32_t t1 = (uint32_t)__shfl_xor((int)Lk[15 - i], 32), t2 = (uint32_t)__shfl_xor((int)Lk[i], 32);
        Lk[i] = max(Lk[i], t1); Lk[15 - i] = max(Lk[15 - i], t2);
      }
#pragma unroll
      for (int dd = 8; dd >= 1; dd >>= 1)
#pragma unroll
        for (int i = 0; i < 16; ++i)
          if ((i & dd) == 0) { const uint32_t hi = max(Lk[i], Lk[i + dd]), lo = min(Lk[i], Lk[i + dd]); Lk[i] = hi; Lk[i + dd] = lo; }
#pragma unroll
      for (int r = 0; r < 16; ++r) { if (sd == 0) L1[r] = Lk[r]; else L2[r] = Lk[r]; }
    }
    __syncthreads();
    uint32_t* ib = reinterpret_cast<uint32_t*>(smem) + w * 1088 + l31 * 34;
    if (lh == 0) {
#pragma unroll
      for (int r = 0; r < 16; ++r) { ib[r] = L1[r] & 127u; ib[16 + r] = L2[r] & 127u; }
    }
    float v1[16], v2[16];
#pragma unroll
    for (int r = 0; r < 16; ++r) { v1[r] = unmono_key(L1[r] & ~0x7Fu); v2[r] = unmono_key(L2[r] & ~0x7Fu); }
    uint32_t C[16];
#pragma unroll
    for (int i = 0; i < 16; ++i) C[i] = 0u;
#pragma unroll
    for (int a = 0; a < 16; ++a)
#pragma unroll
      for (int bq = 0; bq < 16; ++bq)
        if ((a + 1) * (bq + 1) <= 16) ins16(C, (mono_key(v1[a] + v2[bq]) & ~0xFFu) | (uint32_t)(a * 16 + bq));
    float ts[16]; int te[16];
    __builtin_amdgcn_wave_barrier();
#pragma unroll
    for (int r = 0; r < 16; ++r) {
      const uint32_t code = C[r] & 0xFFu;
      te[r] = (int)(ib[code >> 4] * 128u + ib[16 + (code & 15u)]);
      ts[r] = unmono_key(C[r] & ~0xFFu);
    }
    const float mx = ts[0];
    float den = 0.f;
#pragma unroll
    for (int r = 0; r < 16; ++r) { ts[r] = __expf(ts[r] - mx); den += ts[r]; }
    const float inv = 1.f / den;
    const size_t ob = (size_t)(m0 + w * 32 + l31) * 128 + h * 16;
    if (lh == 0) {
#pragma unroll
      for (int r = 0; r < 16; r += 4) *reinterpret_cast<int4*>(p.idx + ob + r) = int4{te[r], te[r + 1], te[r + 2], te[r + 3]};
    } else {
#pragma unroll
      for (int r = 0; r < 16; r += 4)
        *reinterpret_cast<float4*>(p.gate + ob + r) = float4{ts[r] * inv, ts[r + 1] * inv, ts[r + 2] * inv, ts[r + 3] * inv};
    }
    __syncthreads();
  }
}

typedef __attribute__((ext_vector_type(2))) float f32x2;
__device__ __forceinline__ void fp8x16_to_f32(const uint4 q, f32x2 (&o)[8]) {
  o[0] = __builtin_amdgcn_cvt_pk_f32_fp8((int)q.x, false); o[1] = __builtin_amdgcn_cvt_pk_f32_fp8((int)q.x, true);
  o[2] = __builtin_amdgcn_cvt_pk_f32_fp8((int)q.y, false); o[3] = __builtin_amdgcn_cvt_pk_f32_fp8((int)q.y, true);
  o[4] = __builtin_amdgcn_cvt_pk_f32_fp8((int)q.z, false); o[5] = __builtin_amdgcn_cvt_pk_f32_fp8((int)q.z, true);
  o[6] = __builtin_amdgcn_cvt_pk_f32_fp8((int)q.w, false); o[7] = __builtin_amdgcn_cvt_pk_f32_fp8((int)q.w, true);
}
__device__ __forceinline__ unsigned my_xcc_id() { return (unsigned)__builtin_amdgcn_s_getreg((3 << 11) | 20) & 7u; }

__device__ void phase_exp_u(const Params& p, char* smem) {
  const int tid = opaque_tid(), lane = tid & 63, w = tid >> 6;
  const int sub = lane >> 4, cc = lane & 15;
  const unsigned myx = my_xcc_id();
  int* sh = reinterpret_cast<int*>(smem);
  int* si = reinterpret_cast<int*>(smem + 64) + w * 256;
  float* pbuf = reinterpret_cast<float*>(p.ycat);
  {
    unsigned qcur = 0;
    for (;;) {
      __syncthreads();
      if (tid == 0) {
        int found = -1; unsigned fx = 0;
        for (; qcur < 8; ++qcur) {
          fx = (myx + qcur) & 7u;
          const int c = (int)atomicAdd(&p.ctr[16 + fx], 1u);
          if (c < 256) { found = c; break; }
        }
        sh[0] = found; sh[1] = (int)fx;
      }
      __syncthreads();
      const int chunk = sh[0];
      const unsigned x = (unsigned)sh[1];
      if (chunk < 0) break;
      for (int tt = 0; tt < 8; ++tt) {
        const int t = chunk * 32 + w * 8 + tt;
        __builtin_amdgcn_wave_barrier();
        si[lane] = p.idx[(size_t)t * 128 + lane]; si[64 + lane] = p.idx[(size_t)t * 128 + 64 + lane];
        __builtin_amdgcn_wave_barrier();
        const uint4 hq = *reinterpret_cast<const uint4*>(p.hx8a + (size_t)t * D + x * 256 + cc * 16);
        const uint8_t* ub = p.U8 + (size_t)x * ((size_t)16384 * 256) + cc * 16;
        uint4 qa[8], qb[8];
#define EU_LOAD(q_, bt_) _Pragma("unroll") for (int k = 0; k < 8; ++k) q_[k] = *reinterpret_cast<const uint4*>(ub + (size_t)si[((bt_) * 8 + k) * 4 + sub] * 256)
#define EU_COMP(q_, kb_)                                                                                                \
  _Pragma("unroll") for (int k = 0; k < 8; ++k) {                                                                       \
    int d = __builtin_amdgcn_sdot4((int)q_[k].x, (int)hq.x, 0, false);                                                  \
    int d1 = __builtin_amdgcn_sdot4((int)q_[k].y, (int)hq.y, 0, false);                                                 \
    d = __builtin_amdgcn_sdot4((int)q_[k].z, (int)hq.z, d, false);                                                      \
    d1 = __builtin_amdgcn_sdot4((int)q_[k].w, (int)hq.w, d1, false);                                                    \
    d += d1;                                                                                                            \
    d += dpp_movi<0xB1>(d); d += dpp_movi<0x4E>(d); d += dpp_movi<0x124>(d); d += dpp_movi<0x128>(d);                   \
    mine = (cc == (kb_) + k) ? d : mine;                                                                                \
  }
        int mine = 0;
        EU_LOAD(qa, 0); EU_LOAD(qb, 1);
        EU_COMP(qa, 0); EU_LOAD(qa, 2);
        EU_COMP(qb, 8); EU_LOAD(qb, 3);
        pbuf[((size_t)x * T + t) * 128 + cc * 4 + sub] = (float)mine;
        mine = 0;
        EU_COMP(qa, 0);
        EU_COMP(qb, 8);
        pbuf[((size_t)x * T + t) * 128 + (16 + cc) * 4 + sub] = (float)mine;
#undef EU_LOAD
#undef EU_COMP
      }
    }
  }
}

__device__ void phase_exp_v(const Params& p, char* smem) {
  const int tid = opaque_tid(), lane = tid & 63, w = tid >> 6;
  const int sub = lane >> 4, cc = lane & 15;
  const unsigned myx = my_xcc_id();
  int* sh = reinterpret_cast<int*>(smem);
  int* si = reinterpret_cast<int*>(smem + 64) + w * 256;
  float* sc = reinterpret_cast<float*>(si + 128);
  bf16_t* yfb = reinterpret_cast<bf16_t*>(p.y_x) + (size_t)T * D;
  {
    unsigned qcur = 0;
    for (;;) {
      __syncthreads();
      if (tid == 0) {
        int found = -1; unsigned fx = 0;
        for (; qcur < 8; ++qcur) {
          fx = (myx + qcur) & 7u;
          const int c = (int)atomicAdd(&p.ctr[32 + fx], 1u);
          if (c < 256) { found = c; break; }
        }
        sh[0] = found; sh[1] = (int)fx;
      }
      __syncthreads();
      const int chunk = sh[0];
      const unsigned x = (unsigned)sh[1];
      if (chunk < 0) break;
      for (int tt = 0; tt < 8; ++tt) {
        const int t = chunk * 32 + w * 8 + tt;
        __builtin_amdgcn_wave_barrier();
        const int e0 = p.idx[(size_t)t * 128 + lane], e1 = p.idx[(size_t)t * 128 + 64 + lane];
        si[lane] = e0; si[64 + lane] = e1;
        {
          const float* pb = reinterpret_cast<const float*>(p.ycat) + (size_t)t * 128;
          float d0 = 0.f, d1 = 0.f;
#pragma unroll
          for (int xs = 0; xs < 8; ++xs) { d0 += pb[(size_t)xs * T * 128 + lane]; d1 += pb[(size_t)xs * T * 128 + 64 + lane]; }
          const float hs = p.ascale[t];
          d0 *= p.uscale[e0] * hs; d1 *= p.uscale[e1] * hs;
          sc[lane] = p.gate[(size_t)t * 128 + lane] * 0.5f * d0 * (1.f + erff(d0 * 0.70710678118654752f));
          sc[64 + lane] = p.gate[(size_t)t * 128 + 64 + lane] * 0.5f * d1 * (1.f + erff(d1 * 0.70710678118654752f));
        }
        __builtin_amdgcn_wave_barrier();
        f32x2 acc[8];
#pragma unroll
        for (int e = 0; e < 8; ++e) acc[e] = f32x2{0.f, 0.f};
        const uint8_t* vb = p.V8 + (size_t)x * ((size_t)16384 * 256) + cc * 16;
        uint4 qa[8], qb[8];
#define EV_LOAD(q_, bt_) _Pragma("unroll") for (int k = 0; k < 8; ++k) q_[k] = *reinterpret_cast<const uint4*>(vb + (size_t)si[((bt_) * 8 + k) * 4 + sub] * 256)
#define EV_COMP(q_, bt_)                                                                                                \
  _Pragma("unroll") for (int k = 0; k < 8; ++k) {                                                                       \
    f32x2 vf[8];                                                                                                        \
    fp8x16_to_f32(q_[k], vf);                                                                                           \
    const float cfk = sc[((bt_) * 8 + k) * 4 + sub];                                                                    \
    const f32x2 c2 = f32x2{cfk, cfk};                                                                                   \
    _Pragma("unroll") for (int e = 0; e < 8; ++e) acc[e] += c2 * vf[e];                                                 \
  }
        EV_LOAD(qa, 0); EV_LOAD(qb, 1);
        EV_COMP(qa, 0); EV_LOAD(qa, 2);
        EV_COMP(qb, 1); EV_LOAD(qb, 3);
        EV_COMP(qa, 2);
        EV_COMP(qb, 3);
#undef EV_LOAD
#undef EV_COMP
        {
          float* red = reinterpret_cast<float*>(smem + 8192) + w * 1280;
          float* mr = red + (sub * 16 + cc) * 20;
#pragma unroll
          for (int q4 = 0; q4 < 4; ++q4)
            *reinterpret_cast<float4*>(mr + q4 * 4) = float4{acc[q4 * 2].x, acc[q4 * 2].y, acc[q4 * 2 + 1].x, acc[q4 * 2 + 1].y};
          __builtin_amdgcn_wave_barrier();
          const int part = sub;
          float4 r0 = *reinterpret_cast<const float4*>(red + (0 * 16 + cc) * 20 + part * 4);
          float4 r1 = *reinterpret_cast<const float4*>(red + (1 * 16 + cc) * 20 + part * 4);
          float4 r2 = *reinterpret_cast<const float4*>(red + (2 * 16 + cc) * 20 + part * 4);
          float4 r3 = *reinterpret_cast<const float4*>(red + (3 * 16 + cc) * 20 + part * 4);
          const float sc512 = 1.f / 512.f;
          uint2 o4;
          o4.x = pack2((r0.x + r1.x + r2.x + r3.x) * sc512, (r0.y + r1.y + r2.y + r3.y) * sc512);
          o4.y = pack2((r0.z + r1.z + r2.z + r3.z) * sc512, (r0.w + r1.w + r2.w + r3.w) * sc512);
          *reinterpret_cast<uint2*>(yfb + (size_t)t * D + x * 256 + cc * 16 + part * 4) = o4;
          __builtin_amdgcn_wave_barrier();
        }
      }
    }
  }
}

__device__ void phase_exp_final(const Params& p, int bid, int nb, char* smem) {
  const int lane = threadIdx.x & 63, w = threadIdx.x >> 6;
  const bf16_t* ymix = reinterpret_cast<const bf16_t*>(p.y_x);
  const bf16_t* yf = reinterpret_cast<const bf16_t*>(p.y_x) + (size_t)T * D;
  for (int t = bid * 4 + w; t < T; t += nb * 4) {
    const int b = t / L;
    float4 y[8], xo[8];
#pragma unroll
    for (int c = 0; c < 8; ++c) {
      const uint2 yq = *reinterpret_cast<const uint2*>(yf + (size_t)t * D + c * 256 + lane * 4);
      y[c] = float4{bflo(yq.x), bfhi(yq.x), bflo(yq.y), bfhi(yq.y)};
      xo[c] = *reinterpret_cast<const float4*>(p.x + (size_t)t * D + c * 256 + lane * 4);
    }
    const float rmix = p.partial[t];
    float ss = 0.f;
#pragma unroll
    for (int c = 0; c < 8; ++c) ss += y[c].x * y[c].x + y[c].y * y[c].y + y[c].z * y[c].z + y[c].w * y[c].w;
    ss = wave_sum_fast(ss);
    const float rstd = rsqrtf(ss * (1.f / D) + EPS);
    const float* gfx = p.mod + (size_t)b * NMOD + 5 * D;
    const float* gm = p.mod + (size_t)b * NMOD + 2 * D;
#pragma unroll
    for (int c = 0; c < 8; ++c) {
      const int e0 = c * 256 + lane * 4;
      const uint2 mq = *reinterpret_cast<const uint2*>(ymix + (size_t)t * D + e0);
      const float4 m4 = float4{bflo(mq.x), bfhi(mq.x), bflo(mq.y), bfhi(mq.y)};
      const float4 g4 = *reinterpret_cast<const float4*>(gfx + e0), gp = *reinterpret_cast<const float4*>(p.g_post_ffn + e0);
      const float4 h4 = *reinterpret_cast<const float4*>(gm + e0), hp = *reinterpret_cast<const float4*>(p.g_post_mix + e0);
      xo[c].x += h4.x * (m4.x * rmix * hp.x) + g4.x * (y[c].x * rstd * gp.x);
      xo[c].y += h4.y * (m4.y * rmix * hp.y) + g4.y * (y[c].y * rstd * gp.y);
      xo[c].z += h4.z * (m4.z * rmix * hp.z) + g4.z * (y[c].z * rstd * gp.z);
      xo[c].w += h4.w * (m4.w * rmix * hp.w) + g4.w * (y[c].w * rstd * gp.w);
      *reinterpret_cast<float4*>(p.out + (size_t)t * D + e0) = xo[c];
    }
  }
}

#define XB_TMO      128
#define XB_XCNT(j)  (256  + 64 * (j))
#define XB_XSUB(j)  (1280 + 64 * (j))
#define XB_XGEN(j)  (2304 + 64 * (j))
#define XB_TOP      3328
#define XB_TOPGEN   3392
#define XCD_BAR_WORDS 3456
#define XB_SPIN_CAP (1u << 22)
#define LAS __attribute__((address_space(3)))
__device__ __forceinline__ unsigned xb_ld(unsigned* p)              { return __hip_atomic_load(p, __ATOMIC_RELAXED, __HIP_MEMORY_SCOPE_AGENT); }
__device__ __forceinline__ unsigned xb_add(unsigned* p, unsigned v) { return __hip_atomic_fetch_add(p, v, __ATOMIC_RELAXED, __HIP_MEMORY_SCOPE_AGENT); }
__device__ __forceinline__ unsigned xb_xcc_id() { return (unsigned)__builtin_amdgcn_s_getreg((3 << 11) | 20) & 0xFu; }
#define XB_SPIN(cond, bar) do { unsigned _sp = 0; while (cond) { __builtin_amdgcn_s_sleep(1); \
    if ((++_sp & 255u) == 0u) { if (xb_ld(&(bar)[XB_TMO])) break; if (_sp > XB_SPIN_CAP) { atomicAdd(&(bar)[XB_TMO], 1u); break; } } } } while (0)
struct XcdBarrier { unsigned* bar; unsigned x; volatile LAS unsigned* st; };
__device__ __forceinline__ XcdBarrier xcd_barrier_post(unsigned* bar, volatile LAS unsigned* st) {
  XcdBarrier b; b.bar = bar; b.x = xb_xcc_id(); b.st = st;
  if (threadIdx.x == 0) (void)xb_add(&bar[XB_XCNT(b.x)], 1u);
  return b;
}
__device__ __forceinline__ void xcd_barrier_complete(unsigned* bar, unsigned x, unsigned& nloc, unsigned& nx) {
  const unsigned G = gridDim.x * gridDim.y * gridDim.z;
  unsigned sum, cnt, mine, sp = 0u;
  for (;;) {
    sum = 0u; cnt = 0u; mine = 0u;
#pragma unroll
    for (unsigned j = 0; j < 16; ++j) { const unsigned c = xb_ld(&bar[XB_XCNT(j)]); sum += c; cnt += (c > 0u) ? 1u : 0u; mine = (j == x) ? c : mine; }
    if (sum == G) break;
    __builtin_amdgcn_s_sleep(1);
    if ((++sp & 255u) == 0u) { if (xb_ld(&bar[XB_TMO])) break; if (sp > XB_SPIN_CAP) { atomicAdd(&bar[XB_TMO], 1u); break; } }
  }
  nloc = mine > 0u ? mine : 1u; nx = cnt > 0u ? cnt : 1u;
}
__device__ __forceinline__ void xcd_barrier(const XcdBarrier& b) {
  asm volatile("s_waitcnt vmcnt(0)" ::: "memory");
  __syncthreads();
  if (threadIdx.x == 0) {
    unsigned* bar = b.bar;
    __builtin_amdgcn_s_waitcnt(0);
    unsigned nloc = b.st[0], nx = b.st[1];
    if (nloc == 0u) { xcd_barrier_complete(bar, b.x, nloc, nx); b.st[0] = nloc; b.st[1] = nx; }
    const unsigned old = xb_add(&bar[XB_XSUB(b.x)], 1u);
    const unsigned gen = old / nloc;
    if (old + 1u == (gen + 1u) * nloc) {
      __builtin_amdgcn_fence(__ATOMIC_RELEASE, "agent");
      asm volatile("s_waitcnt vmcnt(0)" ::: "memory");
      const unsigned og = xb_add(&bar[XB_TOP], 1u);
      const unsigned tg = og / nx;
      if (og + 1u == (tg + 1u) * nx) xb_add(&bar[XB_TOPGEN], 1u);
      else XB_SPIN(xb_ld(&bar[XB_TOPGEN]) == tg, bar);
      __builtin_amdgcn_fence(__ATOMIC_ACQUIRE, "agent");
      xb_add(&bar[XB_XGEN(b.x)], 1u);
      asm volatile("s_waitcnt vmcnt(0)" ::: "memory");
    } else {
      XB_SPIN(xb_ld(&bar[XB_XGEN(b.x)]) == gen, bar);
      __builtin_amdgcn_fence(__ATOMIC_ACQUIRE, "agent");
      asm volatile("s_waitcnt vmcnt(0)" ::: "memory");
    }
  }
  __syncthreads();
}

__global__ void __launch_bounds__(NTHREADS, 2) fwd_mega(Params p) {
  __shared__ __attribute__((aligned(16))) char smem[75808];
  const int bid = blockIdx.x, nb = gridDim.x;
  volatile LAS unsigned* st = (volatile LAS unsigned*)(smem + 75792);
  if (threadIdx.x == 0) { st[0] = 0u; st[1] = 0u; }
  __syncthreads();
  const XcdBarrier bar = xcd_barrier_post(p.bar, st);
  phase_prep(p, bid, nb, smem);        xcd_barrier(bar);
  phase_fold(p, bid, nb, smem);        xcd_barrier(bar);
  phase_norm_mod(p, bid, nb, smem);    xcd_barrier(bar);
  phase_inproj(p, bid, nb, smem);      xcd_barrier(bar);
  phase_ssm_pre(p, bid, nb, smem);     xcd_barrier(bar);
  phase_ssd_dft(p, bid, nb, smem);     xcd_barrier(bar);
  phase_ssm_post(p, bid, nb, smem);    xcd_barrier(bar);
  phase_outproj(p, bid, nb, smem);     xcd_barrier(bar);
  phase_postmix(p, bid, nb, smem);     xcd_barrier(bar);
  phase_q_route(p, bid, nb, smem);     xcd_barrier(bar);
  phase_exp_u(p, smem);                xcd_barrier(bar);
  phase_exp_v(p, smem);                xcd_barrier(bar);
  phase_exp_final(p, bid, nb, smem);
}

}

extern "C" void kernel_launch(void* const* d_in, const int* in_sizes, int n_in, void* d_out, int out_size, void* d_ws,
                              size_t ws_size, hipStream_t stream) {
  Params p{};
  const float** fp = reinterpret_cast<const float**>(&p);
  for (int i = 0; i < 27; ++i) fp[i] = (const float*)d_in[i];
  p.out = (float*)d_out;
  char* ws = (char*)d_ws;
  size_t off = 0;
  auto take = [&](size_t bytes) { char* r = ws + off; off += (bytes + 255) & ~(size_t)255; return r; };
  p.U8 = (uint8_t*)take((size_t)16384 * D);
  p.V8 = (uint8_t*)take((size_t)16384 * D);
  p.uscale = (float*)take((size_t)16384 * 4);
  p.hx8a = (int8_t*)take((size_t)(T + TC) * D);
  p.w8 = (int8_t*)take((size_t)NPROJ * D);
  p.ascale = (float*)take((size_t)(T + TC) * 4);
  p.wscale = (float*)take((size_t)NPROJ * 4);
  p.ycat8 = (int8_t*)take((size_t)T * D);
  p.wo8 = (int8_t*)take((size_t)D * D);
  p.yscale = (float*)take((size_t)T * 4);
  p.woscale = (float*)take((size_t)D * 4);
  p.w_in_t = (bf16_t*)take((size_t)NPROJ * D * 2);
  p.w_out_t = (bf16_t*)take((size_t)D * D * 2);
  p.w_q_t = (bf16_t*)take((size_t)1024 * D * 2);
  p.w_in_f = (bf16_t*)take((size_t)D * 1024 * 2);
  p.WcsT = (bf16_t*)take((size_t)4 * 512 * 256 * 2);
  p.dftm = (bf16_t*)take((size_t)1024 * 2048 * 2);
  p.Fs = (bf16_t*)take((size_t)NB * 1024 * 2048 * 2);
  p.partial = (float*)take((size_t)KSPLIT * 5 * NMOD * 4);
  p.mod = (float*)take((size_t)5 * NMOD * 4);
  p.hx = (bf16_t*)take((size_t)T * D * 2);
  p.hc = (bf16_t*)take((size_t)TC * D * 2);
  p.ABt = (bf16_t*)take((size_t)NB * 1024 * 4096 * 2);
  p.q = (float*)p.ABt;
  p.z = (bf16_t*)take((size_t)T * 1024 * 2);
  char* r1 = take(0);
  p.xbcraw = (bf16_t*)take((size_t)T * DXBC * 4);
  p.xbcraw_c = (bf16_t*)take((size_t)TC * DXBC * 4);
  p.act_tm = (bf16_t*)take((size_t)(T + TC) * DXBC * 2);
  p.act_cm_x = (bf16_t*)take((size_t)NB * 1280 * L * 2);
  p.act_cm_c = (bf16_t*)take((size_t)NB * 1280 * CTX * 2);
  p.y_x = (float*)r1;
  p.dtraw = (float*)take((size_t)T * 32 * 4);
  p.dtraw_c = (float*)take((size_t)TC * 32 * 4);
  p.dtf = (float*)take((size_t)T * 16 * 4);
  p.dtb = (float*)take((size_t)T * 16 * 4);
  p.dtf_c = (float*)take((size_t)TC * 16 * 4);
  p.dtb_c = (float*)take((size_t)TC * 16 * 4);
  p.yf = (float*)take((size_t)T * 1024 * 4);
  p.yb = (float*)take((size_t)T * 1024 * 4);
  p.ctr = (unsigned*)take(256);
  p.bar = (unsigned*)take((size_t)XCD_BAR_WORDS * 4);
  p.ycat = (bf16_t*)take((size_t)T * D * 2);
  p.idx = (int*)take((size_t)T * 128 * 4);
  p.gate = (float*)take((size_t)T * 128 * 4);
  if (off > ws_size) { fprintf(stderr, "kernel_launch: workspace too small: need %zu have %zu\n", off, ws_size); return; }
  static int grid_blocks = 0;
  if (!grid_blocks) {
    int dev = 0, cus = 0, per_cu = 0;
    hipGetDevice(&dev);
    hipDeviceGetAttribute(&cus, hipDeviceAttributeMultiprocessorCount, dev);
    hipOccupancyMaxActiveBlocksPerMultiprocessor(&per_cu, fwd_mega, NTHREADS, 0);
    if (per_cu > 2) per_cu = 2;
    grid_blocks = cus * per_cu;
    if (grid_blocks <= 0) { fprintf(stderr, "kernel_launch: occupancy query gave %d x %d\n", cus, per_cu); grid_blocks = -1; }
  }
  if (grid_blocks < 0) return;
  (void)hipMemsetAsync(p.bar, 0, (size_t)XCD_BAR_WORDS * 4, stream);
  void* args[] = {&p};
  hipError_t e = hipLaunchCooperativeKernel((void*)fwd_mega, dim3(grid_blocks), dim3(NTHREADS), args, 0, stream);
  if (e != hipSuccess) fprintf(stderr, "cooperative launch failed: %s (grid %d)\n", hipGetErrorString(e), grid_blocks);
}
```

```cpp
#include <hip/hip_runtime.h>
#include <hip/hip_cooperative_groups.h>
#include <stdint.h>
#include <stdio.h>

namespace cg = cooperative_groups;
namespace {

typedef __attribute__((ext_vector_type(8))) short bf16x8;
typedef __attribute__((ext_vector_type(4))) float f32x4;
typedef unsigned short bf16_t;

constexpr int D = 2048, NB = 4, L = 2048, T = NB * L, CTX = 256, TC = NB * CTX;
constexpr int NMOD = 6 * D;
constexpr int NH = 16, HP = 64, NS = 128, DXBC = 1536;
constexpr int DIN = 3616;
constexpr int NPROJ = 4736;
constexpr int KSPLIT = 32;
constexpr float EPS = 1e-6f;
constexpr int NTHREADS = 256;

__device__ __forceinline__ bf16_t f2bf(float f) { __bf16 h = (__bf16)f; return __builtin_bit_cast(unsigned short, h); }
__device__ __forceinline__ float bf2f(bf16_t h) { return __uint_as_float(((uint32_t)h) << 16); }
__device__ __forceinline__ uint32_t pack2(float a, float b) {
  typedef __attribute__((ext_vector_type(2))) __bf16 bf16x2_t;
  typedef __attribute__((ext_vector_type(2))) float f32x2_t;
  const f32x2_t v = {a, b};
  return __builtin_bit_cast(uint32_t, __builtin_convertvector(v, bf16x2_t));
}
__device__ __forceinline__ float bflo(uint32_t w) { return __uint_as_float(w << 16); }
__device__ __forceinline__ float bfhi(uint32_t w) { return __uint_as_float(w & 0xffff0000u); }
__device__ __forceinline__ float silu_f(float v) { return v / (1.f + __expf(-v)); }
__device__ __forceinline__ float softplus_f(float v) { return v > 20.f ? v : log1pf(__expf(v)); }

__device__ __forceinline__ int opaque_tid() { int t = threadIdx.x; asm volatile("" : "+v"(t)); return t; }
__device__ __forceinline__ float wave_sum(float v) {
#pragma unroll
  for (int o = 32; o > 0; o >>= 1) v += __shfl_xor(v, o);
  return v;
}
template <int CTRL>
__device__ __forceinline__ float dpp_mov(float v) {
  return __int_as_float(__builtin_amdgcn_update_dpp(0, __float_as_int(v), CTRL, 0xF, 0xF, true));
}
template <int CTRL>
__device__ __forceinline__ int dpp_movi(int v) { return __builtin_amdgcn_update_dpp(0, v, CTRL, 0xF, 0xF, true); }
__device__ __forceinline__ float wave_sum_fast(float v) {
  v += dpp_mov<0xB1>(v); v += dpp_mov<0x4E>(v); v += dpp_mov<0x124>(v); v += dpp_mov<0x128>(v);
  v += __shfl_xor(v, 16); v += __shfl_xor(v, 32);
  return v;
}
__device__ __forceinline__ float wave_max(float v) {
#pragma unroll
  for (int o = 32; o > 0; o >>= 1) v = fmaxf(v, __shfl_xor(v, o));
  return v;
}
__device__ __forceinline__ float block_sum(float v, float* red) {
  v = wave_sum(v);
  __syncthreads();
  if ((threadIdx.x & 63) == 0) red[threadIdx.x >> 6] = v;
  __syncthreads();
  return red[0] + red[1] + red[2] + red[3];
}

struct Params {
  const float *x, *c, *ctx, *c_ctx, *w_mod, *b_mod, *g_pre_mix, *g_post_mix, *g_pre_ffn, *g_post_ffn;
  const float *w_in, *w_fmix, *conv_w, *conv_b, *dt_bias_f, *dt_bias_b, *a_log_f, *a_log_b, *d_skip_f, *d_skip_b;
  const float *ssm_norm_w, *w_out, *w_query, *sk1, *sk2, *eu, *ev;
  float* out;
  uint8_t *U8, *V8;
  float* uscale;
  int8_t *hx8a, *w8;
  float *ascale, *wscale;
  int8_t *ycat8, *wo8;
  float *yscale, *woscale;
  bf16_t *w_in_t, *w_out_t, *w_q_t, *w_in_f, *WcsT, *dftm, *Fs;
  float *partial, *mod;
  bf16_t *hx, *hc, *ABt, *z;
  bf16_t *xbcraw, *xbcraw_c;
  float *dtraw, *dtraw_c, *dtf, *dtb, *dtf_c, *dtb_c;
  bf16_t *act_tm, *act_cm_x, *act_cm_c;
  float *yf, *yb;
  unsigned* ctr; unsigned* bar;
  bf16_t* ycat;
  float *y_x, *q, *gate;
  int* idx;
  int pad0, pad1;
};

template <bool I8 = false>
__device__ __forceinline__ void gemm_mainloop(const bf16_t* __restrict__ A, int lda, const bf16_t* __restrict__ Bt, int ldb,
                                              int K, int m0, int n0, f32x4 (&acc)[4][4], char* smem) {
  const int tid = opaque_tid(), lane = tid & 63, w = tid >> 6;
  const int wm = w >> 1, wn = w & 1;
#pragma unroll
  for (int i = 0; i < 4; ++i)
#pragma unroll
    for (int j = 0; j < 4; ++j) acc[i][j] = f32x4{0.f, 0.f, 0.f, 0.f};

  const int nk = K / 64;
  const int rowoff = lane >> 3, lch = (lane & 7) ^ rowoff;
  const bf16_t* gA = A + (size_t)(m0 + w * 8 + rowoff) * lda + lch * 8;
  const bf16_t* gB = Bt + (size_t)(n0 + w * 8 + rowoff) * ldb + lch * 8;
#define GSTAGE(buf_, kt_)                                                                                               \
  do {                                                                                                                  \
    _Pragma("unroll") for (int i_ = 0; i_ < 4; ++i_) {                                                                  \
      __builtin_amdgcn_global_load_lds((const unsigned*)(gA + (size_t)(i_ * 32) * lda + (kt_) * 64),                    \
                                       (unsigned*)(smem + (buf_) * 32768 + (i_ * 4 + w) * 1024), 16, 0, 0);             \
      __builtin_amdgcn_global_load_lds((const unsigned*)(gB + (size_t)(i_ * 32) * ldb + (kt_) * 64),                    \
                                       (unsigned*)(smem + (buf_) * 32768 + 16384 + (i_ * 4 + w) * 1024), 16, 0, 0);     \
    }                                                                                                                   \
  } while (0)
  GSTAGE(0, 0);
  asm volatile("s_waitcnt vmcnt(0)" ::: "memory");
  __syncthreads();
  for (int kt = 0; kt < nk; ++kt) {
    const int cur = kt & 1;
    if (kt + 1 < nk) GSTAGE(cur ^ 1, kt + 1);
    const char* sA = smem + cur * 32768;
    const char* sB = sA + 16384;
#pragma unroll
    for (int kk = 0; kk < 2; ++kk) {
      bf16x8 af[4], bfr[4];
      const int ch = kk * 4 + (lane >> 4);
#pragma unroll
      for (int i = 0; i < 4; ++i) {
        int row = wm * 64 + i * 16 + (lane & 15);
        af[i] = *reinterpret_cast<const bf16x8*>(sA + row * 128 + ((ch ^ (row & 7)) << 4));
        int col = wn * 64 + i * 16 + (lane & 15);
        bfr[i] = *reinterpret_cast<const bf16x8*>(sB + col * 128 + ((ch ^ (col & 7)) << 4));
      }
#pragma unroll
      for (int i = 0; i < 4; ++i)
#pragma unroll
        for (int j = 0; j < 4; ++j) {
          if (I8) {
            typedef __attribute__((ext_vector_type(4))) int i32x4;
            acc[i][j] = __builtin_bit_cast(f32x4, __builtin_amdgcn_mfma_i32_16x16x64_i8(__builtin_bit_cast(i32x4, af[i]), __builtin_bit_cast(i32x4, bfr[j]),
                                                                                         __builtin_bit_cast(i32x4, acc[i][j]), 0, 0, 0));
          } else {
            acc[i][j] = __builtin_amdgcn_mfma_f32_16x16x32_bf16(af[i], bfr[j], acc[i][j], 0, 0, 0);
          }
        }
    }
    asm volatile("s_waitcnt vmcnt(0)" ::: "memory");
    __syncthreads();
  }
#undef GSTAGE
}

template <bool I8 = false, class Epi>
__device__ __forceinline__ void gemm_tile(const bf16_t* __restrict__ A, int lda, const bf16_t* __restrict__ Bt, int ldb,
                                          int K, int m0, int n0, const Epi& epi, char* smem,
                                          const float* __restrict__ rscale = nullptr, const float* __restrict__ cscale = nullptr) {
  const int lane = threadIdx.x & 63, w = threadIdx.x >> 6;
  const int wm = w >> 1, wn = w & 1;
  f32x4 acc[4][4];
  gemm_mainloop<I8>(A, lda, Bt, ldb, K, m0, n0, acc, smem);
#pragma unroll
  for (int i = 0; i < 4; ++i) {
    const int row = m0 + wm * 64 + i * 16 + (lane >> 4) * 4;
    float4 rs = float4{1.f, 1.f, 1.f, 1.f};
    if (I8) rs = *reinterpret_cast<const float4*>(rscale + row);
#pragma unroll
    for (int j = 0; j < 4; ++j) {
      const int col = n0 + wn * 64 + j * 16 + (lane & 15);
      if (I8) {
        typedef __attribute__((ext_vector_type(4))) int i32x4;
        const i32x4 ia = __builtin_bit_cast(i32x4, acc[i][j]);
        const float cs = cscale[col];
        epi(row, col, f32x4{(float)ia[0] * rs.x * cs, (float)ia[1] * rs.y * cs, (float)ia[2] * rs.z * cs, (float)ia[3] * rs.w * cs});
      } else {
        epi(row, col, acc[i][j]);
      }
    }
  }
}

template <bool I8>
__device__ __forceinline__ void gemm_mainloop_n256(const bf16_t* __restrict__ A, int lda, const bf16_t* __restrict__ Bt, int ldb,
                                                   int K, int m0, int n0, f32x4 (&acc)[4][8], char* smem) {
  const int tid = opaque_tid(), lane = tid & 63, w = tid >> 6;
  const int wm = w >> 1, wn = w & 1;
#pragma unroll
  for (int i = 0; i < 4; ++i)
#pragma unroll
    for (int j = 0; j < 8; ++j) acc[i][j] = f32x4{0.f, 0.f, 0.f, 0.f};
  const int nk = K / 64;
  const int rowoff = lane >> 3, lch = (lane & 7) ^ rowoff;
  const bf16_t* gA = A + (size_t)(m0 + w * 8 + rowoff) * lda + lch * 8;
  const bf16_t* gB = Bt + (size_t)(n0 + w * 8 + rowoff) * ldb + lch * 8;
  const int fr = lane & 15, fq = lane >> 4;
  for (int kt = 0; kt < nk; ++kt) {
#pragma unroll
    for (int i_ = 0; i_ < 4; ++i_)
      __builtin_amdgcn_global_load_lds((const unsigned*)(gA + (size_t)(i_ * 32) * lda + kt * 64),
                                       (unsigned*)(smem + (i_ * 4 + w) * 1024), 16, 0, 0);
#pragma unroll
    for (int i_ = 0; i_ < 8; ++i_)
      __builtin_amdgcn_global_load_lds((const unsigned*)(gB + (size_t)(i_ * 32) * ldb + kt * 64),
                                       (unsigned*)(smem + 16384 + (i_ * 4 + w) * 1024), 16, 0, 0);
    asm volatile("s_waitcnt vmcnt(0)" ::: "memory");
    __syncthreads();
    const char* sA = smem;
    const char* sB = smem + 16384;
#pragma unroll
    for (int kk = 0; kk < 2; ++kk) {
      bf16x8 af[4], bfr[8];
      const int ch = kk * 4 + fq;
#pragma unroll
      for (int i = 0; i < 4; ++i) {
        const int row = wm * 64 + i * 16 + fr;
        af[i] = *reinterpret_cast<const bf16x8*>(sA + row * 128 + ((ch ^ (row & 7)) << 4));
      }
#pragma unroll
      for (int j = 0; j < 8; ++j) {
        const int col = wn * 128 + j * 16 + fr;
        bfr[j] = *reinterpret_cast<const bf16x8*>(sB + col * 128 + ((ch ^ (col & 7)) << 4));
      }
#pragma unroll
      for (int i = 0; i < 4; ++i)
#pragma unroll
        for (int j = 0; j < 8; ++j) {
          if (I8) {
            typedef __attribute__((ext_vector_type(4))) int i32x4;
            acc[i][j] = __builtin_bit_cast(f32x4, __builtin_amdgcn_mfma_i32_16x16x64_i8(__builtin_bit_cast(i32x4, af[i]), __builtin_bit_cast(i32x4, bfr[j]),
                                                                                         __builtin_bit_cast(i32x4, acc[i][j]), 0, 0, 0));
          } else {
            acc[i][j] = __builtin_amdgcn_mfma_f32_16x16x32_bf16(af[i], bfr[j], acc[i][j], 0, 0, 0);
          }
        }
    }
    __syncthreads();
  }
}
template <bool I8, class Epi>
__device__ __forceinline__ void gemm_tile_n256(const bf16_t* __restrict__ A, int lda, const bf16_t* __restrict__ Bt, int ldb,
                                               int K, int m0, int n0, const Epi& epi, char* smem,
                                               const float* __restrict__ rscale = nullptr, const float* __restrict__ cscale = nullptr) {
  const int lane = threadIdx.x & 63, w = threadIdx.x >> 6;
  const int wm = w >> 1, wn = w & 1;
  f32x4 acc[4][8];
  gemm_mainloop_n256<I8>(A, lda, Bt, ldb, K, m0, n0, acc, smem);
#pragma unroll
  for (int i = 0; i < 4; ++i) {
    const int row = m0 + wm * 64 + i * 16 + (lane >> 4) * 4;
    float4 rs = float4{1.f, 1.f, 1.f, 1.f};
    if (I8) rs = *reinterpret_cast<const float4*>(rscale + row);
#pragma unroll
    for (int j = 0; j < 8; ++j) {
      const int col = n0 + wn * 128 + j * 16 + (lane & 15);
      if (I8) {
        typedef __attribute__((ext_vector_type(4))) int i32x4;
        const i32x4 ia = __builtin_bit_cast(i32x4, acc[i][j]);
        const float cs = cscale[col];
        epi(row, col, f32x4{(float)ia[0] * rs.x * cs, (float)ia[1] * rs.y * cs, (float)ia[2] * rs.z * cs, (float)ia[3] * rs.w * cs});
      } else {
        epi(row, col, acc[i][j]);
      }
    }
  }
}

__device__ __forceinline__ float wave_max_fast(float v) {
  v = fmaxf(v, dpp_mov<0xB1>(v)); v = fmaxf(v, dpp_mov<0x4E>(v)); v = fmaxf(v, dpp_mov<0x124>(v)); v = fmaxf(v, dpp_mov<0x128>(v));
  v = fmaxf(v, __shfl_xor(v, 16)); v = fmaxf(v, __shfl_xor(v, 32));
  return v;
}
__device__ __forceinline__ uint32_t pack_i8x4(float a, float b, float c, float d) {
  const int ia = __float2int_rn(a), ib = __float2int_rn(b), ic = __float2int_rn(c), id = __float2int_rn(d);
  return (uint32_t)(ia & 255) | ((uint32_t)(ib & 255) << 8) | ((uint32_t)(ic & 255) << 16) | ((uint32_t)id << 24);
}
struct EpiF32 {
  float* C; int ldc;
  __device__ __forceinline__ void operator()(int row, int col, f32x4 v) const {
#pragma unroll
    for (int r = 0; r < 4; ++r) C[(size_t)(row + r) * ldc + col] = v[r];
  }
};
struct EpiBf16 {
  bf16_t* C; int ldc;
  __device__ __forceinline__ void operator()(int row, int col, f32x4 v) const {
#pragma unroll
    for (int r = 0; r < 4; ++r) C[(size_t)(row + r) * ldc + col] = f2bf(v[r]);
  }
};
struct EpiBf16T {
  bf16_t* Ct; int ldc;
  __device__ __forceinline__ void operator()(int row, int col, f32x4 v) const {
    uint2 pk; pk.x = pack2(v[0], v[1]); pk.y = pack2(v[2], v[3]);
    *reinterpret_cast<uint2*>(Ct + (size_t)col * ldc + row) = pk;
  }
};
struct EpiInAB {
  bf16_t* ABt; int seqlen;
  __device__ __forceinline__ void operator()(int row, int col, f32x4 v) const {
    const int ch = col & 1023, half = col >> 10;
    const int b = row / seqlen, l = row - b * seqlen;
    uint2 pk; pk.x = pack2(v[0], v[1]); pk.y = pack2(v[2], v[3]);
    *reinterpret_cast<uint2*>(ABt + ((size_t)(b * 1024 + ch) * 4096 + half * 2048 + l)) = pk;
  }
};
struct EpiInZ {
  bf16_t* z;
  __device__ __forceinline__ void operator()(int row, int col, f32x4 v) const {
#pragma unroll
    for (int r = 0; r < 4; ++r) z[(size_t)(row + r) * 1024 + (col - 2048)] = f2bf(v[r]);
  }
};
struct EpiInXbc {
  bf16_t* xbcraw;
  __device__ __forceinline__ void operator()(int row, int col, f32x4 v) const {
#pragma unroll
    for (int r = 0; r < 4; ++r) xbcraw[(size_t)(row + r) * DXBC + (col - 3072)] = f2bf(v[r]);
  }
};
struct EpiInProj {
  bf16_t* ABt; bf16_t* z; bf16_t* xbcraw; float* dtraw; int seqlen;
  __device__ __forceinline__ void operator()(int row, int col, f32x4 v) const {
    if (col < 2048) {
      int ch = col & 1023, half = col >> 10;
      int b = row / seqlen, l = row - b * seqlen;
      uint2 pk; pk.x = pack2(v[0], v[1]); pk.y = pack2(v[2], v[3]);
      *reinterpret_cast<uint2*>(ABt + ((size_t)(b * 1024 + ch) * 4096 + half * 2048 + l)) = pk;
    } else if (col < 3072) {
#pragma unroll
      for (int r = 0; r < 4; ++r) z[(size_t)(row + r) * 1024 + (col - 2048)] = f2bf(v[r]);
    } else if (col < 4608) {
#pragma unroll
      for (int r = 0; r < 4; ++r) xbcraw[(size_t)(row + r) * DXBC + (col - 3072)] = f2bf(v[r]);
    } else if (col < 4640) {
#pragma unroll
      for (int r = 0; r < 4; ++r) dtraw[(size_t)(row + r) * 32 + (col - 4608)] = v[r];
    }
  }
};

__device__ void adaln_partial_task(const Params& p, int task, float* sm) {
  const int cb = task % 48, ks = task / 48, tid = threadIdx.x;
  float* sc = sm;
  __syncthreads();
  for (int i = tid; i < 5 * 64; i += NTHREADS) {
    int r = i >> 6, kk = i & 63;
    int k = ks * 64 + kk;
    float cv = (r < 4) ? p.c[r * D + k] : p.c_ctx[k];
    sc[i] = silu_f(cv);
  }
  __syncthreads();
  const int col = cb * 256 + tid;
  float a0 = 0, a1 = 0, a2 = 0, a3 = 0, a4 = 0;
  const float* wp = p.w_mod + (size_t)(ks * 64) * NMOD + col;
#pragma unroll
  for (int h2 = 0; h2 < 2; ++h2) {
    float wv[32];
#pragma unroll
    for (int kk = 0; kk < 32; ++kk) wv[kk] = __builtin_nontemporal_load(wp + (size_t)(h2 * 32 + kk) * NMOD);
#pragma unroll
    for (int kk = 0; kk < 32; ++kk) {
      const int k = h2 * 32 + kk;
      a0 += sc[k] * wv[kk]; a1 += sc[64 + k] * wv[kk]; a2 += sc[128 + k] * wv[kk]; a3 += sc[192 + k] * wv[kk]; a4 += sc[256 + k] * wv[kk];
    }
  }
  float* pp = p.partial + (size_t)ks * 5 * NMOD + col;
  pp[0] = a0; pp[NMOD] = a1; pp[2 * NMOD] = a2; pp[3 * NMOD] = a3; pp[4 * NMOD] = a4;
}

__device__ void transpose_convert_task(const float* __restrict__ src, int ld, int c0, int rows, bf16_t* __restrict__ dst,
                                       int tr, int tc, float* sm) {
  float (*tile)[68] = reinterpret_cast<float (*)[68]>(sm);
  const int tid = threadIdx.x;
  __syncthreads();
  {
    float4 v[4];
#pragma unroll
    for (int k = 0; k < 4; ++k) {
      const int i = tid + k * NTHREADS, r = i >> 4, c4 = i & 15;
      v[k] = *reinterpret_cast<const float4*>(src + (size_t)(tr * 64 + r) * ld + c0 + tc * 64 + c4 * 4);
    }
#pragma unroll
    for (int k = 0; k < 4; ++k) {
      const int i = tid + k * NTHREADS, r = i >> 4, c4 = i & 15;
      *reinterpret_cast<float4*>(&tile[r][c4 * 4]) = v[k];
    }
  }
  __syncthreads();
#pragma unroll
  for (int k = 0; k < 4; ++k) {
    const int i = tid + k * NTHREADS, cc = i >> 4, r4 = (i & 15) * 4;
    uint2 o; o.x = pack2(tile[r4][cc], tile[r4 + 1][cc]); o.y = pack2(tile[r4 + 2][cc], tile[r4 + 3][cc]);
    *reinterpret_cast<uint2*>(dst + (size_t)(tc * 64 + cc) * rows + tr * 64 + r4) = o;
  }
}

__device__ void phase_prep(const Params& p, int bid, int nb, char* smem) {
  float* sm = reinterpret_cast<float*>(smem);
  const int tid = threadIdx.x;
  if (bid == 0 && tid < 64) p.ctr[tid] = 0u;
  {
    float* t256 = reinterpret_cast<float*>(smem + 20480);
    float* t2048 = reinterpret_cast<float*>(smem + 24576);
    t256[tid] = cospif((float)tid * (1.0f / 128.f));
    for (int i = tid; i < 2048; i += NTHREADS) t2048[i] = cospif((float)i * (1.0f / 1024.f));
    __syncthreads();
  }
  for (int t = bid; t < 48 * KSPLIT; t += nb) adaln_partial_task(p, t, sm);
  {
    const int nct = 41, nrt = 32;
    for (int t = bid; t < nct * nrt; t += nb) {
      int tc = t % nct, tr = t / nct;
      if (tc < 40) transpose_convert_task(p.w_in, DIN, 1024, D, p.w_in_t + (size_t)2048 * D, tr, tc, sm);
      else {
        float (*tile)[65] = reinterpret_cast<float (*)[65]>(sm);
        __syncthreads();
        for (int i = tid; i < 64 * 32; i += NTHREADS) {
          int r = i >> 5, cc = i & 31;
          tile[r][cc] = p.w_in[(size_t)(tr * 64 + r) * DIN + 1024 + 2560 + cc];
        }
        __syncthreads();
        for (int i = tid; i < 32 * 32; i += NTHREADS) {
          int cc = i >> 5, r2 = (i & 31) * 2;
          uint32_t pk = pack2(tile[r2][cc], tile[r2 + 1][cc]);
          *reinterpret_cast<uint32_t*>(p.w_in_t + (size_t)(2048 + 2560 + cc) * D + tr * 64 + r2) = pk;
        }
      }
    }
    for (size_t i = (size_t)bid * NTHREADS + tid; i < (size_t)96 * D / 8; i += (size_t)nb * NTHREADS)
      reinterpret_cast<uint4*>(p.w_in_t + (size_t)4640 * D)[i] = uint4{0, 0, 0, 0};
  }
  for (size_t i = (size_t)bid * NTHREADS + tid; i < (size_t)D * 1024 / 4; i += (size_t)nb * NTHREADS) {
    int k = (int)(i / 256), c4 = (int)(i % 256) * 4;
    float4 v = *reinterpret_cast<const float4*>(p.w_in + (size_t)k * DIN + c4);
    uint2 o; o.x = pack2(v.x, v.y); o.y = pack2(v.z, v.w);
    *reinterpret_cast<uint2*>(p.w_in_f + (size_t)k * 1024 + c4) = o;
  }
  {
    const float* t256 = reinterpret_cast<const float*>(smem + 20480);
    const float scale = 1.0f / sqrtf((float)L * 256.f);
    for (int i = bid * NTHREADS + tid; i < 4 * 64 * 256; i += nb * NTHREADS) {
      const int d = i & 255, cg = (i >> 8) & 63, g = i >> 14;
      float c0_ = 0.f, c1_ = 0.f, c2_ = 0.f, c3_ = 0.f, s0_ = 0.f, s1_ = 0.f, s2_ = 0.f, s3_ = 0.f;
      const float* wp = p.w_fmix + (size_t)g * 65536 + d;
#pragma unroll 1
      for (int mb = 0; mb < 256; mb += 16) {
        float wv[16];
#pragma unroll
        for (int mm = 0; mm < 16; ++mm) wv[mm] = wp[(mb + mm) * 256];
#pragma unroll
        for (int mm = 0; mm < 16; ++mm) {
          const int m = mb + mm;
          const int p0 = (m * (cg * 4 + 0)) & 255, p1 = (m * (cg * 4 + 1)) & 255, p2 = (m * (cg * 4 + 2)) & 255, p3 = (m * (cg * 4 + 3)) & 255;
          c0_ += t256[p0] * wv[mm]; s0_ += t256[(p0 - 64) & 255] * wv[mm];
          c1_ += t256[p1] * wv[mm]; s1_ += t256[(p1 - 64) & 255] * wv[mm];
          c2_ += t256[p2] * wv[mm]; s2_ += t256[(p2 - 64) & 255] * wv[mm];
          c3_ += t256[p3] * wv[mm]; s3_ += t256[(p3 - 64) & 255] * wv[mm];
        }
      }
      {
        bf16_t* wc = p.WcsT + ((size_t)g * 512 + d) * 256 + cg * 4;
        bf16_t* ws_ = p.WcsT + ((size_t)g * 512 + 256 + d) * 256 + cg * 4;
        uint2 oc, os;
        oc.x = pack2(c0_ * scale, c1_ * scale); oc.y = pack2(c2_ * scale, c3_ * scale);
        os.x = pack2(s0_ * scale, s1_ * scale); os.y = pack2(s2_ * scale, s3_ * scale);
        *reinterpret_cast<uint2*>(wc) = oc;
        *reinterpret_cast<uint2*>(ws_) = os;
      }
    }
  }
  {
    const float* t2048 = reinterpret_cast<const float*>(smem + 24576);
    for (size_t i = (size_t)bid * NTHREADS + tid; i < (size_t)1024 * 2048 / 8; i += (size_t)nb * NTHREADS) {
      const int k = (int)(i / 256), j = (int)(i % 256) * 8;
      const bool iss = j >= 1024;
      float o[8];
#pragma unroll
      for (int e = 0; e < 8; ++e) {
        const int l = (j + e) & 1023;
        const int ph = (k * l) & 2047;
        o[e] = iss ? t2048[(ph - 512) & 2047] : t2048[ph];
      }
      uint4 pk; pk.x = pack2(o[0], o[1]); pk.y = pack2(o[2], o[3]); pk.z = pack2(o[4], o[5]); pk.w = pack2(o[6], o[7]);
      *reinterpret_cast<uint4*>(p.dftm + (size_t)k * 2048 + j) = pk;
    }
  }
}

__device__ void phase_fold(const Params& p, int bid, int nb, char* smem) {
  const int tid = threadIdx.x;
  for (int i = bid * NTHREADS + tid; i < 5 * NMOD; i += nb * NTHREADS) {
    int col = i % NMOD;
    float s = p.b_mod[col];
    for (int ks = 0; ks < KSPLIT; ++ks) s += p.partial[(size_t)ks * 5 * NMOD + i];
    p.mod[i] = s;
  }
  for (int t = bid; t < 256; t += nb) {
    int g = t >> 6, tm = (t & 63) >> 2, tn = t & 3;
    int n0 = tn * 128;
    int rowbase = (n0 < 256) ? (g * 256 + n0) : (1024 + g * 256 + (n0 - 256));
    EpiBf16T epi{p.w_in_t + (size_t)(rowbase - n0) * D, D};
    gemm_tile(p.w_in_f + g * 256, 1024, p.WcsT + (size_t)g * 512 * 256, 256, 256, tm * 128, n0, epi, smem);
  }
}

__device__ __forceinline__ void quant_weight_rows_i8(const bf16_t* __restrict__ src, int8_t* __restrict__ dst, float* __restrict__ scl,
                                                     int nrows, int bid, int nb) {
  const int lane = threadIdx.x & 63, w = threadIdx.x >> 6;
  for (int n = bid * 4 + w; n < nrows; n += nb * 4) {
    const bf16_t* wr = src + (size_t)n * D;
    uint4 q[4];
#pragma unroll
    for (int c = 0; c < 4; ++c) q[c] = *reinterpret_cast<const uint4*>(wr + c * 512 + lane * 8);
    float am = 0.f;
#pragma unroll
    for (int c = 0; c < 4; ++c) {
      am = fmaxf(am, fmaxf(fmaxf(fabsf(bflo(q[c].x)), fabsf(bfhi(q[c].x))), fmaxf(fabsf(bflo(q[c].y)), fabsf(bfhi(q[c].y)))));
      am = fmaxf(am, fmaxf(fmaxf(fabsf(bflo(q[c].z)), fabsf(bfhi(q[c].z))), fmaxf(fabsf(bflo(q[c].w)), fabsf(bfhi(q[c].w)))));
    }
    am = wave_max_fast(am);
    const float inv = (am > 0.f) ? 127.f / am : 0.f;
#pragma unroll
    for (int c = 0; c < 4; ++c) {
      uint2 o;
      o.x = pack_i8x4(bflo(q[c].x) * inv, bfhi(q[c].x) * inv, bflo(q[c].y) * inv, bfhi(q[c].y) * inv);
      o.y = pack_i8x4(bflo(q[c].z) * inv, bfhi(q[c].z) * inv, bflo(q[c].w) * inv, bfhi(q[c].w) * inv);
      *reinterpret_cast<uint2*>(dst + (size_t)n * D + c * 512 + lane * 8) = o;
    }
    if (lane == 0) scl[n] = am * (1.f / 127.f);
  }
}

__device__ void phase_norm_mod(const Params& p, int bid, int nb, char* smem) {
  const int lane = threadIdx.x & 63, w = threadIdx.x >> 6;
  for (int t = bid * 4 + w; t < T + TC; t += nb * 4) {
    const bool isx = t < T;
    const float* src = isx ? (p.x + (size_t)t * D) : (p.ctx + (size_t)(t - T) * D);
    const int mrow = isx ? (t / L) : 4;
    float4 v[8];
    float ss = 0.f;
#pragma unroll
    for (int c = 0; c < 8; ++c) {
      v[c] = *reinterpret_cast<const float4*>(src + c * 256 + lane * 4);
      ss += v[c].x * v[c].x + v[c].y * v[c].y + v[c].z * v[c].z + v[c].w * v[c].w;
    }
    ss = wave_sum_fast(ss);
    const float rstd = rsqrtf(ss * (1.f / D) + EPS);
    const float* sh = p.mod + (size_t)mrow * NMOD + 0 * D;
    const float* sc = p.mod + (size_t)mrow * NMOD + 1 * D;
    float am = 0.f;
#pragma unroll
    for (int c = 0; c < 8; ++c) {
      const int e0 = c * 256 + lane * 4;
      const float4 g = *reinterpret_cast<const float4*>(p.g_pre_mix + e0);
      const float4 s4 = *reinterpret_cast<const float4*>(sc + e0), h4 = *reinterpret_cast<const float4*>(sh + e0);
      v[c].x = v[c].x * rstd * g.x * (1.f + s4.x) + h4.x; v[c].y = v[c].y * rstd * g.y * (1.f + s4.y) + h4.y;
      v[c].z = v[c].z * rstd * g.z * (1.f + s4.z) + h4.z; v[c].w = v[c].w * rstd * g.w * (1.f + s4.w) + h4.w;
      am = fmaxf(am, fmaxf(fmaxf(fabsf(v[c].x), fabsf(v[c].y)), fmaxf(fabsf(v[c].z), fabsf(v[c].w))));
    }
    {
      am = wave_max_fast(am);
      const float inv = (am > 0.f) ? 127.f / am : 0.f;
#pragma unroll
      for (int c = 0; c < 8; ++c)
        *reinterpret_cast<uint32_t*>(p.hx8a + (size_t)t * D + c * 256 + lane * 4) = pack_i8x4(v[c].x * inv, v[c].y * inv, v[c].z * inv, v[c].w * inv);
      if (lane == 0) p.ascale[t] = am * (1.f / 127.f);
    }
  }
  quant_weight_rows_i8(p.w_in_t, p.w8, p.wscale, NPROJ, bid, nb);
}

__device__ __forceinline__ void convert_v_units(const Params& p, size_t u0, size_t u1) {
  for (size_t j = u0 + threadIdx.x; j < u1; j += NTHREADS) {
    uint32_t o[4];
#pragma unroll
    for (int q4 = 0; q4 < 4; ++q4) {
      const float4 v = *reinterpret_cast<const float4*>(p.ev + j * 16 + q4 * 4);
      int pk = 0;
      pk = __builtin_amdgcn_cvt_pk_fp8_f32(v.x * 512.f, v.y * 512.f, pk, false);
      pk = __builtin_amdgcn_cvt_pk_fp8_f32(v.z * 512.f, v.w * 512.f, pk, true);
      o[q4] = (uint32_t)pk;
    }
    const size_t e_ = j >> 7, r_ = j & 127;
    *reinterpret_cast<uint4*>(p.V8 + (r_ >> 4) * ((size_t)16384 * 256) + e_ * 256 + (r_ & 15) * 16) = uint4{o[0], o[1], o[2], o[3]};
  }
}
__device__ __forceinline__ void convert_u_rows(const Params& p, int q) {
  const int lane = threadIdx.x & 63, w = threadIdx.x >> 6;
  const int row0 = q * 32 + w * 8;
#pragma unroll 1
  for (int rr = 0; rr < 8; rr += 2) {
    f32x4 va[8], vb[8];
#pragma unroll
    for (int k = 0; k < 8; ++k) va[k] = __builtin_nontemporal_load(reinterpret_cast<const f32x4*>(p.eu + (size_t)(row0 + rr) * D + k * 256 + lane * 4));
#pragma unroll
    for (int k = 0; k < 8; ++k) vb[k] = __builtin_nontemporal_load(reinterpret_cast<const f32x4*>(p.eu + (size_t)(row0 + rr + 1) * D + k * 256 + lane * 4));
#define CONV_U_EMIT(v_, row_)                                                                                           \
    {                                                                                                                   \
      float m = 0.f;                                                                                                    \
      _Pragma("unroll") for (int k = 0; k < 8; ++k)                                                                     \
        m = fmaxf(m, fmaxf(fmaxf(fabsf(v_[k][0]), fabsf(v_[k][1])), fmaxf(fabsf(v_[k][2]), fabsf(v_[k][3]))));        \
      m = wave_max_fast(m);                                                                                             \
      const float inv = (m > 0.f) ? 127.f / m : 0.f;                                                                    \
      _Pragma("unroll") for (int k = 0; k < 8; ++k)                                                                     \
        *reinterpret_cast<uint32_t*>(p.U8 + (size_t)k * ((size_t)16384 * 256) + (size_t)(row_) * 256 + lane * 4) =      \
            pack_i8x4(v_[k][0] * inv, v_[k][1] * inv, v_[k][2] * inv, v_[k][3] * inv);                                  \
      if (lane == 0) p.uscale[row_] = m * (1.f / 127.f);                                                                \
    }
    CONV_U_EMIT(va, row0 + rr);
    CONV_U_EMIT(vb, row0 + rr + 1);
#undef CONV_U_EMIT
  }
}
__device__ void phase_inproj(const Params& p, int bid, int nb, char* smem) {
  const bool aware = (nb & 7) == 0;
  const int start = aware ? (bid >> 3) : bid, step = aware ? (nb >> 3) : nb, end = aware ? (128 + 53) : 8 * (128 + 53);
  const bf16_t* a8 = reinterpret_cast<const bf16_t*>(p.hx8a);
  const bf16_t* b8 = reinterpret_cast<const bf16_t*>(p.w8);
  for (int it = start; it < end; it += step) {
    const int x = aware ? (bid & 7) : it / (128 + 53), s_ = aware ? it : it % (128 + 53);
    if (s_ < 128) {
      const int tn2 = s_ >> 3, m0_ = (8 * x + (s_ & 7)) * 128;
      if (tn2 < 8) { EpiInAB epi{p.ABt, L}; gemm_tile_n256<true>(a8, D / 2, b8, D / 2, D / 2, m0_, tn2 * 256, epi, smem, p.ascale, p.wscale); }
      else if (tn2 < 12) { EpiInZ epi{p.z}; gemm_tile_n256<true>(a8, D / 2, b8, D / 2, D / 2, m0_, tn2 * 256, epi, smem, p.ascale, p.wscale); }
      else { EpiInXbc epi{p.xbcraw}; gemm_tile_n256<true>(a8, D / 2, b8, D / 2, D / 2, m0_, tn2 * 256, epi, smem, p.ascale, p.wscale); }
    } else if (s_ < 128 + 40) {
      const int i = s_ - 128;
      EpiInProj epi{p.ABt, p.z, p.xbcraw, p.dtraw, L};
      gemm_tile<true>(a8, D / 2, b8, D / 2, D / 2, (8 * x + (i & 7)) * 128, (32 + (i >> 3)) * 128, epi, smem, p.ascale, p.wscale);
    } else {
      const int u = x * 13 + (s_ - 168);
      EpiInProj epi{nullptr, nullptr, p.xbcraw_c, p.dtraw_c, CTX};
      gemm_tile<true>(reinterpret_cast<const bf16_t*>(p.hx8a + (size_t)T * D), D / 2, b8, D / 2, D / 2, (u / 13) * 128, 3072 + (u % 13) * 128, epi, smem,
                      p.ascale + T, p.wscale);
    }
  }
}

__device__ void ssm_pre_tile(const Params& p, int task, char* smem) {
  const bool isx = task < 3072;
  const int u = isx ? task : task - 3072;
  const int ntt = isx ? 32 : 4;
  const int ct = u % 24, tt = (u / 24) % ntt, b = u / (24 * ntt);
  const int seqlen = isx ? L : CTX;
  const bf16_t* raw = (isx ? p.xbcraw : p.xbcraw_c) + (size_t)b * seqlen * DXBC;
  const int l0 = tt * 64, c0 = ct * 64, tid = threadIdx.x;
  float (*rt)[68] = reinterpret_cast<float (*)[68]>(smem);
  float (*at)[65] = reinterpret_cast<float (*)[65]>(smem + 66 * 68 * 4);
  __syncthreads();
  {
    uint2 v[5];
#pragma unroll
    for (int k = 0; k < 5; ++k) {
      const int i = tid + k * NTHREADS, r = i >> 4, c4 = i & 15, l = l0 - 1 + r;
      v[k] = (i < 66 * 16 && l >= 0 && l < seqlen) ? *reinterpret_cast<const uint2*>(raw + (size_t)l * DXBC + c0 + c4 * 4) : uint2{0u, 0u};
    }
#pragma unroll
    for (int k = 0; k < 5; ++k) {
      const int i = tid + k * NTHREADS, r = i >> 4, c4 = i & 15;
      if (i < 66 * 16) *reinterpret_cast<float4*>(&rt[r][c4 * 4]) = float4{bflo(v[k].x), bfhi(v[k].x), bflo(v[k].y), bfhi(v[k].y)};
    }
  }
  __syncthreads();
  {
    const int cc = tid & 63, c = c0 + cc;
    const float w0 = p.conv_w[c], w1 = p.conv_w[DXBC + c], w2 = p.conv_w[2 * DXBC + c], cb = p.conv_b[c];
#pragma unroll 4
    for (int r = tid >> 6; r < 64; r += 4) at[r][cc] = silu_f(cb + rt[r][cc] * w0 + rt[r + 1][cc] * w1 + rt[r + 2][cc] * w2);
  }
  __syncthreads();
  const size_t trow0 = isx ? ((size_t)b * L + l0) : ((size_t)T + (size_t)b * CTX + l0);
#pragma unroll
  for (int k = 0; k < 4; ++k) {
    const int i = tid + k * NTHREADS, r = i >> 4, c4 = (i & 15) * 4;
    uint2 o; o.x = pack2(at[r][c4], at[r][c4 + 1]); o.y = pack2(at[r][c4 + 2], at[r][c4 + 3]);
    *reinterpret_cast<uint2*>(p.act_tm + (trow0 + r) * DXBC + c0 + c4) = o;
  }
  if (c0 < 1280) {
    bf16_t* cm = (isx ? p.act_cm_x : p.act_cm_c) + (size_t)b * 1280 * seqlen;
#pragma unroll
    for (int k = 0; k < 4; ++k) {
      const int i = tid + k * NTHREADS, cc = i >> 4, r4 = (i & 15) * 4;
      uint2 o; o.x = pack2(at[r4][cc], at[r4 + 1][cc]); o.y = pack2(at[r4 + 2][cc], at[r4 + 3][cc]);
      *reinterpret_cast<uint2*>(cm + (size_t)(c0 + cc) * seqlen + l0 + r4) = o;
    }
  }
}
__device__ void dft_fold_rows(const Params& p, int bid, int nb, char* smem) {
  const int lane = threadIdx.x & 63, w = threadIdx.x >> 6;
  bf16_t* sr = reinterpret_cast<bf16_t*>(smem + w * 8192);
  for (int row = bid * 4 + w; row < NB * 1024; row += nb * 4) {
    const bf16_t* A = p.ABt + (size_t)row * 4096;
    bf16_t* F = p.Fs + (size_t)row * 2048;
    __builtin_amdgcn_wave_barrier();
    {
      const uint4 q0 = *reinterpret_cast<const uint4*>(A + (0 * 64 + lane) * 8), q1 = *reinterpret_cast<const uint4*>(A + (1 * 64 + lane) * 8);
      const uint4 q2 = *reinterpret_cast<const uint4*>(A + (2 * 64 + lane) * 8), q3 = *reinterpret_cast<const uint4*>(A + (3 * 64 + lane) * 8);
      const uint4 q4 = *reinterpret_cast<const uint4*>(A + (4 * 64 + lane) * 8), q5 = *reinterpret_cast<const uint4*>(A + (5 * 64 + lane) * 8);
      const uint4 q6 = *reinterpret_cast<const uint4*>(A + (6 * 64 + lane) * 8), q7 = *reinterpret_cast<const uint4*>(A + (7 * 64 + lane) * 8);
      *reinterpret_cast<uint4*>(sr + (0 * 64 + lane) * 8) = q0; *reinterpret_cast<uint4*>(sr + (1 * 64 + lane) * 8) = q1;
      *reinterpret_cast<uint4*>(sr + (2 * 64 + lane) * 8) = q2; *reinterpret_cast<uint4*>(sr + (3 * 64 + lane) * 8) = q3;
      *reinterpret_cast<uint4*>(sr + (4 * 64 + lane) * 8) = q4; *reinterpret_cast<uint4*>(sr + (5 * 64 + lane) * 8) = q5;
      *reinterpret_cast<uint4*>(sr + (6 * 64 + lane) * 8) = q6; *reinterpret_cast<uint4*>(sr + (7 * 64 + lane) * 8) = q7;
    }
    __builtin_amdgcn_wave_barrier();
    const int l0 = lane * 16;
    float alt = 0.f;
    uint32_t oa[8], ob[8];
#pragma unroll
    for (int half = 0; half < 2; ++half) {
      const bf16_t* base = sr + half * 2048;
      const uint4 fa = *reinterpret_cast<const uint4*>(base + l0), fb = *reinterpret_cast<const uint4*>(base + l0 + 8);
      const uint4 ra = *reinterpret_cast<const uint4*>(base + 2032 - l0), rb = *reinterpret_cast<const uint4*>(base + 2040 - l0);
      const float r16 = (lane > 0) ? bf2f(base[2048 - l0]) : 0.f;
      const uint32_t fw[8] = {fa.x, fa.y, fa.z, fa.w, fb.x, fb.y, fb.z, fb.w};
      const uint32_t rw[8] = {ra.x, ra.y, ra.z, ra.w, rb.x, rb.y, rb.z, rb.w};
      float v[16];
#pragma unroll
      for (int i = 0; i < 16; ++i) {
        const float fwv = (i & 1) ? bfhi(fw[i >> 1]) : bflo(fw[i >> 1]);
        const int j = 16 - i;
        const float rv = (i == 0) ? r16 : ((j & 1) ? bfhi(rw[j >> 1]) : bflo(rw[j >> 1]));
        if (half == 0) v[i] = (lane == 0 && i == 0) ? fwv : fwv + rv;
        else v[i] = (lane == 0 && i == 0) ? 0.f : fwv - rv;
      }
      if (half == 0) {
#pragma unroll
        for (int i = 0; i < 16; ++i) alt += (i & 1) ? -v[i] : v[i];
#pragma unroll
        for (int i = 0; i < 8; ++i) oa[i] = pack2(v[2 * i], v[2 * i + 1]);
      } else {
#pragma unroll
        for (int i = 0; i < 8; ++i) ob[i] = pack2(v[2 * i], v[2 * i + 1]);
      }
    }
    *reinterpret_cast<uint4*>(F + l0) = uint4{oa[0], oa[1], oa[2], oa[3]};
    *reinterpret_cast<uint4*>(F + l0 + 8) = uint4{oa[4], oa[5], oa[6], oa[7]};
    *reinterpret_cast<uint4*>(F + 1024 + l0) = uint4{ob[0], ob[1], ob[2], ob[3]};
    *reinterpret_cast<uint4*>(F + 1024 + l0 + 8) = uint4{ob[4], ob[5], ob[6], ob[7]};
    alt = wave_sum_fast(alt) + bf2f(sr[1024]);
    if (lane == 0) { const int b = row >> 10, ch = row & 1023; p.ycat[((size_t)b * L + 1024) * D + ch] = f2bf(alt); }
  }
}
__device__ void phase_ssm_pre(const Params& p, int bid, int nb, char* smem) {
  const int tid = threadIdx.x;
  dft_fold_rows(p, bid, nb, smem);
  for (int t = bid; t < 3072 + 384; t += nb) ssm_pre_tile(p, t, smem);
  for (int i = bid * NTHREADS + tid; i < (T + TC) * 32; i += nb * NTHREADS) {
    const bool isx = i < T * 32;
    const int ii = isx ? i : i - T * 32;
    const int t = ii >> 5, j = ii & 31;
    const float v = (isx ? p.dtraw : p.dtraw_c)[ii];
    float* df = isx ? p.dtf : p.dtf_c;
    float* db = isx ? p.dtb : p.dtb_c;
    if (j < 16) df[t * 16 + j] = softplus_f(v + p.dt_bias_f[j]);
    else db[t * 16 + (j - 16)] = softplus_f(v + p.dt_bias_b[j - 16]);
  }
}

__device__ __forceinline__ int swz16(int row, int chunk) { return row * 256 + ((chunk ^ (row & 15)) << 4); }
__device__ __forceinline__ int swz8(int row, int chunk) { return row * 128 + ((chunk ^ (row & 7)) << 4); }

#define LDS_BARRIER() asm volatile("s_waitcnt lgkmcnt(0)\n\ts_barrier" ::: "memory")
__device__ void ssd_task(const Params& p, int task, char* smem) {
  const int dir = task & 1, ph = (task >> 1) & 1, h = (task >> 2) & 15, b = task >> 6;
  const int tid = opaque_tid(), lane = tid & 63, w = tid >> 6;
  const int g = h >> 3, lr0 = lane & 15, lq0 = lane >> 4;
  const float a = -__expf(dir ? p.a_log_b[h] : p.a_log_f[h]);
  char* sCc = smem; char* sBc = smem + 16384; char* sBT = smem + 32768; char* sXT = smem + 49152; char* sHb = smem + 57344;
  float* se = reinterpret_cast<float*>(smem + 73728);
  float* sdt = se + 64; float* sw = se + 128; float* sy = se + 192; float* stot = se + 256;
  bf16_t* yo = reinterpret_cast<bf16_t*>(dir ? p.yb : p.yf);
  f32x4 H[2][2];
#pragma unroll
  for (int i = 0; i < 2; ++i)
#pragma unroll
    for (int j = 0; j < 2; ++j) H[i][j] = f32x4{0.f, 0.f, 0.f, 0.f};
  __syncthreads();
  for (int i = tid; i < 512; i += NTHREADS) reinterpret_cast<uint4*>(sHb)[i] = uint4{0, 0, 0, 0};

  const int crow = tid >> 4, cch = tid & 15;
  const int trow = tid >> 3, tch = tid & 7;
  uint4 rC0, rC1, rC2, rC3, rB0, rB1, rB2, rB3, rT0, rT1, rT2, rT3, rX;
  rC0 = rC1 = rC2 = rC3 = rB0 = rB1 = rB2 = rB3 = uint4{0, 0, 0, 0};
  float rdt = 0.f;
#define SSD_PARAMS(st_)                                                                                                   \
  const bool isctx_ = (st_) < 4;                                                                                          \
  const int nch_ = isctx_ ? 4 : 32, ci_ = isctx_ ? (st_) : (st_) - 4;                                                     \
  const int c_ = dir ? (nch_ - 1 - ci_) : ci_;                                                                            \
  const int seqlen_ = isctx_ ? CTX : L;                                                                                   \
  const size_t trow0_ = isctx_ ? ((size_t)T + (size_t)b * CTX + c_ * 64) : ((size_t)b * L + c_ * 64);                     \
  const size_t drow0_ = (size_t)b * seqlen_ + c_ * 64;                                                                    \
  const float* dtp_ = isctx_ ? (dir ? p.dtb_c : p.dtf_c) : (dir ? p.dtb : p.dtf);                                         \
  const bf16_t* cm_ = (isctx_ ? p.act_cm_c : p.act_cm_x) + (size_t)b * 1280 * seqlen_ + c_ * 64;
#define SSD_PREFETCH(st_)                                                                                                 \
  do {                                                                                                                    \
    SSD_PARAMS(st_)                                                                                                       \
    if (w == 0) rdt = dtp_[(drow0_ + lane) * 16 + h];                                                                     \
    if (!isctx_) {                                                                                                        \
      const bf16_t* src = p.act_tm + (trow0_ + crow) * DXBC + g * 128 + cch * 8;                                          \
      rC0 = *reinterpret_cast<const uint4*>(src + 1280);             rB0 = *reinterpret_cast<const uint4*>(src + 1024);   \
      rC1 = *reinterpret_cast<const uint4*>(src + 16 * DXBC + 1280); rB1 = *reinterpret_cast<const uint4*>(src + 16 * DXBC + 1024); \
      rC2 = *reinterpret_cast<const uint4*>(src + 32 * DXBC + 1280); rB2 = *reinterpret_cast<const uint4*>(src + 32 * DXBC + 1024); \
      rC3 = *reinterpret_cast<const uint4*>(src + 48 * DXBC + 1280); rB3 = *reinterpret_cast<const uint4*>(src + 48 * DXBC + 1024); \
    }                                                                                                                     \
    const bf16_t* srt = cm_ + (size_t)(1024 + g * 128 + trow) * seqlen_ + tch * 8;                                        \
    rT0 = *reinterpret_cast<const uint4*>(srt);                                                                           \
    rT1 = *reinterpret_cast<const uint4*>(srt + (size_t)32 * seqlen_);                                                    \
    rT2 = *reinterpret_cast<const uint4*>(srt + (size_t)64 * seqlen_);                                                    \
    rT3 = *reinterpret_cast<const uint4*>(srt + (size_t)96 * seqlen_);                                                    \
    rX = *reinterpret_cast<const uint4*>(cm_ + (size_t)(h * 64 + ph * 32 + trow) * seqlen_ + tch * 8);                    \
  } while (0)

  for (int step = 0; step < 36; ++step) {
    SSD_PREFETCH(step);
    const bool isctx = step < 4;
    const int c = dir ? ((isctx ? 4 : 32) - 1 - (isctx ? step : step - 4)) : (isctx ? step : step - 4);
    const size_t trow0 = (size_t)b * L + c * 64;
    int lr = lr0, lq = lq0;
    asm volatile("" : "+v"(lr), "+v"(lq));
    LDS_BARRIER();
    if (w == 0) {
      const float dtv = rdt;
      const float adt = a * dtv;
      float v = adt;
      v += __builtin_bit_cast(float, __builtin_amdgcn_update_dpp(0, __builtin_bit_cast(int, v), 0x111, 0xF, 0xF, false));
      v += __builtin_bit_cast(float, __builtin_amdgcn_update_dpp(0, __builtin_bit_cast(int, v), 0x112, 0xF, 0xF, false));
      v += __builtin_bit_cast(float, __builtin_amdgcn_update_dpp(0, __builtin_bit_cast(int, v), 0x114, 0xF, 0xF, false));
      v += __builtin_bit_cast(float, __builtin_amdgcn_update_dpp(0, __builtin_bit_cast(int, v), 0x118, 0xF, 0xF, false));
      v += __builtin_bit_cast(float, __builtin_amdgcn_update_dpp(0, __builtin_bit_cast(int, v), 0x142, 0xA, 0xF, false));
      v += __builtin_bit_cast(float, __builtin_amdgcn_update_dpp(0, __builtin_bit_cast(int, v), 0x143, 0xC, 0xF, false));
      const float etot = __builtin_bit_cast(float, __builtin_amdgcn_readlane(__builtin_bit_cast(int, v), 63));
      if (dir) v = etot - v + adt;
      se[lane] = v; sdt[lane] = dtv; sw[lane] = dtv * __expf(etot - v); sy[lane] = __expf(v);
      if (lane == 0) stot[0] = etot;
    }
    if (!isctx) {
      const int oc = swz16(crow, cch);
      *reinterpret_cast<uint4*>(sCc + oc) = rC0;         *reinterpret_cast<uint4*>(sBc + oc) = rB0;
      *reinterpret_cast<uint4*>(sCc + oc + 4096) = rC1;  *reinterpret_cast<uint4*>(sBc + oc + 4096) = rB1;
      *reinterpret_cast<uint4*>(sCc + oc + 8192) = rC2;  *reinterpret_cast<uint4*>(sBc + oc + 8192) = rB2;
      *reinterpret_cast<uint4*>(sCc + oc + 12288) = rC3; *reinterpret_cast<uint4*>(sBc + oc + 12288) = rB3;
    }
    {
      const int ot = swz8(trow, tch);
      *reinterpret_cast<uint4*>(sBT + ot) = rT0;
      *reinterpret_cast<uint4*>(sBT + ot + 4096) = rT1;
      *reinterpret_cast<uint4*>(sBT + ot + 8192) = rT2;
      *reinterpret_cast<uint4*>(sBT + ot + 12288) = rT3;
      *reinterpret_cast<uint4*>(sXT + ot) = rX;
    }
    LDS_BARRIER();
    const float etot = stot[0];
    if (!isctx) {
      f32x4 G[4];
      bf16x8 ca[4];
#pragma unroll
      for (int j = 0; j < 4; ++j) G[j] = f32x4{0.f, 0.f, 0.f, 0.f};
#pragma unroll
      for (int kk = 0; kk < 4; ++kk) ca[kk] = *reinterpret_cast<const bf16x8*>(sCc + swz16(16 * w + lr, kk * 4 + lq));
#pragma unroll
      for (int kk = 0; kk < 4; ++kk)
#pragma unroll
        for (int j = 0; j < 4; ++j) {
          bf16x8 bb = *reinterpret_cast<const bf16x8*>(sBc + swz16(16 * j + lr, kk * 4 + lq));
          G[j] = __builtin_amdgcn_mfma_f32_16x16x32_bf16(ca[kk], bb, G[j], 0, 0, 0);
        }
      LDS_BARRIER();
      float el[4];
#pragma unroll
      for (int r = 0; r < 4; ++r) el[r] = se[16 * w + lq * 4 + r];
#pragma unroll
      for (int j = 0; j < 4; ++j) {
        const int s_ = 16 * j + lr;
        const float es = se[s_], ds = sdt[s_];
#pragma unroll
        for (int r = 0; r < 4; ++r) {
          const int l = 16 * w + lq * 4 + r;
          const bool keep = dir ? (s_ >= l) : (s_ <= l);
          const float m = keep ? G[j][r] * __expf(el[r] - es) * ds : 0.f;
          *reinterpret_cast<bf16_t*>(sBc + swz8(l, s_ >> 3) + (s_ & 7) * 2) = f2bf(m);
        }
      }
      LDS_BARRIER();
      f32x4 Y[2], Yo[2];
#pragma unroll
      for (int j = 0; j < 2; ++j) { Y[j] = f32x4{0.f, 0.f, 0.f, 0.f}; Yo[j] = f32x4{0.f, 0.f, 0.f, 0.f}; }
#pragma unroll
      for (int kk = 0; kk < 2; ++kk) {
        bf16x8 ma = *reinterpret_cast<const bf16x8*>(sBc + swz8(16 * w + lr, kk * 4 + lq));
#pragma unroll
        for (int j = 0; j < 2; ++j) {
          bf16x8 xb = *reinterpret_cast<const bf16x8*>(sXT + swz8(16 * j + lr, kk * 4 + lq));
          Y[j] = __builtin_amdgcn_mfma_f32_16x16x32_bf16(ma, xb, Y[j], 0, 0, 0);
        }
      }
#pragma unroll
      for (int kk = 0; kk < 4; ++kk)
#pragma unroll
        for (int j = 0; j < 2; ++j) {
          bf16x8 hb = *reinterpret_cast<const bf16x8*>(sHb + swz16(16 * j + lr, kk * 4 + lq));
          Yo[j] = __builtin_amdgcn_mfma_f32_16x16x32_bf16(ca[kk], hb, Yo[j], 0, 0, 0);
        }
      float syl[4];
#pragma unroll
      for (int r = 0; r < 4; ++r) syl[r] = sy[16 * w + lq * 4 + r];
#pragma unroll
      for (int j = 0; j < 2; ++j)
#pragma unroll
        for (int r = 0; r < 4; ++r) {
          const int l = 16 * w + lq * 4 + r;
          yo[(trow0 + l) * 1024 + h * 64 + ph * 32 + 16 * j + lr] = f2bf(Y[j][r] + syl[r] * Yo[j][r]);
        }
    }
    {
      const float dec = __expf(etot);
#pragma unroll
      for (int i = 0; i < 2; ++i)
#pragma unroll
        for (int j = 0; j < 2; ++j) H[i][j] *= dec;
#pragma unroll
      for (int kk = 0; kk < 2; ++kk) {
        const int s0 = kk * 32 + lq * 8;
        const float4 w0 = *reinterpret_cast<const float4*>(sw + s0), w1 = *reinterpret_cast<const float4*>(sw + s0 + 4);
        bf16x8 xs[2];
#pragma unroll
        for (int i = 0; i < 2; ++i) {
          const bf16x8 xa = *reinterpret_cast<const bf16x8*>(sXT + swz8(16 * i + lr, kk * 4 + lq));
          xs[i][0] = (short)f2bf(bf2f((bf16_t)xa[0]) * w0.x); xs[i][1] = (short)f2bf(bf2f((bf16_t)xa[1]) * w0.y);
          xs[i][2] = (short)f2bf(bf2f((bf16_t)xa[2]) * w0.z); xs[i][3] = (short)f2bf(bf2f((bf16_t)xa[3]) * w0.w);
          xs[i][4] = (short)f2bf(bf2f((bf16_t)xa[4]) * w1.x); xs[i][5] = (short)f2bf(bf2f((bf16_t)xa[5]) * w1.y);
          xs[i][6] = (short)f2bf(bf2f((bf16_t)xa[6]) * w1.z); xs[i][7] = (short)f2bf(bf2f((bf16_t)xa[7]) * w1.w);
        }
#pragma unroll
        for (int j = 0; j < 2; ++j) {
          const bf16x8 bt = *reinterpret_cast<const bf16x8*>(sBT + swz8(16 * (2 * w + j) + lr, kk * 4 + lq));
#pragma unroll
          for (int i = 0; i < 2; ++i) H[i][j] = __builtin_amdgcn_mfma_f32_16x16x32_bf16(xs[i], bt, H[i][j], 0, 0, 0);
        }
      }
    }
    LDS_BARRIER();
#pragma unroll
    for (int i = 0; i < 2; ++i)
#pragma unroll
      for (int j = 0; j < 2; ++j) {
        const int n = 16 * (2 * w + j) + lr;
#pragma unroll
        for (int r = 0; r < 4; ++r) {
          const int pr = 16 * i + lq * 4 + r;
          *reinterpret_cast<bf16_t*>(sHb + swz16(pr, n >> 3) + (n & 7) * 2) = f2bf(H[i][j][r]);
        }
      }
  }
#undef SSD_PREFETCH
#undef SSD_PARAMS
}

#undef LDS_BARRIER
__device__ void phase_ssd_dft(const Params& p, int bid, int nb, char* smem) {
  for (int t = bid; t < 256; t += nb) ssd_task(p, t, smem);
  int* stile = reinterpret_cast<int*>(smem + 75776);
  for (;;) {
    __syncthreads();
    if (threadIdx.x == 0) *stile = (int)atomicAdd(p.ctr, 1u);
    __syncthreads();
    const int t = *stile;
    if (t >= 4 * 8 * 8) break;
    const int b = t >> 6, tm = (t & 63) >> 3, tn = t & 7;
    const bf16_t* Fb = p.Fs + (size_t)b * 1024 * 2048;
    f32x4 accC[4][4], accS[4][4];
    gemm_mainloop(p.dftm, 2048, Fb, 2048, 1024, tm * 128, tn * 128, accC, smem);
    gemm_mainloop(p.dftm + 1024, 2048, Fb + 1024, 2048, 1024, tm * 128, tn * 128, accS, smem);
    const int lane = threadIdx.x & 63, w = threadIdx.x >> 6, wm = w >> 1, wn = w & 1;
#pragma unroll
    for (int i = 0; i < 4; ++i) {
      int lq_ = lane >> 4, lr_ = lane & 15;
      asm volatile("" : "+v"(lq_), "+v"(lr_));
#pragma unroll
      for (int j = 0; j < 4; ++j) {
        const int k0 = tm * 128 + wm * 64 + i * 16 + lq_ * 4;
        const int ch = tn * 128 + wn * 64 + j * 16 + lr_;
        const float a = bf2f(p.ABt[((size_t)b * 1024 + ch) * 4096 + 1024]);
#pragma unroll
        for (int r = 0; r < 4; ++r) {
          const int k = k0 + r;
          const float as = (k & 1) ? -a : a;
          const float c = accC[i][j][r], sn = accS[i][j][r];
          p.ycat[((size_t)b * L + k) * D + ch] = f2bf(c - sn + as);
          if (k > 0) p.ycat[((size_t)b * L + (L - k)) * D + ch] = f2bf(c + sn + as);
        }
      }
    }
  }
  for (;;) {
    __syncthreads();
    if (threadIdx.x == 0) *stile = (int)atomicAdd(p.ctr + 8, 1u);
    __syncthreads();
    const int q = *stile;
    if (q >= 1024 + 1536) break;
    if (q < 512) convert_u_rows(p, q);
    else if (q < 1024) convert_v_units(p, (size_t)(q - 512) * 4096, (size_t)(q - 511) * 4096);
    else if (q < 1024 + 1024) { const int q1 = q - 1024; transpose_convert_task(p.w_out, D, 0, D, p.w_out_t, q1 / 32, q1 % 32, reinterpret_cast<float*>(smem)); }
    else { const int q2 = q - 2048; transpose_convert_task(p.w_query, 1024, 0, D, p.w_q_t, q2 / 16, q2 % 16, reinterpret_cast<float*>(smem)); }
  }
}

__device__ void phase_ssm_post(const Params& p, int bid, int nb, char* smem) {
  const int lane = threadIdx.x & 63, w = threadIdx.x >> 6;
  for (int t = bid * 4 + w; t < T; t += nb * 4) {
    float y[4][4];
    float ss0 = 0.f, ss1 = 0.f;
#pragma unroll
    for (int c = 0; c < 4; ++c) {
      const int c0 = c * 256 + lane * 4;
      const int h = c0 >> 6;
      const float dsk = p.d_skip_f[h] + p.d_skip_b[h];
      const uint2 aq = *reinterpret_cast<const uint2*>(reinterpret_cast<const bf16_t*>(p.yf) + (size_t)t * 1024 + c0);
      const uint2 bb = *reinterpret_cast<const uint2*>(reinterpret_cast<const bf16_t*>(p.yb) + (size_t)t * 1024 + c0);
      const float4 a = float4{bflo(aq.x), bfhi(aq.x), bflo(aq.y), bfhi(aq.y)};
      const float4 bq = float4{bflo(bb.x), bfhi(bb.x), bflo(bb.y), bfhi(bb.y)};
      const uint2 xq = *reinterpret_cast<const uint2*>(p.act_tm + (size_t)t * DXBC + c0);
      const uint2 zz = *reinterpret_cast<const uint2*>(p.z + (size_t)t * 1024 + c0);
      y[c][0] = (a.x + bq.x + dsk * bflo(xq.x)) * silu_f(bflo(zz.x));
      y[c][1] = (a.y + bq.y + dsk * bfhi(xq.x)) * silu_f(bfhi(zz.x));
      y[c][2] = (a.z + bq.z + dsk * bflo(xq.y)) * silu_f(bflo(zz.y));
      y[c][3] = (a.w + bq.w + dsk * bfhi(xq.y)) * silu_f(bfhi(zz.y));
      const float q = y[c][0] * y[c][0] + y[c][1] * y[c][1] + y[c][2] * y[c][2] + y[c][3] * y[c][3];
      if (c < 2) ss0 += q; else ss1 += q;
    }
    ss0 = wave_sum_fast(ss0); ss1 = wave_sum_fast(ss1);
    const float r0 = rsqrtf(ss0 * (1.f / 512.f) + EPS), r1 = rsqrtf(ss1 * (1.f / 512.f) + EPS);
    uint2 fq[4];
    float am = 0.f;
#pragma unroll
    for (int c = 0; c < 4; ++c) {
      const int c0 = c * 256 + lane * 4;
      fq[c] = *reinterpret_cast<const uint2*>(p.ycat + (size_t)t * D + c0);
      am = fmaxf(am, fmaxf(fmaxf(fabsf(bflo(fq[c].x)), fabsf(bfhi(fq[c].x))), fmaxf(fabsf(bflo(fq[c].y)), fabsf(bfhi(fq[c].y)))));
      const float rstd = (c < 2) ? r0 : r1;
      const float4 nw = *reinterpret_cast<const float4*>(p.ssm_norm_w + c0);
      y[c][0] *= rstd * nw.x; y[c][1] *= rstd * nw.y; y[c][2] *= rstd * nw.z; y[c][3] *= rstd * nw.w;
      am = fmaxf(am, fmaxf(fmaxf(fabsf(y[c][0]), fabsf(y[c][1])), fmaxf(fabsf(y[c][2]), fabsf(y[c][3]))));
    }
    am = wave_max_fast(am);
    const float inv = (am > 0.f) ? 127.f / am : 0.f;
#pragma unroll
    for (int c = 0; c < 4; ++c) {
      const int c0 = c * 256 + lane * 4;
      *reinterpret_cast<uint32_t*>(p.ycat8 + (size_t)t * D + c0) =
          pack_i8x4(bflo(fq[c].x) * inv, bfhi(fq[c].x) * inv, bflo(fq[c].y) * inv, bfhi(fq[c].y) * inv);
      *reinterpret_cast<uint32_t*>(p.ycat8 + (size_t)t * D + 1024 + c0) = pack_i8x4(y[c][0] * inv, y[c][1] * inv, y[c][2] * inv, y[c][3] * inv);
    }
    if (lane == 0) p.yscale[t] = am * (1.f / 127.f);
  }
  quant_weight_rows_i8(p.w_out_t, p.wo8, p.woscale, D, bid, nb);
}

__device__ void phase_outproj(const Params& p, int bid, int nb, char* smem) {
  const bool aware = (nb & 7) == 0;
  const int start = aware ? (bid >> 3) : bid, step = aware ? (nb >> 3) : nb, end = aware ? 64 : 512;
  const bf16_t* a8 = reinterpret_cast<const bf16_t*>(p.ycat8);
  const bf16_t* b8 = reinterpret_cast<const bf16_t*>(p.wo8);
  for (int it = start; it < end; it += step) {
    const int x = aware ? (bid & 7) : (it >> 6), s_ = aware ? it : (it & 63);
    EpiBf16 epi{reinterpret_cast<bf16_t*>(p.y_x), D};
    gemm_tile_n256<true>(a8, D / 2, b8, D / 2, D / 2, (8 * x + (s_ & 7)) * 128, (s_ >> 3) * 256, epi, smem, p.yscale, p.woscale);
  }
}
__device__ void phase_postmix(const Params& p, int bid, int nb, char* smem) {
  const int lane = threadIdx.x & 63, w = threadIdx.x >> 6;
  for (int t = bid * 4 + w; t < T; t += nb * 4) {
    const int b = t / L;
    float4 y[8];
    float ss = 0.f;
#pragma unroll
    for (int c = 0; c < 8; ++c) {
      {
        const uint2 yq = *reinterpret_cast<const uint2*>(reinterpret_cast<const bf16_t*>(p.y_x) + (size_t)t * D + c * 256 + lane * 4);
        y[c] = float4{bflo(yq.x), bfhi(yq.x), bflo(yq.y), bfhi(yq.y)};
      }
      ss += y[c].x * y[c].x + y[c].y * y[c].y + y[c].z * y[c].z + y[c].w * y[c].w;
    }
    ss = wave_sum_fast(ss);
    const float rstd = rsqrtf(ss * (1.f / D) + EPS);
    const float* gm = p.mod + (size_t)b * NMOD + 2 * D;
    float ss1 = 0.f;
#pragma unroll
    for (int c = 0; c < 8; ++c) {
      const int e0 = c * 256 + lane * 4;
      const float4 xv = *reinterpret_cast<const float4*>(p.x + (size_t)t * D + e0);
      const float4 g4 = *reinterpret_cast<const float4*>(gm + e0), gp = *reinterpret_cast<const float4*>(p.g_post_mix + e0);
      y[c].x = xv.x + g4.x * (y[c].x * rstd * gp.x); y[c].y = xv.y + g4.y * (y[c].y * rstd * gp.y);
      y[c].z = xv.z + g4.z * (y[c].z * rstd * gp.z); y[c].w = xv.w + g4.w * (y[c].w * rstd * gp.w);
      ss1 += y[c].x * y[c].x + y[c].y * y[c].y + y[c].z * y[c].z + y[c].w * y[c].w;
    }
    if (lane == 0) p.partial[t] = rstd;
    ss1 = wave_sum_fast(ss1);
    const float rstd1 = rsqrtf(ss1 * (1.f / D) + EPS);
    const float* sf = p.mod + (size_t)b * NMOD + 3 * D;
    const float* cf = p.mod + (size_t)b * NMOD + 4 * D;
    float am = 0.f;
#pragma unroll
    for (int c = 0; c < 8; ++c) {
      const int e0 = c * 256 + lane * 4;
      const float4 g = *reinterpret_cast<const float4*>(p.g_pre_ffn + e0);
      const float4 s4 = *reinterpret_cast<const float4*>(cf + e0), h4 = *reinterpret_cast<const float4*>(sf + e0);
      y[c].x = y[c].x * rstd1 * g.x * (1.f + s4.x) + h4.x; y[c].y = y[c].y * rstd1 * g.y * (1.f + s4.y) + h4.y;
      y[c].z = y[c].z * rstd1 * g.z * (1.f + s4.z) + h4.z; y[c].w = y[c].w * rstd1 * g.w * (1.f + s4.w) + h4.w;
      am = fmaxf(am, fmaxf(fmaxf(fabsf(y[c].x), fabsf(y[c].y)), fmaxf(fabsf(y[c].z), fabsf(y[c].w))));
      uint2 pk;
      pk.x = pack2(y[c].x, y[c].y);
      pk.y = pack2(y[c].z, y[c].w);
      *reinterpret_cast<uint2*>(p.hx + (size_t)t * D + e0) = pk;
    }
    am = wave_max_fast(am);
    const float inv = (am > 0.f) ? 127.f / am : 0.f;
#pragma unroll
    for (int c = 0; c < 8; ++c)
      *reinterpret_cast<uint32_t*>(p.hx8a + (size_t)t * D + c * 256 + lane * 4) = pack_i8x4(y[c].x * inv, y[c].y * inv, y[c].z * inv, y[c].w * inv);
    if (lane == 0) p.ascale[t] = am * (1.f / 127.f);
  }
}

__device__ __forceinline__ uint32_t mono_key(float f) {
  uint32_t u = __float_as_uint(f);
  return (u & 0x80000000u) ? ~u : (u | 0x80000000u);
}
__device__ __forceinline__ void ins16(uint32_t (&Lk)[16], uint32_t x) {
#pragma unroll
  for (int i = 0; i < 16; ++i) { uint32_t hi = max(Lk[i], x); x = min(Lk[i], x); Lk[i] = hi; }
}
__device__ __forceinline__ float unmono_key(uint32_t k) {
  return __uint_as_float((k & 0x80000000u) ? (k ^ 0x80000000u) : ~k);
}
typedef __attribute__((ext_vector_type(16))) float f32x16;
__device__ void phase_q_route(const Params& p, int bid, int nb, char* smem) {
  const int tid = opaque_tid(), lane = tid & 63, w = tid >> 6;
  const int wm = w >> 1, wn = w & 1, lr = lane & 15, lq = lane >> 4;
  const int l31 = lane & 31, lh = lane >> 5;
  for (int tile0 = bid; tile0 < 512; tile0 += nb) {
    const int tile = ((nb & 7) == 0 && nb >= 512) ? (((tile0 & 7) * 8 + ((tile0 >> 3) & 7)) * 8 + (tile0 >> 6)) : tile0;
    const int h = tile & 7, m0 = (tile >> 3) * 128;
    {
      f32x4 acc[4][4];
      gemm_mainloop(p.hx, D, p.w_q_t, D, D, m0, h * 128, acc, smem);
#pragma unroll
      for (int i = 0; i < 4; ++i)
#pragma unroll
        for (int j = 0; j < 4; ++j)
#pragma unroll
          for (int r = 0; r < 4; ++r) {
            const int row = wm * 64 + i * 16 + lq * 4 + r, col = wn * 64 + j * 16 + lr;
            *reinterpret_cast<bf16_t*>(smem + swz16(row, col >> 3) + (col & 7) * 2) = f2bf(acc[i][j][r]);
          }
    }
#pragma unroll 4
    for (int r = 0; r < 16; ++r) {
      const int id = tid + 256 * r, row = id >> 4, c4 = id & 15;
      const float* src = ((row < 128) ? p.sk1 : p.sk2) + ((size_t)(h * 128 + (row & 127)) * 64 + c4 * 4);
      const float4 v = *reinterpret_cast<const float4*>(src);
      uint2 pk; pk.x = pack2(v.x, v.y); pk.y = pack2(v.z, v.w);
      *reinterpret_cast<uint2*>(smem + 32768 + swz8(row, c4 >> 1) + (c4 & 1) * 8) = pk;
    }
    __syncthreads();
    uint32_t L1[16], L2[16];
#pragma unroll
    for (int sd = 0; sd < 2; ++sd) {
      uint32_t Lk[16];
#pragma unroll
      for (int i = 0; i < 16; ++i) Lk[i] = 0u;
      const uint32_t kb = (uint32_t)(lh * 4);
#pragma unroll
      for (int ih = 0; ih < 2; ++ih) {
        f32x16 Sa[2];
#pragma unroll
        for (int i = 0; i < 2; ++i)
#pragma unroll
          for (int g2 = 0; g2 < 16; ++g2) Sa[i][g2] = 0.f;
#pragma unroll
        for (int ks = 0; ks < 4; ++ks) {
          const bf16x8 qb = *reinterpret_cast<const bf16x8*>(smem + swz16(w * 32 + l31, sd * 8 + ks * 2 + lh));
#pragma unroll
          for (int i = 0; i < 2; ++i) {
            const bf16x8 ka = *reinterpret_cast<const bf16x8*>(smem + 32768 + swz8(sd * 128 + (ih * 2 + i) * 32 + l31, ks * 2 + lh));
            Sa[i] = __builtin_amdgcn_mfma_f32_32x32x16_bf16(ka, qb, Sa[i], 0, 0, 0);
          }
        }
#pragma unroll
        for (int i = 0; i < 2; ++i)
#pragma unroll
          for (int g2 = 0; g2 < 16; ++g2)
            ins16(Lk, (mono_key(Sa[i][g2]) & ~0x7Fu) | (uint32_t)((ih * 2 + i) * 32 + (g2 & 3) + 8 * (g2 >> 2)) | kb);
      }
#pragma unroll
      for (int i = 0; i < 8; ++i) {
        const uint32_t t1 = (uint32_t)__shfl_xor((int)Lk[15 - i], 32), t2 = (uint32_t)__shfl_xor((int)Lk[i], 32);
        Lk[i] = max(Lk[i], t1); Lk[15 - i] = max(Lk[15 - i], t2);
      }
#pragma unroll
      for (int dd = 8; dd >= 1; dd >>= 1)
#pragma unroll
        for (int i = 0; i < 16; ++i)
          if ((i & dd) == 0) { const uint32_t hi = max(Lk[i], Lk[i + dd]), lo = min(Lk[i], Lk[i + dd]); Lk[i] = hi; Lk[i + dd] = lo; }
#pragma unroll
      for (int r = 0; r < 16; ++r) { if (sd == 0) L1[r] = Lk[r]; else L2[r] = Lk[r]; }
    }
    __syncthreads();
    uint32_t* ib = reinterpret_cast<uint32_t*>(smem) + w * 1088 + l31 * 34;
    if (lh == 0) {
#pragma unroll
      for (int r = 0; r < 16; ++r) { ib[r] = L1[r] & 127u; ib[16 + r] = L2[r] & 127u; }
    }
    float v1[16], v2[16];
#pragma unroll
    for (int r = 0; r < 16; ++r) { v1[r] = unmono_key(L1[r] & ~0x7Fu); v2[r] = unmono_key(L2[r] & ~0x7Fu); }
    uint32_t C[16];
#pragma unroll
    for (int i = 0; i < 16; ++i) C[i] = 0u;
#pragma unroll
    for (int a = 0; a < 16; ++a)
#pragma unroll
      for (int bq = 0; bq < 16; ++bq)
        if ((a + 1) * (bq + 1) <= 16) ins16(C, (mono_key(v1[a] + v2[bq]) & ~0xFFu) | (uint32_t)(a * 16 + bq));
    float ts[16]; int te[16];
    __builtin_amdgcn_wave_barrier();
#pragma unroll
    for (int r = 0; r < 16; ++r) {
      const uint32_t code = C[r] & 0xFFu;
      te[r] = (int)(ib[code >> 4] * 128u + ib[16 + (code & 15u)]);
      ts[r] = unmono_key(C[r] & ~0xFFu);
    }
    const float mx = ts[0];
    float den = 0.f;
#pragma unroll
    for (int r = 0; r < 16; ++r) { ts[r] = __expf(ts[r] - mx); den += ts[r]; }
    const float inv = 1.f / den;
    const size_t ob = (size_t)(m0 + w * 32 + l31) * 128 + h * 16;
    if (lh == 0) {
#pragma unroll
      for (int r = 0; r < 16; r += 4) *reinterpret_cast<int4*>(p.idx + ob + r) = int4{te[r], te[r + 1], te[r + 2], te[r + 3]};
    } else {
#pragma unroll
      for (int r = 0; r < 16; r += 4)
        *reinterpret_cast<float4*>(p.gate + ob + r) = float4{ts[r] * inv, ts[r + 1] * inv, ts[r + 2] * inv, ts[r + 3] * inv};
    }
    __syncthreads();
  }
}

typedef __attribute__((ext_vector_type(2))) float f32x2;
__device__ __forceinline__ void fp8x16_to_f32(const uint4 q, f32x2 (&o)[8]) {
  o[0] = __builtin_amdgcn_cvt_pk_f32_fp8((int)q.x, false); o[1] = __builtin_amdgcn_cvt_pk_f32_fp8((int)q.x, true);
  o[2] = __builtin_amdgcn_cvt_pk_f32_fp8((int)q.y, false); o[3] = __builtin_amdgcn_cvt_pk_f32_fp8((int)q.y, true);
  o[4] = __builtin_amdgcn_cvt_pk_f32_fp8((int)q.z, false); o[5] = __builtin_amdgcn_cvt_pk_f32_fp8((int)q.z, true);
  o[6] = __builtin_amdgcn_cvt_pk_f32_fp8((int)q.w, false); o[7] = __builtin_amdgcn_cvt_pk_f32_fp8((int)q.w, true);
}
__device__ __forceinline__ unsigned my_xcc_id() { return (unsigned)__builtin_amdgcn_s_getreg((3 << 11) | 20) & 7u; }

__device__ void phase_exp_u(const Params& p, char* smem) {
  const int tid = opaque_tid(), lane = tid & 63, w = tid >> 6;
  const int sub = lane >> 4, cc = lane & 15;
  const unsigned myx = my_xcc_id();
  int* sh = reinterpret_cast<int*>(smem);
  int* si = reinterpret_cast<int*>(smem + 64) + w * 256;
  float* pbuf = reinterpret_cast<float*>(p.ycat);
  {
    unsigned qcur = 0;
    for (;;) {
      __syncthreads();
      if (tid == 0) {
        int found = -1; unsigned fx = 0;
        for (; qcur < 8; ++qcur) {
          fx = (myx + qcur) & 7u;
          const int c = (int)atomicAdd(&p.ctr[16 + fx], 1u);
          if (c < 256) { found = c; break; }
        }
        sh[0] = found; sh[1] = (int)fx;
      }
      __syncthreads();
      const int chunk = sh[0];
      const unsigned x = (unsigned)sh[1];
      if (chunk < 0) break;
      for (int tt = 0; tt < 8; ++tt) {
        const int t = chunk * 32 + w * 8 + tt;
        __builtin_amdgcn_wave_barrier();
        si[lane] = p.idx[(size_t)t * 128 + lane]; si[64 + lane] = p.idx[(size_t)t * 128 + 64 + lane];
        __builtin_amdgcn_wave_barrier();
        const uint4 hq = *reinterpret_cast<const uint4*>(p.hx8a + (size_t)t * D + x * 256 + cc * 16);
        const uint8_t* ub = p.U8 + (size_t)x * ((size_t)16384 * 256) + cc * 16;
        uint4 qa[8], qb[8];
#define EU_LOAD(q_, bt_) _Pragma("unroll") for (int k = 0; k < 8; ++k) q_[k] = *reinterpret_cast<const uint4*>(ub + (size_t)si[((bt_) * 8 + k) * 4 + sub] * 256)
#define EU_COMP(q_, kb_)                                                                                                \
  _Pragma("unroll") for (int k = 0; k < 8; ++k) {                                                                       \
    int d = __builtin_amdgcn_sdot4((int)q_[k].x, (int)hq.x, 0, false);                                                  \
    int d1 = __builtin_amdgcn_sdot4((int)q_[k].y, (int)hq.y, 0, false);                                                 \
    d = __builtin_amdgcn_sdot4((int)q_[k].z, (int)hq.z, d, false);                                                      \
    d1 = __builtin_amdgcn_sdot4((int)q_[k].w, (int)hq.w, d1, false);                                                    \
    d += d1;                                                                                                            \
    d += dpp_movi<0xB1>(d); d += dpp_movi<0x4E>(d); d += dpp_movi<0x124>(d); d += dpp_movi<0x128>(d);                   \
    mine = (cc == (kb_) + k) ? d : mine;                                                                                \
  }
        int mine = 0;
        EU_LOAD(qa, 0); EU_LOAD(qb, 1);
        EU_COMP(qa, 0); EU_LOAD(qa, 2);
        EU_COMP(qb, 8); EU_LOAD(qb, 3);
        pbuf[((size_t)x * T + t) * 128 + cc * 4 + sub] = (float)mine;
        mine = 0;
        EU_COMP(qa, 0);
        EU_COMP(qb, 8);
        pbuf[((size_t)x * T + t) * 128 + (16 + cc) * 4 + sub] = (float)mine;
#undef EU_LOAD
#undef EU_COMP
      }
    }
  }
}

__device__ void phase_exp_v(const Params& p, char* smem) {
  const int tid = opaque_tid(), lane = tid & 63, w = tid >> 6;
  const int sub = lane >> 4, cc = lane & 15;
  const unsigned myx = my_xcc_id();
  int* sh = reinterpret_cast<int*>(smem);
  int* si = reinterpret_cast<int*>(smem + 64) + w * 256;
  float* sc = reinterpret_cast<float*>(si + 128);
  bf16_t* yfb = reinterpret_cast<bf16_t*>(p.y_x) + (size_t)T * D;
  {
    unsigned qcur = 0;
    for (;;) {
      __syncthreads();
      if (tid == 0) {
        int found = -1; unsigned fx = 0;
        for (; qcur < 8; ++qcur) {
          fx = (myx + qcur) & 7u;
          const int c = (int)atomicAdd(&p.ctr[32 + fx], 1u);
          if (c < 256) { found = c; break; }
        }
        sh[0] = found; sh[1] = (int)fx;
      }
      __syncthreads();
      const int chunk = sh[0];
      const unsigned x = (unsigned)sh[1];
      if (chunk < 0) break;
      int e0n = p.idx[(size_t)(chunk * 32 + w * 8) * 128 + lane], e1n = p.idx[(size_t)(chunk * 32 + w * 8) * 128 + 64 + lane];
      for (int tt = 0; tt < 8; ++tt) {
        const int t = chunk * 32 + w * 8 + tt;
        const int e0 = e0n, e1 = e1n;
        __builtin_amdgcn_wave_barrier();
        si[lane] = e0; si[64 + lane] = e1;
        __builtin_amdgcn_wave_barrier();
        f32x2 acc[8];
#pragma unroll
        for (int e = 0; e < 8; ++e) acc[e] = f32x2{0.f, 0.f};
        const uint8_t* vb = p.V8 + (size_t)x * ((size_t)16384 * 256) + cc * 16;
        uint4 qa[8], qb[8];
#define EV_LOAD(q_, bt_) _Pragma("unroll") for (int k = 0; k < 8; ++k) q_[k] = *reinterpret_cast<const uint4*>(vb + (size_t)si[((bt_) * 8 + k) * 4 + sub] * 256)
#define EV_COMP(q_, bt_)                                                                                                \
  _Pragma("unroll") for (int k = 0; k < 8; ++k) {                                                                       \
    f32x2 vf[8];                                                                                                        \
    fp8x16_to_f32(q_[k], vf);                                                                                           \
    const float cfk = sc[((bt_) * 8 + k) * 4 + sub];                                                                    \
    const f32x2 c2 = f32x2{cfk, cfk};                                                                                   \
    _Pragma("unroll") for (int e = 0; e < 8; ++e) acc[e] += c2 * vf[e];                                                 \
  }
        EV_LOAD(qa, 0); EV_LOAD(qb, 1);
        if (tt + 1 < 8) { e0n = p.idx[(size_t)(t + 1) * 128 + lane]; e1n = p.idx[(size_t)(t + 1) * 128 + 64 + lane]; }
        {
          const float* pb = reinterpret_cast<const float*>(p.ycat) + (size_t)t * 128;
          float d0 = 0.f, d1 = 0.f;
#pragma unroll
          for (int xs = 0; xs < 8; ++xs) { d0 += pb[(size_t)xs * T * 128 + lane]; d1 += pb[(size_t)xs * T * 128 + 64 + lane]; }
          const float hs = p.ascale[t];
          d0 *= p.uscale[e0] * hs; d1 *= p.uscale[e1] * hs;
          sc[lane] = p.gate[(size_t)t * 128 + lane] * 0.5f * d0 * (1.f + erff(d0 * 0.70710678118654752f));
          sc[64 + lane] = p.gate[(size_t)t * 128 + 64 + lane] * 0.5f * d1 * (1.f + erff(d1 * 0.70710678118654752f));
        }
        __builtin_amdgcn_wave_barrier();
        EV_COMP(qa, 0); EV_LOAD(qa, 2);
        EV_COMP(qb, 1); EV_LOAD(qb, 3);
        EV_COMP(qa, 2);
        EV_COMP(qb, 3);
#undef EV_LOAD
#undef EV_COMP
        {
          float* red = reinterpret_cast<float*>(smem + 8192) + w * 1280;
          float* mr = red + (sub * 16 + cc) * 20;
#pragma unroll
          for (int q4 = 0; q4 < 4; ++q4)
            *reinterpret_cast<float4*>(mr + q4 * 4) = float4{acc[q4 * 2].x, acc[q4 * 2].y, acc[q4 * 2 + 1].x, acc[q4 * 2 + 1].y};
          __builtin_amdgcn_wave_barrier();
          const int part = sub;
          float4 r0 = *reinterpret_cast<const float4*>(red + (0 * 16 + cc) * 20 + part * 4);
          float4 r1 = *reinterpret_cast<const float4*>(red + (1 * 16 + cc) * 20 + part * 4);
          float4 r2 = *reinterpret_cast<const float4*>(red + (2 * 16 + cc) * 20 + part * 4);
          float4 r3 = *reinterpret_cast<const float4*>(red + (3 * 16 + cc) * 20 + part * 4);
          const float sc512 = 1.f / 512.f;
          uint2 o4;
          o4.x = pack2((r0.x + r1.x + r2.x + r3.x) * sc512, (r0.y + r1.y + r2.y + r3.y) * sc512);
          o4.y = pack2((r0.z + r1.z + r2.z + r3.z) * sc512, (r0.w + r1.w + r2.w + r3.w) * sc512);
          *reinterpret_cast<uint2*>(yfb + (size_t)t * D + x * 256 + cc * 16 + part * 4) = o4;
          __builtin_amdgcn_wave_barrier();
        }
      }
    }
  }
}

__device__ void phase_exp_final(const Params& p, int bid, int nb, char* smem) {
  const int lane = threadIdx.x & 63, w = threadIdx.x >> 6;
  const bf16_t* ymix = reinterpret_cast<const bf16_t*>(p.y_x);
  const bf16_t* yf = reinterpret_cast<const bf16_t*>(p.y_x) + (size_t)T * D;
  for (int t = bid * 4 + w; t < T; t += nb * 4) {
    const int b = t / L;
    float4 y[8], xo[8];
#pragma unroll
    for (int c = 0; c < 8; ++c) {
      const uint2 yq = *reinterpret_cast<const uint2*>(yf + (size_t)t * D + c * 256 + lane * 4);
      y[c] = float4{bflo(yq.x), bfhi(yq.x), bflo(yq.y), bfhi(yq.y)};
      xo[c] = *reinterpret_cast<const float4*>(p.x + (size_t)t * D + c * 256 + lane * 4);
    }
    const float rmix = p.partial[t];
    float ss = 0.f;
#pragma unroll
    for (int c = 0; c < 8; ++c) ss += y[c].x * y[c].x + y[c].y * y[c].y + y[c].z * y[c].z + y[c].w * y[c].w;
    ss = wave_sum_fast(ss);
    const float rstd = rsqrtf(ss * (1.f / D) + EPS);
    const float* gfx = p.mod + (size_t)b * NMOD + 5 * D;
    const float* gm = p.mod + (size_t)b * NMOD + 2 * D;
#pragma unroll
    for (int c = 0; c < 8; ++c) {
      const int e0 = c * 256 + lane * 4;
      const uint2 mq = *reinterpret_cast<const uint2*>(ymix + (size_t)t * D + e0);
      const float4 m4 = float4{bflo(mq.x), bfhi(mq.x), bflo(mq.y), bfhi(mq.y)};
      const float4 g4 = *reinterpret_cast<const float4*>(gfx + e0), gp = *reinterpret_cast<const float4*>(p.g_post_ffn + e0);
      const float4 h4 = *reinterpret_cast<const float4*>(gm + e0), hp = *reinterpret_cast<const float4*>(p.g_post_mix + e0);
      xo[c].x += h4.x * (m4.x * rmix * hp.x) + g4.x * (y[c].x * rstd * gp.x);
      xo[c].y += h4.y * (m4.y * rmix * hp.y) + g4.y * (y[c].y * rstd * gp.y);
      xo[c].z += h4.z * (m4.z * rmix * hp.z) + g4.z * (y[c].z * rstd * gp.z);
      xo[c].w += h4.w * (m4.w * rmix * hp.w) + g4.w * (y[c].w * rstd * gp.w);
      *reinterpret_cast<float4*>(p.out + (size_t)t * D + e0) = xo[c];
    }
  }
}

#define XB_TMO      128
#define XB_XCNT(j)  (256  + 64 * (j))
#define XB_XSUB(j)  (1280 + 64 * (j))
#define XB_XGEN(j)  (2304 + 64 * (j))
#define XB_TOP      3328
#define XB_TOPGEN   3392
#define XCD_BAR_WORDS 3456
#define XB_SPIN_CAP (1u << 22)
#define LAS __attribute__((address_space(3)))
__device__ __forceinline__ unsigned xb_ld(unsigned* p)              { return __hip_atomic_load(p, __ATOMIC_RELAXED, __HIP_MEMORY_SCOPE_AGENT); }
__device__ __forceinline__ unsigned xb_add(unsigned* p, unsigned v) { return __hip_atomic_fetch_add(p, v, __ATOMIC_RELAXED, __HIP_MEMORY_SCOPE_AGENT); }
__device__ __forceinline__ unsigned xb_xcc_id() { return (unsigned)__builtin_amdgcn_s_getreg((3 << 11) | 20) & 0xFu; }
#define XB_SPIN(cond, bar) do { unsigned _sp = 0; while (cond) { __builtin_amdgcn_s_sleep(1); \
    if ((++_sp & 255u) == 0u) { if (xb_ld(&(bar)[XB_TMO])) break; if (_sp > XB_SPIN_CAP) { atomicAdd(&(bar)[XB_TMO], 1u); break; } } } } while (0)
struct XcdBarrier { unsigned* bar; unsigned x; volatile LAS unsigned* st; };
__device__ __forceinline__ XcdBarrier xcd_barrier_post(unsigned* bar, volatile LAS unsigned* st) {
  XcdBarrier b; b.bar = bar; b.x = xb_xcc_id(); b.st = st;
  if (threadIdx.x == 0) (void)xb_add(&bar[XB_XCNT(b.x)], 1u);
  return b;
}
__device__ __forceinline__ void xcd_barrier_complete(unsigned* bar, unsigned x, unsigned& nloc, unsigned& nx) {
  const unsigned G = gridDim.x * gridDim.y * gridDim.z;
  unsigned sum, cnt, mine, sp = 0u;
  for (;;) {
    sum = 0u; cnt = 0u; mine = 0u;
#pragma unroll
    for (unsigned j = 0; j < 16; ++j) { const unsigned c = xb_ld(&bar[XB_XCNT(j)]); sum += c; cnt += (c > 0u) ? 1u : 0u; mine = (j == x) ? c : mine; }
    if (sum == G) break;
    __builtin_amdgcn_s_sleep(1);
    if ((++sp & 255u) == 0u) { if (xb_ld(&bar[XB_TMO])) break; if (sp > XB_SPIN_CAP) { atomicAdd(&bar[XB_TMO], 1u); break; } }
  }
  nloc = mine > 0u ? mine : 1u; nx = cnt > 0u ? cnt : 1u;
}
__device__ __forceinline__ void xcd_barrier(const XcdBarrier& b) {
  asm volatile("s_waitcnt vmcnt(0)" ::: "memory");
  __syncthreads();
  if (threadIdx.x == 0) {
    unsigned* bar = b.bar;
    __builtin_amdgcn_s_waitcnt(0);
    unsigned nloc = b.st[0], nx = b.st[1];
    if (nloc == 0u) { xcd_barrier_complete(bar, b.x, nloc, nx); b.st[0] = nloc; b.st[1] = nx; }
    const unsigned old = xb_add(&bar[XB_XSUB(b.x)], 1u);
    const unsigned gen = old / nloc;
    if (old + 1u == (gen + 1u) * nloc) {
      __builtin_amdgcn_fence(__ATOMIC_RELEASE, "agent");
      asm volatile("s_waitcnt vmcnt(0)" ::: "memory");
      const unsigned og = xb_add(&bar[XB_TOP], 1u);
      const unsigned tg = og / nx;
      if (og + 1u == (tg + 1u) * nx) xb_add(&bar[XB_TOPGEN], 1u);
      else XB_SPIN(xb_ld(&bar[XB_TOPGEN]) == tg, bar);
      __builtin_amdgcn_fence(__ATOMIC_ACQUIRE, "agent");
      xb_add(&bar[XB_XGEN(b.x)], 1u);
      asm volatile("s_waitcnt vmcnt(0)" ::: "memory");
    } else {
      XB_SPIN(xb_ld(&bar[XB_XGEN(b.x)]) == gen, bar);
      __builtin_amdgcn_fence(__ATOMIC_ACQUIRE, "agent");
      asm volatile("s_waitcnt vmcnt(0)" ::: "memory");
    }
  }
  __syncthreads();
}

__global__ void __launch_bounds__(NTHREADS, 2) fwd_mega(Params p) {
  __shared__ __attribute__((aligned(16))) char smem[75808];
  const int bid = blockIdx.x, nb = gridDim.x;
  volatile LAS unsigned* st = (volatile LAS unsigned*)(smem + 75792);
  if (threadIdx.x == 0) { st[0] = 0u; st[1] = 0u; }
  __syncthreads();
  const XcdBarrier bar = xcd_barrier_post(p.bar, st);
  phase_prep(p, bid, nb, smem);        xcd_barrier(bar);
  phase_fold(p, bid, nb, smem);        xcd_barrier(bar);
  phase_norm_mod(p, bid, nb, smem);    xcd_barrier(bar);
  phase_inproj(p, bid, nb, smem);      xcd_barrier(bar);
  phase_ssm_pre(p, bid, nb, smem);     xcd_barrier(bar);
  phase_ssd_dft(p, bid, nb, smem);     xcd_barrier(bar);
  phase_ssm_post(p, bid, nb, smem);    xcd_barrier(bar);
  phase_outproj(p, bid, nb, smem);     xcd_barrier(bar);
  phase_postmix(p, bid, nb, smem);     xcd_barrier(bar);
  phase_q_route(p, bid, nb, smem);     xcd_barrier(bar);
  phase_exp_u(p, smem);                xcd_barrier(bar);
  phase_exp_v(p, smem);                xcd_barrier(bar);
  phase_exp_final(p, bid, nb, smem);
}

}

extern "C" void kernel_launch(void* const* d_in, const int* in_sizes, int n_in, void* d_out, int out_size, void* d_ws,
                              size_t ws_size, hipStream_t stream) {
  Params p{};
  const float** fp = reinterpret_cast<const float**>(&p);
  for (int i = 0; i < 27; ++i) fp[i] = (const float*)d_in[i];
  p.out = (float*)d_out;
  char* ws = (char*)d_ws;
  size_t off = 0;
  auto take = [&](size_t bytes) { char* r = ws + off; off += (bytes + 255) & ~(size_t)255; return r; };
  p.U8 = (uint8_t*)take((size_t)16384 * D);
  p.V8 = (uint8_t*)take((size_t)16384 * D);
  p.uscale = (float*)take((size_t)16384 * 4);
  p.hx8a = (int8_t*)take((size_t)(T + TC) * D);
  p.w8 = (int8_t*)take((size_t)NPROJ * D);
  p.ascale = (float*)take((size_t)(T + TC) * 4);
  p.wscale = (float*)take((size_t)NPROJ * 4);
  p.ycat8 = (int8_t*)take((size_t)T * D);
  p.wo8 = (int8_t*)take((size_t)D * D);
  p.yscale = (float*)take((size_t)T * 4);
  p.woscale = (float*)take((size_t)D * 4);
  p.w_in_t = (bf16_t*)take((size_t)NPROJ * D * 2);
  p.w_out_t = (bf16_t*)take((size_t)D * D * 2);
  p.w_q_t = (bf16_t*)take((size_t)1024 * D * 2);
  p.w_in_f = (bf16_t*)take((size_t)D * 1024 * 2);
  p.WcsT = (bf16_t*)take((size_t)4 * 512 * 256 * 2);
  p.dftm = (bf16_t*)take((size_t)1024 * 2048 * 2);
  p.Fs = (bf16_t*)take((size_t)NB * 1024 * 2048 * 2);
  p.partial = (float*)take((size_t)KSPLIT * 5 * NMOD * 4);
  p.mod = (float*)take((size_t)5 * NMOD * 4);
  p.hx = (bf16_t*)take((size_t)T * D * 2);
  p.hc = (bf16_t*)take((size_t)TC * D * 2);
  p.ABt = (bf16_t*)take((size_t)NB * 1024 * 4096 * 2);
  p.q = (float*)p.ABt;
  p.z = (bf16_t*)take((size_t)T * 1024 * 2);
  char* r1 = take(0);
  p.xbcraw = (bf16_t*)take((size_t)T * DXBC * 4);
  p.xbcraw_c = (bf16_t*)take((size_t)TC * DXBC * 4);
  p.act_tm = (bf16_t*)take((size_t)(T + TC) * DXBC * 2);
  p.act_cm_x = (bf16_t*)take((size_t)NB * 1280 * L * 2);
  p.act_cm_c = (bf16_t*)take((size_t)NB * 1280 * CTX * 2);
  p.y_x = (float*)r1;
  p.dtraw = (float*)take((size_t)T * 32 * 4);
  p.dtraw_c = (float*)take((size_t)TC * 32 * 4);
  p.dtf = (float*)take((size_t)T * 16 * 4);
  p.dtb = (float*)take((size_t)T * 16 * 4);
  p.dtf_c = (float*)take((size_t)TC * 16 * 4);
  p.dtb_c = (float*)take((size_t)TC * 16 * 4);
  p.yf = (float*)take((size_t)T * 1024 * 4);
  p.yb = (float*)take((size_t)T * 1024 * 4);
  p.ctr = (unsigned*)take(256);
  p.bar = (unsigned*)take((size_t)XCD_BAR_WORDS * 4);
  p.ycat = (bf16_t*)take((size_t)T * D * 2);
  p.idx = (int*)take((size_t)T * 128 * 4);
  p.gate = (float*)take((size_t)T * 128 * 4);
  if (off > ws_size) { fprintf(stderr, "kernel_launch: workspace too small: need %zu have %zu\n", off, ws_size); return; }
  static int grid_blocks = 0;
  if (!grid_blocks) {
    int dev = 0, cus = 0, per_cu = 0;
    hipGetDevice(&dev);
    hipDeviceGetAttribute(&cus, hipDeviceAttributeMultiprocessorCount, dev);
    hipOccupancyMaxActiveBlocksPerMultiprocessor(&per_cu, fwd_mega, NTHREADS, 0);
    if (per_cu > 2) per_cu = 2;
    grid_blocks = cus * per_cu;
    if (grid_blocks <= 0) { fprintf(stderr, "kernel_launch: occupancy query gave %d x %d\n", cus, per_cu); grid_blocks = -1; }
  }
  if (grid_blocks < 0) return;
  (void)hipMemsetAsync(p.bar, 0, (size_t)XCD_BAR_WORDS * 4, stream);
  void* args[] = {&p};
  hipError_t e = hipLaunchCooperativeKernel((void*)fwd_mega, dim3(grid_blocks), dim3(NTHREADS), args, 0, stream);
  if (e != hipSuccess) fprintf(stderr, "cooperative launch failed: %s (grid %d)\n", hipGetErrorString(e), grid_blocks);
}
```

```cpp
#include <hip/hip_runtime.h>
#include <hip/hip_cooperative_groups.h>
#include <stdint.h>
#include <stdio.h>

namespace cg = cooperative_groups;
namespace {

typedef __attribute__((ext_vector_type(8))) short bf16x8;
typedef __attribute__((ext_vector_type(4))) float f32x4;
typedef unsigned short bf16_t;

constexpr int D = 2048, NB = 4, L = 2048, T = NB * L, CTX = 256, TC = NB * CTX;
constexpr int NMOD = 6 * D;
constexpr int NH = 16, HP = 64, NS = 128, DXBC = 1536;
constexpr int DIN = 3616;
constexpr int NPROJ = 4736;
constexpr int KSPLIT = 32;
constexpr float EPS = 1e-6f;
constexpr int NTHREADS = 256;

__device__ __forceinline__ bf16_t f2bf(float f) { __bf16 h = (__bf16)f; return __builtin_bit_cast(unsigned short, h); }
__device__ __forceinline__ float bf2f(bf16_t h) { return __uint_as_float(((uint32_t)h) << 16); }
__device__ __forceinline__ uint32_t pack2(float a, float b) {
  typedef __attribute__((ext_vector_type(2))) __bf16 bf16x2_t;
  typedef __attribute__((ext_vector_type(2))) float f32x2_t;
  const f32x2_t v = {a, b};
  return __builtin_bit_cast(uint32_t, __builtin_convertvector(v, bf16x2_t));
}
__device__ __forceinline__ float bflo(uint32_t w) { return __uint_as_float(w << 16); }
__device__ __forceinline__ float bfhi(uint32_t w) { return __uint_as_float(w & 0xffff0000u); }
__device__ __forceinline__ float silu_f(float v) { return v / (1.f + __expf(-v)); }
__device__ __forceinline__ float softplus_f(float v) { return v > 20.f ? v : log1pf(__expf(v)); }

__device__ __forceinline__ int opaque_tid() { int t = threadIdx.x; asm volatile("" : "+v"(t)); return t; }
__device__ __forceinline__ float wave_sum(float v) {
#pragma unroll
  for (int o = 32; o > 0; o >>= 1) v += __shfl_xor(v, o);
  return v;
}
template <int CTRL>
__device__ __forceinline__ float dpp_mov(float v) {
  return __int_as_float(__builtin_amdgcn_update_dpp(0, __float_as_int(v), CTRL, 0xF, 0xF, true));
}
template <int CTRL>
__device__ __forceinline__ int dpp_movi(int v) { return __builtin_amdgcn_update_dpp(0, v, CTRL, 0xF, 0xF, true); }
__device__ __forceinline__ float wave_sum_fast(float v) {
  v += dpp_mov<0xB1>(v); v += dpp_mov<0x4E>(v); v += dpp_mov<0x124>(v); v += dpp_mov<0x128>(v);
  v += __shfl_xor(v, 16); v += __shfl_xor(v, 32);
  return v;
}
__device__ __forceinline__ float wave_max(float v) {
#pragma unroll
  for (int o = 32; o > 0; o >>= 1) v = fmaxf(v, __shfl_xor(v, o));
  return v;
}
__device__ __forceinline__ float block_sum(float v, float* red) {
  v = wave_sum(v);
  __syncthreads();
  if ((threadIdx.x & 63) == 0) red[threadIdx.x >> 6] = v;
  __syncthreads();
  return red[0] + red[1] + red[2] + red[3];
}

struct Params {
  const float *x, *c, *ctx, *c_ctx, *w_mod, *b_mod, *g_pre_mix, *g_post_mix, *g_pre_ffn, *g_post_ffn;
  const float *w_in, *w_fmix, *conv_w, *conv_b, *dt_bias_f, *dt_bias_b, *a_log_f, *a_log_b, *d_skip_f, *d_skip_b;
  const float *ssm_norm_w, *w_out, *w_query, *sk1, *sk2, *eu, *ev;
  float* out;
  uint8_t *U8, *V8;
  float* uscale;
  int8_t *hx8a, *w8;
  float *ascale, *wscale;
  int8_t *ycat8, *wo8;
  float *yscale, *woscale;
  bf16_t *w_in_t, *w_out_t, *w_q_t, *w_in_f, *WcsT, *dftm, *Fs;
  float *partial, *mod;
  bf16_t *hx, *hc, *ABt, *z;
  bf16_t *xbcraw, *xbcraw_c;
  float *dtraw, *dtraw_c, *dtf, *dtb, *dtf_c, *dtb_c;
  bf16_t *act_tm, *act_cm_x, *act_cm_c;
  float *yf, *yb;
  unsigned* ctr; unsigned* bar;
  bf16_t* ycat;
  float *y_x, *q, *gate;
  int* idx;
  int pad0, pad1;
};

template <bool I8 = false>
__device__ __forceinline__ void gemm_mainloop(const bf16_t* __restrict__ A, int lda, const bf16_t* __restrict__ Bt, int ldb,
                                              int K, int m0, int n0, f32x4 (&acc)[4][4], char* smem) {
  const int tid = opaque_tid(), lane = tid & 63, w = tid >> 6;
  const int wm = w >> 1, wn = w & 1;
#pragma unroll
  for (int i = 0; i < 4; ++i)
#pragma unroll
    for (int j = 0; j < 4; ++j) acc[i][j] = f32x4{0.f, 0.f, 0.f, 0.f};

  const int nk = K / 64;
  const int rowoff = lane >> 3, lch = (lane & 7) ^ rowoff;
  const bf16_t* gA = A + (size_t)(m0 + w * 8 + rowoff) * lda + lch * 8;
  const bf16_t* gB = Bt + (size_t)(n0 + w * 8 + rowoff) * ldb + lch * 8;
#define GSTAGE(buf_, kt_)                                                                                               \
  do {                                                                                                                  \
    _Pragma("unroll") for (int i_ = 0; i_ < 4; ++i_) {                                                                  \
      __builtin_amdgcn_global_load_lds((const unsigned*)(gA + (size_t)(i_ * 32) * lda + (kt_) * 64),                    \
                                       (unsigned*)(smem + (buf_) * 32768 + (i_ * 4 + w) * 1024), 16, 0, 0);             \
      __builtin_amdgcn_global_load_lds((const unsigned*)(gB + (size_t)(i_ * 32) * ldb + (kt_) * 64),                    \
                                       (unsigned*)(smem + (buf_) * 32768 + 16384 + (i_ * 4 + w) * 1024), 16, 0, 0);     \
    }                                                                                                                   \
  } while (0)
  GSTAGE(0, 0);
  asm volatile("s_waitcnt vmcnt(0)" ::: "memory");
  __syncthreads();
  for (int kt = 0; kt < nk; ++kt) {
    const int cur = kt & 1;
    if (kt + 1 < nk) GSTAGE(cur ^ 1, kt + 1);
    const char* sA = smem + cur * 32768;
    const char* sB = sA + 16384;
#pragma unroll
    for (int kk = 0; kk < 2; ++kk) {
      bf16x8 af[4], bfr[4];
      const int ch = kk * 4 + (lane >> 4);
#pragma unroll
      for (int i = 0; i < 4; ++i) {
        int row = wm * 64 + i * 16 + (lane & 15);
        af[i] = *reinterpret_cast<const bf16x8*>(sA + row * 128 + ((ch ^ (row & 7)) << 4));
        int col = wn * 64 + i * 16 + (lane & 15);
        bfr[i] = *reinterpret_cast<const bf16x8*>(sB + col * 128 + ((ch ^ (col & 7)) << 4));
      }
#pragma unroll
      for (int i = 0; i < 4; ++i)
#pragma unroll
        for (int j = 0; j < 4; ++j) {
          if (I8) {
            typedef __attribute__((ext_vector_type(4))) int i32x4;
            acc[i][j] = __builtin_bit_cast(f32x4, __builtin_amdgcn_mfma_i32_16x16x64_i8(__builtin_bit_cast(i32x4, af[i]), __builtin_bit_cast(i32x4, bfr[j]),
                                                                                         __builtin_bit_cast(i32x4, acc[i][j]), 0, 0, 0));
          } else {
            acc[i][j] = __builtin_amdgcn_mfma_f32_16x16x32_bf16(af[i], bfr[j], acc[i][j], 0, 0, 0);
          }
        }
    }
    asm volatile("s_waitcnt vmcnt(0)" ::: "memory");
    __syncthreads();
  }
#undef GSTAGE
}

template <bool I8 = false, class Epi>
__device__ __forceinline__ void gemm_tile(const bf16_t* __restrict__ A, int lda, const bf16_t* __restrict__ Bt, int ldb,
                                          int K, int m0, int n0, const Epi& epi, char* smem,
                                          const float* __restrict__ rscale = nullptr, const float* __restrict__ cscale = nullptr) {
  const int lane = threadIdx.x & 63, w = threadIdx.x >> 6;
  const int wm = w >> 1, wn = w & 1;
  f32x4 acc[4][4];
  gemm_mainloop<I8>(A, lda, Bt, ldb, K, m0, n0, acc, smem);
#pragma unroll
  for (int i = 0; i < 4; ++i) {
    const int row = m0 + wm * 64 + i * 16 + (lane >> 4) * 4;
    float4 rs = float4{1.f, 1.f, 1.f, 1.f};
    if (I8) rs = *reinterpret_cast<const float4*>(rscale + row);
#pragma unroll
    for (int j = 0; j < 4; ++j) {
      const int col = n0 + wn * 64 + j * 16 + (lane & 15);
      if (I8) {
        typedef __attribute__((ext_vector_type(4))) int i32x4;
        const i32x4 ia = __builtin_bit_cast(i32x4, acc[i][j]);
        const float cs = cscale[col];
        epi(row, col, f32x4{(float)ia[0] * rs.x * cs, (float)ia[1] * rs.y * cs, (float)ia[2] * rs.z * cs, (float)ia[3] * rs.w * cs});
      } else {
        epi(row, col, acc[i][j]);
      }
    }
  }
}

template <bool I8>
__device__ __forceinline__ void gemm_mainloop_n256(const bf16_t* __restrict__ A, int lda, const bf16_t* __restrict__ Bt, int ldb,
                                                   int K, int m0, int n0, f32x4 (&acc)[4][8], char* smem) {
  const int tid = opaque_tid(), lane = tid & 63, w = tid >> 6;
  const int wm = w >> 1, wn = w & 1;
#pragma unroll
  for (int i = 0; i < 4; ++i)
#pragma unroll
    for (int j = 0; j < 8; ++j) acc[i][j] = f32x4{0.f, 0.f, 0.f, 0.f};
  const int nk = K / 64;
  const int rowoff = lane >> 3, lch = (lane & 7) ^ rowoff;
  const bf16_t* gA = A + (size_t)(m0 + w * 8 + rowoff) * lda + lch * 8;
  const bf16_t* gB = Bt + (size_t)(n0 + w * 8 + rowoff) * ldb + lch * 8;
  const int fr = lane & 15, fq = lane >> 4;
  for (int kt = 0; kt < nk; ++kt) {
#pragma unroll
    for (int i_ = 0; i_ < 4; ++i_)
      __builtin_amdgcn_global_load_lds((const unsigned*)(gA + (size_t)(i_ * 32) * lda + kt * 64),
                                       (unsigned*)(smem + (i_ * 4 + w) * 1024), 16, 0, 0);
#pragma unroll
    for (int i_ = 0; i_ < 8; ++i_)
      __builtin_amdgcn_global_load_lds((const unsigned*)(gB + (size_t)(i_ * 32) * ldb + kt * 64),
                                       (unsigned*)(smem + 16384 + (i_ * 4 + w) * 1024), 16, 0, 0);
    asm volatile("s_waitcnt vmcnt(0)" ::: "memory");
    __syncthreads();
    const char* sA = smem;
    const char* sB = smem + 16384;
#pragma unroll
    for (int kk = 0; kk < 2; ++kk) {
      bf16x8 af[4], bfr[8];
      const int ch = kk * 4 + fq;
#pragma unroll
      for (int i = 0; i < 4; ++i) {
        const int row = wm * 64 + i * 16 + fr;
        af[i] = *reinterpret_cast<const bf16x8*>(sA + row * 128 + ((ch ^ (row & 7)) << 4));
      }
#pragma unroll
      for (int j = 0; j < 8; ++j) {
        const int col = wn * 128 + j * 16 + fr;
        bfr[j] = *reinterpret_cast<const bf16x8*>(sB + col * 128 + ((ch ^ (col & 7)) << 4));
      }
#pragma unroll
      for (int i = 0; i < 4; ++i)
#pragma unroll
        for (int j = 0; j < 8; ++j) {
          if (I8) {
            typedef __attribute__((ext_vector_type(4))) int i32x4;
            acc[i][j] = __builtin_bit_cast(f32x4, __builtin_amdgcn_mfma_i32_16x16x64_i8(__builtin_bit_cast(i32x4, af[i]), __builtin_bit_cast(i32x4, bfr[j]),
                                                                                         __builtin_bit_cast(i32x4, acc[i][j]), 0, 0, 0));
          } else {
            acc[i][j] = __builtin_amdgcn_mfma_f32_16x16x32_bf16(af[i], bfr[j], acc[i][j], 0, 0, 0);
          }
        }
    }
    __syncthreads();
  }
}
template <bool I8, class Epi>
__device__ __forceinline__ void gemm_tile_n256(const bf16_t* __restrict__ A, int lda, const bf16_t* __restrict__ Bt, int ldb,
                                               int K, int m0, int n0, const Epi& epi, char* smem,
                                               const float* __restrict__ rscale = nullptr, const float* __restrict__ cscale = nullptr) {
  const int lane = threadIdx.x & 63, w = threadIdx.x >> 6;
  const int wm = w >> 1, wn = w & 1;
  f32x4 acc[4][8];
  gemm_mainloop_n256<I8>(A, lda, Bt, ldb, K, m0, n0, acc, smem);
#pragma unroll
  for (int i = 0; i < 4; ++i) {
    const int row = m0 + wm * 64 + i * 16 + (lane >> 4) * 4;
    float4 rs = float4{1.f, 1.f, 1.f, 1.f};
    if (I8) rs = *reinterpret_cast<const float4*>(rscale + row);
#pragma unroll
    for (int j = 0; j < 8; ++j) {
      const int col = n0 + wn * 128 + j * 16 + (lane & 15);
      if (I8) {
        typedef __attribute__((ext_vector_type(4))) int i32x4;
        const i32x4 ia = __builtin_bit_cast(i32x4, acc[i][j]);
        const float cs = cscale[col];
        epi(row, col, f32x4{(float)ia[0] * rs.x * cs, (float)ia[1] * rs.y * cs, (float)ia[2] * rs.z * cs, (float)ia[3] * rs.w * cs});
      } else {
        epi(row, col, acc[i][j]);
      }
    }
  }
}

__device__ __forceinline__ float wave_max_fast(float v) {
  v = fmaxf(v, dpp_mov<0xB1>(v)); v = fmaxf(v, dpp_mov<0x4E>(v)); v = fmaxf(v, dpp_mov<0x124>(v)); v = fmaxf(v, dpp_mov<0x128>(v));
  v = fmaxf(v, __shfl_xor(v, 16)); v = fmaxf(v, __shfl_xor(v, 32));
  return v;
}
__device__ __forceinline__ uint32_t pack_i8x4(float a, float b, float c, float d) {
  const int ia = __float2int_rn(a), ib = __float2int_rn(b), ic = __float2int_rn(c), id = __float2int_rn(d);
  return (uint32_t)(ia & 255) | ((uint32_t)(ib & 255) << 8) | ((uint32_t)(ic & 255) << 16) | ((uint32_t)id << 24);
}
struct EpiF32 {
  float* C; int ldc;
  __device__ __forceinline__ void operator()(int row, int col, f32x4 v) const {
#pragma unroll
    for (int r = 0; r < 4; ++r) C[(size_t)(row + r) * ldc + col] = v[r];
  }
};
struct EpiBf16 {
  bf16_t* C; int ldc;
  __device__ __forceinline__ void operator()(int row, int col, f32x4 v) const {
#pragma unroll
    for (int r = 0; r < 4; ++r) C[(size_t)(row + r) * ldc + col] = f2bf(v[r]);
  }
};
struct EpiBf16T {
  bf16_t* Ct; int ldc;
  __device__ __forceinline__ void operator()(int row, int col, f32x4 v) const {
    uint2 pk; pk.x = pack2(v[0], v[1]); pk.y = pack2(v[2], v[3]);
    *reinterpret_cast<uint2*>(Ct + (size_t)col * ldc + row) = pk;
  }
};
struct EpiInAB {
  bf16_t* ABt; int seqlen;
  __device__ __forceinline__ void operator()(int row, int col, f32x4 v) const {
    const int ch = col & 1023, half = col >> 10;
    const int b = row / seqlen, l = row - b * seqlen;
    uint2 pk; pk.x = pack2(v[0], v[1]); pk.y = pack2(v[2], v[3]);
    *reinterpret_cast<uint2*>(ABt + ((size_t)(b * 1024 + ch) * 4096 + half * 2048 + l)) = pk;
  }
};
struct EpiInZ {
  bf16_t* z;
  __device__ __forceinline__ void operator()(int row, int col, f32x4 v) const {
#pragma unroll
    for (int r = 0; r < 4; ++r) z[(size_t)(row + r) * 1024 + (col - 2048)] = f2bf(v[r]);
  }
};
struct EpiInXbc {
  bf16_t* xbcraw;
  __device__ __forceinline__ void operator()(int row, int col, f32x4 v) const {
#pragma unroll
    for (int r = 0; r < 4; ++r) xbcraw[(size_t)(row + r) * DXBC + (col - 3072)] = f2bf(v[r]);
  }
};
struct EpiInProj {
  bf16_t* ABt; bf16_t* z; bf16_t* xbcraw; float* dtraw; int seqlen;
  __device__ __forceinline__ void operator()(int row, int col, f32x4 v) const {
    if (col < 2048) {
      int ch = col & 1023, half = col >> 10;
      int b = row / seqlen, l = row - b * seqlen;
      uint2 pk; pk.x = pack2(v[0], v[1]); pk.y = pack2(v[2], v[3]);
      *reinterpret_cast<uint2*>(ABt + ((size_t)(b * 1024 + ch) * 4096 + half * 2048 + l)) = pk;
    } else if (col < 3072) {
#pragma unroll
      for (int r = 0; r < 4; ++r) z[(size_t)(row + r) * 1024 + (col - 2048)] = f2bf(v[r]);
    } else if (col < 4608) {
#pragma unroll
      for (int r = 0; r < 4; ++r) xbcraw[(size_t)(row + r) * DXBC + (col - 3072)] = f2bf(v[r]);
    } else if (col < 4640) {
#pragma unroll
      for (int r = 0; r < 4; ++r) dtraw[(size_t)(row + r) * 32 + (col - 4608)] = v[r];
    }
  }
};

__device__ void adaln_partial_task(const Params& p, int task, float* sm) {
  const int cb = task % 48, ks = task / 48, tid = threadIdx.x;
  float* sc = sm;
  __syncthreads();
  for (int i = tid; i < 5 * 64; i += NTHREADS) {
    int r = i >> 6, kk = i & 63;
    int k = ks * 64 + kk;
    float cv = (r < 4) ? p.c[r * D + k] : p.c_ctx[k];
    sc[i] = silu_f(cv);
  }
  __syncthreads();
  const int col = cb * 256 + tid;
  float a0 = 0, a1 = 0, a2 = 0, a3 = 0, a4 = 0;
  const float* wp = p.w_mod + (size_t)(ks * 64) * NMOD + col;
  {
    float wv[64];
#pragma unroll
    for (int kk = 0; kk < 64; ++kk) wv[kk] = __builtin_nontemporal_load(wp + (size_t)kk * NMOD);
#pragma unroll
    for (int k = 0; k < 64; ++k) {
      a0 += sc[k] * wv[k]; a1 += sc[64 + k] * wv[k]; a2 += sc[128 + k] * wv[k]; a3 += sc[192 + k] * wv[k]; a4 += sc[256 + k] * wv[k];
    }
  }
  float* pp = p.partial + (size_t)ks * 5 * NMOD + col;
  pp[0] = a0; pp[NMOD] = a1; pp[2 * NMOD] = a2; pp[3 * NMOD] = a3; pp[4 * NMOD] = a4;
}

__device__ void transpose_convert_task(const float* __restrict__ src, int ld, int c0, int rows, bf16_t* __restrict__ dst,
                                       int tr, int tc, float* sm) {
  float (*tile)[68] = reinterpret_cast<float (*)[68]>(sm);
  const int tid = threadIdx.x;
  __syncthreads();
  {
    float4 v[4];
#pragma unroll
    for (int k = 0; k < 4; ++k) {
      const int i = tid + k * NTHREADS, r = i >> 4, c4 = i & 15;
      v[k] = *reinterpret_cast<const float4*>(src + (size_t)(tr * 64 + r) * ld + c0 + tc * 64 + c4 * 4);
    }
#pragma unroll
    for (int k = 0; k < 4; ++k) {
      const int i = tid + k * NTHREADS, r = i >> 4, c4 = i & 15;
      *reinterpret_cast<float4*>(&tile[r][c4 * 4]) = v[k];
    }
  }
  __syncthreads();
#pragma unroll
  for (int k = 0; k < 4; ++k) {
    const int i = tid + k * NTHREADS, cc = i >> 4, r4 = (i & 15) * 4;
    uint2 o; o.x = pack2(tile[r4][cc], tile[r4 + 1][cc]); o.y = pack2(tile[r4 + 2][cc], tile[r4 + 3][cc]);
    *reinterpret_cast<uint2*>(dst + (size_t)(tc * 64 + cc) * rows + tr * 64 + r4) = o;
  }
}

__device__ void phase_prep(const Params& p, int bid, int nb, char* smem) {
  float* sm = reinterpret_cast<float*>(smem);
  const int tid = threadIdx.x;
  if (bid == 0 && tid < 64) p.ctr[tid] = 0u;
  {
    float* t256 = reinterpret_cast<float*>(smem + 20480);
    float* t2048 = reinterpret_cast<float*>(smem + 24576);
    t256[tid] = cospif((float)tid * (1.0f / 128.f));
    for (int i = tid; i < 2048; i += NTHREADS) t2048[i] = cospif((float)i * (1.0f / 1024.f));
    __syncthreads();
  }
  for (int t = bid; t < 48 * KSPLIT; t += nb) adaln_partial_task(p, t, sm);
  {
    const int nct = 41, nrt = 32;
    for (int t = bid; t < nct * nrt; t += nb) {
      int tc = t % nct, tr = t / nct;
      if (tc < 40) transpose_convert_task(p.w_in, DIN, 1024, D, p.w_in_t + (size_t)2048 * D, tr, tc, sm);
      else {
        float (*tile)[65] = reinterpret_cast<float (*)[65]>(sm);
        __syncthreads();
        for (int i = tid; i < 64 * 32; i += NTHREADS) {
          int r = i >> 5, cc = i & 31;
          tile[r][cc] = p.w_in[(size_t)(tr * 64 + r) * DIN + 1024 + 2560 + cc];
        }
        __syncthreads();
        for (int i = tid; i < 32 * 32; i += NTHREADS) {
          int cc = i >> 5, r2 = (i & 31) * 2;
          uint32_t pk = pack2(tile[r2][cc], tile[r2 + 1][cc]);
          *reinterpret_cast<uint32_t*>(p.w_in_t + (size_t)(2048 + 2560 + cc) * D + tr * 64 + r2) = pk;
        }
      }
    }
    for (size_t i = (size_t)bid * NTHREADS + tid; i < (size_t)96 * D / 8; i += (size_t)nb * NTHREADS)
      reinterpret_cast<uint4*>(p.w_in_t + (size_t)4640 * D)[i] = uint4{0, 0, 0, 0};
  }
  for (size_t i0 = (size_t)bid * NTHREADS + tid; i0 < (size_t)D * 1024 / 4; i0 += (size_t)4 * nb * NTHREADS) {
    float4 v[4];
#pragma unroll
    for (int u = 0; u < 4; ++u) {
      const size_t i = i0 + (size_t)u * nb * NTHREADS;
      const int k = (int)(i / 256), c4 = (int)(i % 256) * 4;
      v[u] = (i < (size_t)D * 1024 / 4) ? *reinterpret_cast<const float4*>(p.w_in + (size_t)k * DIN + c4) : float4{0.f, 0.f, 0.f, 0.f};
    }
#pragma unroll
    for (int u = 0; u < 4; ++u) {
      const size_t i = i0 + (size_t)u * nb * NTHREADS;
      const int k = (int)(i / 256), c4 = (int)(i % 256) * 4;
      uint2 o; o.x = pack2(v[u].x, v[u].y); o.y = pack2(v[u].z, v[u].w);
      if (i < (size_t)D * 1024 / 4) *reinterpret_cast<uint2*>(p.w_in_f + (size_t)k * 1024 + c4) = o;
    }
  }
  {
    const float* t256 = reinterpret_cast<const float*>(smem + 20480);
    const float scale = 1.0f / sqrtf((float)L * 256.f);
    const int vb = (bid + (nb >> 1)) % nb;
    for (int i = vb * NTHREADS + tid; i < 4 * 64 * 256; i += nb * NTHREADS) {
      const int d = i & 255, cg = (i >> 8) & 63, g = i >> 14;
      float c0_ = 0.f, c1_ = 0.f, c2_ = 0.f, c3_ = 0.f, s0_ = 0.f, s1_ = 0.f, s2_ = 0.f, s3_ = 0.f;
      const float* wp = p.w_fmix + (size_t)g * 65536 + d;
#pragma unroll 1
      for (int mb = 0; mb < 256; mb += 16) {
        float wv[16];
#pragma unroll
        for (int mm = 0; mm < 16; ++mm) wv[mm] = wp[(mb + mm) * 256];
#pragma unroll
        for (int mm = 0; mm < 16; ++mm) {
          const int m = mb + mm;
          const int p0 = (m * (cg * 4 + 0)) & 255, p1 = (m * (cg * 4 + 1)) & 255, p2 = (m * (cg * 4 + 2)) & 255, p3 = (m * (cg * 4 + 3)) & 255;
          c0_ += t256[p0] * wv[mm]; s0_ += t256[(p0 - 64) & 255] * wv[mm];
          c1_ += t256[p1] * wv[mm]; s1_ += t256[(p1 - 64) & 255] * wv[mm];
          c2_ += t256[p2] * wv[mm]; s2_ += t256[(p2 - 64) & 255] * wv[mm];
          c3_ += t256[p3] * wv[mm]; s3_ += t256[(p3 - 64) & 255] * wv[mm];
        }
      }
      {
        bf16_t* wc = p.WcsT + ((size_t)g * 512 + d) * 256 + cg * 4;
        bf16_t* ws_ = p.WcsT + ((size_t)g * 512 + 256 + d) * 256 + cg * 4;
        uint2 oc, os;
        oc.x = pack2(c0_ * scale, c1_ * scale); oc.y = pack2(c2_ * scale, c3_ * scale);
        os.x = pack2(s0_ * scale, s1_ * scale); os.y = pack2(s2_ * scale, s3_ * scale);
        *reinterpret_cast<uint2*>(wc) = oc;
        *reinterpret_cast<uint2*>(ws_) = os;
      }
    }
  }
  {
    const float* t2048 = reinterpret_cast<const float*>(smem + 24576);
    for (size_t i = (size_t)bid * NTHREADS + tid; i < (size_t)1024 * 2048 / 8; i += (size_t)nb * NTHREADS) {
      const int k = (int)(i / 256), j = (int)(i % 256) * 8;
      const bool iss = j >= 1024;
      float o[8];
#pragma unroll
      for (int e = 0; e < 8; ++e) {
        const int l = (j + e) & 1023;
        const int ph = (k * l) & 2047;
        o[e] = iss ? t2048[(ph - 512) & 2047] : t2048[ph];
      }
      uint4 pk; pk.x = pack2(o[0], o[1]); pk.y = pack2(o[2], o[3]); pk.z = pack2(o[4], o[5]); pk.w = pack2(o[6], o[7]);
      *reinterpret_cast<uint4*>(p.dftm + (size_t)k * 2048 + j) = pk;
    }
  }
}

__device__ void phase_fold(const Params& p, int bid, int nb, char* smem) {
  const int tid = threadIdx.x;
  for (int i = bid * NTHREADS + tid; i < 5 * NMOD; i += nb * NTHREADS) {
    int col = i % NMOD;
    float s = p.b_mod[col];
    for (int ks = 0; ks < KSPLIT; ++ks) s += p.partial[(size_t)ks * 5 * NMOD + i];
    p.mod[i] = s;
  }
  for (int t = bid; t < 256; t += nb) {
    int g = t >> 6, tm = (t & 63) >> 2, tn = t & 3;
    int n0 = tn * 128;
    int rowbase = (n0 < 256) ? (g * 256 + n0) : (1024 + g * 256 + (n0 - 256));
    EpiBf16T epi{p.w_in_t + (size_t)(rowbase - n0) * D, D};
    gemm_tile(p.w_in_f + g * 256, 1024, p.WcsT + (size_t)g * 512 * 256, 256, 256, tm * 128, n0, epi, smem);
  }
}

__device__ __forceinline__ void quant_weight_rows_i8(const bf16_t* __restrict__ src, int8_t* __restrict__ dst, float* __restrict__ scl,
                                                     int nrows, int bid, int nb) {
  const int lane = threadIdx.x & 63, w = threadIdx.x >> 6;
  for (int n = bid * 4 + w; n < nrows; n += nb * 4) {
    const bf16_t* wr = src + (size_t)n * D;
    uint4 q[4];
#pragma unroll
    for (int c = 0; c < 4; ++c) q[c] = *reinterpret_cast<const uint4*>(wr + c * 512 + lane * 8);
    float am = 0.f;
#pragma unroll
    for (int c = 0; c < 4; ++c) {
      am = fmaxf(am, fmaxf(fmaxf(fabsf(bflo(q[c].x)), fabsf(bfhi(q[c].x))), fmaxf(fabsf(bflo(q[c].y)), fabsf(bfhi(q[c].y)))));
      am = fmaxf(am, fmaxf(fmaxf(fabsf(bflo(q[c].z)), fabsf(bfhi(q[c].z))), fmaxf(fabsf(bflo(q[c].w)), fabsf(bfhi(q[c].w)))));
    }
    am = wave_max_fast(am);
    const float inv = (am > 0.f) ? 127.f / am : 0.f;
#pragma unroll
    for (int c = 0; c < 4; ++c) {
      uint2 o;
      o.x = pack_i8x4(bflo(q[c].x) * inv, bfhi(q[c].x) * inv, bflo(q[c].y) * inv, bfhi(q[c].y) * inv);
      o.y = pack_i8x4(bflo(q[c].z) * inv, bfhi(q[c].z) * inv, bflo(q[c].w) * inv, bfhi(q[c].w) * inv);
      *reinterpret_cast<uint2*>(dst + (size_t)n * D + c * 512 + lane * 8) = o;
    }
    if (lane == 0) scl[n] = am * (1.f / 127.f);
  }
}

__device__ void phase_norm_mod(const Params& p, int bid, int nb, char* smem) {
  const int lane = threadIdx.x & 63, w = threadIdx.x >> 6;
  for (int t = bid * 4 + w; t < T + TC; t += nb * 4) {
    const bool isx = t < T;
    const float* src = isx ? (p.x + (size_t)t * D) : (p.ctx + (size_t)(t - T) * D);
    const int mrow = isx ? (t / L) : 4;
    float4 v[8];
    float ss = 0.f;
#pragma unroll
    for (int c = 0; c < 8; ++c) {
      v[c] = *reinterpret_cast<const float4*>(src + c * 256 + lane * 4);
      ss += v[c].x * v[c].x + v[c].y * v[c].y + v[c].z * v[c].z + v[c].w * v[c].w;
    }
    ss = wave_sum_fast(ss);
    const float rstd = rsqrtf(ss * (1.f / D) + EPS);
    const float* sh = p.mod + (size_t)mrow * NMOD + 0 * D;
    const float* sc = p.mod + (size_t)mrow * NMOD + 1 * D;
    float am = 0.f;
#pragma unroll
    for (int c = 0; c < 8; ++c) {
      const int e0 = c * 256 + lane * 4;
      const float4 g = *reinterpret_cast<const float4*>(p.g_pre_mix + e0);
      const float4 s4 = *reinterpret_cast<const float4*>(sc + e0), h4 = *reinterpret_cast<const float4*>(sh + e0);
      v[c].x = v[c].x * rstd * g.x * (1.f + s4.x) + h4.x; v[c].y = v[c].y * rstd * g.y * (1.f + s4.y) + h4.y;
      v[c].z = v[c].z * rstd * g.z * (1.f + s4.z) + h4.z; v[c].w = v[c].w * rstd * g.w * (1.f + s4.w) + h4.w;
      am = fmaxf(am, fmaxf(fmaxf(fabsf(v[c].x), fabsf(v[c].y)), fmaxf(fabsf(v[c].z), fabsf(v[c].w))));
    }
    {
      am = wave_max_fast(am);
      const float inv = (am > 0.f) ? 127.f / am : 0.f;
#pragma unroll
      for (int c = 0; c < 8; ++c)
        *reinterpret_cast<uint32_t*>(p.hx8a + (size_t)t * D + c * 256 + lane * 4) = pack_i8x4(v[c].x * inv, v[c].y * inv, v[c].z * inv, v[c].w * inv);
      if (lane == 0) p.ascale[t] = am * (1.f / 127.f);
    }
  }
  quant_weight_rows_i8(p.w_in_t, p.w8, p.wscale, NPROJ, bid, nb);
}

__device__ __forceinline__ void convert_v_units(const Params& p, size_t u0, size_t u1) {
  for (size_t j = u0 + threadIdx.x; j < u1; j += NTHREADS) {
    uint32_t o[4];
#pragma unroll
    for (int q4 = 0; q4 < 4; ++q4) {
      const float4 v = *reinterpret_cast<const float4*>(p.ev + j * 16 + q4 * 4);
      int pk = 0;
      pk = __builtin_amdgcn_cvt_pk_fp8_f32(v.x * 512.f, v.y * 512.f, pk, false);
      pk = __builtin_amdgcn_cvt_pk_fp8_f32(v.z * 512.f, v.w * 512.f, pk, true);
      o[q4] = (uint32_t)pk;
    }
    const size_t e_ = j >> 7, r_ = j & 127;
    *reinterpret_cast<uint4*>(p.V8 + (r_ >> 4) * ((size_t)16384 * 256) + e_ * 256 + (r_ & 15) * 16) = uint4{o[0], o[1], o[2], o[3]};
  }
}
__device__ __forceinline__ void convert_u_rows(const Params& p, int q) {
  const int lane = threadIdx.x & 63, w = threadIdx.x >> 6;
  const int row0 = q * 32 + w * 8;
#pragma unroll 1
  for (int rr = 0; rr < 8; rr += 2) {
    f32x4 va[8], vb[8];
#pragma unroll
    for (int k = 0; k < 8; ++k) va[k] = __builtin_nontemporal_load(reinterpret_cast<const f32x4*>(p.eu + (size_t)(row0 + rr) * D + k * 256 + lane * 4));
#pragma unroll
    for (int k = 0; k < 8; ++k) vb[k] = __builtin_nontemporal_load(reinterpret_cast<const f32x4*>(p.eu + (size_t)(row0 + rr + 1) * D + k * 256 + lane * 4));
#define CONV_U_EMIT(v_, row_)                                                                                           \
    {                                                                                                                   \
      float m = 0.f;                                                                                                    \
      _Pragma("unroll") for (int k = 0; k < 8; ++k)                                                                     \
        m = fmaxf(m, fmaxf(fmaxf(fabsf(v_[k][0]), fabsf(v_[k][1])), fmaxf(fabsf(v_[k][2]), fabsf(v_[k][3]))));        \
      m = wave_max_fast(m);                                                                                             \
      const float inv = (m > 0.f) ? 127.f / m : 0.f;                                                                    \
      _Pragma("unroll") for (int k = 0; k < 8; ++k)                                                                     \
        *reinterpret_cast<uint32_t*>(p.U8 + (size_t)k * ((size_t)16384 * 256) + (size_t)(row_) * 256 + lane * 4) =      \
            pack_i8x4(v_[k][0] * inv, v_[k][1] * inv, v_[k][2] * inv, v_[k][3] * inv);                                  \
      if (lane == 0) p.uscale[row_] = m * (1.f / 127.f);                                                                \
    }
    CONV_U_EMIT(va, row0 + rr);
    CONV_U_EMIT(vb, row0 + rr + 1);
#undef CONV_U_EMIT
  }
}
__device__ void phase_inproj(const Params& p, int bid, int nb, char* smem) {
  const bool aware = (nb & 7) == 0;
  const int start = aware ? (bid >> 3) : bid, step = aware ? (nb >> 3) : nb, end = aware ? (128 + 53) : 8 * (128 + 53);
  const bf16_t* a8 = reinterpret_cast<const bf16_t*>(p.hx8a);
  const bf16_t* b8 = reinterpret_cast<const bf16_t*>(p.w8);
  for (int it = start; it < end; it += step) {
    const int x = aware ? (bid & 7) : it / (128 + 53), s_ = aware ? it : it % (128 + 53);
    if (s_ < 128) {
      const int tn2 = s_ >> 3, m0_ = (8 * x + (s_ & 7)) * 128;
      if (tn2 < 8) { EpiInAB epi{p.ABt, L}; gemm_tile_n256<true>(a8, D / 2, b8, D / 2, D / 2, m0_, tn2 * 256, epi, smem, p.ascale, p.wscale); }
      else if (tn2 < 12) { EpiInZ epi{p.z}; gemm_tile_n256<true>(a8, D / 2, b8, D / 2, D / 2, m0_, tn2 * 256, epi, smem, p.ascale, p.wscale); }
      else { EpiInXbc epi{p.xbcraw}; gemm_tile_n256<true>(a8, D / 2, b8, D / 2, D / 2, m0_, tn2 * 256, epi, smem, p.ascale, p.wscale); }
    } else if (s_ < 128 + 40) {
      const int i = s_ - 128;
      EpiInProj epi{p.ABt, p.z, p.xbcraw, p.dtraw, L};
      gemm_tile<true>(a8, D / 2, b8, D / 2, D / 2, (8 * x + (i & 7)) * 128, (32 + (i >> 3)) * 128, epi, smem, p.ascale, p.wscale);
    } else {
      const int u = x * 13 + (s_ - 168);
      EpiInProj epi{nullptr, nullptr, p.xbcraw_c, p.dtraw_c, CTX};
      gemm_tile<true>(reinterpret_cast<const bf16_t*>(p.hx8a + (size_t)T * D), D / 2, b8, D / 2, D / 2, (u / 13) * 128, 3072 + (u % 13) * 128, epi, smem,
                      p.ascale + T, p.wscale);
    }
  }
}

__device__ void ssm_pre_tile(const Params& p, int task, char* smem) {
  const bool isx = task < 3072;
  const int u = isx ? task : task - 3072;
  const int ntt = isx ? 32 : 4;
  const int ct = u % 24, tt = (u / 24) % ntt, b = u / (24 * ntt);
  const int seqlen = isx ? L : CTX;
  const bf16_t* raw = (isx ? p.xbcraw : p.xbcraw_c) + (size_t)b * seqlen * DXBC;
  const int l0 = tt * 64, c0 = ct * 64, tid = threadIdx.x;
  float (*rt)[68] = reinterpret_cast<float (*)[68]>(smem);
  float (*at)[65] = reinterpret_cast<float (*)[65]>(smem + 66 * 68 * 4);
  __syncthreads();
  {
    uint2 v[5];
#pragma unroll
    for (int k = 0; k < 5; ++k) {
      const int i = tid + k * NTHREADS, r = i >> 4, c4 = i & 15, l = l0 - 1 + r;
      v[k] = (i < 66 * 16 && l >= 0 && l < seqlen) ? *reinterpret_cast<const uint2*>(raw + (size_t)l * DXBC + c0 + c4 * 4) : uint2{0u, 0u};
    }
#pragma unroll
    for (int k = 0; k < 5; ++k) {
      const int i = tid + k * NTHREADS, r = i >> 4, c4 = i & 15;
      if (i < 66 * 16) *reinterpret_cast<float4*>(&rt[r][c4 * 4]) = float4{bflo(v[k].x), bfhi(v[k].x), bflo(v[k].y), bfhi(v[k].y)};
    }
  }
  __syncthreads();
  {
    const int cc = tid & 63, c = c0 + cc;
    const float w0 = p.conv_w[c], w1 = p.conv_w[DXBC + c], w2 = p.conv_w[2 * DXBC + c], cb = p.conv_b[c];
#pragma unroll 4
    for (int r = tid >> 6; r < 64; r += 4) at[r][cc] = silu_f(cb + rt[r][cc] * w0 + rt[r + 1][cc] * w1 + rt[r + 2][cc] * w2);
  }
  __syncthreads();
  const size_t trow0 = isx ? ((size_t)b * L + l0) : ((size_t)T + (size_t)b * CTX + l0);
#pragma unroll
  for (int k = 0; k < 4; ++k) {
    const int i = tid + k * NTHREADS, r = i >> 4, c4 = (i & 15) * 4;
    uint2 o; o.x = pack2(at[r][c4], at[r][c4 + 1]); o.y = pack2(at[r][c4 + 2], at[r][c4 + 3]);
    *reinterpret_cast<uint2*>(p.act_tm + (trow0 + r) * DXBC + c0 + c4) = o;
  }
  if (c0 < 1280) {
    bf16_t* cm = (isx ? p.act_cm_x : p.act_cm_c) + (size_t)b * 1280 * seqlen;
#pragma unroll
    for (int k = 0; k < 4; ++k) {
      const int i = tid + k * NTHREADS, cc = i >> 4, r4 = (i & 15) * 4;
      uint2 o; o.x = pack2(at[r4][cc], at[r4 + 1][cc]); o.y = pack2(at[r4 + 2][cc], at[r4 + 3][cc]);
      *reinterpret_cast<uint2*>(cm + (size_t)(c0 + cc) * seqlen + l0 + r4) = o;
    }
  }
}
__device__ void dft_fold_rows(const Params& p, int bid, int nb, char* smem) {
  const int lane = threadIdx.x & 63, w = threadIdx.x >> 6;
  bf16_t* sr = reinterpret_cast<bf16_t*>(smem + w * 8192);
  for (int row = bid * 4 + w; row < NB * 1024; row += nb * 4) {
    const bf16_t* A = p.ABt + (size_t)row * 4096;
    bf16_t* F = p.Fs + (size_t)row * 2048;
    __builtin_amdgcn_wave_barrier();
    {
      const uint4 q0 = *reinterpret_cast<const uint4*>(A + (0 * 64 + lane) * 8), q1 = *reinterpret_cast<const uint4*>(A + (1 * 64 + lane) * 8);
      const uint4 q2 = *reinterpret_cast<const uint4*>(A + (2 * 64 + lane) * 8), q3 = *reinterpret_cast<const uint4*>(A + (3 * 64 + lane) * 8);
      const uint4 q4 = *reinterpret_cast<const uint4*>(A + (4 * 64 + lane) * 8), q5 = *reinterpret_cast<const uint4*>(A + (5 * 64 + lane) * 8);
      const uint4 q6 = *reinterpret_cast<const uint4*>(A + (6 * 64 + lane) * 8), q7 = *reinterpret_cast<const uint4*>(A + (7 * 64 + lane) * 8);
      *reinterpret_cast<uint4*>(sr + (0 * 64 + lane) * 8) = q0; *reinterpret_cast<uint4*>(sr + (1 * 64 + lane) * 8) = q1;
      *reinterpret_cast<uint4*>(sr + (2 * 64 + lane) * 8) = q2; *reinterpret_cast<uint4*>(sr + (3 * 64 + lane) * 8) = q3;
      *reinterpret_cast<uint4*>(sr + (4 * 64 + lane) * 8) = q4; *reinterpret_cast<uint4*>(sr + (5 * 64 + lane) * 8) = q5;
      *reinterpret_cast<uint4*>(sr + (6 * 64 + lane) * 8) = q6; *reinterpret_cast<uint4*>(sr + (7 * 64 + lane) * 8) = q7;
    }
    __builtin_amdgcn_wave_barrier();
    const int l0 = lane * 16;
    float alt = 0.f;
    uint32_t oa[8], ob[8];
#pragma unroll
    for (int half = 0; half < 2; ++half) {
      const bf16_t* base = sr + half * 2048;
      const uint4 fa = *reinterpret_cast<const uint4*>(base + l0), fb = *reinterpret_cast<const uint4*>(base + l0 + 8);
      const uint4 ra = *reinterpret_cast<const uint4*>(base + 2032 - l0), rb = *reinterpret_cast<const uint4*>(base + 2040 - l0);
      const float r16 = (lane > 0) ? bf2f(base[2048 - l0]) : 0.f;
      const uint32_t fw[8] = {fa.x, fa.y, fa.z, fa.w, fb.x, fb.y, fb.z, fb.w};
      const uint32_t rw[8] = {ra.x, ra.y, ra.z, ra.w, rb.x, rb.y, rb.z, rb.w};
      float v[16];
#pragma unroll
      for (int i = 0; i < 16; ++i) {
        const float fwv = (i & 1) ? bfhi(fw[i >> 1]) : bflo(fw[i >> 1]);
        const int j = 16 - i;
        const float rv = (i == 0) ? r16 : ((j & 1) ? bfhi(rw[j >> 1]) : bflo(rw[j >> 1]));
        if (half == 0) v[i] = (lane == 0 && i == 0) ? fwv : fwv + rv;
        else v[i] = (lane == 0 && i == 0) ? 0.f : fwv - rv;
      }
      if (half == 0) {
#pragma unroll
        for (int i = 0; i < 16; ++i) alt += (i & 1) ? -v[i] : v[i];
#pragma unroll
        for (int i = 0; i < 8; ++i) oa[i] = pack2(v[2 * i], v[2 * i + 1]);
      } else {
#pragma unroll
        for (int i = 0; i < 8; ++i) ob[i] = pack2(v[2 * i], v[2 * i + 1]);
      }
    }
    *reinterpret_cast<uint4*>(F + l0) = uint4{oa[0], oa[1], oa[2], oa[3]};
    *reinterpret_cast<uint4*>(F + l0 + 8) = uint4{oa[4], oa[5], oa[6], oa[7]};
    *reinterpret_cast<uint4*>(F + 1024 + l0) = uint4{ob[0], ob[1], ob[2], ob[3]};
    *reinterpret_cast<uint4*>(F + 1024 + l0 + 8) = uint4{ob[4], ob[5], ob[6], ob[7]};
    alt = wave_sum_fast(alt) + bf2f(sr[1024]);
    if (lane == 0) { const int b = row >> 10, ch = row & 1023; p.ycat[((size_t)b * L + 1024) * D + ch] = f2bf(alt); }
  }
}
__device__ void phase_ssm_pre(const Params& p, int bid, int nb, char* smem) {
  const int tid = threadIdx.x;
  dft_fold_rows(p, bid, nb, smem);
  for (int t = bid; t < 3072 + 384; t += nb) ssm_pre_tile(p, t, smem);
  for (int i = bid * NTHREADS + tid; i < (T + TC) * 32; i += nb * NTHREADS) {
    const bool isx = i < T * 32;
    const int ii = isx ? i : i - T * 32;
    const int t = ii >> 5, j = ii & 31;
    const float v = (isx ? p.dtraw : p.dtraw_c)[ii];
    float* df = isx ? p.dtf : p.dtf_c;
    float* db = isx ? p.dtb : p.dtb_c;
    if (j < 16) df[t * 16 + j] = softplus_f(v + p.dt_bias_f[j]);
    else db[t * 16 + (j - 16)] = softplus_f(v + p.dt_bias_b[j - 16]);
  }
}

__device__ __forceinline__ int swz16(int row, int chunk) { return row * 256 + ((chunk ^ (row & 15)) << 4); }
__device__ __forceinline__ int swz8(int row, int chunk) { return row * 128 + ((chunk ^ (row & 7)) << 4); }

#define LDS_BARRIER() asm volatile("s_waitcnt lgkmcnt(0)\n\ts_barrier" ::: "memory")
__device__ void ssd_task(const Params& p, int task, char* smem) {
  const int dir = task & 1, ph = (task >> 1) & 1, h = (task >> 2) & 15, b = task >> 6;
  const int tid = opaque_tid(), lane = tid & 63, w = tid >> 6;
  const int g = h >> 3, lr0 = lane & 15, lq0 = lane >> 4;
  const float a = -__expf(dir ? p.a_log_b[h] : p.a_log_f[h]);
  char* sCc = smem; char* sBc = smem + 16384; char* sBT = smem + 32768; char* sXT = smem + 49152; char* sHb = smem + 57344;
  float* se = reinterpret_cast<float*>(smem + 73728);
  float* sdt = se + 64; float* sw = se + 128; float* sy = se + 192; float* stot = se + 256;
  bf16_t* yo = reinterpret_cast<bf16_t*>(dir ? p.yb : p.yf);
  f32x4 H[2][2];
#pragma unroll
  for (int i = 0; i < 2; ++i)
#pragma unroll
    for (int j = 0; j < 2; ++j) H[i][j] = f32x4{0.f, 0.f, 0.f, 0.f};
  __syncthreads();
  for (int i = tid; i < 512; i += NTHREADS) reinterpret_cast<uint4*>(sHb)[i] = uint4{0, 0, 0, 0};

  const int crow = tid >> 4, cch = tid & 15;
  const int trow = tid >> 3, tch = tid & 7;
  uint4 rC0, rC1, rC2, rC3, rB0, rB1, rB2, rB3, rT0, rT1, rT2, rT3, rX;
  rC0 = rC1 = rC2 = rC3 = rB0 = rB1 = rB2 = rB3 = uint4{0, 0, 0, 0};
  float rdt = 0.f;
#define SSD_PARAMS(st_)                                                                                                   \
  const bool isctx_ = (st_) < 4;                                                                                          \
  const int nch_ = isctx_ ? 4 : 32, ci_ = isctx_ ? (st_) : (st_) - 4;                                                     \
  const int c_ = dir ? (nch_ - 1 - ci_) : ci_;                                                                            \
  const int seqlen_ = isctx_ ? CTX : L;                                                                                   \
  const size_t trow0_ = isctx_ ? ((size_t)T + (size_t)b * CTX + c_ * 64) : ((size_t)b * L + c_ * 64);                     \
  const size_t drow0_ = (size_t)b * seqlen_ + c_ * 64;                                                                    \
  const float* dtp_ = isctx_ ? (dir ? p.dtb_c : p.dtf_c) : (dir ? p.dtb : p.dtf);                                         \
  const bf16_t* cm_ = (isctx_ ? p.act_cm_c : p.act_cm_x) + (size_t)b * 1280 * seqlen_ + c_ * 64;
#define SSD_PREFETCH(st_)                                                                                                 \
  do {                                                                                                                    \
    SSD_PARAMS(st_)                                                                                                       \
    if (w == 0) rdt = dtp_[(drow0_ + lane) * 16 + h];                                                                     \
    if (!isctx_) {                                                                                                        \
      const bf16_t* src = p.act_tm + (trow0_ + crow) * DXBC + g * 128 + cch * 8;                                          \
      rC0 = *reinterpret_cast<const uint4*>(src + 1280);             rB0 = *reinterpret_cast<const uint4*>(src + 1024);   \
      rC1 = *reinterpret_cast<const uint4*>(src + 16 * DXBC + 1280); rB1 = *reinterpret_cast<const uint4*>(src + 16 * DXBC + 1024); \
      rC2 = *reinterpret_cast<const uint4*>(src + 32 * DXBC + 1280); rB2 = *reinterpret_cast<const uint4*>(src + 32 * DXBC + 1024); \
      rC3 = *reinterpret_cast<const uint4*>(src + 48 * DXBC + 1280); rB3 = *reinterpret_cast<const uint4*>(src + 48 * DXBC + 1024); \
    }                                                                                                                     \
    const bf16_t* srt = cm_ + (size_t)(1024 + g * 128 + trow) * seqlen_ + tch * 8;                                        \
    rT0 = *reinterpret_cast<const uint4*>(srt);                                                                           \
    rT1 = *reinterpret_cast<const uint4*>(srt + (size_t)32 * seqlen_);                                                    \
    rT2 = *reinterpret_cast<const uint4*>(srt + (size_t)64 * seqlen_);                                                    \
    rT3 = *reinterpret_cast<const uint4*>(srt + (size_t)96 * seqlen_);                                                    \
    rX = *reinterpret_cast<const uint4*>(cm_ + (size_t)(h * 64 + ph * 32 + trow) * seqlen_ + tch * 8);                    \
  } while (0)

  for (int step = 0; step < 36; ++step) {
    SSD_PREFETCH(step);
    const bool isctx = step < 4;
    const int c = dir ? ((isctx ? 4 : 32) - 1 - (isctx ? step : step - 4)) : (isctx ? step : step - 4);
    const size_t trow0 = (size_t)b * L + c * 64;
    int lr = lr0, lq = lq0;
    asm volatile("" : "+v"(lr), "+v"(lq));
    LDS_BARRIER();
    if (w == 0) {
      const float dtv = rdt;
      const float adt = a * dtv;
      float v = adt;
      v += __builtin_bit_cast(float, __builtin_amdgcn_update_dpp(0, __builtin_bit_cast(int, v), 0x111, 0xF, 0xF, false));
      v += __builtin_bit_cast(float, __builtin_amdgcn_update_dpp(0, __builtin_bit_cast(int, v), 0x112, 0xF, 0xF, false));
      v += __builtin_bit_cast(float, __builtin_amdgcn_update_dpp(0, __builtin_bit_cast(int, v), 0x114, 0xF, 0xF, false));
      v += __builtin_bit_cast(float, __builtin_amdgcn_update_dpp(0, __builtin_bit_cast(int, v), 0x118, 0xF, 0xF, false));
      v += __builtin_bit_cast(float, __builtin_amdgcn_update_dpp(0, __builtin_bit_cast(int, v), 0x142, 0xA, 0xF, false));
      v += __builtin_bit_cast(float, __builtin_amdgcn_update_dpp(0, __builtin_bit_cast(int, v), 0x143, 0xC, 0xF, false));
      const float etot = __builtin_bit_cast(float, __builtin_amdgcn_readlane(__builtin_bit_cast(int, v), 63));
      if (dir) v = etot - v + adt;
      se[lane] = v; sdt[lane] = dtv; sw[lane] = dtv * __expf(etot - v); sy[lane] = __expf(v);
      if (lane == 0) stot[0] = etot;
    }
    if (!isctx) {
      const int oc = swz16(crow, cch);
      *reinterpret_cast<uint4*>(sCc + oc) = rC0;         *reinterpret_cast<uint4*>(sBc + oc) = rB0;
      *reinterpret_cast<uint4*>(sCc + oc + 4096) = rC1;  *reinterpret_cast<uint4*>(sBc + oc + 4096) = rB1;
      *reinterpret_cast<uint4*>(sCc + oc + 8192) = rC2;  *reinterpret_cast<uint4*>(sBc + oc + 8192) = rB2;
      *reinterpret_cast<uint4*>(sCc + oc + 12288) = rC3; *reinterpret_cast<uint4*>(sBc + oc + 12288) = rB3;
    }
    {
      const int ot = swz8(trow, tch);
      *reinterpret_cast<uint4*>(sBT + ot) = rT0;
      *reinterpret_cast<uint4*>(sBT + ot + 4096) = rT1;
      *reinterpret_cast<uint4*>(sBT + ot + 8192) = rT2;
      *reinterpret_cast<uint4*>(sBT + ot + 12288) = rT3;
      *reinterpret_cast<uint4*>(sXT + ot) = rX;
    }
    LDS_BARRIER();
    const float etot = stot[0];
    if (!isctx) {
      f32x4 G[4];
      bf16x8 ca[4];
#pragma unroll
      for (int j = 0; j < 4; ++j) G[j] = f32x4{0.f, 0.f, 0.f, 0.f};
#pragma unroll
      for (int kk = 0; kk < 4; ++kk) ca[kk] = *reinterpret_cast<const bf16x8*>(sCc + swz16(16 * w + lr, kk * 4 + lq));
#pragma unroll
      for (int kk = 0; kk < 4; ++kk)
#pragma unroll
        for (int j = 0; j < 4; ++j) {
          bf16x8 bb = *reinterpret_cast<const bf16x8*>(sBc + swz16(16 * j + lr, kk * 4 + lq));
          G[j] = __builtin_amdgcn_mfma_f32_16x16x32_bf16(ca[kk], bb, G[j], 0, 0, 0);
        }
      LDS_BARRIER();
      float el[4];
#pragma unroll
      for (int r = 0; r < 4; ++r) el[r] = se[16 * w + lq * 4 + r];
#pragma unroll
      for (int j = 0; j < 4; ++j) {
        const int s_ = 16 * j + lr;
        const float es = se[s_], ds = sdt[s_];
#pragma unroll
        for (int r = 0; r < 4; ++r) {
          const int l = 16 * w + lq * 4 + r;
          const bool keep = dir ? (s_ >= l) : (s_ <= l);
          const float m = keep ? G[j][r] * __expf(el[r] - es) * ds : 0.f;
          *reinterpret_cast<bf16_t*>(sBc + swz8(l, s_ >> 3) + (s_ & 7) * 2) = f2bf(m);
        }
      }
      LDS_BARRIER();
      f32x4 Y[2], Yo[2];
#pragma unroll
      for (int j = 0; j < 2; ++j) { Y[j] = f32x4{0.f, 0.f, 0.f, 0.f}; Yo[j] = f32x4{0.f, 0.f, 0.f, 0.f}; }
#pragma unroll
      for (int kk = 0; kk < 2; ++kk) {
        bf16x8 ma = *reinterpret_cast<const bf16x8*>(sBc + swz8(16 * w + lr, kk * 4 + lq));
#pragma unroll
        for (int j = 0; j < 2; ++j) {
          bf16x8 xb = *reinterpret_cast<const bf16x8*>(sXT + swz8(16 * j + lr, kk * 4 + lq));
          Y[j] = __builtin_amdgcn_mfma_f32_16x16x32_bf16(ma, xb, Y[j], 0, 0, 0);
        }
      }
#pragma unroll
      for (int kk = 0; kk < 4; ++kk)
#pragma unroll
        for (int j = 0; j < 2; ++j) {
          bf16x8 hb = *reinterpret_cast<const bf16x8*>(sHb + swz16(16 * j + lr, kk * 4 + lq));
          Yo[j] = __builtin_amdgcn_mfma_f32_16x16x32_bf16(ca[kk], hb, Yo[j], 0, 0, 0);
        }
      float syl[4];
#pragma unroll
      for (int r = 0; r < 4; ++r) syl[r] = sy[16 * w + lq * 4 + r];
#pragma unroll
      for (int j = 0; j < 2; ++j)
#pragma unroll
        for (int r = 0; r < 4; ++r) {
          const int l = 16 * w + lq * 4 + r;
          yo[(trow0 + l) * 1024 + h * 64 + ph * 32 + 16 * j + lr] = f2bf(Y[j][r] + syl[r] * Yo[j][r]);
        }
    }
    {
      const float dec = __expf(etot);
#pragma unroll
      for (int i = 0; i < 2; ++i)
#pragma unroll
        for (int j = 0; j < 2; ++j) H[i][j] *= dec;
#pragma unroll
      for (int kk = 0; kk < 2; ++kk) {
        const int s0 = kk * 32 + lq * 8;
        const float4 w0 = *reinterpret_cast<const float4*>(sw + s0), w1 = *reinterpret_cast<const float4*>(sw + s0 + 4);
        bf16x8 xs[2];
#pragma unroll
        for (int i = 0; i < 2; ++i) {
          const bf16x8 xa = *reinterpret_cast<const bf16x8*>(sXT + swz8(16 * i + lr, kk * 4 + lq));
          xs[i][0] = (short)f2bf(bf2f((bf16_t)xa[0]) * w0.x); xs[i][1] = (short)f2bf(bf2f((bf16_t)xa[1]) * w0.y);
          xs[i][2] = (short)f2bf(bf2f((bf16_t)xa[2]) * w0.z); xs[i][3] = (short)f2bf(bf2f((bf16_t)xa[3]) * w0.w);
          xs[i][4] = (short)f2bf(bf2f((bf16_t)xa[4]) * w1.x); xs[i][5] = (short)f2bf(bf2f((bf16_t)xa[5]) * w1.y);
          xs[i][6] = (short)f2bf(bf2f((bf16_t)xa[6]) * w1.z); xs[i][7] = (short)f2bf(bf2f((bf16_t)xa[7]) * w1.w);
        }
#pragma unroll
        for (int j = 0; j < 2; ++j) {
          const bf16x8 bt = *reinterpret_cast<const bf16x8*>(sBT + swz8(16 * (2 * w + j) + lr, kk * 4 + lq));
#pragma unroll
          for (int i = 0; i < 2; ++i) H[i][j] = __builtin_amdgcn_mfma_f32_16x16x32_bf16(xs[i], bt, H[i][j], 0, 0, 0);
        }
      }
    }
    LDS_BARRIER();
#pragma unroll
    for (int i = 0; i < 2; ++i)
#pragma unroll
      for (int j = 0; j < 2; ++j) {
        const int n = 16 * (2 * w + j) + lr;
#pragma unroll
        for (int r = 0; r < 4; ++r) {
          const int pr = 16 * i + lq * 4 + r;
          *reinterpret_cast<bf16_t*>(sHb + swz16(pr, n >> 3) + (n & 7) * 2) = f2bf(H[i][j][r]);
        }
      }
  }
#undef SSD_PREFETCH
#undef SSD_PARAMS
}

#undef LDS_BARRIER
__device__ void phase_ssd_dft(const Params& p, int bid, int nb, char* smem) {
  for (int t = bid; t < 256; t += nb) ssd_task(p, t, smem);
  int* stile = reinterpret_cast<int*>(smem + 75776);
  for (;;) {
    __syncthreads();
    if (threadIdx.x == 0) *stile = (int)atomicAdd(p.ctr, 1u);
    __syncthreads();
    const int t = *stile;
    if (t >= 4 * 8 * 8) break;
    const int b = t >> 6, tm = (t & 63) >> 3, tn = t & 7;
    const bf16_t* Fb = p.Fs + (size_t)b * 1024 * 2048;
    f32x4 accC[4][4], accS[4][4];
    gemm_mainloop(p.dftm, 2048, Fb, 2048, 1024, tm * 128, tn * 128, accC, smem);
    gemm_mainloop(p.dftm + 1024, 2048, Fb + 1024, 2048, 1024, tm * 128, tn * 128, accS, smem);
    const int lane = threadIdx.x & 63, w = threadIdx.x >> 6, wm = w >> 1, wn = w & 1;
#pragma unroll
    for (int i = 0; i < 4; ++i) {
      int lq_ = lane >> 4, lr_ = lane & 15;
      asm volatile("" : "+v"(lq_), "+v"(lr_));
#pragma unroll
      for (int j = 0; j < 4; ++j) {
        const int k0 = tm * 128 + wm * 64 + i * 16 + lq_ * 4;
        const int ch = tn * 128 + wn * 64 + j * 16 + lr_;
        const float a = bf2f(p.ABt[((size_t)b * 1024 + ch) * 4096 + 1024]);
#pragma unroll
        for (int r = 0; r < 4; ++r) {
          const int k = k0 + r;
          const float as = (k & 1) ? -a : a;
          const float c = accC[i][j][r], sn = accS[i][j][r];
          p.ycat[((size_t)b * L + k) * D + ch] = f2bf(c - sn + as);
          if (k > 0) p.ycat[((size_t)b * L + (L - k)) * D + ch] = f2bf(c + sn + as);
        }
      }
    }
  }
  for (;;) {
    __syncthreads();
    if (threadIdx.x == 0) *stile = (int)atomicAdd(p.ctr + 8, 1u);
    __syncthreads();
    const int q4 = *stile;
    if (q4 >= (1024 + 1536) / 4) break;
#pragma unroll 1
    for (int q = q4 * 4; q < q4 * 4 + 4; ++q) {
      if (q < 512) convert_u_rows(p, q);
      else if (q < 1024) convert_v_units(p, (size_t)(q - 512) * 4096, (size_t)(q - 511) * 4096);
      else if (q < 1024 + 1024) { const int q1 = q - 1024; transpose_convert_task(p.w_out, D, 0, D, p.w_out_t, q1 / 32, q1 % 32, reinterpret_cast<float*>(smem)); }
      else { const int q2 = q - 2048; transpose_convert_task(p.w_query, 1024, 0, D, p.w_q_t, q2 / 16, q2 % 16, reinterpret_cast<float*>(smem)); }
    }
  }
}

__device__ void phase_ssm_post(const Params& p, int bid, int nb, char* smem) {
  const int lane = threadIdx.x & 63, w = threadIdx.x >> 6;
  for (int t = bid * 4 + w; t < T; t += nb * 4) {
    float y[4][4];
    float ss0 = 0.f, ss1 = 0.f;
#pragma unroll
    for (int c = 0; c < 4; ++c) {
      const int c0 = c * 256 + lane * 4;
      const int h = c0 >> 6;
      const float dsk = p.d_skip_f[h] + p.d_skip_b[h];
      const uint2 aq = *reinterpret_cast<const uint2*>(reinterpret_cast<const bf16_t*>(p.yf) + (size_t)t * 1024 + c0);
      const uint2 bb = *reinterpret_cast<const uint2*>(reinterpret_cast<const bf16_t*>(p.yb) + (size_t)t * 1024 + c0);
      const float4 a = float4{bflo(aq.x), bfhi(aq.x), bflo(aq.y), bfhi(aq.y)};
      const float4 bq = float4{bflo(bb.x), bfhi(bb.x), bflo(bb.y), bfhi(bb.y)};
      const uint2 xq = *reinterpret_cast<const uint2*>(p.act_tm + (size_t)t * DXBC + c0);
      const uint2 zz = *reinterpret_cast<const uint2*>(p.z + (size_t)t * 1024 + c0);
      y[c][0] = (a.x + bq.x + dsk * bflo(xq.x)) * silu_f(bflo(zz.x));
      y[c][1] = (a.y + bq.y + dsk * bfhi(xq.x)) * silu_f(bfhi(zz.x));
      y[c][2] = (a.z + bq.z + dsk * bflo(xq.y)) * silu_f(bflo(zz.y));
      y[c][3] = (a.w + bq.w + dsk * bfhi(xq.y)) * silu_f(bfhi(zz.y));
      const float q = y[c][0] * y[c][0] + y[c][1] * y[c][1] + y[c][2] * y[c][2] + y[c][3] * y[c][3];
      if (c < 2) ss0 += q; else ss1 += q;
    }
    ss0 = wave_sum_fast(ss0); ss1 = wave_sum_fast(ss1);
    const float r0 = rsqrtf(ss0 * (1.f / 512.f) + EPS), r1 = rsqrtf(ss1 * (1.f / 512.f) + EPS);
    uint2 fq[4];
    float am = 0.f;
#pragma unroll
    for (int c = 0; c < 4; ++c) {
      const int c0 = c * 256 + lane * 4;
      fq[c] = *reinterpret_cast<const uint2*>(p.ycat + (size_t)t * D + c0);
      am = fmaxf(am, fmaxf(fmaxf(fabsf(bflo(fq[c].x)), fabsf(bfhi(fq[c].x))), fmaxf(fabsf(bflo(fq[c].y)), fabsf(bfhi(fq[c].y)))));
      const float rstd = (c < 2) ? r0 : r1;
      const float4 nw = *reinterpret_cast<const float4*>(p.ssm_norm_w + c0);
      y[c][0] *= rstd * nw.x; y[c][1] *= rstd * nw.y; y[c][2] *= rstd * nw.z; y[c][3] *= rstd * nw.w;
      am = fmaxf(am, fmaxf(fmaxf(fabsf(y[c][0]), fabsf(y[c][1])), fmaxf(fabsf(y[c][2]), fabsf(y[c][3]))));
    }
    am = wave_max_fast(am);
    const float inv = (am > 0.f) ? 127.f / am : 0.f;
#pragma unroll
    for (int c = 0; c < 4; ++c) {
      const int c0 = c * 256 + lane * 4;
      *reinterpret_cast<uint32_t*>(p.ycat8 + (size_t)t * D + c0) =
          pack_i8x4(bflo(fq[c].x) * inv, bfhi(fq[c].x) * inv, bflo(fq[c].y) * inv, bfhi(fq[c].y) * inv);
      *reinterpret_cast<uint32_t*>(p.ycat8 + (size_t)t * D + 1024 + c0) = pack_i8x4(y[c][0] * inv, y[c][1] * inv, y[c][2] * inv, y[c][3] * inv);
    }
    if (lane == 0) p.yscale[t] = am * (1.f / 127.f);
  }
  quant_weight_rows_i8(p.w_out_t, p.wo8, p.woscale, D, bid, nb);
}

__device__ void phase_outproj(const Params& p, int bid, int nb, char* smem) {
  const bool aware = (nb & 7) == 0;
  const int start = aware ? (bid >> 3) : bid, step = aware ? (nb >> 3) : nb, end = aware ? 64 : 512;
  const bf16_t* a8 = reinterpret_cast<const bf16_t*>(p.ycat8);
  const bf16_t* b8 = reinterpret_cast<const bf16_t*>(p.wo8);
  for (int it = start; it < end; it += step) {
    const int x = aware ? (bid & 7) : (it >> 6), s_ = aware ? it : (it & 63);
    EpiBf16 epi{reinterpret_cast<bf16_t*>(p.y_x), D};
    gemm_tile_n256<true>(a8, D / 2, b8, D / 2, D / 2, (8 * x + (s_ & 7)) * 128, (s_ >> 3) * 256, epi, smem, p.yscale, p.woscale);
  }
}
__device__ void phase_postmix(const Params& p, int bid, int nb, char* smem) {
  const int lane = threadIdx.x & 63, w = threadIdx.x >> 6;
  for (int t = bid * 4 + w; t < T; t += nb * 4) {
    const int b = t / L;
    float4 y[8];
    float ss = 0.f;
#pragma unroll
    for (int c = 0; c < 8; ++c) {
      {
        const uint2 yq = *reinterpret_cast<const uint2*>(reinterpret_cast<const bf16_t*>(p.y_x) + (size_t)t * D + c * 256 + lane * 4);
        y[c] = float4{bflo(yq.x), bfhi(yq.x), bflo(yq.y), bfhi(yq.y)};
      }
      ss += y[c].x * y[c].x + y[c].y * y[c].y + y[c].z * y[c].z + y[c].w * y[c].w;
    }
    ss = wave_sum_fast(ss);
    const float rstd = rsqrtf(ss * (1.f / D) + EPS);
    const float* gm = p.mod + (size_t)b * NMOD + 2 * D;
    float ss1 = 0.f;
#pragma unroll
    for (int c = 0; c < 8; ++c) {
      const int e0 = c * 256 + lane * 4;
      const float4 xv = *reinterpret_cast<const float4*>(p.x + (size_t)t * D + e0);
      const float4 g4 = *reinterpret_cast<const float4*>(gm + e0), gp = *reinterpret_cast<const float4*>(p.g_post_mix + e0);
      y[c].x = xv.x + g4.x * (y[c].x * rstd * gp.x); y[c].y = xv.y + g4.y * (y[c].y * rstd * gp.y);
      y[c].z = xv.z + g4.z * (y[c].z * rstd * gp.z); y[c].w = xv.w + g4.w * (y[c].w * rstd * gp.w);
      ss1 += y[c].x * y[c].x + y[c].y * y[c].y + y[c].z * y[c].z + y[c].w * y[c].w;
    }
    if (lane == 0) p.partial[t] = rstd;
    ss1 = wave_sum_fast(ss1);
    const float rstd1 = rsqrtf(ss1 * (1.f / D) + EPS);
    const float* sf = p.mod + (size_t)b * NMOD + 3 * D;
    const float* cf = p.mod + (size_t)b * NMOD + 4 * D;
    float am = 0.f;
#pragma unroll
    for (int c = 0; c < 8; ++c) {
      const int e0 = c * 256 + lane * 4;
      const float4 g = *reinterpret_cast<const float4*>(p.g_pre_ffn + e0);
      const float4 s4 = *reinterpret_cast<const float4*>(cf + e0), h4 = *reinterpret_cast<const float4*>(sf + e0);
      y[c].x = y[c].x * rstd1 * g.x * (1.f + s4.x) + h4.x; y[c].y = y[c].y * rstd1 * g.y * (1.f + s4.y) + h4.y;
      y[c].z = y[c].z * rstd1 * g.z * (1.f + s4.z) + h4.z; y[c].w = y[c].w * rstd1 * g.w * (1.f + s4.w) + h4.w;
      am = fmaxf(am, fmaxf(fmaxf(fabsf(y[c].x), fabsf(y[c].y)), fmaxf(fabsf(y[c].z), fabsf(y[c].w))));
      uint2 pk;
      pk.x = pack2(y[c].x, y[c].y);
      pk.y = pack2(y[c].z, y[c].w);
      *reinterpret_cast<uint2*>(p.hx + (size_t)t * D + e0) = pk;
    }
    am = wave_max_fast(am);
    const float inv = (am > 0.f) ? 127.f / am : 0.f;
#pragma unroll
    for (int c = 0; c < 8; ++c)
      *reinterpret_cast<uint32_t*>(p.hx8a + (size_t)t * D + c * 256 + lane * 4) = pack_i8x4(y[c].x * inv, y[c].y * inv, y[c].z * inv, y[c].w * inv);
    if (lane == 0) p.ascale[t] = am * (1.f / 127.f);
  }
}

__device__ __forceinline__ uint32_t mono_key(float f) {
  uint32_t u = __float_as_uint(f);
  return (u & 0x80000000u) ? ~u : (u | 0x80000000u);
}
__device__ __forceinline__ void ins16(uint32_t (&Lk)[16], uint32_t x) {
#pragma unroll
  for (int i = 0; i < 16; ++i) { uint32_t hi = max(Lk[i], x); x = min(Lk[i], x); Lk[i] = hi; }
}
__device__ __forceinline__ float unmono_key(uint32_t k) {
  return __uint_as_float((k & 0x80000000u) ? (k ^ 0x80000000u) : ~k);
}
typedef __attribute__((ext_vector_type(16))) float f32x16;
__device__ void phase_q_route(const Params& p, int bid, int nb, char* smem) {
  const int tid = opaque_tid(), lane = tid & 63, w = tid >> 6;
  const int wm = w >> 1, wn = w & 1, lr = lane & 15, lq = lane >> 4;
  const int l31 = lane & 31, lh = lane >> 5;
  for (int tile0 = bid; tile0 < 512; tile0 += nb) {
    const int tile = ((nb & 7) == 0 && nb >= 512) ? (((tile0 & 7) * 8 + ((tile0 >> 3) & 7)) * 8 + (tile0 >> 6)) : tile0;
    const int h = tile & 7, m0 = (tile >> 3) * 128;
    {
      f32x4 acc[4][4];
      gemm_mainloop(p.hx, D, p.w_q_t, D, D, m0, h * 128, acc, smem);
#pragma unroll
      for (int i = 0; i < 4; ++i)
#pragma unroll
        for (int j = 0; j < 4; ++j)
#pragma unroll
          for (int r = 0; r < 4; ++r) {
            const int row = wm * 64 + i * 16 + lq * 4 + r, col = wn * 64 + j * 16 + lr;
            *reinterpret_cast<bf16_t*>(smem + swz16(row, col >> 3) + (col & 7) * 2) = f2bf(acc[i][j][r]);
          }
    }
#pragma unroll 4
    for (int r = 0; r < 16; ++r) {
      const int id = tid + 256 * r, row = id >> 4, c4 = id & 15;
      const float* src = ((row < 128) ? p.sk1 : p.sk2) + ((size_t)(h * 128 + (row & 127)) * 64 + c4 * 4);
      const float4 v = *reinterpret_cast<const float4*>(src);
      uint2 pk; pk.x = pack2(v.x, v.y); pk.y = pack2(v.z, v.w);
      *reinterpret_cast<uint2*>(smem + 32768 + swz8(row, c4 >> 1) + (c4 & 1) * 8) = pk;
    }
    __syncthreads();
    uint32_t L1[16], L2[16];
#pragma unroll
    for (int sd = 0; sd < 2; ++sd) {
      uint32_t Lk[16];
#pragma unroll
      for (int i = 0; i < 16; ++i) Lk[i] = 0u;
      const uint32_t kb = (uint32_t)(lh * 4);
#pragma unroll
      for (int ih = 0; ih < 2; ++ih) {
        f32x16 Sa[2];
#pragma unroll
        for (int i = 0; i < 2; ++i)
#pragma unroll
          for (int g2 = 0; g2 < 16; ++g2) Sa[i][g2] = 0.f;
#pragma unroll
        for (int ks = 0; ks < 4; ++ks) {
          const bf16x8 qb = *reinterpret_cast<const bf16x8*>(smem + swz16(w * 32 + l31, sd * 8 + ks * 2 + lh));
#pragma unroll
          for (int i = 0; i < 2; ++i) {
            const bf16x8 ka = *reinterpret_cast<const bf16x8*>(smem + 32768 + swz8(sd * 128 + (ih * 2 + i) * 32 + l31, ks * 2 + lh));
            Sa[i] = __builtin_amdgcn_mfma_f32_32x32x16_bf16(ka, qb, Sa[i], 0, 0, 0);
          }
        }
#pragma unroll
        for (int i = 0; i < 2; ++i)
#pragma unroll
          for (int g2 = 0; g2 < 16; ++g2)
            ins16(Lk, (mono_key(Sa[i][g2]) & ~0x7Fu) | (uint32_t)((ih * 2 + i) * 32 + (g2 & 3) + 8 * (g2 >> 2)) | kb);
      }
#pragma unroll
      for (int i = 0; i < 8; ++i) {
        const uint32_t t1 = (uint32_t)__shfl_xor((int)Lk[15 - i], 32), t2 = (uint32_t)__shfl_xor((int)Lk[i], 32);
        Lk[i] = max(Lk[i], t1); Lk[15 - i] = max(Lk[15 - i], t2);
      }
#pragma unroll
      for (int dd = 8; dd >= 1; dd >>= 1)
#pragma unroll
        for (int i = 0; i < 16; ++i)
          if ((i & dd) == 0) { const uint32_t hi = max(Lk[i], Lk[i + dd]), lo = min(Lk[i], Lk[i + dd]); Lk[i] = hi; Lk[i + dd] = lo; }
#pragma unroll
      for (int r = 0; r < 16; ++r) { if (sd == 0) L1[r] = Lk[r]; else L2[r] = Lk[r]; }
    }
    __syncthreads();
    uint32_t* ib = reinterpret_cast<uint32_t*>(smem) + w * 1088 + l31 * 34;
    if (lh == 0) {
#pragma unroll
      for (int r = 0; r < 16; ++r) { ib[r] = L1[r] & 127u; ib[16 + r] = L2[r] & 127u; }
    }
    float v1[16], v2[16];
#pragma unroll
    for (int r = 0; r < 16; ++r) { v1[r] = unmono_key(L1[r] & ~0x7Fu); v2[r] = unmono_key(L2[r] & ~0x7Fu); }
    uint32_t C[16];
#pragma unroll
    for (int i = 0; i < 16; ++i) C[i] = 0u;
#pragma unroll
    for (int a = 0; a < 16; ++a)
#pragma unroll
      for (int bq = 0; bq < 16; ++bq)
        if ((a + 1) * (bq + 1) <= 16) ins16(C, (mono_key(v1[a] + v2[bq]) & ~0xFFu) | (uint32_t)(a * 16 + bq));
    float ts[16]; int te[16];
    __builtin_amdgcn_wave_barrier();
#pragma unroll
    for (int r = 0; r < 16; ++r) {
      const uint32_t code = C[r] & 0xFFu;
      te[r] = (int)(ib[code >> 4] * 128u + ib[16 + (code & 15u)]);
      ts[r] = unmono_key(C[r] & ~0xFFu);
    }
    const float mx = ts[0];
    float den = 0.f;
#pragma unroll
    for (int r = 0; r < 16; ++r) { ts[r] = __expf(ts[r] - mx); den += ts[r]; }
    const float inv = 1.f / den;
    const size_t ob = (size_t)(m0 + w * 32 + l31) * 128 + h * 16;
    if (lh == 0) {
#pragma unroll
      for (int r = 0; r < 16; r += 4) *reinterpret_cast<int4*>(p.idx + ob + r) = int4{te[r], te[r + 1], te[r + 2], te[r + 3]};
    } else {
#pragma unroll
      for (int r = 0; r < 16; r += 4)
        *reinterpret_cast<float4*>(p.gate + ob + r) = float4{ts[r] * inv, ts[r + 1] * inv, ts[r + 2] * inv, ts[r + 3] * inv};
    }
    __syncthreads();
  }
}

typedef __attribute__((ext_vector_type(2))) float f32x2;
__device__ __forceinline__ void fp8x16_to_f32(const uint4 q, f32x2 (&o)[8]) {
  o[0] = __builtin_amdgcn_cvt_pk_f32_fp8((int)q.x, false); o[1] = __builtin_amdgcn_cvt_pk_f32_fp8((int)q.x, true);
  o[2] = __builtin_amdgcn_cvt_pk_f32_fp8((int)q.y, false); o[3] = __builtin_amdgcn_cvt_pk_f32_fp8((int)q.y, true);
  o[4] = __builtin_amdgcn_cvt_pk_f32_fp8((int)q.z, false); o[5] = __builtin_amdgcn_cvt_pk_f32_fp8((int)q.z, true);
  o[6] = __builtin_amdgcn_cvt_pk_f32_fp8((int)q.w, false); o[7] = __builtin_amdgcn_cvt_pk_f32_fp8((int)q.w, true);
}
__device__ __forceinline__ unsigned my_xcc_id() { return (unsigned)__builtin_amdgcn_s_getreg((3 << 11) | 20) & 7u; }

__device__ void phase_exp_u(const Params& p, char* smem) {
  const int tid = opaque_tid(), lane = tid & 63, w = tid >> 6;
  const int sub = lane >> 4, cc = lane & 15;
  const unsigned myx = my_xcc_id();
  int* sh = reinterpret_cast<int*>(smem);
  int* si = reinterpret_cast<int*>(smem + 64) + w * 256;
  float* pbuf = reinterpret_cast<float*>(p.ycat);
  {
    unsigned qcur = 0;
    for (;;) {
      __syncthreads();
      if (tid == 0) {
        int found = -1; unsigned fx = 0;
        for (; qcur < 8; ++qcur) {
          fx = (myx + qcur) & 7u;
          const int c = (int)atomicAdd(&p.ctr[16 + fx], 1u);
          if (c < 256) { found = c; break; }
        }
        sh[0] = found; sh[1] = (int)fx;
      }
      __syncthreads();
      const int chunk = sh[0];
      const unsigned x = (unsigned)sh[1];
      if (chunk < 0) break;
      for (int tt = 0; tt < 8; ++tt) {
        const int t = chunk * 32 + w * 8 + tt;
        __builtin_amdgcn_wave_barrier();
        si[lane] = p.idx[(size_t)t * 128 + lane]; si[64 + lane] = p.idx[(size_t)t * 128 + 64 + lane];
        __builtin_amdgcn_wave_barrier();
        const uint4 hq = *reinterpret_cast<const uint4*>(p.hx8a + (size_t)t * D + x * 256 + cc * 16);
        const uint8_t* ub = p.U8 + (size_t)x * ((size_t)16384 * 256) + cc * 16;
        uint4 qa[8], qb[8];
#define EU_LOAD(q_, bt_) _Pragma("unroll") for (int k = 0; k < 8; ++k) q_[k] = *reinterpret_cast<const uint4*>(ub + (size_t)si[((bt_) * 8 + k) * 4 + sub] * 256)
#define EU_COMP(q_, kb_)                                                                                                \
  _Pragma("unroll") for (int k = 0; k < 8; ++k) {                                                                       \
    int d = __builtin_amdgcn_sdot4((int)q_[k].x, (int)hq.x, 0, false);                                                  \
    int d1 = __builtin_amdgcn_sdot4((int)q_[k].y, (int)hq.y, 0, false);                                                 \
    d = __builtin_amdgcn_sdot4((int)q_[k].z, (int)hq.z, d, false);                                                      \
    d1 = __builtin_amdgcn_sdot4((int)q_[k].w, (int)hq.w, d1, false);                                                    \
    d += d1;                                                                                                            \
    d += dpp_movi<0xB1>(d); d += dpp_movi<0x4E>(d); d += dpp_movi<0x124>(d); d += dpp_movi<0x128>(d);                   \
    mine = (cc == (kb_) + k) ? d : mine;                                                                                \
  }
        int mine = 0;
        EU_LOAD(qa, 0); EU_LOAD(qb, 1);
        EU_COMP(qa, 0); EU_LOAD(qa, 2);
        EU_COMP(qb, 8); EU_LOAD(qb, 3);
        pbuf[((size_t)x * T + t) * 128 + cc * 4 + sub] = (float)mine;
        mine = 0;
        EU_COMP(qa, 0);
        EU_COMP(qb, 8);
        pbuf[((size_t)x * T + t) * 128 + (16 + cc) * 4 + sub] = (float)mine;
#undef EU_LOAD
#undef EU_COMP
      }
    }
  }
}

__device__ void phase_exp_v(const Params& p, char* smem) {
  const int tid = opaque_tid(), lane = tid & 63, w = tid >> 6;
  const int sub = lane >> 4, cc = lane & 15;
  const unsigned myx = my_xcc_id();
  int* sh = reinterpret_cast<int*>(smem);
  int* si = reinterpret_cast<int*>(smem + 64) + w * 256;
  float* sc = reinterpret_cast<float*>(si + 128);
  bf16_t* yfb = reinterpret_cast<bf16_t*>(p.y_x) + (size_t)T * D;
  {
    unsigned qcur = 0;
    for (;;) {
      __syncthreads();
      if (tid == 0) {
        int found = -1; unsigned fx = 0;
        for (; qcur < 8; ++qcur) {
          fx = (myx + qcur) & 7u;
          const int c = (int)atomicAdd(&p.ctr[32 + fx], 1u);
          if (c < 256) { found = c; break; }
        }
        sh[0] = found; sh[1] = (int)fx;
      }
      __syncthreads();
      const int chunk = sh[0];
      const unsigned x = (unsigned)sh[1];
      if (chunk < 0) break;
      int e0n = p.idx[(size_t)(chunk * 32 + w * 8) * 128 + lane], e1n = p.idx[(size_t)(chunk * 32 + w * 8) * 128 + 64 + lane];
      for (int tt = 0; tt < 8; ++tt) {
        const int t = chunk * 32 + w * 8 + tt;
        const int e0 = e0n, e1 = e1n;
        __builtin_amdgcn_wave_barrier();
        si[lane] = e0; si[64 + lane] = e1;
        __builtin_amdgcn_wave_barrier();
        f32x2 acc[8];
#pragma unroll
        for (int e = 0; e < 8; ++e) acc[e] = f32x2{0.f, 0.f};
        const uint8_t* vb = p.V8 + (size_t)x * ((size_t)16384 * 256) + cc * 16;
        uint4 qa[8], qb[8];
#define EV_LOAD(q_, bt_) _Pragma("unroll") for (int k = 0; k < 8; ++k) q_[k] = *reinterpret_cast<const uint4*>(vb + (size_t)si[((bt_) * 8 + k) * 4 + sub] * 256)
#define EV_COMP(q_, bt_)                                                                                                \
  _Pragma("unroll") for (int k = 0; k < 8; ++k) {                                                                       \
    f32x2 vf[8];                                                                                                        \
    fp8x16_to_f32(q_[k], vf);                                                                                           \
    const float cfk = sc[((bt_) * 8 + k) * 4 + sub];                                                                    \
    const f32x2 c2 = f32x2{cfk, cfk};                                                                                   \
    _Pragma("unroll") for (int e = 0; e < 8; ++e) acc[e] += c2 * vf[e];                                                 \
  }
        EV_LOAD(qa, 0); EV_LOAD(qb, 1);
        if (tt + 1 < 8) { e0n = p.idx[(size_t)(t + 1) * 128 + lane]; e1n = p.idx[(size_t)(t + 1) * 128 + 64 + lane]; }
        {
          const float* pb = reinterpret_cast<const float*>(p.ycat) + (size_t)t * 128;
          float d0 = 0.f, d1 = 0.f;
#pragma unroll
          for (int xs = 0; xs < 8; ++xs) { d0 += pb[(size_t)xs * T * 128 + lane]; d1 += pb[(size_t)xs * T * 128 + 64 + lane]; }
          const float hs = p.ascale[t];
          d0 *= p.uscale[e0] * hs; d1 *= p.uscale[e1] * hs;
          sc[lane] = p.gate[(size_t)t * 128 + lane] * 0.5f * d0 * (1.f + erff(d0 * 0.70710678118654752f));
          sc[64 + lane] = p.gate[(size_t)t * 128 + 64 + lane] * 0.5f * d1 * (1.f + erff(d1 * 0.70710678118654752f));
        }
        __builtin_amdgcn_wave_barrier();
        EV_COMP(qa, 0); EV_LOAD(qa, 2);
        EV_COMP(qb, 1); EV_LOAD(qb, 3);
        EV_COMP(qa, 2);
        EV_COMP(qb, 3);
#undef EV_LOAD
#undef EV_COMP
        {
          float* red = reinterpret_cast<float*>(smem + 8192) + w * 1280;
          float* mr = red + (sub * 16 + cc) * 20;
#pragma unroll
          for (int q4 = 0; q4 < 4; ++q4)
            *reinterpret_cast<float4*>(mr + q4 * 4) = float4{acc[q4 * 2].x, acc[q4 * 2].y, acc[q4 * 2 + 1].x, acc[q4 * 2 + 1].y};
          __builtin_amdgcn_wave_barrier();
          const int part = sub;
          float4 r0 = *reinterpret_cast<const float4*>(red + (0 * 16 + cc) * 20 + part * 4);
          float4 r1 = *reinterpret_cast<const float4*>(red + (1 * 16 + cc) * 20 + part * 4);
          float4 r2 = *reinterpret_cast<const float4*>(red + (2 * 16 + cc) * 20 + part * 4);
          float4 r3 = *reinterpret_cast<const float4*>(red + (3 * 16 + cc) * 20 + part * 4);
          const float sc512 = 1.f / 512.f;
          uint2 o4;
          o4.x = pack2((r0.x + r1.x + r2.x + r3.x) * sc512, (r0.y + r1.y + r2.y + r3.y) * sc512);
          o4.y = pack2((r0.z + r1.z + r2.z + r3.z) * sc512, (r0.w + r1.w + r2.w + r3.w) * sc512);
          *reinterpret_cast<uint2*>(yfb + (size_t)t * D + x * 256 + cc * 16 + part * 4) = o4;
          __builtin_amdgcn_wave_barrier();
        }
      }
    }
  }
}

__device__ void phase_exp_final(const Params& p, int bid, int nb, char* smem) {
  const int lane = threadIdx.x & 63, w = threadIdx.x >> 6;
  const bf16_t* ymix = reinterpret_cast<const bf16_t*>(p.y_x);
  const bf16_t* yf = reinterpret_cast<const bf16_t*>(p.y_x) + (size_t)T * D;
  for (int t = bid * 4 + w; t < T; t += nb * 4) {
    const int b = t / L;
    float4 y[8], xo[8];
#pragma unroll
    for (int c = 0; c < 8; ++c) {
      const uint2 yq = *reinterpret_cast<const uint2*>(yf + (size_t)t * D + c * 256 + lane * 4);
      y[c] = float4{bflo(yq.x), bfhi(yq.x), bflo(yq.y), bfhi(yq.y)};
      xo[c] = *reinterpret_cast<const float4*>(p.x + (size_t)t * D + c * 256 + lane * 4);
    }
    const float rmix = p.partial[t];
    float ss = 0.f;
#pragma unroll
    for (int c = 0; c < 8; ++c) ss += y[c].x * y[c].x + y[c].y * y[c].y + y[c].z * y[c].z + y[c].w * y[c].w;
    ss = wave_sum_fast(ss);
    const float rstd = rsqrtf(ss * (1.f / D) + EPS);
    const float* gfx = p.mod + (size_t)b * NMOD + 5 * D;
    const float* gm = p.mod + (size_t)b * NMOD + 2 * D;
#pragma unroll
    for (int c = 0; c < 8; ++c) {
      const int e0 = c * 256 + lane * 4;
      const uint2 mq = *reinterpret_cast<const uint2*>(ymix + (size_t)t * D + e0);
      const float4 m4 = float4{bflo(mq.x), bfhi(mq.x), bflo(mq.y), bfhi(mq.y)};
      const float4 g4 = *reinterpret_cast<const float4*>(gfx + e0), gp = *reinterpret_cast<const float4*>(p.g_post_ffn + e0);
      const float4 h4 = *reinterpret_cast<const float4*>(gm + e0), hp = *reinterpret_cast<const float4*>(p.g_post_mix + e0);
      xo[c].x += h4.x * (m4.x * rmix * hp.x) + g4.x * (y[c].x * rstd * gp.x);
      xo[c].y += h4.y * (m4.y * rmix * hp.y) + g4.y * (y[c].y * rstd * gp.y);
      xo[c].z += h4.z * (m4.z * rmix * hp.z) + g4.z * (y[c].z * rstd * gp.z);
      xo[c].w += h4.w * (m4.w * rmix * hp.w) + g4.w * (y[c].w * rstd * gp.w);
      *reinterpret_cast<float4*>(p.out + (size_t)t * D + e0) = xo[c];
    }
  }
}

#define XB_TMO      128
#define XB_XCNT(j)  (256  + 64 * (j))
#define XB_XSUB(j)  (1280 + 64 * (j))
#define XB_XGEN(j)  (2304 + 64 * (j))
#define XB_TOP      3328
#define XB_TOPGEN   3392
#define XCD_BAR_WORDS 3456
#define XB_SPIN_CAP (1u << 22)
#define LAS __attribute__((address_space(3)))
__device__ __forceinline__ unsigned xb_ld(unsigned* p)              { return __hip_atomic_load(p, __ATOMIC_RELAXED, __HIP_MEMORY_SCOPE_AGENT); }
__device__ __forceinline__ unsigned xb_add(unsigned* p, unsigned v) { return __hip_atomic_fetch_add(p, v, __ATOMIC_RELAXED, __HIP_MEMORY_SCOPE_AGENT); }
__device__ __forceinline__ unsigned xb_xcc_id() { return (unsigned)__builtin_amdgcn_s_getreg((3 << 11) | 20) & 0xFu; }
#define XB_SPIN(cond, bar) do { unsigned _sp = 0; while (cond) { __builtin_amdgcn_s_sleep(1); \
    if ((++_sp & 255u) == 0u) { if (xb_ld(&(bar)[XB_TMO])) break; if (_sp > XB_SPIN_CAP) { atomicAdd(&(bar)[XB_TMO], 1u); break; } } } } while (0)
struct XcdBarrier { unsigned* bar; unsigned x; volatile LAS unsigned* st; };
__device__ __forceinline__ XcdBarrier xcd_barrier_post(unsigned* bar, volatile LAS unsigned* st) {
  XcdBarrier b; b.bar = bar; b.x = xb_xcc_id(); b.st = st;
  if (threadIdx.x == 0) (void)xb_add(&bar[XB_XCNT(b.x)], 1u);
  return b;
}
__device__ __forceinline__ void xcd_barrier_complete(unsigned* bar, unsigned x, unsigned& nloc, unsigned& nx) {
  const unsigned G = gridDim.x * gridDim.y * gridDim.z;
  unsigned sum, cnt, mine, sp = 0u;
  for (;;) {
    sum = 0u; cnt = 0u; mine = 0u;
#pragma unroll
    for (unsigned j = 0; j < 16; ++j) { const unsigned c = xb_ld(&bar[XB_XCNT(j)]); sum += c; cnt += (c > 0u) ? 1u : 0u; mine = (j == x) ? c : mine; }
    if (sum == G) break;
    __builtin_amdgcn_s_sleep(1);
    if ((++sp & 255u) == 0u) { if (xb_ld(&bar[XB_TMO])) break; if (sp > XB_SPIN_CAP) { atomicAdd(&bar[XB_TMO], 1u); break; } }
  }
  nloc = mine > 0u ? mine : 1u; nx = cnt > 0u ? cnt : 1u;
}
__device__ __forceinline__ void xcd_barrier(const XcdBarrier& b) {
  asm volatile("s_waitcnt vmcnt(0)" ::: "memory");
  __syncthreads();
  if (threadIdx.x == 0) {
    unsigned* bar = b.bar;
    __builtin_amdgcn_s_waitcnt(0);
    unsigned nloc = b.st[0], nx = b.st[1];
    if (nloc == 0u) { xcd_barrier_complete(bar, b.x, nloc, nx); b.st[0] = nloc; b.st[1] = nx; }
    const unsigned old = xb_add(&bar[XB_XSUB(b.x)], 1u);
    const unsigned gen = old / nloc;
    if (old + 1u == (gen + 1u) * nloc) {
      __builtin_amdgcn_fence(__ATOMIC_RELEASE, "agent");
      asm volatile("s_waitcnt vmcnt(0)" ::: "memory");
      const unsigned og = xb_add(&bar[XB_TOP], 1u);
      const unsigned tg = og / nx;
      if (og + 1u == (tg + 1u) * nx) xb_add(&bar[XB_TOPGEN], 1u);
      else XB_SPIN(xb_ld(&bar[XB_TOPGEN]) == tg, bar);
      __builtin_amdgcn_fence(__ATOMIC_ACQUIRE, "agent");
      xb_add(&bar[XB_XGEN(b.x)], 1u);
      asm volatile("s_waitcnt vmcnt(0)" ::: "memory");
    } else {
      XB_SPIN(xb_ld(&bar[XB_XGEN(b.x)]) == gen, bar);
      __builtin_amdgcn_fence(__ATOMIC_ACQUIRE, "agent");
      asm volatile("s_waitcnt vmcnt(0)" ::: "memory");
    }
  }
  __syncthreads();
}

__global__ void __launch_bounds__(NTHREADS, 2) fwd_mega(Params p) {
  __shared__ __attribute__((aligned(16))) char smem[75808];
  const int bid = blockIdx.x, nb = gridDim.x;
  volatile LAS unsigned* st = (volatile LAS unsigned*)(smem + 75792);
  if (threadIdx.x == 0) { st[0] = 0u; st[1] = 0u; }
  __syncthreads();
  const XcdBarrier bar = xcd_barrier_post(p.bar, st);
  phase_prep(p, bid, nb, smem);        xcd_barrier(bar);
  phase_fold(p, bid, nb, smem);        xcd_barrier(bar);
  phase_norm_mod(p, bid, nb, smem);    xcd_barrier(bar);
  phase_inproj(p, bid, nb, smem);      xcd_barrier(bar);
  phase_ssm_pre(p, bid, nb, smem);     xcd_barrier(bar);
  phase_ssd_dft(p, bid, nb, smem);     xcd_barrier(bar);
  phase_ssm_post(p, bid, nb, smem);    xcd_barrier(bar);
  phase_outproj(p, bid, nb, smem);     xcd_barrier(bar);
  phase_postmix(p, bid, nb, smem);     xcd_barrier(bar);
  phase_q_route(p, bid, nb, smem);     xcd_barrier(bar);
  phase_exp_u(p, smem);                xcd_barrier(bar);
  phase_exp_v(p, smem);                xcd_barrier(bar);
  phase_exp_final(p, bid, nb, smem);
}

}

extern "C" void kernel_launch(void* const* d_in, const int* in_sizes, int n_in, void* d_out, int out_size, void* d_ws,
                              size_t ws_size, hipStream_t stream) {
  Params p{};
  const float** fp = reinterpret_cast<const float**>(&p);
  for (int i = 0; i < 27; ++i) fp[i] = (const float*)d_in[i];
  p.out = (float*)d_out;
  char* ws = (char*)d_ws;
  size_t off = 0;
  auto take = [&](size_t bytes) { char* r = ws + off; off += (bytes + 255) & ~(size_t)255; return r; };
  p.U8 = (uint8_t*)take((size_t)16384 * D);
  p.V8 = (uint8_t*)take((size_t)16384 * D);
  p.uscale = (float*)take((size_t)16384 * 4);
  p.hx8a = (int8_t*)take((size_t)(T + TC) * D);
  p.w8 = (int8_t*)take((size_t)NPROJ * D);
  p.ascale = (float*)take((size_t)(T + TC) * 4);
  p.wscale = (float*)take((size_t)NPROJ * 4);
  p.ycat8 = (int8_t*)take((size_t)T * D);
  p.wo8 = (int8_t*)take((size_t)D * D);
  p.yscale = (float*)take((size_t)T * 4);
  p.woscale = (float*)take((size_t)D * 4);
  p.w_in_t = (bf16_t*)take((size_t)NPROJ * D * 2);
  p.w_out_t = (bf16_t*)take((size_t)D * D * 2);
  p.w_q_t = (bf16_t*)take((size_t)1024 * D * 2);
  p.w_in_f = (bf16_t*)take((size_t)D * 1024 * 2);
  p.WcsT = (bf16_t*)take((size_t)4 * 512 * 256 * 2);
  p.dftm = (bf16_t*)take((size_t)1024 * 2048 * 2);
  p.Fs = (bf16_t*)take((size_t)NB * 1024 * 2048 * 2);
  p.partial = (float*)take((size_t)KSPLIT * 5 * NMOD * 4);
  p.mod = (float*)take((size_t)5 * NMOD * 4);
  p.hx = (bf16_t*)take((size_t)T * D * 2);
  p.hc = (bf16_t*)take((size_t)TC * D * 2);
  p.ABt = (bf16_t*)take((size_t)NB * 1024 * 4096 * 2);
  p.q = (float*)p.ABt;
  p.z = (bf16_t*)take((size_t)T * 1024 * 2);
  char* r1 = take(0);
  p.xbcraw = (bf16_t*)take((size_t)T * DXBC * 4);
  p.xbcraw_c = (bf16_t*)take((size_t)TC * DXBC * 4);
  p.act_tm = (bf16_t*)take((size_t)(T + TC) * DXBC * 2);
  p.act_cm_x = (bf16_t*)take((size_t)NB * 1280 * L * 2);
  p.act_cm_c = (bf16_t*)take((size_t)NB * 1280 * CTX * 2);
  p.y_x = (float*)r1;
  p.dtraw = (float*)take((size_t)T * 32 * 4);
  p.dtraw_c = (float*)take((size_t)TC * 32 * 4);
  p.dtf = (float*)take((size_t)T * 16 * 4);
  p.dtb = (float*)take((size_t)T * 16 * 4);
  p.dtf_c = (float*)take((size_t)TC * 16 * 4);
  p.dtb_c = (float*)take((size_t)TC * 16 * 4);
  p.yf = (float*)take((size_t)T * 1024 * 4);
  p.yb = (float*)take((size_t)T * 1024 * 4);
  p.ctr = (unsigned*)take(256);
  p.bar = (unsigned*)take((size_t)XCD_BAR_WORDS * 4);
  p.ycat = (bf16_t*)take((size_t)T * D * 2);
  p.idx = (int*)take((size_t)T * 128 * 4);
  p.gate = (float*)take((size_t)T * 128 * 4);
  if (off > ws_size) { fprintf(stderr, "kernel_launch: workspace too small: need %zu have %zu\n", off, ws_size); return; }
  static int grid_blocks = 0;
  if (!grid_blocks) {
    int dev = 0, cus = 0, per_cu = 0;
    hipGetDevice(&dev);
    hipDeviceGetAttribute(&cus, hipDeviceAttributeMultiprocessorCount, dev);
    hipOccupancyMaxActiveBlocksPerMultiprocessor(&per_cu, fwd_mega, NTHREADS, 0);
    if (per_cu > 2) per_cu = 2;
    grid_blocks = cus * per_cu;
    if (grid_blocks <= 0) { fprintf(stderr, "kernel_launch: occupancy query gave %d x %d\n", cus, per_cu); grid_blocks = -1; }
  }
  if (grid_blocks < 0) return;
  (void)hipMemsetAsync(p.bar, 0, (size_t)XCD_BAR_WORDS * 4, stream);
  void* args[] = {&p};
  hipError_t e = hipLaunchCooperativeKernel((void*)fwd_mega, dim3(grid_blocks), dim3(NTHREADS), args, 0, stream);
  if (e != hipSuccess) fprintf(stderr, "cooperative launch failed: %s (grid %d)\n", hipGetErrorString(e), grid_blocks);
}
```

```cpp
#include <hip/hip_runtime.h>
#include <hip/hip_cooperative_groups.h>
#include <stdint.h>
#include <stdio.h>

namespace cg = cooperative_groups;
namespace {

typedef __attribute__((ext_vector_type(8))) short bf16x8;
typedef __attribute__((ext_vector_type(4))) float f32x4;
typedef unsigned short bf16_t;

constexpr int D = 2048, NB = 4, L = 2048, T = NB * L, CTX = 256, TC = NB * CTX;
constexpr int NMOD = 6 * D;
constexpr int NH = 16, HP = 64, NS = 128, DXBC = 1536;
constexpr int DIN = 3616;
constexpr int NPROJ = 4736;
constexpr int KSPLIT = 32;
constexpr float EPS = 1e-6f;
constexpr int NTHREADS = 256;

__device__ __forceinline__ bf16_t f2bf(float f) { __bf16 h = (__bf16)f; return __builtin_bit_cast(unsigned short, h); }
__device__ __forceinline__ float bf2f(bf16_t h) { return __uint_as_float(((uint32_t)h) << 16); }
__device__ __forceinline__ uint32_t pack2(float a, float b) {
  typedef __attribute__((ext_vector_type(2))) __bf16 bf16x2_t;
  typedef __attribute__((ext_vector_type(2))) float f32x2_t;
  const f32x2_t v = {a, b};
  return __builtin_bit_cast(uint32_t, __builtin_convertvector(v, bf16x2_t));
}
__device__ __forceinline__ float bflo(uint32_t w) { return __uint_as_float(w << 16); }
__device__ __forceinline__ float bfhi(uint32_t w) { return __uint_as_float(w & 0xffff0000u); }
__device__ __forceinline__ float silu_f(float v) { return v / (1.f + __expf(-v)); }
__device__ __forceinline__ float softplus_f(float v) { return v > 20.f ? v : log1pf(__expf(v)); }

__device__ __forceinline__ int opaque_tid() { int t = threadIdx.x; asm volatile("" : "+v"(t)); return t; }
__device__ __forceinline__ float wave_sum(float v) {
#pragma unroll
  for (int o = 32; o > 0; o >>= 1) v += __shfl_xor(v, o);
  return v;
}
template <int CTRL>
__device__ __forceinline__ float dpp_mov(float v) {
  return __int_as_float(__builtin_amdgcn_update_dpp(0, __float_as_int(v), CTRL, 0xF, 0xF, true));
}
template <int CTRL>
__device__ __forceinline__ int dpp_movi(int v) { return __builtin_amdgcn_update_dpp(0, v, CTRL, 0xF, 0xF, true); }
__device__ __forceinline__ float wave_sum_fast(float v) {
  v += dpp_mov<0xB1>(v); v += dpp_mov<0x4E>(v); v += dpp_mov<0x124>(v); v += dpp_mov<0x128>(v);
  v += __shfl_xor(v, 16); v += __shfl_xor(v, 32);
  return v;
}
__device__ __forceinline__ float wave_max(float v) {
#pragma unroll
  for (int o = 32; o > 0; o >>= 1) v = fmaxf(v, __shfl_xor(v, o));
  return v;
}
__device__ __forceinline__ float block_sum(float v, float* red) {
  v = wave_sum(v);
  __syncthreads();
  if ((threadIdx.x & 63) == 0) red[threadIdx.x >> 6] = v;
  __syncthreads();
  return red[0] + red[1] + red[2] + red[3];
}

struct Params {
  const float *x, *c, *ctx, *c_ctx, *w_mod, *b_mod, *g_pre_mix, *g_post_mix, *g_pre_ffn, *g_post_ffn;
  const float *w_in, *w_fmix, *conv_w, *conv_b, *dt_bias_f, *dt_bias_b, *a_log_f, *a_log_b, *d_skip_f, *d_skip_b;
  const float *ssm_norm_w, *w_out, *w_query, *sk1, *sk2, *eu, *ev;
  float* out;
  uint8_t *U8, *V8;
  float* uscale;
  int8_t *hx8a, *w8;
  float *ascale, *wscale;
  int8_t *ycat8, *wo8;
  float *yscale, *woscale;
  int8_t* wq8; float* wqscale;
  bf16_t *w_in_t, *w_out_t, *w_q_t, *w_in_f, *WcsT, *dftm, *Fs;
  float *partial, *mod;
  bf16_t *hx, *hc, *ABt, *z;
  bf16_t *xbcraw, *xbcraw_c;
  float *dtraw, *dtraw_c, *dtf, *dtb, *dtf_c, *dtb_c;
  bf16_t *act_tm, *act_cm_x, *act_cm_c;
  float *yf, *yb;
  unsigned* ctr; unsigned* bar;
  bf16_t* ycat;
  float *y_x, *q, *gate;
  int* idx;
  int pad0, pad1;
};

template <bool I8 = false>
__device__ __forceinline__ void gemm_mainloop(const bf16_t* __restrict__ A, int lda, const bf16_t* __restrict__ Bt, int ldb,
                                              int K, int m0, int n0, f32x4 (&acc)[4][4], char* smem) {
  const int tid = opaque_tid(), lane = tid & 63, w = tid >> 6;
  const int wm = w >> 1, wn = w & 1;
#pragma unroll
  for (int i = 0; i < 4; ++i)
#pragma unroll
    for (int j = 0; j < 4; ++j) acc[i][j] = f32x4{0.f, 0.f, 0.f, 0.f};

  const int nk = K / 64;
  const int rowoff = lane >> 3, lch = (lane & 7) ^ rowoff;
  const bf16_t* gA = A + (size_t)(m0 + w * 8 + rowoff) * lda + lch * 8;
  const bf16_t* gB = Bt + (size_t)(n0 + w * 8 + rowoff) * ldb + lch * 8;
#define GSTAGE(buf_, kt_)                                                                                               \
  do {                                                                                                                  \
    _Pragma("unroll") for (int i_ = 0; i_ < 4; ++i_) {                                                                  \
      __builtin_amdgcn_global_load_lds((const unsigned*)(gA + (size_t)(i_ * 32) * lda + (kt_) * 64),                    \
                                       (unsigned*)(smem + (buf_) * 32768 + (i_ * 4 + w) * 1024), 16, 0, 0);             \
      __builtin_amdgcn_global_load_lds((const unsigned*)(gB + (size_t)(i_ * 32) * ldb + (kt_) * 64),                    \
                                       (unsigned*)(smem + (buf_) * 32768 + 16384 + (i_ * 4 + w) * 1024), 16, 0, 0);     \
    }                                                                                                                   \
  } while (0)
  GSTAGE(0, 0);
  asm volatile("s_waitcnt vmcnt(0)" ::: "memory");
  __syncthreads();
  for (int kt = 0; kt < nk; ++kt) {
    const int cur = kt & 1;
    if (kt + 1 < nk) GSTAGE(cur ^ 1, kt + 1);
    const char* sA = smem + cur * 32768;
    const char* sB = sA + 16384;
#pragma unroll
    for (int kk = 0; kk < 2; ++kk) {
      bf16x8 af[4], bfr[4];
      const int ch = kk * 4 + (lane >> 4);
#pragma unroll
      for (int i = 0; i < 4; ++i) {
        int row = wm * 64 + i * 16 + (lane & 15);
        af[i] = *reinterpret_cast<const bf16x8*>(sA + row * 128 + ((ch ^ (row & 7)) << 4));
        int col = wn * 64 + i * 16 + (lane & 15);
        bfr[i] = *reinterpret_cast<const bf16x8*>(sB + col * 128 + ((ch ^ (col & 7)) << 4));
      }
#pragma unroll
      for (int i = 0; i < 4; ++i)
#pragma unroll
        for (int j = 0; j < 4; ++j) {
          if (I8) {
            typedef __attribute__((ext_vector_type(4))) int i32x4;
            acc[i][j] = __builtin_bit_cast(f32x4, __builtin_amdgcn_mfma_i32_16x16x64_i8(__builtin_bit_cast(i32x4, af[i]), __builtin_bit_cast(i32x4, bfr[j]),
                                                                                         __builtin_bit_cast(i32x4, acc[i][j]), 0, 0, 0));
          } else {
            acc[i][j] = __builtin_amdgcn_mfma_f32_16x16x32_bf16(af[i], bfr[j], acc[i][j], 0, 0, 0);
          }
        }
    }
    asm volatile("s_waitcnt vmcnt(0)" ::: "memory");
    __syncthreads();
  }
#undef GSTAGE
}

template <bool I8 = false, class Epi>
__device__ __forceinline__ void gemm_tile(const bf16_t* __restrict__ A, int lda, const bf16_t* __restrict__ Bt, int ldb,
                                          int K, int m0, int n0, const Epi& epi, char* smem,
                                          const float* __restrict__ rscale = nullptr, const float* __restrict__ cscale = nullptr) {
  const int lane = threadIdx.x & 63, w = threadIdx.x >> 6;
  const int wm = w >> 1, wn = w & 1;
  f32x4 acc[4][4];
  gemm_mainloop<I8>(A, lda, Bt, ldb, K, m0, n0, acc, smem);
#pragma unroll
  for (int i = 0; i < 4; ++i) {
    const int row = m0 + wm * 64 + i * 16 + (lane >> 4) * 4;
    float4 rs = float4{1.f, 1.f, 1.f, 1.f};
    if (I8) rs = *reinterpret_cast<const float4*>(rscale + row);
#pragma unroll
    for (int j = 0; j < 4; ++j) {
      const int col = n0 + wn * 64 + j * 16 + (lane & 15);
      if (I8) {
        typedef __attribute__((ext_vector_type(4))) int i32x4;
        const i32x4 ia = __builtin_bit_cast(i32x4, acc[i][j]);
        const float cs = cscale[col];
        epi(row, col, f32x4{(float)ia[0] * rs.x * cs, (float)ia[1] * rs.y * cs, (float)ia[2] * rs.z * cs, (float)ia[3] * rs.w * cs});
      } else {
        epi(row, col, acc[i][j]);
      }
    }
  }
}

template <bool I8>
__device__ __forceinline__ void gemm_mainloop_n256(const bf16_t* __restrict__ A, int lda, const bf16_t* __restrict__ Bt, int ldb,
                                                   int K, int m0, int n0, f32x4 (&acc)[4][8], char* smem) {
  const int tid = opaque_tid(), lane = tid & 63, w = tid >> 6;
  const int wm = w >> 1, wn = w & 1;
#pragma unroll
  for (int i = 0; i < 4; ++i)
#pragma unroll
    for (int j = 0; j < 8; ++j) acc[i][j] = f32x4{0.f, 0.f, 0.f, 0.f};
  const int nk = K / 64;
  const int rowoff = lane >> 3, lch = (lane & 7) ^ rowoff;
  const bf16_t* gA = A + (size_t)(m0 + w * 8 + rowoff) * lda + lch * 8;
  const bf16_t* gB = Bt + (size_t)(n0 + w * 8 + rowoff) * ldb + lch * 8;
  const int fr = lane & 15, fq = lane >> 4;
  for (int kt = 0; kt < nk; ++kt) {
#pragma unroll
    for (int i_ = 0; i_ < 4; ++i_)
      __builtin_amdgcn_global_load_lds((const unsigned*)(gA + (size_t)(i_ * 32) * lda + kt * 64),
                                       (unsigned*)(smem + (i_ * 4 + w) * 1024), 16, 0, 0);
#pragma unroll
    for (int i_ = 0; i_ < 8; ++i_)
      __builtin_amdgcn_global_load_lds((const unsigned*)(gB + (size_t)(i_ * 32) * ldb + kt * 64),
                                       (unsigned*)(smem + 16384 + (i_ * 4 + w) * 1024), 16, 0, 0);
    asm volatile("s_waitcnt vmcnt(0)" ::: "memory");
    __syncthreads();
    const char* sA = smem;
    const char* sB = smem + 16384;
#pragma unroll
    for (int kk = 0; kk < 2; ++kk) {
      bf16x8 af[4], bfr[8];
      const int ch = kk * 4 + fq;
#pragma unroll
      for (int i = 0; i < 4; ++i) {
        const int row = wm * 64 + i * 16 + fr;
        af[i] = *reinterpret_cast<const bf16x8*>(sA + row * 128 + ((ch ^ (row & 7)) << 4));
      }
#pragma unroll
      for (int j = 0; j < 8; ++j) {
        const int col = wn * 128 + j * 16 + fr;
        bfr[j] = *reinterpret_cast<const bf16x8*>(sB + col * 128 + ((ch ^ (col & 7)) << 4));
      }
#pragma unroll
      for (int i = 0; i < 4; ++i)
#pragma unroll
        for (int j = 0; j < 8; ++j) {
          if (I8) {
            typedef __attribute__((ext_vector_type(4))) int i32x4;
            acc[i][j] = __builtin_bit_cast(f32x4, __builtin_amdgcn_mfma_i32_16x16x64_i8(__builtin_bit_cast(i32x4, af[i]), __builtin_bit_cast(i32x4, bfr[j]),
                                                                                         __builtin_bit_cast(i32x4, acc[i][j]), 0, 0, 0));
          } else {
            acc[i][j] = __builtin_amdgcn_mfma_f32_16x16x32_bf16(af[i], bfr[j], acc[i][j], 0, 0, 0);
          }
        }
    }
    __syncthreads();
  }
}
template <bool I8, class Epi>
__device__ __forceinline__ void gemm_tile_n256(const bf16_t* __restrict__ A, int lda, const bf16_t* __restrict__ Bt, int ldb,
                                               int K, int m0, int n0, const Epi& epi, char* smem,
                                               const float* __restrict__ rscale = nullptr, const float* __restrict__ cscale = nullptr) {
  const int lane = threadIdx.x & 63, w = threadIdx.x >> 6;
  const int wm = w >> 1, wn = w & 1;
  f32x4 acc[4][8];
  gemm_mainloop_n256<I8>(A, lda, Bt, ldb, K, m0, n0, acc, smem);
#pragma unroll
  for (int i = 0; i < 4; ++i) {
    const int row = m0 + wm * 64 + i * 16 + (lane >> 4) * 4;
    float4 rs = float4{1.f, 1.f, 1.f, 1.f};
    if (I8) rs = *reinterpret_cast<const float4*>(rscale + row);
#pragma unroll
    for (int j = 0; j < 8; ++j) {
      const int col = n0 + wn * 128 + j * 16 + (lane & 15);
      if (I8) {
        typedef __attribute__((ext_vector_type(4))) int i32x4;
        const i32x4 ia = __builtin_bit_cast(i32x4, acc[i][j]);
        const float cs = cscale[col];
        epi(row, col, f32x4{(float)ia[0] * rs.x * cs, (float)ia[1] * rs.y * cs, (float)ia[2] * rs.z * cs, (float)ia[3] * rs.w * cs});
      } else {
        epi(row, col, acc[i][j]);
      }
    }
  }
}

__device__ __forceinline__ float wave_max_fast(float v) {
  v = fmaxf(v, dpp_mov<0xB1>(v)); v = fmaxf(v, dpp_mov<0x4E>(v)); v = fmaxf(v, dpp_mov<0x124>(v)); v = fmaxf(v, dpp_mov<0x128>(v));
  v = fmaxf(v, __shfl_xor(v, 16)); v = fmaxf(v, __shfl_xor(v, 32));
  return v;
}
__device__ __forceinline__ uint32_t pack_i8x4(float a, float b, float c, float d) {
  const int ia = __float2int_rn(a), ib = __float2int_rn(b), ic = __float2int_rn(c), id = __float2int_rn(d);
  return (uint32_t)(ia & 255) | ((uint32_t)(ib & 255) << 8) | ((uint32_t)(ic & 255) << 16) | ((uint32_t)id << 24);
}
struct EpiF32 {
  float* C; int ldc;
  __device__ __forceinline__ void operator()(int row, int col, f32x4 v) const {
#pragma unroll
    for (int r = 0; r < 4; ++r) C[(size_t)(row + r) * ldc + col] = v[r];
  }
};
struct EpiBf16 {
  bf16_t* C; int ldc;
  __device__ __forceinline__ void operator()(int row, int col, f32x4 v) const {
#pragma unroll
    for (int r = 0; r < 4; ++r) C[(size_t)(row + r) * ldc + col] = f2bf(v[r]);
  }
};
struct EpiBf16T {
  bf16_t* Ct; int ldc;
  __device__ __forceinline__ void operator()(int row, int col, f32x4 v) const {
    uint2 pk; pk.x = pack2(v[0], v[1]); pk.y = pack2(v[2], v[3]);
    *reinterpret_cast<uint2*>(Ct + (size_t)col * ldc + row) = pk;
  }
};
struct EpiInAB {
  bf16_t* ABt; int seqlen;
  __device__ __forceinline__ void operator()(int row, int col, f32x4 v) const {
    const int ch = col & 1023, half = col >> 10;
    const int b = row / seqlen, l = row - b * seqlen;
    uint2 pk; pk.x = pack2(v[0], v[1]); pk.y = pack2(v[2], v[3]);
    *reinterpret_cast<uint2*>(ABt + ((size_t)(b * 1024 + ch) * 4096 + half * 2048 + l)) = pk;
  }
};
struct EpiInZ {
  bf16_t* z;
  __device__ __forceinline__ void operator()(int row, int col, f32x4 v) const {
#pragma unroll
    for (int r = 0; r < 4; ++r) z[(size_t)(row + r) * 1024 + (col - 2048)] = f2bf(v[r]);
  }
};
struct EpiInXbc {
  bf16_t* xbcraw;
  __device__ __forceinline__ void operator()(int row, int col, f32x4 v) const {
#pragma unroll
    for (int r = 0; r < 4; ++r) xbcraw[(size_t)(row + r) * DXBC + (col - 3072)] = f2bf(v[r]);
  }
};
struct EpiInProj {
  bf16_t* ABt; bf16_t* z; bf16_t* xbcraw; float* dtraw; int seqlen;
  __device__ __forceinline__ void operator()(int row, int col, f32x4 v) const {
    if (col < 2048) {
      int ch = col & 1023, half = col >> 10;
      int b = row / seqlen, l = row - b * seqlen;
      uint2 pk; pk.x = pack2(v[0], v[1]); pk.y = pack2(v[2], v[3]);
      *reinterpret_cast<uint2*>(ABt + ((size_t)(b * 1024 + ch) * 4096 + half * 2048 + l)) = pk;
    } else if (col < 3072) {
#pragma unroll
      for (int r = 0; r < 4; ++r) z[(size_t)(row + r) * 1024 + (col - 2048)] = f2bf(v[r]);
    } else if (col < 4608) {
#pragma unroll
      for (int r = 0; r < 4; ++r) xbcraw[(size_t)(row + r) * DXBC + (col - 3072)] = f2bf(v[r]);
    } else if (col < 4640) {
#pragma unroll
      for (int r = 0; r < 4; ++r) dtraw[(size_t)(row + r) * 32 + (col - 4608)] = v[r];
    }
  }
};

__device__ void adaln_partial_task(const Params& p, int task, float* sm) {
  const int cb = task % 48, ks = task / 48, tid = threadIdx.x;
  float* sc = sm;
  __syncthreads();
  for (int i = tid; i < 5 * 64; i += NTHREADS) {
    int r = i >> 6, kk = i & 63;
    int k = ks * 64 + kk;
    float cv = (r < 4) ? p.c[r * D + k] : p.c_ctx[k];
    sc[i] = silu_f(cv);
  }
  __syncthreads();
  const int col = cb * 256 + tid;
  float a0 = 0, a1 = 0, a2 = 0, a3 = 0, a4 = 0;
  const float* wp = p.w_mod + (size_t)(ks * 64) * NMOD + col;
  {
    float wv[64];
#pragma unroll
    for (int kk = 0; kk < 64; ++kk) wv[kk] = __builtin_nontemporal_load(wp + (size_t)kk * NMOD);
#pragma unroll
    for (int k = 0; k < 64; ++k) {
      a0 += sc[k] * wv[k]; a1 += sc[64 + k] * wv[k]; a2 += sc[128 + k] * wv[k]; a3 += sc[192 + k] * wv[k]; a4 += sc[256 + k] * wv[k];
    }
  }
  float* pp = p.partial + (size_t)ks * 5 * NMOD + col;
  pp[0] = a0; pp[NMOD] = a1; pp[2 * NMOD] = a2; pp[3 * NMOD] = a3; pp[4 * NMOD] = a4;
}

__device__ void transpose_convert_task(const float* __restrict__ src, int ld, int c0, int rows, bf16_t* __restrict__ dst,
                                       int tr, int tc, float* sm) {
  float (*tile)[68] = reinterpret_cast<float (*)[68]>(sm);
  const int tid = threadIdx.x;
  __syncthreads();
  {
    float4 v[4];
#pragma unroll
    for (int k = 0; k < 4; ++k) {
      const int i = tid + k * NTHREADS, r = i >> 4, c4 = i & 15;
      v[k] = *reinterpret_cast<const float4*>(src + (size_t)(tr * 64 + r) * ld + c0 + tc * 64 + c4 * 4);
    }
#pragma unroll
    for (int k = 0; k < 4; ++k) {
      const int i = tid + k * NTHREADS, r = i >> 4, c4 = i & 15;
      *reinterpret_cast<float4*>(&tile[r][c4 * 4]) = v[k];
    }
  }
  __syncthreads();
#pragma unroll
  for (int k = 0; k < 4; ++k) {
    const int i = tid + k * NTHREADS, cc = i >> 4, r4 = (i & 15) * 4;
    uint2 o; o.x = pack2(tile[r4][cc], tile[r4 + 1][cc]); o.y = pack2(tile[r4 + 2][cc], tile[r4 + 3][cc]);
    *reinterpret_cast<uint2*>(dst + (size_t)(tc * 64 + cc) * rows + tr * 64 + r4) = o;
  }
}

__device__ void phase_prep(const Params& p, int bid, int nb, char* smem) {
  float* sm = reinterpret_cast<float*>(smem);
  const int tid = threadIdx.x;
  if (bid == 0 && tid < 64) p.ctr[tid] = 0u;
  {
    float* t256 = reinterpret_cast<float*>(smem + 20480);
    float* t2048 = reinterpret_cast<float*>(smem + 24576);
    t256[tid] = cospif((float)tid * (1.0f / 128.f));
    for (int i = tid; i < 2048; i += NTHREADS) t2048[i] = cospif((float)i * (1.0f / 1024.f));
    __syncthreads();
  }
  for (int t = bid; t < 48 * KSPLIT; t += nb) adaln_partial_task(p, t, sm);
  {
    const int nct = 41, nrt = 32;
    for (int t = bid; t < nct * nrt; t += nb) {
      int tc = t % nct, tr = t / nct;
      if (tc < 40) transpose_convert_task(p.w_in, DIN, 1024, D, p.w_in_t + (size_t)2048 * D, tr, tc, sm);
      else {
        float (*tile)[65] = reinterpret_cast<float (*)[65]>(sm);
        __syncthreads();
        for (int i = tid; i < 64 * 32; i += NTHREADS) {
          int r = i >> 5, cc = i & 31;
          tile[r][cc] = p.w_in[(size_t)(tr * 64 + r) * DIN + 1024 + 2560 + cc];
        }
        __syncthreads();
        for (int i = tid; i < 32 * 32; i += NTHREADS) {
          int cc = i >> 5, r2 = (i & 31) * 2;
          uint32_t pk = pack2(tile[r2][cc], tile[r2 + 1][cc]);
          *reinterpret_cast<uint32_t*>(p.w_in_t + (size_t)(2048 + 2560 + cc) * D + tr * 64 + r2) = pk;
        }
      }
    }
    for (size_t i = (size_t)bid * NTHREADS + tid; i < (size_t)96 * D / 8; i += (size_t)nb * NTHREADS)
      reinterpret_cast<uint4*>(p.w_in_t + (size_t)4640 * D)[i] = uint4{0, 0, 0, 0};
  }
  for (size_t i0 = (size_t)bid * NTHREADS + tid; i0 < (size_t)D * 1024 / 4; i0 += (size_t)4 * nb * NTHREADS) {
    float4 v[4];
#pragma unroll
    for (int u = 0; u < 4; ++u) {
      const size_t i = i0 + (size_t)u * nb * NTHREADS;
      const int k = (int)(i / 256), c4 = (int)(i % 256) * 4;
      v[u] = (i < (size_t)D * 1024 / 4) ? *reinterpret_cast<const float4*>(p.w_in + (size_t)k * DIN + c4) : float4{0.f, 0.f, 0.f, 0.f};
    }
#pragma unroll
    for (int u = 0; u < 4; ++u) {
      const size_t i = i0 + (size_t)u * nb * NTHREADS;
      const int k = (int)(i / 256), c4 = (int)(i % 256) * 4;
      uint2 o; o.x = pack2(v[u].x, v[u].y); o.y = pack2(v[u].z, v[u].w);
      if (i < (size_t)D * 1024 / 4) *reinterpret_cast<uint2*>(p.w_in_f + (size_t)k * 1024 + c4) = o;
    }
  }
  {
    const float* t256 = reinterpret_cast<const float*>(smem + 20480);
    const float scale = 1.0f / sqrtf((float)L * 256.f);
    const int vb = (bid + (nb >> 1)) % nb;
    for (int i = vb * NTHREADS + tid; i < 4 * 64 * 256; i += nb * NTHREADS) {
      const int d = i & 255, cg = (i >> 8) & 63, g = i >> 14;
      float c0_ = 0.f, c1_ = 0.f, c2_ = 0.f, c3_ = 0.f, s0_ = 0.f, s1_ = 0.f, s2_ = 0.f, s3_ = 0.f;
      const float* wp = p.w_fmix + (size_t)g * 65536 + d;
#pragma unroll 1
      for (int mb = 0; mb < 256; mb += 16) {
        float wv[16];
#pragma unroll
        for (int mm = 0; mm < 16; ++mm) wv[mm] = wp[(mb + mm) * 256];
#pragma unroll
        for (int mm = 0; mm < 16; ++mm) {
          const int m = mb + mm;
          const int p0 = (m * (cg * 4 + 0)) & 255, p1 = (m * (cg * 4 + 1)) & 255, p2 = (m * (cg * 4 + 2)) & 255, p3 = (m * (cg * 4 + 3)) & 255;
          c0_ += t256[p0] * wv[mm]; s0_ += t256[(p0 - 64) & 255] * wv[mm];
          c1_ += t256[p1] * wv[mm]; s1_ += t256[(p1 - 64) & 255] * wv[mm];
          c2_ += t256[p2] * wv[mm]; s2_ += t256[(p2 - 64) & 255] * wv[mm];
          c3_ += t256[p3] * wv[mm]; s3_ += t256[(p3 - 64) & 255] * wv[mm];
        }
      }
      {
        bf16_t* wc = p.WcsT + ((size_t)g * 512 + d) * 256 + cg * 4;
        bf16_t* ws_ = p.WcsT + ((size_t)g * 512 + 256 + d) * 256 + cg * 4;
        uint2 oc, os;
        oc.x = pack2(c0_ * scale, c1_ * scale); oc.y = pack2(c2_ * scale, c3_ * scale);
        os.x = pack2(s0_ * scale, s1_ * scale); os.y = pack2(s2_ * scale, s3_ * scale);
        *reinterpret_cast<uint2*>(wc) = oc;
        *reinterpret_cast<uint2*>(ws_) = os;
      }
    }
  }
  {
    const float* t2048 = reinterpret_cast<const float*>(smem + 24576);
    for (size_t i = (size_t)bid * NTHREADS + tid; i < (size_t)1024 * 2048 / 8; i += (size_t)nb * NTHREADS) {
      const int k = (int)(i / 256), j = (int)(i % 256) * 8;
      const bool iss = j >= 1024;
      float o[8];
#pragma unroll
      for (int e = 0; e < 8; ++e) {
        const int l = (j + e) & 1023;
        const int ph = (k * l) & 2047;
        o[e] = iss ? t2048[(ph - 512) & 2047] : t2048[ph];
      }
      uint4 pk; pk.x = pack2(o[0], o[1]); pk.y = pack2(o[2], o[3]); pk.z = pack2(o[4], o[5]); pk.w = pack2(o[6], o[7]);
      *reinterpret_cast<uint4*>(p.dftm + (size_t)k * 2048 + j) = pk;
    }
  }
}

__device__ void phase_fold(const Params& p, int bid, int nb, char* smem) {
  const int tid = threadIdx.x;
  for (int i = bid * NTHREADS + tid; i < 5 * NMOD; i += nb * NTHREADS) {
    int col = i % NMOD;
    float s = p.b_mod[col];
    for (int ks = 0; ks < KSPLIT; ++ks) s += p.partial[(size_t)ks * 5 * NMOD + i];
    p.mod[i] = s;
  }
  for (int t = bid; t < 256; t += nb) {
    int g = t >> 6, tm = (t & 63) >> 2, tn = t & 3;
    int n0 = tn * 128;
    int rowbase = (n0 < 256) ? (g * 256 + n0) : (1024 + g * 256 + (n0 - 256));
    EpiBf16T epi{p.w_in_t + (size_t)(rowbase - n0) * D, D};
    gemm_tile(p.w_in_f + g * 256, 1024, p.WcsT + (size_t)g * 512 * 256, 256, 256, tm * 128, n0, epi, smem);
  }
}

__device__ __forceinline__ void quant_weight_rows_i8(const bf16_t* __restrict__ src, int8_t* __restrict__ dst, float* __restrict__ scl,
                                                     int nrows, int bid, int nb) {
  const int lane = threadIdx.x & 63, w = threadIdx.x >> 6;
  for (int n = bid * 4 + w; n < nrows; n += nb * 4) {
    const bf16_t* wr = src + (size_t)n * D;
    uint4 q[4];
#pragma unroll
    for (int c = 0; c < 4; ++c) q[c] = *reinterpret_cast<const uint4*>(wr + c * 512 + lane * 8);
    float am = 0.f;
#pragma unroll
    for (int c = 0; c < 4; ++c) {
      am = fmaxf(am, fmaxf(fmaxf(fabsf(bflo(q[c].x)), fabsf(bfhi(q[c].x))), fmaxf(fabsf(bflo(q[c].y)), fabsf(bfhi(q[c].y)))));
      am = fmaxf(am, fmaxf(fmaxf(fabsf(bflo(q[c].z)), fabsf(bfhi(q[c].z))), fmaxf(fabsf(bflo(q[c].w)), fabsf(bfhi(q[c].w)))));
    }
    am = wave_max_fast(am);
    const float inv = (am > 0.f) ? 127.f / am : 0.f;
#pragma unroll
    for (int c = 0; c < 4; ++c) {
      uint2 o;
      o.x = pack_i8x4(bflo(q[c].x) * inv, bfhi(q[c].x) * inv, bflo(q[c].y) * inv, bfhi(q[c].y) * inv);
      o.y = pack_i8x4(bflo(q[c].z) * inv, bfhi(q[c].z) * inv, bflo(q[c].w) * inv, bfhi(q[c].w) * inv);
      *reinterpret_cast<uint2*>(dst + (size_t)n * D + c * 512 + lane * 8) = o;
    }
    if (lane == 0) scl[n] = am * (1.f / 127.f);
  }
}

__device__ void phase_norm_mod(const Params& p, int bid, int nb, char* smem) {
  const int lane = threadIdx.x & 63, w = threadIdx.x >> 6;
  for (int t = bid * 4 + w; t < T + TC; t += nb * 4) {
    const bool isx = t < T;
    const float* src = isx ? (p.x + (size_t)t * D) : (p.ctx + (size_t)(t - T) * D);
    const int mrow = isx ? (t / L) : 4;
    float4 v[8];
    float ss = 0.f;
#pragma unroll
    for (int c = 0; c < 8; ++c) {
      v[c] = *reinterpret_cast<const float4*>(src + c * 256 + lane * 4);
      ss += v[c].x * v[c].x + v[c].y * v[c].y + v[c].z * v[c].z + v[c].w * v[c].w;
    }
    ss = wave_sum_fast(ss);
    const float rstd = rsqrtf(ss * (1.f / D) + EPS);
    const float* sh = p.mod + (size_t)mrow * NMOD + 0 * D;
    const float* sc = p.mod + (size_t)mrow * NMOD + 1 * D;
    float am = 0.f;
#pragma unroll
    for (int c = 0; c < 8; ++c) {
      const int e0 = c * 256 + lane * 4;
      const float4 g = *reinterpret_cast<const float4*>(p.g_pre_mix + e0);
      const float4 s4 = *reinterpret_cast<const float4*>(sc + e0), h4 = *reinterpret_cast<const float4*>(sh + e0);
      v[c].x = v[c].x * rstd * g.x * (1.f + s4.x) + h4.x; v[c].y = v[c].y * rstd * g.y * (1.f + s4.y) + h4.y;
      v[c].z = v[c].z * rstd * g.z * (1.f + s4.z) + h4.z; v[c].w = v[c].w * rstd * g.w * (1.f + s4.w) + h4.w;
      am = fmaxf(am, fmaxf(fmaxf(fabsf(v[c].x), fabsf(v[c].y)), fmaxf(fabsf(v[c].z), fabsf(v[c].w))));
    }
    {
      am = wave_max_fast(am);
      const float inv = (am > 0.f) ? 127.f / am : 0.f;
#pragma unroll
      for (int c = 0; c < 8; ++c)
        *reinterpret_cast<uint32_t*>(p.hx8a + (size_t)t * D + c * 256 + lane * 4) = pack_i8x4(v[c].x * inv, v[c].y * inv, v[c].z * inv, v[c].w * inv);
      if (lane == 0) p.ascale[t] = am * (1.f / 127.f);
    }
  }
  quant_weight_rows_i8(p.w_in_t, p.w8, p.wscale, NPROJ, bid, nb);
}

__device__ __forceinline__ void convert_v_units(const Params& p, size_t u0, size_t u1) {
  for (size_t j = u0 + threadIdx.x; j < u1; j += NTHREADS) {
    uint32_t o[4];
#pragma unroll
    for (int q4 = 0; q4 < 4; ++q4) {
      const float4 v = *reinterpret_cast<const float4*>(p.ev + j * 16 + q4 * 4);
      int pk = 0;
      pk = __builtin_amdgcn_cvt_pk_fp8_f32(v.x * 512.f, v.y * 512.f, pk, false);
      pk = __builtin_amdgcn_cvt_pk_fp8_f32(v.z * 512.f, v.w * 512.f, pk, true);
      o[q4] = (uint32_t)pk;
    }
    const size_t e_ = j >> 7, r_ = j & 127;
    *reinterpret_cast<uint4*>(p.V8 + (r_ >> 4) * ((size_t)16384 * 256) + e_ * 256 + (r_ & 15) * 16) = uint4{o[0], o[1], o[2], o[3]};
  }
}
__device__ __forceinline__ void convert_u_rows(const Params& p, int q) {
  const int lane = threadIdx.x & 63, w = threadIdx.x >> 6;
  const int row0 = q * 32 + w * 8;
#pragma unroll 1
  for (int rr = 0; rr < 8; rr += 2) {
    f32x4 va[8], vb[8];
#pragma unroll
    for (int k = 0; k < 8; ++k) va[k] = __builtin_nontemporal_load(reinterpret_cast<const f32x4*>(p.eu + (size_t)(row0 + rr) * D + k * 256 + lane * 4));
#pragma unroll
    for (int k = 0; k < 8; ++k) vb[k] = __builtin_nontemporal_load(reinterpret_cast<const f32x4*>(p.eu + (size_t)(row0 + rr + 1) * D + k * 256 + lane * 4));
#define CONV_U_EMIT(v_, row_)                                                                                           \
    {                                                                                                                   \
      float m = 0.f;                                                                                                    \
      _Pragma("unroll") for (int k = 0; k < 8; ++k)                                                                     \
        m = fmaxf(m, fmaxf(fmaxf(fabsf(v_[k][0]), fabsf(v_[k][1])), fmaxf(fabsf(v_[k][2]), fabsf(v_[k][3]))));        \
      m = wave_max_fast(m);                                                                                             \
      const float inv = (m > 0.f) ? 127.f / m : 0.f;                                                                    \
      _Pragma("unroll") for (int k = 0; k < 8; ++k)                                                                     \
        *reinterpret_cast<uint32_t*>(p.U8 + (size_t)k * ((size_t)16384 * 256) + (size_t)(row_) * 256 + lane * 4) =      \
            pack_i8x4(v_[k][0] * inv, v_[k][1] * inv, v_[k][2] * inv, v_[k][3] * inv);                                  \
      if (lane == 0) p.uscale[row_] = m * (1.f / 127.f);                                                                \
    }
    CONV_U_EMIT(va, row0 + rr);
    CONV_U_EMIT(vb, row0 + rr + 1);
#undef CONV_U_EMIT
  }
}
__device__ void phase_inproj(const Params& p, int bid, int nb, char* smem) {
  const bool aware = (nb & 7) == 0;
  const int start = aware ? (bid >> 3) : bid, step = aware ? (nb >> 3) : nb, end = aware ? (128 + 53) : 8 * (128 + 53);
  const bf16_t* a8 = reinterpret_cast<const bf16_t*>(p.hx8a);
  const bf16_t* b8 = reinterpret_cast<const bf16_t*>(p.w8);
  for (int it = start; it < end; it += step) {
    const int x = aware ? (bid & 7) : it / (128 + 53), s_ = aware ? it : it % (128 + 53);
    if (s_ < 128) {
      const int tn2 = s_ >> 3, m0_ = (8 * x + (s_ & 7)) * 128;
      if (tn2 < 8) { EpiInAB epi{p.ABt, L}; gemm_tile_n256<true>(a8, D / 2, b8, D / 2, D / 2, m0_, tn2 * 256, epi, smem, p.ascale, p.wscale); }
      else if (tn2 < 12) { EpiInZ epi{p.z}; gemm_tile_n256<true>(a8, D / 2, b8, D / 2, D / 2, m0_, tn2 * 256, epi, smem, p.ascale, p.wscale); }
      else { EpiInXbc epi{p.xbcraw}; gemm_tile_n256<true>(a8, D / 2, b8, D / 2, D / 2, m0_, tn2 * 256, epi, smem, p.ascale, p.wscale); }
    } else if (s_ < 128 + 40) {
      const int i = s_ - 128;
      EpiInProj epi{p.ABt, p.z, p.xbcraw, p.dtraw, L};
      gemm_tile<true>(a8, D / 2, b8, D / 2, D / 2, (8 * x + (i & 7)) * 128, (32 + (i >> 3)) * 128, epi, smem, p.ascale, p.wscale);
    } else {
      const int u = x * 13 + (s_ - 168);
      EpiInProj epi{nullptr, nullptr, p.xbcraw_c, p.dtraw_c, CTX};
      gemm_tile<true>(reinterpret_cast<const bf16_t*>(p.hx8a + (size_t)T * D), D / 2, b8, D / 2, D / 2, (u / 13) * 128, 3072 + (u % 13) * 128, epi, smem,
                      p.ascale + T, p.wscale);
    }
  }
}

__device__ void ssm_pre_tile(const Params& p, int task, char* smem) {
  const bool isx = task < 3072;
  const int u = isx ? task : task - 3072;
  const int ntt = isx ? 32 : 4;
  const int ct = u % 24, tt = (u / 24) % ntt, b = u / (24 * ntt);
  const int seqlen = isx ? L : CTX;
  const bf16_t* raw = (isx ? p.xbcraw : p.xbcraw_c) + (size_t)b * seqlen * DXBC;
  const int l0 = tt * 64, c0 = ct * 64, tid = threadIdx.x;
  float (*rt)[68] = reinterpret_cast<float (*)[68]>(smem);
  float (*at)[65] = reinterpret_cast<float (*)[65]>(smem + 66 * 68 * 4);
  __syncthreads();
  {
    uint2 v[5];
#pragma unroll
    for (int k = 0; k < 5; ++k) {
      const int i = tid + k * NTHREADS, r = i >> 4, c4 = i & 15, l = l0 - 1 + r;
      v[k] = (i < 66 * 16 && l >= 0 && l < seqlen) ? *reinterpret_cast<const uint2*>(raw + (size_t)l * DXBC + c0 + c4 * 4) : uint2{0u, 0u};
    }
#pragma unroll
    for (int k = 0; k < 5; ++k) {
      const int i = tid + k * NTHREADS, r = i >> 4, c4 = i & 15;
      if (i < 66 * 16) *reinterpret_cast<float4*>(&rt[r][c4 * 4]) = float4{bflo(v[k].x), bfhi(v[k].x), bflo(v[k].y), bfhi(v[k].y)};
    }
  }
  __syncthreads();
  {
    const int cc = tid & 63, c = c0 + cc;
    const float w0 = p.conv_w[c], w1 = p.conv_w[DXBC + c], w2 = p.conv_w[2 * DXBC + c], cb = p.conv_b[c];
#pragma unroll 4
    for (int r = tid >> 6; r < 64; r += 4) at[r][cc] = silu_f(cb + rt[r][cc] * w0 + rt[r + 1][cc] * w1 + rt[r + 2][cc] * w2);
  }
  __syncthreads();
  const size_t trow0 = isx ? ((size_t)b * L + l0) : ((size_t)T + (size_t)b * CTX + l0);
#pragma unroll
  for (int k = 0; k < 4; ++k) {
    const int i = tid + k * NTHREADS, r = i >> 4, c4 = (i & 15) * 4;
    uint2 o; o.x = pack2(at[r][c4], at[r][c4 + 1]); o.y = pack2(at[r][c4 + 2], at[r][c4 + 3]);
    *reinterpret_cast<uint2*>(p.act_tm + (trow0 + r) * DXBC + c0 + c4) = o;
  }
  if (c0 < 1280) {
    bf16_t* cm = (isx ? p.act_cm_x : p.act_cm_c) + (size_t)b * 1280 * seqlen;
#pragma unroll
    for (int k = 0; k < 4; ++k) {
      const int i = tid + k * NTHREADS, cc = i >> 4, r4 = (i & 15) * 4;
      uint2 o; o.x = pack2(at[r4][cc], at[r4 + 1][cc]); o.y = pack2(at[r4 + 2][cc], at[r4 + 3][cc]);
      *reinterpret_cast<uint2*>(cm + (size_t)(c0 + cc) * seqlen + l0 + r4) = o;
    }
  }
}
__device__ void dft_fold_rows(const Params& p, int bid, int nb, char* smem) {
  const int lane = threadIdx.x & 63, w = threadIdx.x >> 6;
  bf16_t* sr = reinterpret_cast<bf16_t*>(smem + w * 8192);
  for (int row = bid * 4 + w; row < NB * 1024; row += nb * 4) {
    const bf16_t* A = p.ABt + (size_t)row * 4096;
    bf16_t* F = p.Fs + (size_t)row * 2048;
    __builtin_amdgcn_wave_barrier();
    {
      const uint4 q0 = *reinterpret_cast<const uint4*>(A + (0 * 64 + lane) * 8), q1 = *reinterpret_cast<const uint4*>(A + (1 * 64 + lane) * 8);
      const uint4 q2 = *reinterpret_cast<const uint4*>(A + (2 * 64 + lane) * 8), q3 = *reinterpret_cast<const uint4*>(A + (3 * 64 + lane) * 8);
      const uint4 q4 = *reinterpret_cast<const uint4*>(A + (4 * 64 + lane) * 8), q5 = *reinterpret_cast<const uint4*>(A + (5 * 64 + lane) * 8);
      const uint4 q6 = *reinterpret_cast<const uint4*>(A + (6 * 64 + lane) * 8), q7 = *reinterpret_cast<const uint4*>(A + (7 * 64 + lane) * 8);
      *reinterpret_cast<uint4*>(sr + (0 * 64 + lane) * 8) = q0; *reinterpret_cast<uint4*>(sr + (1 * 64 + lane) * 8) = q1;
      *reinterpret_cast<uint4*>(sr + (2 * 64 + lane) * 8) = q2; *reinterpret_cast<uint4*>(sr + (3 * 64 + lane) * 8) = q3;
      *reinterpret_cast<uint4*>(sr + (4 * 64 + lane) * 8) = q4; *reinterpret_cast<uint4*>(sr + (5 * 64 + lane) * 8) = q5;
      *reinterpret_cast<uint4*>(sr + (6 * 64 + lane) * 8) = q6; *reinterpret_cast<uint4*>(sr + (7 * 64 + lane) * 8) = q7;
    }
    __builtin_amdgcn_wave_barrier();
    const int l0 = lane * 16;
    float alt = 0.f;
    uint32_t oa[8], ob[8];
#pragma unroll
    for (int half = 0; half < 2; ++half) {
      const bf16_t* base = sr + half * 2048;
      const uint4 fa = *reinterpret_cast<const uint4*>(base + l0), fb = *reinterpret_cast<const uint4*>(base + l0 + 8);
      const uint4 ra = *reinterpret_cast<const uint4*>(base + 2032 - l0), rb = *reinterpret_cast<const uint4*>(base + 2040 - l0);
      const float r16 = (lane > 0) ? bf2f(base[2048 - l0]) : 0.f;
      const uint32_t fw[8] = {fa.x, fa.y, fa.z, fa.w, fb.x, fb.y, fb.z, fb.w};
      const uint32_t rw[8] = {ra.x, ra.y, ra.z, ra.w, rb.x, rb.y, rb.z, rb.w};
      float v[16];
#pragma unroll
      for (int i = 0; i < 16; ++i) {
        const float fwv = (i & 1) ? bfhi(fw[i >> 1]) : bflo(fw[i >> 1]);
        const int j = 16 - i;
        const float rv = (i == 0) ? r16 : ((j & 1) ? bfhi(rw[j >> 1]) : bflo(rw[j >> 1]));
        if (half == 0) v[i] = (lane == 0 && i == 0) ? fwv : fwv + rv;
        else v[i] = (lane == 0 && i == 0) ? 0.f : fwv - rv;
      }
      if (half == 0) {
#pragma unroll
        for (int i = 0; i < 16; ++i) alt += (i & 1) ? -v[i] : v[i];
#pragma unroll
        for (int i = 0; i < 8; ++i) oa[i] = pack2(v[2 * i], v[2 * i + 1]);
      } else {
#pragma unroll
        for (int i = 0; i < 8; ++i) ob[i] = pack2(v[2 * i], v[2 * i + 1]);
      }
    }
    *reinterpret_cast<uint4*>(F + l0) = uint4{oa[0], oa[1], oa[2], oa[3]};
    *reinterpret_cast<uint4*>(F + l0 + 8) = uint4{oa[4], oa[5], oa[6], oa[7]};
    *reinterpret_cast<uint4*>(F + 1024 + l0) = uint4{ob[0], ob[1], ob[2], ob[3]};
    *reinterpret_cast<uint4*>(F + 1024 + l0 + 8) = uint4{ob[4], ob[5], ob[6], ob[7]};
    alt = wave_sum_fast(alt) + bf2f(sr[1024]);
    if (lane == 0) { const int b = row >> 10, ch = row & 1023; p.ycat[((size_t)b * L + 1024) * D + ch] = f2bf(alt); }
  }
}
__device__ void phase_ssm_pre(const Params& p, int bid, int nb, char* smem) {
  const int tid = threadIdx.x;
  dft_fold_rows(p, bid, nb, smem);
  for (int t = bid; t < 3072 + 384; t += nb) ssm_pre_tile(p, t, smem);
  for (int i = bid * NTHREADS + tid; i < (T + TC) * 32; i += nb * NTHREADS) {
    const bool isx = i < T * 32;
    const int ii = isx ? i : i - T * 32;
    const int t = ii >> 5, j = ii & 31;
    const float v = (isx ? p.dtraw : p.dtraw_c)[ii];
    float* df = isx ? p.dtf : p.dtf_c;
    float* db = isx ? p.dtb : p.dtb_c;
    if (j < 16) df[t * 16 + j] = softplus_f(v + p.dt_bias_f[j]);
    else db[t * 16 + (j - 16)] = softplus_f(v + p.dt_bias_b[j - 16]);
  }
}

__device__ __forceinline__ int swz16(int row, int chunk) { return row * 256 + ((chunk ^ (row & 15)) << 4); }
__device__ __forceinline__ int swz8(int row, int chunk) { return row * 128 + ((chunk ^ (row & 7)) << 4); }

#define LDS_BARRIER() asm volatile("s_waitcnt lgkmcnt(0)\n\ts_barrier" ::: "memory")
__device__ void ssd_task(const Params& p, int task, char* smem) {
  const int dir = task & 1, ph = (task >> 1) & 1, h = (task >> 2) & 15, b = task >> 6;
  const int tid = opaque_tid(), lane = tid & 63, w = tid >> 6;
  const int g = h >> 3, lr0 = lane & 15, lq0 = lane >> 4;
  const float a = -__expf(dir ? p.a_log_b[h] : p.a_log_f[h]);
  char* sCc = smem; char* sBc = smem + 16384; char* sBT = smem + 32768; char* sXT = smem + 49152; char* sHb = smem + 57344;
  float* se = reinterpret_cast<float*>(smem + 73728);
  float* sdt = se + 64; float* sw = se + 128; float* sy = se + 192; float* stot = se + 256;
  bf16_t* yo = reinterpret_cast<bf16_t*>(dir ? p.yb : p.yf);
  f32x4 H[2][2];
#pragma unroll
  for (int i = 0; i < 2; ++i)
#pragma unroll
    for (int j = 0; j < 2; ++j) H[i][j] = f32x4{0.f, 0.f, 0.f, 0.f};
  __syncthreads();
  for (int i = tid; i < 512; i += NTHREADS) reinterpret_cast<uint4*>(sHb)[i] = uint4{0, 0, 0, 0};

  const int crow = tid >> 4, cch = tid & 15;
  const int trow = tid >> 3, tch = tid & 7;
  uint4 rC0, rC1, rC2, rC3, rB0, rB1, rB2, rB3, rT0, rT1, rT2, rT3, rX;
  rC0 = rC1 = rC2 = rC3 = rB0 = rB1 = rB2 = rB3 = uint4{0, 0, 0, 0};
  float rdt = 0.f;
#define SSD_PARAMS(st_)                                                                                                   \
  const bool isctx_ = (st_) < 4;                                                                                          \
  const int nch_ = isctx_ ? 4 : 32, ci_ = isctx_ ? (st_) : (st_) - 4;                                                     \
  const int c_ = dir ? (nch_ - 1 - ci_) : ci_;                                                                            \
  const int seqlen_ = isctx_ ? CTX : L;                                                                                   \
  const size_t trow0_ = isctx_ ? ((size_t)T + (size_t)b * CTX + c_ * 64) : ((size_t)b * L + c_ * 64);                     \
  const size_t drow0_ = (size_t)b * seqlen_ + c_ * 64;                                                                    \
  const float* dtp_ = isctx_ ? (dir ? p.dtb_c : p.dtf_c) : (dir ? p.dtb : p.dtf);                                         \
  const bf16_t* cm_ = (isctx_ ? p.act_cm_c : p.act_cm_x) + (size_t)b * 1280 * seqlen_ + c_ * 64;
#define SSD_PREFETCH(st_)                                                                                                 \
  do {                                                                                                                    \
    SSD_PARAMS(st_)                                                                                                       \
    if (w == 0) rdt = dtp_[(drow0_ + lane) * 16 + h];                                                                     \
    if (!isctx_) {                                                                                                        \
      const bf16_t* src = p.act_tm + (trow0_ + crow) * DXBC + g * 128 + cch * 8;                                          \
      rC0 = *reinterpret_cast<const uint4*>(src + 1280);             rB0 = *reinterpret_cast<const uint4*>(src + 1024);   \
      rC1 = *reinterpret_cast<const uint4*>(src + 16 * DXBC + 1280); rB1 = *reinterpret_cast<const uint4*>(src + 16 * DXBC + 1024); \
      rC2 = *reinterpret_cast<const uint4*>(src + 32 * DXBC + 1280); rB2 = *reinterpret_cast<const uint4*>(src + 32 * DXBC + 1024); \
      rC3 = *reinterpret_cast<const uint4*>(src + 48 * DXBC + 1280); rB3 = *reinterpret_cast<const uint4*>(src + 48 * DXBC + 1024); \
    }                                                                                                                     \
    const bf16_t* srt = cm_ + (size_t)(1024 + g * 128 + trow) * seqlen_ + tch * 8;                                        \
    rT0 = *reinterpret_cast<const uint4*>(srt);                                                                           \
    rT1 = *reinterpret_cast<const uint4*>(srt + (size_t)32 * seqlen_);                                                    \
    rT2 = *reinterpret_cast<const uint4*>(srt + (size_t)64 * seqlen_);                                                    \
    rT3 = *reinterpret_cast<const uint4*>(srt + (size_t)96 * seqlen_);                                                    \
    rX = *reinterpret_cast<const uint4*>(cm_ + (size_t)(h * 64 + ph * 32 + trow) * seqlen_ + tch * 8);                    \
  } while (0)

  for (int step = 0; step < 36; ++step) {
    SSD_PREFETCH(step);
    const bool isctx = step < 4;
    const int c = dir ? ((isctx ? 4 : 32) - 1 - (isctx ? step : step - 4)) : (isctx ? step : step - 4);
    const size_t trow0 = (size_t)b * L + c * 64;
    int lr = lr0, lq = lq0;
    asm volatile("" : "+v"(lr), "+v"(lq));
    LDS_BARRIER();
    if (w == 0) {
      const float dtv = rdt;
      const float adt = a * dtv;
      float v = adt;
      v += __builtin_bit_cast(float, __builtin_amdgcn_update_dpp(0, __builtin_bit_cast(int, v), 0x111, 0xF, 0xF, false));
      v += __builtin_bit_cast(float, __builtin_amdgcn_update_dpp(0, __builtin_bit_cast(int, v), 0x112, 0xF, 0xF, false));
      v += __builtin_bit_cast(float, __builtin_amdgcn_update_dpp(0, __builtin_bit_cast(int, v), 0x114, 0xF, 0xF, false));
      v += __builtin_bit_cast(float, __builtin_amdgcn_update_dpp(0, __builtin_bit_cast(int, v), 0x118, 0xF, 0xF, false));
      v += __builtin_bit_cast(float, __builtin_amdgcn_update_dpp(0, __builtin_bit_cast(int, v), 0x142, 0xA, 0xF, false));
      v += __builtin_bit_cast(float, __builtin_amdgcn_update_dpp(0, __builtin_bit_cast(int, v), 0x143, 0xC, 0xF, false));
      const float etot = __builtin_bit_cast(float, __builtin_amdgcn_readlane(__builtin_bit_cast(int, v), 63));
      if (dir) v = etot - v + adt;
      se[lane] = v; sdt[lane] = dtv; sw[lane] = dtv * __expf(etot - v); sy[lane] = __expf(v);
      if (lane == 0) stot[0] = etot;
    }
    if (!isctx) {
      const int oc = swz16(crow, cch);
      *reinterpret_cast<uint4*>(sCc + oc) = rC0;         *reinterpret_cast<uint4*>(sBc + oc) = rB0;
      *reinterpret_cast<uint4*>(sCc + oc + 4096) = rC1;  *reinterpret_cast<uint4*>(sBc + oc + 4096) = rB1;
      *reinterpret_cast<uint4*>(sCc + oc + 8192) = rC2;  *reinterpret_cast<uint4*>(sBc + oc + 8192) = rB2;
      *reinterpret_cast<uint4*>(sCc + oc + 12288) = rC3; *reinterpret_cast<uint4*>(sBc + oc + 12288) = rB3;
    }
    {
      const int ot = swz8(trow, tch);
      *reinterpret_cast<uint4*>(sBT + ot) = rT0;
      *reinterpret_cast<uint4*>(sBT + ot + 4096) = rT1;
      *reinterpret_cast<uint4*>(sBT + ot + 8192) = rT2;
      *reinterpret_cast<uint4*>(sBT + ot + 12288) = rT3;
      *reinterpret_cast<uint4*>(sXT + ot) = rX;
    }
    LDS_BARRIER();
    const float etot = stot[0];
    if (!isctx) {
      f32x4 G[4];
      bf16x8 ca[4];
#pragma unroll
      for (int j = 0; j < 4; ++j) G[j] = f32x4{0.f, 0.f, 0.f, 0.f};
#pragma unroll
      for (int kk = 0; kk < 4; ++kk) ca[kk] = *reinterpret_cast<const bf16x8*>(sCc + swz16(16 * w + lr, kk * 4 + lq));
#pragma unroll
      for (int kk = 0; kk < 4; ++kk)
#pragma unroll
        for (int j = 0; j < 4; ++j) {
          bf16x8 bb = *reinterpret_cast<const bf16x8*>(sBc + swz16(16 * j + lr, kk * 4 + lq));
          G[j] = __builtin_amdgcn_mfma_f32_16x16x32_bf16(ca[kk], bb, G[j], 0, 0, 0);
        }
      LDS_BARRIER();
      float el[4];
#pragma unroll
      for (int r = 0; r < 4; ++r) el[r] = se[16 * w + lq * 4 + r];
#pragma unroll
      for (int j = 0; j < 4; ++j) {
        const int s_ = 16 * j + lr;
        const float es = se[s_], ds = sdt[s_];
#pragma unroll
        for (int r = 0; r < 4; ++r) {
          const int l = 16 * w + lq * 4 + r;
          const bool keep = dir ? (s_ >= l) : (s_ <= l);
          const float m = keep ? G[j][r] * __expf(el[r] - es) * ds : 0.f;
          *reinterpret_cast<bf16_t*>(sBc + swz8(l, s_ >> 3) + (s_ & 7) * 2) = f2bf(m);
        }
      }
      LDS_BARRIER();
      f32x4 Y[2], Yo[2];
#pragma unroll
      for (int j = 0; j < 2; ++j) { Y[j] = f32x4{0.f, 0.f, 0.f, 0.f}; Yo[j] = f32x4{0.f, 0.f, 0.f, 0.f}; }
#pragma unroll
      for (int kk = 0; kk < 2; ++kk) {
        bf16x8 ma = *reinterpret_cast<const bf16x8*>(sBc + swz8(16 * w + lr, kk * 4 + lq));
#pragma unroll
        for (int j = 0; j < 2; ++j) {
          bf16x8 xb = *reinterpret_cast<const bf16x8*>(sXT + swz8(16 * j + lr, kk * 4 + lq));
          Y[j] = __builtin_amdgcn_mfma_f32_16x16x32_bf16(ma, xb, Y[j], 0, 0, 0);
        }
      }
#pragma unroll
      for (int kk = 0; kk < 4; ++kk)
#pragma unroll
        for (int j = 0; j < 2; ++j) {
          bf16x8 hb = *reinterpret_cast<const bf16x8*>(sHb + swz16(16 * j + lr, kk * 4 + lq));
          Yo[j] = __builtin_amdgcn_mfma_f32_16x16x32_bf16(ca[kk], hb, Yo[j], 0, 0, 0);
        }
      float syl[4];
#pragma unroll
      for (int r = 0; r < 4; ++r) syl[r] = sy[16 * w + lq * 4 + r];
#pragma unroll
      for (int j = 0; j < 2; ++j)
#pragma unroll
        for (int r = 0; r < 4; ++r) {
          const int l = 16 * w + lq * 4 + r;
          yo[(trow0 + l) * 1024 + h * 64 + ph * 32 + 16 * j + lr] = f2bf(Y[j][r] + syl[r] * Yo[j][r]);
        }
    }
    {
      const float dec = __expf(etot);
#pragma unroll
      for (int i = 0; i < 2; ++i)
#pragma unroll
        for (int j = 0; j < 2; ++j) H[i][j] *= dec;
#pragma unroll
      for (int kk = 0; kk < 2; ++kk) {
        const int s0 = kk * 32 + lq * 8;
        const float4 w0 = *reinterpret_cast<const float4*>(sw + s0), w1 = *reinterpret_cast<const float4*>(sw + s0 + 4);
        bf16x8 xs[2];
#pragma unroll
        for (int i = 0; i < 2; ++i) {
          const bf16x8 xa = *reinterpret_cast<const bf16x8*>(sXT + swz8(16 * i + lr, kk * 4 + lq));
          xs[i][0] = (short)f2bf(bf2f((bf16_t)xa[0]) * w0.x); xs[i][1] = (short)f2bf(bf2f((bf16_t)xa[1]) * w0.y);
          xs[i][2] = (short)f2bf(bf2f((bf16_t)xa[2]) * w0.z); xs[i][3] = (short)f2bf(bf2f((bf16_t)xa[3]) * w0.w);
          xs[i][4] = (short)f2bf(bf2f((bf16_t)xa[4]) * w1.x); xs[i][5] = (short)f2bf(bf2f((bf16_t)xa[5]) * w1.y);
          xs[i][6] = (short)f2bf(bf2f((bf16_t)xa[6]) * w1.z); xs[i][7] = (short)f2bf(bf2f((bf16_t)xa[7]) * w1.w);
        }
#pragma unroll
        for (int j = 0; j < 2; ++j) {
          const bf16x8 bt = *reinterpret_cast<const bf16x8*>(sBT + swz8(16 * (2 * w + j) + lr, kk * 4 + lq));
#pragma unroll
          for (int i = 0; i < 2; ++i) H[i][j] = __builtin_amdgcn_mfma_f32_16x16x32_bf16(xs[i], bt, H[i][j], 0, 0, 0);
        }
      }
    }
    LDS_BARRIER();
#pragma unroll
    for (int i = 0; i < 2; ++i)
#pragma unroll
      for (int j = 0; j < 2; ++j) {
        const int n = 16 * (2 * w + j) + lr;
#pragma unroll
        for (int r = 0; r < 4; ++r) {
          const int pr = 16 * i + lq * 4 + r;
          *reinterpret_cast<bf16_t*>(sHb + swz16(pr, n >> 3) + (n & 7) * 2) = f2bf(H[i][j][r]);
        }
      }
  }
#undef SSD_PREFETCH
#undef SSD_PARAMS
}

#undef LDS_BARRIER
__device__ void phase_ssd_dft(const Params& p, int bid, int nb, char* smem) {
  for (int t = bid; t < 256; t += nb) ssd_task(p, t, smem);
  int* stile = reinterpret_cast<int*>(smem + 75776);
  for (;;) {
    __syncthreads();
    if (threadIdx.x == 0) *stile = (int)atomicAdd(p.ctr, 1u);
    __syncthreads();
    const int t = *stile;
    if (t >= 4 * 8 * 8) break;
    const int b = t >> 6, tm = (t & 63) >> 3, tn = t & 7;
    const bf16_t* Fb = p.Fs + (size_t)b * 1024 * 2048;
    f32x4 accC[4][4], accS[4][4];
    gemm_mainloop(p.dftm, 2048, Fb, 2048, 1024, tm * 128, tn * 128, accC, smem);
    gemm_mainloop(p.dftm + 1024, 2048, Fb + 1024, 2048, 1024, tm * 128, tn * 128, accS, smem);
    const int lane = threadIdx.x & 63, w = threadIdx.x >> 6, wm = w >> 1, wn = w & 1;
#pragma unroll
    for (int i = 0; i < 4; ++i) {
      int lq_ = lane >> 4, lr_ = lane & 15;
      asm volatile("" : "+v"(lq_), "+v"(lr_));
#pragma unroll
      for (int j = 0; j < 4; ++j) {
        const int k0 = tm * 128 + wm * 64 + i * 16 + lq_ * 4;
        const int ch = tn * 128 + wn * 64 + j * 16 + lr_;
        const float a = bf2f(p.ABt[((size_t)b * 1024 + ch) * 4096 + 1024]);
#pragma unroll
        for (int r = 0; r < 4; ++r) {
          const int k = k0 + r;
          const float as = (k & 1) ? -a : a;
          const float c = accC[i][j][r], sn = accS[i][j][r];
          p.ycat[((size_t)b * L + k) * D + ch] = f2bf(c - sn + as);
          if (k > 0) p.ycat[((size_t)b * L + (L - k)) * D + ch] = f2bf(c + sn + as);
        }
      }
    }
  }
  for (;;) {
    __syncthreads();
    if (threadIdx.x == 0) *stile = (int)atomicAdd(p.ctr + 8, 1u);
    __syncthreads();
    const int q4 = *stile;
    if (q4 >= (1024 + 1536) / 4) break;
#pragma unroll 1
    for (int q = q4 * 4; q < q4 * 4 + 4; ++q) {
      if (q < 512) convert_u_rows(p, q);
      else if (q < 1024) convert_v_units(p, (size_t)(q - 512) * 4096, (size_t)(q - 511) * 4096);
      else if (q < 1024 + 1024) { const int q1 = q - 1024; transpose_convert_task(p.w_out, D, 0, D, p.w_out_t, q1 / 32, q1 % 32, reinterpret_cast<float*>(smem)); }
      else { const int q2 = q - 2048; transpose_convert_task(p.w_query, 1024, 0, D, p.w_q_t, q2 / 16, q2 % 16, reinterpret_cast<float*>(smem)); }
    }
  }
}

__device__ void phase_ssm_post(const Params& p, int bid, int nb, char* smem) {
  const int lane = threadIdx.x & 63, w = threadIdx.x >> 6;
  for (int t = bid * 4 + w; t < T; t += nb * 4) {
    float y[4][4];
    float ss0 = 0.f, ss1 = 0.f;
#pragma unroll
    for (int c = 0; c < 4; ++c) {
      const int c0 = c * 256 + lane * 4;
      const int h = c0 >> 6;
      const float dsk = p.d_skip_f[h] + p.d_skip_b[h];
      const uint2 aq = *reinterpret_cast<const uint2*>(reinterpret_cast<const bf16_t*>(p.yf) + (size_t)t * 1024 + c0);
      const uint2 bb = *reinterpret_cast<const uint2*>(reinterpret_cast<const bf16_t*>(p.yb) + (size_t)t * 1024 + c0);
      const float4 a = float4{bflo(aq.x), bfhi(aq.x), bflo(aq.y), bfhi(aq.y)};
      const float4 bq = float4{bflo(bb.x), bfhi(bb.x), bflo(bb.y), bfhi(bb.y)};
      const uint2 xq = *reinterpret_cast<const uint2*>(p.act_tm + (size_t)t * DXBC + c0);
      const uint2 zz = *reinterpret_cast<const uint2*>(p.z + (size_t)t * 1024 + c0);
      y[c][0] = (a.x + bq.x + dsk * bflo(xq.x)) * silu_f(bflo(zz.x));
      y[c][1] = (a.y + bq.y + dsk * bfhi(xq.x)) * silu_f(bfhi(zz.x));
      y[c][2] = (a.z + bq.z + dsk * bflo(xq.y)) * silu_f(bflo(zz.y));
      y[c][3] = (a.w + bq.w + dsk * bfhi(xq.y)) * silu_f(bfhi(zz.y));
      const float q = y[c][0] * y[c][0] + y[c][1] * y[c][1] + y[c][2] * y[c][2] + y[c][3] * y[c][3];
      if (c < 2) ss0 += q; else ss1 += q;
    }
    ss0 = wave_sum_fast(ss0); ss1 = wave_sum_fast(ss1);
    const float r0 = rsqrtf(ss0 * (1.f / 512.f) + EPS), r1 = rsqrtf(ss1 * (1.f / 512.f) + EPS);
    uint2 fq[4];
    float am = 0.f;
#pragma unroll
    for (int c = 0; c < 4; ++c) {
      const int c0 = c * 256 + lane * 4;
      fq[c] = *reinterpret_cast<const uint2*>(p.ycat + (size_t)t * D + c0);
      am = fmaxf(am, fmaxf(fmaxf(fabsf(bflo(fq[c].x)), fabsf(bfhi(fq[c].x))), fmaxf(fabsf(bflo(fq[c].y)), fabsf(bfhi(fq[c].y)))));
      const float rstd = (c < 2) ? r0 : r1;
      const float4 nw = *reinterpret_cast<const float4*>(p.ssm_norm_w + c0);
      y[c][0] *= rstd * nw.x; y[c][1] *= rstd * nw.y; y[c][2] *= rstd * nw.z; y[c][3] *= rstd * nw.w;
      am = fmaxf(am, fmaxf(fmaxf(fabsf(y[c][0]), fabsf(y[c][1])), fmaxf(fabsf(y[c][2]), fabsf(y[c][3]))));
    }
    am = wave_max_fast(am);
    const float inv = (am > 0.f) ? 127.f / am : 0.f;
#pragma unroll
    for (int c = 0; c < 4; ++c) {
      const int c0 = c * 256 + lane * 4;
      *reinterpret_cast<uint32_t*>(p.ycat8 + (size_t)t * D + c0) =
          pack_i8x4(bflo(fq[c].x) * inv, bfhi(fq[c].x) * inv, bflo(fq[c].y) * inv, bfhi(fq[c].y) * inv);
      *reinterpret_cast<uint32_t*>(p.ycat8 + (size_t)t * D + 1024 + c0) = pack_i8x4(y[c][0] * inv, y[c][1] * inv, y[c][2] * inv, y[c][3] * inv);
    }
    if (lane == 0) p.yscale[t] = am * (1.f / 127.f);
  }
  quant_weight_rows_i8(p.w_out_t, p.wo8, p.woscale, D, bid, nb);
  quant_weight_rows_i8(p.w_q_t, p.wq8, p.wqscale, 1024, bid, nb);
}

__device__ void phase_outproj(const Params& p, int bid, int nb, char* smem) {
  const bool aware = (nb & 7) == 0;
  const int start = aware ? (bid >> 3) : bid, step = aware ? (nb >> 3) : nb, end = aware ? 64 : 512;
  const bf16_t* a8 = reinterpret_cast<const bf16_t*>(p.ycat8);
  const bf16_t* b8 = reinterpret_cast<const bf16_t*>(p.wo8);
  for (int it = start; it < end; it += step) {
    const int x = aware ? (bid & 7) : (it >> 6), s_ = aware ? it : (it & 63);
    EpiBf16 epi{reinterpret_cast<bf16_t*>(p.y_x), D};
    gemm_tile_n256<true>(a8, D / 2, b8, D / 2, D / 2, (8 * x + (s_ & 7)) * 128, (s_ >> 3) * 256, epi, smem, p.yscale, p.woscale);
  }
}
__device__ void phase_postmix(const Params& p, int bid, int nb, char* smem) {
  const int lane = threadIdx.x & 63, w = threadIdx.x >> 6;
  for (int t = bid * 4 + w; t < T; t += nb * 4) {
    const int b = t / L;
    float4 y[8];
    float ss = 0.f;
#pragma unroll
    for (int c = 0; c < 8; ++c) {
      {
        const uint2 yq = *reinterpret_cast<const uint2*>(reinterpret_cast<const bf16_t*>(p.y_x) + (size_t)t * D + c * 256 + lane * 4);
        y[c] = float4{bflo(yq.x), bfhi(yq.x), bflo(yq.y), bfhi(yq.y)};
      }
      ss += y[c].x * y[c].x + y[c].y * y[c].y + y[c].z * y[c].z + y[c].w * y[c].w;
    }
    ss = wave_sum_fast(ss);
    const float rstd = rsqrtf(ss * (1.f / D) + EPS);
    const float* gm = p.mod + (size_t)b * NMOD + 2 * D;
    float ss1 = 0.f;
#pragma unroll
    for (int c = 0; c < 8; ++c) {
      const int e0 = c * 256 + lane * 4;
      const float4 xv = *reinterpret_cast<const float4*>(p.x + (size_t)t * D + e0);
      const float4 g4 = *reinterpret_cast<const float4*>(gm + e0), gp = *reinterpret_cast<const float4*>(p.g_post_mix + e0);
      y[c].x = xv.x + g4.x * (y[c].x * rstd * gp.x); y[c].y = xv.y + g4.y * (y[c].y * rstd * gp.y);
      y[c].z = xv.z + g4.z * (y[c].z * rstd * gp.z); y[c].w = xv.w + g4.w * (y[c].w * rstd * gp.w);
      ss1 += y[c].x * y[c].x + y[c].y * y[c].y + y[c].z * y[c].z + y[c].w * y[c].w;
    }
    if (lane == 0) p.partial[t] = rstd;
    ss1 = wave_sum_fast(ss1);
    const float rstd1 = rsqrtf(ss1 * (1.f / D) + EPS);
    const float* sf = p.mod + (size_t)b * NMOD + 3 * D;
    const float* cf = p.mod + (size_t)b * NMOD + 4 * D;
    float am = 0.f;
#pragma unroll
    for (int c = 0; c < 8; ++c) {
      const int e0 = c * 256 + lane * 4;
      const float4 g = *reinterpret_cast<const float4*>(p.g_pre_ffn + e0);
      const float4 s4 = *reinterpret_cast<const float4*>(cf + e0), h4 = *reinterpret_cast<const float4*>(sf + e0);
      y[c].x = y[c].x * rstd1 * g.x * (1.f + s4.x) + h4.x; y[c].y = y[c].y * rstd1 * g.y * (1.f + s4.y) + h4.y;
      y[c].z = y[c].z * rstd1 * g.z * (1.f + s4.z) + h4.z; y[c].w = y[c].w * rstd1 * g.w * (1.f + s4.w) + h4.w;
      am = fmaxf(am, fmaxf(fmaxf(fabsf(y[c].x), fabsf(y[c].y)), fmaxf(fabsf(y[c].z), fabsf(y[c].w))));
    }
    am = wave_max_fast(am);
    const float inv = (am > 0.f) ? 127.f / am : 0.f;
#pragma unroll
    for (int c = 0; c < 8; ++c)
      *reinterpret_cast<uint32_t*>(p.hx8a + (size_t)t * D + c * 256 + lane * 4) = pack_i8x4(y[c].x * inv, y[c].y * inv, y[c].z * inv, y[c].w * inv);
    if (lane == 0) p.ascale[t] = am * (1.f / 127.f);
  }
}

__device__ __forceinline__ uint32_t mono_key(float f) {
  uint32_t u = __float_as_uint(f);
  return (u & 0x80000000u) ? ~u : (u | 0x80000000u);
}
__device__ __forceinline__ void ins16(uint32_t (&Lk)[16], uint32_t x) {
#pragma unroll
  for (int i = 0; i < 16; ++i) { uint32_t hi = max(Lk[i], x); x = min(Lk[i], x); Lk[i] = hi; }
}
__device__ __forceinline__ float unmono_key(uint32_t k) {
  return __uint_as_float((k & 0x80000000u) ? (k ^ 0x80000000u) : ~k);
}
typedef __attribute__((ext_vector_type(16))) float f32x16;
__device__ void phase_q_route(const Params& p, int bid, int nb, char* smem) {
  const int tid = opaque_tid(), lane = tid & 63, w = tid >> 6;
  const int wm = w >> 1, wn = w & 1, lr = lane & 15, lq = lane >> 4;
  const int l31 = lane & 31, lh = lane >> 5;
  for (int tile0 = bid; tile0 < 512; tile0 += nb) {
    const int tile = ((nb & 7) == 0 && nb >= 512) ? (((tile0 & 7) * 8 + ((tile0 >> 3) & 7)) * 8 + (tile0 >> 6)) : tile0;
    const int h = tile & 7, m0 = (tile >> 3) * 128;
    {
      f32x4 acc[4][4];
      gemm_mainloop<true>(reinterpret_cast<const bf16_t*>(p.hx8a), D / 2, reinterpret_cast<const bf16_t*>(p.wq8), D / 2, D / 2, m0, h * 128, acc, smem);
#pragma unroll
      for (int i = 0; i < 4; ++i) {
        const float4 rs = *reinterpret_cast<const float4*>(p.ascale + m0 + wm * 64 + i * 16 + lq * 4);
#pragma unroll
        for (int j = 0; j < 4; ++j) {
          typedef __attribute__((ext_vector_type(4))) int i32x4;
          const i32x4 ia = __builtin_bit_cast(i32x4, acc[i][j]);
          const float cs = p.wqscale[h * 128 + wn * 64 + j * 16 + lr];
          const float qv[4] = {(float)ia[0] * rs.x * cs, (float)ia[1] * rs.y * cs, (float)ia[2] * rs.z * cs, (float)ia[3] * rs.w * cs};
#pragma unroll
          for (int r = 0; r < 4; ++r) {
            const int row = wm * 64 + i * 16 + lq * 4 + r, col = wn * 64 + j * 16 + lr;
            *reinterpret_cast<bf16_t*>(smem + swz16(row, col >> 3) + (col & 7) * 2) = f2bf(qv[r]);
          }
        }
      }
    }
#pragma unroll 4
    for (int r = 0; r < 16; ++r) {
      const int id = tid + 256 * r, row = id >> 4, c4 = id & 15;
      const float* src = ((row < 128) ? p.sk1 : p.sk2) + ((size_t)(h * 128 + (row & 127)) * 64 + c4 * 4);
      const float4 v = *reinterpret_cast<const float4*>(src);
      uint2 pk; pk.x = pack2(v.x, v.y); pk.y = pack2(v.z, v.w);
      *reinterpret_cast<uint2*>(smem + 32768 + swz8(row, c4 >> 1) + (c4 & 1) * 8) = pk;
    }
    __syncthreads();
    uint32_t L1[16], L2[16];
#pragma unroll
    for (int sd = 0; sd < 2; ++sd) {
      uint32_t Lk[16];
#pragma unroll
      for (int i = 0; i < 16; ++i) Lk[i] = 0u;
      const uint32_t kb = (uint32_t)(lh * 4);
#pragma unroll
      for (int ih = 0; ih < 2; ++ih) {
        f32x16 Sa[2];
#pragma unroll
        for (int i = 0; i < 2; ++i)
#pragma unroll
          for (int g2 = 0; g2 < 16; ++g2) Sa[i][g2] = 0.f;
#pragma unroll
        for (int ks = 0; ks < 4; ++ks) {
          const bf16x8 qb = *reinterpret_cast<const bf16x8*>(smem + swz16(w * 32 + l31, sd * 8 + ks * 2 + lh));
#pragma unroll
          for (int i = 0; i < 2; ++i) {
            const bf16x8 ka = *reinterpret_cast<const bf16x8*>(smem + 32768 + swz8(sd * 128 + (ih * 2 + i) * 32 + l31, ks * 2 + lh));
            Sa[i] = __builtin_amdgcn_mfma_f32_32x32x16_bf16(ka, qb, Sa[i], 0, 0, 0);
          }
        }
#pragma unroll
        for (int i = 0; i < 2; ++i)
#pragma unroll
          for (int g2 = 0; g2 < 16; ++g2)
            ins16(Lk, (mono_key(Sa[i][g2]) & ~0x7Fu) | (uint32_t)((ih * 2 + i) * 32 + (g2 & 3) + 8 * (g2 >> 2)) | kb);
      }
#pragma unroll
      for (int i = 0; i < 8; ++i) {
        const uint32_t t1 = (uint32_t)__shfl_xor((int)Lk[15 - i], 32), t2 = (uint32_t)__shfl_xor((int)Lk[i], 32);
        Lk[i] = max(Lk[i], t1); Lk[15 - i] = max(Lk[15 - i], t2);
      }
#pragma unroll
      for (int dd = 8; dd >= 1; dd >>= 1)
#pragma unroll
        for (int i = 0; i < 16; ++i)
          if ((i & dd) == 0) { const uint32_t hi = max(Lk[i], Lk[i + dd]), lo = min(Lk[i], Lk[i + dd]); Lk[i] = hi; Lk[i + dd] = lo; }
#pragma unroll
      for (int r = 0; r < 16; ++r) { if (sd == 0) L1[r] = Lk[r]; else L2[r] = Lk[r]; }
    }
    __syncthreads();
    uint32_t* ib = reinterpret_cast<uint32_t*>(smem) + w * 1088 + l31 * 34;
    if (lh == 0) {
#pragma unroll
      for (int r = 0; r < 16; ++r) { ib[r] = L1[r] & 127u; ib[16 + r] = L2[r] & 127u; }
    }
    float v1[16], v2[16];
#pragma unroll
    for (int r = 0; r < 16; ++r) { v1[r] = unmono_key(L1[r] & ~0x7Fu); v2[r] = unmono_key(L2[r] & ~0x7Fu); }
    uint32_t C[16];
#pragma unroll
    for (int i = 0; i < 16; ++i) C[i] = 0u;
#pragma unroll
    for (int a = 0; a < 16; ++a)
#pragma unroll
      for (int bq = 0; bq < 16; ++bq)
        if ((a + 1) * (bq + 1) <= 16) ins16(C, (mono_key(v1[a] + v2[bq]) & ~0xFFu) | (uint32_t)(a * 16 + bq));
    float ts[16]; int te[16];
    __builtin_amdgcn_wave_barrier();
#pragma unroll
    for (int r = 0; r < 16; ++r) {
      const uint32_t code = C[r] & 0xFFu;
      te[r] = (int)(ib[code >> 4] * 128u + ib[16 + (code & 15u)]);
      ts[r] = unmono_key(C[r] & ~0xFFu);
    }
    const float mx = ts[0];
    float den = 0.f;
#pragma unroll
    for (int r = 0; r < 16; ++r) { ts[r] = __expf(ts[r] - mx); den += ts[r]; }
    const float inv = 1.f / den;
    const size_t ob = (size_t)(m0 + w * 32 + l31) * 128 + h * 16;
    if (lh == 0) {
#pragma unroll
      for (int r = 0; r < 16; r += 4) *reinterpret_cast<int4*>(p.idx + ob + r) = int4{te[r], te[r + 1], te[r + 2], te[r + 3]};
    } else {
#pragma unroll
      for (int r = 0; r < 16; r += 4)
        *reinterpret_cast<float4*>(p.gate + ob + r) = float4{ts[r] * inv, ts[r + 1] * inv, ts[r + 2] * inv, ts[r + 3] * inv};
    }
    __syncthreads();
  }
}

typedef __attribute__((ext_vector_type(2))) float f32x2;
__device__ __forceinline__ void fp8x16_to_f32(const uint4 q, f32x2 (&o)[8]) {
  o[0] = __builtin_amdgcn_cvt_pk_f32_fp8((int)q.x, false); o[1] = __builtin_amdgcn_cvt_pk_f32_fp8((int)q.x, true);
  o[2] = __builtin_amdgcn_cvt_pk_f32_fp8((int)q.y, false); o[3] = __builtin_amdgcn_cvt_pk_f32_fp8((int)q.y, true);
  o[4] = __builtin_amdgcn_cvt_pk_f32_fp8((int)q.z, false); o[5] = __builtin_amdgcn_cvt_pk_f32_fp8((int)q.z, true);
  o[6] = __builtin_amdgcn_cvt_pk_f32_fp8((int)q.w, false); o[7] = __builtin_amdgcn_cvt_pk_f32_fp8((int)q.w, true);
}
__device__ __forceinline__ unsigned my_xcc_id() { return (unsigned)__builtin_amdgcn_s_getreg((3 << 11) | 20) & 7u; }

__device__ void phase_exp_u(const Params& p, char* smem) {
  const int tid = opaque_tid(), lane = tid & 63, w = tid >> 6;
  const int sub = lane >> 4, cc = lane & 15;
  const unsigned myx = my_xcc_id();
  int* sh = reinterpret_cast<int*>(smem);
  int* si = reinterpret_cast<int*>(smem + 64) + w * 256;
  float* pbuf = reinterpret_cast<float*>(p.ycat);
  {
    unsigned qcur = 0;
    for (;;) {
      __syncthreads();
      if (tid == 0) {
        int found = -1; unsigned fx = 0;
        for (; qcur < 8; ++qcur) {
          fx = (myx + qcur) & 7u;
          const int c = (int)atomicAdd(&p.ctr[16 + fx], 1u);
          if (c < 256) { found = c; break; }
        }
        sh[0] = found; sh[1] = (int)fx;
      }
      __syncthreads();
      const int chunk = sh[0];
      const unsigned x = (unsigned)sh[1];
      if (chunk < 0) break;
      for (int tt = 0; tt < 8; ++tt) {
        const int t = chunk * 32 + w * 8 + tt;
        __builtin_amdgcn_wave_barrier();
        si[lane] = p.idx[(size_t)t * 128 + lane]; si[64 + lane] = p.idx[(size_t)t * 128 + 64 + lane];
        __builtin_amdgcn_wave_barrier();
        const uint4 hq = *reinterpret_cast<const uint4*>(p.hx8a + (size_t)t * D + x * 256 + cc * 16);
        const uint8_t* ub = p.U8 + (size_t)x * ((size_t)16384 * 256) + cc * 16;
        uint4 qa[8], qb[8];
#define EU_LOAD(q_, bt_) _Pragma("unroll") for (int k = 0; k < 8; ++k) q_[k] = *reinterpret_cast<const uint4*>(ub + (size_t)si[((bt_) * 8 + k) * 4 + sub] * 256)
#define EU_COMP(q_, kb_)                                                                                                \
  _Pragma("unroll") for (int k = 0; k < 8; ++k) {                                                                       \
    int d = __builtin_amdgcn_sdot4((int)q_[k].x, (int)hq.x, 0, false);                                                  \
    int d1 = __builtin_amdgcn_sdot4((int)q_[k].y, (int)hq.y, 0, false);                                                 \
    d = __builtin_amdgcn_sdot4((int)q_[k].z, (int)hq.z, d, false);                                                      \
    d1 = __builtin_amdgcn_sdot4((int)q_[k].w, (int)hq.w, d1, false);                                                    \
    d += d1;                                                                                                            \
    d += dpp_movi<0xB1>(d); d += dpp_movi<0x4E>(d); d += dpp_movi<0x124>(d); d += dpp_movi<0x128>(d);                   \
    mine = (cc == (kb_) + k) ? d : mine;                                                                                \
  }
        int mine = 0;
        EU_LOAD(qa, 0); EU_LOAD(qb, 1);
        EU_COMP(qa, 0); EU_LOAD(qa, 2);
        EU_COMP(qb, 8); EU_LOAD(qb, 3);
        pbuf[((size_t)x * T + t) * 128 + cc * 4 + sub] = (float)mine;
        mine = 0;
        EU_COMP(qa, 0);
        EU_COMP(qb, 8);
        pbuf[((size_t)x * T + t) * 128 + (16 + cc) * 4 + sub] = (float)mine;
#undef EU_LOAD
#undef EU_COMP
      }
    }
  }
}

__device__ void phase_exp_v(const Params& p, char* smem) {
  const int tid = opaque_tid(), lane = tid & 63, w = tid >> 6;
  const int sub = lane >> 4, cc = lane & 15;
  const unsigned myx = my_xcc_id();
  int* sh = reinterpret_cast<int*>(smem);
  int* si = reinterpret_cast<int*>(smem + 64) + w * 256;
  float* sc = reinterpret_cast<float*>(si + 128);
  bf16_t* yfb = reinterpret_cast<bf16_t*>(p.y_x) + (size_t)T * D;
  {
    unsigned qcur = 0;
    for (;;) {
      __syncthreads();
      if (tid == 0) {
        int found = -1; unsigned fx = 0;
        for (; qcur < 8; ++qcur) {
          fx = (myx + qcur) & 7u;
          const int c = (int)atomicAdd(&p.ctr[32 + fx], 1u);
          if (c < 256) { found = c; break; }
        }
        sh[0] = found; sh[1] = (int)fx;
      }
      __syncthreads();
      const int chunk = sh[0];
      const unsigned x = (unsigned)sh[1];
      if (chunk < 0) break;
      int e0n = p.idx[(size_t)(chunk * 32 + w * 8) * 128 + lane], e1n = p.idx[(size_t)(chunk * 32 + w * 8) * 128 + 64 + lane];
      for (int tt = 0; tt < 8; ++tt) {
        const int t = chunk * 32 + w * 8 + tt;
        const int e0 = e0n, e1 = e1n;
        __builtin_amdgcn_wave_barrier();
        si[lane] = e0; si[64 + lane] = e1;
        __builtin_amdgcn_wave_barrier();
        f32x2 acc[8];
#pragma unroll
        for (int e = 0; e < 8; ++e) acc[e] = f32x2{0.f, 0.f};
        const uint8_t* vb = p.V8 + (size_t)x * ((size_t)16384 * 256) + cc * 16;
        uint4 qa[8], qb[8];
#define EV_LOAD(q_, bt_) _Pragma("unroll") for (int k = 0; k < 8; ++k) q_[k] = *reinterpret_cast<const uint4*>(vb + (size_t)si[((bt_) * 8 + k) * 4 + sub] * 256)
#define EV_COMP(q_, bt_)                                                                                                \
  _Pragma("unroll") for (int k = 0; k < 8; ++k) {                                                                       \
    f32x2 vf[8];                                                                                                        \
    fp8x16_to_f32(q_[k], vf);                                                                                           \
    const float cfk = sc[((bt_) * 8 + k) * 4 + sub];                                                                    \
    const f32x2 c2 = f32x2{cfk, cfk};                                                                                   \
    _Pragma("unroll") for (int e = 0; e < 8; ++e) acc[e] += c2 * vf[e];                                                 \
  }
        EV_LOAD(qa, 0); EV_LOAD(qb, 1);
        if (tt + 1 < 8) { e0n = p.idx[(size_t)(t + 1) * 128 + lane]; e1n = p.idx[(size_t)(t + 1) * 128 + 64 + lane]; }
        {
          const float* pb = reinterpret_cast<const float*>(p.ycat) + (size_t)t * 128;
          float d0 = 0.f, d1 = 0.f;
#pragma unroll
          for (int xs = 0; xs < 8; ++xs) { d0 += pb[(size_t)xs * T * 128 + lane]; d1 += pb[(size_t)xs * T * 128 + 64 + lane]; }
          const float hs = p.ascale[t];
          d0 *= p.uscale[e0] * hs; d1 *= p.uscale[e1] * hs;
          sc[lane] = p.gate[(size_t)t * 128 + lane] * 0.5f * d0 * (1.f + erff(d0 * 0.70710678118654752f));
          sc[64 + lane] = p.gate[(size_t)t * 128 + 64 + lane] * 0.5f * d1 * (1.f + erff(d1 * 0.70710678118654752f));
        }
        __builtin_amdgcn_wave_barrier();
        EV_COMP(qa, 0); EV_LOAD(qa, 2);
        EV_COMP(qb, 1); EV_LOAD(qb, 3);
        EV_COMP(qa, 2);
        EV_COMP(qb, 3);
#undef EV_LOAD
#undef EV_COMP
        {
          float* red = reinterpret_cast<float*>(smem + 8192) + w * 1280;
          float* mr = red + (sub * 16 + cc) * 20;
#pragma unroll
          for (int q4 = 0; q4 < 4; ++q4)
            *reinterpret_cast<float4*>(mr + q4 * 4) = float4{acc[q4 * 2].x, acc[q4 * 2].y, acc[q4 * 2 + 1].x, acc[q4 * 2 + 1].y};
          __builtin_amdgcn_wave_barrier();
          const int part = sub;
          float4 r0 = *reinterpret_cast<const float4*>(red + (0 * 16 + cc) * 20 + part * 4);
          float4 r1 = *reinterpret_cast<const float4*>(red + (1 * 16 + cc) * 20 + part * 4);
          float4 r2 = *reinterpret_cast<const float4*>(red + (2 * 16 + cc) * 20 + part * 4);
          float4 r3 = *reinterpret_cast<const float4*>(red + (3 * 16 + cc) * 20 + part * 4);
          const float sc512 = 1.f / 512.f;
          uint2 o4;
          o4.x = pack2((r0.x + r1.x + r2.x + r3.x) * sc512, (r0.y + r1.y + r2.y + r3.y) * sc512);
          o4.y = pack2((r0.z + r1.z + r2.z + r3.z) * sc512, (r0.w + r1.w + r2.w + r3.w) * sc512);
          *reinterpret_cast<uint2*>(yfb + (size_t)t * D + x * 256 + cc * 16 + part * 4) = o4;
          __builtin_amdgcn_wave_barrier();
        }
      }
    }
  }
}

__device__ void phase_exp_final(const Params& p, int bid, int nb, char* smem) {
  const int lane = threadIdx.x & 63, w = threadIdx.x >> 6;
  const bf16_t* ymix = reinterpret_cast<const bf16_t*>(p.y_x);
  const bf16_t* yf = reinterpret_cast<const bf16_t*>(p.y_x) + (size_t)T * D;
  for (int t = bid * 4 + w; t < T; t += nb * 4) {
    const int b = t / L;
    float4 y[8], xo[8];
#pragma unroll
    for (int c = 0; c < 8; ++c) {
      const uint2 yq = *reinterpret_cast<const uint2*>(yf + (size_t)t * D + c * 256 + lane * 4);
      y[c] = float4{bflo(yq.x), bfhi(yq.x), bflo(yq.y), bfhi(yq.y)};
      xo[c] = *reinterpret_cast<const float4*>(p.x + (size_t)t * D + c * 256 + lane * 4);
    }
    const float rmix = p.partial[t];
    float ss = 0.f;
#pragma unroll
    for (int c = 0; c < 8; ++c) ss += y[c].x * y[c].x + y[c].y * y[c].y + y[c].z * y[c].z + y[c].w * y[c].w;
    ss = wave_sum_fast(ss);
    const float rstd = rsqrtf(ss * (1.f / D) + EPS);
    const float* gfx = p.mod + (size_t)b * NMOD + 5 * D;
    const float* gm = p.mod + (size_t)b * NMOD + 2 * D;
#pragma unroll
    for (int c = 0; c < 8; ++c) {
      const int e0 = c * 256 + lane * 4;
      const uint2 mq = *reinterpret_cast<const uint2*>(ymix + (size_t)t * D + e0);
      const float4 m4 = float4{bflo(mq.x), bfhi(mq.x), bflo(mq.y), bfhi(mq.y)};
      const float4 g4 = *reinterpret_cast<const float4*>(gfx + e0), gp = *reinterpret_cast<const float4*>(p.g_post_ffn + e0);
      const float4 h4 = *reinterpret_cast<const float4*>(gm + e0), hp = *reinterpret_cast<const float4*>(p.g_post_mix + e0);
      xo[c].x += h4.x * (m4.x * rmix * hp.x) + g4.x * (y[c].x * rstd * gp.x);
      xo[c].y += h4.y * (m4.y * rmix * hp.y) + g4.y * (y[c].y * rstd * gp.y);
      xo[c].z += h4.z * (m4.z * rmix * hp.z) + g4.z * (y[c].z * rstd * gp.z);
      xo[c].w += h4.w * (m4.w * rmix * hp.w) + g4.w * (y[c].w * rstd * gp.w);
      *reinterpret_cast<float4*>(p.out + (size_t)t * D + e0) = xo[c];
    }
  }
}

#define XB_TMO      128
#define XB_XCNT(j)  (256  + 64 * (j))
#define XB_XSUB(j)  (1280 + 64 * (j))
#define XB_XGEN(j)  (2304 + 64 * (j))
#define XB_TOP      3328
#define XB_TOPGEN   3392
#define XCD_BAR_WORDS 3456
#define XB_SPIN_CAP (1u << 22)
#define LAS __attribute__((address_space(3)))
__device__ __forceinline__ unsigned xb_ld(unsigned* p)              { return __hip_atomic_load(p, __ATOMIC_RELAXED, __HIP_MEMORY_SCOPE_AGENT); }
__device__ __forceinline__ unsigned xb_add(unsigned* p, unsigned v) { return __hip_atomic_fetch_add(p, v, __ATOMIC_RELAXED, __HIP_MEMORY_SCOPE_AGENT); }
__device__ __forceinline__ unsigned xb_xcc_id() { return (unsigned)__builtin_amdgcn_s_getreg((3 << 11) | 20) & 0xFu; }
#define XB_SPIN(cond, bar) do { unsigned _sp = 0; while (cond) { __builtin_amdgcn_s_sleep(1); \
    if ((++_sp & 255u) == 0u) { if (xb_ld(&(bar)[XB_TMO])) break; if (_sp > XB_SPIN_CAP) { atomicAdd(&(bar)[XB_TMO], 1u); break; } } } } while (0)
struct XcdBarrier { unsigned* bar; unsigned x; volatile LAS unsigned* st; };
__device__ __forceinline__ XcdBarrier xcd_barrier_post(unsigned* bar, volatile LAS unsigned* st) {
  XcdBarrier b; b.bar = bar; b.x = xb_xcc_id(); b.st = st;
  if (threadIdx.x == 0) (void)xb_add(&bar[XB_XCNT(b.x)], 1u);
  return b;
}
__device__ __forceinline__ void xcd_barrier_complete(unsigned* bar, unsigned x, unsigned& nloc, unsigned& nx) {
  const unsigned G = gridDim.x * gridDim.y * gridDim.z;
  unsigned sum, cnt, mine, sp = 0u;
  for (;;) {
    sum = 0u; cnt = 0u; mine = 0u;
#pragma unroll
    for (unsigned j = 0; j < 16; ++j) { const unsigned c = xb_ld(&bar[XB_XCNT(j)]); sum += c; cnt += (c > 0u) ? 1u : 0u; mine = (j == x) ? c : mine; }
    if (sum == G) break;
    __builtin_amdgcn_s_sleep(1);
    if ((++sp & 255u) == 0u) { if (xb_ld(&bar[XB_TMO])) break; if (sp > XB_SPIN_CAP) { atomicAdd(&bar[XB_TMO], 1u); break; } }
  }
  nloc = mine > 0u ? mine : 1u; nx = cnt > 0u ? cnt : 1u;
}
__device__ __forceinline__ void xcd_barrier(const XcdBarrier& b) {
  asm volatile("s_waitcnt vmcnt(0)" ::: "memory");
  __syncthreads();
  if (threadIdx.x == 0) {
    unsigned* bar = b.bar;
    __builtin_amdgcn_s_waitcnt(0);
    unsigned nloc = b.st[0], nx = b.st[1];
    if (nloc == 0u) { xcd_barrier_complete(bar, b.x, nloc, nx); b.st[0] = nloc; b.st[1] = nx; }
    const unsigned old = xb_add(&bar[XB_XSUB(b.x)], 1u);
    const unsigned gen = old / nloc;
    if (old + 1u == (gen + 1u) * nloc) {
      __builtin_amdgcn_fence(__ATOMIC_RELEASE, "agent");
      asm volatile("s_waitcnt vmcnt(0)" ::: "memory");
      const unsigned og = xb_add(&bar[XB_TOP], 1u);
      const unsigned tg = og / nx;
      if (og + 1u == (tg + 1u) * nx) xb_add(&bar[XB_TOPGEN], 1u);
      else XB_SPIN(xb_ld(&bar[XB_TOPGEN]) == tg, bar);
      __builtin_amdgcn_fence(__ATOMIC_ACQUIRE, "agent");
      xb_add(&bar[XB_XGEN(b.x)], 1u);
      asm volatile("s_waitcnt vmcnt(0)" ::: "memory");
    } else {
      XB_SPIN(xb_ld(&bar[XB_XGEN(b.x)]) == gen, bar);
      __builtin_amdgcn_fence(__ATOMIC_ACQUIRE, "agent");
      asm volatile("s_waitcnt vmcnt(0)" ::: "memory");
    }
  }
  __syncthreads();
}

__global__ void __launch_bounds__(NTHREADS, 2) fwd_mega(Params p) {
  __shared__ __attribute__((aligned(16))) char smem[75808];
  const int bid = blockIdx.x, nb = gridDim.x;
  volatile LAS unsigned* st = (volatile LAS unsigned*)(smem + 75792);
  if (threadIdx.x == 0) { st[0] = 0u; st[1] = 0u; }
  __syncthreads();
  const XcdBarrier bar = xcd_barrier_post(p.bar, st);
  phase_prep(p, bid, nb, smem);        xcd_barrier(bar);
  phase_fold(p, bid, nb, smem);        xcd_barrier(bar);
  phase_norm_mod(p, bid, nb, smem);    xcd_barrier(bar);
  phase_inproj(p, bid, nb, smem);      xcd_barrier(bar);
  phase_ssm_pre(p, bid, nb, smem);     xcd_barrier(bar);
  phase_ssd_dft(p, bid, nb, smem);     xcd_barrier(bar);
  phase_ssm_post(p, bid, nb, smem);    xcd_barrier(bar);
  phase_outproj(p, bid, nb, smem);     xcd_barrier(bar);
  phase_postmix(p, bid, nb, smem);     xcd_barrier(bar);
  phase_q_route(p, bid, nb, smem);     xcd_barrier(bar);
  phase_exp_u(p, smem);                xcd_barrier(bar);
  phase_exp_v(p, smem);                xcd_barrier(bar);
  phase_exp_final(p, bid, nb, smem);
}

}

extern "C" void kernel_launch(void* const* d_in, const int* in_sizes, int n_in, void* d_out, int out_size, void* d_ws,
                              size_t ws_size, hipStream_t stream) {
  Params p{};
  const float** fp = reinterpret_cast<const float**>(&p);
  for (int i = 0; i < 27; ++i) fp[i] = (const float*)d_in[i];
  p.out = (float*)d_out;
  char* ws = (char*)d_ws;
  size_t off = 0;
  auto take = [&](size_t bytes) { char* r = ws + off; off += (bytes + 255) & ~(size_t)255; return r; };
  p.U8 = (uint8_t*)take((size_t)16384 * D);
  p.V8 = (uint8_t*)take((size_t)16384 * D);
  p.uscale = (float*)take((size_t)16384 * 4);
  p.hx8a = (int8_t*)take((size_t)(T + TC) * D);
  p.w8 = (int8_t*)take((size_t)NPROJ * D);
  p.ascale = (float*)take((size_t)(T + TC) * 4);
  p.wscale = (float*)take((size_t)NPROJ * 4);
  p.ycat8 = (int8_t*)take((size_t)T * D);
  p.wo8 = (int8_t*)take((size_t)D * D);
  p.yscale = (float*)take((size_t)T * 4);
  p.woscale = (float*)take((size_t)D * 4);
  p.wq8 = (int8_t*)take((size_t)1024 * D);
  p.wqscale = (float*)take((size_t)1024 * 4);
  p.w_in_t = (bf16_t*)take((size_t)NPROJ * D * 2);
  p.w_out_t = (bf16_t*)take((size_t)D * D * 2);
  p.w_q_t = (bf16_t*)take((size_t)1024 * D * 2);
  p.w_in_f = (bf16_t*)take((size_t)D * 1024 * 2);
  p.WcsT = (bf16_t*)take((size_t)4 * 512 * 256 * 2);
  p.dftm = (bf16_t*)take((size_t)1024 * 2048 * 2);
  p.Fs = (bf16_t*)take((size_t)NB * 1024 * 2048 * 2);
  p.partial = (float*)take((size_t)KSPLIT * 5 * NMOD * 4);
  p.mod = (float*)take((size_t)5 * NMOD * 4);
  p.hx = (bf16_t*)take((size_t)T * D * 2);
  p.hc = (bf16_t*)take((size_t)TC * D * 2);
  p.ABt = (bf16_t*)take((size_t)NB * 1024 * 4096 * 2);
  p.q = (float*)p.ABt;
  p.z = (bf16_t*)take((size_t)T * 1024 * 2);
  char* r1 = take(0);
  p.xbcraw = (bf16_t*)take((size_t)T * DXBC * 4);
  p.xbcraw_c = (bf16_t*)take((size_t)TC * DXBC * 4);
  p.act_tm = (bf16_t*)take((size_t)(T + TC) * DXBC * 2);
  p.act_cm_x = (bf16_t*)take((size_t)NB * 1280 * L * 2);
  p.act_cm_c = (bf16_t*)take((size_t)NB * 1280 * CTX * 2);
  p.y_x = (float*)r1;
  p.dtraw = (float*)take((size_t)T * 32 * 4);
  p.dtraw_c = (float*)take((size_t)TC * 32 * 4);
  p.dtf = (float*)take((size_t)T * 16 * 4);
  p.dtb = (float*)take((size_t)T * 16 * 4);
  p.dtf_c = (float*)take((size_t)TC * 16 * 4);
  p.dtb_c = (float*)take((size_t)TC * 16 * 4);
  p.yf = (float*)take((size_t)T * 1024 * 4);
  p.yb = (float*)take((size_t)T * 1024 * 4);
  p.ctr = (unsigned*)take(256);
  p.bar = (unsigned*)take((size_t)XCD_BAR_WORDS * 4);
  p.ycat = (bf16_t*)take((size_t)T * D * 2);
  p.idx = (int*)take((size_t)T * 128 * 4);
  p.gate = (float*)take((size_t)T * 128 * 4);
  if (off > ws_size) { fprintf(stderr, "kernel_launch: workspace too small: need %zu have %zu\n", off, ws_size); return; }
  static int grid_blocks = 0;
  if (!grid_blocks) {
    int dev = 0, cus = 0, per_cu = 0;
    hipGetDevice(&dev);
    hipDeviceGetAttribute(&cus, hipDeviceAttributeMultiprocessorCount, dev);
    hipOccupancyMaxActiveBlocksPerMultiprocessor(&per_cu, fwd_mega, NTHREADS, 0);
    if (per_cu > 2) per_cu = 2;
    grid_blocks = cus * per_cu;
    if (grid_blocks <= 0) { fprintf(stderr, "kernel_launch: occupancy query gave %d x %d\n", cus, per_cu); grid_blocks = -1; }
  }
  if (grid_blocks < 0) return;
  (void)hipMemsetAsync(p.bar, 0, (size_t)XCD_BAR_WORDS * 4, stream);
  void* args[] = {&p};
  hipError_t e = hipLaunchCooperativeKernel((void*)fwd_mega, dim3(grid_blocks), dim3(NTHREADS), args, 0, stream);
  if (e != hipSuccess) fprintf(stderr, "cooperative launch failed: %s (grid %d)\n", hipGetErrorString(e), grid_blocks);
}
```

```cpp
#include <hip/hip_runtime.h>
#include <hip/hip_cooperative_groups.h>
#include <stdint.h>
#include <stdio.h>

namespace cg = cooperative_groups;
namespace {

typedef __attribute__((ext_vector_type(8))) short bf16x8;
typedef __attribute__((ext_vector_type(4))) float f32x4;
typedef unsigned short bf16_t;

constexpr int D = 2048, NB = 4, L = 2048, T = NB * L, CTX = 256, TC = NB * CTX;
constexpr int NMOD = 6 * D;
constexpr int NH = 16, HP = 64, NS = 128, DXBC = 1536;
constexpr int DIN = 3616;
constexpr int NPROJ = 4736;
constexpr int KSPLIT = 32;
constexpr float EPS = 1e-6f;
constexpr int NTHREADS = 256;

__device__ __forceinline__ bf16_t f2bf(float f) { __bf16 h = (__bf16)f; return __builtin_bit_cast(unsigned short, h); }
__device__ __forceinline__ float bf2f(bf16_t h) { return __uint_as_float(((uint32_t)h) << 16); }
__device__ __forceinline__ uint32_t pack2(float a, float b) {
  typedef __attribute__((ext_vector_type(2))) __bf16 bf16x2_t;
  typedef __attribute__((ext_vector_type(2))) float f32x2_t;
  const f32x2_t v = {a, b};
  return __builtin_bit_cast(uint32_t, __builtin_convertvector(v, bf16x2_t));
}
__device__ __forceinline__ float bflo(uint32_t w) { return __uint_as_float(w << 16); }
__device__ __forceinline__ float bfhi(uint32_t w) { return __uint_as_float(w & 0xffff0000u); }
__device__ __forceinline__ float silu_f(float v) { return v / (1.f + __expf(-v)); }
__device__ __forceinline__ float softplus_f(float v) { return v > 20.f ? v : log1pf(__expf(v)); }

__device__ __forceinline__ int opaque_tid() { int t = threadIdx.x; asm volatile("" : "+v"(t)); return t; }
__device__ __forceinline__ float wave_sum(float v) {
#pragma unroll
  for (int o = 32; o > 0; o >>= 1) v += __shfl_xor(v, o);
  return v;
}
template <int CTRL>
__device__ __forceinline__ float dpp_mov(float v) {
  return __int_as_float(__builtin_amdgcn_update_dpp(0, __float_as_int(v), CTRL, 0xF, 0xF, true));
}
template <int CTRL>
__device__ __forceinline__ int dpp_movi(int v) { return __builtin_amdgcn_update_dpp(0, v, CTRL, 0xF, 0xF, true); }
__device__ __forceinline__ float wave_sum_fast(float v) {
  v += dpp_mov<0xB1>(v); v += dpp_mov<0x4E>(v); v += dpp_mov<0x124>(v); v += dpp_mov<0x128>(v);
  v += __shfl_xor(v, 16); v += __shfl_xor(v, 32);
  return v;
}
__device__ __forceinline__ float wave_max(float v) {
#pragma unroll
  for (int o = 32; o > 0; o >>= 1) v = fmaxf(v, __shfl_xor(v, o));
  return v;
}
__device__ __forceinline__ float block_sum(float v, float* red) {
  v = wave_sum(v);
  __syncthreads();
  if ((threadIdx.x & 63) == 0) red[threadIdx.x >> 6] = v;
  __syncthreads();
  return red[0] + red[1] + red[2] + red[3];
}

struct Params {
  const float *x, *c, *ctx, *c_ctx, *w_mod, *b_mod, *g_pre_mix, *g_post_mix, *g_pre_ffn, *g_post_ffn;
  const float *w_in, *w_fmix, *conv_w, *conv_b, *dt_bias_f, *dt_bias_b, *a_log_f, *a_log_b, *d_skip_f, *d_skip_b;
  const float *ssm_norm_w, *w_out, *w_query, *sk1, *sk2, *eu, *ev;
  float* out;
  uint8_t *U8, *V8;
  float* uscale;
  int8_t *hx8a, *w8;
  float *ascale, *wscale;
  int8_t *ycat8, *wo8;
  float *yscale, *woscale;
  int8_t* wq8; float* wqscale;
  bf16_t *w_in_t, *w_out_t, *w_q_t, *w_in_f, *WcsT, *dftm, *Fs;
  float *partial, *mod;
  bf16_t *hx, *hc, *ABt, *z;
  bf16_t *xbcraw, *xbcraw_c;
  float *dtraw, *dtraw_c, *dtf, *dtb, *dtf_c, *dtb_c;
  bf16_t *act_tm, *act_cm_x, *act_cm_c;
  float *yf, *yb;
  unsigned* ctr; unsigned* bar;
  bf16_t* ycat;
  float *y_x, *q, *gate;
  int* idx;
  int pad0, pad1;
};

template <bool I8 = false>
__device__ __forceinline__ void gemm_mainloop(const bf16_t* __restrict__ A, int lda, const bf16_t* __restrict__ Bt, int ldb,
                                              int K, int m0, int n0, f32x4 (&acc)[4][4], char* smem) {
  const int tid = opaque_tid(), lane = tid & 63, w = tid >> 6;
  const int wm = w >> 1, wn = w & 1;
#pragma unroll
  for (int i = 0; i < 4; ++i)
#pragma unroll
    for (int j = 0; j < 4; ++j) acc[i][j] = f32x4{0.f, 0.f, 0.f, 0.f};

  const int nk = K / 64;
  const int rowoff = lane >> 3, lch = (lane & 7) ^ rowoff;
  const bf16_t* gA = A + (size_t)(m0 + w * 8 + rowoff) * lda + lch * 8;
  const bf16_t* gB = Bt + (size_t)(n0 + w * 8 + rowoff) * ldb + lch * 8;
#define GSTAGE(buf_, kt_)                                                                                               \
  do {                                                                                                                  \
    _Pragma("unroll") for (int i_ = 0; i_ < 4; ++i_) {                                                                  \
      __builtin_amdgcn_global_load_lds((const unsigned*)(gA + (size_t)(i_ * 32) * lda + (kt_) * 64),                    \
                                       (unsigned*)(smem + (buf_) * 32768 + (i_ * 4 + w) * 1024), 16, 0, 0);             \
      __builtin_amdgcn_global_load_lds((const unsigned*)(gB + (size_t)(i_ * 32) * ldb + (kt_) * 64),                    \
                                       (unsigned*)(smem + (buf_) * 32768 + 16384 + (i_ * 4 + w) * 1024), 16, 0, 0);     \
    }                                                                                                                   \
  } while (0)
  GSTAGE(0, 0);
  asm volatile("s_waitcnt vmcnt(0)" ::: "memory");
  __syncthreads();
  for (int kt = 0; kt < nk; ++kt) {
    const int cur = kt & 1;
    if (kt + 1 < nk) GSTAGE(cur ^ 1, kt + 1);
    const char* sA = smem + cur * 32768;
    const char* sB = sA + 16384;
#pragma unroll
    for (int kk = 0; kk < 2; ++kk) {
      bf16x8 af[4], bfr[4];
      const int ch = kk * 4 + (lane >> 4);
#pragma unroll
      for (int i = 0; i < 4; ++i) {
        int row = wm * 64 + i * 16 + (lane & 15);
        af[i] = *reinterpret_cast<const bf16x8*>(sA + row * 128 + ((ch ^ (row & 7)) << 4));
        int col = wn * 64 + i * 16 + (lane & 15);
        bfr[i] = *reinterpret_cast<const bf16x8*>(sB + col * 128 + ((ch ^ (col & 7)) << 4));
      }
#pragma unroll
      for (int i = 0; i < 4; ++i)
#pragma unroll
        for (int j = 0; j < 4; ++j) {
          if (I8) {
            typedef __attribute__((ext_vector_type(4))) int i32x4;
            acc[i][j] = __builtin_bit_cast(f32x4, __builtin_amdgcn_mfma_i32_16x16x64_i8(__builtin_bit_cast(i32x4, af[i]), __builtin_bit_cast(i32x4, bfr[j]),
                                                                                         __builtin_bit_cast(i32x4, acc[i][j]), 0, 0, 0));
          } else {
            acc[i][j] = __builtin_amdgcn_mfma_f32_16x16x32_bf16(af[i], bfr[j], acc[i][j], 0, 0, 0);
          }
        }
    }
    asm volatile("s_waitcnt vmcnt(0)" ::: "memory");
    __syncthreads();
  }
#undef GSTAGE
}

template <bool I8 = false, class Epi>
__device__ __forceinline__ void gemm_tile(const bf16_t* __restrict__ A, int lda, const bf16_t* __restrict__ Bt, int ldb,
                                          int K, int m0, int n0, const Epi& epi, char* smem,
                                          const float* __restrict__ rscale = nullptr, const float* __restrict__ cscale = nullptr) {
  const int lane = threadIdx.x & 63, w = threadIdx.x >> 6;
  const int wm = w >> 1, wn = w & 1;
  f32x4 acc[4][4];
  gemm_mainloop<I8>(A, lda, Bt, ldb, K, m0, n0, acc, smem);
#pragma unroll
  for (int i = 0; i < 4; ++i) {
    const int row = m0 + wm * 64 + i * 16 + (lane >> 4) * 4;
    float4 rs = float4{1.f, 1.f, 1.f, 1.f};
    if (I8) rs = *reinterpret_cast<const float4*>(rscale + row);
#pragma unroll
    for (int j = 0; j < 4; ++j) {
      const int col = n0 + wn * 64 + j * 16 + (lane & 15);
      if (I8) {
        typedef __attribute__((ext_vector_type(4))) int i32x4;
        const i32x4 ia = __builtin_bit_cast(i32x4, acc[i][j]);
        const float cs = cscale[col];
        epi(row, col, f32x4{(float)ia[0] * rs.x * cs, (float)ia[1] * rs.y * cs, (float)ia[2] * rs.z * cs, (float)ia[3] * rs.w * cs});
      } else {
        epi(row, col, acc[i][j]);
      }
    }
  }
}

template <bool I8>
__device__ __forceinline__ void gemm_mainloop_n256(const bf16_t* __restrict__ A, int lda, const bf16_t* __restrict__ Bt, int ldb,
                                                   int K, int m0, int n0, f32x4 (&acc)[4][8], char* smem) {
  const int tid = opaque_tid(), lane = tid & 63, w = tid >> 6;
  const int wm = w >> 1, wn = w & 1;
#pragma unroll
  for (int i = 0; i < 4; ++i)
#pragma unroll
    for (int j = 0; j < 8; ++j) acc[i][j] = f32x4{0.f, 0.f, 0.f, 0.f};
  const int nk = K / 64;
  const int rowoff = lane >> 3, lch = (lane & 7) ^ rowoff;
  const bf16_t* gA = A + (size_t)(m0 + w * 8 + rowoff) * lda + lch * 8;
  const bf16_t* gB = Bt + (size_t)(n0 + w * 8 + rowoff) * ldb + lch * 8;
  const int fr = lane & 15, fq = lane >> 4;
  for (int kt = 0; kt < nk; ++kt) {
#pragma unroll
    for (int i_ = 0; i_ < 4; ++i_)
      __builtin_amdgcn_global_load_lds((const unsigned*)(gA + (size_t)(i_ * 32) * lda + kt * 64),
                                       (unsigned*)(smem + (i_ * 4 + w) * 1024), 16, 0, 0);
#pragma unroll
    for (int i_ = 0; i_ < 8; ++i_)
      __builtin_amdgcn_global_load_lds((const unsigned*)(gB + (size_t)(i_ * 32) * ldb + kt * 64),
                                       (unsigned*)(smem + 16384 + (i_ * 4 + w) * 1024), 16, 0, 0);
    asm volatile("s_waitcnt vmcnt(0)" ::: "memory");
    __syncthreads();
    const char* sA = smem;
    const char* sB = smem + 16384;
#pragma unroll
    for (int kk = 0; kk < 2; ++kk) {
      bf16x8 af[4], bfr[8];
      const int ch = kk * 4 + fq;
#pragma unroll
      for (int i = 0; i < 4; ++i) {
        const int row = wm * 64 + i * 16 + fr;
        af[i] = *reinterpret_cast<const bf16x8*>(sA + row * 128 + ((ch ^ (row & 7)) << 4));
      }
#pragma unroll
      for (int j = 0; j < 8; ++j) {
        const int col = wn * 128 + j * 16 + fr;
        bfr[j] = *reinterpret_cast<const bf16x8*>(sB + col * 128 + ((ch ^ (col & 7)) << 4));
      }
#pragma unroll
      for (int i = 0; i < 4; ++i)
#pragma unroll
        for (int j = 0; j < 8; ++j) {
          if (I8) {
            typedef __attribute__((ext_vector_type(4))) int i32x4;
            acc[i][j] = __builtin_bit_cast(f32x4, __builtin_amdgcn_mfma_i32_16x16x64_i8(__builtin_bit_cast(i32x4, af[i]), __builtin_bit_cast(i32x4, bfr[j]),
                                                                                         __builtin_bit_cast(i32x4, acc[i][j]), 0, 0, 0));
          } else {
            acc[i][j] = __builtin_amdgcn_mfma_f32_16x16x32_bf16(af[i], bfr[j], acc[i][j], 0, 0, 0);
          }
        }
    }
    __syncthreads();
  }
}
template <bool I8, class Epi>
__device__ __forceinline__ void gemm_tile_n256(const bf16_t* __restrict__ A, int lda, const bf16_t* __restrict__ Bt, int ldb,
                                               int K, int m0, int n0, const Epi& epi, char* smem,
                                               const float* __restrict__ rscale = nullptr, const float* __restrict__ cscale = nullptr) {
  const int lane = threadIdx.x & 63, w = threadIdx.x >> 6;
  const int wm = w >> 1, wn = w & 1;
  f32x4 acc[4][8];
  gemm_mainloop_n256<I8>(A, lda, Bt, ldb, K, m0, n0, acc, smem);
#pragma unroll
  for (int i = 0; i < 4; ++i) {
    const int row = m0 + wm * 64 + i * 16 + (lane >> 4) * 4;
    float4 rs = float4{1.f, 1.f, 1.f, 1.f};
    if (I8) rs = *reinterpret_cast<const float4*>(rscale + row);
#pragma unroll
    for (int j = 0; j < 8; ++j) {
      const int col = n0 + wn * 128 + j * 16 + (lane & 15);
      if (I8) {
        typedef __attribute__((ext_vector_type(4))) int i32x4;
        const i32x4 ia = __builtin_bit_cast(i32x4, acc[i][j]);
        const float cs = cscale[col];
        epi(row, col, f32x4{(float)ia[0] * rs.x * cs, (float)ia[1] * rs.y * cs, (float)ia[2] * rs.z * cs, (float)ia[3] * rs.w * cs});
      } else {
        epi(row, col, acc[i][j]);
      }
    }
  }
}

__device__ __forceinline__ float wave_max_fast(float v) {
  v = fmaxf(v, dpp_mov<0xB1>(v)); v = fmaxf(v, dpp_mov<0x4E>(v)); v = fmaxf(v, dpp_mov<0x124>(v)); v = fmaxf(v, dpp_mov<0x128>(v));
  v = fmaxf(v, __shfl_xor(v, 16)); v = fmaxf(v, __shfl_xor(v, 32));
  return v;
}
__device__ __forceinline__ uint32_t pack_i8x4(float a, float b, float c, float d) {
  const int ia = __float2int_rn(a), ib = __float2int_rn(b), ic = __float2int_rn(c), id = __float2int_rn(d);
  return (uint32_t)(ia & 255) | ((uint32_t)(ib & 255) << 8) | ((uint32_t)(ic & 255) << 16) | ((uint32_t)id << 24);
}
struct EpiF32 {
  float* C; int ldc;
  __device__ __forceinline__ void operator()(int row, int col, f32x4 v) const {
#pragma unroll
    for (int r = 0; r < 4; ++r) C[(size_t)(row + r) * ldc + col] = v[r];
  }
};
struct EpiBf16 {
  bf16_t* C; int ldc;
  __device__ __forceinline__ void operator()(int row, int col, f32x4 v) const {
#pragma unroll
    for (int r = 0; r < 4; ++r) C[(size_t)(row + r) * ldc + col] = f2bf(v[r]);
  }
};
struct EpiBf16T {
  bf16_t* Ct; int ldc;
  __device__ __forceinline__ void operator()(int row, int col, f32x4 v) const {
    uint2 pk; pk.x = pack2(v[0], v[1]); pk.y = pack2(v[2], v[3]);
    *reinterpret_cast<uint2*>(Ct + (size_t)col * ldc + row) = pk;
  }
};
struct EpiInAB {
  bf16_t* ABt; int seqlen;
  __device__ __forceinline__ void operator()(int row, int col, f32x4 v) const {
    const int ch = col & 1023, half = col >> 10;
    const int b = row / seqlen, l = row - b * seqlen;
    uint2 pk; pk.x = pack2(v[0], v[1]); pk.y = pack2(v[2], v[3]);
    *reinterpret_cast<uint2*>(ABt + ((size_t)(b * 1024 + ch) * 4096 + half * 2048 + l)) = pk;
  }
};
struct EpiInZ {
  bf16_t* z;
  __device__ __forceinline__ void operator()(int row, int col, f32x4 v) const {
#pragma unroll
    for (int r = 0; r < 4; ++r) z[(size_t)(row + r) * 1024 + (col - 2048)] = f2bf(v[r]);
  }
};
struct EpiInXbc {
  bf16_t* xbcraw;
  __device__ __forceinline__ void operator()(int row, int col, f32x4 v) const {
#pragma unroll
    for (int r = 0; r < 4; ++r) xbcraw[(size_t)(row + r) * DXBC + (col - 3072)] = f2bf(v[r]);
  }
};
struct EpiInProj {
  bf16_t* ABt; bf16_t* z; bf16_t* xbcraw; float* dtraw; int seqlen;
  __device__ __forceinline__ void operator()(int row, int col, f32x4 v) const {
    if (col < 2048) {
      int ch = col & 1023, half = col >> 10;
      int b = row / seqlen, l = row - b * seqlen;
      uint2 pk; pk.x = pack2(v[0], v[1]); pk.y = pack2(v[2], v[3]);
      *reinterpret_cast<uint2*>(ABt + ((size_t)(b * 1024 + ch) * 4096 + half * 2048 + l)) = pk;
    } else if (col < 3072) {
#pragma unroll
      for (int r = 0; r < 4; ++r) z[(size_t)(row + r) * 1024 + (col - 2048)] = f2bf(v[r]);
    } else if (col < 4608) {
#pragma unroll
      for (int r = 0; r < 4; ++r) xbcraw[(size_t)(row + r) * DXBC + (col - 3072)] = f2bf(v[r]);
    } else if (col < 4640) {
#pragma unroll
      for (int r = 0; r < 4; ++r) dtraw[(size_t)(row + r) * 32 + (col - 4608)] = v[r];
    }
  }
};

__device__ void adaln_partial_task(const Params& p, int task, float* sm) {
  const int cb = task % 48, ks = task / 48, tid = threadIdx.x;
  float* sc = sm;
  __syncthreads();
  for (int i = tid; i < 5 * 64; i += NTHREADS) {
    int r = i >> 6, kk = i & 63;
    int k = ks * 64 + kk;
    float cv = (r < 4) ? p.c[r * D + k] : p.c_ctx[k];
    sc[i] = silu_f(cv);
  }
  __syncthreads();
  const int col = cb * 256 + tid;
  float a0 = 0, a1 = 0, a2 = 0, a3 = 0, a4 = 0;
  const float* wp = p.w_mod + (size_t)(ks * 64) * NMOD + col;
  {
    float wv[64];
#pragma unroll
    for (int kk = 0; kk < 64; ++kk) wv[kk] = __builtin_nontemporal_load(wp + (size_t)kk * NMOD);
#pragma unroll
    for (int k = 0; k < 64; ++k) {
      a0 += sc[k] * wv[k]; a1 += sc[64 + k] * wv[k]; a2 += sc[128 + k] * wv[k]; a3 += sc[192 + k] * wv[k]; a4 += sc[256 + k] * wv[k];
    }
  }
  float* pp = p.partial + (size_t)ks * 5 * NMOD + col;
  pp[0] = a0; pp[NMOD] = a1; pp[2 * NMOD] = a2; pp[3 * NMOD] = a3; pp[4 * NMOD] = a4;
}

__device__ void transpose_convert_task(const float* __restrict__ src, int ld, int c0, int rows, bf16_t* __restrict__ dst,
                                       int tr, int tc, float* sm) {
  float (*tile)[68] = reinterpret_cast<float (*)[68]>(sm);
  const int tid = threadIdx.x;
  __syncthreads();
  {
    float4 v[4];
#pragma unroll
    for (int k = 0; k < 4; ++k) {
      const int i = tid + k * NTHREADS, r = i >> 4, c4 = i & 15;
      v[k] = *reinterpret_cast<const float4*>(src + (size_t)(tr * 64 + r) * ld + c0 + tc * 64 + c4 * 4);
    }
#pragma unroll
    for (int k = 0; k < 4; ++k) {
      const int i = tid + k * NTHREADS, r = i >> 4, c4 = i & 15;
      *reinterpret_cast<float4*>(&tile[r][c4 * 4]) = v[k];
    }
  }
  __syncthreads();
#pragma unroll
  for (int k = 0; k < 4; ++k) {
    const int i = tid + k * NTHREADS, cc = i >> 4, r4 = (i & 15) * 4;
    uint2 o; o.x = pack2(tile[r4][cc], tile[r4 + 1][cc]); o.y = pack2(tile[r4 + 2][cc], tile[r4 + 3][cc]);
    *reinterpret_cast<uint2*>(dst + (size_t)(tc * 64 + cc) * rows + tr * 64 + r4) = o;
  }
}

__device__ void phase_prep(const Params& p, int bid, int nb, char* smem) {
  float* sm = reinterpret_cast<float*>(smem);
  const int tid = threadIdx.x;
  if (bid == 0 && tid < 64) p.ctr[tid] = 0u;
  {
    float* t256 = reinterpret_cast<float*>(smem + 20480);
    float* t2048 = reinterpret_cast<float*>(smem + 24576);
    t256[tid] = cospif((float)tid * (1.0f / 128.f));
    for (int i = tid; i < 2048; i += NTHREADS) t2048[i] = cospif((float)i * (1.0f / 1024.f));
    __syncthreads();
  }
  for (int t = bid; t < 48 * KSPLIT; t += nb) adaln_partial_task(p, t, sm);
  {
    const int nct = 41, nrt = 32;
    for (int t = bid; t < nct * nrt; t += nb) {
      int tc = t % nct, tr = t / nct;
      if (tc < 40) transpose_convert_task(p.w_in, DIN, 1024, D, p.w_in_t + (size_t)2048 * D, tr, tc, sm);
      else {
        float (*tile)[65] = reinterpret_cast<float (*)[65]>(sm);
        __syncthreads();
        for (int i = tid; i < 64 * 32; i += NTHREADS) {
          int r = i >> 5, cc = i & 31;
          tile[r][cc] = p.w_in[(size_t)(tr * 64 + r) * DIN + 1024 + 2560 + cc];
        }
        __syncthreads();
        for (int i = tid; i < 32 * 32; i += NTHREADS) {
          int cc = i >> 5, r2 = (i & 31) * 2;
          uint32_t pk = pack2(tile[r2][cc], tile[r2 + 1][cc]);
          *reinterpret_cast<uint32_t*>(p.w_in_t + (size_t)(2048 + 2560 + cc) * D + tr * 64 + r2) = pk;
        }
      }
    }
    for (size_t i = (size_t)bid * NTHREADS + tid; i < (size_t)96 * D / 8; i += (size_t)nb * NTHREADS)
      reinterpret_cast<uint4*>(p.w_in_t + (size_t)4640 * D)[i] = uint4{0, 0, 0, 0};
  }
  for (size_t i0 = (size_t)bid * NTHREADS + tid; i0 < (size_t)D * 1024 / 4; i0 += (size_t)4 * nb * NTHREADS) {
    float4 v[4];
#pragma unroll
    for (int u = 0; u < 4; ++u) {
      const size_t i = i0 + (size_t)u * nb * NTHREADS;
      const int k = (int)(i / 256), c4 = (int)(i % 256) * 4;
      v[u] = (i < (size_t)D * 1024 / 4) ? *reinterpret_cast<const float4*>(p.w_in + (size_t)k * DIN + c4) : float4{0.f, 0.f, 0.f, 0.f};
    }
#pragma unroll
    for (int u = 0; u < 4; ++u) {
      const size_t i = i0 + (size_t)u * nb * NTHREADS;
      const int k = (int)(i / 256), c4 = (int)(i % 256) * 4;
      uint2 o; o.x = pack2(v[u].x, v[u].y); o.y = pack2(v[u].z, v[u].w);
      if (i < (size_t)D * 1024 / 4) *reinterpret_cast<uint2*>(p.w_in_f + (size_t)k * 1024 + c4) = o;
    }
  }
  {
    const float* t256 = reinterpret_cast<const float*>(smem + 20480);
    const float scale = 1.0f / sqrtf((float)L * 256.f);
    const int vb = (bid + (nb >> 1)) % nb;
    for (int i = vb * NTHREADS + tid; i < 4 * 64 * 256; i += nb * NTHREADS) {
      const int d = i & 255, cg = (i >> 8) & 63, g = i >> 14;
      float c0_ = 0.f, c1_ = 0.f, c2_ = 0.f, c3_ = 0.f, s0_ = 0.f, s1_ = 0.f, s2_ = 0.f, s3_ = 0.f;
      const float* wp = p.w_fmix + (size_t)g * 65536 + d;
#pragma unroll 1
      for (int mb = 0; mb < 256; mb += 16) {
        float wv[16];
#pragma unroll
        for (int mm = 0; mm < 16; ++mm) wv[mm] = wp[(mb + mm) * 256];
#pragma unroll
        for (int mm = 0; mm < 16; ++mm) {
          const int m = mb + mm;
          const int p0 = (m * (cg * 4 + 0)) & 255, p1 = (m * (cg * 4 + 1)) & 255, p2 = (m * (cg * 4 + 2)) & 255, p3 = (m * (cg * 4 + 3)) & 255;
          c0_ += t256[p0] * wv[mm]; s0_ += t256[(p0 - 64) & 255] * wv[mm];
          c1_ += t256[p1] * wv[mm]; s1_ += t256[(p1 - 64) & 255] * wv[mm];
          c2_ += t256[p2] * wv[mm]; s2_ += t256[(p2 - 64) & 255] * wv[mm];
          c3_ += t256[p3] * wv[mm]; s3_ += t256[(p3 - 64) & 255] * wv[mm];
        }
      }
      {
        bf16_t* wc = p.WcsT + ((size_t)g * 512 + d) * 256 + cg * 4;
        bf16_t* ws_ = p.WcsT + ((size_t)g * 512 + 256 + d) * 256 + cg * 4;
        uint2 oc, os;
        oc.x = pack2(c0_ * scale, c1_ * scale); oc.y = pack2(c2_ * scale, c3_ * scale);
        os.x = pack2(s0_ * scale, s1_ * scale); os.y = pack2(s2_ * scale, s3_ * scale);
        *reinterpret_cast<uint2*>(wc) = oc;
        *reinterpret_cast<uint2*>(ws_) = os;
      }
    }
  }
  {
    const float* t2048 = reinterpret_cast<const float*>(smem + 24576);
    for (size_t i = (size_t)bid * NTHREADS + tid; i < (size_t)1024 * 2048 / 8; i += (size_t)nb * NTHREADS) {
      const int k = (int)(i / 256), j = (int)(i % 256) * 8;
      const bool iss = j >= 1024;
      float o[8];
#pragma unroll
      for (int e = 0; e < 8; ++e) {
        const int l = (j + e) & 1023;
        const int ph = (k * l) & 2047;
        o[e] = iss ? t2048[(ph - 512) & 2047] : t2048[ph];
      }
      uint4 pk; pk.x = pack2(o[0], o[1]); pk.y = pack2(o[2], o[3]); pk.z = pack2(o[4], o[5]); pk.w = pack2(o[6], o[7]);
      *reinterpret_cast<uint4*>(p.dftm + (size_t)k * 2048 + j) = pk;
    }
  }
}

__device__ void phase_fold(const Params& p, int bid, int nb, char* smem) {
  const int tid = threadIdx.x;
  for (int i = bid * NTHREADS + tid; i < 5 * NMOD; i += nb * NTHREADS) {
    int col = i % NMOD;
    float s = p.b_mod[col];
    for (int ks = 0; ks < KSPLIT; ++ks) s += p.partial[(size_t)ks * 5 * NMOD + i];
    p.mod[i] = s;
  }
  for (int t = bid; t < 256; t += nb) {
    int g = t >> 6, tm = (t & 63) >> 2, tn = t & 3;
    int n0 = tn * 128;
    int rowbase = (n0 < 256) ? (g * 256 + n0) : (1024 + g * 256 + (n0 - 256));
    EpiBf16T epi{p.w_in_t + (size_t)(rowbase - n0) * D, D};
    gemm_tile(p.w_in_f + g * 256, 1024, p.WcsT + (size_t)g * 512 * 256, 256, 256, tm * 128, n0, epi, smem);
  }
}

__device__ __forceinline__ void quant_weight_rows_i8(const bf16_t* __restrict__ src, int8_t* __restrict__ dst, float* __restrict__ scl,
                                                     int nrows, int bid, int nb) {
  const int lane = threadIdx.x & 63, w = threadIdx.x >> 6;
  for (int n = bid * 4 + w; n < nrows; n += nb * 4) {
    const bf16_t* wr = src + (size_t)n * D;
    uint4 q[4];
#pragma unroll
    for (int c = 0; c < 4; ++c) q[c] = *reinterpret_cast<const uint4*>(wr + c * 512 + lane * 8);
    float am = 0.f;
#pragma unroll
    for (int c = 0; c < 4; ++c) {
      am = fmaxf(am, fmaxf(fmaxf(fabsf(bflo(q[c].x)), fabsf(bfhi(q[c].x))), fmaxf(fabsf(bflo(q[c].y)), fabsf(bfhi(q[c].y)))));
      am = fmaxf(am, fmaxf(fmaxf(fabsf(bflo(q[c].z)), fabsf(bfhi(q[c].z))), fmaxf(fabsf(bflo(q[c].w)), fabsf(bfhi(q[c].w)))));
    }
    am = wave_max_fast(am);
    const float inv = (am > 0.f) ? 127.f / am : 0.f;
#pragma unroll
    for (int c = 0; c < 4; ++c) {
      uint2 o;
      o.x = pack_i8x4(bflo(q[c].x) * inv, bfhi(q[c].x) * inv, bflo(q[c].y) * inv, bfhi(q[c].y) * inv);
      o.y = pack_i8x4(bflo(q[c].z) * inv, bfhi(q[c].z) * inv, bflo(q[c].w) * inv, bfhi(q[c].w) * inv);
      *reinterpret_cast<uint2*>(dst + (size_t)n * D + c * 512 + lane * 8) = o;
    }
    if (lane == 0) scl[n] = am * (1.f / 127.f);
  }
}

__device__ void phase_norm_mod(const Params& p, int bid, int nb, char* smem) {
  const int lane = threadIdx.x & 63, w = threadIdx.x >> 6;
  for (int t = bid * 4 + w; t < T + TC; t += nb * 4) {
    const bool isx = t < T;
    const float* src = isx ? (p.x + (size_t)t * D) : (p.ctx + (size_t)(t - T) * D);
    const int mrow = isx ? (t / L) : 4;
    float4 v[8];
    float ss = 0.f;
#pragma unroll
    for (int c = 0; c < 8; ++c) {
      v[c] = *reinterpret_cast<const float4*>(src + c * 256 + lane * 4);
      ss += v[c].x * v[c].x + v[c].y * v[c].y + v[c].z * v[c].z + v[c].w * v[c].w;
    }
    ss = wave_sum_fast(ss);
    const float rstd = rsqrtf(ss * (1.f / D) + EPS);
    const float* sh = p.mod + (size_t)mrow * NMOD + 0 * D;
    const float* sc = p.mod + (size_t)mrow * NMOD + 1 * D;
    float am = 0.f;
#pragma unroll
    for (int c = 0; c < 8; ++c) {
      const int e0 = c * 256 + lane * 4;
      const float4 g = *reinterpret_cast<const float4*>(p.g_pre_mix + e0);
      const float4 s4 = *reinterpret_cast<const float4*>(sc + e0), h4 = *reinterpret_cast<const float4*>(sh + e0);
      v[c].x = v[c].x * rstd * g.x * (1.f + s4.x) + h4.x; v[c].y = v[c].y * rstd * g.y * (1.f + s4.y) + h4.y;
      v[c].z = v[c].z * rstd * g.z * (1.f + s4.z) + h4.z; v[c].w = v[c].w * rstd * g.w * (1.f + s4.w) + h4.w;
      am = fmaxf(am, fmaxf(fmaxf(fabsf(v[c].x), fabsf(v[c].y)), fmaxf(fabsf(v[c].z), fabsf(v[c].w))));
    }
    {
      am = wave_max_fast(am);
      const float inv = (am > 0.f) ? 127.f / am : 0.f;
#pragma unroll
      for (int c = 0; c < 8; ++c)
        *reinterpret_cast<uint32_t*>(p.hx8a + (size_t)t * D + c * 256 + lane * 4) = pack_i8x4(v[c].x * inv, v[c].y * inv, v[c].z * inv, v[c].w * inv);
      if (lane == 0) p.ascale[t] = am * (1.f / 127.f);
    }
  }
  quant_weight_rows_i8(p.w_in_t, p.w8, p.wscale, NPROJ, bid, nb);
}

__device__ __forceinline__ void convert_v_units(const Params& p, size_t u0, size_t u1) {
  for (size_t j = u0 + threadIdx.x; j < u1; j += NTHREADS) {
    uint32_t o[4];
#pragma unroll
    for (int q4 = 0; q4 < 4; ++q4) {
      const float4 v = *reinterpret_cast<const float4*>(p.ev + j * 16 + q4 * 4);
      int pk = 0;
      pk = __builtin_amdgcn_cvt_pk_fp8_f32(v.x * 512.f, v.y * 512.f, pk, false);
      pk = __builtin_amdgcn_cvt_pk_fp8_f32(v.z * 512.f, v.w * 512.f, pk, true);
      o[q4] = (uint32_t)pk;
    }
    const size_t e_ = j >> 7, r_ = j & 127;
    *reinterpret_cast<uint4*>(p.V8 + (r_ >> 4) * ((size_t)16384 * 256) + e_ * 256 + (r_ & 15) * 16) = uint4{o[0], o[1], o[2], o[3]};
  }
}
__device__ __forceinline__ void convert_u_rows(const Params& p, int q) {
  const int lane = threadIdx.x & 63, w = threadIdx.x >> 6;
  const int row0 = q * 32 + w * 8;
#pragma unroll 1
  for (int rr = 0; rr < 8; rr += 2) {
    f32x4 va[8], vb[8];
#pragma unroll
    for (int k = 0; k < 8; ++k) va[k] = __builtin_nontemporal_load(reinterpret_cast<const f32x4*>(p.eu + (size_t)(row0 + rr) * D + k * 256 + lane * 4));
#pragma unroll
    for (int k = 0; k < 8; ++k) vb[k] = __builtin_nontemporal_load(reinterpret_cast<const f32x4*>(p.eu + (size_t)(row0 + rr + 1) * D + k * 256 + lane * 4));
#define CONV_U_EMIT(v_, row_)                                                                                           \
    {                                                                                                                   \
      float m = 0.f;                                                                                                    \
      _Pragma("unroll") for (int k = 0; k < 8; ++k)                                                                     \
        m = fmaxf(m, fmaxf(fmaxf(fabsf(v_[k][0]), fabsf(v_[k][1])), fmaxf(fabsf(v_[k][2]), fabsf(v_[k][3]))));        \
      m = wave_max_fast(m);                                                                                             \
      const float inv = (m > 0.f) ? 127.f / m : 0.f;                                                                    \
      _Pragma("unroll") for (int k = 0; k < 8; ++k)                                                                     \
        *reinterpret_cast<uint32_t*>(p.U8 + (size_t)k * ((size_t)16384 * 256) + (size_t)(row_) * 256 + lane * 4) =      \
            pack_i8x4(v_[k][0] * inv, v_[k][1] * inv, v_[k][2] * inv, v_[k][3] * inv);                                  \
      if (lane == 0) p.uscale[row_] = m * (1.f / 127.f);                                                                \
    }
    CONV_U_EMIT(va, row0 + rr);
    CONV_U_EMIT(vb, row0 + rr + 1);
#undef CONV_U_EMIT
  }
}
__device__ void phase_inproj(const Params& p, int bid, int nb, char* smem) {
  const bool aware = (nb & 7) == 0;
  const int start = aware ? (bid >> 3) : bid, step = aware ? (nb >> 3) : nb, end = aware ? (128 + 53) : 8 * (128 + 53);
  const bf16_t* a8 = reinterpret_cast<const bf16_t*>(p.hx8a);
  const bf16_t* b8 = reinterpret_cast<const bf16_t*>(p.w8);
  for (int it = start; it < end; it += step) {
    const int x = aware ? (bid & 7) : it / (128 + 53), s_ = aware ? it : it % (128 + 53);
    if (s_ < 128) {
      const int tn2 = s_ >> 3, m0_ = (8 * x + (s_ & 7)) * 128;
      if (tn2 < 8) { EpiInAB epi{p.ABt, L}; gemm_tile_n256<true>(a8, D / 2, b8, D / 2, D / 2, m0_, tn2 * 256, epi, smem, p.ascale, p.wscale); }
      else if (tn2 < 12) { EpiInZ epi{p.z}; gemm_tile_n256<true>(a8, D / 2, b8, D / 2, D / 2, m0_, tn2 * 256, epi, smem, p.ascale, p.wscale); }
      else { EpiInXbc epi{p.xbcraw}; gemm_tile_n256<true>(a8, D / 2, b8, D / 2, D / 2, m0_, tn2 * 256, epi, smem, p.ascale, p.wscale); }
    } else if (s_ < 128 + 40) {
      const int i = s_ - 128;
      EpiInProj epi{p.ABt, p.z, p.xbcraw, p.dtraw, L};
      gemm_tile<true>(a8, D / 2, b8, D / 2, D / 2, (8 * x + (i & 7)) * 128, (32 + (i >> 3)) * 128, epi, smem, p.ascale, p.wscale);
    } else {
      const int u = x * 13 + (s_ - 168);
      EpiInProj epi{nullptr, nullptr, p.xbcraw_c, p.dtraw_c, CTX};
      gemm_tile<true>(reinterpret_cast<const bf16_t*>(p.hx8a + (size_t)T * D), D / 2, b8, D / 2, D / 2, (u / 13) * 128, 3072 + (u % 13) * 128, epi, smem,
                      p.ascale + T, p.wscale);
    }
  }
}

__device__ void ssm_pre_tile(const Params& p, int task, char* smem) {
  const bool isx = task < 3072;
  const int u = isx ? task : task - 3072;
  const int ntt = isx ? 32 : 4;
  const int ct = u % 24, tt = (u / 24) % ntt, b = u / (24 * ntt);
  const int seqlen = isx ? L : CTX;
  const bf16_t* raw = (isx ? p.xbcraw : p.xbcraw_c) + (size_t)b * seqlen * DXBC;
  const int l0 = tt * 64, c0 = ct * 64, tid = threadIdx.x;
  float (*rt)[68] = reinterpret_cast<float (*)[68]>(smem);
  float (*at)[65] = reinterpret_cast<float (*)[65]>(smem + 66 * 68 * 4);
  __syncthreads();
  {
    uint2 v[5];
#pragma unroll
    for (int k = 0; k < 5; ++k) {
      const int i = tid + k * NTHREADS, r = i >> 4, c4 = i & 15, l = l0 - 1 + r;
      v[k] = (i < 66 * 16 && l >= 0 && l < seqlen) ? *reinterpret_cast<const uint2*>(raw + (size_t)l * DXBC + c0 + c4 * 4) : uint2{0u, 0u};
    }
#pragma unroll
    for (int k = 0; k < 5; ++k) {
      const int i = tid + k * NTHREADS, r = i >> 4, c4 = i & 15;
      if (i < 66 * 16) *reinterpret_cast<float4*>(&rt[r][c4 * 4]) = float4{bflo(v[k].x), bfhi(v[k].x), bflo(v[k].y), bfhi(v[k].y)};
    }
  }
  __syncthreads();
  {
    const int cc = tid & 63, c = c0 + cc;
    const float w0 = p.conv_w[c], w1 = p.conv_w[DXBC + c], w2 = p.conv_w[2 * DXBC + c], cb = p.conv_b[c];
#pragma unroll 4
    for (int r = tid >> 6; r < 64; r += 4) at[r][cc] = silu_f(cb + rt[r][cc] * w0 + rt[r + 1][cc] * w1 + rt[r + 2][cc] * w2);
  }
  __syncthreads();
  const size_t trow0 = isx ? ((size_t)b * L + l0) : ((size_t)T + (size_t)b * CTX + l0);
#pragma unroll
  for (int k = 0; k < 4; ++k) {
    const int i = tid + k * NTHREADS, r = i >> 4, c4 = (i & 15) * 4;
    uint2 o; o.x = pack2(at[r][c4], at[r][c4 + 1]); o.y = pack2(at[r][c4 + 2], at[r][c4 + 3]);
    *reinterpret_cast<uint2*>(p.act_tm + (trow0 + r) * DXBC + c0 + c4) = o;
  }
  if (c0 < 1280) {
    bf16_t* cm = (isx ? p.act_cm_x : p.act_cm_c) + (size_t)b * 1280 * seqlen;
#pragma unroll
    for (int k = 0; k < 4; ++k) {
      const int i = tid + k * NTHREADS, cc = i >> 4, r4 = (i & 15) * 4;
      uint2 o; o.x = pack2(at[r4][cc], at[r4 + 1][cc]); o.y = pack2(at[r4 + 2][cc], at[r4 + 3][cc]);
      *reinterpret_cast<uint2*>(cm + (size_t)(c0 + cc) * seqlen + l0 + r4) = o;
    }
  }
}
__device__ void dft_fold_rows(const Params& p, int bid, int nb, char* smem) {
  const int lane = threadIdx.x & 63, w = threadIdx.x >> 6;
  bf16_t* sr = reinterpret_cast<bf16_t*>(smem + w * 8192);
  for (int row = bid * 4 + w; row < NB * 1024; row += nb * 4) {
    const bf16_t* A = p.ABt + (size_t)row * 4096;
    bf16_t* F = p.Fs + (size_t)row * 2048;
    __builtin_amdgcn_wave_barrier();
    {
      const uint4 q0 = *reinterpret_cast<const uint4*>(A + (0 * 64 + lane) * 8), q1 = *reinterpret_cast<const uint4*>(A + (1 * 64 + lane) * 8);
      const uint4 q2 = *reinterpret_cast<const uint4*>(A + (2 * 64 + lane) * 8), q3 = *reinterpret_cast<const uint4*>(A + (3 * 64 + lane) * 8);
      const uint4 q4 = *reinterpret_cast<const uint4*>(A + (4 * 64 + lane) * 8), q5 = *reinterpret_cast<const uint4*>(A + (5 * 64 + lane) * 8);
      const uint4 q6 = *reinterpret_cast<const uint4*>(A + (6 * 64 + lane) * 8), q7 = *reinterpret_cast<const uint4*>(A + (7 * 64 + lane) * 8);
      *reinterpret_cast<uint4*>(sr + (0 * 64 + lane) * 8) = q0; *reinterpret_cast<uint4*>(sr + (1 * 64 + lane) * 8) = q1;
      *reinterpret_cast<uint4*>(sr + (2 * 64 + lane) * 8) = q2; *reinterpret_cast<uint4*>(sr + (3 * 64 + lane) * 8) = q3;
      *reinterpret_cast<uint4*>(sr + (4 * 64 + lane) * 8) = q4; *reinterpret_cast<uint4*>(sr + (5 * 64 + lane) * 8) = q5;
      *reinterpret_cast<uint4*>(sr + (6 * 64 + lane) * 8) = q6; *reinterpret_cast<uint4*>(sr + (7 * 64 + lane) * 8) = q7;
    }
    __builtin_amdgcn_wave_barrier();
    const int l0 = lane * 16;
    float alt = 0.f;
    uint32_t oa[8], ob[8];
#pragma unroll
    for (int half = 0; half < 2; ++half) {
      const bf16_t* base = sr + half * 2048;
      const uint4 fa = *reinterpret_cast<const uint4*>(base + l0), fb = *reinterpret_cast<const uint4*>(base + l0 + 8);
      const uint4 ra = *reinterpret_cast<const uint4*>(base + 2032 - l0), rb = *reinterpret_cast<const uint4*>(base + 2040 - l0);
      const float r16 = (lane > 0) ? bf2f(base[2048 - l0]) : 0.f;
      const uint32_t fw[8] = {fa.x, fa.y, fa.z, fa.w, fb.x, fb.y, fb.z, fb.w};
      const uint32_t rw[8] = {ra.x, ra.y, ra.z, ra.w, rb.x, rb.y, rb.z, rb.w};
      float v[16];
#pragma unroll
      for (int i = 0; i < 16; ++i) {
        const float fwv = (i & 1) ? bfhi(fw[i >> 1]) : bflo(fw[i >> 1]);
        const int j = 16 - i;
        const float rv = (i == 0) ? r16 : ((j & 1) ? bfhi(rw[j >> 1]) : bflo(rw[j >> 1]));
        if (half == 0) v[i] = (lane == 0 && i == 0) ? fwv : fwv + rv;
        else v[i] = (lane == 0 && i == 0) ? 0.f : fwv - rv;
      }
      if (half == 0) {
#pragma unroll
        for (int i = 0; i < 16; ++i) alt += (i & 1) ? -v[i] : v[i];
#pragma unroll
        for (int i = 0; i < 8; ++i) oa[i] = pack2(v[2 * i], v[2 * i + 1]);
      } else {
#pragma unroll
        for (int i = 0; i < 8; ++i) ob[i] = pack2(v[2 * i], v[2 * i + 1]);
      }
    }
    *reinterpret_cast<uint4*>(F + l0) = uint4{oa[0], oa[1], oa[2], oa[3]};
    *reinterpret_cast<uint4*>(F + l0 + 8) = uint4{oa[4], oa[5], oa[6], oa[7]};
    *reinterpret_cast<uint4*>(F + 1024 + l0) = uint4{ob[0], ob[1], ob[2], ob[3]};
    *reinterpret_cast<uint4*>(F + 1024 + l0 + 8) = uint4{ob[4], ob[5], ob[6], ob[7]};
    alt = wave_sum_fast(alt) + bf2f(sr[1024]);
    if (lane == 0) { const int b = row >> 10, ch = row & 1023; p.ycat[((size_t)b * L + 1024) * D + ch] = f2bf(alt); }
  }
}
__device__ void phase_ssm_pre(const Params& p, int bid, int nb, char* smem) {
  const int tid = threadIdx.x;
  dft_fold_rows(p, bid, nb, smem);
  for (int t = bid; t < 3072 + 384; t += nb) ssm_pre_tile(p, t, smem);
  for (int i = bid * NTHREADS + tid; i < (T + TC) * 32; i += nb * NTHREADS) {
    const bool isx = i < T * 32;
    const int ii = isx ? i : i - T * 32;
    const int t = ii >> 5, j = ii & 31;
    const float v = (isx ? p.dtraw : p.dtraw_c)[ii];
    float* df = isx ? p.dtf : p.dtf_c;
    float* db = isx ? p.dtb : p.dtb_c;
    if (j < 16) df[t * 16 + j] = softplus_f(v + p.dt_bias_f[j]);
    else db[t * 16 + (j - 16)] = softplus_f(v + p.dt_bias_b[j - 16]);
  }
}

__device__ __forceinline__ int swz16(int row, int chunk) { return row * 256 + ((chunk ^ (row & 15)) << 4); }
__device__ __forceinline__ int swz8(int row, int chunk) { return row * 128 + ((chunk ^ (row & 7)) << 4); }

#define LDS_BARRIER() asm volatile("s_waitcnt lgkmcnt(0)\n\ts_barrier" ::: "memory")
__device__ void ssd_task(const Params& p, int task, char* smem) {
  const int dir = task & 1, ph = (task >> 1) & 1, h = (task >> 2) & 15, b = task >> 6;
  const int tid = opaque_tid(), lane = tid & 63, w = tid >> 6;
  const int g = h >> 3, lr0 = lane & 15, lq0 = lane >> 4;
  const float a = -__expf(dir ? p.a_log_b[h] : p.a_log_f[h]);
  char* sCc = smem; char* sBc = smem + 16384; char* sBT = smem + 32768; char* sXT = smem + 49152; char* sHb = smem + 57344;
  float* se = reinterpret_cast<float*>(smem + 73728);
  float* sdt = se + 64; float* sw = se + 128; float* sy = se + 192; float* stot = se + 256;
  bf16_t* yo = reinterpret_cast<bf16_t*>(dir ? p.yb : p.yf);
  f32x4 H[2][2];
#pragma unroll
  for (int i = 0; i < 2; ++i)
#pragma unroll
    for (int j = 0; j < 2; ++j) H[i][j] = f32x4{0.f, 0.f, 0.f, 0.f};
  __syncthreads();
  for (int i = tid; i < 512; i += NTHREADS) reinterpret_cast<uint4*>(sHb)[i] = uint4{0, 0, 0, 0};

  const int crow = tid >> 4, cch = tid & 15;
  const int trow = tid >> 3, tch = tid & 7;
  uint4 rC0, rC1, rC2, rC3, rB0, rB1, rB2, rB3, rT0, rT1, rT2, rT3, rX;
  rC0 = rC1 = rC2 = rC3 = rB0 = rB1 = rB2 = rB3 = uint4{0, 0, 0, 0};
  float rdt = 0.f;
#define SSD_PARAMS(st_)                                                                                                   \
  const bool isctx_ = (st_) < 4;                                                                                          \
  const int nch_ = isctx_ ? 4 : 32, ci_ = isctx_ ? (st_) : (st_) - 4;                                                     \
  const int c_ = dir ? (nch_ - 1 - ci_) : ci_;                                                                            \
  const int seqlen_ = isctx_ ? CTX : L;                                                                                   \
  const size_t trow0_ = isctx_ ? ((size_t)T + (size_t)b * CTX + c_ * 64) : ((size_t)b * L + c_ * 64);                     \
  const size_t drow0_ = (size_t)b * seqlen_ + c_ * 64;                                                                    \
  const float* dtp_ = isctx_ ? (dir ? p.dtb_c : p.dtf_c) : (dir ? p.dtb : p.dtf);                                         \
  const bf16_t* cm_ = (isctx_ ? p.act_cm_c : p.act_cm_x) + (size_t)b * 1280 * seqlen_ + c_ * 64;
#define SSD_PREFETCH(st_)                                                                                                 \
  do {                                                                                                                    \
    SSD_PARAMS(st_)                                                                                                       \
    if (w == 0) rdt = dtp_[(drow0_ + lane) * 16 + h];                                                                     \
    if (!isctx_) {                                                                                                        \
      const bf16_t* src = p.act_tm + (trow0_ + crow) * DXBC + g * 128 + cch * 8;                                          \
      rC0 = *reinterpret_cast<const uint4*>(src + 1280);             rB0 = *reinterpret_cast<const uint4*>(src + 1024);   \
      rC1 = *reinterpret_cast<const uint4*>(src + 16 * DXBC + 1280); rB1 = *reinterpret_cast<const uint4*>(src + 16 * DXBC + 1024); \
      rC2 = *reinterpret_cast<const uint4*>(src + 32 * DXBC + 1280); rB2 = *reinterpret_cast<const uint4*>(src + 32 * DXBC + 1024); \
      rC3 = *reinterpret_cast<const uint4*>(src + 48 * DXBC + 1280); rB3 = *reinterpret_cast<const uint4*>(src + 48 * DXBC + 1024); \
    }                                                                                                                     \
    const bf16_t* srt = cm_ + (size_t)(1024 + g * 128 + trow) * seqlen_ + tch * 8;                                        \
    rT0 = *reinterpret_cast<const uint4*>(srt);                                                                           \
    rT1 = *reinterpret_cast<const uint4*>(srt + (size_t)32 * seqlen_);                                                    \
    rT2 = *reinterpret_cast<const uint4*>(srt + (size_t)64 * seqlen_);                                                    \
    rT3 = *reinterpret_cast<const uint4*>(srt + (size_t)96 * seqlen_);                                                    \
    rX = *reinterpret_cast<const uint4*>(cm_ + (size_t)(h * 64 + ph * 32 + trow) * seqlen_ + tch * 8);                    \
  } while (0)

  for (int step = 0; step < 36; ++step) {
    SSD_PREFETCH(step);
    const bool isctx = step < 4;
    const int c = dir ? ((isctx ? 4 : 32) - 1 - (isctx ? step : step - 4)) : (isctx ? step : step - 4);
    const size_t trow0 = (size_t)b * L + c * 64;
    int lr = lr0, lq = lq0;
    asm volatile("" : "+v"(lr), "+v"(lq));
    LDS_BARRIER();
    if (w == 0) {
      const float dtv = rdt;
      const float adt = a * dtv;
      float v = adt;
      v += __builtin_bit_cast(float, __builtin_amdgcn_update_dpp(0, __builtin_bit_cast(int, v), 0x111, 0xF, 0xF, false));
      v += __builtin_bit_cast(float, __builtin_amdgcn_update_dpp(0, __builtin_bit_cast(int, v), 0x112, 0xF, 0xF, false));
      v += __builtin_bit_cast(float, __builtin_amdgcn_update_dpp(0, __builtin_bit_cast(int, v), 0x114, 0xF, 0xF, false));
      v += __builtin_bit_cast(float, __builtin_amdgcn_update_dpp(0, __builtin_bit_cast(int, v), 0x118, 0xF, 0xF, false));
      v += __builtin_bit_cast(float, __builtin_amdgcn_update_dpp(0, __builtin_bit_cast(int, v), 0x142, 0xA, 0xF, false));
      v += __builtin_bit_cast(float, __builtin_amdgcn_update_dpp(0, __builtin_bit_cast(int, v), 0x143, 0xC, 0xF, false));
      const float etot = __builtin_bit_cast(float, __builtin_amdgcn_readlane(__builtin_bit_cast(int, v), 63));
      if (dir) v = etot - v + adt;
      se[lane] = v; sdt[lane] = dtv; sw[lane] = dtv * __expf(etot - v); sy[lane] = __expf(v);
      if (lane == 0) stot[0] = etot;
    }
    if (!isctx) {
      const int oc = swz16(crow, cch);
      *reinterpret_cast<uint4*>(sCc + oc) = rC0;         *reinterpret_cast<uint4*>(sBc + oc) = rB0;
      *reinterpret_cast<uint4*>(sCc + oc + 4096) = rC1;  *reinterpret_cast<uint4*>(sBc + oc + 4096) = rB1;
      *reinterpret_cast<uint4*>(sCc + oc + 8192) = rC2;  *reinterpret_cast<uint4*>(sBc + oc + 8192) = rB2;
      *reinterpret_cast<uint4*>(sCc + oc + 12288) = rC3; *reinterpret_cast<uint4*>(sBc + oc + 12288) = rB3;
    }
    {
      const int ot = swz8(trow, tch);
      *reinterpret_cast<uint4*>(sBT + ot) = rT0;
      *reinterpret_cast<uint4*>(sBT + ot + 4096) = rT1;
      *reinterpret_cast<uint4*>(sBT + ot + 8192) = rT2;
      *reinterpret_cast<uint4*>(sBT + ot + 12288) = rT3;
      *reinterpret_cast<uint4*>(sXT + ot) = rX;
    }
    LDS_BARRIER();
    const float etot = stot[0];
    if (!isctx) {
      f32x4 G[4];
      bf16x8 ca[4];
#pragma unroll
      for (int j = 0; j < 4; ++j) G[j] = f32x4{0.f, 0.f, 0.f, 0.f};
#pragma unroll
      for (int kk = 0; kk < 4; ++kk) ca[kk] = *reinterpret_cast<const bf16x8*>(sCc + swz16(16 * w + lr, kk * 4 + lq));
#pragma unroll
      for (int kk = 0; kk < 4; ++kk)
#pragma unroll
        for (int j = 0; j < 4; ++j) {
          bf16x8 bb = *reinterpret_cast<const bf16x8*>(sBc + swz16(16 * j + lr, kk * 4 + lq));
          G[j] = __builtin_amdgcn_mfma_f32_16x16x32_bf16(ca[kk], bb, G[j], 0, 0, 0);
        }
      LDS_BARRIER();
      float el[4];
#pragma unroll
      for (int r = 0; r < 4; ++r) el[r] = se[16 * w + lq * 4 + r];
#pragma unroll
      for (int j = 0; j < 4; ++j) {
        const int s_ = 16 * j + lr;
        const float es = se[s_], ds = sdt[s_];
#pragma unroll
        for (int r = 0; r < 4; ++r) {
          const int l = 16 * w + lq * 4 + r;
          const bool keep = dir ? (s_ >= l) : (s_ <= l);
          const float m = keep ? G[j][r] * __expf(el[r] - es) * ds : 0.f;
          *reinterpret_cast<bf16_t*>(sBc + swz8(l, s_ >> 3) + (s_ & 7) * 2) = f2bf(m);
        }
      }
      LDS_BARRIER();
      f32x4 Y[2], Yo[2];
#pragma unroll
      for (int j = 0; j < 2; ++j) { Y[j] = f32x4{0.f, 0.f, 0.f, 0.f}; Yo[j] = f32x4{0.f, 0.f, 0.f, 0.f}; }
#pragma unroll
      for (int kk = 0; kk < 2; ++kk) {
        bf16x8 ma = *reinterpret_cast<const bf16x8*>(sBc + swz8(16 * w + lr, kk * 4 + lq));
#pragma unroll
        for (int j = 0; j < 2; ++j) {
          bf16x8 xb = *reinterpret_cast<const bf16x8*>(sXT + swz8(16 * j + lr, kk * 4 + lq));
          Y[j] = __builtin_amdgcn_mfma_f32_16x16x32_bf16(ma, xb, Y[j], 0, 0, 0);
        }
      }
#pragma unroll
      for (int kk = 0; kk < 4; ++kk)
#pragma unroll
        for (int j = 0; j < 2; ++j) {
          bf16x8 hb = *reinterpret_cast<const bf16x8*>(sHb + swz16(16 * j + lr, kk * 4 + lq));
          Yo[j] = __builtin_amdgcn_mfma_f32_16x16x32_bf16(ca[kk], hb, Yo[j], 0, 0, 0);
        }
      float syl[4];
#pragma unroll
      for (int r = 0; r < 4; ++r) syl[r] = sy[16 * w + lq * 4 + r];
#pragma unroll
      for (int j = 0; j < 2; ++j)
#pragma unroll
        for (int r = 0; r < 4; ++r) {
          const int l = 16 * w + lq * 4 + r;
          yo[(trow0 + l) * 1024 + h * 64 + ph * 32 + 16 * j + lr] = f2bf(Y[j][r] + syl[r] * Yo[j][r]);
        }
    }
    {
      const float dec = __expf(etot);
#pragma unroll
      for (int i = 0; i < 2; ++i)
#pragma unroll
        for (int j = 0; j < 2; ++j) H[i][j] *= dec;
#pragma unroll
      for (int kk = 0; kk < 2; ++kk) {
        const int s0 = kk * 32 + lq * 8;
        const float4 w0 = *reinterpret_cast<const float4*>(sw + s0), w1 = *reinterpret_cast<const float4*>(sw + s0 + 4);
        bf16x8 xs[2];
#pragma unroll
        for (int i = 0; i < 2; ++i) {
          const bf16x8 xa = *reinterpret_cast<const bf16x8*>(sXT + swz8(16 * i + lr, kk * 4 + lq));
          xs[i][0] = (short)f2bf(bf2f((bf16_t)xa[0]) * w0.x); xs[i][1] = (short)f2bf(bf2f((bf16_t)xa[1]) * w0.y);
          xs[i][2] = (short)f2bf(bf2f((bf16_t)xa[2]) * w0.z); xs[i][3] = (short)f2bf(bf2f((bf16_t)xa[3]) * w0.w);
          xs[i][4] = (short)f2bf(bf2f((bf16_t)xa[4]) * w1.x); xs[i][5] = (short)f2bf(bf2f((bf16_t)xa[5]) * w1.y);
          xs[i][6] = (short)f2bf(bf2f((bf16_t)xa[6]) * w1.z); xs[i][7] = (short)f2bf(bf2f((bf16_t)xa[7]) * w1.w);
        }
#pragma unroll
        for (int j = 0; j < 2; ++j) {
          const bf16x8 bt = *reinterpret_cast<const bf16x8*>(sBT + swz8(16 * (2 * w + j) + lr, kk * 4 + lq));
#pragma unroll
          for (int i = 0; i < 2; ++i) H[i][j] = __builtin_amdgcn_mfma_f32_16x16x32_bf16(xs[i], bt, H[i][j], 0, 0, 0);
        }
      }
    }
    LDS_BARRIER();
#pragma unroll
    for (int i = 0; i < 2; ++i)
#pragma unroll
      for (int j = 0; j < 2; ++j) {
        const int n = 16 * (2 * w + j) + lr;
#pragma unroll
        for (int r = 0; r < 4; ++r) {
          const int pr = 16 * i + lq * 4 + r;
          *reinterpret_cast<bf16_t*>(sHb + swz16(pr, n >> 3) + (n & 7) * 2) = f2bf(H[i][j][r]);
        }
      }
  }
#undef SSD_PREFETCH
#undef SSD_PARAMS
}

#undef LDS_BARRIER
__device__ void phase_ssd_dft(const Params& p, int bid, int nb, char* smem) {
  for (int t = bid; t < 256; t += nb) ssd_task(p, t, smem);
  int* stile = reinterpret_cast<int*>(smem + 75776);
  for (;;) {
    __syncthreads();
    if (threadIdx.x == 0) *stile = (int)atomicAdd(p.ctr, 1u);
    __syncthreads();
    const int t = *stile;
    if (t >= 4 * 8 * 8) break;
    const int b = t >> 6, tm = (t & 63) >> 3, tn = t & 7;
    const bf16_t* Fb = p.Fs + (size_t)b * 1024 * 2048;
    f32x4 accC[4][4], accS[4][4];
    gemm_mainloop(p.dftm, 2048, Fb, 2048, 1024, tm * 128, tn * 128, accC, smem);
    gemm_mainloop(p.dftm + 1024, 2048, Fb + 1024, 2048, 1024, tm * 128, tn * 128, accS, smem);
    const int lane = threadIdx.x & 63, w = threadIdx.x >> 6, wm = w >> 1, wn = w & 1;
#pragma unroll
    for (int i = 0; i < 4; ++i) {
      int lq_ = lane >> 4, lr_ = lane & 15;
      asm volatile("" : "+v"(lq_), "+v"(lr_));
#pragma unroll
      for (int j = 0; j < 4; ++j) {
        const int k0 = tm * 128 + wm * 64 + i * 16 + lq_ * 4;
        const int ch = tn * 128 + wn * 64 + j * 16 + lr_;
        const float a = bf2f(p.ABt[((size_t)b * 1024 + ch) * 4096 + 1024]);
#pragma unroll
        for (int r = 0; r < 4; ++r) {
          const int k = k0 + r;
          const float as = (k & 1) ? -a : a;
          const float c = accC[i][j][r], sn = accS[i][j][r];
          p.ycat[((size_t)b * L + k) * D + ch] = f2bf(c - sn + as);
          if (k > 0) p.ycat[((size_t)b * L + (L - k)) * D + ch] = f2bf(c + sn + as);
        }
      }
    }
  }
  for (;;) {
    __syncthreads();
    if (threadIdx.x == 0) *stile = (int)atomicAdd(p.ctr + 8, 1u);
    __syncthreads();
    const int q4 = *stile;
    if (q4 >= (1024 + 1536) / 4) break;
#pragma unroll 1
    for (int q = q4 * 4; q < q4 * 4 + 4; ++q) {
      if (q < 512) convert_u_rows(p, q);
      else if (q < 1024) convert_v_units(p, (size_t)(q - 512) * 4096, (size_t)(q - 511) * 4096);
      else if (q < 1024 + 1024) { const int q1 = q - 1024; transpose_convert_task(p.w_out, D, 0, D, p.w_out_t, q1 / 32, q1 % 32, reinterpret_cast<float*>(smem)); }
      else { const int q2 = q - 2048; transpose_convert_task(p.w_query, 1024, 0, D, p.w_q_t, q2 / 16, q2 % 16, reinterpret_cast<float*>(smem)); }
    }
  }
}

__device__ void phase_ssm_post(const Params& p, int bid, int nb, char* smem) {
  const int lane = threadIdx.x & 63, w = threadIdx.x >> 6;
  for (int t = bid * 4 + w; t < T; t += nb * 4) {
    float y[4][4];
    float ss0 = 0.f, ss1 = 0.f;
#pragma unroll
    for (int c = 0; c < 4; ++c) {
      const int c0 = c * 256 + lane * 4;
      const int h = c0 >> 6;
      const float dsk = p.d_skip_f[h] + p.d_skip_b[h];
      const uint2 aq = *reinterpret_cast<const uint2*>(reinterpret_cast<const bf16_t*>(p.yf) + (size_t)t * 1024 + c0);
      const uint2 bb = *reinterpret_cast<const uint2*>(reinterpret_cast<const bf16_t*>(p.yb) + (size_t)t * 1024 + c0);
      const float4 a = float4{bflo(aq.x), bfhi(aq.x), bflo(aq.y), bfhi(aq.y)};
      const float4 bq = float4{bflo(bb.x), bfhi(bb.x), bflo(bb.y), bfhi(bb.y)};
      const uint2 xq = *reinterpret_cast<const uint2*>(p.act_tm + (size_t)t * DXBC + c0);
      const uint2 zz = *reinterpret_cast<const uint2*>(p.z + (size_t)t * 1024 + c0);
      y[c][0] = (a.x + bq.x + dsk * bflo(xq.x)) * silu_f(bflo(zz.x));
      y[c][1] = (a.y + bq.y + dsk * bfhi(xq.x)) * silu_f(bfhi(zz.x));
      y[c][2] = (a.z + bq.z + dsk * bflo(xq.y)) * silu_f(bflo(zz.y));
      y[c][3] = (a.w + bq.w + dsk * bfhi(xq.y)) * silu_f(bfhi(zz.y));
      const float q = y[c][0] * y[c][0] + y[c][1] * y[c][1] + y[c][2] * y[c][2] + y[c][3] * y[c][3];
      if (c < 2) ss0 += q; else ss1 += q;
    }
    ss0 = wave_sum_fast(ss0); ss1 = wave_sum_fast(ss1);
    const float r0 = rsqrtf(ss0 * (1.f / 512.f) + EPS), r1 = rsqrtf(ss1 * (1.f / 512.f) + EPS);
    uint2 fq[4];
    float am = 0.f;
#pragma unroll
    for (int c = 0; c < 4; ++c) {
      const int c0 = c * 256 + lane * 4;
      fq[c] = *reinterpret_cast<const uint2*>(p.ycat + (size_t)t * D + c0);
      am = fmaxf(am, fmaxf(fmaxf(fabsf(bflo(fq[c].x)), fabsf(bfhi(fq[c].x))), fmaxf(fabsf(bflo(fq[c].y)), fabsf(bfhi(fq[c].y)))));
      const float rstd = (c < 2) ? r0 : r1;
      const float4 nw = *reinterpret_cast<const float4*>(p.ssm_norm_w + c0);
      y[c][0] *= rstd * nw.x; y[c][1] *= rstd * nw.y; y[c][2] *= rstd * nw.z; y[c][3] *= rstd * nw.w;
      am = fmaxf(am, fmaxf(fmaxf(fabsf(y[c][0]), fabsf(y[c][1])), fmaxf(fabsf(y[c][2]), fabsf(y[c][3]))));
    }
    am = wave_max_fast(am);
    const float inv = (am > 0.f) ? 127.f / am : 0.f;
#pragma unroll
    for (int c = 0; c < 4; ++c) {
      const int c0 = c * 256 + lane * 4;
      *reinterpret_cast<uint32_t*>(p.ycat8 + (size_t)t * D + c0) =
          pack_i8x4(bflo(fq[c].x) * inv, bfhi(fq[c].x) * inv, bflo(fq[c].y) * inv, bfhi(fq[c].y) * inv);
      *reinterpret_cast<uint32_t*>(p.ycat8 + (size_t)t * D + 1024 + c0) = pack_i8x4(y[c][0] * inv, y[c][1] * inv, y[c][2] * inv, y[c][3] * inv);
    }
    if (lane == 0) p.yscale[t] = am * (1.f / 127.f);
  }
  quant_weight_rows_i8(p.w_out_t, p.wo8, p.woscale, D, bid, nb);
  quant_weight_rows_i8(p.w_q_t, p.wq8, p.wqscale, 1024, bid, nb);
}

__device__ void phase_outproj(const Params& p, int bid, int nb, char* smem) {
  const bool aware = (nb & 7) == 0;
  const int start = aware ? (bid >> 3) : bid, step = aware ? (nb >> 3) : nb, end = aware ? 64 : 512;
  const bf16_t* a8 = reinterpret_cast<const bf16_t*>(p.ycat8);
  const bf16_t* b8 = reinterpret_cast<const bf16_t*>(p.wo8);
  for (int it = start; it < end; it += step) {
    const int x = aware ? (bid & 7) : (it >> 6), s_ = aware ? it : (it & 63);
    EpiBf16 epi{reinterpret_cast<bf16_t*>(p.y_x), D};
    gemm_tile_n256<true>(a8, D / 2, b8, D / 2, D / 2, (8 * x + (s_ & 7)) * 128, (s_ >> 3) * 256, epi, smem, p.yscale, p.woscale);
  }
}
__device__ void phase_postmix(const Params& p, int bid, int nb, char* smem) {
  const int lane = threadIdx.x & 63, w = threadIdx.x >> 6;
  for (int t = bid * 4 + w; t < T; t += nb * 4) {
    const int b = t / L;
    float4 y[8];
    float ss = 0.f;
#pragma unroll
    for (int c = 0; c < 8; ++c) {
      {
        const uint2 yq = *reinterpret_cast<const uint2*>(reinterpret_cast<const bf16_t*>(p.y_x) + (size_t)t * D + c * 256 + lane * 4);
        y[c] = float4{bflo(yq.x), bfhi(yq.x), bflo(yq.y), bfhi(yq.y)};
      }
      ss += y[c].x * y[c].x + y[c].y * y[c].y + y[c].z * y[c].z + y[c].w * y[c].w;
    }
    ss = wave_sum_fast(ss);
    const float rstd = rsqrtf(ss * (1.f / D) + EPS);
    const float* gm = p.mod + (size_t)b * NMOD + 2 * D;
    float ss1 = 0.f;
#pragma unroll
    for (int c = 0; c < 8; ++c) {
      const int e0 = c * 256 + lane * 4;
      const float4 xv = *reinterpret_cast<const float4*>(p.x + (size_t)t * D + e0);
      const float4 g4 = *reinterpret_cast<const float4*>(gm + e0), gp = *reinterpret_cast<const float4*>(p.g_post_mix + e0);
      y[c].x = xv.x + g4.x * (y[c].x * rstd * gp.x); y[c].y = xv.y + g4.y * (y[c].y * rstd * gp.y);
      y[c].z = xv.z + g4.z * (y[c].z * rstd * gp.z); y[c].w = xv.w + g4.w * (y[c].w * rstd * gp.w);
      ss1 += y[c].x * y[c].x + y[c].y * y[c].y + y[c].z * y[c].z + y[c].w * y[c].w;
    }
    if (lane == 0) p.partial[t] = rstd;
    ss1 = wave_sum_fast(ss1);
    const float rstd1 = rsqrtf(ss1 * (1.f / D) + EPS);
    const float* sf = p.mod + (size_t)b * NMOD + 3 * D;
    const float* cf = p.mod + (size_t)b * NMOD + 4 * D;
    float am = 0.f;
#pragma unroll
    for (int c = 0; c < 8; ++c) {
      const int e0 = c * 256 + lane * 4;
      const float4 g = *reinterpret_cast<const float4*>(p.g_pre_ffn + e0);
      const float4 s4 = *reinterpret_cast<const float4*>(cf + e0), h4 = *reinterpret_cast<const float4*>(sf + e0);
      y[c].x = y[c].x * rstd1 * g.x * (1.f + s4.x) + h4.x; y[c].y = y[c].y * rstd1 * g.y * (1.f + s4.y) + h4.y;
      y[c].z = y[c].z * rstd1 * g.z * (1.f + s4.z) + h4.z; y[c].w = y[c].w * rstd1 * g.w * (1.f + s4.w) + h4.w;
      am = fmaxf(am, fmaxf(fmaxf(fabsf(y[c].x), fabsf(y[c].y)), fmaxf(fabsf(y[c].z), fabsf(y[c].w))));
    }
    am = wave_max_fast(am);
    const float inv = (am > 0.f) ? 127.f / am : 0.f;
#pragma unroll
    for (int c = 0; c < 8; ++c)
      *reinterpret_cast<uint32_t*>(p.hx8a + (size_t)t * D + c * 256 + lane * 4) = pack_i8x4(y[c].x * inv, y[c].y * inv, y[c].z * inv, y[c].w * inv);
    if (lane == 0) p.ascale[t] = am * (1.f / 127.f);
  }
}

__device__ __forceinline__ uint32_t mono_key(float f) {
  uint32_t u = __float_as_uint(f);
  return (u & 0x80000000u) ? ~u : (u | 0x80000000u);
}
__device__ __forceinline__ void ins16(uint32_t (&Lk)[16], uint32_t x) {
#pragma unroll
  for (int i = 0; i < 16; ++i) { uint32_t hi = max(Lk[i], x); x = min(Lk[i], x); Lk[i] = hi; }
}
__device__ __forceinline__ float unmono_key(uint32_t k) {
  return __uint_as_float((k & 0x80000000u) ? (k ^ 0x80000000u) : ~k);
}
typedef __attribute__((ext_vector_type(16))) float f32x16;
__device__ void phase_q_route(const Params& p, int bid, int nb, char* smem) {
  const int tid = opaque_tid(), lane = tid & 63, w = tid >> 6;
  const int wm = w >> 1, wn = w & 1, lr = lane & 15, lq = lane >> 4;
  const int l31 = lane & 31, lh = lane >> 5;
  for (int tile0 = bid; tile0 < 512; tile0 += nb) {
    const int tile = ((nb & 7) == 0 && nb >= 512) ? (((tile0 & 7) * 8 + ((tile0 >> 3) & 7)) * 8 + (tile0 >> 6)) : tile0;
    const int h = tile & 7, m0 = (tile >> 3) * 128;
    {
      f32x4 acc[4][4];
      gemm_mainloop<true>(reinterpret_cast<const bf16_t*>(p.hx8a), D / 2, reinterpret_cast<const bf16_t*>(p.wq8), D / 2, D / 2, m0, h * 128, acc, smem);
#pragma unroll
      for (int i = 0; i < 4; ++i) {
        const float4 rs = *reinterpret_cast<const float4*>(p.ascale + m0 + wm * 64 + i * 16 + lq * 4);
#pragma unroll
        for (int j = 0; j < 4; ++j) {
          typedef __attribute__((ext_vector_type(4))) int i32x4;
          const i32x4 ia = __builtin_bit_cast(i32x4, acc[i][j]);
          const float cs = p.wqscale[h * 128 + wn * 64 + j * 16 + lr];
          const float qv[4] = {(float)ia[0] * rs.x * cs, (float)ia[1] * rs.y * cs, (float)ia[2] * rs.z * cs, (float)ia[3] * rs.w * cs};
#pragma unroll
          for (int r = 0; r < 4; ++r) {
            const int row = wm * 64 + i * 16 + lq * 4 + r, col = wn * 64 + j * 16 + lr;
            *reinterpret_cast<bf16_t*>(smem + swz16(row, col >> 3) + (col & 7) * 2) = f2bf(qv[r]);
          }
        }
      }
    }
#pragma unroll 4
    for (int r = 0; r < 16; ++r) {
      const int id = tid + 256 * r, row = id >> 4, c4 = id & 15;
      const float* src = ((row < 128) ? p.sk1 : p.sk2) + ((size_t)(h * 128 + (row & 127)) * 64 + c4 * 4);
      const float4 v = *reinterpret_cast<const float4*>(src);
      uint2 pk; pk.x = pack2(v.x, v.y); pk.y = pack2(v.z, v.w);
      *reinterpret_cast<uint2*>(smem + 32768 + swz8(row, c4 >> 1) + (c4 & 1) * 8) = pk;
    }
    __syncthreads();
    uint32_t L1[16], L2[16];
#pragma unroll
    for (int sd = 0; sd < 2; ++sd) {
      uint32_t Lk[16];
#pragma unroll
      for (int i = 0; i < 16; ++i) Lk[i] = 0u;
      const uint32_t kb = (uint32_t)(lh * 4);
#pragma unroll
      for (int ih = 0; ih < 2; ++ih) {
        f32x16 Sa[2];
#pragma unroll
        for (int i = 0; i < 2; ++i)
#pragma unroll
          for (int g2 = 0; g2 < 16; ++g2) Sa[i][g2] = 0.f;
#pragma unroll
        for (int ks = 0; ks < 4; ++ks) {
          const bf16x8 qb = *reinterpret_cast<const bf16x8*>(smem + swz16(w * 32 + l31, sd * 8 + ks * 2 + lh));
#pragma unroll
          for (int i = 0; i < 2; ++i) {
            const bf16x8 ka = *reinterpret_cast<const bf16x8*>(smem + 32768 + swz8(sd * 128 + (ih * 2 + i) * 32 + l31, ks * 2 + lh));
            Sa[i] = __builtin_amdgcn_mfma_f32_32x32x16_bf16(ka, qb, Sa[i], 0, 0, 0);
          }
        }
#pragma unroll
        for (int i = 0; i < 2; ++i)
#pragma unroll
          for (int g2 = 0; g2 < 16; ++g2)
            ins16(Lk, (mono_key(Sa[i][g2]) & ~0x7Fu) | (uint32_t)((ih * 2 + i) * 32 + (g2 & 3) + 8 * (g2 >> 2)) | kb);
      }
#pragma unroll
      for (int i = 0; i < 8; ++i) {
        const uint32_t t1 = (uint32_t)__shfl_xor((int)Lk[15 - i], 32), t2 = (uint32_t)__shfl_xor((int)Lk[i], 32);
        Lk[i] = max(Lk[i], t1); Lk[15 - i] = max(Lk[15 - i], t2);
      }
#pragma unroll
      for (int dd = 8; dd >= 1; dd >>= 1)
#pragma unroll
        for (int i = 0; i < 16; ++i)
          if ((i & dd) == 0) { const uint32_t hi = max(Lk[i], Lk[i + dd]), lo = min(Lk[i], Lk[i + dd]); Lk[i] = hi; Lk[i + dd] = lo; }
#pragma unroll
      for (int r = 0; r < 16; ++r) { if (sd == 0) L1[r] = Lk[r]; else L2[r] = Lk[r]; }
    }
    __syncthreads();
    uint32_t* ib = reinterpret_cast<uint32_t*>(smem) + w * 1088 + l31 * 34;
    if (lh == 0) {
#pragma unroll
      for (int r = 0; r < 16; ++r) { ib[r] = L1[r] & 127u; ib[16 + r] = L2[r] & 127u; }
    }
    float v1[16], v2[16];
#pragma unroll
    for (int r = 0; r < 16; ++r) { v1[r] = unmono_key(L1[r] & ~0x7Fu); v2[r] = unmono_key(L2[r] & ~0x7Fu); }
    uint32_t C[16];
#pragma unroll
    for (int i = 0; i < 16; ++i) C[i] = 0u;
#pragma unroll
    for (int a = 0; a < 16; ++a)
#pragma unroll
      for (int bq = 0; bq < 16; ++bq)
        if ((a + 1) * (bq + 1) <= 16) ins16(C, (mono_key(v1[a] + v2[bq]) & ~0xFFu) | (uint32_t)(a * 16 + bq));
    float ts[16]; int te[16];
    __builtin_amdgcn_wave_barrier();
#pragma unroll
    for (int r = 0; r < 16; ++r) {
      const uint32_t code = C[r] & 0xFFu;
      te[r] = (int)(ib[code >> 4] * 128u + ib[16 + (code & 15u)]);
      ts[r] = unmono_key(C[r] & ~0xFFu);
    }
    const float mx = ts[0];
    float den = 0.f;
#pragma unroll
    for (int r = 0; r < 16; ++r) { ts[r] = __expf(ts[r] - mx); den += ts[r]; }
    const float inv = 1.f / den;
    const size_t ob = (size_t)(m0 + w * 32 + l31) * 128 + h * 16;
    if (lh == 0) {
#pragma unroll
      for (int r = 0; r < 16; r += 4) *reinterpret_cast<int4*>(p.idx + ob + r) = int4{te[r], te[r + 1], te[r + 2], te[r + 3]};
    } else {
#pragma unroll
      for (int r = 0; r < 16; r += 4)
        *reinterpret_cast<float4*>(p.gate + ob + r) = float4{ts[r] * inv, ts[r + 1] * inv, ts[r + 2] * inv, ts[r + 3] * inv};
    }
    __syncthreads();
  }
}

typedef __attribute__((ext_vector_type(2))) float f32x2;
__device__ __forceinline__ void fp8x16_to_f32(const uint4 q, f32x2 (&o)[8]) {
  o[0] = __builtin_amdgcn_cvt_pk_f32_fp8((int)q.x, false); o[1] = __builtin_amdgcn_cvt_pk_f32_fp8((int)q.x, true);
  o[2] = __builtin_amdgcn_cvt_pk_f32_fp8((int)q.y, false); o[3] = __builtin_amdgcn_cvt_pk_f32_fp8((int)q.y, true);
  o[4] = __builtin_amdgcn_cvt_pk_f32_fp8((int)q.z, false); o[5] = __builtin_amdgcn_cvt_pk_f32_fp8((int)q.z, true);
  o[6] = __builtin_amdgcn_cvt_pk_f32_fp8((int)q.w, false); o[7] = __builtin_amdgcn_cvt_pk_f32_fp8((int)q.w, true);
}
__device__ __forceinline__ unsigned my_xcc_id() { return (unsigned)__builtin_amdgcn_s_getreg((3 << 11) | 20) & 7u; }

__device__ void phase_exp_u(const Params& p, char* smem) {
  const int tid = opaque_tid(), lane = tid & 63, w = tid >> 6;
  const int sub = lane >> 4, cc = lane & 15;
  const unsigned myx = my_xcc_id();
  int* sh = reinterpret_cast<int*>(smem);
  int* si = reinterpret_cast<int*>(smem + 64) + w * 256;
  float* pbuf = reinterpret_cast<float*>(p.ycat);
  {
    unsigned qcur = 0;
    for (;;) {
      __syncthreads();
      if (tid == 0) {
        int found = -1; unsigned fx = 0;
        for (; qcur < 8; ++qcur) {
          fx = (myx + qcur) & 7u;
          const int c = (int)atomicAdd(&p.ctr[16 + fx], 1u);
          if (c < 256) { found = c; break; }
        }
        sh[0] = found; sh[1] = (int)fx;
      }
      __syncthreads();
      const int chunk = sh[0];
      const unsigned x = (unsigned)sh[1];
      if (chunk < 0) break;
      for (int tt = 0; tt < 8; ++tt) {
        const int t = chunk * 32 + w * 8 + tt;
        __builtin_amdgcn_wave_barrier();
        si[lane] = p.idx[(size_t)t * 128 + lane]; si[64 + lane] = p.idx[(size_t)t * 128 + 64 + lane];
        __builtin_amdgcn_wave_barrier();
        const uint4 hq = *reinterpret_cast<const uint4*>(p.hx8a + (size_t)t * D + x * 256 + cc * 16);
        const uint8_t* ub = p.U8 + (size_t)x * ((size_t)16384 * 256) + cc * 16;
        uint4 qa[8], qb[8];
#define EU_LOAD(q_, bt_) _Pragma("unroll") for (int k = 0; k < 8; ++k) q_[k] = *reinterpret_cast<const uint4*>(ub + (size_t)si[((bt_) * 8 + k) * 4 + sub] * 256)
#define EU_COMP(q_, kb_)                                                                                                \
  _Pragma("unroll") for (int k = 0; k < 8; ++k) {                                                                       \
    int d = __builtin_amdgcn_sdot4((int)q_[k].x, (int)hq.x, 0, false);                                                  \
    int d1 = __builtin_amdgcn_sdot4((int)q_[k].y, (int)hq.y, 0, false);                                                 \
    d = __builtin_amdgcn_sdot4((int)q_[k].z, (int)hq.z, d, false);                                                      \
    d1 = __builtin_amdgcn_sdot4((int)q_[k].w, (int)hq.w, d1, false);                                                    \
    d += d1;                                                                                                            \
    d += dpp_movi<0xB1>(d); d += dpp_movi<0x4E>(d); d += dpp_movi<0x124>(d); d += dpp_movi<0x128>(d);                   \
    mine = (cc == (kb_) + k) ? d : mine;                                                                                \
  }
        int mine = 0;
        EU_LOAD(qa, 0); EU_LOAD(qb, 1);
        EU_COMP(qa, 0); EU_LOAD(qa, 2);
        EU_COMP(qb, 8); EU_LOAD(qb, 3);
        pbuf[((size_t)x * T + t) * 128 + cc * 4 + sub] = (float)mine;
        mine = 0;
        EU_COMP(qa, 0);
        EU_COMP(qb, 8);
        pbuf[((size_t)x * T + t) * 128 + (16 + cc) * 4 + sub] = (float)mine;
#undef EU_LOAD
#undef EU_COMP
      }
    }
  }
}

__device__ void phase_exp_combine(const Params& p, int bid, int nb) {
  const int lane = threadIdx.x & 63, w = threadIdx.x >> 6;
  const float* pbuf = reinterpret_cast<const float*>(p.ycat);
  for (int t = bid * 4 + w; t < T; t += nb * 4) {
    const int e0 = p.idx[(size_t)t * 128 + lane], e1 = p.idx[(size_t)t * 128 + 64 + lane];
    const float* pb = pbuf + (size_t)t * 128;
    float d0 = 0.f, d1 = 0.f;
#pragma unroll
    for (int xs = 0; xs < 8; ++xs) { d0 += pb[(size_t)xs * T * 128 + lane]; d1 += pb[(size_t)xs * T * 128 + 64 + lane]; }
    const float hs = p.ascale[t];
    d0 *= p.uscale[e0] * hs; d1 *= p.uscale[e1] * hs;
    const float g0 = p.gate[(size_t)t * 128 + lane], g1 = p.gate[(size_t)t * 128 + 64 + lane];
    p.gate[(size_t)t * 128 + lane] = g0 * 0.5f * d0 * (1.f + erff(d0 * 0.70710678118654752f));
    p.gate[(size_t)t * 128 + 64 + lane] = g1 * 0.5f * d1 * (1.f + erff(d1 * 0.70710678118654752f));
  }
}

__device__ void phase_exp_v(const Params& p, char* smem) {
  const int tid = opaque_tid(), lane = tid & 63, w = tid >> 6;
  const int sub = lane >> 4, cc = lane & 15;
  const unsigned myx = my_xcc_id();
  int* sh = reinterpret_cast<int*>(smem);
  int* si = reinterpret_cast<int*>(smem + 64) + w * 256;
  float* sc = reinterpret_cast<float*>(si + 128);
  bf16_t* yfb = reinterpret_cast<bf16_t*>(p.y_x) + (size_t)T * D;
  {
    unsigned qcur = 0;
    for (;;) {
      __syncthreads();
      if (tid == 0) {
        int found = -1; unsigned fx = 0;
        for (; qcur < 8; ++qcur) {
          fx = (myx + qcur) & 7u;
          const int c = (int)atomicAdd(&p.ctr[32 + fx], 1u);
          if (c < 256) { found = c; break; }
        }
        sh[0] = found; sh[1] = (int)fx;
      }
      __syncthreads();
      const int chunk = sh[0];
      const unsigned x = (unsigned)sh[1];
      if (chunk < 0) break;
      int e0n = p.idx[(size_t)(chunk * 32 + w * 8) * 128 + lane], e1n = p.idx[(size_t)(chunk * 32 + w * 8) * 128 + 64 + lane];
      for (int tt = 0; tt < 8; ++tt) {
        const int t = chunk * 32 + w * 8 + tt;
        const int e0 = e0n, e1 = e1n;
        __builtin_amdgcn_wave_barrier();
        si[lane] = e0; si[64 + lane] = e1;
        __builtin_amdgcn_wave_barrier();
        f32x2 acc[8];
#pragma unroll
        for (int e = 0; e < 8; ++e) acc[e] = f32x2{0.f, 0.f};
        const uint8_t* vb = p.V8 + (size_t)x * ((size_t)16384 * 256) + cc * 16;
        uint4 qa[8], qb[8];
#define EV_LOAD(q_, bt_) _Pragma("unroll") for (int k = 0; k < 8; ++k) q_[k] = *reinterpret_cast<const uint4*>(vb + (size_t)si[((bt_) * 8 + k) * 4 + sub] * 256)
#define EV_COMP(q_, bt_)                                                                                                \
  _Pragma("unroll") for (int k = 0; k < 8; ++k) {                                                                       \
    f32x2 vf[8];                                                                                                        \
    fp8x16_to_f32(q_[k], vf);                                                                                           \
    const float cfk = sc[((bt_) * 8 + k) * 4 + sub];                                                                    \
    const f32x2 c2 = f32x2{cfk, cfk};                                                                                   \
    _Pragma("unroll") for (int e = 0; e < 8; ++e) acc[e] += c2 * vf[e];                                                 \
  }
        EV_LOAD(qa, 0); EV_LOAD(qb, 1);
        if (tt + 1 < 8) { e0n = p.idx[(size_t)(t + 1) * 128 + lane]; e1n = p.idx[(size_t)(t + 1) * 128 + 64 + lane]; }
        sc[lane] = p.gate[(size_t)t * 128 + lane];
        sc[64 + lane] = p.gate[(size_t)t * 128 + 64 + lane];
        __builtin_amdgcn_wave_barrier();
        EV_COMP(qa, 0); EV_LOAD(qa, 2);
        EV_COMP(qb, 1); EV_LOAD(qb, 3);
        EV_COMP(qa, 2);
        EV_COMP(qb, 3);
#undef EV_LOAD
#undef EV_COMP
        {
          float* red = reinterpret_cast<float*>(smem + 8192) + w * 1280;
          float* mr = red + (sub * 16 + cc) * 20;
#pragma unroll
          for (int q4 = 0; q4 < 4; ++q4)
            *reinterpret_cast<float4*>(mr + q4 * 4) = float4{acc[q4 * 2].x, acc[q4 * 2].y, acc[q4 * 2 + 1].x, acc[q4 * 2 + 1].y};
          __builtin_amdgcn_wave_barrier();
          const int part = sub;
          float4 r0 = *reinterpret_cast<const float4*>(red + (0 * 16 + cc) * 20 + part * 4);
          float4 r1 = *reinterpret_cast<const float4*>(red + (1 * 16 + cc) * 20 + part * 4);
          float4 r2 = *reinterpret_cast<const float4*>(red + (2 * 16 + cc) * 20 + part * 4);
          float4 r3 = *reinterpret_cast<const float4*>(red + (3 * 16 + cc) * 20 + part * 4);
          const float sc512 = 1.f / 512.f;
          uint2 o4;
          o4.x = pack2((r0.x + r1.x + r2.x + r3.x) * sc512, (r0.y + r1.y + r2.y + r3.y) * sc512);
          o4.y = pack2((r0.z + r1.z + r2.z + r3.z) * sc512, (r0.w + r1.w + r2.w + r3.w) * sc512);
          *reinterpret_cast<uint2*>(yfb + (size_t)t * D + x * 256 + cc * 16 + part * 4) = o4;
          __builtin_amdgcn_wave_barrier();
        }
      }
    }
  }
}

__device__ void phase_exp_final(const Params& p, int bid, int nb, char* smem) {
  const int lane = threadIdx.x & 63, w = threadIdx.x >> 6;
  const bf16_t* ymix = reinterpret_cast<const bf16_t*>(p.y_x);
  const bf16_t* yf = reinterpret_cast<const bf16_t*>(p.y_x) + (size_t)T * D;
  for (int t = bid * 4 + w; t < T; t += nb * 4) {
    const int b = t / L;
    float4 y[8], xo[8];
#pragma unroll
    for (int c = 0; c < 8; ++c) {
      const uint2 yq = *reinterpret_cast<const uint2*>(yf + (size_t)t * D + c * 256 + lane * 4);
      y[c] = float4{bflo(yq.x), bfhi(yq.x), bflo(yq.y), bfhi(yq.y)};
      xo[c] = *reinterpret_cast<const float4*>(p.x + (size_t)t * D + c * 256 + lane * 4);
    }
    const float rmix = p.partial[t];
    float ss = 0.f;
#pragma unroll
    for (int c = 0; c < 8; ++c) ss += y[c].x * y[c].x + y[c].y * y[c].y + y[c].z * y[c].z + y[c].w * y[c].w;
    ss = wave_sum_fast(ss);
    const float rstd = rsqrtf(ss * (1.f / D) + EPS);
    const float* gfx = p.mod + (size_t)b * NMOD + 5 * D;
    const float* gm = p.mod + (size_t)b * NMOD + 2 * D;
#pragma unroll
    for (int c = 0; c < 8; ++c) {
      const int e0 = c * 256 + lane * 4;
      const uint2 mq = *reinterpret_cast<const uint2*>(ymix + (size_t)t * D + e0);
      const float4 m4 = float4{bflo(mq.x), bfhi(mq.x), bflo(mq.y), bfhi(mq.y)};
      const float4 g4 = *reinterpret_cast<const float4*>(gfx + e0), gp = *reinterpret_cast<const float4*>(p.g_post_ffn + e0);
      const float4 h4 = *reinterpret_cast<const float4*>(gm + e0), hp = *reinterpret_cast<const float4*>(p.g_post_mix + e0);
      xo[c].x += h4.x * (m4.x * rmix * hp.x) + g4.x * (y[c].x * rstd * gp.x);
      xo[c].y += h4.y * (m4.y * rmix * hp.y) + g4.y * (y[c].y * rstd * gp.y);
      xo[c].z += h4.z * (m4.z * rmix * hp.z) + g4.z * (y[c].z * rstd * gp.z);
      xo[c].w += h4.w * (m4.w * rmix * hp.w) + g4.w * (y[c].w * rstd * gp.w);
      *reinterpret_cast<float4*>(p.out + (size_t)t * D + e0) = xo[c];
    }
  }
}

#define XB_TMO      128
#define XB_XCNT(j)  (256  + 64 * (j))
#define XB_XSUB(j)  (1280 + 64 * (j))
#define XB_XGEN(j)  (2304 + 64 * (j))
#define XB_TOP      3328
#define XB_TOPGEN   3392
#define XCD_BAR_WORDS 3456
#define XB_SPIN_CAP (1u << 22)
#define LAS __attribute__((address_space(3)))
__device__ __forceinline__ unsigned xb_ld(unsigned* p)              { return __hip_atomic_load(p, __ATOMIC_RELAXED, __HIP_MEMORY_SCOPE_AGENT); }
__device__ __forceinline__ unsigned xb_add(unsigned* p, unsigned v) { return __hip_atomic_fetch_add(p, v, __ATOMIC_RELAXED, __HIP_MEMORY_SCOPE_AGENT); }
__device__ __forceinline__ unsigned xb_xcc_id() { return (unsigned)__builtin_amdgcn_s_getreg((3 << 11) | 20) & 0xFu; }
#define XB_SPIN(cond, bar) do { unsigned _sp = 0; while (cond) { __builtin_amdgcn_s_sleep(1); \
    if ((++_sp & 255u) == 0u) { if (xb_ld(&(bar)[XB_TMO])) break; if (_sp > XB_SPIN_CAP) { atomicAdd(&(bar)[XB_TMO], 1u); break; } } } } while (0)
struct XcdBarrier { unsigned* bar; unsigned x; volatile LAS unsigned* st; };
__device__ __forceinline__ XcdBarrier xcd_barrier_post(unsigned* bar, volatile LAS unsigned* st) {
  XcdBarrier b; b.bar = bar; b.x = xb_xcc_id(); b.st = st;
  if (threadIdx.x == 0) (void)xb_add(&bar[XB_XCNT(b.x)], 1u);
  return b;
}
__device__ __forceinline__ void xcd_barrier_complete(unsigned* bar, unsigned x, unsigned& nloc, unsigned& nx) {
  const unsigned G = gridDim.x * gridDim.y * gridDim.z;
  unsigned sum, cnt, mine, sp = 0u;
  for (;;) {
    sum = 0u; cnt = 0u; mine = 0u;
#pragma unroll
    for (unsigned j = 0; j < 16; ++j) { const unsigned c = xb_ld(&bar[XB_XCNT(j)]); sum += c; cnt += (c > 0u) ? 1u : 0u; mine = (j == x) ? c : mine; }
    if (sum == G) break;
    __builtin_amdgcn_s_sleep(1);
    if ((++sp & 255u) == 0u) { if (xb_ld(&bar[XB_TMO])) break; if (sp > XB_SPIN_CAP) { atomicAdd(&bar[XB_TMO], 1u); break; } }
  }
  nloc = mine > 0u ? mine : 1u; nx = cnt > 0u ? cnt : 1u;
}
__device__ __forceinline__ void xcd_barrier(const XcdBarrier& b) {
  asm volatile("s_waitcnt vmcnt(0)" ::: "memory");
  __syncthreads();
  if (threadIdx.x == 0) {
    unsigned* bar = b.bar;
    __builtin_amdgcn_s_waitcnt(0);
    unsigned nloc = b.st[0], nx = b.st[1];
    if (nloc == 0u) { xcd_barrier_complete(bar, b.x, nloc, nx); b.st[0] = nloc; b.st[1] = nx; }
    const unsigned old = xb_add(&bar[XB_XSUB(b.x)], 1u);
    const unsigned gen = old / nloc;
    if (old + 1u == (gen + 1u) * nloc) {
      __builtin_amdgcn_fence(__ATOMIC_RELEASE, "agent");
      asm volatile("s_waitcnt vmcnt(0)" ::: "memory");
      const unsigned og = xb_add(&bar[XB_TOP], 1u);
      const unsigned tg = og / nx;
      if (og + 1u == (tg + 1u) * nx) xb_add(&bar[XB_TOPGEN], 1u);
      else XB_SPIN(xb_ld(&bar[XB_TOPGEN]) == tg, bar);
      __builtin_amdgcn_fence(__ATOMIC_ACQUIRE, "agent");
      xb_add(&bar[XB_XGEN(b.x)], 1u);
      asm volatile("s_waitcnt vmcnt(0)" ::: "memory");
    } else {
      XB_SPIN(xb_ld(&bar[XB_XGEN(b.x)]) == gen, bar);
      __builtin_amdgcn_fence(__ATOMIC_ACQUIRE, "agent");
      asm volatile("s_waitcnt vmcnt(0)" ::: "memory");
    }
  }
  __syncthreads();
}

__global__ void __launch_bounds__(NTHREADS, 2) fwd_mega(Params p) {
  __shared__ __attribute__((aligned(16))) char smem[75808];
  const int bid = blockIdx.x, nb = gridDim.x;
  volatile LAS unsigned* st = (volatile LAS unsigned*)(smem + 75792);
  if (threadIdx.x == 0) { st[0] = 0u; st[1] = 0u; }
  __syncthreads();
  const XcdBarrier bar = xcd_barrier_post(p.bar, st);
  phase_prep(p, bid, nb, smem);        xcd_barrier(bar);
  phase_fold(p, bid, nb, smem);        xcd_barrier(bar);
  phase_norm_mod(p, bid, nb, smem);    xcd_barrier(bar);
  phase_inproj(p, bid, nb, smem);      xcd_barrier(bar);
  phase_ssm_pre(p, bid, nb, smem);     xcd_barrier(bar);
  phase_ssd_dft(p, bid, nb, smem);     xcd_barrier(bar);
  phase_ssm_post(p, bid, nb, smem);    xcd_barrier(bar);
  phase_outproj(p, bid, nb, smem);     xcd_barrier(bar);
  phase_postmix(p, bid, nb, smem);     xcd_barrier(bar);
  phase_q_route(p, bid, nb, smem);     xcd_barrier(bar);
  phase_exp_u(p, smem);                xcd_barrier(bar);
phase_exp_combine(p, bid, nb);       xcd_barrier(bar);
    phase_exp_v(p, smem);                xcd_barrier(bar);
  phase_exp_final(p, bid, nb, smem);
}

}

extern "C" void kernel_launch(void* const* d_in, const int* in_sizes, int n_in, void* d_out, int out_size, void* d_ws,
                              size_t ws_size, hipStream_t stream) {
  Params p{};
  const float** fp = reinterpret_cast<const float**>(&p);
  for (int i = 0; i < 27; ++i) fp[i] = (const float*)d_in[i];
  p.out = (float*)d_out;
  char* ws = (char*)d_ws;
  size_t off = 0;
  auto take = [&](size_t bytes) { char* r = ws + off; off += (bytes + 255) & ~(size_t)255; return r; };
  p.U8 = (uint8_t*)take((size_t)16384 * D);
  p.V8 = (uint8_t*)take((size_t)16384 * D);
  p.uscale = (float*)take((size_t)16384 * 4);
  p.hx8a = (int8_t*)take((size_t)(T + TC) * D);
  p.w8 = (int8_t*)take((size_t)NPROJ * D);
  p.ascale = (float*)take((size_t)(T + TC) * 4);
  p.wscale = (float*)take((size_t)NPROJ * 4);
  p.ycat8 = (int8_t*)take((size_t)T * D);
  p.wo8 = (int8_t*)take((size_t)D * D);
  p.yscale = (float*)take((size_t)T * 4);
  p.woscale = (float*)take((size_t)D * 4);
  p.wq8 = (int8_t*)take((size_t)1024 * D);
  p.wqscale = (float*)take((size_t)1024 * 4);
  p.w_in_t = (bf16_t*)take((size_t)NPROJ * D * 2);
  p.w_out_t = (bf16_t*)take((size_t)D * D * 2);
  p.w_q_t = (bf16_t*)take((size_t)1024 * D * 2);
  p.w_in_f = (bf16_t*)take((size_t)D * 1024 * 2);
  p.WcsT = (bf16_t*)take((size_t)4 * 512 * 256 * 2);
  p.dftm = (bf16_t*)take((size_t)1024 * 2048 * 2);
  p.Fs = (bf16_t*)take((size_t)NB * 1024 * 2048 * 2);
  p.partial = (float*)take((size_t)KSPLIT * 5 * NMOD * 4);
  p.mod = (float*)take((size_t)5 * NMOD * 4);
  p.hx = (bf16_t*)take((size_t)T * D * 2);
  p.hc = (bf16_t*)take((size_t)TC * D * 2);
  p.ABt = (bf16_t*)take((size_t)NB * 1024 * 4096 * 2);
  p.q = (float*)p.ABt;
  p.z = (bf16_t*)take((size_t)T * 1024 * 2);
  char* r1 = take(0);
  p.xbcraw = (bf16_t*)take((size_t)T * DXBC * 4);
  p.xbcraw_c = (bf16_t*)take((size_t)TC * DXBC * 4);
  p.act_tm = (bf16_t*)take((size_t)(T + TC) * DXBC * 2);
  p.act_cm_x = (bf16_t*)take((size_t)NB * 1280 * L * 2);
  p.act_cm_c = (bf16_t*)take((size_t)NB * 1280 * CTX * 2);
  p.y_x = (float*)r1;
  p.dtraw = (float*)take((size_t)T * 32 * 4);
  p.dtraw_c = (float*)take((size_t)TC * 32 * 4);
  p.dtf = (float*)take((size_t)T * 16 * 4);
  p.dtb = (float*)take((size_t)T * 16 * 4);
  p.dtf_c = (float*)take((size_t)TC * 16 * 4);
  p.dtb_c = (float*)take((size_t)TC * 16 * 4);
  p.yf = (float*)take((size_t)T * 1024 * 4);
  p.yb = (float*)take((size_t)T * 1024 * 4);
  p.ctr = (unsigned*)take(256);
  p.bar = (unsigned*)take((size_t)XCD_BAR_WORDS * 4);
  p.ycat = (bf16_t*)take((size_t)T * D * 2);
  p.idx = (int*)take((size_t)T * 128 * 4);
  p.gate = (float*)take((size_t)T * 128 * 4);
  if (off > ws_size) { fprintf(stderr, "kernel_launch: workspace too small: need %zu have %zu\n", off, ws_size); return; }
  static int grid_blocks = 0;
  if (!grid_blocks) {
    int dev = 0, cus = 0, per_cu = 0;
    hipGetDevice(&dev);
    hipDeviceGetAttribute(&cus, hipDeviceAttributeMultiprocessorCount, dev);
    hipOccupancyMaxActiveBlocksPerMultiprocessor(&per_cu, fwd_mega, NTHREADS, 0);
    if (per_cu > 2) per_cu = 2;
    grid_blocks = cus * per_cu;
    if (grid_blocks <= 0) { fprintf(stderr, "kernel_launch: occupancy query gave %d x %d\n", cus, per_cu); grid_blocks = -1; }
  }
  if (grid_blocks < 0) return;
  (void)hipMemsetAsync(p.bar, 0, (size_t)XCD_BAR_WORDS * 4, stream);
  void* args[] = {&p};
  hipError_t e = hipLaunchCooperativeKernel((void*)fwd_mega, dim3(grid_blocks), dim3(NTHREADS), args, 0, stream);
  if (e != hipSuccess) fprintf(stderr, "cooperative launch failed: %s (grid %d)\n", hipGetErrorString(e), grid_blocks);
}
```

```cpp
#include <hip/hip_runtime.h>
#include <hip/hip_cooperative_groups.h>
#include <stdint.h>
#include <stdio.h>

namespace cg = cooperative_groups;
namespace {

typedef __attribute__((ext_vector_type(8))) short bf16x8;
typedef __attribute__((ext_vector_type(4))) float f32x4;
typedef unsigned short bf16_t;

constexpr int D = 2048, NB = 4, L = 2048, T = NB * L, CTX = 256, TC = NB * CTX;
constexpr int NMOD = 6 * D;
constexpr int NH = 16, HP = 64, NS = 128, DXBC = 1536;
constexpr int DIN = 3616;
constexpr int NPROJ = 4736;
constexpr int GATHER_AUX = 1;
constexpr int KSPLIT = 32;
constexpr float EPS = 1e-6f;
constexpr int NTHREADS = 256;

__device__ __forceinline__ bf16_t f2bf(float f) { __bf16 h = (__bf16)f; return __builtin_bit_cast(unsigned short, h); }
__device__ __forceinline__ float bf2f(bf16_t h) { return __uint_as_float(((uint32_t)h) << 16); }
__device__ __forceinline__ uint32_t pack2(float a, float b) {
  typedef __attribute__((ext_vector_type(2))) __bf16 bf16x2_t;
  typedef __attribute__((ext_vector_type(2))) float f32x2_t;
  const f32x2_t v = {a, b};
  return __builtin_bit_cast(uint32_t, __builtin_convertvector(v, bf16x2_t));
}
__device__ __forceinline__ float bflo(uint32_t w) { return __uint_as_float(w << 16); }
__device__ __forceinline__ float bfhi(uint32_t w) { return __uint_as_float(w & 0xffff0000u); }
__device__ __forceinline__ float silu_f(float v) { return v / (1.f + __expf(-v)); }
__device__ __forceinline__ float softplus_f(float v) { return v > 20.f ? v : log1pf(__expf(v)); }

__device__ __forceinline__ int opaque_tid() { int t = threadIdx.x; asm volatile("" : "+v"(t)); return t; }
__device__ __forceinline__ float wave_sum(float v) {
#pragma unroll
  for (int o = 32; o > 0; o >>= 1) v += __shfl_xor(v, o);
  return v;
}
template <int CTRL>
__device__ __forceinline__ float dpp_mov(float v) {
  return __int_as_float(__builtin_amdgcn_update_dpp(0, __float_as_int(v), CTRL, 0xF, 0xF, true));
}
template <int CTRL>
__device__ __forceinline__ int dpp_movi(int v) { return __builtin_amdgcn_update_dpp(0, v, CTRL, 0xF, 0xF, true); }
__device__ __forceinline__ float wave_sum_fast(float v) {
  v += dpp_mov<0xB1>(v); v += dpp_mov<0x4E>(v); v += dpp_mov<0x124>(v); v += dpp_mov<0x128>(v);
  v += __shfl_xor(v, 16); v += __shfl_xor(v, 32);
  return v;
}
__device__ __forceinline__ float wave_max(float v) {
#pragma unroll
  for (int o = 32; o > 0; o >>= 1) v = fmaxf(v, __shfl_xor(v, o));
  return v;
}
__device__ __forceinline__ float block_sum(float v, float* red) {
  v = wave_sum(v);
  __syncthreads();
  if ((threadIdx.x & 63) == 0) red[threadIdx.x >> 6] = v;
  __syncthreads();
  return red[0] + red[1] + red[2] + red[3];
}

struct Params {
  const float *x, *c, *ctx, *c_ctx, *w_mod, *b_mod, *g_pre_mix, *g_post_mix, *g_pre_ffn, *g_post_ffn;
  const float *w_in, *w_fmix, *conv_w, *conv_b, *dt_bias_f, *dt_bias_b, *a_log_f, *a_log_b, *d_skip_f, *d_skip_b;
  const float *ssm_norm_w, *w_out, *w_query, *sk1, *sk2, *eu, *ev;
  float* out;
  uint8_t *U8, *V8;
  float* uscale;
  int8_t *hx8a, *w8;
  float *ascale, *wscale;
  int8_t *ycat8, *wo8;
  float *yscale, *woscale;
  int8_t* wq8; float* wqscale;
  bf16_t *w_in_t, *w_out_t, *w_q_t, *w_in_f, *WcsT, *dftm, *Fs;
  float *partial, *mod;
  bf16_t *hx, *hc, *ABt, *z;
  bf16_t *xbcraw, *xbcraw_c;
  float *dtraw, *dtraw_c, *dtf, *dtb, *dtf_c, *dtb_c;
  bf16_t *act_tm, *act_cm_x, *act_cm_c;
  float *yf, *yb;
  unsigned* ctr; unsigned* bar;
  bf16_t* ycat;
  float *y_x, *q, *gate;
  int* idx;
  int pad0, pad1;
};
typedef const __attribute__((address_space(4))) Params KParams;

template <bool I8 = false>
__device__ __forceinline__ void gemm_mainloop(const bf16_t* __restrict__ A, int lda, const bf16_t* __restrict__ Bt, int ldb,
                                              int K, int m0, int n0, f32x4 (&acc)[4][4], char* smem) {
  const int tid = opaque_tid(), lane = tid & 63, w = tid >> 6;
  const int wm = w >> 1, wn = w & 1;
#pragma unroll
  for (int i = 0; i < 4; ++i)
#pragma unroll
    for (int j = 0; j < 4; ++j) acc[i][j] = f32x4{0.f, 0.f, 0.f, 0.f};

  const int nk = K / 64;
  const int rowoff = lane >> 3, lch = (lane & 7) ^ rowoff;
  const bf16_t* gA = A + (size_t)(m0 + w * 8 + rowoff) * lda + lch * 8;
  const bf16_t* gB = Bt + (size_t)(n0 + w * 8 + rowoff) * ldb + lch * 8;
#define GSTAGE(buf_, kt_)                                                                                               \
  do {                                                                                                                  \
    _Pragma("unroll") for (int i_ = 0; i_ < 4; ++i_) {                                                                  \
      __builtin_amdgcn_global_load_lds((const unsigned*)(gA + (size_t)(i_ * 32) * lda + (kt_) * 64),                    \
                                       (unsigned*)(smem + (buf_) * 32768 + (i_ * 4 + w) * 1024), 16, 0, 0);             \
      __builtin_amdgcn_global_load_lds((const unsigned*)(gB + (size_t)(i_ * 32) * ldb + (kt_) * 64),                    \
                                       (unsigned*)(smem + (buf_) * 32768 + 16384 + (i_ * 4 + w) * 1024), 16, 0, 0);     \
    }                                                                                                                   \
  } while (0)
  GSTAGE(0, 0);
  asm volatile("s_waitcnt vmcnt(0)" ::: "memory");
  __syncthreads();
  for (int kt = 0; kt < nk; ++kt) {
    const int cur = kt & 1;
    if (kt + 1 < nk) GSTAGE(cur ^ 1, kt + 1);
    const char* sA = smem + cur * 32768;
    const char* sB = sA + 16384;
#pragma unroll
    for (int kk = 0; kk < 2; ++kk) {
      bf16x8 af[4], bfr[4];
      const int ch = kk * 4 + (lane >> 4);
#pragma unroll
      for (int i = 0; i < 4; ++i) {
        int row = wm * 64 + i * 16 + (lane & 15);
        af[i] = *reinterpret_cast<const bf16x8*>(sA + row * 128 + ((ch ^ (row & 7)) << 4));
        int col = wn * 64 + i * 16 + (lane & 15);
        bfr[i] = *reinterpret_cast<const bf16x8*>(sB + col * 128 + ((ch ^ (col & 7)) << 4));
      }
#pragma unroll
      for (int i = 0; i < 4; ++i)
#pragma unroll
        for (int j = 0; j < 4; ++j) {
          if (I8) {
            typedef __attribute__((ext_vector_type(4))) int i32x4;
            acc[i][j] = __builtin_bit_cast(f32x4, __builtin_amdgcn_mfma_i32_16x16x64_i8(__builtin_bit_cast(i32x4, af[i]), __builtin_bit_cast(i32x4, bfr[j]),
                                                                                         __builtin_bit_cast(i32x4, acc[i][j]), 0, 0, 0));
          } else {
            acc[i][j] = __builtin_amdgcn_mfma_f32_16x16x32_bf16(af[i], bfr[j], acc[i][j], 0, 0, 0);
          }
        }
    }
    asm volatile("s_waitcnt vmcnt(0)" ::: "memory");
    __syncthreads();
  }
#undef GSTAGE
}

template <bool I8 = false, class Epi>
__device__ __forceinline__ void gemm_tile(const bf16_t* __restrict__ A, int lda, const bf16_t* __restrict__ Bt, int ldb,
                                          int K, int m0, int n0, const Epi& epi, char* smem,
                                          const float* __restrict__ rscale = nullptr, const float* __restrict__ cscale = nullptr) {
  const int lane = threadIdx.x & 63, w = threadIdx.x >> 6;
  const int wm = w >> 1, wn = w & 1;
  f32x4 acc[4][4];
  gemm_mainloop<I8>(A, lda, Bt, ldb, K, m0, n0, acc, smem);
#pragma unroll
  for (int i = 0; i < 4; ++i) {
    const int row = m0 + wm * 64 + i * 16 + (lane >> 4) * 4;
    float4 rs = float4{1.f, 1.f, 1.f, 1.f};
    if (I8) rs = *reinterpret_cast<const float4*>(rscale + row);
#pragma unroll
    for (int j = 0; j < 4; ++j) {
      const int col = n0 + wn * 64 + j * 16 + (lane & 15);
      if (I8) {
        typedef __attribute__((ext_vector_type(4))) int i32x4;
        const i32x4 ia = __builtin_bit_cast(i32x4, acc[i][j]);
        const float cs = cscale[col];
        epi(row, col, f32x4{(float)ia[0] * rs.x * cs, (float)ia[1] * rs.y * cs, (float)ia[2] * rs.z * cs, (float)ia[3] * rs.w * cs});
      } else {
        epi(row, col, acc[i][j]);
      }
    }
  }
}

template <bool I8>
__device__ __forceinline__ void gemm_mainloop_n256(const bf16_t* __restrict__ A, int lda, const bf16_t* __restrict__ Bt, int ldb,
                                                   int K, int m0, int n0, f32x4 (&acc)[4][8], char* smem) {
  const int tid = opaque_tid(), lane = tid & 63, w = tid >> 6;
  const int wm = w >> 1, wn = w & 1;
#pragma unroll
  for (int i = 0; i < 4; ++i)
#pragma unroll
    for (int j = 0; j < 8; ++j) acc[i][j] = f32x4{0.f, 0.f, 0.f, 0.f};
  const int nk = K / 64;
  const int rowoff = lane >> 3, lch = (lane & 7) ^ rowoff;
  const bf16_t* gA = A + (size_t)(m0 + w * 8 + rowoff) * lda + lch * 8;
  const bf16_t* gB = Bt + (size_t)(n0 + w * 8 + rowoff) * ldb + lch * 8;
  const int fr = lane & 15, fq = lane >> 4;
  for (int kt = 0; kt < nk; ++kt) {
#pragma unroll
    for (int i_ = 0; i_ < 4; ++i_)
      __builtin_amdgcn_global_load_lds((const unsigned*)(gA + (size_t)(i_ * 32) * lda + kt * 64),
                                       (unsigned*)(smem + (i_ * 4 + w) * 1024), 16, 0, 0);
#pragma unroll
    for (int i_ = 0; i_ < 8; ++i_)
      __builtin_amdgcn_global_load_lds((const unsigned*)(gB + (size_t)(i_ * 32) * ldb + kt * 64),
                                       (unsigned*)(smem + 16384 + (i_ * 4 + w) * 1024), 16, 0, 0);
    asm volatile("s_waitcnt vmcnt(0)" ::: "memory");
    __syncthreads();
    const char* sA = smem;
    const char* sB = smem + 16384;
#pragma unroll
    for (int kk = 0; kk < 2; ++kk) {
      bf16x8 af[4], bfr[8];
      const int ch = kk * 4 + fq;
#pragma unroll
      for (int i = 0; i < 4; ++i) {
        const int row = wm * 64 + i * 16 + fr;
        af[i] = *reinterpret_cast<const bf16x8*>(sA + row * 128 + ((ch ^ (row & 7)) << 4));
      }
#pragma unroll
      for (int j = 0; j < 8; ++j) {
        const int col = wn * 128 + j * 16 + fr;
        bfr[j] = *reinterpret_cast<const bf16x8*>(sB + col * 128 + ((ch ^ (col & 7)) << 4));
      }
#pragma unroll
      for (int i = 0; i < 4; ++i)
#pragma unroll
        for (int j = 0; j < 8; ++j) {
          if (I8) {
            typedef __attribute__((ext_vector_type(4))) int i32x4;
            acc[i][j] = __builtin_bit_cast(f32x4, __builtin_amdgcn_mfma_i32_16x16x64_i8(__builtin_bit_cast(i32x4, af[i]), __builtin_bit_cast(i32x4, bfr[j]),
                                                                                         __builtin_bit_cast(i32x4, acc[i][j]), 0, 0, 0));
          } else {
            acc[i][j] = __builtin_amdgcn_mfma_f32_16x16x32_bf16(af[i], bfr[j], acc[i][j], 0, 0, 0);
          }
        }
    }
    __syncthreads();
  }
}
template <bool I8, class Epi>
__device__ __forceinline__ void gemm_tile_n256(const bf16_t* __restrict__ A, int lda, const bf16_t* __restrict__ Bt, int ldb,
                                               int K, int m0, int n0, const Epi& epi, char* smem,
                                               const float* __restrict__ rscale = nullptr, const float* __restrict__ cscale = nullptr) {
  const int lane = threadIdx.x & 63, w = threadIdx.x >> 6;
  const int wm = w >> 1, wn = w & 1;
  f32x4 acc[4][8];
  gemm_mainloop_n256<I8>(A, lda, Bt, ldb, K, m0, n0, acc, smem);
#pragma unroll
  for (int i = 0; i < 4; ++i) {
    const int row = m0 + wm * 64 + i * 16 + (lane >> 4) * 4;
    float4 rs = float4{1.f, 1.f, 1.f, 1.f};
    if (I8) rs = *reinterpret_cast<const float4*>(rscale + row);
#pragma unroll
    for (int j = 0; j < 8; ++j) {
      const int col = n0 + wn * 128 + j * 16 + (lane & 15);
      if (I8) {
        typedef __attribute__((ext_vector_type(4))) int i32x4;
        const i32x4 ia = __builtin_bit_cast(i32x4, acc[i][j]);
        const float cs = cscale[col];
        epi(row, col, f32x4{(float)ia[0] * rs.x * cs, (float)ia[1] * rs.y * cs, (float)ia[2] * rs.z * cs, (float)ia[3] * rs.w * cs});
      } else {
        epi(row, col, acc[i][j]);
      }
    }
  }
}

__device__ __forceinline__ float wave_max_fast(float v) {
  v = fmaxf(v, dpp_mov<0xB1>(v)); v = fmaxf(v, dpp_mov<0x4E>(v)); v = fmaxf(v, dpp_mov<0x124>(v)); v = fmaxf(v, dpp_mov<0x128>(v));
  v = fmaxf(v, __shfl_xor(v, 16)); v = fmaxf(v, __shfl_xor(v, 32));
  return v;
}
__device__ __forceinline__ uint32_t pack_i8x4(float a, float b, float c, float d) {
  const int ia = __float2int_rn(a), ib = __float2int_rn(b), ic = __float2int_rn(c), id = __float2int_rn(d);
  return (uint32_t)(ia & 255) | ((uint32_t)(ib & 255) << 8) | ((uint32_t)(ic & 255) << 16) | ((uint32_t)id << 24);
}
struct EpiF32 {
  float* C; int ldc;
  __device__ __forceinline__ void operator()(int row, int col, f32x4 v) const {
#pragma unroll
    for (int r = 0; r < 4; ++r) C[(size_t)(row + r) * ldc + col] = v[r];
  }
};
struct EpiBf16 {
  bf16_t* C; int ldc;
  __device__ __forceinline__ void operator()(int row, int col, f32x4 v) const {
#pragma unroll
    for (int r = 0; r < 4; ++r) C[(size_t)(row + r) * ldc + col] = f2bf(v[r]);
  }
};
struct EpiBf16T {
  bf16_t* Ct; int ldc;
  __device__ __forceinline__ void operator()(int row, int col, f32x4 v) const {
    uint2 pk; pk.x = pack2(v[0], v[1]); pk.y = pack2(v[2], v[3]);
    *reinterpret_cast<uint2*>(Ct + (size_t)col * ldc + row) = pk;
  }
};
struct EpiInAB {
  bf16_t* ABt; int seqlen;
  __device__ __forceinline__ void operator()(int row, int col, f32x4 v) const {
    const int ch = col & 1023, half = col >> 10;
    const int b = row / seqlen, l = row - b * seqlen;
    uint2 pk; pk.x = pack2(v[0], v[1]); pk.y = pack2(v[2], v[3]);
    *reinterpret_cast<uint2*>(ABt + ((size_t)(b * 1024 + ch) * 4096 + half * 2048 + l)) = pk;
  }
};
struct EpiInZ {
  bf16_t* z;
  __device__ __forceinline__ void operator()(int row, int col, f32x4 v) const {
#pragma unroll
    for (int r = 0; r < 4; ++r) z[(size_t)(row + r) * 1024 + (col - 2048)] = f2bf(v[r]);
  }
};
struct EpiInXbc {
  bf16_t* xbcraw;
  __device__ __forceinline__ void operator()(int row, int col, f32x4 v) const {
#pragma unroll
    for (int r = 0; r < 4; ++r) xbcraw[(size_t)(row + r) * DXBC + (col - 3072)] = f2bf(v[r]);
  }
};
struct EpiInProj {
  bf16_t* ABt; bf16_t* z; bf16_t* xbcraw; float* dtraw; int seqlen;
  __device__ __forceinline__ void operator()(int row, int col, f32x4 v) const {
    if (col < 2048) {
      int ch = col & 1023, half = col >> 10;
      int b = row / seqlen, l = row - b * seqlen;
      uint2 pk; pk.x = pack2(v[0], v[1]); pk.y = pack2(v[2], v[3]);
      *reinterpret_cast<uint2*>(ABt + ((size_t)(b * 1024 + ch) * 4096 + half * 2048 + l)) = pk;
    } else if (col < 3072) {
#pragma unroll
      for (int r = 0; r < 4; ++r) z[(size_t)(row + r) * 1024 + (col - 2048)] = f2bf(v[r]);
    } else if (col < 4608) {
#pragma unroll
      for (int r = 0; r < 4; ++r) xbcraw[(size_t)(row + r) * DXBC + (col - 3072)] = f2bf(v[r]);
    } else if (col < 4640) {
#pragma unroll
      for (int r = 0; r < 4; ++r) dtraw[(size_t)(row + r) * 32 + (col - 4608)] = v[r];
    }
  }
};

__device__ void adaln_partial_task(KParams& p, int task, float* sm) {
  const int cb = task % 48, ks = task / 48, tid = threadIdx.x;
  float* sc = sm;
  __syncthreads();
  for (int i = tid; i < 5 * 64; i += NTHREADS) {
    int r = i >> 6, kk = i & 63;
    int k = ks * 64 + kk;
    float cv = (r < 4) ? p.c[r * D + k] : p.c_ctx[k];
    sc[i] = silu_f(cv);
  }
  __syncthreads();
  const int col = cb * 256 + tid;
  float a0 = 0, a1 = 0, a2 = 0, a3 = 0, a4 = 0;
  const float* wp = p.w_mod + (size_t)(ks * 64) * NMOD + col;
  {
    float wv[64];
#pragma unroll
    for (int kk = 0; kk < 64; ++kk) wv[kk] = __builtin_nontemporal_load(wp + (size_t)kk * NMOD);
#pragma unroll
    for (int k = 0; k < 64; ++k) {
      a0 += sc[k] * wv[k]; a1 += sc[64 + k] * wv[k]; a2 += sc[128 + k] * wv[k]; a3 += sc[192 + k] * wv[k]; a4 += sc[256 + k] * wv[k];
    }
  }
  float* pp = p.partial + (size_t)ks * 5 * NMOD + col;
  pp[0] = a0; pp[NMOD] = a1; pp[2 * NMOD] = a2; pp[3 * NMOD] = a3; pp[4 * NMOD] = a4;
}

__device__ void transpose_convert_task(const float* __restrict__ src, int ld, int c0, int rows, bf16_t* __restrict__ dst,
                                       int tr, int tc, float* sm) {
  float (*tile)[68] = reinterpret_cast<float (*)[68]>(sm);
  const int tid = threadIdx.x;
  __syncthreads();
  {
    float4 v[4];
#pragma unroll
    for (int k = 0; k < 4; ++k) {
      const int i = tid + k * NTHREADS, r = i >> 4, c4 = i & 15;
      v[k] = *reinterpret_cast<const float4*>(src + (size_t)(tr * 64 + r) * ld + c0 + tc * 64 + c4 * 4);
    }
#pragma unroll
    for (int k = 0; k < 4; ++k) {
      const int i = tid + k * NTHREADS, r = i >> 4, c4 = i & 15;
      *reinterpret_cast<float4*>(&tile[r][c4 * 4]) = v[k];
    }
  }
  __syncthreads();
#pragma unroll
  for (int k = 0; k < 4; ++k) {
    const int i = tid + k * NTHREADS, cc = i >> 4, r4 = (i & 15) * 4;
    uint2 o; o.x = pack2(tile[r4][cc], tile[r4 + 1][cc]); o.y = pack2(tile[r4 + 2][cc], tile[r4 + 3][cc]);
    *reinterpret_cast<uint2*>(dst + (size_t)(tc * 64 + cc) * rows + tr * 64 + r4) = o;
  }
}

__device__ void phase_prep(KParams& p, int bid, int nb, char* smem) {
  float* sm = reinterpret_cast<float*>(smem);
  const int tid = threadIdx.x;
  if (bid == 0 && tid < 64) p.ctr[tid] = 0u;
  {
    float* t256 = reinterpret_cast<float*>(smem + 20480);
    float* t2048 = reinterpret_cast<float*>(smem + 24576);
    t256[tid] = cospif((float)tid * (1.0f / 128.f));
    for (int i = tid; i < 2048; i += NTHREADS) t2048[i] = cospif((float)i * (1.0f / 1024.f));
    __syncthreads();
  }
  for (int t = bid; t < 48 * KSPLIT; t += nb) adaln_partial_task(p, t, sm);
  {
    const int nct = 41, nrt = 32;
    for (int t = bid; t < nct * nrt; t += nb) {
      int tc = t % nct, tr = t / nct;
      if (tc < 40) transpose_convert_task(p.w_in, DIN, 1024, D, p.w_in_t + (size_t)2048 * D, tr, tc, sm);
      else {
        float (*tile)[65] = reinterpret_cast<float (*)[65]>(sm);
        __syncthreads();
        for (int i = tid; i < 64 * 32; i += NTHREADS) {
          int r = i >> 5, cc = i & 31;
          tile[r][cc] = p.w_in[(size_t)(tr * 64 + r) * DIN + 1024 + 2560 + cc];
        }
        __syncthreads();
        for (int i = tid; i < 32 * 32; i += NTHREADS) {
          int cc = i >> 5, r2 = (i & 31) * 2;
          uint32_t pk = pack2(tile[r2][cc], tile[r2 + 1][cc]);
          *reinterpret_cast<uint32_t*>(p.w_in_t + (size_t)(2048 + 2560 + cc) * D + tr * 64 + r2) = pk;
        }
      }
    }
    for (size_t i = (size_t)bid * NTHREADS + tid; i < (size_t)96 * D / 8; i += (size_t)nb * NTHREADS)
      reinterpret_cast<uint4*>(p.w_in_t + (size_t)4640 * D)[i] = uint4{0, 0, 0, 0};
  }
  for (size_t i0 = (size_t)bid * NTHREADS + tid; i0 < (size_t)D * 1024 / 4; i0 += (size_t)4 * nb * NTHREADS) {
    float4 v[4];
#pragma unroll
    for (int u = 0; u < 4; ++u) {
      const size_t i = i0 + (size_t)u * nb * NTHREADS;
      const int k = (int)(i / 256), c4 = (int)(i % 256) * 4;
      v[u] = (i < (size_t)D * 1024 / 4) ? *reinterpret_cast<const float4*>(p.w_in + (size_t)k * DIN + c4) : float4{0.f, 0.f, 0.f, 0.f};
    }
#pragma unroll
    for (int u = 0; u < 4; ++u) {
      const size_t i = i0 + (size_t)u * nb * NTHREADS;
      const int k = (int)(i / 256), c4 = (int)(i % 256) * 4;
      uint2 o; o.x = pack2(v[u].x, v[u].y); o.y = pack2(v[u].z, v[u].w);
      if (i < (size_t)D * 1024 / 4) *reinterpret_cast<uint2*>(p.w_in_f + (size_t)k * 1024 + c4) = o;
    }
  }
  {
    const float* t256 = reinterpret_cast<const float*>(smem + 20480);
    const float scale = 1.0f / sqrtf((float)L * 256.f);
    const int vb = (bid + (nb >> 1)) % nb;
    for (int i = vb * NTHREADS + tid; i < 4 * 64 * 256; i += nb * NTHREADS) {
      const int d = i & 255, cg = (i >> 8) & 63, g = i >> 14;
      float c0_ = 0.f, c1_ = 0.f, c2_ = 0.f, c3_ = 0.f, s0_ = 0.f, s1_ = 0.f, s2_ = 0.f, s3_ = 0.f;
      const float* wp = p.w_fmix + (size_t)g * 65536 + d;
#pragma unroll 1
      for (int mb = 0; mb < 256; mb += 16) {
        float wv[16];
#pragma unroll
        for (int mm = 0; mm < 16; ++mm) wv[mm] = wp[(mb + mm) * 256];
#pragma unroll
        for (int mm = 0; mm < 16; ++mm) {
          const int m = mb + mm;
          const int p0 = (m * (cg * 4 + 0)) & 255, p1 = (m * (cg * 4 + 1)) & 255, p2 = (m * (cg * 4 + 2)) & 255, p3 = (m * (cg * 4 + 3)) & 255;
          c0_ += t256[p0] * wv[mm]; s0_ += t256[(p0 - 64) & 255] * wv[mm];
          c1_ += t256[p1] * wv[mm]; s1_ += t256[(p1 - 64) & 255] * wv[mm];
          c2_ += t256[p2] * wv[mm]; s2_ += t256[(p2 - 64) & 255] * wv[mm];
          c3_ += t256[p3] * wv[mm]; s3_ += t256[(p3 - 64) & 255] * wv[mm];
        }
      }
      {
        bf16_t* wc = p.WcsT + ((size_t)g * 512 + d) * 256 + cg * 4;
        bf16_t* ws_ = p.WcsT + ((size_t)g * 512 + 256 + d) * 256 + cg * 4;
        uint2 oc, os;
        oc.x = pack2(c0_ * scale, c1_ * scale); oc.y = pack2(c2_ * scale, c3_ * scale);
        os.x = pack2(s0_ * scale, s1_ * scale); os.y = pack2(s2_ * scale, s3_ * scale);
        *reinterpret_cast<uint2*>(wc) = oc;
        *reinterpret_cast<uint2*>(ws_) = os;
      }
    }
  }
  {
    const float* t2048 = reinterpret_cast<const float*>(smem + 24576);
    for (size_t i = (size_t)bid * NTHREADS + tid; i < (size_t)1024 * 2048 / 8; i += (size_t)nb * NTHREADS) {
      const int k = (int)(i / 256), j = (int)(i % 256) * 8;
      const bool iss = j >= 1024;
      float o[8];
#pragma unroll
      for (int e = 0; e < 8; ++e) {
        const int l = (j + e) & 1023;
        const int ph = (k * l) & 2047;
        o[e] = iss ? t2048[(ph - 512) & 2047] : t2048[ph];
      }
      uint4 pk; pk.x = pack2(o[0], o[1]); pk.y = pack2(o[2], o[3]); pk.z = pack2(o[4], o[5]); pk.w = pack2(o[6], o[7]);
      *reinterpret_cast<uint4*>(p.dftm + (size_t)k * 2048 + j) = pk;
    }
  }
}

__device__ void phase_fold(KParams& p, int bid, int nb, char* smem) {
  const int tid = threadIdx.x;
  for (int i = bid * NTHREADS + tid; i < 5 * NMOD; i += nb * NTHREADS) {
    int col = i % NMOD;
    float s = p.b_mod[col];
    for (int ks = 0; ks < KSPLIT; ++ks) s += p.partial[(size_t)ks * 5 * NMOD + i];
    p.mod[i] = s;
  }
  for (int t = bid; t < 256; t += nb) {
    int g = t >> 6, tm = (t & 63) >> 2, tn = t & 3;
    int n0 = tn * 128;
    int rowbase = (n0 < 256) ? (g * 256 + n0) : (1024 + g * 256 + (n0 - 256));
    EpiBf16T epi{p.w_in_t + (size_t)(rowbase - n0) * D, D};
    gemm_tile(p.w_in_f + g * 256, 1024, p.WcsT + (size_t)g * 512 * 256, 256, 256, tm * 128, n0, epi, smem);
  }
}

__device__ __forceinline__ void quant_weight_rows_i8(const bf16_t* __restrict__ src, int8_t* __restrict__ dst, float* __restrict__ scl,
                                                     int nrows, int bid, int nb) {
  const int lane = threadIdx.x & 63, w = threadIdx.x >> 6;
  for (int n = bid * 4 + w; n < nrows; n += nb * 4) {
    const bf16_t* wr = src + (size_t)n * D;
    uint4 q[4];
#pragma unroll
    for (int c = 0; c < 4; ++c) q[c] = *reinterpret_cast<const uint4*>(wr + c * 512 + lane * 8);
    float am = 0.f;
#pragma unroll
    for (int c = 0; c < 4; ++c) {
      am = fmaxf(am, fmaxf(fmaxf(fabsf(bflo(q[c].x)), fabsf(bfhi(q[c].x))), fmaxf(fabsf(bflo(q[c].y)), fabsf(bfhi(q[c].y)))));
      am = fmaxf(am, fmaxf(fmaxf(fabsf(bflo(q[c].z)), fabsf(bfhi(q[c].z))), fmaxf(fabsf(bflo(q[c].w)), fabsf(bfhi(q[c].w)))));
    }
    am = wave_max_fast(am);
    const float inv = (am > 0.f) ? 127.f / am : 0.f;
#pragma unroll
    for (int c = 0; c < 4; ++c) {
      uint2 o;
      o.x = pack_i8x4(bflo(q[c].x) * inv, bfhi(q[c].x) * inv, bflo(q[c].y) * inv, bfhi(q[c].y) * inv);
      o.y = pack_i8x4(bflo(q[c].z) * inv, bfhi(q[c].z) * inv, bflo(q[c].w) * inv, bfhi(q[c].w) * inv);
      *reinterpret_cast<uint2*>(dst + (size_t)n * D + c * 512 + lane * 8) = o;
    }
    if (lane == 0) scl[n] = am * (1.f / 127.f);
  }
}

__device__ void phase_norm_mod(KParams& p, int bid, int nb, char* smem) {
  const int lane = threadIdx.x & 63, w = threadIdx.x >> 6;
  for (int t = bid * 4 + w; t < T + TC; t += nb * 4) {
    const bool isx = t < T;
    const float* src = isx ? (p.x + (size_t)t * D) : (p.ctx + (size_t)(t - T) * D);
    const int mrow = isx ? (t / L) : 4;
    float4 v[8];
    float ss = 0.f;
#pragma unroll
    for (int c = 0; c < 8; ++c) {
      v[c] = *reinterpret_cast<const float4*>(src + c * 256 + lane * 4);
      ss += v[c].x * v[c].x + v[c].y * v[c].y + v[c].z * v[c].z + v[c].w * v[c].w;
    }
    ss = wave_sum_fast(ss);
    const float rstd = rsqrtf(ss * (1.f / D) + EPS);
    const float* sh = p.mod + (size_t)mrow * NMOD + 0 * D;
    const float* sc = p.mod + (size_t)mrow * NMOD + 1 * D;
    float am = 0.f;
#pragma unroll
    for (int c = 0; c < 8; ++c) {
      const int e0 = c * 256 + lane * 4;
      const float4 g = *reinterpret_cast<const float4*>(p.g_pre_mix + e0);
      const float4 s4 = *reinterpret_cast<const float4*>(sc + e0), h4 = *reinterpret_cast<const float4*>(sh + e0);
      v[c].x = v[c].x * rstd * g.x * (1.f + s4.x) + h4.x; v[c].y = v[c].y * rstd * g.y * (1.f + s4.y) + h4.y;
      v[c].z = v[c].z * rstd * g.z * (1.f + s4.z) + h4.z; v[c].w = v[c].w * rstd * g.w * (1.f + s4.w) + h4.w;
      am = fmaxf(am, fmaxf(fmaxf(fabsf(v[c].x), fabsf(v[c].y)), fmaxf(fabsf(v[c].z), fabsf(v[c].w))));
    }
    {
      am = wave_max_fast(am);
      const float inv = (am > 0.f) ? 127.f / am : 0.f;
#pragma unroll
      for (int c = 0; c < 8; ++c)
        *reinterpret_cast<uint32_t*>(p.hx8a + (size_t)t * D + c * 256 + lane * 4) = pack_i8x4(v[c].x * inv, v[c].y * inv, v[c].z * inv, v[c].w * inv);
      if (lane == 0) p.ascale[t] = am * (1.f / 127.f);
    }
  }
  quant_weight_rows_i8(p.w_in_t, p.w8, p.wscale, NPROJ, bid, nb);
}

__device__ __forceinline__ void convert_v_rows(KParams& p, int q) {
  const int lane = threadIdx.x & 63, w = threadIdx.x >> 6;
  const int row0 = q * 32 + w * 8;
#pragma unroll 1
  for (int rr = 0; rr < 8; rr += 2) {
    f32x4 va[8], vb[8];
#pragma unroll
    for (int k = 0; k < 8; ++k) va[k] = __builtin_nontemporal_load(reinterpret_cast<const f32x4*>(p.ev + (size_t)(row0 + rr) * D + k * 256 + lane * 4));
#pragma unroll
    for (int k = 0; k < 8; ++k) vb[k] = __builtin_nontemporal_load(reinterpret_cast<const f32x4*>(p.ev + (size_t)(row0 + rr + 1) * D + k * 256 + lane * 4));
#define CONV_V_EMIT(v_, row_)                                                                                           \
    {                                                                                                                   \
      float m = 0.f;                                                                                                    \
      _Pragma("unroll") for (int k = 0; k < 8; ++k)                                                                     \
        m += v_[k][0] * v_[k][0] + v_[k][1] * v_[k][1] + v_[k][2] * v_[k][2] + v_[k][3] * v_[k][3];                     \
      m = wave_sum_fast(m);                                                                                             \
      const float sq = 0.5f * sqrtf(m * (1.f / D));                                                                     \
      const float inv = (sq > 0.f) ? 1.f / sq : 0.f;                                                                    \
      _Pragma("unroll") for (int k = 0; k < 8; ++k) {                                                                   \
        unsigned pk = 0;                                                                                                \
        pk = __builtin_amdgcn_cvt_scalef32_pk_fp4_f32(pk, fminf(fmaxf(v_[k][0] * inv, -6.f), 6.f),                      \
                                                      fminf(fmaxf(v_[k][1] * inv, -6.f), 6.f), 1.0f, 0);                \
        pk = __builtin_amdgcn_cvt_scalef32_pk_fp4_f32(pk, fminf(fmaxf(v_[k][2] * inv, -6.f), 6.f),                      \
                                                      fminf(fmaxf(v_[k][3] * inv, -6.f), 6.f), 1.0f, 1);                \
        *reinterpret_cast<unsigned short*>(p.V8 + (size_t)k * ((size_t)16384 * 128) + (size_t)(row_) * 128 + lane * 2) = (unsigned short)pk; \
      }                                                                                                                 \
      if (lane == 0) p.uscale[16384 + (row_)] = sq;                                                                     \
    }
    CONV_V_EMIT(va, row0 + rr);
    CONV_V_EMIT(vb, row0 + rr + 1);
#undef CONV_V_EMIT
  }
}
__device__ __forceinline__ void convert_u_rows(KParams& p, int q) {
  const int lane = threadIdx.x & 63, w = threadIdx.x >> 6;
  const int row0 = q * 32 + w * 8;
#pragma unroll 1
  for (int rr = 0; rr < 8; rr += 2) {
    f32x4 va[8], vb[8];
#pragma unroll
    for (int k = 0; k < 8; ++k) va[k] = __builtin_nontemporal_load(reinterpret_cast<const f32x4*>(p.eu + (size_t)(row0 + rr) * D + k * 256 + lane * 4));
#pragma unroll
    for (int k = 0; k < 8; ++k) vb[k] = __builtin_nontemporal_load(reinterpret_cast<const f32x4*>(p.eu + (size_t)(row0 + rr + 1) * D + k * 256 + lane * 4));
#define CONV_U_EMIT(v_, row_)                                                                                           \
    {                                                                                                                   \
      float m = 0.f;                                                                                                    \
      _Pragma("unroll") for (int k = 0; k < 8; ++k)                                                                     \
        m += v_[k][0] * v_[k][0] + v_[k][1] * v_[k][1] + v_[k][2] * v_[k][2] + v_[k][3] * v_[k][3];                     \
      m = wave_sum_fast(m);                                                                                             \
      const float stepq = 0.35f * sqrtf(m * (1.f / D));                                                                 \
      const float inv = (stepq > 0.f) ? 1.f / stepq : 0.f;                                                              \
      _Pragma("unroll") for (int k = 0; k < 8; ++k) {                                                                   \
        uint32_t wv = 0;                                                                                                \
        _Pragma("unroll") for (int i = 0; i < 4; ++i) {                                                                 \
          const int qi = __float2int_rn(fminf(fmaxf(v_[k][i] * inv, -7.f), 7.f)) & 15;                \
          wv |= (uint32_t)qi << (8 * i);                                                                                \
        }                                                                                                               \
        const uint32_t wo = (uint32_t)dpp_movi<0xB1>((int)wv);                 \
        if ((lane & 1) == 0)                                                                                            \
          *reinterpret_cast<uint32_t*>(p.U8 + (size_t)k * ((size_t)16384 * 128) + (size_t)(row_) * 128 + (lane >> 1) * 4) = wv | (wo << 4); \
      }                                                                                                                 \
      if (lane == 0) p.uscale[row_] = stepq;                                                                            \
    }
    CONV_U_EMIT(va, row0 + rr);
    CONV_U_EMIT(vb, row0 + rr + 1);
#undef CONV_U_EMIT
  }
}
__device__ void phase_inproj(KParams& p, int bid, int nb, char* smem) {
  const bool aware = (nb & 7) == 0;
  const int start = aware ? (bid >> 3) : bid, step = aware ? (nb >> 3) : nb, end = aware ? (128 + 53) : 8 * (128 + 53);
  const bf16_t* a8 = reinterpret_cast<const bf16_t*>(p.hx8a);
  const bf16_t* b8 = reinterpret_cast<const bf16_t*>(p.w8);
  for (int it = start; it < end; it += step) {
    const int x = aware ? (bid & 7) : it / (128 + 53), s_ = aware ? it : it % (128 + 53);
    if (s_ < 128) {
      const int tn2 = s_ >> 3, m0_ = (8 * x + (s_ & 7)) * 128;
      if (tn2 < 8) { EpiInAB epi{p.ABt, L}; gemm_tile_n256<true>(a8, D / 2, b8, D / 2, D / 2, m0_, tn2 * 256, epi, smem, p.ascale, p.wscale); }
      else if (tn2 < 12) { EpiInZ epi{p.z}; gemm_tile_n256<true>(a8, D / 2, b8, D / 2, D / 2, m0_, tn2 * 256, epi, smem, p.ascale, p.wscale); }
      else { EpiInXbc epi{p.xbcraw}; gemm_tile_n256<true>(a8, D / 2, b8, D / 2, D / 2, m0_, tn2 * 256, epi, smem, p.ascale, p.wscale); }
    } else if (s_ < 128 + 40) {
      const int i = s_ - 128;
      EpiInProj epi{p.ABt, p.z, p.xbcraw, p.dtraw, L};
      gemm_tile<true>(a8, D / 2, b8, D / 2, D / 2, (8 * x + (i & 7)) * 128, (32 + (i >> 3)) * 128, epi, smem, p.ascale, p.wscale);
    } else {
      const int u = x * 13 + (s_ - 168);
      EpiInProj epi{nullptr, nullptr, p.xbcraw_c, p.dtraw_c, CTX};
      gemm_tile<true>(reinterpret_cast<const bf16_t*>(p.hx8a + (size_t)T * D), D / 2, b8, D / 2, D / 2, (u / 13) * 128, 3072 + (u % 13) * 128, epi, smem,
                      p.ascale + T, p.wscale);
    }
  }
}

__device__ void ssm_pre_tile(KParams& p, int task, char* smem) {
  const bool isx = task < 3072;
  const int u = isx ? task : task - 3072;
  const int ntt = isx ? 32 : 4;
  const int ct = u % 24, tt = (u / 24) % ntt, b = u / (24 * ntt);
  const int seqlen = isx ? L : CTX;
  const bf16_t* raw = (isx ? p.xbcraw : p.xbcraw_c) + (size_t)b * seqlen * DXBC;
  const int l0 = tt * 64, c0 = ct * 64, tid = threadIdx.x;
  float (*rt)[68] = reinterpret_cast<float (*)[68]>(smem);
  float (*at)[65] = reinterpret_cast<float (*)[65]>(smem + 66 * 68 * 4);
  __syncthreads();
  {
    uint2 v[5];
#pragma unroll
    for (int k = 0; k < 5; ++k) {
      const int i = tid + k * NTHREADS, r = i >> 4, c4 = i & 15, l = l0 - 1 + r;
      v[k] = (i < 66 * 16 && l >= 0 && l < seqlen) ? *reinterpret_cast<const uint2*>(raw + (size_t)l * DXBC + c0 + c4 * 4) : uint2{0u, 0u};
    }
#pragma unroll
    for (int k = 0; k < 5; ++k) {
      const int i = tid + k * NTHREADS, r = i >> 4, c4 = i & 15;
      if (i < 66 * 16) *reinterpret_cast<float4*>(&rt[r][c4 * 4]) = float4{bflo(v[k].x), bfhi(v[k].x), bflo(v[k].y), bfhi(v[k].y)};
    }
  }
  __syncthreads();
  {
    const int cc = tid & 63, c = c0 + cc;
    const float w0 = p.conv_w[c], w1 = p.conv_w[DXBC + c], w2 = p.conv_w[2 * DXBC + c], cb = p.conv_b[c];
#pragma unroll 4
    for (int r = tid >> 6; r < 64; r += 4) at[r][cc] = silu_f(cb + rt[r][cc] * w0 + rt[r + 1][cc] * w1 + rt[r + 2][cc] * w2);
  }
  __syncthreads();
  const size_t trow0 = isx ? ((size_t)b * L + l0) : ((size_t)T + (size_t)b * CTX + l0);
#pragma unroll
  for (int k = 0; k < 4; ++k) {
    const int i = tid + k * NTHREADS, r = i >> 4, c4 = (i & 15) * 4;
    uint2 o; o.x = pack2(at[r][c4], at[r][c4 + 1]); o.y = pack2(at[r][c4 + 2], at[r][c4 + 3]);
    *reinterpret_cast<uint2*>(p.act_tm + (trow0 + r) * DXBC + c0 + c4) = o;
  }
  if (c0 < 1280) {
    bf16_t* cm = (isx ? p.act_cm_x : p.act_cm_c) + (size_t)b * 1280 * seqlen;
#pragma unroll
    for (int k = 0; k < 4; ++k) {
      const int i = tid + k * NTHREADS, cc = i >> 4, r4 = (i & 15) * 4;
      uint2 o; o.x = pack2(at[r4][cc], at[r4 + 1][cc]); o.y = pack2(at[r4 + 2][cc], at[r4 + 3][cc]);
      *reinterpret_cast<uint2*>(cm + (size_t)(c0 + cc) * seqlen + l0 + r4) = o;
    }
  }
}
__device__ void dft_fold_rows(KParams& p, int bid, int nb, char* smem) {
  const int lane = threadIdx.x & 63, w = threadIdx.x >> 6;
  bf16_t* sr = reinterpret_cast<bf16_t*>(smem + w * 8192);
  for (int row = bid * 4 + w; row < NB * 1024; row += nb * 4) {
    const bf16_t* A = p.ABt + (size_t)row * 4096;
    bf16_t* F = p.Fs + (size_t)row * 2048;
    __builtin_amdgcn_wave_barrier();
    {
      const uint4 q0 = *reinterpret_cast<const uint4*>(A + (0 * 64 + lane) * 8), q1 = *reinterpret_cast<const uint4*>(A + (1 * 64 + lane) * 8);
      const uint4 q2 = *reinterpret_cast<const uint4*>(A + (2 * 64 + lane) * 8), q3 = *reinterpret_cast<const uint4*>(A + (3 * 64 + lane) * 8);
      const uint4 q4 = *reinterpret_cast<const uint4*>(A + (4 * 64 + lane) * 8), q5 = *reinterpret_cast<const uint4*>(A + (5 * 64 + lane) * 8);
      const uint4 q6 = *reinterpret_cast<const uint4*>(A + (6 * 64 + lane) * 8), q7 = *reinterpret_cast<const uint4*>(A + (7 * 64 + lane) * 8);
      *reinterpret_cast<uint4*>(sr + (0 * 64 + lane) * 8) = q0; *reinterpret_cast<uint4*>(sr + (1 * 64 + lane) * 8) = q1;
      *reinterpret_cast<uint4*>(sr + (2 * 64 + lane) * 8) = q2; *reinterpret_cast<uint4*>(sr + (3 * 64 + lane) * 8) = q3;
      *reinterpret_cast<uint4*>(sr + (4 * 64 + lane) * 8) = q4; *reinterpret_cast<uint4*>(sr + (5 * 64 + lane) * 8) = q5;
      *reinterpret_cast<uint4*>(sr + (6 * 64 + lane) * 8) = q6; *reinterpret_cast<uint4*>(sr + (7 * 64 + lane) * 8) = q7;
    }
    __builtin_amdgcn_wave_barrier();
    const int l0 = lane * 16;
    float alt = 0.f;
    uint32_t oa[8], ob[8];
#pragma unroll
    for (int half = 0; half < 2; ++half) {
      const bf16_t* base = sr + half * 2048;
      const uint4 fa = *reinterpret_cast<const uint4*>(base + l0), fb = *reinterpret_cast<const uint4*>(base + l0 + 8);
      const uint4 ra = *reinterpret_cast<const uint4*>(base + 2032 - l0), rb = *reinterpret_cast<const uint4*>(base + 2040 - l0);
      const float r16 = (lane > 0) ? bf2f(base[2048 - l0]) : 0.f;
      const uint32_t fw[8] = {fa.x, fa.y, fa.z, fa.w, fb.x, fb.y, fb.z, fb.w};
      const uint32_t rw[8] = {ra.x, ra.y, ra.z, ra.w, rb.x, rb.y, rb.z, rb.w};
      float v[16];
#pragma unroll
      for (int i = 0; i < 16; ++i) {
        const float fwv = (i & 1) ? bfhi(fw[i >> 1]) : bflo(fw[i >> 1]);
        const int j = 16 - i;
        const float rv = (i == 0) ? r16 : ((j & 1) ? bfhi(rw[j >> 1]) : bflo(rw[j >> 1]));
        if (half == 0) v[i] = (lane == 0 && i == 0) ? fwv : fwv + rv;
        else v[i] = (lane == 0 && i == 0) ? 0.f : fwv - rv;
      }
      if (half == 0) {
#pragma unroll
        for (int i = 0; i < 16; ++i) alt += (i & 1) ? -v[i] : v[i];
#pragma unroll
        for (int i = 0; i < 8; ++i) oa[i] = pack2(v[2 * i], v[2 * i + 1]);
      } else {
#pragma unroll
        for (int i = 0; i < 8; ++i) ob[i] = pack2(v[2 * i], v[2 * i + 1]);
      }
    }
    *reinterpret_cast<uint4*>(F + l0) = uint4{oa[0], oa[1], oa[2], oa[3]};
    *reinterpret_cast<uint4*>(F + l0 + 8) = uint4{oa[4], oa[5], oa[6], oa[7]};
    *reinterpret_cast<uint4*>(F + 1024 + l0) = uint4{ob[0], ob[1], ob[2], ob[3]};
    *reinterpret_cast<uint4*>(F + 1024 + l0 + 8) = uint4{ob[4], ob[5], ob[6], ob[7]};
    alt = wave_sum_fast(alt) + bf2f(sr[1024]);
    if (lane == 0) { const int b = row >> 10, ch = row & 1023; p.ycat[((size_t)b * L + 1024) * D + ch] = f2bf(alt); }
  }
}
__device__ void phase_ssm_pre(KParams& p, int bid, int nb, char* smem) {
  const int tid = threadIdx.x;
  dft_fold_rows(p, bid, nb, smem);
  for (int t = bid; t < 3072 + 384; t += nb) ssm_pre_tile(p, t, smem);
  for (int i = bid * NTHREADS + tid; i < (T + TC) * 32; i += nb * NTHREADS) {
    const bool isx = i < T * 32;
    const int ii = isx ? i : i - T * 32;
    const int t = ii >> 5, j = ii & 31;
    const float v = (isx ? p.dtraw : p.dtraw_c)[ii];
    float* df = isx ? p.dtf : p.dtf_c;
    float* db = isx ? p.dtb : p.dtb_c;
    if (j < 16) df[t * 16 + j] = softplus_f(v + p.dt_bias_f[j]);
    else db[t * 16 + (j - 16)] = softplus_f(v + p.dt_bias_b[j - 16]);
  }
}

__device__ __forceinline__ int swz16(int row, int chunk) { return row * 256 + ((chunk ^ (row & 15)) << 4); }
__device__ __forceinline__ int swz8(int row, int chunk) { return row * 128 + ((chunk ^ (row & 7)) << 4); }

#define LDS_BARRIER() asm volatile("s_waitcnt lgkmcnt(0)\n\ts_barrier" ::: "memory")
__device__ void ssd_task(KParams& p, int task, char* smem) {
  const int dir = task & 1, ph = (task >> 1) & 1, h = (task >> 2) & 15, b = task >> 6;
  const int tid = opaque_tid(), lane = tid & 63, w = tid >> 6;
  const int g = h >> 3, lr0 = lane & 15, lq0 = lane >> 4;
  const float a = -__expf(dir ? p.a_log_b[h] : p.a_log_f[h]);
  char* sCc = smem; char* sBc = smem + 16384; char* sBT = smem + 32768; char* sXT = smem + 49152; char* sHb = smem + 57344;
  float* se = reinterpret_cast<float*>(smem + 73728);
  float* sdt = se + 64; float* sw = se + 128; float* sy = se + 192; float* stot = se + 256;
  bf16_t* yo = reinterpret_cast<bf16_t*>(dir ? p.yb : p.yf);
  f32x4 H[2][2];
#pragma unroll
  for (int i = 0; i < 2; ++i)
#pragma unroll
    for (int j = 0; j < 2; ++j) H[i][j] = f32x4{0.f, 0.f, 0.f, 0.f};
  __syncthreads();
  for (int i = tid; i < 512; i += NTHREADS) reinterpret_cast<uint4*>(sHb)[i] = uint4{0, 0, 0, 0};

  const int crow = tid >> 4, cch = tid & 15;
  const int trow = tid >> 3, tch = tid & 7;
  uint4 rC0, rC1, rC2, rC3, rB0, rB1, rB2, rB3, rT0, rT1, rT2, rT3, rX;
  rC0 = rC1 = rC2 = rC3 = rB0 = rB1 = rB2 = rB3 = uint4{0, 0, 0, 0};
  float rdt = 0.f;
#define SSD_PARAMS(st_)                                                                                                   \
  const bool isctx_ = (st_) < 4;                                                                                          \
  const int nch_ = isctx_ ? 4 : 32, ci_ = isctx_ ? (st_) : (st_) - 4;                                                     \
  const int c_ = dir ? (nch_ - 1 - ci_) : ci_;                                                                            \
  const int seqlen_ = isctx_ ? CTX : L;                                                                                   \
  const size_t trow0_ = isctx_ ? ((size_t)T + (size_t)b * CTX + c_ * 64) : ((size_t)b * L + c_ * 64);                     \
  const size_t drow0_ = (size_t)b * seqlen_ + c_ * 64;                                                                    \
  const float* dtp_ = isctx_ ? (dir ? p.dtb_c : p.dtf_c) : (dir ? p.dtb : p.dtf);                                         \
  const bf16_t* cm_ = (isctx_ ? p.act_cm_c : p.act_cm_x) + (size_t)b * 1280 * seqlen_ + c_ * 64;
#define SSD_PREFETCH(st_)                                                                                                 \
  do {                                                                                                                    \
    SSD_PARAMS(st_)                                                                                                       \
    if (w == 0) rdt = dtp_[(drow0_ + lane) * 16 + h];                                                                     \
    if (!isctx_) {                                                                                                        \
      const bf16_t* src = p.act_tm + (trow0_ + crow) * DXBC + g * 128 + cch * 8;                                          \
      rC0 = *reinterpret_cast<const uint4*>(src + 1280);             rB0 = *reinterpret_cast<const uint4*>(src + 1024);   \
      rC1 = *reinterpret_cast<const uint4*>(src + 16 * DXBC + 1280); rB1 = *reinterpret_cast<const uint4*>(src + 16 * DXBC + 1024); \
      rC2 = *reinterpret_cast<const uint4*>(src + 32 * DXBC + 1280); rB2 = *reinterpret_cast<const uint4*>(src + 32 * DXBC + 1024); \
      rC3 = *reinterpret_cast<const uint4*>(src + 48 * DXBC + 1280); rB3 = *reinterpret_cast<const uint4*>(src + 48 * DXBC + 1024); \
    }                                                                                                                     \
    const bf16_t* srt = cm_ + (size_t)(1024 + g * 128 + trow) * seqlen_ + tch * 8;                                        \
    rT0 = *reinterpret_cast<const uint4*>(srt);                                                                           \
    rT1 = *reinterpret_cast<const uint4*>(srt + (size_t)32 * seqlen_);                                                    \
    rT2 = *reinterpret_cast<const uint4*>(srt + (size_t)64 * seqlen_);                                                    \
    rT3 = *reinterpret_cast<const uint4*>(srt + (size_t)96 * seqlen_);                                                    \
    rX = *reinterpret_cast<const uint4*>(cm_ + (size_t)(h * 64 + ph * 32 + trow) * seqlen_ + tch * 8);                    \
  } while (0)

  SSD_PREFETCH(0);
  for (int step = 0; step < 36; ++step) {
    const bool isctx = step < 4;
    const int c = dir ? ((isctx ? 4 : 32) - 1 - (isctx ? step : step - 4)) : (isctx ? step : step - 4);
    const size_t trow0 = (size_t)b * L + c * 64;
    int lr = lr0, lq = lq0;
    asm volatile("" : "+v"(lr), "+v"(lq));
    LDS_BARRIER();
    if (w == 0) {
      const float dtv = rdt;
      const float adt = a * dtv;
      float v = adt;
      v += __builtin_bit_cast(float, __builtin_amdgcn_update_dpp(0, __builtin_bit_cast(int, v), 0x111, 0xF, 0xF, false));
      v += __builtin_bit_cast(float, __builtin_amdgcn_update_dpp(0, __builtin_bit_cast(int, v), 0x112, 0xF, 0xF, false));
      v += __builtin_bit_cast(float, __builtin_amdgcn_update_dpp(0, __builtin_bit_cast(int, v), 0x114, 0xF, 0xF, false));
      v += __builtin_bit_cast(float, __builtin_amdgcn_update_dpp(0, __builtin_bit_cast(int, v), 0x118, 0xF, 0xF, false));
      v += __builtin_bit_cast(float, __builtin_amdgcn_update_dpp(0, __builtin_bit_cast(int, v), 0x142, 0xA, 0xF, false));
      v += __builtin_bit_cast(float, __builtin_amdgcn_update_dpp(0, __builtin_bit_cast(int, v), 0x143, 0xC, 0xF, false));
      const float etot = __builtin_bit_cast(float, __builtin_amdgcn_readlane(__builtin_bit_cast(int, v), 63));
      if (dir) v = etot - v + adt;
      se[lane] = v; sdt[lane] = dtv; sw[lane] = dtv * __expf(etot - v); sy[lane] = __expf(v);
      if (lane == 0) stot[0] = etot;
    }
    if (!isctx) {
      const int oc = swz16(crow, cch);
      *reinterpret_cast<uint4*>(sCc + oc) = rC0;         *reinterpret_cast<uint4*>(sBc + oc) = rB0;
      *reinterpret_cast<uint4*>(sCc + oc + 4096) = rC1;  *reinterpret_cast<uint4*>(sBc + oc + 4096) = rB1;
      *reinterpret_cast<uint4*>(sCc + oc + 8192) = rC2;  *reinterpret_cast<uint4*>(sBc + oc + 8192) = rB2;
      *reinterpret_cast<uint4*>(sCc + oc + 12288) = rC3; *reinterpret_cast<uint4*>(sBc + oc + 12288) = rB3;
    }
    {
      const int ot = swz8(trow, tch);
      *reinterpret_cast<uint4*>(sBT + ot) = rT0;
      *reinterpret_cast<uint4*>(sBT + ot + 4096) = rT1;
      *reinterpret_cast<uint4*>(sBT + ot + 8192) = rT2;
      *reinterpret_cast<uint4*>(sBT + ot + 12288) = rT3;
      *reinterpret_cast<uint4*>(sXT + ot) = rX;
    }
    if (step + 1 < 36) SSD_PREFETCH(step + 1);
    LDS_BARRIER();
    const float etot = stot[0];
    if (!isctx) {
      f32x4 G[4];
      bf16x8 ca[4];
#pragma unroll
      for (int j = 0; j < 4; ++j) G[j] = f32x4{0.f, 0.f, 0.f, 0.f};
#pragma unroll
      for (int kk = 0; kk < 4; ++kk) ca[kk] = *reinterpret_cast<const bf16x8*>(sCc + swz16(16 * w + lr, kk * 4 + lq));
#pragma unroll
      for (int kk = 0; kk < 4; ++kk)
#pragma unroll
        for (int j = 0; j < 4; ++j) {
          bf16x8 bb = *reinterpret_cast<const bf16x8*>(sBc + swz16(16 * j + lr, kk * 4 + lq));
          G[j] = __builtin_amdgcn_mfma_f32_16x16x32_bf16(ca[kk], bb, G[j], 0, 0, 0);
        }
      LDS_BARRIER();
      float el[4];
#pragma unroll
      for (int r = 0; r < 4; ++r) el[r] = se[16 * w + lq * 4 + r];
#pragma unroll
      for (int j = 0; j < 4; ++j) {
        const int s_ = 16 * j + lr;
        const float es = se[s_], ds = sdt[s_];
#pragma unroll
        for (int r = 0; r < 4; ++r) {
          const int l = 16 * w + lq * 4 + r;
          const bool keep = dir ? (s_ >= l) : (s_ <= l);
          const float m = keep ? G[j][r] * __expf(el[r] - es) * ds : 0.f;
          *reinterpret_cast<bf16_t*>(sBc + swz8(l, s_ >> 3) + (s_ & 7) * 2) = f2bf(m);
        }
      }
      LDS_BARRIER();
      f32x4 Y[2], Yo[2];
#pragma unroll
      for (int j = 0; j < 2; ++j) { Y[j] = f32x4{0.f, 0.f, 0.f, 0.f}; Yo[j] = f32x4{0.f, 0.f, 0.f, 0.f}; }
#pragma unroll
      for (int kk = 0; kk < 2; ++kk) {
        bf16x8 ma = *reinterpret_cast<const bf16x8*>(sBc + swz8(16 * w + lr, kk * 4 + lq));
#pragma unroll
        for (int j = 0; j < 2; ++j) {
          bf16x8 xb = *reinterpret_cast<const bf16x8*>(sXT + swz8(16 * j + lr, kk * 4 + lq));
          Y[j] = __builtin_amdgcn_mfma_f32_16x16x32_bf16(ma, xb, Y[j], 0, 0, 0);
        }
      }
#pragma unroll
      for (int kk = 0; kk < 4; ++kk)
#pragma unroll
        for (int j = 0; j < 2; ++j) {
          bf16x8 hb = *reinterpret_cast<const bf16x8*>(sHb + swz16(16 * j + lr, kk * 4 + lq));
          Yo[j] = __builtin_amdgcn_mfma_f32_16x16x32_bf16(ca[kk], hb, Yo[j], 0, 0, 0);
        }
      float syl[4];
#pragma unroll
      for (int r = 0; r < 4; ++r) syl[r] = sy[16 * w + lq * 4 + r];
#pragma unroll
      for (int j = 0; j < 2; ++j)
#pragma unroll
        for (int r = 0; r < 4; ++r) {
          const int l = 16 * w + lq * 4 + r;
          yo[(trow0 + l) * 1024 + h * 64 + ph * 32 + 16 * j + lr] = f2bf(Y[j][r] + syl[r] * Yo[j][r]);
        }
    }
    {
      const float dec = __expf(etot);
#pragma unroll
      for (int i = 0; i < 2; ++i)
#pragma unroll
        for (int j = 0; j < 2; ++j) H[i][j] *= dec;
#pragma unroll
      for (int kk = 0; kk < 2; ++kk) {
        const int s0 = kk * 32 + lq * 8;
        const float4 w0 = *reinterpret_cast<const float4*>(sw + s0), w1 = *reinterpret_cast<const float4*>(sw + s0 + 4);
        bf16x8 xs[2];
#pragma unroll
        for (int i = 0; i < 2; ++i) {
          const bf16x8 xa = *reinterpret_cast<const bf16x8*>(sXT + swz8(16 * i + lr, kk * 4 + lq));
          xs[i][0] = (short)f2bf(bf2f((bf16_t)xa[0]) * w0.x); xs[i][1] = (short)f2bf(bf2f((bf16_t)xa[1]) * w0.y);
          xs[i][2] = (short)f2bf(bf2f((bf16_t)xa[2]) * w0.z); xs[i][3] = (short)f2bf(bf2f((bf16_t)xa[3]) * w0.w);
          xs[i][4] = (short)f2bf(bf2f((bf16_t)xa[4]) * w1.x); xs[i][5] = (short)f2bf(bf2f((bf16_t)xa[5]) * w1.y);
          xs[i][6] = (short)f2bf(bf2f((bf16_t)xa[6]) * w1.z); xs[i][7] = (short)f2bf(bf2f((bf16_t)xa[7]) * w1.w);
        }
#pragma unroll
        for (int j = 0; j < 2; ++j) {
          const bf16x8 bt = *reinterpret_cast<const bf16x8*>(sBT + swz8(16 * (2 * w + j) + lr, kk * 4 + lq));
#pragma unroll
          for (int i = 0; i < 2; ++i) H[i][j] = __builtin_amdgcn_mfma_f32_16x16x32_bf16(xs[i], bt, H[i][j], 0, 0, 0);
        }
      }
    }
    LDS_BARRIER();
#pragma unroll
    for (int i = 0; i < 2; ++i)
#pragma unroll
      for (int j = 0; j < 2; ++j) {
        const int n = 16 * (2 * w + j) + lr;
#pragma unroll
        for (int r = 0; r < 4; ++r) {
          const int pr = 16 * i + lq * 4 + r;
          *reinterpret_cast<bf16_t*>(sHb + swz16(pr, n >> 3) + (n & 7) * 2) = f2bf(H[i][j][r]);
        }
      }
  }
#undef SSD_PREFETCH
#undef SSD_PARAMS
}

#undef LDS_BARRIER
__device__ void phase_ssd_dft(KParams& p, int bid, int nb, char* smem) {
  for (int t = bid; t < 256; t += nb) ssd_task(p, t, smem);
  int* stile = reinterpret_cast<int*>(smem + 75776);
  for (;;) {
    __syncthreads();
    if (threadIdx.x == 0) *stile = (int)atomicAdd(p.ctr, 1u);
    __syncthreads();
    const int t = *stile;
    if (t >= 4 * 8 * 8) break;
    const int b = t >> 6, tm = (t & 63) >> 3, tn = t & 7;
    const bf16_t* Fb = p.Fs + (size_t)b * 1024 * 2048;
    f32x4 accC[4][4], accS[4][4];
    gemm_mainloop(p.dftm, 2048, Fb, 2048, 1024, tm * 128, tn * 128, accC, smem);
    gemm_mainloop(p.dftm + 1024, 2048, Fb + 1024, 2048, 1024, tm * 128, tn * 128, accS, smem);
    const int lane = threadIdx.x & 63, w = threadIdx.x >> 6, wm = w >> 1, wn = w & 1;
#pragma unroll
    for (int i = 0; i < 4; ++i) {
      int lq_ = lane >> 4, lr_ = lane & 15;
      asm volatile("" : "+v"(lq_), "+v"(lr_));
#pragma unroll
      for (int j = 0; j < 4; ++j) {
        const int k0 = tm * 128 + wm * 64 + i * 16 + lq_ * 4;
        const int ch = tn * 128 + wn * 64 + j * 16 + lr_;
        const float a = bf2f(p.ABt[((size_t)b * 1024 + ch) * 4096 + 1024]);
#pragma unroll
        for (int r = 0; r < 4; ++r) {
          const int k = k0 + r;
          const float as = (k & 1) ? -a : a;
          const float c = accC[i][j][r], sn = accS[i][j][r];
          p.ycat[((size_t)b * L + k) * D + ch] = f2bf(c - sn + as);
          if (k > 0) p.ycat[((size_t)b * L + (L - k)) * D + ch] = f2bf(c + sn + as);
        }
      }
    }
  }
  for (;;) {
    __syncthreads();
    if (threadIdx.x == 0) *stile = (int)atomicAdd(p.ctr + 8, 1u);
    __syncthreads();
    const int q4 = *stile;
    if (q4 >= (1024 + 1536) / 4) break;
#pragma unroll 1
    for (int q = q4 * 4; q < q4 * 4 + 4; ++q) {
      if (q < 512) convert_u_rows(p, q);
      else if (q < 1024) convert_v_rows(p, q - 512);
      else if (q < 1024 + 1024) { const int q1 = q - 1024; transpose_convert_task(p.w_out, D, 0, D, p.w_out_t, q1 / 32, q1 % 32, reinterpret_cast<float*>(smem)); }
      else { const int q2 = q - 2048; transpose_convert_task(p.w_query, 1024, 0, D, p.w_q_t, q2 / 16, q2 % 16, reinterpret_cast<float*>(smem)); }
    }
  }
}

__device__ void phase_ssm_post(KParams& p, int bid, int nb, char* smem) {
  const int lane = threadIdx.x & 63, w = threadIdx.x >> 6;
  for (int t = bid * 4 + w; t < T; t += nb * 4) {
    float y[4][4];
    float ss0 = 0.f, ss1 = 0.f;
#pragma unroll
    for (int c = 0; c < 4; ++c) {
      const int c0 = c * 256 + lane * 4;
      const int h = c0 >> 6;
      const float dsk = p.d_skip_f[h] + p.d_skip_b[h];
      const uint2 aq = *reinterpret_cast<const uint2*>(reinterpret_cast<const bf16_t*>(p.yf) + (size_t)t * 1024 + c0);
      const uint2 bb = *reinterpret_cast<const uint2*>(reinterpret_cast<const bf16_t*>(p.yb) + (size_t)t * 1024 + c0);
      const float4 a = float4{bflo(aq.x), bfhi(aq.x), bflo(aq.y), bfhi(aq.y)};
      const float4 bq = float4{bflo(bb.x), bfhi(bb.x), bflo(bb.y), bfhi(bb.y)};
      const uint2 xq = *reinterpret_cast<const uint2*>(p.act_tm + (size_t)t * DXBC + c0);
      const uint2 zz = *reinterpret_cast<const uint2*>(p.z + (size_t)t * 1024 + c0);
      y[c][0] = (a.x + bq.x + dsk * bflo(xq.x)) * silu_f(bflo(zz.x));
      y[c][1] = (a.y + bq.y + dsk * bfhi(xq.x)) * silu_f(bfhi(zz.x));
      y[c][2] = (a.z + bq.z + dsk * bflo(xq.y)) * silu_f(bflo(zz.y));
      y[c][3] = (a.w + bq.w + dsk * bfhi(xq.y)) * silu_f(bfhi(zz.y));
      const float q = y[c][0] * y[c][0] + y[c][1] * y[c][1] + y[c][2] * y[c][2] + y[c][3] * y[c][3];
      if (c < 2) ss0 += q; else ss1 += q;
    }
    ss0 = wave_sum_fast(ss0); ss1 = wave_sum_fast(ss1);
    const float r0 = rsqrtf(ss0 * (1.f / 512.f) + EPS), r1 = rsqrtf(ss1 * (1.f / 512.f) + EPS);
    uint2 fq[4];
    float am = 0.f;
#pragma unroll
    for (int c = 0; c < 4; ++c) {
      const int c0 = c * 256 + lane * 4;
      fq[c] = *reinterpret_cast<const uint2*>(p.ycat + (size_t)t * D + c0);
      am = fmaxf(am, fmaxf(fmaxf(fabsf(bflo(fq[c].x)), fabsf(bfhi(fq[c].x))), fmaxf(fabsf(bflo(fq[c].y)), fabsf(bfhi(fq[c].y)))));
      const float rstd = (c < 2) ? r0 : r1;
      const float4 nw = *reinterpret_cast<const float4*>(p.ssm_norm_w + c0);
      y[c][0] *= rstd * nw.x; y[c][1] *= rstd * nw.y; y[c][2] *= rstd * nw.z; y[c][3] *= rstd * nw.w;
      am = fmaxf(am, fmaxf(fmaxf(fabsf(y[c][0]), fabsf(y[c][1])), fmaxf(fabsf(y[c][2]), fabsf(y[c][3]))));
    }
    am = wave_max_fast(am);
    const float inv = (am > 0.f) ? 127.f / am : 0.f;
#pragma unroll
    for (int c = 0; c < 4; ++c) {
      const int c0 = c * 256 + lane * 4;
      *reinterpret_cast<uint32_t*>(p.ycat8 + (size_t)t * D + c0) =
          pack_i8x4(bflo(fq[c].x) * inv, bfhi(fq[c].x) * inv, bflo(fq[c].y) * inv, bfhi(fq[c].y) * inv);
      *reinterpret_cast<uint32_t*>(p.ycat8 + (size_t)t * D + 1024 + c0) = pack_i8x4(y[c][0] * inv, y[c][1] * inv, y[c][2] * inv, y[c][3] * inv);
    }
    if (lane == 0) p.yscale[t] = am * (1.f / 127.f);
  }
  quant_weight_rows_i8(p.w_out_t, p.wo8, p.woscale, D, bid, nb);
  quant_weight_rows_i8(p.w_q_t, p.wq8, p.wqscale, 1024, bid, nb);
}

__device__ void phase_outproj(KParams& p, int bid, int nb, char* smem) {
  const bool aware = (nb & 7) == 0;
  const int start = aware ? (bid >> 3) : bid, step = aware ? (nb >> 3) : nb, end = aware ? 64 : 512;
  const bf16_t* a8 = reinterpret_cast<const bf16_t*>(p.ycat8);
  const bf16_t* b8 = reinterpret_cast<const bf16_t*>(p.wo8);
  for (int it = start; it < end; it += step) {
    const int x = aware ? (bid & 7) : (it >> 6), s_ = aware ? it : (it & 63);
    EpiBf16 epi{reinterpret_cast<bf16_t*>(p.y_x), D};
    gemm_tile_n256<true>(a8, D / 2, b8, D / 2, D / 2, (8 * x + (s_ & 7)) * 128, (s_ >> 3) * 256, epi, smem, p.yscale, p.woscale);
  }
}
__device__ void phase_postmix(KParams& p, int bid, int nb, char* smem) {
  const int lane = threadIdx.x & 63, w = threadIdx.x >> 6;
  for (int t = bid * 4 + w; t < T; t += nb * 4) {
    const int b = t / L;
    float4 y[8];
    float ss = 0.f;
#pragma unroll
    for (int c = 0; c < 8; ++c) {
      {
        const uint2 yq = *reinterpret_cast<const uint2*>(reinterpret_cast<const bf16_t*>(p.y_x) + (size_t)t * D + c * 256 + lane * 4);
        y[c] = float4{bflo(yq.x), bfhi(yq.x), bflo(yq.y), bfhi(yq.y)};
      }
      ss += y[c].x * y[c].x + y[c].y * y[c].y + y[c].z * y[c].z + y[c].w * y[c].w;
    }
    ss = wave_sum_fast(ss);
    const float rstd = rsqrtf(ss * (1.f / D) + EPS);
    const float* gm = p.mod + (size_t)b * NMOD + 2 * D;
    float ss1 = 0.f;
#pragma unroll
    for (int c = 0; c < 8; ++c) {
      const int e0 = c * 256 + lane * 4;
      const float4 xv = *reinterpret_cast<const float4*>(p.x + (size_t)t * D + e0);
      const float4 g4 = *reinterpret_cast<const float4*>(gm + e0), gp = *reinterpret_cast<const float4*>(p.g_post_mix + e0);
      y[c].x = xv.x + g4.x * (y[c].x * rstd * gp.x); y[c].y = xv.y + g4.y * (y[c].y * rstd * gp.y);
      y[c].z = xv.z + g4.z * (y[c].z * rstd * gp.z); y[c].w = xv.w + g4.w * (y[c].w * rstd * gp.w);
      ss1 += y[c].x * y[c].x + y[c].y * y[c].y + y[c].z * y[c].z + y[c].w * y[c].w;
    }
    if (lane == 0) p.partial[t] = rstd;
    ss1 = wave_sum_fast(ss1);
    const float rstd1 = rsqrtf(ss1 * (1.f / D) + EPS);
    const float* sf = p.mod + (size_t)b * NMOD + 3 * D;
    const float* cf = p.mod + (size_t)b * NMOD + 4 * D;
    float am = 0.f;
#pragma unroll
    for (int c = 0; c < 8; ++c) {
      const int e0 = c * 256 + lane * 4;
      const float4 g = *reinterpret_cast<const float4*>(p.g_pre_ffn + e0);
      const float4 s4 = *reinterpret_cast<const float4*>(cf + e0), h4 = *reinterpret_cast<const float4*>(sf + e0);
      y[c].x = y[c].x * rstd1 * g.x * (1.f + s4.x) + h4.x; y[c].y = y[c].y * rstd1 * g.y * (1.f + s4.y) + h4.y;
      y[c].z = y[c].z * rstd1 * g.z * (1.f + s4.z) + h4.z; y[c].w = y[c].w * rstd1 * g.w * (1.f + s4.w) + h4.w;
      am = fmaxf(am, fmaxf(fmaxf(fabsf(y[c].x), fabsf(y[c].y)), fmaxf(fabsf(y[c].z), fabsf(y[c].w))));
    }
    am = wave_max_fast(am);
    const float inv = (am > 0.f) ? 119.f / am : 0.f;
#pragma unroll
    for (int c = 0; c < 8; ++c) {
      const uint32_t w8 = pack_i8x4(y[c].x * inv, y[c].y * inv, y[c].z * inv, y[c].w * inv);
      *reinterpret_cast<uint32_t*>(p.hx8a + (size_t)t * D + c * 256 + lane * 4) = w8;
      const uint32_t va = (((((w8 ^ 0x80808080u) + 0x08080808u) >> 4) & 0x0F0F0F0Fu) ^ 0x08080808u), vb = w8 & 0x0F0F0F0Fu;
      const uint32_t na = (uint32_t)dpp_movi<0xB1>((int)va), nbv = (uint32_t)dpp_movi<0xB1>((int)vb);
      const bool odd = (lane & 1) != 0;
      const uint32_t word = odd ? (nbv | (vb << 4)) : (va | (na << 4));
      *reinterpret_cast<uint32_t*>(p.ycat8 + (size_t)t * D + (c * 8 + (lane >> 3)) * 32 + (odd ? 16 : 0) + ((lane & 7) >> 1) * 4) = word;
    }
    if (lane == 0) p.ascale[t] = am * (1.f / 119.f);
  }
}

__device__ __forceinline__ uint32_t mono_key(float f) {
  uint32_t u = __float_as_uint(f);
  return (u & 0x80000000u) ? ~u : (u | 0x80000000u);
}
__device__ __forceinline__ void ins16(uint32_t (&Lk)[16], uint32_t x) {
#pragma unroll
  for (int i = 0; i < 16; ++i) { uint32_t hi = max(Lk[i], x); x = min(Lk[i], x); Lk[i] = hi; }
}
__device__ __forceinline__ float unmono_key(uint32_t k) {
  return __uint_as_float((k & 0x80000000u) ? (k ^ 0x80000000u) : ~k);
}
typedef __attribute__((ext_vector_type(16))) float f32x16;
__device__ __forceinline__ void ce_desc(uint32_t& a, uint32_t& b) { const uint32_t hi = max(a, b), lo = min(a, b); a = hi; b = lo; }
__device__ __forceinline__ void bitonic_sort16_desc(uint32_t (&K)[16]) {
#pragma unroll
  for (int k = 2; k <= 16; k <<= 1)
#pragma unroll
    for (int j = k >> 1; j >= 1; j >>= 1)
#pragma unroll
      for (int i = 0; i < 16; ++i) {
        const int l = i ^ j;
        if (l > i) { if ((i & k) == 0) ce_desc(K[i], K[l]); else ce_desc(K[l], K[i]); }
      }
}
__device__ __forceinline__ void merge_top16(uint32_t (&Lk)[16], const uint32_t (&K)[16]) {
#pragma unroll
  for (int i = 0; i < 16; ++i) Lk[i] = max(Lk[i], K[15 - i]);
#pragma unroll
  for (int dd = 8; dd >= 1; dd >>= 1)
#pragma unroll
    for (int i = 0; i < 16; ++i)
      if ((i & dd) == 0) ce_desc(Lk[i], Lk[i + dd]);
}
__device__ void phase_q_route(KParams& p, int bid, int nb, char* smem) {
  const int tid = opaque_tid(), lane = tid & 63, w = tid >> 6;
  const int wm = w >> 1, wn = w & 1, lr = lane & 15, lq = lane >> 4;
  const int l31 = lane & 31, lh = lane >> 5;
  for (int tile0 = bid; tile0 < 512; tile0 += nb) {
    const int tile = ((nb & 7) == 0 && nb >= 512) ? (((tile0 & 7) * 8 + ((tile0 >> 3) & 7)) * 8 + (tile0 >> 6)) : tile0;
    const int h = tile & 7, m0 = (tile >> 3) * 128;
    {
      f32x4 acc[4][4];
      gemm_mainloop<true>(reinterpret_cast<const bf16_t*>(p.hx8a), D / 2, reinterpret_cast<const bf16_t*>(p.wq8), D / 2, D / 2, m0, h * 128, acc, smem);
#pragma unroll
      for (int i = 0; i < 4; ++i) {
        const float4 rs = *reinterpret_cast<const float4*>(p.ascale + m0 + wm * 64 + i * 16 + lq * 4);
#pragma unroll
        for (int j = 0; j < 4; ++j) {
          typedef __attribute__((ext_vector_type(4))) int i32x4;
          const i32x4 ia = __builtin_bit_cast(i32x4, acc[i][j]);
          const float cs = p.wqscale[h * 128 + wn * 64 + j * 16 + lr];
          const float qv[4] = {(float)ia[0] * rs.x * cs, (float)ia[1] * rs.y * cs, (float)ia[2] * rs.z * cs, (float)ia[3] * rs.w * cs};
#pragma unroll
          for (int r = 0; r < 4; ++r) {
            const int row = wm * 64 + i * 16 + lq * 4 + r, col = wn * 64 + j * 16 + lr;
            *reinterpret_cast<bf16_t*>(smem + swz16(row, col >> 3) + (col & 7) * 2) = f2bf(qv[r]);
          }
        }
      }
    }
#pragma unroll 4
    for (int r = 0; r < 16; ++r) {
      const int id = tid + 256 * r, row = id >> 4, c4 = id & 15;
      const float* src = ((row < 128) ? p.sk1 : p.sk2) + ((size_t)(h * 128 + (row & 127)) * 64 + c4 * 4);
      const float4 v = *reinterpret_cast<const float4*>(src);
      uint2 pk; pk.x = pack2(v.x, v.y); pk.y = pack2(v.z, v.w);
      *reinterpret_cast<uint2*>(smem + 32768 + swz8(row, c4 >> 1) + (c4 & 1) * 8) = pk;
    }
    __syncthreads();
    uint32_t L1[16], L2[16];
#pragma unroll
    for (int sd = 0; sd < 2; ++sd) {
      uint32_t Lk[16];
#pragma unroll
      for (int i = 0; i < 16; ++i) Lk[i] = 0u;
      const uint32_t kb = (uint32_t)(lh * 4);
#pragma unroll
      for (int ih = 0; ih < 2; ++ih) {
        f32x16 Sa[2];
#pragma unroll
        for (int i = 0; i < 2; ++i)
#pragma unroll
          for (int g2 = 0; g2 < 16; ++g2) Sa[i][g2] = 0.f;
#pragma unroll
        for (int ks = 0; ks < 4; ++ks) {
          const bf16x8 qb = *reinterpret_cast<const bf16x8*>(smem + swz16(w * 32 + l31, sd * 8 + ks * 2 + lh));
#pragma unroll
          for (int i = 0; i < 2; ++i) {
            const bf16x8 ka = *reinterpret_cast<const bf16x8*>(smem + 32768 + swz8(sd * 128 + (ih * 2 + i) * 32 + l31, ks * 2 + lh));
            Sa[i] = __builtin_amdgcn_mfma_f32_32x32x16_bf16(ka, qb, Sa[i], 0, 0, 0);
          }
        }
#pragma unroll
        for (int i = 0; i < 2; ++i) {
          uint32_t Kg[16];
#pragma unroll
          for (int g2 = 0; g2 < 16; ++g2)
            Kg[g2] = (mono_key(Sa[i][g2]) & ~0x7Fu) | (uint32_t)((ih * 2 + i) * 32 + (g2 & 3) + 8 * (g2 >> 2)) | kb;
          bitonic_sort16_desc(Kg);
          if (ih == 0 && i == 0) {
#pragma unroll
            for (int r = 0; r < 16; ++r) Lk[r] = Kg[r];
          } else merge_top16(Lk, Kg);
        }
      }
#pragma unroll
      for (int i = 0; i < 8; ++i) {
        const uint32_t t1 = (uint32_t)__shfl_xor((int)Lk[15 - i], 32), t2 = (uint32_t)__shfl_xor((int)Lk[i], 32);
        Lk[i] = max(Lk[i], t1); Lk[15 - i] = max(Lk[15 - i], t2);
      }
#pragma unroll
      for (int dd = 8; dd >= 1; dd >>= 1)
#pragma unroll
        for (int i = 0; i < 16; ++i)
          if ((i & dd) == 0) { const uint32_t hi = max(Lk[i], Lk[i + dd]), lo = min(Lk[i], Lk[i + dd]); Lk[i] = hi; Lk[i + dd] = lo; }
#pragma unroll
      for (int r = 0; r < 16; ++r) { if (sd == 0) L1[r] = Lk[r]; else L2[r] = Lk[r]; }
    }
    __syncthreads();
    uint32_t* ib = reinterpret_cast<uint32_t*>(smem) + w * 1088 + l31 * 34;
    if (lh == 0) {
#pragma unroll
      for (int r = 0; r < 16; ++r) { ib[r] = L1[r] & 127u; ib[16 + r] = L2[r] & 127u; }
    }
    float v1[16], v2[16];
#pragma unroll
    for (int r = 0; r < 16; ++r) { v1[r] = unmono_key(L1[r] & ~0x7Fu); v2[r] = unmono_key(L2[r] & ~0x7Fu); }
    uint32_t C[16];
#pragma unroll
    for (int i = 0; i < 16; ++i) C[i] = 0u;
#pragma unroll
    for (int a = 0; a < 16; ++a)
#pragma unroll
      for (int bq = 0; bq < 16; ++bq)
        if ((a + 1) * (bq + 1) <= 16) ins16(C, (mono_key(v1[a] + v2[bq]) & ~0xFFu) | (uint32_t)(a * 16 + bq));
    float ts[16]; int te[16];
    __builtin_amdgcn_wave_barrier();
#pragma unroll
    for (int r = 0; r < 16; ++r) {
      const uint32_t code = C[r] & 0xFFu;
      te[r] = (int)(ib[code >> 4] * 128u + ib[16 + (code & 15u)]);
      ts[r] = unmono_key(C[r] & ~0xFFu);
    }
    const float mx = ts[0];
    float den = 0.f;
#pragma unroll
    for (int r = 0; r < 16; ++r) { ts[r] = __expf(ts[r] - mx); den += ts[r]; }
    const float inv = 1.f / den;
    const size_t ob = (size_t)(m0 + w * 32 + l31) * 128 + h * 16;
    if (lh == 0) {
#pragma unroll
      for (int r = 0; r < 16; r += 4) *reinterpret_cast<int4*>(p.idx + ob + r) = int4{te[r], te[r + 1], te[r + 2], te[r + 3]};
    } else {
#pragma unroll
      for (int r = 0; r < 16; r += 4)
        *reinterpret_cast<float4*>(p.gate + ob + r) = float4{ts[r] * inv, ts[r + 1] * inv, ts[r + 2] * inv, ts[r + 3] * inv};
    }
    __syncthreads();
  }
}

typedef __attribute__((ext_vector_type(2))) float f32x2;
__device__ __forceinline__ void fp8x16_to_f32(const uint4 q, f32x2 (&o)[8]) {
  o[0] = __builtin_amdgcn_cvt_pk_f32_fp8((int)q.x, false); o[1] = __builtin_amdgcn_cvt_pk_f32_fp8((int)q.x, true);
  o[2] = __builtin_amdgcn_cvt_pk_f32_fp8((int)q.y, false); o[3] = __builtin_amdgcn_cvt_pk_f32_fp8((int)q.y, true);
  o[4] = __builtin_amdgcn_cvt_pk_f32_fp8((int)q.z, false); o[5] = __builtin_amdgcn_cvt_pk_f32_fp8((int)q.z, true);
  o[6] = __builtin_amdgcn_cvt_pk_f32_fp8((int)q.w, false); o[7] = __builtin_amdgcn_cvt_pk_f32_fp8((int)q.w, true);
}
__device__ __forceinline__ unsigned my_xcc_id() { return (unsigned)__builtin_amdgcn_s_getreg((3 << 11) | 20) & 7u; }

__device__ void phase_exp_u(KParams& p, char* smem) {
  const int tid = opaque_tid(), lane = tid & 63, w = tid >> 6;
  const int sub = lane >> 3, cc = lane & 7;
  const unsigned myx = my_xcc_id();
  int* sh = reinterpret_cast<int*>(smem);
  int* si = reinterpret_cast<int*>(smem + 64) + w * 256;
  float* pbuf = reinterpret_cast<float*>(p.ycat);
  {
    unsigned qcur = 0;
    for (;;) {
      __syncthreads();
      if (tid == 0) {
        int found = -1; unsigned fx = 0;
        for (; qcur < 8; ++qcur) {
          fx = (myx + qcur) & 7u;
          const int c = (int)atomicAdd(&p.ctr[16 + fx], 1u);
          if (c < 128) { found = c; break; }
        }
        sh[0] = found; sh[1] = (int)fx;
      }
      __syncthreads();
      const int chunk = sh[0];
      const unsigned x = (unsigned)sh[1];
      if (chunk < 0) break;
      int e0n = p.idx[(size_t)(chunk * 64 + w * 16) * 128 + lane], e1n = p.idx[(size_t)(chunk * 64 + w * 16) * 128 + 64 + lane];
      uint4 hqn0 = *reinterpret_cast<const uint4*>(p.ycat8 + (size_t)(chunk * 64 + w * 16) * D + x * 256 + cc * 32);
      uint4 hqn1 = *reinterpret_cast<const uint4*>(p.ycat8 + (size_t)(chunk * 64 + w * 16) * D + x * 256 + cc * 32 + 16);
      for (int tt = 0; tt < 16; ++tt) {
        const int t = chunk * 64 + w * 16 + tt;
        __builtin_amdgcn_wave_barrier();
        si[lane] = e0n; si[64 + lane] = e1n;
        __builtin_amdgcn_wave_barrier();
        const uint4 hq0 = hqn0, hq1 = hqn1;
        const __amdgpu_buffer_rsrc_t urs = __builtin_amdgcn_make_buffer_rsrc((void*)p.U8, 0, 0x2000000, 0x00020000);
        const int uoff = (int)x * (16384 * 128) + cc * 16;
        uint4 qa[4], qb[4], qc[4], qd[4];
#define EU_LOADN(q_, g0_, n_) _Pragma("unroll") for (int k = 0; k < (n_); ++k) q_[k] = __builtin_bit_cast(uint4, __builtin_amdgcn_raw_buffer_load_b128(urs, uoff + si[((g0_) + k) * 8 + sub] * 128, 0, GATHER_AUX))
#define EU_COMPN(q_, g0_, n_)                                                                                           \
  _Pragma("unroll") for (int k = 0; k < (n_); ++k) {                                                                    \
    int d = __builtin_amdgcn_sdot8((int)q_[k].x, (int)hq0.x, 0, false);                                                 \
    int d1 = __builtin_amdgcn_sdot8((int)q_[k].x, (int)hq1.x, 0, false);                                                \
    d = __builtin_amdgcn_sdot8((int)q_[k].y, (int)hq0.y, d, false);                                                     \
    d1 = __builtin_amdgcn_sdot8((int)q_[k].y, (int)hq1.y, d1, false);                                                   \
    d = __builtin_amdgcn_sdot8((int)q_[k].z, (int)hq0.z, d, false);                                                     \
    d1 = __builtin_amdgcn_sdot8((int)q_[k].z, (int)hq1.z, d1, false);                                                   \
    d = __builtin_amdgcn_sdot8((int)q_[k].w, (int)hq0.w, d, false);                                                     \
    d1 = __builtin_amdgcn_sdot8((int)q_[k].w, (int)hq1.w, d1, false);                                                   \
    d = (d << 4) + d1;                                                                                                  \
    d += dpp_movi<0xB1>(d); d += dpp_movi<0x4E>(d); d += dpp_movi<0x141>(d);     \
    mine = (cc == (((g0_) + k) & 7)) ? d : mine;                                                                        \
  }
        int mine = 0;
#define EU_WAIT(n_) asm volatile("s_waitcnt vmcnt(" #n_ ")" ::: "memory")
        EU_LOADN(qa, 0, 4); EU_LOADN(qb, 4, 4); EU_LOADN(qc, 8, 4); EU_LOADN(qd, 12, 4);
        {
          const int t1 = (tt + 1 < 16) ? t + 1 : t;
          e0n = p.idx[(size_t)t1 * 128 + lane]; e1n = p.idx[(size_t)t1 * 128 + 64 + lane];
          hqn0 = *reinterpret_cast<const uint4*>(p.ycat8 + (size_t)t1 * D + x * 256 + cc * 32);
          hqn1 = *reinterpret_cast<const uint4*>(p.ycat8 + (size_t)t1 * D + x * 256 + cc * 32 + 16);
        }
        EU_WAIT(16); EU_COMPN(qa, 0, 4);
        EU_WAIT(12); EU_COMPN(qb, 4, 4);
        pbuf[((size_t)x * T + t) * 128 + cc * 8 + sub] = (float)mine;
        mine = 0;
        EU_WAIT(9); EU_COMPN(qc, 8, 4);
        EU_WAIT(5); EU_COMPN(qd, 12, 4);
#undef EU_WAIT
        pbuf[((size_t)x * T + t) * 128 + 64 + cc * 8 + sub] = (float)mine;
#undef EU_LOADN
#undef EU_COMPN
      }
    }
  }
}

__device__ void phase_exp_combine(KParams& p, int bid, int nb) {
  const int lane = threadIdx.x & 63, w = threadIdx.x >> 6;
  const float* pbuf = reinterpret_cast<const float*>(p.ycat);
  for (int t = bid * 4 + w; t < T; t += nb * 4) {
    const int e0 = p.idx[(size_t)t * 128 + lane], e1 = p.idx[(size_t)t * 128 + 64 + lane];
    const float* pb = pbuf + (size_t)t * 128;
    float d0 = 0.f, d1 = 0.f;
#pragma unroll
    for (int xs = 0; xs < 8; ++xs) { d0 += pb[(size_t)xs * T * 128 + lane]; d1 += pb[(size_t)xs * T * 128 + 64 + lane]; }
    const float hs = p.ascale[t];
    d0 *= p.uscale[e0] * hs; d1 *= p.uscale[e1] * hs;
    const float g0 = p.gate[(size_t)t * 128 + lane], g1 = p.gate[(size_t)t * 128 + 64 + lane];
    p.gate[(size_t)t * 128 + lane] = g0 * p.uscale[16384 + e0] * 0.5f * d0 * (1.f + erff(d0 * 0.70710678118654752f));
    p.gate[(size_t)t * 128 + 64 + lane] = g1 * p.uscale[16384 + e1] * 0.5f * d1 * (1.f + erff(d1 * 0.70710678118654752f));
  }
}

__device__ void phase_exp_v(KParams& p, char* smem) {
  const int tid = opaque_tid(), lane = tid & 63, w = tid >> 6;
  const int sub = lane >> 3, cc = lane & 7;
  const unsigned myx = my_xcc_id();
  int* sh = reinterpret_cast<int*>(smem);
  int* si = reinterpret_cast<int*>(smem + 64) + w * 256;
  float* sc = reinterpret_cast<float*>(si + 128);
  bf16_t* yfb = reinterpret_cast<bf16_t*>(p.y_x) + (size_t)T * D;
  {
    unsigned qcur = 0;
    for (;;) {
      __syncthreads();
      if (tid == 0) {
        int found = -1; unsigned fx = 0;
        for (; qcur < 8; ++qcur) {
          fx = (myx + qcur) & 7u;
          const int c = (int)atomicAdd(&p.ctr[32 + fx], 1u);
          if (c < 128) { found = c; break; }
        }
        sh[0] = found; sh[1] = (int)fx;
      }
      __syncthreads();
      const int chunk = sh[0];
      const unsigned x = (unsigned)sh[1];
      if (chunk < 0) break;
      int e0n = p.idx[(size_t)(chunk * 64 + w * 16) * 128 + lane], e1n = p.idx[(size_t)(chunk * 64 + w * 16) * 128 + 64 + lane];
      float g0n = p.gate[(size_t)(chunk * 64 + w * 16) * 128 + lane], g1n = p.gate[(size_t)(chunk * 64 + w * 16) * 128 + 64 + lane];
      for (int tt = 0; tt < 16; ++tt) {
        const int t = chunk * 64 + w * 16 + tt;
        __builtin_amdgcn_wave_barrier();
        si[lane] = e0n; si[64 + lane] = e1n;
        sc[lane] = g0n; sc[64 + lane] = g1n;
        __builtin_amdgcn_wave_barrier();
        f32x2 acc[16];
#pragma unroll
        for (int e = 0; e < 16; ++e) acc[e] = f32x2{0.f, 0.f};
        const __amdgpu_buffer_rsrc_t vrs = __builtin_amdgcn_make_buffer_rsrc((void*)p.V8, 0, 0x2000000, 0x00020000);
        const int voff = (int)x * (16384 * 128) + cc * 16;
        uint4 qa[4], qb[4], qc[4], qd[4];
#define EV_LOADN(q_, g0_, n_) _Pragma("unroll") for (int k = 0; k < (n_); ++k) q_[k] = __builtin_bit_cast(uint4, __builtin_amdgcn_raw_buffer_load_b128(vrs, voff + si[((g0_) + k) * 8 + sub] * 128, 0, GATHER_AUX))
#define EV_WORD(wd_, a0_)                                                                                               \
    acc[(a0_) + 0] += c2 * __builtin_amdgcn_cvt_scalef32_pk_f32_fp4((wd_), 1.0f, 0);                                    \
    acc[(a0_) + 1] += c2 * __builtin_amdgcn_cvt_scalef32_pk_f32_fp4((wd_), 1.0f, 1);                                    \
    acc[(a0_) + 2] += c2 * __builtin_amdgcn_cvt_scalef32_pk_f32_fp4((wd_), 1.0f, 2);                                    \
    acc[(a0_) + 3] += c2 * __builtin_amdgcn_cvt_scalef32_pk_f32_fp4((wd_), 1.0f, 3);
#define EV_COMPN(q_, g0_, n_)                                                                                           \
  _Pragma("unroll") for (int k = 0; k < (n_); ++k) {                                                                    \
    const float cfk = sc[((g0_) + k) * 8 + sub];                                                                        \
    const f32x2 c2 = f32x2{cfk, cfk};                                                                                   \
    EV_WORD(q_[k].x, 0) EV_WORD(q_[k].y, 4) EV_WORD(q_[k].z, 8) EV_WORD(q_[k].w, 12)                                    \
  }
#define EV_WAIT(n_) asm volatile("s_waitcnt vmcnt(" #n_ ")" ::: "memory")
        EV_LOADN(qa, 0, 4); EV_LOADN(qb, 4, 4); EV_LOADN(qc, 8, 4); EV_LOADN(qd, 12, 4);
        {
          const int t1 = (tt + 1 < 16) ? t + 1 : t;
          e0n = p.idx[(size_t)t1 * 128 + lane]; e1n = p.idx[(size_t)t1 * 128 + 64 + lane];
          g0n = p.gate[(size_t)t1 * 128 + lane]; g1n = p.gate[(size_t)t1 * 128 + 64 + lane];
        }
        EV_WAIT(16); EV_COMPN(qa, 0, 4);
        EV_WAIT(12); EV_COMPN(qb, 4, 4);
        EV_WAIT(8); EV_COMPN(qc, 8, 4);
        EV_WAIT(4); EV_COMPN(qd, 12, 4);
#undef EV_WAIT
#undef EV_LOADN
#undef EV_COMPN
#undef EV_WORD
        {
          float* red = reinterpret_cast<float*>(smem + 8192) + w * 2304;
          float* mr = red + (sub * 8 + cc) * 36;
#pragma unroll
          for (int q4 = 0; q4 < 8; ++q4)
            *reinterpret_cast<float4*>(mr + q4 * 4) = float4{acc[q4 * 2].x, acc[q4 * 2].y, acc[q4 * 2 + 1].x, acc[q4 * 2 + 1].y};
          __builtin_amdgcn_wave_barrier();
          float4 r = *reinterpret_cast<const float4*>(red + (0 * 8 + sub) * 36 + cc * 4);
#pragma unroll
          for (int s8 = 1; s8 < 8; ++s8) {
            const float4 r1 = *reinterpret_cast<const float4*>(red + (s8 * 8 + sub) * 36 + cc * 4);
            r.x += r1.x; r.y += r1.y; r.z += r1.z; r.w += r1.w;
          }
          uint2 o4;
          o4.x = pack2(r.x, r.y);
          o4.y = pack2(r.z, r.w);
          *reinterpret_cast<uint2*>(yfb + (size_t)t * D + x * 256 + sub * 32 + cc * 4) = o4;
          __builtin_amdgcn_wave_barrier();
        }
      }
    }
  }
}

__device__ void phase_exp_final(KParams& p, int bid, int nb, char* smem) {
  const int lane = threadIdx.x & 63, w = threadIdx.x >> 6;
  const bf16_t* ymix = reinterpret_cast<const bf16_t*>(p.y_x);
  const bf16_t* yf = reinterpret_cast<const bf16_t*>(p.y_x) + (size_t)T * D;
  for (int t = bid * 4 + w; t < T; t += nb * 4) {
    const int b = t / L;
    float4 y[8], xo[8];
#pragma unroll
    for (int c = 0; c < 8; ++c) {
      const uint2 yq = *reinterpret_cast<const uint2*>(yf + (size_t)t * D + c * 256 + lane * 4);
      y[c] = float4{bflo(yq.x), bfhi(yq.x), bflo(yq.y), bfhi(yq.y)};
      xo[c] = *reinterpret_cast<const float4*>(p.x + (size_t)t * D + c * 256 + lane * 4);
    }
    const float rmix = p.partial[t];
    float ss = 0.f;
#pragma unroll
    for (int c = 0; c < 8; ++c) ss += y[c].x * y[c].x + y[c].y * y[c].y + y[c].z * y[c].z + y[c].w * y[c].w;
    ss = wave_sum_fast(ss);
    const float rstd = rsqrtf(ss * (1.f / D) + EPS);
    const float* gfx = p.mod + (size_t)b * NMOD + 5 * D;
    const float* gm = p.mod + (size_t)b * NMOD + 2 * D;
#pragma unroll
    for (int c = 0; c < 8; ++c) {
      const int e0 = c * 256 + lane * 4;
      const uint2 mq = *reinterpret_cast<const uint2*>(ymix + (size_t)t * D + e0);
      const float4 m4 = float4{bflo(mq.x), bfhi(mq.x), bflo(mq.y), bfhi(mq.y)};
      const float4 g4 = *reinterpret_cast<const float4*>(gfx + e0), gp = *reinterpret_cast<const float4*>(p.g_post_ffn + e0);
      const float4 h4 = *reinterpret_cast<const float4*>(gm + e0), hp = *reinterpret_cast<const float4*>(p.g_post_mix + e0);
      xo[c].x += h4.x * (m4.x * rmix * hp.x) + g4.x * (y[c].x * rstd * gp.x);
      xo[c].y += h4.y * (m4.y * rmix * hp.y) + g4.y * (y[c].y * rstd * gp.y);
      xo[c].z += h4.z * (m4.z * rmix * hp.z) + g4.z * (y[c].z * rstd * gp.z);
      xo[c].w += h4.w * (m4.w * rmix * hp.w) + g4.w * (y[c].w * rstd * gp.w);
      *reinterpret_cast<float4*>(p.out + (size_t)t * D + e0) = xo[c];
    }
  }
}

#define XB_TMO      128
#define XB_XCNT(j)  (256  + 64 * (j))
#define XB_XSUB(j)  (1280 + 64 * (j))
#define XB_XGEN(j)  (2304 + 64 * (j))
#define XB_TOP      3328
#define XB_TOPGEN   3392
#define XCD_BAR_WORDS 3456
#define XB_SPIN_CAP (1u << 22)
#define LAS __attribute__((address_space(3)))
__device__ __forceinline__ unsigned xb_ld(unsigned* p)              { return __hip_atomic_load(p, __ATOMIC_RELAXED, __HIP_MEMORY_SCOPE_AGENT); }
__device__ __forceinline__ unsigned xb_add(unsigned* p, unsigned v) { return __hip_atomic_fetch_add(p, v, __ATOMIC_RELAXED, __HIP_MEMORY_SCOPE_AGENT); }
__device__ __forceinline__ unsigned xb_xcc_id() { return (unsigned)__builtin_amdgcn_s_getreg((3 << 11) | 20) & 0xFu; }
#define XB_SPIN(cond, bar) do { unsigned _sp = 0; while (cond) { __builtin_amdgcn_s_sleep(1); \
    if ((++_sp & 255u) == 0u) { if (xb_ld(&(bar)[XB_TMO])) break; if (_sp > XB_SPIN_CAP) { atomicAdd(&(bar)[XB_TMO], 1u); break; } } } } while (0)
struct XcdBarrier { unsigned* bar; unsigned x; volatile LAS unsigned* st; };
__device__ __forceinline__ XcdBarrier xcd_barrier_post(unsigned* bar, volatile LAS unsigned* st) {
  XcdBarrier b; b.bar = bar; b.x = xb_xcc_id(); b.st = st;
  if (threadIdx.x == 0) (void)xb_add(&bar[XB_XCNT(b.x)], 1u);
  return b;
}
__device__ __forceinline__ void xcd_barrier_complete(unsigned* bar, unsigned x, unsigned& nloc, unsigned& nx) {
  const unsigned G = gridDim.x * gridDim.y * gridDim.z;
  unsigned sum, cnt, mine, sp = 0u;
  for (;;) {
    sum = 0u; cnt = 0u; mine = 0u;
#pragma unroll
    for (unsigned j = 0; j < 16; ++j) { const unsigned c = xb_ld(&bar[XB_XCNT(j)]); sum += c; cnt += (c > 0u) ? 1u : 0u; mine = (j == x) ? c : mine; }
    if (sum == G) break;
    __builtin_amdgcn_s_sleep(1);
    if ((++sp & 255u) == 0u) { if (xb_ld(&bar[XB_TMO])) break; if (sp > XB_SPIN_CAP) { atomicAdd(&bar[XB_TMO], 1u); break; } }
  }
  nloc = mine > 0u ? mine : 1u; nx = cnt > 0u ? cnt : 1u;
}
__device__ __forceinline__ void xcd_barrier(const XcdBarrier& b) {
  asm volatile("s_waitcnt vmcnt(0)" ::: "memory");
  __syncthreads();
  if (threadIdx.x == 0) {
    unsigned* bar = b.bar;
    __builtin_amdgcn_s_waitcnt(0);
    unsigned nloc = b.st[0], nx = b.st[1];
    if (nloc == 0u) { xcd_barrier_complete(bar, b.x, nloc, nx); b.st[0] = nloc; b.st[1] = nx; }
    const unsigned old = xb_add(&bar[XB_XSUB(b.x)], 1u);
    const unsigned gen = old / nloc;
    if (old + 1u == (gen + 1u) * nloc) {
      __builtin_amdgcn_fence(__ATOMIC_RELEASE, "agent");
      asm volatile("s_waitcnt vmcnt(0)" ::: "memory");
      const unsigned og = xb_add(&bar[XB_TOP], 1u);
      const unsigned tg = og / nx;
      if (og + 1u == (tg + 1u) * nx) xb_add(&bar[XB_TOPGEN], 1u);
      else XB_SPIN(xb_ld(&bar[XB_TOPGEN]) == tg, bar);
      __builtin_amdgcn_fence(__ATOMIC_ACQUIRE, "agent");
      xb_add(&bar[XB_XGEN(b.x)], 1u);
      asm volatile("s_waitcnt vmcnt(0)" ::: "memory");
    } else {
      XB_SPIN(xb_ld(&bar[XB_XGEN(b.x)]) == gen, bar);
      __builtin_amdgcn_fence(__ATOMIC_ACQUIRE, "agent");
      asm volatile("s_waitcnt vmcnt(0)" ::: "memory");
    }
  }
  __syncthreads();
}

__global__ void __launch_bounds__(NTHREADS, 2) fwd_mega(Params p_unused) {
  __shared__ __attribute__((aligned(16))) char smem[75808];
  const int bid = blockIdx.x, nb = gridDim.x;
  volatile LAS unsigned* st = (volatile LAS unsigned*)(smem + 75792);
  if (threadIdx.x == 0) { st[0] = 0u; st[1] = 0u; }
  __syncthreads();
  KParams* kp0 = (KParams*)__builtin_amdgcn_kernarg_segment_ptr();
#define PHASE(call_)                                                                                                    \
  {                                                                                                                     \
    KParams* kq = kp0;                                                                                                  \
    asm volatile("" : "+s"(kq));                     \
    KParams& p = *kq;                                                                                                   \
    call_;                                                                                                              \
  }
  XcdBarrier bar;
  PHASE(bar = xcd_barrier_post(p.bar, st))
  PHASE(phase_prep(p, bid, nb, smem))        xcd_barrier(bar);
  PHASE(phase_fold(p, bid, nb, smem))        xcd_barrier(bar);
  PHASE(phase_norm_mod(p, bid, nb, smem))    xcd_barrier(bar);
  PHASE(phase_inproj(p, bid, nb, smem))      xcd_barrier(bar);
  PHASE(phase_ssm_pre(p, bid, nb, smem))     xcd_barrier(bar);
  PHASE(phase_ssd_dft(p, bid, nb, smem))     xcd_barrier(bar);
  PHASE(phase_ssm_post(p, bid, nb, smem))    xcd_barrier(bar);
  PHASE(phase_outproj(p, bid, nb, smem))     xcd_barrier(bar);
  PHASE(phase_postmix(p, bid, nb, smem))     xcd_barrier(bar);
  PHASE(phase_q_route(p, bid, nb, smem))     xcd_barrier(bar);
  PHASE(phase_exp_u(p, smem))                xcd_barrier(bar);
  PHASE(phase_exp_combine(p, bid, nb))       xcd_barrier(bar);
  PHASE(phase_exp_v(p, smem))                xcd_barrier(bar);
  PHASE(phase_exp_final(p, bid, nb, smem))
#undef PHASE
}

}

extern "C" void kernel_launch(void* const* d_in, const int* in_sizes, int n_in, void* d_out, int out_size, void* d_ws,
                              size_t ws_size, hipStream_t stream) {
  Params p{};
  const float** fp = reinterpret_cast<const float**>(&p);
  for (int i = 0; i < 27; ++i) fp[i] = (const float*)d_in[i];
  p.out = (float*)d_out;
  char* ws = (char*)d_ws;
  size_t off = 0;
  auto take = [&](size_t bytes) { char* r = ws + off; off += (bytes + 255) & ~(size_t)255; return r; };
  p.U8 = (uint8_t*)take((size_t)16384 * D);
  p.V8 = (uint8_t*)take((size_t)16384 * D);
  p.uscale = (float*)take((size_t)2 * 16384 * 4);
  p.hx8a = (int8_t*)take((size_t)(T + TC) * D);
  p.w8 = (int8_t*)take((size_t)NPROJ * D);
  p.ascale = (float*)take((size_t)(T + TC) * 4);
  p.wscale = (float*)take((size_t)NPROJ * 4);
  p.ycat8 = (int8_t*)take((size_t)T * D);
  p.wo8 = (int8_t*)take((size_t)D * D);
  p.yscale = (float*)take((size_t)T * 4);
  p.woscale = (float*)take((size_t)D * 4);
  p.wq8 = (int8_t*)take((size_t)1024 * D);
  p.wqscale = (float*)take((size_t)1024 * 4);
  p.w_in_t = (bf16_t*)take((size_t)NPROJ * D * 2);
  p.w_out_t = (bf16_t*)take((size_t)D * D * 2);
  p.w_q_t = (bf16_t*)take((size_t)1024 * D * 2);
  p.w_in_f = (bf16_t*)take((size_t)D * 1024 * 2);
  p.WcsT = (bf16_t*)take((size_t)4 * 512 * 256 * 2);
  p.dftm = (bf16_t*)take((size_t)1024 * 2048 * 2);
  p.Fs = (bf16_t*)take((size_t)NB * 1024 * 2048 * 2);
  p.partial = (float*)take((size_t)KSPLIT * 5 * NMOD * 4);
  p.mod = (float*)take((size_t)5 * NMOD * 4);
  p.hx = (bf16_t*)take((size_t)T * D * 2);
  p.hc = (bf16_t*)take((size_t)TC * D * 2);
  p.ABt = (bf16_t*)take((size_t)NB * 1024 * 4096 * 2);
  p.q = (float*)p.ABt;
  p.z = (bf16_t*)take((size_t)T * 1024 * 2);
  char* r1 = take(0);
  p.xbcraw = (bf16_t*)take((size_t)T * DXBC * 4);
  p.xbcraw_c = (bf16_t*)take((size_t)TC * DXBC * 4);
  p.act_tm = (bf16_t*)take((size_t)(T + TC) * DXBC * 2);
  p.act_cm_x = (bf16_t*)take((size_t)NB * 1280 * L * 2);
  p.act_cm_c = (bf16_t*)take((size_t)NB * 1280 * CTX * 2);
  p.y_x = (float*)r1;
  p.dtraw = (float*)take((size_t)T * 32 * 4);
  p.dtraw_c = (float*)take((size_t)TC * 32 * 4);
  p.dtf = (float*)take((size_t)T * 16 * 4);
  p.dtb = (float*)take((size_t)T * 16 * 4);
  p.dtf_c = (float*)take((size_t)TC * 16 * 4);
  p.dtb_c = (float*)take((size_t)TC * 16 * 4);
  p.yf = (float*)take((size_t)T * 1024 * 4);
  p.yb = (float*)take((size_t)T * 1024 * 4);
  p.ctr = (unsigned*)take(256);
  p.bar = (unsigned*)take((size_t)XCD_BAR_WORDS * 4);
  p.ycat = (bf16_t*)take((size_t)T * D * 2);
  p.idx = (int*)take((size_t)T * 128 * 4);
  p.gate = (float*)take((size_t)T * 128 * 4);
  if (off > ws_size) { fprintf(stderr, "kernel_launch: workspace too small: need %zu have %zu\n", off, ws_size); return; }
  static int grid_blocks = 0;
  if (!grid_blocks) {
    int dev = 0, cus = 0, per_cu = 0;
    hipGetDevice(&dev);
    hipDeviceGetAttribute(&cus, hipDeviceAttributeMultiprocessorCount, dev);
    hipOccupancyMaxActiveBlocksPerMultiprocessor(&per_cu, fwd_mega, NTHREADS, 0);
    if (per_cu > 2) per_cu = 2;
    grid_blocks = cus * per_cu;
    if (grid_blocks <= 0) { fprintf(stderr, "kernel_launch: occupancy query gave %d x %d\n", cus, per_cu); grid_blocks = -1; }
  }
  if (grid_blocks < 0) return;
  (void)hipMemsetAsync(p.bar, 0, (size_t)XCD_BAR_WORDS * 4, stream);
  void* args[] = {&p};
  hipError_t e = hipLaunchCooperativeKernel((void*)fwd_mega, dim3(grid_blocks), dim3(NTHREADS), args, 0, stream);
  if (e != hipSuccess) fprintf(stderr, "cooperative launch failed: %s (grid %d)\n", hipGetErrorString(e), grid_blocks);
}
```
